# Optimizing an MI355X kernel written in HIP

```python
import math
import jax, jax.numpy as jnp
from jax import lax
import numpy as np

D_MODEL = 1024
BATCH = 2
SEQ = 16384
DEPTH = 4
DEC_BATCH = 1
DEC_SEQ = 16384
PAST_LEN = 128

HY_WIDTH = D_MODEL // 2
HY_GROUPS = 8
HY_ORDER = 2
HY_PROJ = (HY_ORDER + 1) * HY_WIDTH
HY_BANDS = 16
HY_EMB = 2 * HY_BANDS + 1
HY_FFN = 64
HY_TARGET = 1e-2
HY_FAST = 0.3
HY_SLOW = 1.5
MLA_HEADS = 8
QK_NOPE = 64
QK_ROPE = 32
V_HEAD = 64
Q_RANK = 256
KV_RANK = 128
ATTN_WIDTH = MLA_HEADS * V_HEAD
ROPE_BASE = 10000.0
Q_BLOCK = 128
IN_WIDTH = HY_PROJ + Q_RANK + KV_RANK + QK_ROPE
MIX_WIDTH = HY_WIDTH + ATTN_WIDTH
D_FF = 4 * D_MODEL
EPS = 1e-6

kernel_name = 'hyena_mla_parallel_encoder'


def rms_norm(x, g):
    xf = x.astype(jnp.float32)
    y = xf * lax.rsqrt(jnp.mean(xf * xf, axis=-1, keepdims=True) + EPS)
    return (y * g.astype(jnp.float32)).astype(x.dtype)


def group_rms_norm(x, g, n_groups):
    shp = x.shape
    xf = x.astype(jnp.float32).reshape(shp[:-1] + (n_groups, shp[-1] // n_groups))
    y = xf * lax.rsqrt(jnp.mean(xf * xf, axis=-1, keepdims=True) + EPS)
    return (y.reshape(shp) * g.astype(jnp.float32)).astype(x.dtype)


def hyena_filters(L, w1, b1, w2, b2, w3, sin_freq, decay):
    f32 = jnp.float32
    t = jnp.linspace(0.0, 1.0, L, dtype=f32)[:, None]
    omega = (2.0 * math.pi / L) * jnp.arange(L, dtype=f32)
    bands = jnp.linspace(1e-4, HY_BANDS - 1, HY_BANDS, dtype=f32)
    phase = omega[:, None] * bands[None, :]
    z = jnp.concatenate([t, jnp.cos(phase), -jnp.sin(phase)], axis=-1)
    sf = sin_freq.astype(f32)
    h = jnp.sin(sf[0] * (z @ w1.astype(f32) + b1.astype(f32)))
    h = jnp.sin(sf[1] * (h @ w2.astype(f32) + b2.astype(f32)))
    h = (h @ w3.astype(f32)).reshape(L, HY_ORDER, 2, HY_WIDTH)
    h = h * jnp.exp(-t[:, :, None, None] * jnp.abs(decay.astype(f32)))
    fwd = h[:, :, 0]
    bwd = h[:, :, 1]
    k_circ = jnp.concatenate([fwd, jnp.zeros_like(fwd[:1]), bwd[:0:-1]], axis=0)
    return jnp.fft.rfft(k_circ, axis=0)


def long_conv(z, kf):
    L = z.shape[1]
    zf = jnp.fft.rfft(z.astype(jnp.float32), n=2 * L, axis=1)
    return jnp.fft.irfft(zf * kf[None], n=2 * L, axis=1)[:, :L]


def hyena_mixer(u, conv_w, conv_b, w1, b1, w2, b2, w3, sin_freq, decay, hy_bias):
    L = u.shape[1]
    up = jnp.pad(u, ((0, 0), (1, 1), (0, 0)))
    u = up[:, :-2] * conv_w[0] + up[:, 1:-1] * conv_w[1] + up[:, 2:] * conv_w[2] + conv_b
    v, x1, x2 = jnp.split(u, 3, axis=-1)
    kf = hyena_filters(L, w1, b1, w2, b2, w3, sin_freq, decay)
    z = v
    for n, gate in enumerate((x1, x2)):
        zf = z.astype(jnp.float32)
        conv = long_conv(zf, kf[:, n]) + zf * hy_bias[n].astype(jnp.float32)
        z = (gate.astype(jnp.float32) * conv).astype(u.dtype)
    return z


def rope_tables(L):
    inv = 1.0 / (ROPE_BASE ** (jnp.arange(0, QK_ROPE, 2, dtype=jnp.float32) / QK_ROPE))
    ang = jnp.arange(L, dtype=jnp.float32)[:, None] * inv[None, :]
    return jnp.cos(ang)[:, None, :], jnp.sin(ang)[:, None, :]


def apply_rope(x, cos, sin):
    half = x.shape[-1] // 2
    x1, x2 = x[..., :half], x[..., half:]
    return jnp.concatenate([x1 * cos - x2 * sin, x2 * cos + x1 * sin], axis=-1).astype(x.dtype)


def mla_mixer(p, q_norm, w_uq, kv_norm, w_ukv):
    B, L, _ = p.shape
    H = MLA_HEADS
    dq = QK_NOPE + QK_ROPE
    c_q = p[..., :Q_RANK]
    c_kv = p[..., Q_RANK:Q_RANK + KV_RANK]
    k_pe = p[..., Q_RANK + KV_RANK:]
    q = (rms_norm(c_q, q_norm) @ w_uq).reshape(B, L, H, dq)
    kv = (rms_norm(c_kv, kv_norm) @ w_ukv).reshape(B, L, H, QK_NOPE + V_HEAD)
    cos, sin = rope_tables(L)
    q = jnp.concatenate([q[..., :QK_NOPE], apply_rope(q[..., QK_NOPE:], cos, sin)], axis=-1)
    k_pe = apply_rope(k_pe[:, :, None, :], cos, sin)
    k = jnp.concatenate([kv[..., :QK_NOPE], jnp.broadcast_to(k_pe, (B, L, H, QK_ROPE))], axis=-1)
    v = kv[..., QK_NOPE:]
    q = q.transpose(0, 2, 1, 3)
    k = k.transpose(0, 2, 1, 3)
    v = v.transpose(0, 2, 1, 3)
    scale = dq ** -0.5
    nblk = L // Q_BLOCK
    qb = q.reshape(B, H, nblk, Q_BLOCK, dq).transpose(2, 0, 1, 3, 4)

    def attend(qblk):
        s = jnp.einsum('bhqd,bhkd->bhqk', qblk, k).astype(jnp.float32) * scale
        pr = jax.nn.softmax(s, axis=-1).astype(v.dtype)
        return jnp.einsum('bhqk,bhkd->bhqd', pr, v)

    o = lax.map(attend, qb)
    return o.transpose(1, 0, 3, 2, 4).reshape(B, L, H * V_HEAD)


def encoder_layer(x, w_in, hy_conv_w, hy_conv_b, hy_ffn_w1, hy_ffn_b1, hy_ffn_w2, hy_ffn_b2,
                  hy_ffn_w3, hy_sin_freq, hy_decay, hy_bias, mla_q_norm, mla_w_uq, mla_kv_norm,
                  mla_w_ukv, grp_norm_hy, grp_norm_attn, w_out, norm_mix_pre, norm_mix_post,
                  norm_mlp_pre, norm_mlp_post, w_mlp_up, w_mlp_down):
    h = rms_norm(x, norm_mix_pre)
    proj = h @ w_in
    y_hy = hyena_mixer(proj[..., :HY_PROJ], hy_conv_w, hy_conv_b, hy_ffn_w1, hy_ffn_b1,
                       hy_ffn_w2, hy_ffn_b2, hy_ffn_w3, hy_sin_freq, hy_decay, hy_bias)
    y_at = mla_mixer(proj[..., HY_PROJ:], mla_q_norm, mla_w_uq, mla_kv_norm, mla_w_ukv)
    mix = jnp.concatenate([group_rms_norm(y_hy, grp_norm_hy, HY_GROUPS),
                           group_rms_norm(y_at, grp_norm_attn, MLA_HEADS)], axis=-1) @ w_out
    x = x + rms_norm(mix, norm_mix_post)
    h = rms_norm(x, norm_mlp_pre)
    m = jnp.square(jax.nn.relu(h @ w_mlp_up)) @ w_mlp_down
    return x + rms_norm(m, norm_mlp_post)


def setup_inputs(seed: int = 0) -> dict:
    key = jax.random.key(seed)
    ks = jax.random.split(key, 26)
    f32 = jnp.float32

    def nrm(k, shape, scale):
        return jax.random.normal(k, shape, f32) * scale

    def gain(k, shape):
        return 1.0 + 0.02 * jax.random.normal(k, shape, f32)

    decay_base = jnp.abs(jnp.linspace(math.log(HY_TARGET) / HY_SLOW, math.log(HY_TARGET) / HY_FAST,
                                      HY_WIDTH, dtype=f32))
    return {
        'x_prompt': nrm(ks[0], (BATCH, SEQ, D_MODEL), 1.0),
        'x_sample': nrm(ks[1], (DEC_BATCH, DEC_SEQ, D_MODEL), 1.0),
        'w_in': nrm(ks[2], (DEPTH, D_MODEL, IN_WIDTH), D_MODEL ** -0.5),
        'hy_conv_w': nrm(ks[3], (DEPTH, 3, HY_PROJ), 3 ** -0.5),
        'hy_conv_b': nrm(ks[4], (DEPTH, HY_PROJ), 0.02),
        'hy_ffn_w1': nrm(ks[5], (DEPTH, HY_EMB, HY_FFN), HY_EMB ** -0.5),
        'hy_ffn_b1': nrm(ks[6], (DEPTH, HY_FFN), 0.02),
        'hy_ffn_w2': nrm(ks[7], (DEPTH, HY_FFN, HY_FFN), HY_FFN ** -0.5),
        'hy_ffn_b2': nrm(ks[8], (DEPTH, HY_FFN), 0.02),
        'hy_ffn_w3': nrm(ks[9], (DEPTH, HY_FFN, HY_ORDER * 2 * HY_WIDTH), HY_FFN ** -0.5),
        'hy_sin_freq': gain(ks[10], (DEPTH, 2, HY_FFN)),
        'hy_decay': decay_base * (1.0 + 0.05 * jax.random.normal(ks[11], (DEPTH, HY_ORDER, 2, HY_WIDTH), f32)),
        'hy_bias': nrm(ks[12], (DEPTH, HY_ORDER, HY_WIDTH), 1.0),
        'mla_q_norm': gain(ks[13], (DEPTH, Q_RANK)),
        'mla_w_uq': nrm(ks[14], (DEPTH, Q_RANK, MLA_HEADS * (QK_NOPE + QK_ROPE)), Q_RANK ** -0.5),
        'mla_kv_norm': gain(ks[15], (DEPTH, KV_RANK)),
        'mla_w_ukv': nrm(ks[16], (DEPTH, KV_RANK, MLA_HEADS * (QK_NOPE + V_HEAD)), KV_RANK ** -0.5),
        'grp_norm_hy': gain(ks[17], (DEPTH, HY_WIDTH)),
        'grp_norm_attn': gain(ks[18], (DEPTH, ATTN_WIDTH)),
        'w_out': nrm(ks[19], (DEPTH, MIX_WIDTH, D_MODEL), MIX_WIDTH ** -0.5),
        'norm_mix_pre': gain(ks[20], (DEPTH, D_MODEL)),
        'norm_mix_post': gain(ks[21], (DEPTH, D_MODEL)),
        'norm_mlp_pre': gain(ks[22], (DEPTH, D_MODEL)),
        'norm_mlp_post': gain(ks[23], (DEPTH, D_MODEL)),
        'w_mlp_up': nrm(ks[24], (DEPTH, D_MODEL, D_FF), D_MODEL ** -0.5),
        'w_mlp_down': nrm(ks[25], (DEPTH, D_FF, D_MODEL), D_FF ** -0.5),
    }


def reference(x_prompt, x_sample, w_in, hy_conv_w, hy_conv_b, hy_ffn_w1, hy_ffn_b1, hy_ffn_w2,
              hy_ffn_b2, hy_ffn_w3, hy_sin_freq, hy_decay, hy_bias, mla_q_norm, mla_w_uq,
              mla_kv_norm, mla_w_ukv, grp_norm_hy, grp_norm_attn, w_out, norm_mix_pre,
              norm_mix_post, norm_mlp_pre, norm_mlp_post, w_mlp_up, w_mlp_down):
    params = (w_in, hy_conv_w, hy_conv_b, hy_ffn_w1, hy_ffn_b1, hy_ffn_w2, hy_ffn_b2, hy_ffn_w3,
              hy_sin_freq, hy_decay, hy_bias, mla_q_norm, mla_w_uq, mla_kv_norm, mla_w_ukv,
              grp_norm_hy, grp_norm_attn, w_out, norm_mix_pre, norm_mix_post, norm_mlp_pre,
              norm_mlp_post, w_mlp_up, w_mlp_down)
    y_prompt = x_prompt
    y_sample = x_sample
    for i in range(DEPTH):
        layer_p = [p[i] for p in params]
        y_prompt = encoder_layer(y_prompt, *layer_p)
        y_sample = encoder_layer(y_sample, *layer_p)
    return (y_prompt, y_sample)
```

```cpp
#include <hip/hip_runtime.h>
#include <cstdio>
#include <cstdint>
namespace pg8 {
#define PG8_LAS __attribute__((address_space(3)))
typedef unsigned short bf16_t;
typedef short bf16x8 __attribute__((ext_vector_type(8)));
typedef float f32x4 __attribute__((ext_vector_type(4)));
typedef unsigned u32x4 __attribute__((ext_vector_type(4)));
constexpr int BM = 256, BK = 64, HALF = 128, HTB = HALF * BK * 2  , STAGE_BYTES = 8 * HTB, NXCD = 8, WGM = 8;

__host__ __device__ __forceinline__ int lds_byte(int r, int c) { const int st = (r >> 4) * 2 + (c >> 5), rr = r & 15, cc = c & 31, ob = rr * 64 + cc * 2; return st * 1024 + (ob ^ (((ob >> 9) & 1) << 5)); }
__host__ __device__ __forceinline__ void stage_rc(int b, int& R, int& C) { const int st = b / 1024, sb = b % 1024, swz = sb ^ (((sb >> 9) & 1) << 5); R = (st >> 1) * 16 + swz / 64; C = (st & 1) * 32 + (swz % 64) / 2; }
__host__ __device__ __forceinline__ int perm32(int rho) { const int n = rho >> 4, i = rho & 15; return 8 * (i >> 2) + 4 * n + (i & 3); }

struct Unit { int pm, pn; };
struct Gemm { const bf16_t* A; const bf16_t* Bt; int M, N, K; };

struct StaticOrder {
    int nM, nN, nwg, G, c;
    __host__ __device__ void init(int M, int N, int G_, int c_) { nM = M / BM; nN = N / BM; nwg = nM * nN; G = G_; c = c_; }
    __host__ __device__ bool next(int i, Unit& u) const {
        const long L = (long)i * G + c; if (L >= nwg) return false;
        int wgid = (int)L; { const int q = nwg / NXCD, r = nwg % NXCD, xcd = wgid % NXCD, off = wgid / NXCD; wgid = (xcd < r ? xcd * (q + 1) : r * (q + 1) + (xcd - r) * q) + off; }
        const int nig = WGM * nN, gid = wgid / nig, fm = gid * WGM, gsz = (nM - fm) < WGM ? (nM - fm) : WGM;
        u.pm = fm + ((wgid % nig) % gsz); u.pn = (wgid % nig) / gsz; return true;
    }
    __device__ __forceinline__ void a_ready(const Unit&) const {}
    __device__ __forceinline__ void done(const Unit&) const {}
};

__device__ __forceinline__ unsigned cvt_pk_bf16(float lo, float hi) { unsigned r; asm volatile("v_cvt_pk_bf16_f32 %0, %1, %2" : "=v"(r) : "v"(lo), "v"(hi)); return r; }
typedef float f32x2 __attribute__((ext_vector_type(2)));
__device__ __forceinline__ void relane(int& wr, int& wc, int& fr, int& fq) { int t = threadIdx.x; asm volatile("" : "+v"(t)); const int wid = __builtin_amdgcn_readfirstlane(t >> 6), lane = t & 63; wr = wid >> 2; wc = wid & 3; fr = lane & 15; fq = lane >> 4; }
__device__ __forceinline__ f32x2 gelu_pk(f32x2 v) {
    const f32x2 av = __builtin_elementwise_abs(v), d = av * 0.2316418882f + 1.0f;
    f32x2 t; t.x = __builtin_amdgcn_rcpf(d.x); t.y = __builtin_amdgcn_rcpf(d.y);
    f32x2 q = t * 0.5307027145f + (-0.7265760135f); q = q * t + 0.7107068705f; q = q * t + (-0.142248368f); q = q * t + 0.127414796f; q = q * t;
    const f32x2 s = (v * v) * (-0.72134752044f);
    f32x2 e; e.x = __builtin_amdgcn_exp2f(s.x); e.y = __builtin_amdgcn_exp2f(s.y);
    const f32x2 m = v * (q * e), r = v - m;
    f32x2 o; o.x = v.x < 0.f ? m.x : r.x; o.y = v.y < 0.f ? m.y : r.y; return o;
}

template <int ACT  > struct EpiBf16 {
    static constexpr bool PERM = true, AFTER_DRAIN = false; static_assert(ACT == 0 || ACT == 1, "EpiBf16: ACT is 0 (none) or 1 (gelu_pk)");
    bf16_t* O; int ldc; const float* bias; int split_cols; size_t split_stride; float scale0;
    __device__ __forceinline__ void operator()(const f32x4 (&acc)[2][2][4][2], const Unit& u, int wr, int wc, int fr, int fq) const {
        relane(wr, wc, fr, fq);
        const int row0 = u.pm * BM + wr * 64 + fr; int colt = u.pn * BM; bf16_t* base = O;
        float sc = 1.f; if (split_cols) { const int t = colt / split_cols; base += (size_t)t * split_stride; colt -= t * split_cols; if (t == 0) sc = scale0; }
        const int col0 = colt + wc * 32 + 8 * fq, bcol0 = u.pn * BM + wc * 32 + 8 * fq;
        f32x4 bv[2][2];
#pragma unroll
        for (int bj = 0; bj < 2; ++bj)
#pragma unroll
            for (int n = 0; n < 2; ++n) bv[bj][n] = bias ? *(const f32x4*)(bias + bcol0 + bj * HALF + 4 * n) : (f32x4){0.f, 0.f, 0.f, 0.f};
#pragma unroll
        for (int ai = 0; ai < 2; ++ai)
#pragma unroll
            for (int m = 0; m < 4; ++m) { bf16_t* rowp = base + (size_t)(row0 + ai * HALF + m * 16) * ldc + col0;
#pragma unroll
                for (int bj = 0; bj < 2; ++bj) { f32x4 v0 = acc[ai][bj][m][0] + bv[bj][0], v1 = acc[ai][bj][m][1] + bv[bj][1];
                    if (ACT == 1) { f32x2 a = gelu_pk((f32x2){v0[0], v0[1]}), b = gelu_pk((f32x2){v0[2], v0[3]}), c = gelu_pk((f32x2){v1[0], v1[1]}), d = gelu_pk((f32x2){v1[2], v1[3]});
                        v0 = (f32x4){a.x, a.y, b.x, b.y}; v1 = (f32x4){c.x, c.y, d.x, d.y}; }
                    v0 = v0 * sc; v1 = v1 * sc; u32x4 w; w.x = cvt_pk_bf16(v0[0], v0[1]); w.y = cvt_pk_bf16(v0[2], v0[3]); w.z = cvt_pk_bf16(v1[0], v1[1]); w.w = cvt_pk_bf16(v1[2], v1[3]);
                    *(u32x4*)(rowp + bj * HALF) = w; } }
    }
};

struct PanelStats {
    unsigned* xbuf;
    unsigned* cnt;
    unsigned* tmo;
    int ntn; float eps;
    unsigned code;
    __device__ __forceinline__ bool run(const f32x4 (&v)[2][2][4][2], const Unit& u, int wr, int wc, int fr, int fq, PG8_LAS unsigned char* lds, int wid, int lane) const {
        typedef float f32x2v __attribute__((ext_vector_type(2)));
        PG8_LAS f32x2v* P = (PG8_LAS f32x2v*)lds;
        PG8_LAS f32x2v* S = (PG8_LAS f32x2v*)(lds + 8192);
        PG8_LAS unsigned* flag = (PG8_LAS unsigned*)(lds + 8192 + 2048);
#pragma unroll
        for (int ai = 0; ai < 2; ++ai)
#pragma unroll
            for (int m = 0; m < 4; ++m) {
                float s = 0.f;
#pragma unroll
                for (int bj = 0; bj < 2; ++bj)
#pragma unroll
                    for (int n = 0; n < 2; ++n) { const f32x4 x = v[ai][bj][m][n]; s += (x[0] + x[1]) + (x[2] + x[3]); }
                s += __shfl_xor(s, 16); s += __shfl_xor(s, 32);
                const float mw = s * (1.0f / 64.0f); float q = 0.f;
#pragma unroll
                for (int bj = 0; bj < 2; ++bj)
#pragma unroll
                    for (int n = 0; n < 2; ++n) { const f32x4 d = v[ai][bj][m][n] - mw; q += (d[0] * d[0] + d[1] * d[1]) + (d[2] * d[2] + d[3] * d[3]); }
                q += __shfl_xor(q, 16); q += __shfl_xor(q, 32);
                if (fq == 0) P[(ai * HALF + wr * 64 + m * 16 + fr) * 4 + wc] = (f32x2v){mw, q};
            }
        asm volatile("s_waitcnt lgkmcnt(0)" ::: "memory"); __builtin_amdgcn_s_barrier(); asm volatile("" ::: "memory");
#if defined(BROKEN_EXCHANGE_NO_WAIT)
#warning BROKEN CONTROL BUILD: the row-statistics exchange does not wait; results are wrong by design
        if (blockIdx.x >= 64) { const long long t0_ = clock64(); while (clock64() - t0_ < 60000) __builtin_amdgcn_s_sleep(8); }
#endif
        const int row = wid * 32 + (lane & 31);
        if (lane < 32) {
            const f32x2v a = P[row * 4 + 0], b = P[row * 4 + 1], c = P[row * 4 + 2], d = P[row * 4 + 3];
            const float mt = (a.x + b.x + c.x + d.x) * 0.25f;
            const float da = a.x - mt, db = b.x - mt, dc = c.x - mt, dd = d.x - mt;
            const float m2 = (a.y + b.y) + (c.y + d.y) + 64.0f * ((da * da + db * db) + (dc * dc + dd * dd));
            unsigned long long* slot = (unsigned long long*)xbuf + ((size_t)(u.pm * BM + row) * 4 + u.pn);
            __hip_atomic_store(slot, ((unsigned long long)__float_as_uint(m2) << 32) | __float_as_uint(mt), __ATOMIC_RELAXED, __HIP_MEMORY_SCOPE_AGENT);
        }
        asm volatile("s_waitcnt vmcnt(0)" ::: "memory");
        if (lane == 0) __hip_atomic_fetch_add(cnt + 64 * u.pm, 1u, __ATOMIC_RELAXED, __HIP_MEMORY_SCOPE_AGENT);
        if (wid == 0) {
            bool dead = false; const unsigned long long t0 = __builtin_amdgcn_s_memrealtime(); const unsigned want = 8u * (unsigned)ntn;
            for (;;) {
#if defined(BROKEN_EXCHANGE_NO_WAIT)
                break;
#endif
                if ((unsigned)__builtin_amdgcn_readfirstlane(__hip_atomic_load(cnt + 64 * u.pm, __ATOMIC_RELAXED, __HIP_MEMORY_SCOPE_AGENT)) >= want) break;
                if (__builtin_amdgcn_s_memrealtime() - t0 > 2000000ull) {
                    if (lane == 0) { unsigned expect = 0u; __hip_atomic_compare_exchange_strong(tmo + 1, &expect, code | (unsigned)(u.pm & 0xff), __ATOMIC_RELAXED, __ATOMIC_RELAXED, __HIP_MEMORY_SCOPE_AGENT);
                                     __hip_atomic_store(tmo, 1u, __ATOMIC_RELAXED, __HIP_MEMORY_SCOPE_AGENT); }
                    dead = true; break; }
                __builtin_amdgcn_s_sleep(2);
            }
            __builtin_amdgcn_fence(__ATOMIC_ACQUIRE, "agent");
            if (lane == 0) flag[0] = dead ? 1u : 0u;
        }
        asm volatile("s_waitcnt vmcnt(0) lgkmcnt(0)" ::: "memory"); __builtin_amdgcn_s_barrier(); asm volatile("" ::: "memory");
        const bool bad = flag[0] != 0u;
        if (lane < 32) {
            const unsigned long long* slot = (const unsigned long long*)xbuf + (size_t)(u.pm * BM + row) * 4; float mt[4], m2[4]; float ms = 0.f;
#pragma unroll
            for (int t = 0; t < 4; ++t) { if (t < ntn) { const unsigned long long w = __hip_atomic_load(slot + t, __ATOMIC_RELAXED, __HIP_MEMORY_SCOPE_AGENT); mt[t] = __uint_as_float((unsigned)w); m2[t] = __uint_as_float((unsigned)(w >> 32)); } else { mt[t] = 0.f; m2[t] = 0.f; } ms += mt[t]; }
            const float mean = ms / (float)ntn; float q = 0.f;
#pragma unroll
            for (int t = 0; t < 4; ++t) if (t < ntn) { const float dm = mt[t] - mean; q += m2[t] + 256.0f * dm * dm; }
            S[row] = (f32x2v){mean, 1.0f / sqrtf(q / (256.0f * (float)ntn) + eps)};
        }
        asm volatile("s_waitcnt lgkmcnt(0)" ::: "memory"); __builtin_amdgcn_s_barrier(); asm volatile("" ::: "memory");
        return bad;
    }
};
struct EpiLnRes {
    static constexpr bool PERM = false, AFTER_DRAIN = true;
    const float* base; float* out; int ldc; const float* bias; PanelStats st; unsigned poison;
    __device__ __forceinline__ void fused(f32x4 (&acc)[2][2][4][2], const Unit& u, int wr, int wc, int fr, int fq, PG8_LAS unsigned char* lds, int wid, int lane) const {
        typedef float f32x2v __attribute__((ext_vector_type(2)));
        const PG8_LAS f32x2v* S = (const PG8_LAS f32x2v*)(lds + 8192);
        const int col0 = u.pn * BM + wc * 32 + 4 * fq;
#pragma unroll
        for (int bj = 0; bj < 2; ++bj)
#pragma unroll
            for (int n = 0; n < 2; ++n) { const f32x4 bv = bias ? *(const f32x4*)(bias + col0 + bj * HALF + n * 16) : (f32x4){0.f, 0.f, 0.f, 0.f};
#pragma unroll
                for (int ai = 0; ai < 2; ++ai)
#pragma unroll
                    for (int m = 0; m < 4; ++m) acc[ai][bj][m][n] += bv; }
        f32x4 pre[4][2][2];
#pragma unroll
        for (int m = 0; m < 4; ++m) { const size_t off = (size_t)(u.pm * BM + wr * 64 + m * 16 + fr) * ldc + col0;
#pragma unroll
            for (int bj = 0; bj < 2; ++bj)
#pragma unroll
                for (int n = 0; n < 2; ++n) pre[m][bj][n] = *(const f32x4*)(base + off + bj * HALF + n * 16); }
        const bool bad = st.run(acc, u, wr, wc, fr, fq, lds, wid, lane) || poison != 0u;
        const float qnan = __builtin_nanf("");
#pragma unroll
        for (int ai = 0; ai < 2; ++ai)
#pragma unroll
            for (int m = 0; m < 4; ++m) { const int r = ai * HALF + wr * 64 + m * 16 + fr; const f32x2v sr = S[r]; const size_t off = (size_t)(u.pm * BM + r) * ldc + col0;
#pragma unroll
                for (int bj = 0; bj < 2; ++bj)
#pragma unroll
                    for (int n = 0; n < 2; ++n) { const f32x4 bs = ai == 0 ? pre[m][bj][n] : *(const f32x4*)(base + off + bj * HALF + n * 16); f32x4 o = bs + (acc[ai][bj][m][n] - sr.x) * sr.y;
                        if (bad) o = (f32x4){qnan, qnan, qnan, qnan}; *(f32x4*)(out + off + bj * HALF + n * 16) = o; }
                if (m & 1) asm volatile("" ::: "memory"); }
    }
};
struct EpiLnResLn {
    static constexpr bool PERM = false, AFTER_DRAIN = true;
    const float* base; float* out; bf16_t* xn; int ldc; const float* bias; PanelStats st1, st2; unsigned poison;
    __device__ __forceinline__ void fused(f32x4 (&acc)[2][2][4][2], const Unit& u, int wr, int wc, int fr, int fq, PG8_LAS unsigned char* lds, int wid, int lane) const {
        typedef float f32x2v __attribute__((ext_vector_type(2))); typedef unsigned u32x2v __attribute__((ext_vector_type(2)));
        const PG8_LAS f32x2v* S = (const PG8_LAS f32x2v*)(lds + 8192);
        const int col0 = u.pn * BM + wc * 32 + 4 * fq;
#pragma unroll
        for (int bj = 0; bj < 2; ++bj)
#pragma unroll
            for (int n = 0; n < 2; ++n) { const f32x4 bv = bias ? *(const f32x4*)(bias + col0 + bj * HALF + n * 16) : (f32x4){0.f, 0.f, 0.f, 0.f};
#pragma unroll
                for (int ai = 0; ai < 2; ++ai)
#pragma unroll
                    for (int m = 0; m < 4; ++m) acc[ai][bj][m][n] += bv; }
        bool bad = st1.run(acc, u, wr, wc, fr, fq, lds, wid, lane) || poison != 0u;
        const float qnan = __builtin_nanf("");
#pragma unroll
        for (int ai = 0; ai < 2; ++ai)
#pragma unroll
            for (int m = 0; m < 4; ++m) { const int r = ai * HALF + wr * 64 + m * 16 + fr; const f32x2v sr = S[r]; const size_t off = (size_t)(u.pm * BM + r) * ldc + col0;
#pragma unroll
                for (int bj = 0; bj < 2; ++bj)
#pragma unroll
                    for (int n = 0; n < 2; ++n) { const f32x4 bs = *(const f32x4*)(base + off + bj * HALF + n * 16); acc[ai][bj][m][n] = bs + (acc[ai][bj][m][n] - sr.x) * sr.y; }
                asm volatile("" : "+v"(acc[ai][0][m][0]), "+v"(acc[ai][0][m][1]), "+v"(acc[ai][1][m][0]), "+v"(acc[ai][1][m][1]));
                if (m & 1) asm volatile("" ::: "memory"); }
        const bool bad1 = bad;
        bad = st2.run(acc, u, wr, wc, fr, fq, lds, wid, lane) || bad;
#pragma unroll
        for (int ai = 0; ai < 2; ++ai)
#pragma unroll
            for (int m = 0; m < 4; ++m) { const int r = ai * HALF + wr * 64 + m * 16 + fr; const f32x2v sr = S[r]; const size_t off = (size_t)(u.pm * BM + r) * ldc + col0;
#pragma unroll
                for (int bj = 0; bj < 2; ++bj)
#pragma unroll
                    for (int n = 0; n < 2; ++n) { const f32x4 x1 = acc[ai][bj][m][n]; *(f32x4*)(out + off + bj * HALF + n * 16) = bad1 ? (f32x4){qnan, qnan, qnan, qnan} : x1;
                        const f32x4 o = (x1 - sr.x) * sr.y; u32x2v w; w.x = cvt_pk_bf16(o[0], o[1]); w.y = cvt_pk_bf16(o[2], o[3]);
                        if (bad) { w.x = 0x7fc07fc0u; w.y = 0x7fc07fc0u; } *(u32x2v*)(xn + off + bj * HALF + n * 16) = w; }
                asm volatile("" ::: "memory"); }
    }
};

template <class Epi, class Sched, bool ALIGN_EPI = false, bool SP2 = false>
__device__ __forceinline__ void gemm_phase(PG8_LAS unsigned char* lds, const Gemm g, const Sched& S, const Epi& E) {
    int tid_ = threadIdx.x; asm volatile("" : "+v"(tid_));
    const int tid = tid_, wid = __builtin_amdgcn_readfirstlane(tid >> 6), lane = tid & 63, wr = wid >> 2, wc = wid & 3, fr = lane & 15, fq = lane >> 4;
    const int K = g.K, nt = K / BK;
    unsigned voffA[2], voffB[2];
#pragma unroll
    for (int i = 0; i < 2; ++i) { int R, C; stage_rc(tid * 16 + i * 8192, R, C); const int Rb = Epi::PERM ? ((R & ~31) + perm32(R & 31)) : R;
        voffA[i] = (unsigned)(R * K + C) * 2u; voffB[i] = (unsigned)(Rb * K + C) * 2u; }
    const size_t kstep = (size_t)(BK * 2);
    const size_t hstep = (size_t)HALF * K * 2;
    const size_t tstep = 2 * hstep;
    const unsigned ldsw = (unsigned)wid * 1024u;
    const int aoff = lds_byte(wr * 64 + fr, fq * 8), boff = lds_byte(wc * 32 + fr, fq * 8);
#define PG8_SA(b, h) (((b) * 2 + (h)) * HTB)
#define PG8_SB(b, h) ((4 + (b) * 2 + (h)) * HTB)
#define PG8_STAGE(bufoff, gbase, voff) do { _Pragma("unroll") for (int _i = 0; _i < 2; ++_i) \
        __builtin_amdgcn_global_load_lds((const unsigned*)((const char*)(gbase) + (voff)[_i]), (PG8_LAS unsigned*)(lds + (bufoff) + ldsw + _i * 8192), 16, 0, 0); } while (0)
#define PG8_LDA(dst, b, h) do { _Pragma("unroll") for (int m = 0; m < 4; ++m) _Pragma("unroll") for (int k = 0; k < 2; ++k) dst[m][k] = *(const PG8_LAS bf16x8*)(lds + PG8_SA(b, h) + aoff + m * 2048 + k * 1024); } while (0)
#define PG8_LDB(dst, b, h) do { _Pragma("unroll") for (int n = 0; n < 2; ++n) _Pragma("unroll") for (int k = 0; k < 2; ++k) dst[n][k] = *(const PG8_LAS bf16x8*)(lds + PG8_SB(b, h) + boff + n * 2048 + k * 1024); } while (0)
#define PG8_MMA(ai, bj, At, Bt) do { __builtin_amdgcn_s_setprio(1); _Pragma("unroll") for (int m = 0; m < 4; ++m) _Pragma("unroll") for (int n = 0; n < 2; ++n) _Pragma("unroll") for (int k = 0; k < 2; ++k) \
        acc[ai][bj][m][n] = __builtin_amdgcn_mfma_f32_16x16x32_bf16(Bt[n][k], At[m][k], acc[ai][bj][m][n], 0, 0, 0); __builtin_amdgcn_s_setprio(0); } while (0)
#define PG8_WAIT_V(n) asm volatile("s_waitcnt vmcnt(" #n ")" ::: "memory")
#define PG8_WAIT_L(n) asm volatile("s_waitcnt lgkmcnt(" #n ")" ::: "memory")
#define PG8_BAR __builtin_amdgcn_s_barrier()
#define PG8_SCHED __builtin_amdgcn_sched_barrier(0)
    Unit cur, nxt; int ui = 0;
    if (!S.next(0, cur)) return;
    f32x4 acc[2][2][4][2];
#pragma unroll
    for (int a = 0; a < 2; ++a)
#pragma unroll
        for (int b = 0; b < 2; ++b)
#pragma unroll
            for (int m = 0; m < 4; ++m)
#pragma unroll
                for (int n = 0; n < 2; ++n) acc[a][b][m][n] = (f32x4){0.f, 0.f, 0.f, 0.f};
    bf16x8 At[4][2], B0[2][2], B1[2][2];
    const char* cA = (const char*)g.A + (size_t)cur.pm * tstep; const char* cB = (const char*)g.Bt + (size_t)cur.pn * tstep;
    S.a_ready(cur);
    if constexpr (SP2) {
        PG8_STAGE(PG8_SB(0, 0), cB, voffB); PG8_STAGE(PG8_SB(0, 1), cB + hstep, voffB); PG8_STAGE(PG8_SA(0, 0), cA, voffA); PG8_STAGE(PG8_SA(0, 1), cA + hstep, voffA);
        if (wr == 1) PG8_BAR;
        PG8_WAIT_V(2); PG8_BAR;
        PG8_STAGE(PG8_SB(1, 0), cB + kstep, voffB); PG8_STAGE(PG8_SA(1, 0), cA + kstep, voffA); PG8_STAGE(PG8_SB(1, 1), cB + hstep + kstep, voffB);
        PG8_WAIT_V(6); PG8_BAR;
    } else {
        PG8_STAGE(PG8_SB(0, 0), cB, voffB); PG8_STAGE(PG8_SA(0, 0), cA, voffA); PG8_STAGE(PG8_SB(0, 1), cB + hstep, voffB); PG8_STAGE(PG8_SA(0, 1), cA + hstep, voffA);
        if (wr == 1) PG8_BAR;
        PG8_WAIT_V(4); PG8_BAR;
        PG8_STAGE(PG8_SB(1, 0), cB + kstep, voffB); PG8_STAGE(PG8_SA(1, 0), cA + kstep, voffA); PG8_STAGE(PG8_SB(1, 1), cB + hstep + kstep, voffB);
        PG8_WAIT_V(6); PG8_BAR;
    }
    for (;;) {
        const bool has_next = S.next(ui + 1, nxt);
        const char* nA = has_next ? (const char*)g.A + (size_t)nxt.pm * tstep : cA; const char* nB = has_next ? (const char*)g.Bt + (size_t)nxt.pn * tstep : cB;
        for (int t = 0; t < nt; t += 2) {
            const bool last = (t == nt - 2);
            const char* a1 = cA + (size_t)(t + 1) * kstep;
            const char* a2 = last ? nA : cA + (size_t)(t + 2) * kstep; const char* b2 = last ? nB : cB + (size_t)(t + 2) * kstep;
            const char* a3 = a2 + kstep; const char* b3 = b2 + kstep;
            if (last && has_next) S.a_ready(nxt);
            if constexpr (SP2) {
            PG8_LDB(B0, 0, 0); PG8_LDB(B1, 0, 1); PG8_SCHED; PG8_LDA(At, 0, 0); PG8_STAGE(PG8_SA(1, 1), a1 + hstep, voffA);
            PG8_WAIT_V(8); PG8_WAIT_L(0); PG8_BAR; PG8_MMA(0, 0, At, B0); PG8_MMA(0, 1, At, B1); PG8_BAR; PG8_SCHED;
            PG8_LDA(At, 0, 1); PG8_STAGE(PG8_SB(0, 0), b2, voffB); PG8_STAGE(PG8_SB(0, 1), b2 + hstep, voffB); PG8_STAGE(PG8_SA(0, 0), a2, voffA);
            PG8_WAIT_V(8); PG8_WAIT_L(0); PG8_BAR; PG8_MMA(1, 0, At, B0); PG8_MMA(1, 1, At, B1); PG8_BAR; PG8_SCHED;
            PG8_LDB(B0, 1, 0); PG8_LDB(B1, 1, 1); PG8_SCHED; PG8_LDA(At, 1, 0); PG8_STAGE(PG8_SA(0, 1), a2 + hstep, voffA);
            PG8_WAIT_V(8); PG8_WAIT_L(0); PG8_BAR; PG8_MMA(0, 0, At, B0); PG8_MMA(0, 1, At, B1); PG8_BAR; PG8_SCHED;
            PG8_LDA(At, 1, 1); PG8_STAGE(PG8_SB(1, 0), b3, voffB); PG8_STAGE(PG8_SB(1, 1), b3 + hstep, voffB); PG8_STAGE(PG8_SA(1, 0), a3, voffA);
            PG8_WAIT_V(8); PG8_WAIT_L(0); PG8_BAR; PG8_MMA(1, 0, At, B0); PG8_MMA(1, 1, At, B1); PG8_BAR; PG8_SCHED;
            } else {
            PG8_LDB(B0, 0, 0); PG8_SCHED; PG8_LDA(At, 0, 0); PG8_STAGE(PG8_SA(1, 1), a1 + hstep, voffA);
            PG8_WAIT_L(8); PG8_BAR; PG8_WAIT_L(0); PG8_MMA(0, 0, At, B0); PG8_BAR; PG8_SCHED;
            PG8_LDB(B1, 0, 1); PG8_STAGE(PG8_SB(0, 0), b2, voffB);
            PG8_BAR; PG8_WAIT_L(0); PG8_MMA(0, 1, At, B1); PG8_BAR;
            PG8_LDA(At, 0, 1); PG8_STAGE(PG8_SA(0, 0), a2, voffA);
            PG8_BAR; PG8_WAIT_L(0); PG8_MMA(1, 0, At, B0); PG8_BAR; PG8_SCHED;
            PG8_STAGE(PG8_SB(0, 1), b2 + hstep, voffB);
            PG8_WAIT_V(6); PG8_BAR; PG8_MMA(1, 1, At, B1); PG8_BAR;
            PG8_LDB(B0, 1, 0); PG8_SCHED; PG8_LDA(At, 1, 0); PG8_STAGE(PG8_SA(0, 1), a2 + hstep, voffA);
            PG8_WAIT_L(8); PG8_BAR; PG8_WAIT_L(0); PG8_MMA(0, 0, At, B0); PG8_BAR; PG8_SCHED;
            PG8_LDB(B1, 1, 1); PG8_STAGE(PG8_SB(1, 0), b3, voffB);
            PG8_BAR; PG8_WAIT_L(0); PG8_MMA(0, 1, At, B1); PG8_BAR;
            PG8_LDA(At, 1, 1); PG8_STAGE(PG8_SA(1, 0), a3, voffA);
            PG8_BAR; PG8_WAIT_L(0); PG8_MMA(1, 0, At, B0); PG8_BAR; PG8_SCHED;
            PG8_STAGE(PG8_SB(1, 1), b3 + hstep, voffB);
            PG8_WAIT_V(6); PG8_BAR; PG8_MMA(1, 1, At, B1); PG8_BAR;
            }
        }
        if constexpr (ALIGN_EPI) { if (wr == 0) PG8_BAR; }
        if constexpr (!Epi::AFTER_DRAIN) { E(acc, cur, wr, wc, fr, fq); S.done(cur); }
        if (!has_next) break;
#pragma unroll
        for (int a = 0; a < 2; ++a)
#pragma unroll
            for (int b = 0; b < 2; ++b)
#pragma unroll
                for (int m = 0; m < 4; ++m)
#pragma unroll
                    for (int n = 0; n < 2; ++n) acc[a][b][m][n] = (f32x4){0.f, 0.f, 0.f, 0.f};
        cur = nxt; cA = nA; cB = nB; ++ui;
        if constexpr (ALIGN_EPI) { if (wr == 1) PG8_BAR; }
    }
    PG8_WAIT_V(0);
    if constexpr (!ALIGN_EPI) { if (wr == 0) PG8_BAR; }
    PG8_BAR;
    if constexpr (Epi::AFTER_DRAIN) { E.fused(acc, cur, wr, wc, fr, fq, lds, wid, lane); S.done(cur); }
#undef PG8_SA
#undef PG8_SB
#undef PG8_STAGE
#undef PG8_LDA
#undef PG8_LDB
#undef PG8_MMA
#undef PG8_WAIT_V
#undef PG8_WAIT_L
#undef PG8_BAR
#undef PG8_SCHED
}
}

namespace pg8 {
struct EpiRelu2 {
    static constexpr bool PERM = true, AFTER_DRAIN = false;
    bf16_t* O; int ldc;
    __device__ __forceinline__ void operator()(const f32x4 (&acc)[2][2][4][2], const Unit& u, int wr, int wc, int fr, int fq) const {
        relane(wr, wc, fr, fq);
        const int row0 = u.pm * BM + wr * 64 + fr, col0 = u.pn * BM + wc * 32 + 8 * fq;
#pragma unroll
        for (int ai = 0; ai < 2; ++ai)
#pragma unroll
            for (int m = 0; m < 4; ++m) { bf16_t* rowp = O + (size_t)(row0 + ai * HALF + m * 16) * ldc + col0;
#pragma unroll
                for (int bj = 0; bj < 2; ++bj) { f32x4 v0 = acc[ai][bj][m][0], v1 = acc[ai][bj][m][1];
                    v0 = __builtin_elementwise_max(v0, (f32x4){0.f, 0.f, 0.f, 0.f}); v1 = __builtin_elementwise_max(v1, (f32x4){0.f, 0.f, 0.f, 0.f}); v0 = v0 * v0; v1 = v1 * v1;
                    u32x4 w; w.x = cvt_pk_bf16(v0[0], v0[1]); w.y = cvt_pk_bf16(v0[2], v0[3]); w.z = cvt_pk_bf16(v1[0], v1[1]); w.w = cvt_pk_bf16(v1[2], v1[3]);
                    *(u32x4*)(rowp + bj * HALF) = w; } }
    }
};
struct EpiF32 {
    static constexpr bool PERM = false, AFTER_DRAIN = false;
    float* O; int ldc;
    __device__ __forceinline__ void operator()(const f32x4 (&acc)[2][2][4][2], const Unit& u, int wr, int wc, int fr, int fq) const {
        relane(wr, wc, fr, fq);
        const int row0 = u.pm * BM + wr * 64 + fr, col0 = u.pn * BM + wc * 32 + 4 * fq;
#pragma unroll
        for (int ai = 0; ai < 2; ++ai)
#pragma unroll
            for (int m = 0; m < 4; ++m) { float* rowp = O + (size_t)(row0 + ai * HALF + m * 16) * ldc + col0;
#pragma unroll
                for (int bj = 0; bj < 2; ++bj)
#pragma unroll
                    for (int n = 0; n < 2; ++n) *(f32x4*)(rowp + bj * HALF + n * 16) = acc[ai][bj][m][n]; }
    }
};
struct EpiKV {
    static constexpr bool PERM = true, AFTER_DRAIN = false;
    bf16_t* KN; long vdelta;
    __device__ __forceinline__ void operator()(const f32x4 (&acc)[2][2][4][2], const Unit& u, int wr, int wc, int fr, int fq) const {
        relane(wr, wc, fr, fq);
        const int row0 = u.pm * BM + wr * 64 + fr; bf16_t* base = KN + (long)(wc >> 1) * vdelta; const int cin = (wc & 1) * 32 + 8 * fq;
#pragma unroll
        for (int ai = 0; ai < 2; ++ai)
#pragma unroll
            for (int m = 0; m < 4; ++m) { const int row = row0 + ai * HALF + m * 16;
#pragma unroll
                for (int bj = 0; bj < 2; ++bj) { const f32x4 v0 = acc[ai][bj][m][0], v1 = acc[ai][bj][m][1]; const int head = u.pn * 2 + bj;
                    u32x4 w; w.x = cvt_pk_bf16(v0[0], v0[1]); w.y = cvt_pk_bf16(v0[2], v0[3]); w.z = cvt_pk_bf16(v1[0], v1[1]); w.w = cvt_pk_bf16(v1[2], v1[3]);
                    *(u32x4*)(base + (size_t)row * 512 + head * 64 + cin) = w; } }
    }
};
}

constexpr int L = 16384, NSEQ = 3, M = NSEQ * L, D = 1024, DEPTH = 4;
constexpr int HYW = 512, HYP = 1536, QR = 256, KVR = 128, ROPE = 32, INW = 1952;
constexpr int NH = 8, DQ = 96, DV = 64, NQ = NH * DQ, NKV = NH * 128;
constexpr int FF = 4096;
constexpr float EPS = 1e-6f;
constexpr int NWAVES = 8, NTHR = 512;
constexpr int MLP_CHUNK = 16384, N_MLP_CHUNKS = M / MLP_CHUNK;

constexpr size_t MiB = 1u << 20;
constexpr size_t WS_CTL = 0, CTL_ZERO_BYTES = 65536;
constexpr size_t WS_COS = 1 * MiB, WS_SIN = 2 * MiB;
constexpr size_t WS_H2 = 4 * MiB;
constexpr size_t WS_WIN = 12 * MiB, WS_WOUT = 16 * MiB, WS_WUP = 18 * MiB, WS_WDOWN = 26 * MiB, WS_WUQ = 34 * MiB, WS_WUKV = 34 * MiB + 512 * 1024;
constexpr size_t WS_XN = 36 * MiB;
constexpr size_t WS_CQN = 36 * MiB, WS_CKVN = 60 * MiB, WS_KPE = 72 * MiB;
constexpr size_t WS_KEO = 132 * MiB;
constexpr size_t WS_KT = 261 * MiB;
constexpr size_t WS_UT = 261 * MiB;
constexpr size_t WS_CQKV = 405 * MiB;
constexpr size_t WS_YT = 453 * MiB;
constexpr size_t WS_Q = 132 * MiB, WS_KN = 204 * MiB, WS_V = 252 * MiB;
constexpr size_t WS_MIX = 324 * MiB;
constexpr size_t WS_T = 132 * MiB;
constexpr size_t WS_H = 324 * MiB;
constexpr size_t WS_G0 = 75 * MiB, WS_G1A = 107 * MiB, WS_G1B = 501 * MiB;
constexpr size_t WS_END = 508 * MiB;
constexpr int KEO_BLK = 16512, KEO_KO = 8256;
static_assert(WS_KEO + (size_t)1024 * KEO_BLK * 8 <= WS_KT, "KEO fits");
static_assert(WS_UT + (size_t)HYP * M * 2 <= WS_CQKV && WS_CQKV + (size_t)M * 512 * 2 <= WS_YT && WS_YT + (size_t)HYW * M * 2 <= WS_END, "map");
static_assert(WS_V + (size_t)M * 512 * 2 <= WS_MIX && WS_T + (size_t)M * D * 4 <= WS_MIX && WS_H + (size_t)MLP_CHUNK * FF * 2 <= WS_END, "map2");

constexpr int RING_OFF = 0, RING_BYTES = 139264;
constexpr int LDSCTL_OFF = RING_BYTES, MISC_OFF = LDSCTL_OFF + 320;
constexpr int LDS_BYTES = 147456;
static_assert(MISC_OFF + 128 <= LDS_BYTES, "LDS map");

#define GAS __attribute__((address_space(1)))
#define LAS __attribute__((address_space(3)))
typedef unsigned short bf16;
typedef unsigned v4u __attribute__((ext_vector_type(4)));
typedef unsigned v2u __attribute__((ext_vector_type(2)));
typedef float f32x4 __attribute__((ext_vector_type(4)));
typedef float f32x2 __attribute__((ext_vector_type(2)));
typedef short bf16x8 __attribute__((ext_vector_type(8)));
typedef GAS unsigned gu32;
#define RLX_AGENT __ATOMIC_RELAXED, __HIP_MEMORY_SCOPE_AGENT
#define LDS_WAIT() asm volatile("s_waitcnt lgkmcnt(0)" ::: "memory")
#define VM_WAIT() asm volatile("s_waitcnt vmcnt(0)" ::: "memory")
typedef __bf16 bf16x2_t __attribute__((ext_vector_type(2)));
__device__ __forceinline__ unsigned pk2(float lo, float hi) { f32x2 v = {lo, hi}; bf16x2_t b = __builtin_convertvector(v, bf16x2_t); return __builtin_bit_cast(unsigned, b); }
__device__ __forceinline__ bf16 f2bf(float f) { return (bf16)(pk2(f, 0.f) & 0xffffu); }
__device__ __forceinline__ float bf2f(unsigned h) { return __uint_as_float(h << 16); }
__device__ __forceinline__ float wave_sum(float v) {
#pragma unroll
    for (int o = 1; o < 64; o <<= 1) v += __shfl_xor(v, o);
    return v;
}

namespace hfft {
constexpr float w32c(int i) { constexpr float t[16] = {1.000000000e+00f, 9.807852507e-01f, 9.238795042e-01f, 8.314695954e-01f, 7.071067691e-01f, 5.555702448e-01f, 3.826834261e-01f, 1.950903237e-01f, 0.f, -1.950903237e-01f, -3.826834261e-01f, -5.555702448e-01f, -7.071067691e-01f, -8.314695954e-01f, -9.238795042e-01f, -9.807852507e-01f}; return t[i]; }
constexpr float w32s(int i) { constexpr float t[16] = {0.000000000e+00f, 1.950903237e-01f, 3.826834261e-01f, 5.555702448e-01f, 7.071067691e-01f, 8.314695954e-01f, 9.238795042e-01f, 9.807852507e-01f, 1.000000000e+00f, 9.807852507e-01f, 9.238795042e-01f, 8.314695954e-01f, 7.071067691e-01f, 5.555702448e-01f, 3.826834261e-01f, 1.950903237e-01f}; return t[i]; }
constexpr int brev(int x, int bits) { int r = 0; for (int i = 0; i < bits; ++i) r |= ((x >> i) & 1) << (bits - 1 - i); return r; }
constexpr int ilog2(int x) { int r = 0; while ((1 << r) < x) ++r; return r; }
__device__ __forceinline__ int pad(int i) { return i + (i >> 5); }

__device__ __forceinline__ float fadd(float a, float b) { float r; asm("v_add_f32_e32 %0, %1, %2" : "=v"(r) : "v"(a), "v"(b)); return r; }
__device__ __forceinline__ float fsub(float a, float b) { float r; asm("v_sub_f32_e32 %0, %1, %2" : "=v"(r) : "v"(a), "v"(b)); return r; }
__device__ __forceinline__ float fmulc(float c, float x) { float r; asm("v_mul_f32_e32 %0, %1, %2" : "=v"(r) : "s"(c), "v"(x)); return r; }
__device__ __forceinline__ float ffmac(float c, float x, float acc) { asm("v_fmac_f32_e32 %0, %1, %2" : "+v"(acc) : "s"(c), "v"(x)); return acc; }
__device__ __forceinline__ float fmulv(float a, float b) { float r; asm("v_mul_f32_e32 %0, %1, %2" : "=v"(r) : "v"(a), "v"(b)); return r; }
__device__ __forceinline__ float ffmav(float a, float b, float acc) { asm("v_fmac_f32_e32 %0, %1, %2" : "+v"(acc) : "v"(a), "v"(b)); return acc; }
template <int R, bool INV> __device__ __forceinline__ void fft_r2(float (&re)[R], float (&im)[R]) {
    constexpr int LG = ilog2(R);
#pragma unroll
    for (int st = 0; st < LG; ++st) {
        const int s = (R / 2) >> st;
#pragma unroll
        for (int blk = 0; blk < R; blk += 2 * s) {
#pragma unroll
            for (int a = 0; a < s; ++a) {
                const int i0 = blk + a, i1 = i0 + s;
                const float ur = fadd(re[i0], re[i1]), ui = fadd(im[i0], im[i1]);
                const float dr = fsub(re[i0], re[i1]), di = fsub(im[i0], im[i1]);
                re[i0] = ur; im[i0] = ui;
                const int w = a * (16 / s);
                if (w == 0) { re[i1] = dr; im[i1] = di; }
                else if (w == 8) { re[i1] = INV ? -di : di; im[i1] = INV ? dr : -dr; }
                else { const float c = w32c(w), sn = INV ? w32s(w) : -w32s(w);
                    re[i1] = ffmac(-sn, di, fmulc(c, dr)); im[i1] = ffmac(c, di, fmulc(sn, dr)); }
            }
        }
    }
}

__device__ __forceinline__ int opaque(int x) { asm volatile("" : "+v"(x)); return x; }
template <bool INV> __device__ __forceinline__ void fft16k(float (&re)[32], float (&im)[32], LAS f32x2* buf, const int t_in) {
    asm volatile("" ::: "memory"); __builtin_amdgcn_sched_barrier(0);
    int t = opaque(t_in);
    fft_r2<32, INV>(re, im);
    __syncthreads();
#pragma unroll
    for (int r = 0; r < 32; ++r) buf[33 * t + r] = (f32x2){re[brev(r, 5)], im[brev(r, 5)]};
    __syncthreads();
    t = opaque(t);
    { const int b2 = t + (t >> 5);
#pragma unroll
    for (int r = 0; r < 32; ++r) { const f32x2 v = buf[b2 + 528 * r]; re[r] = v.x; im[r] = v.y; } }
    {
        const float f1 = (float)(t & 31) * (1.0f / 1024.0f);
        const float c1 = __builtin_amdgcn_cosf(f1), s1 = INV ? __builtin_amdgcn_sinf(f1) : -__builtin_amdgcn_sinf(f1);
        float wc = c1, ws = s1;
#pragma unroll
        for (int r = 1; r < 32; ++r) {
            const float xr = re[r], xi = im[r]; re[r] = ffmav(-xi, ws, fmulv(xr, wc)); im[r] = ffmav(xi, wc, fmulv(xr, ws));
            const float nc = ffmav(-ws, s1, fmulv(wc, c1)), ns = ffmav(ws, c1, fmulv(wc, s1)); wc = nc; ws = ns;
        }
    }
    fft_r2<32, INV>(re, im);
    __syncthreads();
    {
        t = opaque(t);
        const int ob = (t >> 5) * 1056 + (t & 31);
#pragma unroll
        for (int r = 0; r < 32; ++r) buf[ob + 33 * r] = (f32x2){re[brev(r, 5)], im[brev(r, 5)]};
    }
    __syncthreads();
#pragma unroll
    for (int h = 0; h < 2; ++h) {
        t = opaque(t);
        float ar[16], ai[16]; const int j = t + 512 * h; const int b3 = t + (t >> 5) + 528 * h;
#pragma unroll
        for (int r = 0; r < 16; ++r) { const f32x2 v = buf[b3 + 1056 * r]; ar[r] = v.x; ai[r] = v.y; }
        {
            const float f1 = (float)j * (1.0f / 16384.0f);
            const float c1 = __builtin_amdgcn_cosf(f1), s1 = INV ? __builtin_amdgcn_sinf(f1) : -__builtin_amdgcn_sinf(f1);
            float wc = c1, ws = s1;
#pragma unroll
            for (int r = 1; r < 16; ++r) {
                const float xr = ar[r], xi = ai[r]; ar[r] = ffmav(-xi, ws, fmulv(xr, wc)); ai[r] = ffmav(xi, wc, fmulv(xr, ws));
                const float nc = ffmav(-ws, s1, fmulv(wc, c1)), ns = ffmav(ws, c1, fmulv(wc, s1)); wc = nc; ws = ns;
            }
        }
        fft_r2<16, INV>(ar, ai);
#pragma unroll
        for (int r = 0; r < 16; ++r) { re[h + 2 * r] = ar[brev(r, 4)]; im[h + 2 * r] = ai[brev(r, 4)]; }
    }
    asm volatile("" ::: "memory"); __builtin_amdgcn_sched_barrier(0);
}
}

struct Frame {
    LAS unsigned char* lds;
    volatile LAS unsigned* MISC;
    gu32* ctl;
    int tid, lane, wave;
    int vcu, G;
    float* out;
    unsigned char* ws;
};
constexpr int PTRTAB_OFF = LDSCTL_OFF + 512;
__device__ __forceinline__ const float* inp(const Frame& F, int i) {
    const v2u w = *(const LAS v2u*)(F.lds + PTRTAB_OFF + 8 * i);
    const unsigned lo = __builtin_amdgcn_readfirstlane(w.x), hi = __builtin_amdgcn_readfirstlane(w.y);
    return (const float*)(((unsigned long long)hi << 32) | lo);
}
__device__ __forceinline__ unsigned char* wsq(const Frame& F) { unsigned char* p = F.ws; asm volatile("" : "+s"(p)); return p; }
enum { I_XP = 0, I_XS, I_WIN, I_CONVW, I_CONVB, I_FW1, I_FB1, I_FW2, I_FB2, I_FW3, I_SINF, I_DECAY, I_HBIAS, I_QNORM, I_WUQ, I_KVNORM, I_WUKV, I_GNHY, I_GNAT, I_WOUT,
       I_NMIXPRE, I_NMIXPOST, I_NMLPPRE, I_NMLPPOST, I_WUP, I_WDOWN };

__device__ __forceinline__ int rope_src(int p) { return 4 * (p >> 3) + (p & 3) + 16 * ((p >> 2) & 1); }
template <bool ROPEPERM>
__device__ __forceinline__ void transpose_item(const float* W, int K, int N, bf16* WT, LAS float* scr, int item, int lane) {
    const int nblk = N / 32, kb = item / nblk, nb = item % nblk, k0 = 64 * kb, n0 = 32 * nb;
    int sc = lane & 31; if (ROPEPERM && (nb % 3) == 2) sc = rope_src(sc);
#pragma unroll 8
    for (int i = 0; i < 32; ++i) { const int kk = 2 * i + (lane >> 5); scr[kk * 33 + (lane & 31)] = W[(size_t)(k0 + kk) * N + n0 + sc]; }
    LDS_WAIT(); asm volatile("" ::: "memory");
    const int c = lane & 7;
#pragma unroll
    for (int j = 0; j < 4; ++j) { const int n = (lane >> 3) + 8 * j; const LAS float* s = scr + (8 * c) * 33 + n;
        v4u o; o.x = pk2(s[0 * 33], s[1 * 33]); o.y = pk2(s[2 * 33], s[3 * 33]); o.z = pk2(s[4 * 33], s[5 * 33]); o.w = pk2(s[6 * 33], s[7 * 33]);
        *(GAS v4u*)(WT + (size_t)(n0 + n) * K + k0 + 8 * c) = o; }
    LDS_WAIT(); asm volatile("" ::: "memory");
}
__device__ __forceinline__ void phase_weights(Frame& F, int l) {
    LAS float* scr = (LAS float*)(F.lds + RING_OFF + F.wave * 16384);
    const int gw = F.vcu * NWAVES + F.wave, NGW = F.G * NWAVES;
    bf16* WinT = (bf16*)(wsq(F) + WS_WIN); bf16* WoutT = (bf16*)(wsq(F) + WS_WOUT); bf16* WupT = (bf16*)(wsq(F) + WS_WUP); bf16* WdownT = (bf16*)(wsq(F) + WS_WDOWN);
    bf16* WuqT = (bf16*)(wsq(F) + WS_WUQ); bf16* WukvT = (bf16*)(wsq(F) + WS_WUKV);
    constexpr int I_IN = (D / 64) * (INW / 32), I_OUT = (D / 64) * (D / 32), I_UP = (D / 64) * (FF / 32), I_DN = (FF / 64) * (D / 32), I_UQ = (QR / 64) * (NQ / 32), I_UKV = (KVR / 64) * (NKV / 32);
    constexpr int NITEMS = I_IN + I_OUT + I_UP + I_DN + I_UQ + I_UKV;
    for (int it = gw; it < NITEMS; it += NGW) {
        int r = it;
        if (r < I_IN) { transpose_item<false>(inp(F, I_WIN) + (size_t)l * D * INW, D, INW, WinT, scr, r, F.lane); continue; } r -= I_IN;
        if (r < I_OUT) { transpose_item<false>(inp(F, I_WOUT) + (size_t)l * D * D, D, D, WoutT, scr, r, F.lane); continue; } r -= I_OUT;
        if (r < I_UP) { transpose_item<false>(inp(F, I_WUP) + (size_t)l * D * FF, D, FF, WupT, scr, r, F.lane); continue; } r -= I_UP;
        if (r < I_DN) { transpose_item<false>(inp(F, I_WDOWN) + (size_t)l * FF * D, FF, D, WdownT, scr, r, F.lane); continue; } r -= I_DN;
        if (r < I_UQ) { transpose_item<true>(inp(F, I_WUQ) + (size_t)l * QR * NQ, QR, NQ, WuqT, scr, r, F.lane); continue; } r -= I_UQ;
        transpose_item<false>(inp(F, I_WUKV) + (size_t)l * KVR * NKV, KVR, NKV, WukvT, scr, r, F.lane);
    }
    { unsigned z = 0u; asm volatile("" : "+v"(z)); const v4u zz = {z, z, z, z};
      for (int i = gw * 64 + F.lane; i < 12288; i += NGW * 64) ((GAS v4u*)(WinT + (size_t)INW * D))[i] = zz; }
}
__device__ __forceinline__ void phase_rope_tab(Frame& F) {
    const float inv[16] = {1.000000000e+00f, 5.623413324e-01f, 3.162277639e-01f, 1.778279394e-01f, 1.000000015e-01f, 5.623412877e-02f, 3.162277862e-02f, 1.778279431e-02f,
                           9.999999776e-03f, 5.623413250e-03f, 3.162277862e-03f, 1.778279431e-03f, 1.000000047e-03f, 5.623413017e-04f, 3.162277862e-04f, 1.778279402e-04f};
    float* ct = (float*)(wsq(F) + WS_COS); float* st = (float*)(wsq(F) + WS_SIN);
    for (int i = F.vcu * NTHR + F.tid; i < L * 16; i += F.G * NTHR) {
        const int t = i >> 4, j = i & 15; float iv = inv[0];
#pragma unroll
        for (int q = 1; q < 16; ++q) iv = (j == q) ? inv[q] : iv;
        const float ang = (float)t * iv; ct[i] = cosf(ang); st[i] = sinf(ang);
    }
}
__device__ __forceinline__ const float* x_src_row(Frame& F, int l, int m) {
    if (l == 0) return (m < 2 * L) ? inp(F, I_XP) + (size_t)m * D : inp(F, I_XS) + (size_t)(m - 2 * L) * D;
    return F.out + (size_t)m * D;
}
__device__ __forceinline__ void store_xn_row(f32x4 (&v)[4], float rstd, const float* g, bf16* orow, int lane) {
    GAS v2u* o8 = (GAS v2u*)orow + lane;
#pragma unroll
    for (int j = 0; j < 4; ++j) { const f32x4 gg = ((const GAS f32x4*)g)[lane + 64 * j]; v2u w; w.x = pk2(v[j].x * rstd * gg.x, v[j].y * rstd * gg.y); w.y = pk2(v[j].z * rstd * gg.z, v[j].w * rstd * gg.w); o8[64 * j] = w; }
}
__device__ __forceinline__ float row_ss(const f32x4 (&v)[4]) { float s = 0.f;
#pragma unroll
    for (int j = 0; j < 4; ++j) s += (v[j].x * v[j].x + v[j].y * v[j].y) + (v[j].z * v[j].z + v[j].w * v[j].w);
    return wave_sum(s); }
__device__ __forceinline__ void phase_norm_first(Frame& F, int l, const float* g) {
    const int gw = F.vcu * NWAVES + F.wave, NGW = F.G * NWAVES; bf16* XN = (bf16*)(wsq(F) + WS_XN);
    for (int m = gw; m < M; m += NGW) {
        const GAS f32x4* xr = (const GAS f32x4*)x_src_row(F, l, m) + F.lane; f32x4 v[4];
#pragma unroll
        for (int j = 0; j < 4; ++j) v[j] = xr[64 * j];
        const float rstd = 1.0f / sqrtf(row_ss(v) * (1.0f / D) + EPS);
        store_xn_row(v, rstd, g, XN + (size_t)m * D, F.lane);
    }
}
__device__ __forceinline__ void phase_norm_res(Frame& F, int lsrc, const float* T, const float* gpost, const float* gnext) {
    const int gw = F.vcu * NWAVES + F.wave, NGW = F.G * NWAVES; bf16* XN = (bf16*)(wsq(F) + WS_XN);
    for (int m = gw; m < M; m += NGW) {
        const GAS f32x4* xr = (const GAS f32x4*)x_src_row(F, lsrc, m) + F.lane; const GAS f32x4* tr = (const GAS f32x4*)(T + (size_t)m * D) + F.lane; f32x4 v[4], tv[4];
#pragma unroll
        for (int j = 0; j < 4; ++j) { v[j] = xr[64 * j]; tv[j] = tr[64 * j]; }
        const float rt = 1.0f / sqrtf(row_ss(tv) * (1.0f / D) + EPS);
        GAS f32x4* orow = (GAS f32x4*)(F.out + (size_t)m * D) + F.lane;
#pragma unroll
        for (int j = 0; j < 4; ++j) { const f32x4 gg = ((const GAS f32x4*)gpost)[F.lane + 64 * j]; v[j] = v[j] + tv[j] * rt * gg; orow[64 * j] = v[j]; }
        if (gnext) { const float rstd = 1.0f / sqrtf(row_ss(v) * (1.0f / D) + EPS); store_xn_row(v, rstd, gnext, XN + (size_t)m * D, F.lane); }
    }
}

__device__ __forceinline__ void phase_filter_mlp(Frame& F, int l) {
    const float* w1 = inp(F, I_FW1) + (size_t)l * 33 * 64; const float* b1 = inp(F, I_FB1) + l * 64; const float* w2 = inp(F, I_FW2) + (size_t)l * 64 * 64; const float* b2 = inp(F, I_FB2) + l * 64;
    const float* sf = inp(F, I_SINF) + l * 128; float* H2 = (float*)(wsq(F) + WS_H2);
    LAS float* hl = (LAS float*)(F.lds + RING_OFF);
    for (int task = F.vcu; task < L / NTHR; task += F.G) {
        const int n = task * NTHR + F.tid;
        float z[33]; z[0] = (float)n * (1.0f / (float)(L - 1));
        const float omega = (float)(2.0 * 3.14159265358979323846 / L) * (float)n;
#pragma unroll
        for (int b = 0; b < 16; ++b) { const float band = 1e-4f + (float)b * ((15.0f - 1e-4f) / 15.0f); const float ph = omega * band; z[1 + b] = cosf(ph); z[17 + b] = -sinf(ph); }
        for (int i = 0; i < 64; ++i) { float acc = b1[i];
#pragma unroll
            for (int f = 0; f < 33; ++f) acc += z[f] * w1[f * 64 + i];
            hl[i * NTHR + F.tid] = sinf(sf[i] * acc); }
        float h1[64];
#pragma unroll
        for (int i = 0; i < 64; ++i) h1[i] = hl[i * NTHR + F.tid];
        for (int j = 0; j < 64; ++j) { float acc = b2[j];
#pragma unroll
            for (int i = 0; i < 64; ++i) acc += h1[i] * w2[i * 64 + j];
            H2[(size_t)n * 64 + j] = sinf(sf[64 + j] * acc); }
        __syncthreads();
    }
}
__device__ __forceinline__ void phase_filter_taps(Frame& F, int l) {
    const float* w3 = inp(F, I_FW3) + (size_t)l * 64 * 2048; const float* decay = inp(F, I_DECAY) + (size_t)l * 2048; const float* H2 = (const float*)(wsq(F) + WS_H2); float* KT = (float*)(wsq(F) + WS_KT);
    LAS float* wl = (LAS float*)(F.lds + RING_OFF);
    for (int task = F.vcu; task < 32 * 32; task += F.G) {
        const int nb = task >> 5, cb = task & 31;
        __syncthreads();
        { const int j = F.tid >> 3, c8 = (F.tid & 7) * 8; const f32x4 a = *(const GAS f32x4*)(w3 + (size_t)j * 2048 + cb * 64 + c8), b = *(const GAS f32x4*)(w3 + (size_t)j * 2048 + cb * 64 + c8 + 4);
          wl[(c8 + 0) * 64 + j] = a.x; wl[(c8 + 1) * 64 + j] = a.y; wl[(c8 + 2) * 64 + j] = a.z; wl[(c8 + 3) * 64 + j] = a.w;
          wl[(c8 + 4) * 64 + j] = b.x; wl[(c8 + 5) * 64 + j] = b.y; wl[(c8 + 6) * 64 + j] = b.z; wl[(c8 + 7) * 64 + j] = b.w; }
        __syncthreads();
        const int n = nb * NTHR + F.tid; float h[64];
#pragma unroll
        for (int q = 0; q < 16; ++q) { const f32x4 v = *(const GAS f32x4*)(H2 + (size_t)n * 64 + 4 * q); h[4 * q] = v.x; h[4 * q + 1] = v.y; h[4 * q + 2] = v.z; h[4 * q + 3] = v.w; }
        const float tn = (float)n * (1.0f / (float)(L - 1));
        for (int c = 0; c < 64; ++c) {
            float acc = 0.f;
#pragma unroll
            for (int q = 0; q < 16; ++q) { const f32x4 w = *(const LAS f32x4*)(wl + c * 64 + 4 * q); acc += h[4 * q] * w.x; acc += h[4 * q + 1] * w.y; acc += h[4 * q + 2] * w.z; acc += h[4 * q + 3] * w.w; }
            const int col = cb * 64 + c;
            KT[(size_t)col * L + n] = acc * __expf(-tn * fabsf(decay[col]));
        }
    }
    __syncthreads();
}

__device__ __forceinline__ void phase_filter_fft(Frame& F, int l) {
    const float* KT = (const float*)(wsq(F) + WS_KT); f32x2* KEO = (f32x2*)(wsq(F) + WS_KEO); const float* hb = inp(F, I_HBIAS) + (size_t)l * 2 * HYW;
    LAS f32x2* buf = (LAS f32x2*)(F.lds + RING_OFF); const int t = F.tid;
    for (int item = F.vcu; item < 2 * HYW; item += F.G) {
        const int o = item >> 9, c = item & 511;
        const float* fw = KT + (size_t)((o * 2 + 0) * HYW + c) * L; const float* bw = KT + (size_t)((o * 2 + 1) * HYW + c) * L;
        const float bias = hb[o * HYW + c]; const float sc = 1.0f / (2.0f * L);
        f32x2* ke = KEO + (size_t)item * KEO_BLK; f32x2* ko = ke + KEO_KO;
        float ar[32], ai[32];
        { const int tq = hfft::opaque(t); (void)tq;
#pragma unroll
        for (int m = 0; m < 32; ++m) { const int n = tq + 512 * m; const float f = fw[n]; float b = bw[n >= 1 ? L - n : 0]; b = n >= 1 ? b : 0.f; ar[m] = f + b; ai[m] = 0.f; if ((m & 3) == 3) { asm volatile("" ::: "memory"); __builtin_amdgcn_sched_barrier(0); } }
        }
        hfft::fft16k<false>(ar, ai, buf, t);
        { const int tq = hfft::opaque(t); (void)tq;
#pragma unroll
        for (int m = 0; m <= 16; ++m) { const int k = tq + 512 * m; if (k <= 8192) ke[k] = (f32x2){(ar[m] + bias) * sc, ai[m] * sc}; }
        }
        { const int tq = hfft::opaque(t); (void)tq;
#pragma unroll
        for (int m = 0; m < 32; ++m) { const int n = tq + 512 * m; const float f = fw[n]; float b = bw[n >= 1 ? L - n : 0]; b = n >= 1 ? b : 0.f; const float d = f - b; const float fr = (float)n * (1.0f / 32768.0f);
            ar[m] = d * __builtin_amdgcn_cosf(fr); ai[m] = -d * __builtin_amdgcn_sinf(fr); if ((m & 3) == 3) { asm volatile("" ::: "memory"); __builtin_amdgcn_sched_barrier(0); } }
        }
        hfft::fft16k<false>(ar, ai, buf, t);
        { const int tq = hfft::opaque(t); (void)tq;
#pragma unroll
        for (int m = 0; m < 16; ++m) { const int k = tq + 512 * m; ko[k] = (f32x2){(ar[m] + bias) * sc, ai[m] * sc}; }
        }
    }
    __syncthreads();
}

__device__ __forceinline__ float u_conv3(const bf16* row, int n, float w0, float w1, float w2, float cb) {
    const int nm = n >= 1 ? n - 1 : 0, np = n + 1 < L ? n + 1 : L - 1;
    float um = bf2f(row[nm]), up = bf2f(row[np]); const float u0 = bf2f(row[n]);
    um = n >= 1 ? um : 0.f; up = n + 1 < L ? up : 0.f;
    return um * w0 + u0 * w1 + up * w2 + cb;
}
__device__ __forceinline__ void cmul_spec(float (&xr)[32], float (&xi)[32], const f32x2* ke, int t, bool odd) {
    { const int tq = hfft::opaque(t); (void)tq;
#pragma unroll
    for (int m = 0; m < 32; ++m) { const int k = tq + 512 * m; int idx; bool cj;
        if (!odd) { cj = k > 8192; idx = cj ? 16384 - k : k; } else { cj = k >= 8192; idx = cj ? 16383 - k : k; }
        const f32x2 kv = ke[idx]; const float kr = kv.x, ki = cj ? -kv.y : kv.y;
        const float a = xr[m], b = xi[m]; xr[m] = a * kr - b * ki; xi[m] = a * ki + b * kr; if ((m & 3) == 3) { asm volatile("" ::: "memory"); __builtin_amdgcn_sched_barrier(0); } }
    }
}
__device__ __forceinline__ void phase_hyena(Frame& F, int l) {
    const bf16* UT = (const bf16*)(wsq(F) + WS_UT); bf16* YT = (bf16*)(wsq(F) + WS_YT); const f32x2* KEO = (const f32x2*)(wsq(F) + WS_KEO);
    const float* cw = inp(F, I_CONVW) + (size_t)l * 3 * HYP; const float* cbv = inp(F, I_CONVB) + (size_t)l * HYP;
    LAS f32x2* buf = (LAS f32x2*)(F.lds + RING_OFF); const int t = F.tid;
    f32x2* G0 = (f32x2*)(wsq(F) + WS_G0) + (size_t)F.vcu * 16384 + t;
    f32x2* G1 = (f32x2*)(wsq(F) + (F.vcu < 200 ? WS_G1A + (size_t)F.vcu * 131072 : WS_G1B + (size_t)(F.vcu - 200) * 131072)) + t;
    for (int item = F.vcu; item < 2 * HYW; item += F.G) {
        const int c = item >> 1, pair = item & 1; const int b0 = pair ? 2 : 0;
        float ar[32], ai[32];
#pragma unroll 1
        for (int o = 0; o < 2; ++o) {
            const f32x2* ke = KEO + (size_t)(o * HYW + c) * KEO_BLK; const f32x2* ko = ke + KEO_KO;
#pragma unroll 1
            for (int half = 0; half < 2; ++half) {
                if (o == 0) { const int ch = c; const float w0 = cw[ch], w1 = cw[HYP + ch], w2 = cw[2 * HYP + ch], cb = cbv[ch];
                    const bf16* r0 = UT + (size_t)ch * M + (size_t)b0 * L; const bf16* r1 = pair ? r0 : r0 + L;
                    { const int tq = hfft::opaque(t); (void)tq;
#pragma unroll
                    for (int m = 0; m < 32; ++m) { const int n = tq + 512 * m; ar[m] = u_conv3(r0, n, w0, w1, w2, cb); { const float q1 = u_conv3(r1, n, w0, w1, w2, cb); ai[m] = pair ? 0.f : q1; } if ((m & 3) == 3) { asm volatile("" ::: "memory"); __builtin_amdgcn_sched_barrier(0); } } }
                    }
                else {
                    { const int tq = hfft::opaque(t); (void)tq; f32x2* G0q = G0 + (tq - t);
#pragma unroll
                    for (int m = 0; m < 32; ++m) { const f32x2 v = G0q[m * 512]; ar[m] = v.x; ai[m] = v.y; if ((m & 7) == 7) { asm volatile("" ::: "memory"); __builtin_amdgcn_sched_barrier(0); } } }
                    }
                if (half == 0) {
                    hfft::fft16k<false>(ar, ai, buf, t);
                    cmul_spec(ar, ai, ke, t, false);
                    hfft::fft16k<true>(ar, ai, buf, t);
                    { const int tq = hfft::opaque(t); (void)tq; f32x2* G1q = G1 + (tq - t);
#pragma unroll
                    for (int m = 0; m < 32; ++m) G1q[m * 512] = (f32x2){ar[m], ai[m]};
                    }
                } else {
                    { const int tq = hfft::opaque(t); (void)tq;
#pragma unroll
                    for (int m = 0; m < 32; ++m) { const float fr = (float)(tq + 512 * m) * (1.0f / 32768.0f); const float cs = __builtin_amdgcn_cosf(fr), sn = -__builtin_amdgcn_sinf(fr);
                        const float a = ar[m], b = ai[m]; ar[m] = a * cs - b * sn; ai[m] = a * sn + b * cs; }
                    }
                    hfft::fft16k<false>(ar, ai, buf, t);
                    cmul_spec(ar, ai, ko, t, true);
                    hfft::fft16k<true>(ar, ai, buf, t);
                    const int ch = (o + 1) * HYW + c; const float w0 = cw[ch], w1 = cw[HYP + ch], w2 = cw[2 * HYP + ch], cb = cbv[ch];
                    const bf16* r0 = UT + (size_t)ch * M + (size_t)b0 * L; const bf16* r1 = pair ? r0 : r0 + L;
                    { const int tq = hfft::opaque(t); (void)tq; f32x2* G1q = G1 + (tq - t);
#pragma unroll
                    for (int m = 0; m < 32; ++m) { const int n = tq + 512 * m; const float fr = (float)n * (1.0f / 32768.0f); const float cs = __builtin_amdgcn_cosf(fr), sn = __builtin_amdgcn_sinf(fr);
                        const float a = ar[m], b = ai[m]; const f32x2 e = G1q[m * 512]; const float yr = e.x + (a * cs - b * sn), yi = e.y + (a * sn + b * cs);
                        ar[m] = yr * u_conv3(r0, n, w0, w1, w2, cb); { const float q1 = yi * u_conv3(r1, n, w0, w1, w2, cb); ai[m] = pair ? 0.f : q1; } if ((m & 3) == 3) { asm volatile("" ::: "memory"); __builtin_amdgcn_sched_barrier(0); } }
                    }
                    if (o == 0) {
                        { const int tq = hfft::opaque(t); (void)tq; f32x2* G0q = G0 + (tq - t);
#pragma unroll
                        for (int m = 0; m < 32; ++m) G0q[m * 512] = (f32x2){ar[m], ai[m]};
                        }
                    } else { bf16* y0 = YT + (size_t)c * M + (size_t)b0 * L; bf16* y1 = y0 + L;
                        { const int tq = hfft::opaque(t); (void)tq;
#pragma unroll
                        for (int m = 0; m < 32; ++m) { const int n = tq + 512 * m; y0[n] = f2bf(ar[m]); if (!pair) y1[n] = f2bf(ai[m]); } }
                        }
                }
            }
        }
    }
    __syncthreads();
}

__device__ __forceinline__ void phase_mla_prep(Frame& F, int l) {
    const bf16* CQKV = (const bf16*)(wsq(F) + WS_CQKV); bf16* CQN = (bf16*)(wsq(F) + WS_CQN); bf16* CKVN = (bf16*)(wsq(F) + WS_CKVN); bf16* KPE = (bf16*)(wsq(F) + WS_KPE);
    const float* gq = inp(F, I_QNORM) + l * QR; const float* gkv = inp(F, I_KVNORM) + l * KVR; const float* ct = (const float*)(wsq(F) + WS_COS); const float* st = (const float*)(wsq(F) + WS_SIN);
    const int gw = F.vcu * NWAVES + F.wave, NGW = F.G * NWAVES, lane = F.lane;
    for (int m = gw; m < M; m += NGW) {
        const bf16* row = CQKV + (size_t)m * 512;
        const v2u q = *(const GAS v2u*)(row + 4 * lane); const unsigned kv = *(const GAS unsigned*)(row + 256 + 2 * lane);
        const float q0 = bf2f(q.x & 0xffffu), q1 = bf2f(q.x >> 16), q2 = bf2f(q.y & 0xffffu), q3 = bf2f(q.y >> 16), k0 = bf2f(kv & 0xffffu), k1 = bf2f(kv >> 16);
        const float rq = 1.0f / sqrtf(wave_sum((q0 * q0 + q1 * q1) + (q2 * q2 + q3 * q3)) * (1.0f / QR) + EPS);
        const float rk = 1.0f / sqrtf(wave_sum(k0 * k0 + k1 * k1) * (1.0f / KVR) + EPS);
        const f32x4 g4 = *(const GAS f32x4*)(gq + 4 * lane); const f32x2 g2 = *(const GAS f32x2*)(gkv + 2 * lane);
        v2u oq; oq.x = pk2(q0 * rq * g4.x, q1 * rq * g4.y); oq.y = pk2(q2 * rq * g4.z, q3 * rq * g4.w);
        *(GAS v2u*)(CQN + (size_t)m * QR + 4 * lane) = oq;
        *(GAS unsigned*)(CKVN + (size_t)m * KVR + 2 * lane) = pk2(k0 * rk * g2.x, k1 * rk * g2.y);
        if (lane < 16) { const int j = lane, tpos = m & (L - 1); const float x1 = bf2f(row[384 + j]), x2 = bf2f(row[384 + 16 + j]); const float cs = ct[tpos * 16 + j], sn = st[tpos * 16 + j];
            const int p1 = 8 * (j >> 2) + (j & 3); KPE[(size_t)m * ROPE + p1] = f2bf(x1 * cs - x2 * sn); KPE[(size_t)m * ROPE + p1 + 4] = f2bf(x2 * cs + x1 * sn); }
    }
}

__device__ __forceinline__ void phase_hy_out(Frame& F, int l) {
    const bf16* YT = (const bf16*)(wsq(F) + WS_YT); bf16* MIX = (bf16*)(wsq(F) + WS_MIX); const float* gn = inp(F, I_GNHY) + l * HYW;
    LAS bf16* tl = (LAS bf16*)(F.lds + RING_OFF + F.wave * 16384);
    const int gw = F.vcu * NWAVES + F.wave, NGW = F.G * NWAVES, lane = F.lane;
    for (int task = gw; task < 8 * (M / 64); task += NGW) {
        const int g = task & 7, tb = task >> 3, tok0 = tb * 64; const int cl = lane >> 3, t8 = (lane & 7) * 8;
        float v[8][8]; float ss[8];
#pragma unroll
        for (int j = 0; j < 8; ++j) ss[j] = 0.f;
#pragma unroll
        for (int i = 0; i < 8; ++i) { const int ch = g * 64 + 8 * i + cl; const v4u w = *(const GAS v4u*)(YT + (size_t)ch * M + tok0 + t8);
            v[i][0] = bf2f(w.x & 0xffffu); v[i][1] = bf2f(w.x >> 16); v[i][2] = bf2f(w.y & 0xffffu); v[i][3] = bf2f(w.y >> 16);
            v[i][4] = bf2f(w.z & 0xffffu); v[i][5] = bf2f(w.z >> 16); v[i][6] = bf2f(w.w & 0xffffu); v[i][7] = bf2f(w.w >> 16);
#pragma unroll
            for (int j = 0; j < 8; ++j) ss[j] += v[i][j] * v[i][j]; }
#pragma unroll
        for (int j = 0; j < 8; ++j) { float s = ss[j]; s += __shfl_xor(s, 8); s += __shfl_xor(s, 16); s += __shfl_xor(s, 32); ss[j] = 1.0f / sqrtf(s * (1.0f / 64.0f) + EPS); }
#pragma unroll
        for (int i = 0; i < 8; ++i) { const int cc = 8 * i + cl; const float gg = gn[g * 64 + cc];
#pragma unroll
            for (int j = 0; j < 8; ++j) tl[(t8 + j) * 72 + cc] = f2bf(v[i][j] * ss[j] * gg); }
        LDS_WAIT(); asm volatile("" ::: "memory");
#pragma unroll
        for (int i = 0; i < 8; ++i) { const int tok = 8 * i + (lane >> 3), c8 = (lane & 7) * 8; const v4u w = *(const LAS v4u*)(tl + tok * 72 + c8);
            *(GAS v4u*)(MIX + (size_t)(tok0 + tok) * D + g * 64 + c8) = w; }
        LDS_WAIT(); asm volatile("" ::: "memory");
    }
}

namespace att {
using s16x4 = __attribute__((ext_vector_type(4))) short;
using f32x16 = __attribute__((ext_vector_type(16))) float;
using u32x4 = __attribute__((ext_vector_type(4))) unsigned;
constexpr int QBLK = 32, KVBLK = 64, NW = 8;
constexpr float SCALE = 0.10206207261596575f;
constexpr float THR = 8.f;
constexpr int SHM_K = KVBLK * 256, SHM_V = KVBLK * DV * 2;
constexpr int OFF_V = 0, OFF_K = 2 * SHM_V, OFF_WS = OFF_K + 2 * SHM_K, SHM_ATTN = OFF_WS + NW * 64 * 4;
#define KSWZ(row, colB) ((row) * 256 + ((colB) ^ (((row) & 7) << 4)))
#define SBAR() __builtin_amdgcn_sched_barrier(0)
__device__ __forceinline__ int crow(int r, int hi) { return (r & 3) + 8 * (r >> 2) + 4 * hi; }
__device__ __forceinline__ unsigned cvtpk(float lo, float hi) { unsigned r; asm volatile("v_cvt_pk_bf16_f32 %0, %1, %2" : "=v"(r) : "v"(lo), "v"(hi)); return r; }
__device__ __forceinline__ void partialSM(f32x16& p0, f32x16& p1, float& m_reg, float& mn, float& alpha) {
  constexpr float C = SCALE * 1.4426950408889634f;
  float pmax = p0[0];
#pragma unroll
  for (int r = 1; r < 16; ++r) pmax = fmaxf(pmax, p0[r]);
#pragma unroll
  for (int r = 0; r < 16; ++r) pmax = fmaxf(pmax, p1[r]);
  { auto rr = __builtin_amdgcn_permlane32_swap(__float_as_uint(pmax), __float_as_uint(pmax), false, false);
    pmax = fmaxf(__uint_as_float(rr[0]), __uint_as_float(rr[1])); }
  if (__builtin_expect(__all(pmax - m_reg <= THR / SCALE), 1)) { mn = m_reg; alpha = 1.f; }
  else { mn = fmaxf(m_reg, pmax); alpha = __builtin_amdgcn_exp2f((m_reg - mn) * C); m_reg = mn; }
  const float mnC = -mn * C;
#pragma unroll
  for (int r = 0; r < 16; ++r) p0[r] = fmaf(p0[r], C, mnC);
#pragma unroll
  for (int r = 0; r < 16; ++r) p1[r] = fmaf(p1[r], C, mnC);
#pragma unroll
  for (int r = 0; r < 16; ++r) p0[r] = __builtin_amdgcn_exp2f(p0[r]);
}
__device__ __forceinline__ void finishSM(f32x16& p0, f32x16& p1, float alpha, float& l_reg, bf16x8& pa0, bf16x8& pa1, bf16x8& pa2, bf16x8& pa3) {
#pragma unroll
  for (int r = 0; r < 16; ++r) p1[r] = __builtin_amdgcn_exp2f(p1[r]);
  float ps = 0;
#pragma unroll
  for (int r = 0; r < 16; ++r) ps += p0[r];
#pragma unroll
  for (int r = 0; r < 16; ++r) ps += p1[r];
  { auto rr = __builtin_amdgcn_permlane32_swap(__float_as_uint(ps), __float_as_uint(ps), false, false);
    ps = __uint_as_float(rr[0]) + __uint_as_float(rr[1]); }
  l_reg = l_reg * alpha + ps;
#define PK4(P, BASE, OUT) do { unsigned a0 = cvtpk(P[BASE + 0], P[BASE + 1]), a1 = cvtpk(P[BASE + 2], P[BASE + 3]);   \
    unsigned b0 = cvtpk(P[BASE + 4], P[BASE + 5]), b1 = cvtpk(P[BASE + 6], P[BASE + 7]);                              \
    auto r0 = __builtin_amdgcn_permlane32_swap(a0, b0, false, false); auto r1 = __builtin_amdgcn_permlane32_swap(a1, b1, false, false); \
    u32x4 w = {r0[0], r1[0], r0[1], r1[1]}; OUT = __builtin_bit_cast(bf16x8, w); } while (0)
  PK4(p0, 0, pa0); PK4(p0, 8, pa1); PK4(p1, 0, pa2); PK4(p1, 8, pa3);
#undef PK4
}
__device__ __forceinline__ void qkt(f32x16& p0, f32x16& p1, const LAS char* Ks, const bf16x8* qr, int r32, int hi) {
  p0 = f32x16{}; p1 = f32x16{};
#pragma unroll
  for (int d0 = 0; d0 < 6; ++d0) { const int cb = (d0 * 16 + hi * 8) * 2;
    const bf16x8 b0 = *reinterpret_cast<const LAS bf16x8*>(Ks + KSWZ(r32, cb));
    const bf16x8 b1 = *reinterpret_cast<const LAS bf16x8*>(Ks + KSWZ(32 + r32, cb));
    p0 = __builtin_amdgcn_mfma_f32_32x32x16_bf16(b0, qr[d0], p0, 0, 0, 0);
    p1 = __builtin_amdgcn_mfma_f32_32x32x16_bf16(b1, qr[d0], p1, 0, 0, 0); }
}
__device__ __forceinline__ int v_st(int k, int c) { const int kk = (k & ~0xC) | ((k & 4) << 1) | ((k & 8) >> 1); return ((kk >> 3) * 2 + (c >> 5)) * 512 + ((kk & 7) * 32 + (c & 31)) * 2; }
__device__ __forceinline__ int v_rd_base(int lane) { return ((lane & 3) << 3) | (((lane >> 2) & 3) << 6) | (((lane >> 4) & 1) << 5) | (((lane >> 5) & 1) << 8); }
constexpr int v_rd_off(int d0, int ks, int half) { return d0 * 512 + ks * 2048 + half * 1024; }
template <int OFF> __device__ __forceinline__ s16x4 tr_read(int vb) { s16x4 r; asm volatile("ds_read_b64_tr_b16 %0, %1 offset:%2" : "=&v"(r) : "v"(vb), "i"(OFF) : "memory"); return r; }
template <int D0> __device__ __forceinline__ void pv_one(f32x16& od, int vb, bf16x8 pa0, bf16x8 pa1, bf16x8 pa2, bf16x8 pa3) {
  const s16x4 l0 = tr_read<v_rd_off(D0, 0, 0)>(vb), h0 = tr_read<v_rd_off(D0, 0, 1)>(vb), l1 = tr_read<v_rd_off(D0, 1, 0)>(vb), h1 = tr_read<v_rd_off(D0, 1, 1)>(vb);
  const s16x4 l2 = tr_read<v_rd_off(D0, 2, 0)>(vb), h2 = tr_read<v_rd_off(D0, 2, 1)>(vb), l3 = tr_read<v_rd_off(D0, 3, 0)>(vb), h3 = tr_read<v_rd_off(D0, 3, 1)>(vb);
  asm volatile("s_waitcnt lgkmcnt(0)" ::: "memory"); SBAR();
#define PK(Lo, Hi) (bf16x8){Lo[0], Lo[1], Lo[2], Lo[3], Hi[0], Hi[1], Hi[2], Hi[3]}
  od = __builtin_amdgcn_mfma_f32_32x32x16_bf16(pa0, PK(l0, h0), od, 0, 0, 0);
  od = __builtin_amdgcn_mfma_f32_32x32x16_bf16(pa1, PK(l1, h1), od, 0, 0, 0);
  od = __builtin_amdgcn_mfma_f32_32x32x16_bf16(pa2, PK(l2, h2), od, 0, 0, 0);
  od = __builtin_amdgcn_mfma_f32_32x32x16_bf16(pa3, PK(l3, h3), od, 0, 0, 0);
#undef PK
}
__device__ __forceinline__ void pv_d0(f32x16* o, int vb, bf16x8 pa0, bf16x8 pa1, bf16x8 pa2, bf16x8 pa3) {
  pv_one<0>(o[0], vb, pa0, pa1, pa2, pa3); pv_one<1>(o[1], vb, pa0, pa1, pa2, pa3);
}
__device__ __forceinline__ void attn_unit(const bf16* __restrict__ Qb, const bf16* __restrict__ KNh, const bf16* __restrict__ KPEb, const bf16* __restrict__ Vh, bf16* __restrict__ Mo,
                                          const float* __restrict__ gain, const float* __restrict__ ct, const float* __restrict__ st, int tpos0, LAS char* lds) {
  int tid_ = threadIdx.x; asm volatile("" : "+v"(tid_));
  const int tid = tid_, wid = tid >> 6, lane = tid & 63, r32 = lane & 31, hi = lane >> 5;
  LAS char* V_lds = lds + OFF_V; LAS char* K_lds = lds + OFF_K;
  LAS float* ws = (LAS float*)(lds + OFF_WS) + wid * 64; LAS float* li_l = ws; LAS float* al_l = ws + 32;
  float m_reg = -1e30f, l_reg = 0; f32x16 o[2] = {}; bf16x8 qr[6];
  const bf16* Qw = Qb + (long)(wid * QBLK + r32) * NQ + hi * 8;
#pragma unroll
  for (int d0 = 0; d0 < 6; ++d0) qr[d0] = *reinterpret_cast<const bf16x8*>(Qw + d0 * 16);
  { const int tq = tpos0 + wid * QBLK + r32;
#pragma unroll
    for (int d0 = 4; d0 < 6; ++d0) { const int fq = 2 * (d0 - 4) + hi; const f32x4 cs = *reinterpret_cast<const f32x4*>(ct + tq * 16 + 4 * fq), sn = *reinterpret_cast<const f32x4*>(st + tq * 16 + 4 * fq);
      const u32x4 w = __builtin_bit_cast(u32x4, qr[d0]);
      const f32x4 x1 = {bf2f(w[0] & 0xffffu), bf2f(w[0] >> 16), bf2f(w[1] & 0xffffu), bf2f(w[1] >> 16)}, x2 = {bf2f(w[2] & 0xffffu), bf2f(w[2] >> 16), bf2f(w[3] & 0xffffu), bf2f(w[3] >> 16)};
      const f32x4 a = x1 * cs - x2 * sn, b = x2 * cs + x1 * sn;
      const u32x4 o4 = {cvtpk(a[0], a[1]), cvtpk(a[2], a[3]), cvtpk(b[0], b[1]), cvtpk(b[2], b[3])}; qr[d0] = __builtin_bit_cast(bf16x8, o4); } }
  const int sr = tid >> 3, sc = (tid & 7) * 8;
  const int rr_ = (tid & 255) >> 2, rc = (tid & 3) * 8;
  const int vst0 = v_st(sr, sc), kst0 = KSWZ(sr, sc * 2), kst1 = KSWZ(rr_, 128 + rc * 2);
  const int vb0 = (int)(unsigned)(uintptr_t)V_lds + v_rd_base(lane);
  struct { bf16x8 vs, kn, kr; } sr_[2];
#define SLOAD(i, k0) do { sr_[i].vs = *reinterpret_cast<const bf16x8*>(&Vh[(long)((k0) + sr) * 512 + sc]); sr_[i].kn = *reinterpret_cast<const bf16x8*>(&KNh[(long)((k0) + sr) * 512 + sc]); \
    sr_[i].kr = *reinterpret_cast<const bf16x8*>(&KPEb[(long)((k0) + rr_) * ROPE + rc]); } while (0)
#define SWRITE(b, i) do { *(LAS bf16x8*)(V_lds + (b) * SHM_V + vst0) = sr_[i].vs; *(LAS bf16x8*)(K_lds + (b) * SHM_K + kst0) = sr_[i].kn; *(LAS bf16x8*)(K_lds + (b) * SHM_K + kst1) = sr_[i].kr; } while (0)
#define SWAIT() asm volatile("s_waitcnt vmcnt(3)" ::: "memory")
#define RESC(a) do { if (__any((a) < 1.f)) { if (hi == 0) al_l[r32] = (a); asm volatile("s_waitcnt lgkmcnt(0)" ::: "memory"); \
    _Pragma("unroll") for (int d = 0; d < 2; ++d) _Pragma("unroll") for (int r = 0; r < 16; ++r) o[d][r] *= al_l[crow(r, hi)]; } } while (0)
  f32x16 pA0, pA1, pB0, pB1; float mnA, mnB, alA, alB; bf16x8 pa0, pa1, pa2, pa3; constexpr int NTL = L / KVBLK;
  constexpr int SE = 0, SO = 1;
  SLOAD(SE, 0); asm volatile("s_waitcnt vmcnt(0)" ::: "memory"); SWRITE(0, SE); __syncthreads();
  qkt(pA0, pA1, K_lds, qr, r32, hi); partialSM(pA0, pA1, m_reg, mnA, alA);
  SLOAD(SO, KVBLK); SLOAD(SE, 2 * KVBLK);
  SWAIT(); SWRITE(1, SO); __syncthreads();
  for (int j = 1; j + 1 < NTL; j += 2) {
    SBAR(); qkt(pB0, pB1, K_lds + SHM_K, qr, r32, hi);
    finishSM(pA0, pA1, alA, l_reg, pa0, pa1, pa2, pa3); SBAR();
    SLOAD(SO, (j + 2) * KVBLK); SBAR();
    pv_d0(o, vb0, pa0, pa1, pa2, pa3); partialSM(pB0, pB1, m_reg, mnB, alB);
    __syncthreads(); SWAIT(); SWRITE(0, SE);
    RESC(alB); __syncthreads();
    SBAR(); qkt(pA0, pA1, K_lds, qr, r32, hi);
    finishSM(pB0, pB1, alB, l_reg, pa0, pa1, pa2, pa3); SBAR();
    if (j + 3 < NTL) SLOAD(SE, (j + 3) * KVBLK); SBAR();
    pv_d0(o, vb0 + SHM_V, pa0, pa1, pa2, pa3); partialSM(pA0, pA1, m_reg, mnA, alA);
    __syncthreads(); SWAIT(); SWRITE(1, SO);
    RESC(alA); __syncthreads();
  }
  SBAR(); qkt(pB0, pB1, K_lds + SHM_K, qr, r32, hi);
  finishSM(pA0, pA1, alA, l_reg, pa0, pa1, pa2, pa3); SBAR();
  pv_d0(o, vb0, pa0, pa1, pa2, pa3); partialSM(pB0, pB1, m_reg, mnB, alB);
  __syncthreads(); RESC(alB);
  finishSM(pB0, pB1, alB, l_reg, pa0, pa1, pa2, pa3); SBAR();
  pv_d0(o, vb0 + SHM_V, pa0, pa1, pa2, pa3);
  if (hi == 0) li_l[r32] = l_reg; asm volatile("s_waitcnt lgkmcnt(0)" ::: "memory");
  const float g0 = gain[r32], g1 = gain[32 + r32];
  bf16* Ow = Mo + (long)(wid * QBLK) * D;
#pragma unroll
  for (int r = 0; r < 16; ++r) { const int orow = crow(r, hi); const float rl = __builtin_amdgcn_rcpf(li_l[orow]);
    const float y0 = o[0][r] * rl, y1 = o[1][r] * rl; float s = y0 * y0 + y1 * y1;
    s += __shfl_xor(s, 1); s += __shfl_xor(s, 2); s += __shfl_xor(s, 4); s += __shfl_xor(s, 8); s += __shfl_xor(s, 16);
    const float rs = 1.0f / sqrtf(s * (1.0f / 64.0f) + EPS);
    Ow[(long)orow * D + r32] = f2bf(y0 * rs * g0); Ow[(long)orow * D + 32 + r32] = f2bf(y1 * rs * g1); }
  __syncthreads();
#undef SLOAD
#undef SWRITE
#undef SWAIT
#undef RESC
}
#undef KSWZ
#undef SBAR
}
#define XB_TMO      128
#define XB_XCNT(j)  (256  + 64 * (j))
#define XB_XSUB(j)  (1280 + 64 * (j))
#define XB_XGEN(j)  (2304 + 64 * (j))
#define XB_TOP      3328
#define XB_TOPGEN   3392
#define XCD_BAR_WORDS 3456
#define XB_SPIN_CAP (1u << 18)

__device__ __forceinline__ unsigned xb_ld(unsigned* p)              { return __hip_atomic_load(p, __ATOMIC_RELAXED, __HIP_MEMORY_SCOPE_AGENT); }
__device__ __forceinline__ unsigned xb_add(unsigned* p, unsigned v) { return __hip_atomic_fetch_add(p, v, __ATOMIC_RELAXED, __HIP_MEMORY_SCOPE_AGENT); }
__device__ __forceinline__ unsigned xb_xcc_id() { return (unsigned)__builtin_amdgcn_s_getreg((3 << 11) | 20) & 0xFu; }
#define XB_SPIN(cond, bar) do { unsigned _sp = 0; while (cond) { __builtin_amdgcn_s_sleep(1); \
    if ((++_sp & 255u) == 0u) { if (xb_ld(&(bar)[XB_TMO])) break; if (_sp > XB_SPIN_CAP) { atomicAdd(&(bar)[XB_TMO], 1u); break; } } } } while (0)

struct XcdBarrier {
    unsigned* bar; unsigned x;
    volatile LAS unsigned* st;
};

__device__ __forceinline__ XcdBarrier xcd_barrier_post(unsigned* bar, volatile LAS unsigned* st) {
    XcdBarrier b; b.bar = bar; b.x = xb_xcc_id(); b.st = st;
    if (threadIdx.x == 0) (void)xb_add(&bar[XB_XCNT(b.x)], 1u);
    return b;
}
__device__ __forceinline__ void xcd_barrier_complete(unsigned* bar, unsigned x, unsigned& nloc, unsigned& nx) {
    const unsigned G = gridDim.x * gridDim.y * gridDim.z;
    unsigned sum, cnt, mine, sp = 0u;
    for (;;) {
        sum = 0u; cnt = 0u; mine = 0u;
#pragma unroll
        for (unsigned j = 0; j < 16; ++j) { const unsigned c = xb_ld(&bar[XB_XCNT(j)]); sum += c; cnt += (c > 0u) ? 1u : 0u; mine = (j == x) ? c : mine; }
        if (sum == G) break;
        __builtin_amdgcn_s_sleep(1);
        if ((++sp & 255u) == 0u) { if (xb_ld(&bar[XB_TMO])) break; if (sp > XB_SPIN_CAP) { atomicAdd(&bar[XB_TMO], 1u); break; } }
    }
    nloc = mine > 0u ? mine : 1u; nx = cnt > 0u ? cnt : 1u;
}

__device__ __forceinline__ void xcd_barrier(const XcdBarrier& b) {
    asm volatile("s_waitcnt vmcnt(0)" ::: "memory");
    __syncthreads();
    if (threadIdx.x == 0) {
        unsigned* bar = b.bar;
        __builtin_amdgcn_s_waitcnt(0);
        unsigned nloc = b.st[0], nx = b.st[1];
        if (nloc == 0u) { xcd_barrier_complete(bar, b.x, nloc, nx); b.st[0] = nloc; b.st[1] = nx; }
        const unsigned old = xb_add(&bar[XB_XSUB(b.x)], 1u);
        const unsigned gen = old / nloc;
        if (old + 1u == (gen + 1u) * nloc) {
            __builtin_amdgcn_fence(__ATOMIC_RELEASE, "agent");
            asm volatile("s_waitcnt vmcnt(0)" ::: "memory");
            const unsigned og = xb_add(&bar[XB_TOP], 1u);
            const unsigned tg = og / nx;
            if (og + 1u == (tg + 1u) * nx) xb_add(&bar[XB_TOPGEN], 1u);
            else XB_SPIN(xb_ld(&bar[XB_TOPGEN]) == tg, bar);
            __builtin_amdgcn_fence(__ATOMIC_ACQUIRE, "agent");
            xb_add(&bar[XB_XGEN(b.x)], 1u);
            asm volatile("s_waitcnt vmcnt(0)" ::: "memory");
        } else {
            XB_SPIN(xb_ld(&bar[XB_XGEN(b.x)]) == gen, bar);
            __builtin_amdgcn_fence(__ATOMIC_ACQUIRE, "agent");
            asm volatile("s_waitcnt vmcnt(0)" ::: "memory");
        }
    }
    __syncthreads();
}

constexpr int CW_BAR = 4096;
struct Args { const float* in[26]; float* out; unsigned char* ws; };
#define REFRESH() do { int t_ = threadIdx.x; asm volatile("" : "+v"(t_)); F.tid = t_; F.lane = t_ & 63; F.wave = __builtin_amdgcn_readfirstlane(t_ >> 6); int v_ = F.vcu; asm volatile("" : "+s"(v_)); F.vcu = v_; } while (0)
#define BXQ() ({ int b_ = (int)blockIdx.x; asm volatile("" : "+s"(b_)); b_; })
#define GEMM_PHASE(EPI, g, S, E) pg8::gemm_phase<EPI, pg8::StaticOrder, true, true>(F.lds + RING_OFF, g, S, E)

__global__ void __launch_bounds__(NTHR, 2) hyena_mla_fwd(Args args) {
    extern __shared__ __attribute__((aligned(16))) unsigned char lds[];
    Frame F;
    F.lds = (LAS unsigned char*)lds;
    F.MISC = (volatile LAS unsigned*)(F.lds + MISC_OFF);
    F.tid = threadIdx.x; F.lane = F.tid & 63; F.wave = __builtin_amdgcn_readfirstlane(F.tid >> 6);
    F.G = gridDim.x; { const int bx = blockIdx.x; F.vcu = (F.G % 8 == 0) ? (bx % 8) * (F.G / 8) + bx / 8 : bx; }
    F.ws = args.ws; F.out = args.out; F.ctl = (gu32*)(args.ws + WS_CTL);
    if (F.tid == 0) {
#pragma unroll
        for (int i = 0; i < 26; ++i) *(LAS unsigned long long*)(F.lds + PTRTAB_OFF + 8 * i) = (unsigned long long)args.in[i];
    }
    for (int u = F.tid; u < 512 / 4; u += NTHR) ((LAS unsigned*)(F.lds + LDSCTL_OFF))[u] = 0u;
    __syncthreads();
    XcdBarrier bar = xcd_barrier_post((unsigned*)(F.ctl + CW_BAR), F.MISC + 8);
#pragma unroll 1
    for (int l = 0; l < DEPTH; ++l) {
        REFRESH(); phase_weights(F, l);
        __syncthreads();
        REFRESH(); phase_filter_mlp(F, l);
        if (l == 0) { REFRESH(); phase_rope_tab(F); REFRESH(); phase_norm_first(F, 0, inp(F, I_NMIXPRE)); }
        xcd_barrier(bar);
        REFRESH(); phase_filter_taps(F, l);
        xcd_barrier(bar);
        REFRESH(); phase_filter_fft(F, l);
        xcd_barrier(bar);
        { unsigned char* w = wsq(F); bf16* WinT = (bf16*)(w + WS_WIN); bf16* XN = (bf16*)(w + WS_XN); bf16* UT = (bf16*)(w + WS_UT); bf16* CQKV = (bf16*)(w + WS_CQKV);
          { pg8::Gemm g{WinT, XN, HYP, M, D}; pg8::StaticOrder S; S.init(HYP, M, F.G, BXQ());
          pg8::EpiBf16<0> E{UT, M, nullptr, 0, 0, 1.f}; GEMM_PHASE(pg8::EpiBf16<0>, g, S, E); }
        { pg8::Gemm g{XN, WinT + (size_t)HYP * D, M, 512, D}; pg8::StaticOrder S; S.init(M, 512, F.G, (BXQ() + 128) % F.G);
          pg8::EpiBf16<0> E{CQKV, 512, nullptr, 0, 0, 1.f}; GEMM_PHASE(pg8::EpiBf16<0>, g, S, E); } }
        xcd_barrier(bar);
        REFRESH(); phase_mla_prep(F, l);
        REFRESH(); phase_hyena(F, l);
        xcd_barrier(bar);
        { unsigned char* w = wsq(F); bf16* CQN = (bf16*)(w + WS_CQN); bf16* CKVN = (bf16*)(w + WS_CKVN); bf16* WuqT = (bf16*)(w + WS_WUQ); bf16* WukvT = (bf16*)(w + WS_WUKV);
          bf16* Qb = (bf16*)(w + WS_Q); bf16* KN = (bf16*)(w + WS_KN); bf16* Vb = (bf16*)(w + WS_V);
          { pg8::Gemm g{CQN, WuqT, M, NQ, QR}; pg8::StaticOrder S; S.init(M, NQ, F.G, BXQ());
          pg8::EpiBf16<0> E{Qb, NQ, nullptr, 0, 0, 1.f}; GEMM_PHASE(pg8::EpiBf16<0>, g, S, E); }
        { pg8::Gemm g{CKVN, WukvT, M, NKV, KVR}; pg8::StaticOrder S; S.init(M, NKV, F.G, BXQ());
          pg8::EpiKV E{KN, (long)((WS_V - WS_KN) / 2)}; GEMM_PHASE(pg8::EpiKV, g, S, E); } }
        xcd_barrier(bar);
        REFRESH();
        { unsigned char* w = wsq(F); bf16* Qb = (bf16*)(w + WS_Q); bf16* KN = (bf16*)(w + WS_KN); bf16* Vb = (bf16*)(w + WS_V); bf16* KPE = (bf16*)(w + WS_KPE); bf16* MIX = (bf16*)(w + WS_MIX);
          const float* ct = (const float*)(w + WS_COS); const float* st = (const float*)(w + WS_SIN); const float* gat = inp(F, I_GNAT) + l * 512;
        for (int i = 0; i < 6; ++i) {
            const int bh = 3 * (F.vcu >> 5) + (i >> 1), qb = (i & 1) * 32 + (F.vcu & 31); const int b = bh >> 3, h = bh & 7;
            const size_t row0 = (size_t)b * L + (size_t)qb * 256;
            att::attn_unit(Qb + row0 * NQ + h * DQ, KN + (size_t)b * L * 512 + h * 64, KPE + (size_t)b * L * ROPE, Vb + (size_t)b * L * 512 + h * 64,
                           MIX + row0 * D + 512 + h * 64, gat + h * 64, ct, st, qb * 256, (LAS char*)(F.lds + RING_OFF));
        } }
        REFRESH(); phase_hy_out(F, l);
        xcd_barrier(bar);
        { unsigned char* w = wsq(F); bf16* MIX = (bf16*)(w + WS_MIX); bf16* WoutT = (bf16*)(w + WS_WOUT); float* T = (float*)(w + WS_T);
          pg8::Gemm g{MIX, WoutT, M, D, D}; pg8::StaticOrder S; S.init(M, D, F.G, BXQ());
          pg8::EpiF32 E{T, D}; GEMM_PHASE(pg8::EpiF32, g, S, E); }
        xcd_barrier(bar);
        REFRESH(); phase_norm_res(F, l, (const float*)(wsq(F) + WS_T), inp(F, I_NMIXPOST) + l * D, inp(F, I_NMLPPRE) + l * D);
        xcd_barrier(bar);
#pragma unroll 1
        for (int ch = 0; ch < N_MLP_CHUNKS; ++ch) {
            { unsigned char* w = wsq(F); bf16* XN = (bf16*)(w + WS_XN); bf16* WupT = (bf16*)(w + WS_WUP); bf16* Hb = (bf16*)(w + WS_H);
              pg8::Gemm g{XN + (size_t)ch * MLP_CHUNK * D, WupT, MLP_CHUNK, FF, D}; pg8::StaticOrder S; S.init(MLP_CHUNK, FF, F.G, BXQ());
              pg8::EpiRelu2 E{Hb, FF}; GEMM_PHASE(pg8::EpiRelu2, g, S, E); }
            xcd_barrier(bar);
            { unsigned char* w = wsq(F); bf16* Hb = (bf16*)(w + WS_H); bf16* WdownT = (bf16*)(w + WS_WDOWN); float* T = (float*)(w + WS_T);
              pg8::Gemm g{Hb, WdownT, MLP_CHUNK, D, FF}; pg8::StaticOrder S; S.init(MLP_CHUNK, D, F.G, BXQ());
              pg8::EpiF32 E{T + (size_t)ch * MLP_CHUNK * D, D}; GEMM_PHASE(pg8::EpiF32, g, S, E); }
            xcd_barrier(bar);
        }
        REFRESH(); phase_norm_res(F, 1, (const float*)(wsq(F) + WS_T), inp(F, I_NMLPPOST) + l * D, (l + 1 < DEPTH) ? inp(F, I_NMIXPRE) + (l + 1) * D : nullptr);
        xcd_barrier(bar);
    }
}

extern "C" void kernel_launch(void* const* d_in, const int* in_sizes, int n_in, void* d_out, int out_size, void* d_ws, size_t ws_size, hipStream_t stream) {
    static int grid = 0;
    if (grid == 0) {
        if (n_in != 26 || out_size != M * D || ws_size < WS_END) { fprintf(stderr, "kernel_launch: shape mismatch n_in %d out %d ws %zu (need %zu)\n", n_in, out_size, ws_size, (size_t)WS_END); grid = -1; return; }
        int dev = 0, cus = 0, per_cu = 0;
        if (hipGetDevice(&dev) != hipSuccess || hipDeviceGetAttribute(&cus, hipDeviceAttributeMultiprocessorCount, dev) != hipSuccess) { grid = -1; return; }
        if (hipFuncSetAttribute((const void*)hyena_mla_fwd, hipFuncAttributeMaxDynamicSharedMemorySize, LDS_BYTES) != hipSuccess) { fprintf(stderr, "kernel_launch: hipFuncSetAttribute failed\n"); grid = -1; return; }
        if (hipOccupancyMaxActiveBlocksPerMultiprocessor(&per_cu, (const void*)hyena_mla_fwd, NTHR, LDS_BYTES) != hipSuccess || per_cu < 1) fprintf(stderr, "kernel_launch: occupancy query says %d\n", per_cu);
        (void)hipGetLastError();
        grid = cus;
    }
    if (grid < 0) return;
    if (hipMemsetAsync((char*)d_ws + WS_CTL, 0, CTL_ZERO_BYTES, stream) != hipSuccess) { fprintf(stderr, "kernel_launch: memset failed\n"); return; }
    Args a{};
    for (int i = 0; i < 26; ++i) a.in[i] = (const float*)d_in[i];
    a.out = (float*)d_out; a.ws = (unsigned char*)d_ws;
    hipLaunchKernelGGL(hyena_mla_fwd, dim3(grid), dim3(NTHR), LDS_BYTES, stream, a);
    const hipError_t le = hipPeekAtLastError();
    if (le != hipSuccess) fprintf(stderr, "kernel_launch: launch failed: %s\n", hipGetErrorName(le));
}
```

```cpp
#include <hip/hip_runtime.h>
#include <cstdio>
#include <cstdint>
__device__ __forceinline__ int hw_lane() { int l; asm volatile("v_mbcnt_lo_u32_b32 %0, -1, 0\n\tv_mbcnt_hi_u32_b32 %0, -1, %0" : "=v"(l)); return l; }
__device__ __forceinline__ int tid_from_wave(int wave0) { int w = wave0; asm volatile("" : "+s"(w)); int t = w * 64 + hw_lane(); asm volatile("" : "+v"(t)); return t; }
namespace pg8 {
#define PG8_LAS __attribute__((address_space(3)))
typedef unsigned short bf16_t;
typedef short bf16x8 __attribute__((ext_vector_type(8)));
typedef float f32x4 __attribute__((ext_vector_type(4)));
typedef unsigned u32x4 __attribute__((ext_vector_type(4)));
constexpr int BM = 256, BK = 64, HALF = 128, HTB = HALF * BK * 2  , STAGE_BYTES = 8 * HTB, NXCD = 8, WGM = 8;

__host__ __device__ __forceinline__ int lds_byte(int r, int c) { const int st = (r >> 4) * 2 + (c >> 5), rr = r & 15, cc = c & 31, ob = rr * 64 + cc * 2; return st * 1024 + (ob ^ (((ob >> 9) & 1) << 5)); }
__host__ __device__ __forceinline__ void stage_rc(int b, int& R, int& C) { const int st = b / 1024, sb = b % 1024, swz = sb ^ (((sb >> 9) & 1) << 5); R = (st >> 1) * 16 + swz / 64; C = (st & 1) * 32 + (swz % 64) / 2; }
__host__ __device__ __forceinline__ int perm32(int rho) { const int n = rho >> 4, i = rho & 15; return 8 * (i >> 2) + 4 * n + (i & 3); }

struct Unit { int pm, pn; };
struct Gemm { const bf16_t* A; const bf16_t* Bt; int M, N, K; };

struct StaticOrder {
    int nM, nN, nwg, G, c;
    __host__ __device__ void init(int M, int N, int G_, int c_) { nM = M / BM; nN = N / BM; nwg = nM * nN; G = G_; c = c_; }
    __host__ __device__ bool next(int i, Unit& u) const {
        const long L = (long)i * G + c; if (L >= nwg) return false;
        int wgid = (int)L; { const int q = nwg / NXCD, r = nwg % NXCD, xcd = wgid % NXCD, off = wgid / NXCD; wgid = (xcd < r ? xcd * (q + 1) : r * (q + 1) + (xcd - r) * q) + off; }
        const int nig = WGM * nN, gid = wgid / nig, fm = gid * WGM, gsz = (nM - fm) < WGM ? (nM - fm) : WGM;
        u.pm = fm + ((wgid % nig) % gsz); u.pn = (wgid % nig) / gsz; return true;
    }
    __device__ __forceinline__ void a_ready(const Unit&) const {}
    __device__ __forceinline__ void done(const Unit&) const {}
};

__device__ __forceinline__ unsigned cvt_pk_bf16(float lo, float hi) { unsigned r; asm volatile("v_cvt_pk_bf16_f32 %0, %1, %2" : "=v"(r) : "v"(lo), "v"(hi)); return r; }
typedef float f32x2 __attribute__((ext_vector_type(2)));
__device__ __forceinline__ void relane(int& wr, int& wc, int& fr, int& fq) { int l = hw_lane(); asm volatile("" : "+v"(l)); fr = l & 15; fq = l >> 4; (void)wr; (void)wc; }
__device__ __forceinline__ f32x2 gelu_pk(f32x2 v) {
    const f32x2 av = __builtin_elementwise_abs(v), d = av * 0.2316418882f + 1.0f;
    f32x2 t; t.x = __builtin_amdgcn_rcpf(d.x); t.y = __builtin_amdgcn_rcpf(d.y);
    f32x2 q = t * 0.5307027145f + (-0.7265760135f); q = q * t + 0.7107068705f; q = q * t + (-0.142248368f); q = q * t + 0.127414796f; q = q * t;
    const f32x2 s = (v * v) * (-0.72134752044f);
    f32x2 e; e.x = __builtin_amdgcn_exp2f(s.x); e.y = __builtin_amdgcn_exp2f(s.y);
    const f32x2 m = v * (q * e), r = v - m;
    f32x2 o; o.x = v.x < 0.f ? m.x : r.x; o.y = v.y < 0.f ? m.y : r.y; return o;
}

template <int ACT  > struct EpiBf16 {
    static constexpr bool PERM = true, AFTER_DRAIN = false; static_assert(ACT == 0 || ACT == 1, "EpiBf16: ACT is 0 (none) or 1 (gelu_pk)");
    bf16_t* O; int ldc; const float* bias; int split_cols; size_t split_stride; float scale0;
    __device__ __forceinline__ void operator()(const f32x4 (&acc)[2][2][4][2], const Unit& u, int wr, int wc, int fr, int fq) const {
        relane(wr, wc, fr, fq);
        const int row0 = u.pm * BM + wr * 64 + fr; int colt = u.pn * BM; bf16_t* base = O;
        float sc = 1.f; if (split_cols) { const int t = colt / split_cols; base += (size_t)t * split_stride; colt -= t * split_cols; if (t == 0) sc = scale0; }
        const int col0 = colt + wc * 32 + 8 * fq, bcol0 = u.pn * BM + wc * 32 + 8 * fq;
        f32x4 bv[2][2];
#pragma unroll
        for (int bj = 0; bj < 2; ++bj)
#pragma unroll
            for (int n = 0; n < 2; ++n) bv[bj][n] = bias ? *(const f32x4*)(bias + bcol0 + bj * HALF + 4 * n) : (f32x4){0.f, 0.f, 0.f, 0.f};
#pragma unroll
        for (int ai = 0; ai < 2; ++ai)
#pragma unroll
            for (int m = 0; m < 4; ++m) { bf16_t* rowp = base + (size_t)(row0 + ai * HALF + m * 16) * ldc + col0;
#pragma unroll
                for (int bj = 0; bj < 2; ++bj) { f32x4 v0 = acc[ai][bj][m][0] + bv[bj][0], v1 = acc[ai][bj][m][1] + bv[bj][1];
                    if (ACT == 1) { f32x2 a = gelu_pk((f32x2){v0[0], v0[1]}), b = gelu_pk((f32x2){v0[2], v0[3]}), c = gelu_pk((f32x2){v1[0], v1[1]}), d = gelu_pk((f32x2){v1[2], v1[3]});
                        v0 = (f32x4){a.x, a.y, b.x, b.y}; v1 = (f32x4){c.x, c.y, d.x, d.y}; }
                    v0 = v0 * sc; v1 = v1 * sc; u32x4 w; w.x = cvt_pk_bf16(v0[0], v0[1]); w.y = cvt_pk_bf16(v0[2], v0[3]); w.z = cvt_pk_bf16(v1[0], v1[1]); w.w = cvt_pk_bf16(v1[2], v1[3]);
                    *(u32x4*)(rowp + bj * HALF) = w; } }
    }
};

struct PanelStats {
    unsigned* xbuf;
    unsigned* cnt;
    unsigned* tmo;
    int ntn; float eps;
    unsigned code;
    __device__ __forceinline__ bool run(const f32x4 (&v)[2][2][4][2], const Unit& u, int wr, int wc, int fr, int fq, PG8_LAS unsigned char* lds, int wid, int lane) const {
        typedef float f32x2v __attribute__((ext_vector_type(2)));
        PG8_LAS f32x2v* P = (PG8_LAS f32x2v*)lds;
        PG8_LAS f32x2v* S = (PG8_LAS f32x2v*)(lds + 8192);
        PG8_LAS unsigned* flag = (PG8_LAS unsigned*)(lds + 8192 + 2048);
#pragma unroll
        for (int ai = 0; ai < 2; ++ai)
#pragma unroll
            for (int m = 0; m < 4; ++m) {
                float s = 0.f;
#pragma unroll
                for (int bj = 0; bj < 2; ++bj)
#pragma unroll
                    for (int n = 0; n < 2; ++n) { const f32x4 x = v[ai][bj][m][n]; s += (x[0] + x[1]) + (x[2] + x[3]); }
                s += __shfl_xor(s, 16); s += __shfl_xor(s, 32);
                const float mw = s * (1.0f / 64.0f); float q = 0.f;
#pragma unroll
                for (int bj = 0; bj < 2; ++bj)
#pragma unroll
                    for (int n = 0; n < 2; ++n) { const f32x4 d = v[ai][bj][m][n] - mw; q += (d[0] * d[0] + d[1] * d[1]) + (d[2] * d[2] + d[3] * d[3]); }
                q += __shfl_xor(q, 16); q += __shfl_xor(q, 32);
                if (fq == 0) P[(ai * HALF + wr * 64 + m * 16 + fr) * 4 + wc] = (f32x2v){mw, q};
            }
        asm volatile("s_waitcnt lgkmcnt(0)" ::: "memory"); __builtin_amdgcn_s_barrier(); asm volatile("" ::: "memory");
#if defined(BROKEN_EXCHANGE_NO_WAIT)
#warning BROKEN CONTROL BUILD: the row-statistics exchange does not wait; results are wrong by design
        if (blockIdx.x >= 64) { const long long t0_ = clock64(); while (clock64() - t0_ < 60000) __builtin_amdgcn_s_sleep(8); }
#endif
        const int row = wid * 32 + (lane & 31);
        if (lane < 32) {
            const f32x2v a = P[row * 4 + 0], b = P[row * 4 + 1], c = P[row * 4 + 2], d = P[row * 4 + 3];
            const float mt = (a.x + b.x + c.x + d.x) * 0.25f;
            const float da = a.x - mt, db = b.x - mt, dc = c.x - mt, dd = d.x - mt;
            const float m2 = (a.y + b.y) + (c.y + d.y) + 64.0f * ((da * da + db * db) + (dc * dc + dd * dd));
            unsigned long long* slot = (unsigned long long*)xbuf + ((size_t)(u.pm * BM + row) * 4 + u.pn);
            __hip_atomic_store(slot, ((unsigned long long)__float_as_uint(m2) << 32) | __float_as_uint(mt), __ATOMIC_RELAXED, __HIP_MEMORY_SCOPE_AGENT);
        }
        asm volatile("s_waitcnt vmcnt(0)" ::: "memory");
        if (lane == 0) __hip_atomic_fetch_add(cnt + 64 * u.pm, 1u, __ATOMIC_RELAXED, __HIP_MEMORY_SCOPE_AGENT);
        if (wid == 0) {
            bool dead = false; const unsigned long long t0 = __builtin_amdgcn_s_memrealtime(); const unsigned want = 8u * (unsigned)ntn;
            for (;;) {
#if defined(BROKEN_EXCHANGE_NO_WAIT)
                break;
#endif
                if ((unsigned)__builtin_amdgcn_readfirstlane(__hip_atomic_load(cnt + 64 * u.pm, __ATOMIC_RELAXED, __HIP_MEMORY_SCOPE_AGENT)) >= want) break;
                if (__builtin_amdgcn_s_memrealtime() - t0 > 2000000ull) {
                    if (lane == 0) { unsigned expect = 0u; __hip_atomic_compare_exchange_strong(tmo + 1, &expect, code | (unsigned)(u.pm & 0xff), __ATOMIC_RELAXED, __ATOMIC_RELAXED, __HIP_MEMORY_SCOPE_AGENT);
                                     __hip_atomic_store(tmo, 1u, __ATOMIC_RELAXED, __HIP_MEMORY_SCOPE_AGENT); }
                    dead = true; break; }
                __builtin_amdgcn_s_sleep(2);
            }
            __builtin_amdgcn_fence(__ATOMIC_ACQUIRE, "agent");
            if (lane == 0) flag[0] = dead ? 1u : 0u;
        }
        asm volatile("s_waitcnt vmcnt(0) lgkmcnt(0)" ::: "memory"); __builtin_amdgcn_s_barrier(); asm volatile("" ::: "memory");
        const bool bad = flag[0] != 0u;
        if (lane < 32) {
            const unsigned long long* slot = (const unsigned long long*)xbuf + (size_t)(u.pm * BM + row) * 4; float mt[4], m2[4]; float ms = 0.f;
#pragma unroll
            for (int t = 0; t < 4; ++t) { if (t < ntn) { const unsigned long long w = __hip_atomic_load(slot + t, __ATOMIC_RELAXED, __HIP_MEMORY_SCOPE_AGENT); mt[t] = __uint_as_float((unsigned)w); m2[t] = __uint_as_float((unsigned)(w >> 32)); } else { mt[t] = 0.f; m2[t] = 0.f; } ms += mt[t]; }
            const float mean = ms / (float)ntn; float q = 0.f;
#pragma unroll
            for (int t = 0; t < 4; ++t) if (t < ntn) { const float dm = mt[t] - mean; q += m2[t] + 256.0f * dm * dm; }
            S[row] = (f32x2v){mean, 1.0f / sqrtf(q / (256.0f * (float)ntn) + eps)};
        }
        asm volatile("s_waitcnt lgkmcnt(0)" ::: "memory"); __builtin_amdgcn_s_barrier(); asm volatile("" ::: "memory");
        return bad;
    }
};
struct EpiLnRes {
    static constexpr bool PERM = false, AFTER_DRAIN = true;
    const float* base; float* out; int ldc; const float* bias; PanelStats st; unsigned poison;
    __device__ __forceinline__ void fused(f32x4 (&acc)[2][2][4][2], const Unit& u, int wr, int wc, int fr, int fq, PG8_LAS unsigned char* lds, int wid, int lane) const {
        typedef float f32x2v __attribute__((ext_vector_type(2)));
        const PG8_LAS f32x2v* S = (const PG8_LAS f32x2v*)(lds + 8192);
        const int col0 = u.pn * BM + wc * 32 + 4 * fq;
#pragma unroll
        for (int bj = 0; bj < 2; ++bj)
#pragma unroll
            for (int n = 0; n < 2; ++n) { const f32x4 bv = bias ? *(const f32x4*)(bias + col0 + bj * HALF + n * 16) : (f32x4){0.f, 0.f, 0.f, 0.f};
#pragma unroll
                for (int ai = 0; ai < 2; ++ai)
#pragma unroll
                    for (int m = 0; m < 4; ++m) acc[ai][bj][m][n] += bv; }
        f32x4 pre[4][2][2];
#pragma unroll
        for (int m = 0; m < 4; ++m) { const size_t off = (size_t)(u.pm * BM + wr * 64 + m * 16 + fr) * ldc + col0;
#pragma unroll
            for (int bj = 0; bj < 2; ++bj)
#pragma unroll
                for (int n = 0; n < 2; ++n) pre[m][bj][n] = *(const f32x4*)(base + off + bj * HALF + n * 16); }
        const bool bad = st.run(acc, u, wr, wc, fr, fq, lds, wid, lane) || poison != 0u;
        const float qnan = __builtin_nanf("");
#pragma unroll
        for (int ai = 0; ai < 2; ++ai)
#pragma unroll
            for (int m = 0; m < 4; ++m) { const int r = ai * HALF + wr * 64 + m * 16 + fr; const f32x2v sr = S[r]; const size_t off = (size_t)(u.pm * BM + r) * ldc + col0;
#pragma unroll
                for (int bj = 0; bj < 2; ++bj)
#pragma unroll
                    for (int n = 0; n < 2; ++n) { const f32x4 bs = ai == 0 ? pre[m][bj][n] : *(const f32x4*)(base + off + bj * HALF + n * 16); f32x4 o = bs + (acc[ai][bj][m][n] - sr.x) * sr.y;
                        if (bad) o = (f32x4){qnan, qnan, qnan, qnan}; *(f32x4*)(out + off + bj * HALF + n * 16) = o; }
                if (m & 1) asm volatile("" ::: "memory"); }
    }
};
struct EpiLnResLn {
    static constexpr bool PERM = false, AFTER_DRAIN = true;
    const float* base; float* out; bf16_t* xn; int ldc; const float* bias; PanelStats st1, st2; unsigned poison;
    __device__ __forceinline__ void fused(f32x4 (&acc)[2][2][4][2], const Unit& u, int wr, int wc, int fr, int fq, PG8_LAS unsigned char* lds, int wid, int lane) const {
        typedef float f32x2v __attribute__((ext_vector_type(2))); typedef unsigned u32x2v __attribute__((ext_vector_type(2)));
        const PG8_LAS f32x2v* S = (const PG8_LAS f32x2v*)(lds + 8192);
        const int col0 = u.pn * BM + wc * 32 + 4 * fq;
#pragma unroll
        for (int bj = 0; bj < 2; ++bj)
#pragma unroll
            for (int n = 0; n < 2; ++n) { const f32x4 bv = bias ? *(const f32x4*)(bias + col0 + bj * HALF + n * 16) : (f32x4){0.f, 0.f, 0.f, 0.f};
#pragma unroll
                for (int ai = 0; ai < 2; ++ai)
#pragma unroll
                    for (int m = 0; m < 4; ++m) acc[ai][bj][m][n] += bv; }
        bool bad = st1.run(acc, u, wr, wc, fr, fq, lds, wid, lane) || poison != 0u;
        const float qnan = __builtin_nanf("");
#pragma unroll
        for (int ai = 0; ai < 2; ++ai)
#pragma unroll
            for (int m = 0; m < 4; ++m) { const int r = ai * HALF + wr * 64 + m * 16 + fr; const f32x2v sr = S[r]; const size_t off = (size_t)(u.pm * BM + r) * ldc + col0;
#pragma unroll
                for (int bj = 0; bj < 2; ++bj)
#pragma unroll
                    for (int n = 0; n < 2; ++n) { const f32x4 bs = *(const f32x4*)(base + off + bj * HALF + n * 16); acc[ai][bj][m][n] = bs + (acc[ai][bj][m][n] - sr.x) * sr.y; }
                asm volatile("" : "+v"(acc[ai][0][m][0]), "+v"(acc[ai][0][m][1]), "+v"(acc[ai][1][m][0]), "+v"(acc[ai][1][m][1]));
                if (m & 1) asm volatile("" ::: "memory"); }
        const bool bad1 = bad;
        bad = st2.run(acc, u, wr, wc, fr, fq, lds, wid, lane) || bad;
#pragma unroll
        for (int ai = 0; ai < 2; ++ai)
#pragma unroll
            for (int m = 0; m < 4; ++m) { const int r = ai * HALF + wr * 64 + m * 16 + fr; const f32x2v sr = S[r]; const size_t off = (size_t)(u.pm * BM + r) * ldc + col0;
#pragma unroll
                for (int bj = 0; bj < 2; ++bj)
#pragma unroll
                    for (int n = 0; n < 2; ++n) { const f32x4 x1 = acc[ai][bj][m][n]; *(f32x4*)(out + off + bj * HALF + n * 16) = bad1 ? (f32x4){qnan, qnan, qnan, qnan} : x1;
                        const f32x4 o = (x1 - sr.x) * sr.y; u32x2v w; w.x = cvt_pk_bf16(o[0], o[1]); w.y = cvt_pk_bf16(o[2], o[3]);
                        if (bad) { w.x = 0x7fc07fc0u; w.y = 0x7fc07fc0u; } *(u32x2v*)(xn + off + bj * HALF + n * 16) = w; }
                asm volatile("" ::: "memory"); }
    }
};

template <class Epi, class Sched, bool ALIGN_EPI = false, bool SP2 = false>
__device__ __forceinline__ void gemm_phase(PG8_LAS unsigned char* lds, const Gemm g, const Sched& S, const Epi& E, const int wave0) {
    int tid_ = tid_from_wave(wave0);
    const int tid = tid_, wid = __builtin_amdgcn_readfirstlane(tid >> 6), lane = tid & 63, wr = wid >> 2, wc = wid & 3, fr = lane & 15, fq = lane >> 4;
    const int K = g.K, nt = K / BK;
    unsigned voffA[2], voffB[2];
#pragma unroll
    for (int i = 0; i < 2; ++i) { int R, C; stage_rc(tid * 16 + i * 8192, R, C); const int Rb = Epi::PERM ? ((R & ~31) + perm32(R & 31)) : R;
        voffA[i] = (unsigned)(R * K + C) * 2u; voffB[i] = (unsigned)(Rb * K + C) * 2u; }
    const size_t kstep = (size_t)(BK * 2);
    const size_t hstep = (size_t)HALF * K * 2;
    const size_t tstep = 2 * hstep;
    const unsigned ldsw = (unsigned)wid * 1024u;
    const int aoff = lds_byte(wr * 64 + fr, fq * 8), boff = lds_byte(wc * 32 + fr, fq * 8);
#define PG8_SA(b, h) (((b) * 2 + (h)) * HTB)
#define PG8_SB(b, h) ((4 + (b) * 2 + (h)) * HTB)
#define PG8_STAGE(bufoff, gbase, voff) do { _Pragma("unroll") for (int _i = 0; _i < 2; ++_i) \
        __builtin_amdgcn_global_load_lds((const unsigned*)((const char*)(gbase) + (voff)[_i]), (PG8_LAS unsigned*)(lds + (bufoff) + ldsw + _i * 8192), 16, 0, 0); } while (0)
#define PG8_LDA(dst, b, h) do { _Pragma("unroll") for (int m = 0; m < 4; ++m) _Pragma("unroll") for (int k = 0; k < 2; ++k) dst[m][k] = *(const PG8_LAS bf16x8*)(lds + PG8_SA(b, h) + aoff + m * 2048 + k * 1024); } while (0)
#define PG8_LDB(dst, b, h) do { _Pragma("unroll") for (int n = 0; n < 2; ++n) _Pragma("unroll") for (int k = 0; k < 2; ++k) dst[n][k] = *(const PG8_LAS bf16x8*)(lds + PG8_SB(b, h) + boff + n * 2048 + k * 1024); } while (0)
#define PG8_MMA(ai, bj, At, Bt) do { __builtin_amdgcn_s_setprio(1); _Pragma("unroll") for (int m = 0; m < 4; ++m) _Pragma("unroll") for (int n = 0; n < 2; ++n) _Pragma("unroll") for (int k = 0; k < 2; ++k) \
        acc[ai][bj][m][n] = __builtin_amdgcn_mfma_f32_16x16x32_bf16(Bt[n][k], At[m][k], acc[ai][bj][m][n], 0, 0, 0); __builtin_amdgcn_s_setprio(0); } while (0)
#define PG8_WAIT_V(n) asm volatile("s_waitcnt vmcnt(" #n ")" ::: "memory")
#define PG8_WAIT_L(n) asm volatile("s_waitcnt lgkmcnt(" #n ")" ::: "memory")
#define PG8_BAR __builtin_amdgcn_s_barrier()
#define PG8_SCHED __builtin_amdgcn_sched_barrier(0)
    Unit cur, nxt; int ui = 0;
    if (!S.next(0, cur)) return;
    f32x4 acc[2][2][4][2];
#pragma unroll
    for (int a = 0; a < 2; ++a)
#pragma unroll
        for (int b = 0; b < 2; ++b)
#pragma unroll
            for (int m = 0; m < 4; ++m)
#pragma unroll
                for (int n = 0; n < 2; ++n) acc[a][b][m][n] = (f32x4){0.f, 0.f, 0.f, 0.f};
    bf16x8 At[4][2], B0[2][2], B1[2][2];
    const char* cA = (const char*)g.A + (size_t)cur.pm * tstep; const char* cB = (const char*)g.Bt + (size_t)cur.pn * tstep;
    S.a_ready(cur);
    if constexpr (SP2) {
        PG8_STAGE(PG8_SB(0, 0), cB, voffB); PG8_STAGE(PG8_SB(0, 1), cB + hstep, voffB); PG8_STAGE(PG8_SA(0, 0), cA, voffA); PG8_STAGE(PG8_SA(0, 1), cA + hstep, voffA);
        if (wr == 1) PG8_BAR;
        PG8_WAIT_V(2); PG8_BAR;
        PG8_STAGE(PG8_SB(1, 0), cB + kstep, voffB); PG8_STAGE(PG8_SA(1, 0), cA + kstep, voffA); PG8_STAGE(PG8_SB(1, 1), cB + hstep + kstep, voffB);
        PG8_WAIT_V(6); PG8_BAR;
    } else {
        PG8_STAGE(PG8_SB(0, 0), cB, voffB); PG8_STAGE(PG8_SA(0, 0), cA, voffA); PG8_STAGE(PG8_SB(0, 1), cB + hstep, voffB); PG8_STAGE(PG8_SA(0, 1), cA + hstep, voffA);
        if (wr == 1) PG8_BAR;
        PG8_WAIT_V(4); PG8_BAR;
        PG8_STAGE(PG8_SB(1, 0), cB + kstep, voffB); PG8_STAGE(PG8_SA(1, 0), cA + kstep, voffA); PG8_STAGE(PG8_SB(1, 1), cB + hstep + kstep, voffB);
        PG8_WAIT_V(6); PG8_BAR;
    }
    for (;;) {
        const bool has_next = S.next(ui + 1, nxt);
        const char* nA = has_next ? (const char*)g.A + (size_t)nxt.pm * tstep : cA; const char* nB = has_next ? (const char*)g.Bt + (size_t)nxt.pn * tstep : cB;
        for (int t = 0; t < nt; t += 2) {
            const bool last = (t == nt - 2);
            const char* a1 = cA + (size_t)(t + 1) * kstep;
            const char* a2 = last ? nA : cA + (size_t)(t + 2) * kstep; const char* b2 = last ? nB : cB + (size_t)(t + 2) * kstep;
            const char* a3 = a2 + kstep; const char* b3 = b2 + kstep;
            if (last && has_next) S.a_ready(nxt);
            if constexpr (SP2) {
            PG8_LDB(B0, 0, 0); PG8_LDB(B1, 0, 1); PG8_SCHED; PG8_LDA(At, 0, 0); PG8_STAGE(PG8_SA(1, 1), a1 + hstep, voffA);
            PG8_WAIT_V(8); PG8_WAIT_L(0); PG8_BAR; PG8_MMA(0, 0, At, B0); PG8_MMA(0, 1, At, B1); PG8_BAR; PG8_SCHED;
            PG8_LDA(At, 0, 1); PG8_STAGE(PG8_SB(0, 0), b2, voffB); PG8_STAGE(PG8_SB(0, 1), b2 + hstep, voffB); PG8_STAGE(PG8_SA(0, 0), a2, voffA);
            PG8_WAIT_V(8); PG8_WAIT_L(0); PG8_BAR; PG8_MMA(1, 0, At, B0); PG8_MMA(1, 1, At, B1); PG8_BAR; PG8_SCHED;
            PG8_LDB(B0, 1, 0); PG8_LDB(B1, 1, 1); PG8_SCHED; PG8_LDA(At, 1, 0); PG8_STAGE(PG8_SA(0, 1), a2 + hstep, voffA);
            PG8_WAIT_V(8); PG8_WAIT_L(0); PG8_BAR; PG8_MMA(0, 0, At, B0); PG8_MMA(0, 1, At, B1); PG8_BAR; PG8_SCHED;
            PG8_LDA(At, 1, 1); PG8_STAGE(PG8_SB(1, 0), b3, voffB); PG8_STAGE(PG8_SB(1, 1), b3 + hstep, voffB); PG8_STAGE(PG8_SA(1, 0), a3, voffA);
            PG8_WAIT_V(8); PG8_WAIT_L(0); PG8_BAR; PG8_MMA(1, 0, At, B0); PG8_MMA(1, 1, At, B1); PG8_BAR; PG8_SCHED;
            } else {
            PG8_LDB(B0, 0, 0); PG8_SCHED; PG8_LDA(At, 0, 0); PG8_STAGE(PG8_SA(1, 1), a1 + hstep, voffA);
            PG8_WAIT_L(8); PG8_BAR; PG8_WAIT_L(0); PG8_MMA(0, 0, At, B0); PG8_BAR; PG8_SCHED;
            PG8_LDB(B1, 0, 1); PG8_STAGE(PG8_SB(0, 0), b2, voffB);
            PG8_BAR; PG8_WAIT_L(0); PG8_MMA(0, 1, At, B1); PG8_BAR;
            PG8_LDA(At, 0, 1); PG8_STAGE(PG8_SA(0, 0), a2, voffA);
            PG8_BAR; PG8_WAIT_L(0); PG8_MMA(1, 0, At, B0); PG8_BAR; PG8_SCHED;
            PG8_STAGE(PG8_SB(0, 1), b2 + hstep, voffB);
            PG8_WAIT_V(6); PG8_BAR; PG8_MMA(1, 1, At, B1); PG8_BAR;
            PG8_LDB(B0, 1, 0); PG8_SCHED; PG8_LDA(At, 1, 0); PG8_STAGE(PG8_SA(0, 1), a2 + hstep, voffA);
            PG8_WAIT_L(8); PG8_BAR; PG8_WAIT_L(0); PG8_MMA(0, 0, At, B0); PG8_BAR; PG8_SCHED;
            PG8_LDB(B1, 1, 1); PG8_STAGE(PG8_SB(1, 0), b3, voffB);
            PG8_BAR; PG8_WAIT_L(0); PG8_MMA(0, 1, At, B1); PG8_BAR;
            PG8_LDA(At, 1, 1); PG8_STAGE(PG8_SA(1, 0), a3, voffA);
            PG8_BAR; PG8_WAIT_L(0); PG8_MMA(1, 0, At, B0); PG8_BAR; PG8_SCHED;
            PG8_STAGE(PG8_SB(1, 1), b3 + hstep, voffB);
            PG8_WAIT_V(6); PG8_BAR; PG8_MMA(1, 1, At, B1); PG8_BAR;
            }
        }
        if constexpr (ALIGN_EPI) { if (wr == 0) PG8_BAR; }
        if constexpr (!Epi::AFTER_DRAIN) { E(acc, cur, wr, wc, fr, fq); S.done(cur); }
        if (!has_next) break;
#pragma unroll
        for (int a = 0; a < 2; ++a)
#pragma unroll
            for (int b = 0; b < 2; ++b)
#pragma unroll
                for (int m = 0; m < 4; ++m)
#pragma unroll
                    for (int n = 0; n < 2; ++n) acc[a][b][m][n] = (f32x4){0.f, 0.f, 0.f, 0.f};
        cur = nxt; cA = nA; cB = nB; ++ui;
        if constexpr (ALIGN_EPI) { if (wr == 1) PG8_BAR; }
    }
    PG8_WAIT_V(0);
    if constexpr (!ALIGN_EPI) { if (wr == 0) PG8_BAR; }
    PG8_BAR;
    if constexpr (Epi::AFTER_DRAIN) { E.fused(acc, cur, wr, wc, fr, fq, lds, wid, lane); S.done(cur); }
#undef PG8_SA
#undef PG8_SB
#undef PG8_STAGE
#undef PG8_LDA
#undef PG8_LDB
#undef PG8_MMA
#undef PG8_WAIT_V
#undef PG8_WAIT_L
#undef PG8_BAR
#undef PG8_SCHED
}
}

namespace pg8 {
struct EpiRelu2 {
    static constexpr bool PERM = true, AFTER_DRAIN = false;
    bf16_t* O; int ldc;
    __device__ __forceinline__ void operator()(const f32x4 (&acc)[2][2][4][2], const Unit& u, int wr, int wc, int fr, int fq) const {
        relane(wr, wc, fr, fq);
        const int row0 = u.pm * BM + wr * 64 + fr, col0 = u.pn * BM + wc * 32 + 8 * fq;
#pragma unroll
        for (int ai = 0; ai < 2; ++ai)
#pragma unroll
            for (int m = 0; m < 4; ++m) { bf16_t* rowp = O + (size_t)(row0 + ai * HALF + m * 16) * ldc + col0;
#pragma unroll
                for (int bj = 0; bj < 2; ++bj) { f32x4 v0 = acc[ai][bj][m][0], v1 = acc[ai][bj][m][1];
                    v0 = __builtin_elementwise_max(v0, (f32x4){0.f, 0.f, 0.f, 0.f}); v1 = __builtin_elementwise_max(v1, (f32x4){0.f, 0.f, 0.f, 0.f}); v0 = v0 * v0; v1 = v1 * v1;
                    u32x4 w; w.x = cvt_pk_bf16(v0[0], v0[1]); w.y = cvt_pk_bf16(v0[2], v0[3]); w.z = cvt_pk_bf16(v1[0], v1[1]); w.w = cvt_pk_bf16(v1[2], v1[3]);
                    *(u32x4*)(rowp + bj * HALF) = w; } }
    }
};
struct EpiF32 {
    static constexpr bool PERM = false, AFTER_DRAIN = false;
    float* O; int ldc;
    __device__ __forceinline__ void operator()(const f32x4 (&acc)[2][2][4][2], const Unit& u, int wr, int wc, int fr, int fq) const {
        relane(wr, wc, fr, fq);
        const int row0 = u.pm * BM + wr * 64 + fr, col0 = u.pn * BM + wc * 32 + 4 * fq;
#pragma unroll
        for (int ai = 0; ai < 2; ++ai)
#pragma unroll
            for (int m = 0; m < 4; ++m) { float* rowp = O + (size_t)(row0 + ai * HALF + m * 16) * ldc + col0;
#pragma unroll
                for (int bj = 0; bj < 2; ++bj)
#pragma unroll
                    for (int n = 0; n < 2; ++n) *(f32x4*)(rowp + bj * HALF + n * 16) = acc[ai][bj][m][n]; }
    }
};
struct EpiTaps {
    static constexpr bool PERM = false, AFTER_DRAIN = false;
    float* O; const float* decay;
    __device__ __forceinline__ void operator()(const f32x4 (&acc)[2][2][4][2], const Unit& u, int wr, int wc, int fr, int fq) const {
        relane(wr, wc, fr, fq);
        const int row0 = u.pm * BM + wr * 64 + fr, col0 = u.pn * BM + wc * 32 + 4 * fq;
#pragma unroll
        for (int ai = 0; ai < 2; ++ai)
#pragma unroll
            for (int m = 0; m < 4; ++m) { const int row = row0 + ai * HALF + m * 16; float* rowp = O + (size_t)row * 16384 + col0; const float nd = -fabsf(decay[row]) * (1.0f / 16383.0f) * 1.4426950408889634f;
#pragma unroll
                for (int bj = 0; bj < 2; ++bj)
#pragma unroll
                    for (int n = 0; n < 2; ++n) { const int c = col0 + bj * HALF + n * 16; const f32x4 a = acc[ai][bj][m][n]; f32x4 o;
                        o[0] = a[0] * __builtin_amdgcn_exp2f(nd * (float)(c + 0)); o[1] = a[1] * __builtin_amdgcn_exp2f(nd * (float)(c + 1));
                        o[2] = a[2] * __builtin_amdgcn_exp2f(nd * (float)(c + 2)); o[3] = a[3] * __builtin_amdgcn_exp2f(nd * (float)(c + 3));
                        *(f32x4*)(rowp + bj * HALF + n * 16) = o; } }
    }
};
}

constexpr int L = 16384, NSEQ = 3, M = NSEQ * L, D = 1024, DEPTH = 4;
constexpr int HYW = 512, HYP = 1536, QR = 256, KVR = 128, ROPE = 32, INW = 1952;
constexpr int NH = 8, DQ = 96, DV = 64, NQ = NH * DQ, NKV = NH * 128;
constexpr int FF = 4096;
constexpr float EPS = 1e-6f;
constexpr int NWAVES = 8, NTHR = 512;
constexpr int MLP_CHUNK = 16384, N_MLP_CHUNKS = M / MLP_CHUNK;

constexpr size_t MiB = 1u << 20;
constexpr size_t WS_CTL = 0, CTL_ZERO_BYTES = 65536;
constexpr size_t WS_COS = 1 * MiB, WS_SIN = 2 * MiB;
constexpr size_t WS_H2 = 4 * MiB;
constexpr size_t WS_W3T = 8 * MiB;
constexpr size_t WS_WIN = 12 * MiB, WS_WOUT = 16 * MiB, WS_WUP = 18 * MiB, WS_WDOWN = 26 * MiB, WS_WUQ = 34 * MiB, WS_WUKV = 34 * MiB + 512 * 1024;
constexpr size_t WS_XN = 36 * MiB;
constexpr size_t WS_CQN = 36 * MiB, WS_CKVN = 60 * MiB, WS_KPE = 72 * MiB;
constexpr size_t WS_KEO = 132 * MiB;
constexpr size_t WS_KT = 261 * MiB;
constexpr size_t WS_UT = 261 * MiB;
constexpr size_t WS_CQKV = 405 * MiB;
constexpr size_t WS_YT = 453 * MiB;
constexpr size_t WS_Q = 132 * MiB, WS_KN = 204 * MiB;
constexpr size_t WS_MIX = 324 * MiB;
constexpr size_t WS_T = 132 * MiB;
constexpr size_t WS_H = 324 * MiB;
constexpr size_t WS_G0 = 75 * MiB, WS_G1A = 107 * MiB, WS_G1B = 501 * MiB;
constexpr size_t WS_END = 508 * MiB;
constexpr int KEO_BLK = 16512, KEO_KO = 8256;
static_assert(WS_KEO + (size_t)1024 * KEO_BLK * 8 <= WS_KT, "KEO fits");
static_assert(WS_UT + (size_t)HYP * M * 2 <= WS_CQKV && WS_CQKV + (size_t)M * 512 * 2 <= WS_YT && WS_YT + (size_t)HYW * M * 2 <= WS_END, "map");
static_assert(WS_KN + (size_t)M * NKV * 2 <= WS_MIX && WS_T + (size_t)M * D * 4 <= WS_MIX && WS_H + (size_t)MLP_CHUNK * FF * 2 <= WS_END, "map2");

constexpr int RING_OFF = 0, RING_BYTES = 139264;
constexpr int LDSCTL_OFF = RING_BYTES, MISC_OFF = LDSCTL_OFF + 320;
constexpr int LDS_BYTES = 147456;
static_assert(MISC_OFF + 128 <= LDS_BYTES, "LDS map");

#define GAS __attribute__((address_space(1)))
#define LAS __attribute__((address_space(3)))
typedef unsigned short bf16;
typedef unsigned v4u __attribute__((ext_vector_type(4)));
typedef unsigned v2u __attribute__((ext_vector_type(2)));
typedef float f32x4 __attribute__((ext_vector_type(4)));
typedef float f32x2 __attribute__((ext_vector_type(2)));
typedef short bf16x8 __attribute__((ext_vector_type(8)));
typedef GAS unsigned gu32;
#define RLX_AGENT __ATOMIC_RELAXED, __HIP_MEMORY_SCOPE_AGENT
#define LDS_WAIT() asm volatile("s_waitcnt lgkmcnt(0)" ::: "memory")
#define VM_WAIT() asm volatile("s_waitcnt vmcnt(0)" ::: "memory")
typedef __bf16 bf16x2_t __attribute__((ext_vector_type(2)));
__device__ __forceinline__ unsigned pk2(float lo, float hi) { f32x2 v = {lo, hi}; bf16x2_t b = __builtin_convertvector(v, bf16x2_t); return __builtin_bit_cast(unsigned, b); }
__device__ __forceinline__ bf16 f2bf(float f) { return (bf16)(pk2(f, 0.f) & 0xffffu); }
__device__ __forceinline__ float bf2f(unsigned h) { return __uint_as_float(h << 16); }
__device__ __forceinline__ float wave_sum(float v) {
#pragma unroll
    for (int o = 1; o < 64; o <<= 1) v += __shfl_xor(v, o);
    return v;
}

namespace hfft {
constexpr float w32c(int i) { constexpr float t[16] = {1.000000000e+00f, 9.807852507e-01f, 9.238795042e-01f, 8.314695954e-01f, 7.071067691e-01f, 5.555702448e-01f, 3.826834261e-01f, 1.950903237e-01f, 0.f, -1.950903237e-01f, -3.826834261e-01f, -5.555702448e-01f, -7.071067691e-01f, -8.314695954e-01f, -9.238795042e-01f, -9.807852507e-01f}; return t[i]; }
constexpr float w32s(int i) { constexpr float t[16] = {0.000000000e+00f, 1.950903237e-01f, 3.826834261e-01f, 5.555702448e-01f, 7.071067691e-01f, 8.314695954e-01f, 9.238795042e-01f, 9.807852507e-01f, 1.000000000e+00f, 9.807852507e-01f, 9.238795042e-01f, 8.314695954e-01f, 7.071067691e-01f, 5.555702448e-01f, 3.826834261e-01f, 1.950903237e-01f}; return t[i]; }
constexpr int brev(int x, int bits) { int r = 0; for (int i = 0; i < bits; ++i) r |= ((x >> i) & 1) << (bits - 1 - i); return r; }
constexpr int ilog2(int x) { int r = 0; while ((1 << r) < x) ++r; return r; }
__device__ __forceinline__ int pad(int i) { return i + (i >> 5); }

__device__ __forceinline__ float fadd(float a, float b) { float r; asm("v_add_f32_e32 %0, %1, %2" : "=v"(r) : "v"(a), "v"(b)); return r; }
__device__ __forceinline__ float fsub(float a, float b) { float r; asm("v_sub_f32_e32 %0, %1, %2" : "=v"(r) : "v"(a), "v"(b)); return r; }
__device__ __forceinline__ float fmulc(float c, float x) { float r; asm("v_mul_f32_e32 %0, %1, %2" : "=v"(r) : "s"(c), "v"(x)); return r; }
__device__ __forceinline__ float ffmac(float c, float x, float acc) { asm("v_fmac_f32_e32 %0, %1, %2" : "+v"(acc) : "s"(c), "v"(x)); return acc; }
__device__ __forceinline__ float fmulv(float a, float b) { float r; asm("v_mul_f32_e32 %0, %1, %2" : "=v"(r) : "v"(a), "v"(b)); return r; }
__device__ __forceinline__ float ffmav(float a, float b, float acc) { asm("v_fmac_f32_e32 %0, %1, %2" : "+v"(acc) : "v"(a), "v"(b)); return acc; }
template <int R, bool INV> __device__ __forceinline__ void fft_r2(float (&re)[R], float (&im)[R], const unsigned z0) {
    constexpr int LG = ilog2(R);
#pragma unroll
    for (int st = 0; st < LG; ++st) {
        const int s = (R / 2) >> st;
#pragma unroll
        for (int blk = 0; blk < R; blk += 2 * s) {
#pragma unroll
            for (int a = 0; a < s; ++a) {
                const int i0 = blk + a, i1 = i0 + s;
                const float ur = fadd(re[i0], re[i1]), ui = fadd(im[i0], im[i1]);
                const float dr = fsub(re[i0], re[i1]), di = fsub(im[i0], im[i1]);
                re[i0] = ur; im[i0] = ui;
                const int w = a * (16 / s);
                if (w == 0) { re[i1] = dr; im[i1] = di; }
                else if (w == 8) { re[i1] = INV ? -di : di; im[i1] = INV ? dr : -dr; }
                else { const float c = __uint_as_float(__float_as_uint(w32c(w)) | z0), sn = __uint_as_float(__float_as_uint(INV ? w32s(w) : -w32s(w)) | z0);
                    re[i1] = ffmac(-sn, di, fmulc(c, dr)); im[i1] = ffmac(c, di, fmulc(sn, dr)); }
            }
        }
    }
}

__device__ __forceinline__ int opaque(int x) { asm volatile("" : "+v"(x)); return x; }
template <bool INV> __device__ __forceinline__ void fft16k(float (&re)[32], float (&im)[32], LAS f32x2* buf, const int t_in) {
    asm volatile("" ::: "memory"); __builtin_amdgcn_sched_barrier(0);
    int t = opaque(t_in);
    unsigned z0 = 0u; asm volatile("" : "+s"(z0));
    fft_r2<32, INV>(re, im, z0);
    __syncthreads();
#pragma unroll
    for (int r = 0; r < 32; ++r) buf[33 * t + r] = (f32x2){re[brev(r, 5)], im[brev(r, 5)]};
    __syncthreads();
    t = opaque(t);
    { const int b2 = t + (t >> 5);
#pragma unroll
    for (int r = 0; r < 32; ++r) { const f32x2 v = buf[b2 + 528 * r]; re[r] = v.x; im[r] = v.y; } }
    {
        const float f1 = (float)(t & 31) * (1.0f / 1024.0f);
        const float c1 = __builtin_amdgcn_cosf(f1), s1 = INV ? __builtin_amdgcn_sinf(f1) : -__builtin_amdgcn_sinf(f1);
        float wc = c1, ws = s1;
#pragma unroll
        for (int r = 1; r < 32; ++r) {
            const float xr = re[r], xi = im[r]; re[r] = ffmav(-xi, ws, fmulv(xr, wc)); im[r] = ffmav(xi, wc, fmulv(xr, ws));
            const float nc = ffmav(-ws, s1, fmulv(wc, c1)), ns = ffmav(ws, c1, fmulv(wc, s1)); wc = nc; ws = ns;
        }
    }
    fft_r2<32, INV>(re, im, z0);
    __syncthreads();
    {
        t = opaque(t);
        const int ob = (t >> 5) * 1056 + (t & 31);
#pragma unroll
        for (int r = 0; r < 32; ++r) buf[ob + 33 * r] = (f32x2){re[brev(r, 5)], im[brev(r, 5)]};
    }
    __syncthreads();
#pragma unroll
    for (int h = 0; h < 2; ++h) {
        t = opaque(t);
        float ar[16], ai[16]; const int j = t + 512 * h; const int b3 = t + (t >> 5) + 528 * h;
#pragma unroll
        for (int r = 0; r < 16; ++r) { const f32x2 v = buf[b3 + 1056 * r]; ar[r] = v.x; ai[r] = v.y; }
        {
            const float f1 = (float)j * (1.0f / 16384.0f);
            const float c1 = __builtin_amdgcn_cosf(f1), s1 = INV ? __builtin_amdgcn_sinf(f1) : -__builtin_amdgcn_sinf(f1);
            float wc = c1, ws = s1;
#pragma unroll
            for (int r = 1; r < 16; ++r) {
                const float xr = ar[r], xi = ai[r]; ar[r] = ffmav(-xi, ws, fmulv(xr, wc)); ai[r] = ffmav(xi, wc, fmulv(xr, ws));
                const float nc = ffmav(-ws, s1, fmulv(wc, c1)), ns = ffmav(ws, c1, fmulv(wc, s1)); wc = nc; ws = ns;
            }
        }
        fft_r2<16, INV>(ar, ai, z0);
#pragma unroll
        for (int r = 0; r < 16; ++r) { re[h + 2 * r] = ar[brev(r, 4)]; im[h + 2 * r] = ai[brev(r, 4)]; }
    }
    asm volatile("" ::: "memory"); __builtin_amdgcn_sched_barrier(0);
}
}

struct Frame {
    LAS unsigned char* lds;
    volatile LAS unsigned* MISC;
    gu32* ctl;
    int tid, lane, wave;
    int wave0;
    int vcu, G;
    float* out;
    unsigned char* ws;
};
constexpr int PTRTAB_OFF = LDSCTL_OFF + 512;
__device__ __forceinline__ const float* inp(const Frame& F, int i) {
    const v2u w = *(const LAS v2u*)(F.lds + PTRTAB_OFF + 8 * i);
    const unsigned lo = __builtin_amdgcn_readfirstlane(w.x), hi = __builtin_amdgcn_readfirstlane(w.y);
    return (const float*)(((unsigned long long)hi << 32) | lo);
}
__device__ __forceinline__ unsigned char* wsq(const Frame& F) { unsigned char* p = F.ws; asm volatile("" : "+s"(p)); return p; }
enum { I_XP = 0, I_XS, I_WIN, I_CONVW, I_CONVB, I_FW1, I_FB1, I_FW2, I_FB2, I_FW3, I_SINF, I_DECAY, I_HBIAS, I_QNORM, I_WUQ, I_KVNORM, I_WUKV, I_GNHY, I_GNAT, I_WOUT,
       I_NMIXPRE, I_NMIXPOST, I_NMLPPRE, I_NMLPPOST, I_WUP, I_WDOWN };

__device__ __forceinline__ int rope_src(int p) { return 4 * (p >> 3) + (p & 3) + 16 * ((p >> 2) & 1); }
template <bool ROPEPERM>
__device__ __forceinline__ void transpose_item(const float* W, int K, int N, bf16* WT, LAS float* scr, int item, int lane, int ldk = 0, int koff = 0) {
    if (ldk == 0) ldk = K;
    const int nblk = N / 32, kb = item / nblk, nb = item % nblk, k0 = 64 * kb, n0 = 32 * nb;
    int sc = lane & 31; if (ROPEPERM && (nb % 3) == 2) sc = rope_src(sc);
#pragma unroll 8
    for (int i = 0; i < 32; ++i) { const int kk = 2 * i + (lane >> 5); scr[kk * 33 + (lane & 31)] = W[(size_t)(k0 + kk) * N + n0 + sc]; }
    LDS_WAIT(); asm volatile("" ::: "memory");
    const int c = lane & 7;
#pragma unroll
    for (int j = 0; j < 4; ++j) { const int n = (lane >> 3) + 8 * j; const LAS float* s = scr + (8 * c) * 33 + n;
        v4u o; o.x = pk2(s[0 * 33], s[1 * 33]); o.y = pk2(s[2 * 33], s[3 * 33]); o.z = pk2(s[4 * 33], s[5 * 33]); o.w = pk2(s[6 * 33], s[7 * 33]);
        *(GAS v4u*)(WT + (size_t)(n0 + n) * ldk + koff + k0 + 8 * c) = o; }
    LDS_WAIT(); asm volatile("" ::: "memory");
}
__device__ __forceinline__ void phase_weights(Frame& F, int l) {
    LAS float* scr = (LAS float*)(F.lds + RING_OFF + F.wave * 16384);
    const int gw = F.vcu * NWAVES + F.wave, NGW = F.G * NWAVES;
    bf16* WinT = (bf16*)(wsq(F) + WS_WIN); bf16* WoutT = (bf16*)(wsq(F) + WS_WOUT); bf16* WupT = (bf16*)(wsq(F) + WS_WUP); bf16* WdownT = (bf16*)(wsq(F) + WS_WDOWN);
    bf16* WuqT = (bf16*)(wsq(F) + WS_WUQ); bf16* WukvT = (bf16*)(wsq(F) + WS_WUKV);
    constexpr int I_IN = (D / 64) * (INW / 32), I_OUT = (D / 64) * (D / 32), I_UP = (D / 64) * (FF / 32), I_DN = (FF / 64) * (D / 32), I_UQ = (QR / 64) * (NQ / 32), I_UKV = (KVR / 64) * (NKV / 32);
    constexpr int I_W3 = 2048 / 32;
    constexpr int NITEMS = I_IN + I_OUT + I_UP + I_DN + I_UQ + I_UKV + 2 * I_W3;
    for (int it = gw; it < NITEMS; it += NGW) {
        int r = it;
        if (r < I_IN) { transpose_item<false>(inp(F, I_WIN) + (size_t)l * D * INW, D, INW, WinT, scr, r, F.lane); continue; } r -= I_IN;
        if (r < I_OUT) { transpose_item<false>(inp(F, I_WOUT) + (size_t)l * D * D, D, D, WoutT, scr, r, F.lane); continue; } r -= I_OUT;
        if (r < I_UP) { transpose_item<false>(inp(F, I_WUP) + (size_t)l * D * FF, D, FF, WupT, scr, r, F.lane); continue; } r -= I_UP;
        if (r < I_DN) { transpose_item<false>(inp(F, I_WDOWN) + (size_t)l * FF * D, FF, D, WdownT, scr, r, F.lane); continue; } r -= I_DN;
        if (r < I_UQ) { transpose_item<true>(inp(F, I_WUQ) + (size_t)l * QR * NQ, QR, NQ, WuqT, scr, r, F.lane); continue; } r -= I_UQ;
        if (r < I_UKV) { transpose_item<false>(inp(F, I_WUKV) + (size_t)l * KVR * NKV, KVR, NKV, WukvT, scr, r, F.lane); continue; } r -= I_UKV;
        transpose_item<false>(inp(F, I_FW3) + (size_t)l * 64 * 2048, 64, 2048, (bf16*)(wsq(F) + WS_W3T), scr, r % I_W3, F.lane, 128, (r / I_W3) * 64);
    }
    { unsigned z = 0u; asm volatile("" : "+v"(z)); const v4u zz = {z, z, z, z};
      for (int i = gw * 64 + F.lane; i < 12288; i += NGW * 64) ((GAS v4u*)(WinT + (size_t)INW * D))[i] = zz; }
}
__device__ __forceinline__ void phase_rope_tab(Frame& F) {
    const float inv[16] = {1.000000000e+00f, 5.623413324e-01f, 3.162277639e-01f, 1.778279394e-01f, 1.000000015e-01f, 5.623412877e-02f, 3.162277862e-02f, 1.778279431e-02f,
                           9.999999776e-03f, 5.623413250e-03f, 3.162277862e-03f, 1.778279431e-03f, 1.000000047e-03f, 5.623413017e-04f, 3.162277862e-04f, 1.778279402e-04f};
    float* ct = (float*)(wsq(F) + WS_COS); float* st = (float*)(wsq(F) + WS_SIN);
    for (int i = F.vcu * NTHR + F.tid; i < L * 16; i += F.G * NTHR) {
        const int t = i >> 4, j = i & 15; float iv = inv[0];
#pragma unroll
        for (int q = 1; q < 16; ++q) iv = (j == q) ? inv[q] : iv;
        const float ang = (float)t * iv; ct[i] = cosf(ang); st[i] = sinf(ang);
    }
}
__device__ __forceinline__ const float* x_src_row(Frame& F, int l, int m) {
    if (l == 0) return (m < 2 * L) ? inp(F, I_XP) + (size_t)m * D : inp(F, I_XS) + (size_t)(m - 2 * L) * D;
    return F.out + (size_t)m * D;
}
__device__ __forceinline__ void store_xn_row(f32x4 (&v)[4], float rstd, const float* g, bf16* orow, int lane) {
    GAS v2u* o8 = (GAS v2u*)orow + lane;
#pragma unroll
    for (int j = 0; j < 4; ++j) { const f32x4 gg = ((const GAS f32x4*)g)[lane + 64 * j]; v2u w; w.x = pk2(v[j].x * rstd * gg.x, v[j].y * rstd * gg.y); w.y = pk2(v[j].z * rstd * gg.z, v[j].w * rstd * gg.w); o8[64 * j] = w; }
}
__device__ __forceinline__ float row_ss(const f32x4 (&v)[4]) { float s = 0.f;
#pragma unroll
    for (int j = 0; j < 4; ++j) s += (v[j].x * v[j].x + v[j].y * v[j].y) + (v[j].z * v[j].z + v[j].w * v[j].w);
    return wave_sum(s); }
__device__ __forceinline__ void phase_norm_first(Frame& F, int l, const float* g) {
    const int gw = F.vcu * NWAVES + F.wave, NGW = F.G * NWAVES; bf16* XN = (bf16*)(wsq(F) + WS_XN);
    for (int m = gw; m < M; m += NGW) {
        const GAS f32x4* xr = (const GAS f32x4*)x_src_row(F, l, m) + F.lane; f32x4 v[4];
#pragma unroll
        for (int j = 0; j < 4; ++j) v[j] = xr[64 * j];
        const float rstd = 1.0f / sqrtf(row_ss(v) * (1.0f / D) + EPS);
        store_xn_row(v, rstd, g, XN + (size_t)m * D, F.lane);
    }
}
__device__ __forceinline__ void phase_norm_res(Frame& F, int lsrc, const float* T, const float* gpost, const float* gnext) {
    const int gw = F.vcu * NWAVES + F.wave, NGW = F.G * NWAVES; bf16* XN = (bf16*)(wsq(F) + WS_XN);
    for (int m = gw; m < M; m += NGW) {
        const GAS f32x4* xr = (const GAS f32x4*)x_src_row(F, lsrc, m) + F.lane; const GAS f32x4* tr = (const GAS f32x4*)(T + (size_t)m * D) + F.lane; f32x4 v[4], tv[4];
#pragma unroll
        for (int j = 0; j < 4; ++j) { v[j] = xr[64 * j]; tv[j] = tr[64 * j]; }
        const float rt = 1.0f / sqrtf(row_ss(tv) * (1.0f / D) + EPS);
        GAS f32x4* orow = (GAS f32x4*)(F.out + (size_t)m * D) + F.lane;
#pragma unroll
        for (int j = 0; j < 4; ++j) { const f32x4 gg = ((const GAS f32x4*)gpost)[F.lane + 64 * j]; v[j] = v[j] + tv[j] * rt * gg; orow[64 * j] = v[j]; }
        if (gnext) { const float rstd = 1.0f / sqrtf(row_ss(v) * (1.0f / D) + EPS); store_xn_row(v, rstd, gnext, XN + (size_t)m * D, F.lane); }
    }
}

__device__ __forceinline__ void phase_filter_mlp(Frame& F, int l) {
    const float* w1 = inp(F, I_FW1) + (size_t)l * 33 * 64; const float* b1 = inp(F, I_FB1) + l * 64; const float* w2 = inp(F, I_FW2) + (size_t)l * 64 * 64; const float* b2 = inp(F, I_FB2) + l * 64;
    const float* sf = inp(F, I_SINF) + l * 128; bf16* H2 = (bf16*)(wsq(F) + WS_H2);
    const int lane = F.lane, gw = F.vcu * NWAVES + F.wave, NGW = F.G * NWAVES;
    float w1c[33], w2c[64];
#pragma unroll
    for (int f = 0; f < 33; ++f) w1c[f] = w1[f * 64 + lane];
#pragma unroll
    for (int i = 0; i < 64; ++i) w2c[i] = w2[i * 64 + lane];
    const float b1l = b1[lane], b2l = b2[lane], sf0 = sf[lane], sf1 = sf[64 + lane];
    for (int n = gw; n < L; n += NGW) {
        const float tn = (float)n * (1.0f / (float)(L - 1)); const float omega = (float)(2.0 * 3.14159265358979323846 / L) * (float)n;
        const int bidx = (lane >= 17) ? lane - 17 : lane - 1; const float band = 1e-4f + (float)bidx * ((15.0f - 1e-4f) / 15.0f); const float ph = omega * band;
        const float zf = (lane == 0) ? tn : ((lane <= 16) ? cosf(ph) : -sinf(ph));
        float acc = b1l;
#pragma unroll
        for (int f = 0; f < 33; ++f) acc += __uint_as_float(__builtin_amdgcn_readlane(__float_as_uint(zf), f)) * w1c[f];
        const float h1 = sinf(sf0 * acc);
        float acc2 = b2l;
#pragma unroll
        for (int i = 0; i < 64; ++i) acc2 += __uint_as_float(__builtin_amdgcn_readlane(__float_as_uint(h1), i)) * w2c[i];
        const float hv = sinf(sf1 * acc2); const bf16 hi = f2bf(hv);
        H2[(size_t)n * 128 + lane] = hi; H2[(size_t)n * 128 + 64 + lane] = f2bf(hv - bf2f(hi));
    }
}

__device__ __forceinline__ void phase_filter_fft(Frame& F, int l) {
    const float* KT = (const float*)(wsq(F) + WS_KT); f32x2* KEO = (f32x2*)(wsq(F) + WS_KEO); const float* hb = inp(F, I_HBIAS) + (size_t)l * 2 * HYW;
    LAS f32x2* buf = (LAS f32x2*)(F.lds + RING_OFF); const int t = F.tid;
    for (int item = F.vcu; item < 2 * HYW; item += F.G) {
        const int o = item >> 9, c = item & 511;
        const float* fw = KT + (size_t)((o * 2 + 0) * HYW + c) * L; const float* bw = KT + (size_t)((o * 2 + 1) * HYW + c) * L;
        const float bias = hb[o * HYW + c]; const float sc = 1.0f / (2.0f * L);
        f32x2* ke = KEO + (size_t)item * KEO_BLK; f32x2* ko = ke + KEO_KO;
        float ar[32], ai[32];
        { const int tq = hfft::opaque(t); (void)tq;
#pragma unroll
        for (int m = 0; m < 32; ++m) { const int n = tq + 512 * m; const float f = fw[n]; float b = bw[n >= 1 ? L - n : 0]; b = n >= 1 ? b : 0.f; ar[m] = f + b; ai[m] = 0.f; if ((m & 15) == 15) { asm volatile("" ::: "memory"); __builtin_amdgcn_sched_barrier(0); } }
        }
        hfft::fft16k<false>(ar, ai, buf, t);
        { const int tq = hfft::opaque(t); (void)tq;
#pragma unroll
        for (int m = 0; m <= 16; ++m) { const int k = tq + 512 * m; if (k <= 8192) ke[k] = (f32x2){(ar[m] + bias) * sc, ai[m] * sc}; }
        }
        { const int tq = hfft::opaque(t); (void)tq;
#pragma unroll
        for (int m = 0; m < 32; ++m) { const int n = tq + 512 * m; const float f = fw[n]; float b = bw[n >= 1 ? L - n : 0]; b = n >= 1 ? b : 0.f; const float d = f - b; const float fr = (float)n * (1.0f / 32768.0f);
            ar[m] = d * __builtin_amdgcn_cosf(fr); ai[m] = -d * __builtin_amdgcn_sinf(fr); if ((m & 15) == 15) { asm volatile("" ::: "memory"); __builtin_amdgcn_sched_barrier(0); } }
        }
        hfft::fft16k<false>(ar, ai, buf, t);
        { const int tq = hfft::opaque(t); (void)tq;
#pragma unroll
        for (int m = 0; m < 16; ++m) { const int k = tq + 512 * m; ko[k] = (f32x2){(ar[m] + bias) * sc, ai[m] * sc}; }
        }
    }
    __syncthreads();
}

__device__ __forceinline__ float u_conv3(const bf16* row, int n, float w0, float w1, float w2, float cb) {
    const int nm = n >= 1 ? n - 1 : 0, np = n + 1 < L ? n + 1 : L - 1;
    float um = bf2f(row[nm]), up = bf2f(row[np]); const float u0 = bf2f(row[n]);
    um = n >= 1 ? um : 0.f; up = n + 1 < L ? up : 0.f;
    return um * w0 + u0 * w1 + up * w2 + cb;
}
__device__ __forceinline__ void cmul_spec(float (&xr)[32], float (&xi)[32], const f32x2* ke, int t, bool odd) {
    { const int tq = hfft::opaque(t); (void)tq;
#pragma unroll
    for (int m = 0; m < 32; ++m) { const int k = tq + 512 * m; int idx; bool cj;
        if (!odd) { cj = k > 8192; idx = cj ? 16384 - k : k; } else { cj = k >= 8192; idx = cj ? 16383 - k : k; }
        const f32x2 kv = ke[idx]; const float kr = kv.x, ki = cj ? -kv.y : kv.y;
        const float a = xr[m], b = xi[m]; xr[m] = a * kr - b * ki; xi[m] = a * ki + b * kr; if ((m & 15) == 15) { asm volatile("" ::: "memory"); __builtin_amdgcn_sched_barrier(0); } }
    }
}
__device__ __forceinline__ void phase_hyena(Frame& F, int l) {
    const bf16* UT = (const bf16*)(wsq(F) + WS_UT); bf16* YT = (bf16*)(wsq(F) + WS_YT); const f32x2* KEO = (const f32x2*)(wsq(F) + WS_KEO);
    const float* cw = inp(F, I_CONVW) + (size_t)l * 3 * HYP; const float* cbv = inp(F, I_CONVB) + (size_t)l * HYP;
    LAS f32x2* buf = (LAS f32x2*)(F.lds + RING_OFF); const int t = F.tid;
    f32x2* G0 = (f32x2*)(wsq(F) + WS_G0) + (size_t)F.vcu * 16384 + t;
    f32x2* G1 = (f32x2*)(wsq(F) + (F.vcu < 200 ? WS_G1A + (size_t)F.vcu * 131072 : WS_G1B + (size_t)(F.vcu - 200) * 131072)) + t;
    for (int item = F.vcu; item < 2 * HYW; item += F.G) {
        const int c = item >> 1, pair = item & 1; const int b0 = pair ? 2 : 0;
        float ar[32], ai[32];
#pragma unroll 1
        for (int o = 0; o < 2; ++o) {
            const f32x2* ke = KEO + (size_t)(o * HYW + c) * KEO_BLK; const f32x2* ko = ke + KEO_KO;
#pragma unroll 1
            for (int half = 0; half < 2; ++half) {
                if (o == 0) { const int ch = c; const float w0 = cw[ch], w1 = cw[HYP + ch], w2 = cw[2 * HYP + ch], cb = cbv[ch];
                    const bf16* r0 = UT + (size_t)ch * M + (size_t)b0 * L; const bf16* r1 = pair ? r0 : r0 + L;
                    { const int tq = hfft::opaque(t); (void)tq;
#pragma unroll
                    for (int m = 0; m < 32; ++m) { const int n = tq + 512 * m; ar[m] = u_conv3(r0, n, w0, w1, w2, cb); { const float q1 = u_conv3(r1, n, w0, w1, w2, cb); ai[m] = pair ? 0.f : q1; } if ((m & 15) == 15) { asm volatile("" ::: "memory"); __builtin_amdgcn_sched_barrier(0); } } }
                    }
                else {
                    { const int tq = hfft::opaque(t); (void)tq; f32x2* G0q = G0 + (tq - t);
#pragma unroll
                    for (int m = 0; m < 32; ++m) { const f32x2 v = G0q[m * 512]; ar[m] = v.x; ai[m] = v.y; if ((m & 15) == 15) { asm volatile("" ::: "memory"); __builtin_amdgcn_sched_barrier(0); } } }
                    }
                if (half == 0) {
                    hfft::fft16k<false>(ar, ai, buf, t);
                    cmul_spec(ar, ai, ke, t, false);
                    hfft::fft16k<true>(ar, ai, buf, t);
                    { const int tq = hfft::opaque(t); (void)tq; f32x2* G1q = G1 + (tq - t);
#pragma unroll
                    for (int m = 0; m < 32; ++m) G1q[m * 512] = (f32x2){ar[m], ai[m]};
                    }
                } else {
                    { const int tq = hfft::opaque(t); (void)tq;
#pragma unroll
                    for (int m = 0; m < 32; ++m) { const float fr = (float)(tq + 512 * m) * (1.0f / 32768.0f); const float cs = __builtin_amdgcn_cosf(fr), sn = -__builtin_amdgcn_sinf(fr);
                        const float a = ar[m], b = ai[m]; ar[m] = a * cs - b * sn; ai[m] = a * sn + b * cs; }
                    }
                    hfft::fft16k<false>(ar, ai, buf, t);
                    cmul_spec(ar, ai, ko, t, true);
                    hfft::fft16k<true>(ar, ai, buf, t);
                    const int ch = (o + 1) * HYW + c; const float w0 = cw[ch], w1 = cw[HYP + ch], w2 = cw[2 * HYP + ch], cb = cbv[ch];
                    const bf16* r0 = UT + (size_t)ch * M + (size_t)b0 * L; const bf16* r1 = pair ? r0 : r0 + L;
                    { const int tq = hfft::opaque(t); (void)tq; f32x2* G1q = G1 + (tq - t);
#pragma unroll
                    for (int m = 0; m < 32; ++m) { const int n = tq + 512 * m; const float fr = (float)n * (1.0f / 32768.0f); const float cs = __builtin_amdgcn_cosf(fr), sn = __builtin_amdgcn_sinf(fr);
                        const float a = ar[m], b = ai[m]; const f32x2 e = G1q[m * 512]; const float yr = e.x + (a * cs - b * sn), yi = e.y + (a * sn + b * cs);
                        ar[m] = yr * u_conv3(r0, n, w0, w1, w2, cb); { const float q1 = yi * u_conv3(r1, n, w0, w1, w2, cb); ai[m] = pair ? 0.f : q1; } if ((m & 15) == 15) { asm volatile("" ::: "memory"); __builtin_amdgcn_sched_barrier(0); } }
                    }
                    if (o == 0) {
                        { const int tq = hfft::opaque(t); (void)tq; f32x2* G0q = G0 + (tq - t);
#pragma unroll
                        for (int m = 0; m < 32; ++m) G0q[m * 512] = (f32x2){ar[m], ai[m]};
                        }
                    } else { bf16* y0 = YT + (size_t)c * M + (size_t)b0 * L; bf16* y1 = y0 + L;
                        { const int tq = hfft::opaque(t); (void)tq;
#pragma unroll
                        for (int m = 0; m < 32; ++m) { const int n = tq + 512 * m; y0[n] = f2bf(ar[m]); if (!pair) y1[n] = f2bf(ai[m]); } }
                        }
                }
            }
        }
    }
    __syncthreads();
}

__device__ __forceinline__ void phase_mla_prep(Frame& F, int l) {
    const bf16* CQKV = (const bf16*)(wsq(F) + WS_CQKV); bf16* CQN = (bf16*)(wsq(F) + WS_CQN); bf16* CKVN = (bf16*)(wsq(F) + WS_CKVN); bf16* KPE = (bf16*)(wsq(F) + WS_KPE);
    const float* gq = inp(F, I_QNORM) + l * QR; const float* gkv = inp(F, I_KVNORM) + l * KVR; const float* ct = (const float*)(wsq(F) + WS_COS); const float* st = (const float*)(wsq(F) + WS_SIN);
    const int gw = F.vcu * NWAVES + F.wave, NGW = F.G * NWAVES, lane = F.lane;
    for (int m = gw; m < M; m += NGW) {
        const bf16* row = CQKV + (size_t)m * 512;
        const v2u q = *(const GAS v2u*)(row + 4 * lane); const unsigned kv = *(const GAS unsigned*)(row + 256 + 2 * lane);
        const float q0 = bf2f(q.x & 0xffffu), q1 = bf2f(q.x >> 16), q2 = bf2f(q.y & 0xffffu), q3 = bf2f(q.y >> 16), k0 = bf2f(kv & 0xffffu), k1 = bf2f(kv >> 16);
        const float rq = 1.0f / sqrtf(wave_sum((q0 * q0 + q1 * q1) + (q2 * q2 + q3 * q3)) * (1.0f / QR) + EPS);
        const float rk = 1.0f / sqrtf(wave_sum(k0 * k0 + k1 * k1) * (1.0f / KVR) + EPS);
        const f32x4 g4 = *(const GAS f32x4*)(gq + 4 * lane); const f32x2 g2 = *(const GAS f32x2*)(gkv + 2 * lane);
        v2u oq; oq.x = pk2(q0 * rq * g4.x, q1 * rq * g4.y); oq.y = pk2(q2 * rq * g4.z, q3 * rq * g4.w);
        *(GAS v2u*)(CQN + (size_t)m * QR + 4 * lane) = oq;
        *(GAS unsigned*)(CKVN + (size_t)m * KVR + 2 * lane) = pk2(k0 * rk * g2.x, k1 * rk * g2.y);
        if (lane < 16) { const int j = lane, tpos = m & (L - 1); const float x1 = bf2f(row[384 + j]), x2 = bf2f(row[384 + 16 + j]); const float cs = ct[tpos * 16 + j], sn = st[tpos * 16 + j];
            const int p1 = 8 * (j >> 2) + (j & 3); KPE[(size_t)m * ROPE + p1] = f2bf(x1 * cs - x2 * sn); KPE[(size_t)m * ROPE + p1 + 4] = f2bf(x2 * cs + x1 * sn); }
    }
}

__device__ __forceinline__ void phase_hy_out(Frame& F, int l) {
    const bf16* YT = (const bf16*)(wsq(F) + WS_YT); bf16* MIX = (bf16*)(wsq(F) + WS_MIX); const float* gn = inp(F, I_GNHY) + l * HYW;
    LAS bf16* tl = (LAS bf16*)(F.lds + RING_OFF + F.wave * 16384);
    const int gw = F.vcu * NWAVES + F.wave, NGW = F.G * NWAVES, lane = F.lane;
    for (int task = gw; task < 8 * (M / 64); task += NGW) {
        const int g = task & 7, tb = task >> 3, tok0 = tb * 64; const int cl = lane >> 3, t8 = (lane & 7) * 8;
        float v[8][8]; float ss[8];
#pragma unroll
        for (int j = 0; j < 8; ++j) ss[j] = 0.f;
#pragma unroll
        for (int i = 0; i < 8; ++i) { const int ch = g * 64 + 8 * i + cl; const v4u w = *(const GAS v4u*)(YT + (size_t)ch * M + tok0 + t8);
            v[i][0] = bf2f(w.x & 0xffffu); v[i][1] = bf2f(w.x >> 16); v[i][2] = bf2f(w.y & 0xffffu); v[i][3] = bf2f(w.y >> 16);
            v[i][4] = bf2f(w.z & 0xffffu); v[i][5] = bf2f(w.z >> 16); v[i][6] = bf2f(w.w & 0xffffu); v[i][7] = bf2f(w.w >> 16);
#pragma unroll
            for (int j = 0; j < 8; ++j) ss[j] += v[i][j] * v[i][j]; }
#pragma unroll
        for (int j = 0; j < 8; ++j) { float s = ss[j]; s += __shfl_xor(s, 8); s += __shfl_xor(s, 16); s += __shfl_xor(s, 32); ss[j] = 1.0f / sqrtf(s * (1.0f / 64.0f) + EPS); }
#pragma unroll
        for (int i = 0; i < 8; ++i) { const int cc = 8 * i + cl; const float gg = gn[g * 64 + cc];
#pragma unroll
            for (int j = 0; j < 8; ++j) tl[(t8 + j) * 72 + cc] = f2bf(v[i][j] * ss[j] * gg); }
        LDS_WAIT(); asm volatile("" ::: "memory");
#pragma unroll
        for (int i = 0; i < 8; ++i) { const int tok = 8 * i + (lane >> 3), c8 = (lane & 7) * 8; const v4u w = *(const LAS v4u*)(tl + tok * 72 + c8);
            *(GAS v4u*)(MIX + (size_t)(tok0 + tok) * D + g * 64 + c8) = w; }
        LDS_WAIT(); asm volatile("" ::: "memory");
    }
}

namespace att {
using s16x4 = __attribute__((ext_vector_type(4))) short;
using f32x16 = __attribute__((ext_vector_type(16))) float;
using u32x4 = __attribute__((ext_vector_type(4))) unsigned;
constexpr int QBLK = 32, KVBLK = 64, NW = 8;
constexpr float SCALE = 0.10206207261596575f;
constexpr float THR = 8.f;
constexpr int SHM_K = KVBLK * 256, SHM_V = KVBLK * DV * 2;
constexpr int OFF_V = 0, OFF_K = 2 * SHM_V, OFF_WS = OFF_K + 2 * SHM_K, SHM_ATTN = OFF_WS + NW * 64 * 4;
#define KSWZ(row, colB) ((row) * 256 + ((colB) ^ (((row) & 7) << 4)))
#define SBAR() __builtin_amdgcn_sched_barrier(0)
__device__ __forceinline__ int crow(int r, int hi) { return (r & 3) + 8 * (r >> 2) + 4 * hi; }
__device__ __forceinline__ unsigned cvtpk(float lo, float hi) { unsigned r; asm volatile("v_cvt_pk_bf16_f32 %0, %1, %2" : "=v"(r) : "v"(lo), "v"(hi)); return r; }
__device__ __forceinline__ void partialSM(f32x16& p0, f32x16& p1, float& m_reg, float& mn, float& alpha) {
  constexpr float C = SCALE * 1.4426950408889634f;
  float pmax = p0[0];
#pragma unroll
  for (int r = 1; r < 16; ++r) pmax = fmaxf(pmax, p0[r]);
#pragma unroll
  for (int r = 0; r < 16; ++r) pmax = fmaxf(pmax, p1[r]);
  { auto rr = __builtin_amdgcn_permlane32_swap(__float_as_uint(pmax), __float_as_uint(pmax), false, false);
    pmax = fmaxf(__uint_as_float(rr[0]), __uint_as_float(rr[1])); }
  if (__builtin_expect(__all(pmax - m_reg <= THR / SCALE), 1)) { mn = m_reg; alpha = 1.f; }
  else { mn = fmaxf(m_reg, pmax); alpha = __builtin_amdgcn_exp2f((m_reg - mn) * C); m_reg = mn; }
  const float mnC = -mn * C;
#pragma unroll
  for (int r = 0; r < 16; ++r) p0[r] = fmaf(p0[r], C, mnC);
#pragma unroll
  for (int r = 0; r < 16; ++r) p1[r] = fmaf(p1[r], C, mnC);
#pragma unroll
  for (int r = 0; r < 16; ++r) p0[r] = __builtin_amdgcn_exp2f(p0[r]);
}
__device__ __forceinline__ void finishSM(f32x16& p0, f32x16& p1, float alpha, float& l_reg, bf16x8& pa0, bf16x8& pa1, bf16x8& pa2, bf16x8& pa3) {
#pragma unroll
  for (int r = 0; r < 16; ++r) p1[r] = __builtin_amdgcn_exp2f(p1[r]);
  float ps = 0;
#pragma unroll
  for (int r = 0; r < 16; ++r) ps += p0[r];
#pragma unroll
  for (int r = 0; r < 16; ++r) ps += p1[r];
  { auto rr = __builtin_amdgcn_permlane32_swap(__float_as_uint(ps), __float_as_uint(ps), false, false);
    ps = __uint_as_float(rr[0]) + __uint_as_float(rr[1]); }
  l_reg = l_reg * alpha + ps;
#define PK4(P, BASE, OUT) do { unsigned a0 = cvtpk(P[BASE + 0], P[BASE + 1]), a1 = cvtpk(P[BASE + 2], P[BASE + 3]);   \
    unsigned b0 = cvtpk(P[BASE + 4], P[BASE + 5]), b1 = cvtpk(P[BASE + 6], P[BASE + 7]);                              \
    auto r0 = __builtin_amdgcn_permlane32_swap(a0, b0, false, false); auto r1 = __builtin_amdgcn_permlane32_swap(a1, b1, false, false); \
    u32x4 w = {r0[0], r1[0], r0[1], r1[1]}; OUT = __builtin_bit_cast(bf16x8, w); } while (0)
  PK4(p0, 0, pa0); PK4(p0, 8, pa1); PK4(p1, 0, pa2); PK4(p1, 8, pa3);
#undef PK4
}
__device__ __forceinline__ void qkt(f32x16& p0, f32x16& p1, const LAS char* Ks, const bf16x8* qr, int r32, int hi) {
  p0 = f32x16{}; p1 = f32x16{};
#pragma unroll
  for (int d0 = 0; d0 < 6; ++d0) { const int cb = (d0 * 16 + hi * 8) * 2;
    const bf16x8 b0 = *reinterpret_cast<const LAS bf16x8*>(Ks + KSWZ(r32, cb));
    const bf16x8 b1 = *reinterpret_cast<const LAS bf16x8*>(Ks + KSWZ(32 + r32, cb));
    p0 = __builtin_amdgcn_mfma_f32_32x32x16_bf16(b0, qr[d0], p0, 0, 0, 0);
    p1 = __builtin_amdgcn_mfma_f32_32x32x16_bf16(b1, qr[d0], p1, 0, 0, 0); }
}
__device__ __forceinline__ int v_st(int k, int c) { const int kk = (k & ~0xC) | ((k & 4) << 1) | ((k & 8) >> 1); return ((kk >> 3) * 2 + (c >> 5)) * 512 + ((kk & 7) * 32 + (c & 31)) * 2; }
__device__ __forceinline__ int v_rd_base(int lane) { return ((lane & 3) << 3) | (((lane >> 2) & 3) << 6) | (((lane >> 4) & 1) << 5) | (((lane >> 5) & 1) << 8); }
constexpr int v_rd_off(int d0, int ks, int half) { return d0 * 512 + ks * 2048 + half * 1024; }
template <int OFF> __device__ __forceinline__ s16x4 tr_read(int vb) { s16x4 r; asm volatile("ds_read_b64_tr_b16 %0, %1 offset:%2" : "=&v"(r) : "v"(vb), "i"(OFF) : "memory"); return r; }
template <int D0> __device__ __forceinline__ void pv_one(f32x16& od, int vb, bf16x8 pa0, bf16x8 pa1, bf16x8 pa2, bf16x8 pa3) {
  const s16x4 l0 = tr_read<v_rd_off(D0, 0, 0)>(vb), h0 = tr_read<v_rd_off(D0, 0, 1)>(vb), l1 = tr_read<v_rd_off(D0, 1, 0)>(vb), h1 = tr_read<v_rd_off(D0, 1, 1)>(vb);
  const s16x4 l2 = tr_read<v_rd_off(D0, 2, 0)>(vb), h2 = tr_read<v_rd_off(D0, 2, 1)>(vb), l3 = tr_read<v_rd_off(D0, 3, 0)>(vb), h3 = tr_read<v_rd_off(D0, 3, 1)>(vb);
  asm volatile("s_waitcnt lgkmcnt(0)" ::: "memory"); SBAR();
#define PK(Lo, Hi) (bf16x8){Lo[0], Lo[1], Lo[2], Lo[3], Hi[0], Hi[1], Hi[2], Hi[3]}
  od = __builtin_amdgcn_mfma_f32_32x32x16_bf16(pa0, PK(l0, h0), od, 0, 0, 0);
  od = __builtin_amdgcn_mfma_f32_32x32x16_bf16(pa1, PK(l1, h1), od, 0, 0, 0);
  od = __builtin_amdgcn_mfma_f32_32x32x16_bf16(pa2, PK(l2, h2), od, 0, 0, 0);
  od = __builtin_amdgcn_mfma_f32_32x32x16_bf16(pa3, PK(l3, h3), od, 0, 0, 0);
#undef PK
}
__device__ __forceinline__ void pv_d0(f32x16* o, int vb, bf16x8 pa0, bf16x8 pa1, bf16x8 pa2, bf16x8 pa3) {
  pv_one<0>(o[0], vb, pa0, pa1, pa2, pa3); pv_one<1>(o[1], vb, pa0, pa1, pa2, pa3);
}
__device__ __forceinline__ void attn_unit(const bf16* __restrict__ Qb, const bf16* __restrict__ KNh, const bf16* __restrict__ KPEb, const bf16* __restrict__ Vh, bf16* __restrict__ Mo,
                                          const float* __restrict__ gain, const float* __restrict__ ct, const float* __restrict__ st, int tpos0, LAS char* lds, const int wave0) {
  int tid_ = tid_from_wave(wave0);
  const int tid = tid_, wid = tid >> 6, lane = tid & 63, r32 = lane & 31, hi = lane >> 5;
  LAS char* V_lds = lds + OFF_V; LAS char* K_lds = lds + OFF_K;
  LAS float* ws = (LAS float*)(lds + OFF_WS) + wid * 64; LAS float* li_l = ws; LAS float* al_l = ws + 32;
  float m_reg = -1e30f, l_reg = 0; f32x16 o[2] = {}; bf16x8 qr[6];
  const bf16* Qw = Qb + (long)(wid * QBLK + r32) * NQ + hi * 8;
#pragma unroll
  for (int d0 = 0; d0 < 6; ++d0) qr[d0] = *reinterpret_cast<const bf16x8*>(Qw + d0 * 16);
  { const int tq = tpos0 + wid * QBLK + r32;
#pragma unroll
    for (int d0 = 4; d0 < 6; ++d0) { const int fq = 2 * (d0 - 4) + hi; const f32x4 cs = *reinterpret_cast<const f32x4*>(ct + tq * 16 + 4 * fq), sn = *reinterpret_cast<const f32x4*>(st + tq * 16 + 4 * fq);
      const u32x4 w = __builtin_bit_cast(u32x4, qr[d0]);
      const f32x4 x1 = {bf2f(w[0] & 0xffffu), bf2f(w[0] >> 16), bf2f(w[1] & 0xffffu), bf2f(w[1] >> 16)}, x2 = {bf2f(w[2] & 0xffffu), bf2f(w[2] >> 16), bf2f(w[3] & 0xffffu), bf2f(w[3] >> 16)};
      const f32x4 a = x1 * cs - x2 * sn, b = x2 * cs + x1 * sn;
      const u32x4 o4 = {cvtpk(a[0], a[1]), cvtpk(a[2], a[3]), cvtpk(b[0], b[1]), cvtpk(b[2], b[3])}; qr[d0] = __builtin_bit_cast(bf16x8, o4); } }
  const int sr = tid >> 3, sc = (tid & 7) * 8;
  const int rr_ = (tid & 255) >> 2, rc = (tid & 3) * 8;
  const int vst0 = v_st(sr, sc), kst0 = KSWZ(sr, sc * 2), kst1 = KSWZ(rr_, 128 + rc * 2);
  const int vb0 = (int)(unsigned)(uintptr_t)V_lds + v_rd_base(lane);
  struct { bf16x8 vs, kn, kr; } sr_[2];
#define SLOAD(i, k0) do { sr_[i].vs = *reinterpret_cast<const bf16x8*>(&Vh[(long)((k0) + sr) * NKV + sc]); sr_[i].kn = *reinterpret_cast<const bf16x8*>(&KNh[(long)((k0) + sr) * NKV + sc]); \
    sr_[i].kr = *reinterpret_cast<const bf16x8*>(&KPEb[(long)((k0) + rr_) * ROPE + rc]); } while (0)
#define SWRITE(b, i) do { *(LAS bf16x8*)(V_lds + (b) * SHM_V + vst0) = sr_[i].vs; *(LAS bf16x8*)(K_lds + (b) * SHM_K + kst0) = sr_[i].kn; *(LAS bf16x8*)(K_lds + (b) * SHM_K + kst1) = sr_[i].kr; } while (0)
#define SWAIT() asm volatile("s_waitcnt vmcnt(3)" ::: "memory")
#define RESC(a) do { if (__any((a) < 1.f)) { if (hi == 0) al_l[r32] = (a); asm volatile("s_waitcnt lgkmcnt(0)" ::: "memory"); \
    _Pragma("unroll") for (int d = 0; d < 2; ++d) _Pragma("unroll") for (int r = 0; r < 16; ++r) o[d][r] *= al_l[crow(r, hi)]; } } while (0)
  f32x16 pA0, pA1, pB0, pB1; float mnA, mnB, alA, alB; bf16x8 pa0, pa1, pa2, pa3; constexpr int NTL = L / KVBLK;
  constexpr int SE = 0, SO = 1;
  SLOAD(SE, 0); asm volatile("s_waitcnt vmcnt(0)" ::: "memory"); SWRITE(0, SE); __syncthreads();
  qkt(pA0, pA1, K_lds, qr, r32, hi); partialSM(pA0, pA1, m_reg, mnA, alA);
  SLOAD(SO, KVBLK); SLOAD(SE, 2 * KVBLK);
  SWAIT(); SWRITE(1, SO); __syncthreads();
  for (int j = 1; j + 1 < NTL; j += 2) {
    SBAR(); qkt(pB0, pB1, K_lds + SHM_K, qr, r32, hi);
    finishSM(pA0, pA1, alA, l_reg, pa0, pa1, pa2, pa3); SBAR();
    SLOAD(SO, (j + 2) * KVBLK); SBAR();
    pv_d0(o, vb0, pa0, pa1, pa2, pa3); partialSM(pB0, pB1, m_reg, mnB, alB);
    __syncthreads(); SWAIT(); SWRITE(0, SE);
    RESC(alB); __syncthreads();
    SBAR(); qkt(pA0, pA1, K_lds, qr, r32, hi);
    finishSM(pB0, pB1, alB, l_reg, pa0, pa1, pa2, pa3); SBAR();
    if (j + 3 < NTL) SLOAD(SE, (j + 3) * KVBLK); SBAR();
    pv_d0(o, vb0 + SHM_V, pa0, pa1, pa2, pa3); partialSM(pA0, pA1, m_reg, mnA, alA);
    __syncthreads(); SWAIT(); SWRITE(1, SO);
    RESC(alA); __syncthreads();
  }
  SBAR(); qkt(pB0, pB1, K_lds + SHM_K, qr, r32, hi);
  finishSM(pA0, pA1, alA, l_reg, pa0, pa1, pa2, pa3); SBAR();
  pv_d0(o, vb0, pa0, pa1, pa2, pa3); partialSM(pB0, pB1, m_reg, mnB, alB);
  __syncthreads(); RESC(alB);
  finishSM(pB0, pB1, alB, l_reg, pa0, pa1, pa2, pa3); SBAR();
  pv_d0(o, vb0 + SHM_V, pa0, pa1, pa2, pa3);
  if (hi == 0) li_l[r32] = l_reg; asm volatile("s_waitcnt lgkmcnt(0)" ::: "memory");
  const float g0 = gain[r32], g1 = gain[32 + r32];
  bf16* Ow = Mo + (long)(wid * QBLK) * D;
#pragma unroll
  for (int r = 0; r < 16; ++r) { const int orow = crow(r, hi); const float rl = __builtin_amdgcn_rcpf(li_l[orow]);
    const float y0 = o[0][r] * rl, y1 = o[1][r] * rl; float s = y0 * y0 + y1 * y1;
    s += __shfl_xor(s, 1); s += __shfl_xor(s, 2); s += __shfl_xor(s, 4); s += __shfl_xor(s, 8); s += __shfl_xor(s, 16);
    const float rs = 1.0f / sqrtf(s * (1.0f / 64.0f) + EPS);
    Ow[(long)orow * D + r32] = f2bf(y0 * rs * g0); Ow[(long)orow * D + 32 + r32] = f2bf(y1 * rs * g1); }
  __syncthreads();
#undef SLOAD
#undef SWRITE
#undef SWAIT
#undef RESC
}
#undef KSWZ
#undef SBAR
}
#define XB_TMO      128
#define XB_XCNT(j)  (256  + 64 * (j))
#define XB_XSUB(j)  (1280 + 64 * (j))
#define XB_XGEN(j)  (2304 + 64 * (j))
#define XB_TOP      3328
#define XB_TOPGEN   3392
#define XCD_BAR_WORDS 3456
#define XB_SPIN_CAP (1u << 18)

__device__ __forceinline__ unsigned xb_ld(unsigned* p)              { return __hip_atomic_load(p, __ATOMIC_RELAXED, __HIP_MEMORY_SCOPE_AGENT); }
__device__ __forceinline__ unsigned xb_add(unsigned* p, unsigned v) { return __hip_atomic_fetch_add(p, v, __ATOMIC_RELAXED, __HIP_MEMORY_SCOPE_AGENT); }
__device__ __forceinline__ unsigned xb_xcc_id() { return (unsigned)__builtin_amdgcn_s_getreg((3 << 11) | 20) & 0xFu; }
#define XB_SPIN(cond, bar) do { unsigned _sp = 0; while (cond) { __builtin_amdgcn_s_sleep(1); \
    if ((++_sp & 255u) == 0u) { if (xb_ld(&(bar)[XB_TMO])) break; if (_sp > XB_SPIN_CAP) { atomicAdd(&(bar)[XB_TMO], 1u); break; } } } } while (0)

struct XcdBarrier {
    unsigned* bar; unsigned x;
    volatile LAS unsigned* st;
};

__device__ __forceinline__ XcdBarrier xcd_barrier_post(unsigned* bar, volatile LAS unsigned* st, const bool t0) {
    XcdBarrier b; b.bar = bar; b.x = xb_xcc_id(); b.st = st;
    if (t0) (void)xb_add(&bar[XB_XCNT(b.x)], 1u);
    return b;
}
__device__ __forceinline__ void xcd_barrier_complete(unsigned* bar, unsigned x, unsigned& nloc, unsigned& nx) {
    const unsigned G = gridDim.x * gridDim.y * gridDim.z;
    unsigned sum, cnt, mine, sp = 0u;
    for (;;) {
        sum = 0u; cnt = 0u; mine = 0u;
#pragma unroll
        for (unsigned j = 0; j < 16; ++j) { const unsigned c = xb_ld(&bar[XB_XCNT(j)]); sum += c; cnt += (c > 0u) ? 1u : 0u; mine = (j == x) ? c : mine; }
        if (sum == G) break;
        __builtin_amdgcn_s_sleep(1);
        if ((++sp & 255u) == 0u) { if (xb_ld(&bar[XB_TMO])) break; if (sp > XB_SPIN_CAP) { atomicAdd(&bar[XB_TMO], 1u); break; } }
    }
    nloc = mine > 0u ? mine : 1u; nx = cnt > 0u ? cnt : 1u;
}

__device__ __forceinline__ void xcd_barrier(const XcdBarrier& b, const bool t0) {
    asm volatile("s_waitcnt vmcnt(0)" ::: "memory");
    __syncthreads();
    if (t0) {
        unsigned* bar = b.bar;
        __builtin_amdgcn_s_waitcnt(0);
        unsigned nloc = b.st[0], nx = b.st[1];
        if (nloc == 0u) { xcd_barrier_complete(bar, b.x, nloc, nx); b.st[0] = nloc; b.st[1] = nx; }
        const unsigned old = xb_add(&bar[XB_XSUB(b.x)], 1u);
        const unsigned gen = old / nloc;
        if (old + 1u == (gen + 1u) * nloc) {
            __builtin_amdgcn_fence(__ATOMIC_RELEASE, "agent");
            asm volatile("s_waitcnt vmcnt(0)" ::: "memory");
            const unsigned og = xb_add(&bar[XB_TOP], 1u);
            const unsigned tg = og / nx;
            if (og + 1u == (tg + 1u) * nx) xb_add(&bar[XB_TOPGEN], 1u);
            else XB_SPIN(xb_ld(&bar[XB_TOPGEN]) == tg, bar);
            __builtin_amdgcn_fence(__ATOMIC_ACQUIRE, "agent");
            xb_add(&bar[XB_XGEN(b.x)], 1u);
            asm volatile("s_waitcnt vmcnt(0)" ::: "memory");
        } else {
            XB_SPIN(xb_ld(&bar[XB_XGEN(b.x)]) == gen, bar);
            __builtin_amdgcn_fence(__ATOMIC_ACQUIRE, "agent");
            asm volatile("s_waitcnt vmcnt(0)" ::: "memory");
        }
    }
    __syncthreads();
}

__device__ __forceinline__ void xcd_barrier_fast(const XcdBarrier& b, const bool t0) {
    asm volatile("s_waitcnt vmcnt(0)" ::: "memory");
    __syncthreads();
    if (t0) {
        unsigned* bar = b.bar; asm volatile("" : "+s"(bar));
        __builtin_amdgcn_s_waitcnt(0);
        unsigned nloc = b.st[0], nx = b.st[1];
        unsigned bx_ = b.x; asm volatile("" : "+s"(bx_));
        const unsigned old = xb_add(&bar[XB_XSUB(bx_)], 1u);
        const unsigned gen = old / nloc;
        if (old + 1u == (gen + 1u) * nloc) {
            __builtin_amdgcn_fence(__ATOMIC_RELEASE, "agent");
            asm volatile("s_waitcnt vmcnt(0)" ::: "memory");
            const unsigned og = xb_add(&bar[XB_TOP], 1u);
            const unsigned tg = og / nx;
            if (og + 1u == (tg + 1u) * nx) xb_add(&bar[XB_TOPGEN], 1u);
            else XB_SPIN(xb_ld(&bar[XB_TOPGEN]) == tg, bar);
            __builtin_amdgcn_fence(__ATOMIC_ACQUIRE, "agent");
            xb_add(&bar[XB_XGEN(bx_)], 1u);
            asm volatile("s_waitcnt vmcnt(0)" ::: "memory");
        } else {
            XB_SPIN(xb_ld(&bar[XB_XGEN(bx_)]) == gen, bar);
            __builtin_amdgcn_fence(__ATOMIC_ACQUIRE, "agent");
            asm volatile("s_waitcnt vmcnt(0)" ::: "memory");
        }
    }
    __syncthreads();
}

constexpr int CW_BAR = 4096;
struct Args { const float* in[26]; float* out; unsigned char* ws; };
#ifndef REP_ATT
#define REP_ATT 1
#endif
#ifndef REP_GEMM
#define REP_GEMM 1
#endif
#ifndef REP_HY
#define REP_HY 1
#endif
#ifndef REP_FILT
#define REP_FILT 1
#endif
#ifndef REP_MISC
#define REP_MISC 1
#endif
#ifndef PROBE_MASK
#define PROBE_MASK 0
#endif
#define TIC() do { if (PROBE_MASK) pr_t0 = __builtin_amdgcn_s_memrealtime(); } while (0)
#define TOC(ph) do { if (PROBE_MASK & (1u << (ph))) pr_acc += __builtin_amdgcn_s_memrealtime() - pr_t0; } while (0)
#define REPEAT(n) _Pragma("unroll 1") for (int rep_ = 0; rep_ < (n); ++rep_)
#define REFRESH() do { const int t_ = tid_from_wave(F.wave0); F.tid = t_; F.lane = t_ & 63; F.wave = __builtin_amdgcn_readfirstlane(t_ >> 6); int v_ = F.vcu; asm volatile("" : "+s"(v_)); F.vcu = v_; } while (0)
#define BXQ() ({ int b_ = (int)blockIdx.x; asm volatile("" : "+s"(b_)); b_; })
#define GEMM_PHASE(EPI, g, S, E) REPEAT(REP_GEMM) pg8::gemm_phase<EPI, pg8::StaticOrder, true, true>(F.lds + RING_OFF, g, S, E, F.wave0)

__global__ void __launch_bounds__(NTHR, 2) hyena_mla_fwd(Args args) {
    extern __shared__ __attribute__((aligned(16))) unsigned char lds[];
    Frame F;
    F.lds = (LAS unsigned char*)lds;
    F.MISC = (volatile LAS unsigned*)(F.lds + MISC_OFF);
    F.tid = threadIdx.x; F.lane = F.tid & 63; F.wave = __builtin_amdgcn_readfirstlane(F.tid >> 6); F.wave0 = F.wave;
    F.G = gridDim.x; { const int bx = blockIdx.x; F.vcu = (F.G % 8 == 0) ? (bx % 8) * (F.G / 8) + bx / 8 : bx; }
    F.ws = args.ws; F.out = args.out; F.ctl = (gu32*)(args.ws + WS_CTL);
    if (F.tid == 0) {
#pragma unroll
        for (int i = 0; i < 26; ++i) *(LAS unsigned long long*)(F.lds + PTRTAB_OFF + 8 * i) = (unsigned long long)args.in[i];
    }
    for (int u = F.tid; u < 512 / 4; u += NTHR) ((LAS unsigned*)(F.lds + LDSCTL_OFF))[u] = 0u;
    __syncthreads();
    XcdBarrier bar = xcd_barrier_post((unsigned*)(F.ctl + CW_BAR), F.MISC + 8, F.tid == 0);
    xcd_barrier(bar, F.tid == 0);
    unsigned long long pr_t0 = 0, pr_acc = 0; (void)pr_t0;
#pragma unroll 1
    for (int l = 0; l < DEPTH; ++l) {
        TIC();
        REPEAT(REP_MISC) { REFRESH(); phase_weights(F, l); }
        __syncthreads();
        REFRESH(); phase_filter_mlp(F, l);
        if (l == 0) { REFRESH(); phase_rope_tab(F); REFRESH(); phase_norm_first(F, 0, inp(F, I_NMIXPRE)); }
        { REFRESH(); xcd_barrier_fast(bar, F.tid == 0); } TOC(0); TIC();
        { unsigned char* w = wsq(F); pg8::Gemm g{(bf16*)(w + WS_W3T), (bf16*)(w + WS_H2), 2048, L, 128}; pg8::StaticOrder S; S.init(2048, L, F.G, BXQ());
          pg8::EpiTaps E{(float*)(w + WS_KT), inp(F, I_DECAY) + (size_t)l * 2048}; GEMM_PHASE(pg8::EpiTaps, g, S, E); }
        { REFRESH(); xcd_barrier_fast(bar, F.tid == 0); } TOC(1); TIC();
        REPEAT(REP_FILT) { REFRESH(); phase_filter_fft(F, l); }
        { REFRESH(); xcd_barrier_fast(bar, F.tid == 0); } TOC(2); TIC();
        { unsigned char* w = wsq(F); bf16* WinT = (bf16*)(w + WS_WIN); bf16* XN = (bf16*)(w + WS_XN); bf16* UT = (bf16*)(w + WS_UT); bf16* CQKV = (bf16*)(w + WS_CQKV);
          { pg8::Gemm g{WinT, XN, HYP, M, D}; pg8::StaticOrder S; S.init(HYP, M, F.G, BXQ());
          pg8::EpiBf16<0> E{UT, M, nullptr, 0, 0, 1.f}; GEMM_PHASE(pg8::EpiBf16<0>, g, S, E); }
        { pg8::Gemm g{XN, WinT + (size_t)HYP * D, M, 512, D}; pg8::StaticOrder S; S.init(M, 512, F.G, (BXQ() + 128) % F.G);
          pg8::EpiBf16<0> E{CQKV, 512, nullptr, 0, 0, 1.f}; GEMM_PHASE(pg8::EpiBf16<0>, g, S, E); } }
        { REFRESH(); xcd_barrier_fast(bar, F.tid == 0); } TOC(3); TIC();
        REPEAT(REP_MISC) { REFRESH(); phase_mla_prep(F, l); }
        REPEAT(REP_HY) { REFRESH(); phase_hyena(F, l); }
        { REFRESH(); xcd_barrier_fast(bar, F.tid == 0); } TOC(4); TIC();
        { unsigned char* w = wsq(F); bf16* CQN = (bf16*)(w + WS_CQN); bf16* CKVN = (bf16*)(w + WS_CKVN); bf16* WuqT = (bf16*)(w + WS_WUQ); bf16* WukvT = (bf16*)(w + WS_WUKV);
          bf16* Qb = (bf16*)(w + WS_Q); bf16* KV = (bf16*)(w + WS_KN);
          { pg8::Gemm g{CQN, WuqT, M, NQ, QR}; pg8::StaticOrder S; S.init(M, NQ, F.G, BXQ());
          pg8::EpiBf16<0> E{Qb, NQ, nullptr, 0, 0, 1.f}; GEMM_PHASE(pg8::EpiBf16<0>, g, S, E); }
        { pg8::Gemm g{CKVN, WukvT, M, NKV, KVR}; pg8::StaticOrder S; S.init(M, NKV, F.G, BXQ());
          pg8::EpiBf16<0> E{KV, NKV, nullptr, 0, 0, 1.f}; GEMM_PHASE(pg8::EpiBf16<0>, g, S, E); } }
        { REFRESH(); xcd_barrier_fast(bar, F.tid == 0); } TOC(5); TIC();
        REFRESH();
        { unsigned char* w = wsq(F); bf16* Qb = (bf16*)(w + WS_Q); bf16* KV = (bf16*)(w + WS_KN); bf16* KPE = (bf16*)(w + WS_KPE); bf16* MIX = (bf16*)(w + WS_MIX);
          const float* ct = (const float*)(w + WS_COS); const float* st = (const float*)(w + WS_SIN); const float* gat = inp(F, I_GNAT) + l * 512;
        REPEAT(REP_ATT) for (int i = 0; i < 6; ++i) {
            const int bh = 3 * (F.vcu >> 5) + (i >> 1), qb = (i & 1) * 32 + (F.vcu & 31); const int b = bh >> 3, h = bh & 7;
            const size_t row0 = (size_t)b * L + (size_t)qb * 256;
            att::attn_unit(Qb + row0 * NQ + h * DQ, KV + (size_t)b * L * NKV + h * 128, KPE + (size_t)b * L * ROPE, KV + (size_t)b * L * NKV + h * 128 + 64,
                           MIX + row0 * D + 512 + h * 64, gat + h * 64, ct, st, qb * 256, (LAS char*)(F.lds + RING_OFF), F.wave0);
        } }
        REPEAT(REP_MISC) { REFRESH(); phase_hy_out(F, l); }
        { REFRESH(); xcd_barrier_fast(bar, F.tid == 0); } TOC(6); TIC();
        { unsigned char* w = wsq(F); bf16* MIX = (bf16*)(w + WS_MIX); bf16* WoutT = (bf16*)(w + WS_WOUT); float* T = (float*)(w + WS_T);
          pg8::Gemm g{MIX, WoutT, M, D, D}; pg8::StaticOrder S; S.init(M, D, F.G, BXQ());
          pg8::EpiF32 E{T, D}; GEMM_PHASE(pg8::EpiF32, g, S, E); }
        { REFRESH(); xcd_barrier_fast(bar, F.tid == 0); } TOC(7); TIC();
        REFRESH(); phase_norm_res(F, l, (const float*)(wsq(F) + WS_T), inp(F, I_NMIXPOST) + l * D, inp(F, I_NMLPPRE) + l * D);
        { REFRESH(); xcd_barrier_fast(bar, F.tid == 0); } TOC(8); TIC();
#pragma unroll 1
        for (int ch = 0; ch < N_MLP_CHUNKS; ++ch) {
            { unsigned char* w = wsq(F); bf16* XN = (bf16*)(w + WS_XN); bf16* WupT = (bf16*)(w + WS_WUP); bf16* Hb = (bf16*)(w + WS_H);
              pg8::Gemm g{XN + (size_t)ch * MLP_CHUNK * D, WupT, MLP_CHUNK, FF, D}; pg8::StaticOrder S; S.init(MLP_CHUNK, FF, F.G, BXQ());
              pg8::EpiRelu2 E{Hb, FF}; GEMM_PHASE(pg8::EpiRelu2, g, S, E); }
            { REFRESH(); xcd_barrier_fast(bar, F.tid == 0); } TOC(9); TIC();
            { unsigned char* w = wsq(F); bf16* Hb = (bf16*)(w + WS_H); bf16* WdownT = (bf16*)(w + WS_WDOWN); float* T = (float*)(w + WS_T);
              pg8::Gemm g{Hb, WdownT, MLP_CHUNK, D, FF}; pg8::StaticOrder S; S.init(MLP_CHUNK, D, F.G, BXQ());
              pg8::EpiF32 E{T + (size_t)ch * MLP_CHUNK * D, D}; GEMM_PHASE(pg8::EpiF32, g, S, E); }
            { REFRESH(); xcd_barrier_fast(bar, F.tid == 0); } TOC(10); TIC();
        }
        REFRESH(); phase_norm_res(F, 1, (const float*)(wsq(F) + WS_T), inp(F, I_NMLPPOST) + l * D, (l + 1 < DEPTH) ? inp(F, I_NMIXPRE) + (l + 1) * D : nullptr);
        { REFRESH(); xcd_barrier_fast(bar, F.tid == 0); } TOC(11); TIC();
    }
    if (PROBE_MASK) { const unsigned long long ts = __builtin_amdgcn_s_memrealtime(); while (__builtin_amdgcn_s_memrealtime() - ts < pr_acc) __builtin_amdgcn_s_sleep(8); }
}

extern "C" void kernel_launch(void* const* d_in, const int* in_sizes, int n_in, void* d_out, int out_size, void* d_ws, size_t ws_size, hipStream_t stream) {
    static int grid = 0;
    if (grid == 0) {
        if (n_in != 26 || out_size != M * D || ws_size < WS_END) { fprintf(stderr, "kernel_launch: shape mismatch n_in %d out %d ws %zu (need %zu)\n", n_in, out_size, ws_size, (size_t)WS_END); grid = -1; return; }
        int dev = 0, cus = 0, per_cu = 0;
        if (hipGetDevice(&dev) != hipSuccess || hipDeviceGetAttribute(&cus, hipDeviceAttributeMultiprocessorCount, dev) != hipSuccess) { grid = -1; return; }
        if (hipFuncSetAttribute((const void*)hyena_mla_fwd, hipFuncAttributeMaxDynamicSharedMemorySize, LDS_BYTES) != hipSuccess) { fprintf(stderr, "kernel_launch: hipFuncSetAttribute failed\n"); grid = -1; return; }
        if (hipOccupancyMaxActiveBlocksPerMultiprocessor(&per_cu, (const void*)hyena_mla_fwd, NTHR, LDS_BYTES) != hipSuccess || per_cu < 1) fprintf(stderr, "kernel_launch: occupancy query says %d\n", per_cu);
        (void)hipGetLastError();
        grid = cus;
    }
    if (grid < 0) return;
    if (hipMemsetAsync((char*)d_ws + WS_CTL, 0, CTL_ZERO_BYTES, stream) != hipSuccess) { fprintf(stderr, "kernel_launch: memset failed\n"); return; }
    Args a{};
    for (int i = 0; i < 26; ++i) a.in[i] = (const float*)d_in[i];
    a.out = (float*)d_out; a.ws = (unsigned char*)d_ws;
    hipLaunchKernelGGL(hyena_mla_fwd, dim3(grid), dim3(NTHR), LDS_BYTES, stream, a);
    const hipError_t le = hipPeekAtLastError();
    if (le != hipSuccess) fprintf(stderr, "kernel_launch: launch failed: %s\n", hipGetErrorName(le));
}
```

```cpp
#include <hip/hip_runtime.h>
#include <cstdio>
#include <cstdint>
__device__ __forceinline__ int hw_lane() { int l; asm volatile("v_mbcnt_lo_u32_b32 %0, -1, 0\n\tv_mbcnt_hi_u32_b32 %0, -1, %0" : "=v"(l)); return l; }
__device__ __forceinline__ int tid_from_wave(int wave0) { int w = wave0; asm volatile("" : "+s"(w)); int t = w * 64 + hw_lane(); asm volatile("" : "+v"(t)); return t; }
namespace pg8 {
#define PG8_LAS __attribute__((address_space(3)))
#define PG8_GAS __attribute__((address_space(1)))
typedef unsigned short bf16_t;
typedef short bf16x8 __attribute__((ext_vector_type(8)));
typedef float f32x4 __attribute__((ext_vector_type(4)));
typedef unsigned u32x4 __attribute__((ext_vector_type(4)));
constexpr int BM = 256, BK = 64, HALF = 128, HTB = HALF * BK * 2  , STAGE_BYTES = 8 * HTB, NXCD = 8, WGM = 8;

__host__ __device__ __forceinline__ int lds_byte(int r, int c) { const int st = (r >> 4) * 2 + (c >> 5), rr = r & 15, cc = c & 31, ob = rr * 64 + cc * 2; return st * 1024 + (ob ^ (((ob >> 9) & 1) << 5)); }
__host__ __device__ __forceinline__ void stage_rc(int b, int& R, int& C) { const int st = b / 1024, sb = b % 1024, swz = sb ^ (((sb >> 9) & 1) << 5); R = (st >> 1) * 16 + swz / 64; C = (st & 1) * 32 + (swz % 64) / 2; }
__host__ __device__ __forceinline__ int perm32(int rho) { const int n = rho >> 4, i = rho & 15; return 8 * (i >> 2) + 4 * n + (i & 3); }

struct Unit { int pm, pn; };
struct Gemm { const bf16_t* A; const bf16_t* Bt; int M, N, K; };

struct StaticOrder {
    int nM, nN, nwg, G, c;
    __host__ __device__ void init(int M, int N, int G_, int c_) { nM = M / BM; nN = N / BM; nwg = nM * nN; G = G_; c = c_; }
    __host__ __device__ bool next(int i, Unit& u) const {
        const long L = (long)i * G + c; if (L >= nwg) return false;
        int wgid = (int)L; { const int q = nwg / NXCD, r = nwg % NXCD, xcd = wgid % NXCD, off = wgid / NXCD; wgid = (xcd < r ? xcd * (q + 1) : r * (q + 1) + (xcd - r) * q) + off; }
        const int nig = WGM * nN, gid = wgid / nig, fm = gid * WGM, gsz = (nM - fm) < WGM ? (nM - fm) : WGM;
        u.pm = fm + ((wgid % nig) % gsz); u.pn = (wgid % nig) / gsz; return true;
    }
    __device__ __forceinline__ void a_ready(const Unit&) const {}
    __device__ __forceinline__ void done(const Unit&) const {}
};

__device__ __forceinline__ unsigned cvt_pk_bf16(float lo, float hi) { unsigned r; asm volatile("v_cvt_pk_bf16_f32 %0, %1, %2" : "=v"(r) : "v"(lo), "v"(hi)); return r; }
typedef float f32x2 __attribute__((ext_vector_type(2)));
__device__ __forceinline__ void relane(int& wr, int& wc, int& fr, int& fq) { int l = hw_lane(); asm volatile("" : "+v"(l)); fr = l & 15; fq = l >> 4; (void)wr; (void)wc; }
__device__ __forceinline__ f32x2 gelu_pk(f32x2 v) {
    const f32x2 av = __builtin_elementwise_abs(v), d = av * 0.2316418882f + 1.0f;
    f32x2 t; t.x = __builtin_amdgcn_rcpf(d.x); t.y = __builtin_amdgcn_rcpf(d.y);
    f32x2 q = t * 0.5307027145f + (-0.7265760135f); q = q * t + 0.7107068705f; q = q * t + (-0.142248368f); q = q * t + 0.127414796f; q = q * t;
    const f32x2 s = (v * v) * (-0.72134752044f);
    f32x2 e; e.x = __builtin_amdgcn_exp2f(s.x); e.y = __builtin_amdgcn_exp2f(s.y);
    const f32x2 m = v * (q * e), r = v - m;
    f32x2 o; o.x = v.x < 0.f ? m.x : r.x; o.y = v.y < 0.f ? m.y : r.y; return o;
}

template <int ACT  > struct EpiBf16 {
    static constexpr bool PERM = true, AFTER_DRAIN = false; static_assert(ACT == 0 || ACT == 1, "EpiBf16: ACT is 0 (none) or 1 (gelu_pk)");
    bf16_t* O; int ldc; const float* bias; int split_cols; size_t split_stride; float scale0;
    __device__ __forceinline__ void operator()(const f32x4 (&acc)[2][2][4][2], const Unit& u, int wr, int wc, int fr, int fq) const {
        relane(wr, wc, fr, fq);
        const int row0 = u.pm * BM + wr * 64 + fr; int colt = u.pn * BM; bf16_t* base = O;
        float sc = 1.f; if (split_cols) { const int t = colt / split_cols; base += (size_t)t * split_stride; colt -= t * split_cols; if (t == 0) sc = scale0; }
        const int col0 = colt + wc * 32 + 8 * fq, bcol0 = u.pn * BM + wc * 32 + 8 * fq;
        f32x4 bv[2][2];
#pragma unroll
        for (int bj = 0; bj < 2; ++bj)
#pragma unroll
            for (int n = 0; n < 2; ++n) bv[bj][n] = bias ? *(const PG8_GAS f32x4*)(bias + bcol0 + bj * HALF + 4 * n) : (f32x4){0.f, 0.f, 0.f, 0.f};
#pragma unroll
        for (int ai = 0; ai < 2; ++ai)
#pragma unroll
            for (int m = 0; m < 4; ++m) { bf16_t* rowp = base + (size_t)(row0 + ai * HALF + m * 16) * ldc + col0;
#pragma unroll
                for (int bj = 0; bj < 2; ++bj) { f32x4 v0 = acc[ai][bj][m][0] + bv[bj][0], v1 = acc[ai][bj][m][1] + bv[bj][1];
                    if (ACT == 1) { f32x2 a = gelu_pk((f32x2){v0[0], v0[1]}), b = gelu_pk((f32x2){v0[2], v0[3]}), c = gelu_pk((f32x2){v1[0], v1[1]}), d = gelu_pk((f32x2){v1[2], v1[3]});
                        v0 = (f32x4){a.x, a.y, b.x, b.y}; v1 = (f32x4){c.x, c.y, d.x, d.y}; }
                    v0 = v0 * sc; v1 = v1 * sc; u32x4 w; w.x = cvt_pk_bf16(v0[0], v0[1]); w.y = cvt_pk_bf16(v0[2], v0[3]); w.z = cvt_pk_bf16(v1[0], v1[1]); w.w = cvt_pk_bf16(v1[2], v1[3]);
                    *(PG8_GAS u32x4*)(rowp + bj * HALF) = w; } }
    }
};

struct PanelStats {
    unsigned* xbuf;
    unsigned* cnt;
    unsigned* tmo;
    int ntn; float eps;
    unsigned code;
    __device__ __forceinline__ bool run(const f32x4 (&v)[2][2][4][2], const Unit& u, int wr, int wc, int fr, int fq, PG8_LAS unsigned char* lds, int wid, int lane) const {
        typedef float f32x2v __attribute__((ext_vector_type(2)));
        PG8_LAS f32x2v* P = (PG8_LAS f32x2v*)lds;
        PG8_LAS f32x2v* S = (PG8_LAS f32x2v*)(lds + 8192);
        PG8_LAS unsigned* flag = (PG8_LAS unsigned*)(lds + 8192 + 2048);
#pragma unroll
        for (int ai = 0; ai < 2; ++ai)
#pragma unroll
            for (int m = 0; m < 4; ++m) {
                float s = 0.f;
#pragma unroll
                for (int bj = 0; bj < 2; ++bj)
#pragma unroll
                    for (int n = 0; n < 2; ++n) { const f32x4 x = v[ai][bj][m][n]; s += (x[0] + x[1]) + (x[2] + x[3]); }
                s += __shfl_xor(s, 16); s += __shfl_xor(s, 32);
                const float mw = s * (1.0f / 64.0f); float q = 0.f;
#pragma unroll
                for (int bj = 0; bj < 2; ++bj)
#pragma unroll
                    for (int n = 0; n < 2; ++n) { const f32x4 d = v[ai][bj][m][n] - mw; q += (d[0] * d[0] + d[1] * d[1]) + (d[2] * d[2] + d[3] * d[3]); }
                q += __shfl_xor(q, 16); q += __shfl_xor(q, 32);
                if (fq == 0) P[(ai * HALF + wr * 64 + m * 16 + fr) * 4 + wc] = (f32x2v){mw, q};
            }
        asm volatile("s_waitcnt lgkmcnt(0)" ::: "memory"); __builtin_amdgcn_s_barrier(); asm volatile("" ::: "memory");
#if defined(BROKEN_EXCHANGE_NO_WAIT)
#warning BROKEN CONTROL BUILD: the row-statistics exchange does not wait; results are wrong by design
        if (blockIdx.x >= 64) { const long long t0_ = clock64(); while (clock64() - t0_ < 60000) __builtin_amdgcn_s_sleep(8); }
#endif
        const int row = wid * 32 + (lane & 31);
        if (lane < 32) {
            const f32x2v a = P[row * 4 + 0], b = P[row * 4 + 1], c = P[row * 4 + 2], d = P[row * 4 + 3];
            const float mt = (a.x + b.x + c.x + d.x) * 0.25f;
            const float da = a.x - mt, db = b.x - mt, dc = c.x - mt, dd = d.x - mt;
            const float m2 = (a.y + b.y) + (c.y + d.y) + 64.0f * ((da * da + db * db) + (dc * dc + dd * dd));
            unsigned long long* slot = (unsigned long long*)xbuf + ((size_t)(u.pm * BM + row) * 4 + u.pn);
            __hip_atomic_store(slot, ((unsigned long long)__float_as_uint(m2) << 32) | __float_as_uint(mt), __ATOMIC_RELAXED, __HIP_MEMORY_SCOPE_AGENT);
        }
        asm volatile("s_waitcnt vmcnt(0)" ::: "memory");
        if (lane == 0) __hip_atomic_fetch_add(cnt + 64 * u.pm, 1u, __ATOMIC_RELAXED, __HIP_MEMORY_SCOPE_AGENT);
        if (wid == 0) {
            bool dead = false; const unsigned long long t0 = __builtin_amdgcn_s_memrealtime(); const unsigned want = 8u * (unsigned)ntn;
            for (;;) {
#if defined(BROKEN_EXCHANGE_NO_WAIT)
                break;
#endif
                if ((unsigned)__builtin_amdgcn_readfirstlane(__hip_atomic_load(cnt + 64 * u.pm, __ATOMIC_RELAXED, __HIP_MEMORY_SCOPE_AGENT)) >= want) break;
                if (__builtin_amdgcn_s_memrealtime() - t0 > 2000000ull) {
                    if (lane == 0) { unsigned expect = 0u; __hip_atomic_compare_exchange_strong(tmo + 1, &expect, code | (unsigned)(u.pm & 0xff), __ATOMIC_RELAXED, __ATOMIC_RELAXED, __HIP_MEMORY_SCOPE_AGENT);
                                     __hip_atomic_store(tmo, 1u, __ATOMIC_RELAXED, __HIP_MEMORY_SCOPE_AGENT); }
                    dead = true; break; }
                __builtin_amdgcn_s_sleep(2);
            }
            __builtin_amdgcn_fence(__ATOMIC_ACQUIRE, "agent");
            if (lane == 0) flag[0] = dead ? 1u : 0u;
        }
        asm volatile("s_waitcnt vmcnt(0) lgkmcnt(0)" ::: "memory"); __builtin_amdgcn_s_barrier(); asm volatile("" ::: "memory");
        const bool bad = flag[0] != 0u;
        if (lane < 32) {
            const unsigned long long* slot = (const unsigned long long*)xbuf + (size_t)(u.pm * BM + row) * 4; float mt[4], m2[4]; float ms = 0.f;
#pragma unroll
            for (int t = 0; t < 4; ++t) { if (t < ntn) { const unsigned long long w = __hip_atomic_load(slot + t, __ATOMIC_RELAXED, __HIP_MEMORY_SCOPE_AGENT); mt[t] = __uint_as_float((unsigned)w); m2[t] = __uint_as_float((unsigned)(w >> 32)); } else { mt[t] = 0.f; m2[t] = 0.f; } ms += mt[t]; }
            const float mean = ms / (float)ntn; float q = 0.f;
#pragma unroll
            for (int t = 0; t < 4; ++t) if (t < ntn) { const float dm = mt[t] - mean; q += m2[t] + 256.0f * dm * dm; }
            S[row] = (f32x2v){mean, 1.0f / sqrtf(q / (256.0f * (float)ntn) + eps)};
        }
        asm volatile("s_waitcnt lgkmcnt(0)" ::: "memory"); __builtin_amdgcn_s_barrier(); asm volatile("" ::: "memory");
        return bad;
    }
};
struct EpiLnRes {
    static constexpr bool PERM = false, AFTER_DRAIN = true;
    const float* base; float* out; int ldc; const float* bias; PanelStats st; unsigned poison;
    __device__ __forceinline__ void fused(f32x4 (&acc)[2][2][4][2], const Unit& u, int wr, int wc, int fr, int fq, PG8_LAS unsigned char* lds, int wid, int lane) const {
        typedef float f32x2v __attribute__((ext_vector_type(2)));
        const PG8_LAS f32x2v* S = (const PG8_LAS f32x2v*)(lds + 8192);
        const int col0 = u.pn * BM + wc * 32 + 4 * fq;
#pragma unroll
        for (int bj = 0; bj < 2; ++bj)
#pragma unroll
            for (int n = 0; n < 2; ++n) { const f32x4 bv = bias ? *(const f32x4*)(bias + col0 + bj * HALF + n * 16) : (f32x4){0.f, 0.f, 0.f, 0.f};
#pragma unroll
                for (int ai = 0; ai < 2; ++ai)
#pragma unroll
                    for (int m = 0; m < 4; ++m) acc[ai][bj][m][n] += bv; }
        f32x4 pre[4][2][2];
#pragma unroll
        for (int m = 0; m < 4; ++m) { const size_t off = (size_t)(u.pm * BM + wr * 64 + m * 16 + fr) * ldc + col0;
#pragma unroll
            for (int bj = 0; bj < 2; ++bj)
#pragma unroll
                for (int n = 0; n < 2; ++n) pre[m][bj][n] = *(const f32x4*)(base + off + bj * HALF + n * 16); }
        const bool bad = st.run(acc, u, wr, wc, fr, fq, lds, wid, lane) || poison != 0u;
        const float qnan = __builtin_nanf("");
#pragma unroll
        for (int ai = 0; ai < 2; ++ai)
#pragma unroll
            for (int m = 0; m < 4; ++m) { const int r = ai * HALF + wr * 64 + m * 16 + fr; const f32x2v sr = S[r]; const size_t off = (size_t)(u.pm * BM + r) * ldc + col0;
#pragma unroll
                for (int bj = 0; bj < 2; ++bj)
#pragma unroll
                    for (int n = 0; n < 2; ++n) { const f32x4 bs = ai == 0 ? pre[m][bj][n] : *(const f32x4*)(base + off + bj * HALF + n * 16); f32x4 o = bs + (acc[ai][bj][m][n] - sr.x) * sr.y;
                        if (bad) o = (f32x4){qnan, qnan, qnan, qnan}; *(f32x4*)(out + off + bj * HALF + n * 16) = o; }
                if (m & 1) asm volatile("" ::: "memory"); }
    }
};
struct EpiLnResLn {
    static constexpr bool PERM = false, AFTER_DRAIN = true;
    const float* base; float* out; bf16_t* xn; int ldc; const float* bias; PanelStats st1, st2; unsigned poison;
    __device__ __forceinline__ void fused(f32x4 (&acc)[2][2][4][2], const Unit& u, int wr, int wc, int fr, int fq, PG8_LAS unsigned char* lds, int wid, int lane) const {
        typedef float f32x2v __attribute__((ext_vector_type(2))); typedef unsigned u32x2v __attribute__((ext_vector_type(2)));
        const PG8_LAS f32x2v* S = (const PG8_LAS f32x2v*)(lds + 8192);
        const int col0 = u.pn * BM + wc * 32 + 4 * fq;
#pragma unroll
        for (int bj = 0; bj < 2; ++bj)
#pragma unroll
            for (int n = 0; n < 2; ++n) { const f32x4 bv = bias ? *(const f32x4*)(bias + col0 + bj * HALF + n * 16) : (f32x4){0.f, 0.f, 0.f, 0.f};
#pragma unroll
                for (int ai = 0; ai < 2; ++ai)
#pragma unroll
                    for (int m = 0; m < 4; ++m) acc[ai][bj][m][n] += bv; }
        bool bad = st1.run(acc, u, wr, wc, fr, fq, lds, wid, lane) || poison != 0u;
        const float qnan = __builtin_nanf("");
#pragma unroll
        for (int ai = 0; ai < 2; ++ai)
#pragma unroll
            for (int m = 0; m < 4; ++m) { const int r = ai * HALF + wr * 64 + m * 16 + fr; const f32x2v sr = S[r]; const size_t off = (size_t)(u.pm * BM + r) * ldc + col0;
#pragma unroll
                for (int bj = 0; bj < 2; ++bj)
#pragma unroll
                    for (int n = 0; n < 2; ++n) { const f32x4 bs = *(const f32x4*)(base + off + bj * HALF + n * 16); acc[ai][bj][m][n] = bs + (acc[ai][bj][m][n] - sr.x) * sr.y; }
                asm volatile("" : "+v"(acc[ai][0][m][0]), "+v"(acc[ai][0][m][1]), "+v"(acc[ai][1][m][0]), "+v"(acc[ai][1][m][1]));
                if (m & 1) asm volatile("" ::: "memory"); }
        const bool bad1 = bad;
        bad = st2.run(acc, u, wr, wc, fr, fq, lds, wid, lane) || bad;
#pragma unroll
        for (int ai = 0; ai < 2; ++ai)
#pragma unroll
            for (int m = 0; m < 4; ++m) { const int r = ai * HALF + wr * 64 + m * 16 + fr; const f32x2v sr = S[r]; const size_t off = (size_t)(u.pm * BM + r) * ldc + col0;
#pragma unroll
                for (int bj = 0; bj < 2; ++bj)
#pragma unroll
                    for (int n = 0; n < 2; ++n) { const f32x4 x1 = acc[ai][bj][m][n]; *(f32x4*)(out + off + bj * HALF + n * 16) = bad1 ? (f32x4){qnan, qnan, qnan, qnan} : x1;
                        const f32x4 o = (x1 - sr.x) * sr.y; u32x2v w; w.x = cvt_pk_bf16(o[0], o[1]); w.y = cvt_pk_bf16(o[2], o[3]);
                        if (bad) { w.x = 0x7fc07fc0u; w.y = 0x7fc07fc0u; } *(u32x2v*)(xn + off + bj * HALF + n * 16) = w; }
                asm volatile("" ::: "memory"); }
    }
};

template <class Epi, class Sched, bool ALIGN_EPI = false, bool SP2 = false>
__device__ __forceinline__ void gemm_phase(PG8_LAS unsigned char* lds, const Gemm g, const Sched& S, const Epi& E, const int wave0) {
    int tid_ = tid_from_wave(wave0);
    const int tid = tid_, wid = __builtin_amdgcn_readfirstlane(tid >> 6), lane = tid & 63, wr = wid >> 2, wc = wid & 3, fr = lane & 15, fq = lane >> 4;
    const int K = g.K, nt = K / BK;
    unsigned voffA[2], voffB[2];
#pragma unroll
    for (int i = 0; i < 2; ++i) { int R, C; stage_rc(tid * 16 + i * 8192, R, C); const int Rb = Epi::PERM ? ((R & ~31) + perm32(R & 31)) : R;
        voffA[i] = (unsigned)(R * K + C) * 2u; voffB[i] = (unsigned)(Rb * K + C) * 2u; }
    const size_t kstep = (size_t)(BK * 2);
    const size_t hstep = (size_t)HALF * K * 2;
    const size_t tstep = 2 * hstep;
    const unsigned ldsw = (unsigned)wid * 1024u;
    const int aoff = lds_byte(wr * 64 + fr, fq * 8), boff = lds_byte(wc * 32 + fr, fq * 8);
#define PG8_SA(b, h) (((b) * 2 + (h)) * HTB)
#define PG8_SB(b, h) ((4 + (b) * 2 + (h)) * HTB)
#define PG8_STAGE(bufoff, gbase, voff) do { _Pragma("unroll") for (int _i = 0; _i < 2; ++_i) \
        __builtin_amdgcn_global_load_lds((const unsigned*)((const char*)(gbase) + (voff)[_i]), (PG8_LAS unsigned*)(lds + (bufoff) + ldsw + _i * 8192), 16, 0, 0); } while (0)
#define PG8_LDA(dst, b, h) do { _Pragma("unroll") for (int m = 0; m < 4; ++m) _Pragma("unroll") for (int k = 0; k < 2; ++k) dst[m][k] = *(const PG8_LAS bf16x8*)(lds + PG8_SA(b, h) + aoff + m * 2048 + k * 1024); } while (0)
#define PG8_LDB(dst, b, h) do { _Pragma("unroll") for (int n = 0; n < 2; ++n) _Pragma("unroll") for (int k = 0; k < 2; ++k) dst[n][k] = *(const PG8_LAS bf16x8*)(lds + PG8_SB(b, h) + boff + n * 2048 + k * 1024); } while (0)
#define PG8_MMA(ai, bj, At, Bt) do { __builtin_amdgcn_s_setprio(1); _Pragma("unroll") for (int m = 0; m < 4; ++m) _Pragma("unroll") for (int n = 0; n < 2; ++n) _Pragma("unroll") for (int k = 0; k < 2; ++k) \
        acc[ai][bj][m][n] = __builtin_amdgcn_mfma_f32_16x16x32_bf16(Bt[n][k], At[m][k], acc[ai][bj][m][n], 0, 0, 0); __builtin_amdgcn_s_setprio(0); } while (0)
#define PG8_WAIT_V(n) asm volatile("s_waitcnt vmcnt(" #n ")" ::: "memory")
#define PG8_WAIT_L(n) asm volatile("s_waitcnt lgkmcnt(" #n ")" ::: "memory")
#define PG8_BAR __builtin_amdgcn_s_barrier()
#define PG8_SCHED __builtin_amdgcn_sched_barrier(0)
    Unit cur, nxt; int ui = 0;
    if (!S.next(0, cur)) return;
    f32x4 acc[2][2][4][2];
#pragma unroll
    for (int a = 0; a < 2; ++a)
#pragma unroll
        for (int b = 0; b < 2; ++b)
#pragma unroll
            for (int m = 0; m < 4; ++m)
#pragma unroll
                for (int n = 0; n < 2; ++n) acc[a][b][m][n] = (f32x4){0.f, 0.f, 0.f, 0.f};
    bf16x8 At[4][2], B0[2][2], B1[2][2];
    const char* cA = (const char*)g.A + (size_t)cur.pm * tstep; const char* cB = (const char*)g.Bt + (size_t)cur.pn * tstep;
    S.a_ready(cur);
    if constexpr (SP2) {
        PG8_STAGE(PG8_SB(0, 0), cB, voffB); PG8_STAGE(PG8_SB(0, 1), cB + hstep, voffB); PG8_STAGE(PG8_SA(0, 0), cA, voffA); PG8_STAGE(PG8_SA(0, 1), cA + hstep, voffA);
        if (wr == 1) PG8_BAR;
        PG8_WAIT_V(2); PG8_BAR;
        PG8_STAGE(PG8_SB(1, 0), cB + kstep, voffB); PG8_STAGE(PG8_SA(1, 0), cA + kstep, voffA); PG8_STAGE(PG8_SB(1, 1), cB + hstep + kstep, voffB);
        PG8_WAIT_V(6); PG8_BAR;
    } else {
        PG8_STAGE(PG8_SB(0, 0), cB, voffB); PG8_STAGE(PG8_SA(0, 0), cA, voffA); PG8_STAGE(PG8_SB(0, 1), cB + hstep, voffB); PG8_STAGE(PG8_SA(0, 1), cA + hstep, voffA);
        if (wr == 1) PG8_BAR;
        PG8_WAIT_V(4); PG8_BAR;
        PG8_STAGE(PG8_SB(1, 0), cB + kstep, voffB); PG8_STAGE(PG8_SA(1, 0), cA + kstep, voffA); PG8_STAGE(PG8_SB(1, 1), cB + hstep + kstep, voffB);
        PG8_WAIT_V(6); PG8_BAR;
    }
    for (;;) {
        const bool has_next = S.next(ui + 1, nxt);
        const char* nA = has_next ? (const char*)g.A + (size_t)nxt.pm * tstep : cA; const char* nB = has_next ? (const char*)g.Bt + (size_t)nxt.pn * tstep : cB;
        for (int t = 0; t < nt; t += 2) {
            const bool last = (t == nt - 2);
            const char* a1 = cA + (size_t)(t + 1) * kstep;
            const char* a2 = last ? nA : cA + (size_t)(t + 2) * kstep; const char* b2 = last ? nB : cB + (size_t)(t + 2) * kstep;
            const char* a3 = a2 + kstep; const char* b3 = b2 + kstep;
            if (last && has_next) S.a_ready(nxt);
            if constexpr (SP2) {
            PG8_LDB(B0, 0, 0); PG8_LDB(B1, 0, 1); PG8_SCHED; PG8_LDA(At, 0, 0); PG8_STAGE(PG8_SA(1, 1), a1 + hstep, voffA);
            PG8_WAIT_V(8); PG8_WAIT_L(0); PG8_BAR; PG8_MMA(0, 0, At, B0); PG8_MMA(0, 1, At, B1); PG8_BAR; PG8_SCHED;
            PG8_LDA(At, 0, 1); PG8_STAGE(PG8_SB(0, 0), b2, voffB); PG8_STAGE(PG8_SB(0, 1), b2 + hstep, voffB); PG8_STAGE(PG8_SA(0, 0), a2, voffA);
            PG8_WAIT_V(8); PG8_WAIT_L(0); PG8_BAR; PG8_MMA(1, 0, At, B0); PG8_MMA(1, 1, At, B1); PG8_BAR; PG8_SCHED;
            PG8_LDB(B0, 1, 0); PG8_LDB(B1, 1, 1); PG8_SCHED; PG8_LDA(At, 1, 0); PG8_STAGE(PG8_SA(0, 1), a2 + hstep, voffA);
            PG8_WAIT_V(8); PG8_WAIT_L(0); PG8_BAR; PG8_MMA(0, 0, At, B0); PG8_MMA(0, 1, At, B1); PG8_BAR; PG8_SCHED;
            PG8_LDA(At, 1, 1); PG8_STAGE(PG8_SB(1, 0), b3, voffB); PG8_STAGE(PG8_SB(1, 1), b3 + hstep, voffB); PG8_STAGE(PG8_SA(1, 0), a3, voffA);
            PG8_WAIT_V(8); PG8_WAIT_L(0); PG8_BAR; PG8_MMA(1, 0, At, B0); PG8_MMA(1, 1, At, B1); PG8_BAR; PG8_SCHED;
            } else {
            PG8_LDB(B0, 0, 0); PG8_SCHED; PG8_LDA(At, 0, 0); PG8_STAGE(PG8_SA(1, 1), a1 + hstep, voffA);
            PG8_WAIT_L(8); PG8_BAR; PG8_WAIT_L(0); PG8_MMA(0, 0, At, B0); PG8_BAR; PG8_SCHED;
            PG8_LDB(B1, 0, 1); PG8_STAGE(PG8_SB(0, 0), b2, voffB);
            PG8_BAR; PG8_WAIT_L(0); PG8_MMA(0, 1, At, B1); PG8_BAR;
            PG8_LDA(At, 0, 1); PG8_STAGE(PG8_SA(0, 0), a2, voffA);
            PG8_BAR; PG8_WAIT_L(0); PG8_MMA(1, 0, At, B0); PG8_BAR; PG8_SCHED;
            PG8_STAGE(PG8_SB(0, 1), b2 + hstep, voffB);
            PG8_WAIT_V(6); PG8_BAR; PG8_MMA(1, 1, At, B1); PG8_BAR;
            PG8_LDB(B0, 1, 0); PG8_SCHED; PG8_LDA(At, 1, 0); PG8_STAGE(PG8_SA(0, 1), a2 + hstep, voffA);
            PG8_WAIT_L(8); PG8_BAR; PG8_WAIT_L(0); PG8_MMA(0, 0, At, B0); PG8_BAR; PG8_SCHED;
            PG8_LDB(B1, 1, 1); PG8_STAGE(PG8_SB(1, 0), b3, voffB);
            PG8_BAR; PG8_WAIT_L(0); PG8_MMA(0, 1, At, B1); PG8_BAR;
            PG8_LDA(At, 1, 1); PG8_STAGE(PG8_SA(1, 0), a3, voffA);
            PG8_BAR; PG8_WAIT_L(0); PG8_MMA(1, 0, At, B0); PG8_BAR; PG8_SCHED;
            PG8_STAGE(PG8_SB(1, 1), b3 + hstep, voffB);
            PG8_WAIT_V(6); PG8_BAR; PG8_MMA(1, 1, At, B1); PG8_BAR;
            }
        }
        if constexpr (ALIGN_EPI) { if (wr == 0) PG8_BAR; }
        if constexpr (!Epi::AFTER_DRAIN) { E(acc, cur, wr, wc, fr, fq); S.done(cur); }
        if (!has_next) break;
#pragma unroll
        for (int a = 0; a < 2; ++a)
#pragma unroll
            for (int b = 0; b < 2; ++b)
#pragma unroll
                for (int m = 0; m < 4; ++m)
#pragma unroll
                    for (int n = 0; n < 2; ++n) acc[a][b][m][n] = (f32x4){0.f, 0.f, 0.f, 0.f};
        cur = nxt; cA = nA; cB = nB; ++ui;
        if constexpr (ALIGN_EPI) { if (wr == 1) PG8_BAR; }
    }
    PG8_WAIT_V(0);
    if constexpr (!ALIGN_EPI) { if (wr == 0) PG8_BAR; }
    PG8_BAR;
    if constexpr (Epi::AFTER_DRAIN) { E.fused(acc, cur, wr, wc, fr, fq, lds, wid, lane); S.done(cur); }
#undef PG8_SA
#undef PG8_SB
#undef PG8_STAGE
#undef PG8_LDA
#undef PG8_LDB
#undef PG8_MMA
#undef PG8_WAIT_V
#undef PG8_WAIT_L
#undef PG8_BAR
#undef PG8_SCHED
}
}

namespace pg8 {
struct EpiRelu2 {
    static constexpr bool PERM = true, AFTER_DRAIN = false;
    bf16_t* O; int ldc;
    __device__ __forceinline__ void operator()(const f32x4 (&acc)[2][2][4][2], const Unit& u, int wr, int wc, int fr, int fq) const {
        relane(wr, wc, fr, fq);
        const int row0 = u.pm * BM + wr * 64 + fr, col0 = u.pn * BM + wc * 32 + 8 * fq;
#pragma unroll
        for (int ai = 0; ai < 2; ++ai)
#pragma unroll
            for (int m = 0; m < 4; ++m) { bf16_t* rowp = O + (size_t)(row0 + ai * HALF + m * 16) * ldc + col0;
#pragma unroll
                for (int bj = 0; bj < 2; ++bj) { f32x4 v0 = acc[ai][bj][m][0], v1 = acc[ai][bj][m][1];
                    v0 = __builtin_elementwise_max(v0, (f32x4){0.f, 0.f, 0.f, 0.f}); v1 = __builtin_elementwise_max(v1, (f32x4){0.f, 0.f, 0.f, 0.f}); v0 = v0 * v0; v1 = v1 * v1;
                    u32x4 w; w.x = cvt_pk_bf16(v0[0], v0[1]); w.y = cvt_pk_bf16(v0[2], v0[3]); w.z = cvt_pk_bf16(v1[0], v1[1]); w.w = cvt_pk_bf16(v1[2], v1[3]);
                    *(PG8_GAS u32x4*)(rowp + bj * HALF) = w; } }
    }
};
struct EpiF32 {
    static constexpr bool PERM = false, AFTER_DRAIN = false;
    float* O; int ldc;
    __device__ __forceinline__ void operator()(const f32x4 (&acc)[2][2][4][2], const Unit& u, int wr, int wc, int fr, int fq) const {
        relane(wr, wc, fr, fq);
        const int row0 = u.pm * BM + wr * 64 + fr, col0 = u.pn * BM + wc * 32 + 4 * fq;
#pragma unroll
        for (int ai = 0; ai < 2; ++ai)
#pragma unroll
            for (int m = 0; m < 4; ++m) { float* rowp = O + (size_t)(row0 + ai * HALF + m * 16) * ldc + col0;
#pragma unroll
                for (int bj = 0; bj < 2; ++bj)
#pragma unroll
                    for (int n = 0; n < 2; ++n) *(PG8_GAS f32x4*)(rowp + bj * HALF + n * 16) = acc[ai][bj][m][n]; }
    }
};
struct EpiTaps {
    static constexpr bool PERM = false, AFTER_DRAIN = false;
    float* O; const float* decay;
    __device__ __forceinline__ void operator()(const f32x4 (&acc)[2][2][4][2], const Unit& u, int wr, int wc, int fr, int fq) const {
        relane(wr, wc, fr, fq);
        const int row0 = u.pm * BM + wr * 64 + fr, col0 = u.pn * BM + wc * 32 + 4 * fq;
#pragma unroll
        for (int ai = 0; ai < 2; ++ai)
#pragma unroll
            for (int m = 0; m < 4; ++m) { const int row = row0 + ai * HALF + m * 16; float* rowp = O + (size_t)row * 16384 + col0; const float nd = -fabsf(((const PG8_GAS float*)decay)[row]) * (1.0f / 16383.0f) * 1.4426950408889634f;
#pragma unroll
                for (int bj = 0; bj < 2; ++bj)
#pragma unroll
                    for (int n = 0; n < 2; ++n) { const int c = col0 + bj * HALF + n * 16; const f32x4 a = acc[ai][bj][m][n]; f32x4 o;
                        o[0] = a[0] * __builtin_amdgcn_exp2f(nd * (float)(c + 0)); o[1] = a[1] * __builtin_amdgcn_exp2f(nd * (float)(c + 1));
                        o[2] = a[2] * __builtin_amdgcn_exp2f(nd * (float)(c + 2)); o[3] = a[3] * __builtin_amdgcn_exp2f(nd * (float)(c + 3));
                        *(PG8_GAS f32x4*)(rowp + bj * HALF + n * 16) = o; } }
    }
};
}

constexpr int L = 16384, NSEQ = 3, M = NSEQ * L, D = 1024, DEPTH = 4;
constexpr int HYW = 512, HYP = 1536, QR = 256, KVR = 128, ROPE = 32, INW = 1952;
constexpr int NH = 8, DQ = 96, DV = 64, NQ = NH * DQ, NKV = NH * 128;
constexpr int FF = 4096;
constexpr float EPS = 1e-6f;
constexpr int NWAVES = 8, NTHR = 512;
constexpr int MLP_CHUNK = 16384, N_MLP_CHUNKS = M / MLP_CHUNK;

constexpr size_t MiB = 1u << 20;
constexpr size_t WS_CTL = 0, CTL_ZERO_BYTES = 65536;
constexpr size_t WS_COS = 1 * MiB, WS_SIN = 2 * MiB;
constexpr size_t WS_H2 = 4 * MiB;
constexpr size_t WS_W3T = 8 * MiB;
constexpr size_t WS_WIN = 12 * MiB, WS_WOUT = 16 * MiB, WS_WUP = 18 * MiB, WS_WDOWN = 26 * MiB, WS_WUQ = 34 * MiB, WS_WUKV = 34 * MiB + 512 * 1024;
constexpr size_t WS_XN = 36 * MiB;
constexpr size_t WS_CQN = 36 * MiB, WS_CKVN = 60 * MiB, WS_KPE = 72 * MiB;
constexpr size_t WS_KEO = 132 * MiB;
constexpr size_t WS_KT = 261 * MiB;
constexpr size_t WS_UT = 261 * MiB;
constexpr size_t WS_CQKV = 405 * MiB;
constexpr size_t WS_YT = 453 * MiB;
constexpr size_t WS_Q = 132 * MiB, WS_KN = 204 * MiB;
constexpr size_t WS_MIX = 324 * MiB;
constexpr size_t WS_T = 132 * MiB;
constexpr size_t WS_H = 324 * MiB;
constexpr size_t WS_G0 = 75 * MiB, WS_G1A = 107 * MiB, WS_G1B = 501 * MiB;
constexpr size_t WS_END = 508 * MiB;
constexpr int KEO_BLK = 16512, KEO_KO = 8256;
static_assert(WS_KEO + (size_t)1024 * KEO_BLK * 8 <= WS_KT, "KEO fits");
static_assert(WS_UT + (size_t)HYP * M * 2 <= WS_CQKV && WS_CQKV + (size_t)M * 512 * 2 <= WS_YT && WS_YT + (size_t)HYW * M * 2 <= WS_END, "map");
static_assert(WS_KN + (size_t)M * NKV * 2 <= WS_MIX && WS_T + (size_t)M * D * 4 <= WS_MIX && WS_H + (size_t)MLP_CHUNK * FF * 2 <= WS_END, "map2");

constexpr int RING_OFF = 0, RING_BYTES = 139264;
constexpr int LDSCTL_OFF = RING_BYTES, MISC_OFF = LDSCTL_OFF + 320;
constexpr int LDS_BYTES = 147456;
static_assert(MISC_OFF + 128 <= LDS_BYTES, "LDS map");

#define GAS __attribute__((address_space(1)))
#define LAS __attribute__((address_space(3)))
typedef unsigned short bf16;
typedef unsigned v4u __attribute__((ext_vector_type(4)));
typedef unsigned v2u __attribute__((ext_vector_type(2)));
typedef float f32x4 __attribute__((ext_vector_type(4)));
typedef float f32x2 __attribute__((ext_vector_type(2)));
typedef short bf16x8 __attribute__((ext_vector_type(8)));
typedef GAS unsigned gu32;
#define RLX_AGENT __ATOMIC_RELAXED, __HIP_MEMORY_SCOPE_AGENT
#define LDS_WAIT() asm volatile("s_waitcnt lgkmcnt(0)" ::: "memory")
#define VM_WAIT() asm volatile("s_waitcnt vmcnt(0)" ::: "memory")
typedef __bf16 bf16x2_t __attribute__((ext_vector_type(2)));
__device__ __forceinline__ unsigned pk2(float lo, float hi) { f32x2 v = {lo, hi}; bf16x2_t b = __builtin_convertvector(v, bf16x2_t); return __builtin_bit_cast(unsigned, b); }
__device__ __forceinline__ bf16 f2bf(float f) { return (bf16)(pk2(f, 0.f) & 0xffffu); }
__device__ __forceinline__ float bf2f(unsigned h) { return __uint_as_float(h << 16); }
__device__ __forceinline__ float wave_sum(float v) {
#pragma unroll
    for (int o = 1; o < 64; o <<= 1) v += __shfl_xor(v, o);
    return v;
}

namespace hfft {
constexpr float w32c(int i) { constexpr float t[16] = {1.000000000e+00f, 9.807852507e-01f, 9.238795042e-01f, 8.314695954e-01f, 7.071067691e-01f, 5.555702448e-01f, 3.826834261e-01f, 1.950903237e-01f, 0.f, -1.950903237e-01f, -3.826834261e-01f, -5.555702448e-01f, -7.071067691e-01f, -8.314695954e-01f, -9.238795042e-01f, -9.807852507e-01f}; return t[i]; }
constexpr float w32s(int i) { constexpr float t[16] = {0.000000000e+00f, 1.950903237e-01f, 3.826834261e-01f, 5.555702448e-01f, 7.071067691e-01f, 8.314695954e-01f, 9.238795042e-01f, 9.807852507e-01f, 1.000000000e+00f, 9.807852507e-01f, 9.238795042e-01f, 8.314695954e-01f, 7.071067691e-01f, 5.555702448e-01f, 3.826834261e-01f, 1.950903237e-01f}; return t[i]; }
constexpr int brev(int x, int bits) { int r = 0; for (int i = 0; i < bits; ++i) r |= ((x >> i) & 1) << (bits - 1 - i); return r; }
constexpr int ilog2(int x) { int r = 0; while ((1 << r) < x) ++r; return r; }
__device__ __forceinline__ int pad(int i) { return i + (i >> 5); }

__device__ __forceinline__ float fadd(float a, float b) { float r; asm("v_add_f32_e32 %0, %1, %2" : "=v"(r) : "v"(a), "v"(b)); return r; }
__device__ __forceinline__ float fsub(float a, float b) { float r; asm("v_sub_f32_e32 %0, %1, %2" : "=v"(r) : "v"(a), "v"(b)); return r; }
__device__ __forceinline__ float fmulc(float c, float x) { float r; asm("v_mul_f32_e32 %0, %1, %2" : "=v"(r) : "s"(c), "v"(x)); return r; }
__device__ __forceinline__ float ffmac(float c, float x, float acc) { asm("v_fmac_f32_e32 %0, %1, %2" : "+v"(acc) : "s"(c), "v"(x)); return acc; }
__device__ __forceinline__ float fmulv(float a, float b) { float r; asm("v_mul_f32_e32 %0, %1, %2" : "=v"(r) : "v"(a), "v"(b)); return r; }
__device__ __forceinline__ float ffmav(float a, float b, float acc) { asm("v_fmac_f32_e32 %0, %1, %2" : "+v"(acc) : "v"(a), "v"(b)); return acc; }
template <int R, bool INV> __device__ __forceinline__ void fft_r2(float (&re)[R], float (&im)[R], const unsigned z0) {
    constexpr int LG = ilog2(R);
#pragma unroll
    for (int st = 0; st < LG; ++st) {
        const int s = (R / 2) >> st;
#pragma unroll
        for (int blk = 0; blk < R; blk += 2 * s) {
#pragma unroll
            for (int a = 0; a < s; ++a) {
                const int i0 = blk + a, i1 = i0 + s;
                const float ur = fadd(re[i0], re[i1]), ui = fadd(im[i0], im[i1]);
                const float dr = fsub(re[i0], re[i1]), di = fsub(im[i0], im[i1]);
                re[i0] = ur; im[i0] = ui;
                const int w = a * (16 / s);
                if (w == 0) { re[i1] = dr; im[i1] = di; }
                else if (w == 8) { re[i1] = INV ? -di : di; im[i1] = INV ? dr : -dr; }
                else { const float c = __uint_as_float(__float_as_uint(w32c(w)) | z0), sn = __uint_as_float(__float_as_uint(INV ? w32s(w) : -w32s(w)) | z0);
                    re[i1] = ffmac(-sn, di, fmulc(c, dr)); im[i1] = ffmac(c, di, fmulc(sn, dr)); }
            }
        }
    }
}

__device__ __forceinline__ int opaque(int x) { asm volatile("" : "+v"(x)); return x; }
template <bool INV> __device__ __forceinline__ void fft16k(float (&re)[32], float (&im)[32], LAS f32x2* buf, const int t_in) {
    asm volatile("" ::: "memory"); __builtin_amdgcn_sched_barrier(0);
    int t = opaque(t_in);
    unsigned z0 = 0u; asm volatile("" : "+s"(z0));
    fft_r2<32, INV>(re, im, z0);
    __syncthreads();
#pragma unroll
    for (int r = 0; r < 32; ++r) buf[33 * t + r] = (f32x2){re[brev(r, 5)], im[brev(r, 5)]};
    __syncthreads();
    t = opaque(t);
    { const int b2 = t + (t >> 5);
#pragma unroll
    for (int r = 0; r < 32; ++r) { const f32x2 v = buf[b2 + 528 * r]; re[r] = v.x; im[r] = v.y; } }
    {
        const float f1 = (float)(t & 31) * (1.0f / 1024.0f);
        const float c1 = __builtin_amdgcn_cosf(f1), s1 = INV ? __builtin_amdgcn_sinf(f1) : -__builtin_amdgcn_sinf(f1);
        float wc = c1, ws = s1;
#pragma unroll
        for (int r = 1; r < 32; ++r) {
            const float xr = re[r], xi = im[r]; re[r] = ffmav(-xi, ws, fmulv(xr, wc)); im[r] = ffmav(xi, wc, fmulv(xr, ws));
            const float nc = ffmav(-ws, s1, fmulv(wc, c1)), ns = ffmav(ws, c1, fmulv(wc, s1)); wc = nc; ws = ns;
        }
    }
    fft_r2<32, INV>(re, im, z0);
    __syncthreads();
    {
        t = opaque(t);
        const int ob = (t >> 5) * 1056 + (t & 31);
#pragma unroll
        for (int r = 0; r < 32; ++r) buf[ob + 33 * r] = (f32x2){re[brev(r, 5)], im[brev(r, 5)]};
    }
    __syncthreads();
#pragma unroll
    for (int h = 0; h < 2; ++h) {
        t = opaque(t);
        float ar[16], ai[16]; const int j = t + 512 * h; const int b3 = t + (t >> 5) + 528 * h;
#pragma unroll
        for (int r = 0; r < 16; ++r) { const f32x2 v = buf[b3 + 1056 * r]; ar[r] = v.x; ai[r] = v.y; }
        {
            const float f1 = (float)j * (1.0f / 16384.0f);
            const float c1 = __builtin_amdgcn_cosf(f1), s1 = INV ? __builtin_amdgcn_sinf(f1) : -__builtin_amdgcn_sinf(f1);
            float wc = c1, ws = s1;
#pragma unroll
            for (int r = 1; r < 16; ++r) {
                const float xr = ar[r], xi = ai[r]; ar[r] = ffmav(-xi, ws, fmulv(xr, wc)); ai[r] = ffmav(xi, wc, fmulv(xr, ws));
                const float nc = ffmav(-ws, s1, fmulv(wc, c1)), ns = ffmav(ws, c1, fmulv(wc, s1)); wc = nc; ws = ns;
            }
        }
        fft_r2<16, INV>(ar, ai, z0);
#pragma unroll
        for (int r = 0; r < 16; ++r) { re[h + 2 * r] = ar[brev(r, 4)]; im[h + 2 * r] = ai[brev(r, 4)]; }
    }
    asm volatile("" ::: "memory"); __builtin_amdgcn_sched_barrier(0);
}
}

struct Frame {
    LAS unsigned char* lds;
    volatile LAS unsigned* MISC;
    gu32* ctl;
    int tid, lane, wave;
    int wave0;
    int vcu, G;
    float* out;
    unsigned char* ws;
};
constexpr int PTRTAB_OFF = LDSCTL_OFF + 512;
__device__ __forceinline__ const GAS float* inp(const Frame& F, int i) {
    const v2u w = *(const LAS v2u*)(F.lds + PTRTAB_OFF + 8 * i);
    const unsigned lo = __builtin_amdgcn_readfirstlane(w.x), hi = __builtin_amdgcn_readfirstlane(w.y);
    return (const GAS float*)(((unsigned long long)hi << 32) | lo);
}
__device__ __forceinline__ GAS unsigned char* wsq(const Frame& F) { unsigned char* p = F.ws; asm volatile("" : "+s"(p)); return (GAS unsigned char*)p; }
enum { I_XP = 0, I_XS, I_WIN, I_CONVW, I_CONVB, I_FW1, I_FB1, I_FW2, I_FB2, I_FW3, I_SINF, I_DECAY, I_HBIAS, I_QNORM, I_WUQ, I_KVNORM, I_WUKV, I_GNHY, I_GNAT, I_WOUT,
       I_NMIXPRE, I_NMIXPOST, I_NMLPPRE, I_NMLPPOST, I_WUP, I_WDOWN };

__device__ __forceinline__ int rope_src(int p) { return 4 * (p >> 3) + (p & 3) + 16 * ((p >> 2) & 1); }
template <bool ROPEPERM>
__device__ __forceinline__ void transpose_item(const GAS float* W, int K, int N, GAS bf16* WT, LAS float* scr, int item, int lane, int ldk = 0, int koff = 0) {
    if (ldk == 0) ldk = K;
    const int nblk = N / 32, kb = item / nblk, nb = item % nblk, k0 = 64 * kb, n0 = 32 * nb;
    int sc = lane & 31; if (ROPEPERM && (nb % 3) == 2) sc = rope_src(sc);
#pragma unroll 8
    for (int i = 0; i < 32; ++i) { const int kk = 2 * i + (lane >> 5); scr[kk * 33 + (lane & 31)] = W[(size_t)(k0 + kk) * N + n0 + sc]; }
    LDS_WAIT(); asm volatile("" ::: "memory");
    const int c = lane & 7;
#pragma unroll
    for (int j = 0; j < 4; ++j) { const int n = (lane >> 3) + 8 * j; const LAS float* s = scr + (8 * c) * 33 + n;
        v4u o; o.x = pk2(s[0 * 33], s[1 * 33]); o.y = pk2(s[2 * 33], s[3 * 33]); o.z = pk2(s[4 * 33], s[5 * 33]); o.w = pk2(s[6 * 33], s[7 * 33]);
        *(GAS v4u*)(WT + (size_t)(n0 + n) * ldk + koff + k0 + 8 * c) = o; }
    LDS_WAIT(); asm volatile("" ::: "memory");
}
__device__ __forceinline__ void phase_weights(Frame& F, int l) {
    LAS float* scr = (LAS float*)(F.lds + RING_OFF + F.wave * 16384);
    const int gw = F.vcu * NWAVES + F.wave, NGW = F.G * NWAVES;
    GAS bf16* WinT = (GAS bf16*)(wsq(F) + WS_WIN); GAS bf16* WoutT = (GAS bf16*)(wsq(F) + WS_WOUT); GAS bf16* WupT = (GAS bf16*)(wsq(F) + WS_WUP); GAS bf16* WdownT = (GAS bf16*)(wsq(F) + WS_WDOWN);
    GAS bf16* WuqT = (GAS bf16*)(wsq(F) + WS_WUQ); GAS bf16* WukvT = (GAS bf16*)(wsq(F) + WS_WUKV);
    constexpr int I_IN = (D / 64) * (INW / 32), I_OUT = (D / 64) * (D / 32), I_UP = (D / 64) * (FF / 32), I_DN = (FF / 64) * (D / 32), I_UQ = (QR / 64) * (NQ / 32), I_UKV = (KVR / 64) * (NKV / 32);
    constexpr int I_W3 = 2048 / 32;
    constexpr int NITEMS = I_IN + I_OUT + I_UP + I_DN + I_UQ + I_UKV + 2 * I_W3;
    for (int it = gw; it < NITEMS; it += NGW) {
        int r = it;
        if (r < I_IN) { transpose_item<false>(inp(F, I_WIN) + (size_t)l * D * INW, D, INW, WinT, scr, r, F.lane); continue; } r -= I_IN;
        if (r < I_OUT) { transpose_item<false>(inp(F, I_WOUT) + (size_t)l * D * D, D, D, WoutT, scr, r, F.lane); continue; } r -= I_OUT;
        if (r < I_UP) { transpose_item<false>(inp(F, I_WUP) + (size_t)l * D * FF, D, FF, WupT, scr, r, F.lane); continue; } r -= I_UP;
        if (r < I_DN) { transpose_item<false>(inp(F, I_WDOWN) + (size_t)l * FF * D, FF, D, WdownT, scr, r, F.lane); continue; } r -= I_DN;
        if (r < I_UQ) { transpose_item<true>(inp(F, I_WUQ) + (size_t)l * QR * NQ, QR, NQ, WuqT, scr, r, F.lane); continue; } r -= I_UQ;
        if (r < I_UKV) { transpose_item<false>(inp(F, I_WUKV) + (size_t)l * KVR * NKV, KVR, NKV, WukvT, scr, r, F.lane); continue; } r -= I_UKV;
        transpose_item<false>(inp(F, I_FW3) + (size_t)l * 64 * 2048, 64, 2048, (GAS bf16*)(wsq(F) + WS_W3T), scr, r % I_W3, F.lane, 128, (r / I_W3) * 64);
    }
    { unsigned z = 0u; asm volatile("" : "+v"(z)); const v4u zz = {z, z, z, z};
      for (int i = gw * 64 + F.lane; i < 12288; i += NGW * 64) ((GAS v4u*)(WinT + (size_t)INW * D))[i] = zz; }
}
__device__ __forceinline__ void phase_rope_tab(Frame& F) {
    const float inv[16] = {1.000000000e+00f, 5.623413324e-01f, 3.162277639e-01f, 1.778279394e-01f, 1.000000015e-01f, 5.623412877e-02f, 3.162277862e-02f, 1.778279431e-02f,
                           9.999999776e-03f, 5.623413250e-03f, 3.162277862e-03f, 1.778279431e-03f, 1.000000047e-03f, 5.623413017e-04f, 3.162277862e-04f, 1.778279402e-04f};
    GAS float* ct = (GAS float*)(wsq(F) + WS_COS); GAS float* st = (GAS float*)(wsq(F) + WS_SIN);
    for (int i = F.vcu * NTHR + F.tid; i < L * 16; i += F.G * NTHR) {
        const int t = i >> 4, j = i & 15; float iv = inv[0];
#pragma unroll
        for (int q = 1; q < 16; ++q) iv = (j == q) ? inv[q] : iv;
        const float ang = (float)t * iv; ct[i] = cosf(ang); st[i] = sinf(ang);
    }
}
__device__ __forceinline__ const GAS float* x_src_row(Frame& F, int l, int m) {
    if (l == 0) return (m < 2 * L) ? inp(F, I_XP) + (size_t)m * D : inp(F, I_XS) + (size_t)(m - 2 * L) * D;
    return (const GAS float*)F.out + (size_t)m * D;
}
__device__ __forceinline__ void store_xn_row(f32x4 (&v)[4], float rstd, const GAS float* g, GAS bf16* orow, int lane) {
    GAS v2u* o8 = (GAS v2u*)orow + lane;
#pragma unroll
    for (int j = 0; j < 4; ++j) { const f32x4 gg = ((const GAS f32x4*)g)[lane + 64 * j]; v2u w; w.x = pk2(v[j].x * rstd * gg.x, v[j].y * rstd * gg.y); w.y = pk2(v[j].z * rstd * gg.z, v[j].w * rstd * gg.w); o8[64 * j] = w; }
}
__device__ __forceinline__ float row_ss(const f32x4 (&v)[4]) { float s = 0.f;
#pragma unroll
    for (int j = 0; j < 4; ++j) s += (v[j].x * v[j].x + v[j].y * v[j].y) + (v[j].z * v[j].z + v[j].w * v[j].w);
    return wave_sum(s); }
__device__ __forceinline__ void phase_norm_first(Frame& F, int l, const GAS float* g) {
    const int gw = F.vcu * NWAVES + F.wave, NGW = F.G * NWAVES; GAS bf16* XN = (GAS bf16*)(wsq(F) + WS_XN);
    for (int m = gw; m < M; m += NGW) {
        const GAS f32x4* xr = (const GAS f32x4*)x_src_row(F, l, m) + F.lane; f32x4 v[4];
#pragma unroll
        for (int j = 0; j < 4; ++j) v[j] = xr[64 * j];
        const float rstd = 1.0f / sqrtf(row_ss(v) * (1.0f / D) + EPS);
        store_xn_row(v, rstd, g, XN + (size_t)m * D, F.lane);
    }
}
__device__ __forceinline__ void phase_norm_res(Frame& F, int lsrc, const GAS float* T, const GAS float* gpost, const GAS float* gnext) {
    const int gw = F.vcu * NWAVES + F.wave, NGW = F.G * NWAVES; GAS bf16* XN = (GAS bf16*)(wsq(F) + WS_XN);
    for (int m = gw; m < M; m += NGW) {
        const GAS f32x4* xr = (const GAS f32x4*)x_src_row(F, lsrc, m) + F.lane; const GAS f32x4* tr = (const GAS f32x4*)(T + (size_t)m * D) + F.lane; f32x4 v[4], tv[4];
#pragma unroll
        for (int j = 0; j < 4; ++j) { v[j] = xr[64 * j]; tv[j] = tr[64 * j]; }
        const float rt = 1.0f / sqrtf(row_ss(tv) * (1.0f / D) + EPS);
        GAS f32x4* orow = (GAS f32x4*)(F.out + (size_t)m * D) + F.lane;
#pragma unroll
        for (int j = 0; j < 4; ++j) { const f32x4 gg = ((const GAS f32x4*)gpost)[F.lane + 64 * j]; v[j] = v[j] + tv[j] * rt * gg; orow[64 * j] = v[j]; }
        if (gnext) { const float rstd = 1.0f / sqrtf(row_ss(v) * (1.0f / D) + EPS); store_xn_row(v, rstd, gnext, XN + (size_t)m * D, F.lane); }
    }
}

__device__ __forceinline__ void phase_filter_mlp(Frame& F, int l) {
    const GAS float* w1 = inp(F, I_FW1) + (size_t)l * 33 * 64; const GAS float* b1 = inp(F, I_FB1) + l * 64; const GAS float* w2 = inp(F, I_FW2) + (size_t)l * 64 * 64; const GAS float* b2 = inp(F, I_FB2) + l * 64;
    const GAS float* sf = inp(F, I_SINF) + l * 128; GAS bf16* H2 = (GAS bf16*)(wsq(F) + WS_H2);
    const int lane = F.lane, gw = F.vcu * NWAVES + F.wave, NGW = F.G * NWAVES;
    float w1c[33], w2c[64];
#pragma unroll
    for (int f = 0; f < 33; ++f) w1c[f] = w1[f * 64 + lane];
#pragma unroll
    for (int i = 0; i < 64; ++i) w2c[i] = w2[i * 64 + lane];
    const float b1l = b1[lane], b2l = b2[lane], sf0 = sf[lane], sf1 = sf[64 + lane];
    for (int n = gw; n < L; n += NGW) {
        const float tn = (float)n * (1.0f / (float)(L - 1)); const float omega = (float)(2.0 * 3.14159265358979323846 / L) * (float)n;
        const int bidx = (lane >= 17) ? lane - 17 : lane - 1; const float band = 1e-4f + (float)bidx * ((15.0f - 1e-4f) / 15.0f); const float ph = omega * band;
        const float zf = (lane == 0) ? tn : ((lane <= 16) ? cosf(ph) : -sinf(ph));
        float acc = b1l;
#pragma unroll
        for (int f = 0; f < 33; ++f) acc += __uint_as_float(__builtin_amdgcn_readlane(__float_as_uint(zf), f)) * w1c[f];
        const float h1 = sinf(sf0 * acc);
        float acc2 = b2l;
#pragma unroll
        for (int i = 0; i < 64; ++i) acc2 += __uint_as_float(__builtin_amdgcn_readlane(__float_as_uint(h1), i)) * w2c[i];
        const float hv = sinf(sf1 * acc2); const bf16 hi = f2bf(hv);
        H2[(size_t)n * 128 + lane] = hi; H2[(size_t)n * 128 + 64 + lane] = f2bf(hv - bf2f(hi));
    }
}

__device__ __forceinline__ void phase_filter_fft(Frame& F, int l) {
    const GAS float* KT = (const GAS float*)(wsq(F) + WS_KT); GAS f32x2* KEO = (GAS f32x2*)(wsq(F) + WS_KEO); const GAS float* hb = inp(F, I_HBIAS) + (size_t)l * 2 * HYW;
    LAS f32x2* buf = (LAS f32x2*)(F.lds + RING_OFF); const int t = F.tid;
    for (int item = F.vcu; item < 2 * HYW; item += F.G) {
        const int o = item >> 9, c = item & 511;
        const GAS float* fw = KT + (size_t)((o * 2 + 0) * HYW + c) * L; const GAS float* bw = KT + (size_t)((o * 2 + 1) * HYW + c) * L;
        const float bias = hb[o * HYW + c]; const float sc = 1.0f / (2.0f * L);
        GAS f32x2* ke = KEO + (size_t)item * KEO_BLK; GAS f32x2* ko = ke + KEO_KO;
        float ar[32], ai[32];
        { const int tq = hfft::opaque(t); (void)tq;
#pragma unroll
        for (int m = 0; m < 32; ++m) { const int n = tq + 512 * m; const float f = fw[n]; float b = bw[n >= 1 ? L - n : 0]; b = n >= 1 ? b : 0.f; ar[m] = f + b; ai[m] = 0.f; if ((m & 15) == 15) { asm volatile("" ::: "memory"); __builtin_amdgcn_sched_barrier(0); } }
        }
        hfft::fft16k<false>(ar, ai, buf, t);
        { const int tq = hfft::opaque(t); (void)tq;
#pragma unroll
        for (int m = 0; m <= 16; ++m) { const int k = tq + 512 * m; if (k <= 8192) ke[k] = (f32x2){(ar[m] + bias) * sc, ai[m] * sc}; }
        }
        { const int tq = hfft::opaque(t); (void)tq;
#pragma unroll
        for (int m = 0; m < 32; ++m) { const int n = tq + 512 * m; const float f = fw[n]; float b = bw[n >= 1 ? L - n : 0]; b = n >= 1 ? b : 0.f; const float d = f - b; const float fr = (float)n * (1.0f / 32768.0f);
            ar[m] = d * __builtin_amdgcn_cosf(fr); ai[m] = -d * __builtin_amdgcn_sinf(fr); if ((m & 15) == 15) { asm volatile("" ::: "memory"); __builtin_amdgcn_sched_barrier(0); } }
        }
        hfft::fft16k<false>(ar, ai, buf, t);
        { const int tq = hfft::opaque(t); (void)tq;
#pragma unroll
        for (int m = 0; m < 16; ++m) { const int k = tq + 512 * m; ko[k] = (f32x2){(ar[m] + bias) * sc, ai[m] * sc}; }
        }
    }
    __syncthreads();
}

__device__ __forceinline__ float u_conv3(const GAS bf16* row, int n, float w0, float w1, float w2, float cb) {
    const int nm = n >= 1 ? n - 1 : 0, np = n + 1 < L ? n + 1 : L - 1;
    float um = bf2f(row[nm]), up = bf2f(row[np]); const float u0 = bf2f(row[n]);
    um = n >= 1 ? um : 0.f; up = n + 1 < L ? up : 0.f;
    return um * w0 + u0 * w1 + up * w2 + cb;
}
__device__ __forceinline__ void cmul_spec(float (&xr)[32], float (&xi)[32], const GAS f32x2* ke, int t, bool odd) {
    { const int tq = hfft::opaque(t); (void)tq;
#pragma unroll
    for (int m = 0; m < 32; ++m) { const int k = tq + 512 * m; int idx; bool cj;
        if (!odd) { cj = k > 8192; idx = cj ? 16384 - k : k; } else { cj = k >= 8192; idx = cj ? 16383 - k : k; }
        const f32x2 kv = ke[idx]; const float kr = kv.x, ki = cj ? -kv.y : kv.y;
        const float a = xr[m], b = xi[m]; xr[m] = a * kr - b * ki; xi[m] = a * ki + b * kr; if ((m & 15) == 15) { asm volatile("" ::: "memory"); __builtin_amdgcn_sched_barrier(0); } }
    }
}
__device__ __forceinline__ void phase_hyena(Frame& F, int l) {
    const GAS bf16* UT = (const GAS bf16*)(wsq(F) + WS_UT); GAS bf16* YT = (GAS bf16*)(wsq(F) + WS_YT); const GAS f32x2* KEO = (const GAS f32x2*)(wsq(F) + WS_KEO);
    const GAS float* cw = inp(F, I_CONVW) + (size_t)l * 3 * HYP; const GAS float* cbv = inp(F, I_CONVB) + (size_t)l * HYP;
    LAS f32x2* buf = (LAS f32x2*)(F.lds + RING_OFF); const int t = F.tid;
    GAS f32x2* G0 = (GAS f32x2*)(wsq(F) + WS_G0) + (size_t)F.vcu * 16384 + t;
    GAS f32x2* G1 = (GAS f32x2*)(wsq(F) + (F.vcu < 200 ? WS_G1A + (size_t)F.vcu * 131072 : WS_G1B + (size_t)(F.vcu - 200) * 131072)) + t;
    for (int item = F.vcu; item < 2 * HYW; item += F.G) {
        const int c = item >> 1, pair = item & 1; const int b0 = pair ? 2 : 0;
        float ar[32], ai[32];
#pragma unroll 1
        for (int o = 0; o < 2; ++o) {
            const GAS f32x2* ke = KEO + (size_t)(o * HYW + c) * KEO_BLK; const GAS f32x2* ko = ke + KEO_KO;
#pragma unroll 1
            for (int half = 0; half < 2; ++half) {
                if (o == 0) { const int ch = c; const float w0 = cw[ch], w1 = cw[HYP + ch], w2 = cw[2 * HYP + ch], cb = cbv[ch];
                    const GAS bf16* r0 = UT + (size_t)ch * M + (size_t)b0 * L; const GAS bf16* r1 = pair ? r0 : r0 + L;
                    { const int tq = hfft::opaque(t); (void)tq;
#pragma unroll
                    for (int m = 0; m < 32; ++m) { const int n = tq + 512 * m; ar[m] = u_conv3(r0, n, w0, w1, w2, cb); { const float q1 = u_conv3(r1, n, w0, w1, w2, cb); ai[m] = pair ? 0.f : q1; } if ((m & 15) == 15) { asm volatile("" ::: "memory"); __builtin_amdgcn_sched_barrier(0); } } }
                    }
                else {
                    { const int tq = hfft::opaque(t); (void)tq; GAS f32x2* G0q = G0 + (tq - t);
#pragma unroll
                    for (int m = 0; m < 32; ++m) { const f32x2 v = G0q[m * 512]; ar[m] = v.x; ai[m] = v.y; if ((m & 15) == 15) { asm volatile("" ::: "memory"); __builtin_amdgcn_sched_barrier(0); } } }
                    }
                if (half == 0) {
                    hfft::fft16k<false>(ar, ai, buf, t);
                    cmul_spec(ar, ai, ke, t, false);
                    hfft::fft16k<true>(ar, ai, buf, t);
                    { const int tq = hfft::opaque(t); (void)tq; GAS f32x2* G1q = G1 + (tq - t);
#pragma unroll
                    for (int m = 0; m < 32; ++m) G1q[m * 512] = (f32x2){ar[m], ai[m]};
                    }
                } else {
                    { const int tq = hfft::opaque(t); (void)tq;
#pragma unroll
                    for (int m = 0; m < 32; ++m) { const float fr = (float)(tq + 512 * m) * (1.0f / 32768.0f); const float cs = __builtin_amdgcn_cosf(fr), sn = -__builtin_amdgcn_sinf(fr);
                        const float a = ar[m], b = ai[m]; ar[m] = a * cs - b * sn; ai[m] = a * sn + b * cs; }
                    }
                    hfft::fft16k<false>(ar, ai, buf, t);
                    cmul_spec(ar, ai, ko, t, true);
                    hfft::fft16k<true>(ar, ai, buf, t);
                    const int ch = (o + 1) * HYW + c; const float w0 = cw[ch], w1 = cw[HYP + ch], w2 = cw[2 * HYP + ch], cb = cbv[ch];
                    const GAS bf16* r0 = UT + (size_t)ch * M + (size_t)b0 * L; const GAS bf16* r1 = pair ? r0 : r0 + L;
                    { const int tq = hfft::opaque(t); (void)tq; GAS f32x2* G1q = G1 + (tq - t);
#pragma unroll
                    for (int m = 0; m < 32; ++m) { const int n = tq + 512 * m; const float fr = (float)n * (1.0f / 32768.0f); const float cs = __builtin_amdgcn_cosf(fr), sn = __builtin_amdgcn_sinf(fr);
                        const float a = ar[m], b = ai[m]; const f32x2 e = G1q[m * 512]; const float yr = e.x + (a * cs - b * sn), yi = e.y + (a * sn + b * cs);
                        ar[m] = yr * u_conv3(r0, n, w0, w1, w2, cb); { const float q1 = yi * u_conv3(r1, n, w0, w1, w2, cb); ai[m] = pair ? 0.f : q1; } if ((m & 15) == 15) { asm volatile("" ::: "memory"); __builtin_amdgcn_sched_barrier(0); } }
                    }
                    if (o == 0) {
                        { const int tq = hfft::opaque(t); (void)tq; GAS f32x2* G0q = G0 + (tq - t);
#pragma unroll
                        for (int m = 0; m < 32; ++m) G0q[m * 512] = (f32x2){ar[m], ai[m]};
                        }
                    } else { GAS bf16* y0 = YT + (size_t)c * M + (size_t)b0 * L; GAS bf16* y1 = y0 + L;
                        { const int tq = hfft::opaque(t); (void)tq;
#pragma unroll
                        for (int m = 0; m < 32; ++m) { const int n = tq + 512 * m; y0[n] = f2bf(ar[m]); if (!pair) y1[n] = f2bf(ai[m]); } }
                        }
                }
            }
        }
    }
    __syncthreads();
}

__device__ __forceinline__ void phase_mla_prep(Frame& F, int l) {
    const GAS bf16* CQKV = (const GAS bf16*)(wsq(F) + WS_CQKV); GAS bf16* CQN = (GAS bf16*)(wsq(F) + WS_CQN); GAS bf16* CKVN = (GAS bf16*)(wsq(F) + WS_CKVN); GAS bf16* KPE = (GAS bf16*)(wsq(F) + WS_KPE);
    const GAS float* gq = inp(F, I_QNORM) + l * QR; const GAS float* gkv = inp(F, I_KVNORM) + l * KVR; const GAS float* ct = (const GAS float*)(wsq(F) + WS_COS); const GAS float* st = (const GAS float*)(wsq(F) + WS_SIN);
    const int gw = F.vcu * NWAVES + F.wave, NGW = F.G * NWAVES, lane = F.lane;
    for (int m = gw; m < M; m += NGW) {
        const GAS bf16* row = CQKV + (size_t)m * 512;
        const v2u q = *(const GAS v2u*)(row + 4 * lane); const unsigned kv = *(const GAS unsigned*)(row + 256 + 2 * lane);
        const float q0 = bf2f(q.x & 0xffffu), q1 = bf2f(q.x >> 16), q2 = bf2f(q.y & 0xffffu), q3 = bf2f(q.y >> 16), k0 = bf2f(kv & 0xffffu), k1 = bf2f(kv >> 16);
        const float rq = 1.0f / sqrtf(wave_sum((q0 * q0 + q1 * q1) + (q2 * q2 + q3 * q3)) * (1.0f / QR) + EPS);
        const float rk = 1.0f / sqrtf(wave_sum(k0 * k0 + k1 * k1) * (1.0f / KVR) + EPS);
        const f32x4 g4 = *(const GAS f32x4*)(gq + 4 * lane); const f32x2 g2 = *(const GAS f32x2*)(gkv + 2 * lane);
        v2u oq; oq.x = pk2(q0 * rq * g4.x, q1 * rq * g4.y); oq.y = pk2(q2 * rq * g4.z, q3 * rq * g4.w);
        *(GAS v2u*)(CQN + (size_t)m * QR + 4 * lane) = oq;
        *(GAS unsigned*)(CKVN + (size_t)m * KVR + 2 * lane) = pk2(k0 * rk * g2.x, k1 * rk * g2.y);
        if (lane < 16) { const int j = lane, tpos = m & (L - 1); const float x1 = bf2f(row[384 + j]), x2 = bf2f(row[384 + 16 + j]); const float cs = ct[tpos * 16 + j], sn = st[tpos * 16 + j];
            const int p1 = 8 * (j >> 2) + (j & 3); KPE[(size_t)m * ROPE + p1] = f2bf(x1 * cs - x2 * sn); KPE[(size_t)m * ROPE + p1 + 4] = f2bf(x2 * cs + x1 * sn); }
    }
}

__device__ __forceinline__ void phase_hy_out(Frame& F, int l) {
    const GAS bf16* YT = (const GAS bf16*)(wsq(F) + WS_YT); GAS bf16* MIX = (GAS bf16*)(wsq(F) + WS_MIX); const GAS float* gn = inp(F, I_GNHY) + l * HYW;
    LAS bf16* tl = (LAS bf16*)(F.lds + RING_OFF + F.wave * 16384);
    const int gw = F.vcu * NWAVES + F.wave, NGW = F.G * NWAVES, lane = F.lane;
    for (int task = gw; task < 8 * (M / 64); task += NGW) {
        const int g = task & 7, tb = task >> 3, tok0 = tb * 64; const int cl = lane >> 3, t8 = (lane & 7) * 8;
        float v[8][8]; float ss[8];
#pragma unroll
        for (int j = 0; j < 8; ++j) ss[j] = 0.f;
#pragma unroll
        for (int i = 0; i < 8; ++i) { const int ch = g * 64 + 8 * i + cl; const v4u w = *(const GAS v4u*)(YT + (size_t)ch * M + tok0 + t8);
            v[i][0] = bf2f(w.x & 0xffffu); v[i][1] = bf2f(w.x >> 16); v[i][2] = bf2f(w.y & 0xffffu); v[i][3] = bf2f(w.y >> 16);
            v[i][4] = bf2f(w.z & 0xffffu); v[i][5] = bf2f(w.z >> 16); v[i][6] = bf2f(w.w & 0xffffu); v[i][7] = bf2f(w.w >> 16);
#pragma unroll
            for (int j = 0; j < 8; ++j) ss[j] += v[i][j] * v[i][j]; }
#pragma unroll
        for (int j = 0; j < 8; ++j) { float s = ss[j]; s += __shfl_xor(s, 8); s += __shfl_xor(s, 16); s += __shfl_xor(s, 32); ss[j] = 1.0f / sqrtf(s * (1.0f / 64.0f) + EPS); }
#pragma unroll
        for (int i = 0; i < 8; ++i) { const int cc = 8 * i + cl; const float gg = gn[g * 64 + cc];
#pragma unroll
            for (int j = 0; j < 8; ++j) tl[(t8 + j) * 72 + cc] = f2bf(v[i][j] * ss[j] * gg); }
        LDS_WAIT(); asm volatile("" ::: "memory");
#pragma unroll
        for (int i = 0; i < 8; ++i) { const int tok = 8 * i + (lane >> 3), c8 = (lane & 7) * 8; const v4u w = *(const LAS v4u*)(tl + tok * 72 + c8);
            *(GAS v4u*)(MIX + (size_t)(tok0 + tok) * D + g * 64 + c8) = w; }
        LDS_WAIT(); asm volatile("" ::: "memory");
    }
}

namespace att {
using s16x4 = __attribute__((ext_vector_type(4))) short;
using f32x16 = __attribute__((ext_vector_type(16))) float;
using u32x4 = __attribute__((ext_vector_type(4))) unsigned;
constexpr int QBLK = 32, KVBLK = 64, NW = 8;
constexpr float SCALE = 0.10206207261596575f;
constexpr float THR = 8.f;
constexpr int SHM_K = KVBLK * 256, SHM_V = KVBLK * DV * 2;
constexpr int NSLOT = 3;
constexpr int OFF_V = 0, OFF_K = NSLOT * SHM_V, OFF_WS = OFF_K + NSLOT * SHM_K, SHM_ATTN = OFF_WS + NW * 64 * 4;
#define KSWZ(row, colB) ((row) * 256 + ((colB) ^ (((row) & 15) << 4)))
#define SBAR() __builtin_amdgcn_sched_barrier(0)
__device__ __forceinline__ int crow(int r, int hi) { return (r & 3) + 8 * (r >> 2) + 4 * hi; }
__device__ __forceinline__ unsigned cvtpk(float lo, float hi) { unsigned r; asm volatile("v_cvt_pk_bf16_f32 %0, %1, %2" : "=v"(r) : "v"(lo), "v"(hi)); return r; }
constexpr float THRL = THR * 1.4426950408889634f;
template <bool FIRST> __device__ __forceinline__ void partialSM(f32x16& p0, f32x16& p1, float& m_ref, f32x16& negm, float& alpha) {
  float pmax = p0[0];
#pragma unroll
  for (int r = 1; r < 16; ++r) pmax = fmaxf(pmax, p0[r]);
#pragma unroll
  for (int r = 0; r < 16; ++r) pmax = fmaxf(pmax, p1[r]);
  { auto rr = __builtin_amdgcn_permlane32_swap(__float_as_uint(pmax), __float_as_uint(pmax), false, false);
    pmax = fmaxf(__uint_as_float(rr[0]), __uint_as_float(rr[1])); }
  alpha = 1.f;
  if (FIRST || !__builtin_expect(__all(pmax <= THRL), 1)) {
    const float d = FIRST ? pmax : fmaxf(pmax, 0.f); m_ref += d; if (!FIRST) alpha = __builtin_amdgcn_exp2f(-d);
#pragma unroll
    for (int r = 0; r < 16; ++r) { p0[r] -= d; p1[r] -= d; }
#pragma unroll
    for (int r = 0; r < 16; ++r) negm[r] = -m_ref;
  }
#pragma unroll
  for (int r = 0; r < 16; ++r) p0[r] = __builtin_amdgcn_exp2f(p0[r]);
}
__device__ __forceinline__ void finishSM(f32x16& p0, f32x16& p1, bf16x8& pa0, bf16x8& pa1, bf16x8& pa2, bf16x8& pa3) {
#pragma unroll
  for (int r = 0; r < 16; ++r) p1[r] = __builtin_amdgcn_exp2f(p1[r]);
#define PK4(P, BASE, OUT) do { unsigned a0 = cvtpk(P[BASE + 0], P[BASE + 1]), a1 = cvtpk(P[BASE + 2], P[BASE + 3]);   \
    unsigned b0 = cvtpk(P[BASE + 4], P[BASE + 5]), b1 = cvtpk(P[BASE + 6], P[BASE + 7]);                              \
    auto r0 = __builtin_amdgcn_permlane32_swap(a0, b0, false, false); auto r1 = __builtin_amdgcn_permlane32_swap(a1, b1, false, false); \
    u32x4 w = {r0[0], r1[0], r0[1], r1[1]}; OUT = __builtin_bit_cast(bf16x8, w); } while (0)
  PK4(p0, 0, pa0); PK4(p0, 8, pa1); PK4(p1, 0, pa2); PK4(p1, 8, pa3);
#undef PK4
}
__device__ __forceinline__ void qkt(f32x16& p0, f32x16& p1, const LAS char* Ks, const bf16x8* qr, const f32x16& negm, int r32, int hi) {
#pragma unroll
  for (int d0 = 0; d0 < 6; ++d0) { const int cb = (d0 * 16 + hi * 8) * 2;
    const bf16x8 b0 = *reinterpret_cast<const LAS bf16x8*>(Ks + KSWZ(r32, cb));
    const bf16x8 b1 = *reinterpret_cast<const LAS bf16x8*>(Ks + KSWZ(32 + r32, cb));
    if (d0 == 0) { p0 = __builtin_amdgcn_mfma_f32_32x32x16_bf16(b0, qr[0], negm, 0, 0, 0); p1 = __builtin_amdgcn_mfma_f32_32x32x16_bf16(b1, qr[0], negm, 0, 0, 0); }
    else { p0 = __builtin_amdgcn_mfma_f32_32x32x16_bf16(b0, qr[d0], p0, 0, 0, 0); p1 = __builtin_amdgcn_mfma_f32_32x32x16_bf16(b1, qr[d0], p1, 0, 0, 0); } }
}
__device__ __forceinline__ int v_st(int k, int c) { const int kk = (k & ~0xC) | ((k & 4) << 1) | ((k & 8) >> 1); return ((kk >> 3) * 2 + (c >> 5)) * 512 + ((kk & 7) * 32 + (c & 31)) * 2; }
__device__ __forceinline__ int v_rd_base(int lane) { return ((lane & 3) << 3) | (((lane >> 2) & 3) << 6) | (((lane >> 4) & 1) << 5) | (((lane >> 5) & 1) << 8); }
constexpr int v_rd_off(int d0, int ks, int half) { return d0 * 512 + ks * 2048 + half * 1024; }
template <int OFF> __device__ __forceinline__ s16x4 tr_read(int vb) { s16x4 r; asm volatile("ds_read_b64_tr_b16 %0, %1 offset:%2" : "=&v"(r) : "v"(vb), "i"(OFF) : "memory"); return r; }
template <int D0> __device__ __forceinline__ void pv_one(f32x16& od, int vb, bf16x8 pa0, bf16x8 pa1, bf16x8 pa2, bf16x8 pa3) {
  const s16x4 l0 = tr_read<v_rd_off(D0, 0, 0)>(vb), h0 = tr_read<v_rd_off(D0, 0, 1)>(vb), l1 = tr_read<v_rd_off(D0, 1, 0)>(vb), h1 = tr_read<v_rd_off(D0, 1, 1)>(vb);
  const s16x4 l2 = tr_read<v_rd_off(D0, 2, 0)>(vb), h2 = tr_read<v_rd_off(D0, 2, 1)>(vb), l3 = tr_read<v_rd_off(D0, 3, 0)>(vb), h3 = tr_read<v_rd_off(D0, 3, 1)>(vb);
  asm volatile("s_waitcnt lgkmcnt(0)" ::: "memory"); SBAR();
#define PK(Lo, Hi) (bf16x8){Lo[0], Lo[1], Lo[2], Lo[3], Hi[0], Hi[1], Hi[2], Hi[3]}
  od = __builtin_amdgcn_mfma_f32_32x32x16_bf16(pa0, PK(l0, h0), od, 0, 0, 0);
  od = __builtin_amdgcn_mfma_f32_32x32x16_bf16(pa1, PK(l1, h1), od, 0, 0, 0);
  od = __builtin_amdgcn_mfma_f32_32x32x16_bf16(pa2, PK(l2, h2), od, 0, 0, 0);
  od = __builtin_amdgcn_mfma_f32_32x32x16_bf16(pa3, PK(l3, h3), od, 0, 0, 0);
#undef PK
}
__device__ __forceinline__ void pv_d0(f32x16* o, int vb, bf16x8 pa0, bf16x8 pa1, bf16x8 pa2, bf16x8 pa3) {
  pv_one<0>(o[0], vb, pa0, pa1, pa2, pa3); pv_one<1>(o[1], vb, pa0, pa1, pa2, pa3);
  const bf16x8 ones = {(short)0x3f80, (short)0x3f80, (short)0x3f80, (short)0x3f80, (short)0x3f80, (short)0x3f80, (short)0x3f80, (short)0x3f80};
  o[2] = __builtin_amdgcn_mfma_f32_32x32x16_bf16(pa0, ones, o[2], 0, 0, 0); o[2] = __builtin_amdgcn_mfma_f32_32x32x16_bf16(pa1, ones, o[2], 0, 0, 0);
  o[2] = __builtin_amdgcn_mfma_f32_32x32x16_bf16(pa2, ones, o[2], 0, 0, 0); o[2] = __builtin_amdgcn_mfma_f32_32x32x16_bf16(pa3, ones, o[2], 0, 0, 0);
}
__device__ __forceinline__ void attn_unit(const bf16* Qb_, const bf16* KNh_, const bf16* KPEb_, const bf16* Vh_, bf16* Mo_,
                                          const float* gain_, const float* ct_, const float* st_, int tpos0, LAS char* lds, const int wave0) {
  const GAS bf16* Qb = (const GAS bf16*)Qb_; const GAS bf16* KNh = (const GAS bf16*)KNh_; const GAS bf16* KPEb = (const GAS bf16*)KPEb_; const GAS bf16* Vh = (const GAS bf16*)Vh_; GAS bf16* Mo = (GAS bf16*)Mo_;
  const GAS float* gain = (const GAS float*)gain_; const GAS float* ct = (const GAS float*)ct_; const GAS float* st = (const GAS float*)st_;

  int tid_ = tid_from_wave(wave0);
  const int tid = tid_, wid = tid >> 6, lane = tid & 63, r32 = lane & 31, hi = lane >> 5;
  LAS char* V_lds = lds + OFF_V; LAS char* K_lds = lds + OFF_K;
  LAS float* ws = (LAS float*)(lds + OFF_WS) + wid * 64; LAS float* li_l = ws; LAS float* al_l = ws + 32;
  float m_reg = 0.f; f32x16 o[3] = {}; f32x16 negm = {}; bf16x8 qr[6];
  const GAS bf16* Qw = Qb + (long)(wid * QBLK + r32) * NQ + hi * 8;
#pragma unroll
  for (int d0 = 0; d0 < 6; ++d0) qr[d0] = *reinterpret_cast<const GAS bf16x8*>(Qw + d0 * 16);
  { const int tq = tpos0 + wid * QBLK + r32;
#pragma unroll
    for (int d0 = 4; d0 < 6; ++d0) { const int fq = 2 * (d0 - 4) + hi; const f32x4 cs = *reinterpret_cast<const GAS f32x4*>(ct + tq * 16 + 4 * fq), sn = *reinterpret_cast<const GAS f32x4*>(st + tq * 16 + 4 * fq);
      const u32x4 w = __builtin_bit_cast(u32x4, qr[d0]);
      const f32x4 x1 = {bf2f(w[0] & 0xffffu), bf2f(w[0] >> 16), bf2f(w[1] & 0xffffu), bf2f(w[1] >> 16)}, x2 = {bf2f(w[2] & 0xffffu), bf2f(w[2] >> 16), bf2f(w[3] & 0xffffu), bf2f(w[3] >> 16)};
      const f32x4 a = x1 * cs - x2 * sn, b = x2 * cs + x1 * sn;
      const u32x4 o4 = {cvtpk(a[0], a[1]), cvtpk(a[2], a[3]), cvtpk(b[0], b[1]), cvtpk(b[2], b[3])}; qr[d0] = __builtin_bit_cast(bf16x8, o4); } }
  { constexpr float C = SCALE * 1.4426950408889634f;
#pragma unroll
    for (int d0 = 0; d0 < 6; ++d0) { const u32x4 w = __builtin_bit_cast(u32x4, qr[d0]); u32x4 o4;
#pragma unroll
      for (int e = 0; e < 4; ++e) o4[e] = cvtpk(bf2f(w[e] & 0xffffu) * C, bf2f(w[e] >> 16) * C);
      qr[d0] = __builtin_bit_cast(bf16x8, o4); } }
  const int sr = tid >> 3, sc = (tid & 7) * 8;
  const int rr_ = (tid & 255) >> 2, rc = (tid & 3) * 8;
  const int vst0 = v_st(sr, sc), kst0 = KSWZ(sr, sc * 2), kst1 = KSWZ(rr_, 128 + rc * 2);
  const int vb0 = (int)(unsigned)(uintptr_t)V_lds + v_rd_base(lane);
  struct { bf16x8 vs, kn, kr; } sr_[2];
#define SLOAD(i, k0) do { sr_[i].vs = *reinterpret_cast<const GAS bf16x8*>(&Vh[(long)((k0) + sr) * NKV + sc]); sr_[i].kn = *reinterpret_cast<const GAS bf16x8*>(&KNh[(long)((k0) + sr) * NKV + sc]); \
    sr_[i].kr = *reinterpret_cast<const GAS bf16x8*>(&KPEb[(long)((k0) + rr_) * ROPE + rc]); } while (0)
#define SWRITE(b, i) do { *(LAS bf16x8*)(V_lds + (b) * SHM_V + vst0) = sr_[i].vs; *(LAS bf16x8*)(K_lds + (b) * SHM_K + kst0) = sr_[i].kn; *(LAS bf16x8*)(K_lds + (b) * SHM_K + kst1) = sr_[i].kr; } while (0)
#define SWAIT() asm volatile("s_waitcnt vmcnt(3)" ::: "memory")
#define RESC(a) do { if (__any((a) < 1.f)) { if (hi == 0) al_l[r32] = (a); asm volatile("s_waitcnt lgkmcnt(0)" ::: "memory"); \
    _Pragma("unroll") for (int d = 0; d < 3; ++d) _Pragma("unroll") for (int r = 0; r < 16; ++r) o[d][r] *= al_l[crow(r, hi)]; } } while (0)
  f32x16 pA0, pA1, pB0, pB1; float alA, alB; bf16x8 pa0, pa1, pa2, pa3; constexpr int NTL = L / KVBLK;
  constexpr int SE = 0, SO = 1;
  int sp_ = 0, sc_ = 0, sn_ = 1;
#define ROT() do { sp_ = sc_; sc_ = sn_; sn_ = (sn_ == NSLOT - 1) ? 0 : sn_ + 1; } while (0)
  SLOAD(SE, 0); asm volatile("s_waitcnt vmcnt(0)" ::: "memory"); SWRITE(0, SE); __syncthreads();
  qkt(pA0, pA1, K_lds, qr, negm, r32, hi); partialSM<true>(pA0, pA1, m_reg, negm, alA);
  SLOAD(SO, KVBLK); SLOAD(SE, 2 * KVBLK);
  SWAIT(); SWRITE(1, SO); __syncthreads();
  ROT();
  for (int j = 1; j + 1 < NTL; j += 2) {
    SBAR(); qkt(pB0, pB1, K_lds + sc_ * SHM_K, qr, negm, r32, hi);
    finishSM(pA0, pA1, pa0, pa1, pa2, pa3); SBAR();
    SLOAD(SO, (j + 2) * KVBLK); SBAR();
    pv_d0(o, vb0 + sp_ * SHM_V, pa0, pa1, pa2, pa3); partialSM<false>(pB0, pB1, m_reg, negm, alB);
    SWAIT(); SWRITE(sn_, SE);
    RESC(alB); __syncthreads(); ROT();
    SBAR(); qkt(pA0, pA1, K_lds + sc_ * SHM_K, qr, negm, r32, hi);
    finishSM(pB0, pB1, pa0, pa1, pa2, pa3); SBAR();
    if (j + 3 < NTL) SLOAD(SE, (j + 3) * KVBLK); SBAR();
    pv_d0(o, vb0 + sp_ * SHM_V, pa0, pa1, pa2, pa3); partialSM<false>(pA0, pA1, m_reg, negm, alA);
    SWAIT(); SWRITE(sn_, SO);
    RESC(alA); __syncthreads(); ROT();
  }
  SBAR(); qkt(pB0, pB1, K_lds + sc_ * SHM_K, qr, negm, r32, hi);
  finishSM(pA0, pA1, pa0, pa1, pa2, pa3); SBAR();
  pv_d0(o, vb0 + sp_ * SHM_V, pa0, pa1, pa2, pa3); partialSM<false>(pB0, pB1, m_reg, negm, alB);
  RESC(alB);
  finishSM(pB0, pB1, pa0, pa1, pa2, pa3); SBAR();
  pv_d0(o, vb0 + sc_ * SHM_V, pa0, pa1, pa2, pa3);
#undef ROT
  const float g0 = gain[r32], g1 = gain[32 + r32];
  GAS bf16* Ow = Mo + (long)(wid * QBLK) * D;
#pragma unroll
  for (int r = 0; r < 16; ++r) { const int orow = crow(r, hi); const float rl = __builtin_amdgcn_rcpf(o[2][r]);
    const float y0 = o[0][r] * rl, y1 = o[1][r] * rl; float s = y0 * y0 + y1 * y1;
    s += __shfl_xor(s, 1); s += __shfl_xor(s, 2); s += __shfl_xor(s, 4); s += __shfl_xor(s, 8); s += __shfl_xor(s, 16);
    const float rs = 1.0f / sqrtf(s * (1.0f / 64.0f) + EPS);
    Ow[(long)orow * D + r32] = f2bf(y0 * rs * g0); Ow[(long)orow * D + 32 + r32] = f2bf(y1 * rs * g1); }
  __syncthreads();
#undef SLOAD
#undef SWRITE
#undef SWAIT
#undef RESC
}
#undef KSWZ
#undef SBAR
}
#define XB_TMO      128
#define XB_XCNT(j)  (256  + 64 * (j))
#define XB_XSUB(j)  (1280 + 64 * (j))
#define XB_XGEN(j)  (2304 + 64 * (j))
#define XB_TOP      3328
#define XB_TOPGEN   3392
#define XCD_BAR_WORDS 3456
#define XB_SPIN_CAP (1u << 18)

__device__ __forceinline__ unsigned xb_ld(unsigned* p)              { return __hip_atomic_load(p, __ATOMIC_RELAXED, __HIP_MEMORY_SCOPE_AGENT); }
__device__ __forceinline__ unsigned xb_add(unsigned* p, unsigned v) { return __hip_atomic_fetch_add(p, v, __ATOMIC_RELAXED, __HIP_MEMORY_SCOPE_AGENT); }
__device__ __forceinline__ unsigned xb_xcc_id() { return (unsigned)__builtin_amdgcn_s_getreg((3 << 11) | 20) & 0xFu; }
#define XB_SPIN(cond, bar) do { unsigned _sp = 0; while (cond) { __builtin_amdgcn_s_sleep(1); \
    if ((++_sp & 255u) == 0u) { if (xb_ld(&(bar)[XB_TMO])) break; if (_sp > XB_SPIN_CAP) { atomicAdd(&(bar)[XB_TMO], 1u); break; } } } } while (0)

struct XcdBarrier {
    unsigned* bar; unsigned x;
    volatile LAS unsigned* st;
};

__device__ __forceinline__ XcdBarrier xcd_barrier_post(unsigned* bar, volatile LAS unsigned* st, const bool t0) {
    XcdBarrier b; b.bar = bar; b.x = xb_xcc_id(); b.st = st;
    if (t0) (void)xb_add(&bar[XB_XCNT(b.x)], 1u);
    return b;
}
__device__ __forceinline__ void xcd_barrier_complete(unsigned* bar, unsigned x, unsigned& nloc, unsigned& nx) {
    const unsigned G = gridDim.x * gridDim.y * gridDim.z;
    unsigned sum, cnt, mine, sp = 0u;
    for (;;) {
        sum = 0u; cnt = 0u; mine = 0u;
#pragma unroll
        for (unsigned j = 0; j < 16; ++j) { const unsigned c = xb_ld(&bar[XB_XCNT(j)]); sum += c; cnt += (c > 0u) ? 1u : 0u; mine = (j == x) ? c : mine; }
        if (sum == G) break;
        __builtin_amdgcn_s_sleep(1);
        if ((++sp & 255u) == 0u) { if (xb_ld(&bar[XB_TMO])) break; if (sp > XB_SPIN_CAP) { atomicAdd(&bar[XB_TMO], 1u); break; } }
    }
    nloc = mine > 0u ? mine : 1u; nx = cnt > 0u ? cnt : 1u;
}

__device__ __forceinline__ void xcd_barrier(const XcdBarrier& b, const bool t0) {
    asm volatile("s_waitcnt vmcnt(0)" ::: "memory");
    __syncthreads();
    if (t0) {
        unsigned* bar = b.bar;
        __builtin_amdgcn_s_waitcnt(0);
        unsigned nloc = b.st[0], nx = b.st[1];
        if (nloc == 0u) { xcd_barrier_complete(bar, b.x, nloc, nx); b.st[0] = nloc; b.st[1] = nx; }
        const unsigned old = xb_add(&bar[XB_XSUB(b.x)], 1u);
        const unsigned gen = old / nloc;
        if (old + 1u == (gen + 1u) * nloc) {
            __builtin_amdgcn_fence(__ATOMIC_RELEASE, "agent");
            asm volatile("s_waitcnt vmcnt(0)" ::: "memory");
            const unsigned og = xb_add(&bar[XB_TOP], 1u);
            const unsigned tg = og / nx;
            if (og + 1u == (tg + 1u) * nx) xb_add(&bar[XB_TOPGEN], 1u);
            else XB_SPIN(xb_ld(&bar[XB_TOPGEN]) == tg, bar);
            __builtin_amdgcn_fence(__ATOMIC_ACQUIRE, "agent");
            xb_add(&bar[XB_XGEN(b.x)], 1u);
            asm volatile("s_waitcnt vmcnt(0)" ::: "memory");
        } else {
            XB_SPIN(xb_ld(&bar[XB_XGEN(b.x)]) == gen, bar);
            __builtin_amdgcn_fence(__ATOMIC_ACQUIRE, "agent");
            asm volatile("s_waitcnt vmcnt(0)" ::: "memory");
        }
    }
    __syncthreads();
}

__device__ __forceinline__ void xcd_barrier_fast(const XcdBarrier& b, const bool t0) {
    asm volatile("s_waitcnt vmcnt(0)" ::: "memory");
    __syncthreads();
    if (t0) {
        unsigned* bar = b.bar; asm volatile("" : "+s"(bar));
        __builtin_amdgcn_s_waitcnt(0);
        unsigned nloc = b.st[0], nx = b.st[1];
        unsigned bx_ = b.x; asm volatile("" : "+s"(bx_));
        const unsigned old = xb_add(&bar[XB_XSUB(bx_)], 1u);
        const unsigned gen = old / nloc;
        if (old + 1u == (gen + 1u) * nloc) {
            __builtin_amdgcn_fence(__ATOMIC_RELEASE, "agent");
            asm volatile("s_waitcnt vmcnt(0)" ::: "memory");
            const unsigned og = xb_add(&bar[XB_TOP], 1u);
            const unsigned tg = og / nx;
            if (og + 1u == (tg + 1u) * nx) xb_add(&bar[XB_TOPGEN], 1u);
            else XB_SPIN(xb_ld(&bar[XB_TOPGEN]) == tg, bar);
            __builtin_amdgcn_fence(__ATOMIC_ACQUIRE, "agent");
            xb_add(&bar[XB_XGEN(bx_)], 1u);
            asm volatile("s_waitcnt vmcnt(0)" ::: "memory");
        } else {
            XB_SPIN(xb_ld(&bar[XB_XGEN(bx_)]) == gen, bar);
            __builtin_amdgcn_fence(__ATOMIC_ACQUIRE, "agent");
            asm volatile("s_waitcnt vmcnt(0)" ::: "memory");
        }
    }
    __syncthreads();
}

constexpr int CW_BAR = 4096;
struct Args { const float* in[26]; float* out; unsigned char* ws; };
#ifndef REP_ATT
#define REP_ATT 1
#endif
#ifndef REP_GEMM
#define REP_GEMM 1
#endif
#ifndef REP_HY
#define REP_HY 1
#endif
#ifndef REP_FILT
#define REP_FILT 1
#endif
#ifndef REP_MISC
#define REP_MISC 1
#endif
#ifndef PROBE_MASK
#define PROBE_MASK 0
#endif
#define TIC() do { if (PROBE_MASK) pr_t0 = __builtin_amdgcn_s_memrealtime(); } while (0)
#define TOC(ph) do { if (PROBE_MASK & (1u << (ph))) pr_acc += __builtin_amdgcn_s_memrealtime() - pr_t0; } while (0)
#define REPEAT(n) _Pragma("unroll 1") for (int rep_ = 0; rep_ < (n); ++rep_)
#define REFRESH() do { const int t_ = tid_from_wave(F.wave0); F.tid = t_; F.lane = t_ & 63; F.wave = __builtin_amdgcn_readfirstlane(t_ >> 6); int v_ = F.vcu; asm volatile("" : "+s"(v_)); F.vcu = v_; } while (0)
#define BXQ() ({ int b_ = (int)blockIdx.x; asm volatile("" : "+s"(b_)); b_; })
#define GEMM_PHASE(EPI, g, S, E) REPEAT(REP_GEMM) pg8::gemm_phase<EPI, pg8::StaticOrder, true, true>(F.lds + RING_OFF, g, S, E, F.wave0)

__global__ void __launch_bounds__(NTHR, 2) hyena_mla_fwd(Args args) {
    extern __shared__ __attribute__((aligned(16))) unsigned char lds[];
    Frame F;
    F.lds = (LAS unsigned char*)lds;
    F.MISC = (volatile LAS unsigned*)(F.lds + MISC_OFF);
    F.tid = threadIdx.x; F.lane = F.tid & 63; F.wave = __builtin_amdgcn_readfirstlane(F.tid >> 6); F.wave0 = F.wave;
    F.G = gridDim.x; { const int bx = blockIdx.x; F.vcu = (F.G % 8 == 0) ? (bx % 8) * (F.G / 8) + bx / 8 : bx; }
    F.ws = args.ws; F.out = args.out; F.ctl = (gu32*)(args.ws + WS_CTL);
    if (F.tid == 0) {
#pragma unroll
        for (int i = 0; i < 26; ++i) *(LAS unsigned long long*)(F.lds + PTRTAB_OFF + 8 * i) = (unsigned long long)args.in[i];
    }
    for (int u = F.tid; u < 512 / 4; u += NTHR) ((LAS unsigned*)(F.lds + LDSCTL_OFF))[u] = 0u;
    __syncthreads();
    XcdBarrier bar = xcd_barrier_post((unsigned*)(F.ctl + CW_BAR), F.MISC + 8, F.tid == 0);
    xcd_barrier(bar, F.tid == 0);
    unsigned long long pr_t0 = 0, pr_acc = 0; (void)pr_t0;
#pragma unroll 1
    for (int l = 0; l < DEPTH; ++l) {
        TIC();
        REPEAT(REP_MISC) { REFRESH(); phase_weights(F, l); }
        __syncthreads();
        REFRESH(); phase_filter_mlp(F, l);
        if (l == 0) { REFRESH(); phase_rope_tab(F); REFRESH(); phase_norm_first(F, 0, inp(F, I_NMIXPRE)); }
        { REFRESH(); xcd_barrier_fast(bar, F.tid == 0); } TOC(0); TIC();
        { unsigned char* w = (unsigned char*)wsq(F); pg8::Gemm g{(bf16*)(w + WS_W3T), (bf16*)(w + WS_H2), 2048, L, 128}; pg8::StaticOrder S; S.init(2048, L, F.G, BXQ());
          pg8::EpiTaps E{(float*)(w + WS_KT), (const float*)inp(F, I_DECAY) + (size_t)l * 2048}; GEMM_PHASE(pg8::EpiTaps, g, S, E); }
        { REFRESH(); xcd_barrier_fast(bar, F.tid == 0); } TOC(1); TIC();
        REPEAT(REP_FILT) { REFRESH(); phase_filter_fft(F, l); }
        { REFRESH(); xcd_barrier_fast(bar, F.tid == 0); } TOC(2); TIC();
        { unsigned char* w = (unsigned char*)wsq(F); bf16* WinT = (bf16*)(w + WS_WIN); bf16* XN = (bf16*)(w + WS_XN); bf16* UT = (bf16*)(w + WS_UT); bf16* CQKV = (bf16*)(w + WS_CQKV);
          { pg8::Gemm g{WinT, XN, HYP, M, D}; pg8::StaticOrder S; S.init(HYP, M, F.G, BXQ());
          pg8::EpiBf16<0> E{UT, M, nullptr, 0, 0, 1.f}; GEMM_PHASE(pg8::EpiBf16<0>, g, S, E); }
        { pg8::Gemm g{XN, WinT + (size_t)HYP * D, M, 512, D}; pg8::StaticOrder S; S.init(M, 512, F.G, (BXQ() + 128) % F.G);
          pg8::EpiBf16<0> E{CQKV, 512, nullptr, 0, 0, 1.f}; GEMM_PHASE(pg8::EpiBf16<0>, g, S, E); } }
        { REFRESH(); xcd_barrier_fast(bar, F.tid == 0); } TOC(3); TIC();
        REPEAT(REP_MISC) { REFRESH(); phase_mla_prep(F, l); }
        REPEAT(REP_HY) { REFRESH(); phase_hyena(F, l); }
        { REFRESH(); xcd_barrier_fast(bar, F.tid == 0); } TOC(4); TIC();
        { unsigned char* w = (unsigned char*)wsq(F); bf16* CQN = (bf16*)(w + WS_CQN); bf16* CKVN = (bf16*)(w + WS_CKVN); bf16* WuqT = (bf16*)(w + WS_WUQ); bf16* WukvT = (bf16*)(w + WS_WUKV);
          bf16* Qb = (bf16*)(w + WS_Q); bf16* KV = (bf16*)(w + WS_KN);
          { pg8::Gemm g{CQN, WuqT, M, NQ, QR}; pg8::StaticOrder S; S.init(M, NQ, F.G, BXQ());
          pg8::EpiBf16<0> E{Qb, NQ, nullptr, 0, 0, 1.f}; GEMM_PHASE(pg8::EpiBf16<0>, g, S, E); }
        { pg8::Gemm g{CKVN, WukvT, M, NKV, KVR}; pg8::StaticOrder S; S.init(M, NKV, F.G, BXQ());
          pg8::EpiBf16<0> E{KV, NKV, nullptr, 0, 0, 1.f}; GEMM_PHASE(pg8::EpiBf16<0>, g, S, E); } }
        { REFRESH(); xcd_barrier_fast(bar, F.tid == 0); } TOC(5); TIC();
        REFRESH();
        { unsigned char* w = (unsigned char*)wsq(F); bf16* Qb = (bf16*)(w + WS_Q); bf16* KV = (bf16*)(w + WS_KN); bf16* KPE = (bf16*)(w + WS_KPE); bf16* MIX = (bf16*)(w + WS_MIX);
          const float* ct = (const float*)(w + WS_COS); const float* st = (const float*)(w + WS_SIN); const float* gat = (const float*)inp(F, I_GNAT) + l * 512;
        REPEAT(REP_ATT) for (int i = 0; i < 6; ++i) {
            const int bh = 3 * (F.vcu >> 5) + (i >> 1), qb = (i & 1) * 32 + (F.vcu & 31); const int b = bh >> 3, h = bh & 7;
            const size_t row0 = (size_t)b * L + (size_t)qb * 256;
            att::attn_unit(Qb + row0 * NQ + h * DQ, KV + (size_t)b * L * NKV + h * 128, KPE + (size_t)b * L * ROPE, KV + (size_t)b * L * NKV + h * 128 + 64,
                           MIX + row0 * D + 512 + h * 64, gat + h * 64, ct, st, qb * 256, (LAS char*)(F.lds + RING_OFF), F.wave0);
        } }
        REPEAT(REP_MISC) { REFRESH(); phase_hy_out(F, l); }
        { REFRESH(); xcd_barrier_fast(bar, F.tid == 0); } TOC(6); TIC();
        { unsigned char* w = (unsigned char*)wsq(F); bf16* MIX = (bf16*)(w + WS_MIX); bf16* WoutT = (bf16*)(w + WS_WOUT); float* T = (float*)(w + WS_T);
          pg8::Gemm g{MIX, WoutT, M, D, D}; pg8::StaticOrder S; S.init(M, D, F.G, BXQ());
          pg8::EpiF32 E{T, D}; GEMM_PHASE(pg8::EpiF32, g, S, E); }
        { REFRESH(); xcd_barrier_fast(bar, F.tid == 0); } TOC(7); TIC();
        REFRESH(); phase_norm_res(F, l, (const GAS float*)(wsq(F) + WS_T), inp(F, I_NMIXPOST) + l * D, inp(F, I_NMLPPRE) + l * D);
        { REFRESH(); xcd_barrier_fast(bar, F.tid == 0); } TOC(8); TIC();
#pragma unroll 1
        for (int ch = 0; ch < N_MLP_CHUNKS; ++ch) {
            { unsigned char* w = (unsigned char*)wsq(F); bf16* XN = (bf16*)(w + WS_XN); bf16* WupT = (bf16*)(w + WS_WUP); bf16* Hb = (bf16*)(w + WS_H);
              pg8::Gemm g{XN + (size_t)ch * MLP_CHUNK * D, WupT, MLP_CHUNK, FF, D}; pg8::StaticOrder S; S.init(MLP_CHUNK, FF, F.G, BXQ());
              pg8::EpiRelu2 E{Hb, FF}; GEMM_PHASE(pg8::EpiRelu2, g, S, E); }
            { REFRESH(); xcd_barrier_fast(bar, F.tid == 0); } TOC(9); TIC();
            { unsigned char* w = (unsigned char*)wsq(F); bf16* Hb = (bf16*)(w + WS_H); bf16* WdownT = (bf16*)(w + WS_WDOWN); float* T = (float*)(w + WS_T);
              pg8::Gemm g{Hb, WdownT, MLP_CHUNK, D, FF}; pg8::StaticOrder S; S.init(MLP_CHUNK, D, F.G, BXQ());
              pg8::EpiF32 E{T + (size_t)ch * MLP_CHUNK * D, D}; GEMM_PHASE(pg8::EpiF32, g, S, E); }
            { REFRESH(); xcd_barrier_fast(bar, F.tid == 0); } TOC(10); TIC();
        }
        REFRESH(); phase_norm_res(F, 1, (const GAS float*)(wsq(F) + WS_T), inp(F, I_NMLPPOST) + l * D, (l + 1 < DEPTH) ? inp(F, I_NMIXPRE) + (l + 1) * D : (const GAS float*)nullptr);
        { REFRESH(); xcd_barrier_fast(bar, F.tid == 0); } TOC(11); TIC();
    }
    if (PROBE_MASK) { const unsigned long long ts = __builtin_amdgcn_s_memrealtime(); while (__builtin_amdgcn_s_memrealtime() - ts < pr_acc) __builtin_amdgcn_s_sleep(8); }
}

extern "C" void kernel_launch(void* const* d_in, const int* in_sizes, int n_in, void* d_out, int out_size, void* d_ws, size_t ws_size, hipStream_t stream) {
    static int grid = 0;
    if (grid == 0) {
        if (n_in != 26 || out_size != M * D || ws_size < WS_END) { fprintf(stderr, "kernel_launch: shape mismatch n_in %d out %d ws %zu (need %zu)\n", n_in, out_size, ws_size, (size_t)WS_END); grid = -1; return; }
        int dev = 0, cus = 0, per_cu = 0;
        if (hipGetDevice(&dev) != hipSuccess || hipDeviceGetAttribute(&cus, hipDeviceAttributeMultiprocessorCount, dev) != hipSuccess) { grid = -1; return; }
        if (hipFuncSetAttribute((const void*)hyena_mla_fwd, hipFuncAttributeMaxDynamicSharedMemorySize, LDS_BYTES) != hipSuccess) { fprintf(stderr, "kernel_launch: hipFuncSetAttribute failed\n"); grid = -1; return; }
        if (hipOccupancyMaxActiveBlocksPerMultiprocessor(&per_cu, (const void*)hyena_mla_fwd, NTHR, LDS_BYTES) != hipSuccess || per_cu < 1) fprintf(stderr, "kernel_launch: occupancy query says %d\n", per_cu);
        (void)hipGetLastError();
        grid = cus;
    }
    if (grid < 0) return;
    if (hipMemsetAsync((char*)d_ws + WS_CTL, 0, CTL_ZERO_BYTES, stream) != hipSuccess) { fprintf(stderr, "kernel_launch: memset failed\n"); return; }
    Args a{};
    for (int i = 0; i < 26; ++i) a.in[i] = (const float*)d_in[i];
    a.out = (float*)d_out; a.ws = (unsigned char*)d_ws;
    hipLaunchKernelGGL(hyena_mla_fwd, dim3(grid), dim3(NTHR), LDS_BYTES, stream, a);
    const hipError_t le = hipPeekAtLastError();
    if (le != hipSuccess) fprintf(stderr, "kernel_launch: launch failed: %s\n", hipGetErrorName(le));
}
```

```cpp
#include <hip/hip_runtime.h>
#include <cstdio>
#include <cstdint>
__device__ __forceinline__ int hw_lane() { int l; asm volatile("v_mbcnt_lo_u32_b32 %0, -1, 0\n\tv_mbcnt_hi_u32_b32 %0, -1, %0" : "=v"(l)); return l; }
__device__ __forceinline__ int tid_from_wave(int wave0) { int w = wave0; asm volatile("" : "+s"(w)); int t = w * 64 + hw_lane(); asm volatile("" : "+v"(t)); return t; }
namespace pg8 {
#define PG8_LAS __attribute__((address_space(3)))
#define PG8_GAS __attribute__((address_space(1)))
typedef unsigned short bf16_t;
typedef short bf16x8 __attribute__((ext_vector_type(8)));
typedef float f32x4 __attribute__((ext_vector_type(4)));
typedef unsigned u32x4 __attribute__((ext_vector_type(4)));
constexpr int BM = 256, BK = 64, HALF = 128, HTB = HALF * BK * 2  , STAGE_BYTES = 8 * HTB, NXCD = 8, WGM = 8;

__host__ __device__ __forceinline__ int lds_byte(int r, int c) { const int st = (r >> 4) * 2 + (c >> 5), rr = r & 15, cc = c & 31, ob = rr * 64 + cc * 2; return st * 1024 + (ob ^ (((ob >> 9) & 1) << 5)); }
__host__ __device__ __forceinline__ void stage_rc(int b, int& R, int& C) { const int st = b / 1024, sb = b % 1024, swz = sb ^ (((sb >> 9) & 1) << 5); R = (st >> 1) * 16 + swz / 64; C = (st & 1) * 32 + (swz % 64) / 2; }
__host__ __device__ __forceinline__ int perm32(int rho) { const int n = rho >> 4, i = rho & 15; return 8 * (i >> 2) + 4 * n + (i & 3); }

struct Unit { int pm, pn; };
struct Gemm { const bf16_t* A; const bf16_t* Bt; int M, N, K; };

struct StaticOrder {
    int nM, nN, nwg, G, c;
    __host__ __device__ void init(int M, int N, int G_, int c_) { nM = M / BM; nN = N / BM; nwg = nM * nN; G = G_; c = c_; }
    __host__ __device__ bool next(int i, Unit& u) const {
        const long L = (long)i * G + c; if (L >= nwg) return false;
        int wgid = (int)L; { const int q = nwg / NXCD, r = nwg % NXCD, xcd = wgid % NXCD, off = wgid / NXCD; wgid = (xcd < r ? xcd * (q + 1) : r * (q + 1) + (xcd - r) * q) + off; }
        const int nig = WGM * nN, gid = wgid / nig, fm = gid * WGM, gsz = (nM - fm) < WGM ? (nM - fm) : WGM;
        u.pm = fm + ((wgid % nig) % gsz); u.pn = (wgid % nig) / gsz; return true;
    }
    __device__ __forceinline__ void a_ready(const Unit&) const {}
    __device__ __forceinline__ void done(const Unit&) const {}
};

__device__ __forceinline__ unsigned cvt_pk_bf16(float lo, float hi) { unsigned r; asm volatile("v_cvt_pk_bf16_f32 %0, %1, %2" : "=v"(r) : "v"(lo), "v"(hi)); return r; }
typedef float f32x2 __attribute__((ext_vector_type(2)));
__device__ __forceinline__ void relane(int& wr, int& wc, int& fr, int& fq) { int l = hw_lane(); asm volatile("" : "+v"(l)); fr = l & 15; fq = l >> 4; (void)wr; (void)wc; }
__device__ __forceinline__ f32x2 gelu_pk(f32x2 v) {
    const f32x2 av = __builtin_elementwise_abs(v), d = av * 0.2316418882f + 1.0f;
    f32x2 t; t.x = __builtin_amdgcn_rcpf(d.x); t.y = __builtin_amdgcn_rcpf(d.y);
    f32x2 q = t * 0.5307027145f + (-0.7265760135f); q = q * t + 0.7107068705f; q = q * t + (-0.142248368f); q = q * t + 0.127414796f; q = q * t;
    const f32x2 s = (v * v) * (-0.72134752044f);
    f32x2 e; e.x = __builtin_amdgcn_exp2f(s.x); e.y = __builtin_amdgcn_exp2f(s.y);
    const f32x2 m = v * (q * e), r = v - m;
    f32x2 o; o.x = v.x < 0.f ? m.x : r.x; o.y = v.y < 0.f ? m.y : r.y; return o;
}

template <int ACT  > struct EpiBf16 {
    static constexpr bool PERM = true, AFTER_DRAIN = false; static_assert(ACT == 0 || ACT == 1, "EpiBf16: ACT is 0 (none) or 1 (gelu_pk)");
    bf16_t* O; int ldc; const float* bias; int split_cols; size_t split_stride; float scale0;
    __device__ __forceinline__ void operator()(const f32x4 (&acc)[2][2][4][2], const Unit& u, int wr, int wc, int fr, int fq) const {
        relane(wr, wc, fr, fq);
        const int row0 = u.pm * BM + wr * 64 + fr; int colt = u.pn * BM; bf16_t* base = O;
        float sc = 1.f; if (split_cols) { const int t = colt / split_cols; base += (size_t)t * split_stride; colt -= t * split_cols; if (t == 0) sc = scale0; }
        const int col0 = colt + wc * 32 + 8 * fq, bcol0 = u.pn * BM + wc * 32 + 8 * fq;
        f32x4 bv[2][2];
#pragma unroll
        for (int bj = 0; bj < 2; ++bj)
#pragma unroll
            for (int n = 0; n < 2; ++n) bv[bj][n] = bias ? *(const PG8_GAS f32x4*)(bias + bcol0 + bj * HALF + 4 * n) : (f32x4){0.f, 0.f, 0.f, 0.f};
#pragma unroll
        for (int ai = 0; ai < 2; ++ai)
#pragma unroll
            for (int m = 0; m < 4; ++m) { bf16_t* rowp = base + (size_t)(row0 + ai * HALF + m * 16) * ldc + col0;
#pragma unroll
                for (int bj = 0; bj < 2; ++bj) { f32x4 v0 = acc[ai][bj][m][0] + bv[bj][0], v1 = acc[ai][bj][m][1] + bv[bj][1];
                    if (ACT == 1) { f32x2 a = gelu_pk((f32x2){v0[0], v0[1]}), b = gelu_pk((f32x2){v0[2], v0[3]}), c = gelu_pk((f32x2){v1[0], v1[1]}), d = gelu_pk((f32x2){v1[2], v1[3]});
                        v0 = (f32x4){a.x, a.y, b.x, b.y}; v1 = (f32x4){c.x, c.y, d.x, d.y}; }
                    v0 = v0 * sc; v1 = v1 * sc; u32x4 w; w.x = cvt_pk_bf16(v0[0], v0[1]); w.y = cvt_pk_bf16(v0[2], v0[3]); w.z = cvt_pk_bf16(v1[0], v1[1]); w.w = cvt_pk_bf16(v1[2], v1[3]);
                    *(PG8_GAS u32x4*)(rowp + bj * HALF) = w; } }
    }
};

struct PanelStats {
    unsigned* xbuf;
    unsigned* cnt;
    unsigned* tmo;
    int ntn; float eps;
    unsigned code;
    __device__ __forceinline__ bool run(const f32x4 (&v)[2][2][4][2], const Unit& u, int wr, int wc, int fr, int fq, PG8_LAS unsigned char* lds, int wid, int lane) const {
        typedef float f32x2v __attribute__((ext_vector_type(2)));
        PG8_LAS f32x2v* P = (PG8_LAS f32x2v*)lds;
        PG8_LAS f32x2v* S = (PG8_LAS f32x2v*)(lds + 8192);
        PG8_LAS unsigned* flag = (PG8_LAS unsigned*)(lds + 8192 + 2048);
#pragma unroll
        for (int ai = 0; ai < 2; ++ai)
#pragma unroll
            for (int m = 0; m < 4; ++m) {
                float s = 0.f;
#pragma unroll
                for (int bj = 0; bj < 2; ++bj)
#pragma unroll
                    for (int n = 0; n < 2; ++n) { const f32x4 x = v[ai][bj][m][n]; s += (x[0] + x[1]) + (x[2] + x[3]); }
                s += __shfl_xor(s, 16); s += __shfl_xor(s, 32);
                const float mw = s * (1.0f / 64.0f); float q = 0.f;
#pragma unroll
                for (int bj = 0; bj < 2; ++bj)
#pragma unroll
                    for (int n = 0; n < 2; ++n) { const f32x4 d = v[ai][bj][m][n] - mw; q += (d[0] * d[0] + d[1] * d[1]) + (d[2] * d[2] + d[3] * d[3]); }
                q += __shfl_xor(q, 16); q += __shfl_xor(q, 32);
                if (fq == 0) P[(ai * HALF + wr * 64 + m * 16 + fr) * 4 + wc] = (f32x2v){mw, q};
            }
        asm volatile("s_waitcnt lgkmcnt(0)" ::: "memory"); __builtin_amdgcn_s_barrier(); asm volatile("" ::: "memory");
#if defined(BROKEN_EXCHANGE_NO_WAIT)
#warning BROKEN CONTROL BUILD: the row-statistics exchange does not wait; results are wrong by design
        if (blockIdx.x >= 64) { const long long t0_ = clock64(); while (clock64() - t0_ < 60000) __builtin_amdgcn_s_sleep(8); }
#endif
        const int row = wid * 32 + (lane & 31);
        if (lane < 32) {
            const f32x2v a = P[row * 4 + 0], b = P[row * 4 + 1], c = P[row * 4 + 2], d = P[row * 4 + 3];
            const float mt = (a.x + b.x + c.x + d.x) * 0.25f;
            const float da = a.x - mt, db = b.x - mt, dc = c.x - mt, dd = d.x - mt;
            const float m2 = (a.y + b.y) + (c.y + d.y) + 64.0f * ((da * da + db * db) + (dc * dc + dd * dd));
            unsigned long long* slot = (unsigned long long*)xbuf + ((size_t)(u.pm * BM + row) * 4 + u.pn);
            __hip_atomic_store(slot, ((unsigned long long)__float_as_uint(m2) << 32) | __float_as_uint(mt), __ATOMIC_RELAXED, __HIP_MEMORY_SCOPE_AGENT);
        }
        asm volatile("s_waitcnt vmcnt(0)" ::: "memory");
        if (lane == 0) __hip_atomic_fetch_add(cnt + 64 * u.pm, 1u, __ATOMIC_RELAXED, __HIP_MEMORY_SCOPE_AGENT);
        if (wid == 0) {
            bool dead = false; const unsigned long long t0 = __builtin_amdgcn_s_memrealtime(); const unsigned want = 8u * (unsigned)ntn;
            for (;;) {
#if defined(BROKEN_EXCHANGE_NO_WAIT)
                break;
#endif
                if ((unsigned)__builtin_amdgcn_readfirstlane(__hip_atomic_load(cnt + 64 * u.pm, __ATOMIC_RELAXED, __HIP_MEMORY_SCOPE_AGENT)) >= want) break;
                if (__builtin_amdgcn_s_memrealtime() - t0 > 2000000ull) {
                    if (lane == 0) { unsigned expect = 0u; __hip_atomic_compare_exchange_strong(tmo + 1, &expect, code | (unsigned)(u.pm & 0xff), __ATOMIC_RELAXED, __ATOMIC_RELAXED, __HIP_MEMORY_SCOPE_AGENT);
                                     __hip_atomic_store(tmo, 1u, __ATOMIC_RELAXED, __HIP_MEMORY_SCOPE_AGENT); }
                    dead = true; break; }
                __builtin_amdgcn_s_sleep(2);
            }
            __builtin_amdgcn_fence(__ATOMIC_ACQUIRE, "agent");
            if (lane == 0) flag[0] = dead ? 1u : 0u;
        }
        asm volatile("s_waitcnt vmcnt(0) lgkmcnt(0)" ::: "memory"); __builtin_amdgcn_s_barrier(); asm volatile("" ::: "memory");
        const bool bad = flag[0] != 0u;
        if (lane < 32) {
            const unsigned long long* slot = (const unsigned long long*)xbuf + (size_t)(u.pm * BM + row) * 4; float mt[4], m2[4]; float ms = 0.f;
#pragma unroll
            for (int t = 0; t < 4; ++t) { if (t < ntn) { const unsigned long long w = __hip_atomic_load(slot + t, __ATOMIC_RELAXED, __HIP_MEMORY_SCOPE_AGENT); mt[t] = __uint_as_float((unsigned)w); m2[t] = __uint_as_float((unsigned)(w >> 32)); } else { mt[t] = 0.f; m2[t] = 0.f; } ms += mt[t]; }
            const float mean = ms / (float)ntn; float q = 0.f;
#pragma unroll
            for (int t = 0; t < 4; ++t) if (t < ntn) { const float dm = mt[t] - mean; q += m2[t] + 256.0f * dm * dm; }
            S[row] = (f32x2v){mean, 1.0f / sqrtf(q / (256.0f * (float)ntn) + eps)};
        }
        asm volatile("s_waitcnt lgkmcnt(0)" ::: "memory"); __builtin_amdgcn_s_barrier(); asm volatile("" ::: "memory");
        return bad;
    }
};
struct EpiLnRes {
    static constexpr bool PERM = false, AFTER_DRAIN = true;
    const float* base; float* out; int ldc; const float* bias; PanelStats st; unsigned poison;
    __device__ __forceinline__ void fused(f32x4 (&acc)[2][2][4][2], const Unit& u, int wr, int wc, int fr, int fq, PG8_LAS unsigned char* lds, int wid, int lane) const {
        typedef float f32x2v __attribute__((ext_vector_type(2)));
        const PG8_LAS f32x2v* S = (const PG8_LAS f32x2v*)(lds + 8192);
        const int col0 = u.pn * BM + wc * 32 + 4 * fq;
#pragma unroll
        for (int bj = 0; bj < 2; ++bj)
#pragma unroll
            for (int n = 0; n < 2; ++n) { const f32x4 bv = bias ? *(const f32x4*)(bias + col0 + bj * HALF + n * 16) : (f32x4){0.f, 0.f, 0.f, 0.f};
#pragma unroll
                for (int ai = 0; ai < 2; ++ai)
#pragma unroll
                    for (int m = 0; m < 4; ++m) acc[ai][bj][m][n] += bv; }
        f32x4 pre[4][2][2];
#pragma unroll
        for (int m = 0; m < 4; ++m) { const size_t off = (size_t)(u.pm * BM + wr * 64 + m * 16 + fr) * ldc + col0;
#pragma unroll
            for (int bj = 0; bj < 2; ++bj)
#pragma unroll
                for (int n = 0; n < 2; ++n) pre[m][bj][n] = *(const f32x4*)(base + off + bj * HALF + n * 16); }
        const bool bad = st.run(acc, u, wr, wc, fr, fq, lds, wid, lane) || poison != 0u;
        const float qnan = __builtin_nanf("");
#pragma unroll
        for (int ai = 0; ai < 2; ++ai)
#pragma unroll
            for (int m = 0; m < 4; ++m) { const int r = ai * HALF + wr * 64 + m * 16 + fr; const f32x2v sr = S[r]; const size_t off = (size_t)(u.pm * BM + r) * ldc + col0;
#pragma unroll
                for (int bj = 0; bj < 2; ++bj)
#pragma unroll
                    for (int n = 0; n < 2; ++n) { const f32x4 bs = ai == 0 ? pre[m][bj][n] : *(const f32x4*)(base + off + bj * HALF + n * 16); f32x4 o = bs + (acc[ai][bj][m][n] - sr.x) * sr.y;
                        if (bad) o = (f32x4){qnan, qnan, qnan, qnan}; *(f32x4*)(out + off + bj * HALF + n * 16) = o; }
                if (m & 1) asm volatile("" ::: "memory"); }
    }
};
struct EpiLnResLn {
    static constexpr bool PERM = false, AFTER_DRAIN = true;
    const float* base; float* out; bf16_t* xn; int ldc; const float* bias; PanelStats st1, st2; unsigned poison;
    __device__ __forceinline__ void fused(f32x4 (&acc)[2][2][4][2], const Unit& u, int wr, int wc, int fr, int fq, PG8_LAS unsigned char* lds, int wid, int lane) const {
        typedef float f32x2v __attribute__((ext_vector_type(2))); typedef unsigned u32x2v __attribute__((ext_vector_type(2)));
        const PG8_LAS f32x2v* S = (const PG8_LAS f32x2v*)(lds + 8192);
        const int col0 = u.pn * BM + wc * 32 + 4 * fq;
#pragma unroll
        for (int bj = 0; bj < 2; ++bj)
#pragma unroll
            for (int n = 0; n < 2; ++n) { const f32x4 bv = bias ? *(const f32x4*)(bias + col0 + bj * HALF + n * 16) : (f32x4){0.f, 0.f, 0.f, 0.f};
#pragma unroll
                for (int ai = 0; ai < 2; ++ai)
#pragma unroll
                    for (int m = 0; m < 4; ++m) acc[ai][bj][m][n] += bv; }
        bool bad = st1.run(acc, u, wr, wc, fr, fq, lds, wid, lane) || poison != 0u;
        const float qnan = __builtin_nanf("");
#pragma unroll
        for (int ai = 0; ai < 2; ++ai)
#pragma unroll
            for (int m = 0; m < 4; ++m) { const int r = ai * HALF + wr * 64 + m * 16 + fr; const f32x2v sr = S[r]; const size_t off = (size_t)(u.pm * BM + r) * ldc + col0;
#pragma unroll
                for (int bj = 0; bj < 2; ++bj)
#pragma unroll
                    for (int n = 0; n < 2; ++n) { const f32x4 bs = *(const f32x4*)(base + off + bj * HALF + n * 16); acc[ai][bj][m][n] = bs + (acc[ai][bj][m][n] - sr.x) * sr.y; }
                asm volatile("" : "+v"(acc[ai][0][m][0]), "+v"(acc[ai][0][m][1]), "+v"(acc[ai][1][m][0]), "+v"(acc[ai][1][m][1]));
                if (m & 1) asm volatile("" ::: "memory"); }
        const bool bad1 = bad;
        bad = st2.run(acc, u, wr, wc, fr, fq, lds, wid, lane) || bad;
#pragma unroll
        for (int ai = 0; ai < 2; ++ai)
#pragma unroll
            for (int m = 0; m < 4; ++m) { const int r = ai * HALF + wr * 64 + m * 16 + fr; const f32x2v sr = S[r]; const size_t off = (size_t)(u.pm * BM + r) * ldc + col0;
#pragma unroll
                for (int bj = 0; bj < 2; ++bj)
#pragma unroll
                    for (int n = 0; n < 2; ++n) { const f32x4 x1 = acc[ai][bj][m][n]; *(f32x4*)(out + off + bj * HALF + n * 16) = bad1 ? (f32x4){qnan, qnan, qnan, qnan} : x1;
                        const f32x4 o = (x1 - sr.x) * sr.y; u32x2v w; w.x = cvt_pk_bf16(o[0], o[1]); w.y = cvt_pk_bf16(o[2], o[3]);
                        if (bad) { w.x = 0x7fc07fc0u; w.y = 0x7fc07fc0u; } *(u32x2v*)(xn + off + bj * HALF + n * 16) = w; }
                asm volatile("" ::: "memory"); }
    }
};

template <class Epi, class Sched, bool ALIGN_EPI = false, bool SP2 = false>
__device__ __forceinline__ void gemm_phase(PG8_LAS unsigned char* lds, const Gemm g, const Sched& S, const Epi& E, const int wave0) {
    int tid_ = tid_from_wave(wave0);
    const int tid = tid_, wid = __builtin_amdgcn_readfirstlane(tid >> 6), lane = tid & 63, wr = wid >> 2, wc = wid & 3, fr = lane & 15, fq = lane >> 4;
    const int K = g.K, nt = K / BK;
    unsigned voffA[2], voffB[2];
#pragma unroll
    for (int i = 0; i < 2; ++i) { int R, C; stage_rc(tid * 16 + i * 8192, R, C); const int Rb = Epi::PERM ? ((R & ~31) + perm32(R & 31)) : R;
        voffA[i] = (unsigned)(R * K + C) * 2u; voffB[i] = (unsigned)(Rb * K + C) * 2u; }
    const size_t kstep = (size_t)(BK * 2);
    const size_t hstep = (size_t)HALF * K * 2;
    const size_t tstep = 2 * hstep;
    const unsigned ldsw = (unsigned)wid * 1024u;
    const int aoff = lds_byte(wr * 64 + fr, fq * 8), boff = lds_byte(wc * 32 + fr, fq * 8);
#define PG8_SA(b, h) (((b) * 2 + (h)) * HTB)
#define PG8_SB(b, h) ((4 + (b) * 2 + (h)) * HTB)
#define PG8_STAGE(bufoff, gbase, voff) do { _Pragma("unroll") for (int _i = 0; _i < 2; ++_i) \
        __builtin_amdgcn_global_load_lds((const unsigned*)((const char*)(gbase) + (voff)[_i]), (PG8_LAS unsigned*)(lds + (bufoff) + ldsw + _i * 8192), 16, 0, 0); } while (0)
#define PG8_LDA(dst, b, h) do { _Pragma("unroll") for (int m = 0; m < 4; ++m) _Pragma("unroll") for (int k = 0; k < 2; ++k) dst[m][k] = *(const PG8_LAS bf16x8*)(lds + PG8_SA(b, h) + aoff + m * 2048 + k * 1024); } while (0)
#define PG8_LDB(dst, b, h) do { _Pragma("unroll") for (int n = 0; n < 2; ++n) _Pragma("unroll") for (int k = 0; k < 2; ++k) dst[n][k] = *(const PG8_LAS bf16x8*)(lds + PG8_SB(b, h) + boff + n * 2048 + k * 1024); } while (0)
#define PG8_MMA(ai, bj, At, Bt) do { __builtin_amdgcn_s_setprio(1); _Pragma("unroll") for (int m = 0; m < 4; ++m) _Pragma("unroll") for (int n = 0; n < 2; ++n) _Pragma("unroll") for (int k = 0; k < 2; ++k) \
        acc[ai][bj][m][n] = __builtin_amdgcn_mfma_f32_16x16x32_bf16(Bt[n][k], At[m][k], acc[ai][bj][m][n], 0, 0, 0); __builtin_amdgcn_s_setprio(0); } while (0)
#define PG8_WAIT_V(n) asm volatile("s_waitcnt vmcnt(" #n ")" ::: "memory")
#define PG8_WAIT_L(n) asm volatile("s_waitcnt lgkmcnt(" #n ")" ::: "memory")
#define PG8_BAR __builtin_amdgcn_s_barrier()
#define PG8_SCHED __builtin_amdgcn_sched_barrier(0)
    Unit cur, nxt; int ui = 0;
    if (!S.next(0, cur)) return;
    f32x4 acc[2][2][4][2];
#pragma unroll
    for (int a = 0; a < 2; ++a)
#pragma unroll
        for (int b = 0; b < 2; ++b)
#pragma unroll
            for (int m = 0; m < 4; ++m)
#pragma unroll
                for (int n = 0; n < 2; ++n) acc[a][b][m][n] = (f32x4){0.f, 0.f, 0.f, 0.f};
    bf16x8 At[4][2], B0[2][2], B1[2][2];
    const char* cA = (const char*)g.A + (size_t)cur.pm * tstep; const char* cB = (const char*)g.Bt + (size_t)cur.pn * tstep;
    S.a_ready(cur);
    if constexpr (SP2) {
        PG8_STAGE(PG8_SB(0, 0), cB, voffB); PG8_STAGE(PG8_SB(0, 1), cB + hstep, voffB); PG8_STAGE(PG8_SA(0, 0), cA, voffA); PG8_STAGE(PG8_SA(0, 1), cA + hstep, voffA);
        if (wr == 1) PG8_BAR;
        PG8_WAIT_V(2); PG8_BAR;
        PG8_STAGE(PG8_SB(1, 0), cB + kstep, voffB); PG8_STAGE(PG8_SA(1, 0), cA + kstep, voffA); PG8_STAGE(PG8_SB(1, 1), cB + hstep + kstep, voffB);
        PG8_WAIT_V(6); PG8_BAR;
    } else {
        PG8_STAGE(PG8_SB(0, 0), cB, voffB); PG8_STAGE(PG8_SA(0, 0), cA, voffA); PG8_STAGE(PG8_SB(0, 1), cB + hstep, voffB); PG8_STAGE(PG8_SA(0, 1), cA + hstep, voffA);
        if (wr == 1) PG8_BAR;
        PG8_WAIT_V(4); PG8_BAR;
        PG8_STAGE(PG8_SB(1, 0), cB + kstep, voffB); PG8_STAGE(PG8_SA(1, 0), cA + kstep, voffA); PG8_STAGE(PG8_SB(1, 1), cB + hstep + kstep, voffB);
        PG8_WAIT_V(6); PG8_BAR;
    }
    for (;;) {
        const bool has_next = S.next(ui + 1, nxt);
        const char* nA = has_next ? (const char*)g.A + (size_t)nxt.pm * tstep : cA; const char* nB = has_next ? (const char*)g.Bt + (size_t)nxt.pn * tstep : cB;
        for (int t = 0; t < nt; t += 2) {
            const bool last = (t == nt - 2);
            const char* a1 = cA + (size_t)(t + 1) * kstep;
            const char* a2 = last ? nA : cA + (size_t)(t + 2) * kstep; const char* b2 = last ? nB : cB + (size_t)(t + 2) * kstep;
            const char* a3 = a2 + kstep; const char* b3 = b2 + kstep;
            if (last && has_next) S.a_ready(nxt);
            if constexpr (SP2) {
            PG8_LDB(B0, 0, 0); PG8_LDB(B1, 0, 1); PG8_SCHED; PG8_LDA(At, 0, 0); PG8_STAGE(PG8_SA(1, 1), a1 + hstep, voffA);
            PG8_WAIT_V(8); PG8_WAIT_L(0); PG8_BAR; PG8_MMA(0, 0, At, B0); PG8_MMA(0, 1, At, B1); PG8_BAR; PG8_SCHED;
            PG8_LDA(At, 0, 1); PG8_STAGE(PG8_SB(0, 0), b2, voffB); PG8_STAGE(PG8_SB(0, 1), b2 + hstep, voffB); PG8_STAGE(PG8_SA(0, 0), a2, voffA);
            PG8_WAIT_V(8); PG8_WAIT_L(0); PG8_BAR; PG8_MMA(1, 0, At, B0); PG8_MMA(1, 1, At, B1); PG8_BAR; PG8_SCHED;
            PG8_LDB(B0, 1, 0); PG8_LDB(B1, 1, 1); PG8_SCHED; PG8_LDA(At, 1, 0); PG8_STAGE(PG8_SA(0, 1), a2 + hstep, voffA);
            PG8_WAIT_V(8); PG8_WAIT_L(0); PG8_BAR; PG8_MMA(0, 0, At, B0); PG8_MMA(0, 1, At, B1); PG8_BAR; PG8_SCHED;
            PG8_LDA(At, 1, 1); PG8_STAGE(PG8_SB(1, 0), b3, voffB); PG8_STAGE(PG8_SB(1, 1), b3 + hstep, voffB); PG8_STAGE(PG8_SA(1, 0), a3, voffA);
            PG8_WAIT_V(8); PG8_WAIT_L(0); PG8_BAR; PG8_MMA(1, 0, At, B0); PG8_MMA(1, 1, At, B1); PG8_BAR; PG8_SCHED;
            } else {
            PG8_LDB(B0, 0, 0); PG8_SCHED; PG8_LDA(At, 0, 0); PG8_STAGE(PG8_SA(1, 1), a1 + hstep, voffA);
            PG8_WAIT_L(8); PG8_BAR; PG8_WAIT_L(0); PG8_MMA(0, 0, At, B0); PG8_BAR; PG8_SCHED;
            PG8_LDB(B1, 0, 1); PG8_STAGE(PG8_SB(0, 0), b2, voffB);
            PG8_BAR; PG8_WAIT_L(0); PG8_MMA(0, 1, At, B1); PG8_BAR;
            PG8_LDA(At, 0, 1); PG8_STAGE(PG8_SA(0, 0), a2, voffA);
            PG8_BAR; PG8_WAIT_L(0); PG8_MMA(1, 0, At, B0); PG8_BAR; PG8_SCHED;
            PG8_STAGE(PG8_SB(0, 1), b2 + hstep, voffB);
            PG8_WAIT_V(6); PG8_BAR; PG8_MMA(1, 1, At, B1); PG8_BAR;
            PG8_LDB(B0, 1, 0); PG8_SCHED; PG8_LDA(At, 1, 0); PG8_STAGE(PG8_SA(0, 1), a2 + hstep, voffA);
            PG8_WAIT_L(8); PG8_BAR; PG8_WAIT_L(0); PG8_MMA(0, 0, At, B0); PG8_BAR; PG8_SCHED;
            PG8_LDB(B1, 1, 1); PG8_STAGE(PG8_SB(1, 0), b3, voffB);
            PG8_BAR; PG8_WAIT_L(0); PG8_MMA(0, 1, At, B1); PG8_BAR;
            PG8_LDA(At, 1, 1); PG8_STAGE(PG8_SA(1, 0), a3, voffA);
            PG8_BAR; PG8_WAIT_L(0); PG8_MMA(1, 0, At, B0); PG8_BAR; PG8_SCHED;
            PG8_STAGE(PG8_SB(1, 1), b3 + hstep, voffB);
            PG8_WAIT_V(6); PG8_BAR; PG8_MMA(1, 1, At, B1); PG8_BAR;
            }
        }
        if constexpr (ALIGN_EPI) { if (wr == 0) PG8_BAR; }
        if constexpr (!Epi::AFTER_DRAIN) { E(acc, cur, wr, wc, fr, fq); S.done(cur); }
        if (!has_next) break;
#pragma unroll
        for (int a = 0; a < 2; ++a)
#pragma unroll
            for (int b = 0; b < 2; ++b)
#pragma unroll
                for (int m = 0; m < 4; ++m)
#pragma unroll
                    for (int n = 0; n < 2; ++n) acc[a][b][m][n] = (f32x4){0.f, 0.f, 0.f, 0.f};
        cur = nxt; cA = nA; cB = nB; ++ui;
        if constexpr (ALIGN_EPI) { if (wr == 1) PG8_BAR; }
    }
    PG8_WAIT_V(0);
    if constexpr (!ALIGN_EPI) { if (wr == 0) PG8_BAR; }
    PG8_BAR;
    if constexpr (Epi::AFTER_DRAIN) { E.fused(acc, cur, wr, wc, fr, fq, lds, wid, lane); S.done(cur); }
#undef PG8_SA
#undef PG8_SB
#undef PG8_STAGE
#undef PG8_LDA
#undef PG8_LDB
#undef PG8_MMA
#undef PG8_WAIT_V
#undef PG8_WAIT_L
#undef PG8_BAR
#undef PG8_SCHED
}
}

namespace pg8 {
struct EpiRelu2 {
    static constexpr bool PERM = true, AFTER_DRAIN = false;
    bf16_t* O; int ldc;
    __device__ __forceinline__ void operator()(const f32x4 (&acc)[2][2][4][2], const Unit& u, int wr, int wc, int fr, int fq) const {
        relane(wr, wc, fr, fq);
        const int row0 = u.pm * BM + wr * 64 + fr, col0 = u.pn * BM + wc * 32 + 8 * fq;
#pragma unroll
        for (int ai = 0; ai < 2; ++ai)
#pragma unroll
            for (int m = 0; m < 4; ++m) { bf16_t* rowp = O + (size_t)(row0 + ai * HALF + m * 16) * ldc + col0;
#pragma unroll
                for (int bj = 0; bj < 2; ++bj) { f32x4 v0 = acc[ai][bj][m][0], v1 = acc[ai][bj][m][1];
                    v0 = __builtin_elementwise_max(v0, (f32x4){0.f, 0.f, 0.f, 0.f}); v1 = __builtin_elementwise_max(v1, (f32x4){0.f, 0.f, 0.f, 0.f}); v0 = v0 * v0; v1 = v1 * v1;
                    u32x4 w; w.x = cvt_pk_bf16(v0[0], v0[1]); w.y = cvt_pk_bf16(v0[2], v0[3]); w.z = cvt_pk_bf16(v1[0], v1[1]); w.w = cvt_pk_bf16(v1[2], v1[3]);
                    *(PG8_GAS u32x4*)(rowp + bj * HALF) = w; } }
    }
};
struct EpiF32 {
    static constexpr bool PERM = false, AFTER_DRAIN = false;
    float* O; int ldc;
    __device__ __forceinline__ void operator()(const f32x4 (&acc)[2][2][4][2], const Unit& u, int wr, int wc, int fr, int fq) const {
        relane(wr, wc, fr, fq);
        const int row0 = u.pm * BM + wr * 64 + fr, col0 = u.pn * BM + wc * 32 + 4 * fq;
#pragma unroll
        for (int ai = 0; ai < 2; ++ai)
#pragma unroll
            for (int m = 0; m < 4; ++m) { float* rowp = O + (size_t)(row0 + ai * HALF + m * 16) * ldc + col0;
#pragma unroll
                for (int bj = 0; bj < 2; ++bj)
#pragma unroll
                    for (int n = 0; n < 2; ++n) *(PG8_GAS f32x4*)(rowp + bj * HALF + n * 16) = acc[ai][bj][m][n]; }
    }
};
struct EpiTaps {
    static constexpr bool PERM = false, AFTER_DRAIN = false;
    float* O; const float* decay;
    __device__ __forceinline__ void operator()(const f32x4 (&acc)[2][2][4][2], const Unit& u, int wr, int wc, int fr, int fq) const {
        relane(wr, wc, fr, fq);
        const int row0 = u.pm * BM + wr * 64 + fr, col0 = u.pn * BM + wc * 32 + 4 * fq;
#pragma unroll
        for (int ai = 0; ai < 2; ++ai)
#pragma unroll
            for (int m = 0; m < 4; ++m) { const int row = row0 + ai * HALF + m * 16; float* rowp = O + (size_t)row * 16384 + col0; const float nd = -fabsf(((const PG8_GAS float*)decay)[row]) * (1.0f / 16383.0f) * 1.4426950408889634f;
#pragma unroll
                for (int bj = 0; bj < 2; ++bj)
#pragma unroll
                    for (int n = 0; n < 2; ++n) { const int c = col0 + bj * HALF + n * 16; const f32x4 a = acc[ai][bj][m][n]; f32x4 o;
                        o[0] = a[0] * __builtin_amdgcn_exp2f(nd * (float)(c + 0)); o[1] = a[1] * __builtin_amdgcn_exp2f(nd * (float)(c + 1));
                        o[2] = a[2] * __builtin_amdgcn_exp2f(nd * (float)(c + 2)); o[3] = a[3] * __builtin_amdgcn_exp2f(nd * (float)(c + 3));
                        *(PG8_GAS f32x4*)(rowp + bj * HALF + n * 16) = o; } }
    }
};
}

constexpr int L = 16384, NSEQ = 3, M = NSEQ * L, D = 1024, DEPTH = 4;
constexpr int HYW = 512, HYP = 1536, QR = 256, KVR = 128, ROPE = 32, INW = 1952;
constexpr int NH = 8, DQ = 96, DV = 64, NQ = NH * DQ, NKV = NH * 128;
constexpr int FF = 4096;
constexpr float EPS = 1e-6f;
constexpr int NWAVES = 8, NTHR = 512;
constexpr int MLP_CHUNK = 16384, N_MLP_CHUNKS = M / MLP_CHUNK;

constexpr size_t MiB = 1u << 20;
constexpr size_t WS_CTL = 0, CTL_ZERO_BYTES = 65536;
constexpr size_t WS_COS = 1 * MiB, WS_SIN = 2 * MiB;
constexpr size_t WS_H2 = 4 * MiB;
constexpr size_t WS_W3T = 8 * MiB;
constexpr size_t WS_WIN = 12 * MiB, WS_WOUT = 16 * MiB, WS_WUP = 18 * MiB, WS_WDOWN = 26 * MiB, WS_WUQ = 34 * MiB, WS_WUKV = 34 * MiB + 512 * 1024;
constexpr size_t WS_XN = 36 * MiB;
constexpr size_t WS_CQN = 36 * MiB, WS_CKVN = 60 * MiB, WS_KPE = 72 * MiB;
constexpr size_t WS_KEO = 132 * MiB;
constexpr size_t WS_KT = 261 * MiB;
constexpr size_t WS_UT = 261 * MiB;
constexpr size_t WS_CQKV = 405 * MiB;
constexpr size_t WS_YT = 453 * MiB;
constexpr size_t WS_Q = 132 * MiB, WS_KN = 204 * MiB;
constexpr size_t WS_MIX = 324 * MiB;
constexpr size_t WS_T = 132 * MiB;
constexpr size_t WS_H = 324 * MiB;
constexpr size_t WS_G0 = 75 * MiB, WS_G1A = 107 * MiB, WS_G1B = 501 * MiB;
constexpr size_t WS_END = 508 * MiB;
constexpr int KEO_BLK = 16512, KEO_KO = 8256;
static_assert(WS_KEO + (size_t)1024 * KEO_BLK * 8 <= WS_KT, "KEO fits");
static_assert(WS_UT + (size_t)HYP * M * 2 <= WS_CQKV && WS_CQKV + (size_t)M * 512 * 2 <= WS_YT && WS_YT + (size_t)HYW * M * 2 <= WS_END, "map");
static_assert(WS_KN + (size_t)M * NKV * 2 <= WS_MIX && WS_T + (size_t)M * D * 4 <= WS_MIX && WS_H + (size_t)MLP_CHUNK * FF * 2 <= WS_END, "map2");

constexpr int RING_OFF = 0, RING_BYTES = 139264;
constexpr int LDSCTL_OFF = RING_BYTES, MISC_OFF = LDSCTL_OFF + 320;
constexpr int LDS_BYTES = 147456;
static_assert(MISC_OFF + 128 <= LDS_BYTES, "LDS map");

#define GAS __attribute__((address_space(1)))
#define LAS __attribute__((address_space(3)))
typedef unsigned short bf16;
typedef unsigned v4u __attribute__((ext_vector_type(4)));
typedef unsigned v2u __attribute__((ext_vector_type(2)));
typedef float f32x4 __attribute__((ext_vector_type(4)));
typedef float f32x2 __attribute__((ext_vector_type(2)));
typedef short bf16x8 __attribute__((ext_vector_type(8)));
typedef GAS unsigned gu32;
#define RLX_AGENT __ATOMIC_RELAXED, __HIP_MEMORY_SCOPE_AGENT
#define LDS_WAIT() asm volatile("s_waitcnt lgkmcnt(0)" ::: "memory")
#define VM_WAIT() asm volatile("s_waitcnt vmcnt(0)" ::: "memory")
typedef __bf16 bf16x2_t __attribute__((ext_vector_type(2)));
__device__ __forceinline__ unsigned pk2(float lo, float hi) { f32x2 v = {lo, hi}; bf16x2_t b = __builtin_convertvector(v, bf16x2_t); return __builtin_bit_cast(unsigned, b); }
__device__ __forceinline__ bf16 f2bf(float f) { return (bf16)(pk2(f, 0.f) & 0xffffu); }
__device__ __forceinline__ float bf2f(unsigned h) { return __uint_as_float(h << 16); }
__device__ __forceinline__ float wave_sum(float v) {
#pragma unroll
    for (int o = 1; o < 64; o <<= 1) v += __shfl_xor(v, o);
    return v;
}

namespace hfft {
constexpr float w32c(int i) { constexpr float t[16] = {1.000000000e+00f, 9.807852507e-01f, 9.238795042e-01f, 8.314695954e-01f, 7.071067691e-01f, 5.555702448e-01f, 3.826834261e-01f, 1.950903237e-01f, 0.f, -1.950903237e-01f, -3.826834261e-01f, -5.555702448e-01f, -7.071067691e-01f, -8.314695954e-01f, -9.238795042e-01f, -9.807852507e-01f}; return t[i]; }
constexpr float w32s(int i) { constexpr float t[16] = {0.000000000e+00f, 1.950903237e-01f, 3.826834261e-01f, 5.555702448e-01f, 7.071067691e-01f, 8.314695954e-01f, 9.238795042e-01f, 9.807852507e-01f, 1.000000000e+00f, 9.807852507e-01f, 9.238795042e-01f, 8.314695954e-01f, 7.071067691e-01f, 5.555702448e-01f, 3.826834261e-01f, 1.950903237e-01f}; return t[i]; }
constexpr int brev(int x, int bits) { int r = 0; for (int i = 0; i < bits; ++i) r |= ((x >> i) & 1) << (bits - 1 - i); return r; }
constexpr int ilog2(int x) { int r = 0; while ((1 << r) < x) ++r; return r; }
__device__ __forceinline__ int pad(int i) { return i + (i >> 5); }

__device__ __forceinline__ float fadd(float a, float b) { float r; asm("v_add_f32_e32 %0, %1, %2" : "=v"(r) : "v"(a), "v"(b)); return r; }
__device__ __forceinline__ float fsub(float a, float b) { float r; asm("v_sub_f32_e32 %0, %1, %2" : "=v"(r) : "v"(a), "v"(b)); return r; }
__device__ __forceinline__ float fmulc(float c, float x) { float r; asm("v_mul_f32_e32 %0, %1, %2" : "=v"(r) : "s"(c), "v"(x)); return r; }
__device__ __forceinline__ float ffmac(float c, float x, float acc) { asm("v_fmac_f32_e32 %0, %1, %2" : "+v"(acc) : "s"(c), "v"(x)); return acc; }
__device__ __forceinline__ float fmulv(float a, float b) { float r; asm("v_mul_f32_e32 %0, %1, %2" : "=v"(r) : "v"(a), "v"(b)); return r; }
__device__ __forceinline__ float ffmav(float a, float b, float acc) { asm("v_fmac_f32_e32 %0, %1, %2" : "+v"(acc) : "v"(a), "v"(b)); return acc; }
template <int R, bool INV> __device__ __forceinline__ void fft_r2(float (&re)[R], float (&im)[R], const unsigned z0) {
    constexpr int LG = ilog2(R);
#pragma unroll
    for (int st = 0; st < LG; ++st) {
        const int s = (R / 2) >> st;
#pragma unroll
        for (int blk = 0; blk < R; blk += 2 * s) {
#pragma unroll
            for (int a = 0; a < s; ++a) {
                const int i0 = blk + a, i1 = i0 + s;
                const float ur = fadd(re[i0], re[i1]), ui = fadd(im[i0], im[i1]);
                const float dr = fsub(re[i0], re[i1]), di = fsub(im[i0], im[i1]);
                re[i0] = ur; im[i0] = ui;
                const int w = a * (16 / s);
                if (w == 0) { re[i1] = dr; im[i1] = di; }
                else if (w == 8) { re[i1] = INV ? -di : di; im[i1] = INV ? dr : -dr; }
                else { const float c = __uint_as_float(__float_as_uint(w32c(w)) | z0), sn = __uint_as_float(__float_as_uint(INV ? w32s(w) : -w32s(w)) | z0);
                    re[i1] = ffmac(-sn, di, fmulc(c, dr)); im[i1] = ffmac(c, di, fmulc(sn, dr)); }
            }
        }
    }
}

__device__ __forceinline__ int opaque(int x) { asm volatile("" : "+v"(x)); return x; }
template <bool INV> __device__ __forceinline__ void fft16k(float (&re)[32], float (&im)[32], LAS f32x2* buf, const int t_in) {
    asm volatile("" ::: "memory"); __builtin_amdgcn_sched_barrier(0);
    int t = opaque(t_in);
    unsigned z0 = 0u; asm volatile("" : "+s"(z0));
    fft_r2<32, INV>(re, im, z0);
    __syncthreads();
#pragma unroll
    for (int r = 0; r < 32; ++r) buf[33 * t + r] = (f32x2){re[brev(r, 5)], im[brev(r, 5)]};
    __syncthreads();
    t = opaque(t);
    { const int b2 = t + (t >> 5);
#pragma unroll
    for (int r = 0; r < 32; ++r) { const f32x2 v = buf[b2 + 528 * r]; re[r] = v.x; im[r] = v.y; } }
    {
        const float f1 = (float)(t & 31) * (1.0f / 1024.0f);
        const float c1 = __builtin_amdgcn_cosf(f1), s1 = INV ? __builtin_amdgcn_sinf(f1) : -__builtin_amdgcn_sinf(f1);
        float wc = c1, ws = s1;
#pragma unroll
        for (int r = 1; r < 32; ++r) {
            const float xr = re[r], xi = im[r]; re[r] = ffmav(-xi, ws, fmulv(xr, wc)); im[r] = ffmav(xi, wc, fmulv(xr, ws));
            const float nc = ffmav(-ws, s1, fmulv(wc, c1)), ns = ffmav(ws, c1, fmulv(wc, s1)); wc = nc; ws = ns;
        }
    }
    fft_r2<32, INV>(re, im, z0);
    __syncthreads();
    {
        t = opaque(t);
        const int ob = (t >> 5) * 1056 + (t & 31);
#pragma unroll
        for (int r = 0; r < 32; ++r) buf[ob + 33 * r] = (f32x2){re[brev(r, 5)], im[brev(r, 5)]};
    }
    __syncthreads();
#pragma unroll
    for (int h = 0; h < 2; ++h) {
        t = opaque(t);
        float ar[16], ai[16]; const int j = t + 512 * h; const int b3 = t + (t >> 5) + 528 * h;
#pragma unroll
        for (int r = 0; r < 16; ++r) { const f32x2 v = buf[b3 + 1056 * r]; ar[r] = v.x; ai[r] = v.y; }
        {
            const float f1 = (float)j * (1.0f / 16384.0f);
            const float c1 = __builtin_amdgcn_cosf(f1), s1 = INV ? __builtin_amdgcn_sinf(f1) : -__builtin_amdgcn_sinf(f1);
            float wc = c1, ws = s1;
#pragma unroll
            for (int r = 1; r < 16; ++r) {
                const float xr = ar[r], xi = ai[r]; ar[r] = ffmav(-xi, ws, fmulv(xr, wc)); ai[r] = ffmav(xi, wc, fmulv(xr, ws));
                const float nc = ffmav(-ws, s1, fmulv(wc, c1)), ns = ffmav(ws, c1, fmulv(wc, s1)); wc = nc; ws = ns;
            }
        }
        fft_r2<16, INV>(ar, ai, z0);
#pragma unroll
        for (int r = 0; r < 16; ++r) { re[h + 2 * r] = ar[brev(r, 4)]; im[h + 2 * r] = ai[brev(r, 4)]; }
    }
    asm volatile("" ::: "memory"); __builtin_amdgcn_sched_barrier(0);
}
}

struct Frame {
    LAS unsigned char* lds;
    volatile LAS unsigned* MISC;
    gu32* ctl;
    int tid, lane, wave;
    int wave0;
    int vcu, G;
    float* out;
    unsigned char* ws;
};
constexpr int PTRTAB_OFF = LDSCTL_OFF + 512;
__device__ __forceinline__ const GAS float* inp(const Frame& F, int i) {
    const v2u w = *(const LAS v2u*)(F.lds + PTRTAB_OFF + 8 * i);
    const unsigned lo = __builtin_amdgcn_readfirstlane(w.x), hi = __builtin_amdgcn_readfirstlane(w.y);
    return (const GAS float*)(((unsigned long long)hi << 32) | lo);
}
__device__ __forceinline__ GAS unsigned char* wsq(const Frame& F) { unsigned char* p = F.ws; asm volatile("" : "+s"(p)); return (GAS unsigned char*)p; }
enum { I_XP = 0, I_XS, I_WIN, I_CONVW, I_CONVB, I_FW1, I_FB1, I_FW2, I_FB2, I_FW3, I_SINF, I_DECAY, I_HBIAS, I_QNORM, I_WUQ, I_KVNORM, I_WUKV, I_GNHY, I_GNAT, I_WOUT,
       I_NMIXPRE, I_NMIXPOST, I_NMLPPRE, I_NMLPPOST, I_WUP, I_WDOWN };

__device__ __forceinline__ int rope_src(int p) { return 4 * (p >> 3) + (p & 3) + 16 * ((p >> 2) & 1); }
template <bool ROPEPERM>
__device__ __forceinline__ void transpose_item(const GAS float* W, int K, int N, GAS bf16* WT, LAS float* scr, int item, int lane, int ldk = 0, int koff = 0) {
    if (ldk == 0) ldk = K;
    const int nblk = N / 32, kb = item / nblk, nb = item % nblk, k0 = 64 * kb, n0 = 32 * nb;
    int sc = lane & 31; if (ROPEPERM && (nb % 3) == 2) sc = rope_src(sc);
#pragma unroll 8
    for (int i = 0; i < 32; ++i) { const int kk = 2 * i + (lane >> 5); scr[kk * 33 + (lane & 31)] = W[(size_t)(k0 + kk) * N + n0 + sc]; }
    LDS_WAIT(); asm volatile("" ::: "memory");
    const int c = lane & 7;
#pragma unroll
    for (int j = 0; j < 4; ++j) { const int n = (lane >> 3) + 8 * j; const LAS float* s = scr + (8 * c) * 33 + n;
        v4u o; o.x = pk2(s[0 * 33], s[1 * 33]); o.y = pk2(s[2 * 33], s[3 * 33]); o.z = pk2(s[4 * 33], s[5 * 33]); o.w = pk2(s[6 * 33], s[7 * 33]);
        *(GAS v4u*)(WT + (size_t)(n0 + n) * ldk + koff + k0 + 8 * c) = o; }
    LDS_WAIT(); asm volatile("" ::: "memory");
}
__device__ __forceinline__ void phase_weights(Frame& F, int l) {
    LAS float* scr = (LAS float*)(F.lds + RING_OFF + F.wave * 16384);
    const int gw = F.vcu * NWAVES + F.wave, NGW = F.G * NWAVES;
    GAS bf16* WinT = (GAS bf16*)(wsq(F) + WS_WIN); GAS bf16* WoutT = (GAS bf16*)(wsq(F) + WS_WOUT); GAS bf16* WupT = (GAS bf16*)(wsq(F) + WS_WUP); GAS bf16* WdownT = (GAS bf16*)(wsq(F) + WS_WDOWN);
    GAS bf16* WuqT = (GAS bf16*)(wsq(F) + WS_WUQ); GAS bf16* WukvT = (GAS bf16*)(wsq(F) + WS_WUKV);
    constexpr int I_IN = (D / 64) * (INW / 32), I_OUT = (D / 64) * (D / 32), I_UP = (D / 64) * (FF / 32), I_DN = (FF / 64) * (D / 32), I_UQ = (QR / 64) * (NQ / 32), I_UKV = (KVR / 64) * (NKV / 32);
    constexpr int I_W3 = 2048 / 32;
    constexpr int NITEMS = I_IN + I_OUT + I_UP + I_DN + I_UQ + I_UKV + 2 * I_W3;
    for (int it = gw; it < NITEMS; it += NGW) {
        int r = it;
        if (r < I_IN) { transpose_item<false>(inp(F, I_WIN) + (size_t)l * D * INW, D, INW, WinT, scr, r, F.lane); continue; } r -= I_IN;
        if (r < I_OUT) { transpose_item<false>(inp(F, I_WOUT) + (size_t)l * D * D, D, D, WoutT, scr, r, F.lane); continue; } r -= I_OUT;
        if (r < I_UP) { transpose_item<false>(inp(F, I_WUP) + (size_t)l * D * FF, D, FF, WupT, scr, r, F.lane); continue; } r -= I_UP;
        if (r < I_DN) { transpose_item<false>(inp(F, I_WDOWN) + (size_t)l * FF * D, FF, D, WdownT, scr, r, F.lane); continue; } r -= I_DN;
        if (r < I_UQ) { transpose_item<true>(inp(F, I_WUQ) + (size_t)l * QR * NQ, QR, NQ, WuqT, scr, r, F.lane); continue; } r -= I_UQ;
        if (r < I_UKV) { transpose_item<false>(inp(F, I_WUKV) + (size_t)l * KVR * NKV, KVR, NKV, WukvT, scr, r, F.lane); continue; } r -= I_UKV;
        transpose_item<false>(inp(F, I_FW3) + (size_t)l * 64 * 2048, 64, 2048, (GAS bf16*)(wsq(F) + WS_W3T), scr, r % I_W3, F.lane, 128, (r / I_W3) * 64);
    }
    { unsigned z = 0u; asm volatile("" : "+v"(z)); const v4u zz = {z, z, z, z};
      for (int i = gw * 64 + F.lane; i < 12288; i += NGW * 64) ((GAS v4u*)(WinT + (size_t)INW * D))[i] = zz; }
}
__device__ __forceinline__ void phase_rope_tab(Frame& F) {
    const float inv[16] = {1.000000000e+00f, 5.623413324e-01f, 3.162277639e-01f, 1.778279394e-01f, 1.000000015e-01f, 5.623412877e-02f, 3.162277862e-02f, 1.778279431e-02f,
                           9.999999776e-03f, 5.623413250e-03f, 3.162277862e-03f, 1.778279431e-03f, 1.000000047e-03f, 5.623413017e-04f, 3.162277862e-04f, 1.778279402e-04f};
    GAS float* ct = (GAS float*)(wsq(F) + WS_COS); GAS float* st = (GAS float*)(wsq(F) + WS_SIN);
    for (int i = F.vcu * NTHR + F.tid; i < L * 16; i += F.G * NTHR) {
        const int t = i >> 4, j = i & 15; float iv = inv[0];
#pragma unroll
        for (int q = 1; q < 16; ++q) iv = (j == q) ? inv[q] : iv;
        const float ang = (float)t * iv; ct[i] = cosf(ang); st[i] = sinf(ang);
    }
}
__device__ __forceinline__ const GAS float* x_src_row(Frame& F, int l, int m) {
    if (l == 0) return (m < 2 * L) ? inp(F, I_XP) + (size_t)m * D : inp(F, I_XS) + (size_t)(m - 2 * L) * D;
    return (const GAS float*)F.out + (size_t)m * D;
}
__device__ __forceinline__ void store_xn_row(f32x4 (&v)[4], float rstd, const GAS float* g, GAS bf16* orow, int lane) {
    GAS v2u* o8 = (GAS v2u*)orow + lane;
#pragma unroll
    for (int j = 0; j < 4; ++j) { const f32x4 gg = ((const GAS f32x4*)g)[lane + 64 * j]; v2u w; w.x = pk2(v[j].x * rstd * gg.x, v[j].y * rstd * gg.y); w.y = pk2(v[j].z * rstd * gg.z, v[j].w * rstd * gg.w); o8[64 * j] = w; }
}
__device__ __forceinline__ float row_ss(const f32x4 (&v)[4]) { float s = 0.f;
#pragma unroll
    for (int j = 0; j < 4; ++j) s += (v[j].x * v[j].x + v[j].y * v[j].y) + (v[j].z * v[j].z + v[j].w * v[j].w);
    return wave_sum(s); }
__device__ __forceinline__ void phase_norm_first(Frame& F, int l, const GAS float* g) {
    const int gw = F.vcu * NWAVES + F.wave, NGW = F.G * NWAVES; GAS bf16* XN = (GAS bf16*)(wsq(F) + WS_XN);
    for (int m = gw; m < M; m += NGW) {
        const GAS f32x4* xr = (const GAS f32x4*)x_src_row(F, l, m) + F.lane; f32x4 v[4];
#pragma unroll
        for (int j = 0; j < 4; ++j) v[j] = xr[64 * j];
        const float rstd = 1.0f / sqrtf(row_ss(v) * (1.0f / D) + EPS);
        store_xn_row(v, rstd, g, XN + (size_t)m * D, F.lane);
    }
}
__device__ __forceinline__ void phase_norm_res(Frame& F, int lsrc, const GAS bf16* T, const GAS float* gpost, const GAS float* gnext) {
    const int gw = F.vcu * NWAVES + F.wave, NGW = F.G * NWAVES; GAS bf16* XN = (GAS bf16*)(wsq(F) + WS_XN);
    for (int m0 = gw; m0 < M; m0 += 2 * NGW) {
        f32x4 v[2][4], tv[2][4];
#pragma unroll
        for (int q = 0; q < 2; ++q) { const int m = m0 + q * NGW; const GAS f32x4* xr = (const GAS f32x4*)x_src_row(F, lsrc, m) + F.lane; const GAS v2u* tr = (const GAS v2u*)(T + (size_t)m * D) + F.lane;
#pragma unroll
            for (int j = 0; j < 4; ++j) { v[q][j] = xr[64 * j]; const v2u w = tr[64 * j]; tv[q][j] = (f32x4){bf2f(w.x & 0xffffu), bf2f(w.x >> 16), bf2f(w.y & 0xffffu), bf2f(w.y >> 16)}; } }
#pragma unroll
        for (int q = 0; q < 2; ++q) { const int m = m0 + q * NGW;
            const float rt = 1.0f / sqrtf(row_ss(tv[q]) * (1.0f / D) + EPS);
            GAS f32x4* orow = (GAS f32x4*)(F.out + (size_t)m * D) + F.lane;
#pragma unroll
            for (int j = 0; j < 4; ++j) { const f32x4 gg = ((const GAS f32x4*)gpost)[F.lane + 64 * j]; v[q][j] = v[q][j] + tv[q][j] * rt * gg; orow[64 * j] = v[q][j]; }
            if (gnext) { const float rstd = 1.0f / sqrtf(row_ss(v[q]) * (1.0f / D) + EPS); store_xn_row(v[q], rstd, gnext, XN + (size_t)m * D, F.lane); } }
    }
}

__device__ __forceinline__ void phase_filter_mlp(Frame& F, int l) {
    const GAS float* w1 = inp(F, I_FW1) + (size_t)l * 33 * 64; const GAS float* b1 = inp(F, I_FB1) + l * 64; const GAS float* w2 = inp(F, I_FW2) + (size_t)l * 64 * 64; const GAS float* b2 = inp(F, I_FB2) + l * 64;
    const GAS float* sf = inp(F, I_SINF) + l * 128; GAS bf16* H2 = (GAS bf16*)(wsq(F) + WS_H2);
    const int lane = F.lane, gw = F.vcu * NWAVES + F.wave, NGW = F.G * NWAVES;
    float w1c[33], w2c[64];
#pragma unroll
    for (int f = 0; f < 33; ++f) w1c[f] = w1[f * 64 + lane];
#pragma unroll
    for (int i = 0; i < 64; ++i) w2c[i] = w2[i * 64 + lane];
    const float b1l = b1[lane], b2l = b2[lane], sf0 = sf[lane], sf1 = sf[64 + lane];
    for (int n = gw; n < L; n += NGW) {
        const float tn = (float)n * (1.0f / (float)(L - 1)); const float omega = (float)(2.0 * 3.14159265358979323846 / L) * (float)n;
        const int bidx = (lane >= 17) ? lane - 17 : lane - 1; const float band = 1e-4f + (float)bidx * ((15.0f - 1e-4f) / 15.0f); const float ph = omega * band;
        const float zf = (lane == 0) ? tn : ((lane <= 16) ? cosf(ph) : -sinf(ph));
        float acc = b1l;
#pragma unroll
        for (int f = 0; f < 33; ++f) acc += __uint_as_float(__builtin_amdgcn_readlane(__float_as_uint(zf), f)) * w1c[f];
        const float h1 = sinf(sf0 * acc);
        float acc2 = b2l;
#pragma unroll
        for (int i = 0; i < 64; ++i) acc2 += __uint_as_float(__builtin_amdgcn_readlane(__float_as_uint(h1), i)) * w2c[i];
        const float hv = sinf(sf1 * acc2); const bf16 hi = f2bf(hv);
        H2[(size_t)n * 128 + lane] = hi; H2[(size_t)n * 128 + 64 + lane] = f2bf(hv - bf2f(hi));
    }
}

__device__ __forceinline__ void phase_filter_fft(Frame& F, int l) {
    const GAS float* KT = (const GAS float*)(wsq(F) + WS_KT); GAS f32x2* KEO = (GAS f32x2*)(wsq(F) + WS_KEO); const GAS float* hb = inp(F, I_HBIAS) + (size_t)l * 2 * HYW;
    LAS f32x2* buf = (LAS f32x2*)(F.lds + RING_OFF); const int t = F.tid;
    for (int item = F.vcu; item < 2 * HYW; item += F.G) {
        const int o = item >> 9, c = item & 511;
        const GAS float* fw = KT + (size_t)((o * 2 + 0) * HYW + c) * L; const GAS float* bw = KT + (size_t)((o * 2 + 1) * HYW + c) * L;
        const float bias = hb[o * HYW + c]; const float sc = 1.0f / (2.0f * L);
        GAS f32x2* ke = KEO + (size_t)item * KEO_BLK; GAS f32x2* ko = ke + KEO_KO;
        float ar[32], ai[32];
        { const int tq = hfft::opaque(t); (void)tq;
#pragma unroll
        for (int m = 0; m < 32; ++m) { const int n = tq + 512 * m; const float f = fw[n]; float b = bw[n >= 1 ? L - n : 0]; b = n >= 1 ? b : 0.f; ar[m] = f + b; ai[m] = 0.f; if ((m & 15) == 15) { asm volatile("" ::: "memory"); __builtin_amdgcn_sched_barrier(0); } }
        }
        hfft::fft16k<false>(ar, ai, buf, t);
        { const int tq = hfft::opaque(t); (void)tq;
#pragma unroll
        for (int m = 0; m <= 16; ++m) { const int k = tq + 512 * m; if (k <= 8192) ke[k] = (f32x2){(ar[m] + bias) * sc, ai[m] * sc}; }
        }
        { const int tq = hfft::opaque(t); (void)tq;
#pragma unroll
        for (int m = 0; m < 32; ++m) { const int n = tq + 512 * m; const float f = fw[n]; float b = bw[n >= 1 ? L - n : 0]; b = n >= 1 ? b : 0.f; const float d = f - b; const float fr = (float)n * (1.0f / 32768.0f);
            ar[m] = d * __builtin_amdgcn_cosf(fr); ai[m] = -d * __builtin_amdgcn_sinf(fr); if ((m & 15) == 15) { asm volatile("" ::: "memory"); __builtin_amdgcn_sched_barrier(0); } }
        }
        hfft::fft16k<false>(ar, ai, buf, t);
        { const int tq = hfft::opaque(t); (void)tq;
#pragma unroll
        for (int m = 0; m < 16; ++m) { const int k = tq + 512 * m; ko[k] = (f32x2){(ar[m] + bias) * sc, ai[m] * sc}; }
        }
    }
    __syncthreads();
}

__device__ __forceinline__ float u_conv3(const GAS bf16* row, int n, float w0, float w1, float w2, float cb) {
    const int nm = n >= 1 ? n - 1 : 0, np = n + 1 < L ? n + 1 : L - 1;
    float um = bf2f(row[nm]), up = bf2f(row[np]); const float u0 = bf2f(row[n]);
    um = n >= 1 ? um : 0.f; up = n + 1 < L ? up : 0.f;
    return um * w0 + u0 * w1 + up * w2 + cb;
}
__device__ __forceinline__ void cmul_spec(float (&xr)[32], float (&xi)[32], const GAS f32x2* ke, int t, bool odd) {
    { const int tq = hfft::opaque(t); (void)tq;
#pragma unroll
    for (int m = 0; m < 32; ++m) { const int k = tq + 512 * m; int idx; bool cj;
        if (!odd) { cj = k > 8192; idx = cj ? 16384 - k : k; } else { cj = k >= 8192; idx = cj ? 16383 - k : k; }
        const f32x2 kv = ke[idx]; const float kr = kv.x, ki = cj ? -kv.y : kv.y;
        const float a = xr[m], b = xi[m]; xr[m] = a * kr - b * ki; xi[m] = a * ki + b * kr; if ((m & 15) == 15) { asm volatile("" ::: "memory"); __builtin_amdgcn_sched_barrier(0); } }
    }
}
__device__ __forceinline__ void phase_hyena(Frame& F, int l) {
    const GAS bf16* UT = (const GAS bf16*)(wsq(F) + WS_UT); GAS bf16* YT = (GAS bf16*)(wsq(F) + WS_YT); const GAS f32x2* KEO = (const GAS f32x2*)(wsq(F) + WS_KEO);
    const GAS float* cw = inp(F, I_CONVW) + (size_t)l * 3 * HYP; const GAS float* cbv = inp(F, I_CONVB) + (size_t)l * HYP;
    LAS f32x2* buf = (LAS f32x2*)(F.lds + RING_OFF); const int t = F.tid;
    GAS f32x2* G0 = (GAS f32x2*)(wsq(F) + WS_G0) + (size_t)F.vcu * 16384 + t;
    GAS f32x2* G1 = (GAS f32x2*)(wsq(F) + (F.vcu < 200 ? WS_G1A + (size_t)F.vcu * 131072 : WS_G1B + (size_t)(F.vcu - 200) * 131072)) + t;
    for (int item = F.vcu; item < 2 * HYW; item += F.G) {
        const int c = item >> 1, pair = item & 1; const int b0 = pair ? 2 : 0;
        float ar[32], ai[32];
#pragma unroll 1
        for (int o = 0; o < 2; ++o) {
            const GAS f32x2* ke = KEO + (size_t)(o * HYW + c) * KEO_BLK; const GAS f32x2* ko = ke + KEO_KO;
#pragma unroll 1
            for (int half = 0; half < 2; ++half) {
                if (o == 0) { const int ch = c; const float w0 = cw[ch], w1 = cw[HYP + ch], w2 = cw[2 * HYP + ch], cb = cbv[ch];
                    const GAS bf16* r0 = UT + (size_t)ch * M + (size_t)b0 * L; const GAS bf16* r1 = pair ? r0 : r0 + L;
                    { const int tq = hfft::opaque(t); (void)tq;
#pragma unroll
                    for (int m = 0; m < 32; ++m) { const int n = tq + 512 * m; ar[m] = u_conv3(r0, n, w0, w1, w2, cb); { const float q1 = u_conv3(r1, n, w0, w1, w2, cb); ai[m] = pair ? 0.f : q1; } if ((m & 15) == 15) { asm volatile("" ::: "memory"); __builtin_amdgcn_sched_barrier(0); } } }
                    }
                else {
                    { const int tq = hfft::opaque(t); (void)tq; GAS f32x2* G0q = G0 + (tq - t);
#pragma unroll
                    for (int m = 0; m < 32; ++m) { const f32x2 v = G0q[m * 512]; ar[m] = v.x; ai[m] = v.y; if ((m & 15) == 15) { asm volatile("" ::: "memory"); __builtin_amdgcn_sched_barrier(0); } } }
                    }
                if (half == 0) {
                    hfft::fft16k<false>(ar, ai, buf, t);
                    cmul_spec(ar, ai, ke, t, false);
                    hfft::fft16k<true>(ar, ai, buf, t);
                    { const int tq = hfft::opaque(t); (void)tq; GAS f32x2* G1q = G1 + (tq - t);
#pragma unroll
                    for (int m = 0; m < 32; ++m) G1q[m * 512] = (f32x2){ar[m], ai[m]};
                    }
                } else {
                    { const int tq = hfft::opaque(t); (void)tq;
#pragma unroll
                    for (int m = 0; m < 32; ++m) { const float fr = (float)(tq + 512 * m) * (1.0f / 32768.0f); const float cs = __builtin_amdgcn_cosf(fr), sn = -__builtin_amdgcn_sinf(fr);
                        const float a = ar[m], b = ai[m]; ar[m] = a * cs - b * sn; ai[m] = a * sn + b * cs; }
                    }
                    hfft::fft16k<false>(ar, ai, buf, t);
                    cmul_spec(ar, ai, ko, t, true);
                    hfft::fft16k<true>(ar, ai, buf, t);
                    const int ch = (o + 1) * HYW + c; const float w0 = cw[ch], w1 = cw[HYP + ch], w2 = cw[2 * HYP + ch], cb = cbv[ch];
                    const GAS bf16* r0 = UT + (size_t)ch * M + (size_t)b0 * L; const GAS bf16* r1 = pair ? r0 : r0 + L;
                    { const int tq = hfft::opaque(t); (void)tq; GAS f32x2* G1q = G1 + (tq - t);
#pragma unroll
                    for (int m = 0; m < 32; ++m) { const int n = tq + 512 * m; const float fr = (float)n * (1.0f / 32768.0f); const float cs = __builtin_amdgcn_cosf(fr), sn = __builtin_amdgcn_sinf(fr);
                        const float a = ar[m], b = ai[m]; const f32x2 e = G1q[m * 512]; const float yr = e.x + (a * cs - b * sn), yi = e.y + (a * sn + b * cs);
                        ar[m] = yr * u_conv3(r0, n, w0, w1, w2, cb); { const float q1 = yi * u_conv3(r1, n, w0, w1, w2, cb); ai[m] = pair ? 0.f : q1; } if ((m & 15) == 15) { asm volatile("" ::: "memory"); __builtin_amdgcn_sched_barrier(0); } }
                    }
                    if (o == 0) {
                        { const int tq = hfft::opaque(t); (void)tq; GAS f32x2* G0q = G0 + (tq - t);
#pragma unroll
                        for (int m = 0; m < 32; ++m) G0q[m * 512] = (f32x2){ar[m], ai[m]};
                        }
                    } else { GAS bf16* y0 = YT + (size_t)c * M + (size_t)b0 * L; GAS bf16* y1 = y0 + L;
                        { const int tq = hfft::opaque(t); (void)tq;
#pragma unroll
                        for (int m = 0; m < 32; ++m) { const int n = tq + 512 * m; y0[n] = f2bf(ar[m]); if (!pair) y1[n] = f2bf(ai[m]); } }
                        }
                }
            }
        }
    }
    __syncthreads();
}

__device__ __forceinline__ void phase_mla_prep(Frame& F, int l) {
    const GAS bf16* CQKV = (const GAS bf16*)(wsq(F) + WS_CQKV); GAS bf16* CQN = (GAS bf16*)(wsq(F) + WS_CQN); GAS bf16* CKVN = (GAS bf16*)(wsq(F) + WS_CKVN); GAS bf16* KPE = (GAS bf16*)(wsq(F) + WS_KPE);
    const GAS float* gq = inp(F, I_QNORM) + l * QR; const GAS float* gkv = inp(F, I_KVNORM) + l * KVR; const GAS float* ct = (const GAS float*)(wsq(F) + WS_COS); const GAS float* st = (const GAS float*)(wsq(F) + WS_SIN);
    const int gw = F.vcu * NWAVES + F.wave, NGW = F.G * NWAVES, lane = F.lane;
    for (int m = gw; m < M; m += NGW) {
        const GAS bf16* row = CQKV + (size_t)m * 512;
        const v2u q = *(const GAS v2u*)(row + 4 * lane); const unsigned kv = *(const GAS unsigned*)(row + 256 + 2 * lane);
        const float q0 = bf2f(q.x & 0xffffu), q1 = bf2f(q.x >> 16), q2 = bf2f(q.y & 0xffffu), q3 = bf2f(q.y >> 16), k0 = bf2f(kv & 0xffffu), k1 = bf2f(kv >> 16);
        const float rq = 1.0f / sqrtf(wave_sum((q0 * q0 + q1 * q1) + (q2 * q2 + q3 * q3)) * (1.0f / QR) + EPS);
        const float rk = 1.0f / sqrtf(wave_sum(k0 * k0 + k1 * k1) * (1.0f / KVR) + EPS);
        const f32x4 g4 = *(const GAS f32x4*)(gq + 4 * lane); const f32x2 g2 = *(const GAS f32x2*)(gkv + 2 * lane);
        v2u oq; oq.x = pk2(q0 * rq * g4.x, q1 * rq * g4.y); oq.y = pk2(q2 * rq * g4.z, q3 * rq * g4.w);
        *(GAS v2u*)(CQN + (size_t)m * QR + 4 * lane) = oq;
        *(GAS unsigned*)(CKVN + (size_t)m * KVR + 2 * lane) = pk2(k0 * rk * g2.x, k1 * rk * g2.y);
        if (lane < 16) { const int j = lane, tpos = m & (L - 1); const float x1 = bf2f(row[384 + j]), x2 = bf2f(row[384 + 16 + j]); const float cs = ct[tpos * 16 + j], sn = st[tpos * 16 + j];
            const int p1 = 8 * (j >> 2) + (j & 3); KPE[(size_t)m * ROPE + p1] = f2bf(x1 * cs - x2 * sn); KPE[(size_t)m * ROPE + p1 + 4] = f2bf(x2 * cs + x1 * sn); }
    }
}

__device__ __forceinline__ void phase_hy_out(Frame& F, int l) {
    const GAS bf16* YT = (const GAS bf16*)(wsq(F) + WS_YT); GAS bf16* MIX = (GAS bf16*)(wsq(F) + WS_MIX); const GAS float* gn = inp(F, I_GNHY) + l * HYW;
    LAS bf16* tl = (LAS bf16*)(F.lds + RING_OFF + F.wave * 16384);
    const int gw = F.vcu * NWAVES + F.wave, NGW = F.G * NWAVES, lane = F.lane;
    for (int task = gw; task < 8 * (M / 64); task += NGW) {
        const int g = task & 7, tb = task >> 3, tok0 = tb * 64; const int cl = lane >> 3, t8 = (lane & 7) * 8;
        float v[8][8]; float ss[8];
#pragma unroll
        for (int j = 0; j < 8; ++j) ss[j] = 0.f;
#pragma unroll
        for (int i = 0; i < 8; ++i) { const int ch = g * 64 + 8 * i + cl; const v4u w = *(const GAS v4u*)(YT + (size_t)ch * M + tok0 + t8);
            v[i][0] = bf2f(w.x & 0xffffu); v[i][1] = bf2f(w.x >> 16); v[i][2] = bf2f(w.y & 0xffffu); v[i][3] = bf2f(w.y >> 16);
            v[i][4] = bf2f(w.z & 0xffffu); v[i][5] = bf2f(w.z >> 16); v[i][6] = bf2f(w.w & 0xffffu); v[i][7] = bf2f(w.w >> 16);
#pragma unroll
            for (int j = 0; j < 8; ++j) ss[j] += v[i][j] * v[i][j]; }
#pragma unroll
        for (int j = 0; j < 8; ++j) { float s = ss[j]; s += __shfl_xor(s, 8); s += __shfl_xor(s, 16); s += __shfl_xor(s, 32); ss[j] = 1.0f / sqrtf(s * (1.0f / 64.0f) + EPS); }
#pragma unroll
        for (int i = 0; i < 8; ++i) { const int cc = 8 * i + cl; const float gg = gn[g * 64 + cc];
#pragma unroll
            for (int j = 0; j < 8; ++j) tl[(t8 + j) * 72 + cc] = f2bf(v[i][j] * ss[j] * gg); }
        LDS_WAIT(); asm volatile("" ::: "memory");
#pragma unroll
        for (int i = 0; i < 8; ++i) { const int tok = 8 * i + (lane >> 3), c8 = (lane & 7) * 8; const v4u w = *(const LAS v4u*)(tl + tok * 72 + c8);
            *(GAS v4u*)(MIX + (size_t)(tok0 + tok) * D + g * 64 + c8) = w; }
        LDS_WAIT(); asm volatile("" ::: "memory");
    }
}

namespace att {
using s16x4 = __attribute__((ext_vector_type(4))) short;
using f32x16 = __attribute__((ext_vector_type(16))) float;
using u32x4 = __attribute__((ext_vector_type(4))) unsigned;
constexpr int QBLK = 32, KVBLK = 64, NW = 8;
constexpr float SCALE = 0.10206207261596575f;
constexpr float THR = 8.f;
constexpr int SHM_K = KVBLK * 256, SHM_V = KVBLK * DV * 2;
constexpr int NSLOT = 3;
constexpr int OFF_V = 0, OFF_K = NSLOT * SHM_V, OFF_WS = OFF_K + NSLOT * SHM_K, SHM_ATTN = OFF_WS + NW * 64 * 4;
#define KSWZ(row, colB) ((row) * 256 + ((colB) ^ (((row) & 15) << 4)))
#define SBAR() __builtin_amdgcn_sched_barrier(0)
__device__ __forceinline__ int crow(int r, int hi) { return (r & 3) + 8 * (r >> 2) + 4 * hi; }
__device__ __forceinline__ unsigned cvtpk(float lo, float hi) { unsigned r; asm volatile("v_cvt_pk_bf16_f32 %0, %1, %2" : "=v"(r) : "v"(lo), "v"(hi)); return r; }
constexpr float THRL = THR * 1.4426950408889634f;
#define EX2(v) __builtin_amdgcn_exp2f(v)
#define MX3(a, b, c) __builtin_fmaxf(__builtin_fmaxf((a), (b)), (c))
__device__ __forceinline__ int v_st(int k, int c) { const int kk = (k & ~0xC) | ((k & 4) << 1) | ((k & 8) >> 1); return ((kk >> 3) * 2 + (c >> 5)) * 512 + ((kk & 7) * 32 + (c & 31)) * 2; }
__device__ __forceinline__ int v_rd_base(int lane) { return ((lane & 3) << 3) | (((lane >> 2) & 3) << 6) | (((lane >> 4) & 1) << 5) | (((lane >> 5) & 1) << 8); }
constexpr int v_rd_off(int d0, int ks, int half) { return d0 * 512 + ks * 2048 + half * 1024; }
template <int OFF> __device__ __forceinline__ s16x4 tr_read(int vb) { s16x4 r; asm volatile("ds_read_b64_tr_b16 %0, %1 offset:%2" : "=&v"(r) : "v"(vb), "i"(OFF) : "memory"); return r; }
__device__ __forceinline__ void attn_unit(const bf16* Qb_, const bf16* KNh_, const bf16* KPEb_, const bf16* Vh_, bf16* Mo_,
                                          const float* gain_, const float* ct_, const float* st_, int tpos0, LAS char* lds, const int wave0) {
  const GAS bf16* Qb = (const GAS bf16*)Qb_; const GAS bf16* KNh = (const GAS bf16*)KNh_; const GAS bf16* KPEb = (const GAS bf16*)KPEb_; const GAS bf16* Vh = (const GAS bf16*)Vh_; GAS bf16* Mo = (GAS bf16*)Mo_;
  const GAS float* gain = (const GAS float*)gain_; const GAS float* ct = (const GAS float*)ct_; const GAS float* st = (const GAS float*)st_;

  int tid_ = tid_from_wave(wave0);
  const int tid = tid_, wid = tid >> 6, lane = tid & 63, r32 = lane & 31, hi = lane >> 5;
  LAS char* V_lds = lds + OFF_V; LAS char* K_lds = lds + OFF_K;
  LAS float* ws = (LAS float*)(lds + OFF_WS) + wid * 64; LAS float* li_l = ws; LAS float* al_l = ws + 32;
  float m_reg = 0.f, l_reg = 0.f; f32x16 o[2] = {}; f32x16 negm = {}; bf16x8 qr[6];
  const GAS bf16* Qw = Qb + (long)(wid * QBLK + r32) * NQ + hi * 8;
#pragma unroll
  for (int d0 = 0; d0 < 6; ++d0) qr[d0] = *reinterpret_cast<const GAS bf16x8*>(Qw + d0 * 16);
  { const int tq = tpos0 + wid * QBLK + r32;
#pragma unroll
    for (int d0 = 4; d0 < 6; ++d0) { const int fq = 2 * (d0 - 4) + hi; const f32x4 cs = *reinterpret_cast<const GAS f32x4*>(ct + tq * 16 + 4 * fq), sn = *reinterpret_cast<const GAS f32x4*>(st + tq * 16 + 4 * fq);
      const u32x4 w = __builtin_bit_cast(u32x4, qr[d0]);
      const f32x4 x1 = {bf2f(w[0] & 0xffffu), bf2f(w[0] >> 16), bf2f(w[1] & 0xffffu), bf2f(w[1] >> 16)}, x2 = {bf2f(w[2] & 0xffffu), bf2f(w[2] >> 16), bf2f(w[3] & 0xffffu), bf2f(w[3] >> 16)};
      const f32x4 a = x1 * cs - x2 * sn, b = x2 * cs + x1 * sn;
      const u32x4 o4 = {cvtpk(a[0], a[1]), cvtpk(a[2], a[3]), cvtpk(b[0], b[1]), cvtpk(b[2], b[3])}; qr[d0] = __builtin_bit_cast(bf16x8, o4); } }
  { constexpr float C = SCALE * 1.4426950408889634f;
#pragma unroll
    for (int d0 = 0; d0 < 6; ++d0) { const u32x4 w = __builtin_bit_cast(u32x4, qr[d0]); u32x4 o4;
#pragma unroll
      for (int e = 0; e < 4; ++e) o4[e] = cvtpk(bf2f(w[e] & 0xffffu) * C, bf2f(w[e] >> 16) * C);
      qr[d0] = __builtin_bit_cast(bf16x8, o4); } }
  const int sr = tid >> 3, sc = (tid & 7) * 8;
  const int rr_ = (tid & 255) >> 2, rc = (tid & 3) * 8;
  const int vst0 = v_st(sr, sc), kst0 = KSWZ(sr, sc * 2), kst1 = KSWZ(rr_, 128 + rc * 2);
  const int vb0 = (int)(unsigned)(uintptr_t)V_lds + v_rd_base(lane);
  struct { bf16x8 vs, kn, kr; } sr_[2];
#define SLOAD(i, k0) do { sr_[i].vs = *reinterpret_cast<const GAS bf16x8*>(&Vh[(long)((k0) + sr) * NKV + sc]); sr_[i].kn = *reinterpret_cast<const GAS bf16x8*>(&KNh[(long)((k0) + sr) * NKV + sc]); \
    sr_[i].kr = *reinterpret_cast<const GAS bf16x8*>(&KPEb[(long)((k0) + rr_) * ROPE + rc]); } while (0)
#define SWRITE(b, i) do { *(LAS bf16x8*)(V_lds + (b) * SHM_V + vst0) = sr_[i].vs; *(LAS bf16x8*)(K_lds + (b) * SHM_K + kst0) = sr_[i].kn; *(LAS bf16x8*)(K_lds + (b) * SHM_K + kst1) = sr_[i].kr; } while (0)
#define SWAIT() asm volatile("s_waitcnt vmcnt(3)" ::: "memory")
#define RESC(a) do { if (__any((a) < 1.f)) { if (hi == 0) al_l[r32] = (a); asm volatile("s_waitcnt lgkmcnt(0)" ::: "memory"); \
    _Pragma("unroll") for (int d = 0; d < 2; ++d) _Pragma("unroll") for (int r = 0; r < 16; ++r) o[d][r] *= al_l[crow(r, hi)]; } } while (0)
  f32x16 pA0, pA1, pB0, pB1; bf16x8 pa0, pa1, pa2, pa3; constexpr int NTL = L / KVBLK; constexpr int SE = 0, SO = 1;
  int koff[6];
#pragma unroll
  for (int d0 = 0; d0 < 6; ++d0) koff[d0] = KSWZ(r32, (d0 * 16 + hi * 8) * 2);
  s16x4 vl[4], vh[4]; float pmax = 0.f, alpha = 1.f;
#define KFR(i) (*(const LAS bf16x8*)(kbase + koff[(i) >> 1] + ((i) & 1) * 8192))
#define VRD8(D0) do { vl[0] = tr_read<v_rd_off(D0, 0, 0)>(vbq); vh[0] = tr_read<v_rd_off(D0, 0, 1)>(vbq); vl[1] = tr_read<v_rd_off(D0, 1, 0)>(vbq); vh[1] = tr_read<v_rd_off(D0, 1, 1)>(vbq); \
    vl[2] = tr_read<v_rd_off(D0, 2, 0)>(vbq); vh[2] = tr_read<v_rd_off(D0, 2, 1)>(vbq); vl[3] = tr_read<v_rd_off(D0, 3, 0)>(vbq); vh[3] = tr_read<v_rd_off(D0, 3, 1)>(vbq); } while (0)
#define VWAIT() asm volatile("s_waitcnt lgkmcnt(0)" : "+v"(vl[0]), "+v"(vh[0]), "+v"(vl[1]), "+v"(vh[1]), "+v"(vl[2]), "+v"(vh[2]), "+v"(vl[3]), "+v"(vh[3]) :: "memory")
#define VFR(k) (bf16x8){vl[k][0], vl[k][1], vl[k][2], vl[k][3], vh[k][0], vh[k][1], vh[k][2], vh[k][3]}
#define PKA(P, B) do { ca_ = cvtpk(P[B + 0], P[B + 1]); cb_ = cvtpk(P[B + 4], P[B + 5]); auto r_ = __builtin_amdgcn_permlane32_swap(ca_, cb_, false, false); w0_ = r_[0]; w2_ = r_[1]; } while (0)
#define PKB(P, B, OUT) do { ca_ = cvtpk(P[B + 2], P[B + 3]); cb_ = cvtpk(P[B + 6], P[B + 7]); auto r_ = __builtin_amdgcn_permlane32_swap(ca_, cb_, false, false); \
    const u32x4 w_ = {w0_, r_[0], w2_, r_[1]}; OUT = __builtin_bit_cast(bf16x8, w_); } while (0)
#define R1(DO_QK, DO_FIN, X0, X1, Y0, Y1, KSLOT) do { const LAS char* kbase = K_lds + (KSLOT) * SHM_K; bf16x8 kf0, kf1, kf2, kf3; unsigned ca_, cb_, w0_ = 0, w2_ = 0; \
    if (DO_QK) { kf0 = KFR(0); kf1 = KFR(1); kf2 = KFR(2); } SBAR(); \
      if (DO_QK) { kf3 = KFR(3); X0 = __builtin_amdgcn_mfma_f32_32x32x16_bf16(kf0, qr[0], negm, 0, 0, 0); } if (DO_FIN) { Y0[0] = EX2(Y0[0]); Y0[1] = EX2(Y0[1]); Y0[2] = EX2(Y0[2]); Y0[3] = EX2(Y0[3]); } SBAR(); \
      if (DO_QK) { kf0 = KFR(4); X1 = __builtin_amdgcn_mfma_f32_32x32x16_bf16(kf1, qr[0], negm, 0, 0, 0); } if (DO_FIN) { Y0[4] = EX2(Y0[4]); Y0[5] = EX2(Y0[5]); Y0[6] = EX2(Y0[6]); Y0[7] = EX2(Y0[7]); } SBAR(); \
      if (DO_QK) { kf1 = KFR(5); X0 = __builtin_amdgcn_mfma_f32_32x32x16_bf16(kf2, qr[1], X0, 0, 0, 0); } if (DO_FIN) { Y0[8] = EX2(Y0[8]); Y0[9] = EX2(Y0[9]); Y0[10] = EX2(Y0[10]); Y0[11] = EX2(Y0[11]); } SBAR(); \
      if (DO_QK) { kf2 = KFR(6); X1 = __builtin_amdgcn_mfma_f32_32x32x16_bf16(kf3, qr[1], X1, 0, 0, 0); } if (DO_FIN) { Y0[12] = EX2(Y0[12]); Y0[13] = EX2(Y0[13]); Y0[14] = EX2(Y0[14]); Y0[15] = EX2(Y0[15]); } SBAR(); \
      if (DO_QK) { kf3 = KFR(7); X0 = __builtin_amdgcn_mfma_f32_32x32x16_bf16(kf0, qr[2], X0, 0, 0, 0); } if (DO_FIN) { Y1[0] = EX2(Y1[0]); Y1[1] = EX2(Y1[1]); Y1[2] = EX2(Y1[2]); Y1[3] = EX2(Y1[3]); PKA(Y0, 0); } SBAR(); \
      if (DO_QK) { kf0 = KFR(8); X1 = __builtin_amdgcn_mfma_f32_32x32x16_bf16(kf1, qr[2], X1, 0, 0, 0); } if (DO_FIN) { Y1[4] = EX2(Y1[4]); Y1[5] = EX2(Y1[5]); Y1[6] = EX2(Y1[6]); Y1[7] = EX2(Y1[7]); PKB(Y0, 0, pa0); } SBAR(); \
      if (DO_QK) { kf1 = KFR(9); X0 = __builtin_amdgcn_mfma_f32_32x32x16_bf16(kf2, qr[3], X0, 0, 0, 0); } if (DO_FIN) { Y1[8] = EX2(Y1[8]); Y1[9] = EX2(Y1[9]); Y1[10] = EX2(Y1[10]); Y1[11] = EX2(Y1[11]); PKA(Y0, 8); } SBAR(); \
      if (DO_QK) { kf2 = KFR(10); X1 = __builtin_amdgcn_mfma_f32_32x32x16_bf16(kf3, qr[3], X1, 0, 0, 0); } if (DO_FIN) { Y1[12] = EX2(Y1[12]); Y1[13] = EX2(Y1[13]); Y1[14] = EX2(Y1[14]); Y1[15] = EX2(Y1[15]); PKB(Y0, 8, pa1); } SBAR(); \
      if (DO_QK) { kf3 = KFR(11); X0 = __builtin_amdgcn_mfma_f32_32x32x16_bf16(kf0, qr[4], X0, 0, 0, 0); } if (DO_FIN) { PKA(Y1, 0); } SBAR(); \
      if (DO_QK) { X1 = __builtin_amdgcn_mfma_f32_32x32x16_bf16(kf1, qr[4], X1, 0, 0, 0); } if (DO_FIN) { PKB(Y1, 0, pa2); } SBAR(); \
      if (DO_QK) { X0 = __builtin_amdgcn_mfma_f32_32x32x16_bf16(kf2, qr[5], X0, 0, 0, 0); } if (DO_FIN) { PKA(Y1, 8); } SBAR(); \
      if (DO_QK) { X1 = __builtin_amdgcn_mfma_f32_32x32x16_bf16(kf3, qr[5], X1, 0, 0, 0); } if (DO_FIN) { PKB(Y1, 8, pa3); } SBAR(); \
  } while (0)
#define R2(DO_PV, DO_MAX, X0, X1, Y0, Y1, VSLOT, LOADS) do { const int vbq = vb0 + (VSLOT) * SHM_V; float ma_ = 0.f, mb_ = 0.f, sa_ = 0.f; \
    if (DO_PV) { VRD8(0); } SBAR(); \
    if (DO_PV) { VWAIT(); o[0] = __builtin_amdgcn_mfma_f32_32x32x16_bf16(pa0, VFR(0), o[0], 0, 0, 0); sa_ = (Y0[0] + Y0[1]) + (Y0[2] + Y0[3]); } SBAR(); \
    if (DO_PV) { o[0] = __builtin_amdgcn_mfma_f32_32x32x16_bf16(pa1, VFR(1), o[0], 0, 0, 0); sa_ += Y0[4]; sa_ += Y0[5]; sa_ += Y0[6]; sa_ += Y0[7]; } LOADS; SBAR(); \
    if (DO_PV) { o[0] = __builtin_amdgcn_mfma_f32_32x32x16_bf16(pa2, VFR(2), o[0], 0, 0, 0); sa_ += Y0[8]; sa_ += Y0[9]; sa_ += Y0[10]; sa_ += Y0[11]; } SBAR(); \
    if (DO_PV) { o[0] = __builtin_amdgcn_mfma_f32_32x32x16_bf16(pa3, VFR(3), o[0], 0, 0, 0); sa_ += Y0[12]; sa_ += Y0[13]; sa_ += Y0[14]; sa_ += Y0[15]; } SBAR(); \
    if (DO_PV) { VRD8(1); sa_ += Y1[0]; sa_ += Y1[1]; sa_ += Y1[2]; sa_ += Y1[3]; sa_ += Y1[4]; sa_ += Y1[5]; sa_ += Y1[6]; sa_ += Y1[7]; } \
    if (DO_MAX) { ma_ = MX3(X0[0], X0[1], X1[0]); mb_ = MX3(X0[2], X0[3], X1[1]); ma_ = MX3(ma_, X1[2], X1[3]); ma_ = MX3(ma_, X0[4], X0[5]); mb_ = MX3(mb_, X0[6], X0[7]); ma_ = MX3(ma_, X1[4], X1[5]); mb_ = MX3(mb_, X1[6], X1[7]); } SBAR(); \
    if (DO_PV) { VWAIT(); o[1] = __builtin_amdgcn_mfma_f32_32x32x16_bf16(pa0, VFR(0), o[1], 0, 0, 0); sa_ += Y1[8]; sa_ += Y1[9]; sa_ += Y1[10]; sa_ += Y1[11]; } if (DO_MAX) { ma_ = MX3(ma_, X0[8], X0[9]); mb_ = MX3(mb_, X0[10], X0[11]); } SBAR(); \
    if (DO_PV) { o[1] = __builtin_amdgcn_mfma_f32_32x32x16_bf16(pa1, VFR(1), o[1], 0, 0, 0); sa_ += Y1[12]; sa_ += Y1[13]; sa_ += Y1[14]; sa_ += Y1[15]; } if (DO_MAX) { ma_ = MX3(ma_, X1[8], X1[9]); mb_ = MX3(mb_, X1[10], X1[11]); } SBAR(); \
    if (DO_PV) { o[1] = __builtin_amdgcn_mfma_f32_32x32x16_bf16(pa2, VFR(2), o[1], 0, 0, 0); l_reg += sa_; } if (DO_MAX) { ma_ = MX3(ma_, X0[12], X0[13]); mb_ = MX3(mb_, X0[14], X0[15]); ma_ = MX3(ma_, X1[12], X1[13]); mb_ = MX3(mb_, X1[14], X1[15]); } SBAR(); \
    if (DO_PV) { o[1] = __builtin_amdgcn_mfma_f32_32x32x16_bf16(pa3, VFR(3), o[1], 0, 0, 0); } if (DO_MAX) { float m_ = __builtin_fmaxf(ma_, mb_); auto rr_ = __builtin_amdgcn_permlane32_swap(__float_as_uint(m_), __float_as_uint(m_), false, false); pmax = __builtin_fmaxf(__uint_as_float(rr_[0]), __uint_as_float(rr_[1])); } SBAR(); \
  } while (0)
#define DECIDE(FIRST, X0, X1) do { alpha = 1.f; \
    if ((FIRST) || !__builtin_expect(__all(pmax <= THRL), 1)) { const float d_ = (FIRST) ? pmax : __builtin_fmaxf(pmax, 0.f); m_reg += d_; if (!(FIRST)) alpha = EX2(-d_); \
      _Pragma("unroll") for (int r = 0; r < 16; ++r) { X0[r] -= d_; X1[r] -= d_; } \
      _Pragma("unroll") for (int r = 0; r < 16; ++r) negm[r] = -m_reg; l_reg *= alpha; } \
    RESC(alpha); } while (0)
  int sp_ = 0, sc_ = 0, sn_ = 1;
#define ROT() do { sp_ = sc_; sc_ = sn_; sn_ = (sn_ == NSLOT - 1) ? 0 : sn_ + 1; } while (0)
  SLOAD(SE, 0); asm volatile("s_waitcnt vmcnt(0)" ::: "memory"); SWRITE(0, SE); __syncthreads();
  R1(true, false, pA0, pA1, pB0, pB1, 0);
  R2(false, true, pA0, pA1, pB0, pB1, 0, (void)0);
  DECIDE(true, pA0, pA1);
  SLOAD(SO, KVBLK); SLOAD(SE, 2 * KVBLK);
  SWAIT(); SWRITE(1, SO); __syncthreads();
  ROT();
  for (int j = 1; j + 1 < NTL; j += 2) {
    R1(true, true, pB0, pB1, pA0, pA1, sc_);
    R2(true, true, pB0, pB1, pA0, pA1, sp_, SLOAD(SO, (j + 2) * KVBLK));
    DECIDE(false, pB0, pB1);
    SWAIT(); SWRITE(sn_, SE);
    __syncthreads(); ROT();
    R1(true, true, pA0, pA1, pB0, pB1, sc_);
    R2(true, true, pA0, pA1, pB0, pB1, sp_, if (j + 3 < NTL) SLOAD(SE, (j + 3) * KVBLK));
    DECIDE(false, pA0, pA1);
    SWAIT(); SWRITE(sn_, SO);
    __syncthreads(); ROT();
  }
  R1(true, true, pB0, pB1, pA0, pA1, sc_);
  R2(true, true, pB0, pB1, pA0, pA1, sp_, (void)0);
  DECIDE(false, pB0, pB1);
  R1(false, true, pA0, pA1, pB0, pB1, sc_);
  R2(true, false, pA0, pA1, pB0, pB1, sc_, (void)0);
#undef ROT
#undef DECIDE
#undef R2
#undef R1
#undef PKA
#undef PKB
#undef VFR
#undef VWAIT
#undef VRD8
#undef KFR
  { auto rr = __builtin_amdgcn_permlane32_swap(__float_as_uint(l_reg), __float_as_uint(l_reg), false, false); l_reg = __uint_as_float(rr[0]) + __uint_as_float(rr[1]); }
  if (hi == 0) li_l[r32] = l_reg; asm volatile("s_waitcnt lgkmcnt(0)" ::: "memory");
  const float g0 = gain[r32], g1 = gain[32 + r32];
  GAS bf16* Ow = Mo + (long)(wid * QBLK) * D;
#pragma unroll
  for (int r = 0; r < 16; ++r) { const int orow = crow(r, hi); const float rl = __builtin_amdgcn_rcpf(li_l[orow]);
    const float y0 = o[0][r] * rl, y1 = o[1][r] * rl; float s = y0 * y0 + y1 * y1;
    s += __shfl_xor(s, 1); s += __shfl_xor(s, 2); s += __shfl_xor(s, 4); s += __shfl_xor(s, 8); s += __shfl_xor(s, 16);
    const float rs = 1.0f / sqrtf(s * (1.0f / 64.0f) + EPS);
    Ow[(long)orow * D + r32] = f2bf(y0 * rs * g0); Ow[(long)orow * D + 32 + r32] = f2bf(y1 * rs * g1); }
  __syncthreads();
#undef SLOAD
#undef SWRITE
#undef SWAIT
#undef RESC
}
#undef EX2
#undef MX3
#undef KSWZ
#undef SBAR
}
#define XB_TMO      128
#define XB_XCNT(j)  (256  + 64 * (j))
#define XB_XSUB(j)  (1280 + 64 * (j))
#define XB_XGEN(j)  (2304 + 64 * (j))
#define XB_TOP      3328
#define XB_TOPGEN   3392
#define XCD_BAR_WORDS 3456
#define XB_SPIN_CAP (1u << 18)

__device__ __forceinline__ unsigned xb_ld(unsigned* p)              { return __hip_atomic_load(p, __ATOMIC_RELAXED, __HIP_MEMORY_SCOPE_AGENT); }
__device__ __forceinline__ unsigned xb_add(unsigned* p, unsigned v) { return __hip_atomic_fetch_add(p, v, __ATOMIC_RELAXED, __HIP_MEMORY_SCOPE_AGENT); }
__device__ __forceinline__ unsigned xb_xcc_id() { return (unsigned)__builtin_amdgcn_s_getreg((3 << 11) | 20) & 0xFu; }
#define XB_SPIN(cond, bar) do { unsigned _sp = 0; while (cond) { __builtin_amdgcn_s_sleep(1); \
    if ((++_sp & 255u) == 0u) { if (xb_ld(&(bar)[XB_TMO])) break; if (_sp > XB_SPIN_CAP) { atomicAdd(&(bar)[XB_TMO], 1u); break; } } } } while (0)

struct XcdBarrier {
    unsigned* bar; unsigned x;
    volatile LAS unsigned* st;
};

__device__ __forceinline__ XcdBarrier xcd_barrier_post(unsigned* bar, volatile LAS unsigned* st, const bool t0) {
    XcdBarrier b; b.bar = bar; b.x = xb_xcc_id(); b.st = st;
    if (t0) (void)xb_add(&bar[XB_XCNT(b.x)], 1u);
    return b;
}
__device__ __forceinline__ void xcd_barrier_complete(unsigned* bar, unsigned x, unsigned& nloc, unsigned& nx) {
    const unsigned G = gridDim.x * gridDim.y * gridDim.z;
    unsigned sum, cnt, mine, sp = 0u;
    for (;;) {
        sum = 0u; cnt = 0u; mine = 0u;
#pragma unroll
        for (unsigned j = 0; j < 16; ++j) { const unsigned c = xb_ld(&bar[XB_XCNT(j)]); sum += c; cnt += (c > 0u) ? 1u : 0u; mine = (j == x) ? c : mine; }
        if (sum == G) break;
        __builtin_amdgcn_s_sleep(1);
        if ((++sp & 255u) == 0u) { if (xb_ld(&bar[XB_TMO])) break; if (sp > XB_SPIN_CAP) { atomicAdd(&bar[XB_TMO], 1u); break; } }
    }
    nloc = mine > 0u ? mine : 1u; nx = cnt > 0u ? cnt : 1u;
}

__device__ __forceinline__ void xcd_barrier(const XcdBarrier& b, const bool t0) {
    asm volatile("s_waitcnt vmcnt(0)" ::: "memory");
    __syncthreads();
    if (t0) {
        unsigned* bar = b.bar;
        __builtin_amdgcn_s_waitcnt(0);
        unsigned nloc = b.st[0], nx = b.st[1];
        if (nloc == 0u) { xcd_barrier_complete(bar, b.x, nloc, nx); b.st[0] = nloc; b.st[1] = nx; }
        const unsigned old = xb_add(&bar[XB_XSUB(b.x)], 1u);
        const unsigned gen = old / nloc;
        if (old + 1u == (gen + 1u) * nloc) {
            __builtin_amdgcn_fence(__ATOMIC_RELEASE, "agent");
            asm volatile("s_waitcnt vmcnt(0)" ::: "memory");
            const unsigned og = xb_add(&bar[XB_TOP], 1u);
            const unsigned tg = og / nx;
            if (og + 1u == (tg + 1u) * nx) xb_add(&bar[XB_TOPGEN], 1u);
            else XB_SPIN(xb_ld(&bar[XB_TOPGEN]) == tg, bar);
            __builtin_amdgcn_fence(__ATOMIC_ACQUIRE, "agent");
            xb_add(&bar[XB_XGEN(b.x)], 1u);
            asm volatile("s_waitcnt vmcnt(0)" ::: "memory");
        } else {
            XB_SPIN(xb_ld(&bar[XB_XGEN(b.x)]) == gen, bar);
            __builtin_amdgcn_fence(__ATOMIC_ACQUIRE, "agent");
            asm volatile("s_waitcnt vmcnt(0)" ::: "memory");
        }
    }
    __syncthreads();
}

__device__ __forceinline__ void xcd_barrier_fast(const XcdBarrier& b, const bool t0) {
    asm volatile("s_waitcnt vmcnt(0)" ::: "memory");
    __syncthreads();
    if (t0) {
        unsigned* bar = b.bar; asm volatile("" : "+s"(bar));
        __builtin_amdgcn_s_waitcnt(0);
        unsigned nloc = b.st[0], nx = b.st[1];
        unsigned bx_ = b.x; asm volatile("" : "+s"(bx_));
        const unsigned old = xb_add(&bar[XB_XSUB(bx_)], 1u);
        const unsigned gen = old / nloc;
        if (old + 1u == (gen + 1u) * nloc) {
            __builtin_amdgcn_fence(__ATOMIC_RELEASE, "agent");
            asm volatile("s_waitcnt vmcnt(0)" ::: "memory");
            const unsigned og = xb_add(&bar[XB_TOP], 1u);
            const unsigned tg = og / nx;
            if (og + 1u == (tg + 1u) * nx) xb_add(&bar[XB_TOPGEN], 1u);
            else XB_SPIN(xb_ld(&bar[XB_TOPGEN]) == tg, bar);
            __builtin_amdgcn_fence(__ATOMIC_ACQUIRE, "agent");
            xb_add(&bar[XB_XGEN(bx_)], 1u);
            asm volatile("s_waitcnt vmcnt(0)" ::: "memory");
        } else {
            XB_SPIN(xb_ld(&bar[XB_XGEN(bx_)]) == gen, bar);
            __builtin_amdgcn_fence(__ATOMIC_ACQUIRE, "agent");
            asm volatile("s_waitcnt vmcnt(0)" ::: "memory");
        }
    }
    __syncthreads();
}

constexpr int CW_BAR = 4096;
struct Args { const float* in[26]; float* out; unsigned char* ws; };
#ifndef REP_ATT
#define REP_ATT 1
#endif
#ifndef REP_GEMM
#define REP_GEMM 1
#endif
#ifndef REP_HY
#define REP_HY 1
#endif
#ifndef REP_FILT
#define REP_FILT 1
#endif
#ifndef REP_MISC
#define REP_MISC 1
#endif
#ifndef PROBE_MASK
#define PROBE_MASK 0
#endif
#define TIC() do { if (PROBE_MASK) pr_t0 = __builtin_amdgcn_s_memrealtime(); } while (0)
#define TOC(ph) do { if (PROBE_MASK & (1u << (ph))) pr_acc += __builtin_amdgcn_s_memrealtime() - pr_t0; } while (0)
#define REPEAT(n) _Pragma("unroll 1") for (int rep_ = 0; rep_ < (n); ++rep_)
#define REFRESH() do { const int t_ = tid_from_wave(F.wave0); F.tid = t_; F.lane = t_ & 63; F.wave = __builtin_amdgcn_readfirstlane(t_ >> 6); int v_ = F.vcu; asm volatile("" : "+s"(v_)); F.vcu = v_; } while (0)
#define BXQ() ({ int b_ = (int)blockIdx.x; asm volatile("" : "+s"(b_)); b_; })
#define GEMM_PHASE(EPI, g, S, E) REPEAT(REP_GEMM) pg8::gemm_phase<EPI, pg8::StaticOrder, true, true>(F.lds + RING_OFF, g, S, E, F.wave0)

__global__ void __launch_bounds__(NTHR, 2) hyena_mla_fwd(Args args) {
    extern __shared__ __attribute__((aligned(16))) unsigned char lds[];
    Frame F;
    F.lds = (LAS unsigned char*)lds;
    F.MISC = (volatile LAS unsigned*)(F.lds + MISC_OFF);
    F.tid = threadIdx.x; F.lane = F.tid & 63; F.wave = __builtin_amdgcn_readfirstlane(F.tid >> 6); F.wave0 = F.wave;
    F.G = gridDim.x; { const int bx = blockIdx.x; F.vcu = (F.G % 8 == 0) ? (bx % 8) * (F.G / 8) + bx / 8 : bx; }
    F.ws = args.ws; F.out = args.out; F.ctl = (gu32*)(args.ws + WS_CTL);
    if (F.tid == 0) {
#pragma unroll
        for (int i = 0; i < 26; ++i) *(LAS unsigned long long*)(F.lds + PTRTAB_OFF + 8 * i) = (unsigned long long)args.in[i];
    }
    for (int u = F.tid; u < 512 / 4; u += NTHR) ((LAS unsigned*)(F.lds + LDSCTL_OFF))[u] = 0u;
    __syncthreads();
    XcdBarrier bar = xcd_barrier_post((unsigned*)(F.ctl + CW_BAR), F.MISC + 8, F.tid == 0);
    xcd_barrier(bar, F.tid == 0);
    unsigned long long pr_t0 = 0, pr_acc = 0; (void)pr_t0;
#pragma unroll 1
    for (int l = 0; l < DEPTH; ++l) {
        TIC();
        REPEAT(REP_MISC) { REFRESH(); phase_weights(F, l); }
        __syncthreads();
        REFRESH(); phase_filter_mlp(F, l);
        if (l == 0) { REFRESH(); phase_rope_tab(F); REFRESH(); phase_norm_first(F, 0, inp(F, I_NMIXPRE)); }
        { REFRESH(); xcd_barrier_fast(bar, F.tid == 0); } TOC(0); TIC();
        { unsigned char* w = (unsigned char*)wsq(F); pg8::Gemm g{(bf16*)(w + WS_W3T), (bf16*)(w + WS_H2), 2048, L, 128}; pg8::StaticOrder S; S.init(2048, L, F.G, BXQ());
          pg8::EpiTaps E{(float*)(w + WS_KT), (const float*)inp(F, I_DECAY) + (size_t)l * 2048}; GEMM_PHASE(pg8::EpiTaps, g, S, E); }
        { REFRESH(); xcd_barrier_fast(bar, F.tid == 0); } TOC(1); TIC();
        REPEAT(REP_FILT) { REFRESH(); phase_filter_fft(F, l); }
        { REFRESH(); xcd_barrier_fast(bar, F.tid == 0); } TOC(2); TIC();
        { unsigned char* w = (unsigned char*)wsq(F); bf16* WinT = (bf16*)(w + WS_WIN); bf16* XN = (bf16*)(w + WS_XN); bf16* UT = (bf16*)(w + WS_UT); bf16* CQKV = (bf16*)(w + WS_CQKV);
          { pg8::Gemm g{WinT, XN, HYP, M, D}; pg8::StaticOrder S; S.init(HYP, M, F.G, BXQ());
          pg8::EpiBf16<0> E{UT, M, nullptr, 0, 0, 1.f}; GEMM_PHASE(pg8::EpiBf16<0>, g, S, E); }
        { pg8::Gemm g{XN, WinT + (size_t)HYP * D, M, 512, D}; pg8::StaticOrder S; S.init(M, 512, F.G, (BXQ() + 128) % F.G);
          pg8::EpiBf16<0> E{CQKV, 512, nullptr, 0, 0, 1.f}; GEMM_PHASE(pg8::EpiBf16<0>, g, S, E); } }
        { REFRESH(); xcd_barrier_fast(bar, F.tid == 0); } TOC(3); TIC();
        REPEAT(REP_MISC) { REFRESH(); phase_mla_prep(F, l); }
        REPEAT(REP_HY) { REFRESH(); phase_hyena(F, l); }
        { REFRESH(); xcd_barrier_fast(bar, F.tid == 0); } TOC(4); TIC();
        { unsigned char* w = (unsigned char*)wsq(F); bf16* CQN = (bf16*)(w + WS_CQN); bf16* CKVN = (bf16*)(w + WS_CKVN); bf16* WuqT = (bf16*)(w + WS_WUQ); bf16* WukvT = (bf16*)(w + WS_WUKV);
          bf16* Qb = (bf16*)(w + WS_Q); bf16* KV = (bf16*)(w + WS_KN);
          { pg8::Gemm g{CQN, WuqT, M, NQ, QR}; pg8::StaticOrder S; S.init(M, NQ, F.G, BXQ());
          pg8::EpiBf16<0> E{Qb, NQ, nullptr, 0, 0, 1.f}; GEMM_PHASE(pg8::EpiBf16<0>, g, S, E); }
        { pg8::Gemm g{CKVN, WukvT, M, NKV, KVR}; pg8::StaticOrder S; S.init(M, NKV, F.G, BXQ());
          pg8::EpiBf16<0> E{KV, NKV, nullptr, 0, 0, 1.f}; GEMM_PHASE(pg8::EpiBf16<0>, g, S, E); } }
        { REFRESH(); xcd_barrier_fast(bar, F.tid == 0); } TOC(5); TIC();
        REFRESH();
        { unsigned char* w = (unsigned char*)wsq(F); bf16* Qb = (bf16*)(w + WS_Q); bf16* KV = (bf16*)(w + WS_KN); bf16* KPE = (bf16*)(w + WS_KPE); bf16* MIX = (bf16*)(w + WS_MIX);
          const float* ct = (const float*)(w + WS_COS); const float* st = (const float*)(w + WS_SIN); const float* gat = (const float*)inp(F, I_GNAT) + l * 512;
        REPEAT(REP_ATT) for (int i = 0; i < 6; ++i) {
            const int bh = 3 * (F.vcu >> 5) + (i >> 1), qb = (i & 1) * 32 + (F.vcu & 31); const int b = bh >> 3, h = bh & 7;
            const size_t row0 = (size_t)b * L + (size_t)qb * 256;
            att::attn_unit(Qb + row0 * NQ + h * DQ, KV + (size_t)b * L * NKV + h * 128, KPE + (size_t)b * L * ROPE, KV + (size_t)b * L * NKV + h * 128 + 64,
                           MIX + row0 * D + 512 + h * 64, gat + h * 64, ct, st, qb * 256, (LAS char*)(F.lds + RING_OFF), F.wave0);
        } }
        REPEAT(REP_MISC) { REFRESH(); phase_hy_out(F, l); }
        { REFRESH(); xcd_barrier_fast(bar, F.tid == 0); } TOC(6); TIC();
        { unsigned char* w = (unsigned char*)wsq(F); bf16* MIX = (bf16*)(w + WS_MIX); bf16* WoutT = (bf16*)(w + WS_WOUT); bf16* T = (bf16*)(w + WS_T);
          pg8::Gemm g{MIX, WoutT, M, D, D}; pg8::StaticOrder S; S.init(M, D, F.G, BXQ());
          pg8::EpiBf16<0> E{T, D, nullptr, 0, 0, 1.f}; GEMM_PHASE(pg8::EpiBf16<0>, g, S, E); }
        { REFRESH(); xcd_barrier_fast(bar, F.tid == 0); } TOC(7); TIC();
        REFRESH(); phase_norm_res(F, l, (const GAS bf16*)(wsq(F) + WS_T), inp(F, I_NMIXPOST) + l * D, inp(F, I_NMLPPRE) + l * D);
        { REFRESH(); xcd_barrier_fast(bar, F.tid == 0); } TOC(8); TIC();
#pragma unroll 1
        for (int ch = 0; ch < N_MLP_CHUNKS; ++ch) {
            { unsigned char* w = (unsigned char*)wsq(F); bf16* XN = (bf16*)(w + WS_XN); bf16* WupT = (bf16*)(w + WS_WUP); bf16* Hb = (bf16*)(w + WS_H);
              pg8::Gemm g{XN + (size_t)ch * MLP_CHUNK * D, WupT, MLP_CHUNK, FF, D}; pg8::StaticOrder S; S.init(MLP_CHUNK, FF, F.G, BXQ());
              pg8::EpiRelu2 E{Hb, FF}; GEMM_PHASE(pg8::EpiRelu2, g, S, E); }
            { REFRESH(); xcd_barrier_fast(bar, F.tid == 0); } TOC(9); TIC();
            { unsigned char* w = (unsigned char*)wsq(F); bf16* Hb = (bf16*)(w + WS_H); bf16* WdownT = (bf16*)(w + WS_WDOWN); bf16* T = (bf16*)(w + WS_T);
              pg8::Gemm g{Hb, WdownT, MLP_CHUNK, D, FF}; pg8::StaticOrder S; S.init(MLP_CHUNK, D, F.G, BXQ());
              pg8::EpiBf16<0> E{T + (size_t)ch * MLP_CHUNK * D, D, nullptr, 0, 0, 1.f}; GEMM_PHASE(pg8::EpiBf16<0>, g, S, E); }
            { REFRESH(); xcd_barrier_fast(bar, F.tid == 0); } TOC(10); TIC();
        }
        REFRESH(); phase_norm_res(F, 1, (const GAS bf16*)(wsq(F) + WS_T), inp(F, I_NMLPPOST) + l * D, (l + 1 < DEPTH) ? inp(F, I_NMIXPRE) + (l + 1) * D : (const GAS float*)nullptr);
        { REFRESH(); xcd_barrier_fast(bar, F.tid == 0); } TOC(11); TIC();
    }
    if (PROBE_MASK) { const unsigned long long ts = __builtin_amdgcn_s_memrealtime(); while (__builtin_amdgcn_s_memrealtime() - ts < pr_acc) __builtin_amdgcn_s_sleep(8); }
}

extern "C" void kernel_launch(void* const* d_in, const int* in_sizes, int n_in, void* d_out, int out_size, void* d_ws, size_t ws_size, hipStream_t stream) {
    static int grid = 0;
    if (grid == 0) {
        if (n_in != 26 || out_size != M * D || ws_size < WS_END) { fprintf(stderr, "kernel_launch: shape mismatch n_in %d out %d ws %zu (need %zu)\n", n_in, out_size, ws_size, (size_t)WS_END); grid = -1; return; }
        int dev = 0, cus = 0, per_cu = 0;
        if (hipGetDevice(&dev) != hipSuccess || hipDeviceGetAttribute(&cus, hipDeviceAttributeMultiprocessorCount, dev) != hipSuccess) { grid = -1; return; }
        if (hipFuncSetAttribute((const void*)hyena_mla_fwd, hipFuncAttributeMaxDynamicSharedMemorySize, LDS_BYTES) != hipSuccess) { fprintf(stderr, "kernel_launch: hipFuncSetAttribute failed\n"); grid = -1; return; }
        if (hipOccupancyMaxActiveBlocksPerMultiprocessor(&per_cu, (const void*)hyena_mla_fwd, NTHR, LDS_BYTES) != hipSuccess || per_cu < 1) fprintf(stderr, "kernel_launch: occupancy query says %d\n", per_cu);
        (void)hipGetLastError();
        grid = cus;
    }
    if (grid < 0) return;
    if (hipMemsetAsync((char*)d_ws + WS_CTL, 0, CTL_ZERO_BYTES, stream) != hipSuccess) { fprintf(stderr, "kernel_launch: memset failed\n"); return; }
    Args a{};
    for (int i = 0; i < 26; ++i) a.in[i] = (const float*)d_in[i];
    a.out = (float*)d_out; a.ws = (unsigned char*)d_ws;
    hipLaunchKernelGGL(hyena_mla_fwd, dim3(grid), dim3(NTHR), LDS_BYTES, stream, a);
    const hipError_t le = hipPeekAtLastError();
    if (le != hipSuccess) fprintf(stderr, "kernel_launch: launch failed: %s\n", hipGetErrorName(le));
}
```

```cpp
#include <hip/hip_runtime.h>
#include <cstdio>
#include <cstdint>
__device__ __forceinline__ int hw_lane() { int l; asm volatile("v_mbcnt_lo_u32_b32 %0, -1, 0\n\tv_mbcnt_hi_u32_b32 %0, -1, %0" : "=v"(l)); return l; }
__device__ __forceinline__ int tid_from_wave(int wave0) { int w = wave0; asm volatile("" : "+s"(w)); int t = w * 64 + hw_lane(); asm volatile("" : "+v"(t)); return t; }
namespace pg8 {
#define PG8_LAS __attribute__((address_space(3)))
#define PG8_GAS __attribute__((address_space(1)))
typedef unsigned short bf16_t;
typedef short bf16x8 __attribute__((ext_vector_type(8)));
typedef float f32x4 __attribute__((ext_vector_type(4)));
typedef unsigned u32x4 __attribute__((ext_vector_type(4)));
constexpr int BM = 256, BK = 64, HALF = 128, HTB = HALF * BK * 2  , STAGE_BYTES = 8 * HTB, NXCD = 8, WGM = 8;

__host__ __device__ __forceinline__ int lds_byte(int r, int c) { const int st = (r >> 4) * 2 + (c >> 5), rr = r & 15, cc = c & 31, ob = rr * 64 + cc * 2; return st * 1024 + (ob ^ (((ob >> 9) & 1) << 5)); }
__host__ __device__ __forceinline__ void stage_rc(int b, int& R, int& C) { const int st = b / 1024, sb = b % 1024, swz = sb ^ (((sb >> 9) & 1) << 5); R = (st >> 1) * 16 + swz / 64; C = (st & 1) * 32 + (swz % 64) / 2; }
__host__ __device__ __forceinline__ int perm32(int rho) { const int n = rho >> 4, i = rho & 15; return 8 * (i >> 2) + 4 * n + (i & 3); }

struct Unit { int pm, pn; };
struct Gemm { const bf16_t* A; const bf16_t* Bt; int M, N, K; };

struct StaticOrder {
    int nM, nN, nwg, G, c;
    __host__ __device__ void init(int M, int N, int G_, int c_) { nM = M / BM; nN = N / BM; nwg = nM * nN; G = G_; c = c_; }
    __host__ __device__ bool next(int i, Unit& u) const {
        const long L = (long)i * G + c; if (L >= nwg) return false;
        int wgid = (int)L; { const int q = nwg / NXCD, r = nwg % NXCD, xcd = wgid % NXCD, off = wgid / NXCD; wgid = (xcd < r ? xcd * (q + 1) : r * (q + 1) + (xcd - r) * q) + off; }
        const int nig = WGM * nN, gid = wgid / nig, fm = gid * WGM, gsz = (nM - fm) < WGM ? (nM - fm) : WGM;
        u.pm = fm + ((wgid % nig) % gsz); u.pn = (wgid % nig) / gsz; return true;
    }
    __device__ __forceinline__ void a_ready(const Unit&) const {}
    __device__ __forceinline__ void done(const Unit&) const {}
};

__device__ __forceinline__ unsigned cvt_pk_bf16(float lo, float hi) { unsigned r; asm volatile("v_cvt_pk_bf16_f32 %0, %1, %2" : "=v"(r) : "v"(lo), "v"(hi)); return r; }
typedef float f32x2 __attribute__((ext_vector_type(2)));
__device__ __forceinline__ void relane(int& wr, int& wc, int& fr, int& fq) { int l = hw_lane(); asm volatile("" : "+v"(l)); fr = l & 15; fq = l >> 4; (void)wr; (void)wc; }
__device__ __forceinline__ f32x2 gelu_pk(f32x2 v) {
    const f32x2 av = __builtin_elementwise_abs(v), d = av * 0.2316418882f + 1.0f;
    f32x2 t; t.x = __builtin_amdgcn_rcpf(d.x); t.y = __builtin_amdgcn_rcpf(d.y);
    f32x2 q = t * 0.5307027145f + (-0.7265760135f); q = q * t + 0.7107068705f; q = q * t + (-0.142248368f); q = q * t + 0.127414796f; q = q * t;
    const f32x2 s = (v * v) * (-0.72134752044f);
    f32x2 e; e.x = __builtin_amdgcn_exp2f(s.x); e.y = __builtin_amdgcn_exp2f(s.y);
    const f32x2 m = v * (q * e), r = v - m;
    f32x2 o; o.x = v.x < 0.f ? m.x : r.x; o.y = v.y < 0.f ? m.y : r.y; return o;
}

template <int ACT  > struct EpiBf16 {
    static constexpr bool PERM = true, AFTER_DRAIN = false; static_assert(ACT == 0 || ACT == 1, "EpiBf16: ACT is 0 (none) or 1 (gelu_pk)");
    bf16_t* O; int ldc; const float* bias; int split_cols; size_t split_stride; float scale0;
    __device__ __forceinline__ void operator()(const f32x4 (&acc)[2][2][4][2], const Unit& u, int wr, int wc, int fr, int fq) const {
        relane(wr, wc, fr, fq);
        const int row0 = u.pm * BM + wr * 64 + fr; int colt = u.pn * BM; bf16_t* base = O;
        float sc = 1.f; if (split_cols) { const int t = colt / split_cols; base += (size_t)t * split_stride; colt -= t * split_cols; if (t == 0) sc = scale0; }
        const int col0 = colt + wc * 32 + 8 * fq, bcol0 = u.pn * BM + wc * 32 + 8 * fq;
        f32x4 bv[2][2];
#pragma unroll
        for (int bj = 0; bj < 2; ++bj)
#pragma unroll
            for (int n = 0; n < 2; ++n) bv[bj][n] = bias ? *(const PG8_GAS f32x4*)(bias + bcol0 + bj * HALF + 4 * n) : (f32x4){0.f, 0.f, 0.f, 0.f};
#pragma unroll
        for (int ai = 0; ai < 2; ++ai)
#pragma unroll
            for (int m = 0; m < 4; ++m) { bf16_t* rowp = base + (size_t)(row0 + ai * HALF + m * 16) * ldc + col0;
#pragma unroll
                for (int bj = 0; bj < 2; ++bj) { f32x4 v0 = acc[ai][bj][m][0] + bv[bj][0], v1 = acc[ai][bj][m][1] + bv[bj][1];
                    if (ACT == 1) { f32x2 a = gelu_pk((f32x2){v0[0], v0[1]}), b = gelu_pk((f32x2){v0[2], v0[3]}), c = gelu_pk((f32x2){v1[0], v1[1]}), d = gelu_pk((f32x2){v1[2], v1[3]});
                        v0 = (f32x4){a.x, a.y, b.x, b.y}; v1 = (f32x4){c.x, c.y, d.x, d.y}; }
                    v0 = v0 * sc; v1 = v1 * sc; u32x4 w; w.x = cvt_pk_bf16(v0[0], v0[1]); w.y = cvt_pk_bf16(v0[2], v0[3]); w.z = cvt_pk_bf16(v1[0], v1[1]); w.w = cvt_pk_bf16(v1[2], v1[3]);
                    *(PG8_GAS u32x4*)(rowp + bj * HALF) = w; } }
    }
};

struct PanelStats {
    unsigned* xbuf;
    unsigned* cnt;
    unsigned* tmo;
    int ntn; float eps;
    unsigned code;
    __device__ __forceinline__ bool run(const f32x4 (&v)[2][2][4][2], const Unit& u, int wr, int wc, int fr, int fq, PG8_LAS unsigned char* lds, int wid, int lane) const {
        typedef float f32x2v __attribute__((ext_vector_type(2)));
        PG8_LAS f32x2v* P = (PG8_LAS f32x2v*)lds;
        PG8_LAS f32x2v* S = (PG8_LAS f32x2v*)(lds + 8192);
        PG8_LAS unsigned* flag = (PG8_LAS unsigned*)(lds + 8192 + 2048);
#pragma unroll
        for (int ai = 0; ai < 2; ++ai)
#pragma unroll
            for (int m = 0; m < 4; ++m) {
                float s = 0.f;
#pragma unroll
                for (int bj = 0; bj < 2; ++bj)
#pragma unroll
                    for (int n = 0; n < 2; ++n) { const f32x4 x = v[ai][bj][m][n]; s += (x[0] + x[1]) + (x[2] + x[3]); }
                s += __shfl_xor(s, 16); s += __shfl_xor(s, 32);
                const float mw = s * (1.0f / 64.0f); float q = 0.f;
#pragma unroll
                for (int bj = 0; bj < 2; ++bj)
#pragma unroll
                    for (int n = 0; n < 2; ++n) { const f32x4 d = v[ai][bj][m][n] - mw; q += (d[0] * d[0] + d[1] * d[1]) + (d[2] * d[2] + d[3] * d[3]); }
                q += __shfl_xor(q, 16); q += __shfl_xor(q, 32);
                if (fq == 0) P[(ai * HALF + wr * 64 + m * 16 + fr) * 4 + wc] = (f32x2v){mw, q};
            }
        asm volatile("s_waitcnt lgkmcnt(0)" ::: "memory"); __builtin_amdgcn_s_barrier(); asm volatile("" ::: "memory");
#if defined(BROKEN_EXCHANGE_NO_WAIT)
#warning BROKEN CONTROL BUILD: the row-statistics exchange does not wait; results are wrong by design
        if (blockIdx.x >= 64) { const long long t0_ = clock64(); while (clock64() - t0_ < 60000) __builtin_amdgcn_s_sleep(8); }
#endif
        const int row = wid * 32 + (lane & 31);
        if (lane < 32) {
            const f32x2v a = P[row * 4 + 0], b = P[row * 4 + 1], c = P[row * 4 + 2], d = P[row * 4 + 3];
            const float mt = (a.x + b.x + c.x + d.x) * 0.25f;
            const float da = a.x - mt, db = b.x - mt, dc = c.x - mt, dd = d.x - mt;
            const float m2 = (a.y + b.y) + (c.y + d.y) + 64.0f * ((da * da + db * db) + (dc * dc + dd * dd));
            unsigned long long* slot = (unsigned long long*)xbuf + ((size_t)(u.pm * BM + row) * 4 + u.pn);
            __hip_atomic_store(slot, ((unsigned long long)__float_as_uint(m2) << 32) | __float_as_uint(mt), __ATOMIC_RELAXED, __HIP_MEMORY_SCOPE_AGENT);
        }
        asm volatile("s_waitcnt vmcnt(0)" ::: "memory");
        if (lane == 0) __hip_atomic_fetch_add(cnt + 64 * u.pm, 1u, __ATOMIC_RELAXED, __HIP_MEMORY_SCOPE_AGENT);
        if (wid == 0) {
            bool dead = false; const unsigned long long t0 = __builtin_amdgcn_s_memrealtime(); const unsigned want = 8u * (unsigned)ntn;
            for (;;) {
#if defined(BROKEN_EXCHANGE_NO_WAIT)
                break;
#endif
                if ((unsigned)__builtin_amdgcn_readfirstlane(__hip_atomic_load(cnt + 64 * u.pm, __ATOMIC_RELAXED, __HIP_MEMORY_SCOPE_AGENT)) >= want) break;
                if (__builtin_amdgcn_s_memrealtime() - t0 > 2000000ull) {
                    if (lane == 0) { unsigned expect = 0u; __hip_atomic_compare_exchange_strong(tmo + 1, &expect, code | (unsigned)(u.pm & 0xff), __ATOMIC_RELAXED, __ATOMIC_RELAXED, __HIP_MEMORY_SCOPE_AGENT);
                                     __hip_atomic_store(tmo, 1u, __ATOMIC_RELAXED, __HIP_MEMORY_SCOPE_AGENT); }
                    dead = true; break; }
                __builtin_amdgcn_s_sleep(2);
            }
            __builtin_amdgcn_fence(__ATOMIC_ACQUIRE, "agent");
            if (lane == 0) flag[0] = dead ? 1u : 0u;
        }
        asm volatile("s_waitcnt vmcnt(0) lgkmcnt(0)" ::: "memory"); __builtin_amdgcn_s_barrier(); asm volatile("" ::: "memory");
        const bool bad = flag[0] != 0u;
        if (lane < 32) {
            const unsigned long long* slot = (const unsigned long long*)xbuf + (size_t)(u.pm * BM + row) * 4; float mt[4], m2[4]; float ms = 0.f;
#pragma unroll
            for (int t = 0; t < 4; ++t) { if (t < ntn) { const unsigned long long w = __hip_atomic_load(slot + t, __ATOMIC_RELAXED, __HIP_MEMORY_SCOPE_AGENT); mt[t] = __uint_as_float((unsigned)w); m2[t] = __uint_as_float((unsigned)(w >> 32)); } else { mt[t] = 0.f; m2[t] = 0.f; } ms += mt[t]; }
            const float mean = ms / (float)ntn; float q = 0.f;
#pragma unroll
            for (int t = 0; t < 4; ++t) if (t < ntn) { const float dm = mt[t] - mean; q += m2[t] + 256.0f * dm * dm; }
            S[row] = (f32x2v){mean, 1.0f / sqrtf(q / (256.0f * (float)ntn) + eps)};
        }
        asm volatile("s_waitcnt lgkmcnt(0)" ::: "memory"); __builtin_amdgcn_s_barrier(); asm volatile("" ::: "memory");
        return bad;
    }
};
struct EpiLnRes {
    static constexpr bool PERM = false, AFTER_DRAIN = true;
    const float* base; float* out; int ldc; const float* bias; PanelStats st; unsigned poison;
    __device__ __forceinline__ void fused(f32x4 (&acc)[2][2][4][2], const Unit& u, int wr, int wc, int fr, int fq, PG8_LAS unsigned char* lds, int wid, int lane) const {
        typedef float f32x2v __attribute__((ext_vector_type(2)));
        const PG8_LAS f32x2v* S = (const PG8_LAS f32x2v*)(lds + 8192);
        const int col0 = u.pn * BM + wc * 32 + 4 * fq;
#pragma unroll
        for (int bj = 0; bj < 2; ++bj)
#pragma unroll
            for (int n = 0; n < 2; ++n) { const f32x4 bv = bias ? *(const f32x4*)(bias + col0 + bj * HALF + n * 16) : (f32x4){0.f, 0.f, 0.f, 0.f};
#pragma unroll
                for (int ai = 0; ai < 2; ++ai)
#pragma unroll
                    for (int m = 0; m < 4; ++m) acc[ai][bj][m][n] += bv; }
        f32x4 pre[4][2][2];
#pragma unroll
        for (int m = 0; m < 4; ++m) { const size_t off = (size_t)(u.pm * BM + wr * 64 + m * 16 + fr) * ldc + col0;
#pragma unroll
            for (int bj = 0; bj < 2; ++bj)
#pragma unroll
                for (int n = 0; n < 2; ++n) pre[m][bj][n] = *(const f32x4*)(base + off + bj * HALF + n * 16); }
        const bool bad = st.run(acc, u, wr, wc, fr, fq, lds, wid, lane) || poison != 0u;
        const float qnan = __builtin_nanf("");
#pragma unroll
        for (int ai = 0; ai < 2; ++ai)
#pragma unroll
            for (int m = 0; m < 4; ++m) { const int r = ai * HALF + wr * 64 + m * 16 + fr; const f32x2v sr = S[r]; const size_t off = (size_t)(u.pm * BM + r) * ldc + col0;
#pragma unroll
                for (int bj = 0; bj < 2; ++bj)
#pragma unroll
                    for (int n = 0; n < 2; ++n) { const f32x4 bs = ai == 0 ? pre[m][bj][n] : *(const f32x4*)(base + off + bj * HALF + n * 16); f32x4 o = bs + (acc[ai][bj][m][n] - sr.x) * sr.y;
                        if (bad) o = (f32x4){qnan, qnan, qnan, qnan}; *(f32x4*)(out + off + bj * HALF + n * 16) = o; }
                if (m & 1) asm volatile("" ::: "memory"); }
    }
};
struct EpiLnResLn {
    static constexpr bool PERM = false, AFTER_DRAIN = true;
    const float* base; float* out; bf16_t* xn; int ldc; const float* bias; PanelStats st1, st2; unsigned poison;
    __device__ __forceinline__ void fused(f32x4 (&acc)[2][2][4][2], const Unit& u, int wr, int wc, int fr, int fq, PG8_LAS unsigned char* lds, int wid, int lane) const {
        typedef float f32x2v __attribute__((ext_vector_type(2))); typedef unsigned u32x2v __attribute__((ext_vector_type(2)));
        const PG8_LAS f32x2v* S = (const PG8_LAS f32x2v*)(lds + 8192);
        const int col0 = u.pn * BM + wc * 32 + 4 * fq;
#pragma unroll
        for (int bj = 0; bj < 2; ++bj)
#pragma unroll
            for (int n = 0; n < 2; ++n) { const f32x4 bv = bias ? *(const f32x4*)(bias + col0 + bj * HALF + n * 16) : (f32x4){0.f, 0.f, 0.f, 0.f};
#pragma unroll
                for (int ai = 0; ai < 2; ++ai)
#pragma unroll
                    for (int m = 0; m < 4; ++m) acc[ai][bj][m][n] += bv; }
        bool bad = st1.run(acc, u, wr, wc, fr, fq, lds, wid, lane) || poison != 0u;
        const float qnan = __builtin_nanf("");
#pragma unroll
        for (int ai = 0; ai < 2; ++ai)
#pragma unroll
            for (int m = 0; m < 4; ++m) { const int r = ai * HALF + wr * 64 + m * 16 + fr; const f32x2v sr = S[r]; const size_t off = (size_t)(u.pm * BM + r) * ldc + col0;
#pragma unroll
                for (int bj = 0; bj < 2; ++bj)
#pragma unroll
                    for (int n = 0; n < 2; ++n) { const f32x4 bs = *(const f32x4*)(base + off + bj * HALF + n * 16); acc[ai][bj][m][n] = bs + (acc[ai][bj][m][n] - sr.x) * sr.y; }
                asm volatile("" : "+v"(acc[ai][0][m][0]), "+v"(acc[ai][0][m][1]), "+v"(acc[ai][1][m][0]), "+v"(acc[ai][1][m][1]));
                if (m & 1) asm volatile("" ::: "memory"); }
        const bool bad1 = bad;
        bad = st2.run(acc, u, wr, wc, fr, fq, lds, wid, lane) || bad;
#pragma unroll
        for (int ai = 0; ai < 2; ++ai)
#pragma unroll
            for (int m = 0; m < 4; ++m) { const int r = ai * HALF + wr * 64 + m * 16 + fr; const f32x2v sr = S[r]; const size_t off = (size_t)(u.pm * BM + r) * ldc + col0;
#pragma unroll
                for (int bj = 0; bj < 2; ++bj)
#pragma unroll
                    for (int n = 0; n < 2; ++n) { const f32x4 x1 = acc[ai][bj][m][n]; *(f32x4*)(out + off + bj * HALF + n * 16) = bad1 ? (f32x4){qnan, qnan, qnan, qnan} : x1;
                        const f32x4 o = (x1 - sr.x) * sr.y; u32x2v w; w.x = cvt_pk_bf16(o[0], o[1]); w.y = cvt_pk_bf16(o[2], o[3]);
                        if (bad) { w.x = 0x7fc07fc0u; w.y = 0x7fc07fc0u; } *(u32x2v*)(xn + off + bj * HALF + n * 16) = w; }
                asm volatile("" ::: "memory"); }
    }
};

template <class Epi, class Sched, bool ALIGN_EPI = false, bool SP2 = false>
__device__ __forceinline__ void gemm_phase(PG8_LAS unsigned char* lds, const Gemm g, const Sched& S, const Epi& E, const int wave0) {
    int tid_ = tid_from_wave(wave0);
    const int tid = tid_, wid = __builtin_amdgcn_readfirstlane(tid >> 6), lane = tid & 63, wr = wid >> 2, wc = wid & 3, fr = lane & 15, fq = lane >> 4;
    const int K = g.K, nt = K / BK;
    unsigned voffA[2], voffB[2];
#pragma unroll
    for (int i = 0; i < 2; ++i) { int R, C; stage_rc(tid * 16 + i * 8192, R, C); const int Rb = Epi::PERM ? ((R & ~31) + perm32(R & 31)) : R;
        voffA[i] = (unsigned)(R * K + C) * 2u; voffB[i] = (unsigned)(Rb * K + C) * 2u; }
    const size_t kstep = (size_t)(BK * 2);
    const size_t hstep = (size_t)HALF * K * 2;
    const size_t tstep = 2 * hstep;
    const unsigned ldsw = (unsigned)wid * 1024u;
    const int aoff = lds_byte(wr * 64 + fr, fq * 8), boff = lds_byte(wc * 32 + fr, fq * 8);
#define PG8_SA(b, h) (((b) * 2 + (h)) * HTB)
#define PG8_SB(b, h) ((4 + (b) * 2 + (h)) * HTB)
#define PG8_STAGE(bufoff, gbase, voff) do { _Pragma("unroll") for (int _i = 0; _i < 2; ++_i) \
        __builtin_amdgcn_global_load_lds((const unsigned*)((const char*)(gbase) + (voff)[_i]), (PG8_LAS unsigned*)(lds + (bufoff) + ldsw + _i * 8192), 16, 0, 0); } while (0)
#define PG8_LDA(dst, b, h) do { _Pragma("unroll") for (int m = 0; m < 4; ++m) _Pragma("unroll") for (int k = 0; k < 2; ++k) dst[m][k] = *(const PG8_LAS bf16x8*)(lds + PG8_SA(b, h) + aoff + m * 2048 + k * 1024); } while (0)
#define PG8_LDB(dst, b, h) do { _Pragma("unroll") for (int n = 0; n < 2; ++n) _Pragma("unroll") for (int k = 0; k < 2; ++k) dst[n][k] = *(const PG8_LAS bf16x8*)(lds + PG8_SB(b, h) + boff + n * 2048 + k * 1024); } while (0)
#define PG8_MMA(ai, bj, At, Bt) do { __builtin_amdgcn_s_setprio(1); _Pragma("unroll") for (int m = 0; m < 4; ++m) _Pragma("unroll") for (int n = 0; n < 2; ++n) _Pragma("unroll") for (int k = 0; k < 2; ++k) \
        acc[ai][bj][m][n] = __builtin_amdgcn_mfma_f32_16x16x32_bf16(Bt[n][k], At[m][k], acc[ai][bj][m][n], 0, 0, 0); __builtin_amdgcn_s_setprio(0); } while (0)
#define PG8_WAIT_V(n) asm volatile("s_waitcnt vmcnt(" #n ")" ::: "memory")
#define PG8_WAIT_L(n) asm volatile("s_waitcnt lgkmcnt(" #n ")" ::: "memory")
#define PG8_BAR __builtin_amdgcn_s_barrier()
#define PG8_SCHED __builtin_amdgcn_sched_barrier(0)
    Unit cur, nxt; int ui = 0;
    if (!S.next(0, cur)) return;
    f32x4 acc[2][2][4][2];
#pragma unroll
    for (int a = 0; a < 2; ++a)
#pragma unroll
        for (int b = 0; b < 2; ++b)
#pragma unroll
            for (int m = 0; m < 4; ++m)
#pragma unroll
                for (int n = 0; n < 2; ++n) acc[a][b][m][n] = (f32x4){0.f, 0.f, 0.f, 0.f};
    bf16x8 At[4][2], B0[2][2], B1[2][2];
    const char* cA = (const char*)g.A + (size_t)cur.pm * tstep; const char* cB = (const char*)g.Bt + (size_t)cur.pn * tstep;
    S.a_ready(cur);
    if constexpr (SP2) {
        PG8_STAGE(PG8_SB(0, 0), cB, voffB); PG8_STAGE(PG8_SB(0, 1), cB + hstep, voffB); PG8_STAGE(PG8_SA(0, 0), cA, voffA); PG8_STAGE(PG8_SA(0, 1), cA + hstep, voffA);
        if (wr == 1) PG8_BAR;
        PG8_WAIT_V(2); PG8_BAR;
        PG8_STAGE(PG8_SB(1, 0), cB + kstep, voffB); PG8_STAGE(PG8_SA(1, 0), cA + kstep, voffA); PG8_STAGE(PG8_SB(1, 1), cB + hstep + kstep, voffB);
        PG8_WAIT_V(6); PG8_BAR;
    } else {
        PG8_STAGE(PG8_SB(0, 0), cB, voffB); PG8_STAGE(PG8_SA(0, 0), cA, voffA); PG8_STAGE(PG8_SB(0, 1), cB + hstep, voffB); PG8_STAGE(PG8_SA(0, 1), cA + hstep, voffA);
        if (wr == 1) PG8_BAR;
        PG8_WAIT_V(4); PG8_BAR;
        PG8_STAGE(PG8_SB(1, 0), cB + kstep, voffB); PG8_STAGE(PG8_SA(1, 0), cA + kstep, voffA); PG8_STAGE(PG8_SB(1, 1), cB + hstep + kstep, voffB);
        PG8_WAIT_V(6); PG8_BAR;
    }
    for (;;) {
        const bool has_next = S.next(ui + 1, nxt);
        const char* nA = has_next ? (const char*)g.A + (size_t)nxt.pm * tstep : cA; const char* nB = has_next ? (const char*)g.Bt + (size_t)nxt.pn * tstep : cB;
        for (int t = 0; t < nt; t += 2) {
            const bool last = (t == nt - 2);
            const char* a1 = cA + (size_t)(t + 1) * kstep;
            const char* a2 = last ? nA : cA + (size_t)(t + 2) * kstep; const char* b2 = last ? nB : cB + (size_t)(t + 2) * kstep;
            const char* a3 = a2 + kstep; const char* b3 = b2 + kstep;
            if (last && has_next) S.a_ready(nxt);
            if constexpr (SP2) {
            PG8_LDB(B0, 0, 0); PG8_LDB(B1, 0, 1); PG8_SCHED; PG8_LDA(At, 0, 0); PG8_STAGE(PG8_SA(1, 1), a1 + hstep, voffA);
            PG8_WAIT_V(8); PG8_WAIT_L(0); PG8_BAR; PG8_MMA(0, 0, At, B0); PG8_MMA(0, 1, At, B1); PG8_BAR; PG8_SCHED;
            PG8_LDA(At, 0, 1); PG8_STAGE(PG8_SB(0, 0), b2, voffB); PG8_STAGE(PG8_SB(0, 1), b2 + hstep, voffB); PG8_STAGE(PG8_SA(0, 0), a2, voffA);
            PG8_WAIT_V(8); PG8_WAIT_L(0); PG8_BAR; PG8_MMA(1, 0, At, B0); PG8_MMA(1, 1, At, B1); PG8_BAR; PG8_SCHED;
            PG8_LDB(B0, 1, 0); PG8_LDB(B1, 1, 1); PG8_SCHED; PG8_LDA(At, 1, 0); PG8_STAGE(PG8_SA(0, 1), a2 + hstep, voffA);
            PG8_WAIT_V(8); PG8_WAIT_L(0); PG8_BAR; PG8_MMA(0, 0, At, B0); PG8_MMA(0, 1, At, B1); PG8_BAR; PG8_SCHED;
            PG8_LDA(At, 1, 1); PG8_STAGE(PG8_SB(1, 0), b3, voffB); PG8_STAGE(PG8_SB(1, 1), b3 + hstep, voffB); PG8_STAGE(PG8_SA(1, 0), a3, voffA);
            PG8_WAIT_V(8); PG8_WAIT_L(0); PG8_BAR; PG8_MMA(1, 0, At, B0); PG8_MMA(1, 1, At, B1); PG8_BAR; PG8_SCHED;
            } else {
            PG8_LDB(B0, 0, 0); PG8_SCHED; PG8_LDA(At, 0, 0); PG8_STAGE(PG8_SA(1, 1), a1 + hstep, voffA);
            PG8_WAIT_L(8); PG8_BAR; PG8_WAIT_L(0); PG8_MMA(0, 0, At, B0); PG8_BAR; PG8_SCHED;
            PG8_LDB(B1, 0, 1); PG8_STAGE(PG8_SB(0, 0), b2, voffB);
            PG8_BAR; PG8_WAIT_L(0); PG8_MMA(0, 1, At, B1); PG8_BAR;
            PG8_LDA(At, 0, 1); PG8_STAGE(PG8_SA(0, 0), a2, voffA);
            PG8_BAR; PG8_WAIT_L(0); PG8_MMA(1, 0, At, B0); PG8_BAR; PG8_SCHED;
            PG8_STAGE(PG8_SB(0, 1), b2 + hstep, voffB);
            PG8_WAIT_V(6); PG8_BAR; PG8_MMA(1, 1, At, B1); PG8_BAR;
            PG8_LDB(B0, 1, 0); PG8_SCHED; PG8_LDA(At, 1, 0); PG8_STAGE(PG8_SA(0, 1), a2 + hstep, voffA);
            PG8_WAIT_L(8); PG8_BAR; PG8_WAIT_L(0); PG8_MMA(0, 0, At, B0); PG8_BAR; PG8_SCHED;
            PG8_LDB(B1, 1, 1); PG8_STAGE(PG8_SB(1, 0), b3, voffB);
            PG8_BAR; PG8_WAIT_L(0); PG8_MMA(0, 1, At, B1); PG8_BAR;
            PG8_LDA(At, 1, 1); PG8_STAGE(PG8_SA(1, 0), a3, voffA);
            PG8_BAR; PG8_WAIT_L(0); PG8_MMA(1, 0, At, B0); PG8_BAR; PG8_SCHED;
            PG8_STAGE(PG8_SB(1, 1), b3 + hstep, voffB);
            PG8_WAIT_V(6); PG8_BAR; PG8_MMA(1, 1, At, B1); PG8_BAR;
            }
        }
        if constexpr (ALIGN_EPI) { if (wr == 0) PG8_BAR; }
        if constexpr (!Epi::AFTER_DRAIN) { E(acc, cur, wr, wc, fr, fq); S.done(cur); }
        if (!has_next) break;
#pragma unroll
        for (int a = 0; a < 2; ++a)
#pragma unroll
            for (int b = 0; b < 2; ++b)
#pragma unroll
                for (int m = 0; m < 4; ++m)
#pragma unroll
                    for (int n = 0; n < 2; ++n) acc[a][b][m][n] = (f32x4){0.f, 0.f, 0.f, 0.f};
        cur = nxt; cA = nA; cB = nB; ++ui;
        if constexpr (ALIGN_EPI) { if (wr == 1) PG8_BAR; }
    }
    PG8_WAIT_V(0);
    if constexpr (!ALIGN_EPI) { if (wr == 0) PG8_BAR; }
    PG8_BAR;
    if constexpr (Epi::AFTER_DRAIN) { E.fused(acc, cur, wr, wc, fr, fq, lds, wid, lane); S.done(cur); }
#undef PG8_SA
#undef PG8_SB
#undef PG8_STAGE
#undef PG8_LDA
#undef PG8_LDB
#undef PG8_MMA
#undef PG8_WAIT_V
#undef PG8_WAIT_L
#undef PG8_BAR
#undef PG8_SCHED
}
}

namespace pg8 {
struct EpiRelu2 {
    static constexpr bool PERM = true, AFTER_DRAIN = false;
    bf16_t* O; int ldc;
    __device__ __forceinline__ void operator()(const f32x4 (&acc)[2][2][4][2], const Unit& u, int wr, int wc, int fr, int fq) const {
        relane(wr, wc, fr, fq);
        const int row0 = u.pm * BM + wr * 64 + fr, col0 = u.pn * BM + wc * 32 + 8 * fq;
#pragma unroll
        for (int ai = 0; ai < 2; ++ai)
#pragma unroll
            for (int m = 0; m < 4; ++m) { bf16_t* rowp = O + (size_t)(row0 + ai * HALF + m * 16) * ldc + col0;
#pragma unroll
                for (int bj = 0; bj < 2; ++bj) { f32x4 v0 = acc[ai][bj][m][0], v1 = acc[ai][bj][m][1];
                    v0 = __builtin_elementwise_max(v0, (f32x4){0.f, 0.f, 0.f, 0.f}); v1 = __builtin_elementwise_max(v1, (f32x4){0.f, 0.f, 0.f, 0.f}); v0 = v0 * v0; v1 = v1 * v1;
                    u32x4 w; w.x = cvt_pk_bf16(v0[0], v0[1]); w.y = cvt_pk_bf16(v0[2], v0[3]); w.z = cvt_pk_bf16(v1[0], v1[1]); w.w = cvt_pk_bf16(v1[2], v1[3]);
                    *(PG8_GAS u32x4*)(rowp + bj * HALF) = w; } }
    }
};
struct EpiF32 {
    static constexpr bool PERM = false, AFTER_DRAIN = false;
    float* O; int ldc;
    __device__ __forceinline__ void operator()(const f32x4 (&acc)[2][2][4][2], const Unit& u, int wr, int wc, int fr, int fq) const {
        relane(wr, wc, fr, fq);
        const int row0 = u.pm * BM + wr * 64 + fr, col0 = u.pn * BM + wc * 32 + 4 * fq;
#pragma unroll
        for (int ai = 0; ai < 2; ++ai)
#pragma unroll
            for (int m = 0; m < 4; ++m) { float* rowp = O + (size_t)(row0 + ai * HALF + m * 16) * ldc + col0;
#pragma unroll
                for (int bj = 0; bj < 2; ++bj)
#pragma unroll
                    for (int n = 0; n < 2; ++n) *(PG8_GAS f32x4*)(rowp + bj * HALF + n * 16) = acc[ai][bj][m][n]; }
    }
};
struct EpiTaps {
    static constexpr bool PERM = false, AFTER_DRAIN = false;
    float* O; const float* decay;
    __device__ __forceinline__ void operator()(const f32x4 (&acc)[2][2][4][2], const Unit& u, int wr, int wc, int fr, int fq) const {
        relane(wr, wc, fr, fq);
        const int row0 = u.pm * BM + wr * 64 + fr, col0 = u.pn * BM + wc * 32 + 4 * fq;
#pragma unroll
        for (int ai = 0; ai < 2; ++ai)
#pragma unroll
            for (int m = 0; m < 4; ++m) { const int row = row0 + ai * HALF + m * 16; float* rowp = O + (size_t)row * 16384 + col0; const float nd = -fabsf(((const PG8_GAS float*)decay)[row]) * (1.0f / 16383.0f) * 1.4426950408889634f;
#pragma unroll
                for (int bj = 0; bj < 2; ++bj)
#pragma unroll
                    for (int n = 0; n < 2; ++n) { const int c = col0 + bj * HALF + n * 16; const f32x4 a = acc[ai][bj][m][n]; f32x4 o;
                        o[0] = a[0] * __builtin_amdgcn_exp2f(nd * (float)(c + 0)); o[1] = a[1] * __builtin_amdgcn_exp2f(nd * (float)(c + 1));
                        o[2] = a[2] * __builtin_amdgcn_exp2f(nd * (float)(c + 2)); o[3] = a[3] * __builtin_amdgcn_exp2f(nd * (float)(c + 3));
                        *(PG8_GAS f32x4*)(rowp + bj * HALF + n * 16) = o; } }
    }
};
}

constexpr int L = 16384, NSEQ = 3, M = NSEQ * L, D = 1024, DEPTH = 4;
constexpr int HYW = 512, HYP = 1536, QR = 256, KVR = 128, ROPE = 32, INW = 1952;
constexpr int NH = 8, DQ = 96, DV = 64, NQ = NH * DQ, NKV = NH * 128;
constexpr int FF = 4096;
constexpr float EPS = 1e-6f;
constexpr int NWAVES = 8, NTHR = 512;
constexpr int MLP_CHUNK = 16384, N_MLP_CHUNKS = M / MLP_CHUNK;

constexpr size_t MiB = 1u << 20;
constexpr size_t WS_CTL = 0, CTL_ZERO_BYTES = 65536;
constexpr size_t WS_COS = 1 * MiB, WS_SIN = 2 * MiB;
constexpr size_t WS_H2 = 4 * MiB;
constexpr size_t WS_W3T = 8 * MiB;
constexpr size_t WS_WIN = 12 * MiB, WS_WOUT = 16 * MiB, WS_WUP = 18 * MiB, WS_WDOWN = 26 * MiB, WS_WUQ = 34 * MiB, WS_WUKV = 34 * MiB + 512 * 1024;
constexpr size_t WS_XN = 36 * MiB;
constexpr size_t WS_CQN = 36 * MiB, WS_CKVN = 60 * MiB, WS_KPE = 72 * MiB;
constexpr size_t WS_KEO = 132 * MiB;
constexpr size_t WS_KT = 261 * MiB;
constexpr size_t WS_UT = 261 * MiB;
constexpr size_t WS_CQKV = 405 * MiB;
constexpr size_t WS_YT = 453 * MiB;
constexpr size_t WS_Q = 132 * MiB, WS_KN = 204 * MiB;
constexpr size_t WS_MIX = 324 * MiB;
constexpr size_t WS_T = 132 * MiB;
constexpr size_t WS_H = 324 * MiB;
constexpr size_t WS_G0 = 75 * MiB, WS_G1A = 107 * MiB, WS_G1B = 501 * MiB;
constexpr size_t WS_END = 508 * MiB;
constexpr int KEO_BLK = 16512, KEO_KO = 8256;
static_assert(WS_KEO + (size_t)1024 * KEO_BLK * 8 <= WS_KT, "KEO fits");
static_assert(WS_UT + (size_t)HYP * M * 2 <= WS_CQKV && WS_CQKV + (size_t)M * 512 * 2 <= WS_YT && WS_YT + (size_t)HYW * M * 2 <= WS_END, "map");
static_assert(WS_KN + (size_t)M * NKV * 2 <= WS_MIX && WS_T + (size_t)M * D * 4 <= WS_MIX && WS_H + (size_t)MLP_CHUNK * FF * 2 <= WS_END, "map2");

constexpr int RING_OFF = 0, RING_BYTES = 139264;
constexpr int LDSCTL_OFF = RING_BYTES, MISC_OFF = LDSCTL_OFF + 320;
constexpr int LDS_BYTES = 147456;
static_assert(MISC_OFF + 128 <= LDS_BYTES, "LDS map");

#define GAS __attribute__((address_space(1)))
#define LAS __attribute__((address_space(3)))
typedef unsigned short bf16;
typedef unsigned v4u __attribute__((ext_vector_type(4)));
typedef unsigned v2u __attribute__((ext_vector_type(2)));
typedef float f32x4 __attribute__((ext_vector_type(4)));
typedef float f32x2 __attribute__((ext_vector_type(2)));
typedef short bf16x8 __attribute__((ext_vector_type(8)));
typedef GAS unsigned gu32;
#define RLX_AGENT __ATOMIC_RELAXED, __HIP_MEMORY_SCOPE_AGENT
#define LDS_WAIT() asm volatile("s_waitcnt lgkmcnt(0)" ::: "memory")
#define VM_WAIT() asm volatile("s_waitcnt vmcnt(0)" ::: "memory")
typedef __bf16 bf16x2_t __attribute__((ext_vector_type(2)));
__device__ __forceinline__ unsigned pk2(float lo, float hi) { f32x2 v = {lo, hi}; bf16x2_t b = __builtin_convertvector(v, bf16x2_t); return __builtin_bit_cast(unsigned, b); }
__device__ __forceinline__ bf16 f2bf(float f) { return (bf16)(pk2(f, 0.f) & 0xffffu); }
__device__ __forceinline__ float bf2f(unsigned h) { return __uint_as_float(h << 16); }
__device__ __forceinline__ float wave_sum(float v) {
#pragma unroll
    for (int o = 1; o < 64; o <<= 1) v += __shfl_xor(v, o);
    return v;
}

namespace hfft {
constexpr float w32c(int i) { constexpr float t[16] = {1.000000000e+00f, 9.807852507e-01f, 9.238795042e-01f, 8.314695954e-01f, 7.071067691e-01f, 5.555702448e-01f, 3.826834261e-01f, 1.950903237e-01f, 0.f, -1.950903237e-01f, -3.826834261e-01f, -5.555702448e-01f, -7.071067691e-01f, -8.314695954e-01f, -9.238795042e-01f, -9.807852507e-01f}; return t[i]; }
constexpr float w32s(int i) { constexpr float t[16] = {0.000000000e+00f, 1.950903237e-01f, 3.826834261e-01f, 5.555702448e-01f, 7.071067691e-01f, 8.314695954e-01f, 9.238795042e-01f, 9.807852507e-01f, 1.000000000e+00f, 9.807852507e-01f, 9.238795042e-01f, 8.314695954e-01f, 7.071067691e-01f, 5.555702448e-01f, 3.826834261e-01f, 1.950903237e-01f}; return t[i]; }
constexpr int brev(int x, int bits) { int r = 0; for (int i = 0; i < bits; ++i) r |= ((x >> i) & 1) << (bits - 1 - i); return r; }
constexpr int ilog2(int x) { int r = 0; while ((1 << r) < x) ++r; return r; }
__device__ __forceinline__ int pad(int i) { return i + (i >> 5); }

__device__ __forceinline__ void bfly(float ar, float ai, float br, float bi, float& ur, float& ui, float& dr, float& di) {
    asm("v_add_f32_e32 %0, %4, %6\n\tv_add_f32_e32 %1, %5, %7\n\tv_sub_f32_e32 %2, %4, %6\n\tv_sub_f32_e32 %3, %5, %7"
        : "=&v"(ur), "=&v"(ui), "=&v"(dr), "=&v"(di) : "v"(ar), "v"(ai), "v"(br), "v"(bi));
}
template <bool INV> __device__ __forceinline__ void bfly_rot(float ar, float ai, float br, float bi, float& ur, float& ui, float& dr, float& di) {
    if (!INV) asm("v_add_f32_e32 %0, %4, %6\n\tv_add_f32_e32 %1, %5, %7\n\tv_sub_f32_e32 %2, %5, %7\n\tv_sub_f32_e32 %3, %6, %4" : "=&v"(ur), "=&v"(ui), "=&v"(dr), "=&v"(di) : "v"(ar), "v"(ai), "v"(br), "v"(bi));
    else      asm("v_add_f32_e32 %0, %4, %6\n\tv_add_f32_e32 %1, %5, %7\n\tv_sub_f32_e32 %2, %7, %5\n\tv_sub_f32_e32 %3, %4, %6" : "=&v"(ur), "=&v"(ui), "=&v"(dr), "=&v"(di) : "v"(ar), "v"(ai), "v"(br), "v"(bi));
}
__device__ __forceinline__ void bfly_tw(float ar, float ai, float br, float bi, float c, float s, float& ur, float& ui, float& dr, float& di) {
    float tr, ti;
    asm("v_sub_f32_e32 %4, %6, %8\n\tv_sub_f32_e32 %5, %7, %9\n\tv_add_f32_e32 %0, %6, %8\n\tv_add_f32_e32 %1, %7, %9\n\t"
        "v_mul_f32_e32 %2, %10, %4\n\tv_mul_f32_e32 %3, %11, %4\n\tv_fma_f32 %2, -%11, %5, %2\n\tv_fma_f32 %3, %10, %5, %3"
        : "=&v"(ur), "=&v"(ui), "=&v"(dr), "=&v"(di), "=&v"(tr), "=&v"(ti) : "v"(ar), "v"(ai), "v"(br), "v"(bi), "s"(c), "s"(s));
}
__device__ __forceinline__ void cmul_chain(float& xr, float& xi, float& wc, float& ws, float c1, float s1) {
    float a, b, nc, ns;
    asm("v_mul_f32_e32 %0, %4, %6\n\tv_mul_f32_e32 %1, %4, %7\n\tv_fma_f32 %0, -%5, %7, %0\n\tv_fma_f32 %1, %5, %6, %1\n\t"
        "v_mul_f32_e32 %2, %6, %8\n\tv_mul_f32_e32 %3, %6, %9\n\tv_fma_f32 %2, -%7, %9, %2\n\tv_fma_f32 %3, %7, %8, %3"
        : "=&v"(a), "=&v"(b), "=&v"(nc), "=&v"(ns) : "v"(xr), "v"(xi), "v"(wc), "v"(ws), "v"(c1), "v"(s1));
    xr = a; xi = b; wc = nc; ws = ns;
}
template <int R, bool INV> __device__ __forceinline__ void fft_r2(float (&re)[R], float (&im)[R], const unsigned z0) {
    constexpr int LG = ilog2(R);
#pragma unroll
    for (int st = 0; st < LG; ++st) {
        const int s = (R / 2) >> st;
#pragma unroll
        for (int blk = 0; blk < R; blk += 2 * s) {
#pragma unroll
            for (int a = 0; a < s; ++a) {
                const int i0 = blk + a, i1 = i0 + s;
                const int w = a * (16 / s);
                float ur, ui, dr, di;
                if (w == 0) { bfly(re[i0], im[i0], re[i1], im[i1], ur, ui, dr, di); re[i1] = dr; im[i1] = di; }
                else if (w == 8) { bfly_rot<INV>(re[i0], im[i0], re[i1], im[i1], ur, ui, dr, di); re[i1] = dr; im[i1] = di; }
                else { const float c = __uint_as_float(__float_as_uint(w32c(w)) | z0), sn = __uint_as_float(__float_as_uint(INV ? w32s(w) : -w32s(w)) | z0);
                    bfly_tw(re[i0], im[i0], re[i1], im[i1], c, sn, ur, ui, dr, di); re[i1] = dr; im[i1] = di; }
                re[i0] = ur; im[i0] = ui;
            }
        }
    }
}

__device__ __forceinline__ int opaque(int x) { asm volatile("" : "+v"(x)); return x; }
template <bool INV> __device__ __forceinline__ void fft16k(float (&re)[32], float (&im)[32], LAS f32x2* buf, const int t_in) {
    asm volatile("" ::: "memory"); __builtin_amdgcn_sched_barrier(0);
    int t = opaque(t_in);
    unsigned z0 = 0u; asm volatile("" : "+s"(z0));
    fft_r2<32, INV>(re, im, z0);
    __syncthreads();
#pragma unroll
    for (int r = 0; r < 32; ++r) buf[33 * t + r] = (f32x2){re[brev(r, 5)], im[brev(r, 5)]};
    __syncthreads();
    t = opaque(t);
    { const int b2 = t + (t >> 5);
#pragma unroll
    for (int r = 0; r < 32; ++r) { const f32x2 v = buf[b2 + 528 * r]; re[r] = v.x; im[r] = v.y; } }
    {
        const float f1 = (float)(t & 31) * (1.0f / 1024.0f);
        const float c1 = __builtin_amdgcn_cosf(f1), s1 = INV ? __builtin_amdgcn_sinf(f1) : -__builtin_amdgcn_sinf(f1);
        float wc = c1, ws = s1;
#pragma unroll
        for (int r = 1; r < 32; ++r) {
            cmul_chain(re[r], im[r], wc, ws, c1, s1);
        }
    }
    fft_r2<32, INV>(re, im, z0);
    __syncthreads();
    {
        t = opaque(t);
        const int ob = (t >> 5) * 1056 + (t & 31);
#pragma unroll
        for (int r = 0; r < 32; ++r) buf[ob + 33 * r] = (f32x2){re[brev(r, 5)], im[brev(r, 5)]};
    }
    __syncthreads();
#pragma unroll
    for (int h = 0; h < 2; ++h) {
        t = opaque(t);
        float ar[16], ai[16]; const int j = t + 512 * h; const int b3 = t + (t >> 5) + 528 * h;
#pragma unroll
        for (int r = 0; r < 16; ++r) { const f32x2 v = buf[b3 + 1056 * r]; ar[r] = v.x; ai[r] = v.y; }
        {
            const float f1 = (float)j * (1.0f / 16384.0f);
            const float c1 = __builtin_amdgcn_cosf(f1), s1 = INV ? __builtin_amdgcn_sinf(f1) : -__builtin_amdgcn_sinf(f1);
            float wc = c1, ws = s1;
#pragma unroll
            for (int r = 1; r < 16; ++r) {
                cmul_chain(ar[r], ai[r], wc, ws, c1, s1);
            }
        }
        fft_r2<16, INV>(ar, ai, z0);
#pragma unroll
        for (int r = 0; r < 16; ++r) { re[h + 2 * r] = ar[brev(r, 4)]; im[h + 2 * r] = ai[brev(r, 4)]; }
    }
    asm volatile("" ::: "memory"); __builtin_amdgcn_sched_barrier(0);
}
}

struct Frame {
    LAS unsigned char* lds;
    volatile LAS unsigned* MISC;
    gu32* ctl;
    int tid, lane, wave;
    int wave0;
    int vcu, G;
    float* out;
    unsigned char* ws;
};
constexpr int PTRTAB_OFF = LDSCTL_OFF + 512;
__device__ __forceinline__ const GAS float* inp(const Frame& F, int i) {
    const v2u w = *(const LAS v2u*)(F.lds + PTRTAB_OFF + 8 * i);
    const unsigned lo = __builtin_amdgcn_readfirstlane(w.x), hi = __builtin_amdgcn_readfirstlane(w.y);
    return (const GAS float*)(((unsigned long long)hi << 32) | lo);
}
__device__ __forceinline__ GAS unsigned char* wsq(const Frame& F) { unsigned char* p = F.ws; asm volatile("" : "+s"(p)); return (GAS unsigned char*)p; }
enum { I_XP = 0, I_XS, I_WIN, I_CONVW, I_CONVB, I_FW1, I_FB1, I_FW2, I_FB2, I_FW3, I_SINF, I_DECAY, I_HBIAS, I_QNORM, I_WUQ, I_KVNORM, I_WUKV, I_GNHY, I_GNAT, I_WOUT,
       I_NMIXPRE, I_NMIXPOST, I_NMLPPRE, I_NMLPPOST, I_WUP, I_WDOWN };

__device__ __forceinline__ int rope_src(int p) { return 4 * (p >> 3) + (p & 3) + 16 * ((p >> 2) & 1); }
template <bool ROPEPERM>
__device__ __forceinline__ void transpose_item(const GAS float* W, int K, int N, GAS bf16* WT, LAS float* scr, int item, int lane, int ldk = 0, int koff = 0) {
    if (ldk == 0) ldk = K;
    const int nblk = N / 32, kb = item / nblk, nb = item % nblk, k0 = 64 * kb, n0 = 32 * nb;
    int sc = lane & 31; if (ROPEPERM && (nb % 3) == 2) sc = rope_src(sc);
#pragma unroll 8
    for (int i = 0; i < 32; ++i) { const int kk = 2 * i + (lane >> 5); scr[kk * 33 + (lane & 31)] = W[(size_t)(k0 + kk) * N + n0 + sc]; }
    LDS_WAIT(); asm volatile("" ::: "memory");
    const int c = lane & 7;
#pragma unroll
    for (int j = 0; j < 4; ++j) { const int n = (lane >> 3) + 8 * j; const LAS float* s = scr + (8 * c) * 33 + n;
        v4u o; o.x = pk2(s[0 * 33], s[1 * 33]); o.y = pk2(s[2 * 33], s[3 * 33]); o.z = pk2(s[4 * 33], s[5 * 33]); o.w = pk2(s[6 * 33], s[7 * 33]);
        *(GAS v4u*)(WT + (size_t)(n0 + n) * ldk + koff + k0 + 8 * c) = o; }
    LDS_WAIT(); asm volatile("" ::: "memory");
}
__device__ __forceinline__ void phase_weights(Frame& F, int l) {
    LAS float* scr = (LAS float*)(F.lds + RING_OFF + F.wave * 16384);
    const int gw = F.vcu * NWAVES + F.wave, NGW = F.G * NWAVES;
    GAS bf16* WinT = (GAS bf16*)(wsq(F) + WS_WIN); GAS bf16* WoutT = (GAS bf16*)(wsq(F) + WS_WOUT); GAS bf16* WupT = (GAS bf16*)(wsq(F) + WS_WUP); GAS bf16* WdownT = (GAS bf16*)(wsq(F) + WS_WDOWN);
    GAS bf16* WuqT = (GAS bf16*)(wsq(F) + WS_WUQ); GAS bf16* WukvT = (GAS bf16*)(wsq(F) + WS_WUKV);
    constexpr int I_IN = (D / 64) * (INW / 32), I_OUT = (D / 64) * (D / 32), I_UP = (D / 64) * (FF / 32), I_DN = (FF / 64) * (D / 32), I_UQ = (QR / 64) * (NQ / 32), I_UKV = (KVR / 64) * (NKV / 32);
    constexpr int I_W3 = 2048 / 32;
    constexpr int NITEMS = I_IN + I_OUT + I_UP + I_DN + I_UQ + I_UKV + 2 * I_W3;
    for (int it = gw; it < NITEMS; it += NGW) {
        int r = it;
        if (r < I_IN) { transpose_item<false>(inp(F, I_WIN) + (size_t)l * D * INW, D, INW, WinT, scr, r, F.lane); continue; } r -= I_IN;
        if (r < I_OUT) { transpose_item<false>(inp(F, I_WOUT) + (size_t)l * D * D, D, D, WoutT, scr, r, F.lane); continue; } r -= I_OUT;
        if (r < I_UP) { transpose_item<false>(inp(F, I_WUP) + (size_t)l * D * FF, D, FF, WupT, scr, r, F.lane); continue; } r -= I_UP;
        if (r < I_DN) { transpose_item<false>(inp(F, I_WDOWN) + (size_t)l * FF * D, FF, D, WdownT, scr, r, F.lane); continue; } r -= I_DN;
        if (r < I_UQ) { transpose_item<true>(inp(F, I_WUQ) + (size_t)l * QR * NQ, QR, NQ, WuqT, scr, r, F.lane); continue; } r -= I_UQ;
        if (r < I_UKV) { transpose_item<false>(inp(F, I_WUKV) + (size_t)l * KVR * NKV, KVR, NKV, WukvT, scr, r, F.lane); continue; } r -= I_UKV;
        transpose_item<false>(inp(F, I_FW3) + (size_t)l * 64 * 2048, 64, 2048, (GAS bf16*)(wsq(F) + WS_W3T), scr, r % I_W3, F.lane, 128, (r / I_W3) * 64);
    }
    { unsigned z = 0u; asm volatile("" : "+v"(z)); const v4u zz = {z, z, z, z};
      for (int i = gw * 64 + F.lane; i < 12288; i += NGW * 64) ((GAS v4u*)(WinT + (size_t)INW * D))[i] = zz; }
}
__device__ __forceinline__ void phase_rope_tab(Frame& F) {
    const float inv[16] = {1.000000000e+00f, 5.623413324e-01f, 3.162277639e-01f, 1.778279394e-01f, 1.000000015e-01f, 5.623412877e-02f, 3.162277862e-02f, 1.778279431e-02f,
                           9.999999776e-03f, 5.623413250e-03f, 3.162277862e-03f, 1.778279431e-03f, 1.000000047e-03f, 5.623413017e-04f, 3.162277862e-04f, 1.778279402e-04f};
    GAS float* ct = (GAS float*)(wsq(F) + WS_COS); GAS float* st = (GAS float*)(wsq(F) + WS_SIN);
    for (int i = F.vcu * NTHR + F.tid; i < L * 16; i += F.G * NTHR) {
        const int t = i >> 4, j = i & 15; float iv = inv[0];
#pragma unroll
        for (int q = 1; q < 16; ++q) iv = (j == q) ? inv[q] : iv;
        const float ang = (float)t * iv; ct[i] = cosf(ang); st[i] = sinf(ang);
    }
}
__device__ __forceinline__ const GAS float* x_src_row(Frame& F, int l, int m) {
    if (l == 0) return (m < 2 * L) ? inp(F, I_XP) + (size_t)m * D : inp(F, I_XS) + (size_t)(m - 2 * L) * D;
    return (const GAS float*)F.out + (size_t)m * D;
}
__device__ __forceinline__ void store_xn_row(f32x4 (&v)[4], float rstd, const GAS float* g, GAS bf16* orow, int lane) {
    GAS v2u* o8 = (GAS v2u*)orow + lane;
#pragma unroll
    for (int j = 0; j < 4; ++j) { const f32x4 gg = ((const GAS f32x4*)g)[lane + 64 * j]; v2u w; w.x = pk2(v[j].x * rstd * gg.x, v[j].y * rstd * gg.y); w.y = pk2(v[j].z * rstd * gg.z, v[j].w * rstd * gg.w); o8[64 * j] = w; }
}
__device__ __forceinline__ float row_ss(const f32x4 (&v)[4]) { float s = 0.f;
#pragma unroll
    for (int j = 0; j < 4; ++j) s += (v[j].x * v[j].x + v[j].y * v[j].y) + (v[j].z * v[j].z + v[j].w * v[j].w);
    return wave_sum(s); }
__device__ __forceinline__ void phase_norm_first(Frame& F, int l, const GAS float* g) {
    const int gw = F.vcu * NWAVES + F.wave, NGW = F.G * NWAVES; GAS bf16* XN = (GAS bf16*)(wsq(F) + WS_XN);
    for (int m = gw; m < M; m += NGW) {
        const GAS f32x4* xr = (const GAS f32x4*)x_src_row(F, l, m) + F.lane; f32x4 v[4];
#pragma unroll
        for (int j = 0; j < 4; ++j) v[j] = xr[64 * j];
        const float rstd = 1.0f / sqrtf(row_ss(v) * (1.0f / D) + EPS);
        store_xn_row(v, rstd, g, XN + (size_t)m * D, F.lane);
    }
}
__device__ __forceinline__ void phase_norm_res(Frame& F, int lsrc, const GAS bf16* T, const GAS float* gpost, const GAS float* gnext) {
    const int gw = F.vcu * NWAVES + F.wave, NGW = F.G * NWAVES; GAS bf16* XN = (GAS bf16*)(wsq(F) + WS_XN);
    for (int m0 = gw; m0 < M; m0 += 2 * NGW) {
        f32x4 v[2][4], tv[2][4];
#pragma unroll
        for (int q = 0; q < 2; ++q) { const int m = m0 + q * NGW; const GAS f32x4* xr = (const GAS f32x4*)x_src_row(F, lsrc, m) + F.lane; const GAS v2u* tr = (const GAS v2u*)(T + (size_t)m * D) + F.lane;
#pragma unroll
            for (int j = 0; j < 4; ++j) { v[q][j] = xr[64 * j]; const v2u w = tr[64 * j]; tv[q][j] = (f32x4){bf2f(w.x & 0xffffu), bf2f(w.x >> 16), bf2f(w.y & 0xffffu), bf2f(w.y >> 16)}; } }
#pragma unroll
        for (int q = 0; q < 2; ++q) { const int m = m0 + q * NGW;
            const float rt = 1.0f / sqrtf(row_ss(tv[q]) * (1.0f / D) + EPS);
            GAS f32x4* orow = (GAS f32x4*)(F.out + (size_t)m * D) + F.lane;
#pragma unroll
            for (int j = 0; j < 4; ++j) { const f32x4 gg = ((const GAS f32x4*)gpost)[F.lane + 64 * j]; v[q][j] = v[q][j] + tv[q][j] * rt * gg; orow[64 * j] = v[q][j]; }
            if (gnext) { const float rstd = 1.0f / sqrtf(row_ss(v[q]) * (1.0f / D) + EPS); store_xn_row(v[q], rstd, gnext, XN + (size_t)m * D, F.lane); } }
    }
}

__device__ __forceinline__ void phase_filter_mlp(Frame& F, int l) {
    const GAS float* w1 = inp(F, I_FW1) + (size_t)l * 33 * 64; const GAS float* b1 = inp(F, I_FB1) + l * 64; const GAS float* w2 = inp(F, I_FW2) + (size_t)l * 64 * 64; const GAS float* b2 = inp(F, I_FB2) + l * 64;
    const GAS float* sf = inp(F, I_SINF) + l * 128; GAS bf16* H2 = (GAS bf16*)(wsq(F) + WS_H2);
    const int lane = F.lane, gw = F.vcu * NWAVES + F.wave, NGW = F.G * NWAVES;
    float w1c[33], w2c[64];
#pragma unroll
    for (int f = 0; f < 33; ++f) w1c[f] = w1[f * 64 + lane];
#pragma unroll
    for (int i = 0; i < 64; ++i) w2c[i] = w2[i * 64 + lane];
    const float b1l = b1[lane], b2l = b2[lane], sf0 = sf[lane], sf1 = sf[64 + lane];
    for (int n = gw; n < L; n += NGW) {
        const float tn = (float)n * (1.0f / (float)(L - 1)); const float omega = (float)(2.0 * 3.14159265358979323846 / L) * (float)n;
        const int bidx = (lane >= 17) ? lane - 17 : lane - 1; const float band = 1e-4f + (float)bidx * ((15.0f - 1e-4f) / 15.0f); const float ph = omega * band;
        const float zf = (lane == 0) ? tn : ((lane <= 16) ? cosf(ph) : -sinf(ph));
        float acc = b1l;
#pragma unroll
        for (int f = 0; f < 33; ++f) acc += __uint_as_float(__builtin_amdgcn_readlane(__float_as_uint(zf), f)) * w1c[f];
        const float h1 = sinf(sf0 * acc);
        float acc2 = b2l;
#pragma unroll
        for (int i = 0; i < 64; ++i) acc2 += __uint_as_float(__builtin_amdgcn_readlane(__float_as_uint(h1), i)) * w2c[i];
        const float hv = sinf(sf1 * acc2); const bf16 hi = f2bf(hv);
        H2[(size_t)n * 128 + lane] = hi; H2[(size_t)n * 128 + 64 + lane] = f2bf(hv - bf2f(hi));
    }
}

__device__ __forceinline__ void phase_filter_fft(Frame& F, int l) {
    const GAS float* KT = (const GAS float*)(wsq(F) + WS_KT); GAS f32x2* KEO = (GAS f32x2*)(wsq(F) + WS_KEO); const GAS float* hb = inp(F, I_HBIAS) + (size_t)l * 2 * HYW;
    LAS f32x2* buf = (LAS f32x2*)(F.lds + RING_OFF); const int t = F.tid;
    for (int item = F.vcu; item < 2 * HYW; item += F.G) {
        const int o = item >> 9, c = item & 511;
        const GAS float* fw = KT + (size_t)((o * 2 + 0) * HYW + c) * L; const GAS float* bw = KT + (size_t)((o * 2 + 1) * HYW + c) * L;
        const float bias = hb[o * HYW + c]; const float sc = 1.0f / (2.0f * L);
        GAS f32x2* ke = KEO + (size_t)item * KEO_BLK; GAS f32x2* ko = ke + KEO_KO;
        float ar[32], ai[32];
        { const int tq = hfft::opaque(t); (void)tq;
#pragma unroll
        for (int m = 0; m < 32; ++m) { const int n = tq + 512 * m; const float f = fw[n]; float b = bw[n >= 1 ? L - n : 0]; b = n >= 1 ? b : 0.f; ar[m] = f + b; ai[m] = 0.f; if ((m & 15) == 15) { asm volatile("" ::: "memory"); __builtin_amdgcn_sched_barrier(0); } }
        }
        hfft::fft16k<false>(ar, ai, buf, t);
        { const int tq = hfft::opaque(t); (void)tq;
#pragma unroll
        for (int m = 0; m <= 16; ++m) { const int k = tq + 512 * m; if (k <= 8192) ke[k] = (f32x2){(ar[m] + bias) * sc, ai[m] * sc}; }
        }
        { const int tq = hfft::opaque(t); (void)tq;
#pragma unroll
        for (int m = 0; m < 32; ++m) { const int n = tq + 512 * m; const float f = fw[n]; float b = bw[n >= 1 ? L - n : 0]; b = n >= 1 ? b : 0.f; const float d = f - b; const float fr = (float)n * (1.0f / 32768.0f);
            ar[m] = d * __builtin_amdgcn_cosf(fr); ai[m] = -d * __builtin_amdgcn_sinf(fr); if ((m & 15) == 15) { asm volatile("" ::: "memory"); __builtin_amdgcn_sched_barrier(0); } }
        }
        hfft::fft16k<false>(ar, ai, buf, t);
        { const int tq = hfft::opaque(t); (void)tq;
#pragma unroll
        for (int m = 0; m < 16; ++m) { const int k = tq + 512 * m; ko[k] = (f32x2){(ar[m] + bias) * sc, ai[m] * sc}; }
        }
    }
    __syncthreads();
}

__device__ __forceinline__ float u_conv3(const GAS bf16* row, int n, float w0, float w1, float w2, float cb) {
    const int nm = n >= 1 ? n - 1 : 0, np = n + 1 < L ? n + 1 : L - 1;
    float um = bf2f(row[nm]), up = bf2f(row[np]); const float u0 = bf2f(row[n]);
    um = n >= 1 ? um : 0.f; up = n + 1 < L ? up : 0.f;
    return um * w0 + u0 * w1 + up * w2 + cb;
}
__device__ __forceinline__ void cmul_spec(float (&xr)[32], float (&xi)[32], const GAS f32x2* ke, int t, bool odd) {
    { const int tq = hfft::opaque(t); (void)tq;
#pragma unroll
    for (int m = 0; m < 32; ++m) { const int k = tq + 512 * m; int idx; bool cj;
        if (!odd) { cj = k > 8192; idx = cj ? 16384 - k : k; } else { cj = k >= 8192; idx = cj ? 16383 - k : k; }
        const f32x2 kv = ke[idx]; const float kr = kv.x, ki = cj ? -kv.y : kv.y;
        const float a = xr[m], b = xi[m]; xr[m] = a * kr - b * ki; xi[m] = a * ki + b * kr; if ((m & 15) == 15) { asm volatile("" ::: "memory"); __builtin_amdgcn_sched_barrier(0); } }
    }
}
__device__ __forceinline__ void phase_hyena(Frame& F, int l) {
    const GAS bf16* UT = (const GAS bf16*)(wsq(F) + WS_UT); GAS bf16* YT = (GAS bf16*)(wsq(F) + WS_YT); const GAS f32x2* KEO = (const GAS f32x2*)(wsq(F) + WS_KEO);
    const GAS float* cw = inp(F, I_CONVW) + (size_t)l * 3 * HYP; const GAS float* cbv = inp(F, I_CONVB) + (size_t)l * HYP;
    LAS f32x2* buf = (LAS f32x2*)(F.lds + RING_OFF); const int t = F.tid;
    GAS f32x2* G0 = (GAS f32x2*)(wsq(F) + WS_G0) + (size_t)F.vcu * 16384 + t;
    GAS f32x2* G1 = (GAS f32x2*)(wsq(F) + (F.vcu < 200 ? WS_G1A + (size_t)F.vcu * 131072 : WS_G1B + (size_t)(F.vcu - 200) * 131072)) + t;
    for (int item = F.vcu; item < 2 * HYW; item += F.G) {
        const int c = item >> 1, pair = item & 1; const int b0 = pair ? 2 : 0;
        float ar[32], ai[32];
#pragma unroll 1
        for (int o = 0; o < 2; ++o) {
            const GAS f32x2* ke = KEO + (size_t)(o * HYW + c) * KEO_BLK; const GAS f32x2* ko = ke + KEO_KO;
#pragma unroll 1
            for (int half = 0; half < 2; ++half) {
                if (o == 0) { const int ch = c; const float w0 = cw[ch], w1 = cw[HYP + ch], w2 = cw[2 * HYP + ch], cb = cbv[ch];
                    const GAS bf16* r0 = UT + (size_t)ch * M + (size_t)b0 * L; const GAS bf16* r1 = pair ? r0 : r0 + L;
                    { const int tq = hfft::opaque(t); (void)tq;
#pragma unroll
                    for (int m = 0; m < 32; ++m) { const int n = tq + 512 * m; ar[m] = u_conv3(r0, n, w0, w1, w2, cb); { const float q1 = u_conv3(r1, n, w0, w1, w2, cb); ai[m] = pair ? 0.f : q1; } if ((m & 15) == 15) { asm volatile("" ::: "memory"); __builtin_amdgcn_sched_barrier(0); } } }
                    }
                else {
                    { const int tq = hfft::opaque(t); (void)tq; GAS f32x2* G0q = G0 + (tq - t);
#pragma unroll
                    for (int m = 0; m < 32; ++m) { const f32x2 v = G0q[m * 512]; ar[m] = v.x; ai[m] = v.y; if ((m & 15) == 15) { asm volatile("" ::: "memory"); __builtin_amdgcn_sched_barrier(0); } } }
                    }
                if (half == 0) {
                    hfft::fft16k<false>(ar, ai, buf, t);
                    cmul_spec(ar, ai, ke, t, false);
                    hfft::fft16k<true>(ar, ai, buf, t);
                    { const int tq = hfft::opaque(t); (void)tq; GAS f32x2* G1q = G1 + (tq - t);
#pragma unroll
                    for (int m = 0; m < 32; ++m) G1q[m * 512] = (f32x2){ar[m], ai[m]};
                    }
                } else {
                    { const int tq = hfft::opaque(t); (void)tq;
#pragma unroll
                    for (int m = 0; m < 32; ++m) { const float fr = (float)(tq + 512 * m) * (1.0f / 32768.0f); const float cs = __builtin_amdgcn_cosf(fr), sn = -__builtin_amdgcn_sinf(fr);
                        const float a = ar[m], b = ai[m]; ar[m] = a * cs - b * sn; ai[m] = a * sn + b * cs; }
                    }
                    hfft::fft16k<false>(ar, ai, buf, t);
                    cmul_spec(ar, ai, ko, t, true);
                    hfft::fft16k<true>(ar, ai, buf, t);
                    const int ch = (o + 1) * HYW + c; const float w0 = cw[ch], w1 = cw[HYP + ch], w2 = cw[2 * HYP + ch], cb = cbv[ch];
                    const GAS bf16* r0 = UT + (size_t)ch * M + (size_t)b0 * L; const GAS bf16* r1 = pair ? r0 : r0 + L;
                    { const int tq = hfft::opaque(t); (void)tq; GAS f32x2* G1q = G1 + (tq - t);
#pragma unroll
                    for (int m = 0; m < 32; ++m) { const int n = tq + 512 * m; const float fr = (float)n * (1.0f / 32768.0f); const float cs = __builtin_amdgcn_cosf(fr), sn = __builtin_amdgcn_sinf(fr);
                        const float a = ar[m], b = ai[m]; const f32x2 e = G1q[m * 512]; const float yr = e.x + (a * cs - b * sn), yi = e.y + (a * sn + b * cs);
                        ar[m] = yr * u_conv3(r0, n, w0, w1, w2, cb); { const float q1 = yi * u_conv3(r1, n, w0, w1, w2, cb); ai[m] = pair ? 0.f : q1; } if ((m & 15) == 15) { asm volatile("" ::: "memory"); __builtin_amdgcn_sched_barrier(0); } }
                    }
                    if (o == 0) {
                        { const int tq = hfft::opaque(t); (void)tq; GAS f32x2* G0q = G0 + (tq - t);
#pragma unroll
                        for (int m = 0; m < 32; ++m) G0q[m * 512] = (f32x2){ar[m], ai[m]};
                        }
                    } else { GAS bf16* y0 = YT + (size_t)c * M + (size_t)b0 * L; GAS bf16* y1 = y0 + L;
                        { const int tq = hfft::opaque(t); (void)tq;
#pragma unroll
                        for (int m = 0; m < 32; ++m) { const int n = tq + 512 * m; y0[n] = f2bf(ar[m]); if (!pair) y1[n] = f2bf(ai[m]); } }
                        }
                }
            }
        }
    }
    __syncthreads();
}

__device__ __forceinline__ void phase_mla_prep(Frame& F, int l) {
    const GAS bf16* CQKV = (const GAS bf16*)(wsq(F) + WS_CQKV); GAS bf16* CQN = (GAS bf16*)(wsq(F) + WS_CQN); GAS bf16* CKVN = (GAS bf16*)(wsq(F) + WS_CKVN); GAS bf16* KPE = (GAS bf16*)(wsq(F) + WS_KPE);
    const GAS float* gq = inp(F, I_QNORM) + l * QR; const GAS float* gkv = inp(F, I_KVNORM) + l * KVR; const GAS float* ct = (const GAS float*)(wsq(F) + WS_COS); const GAS float* st = (const GAS float*)(wsq(F) + WS_SIN);
    const int gw = F.vcu * NWAVES + F.wave, NGW = F.G * NWAVES, lane = F.lane;
    for (int m = gw; m < M; m += NGW) {
        const GAS bf16* row = CQKV + (size_t)m * 512;
        const v2u q = *(const GAS v2u*)(row + 4 * lane); const unsigned kv = *(const GAS unsigned*)(row + 256 + 2 * lane);
        const float q0 = bf2f(q.x & 0xffffu), q1 = bf2f(q.x >> 16), q2 = bf2f(q.y & 0xffffu), q3 = bf2f(q.y >> 16), k0 = bf2f(kv & 0xffffu), k1 = bf2f(kv >> 16);
        const float rq = 1.0f / sqrtf(wave_sum((q0 * q0 + q1 * q1) + (q2 * q2 + q3 * q3)) * (1.0f / QR) + EPS);
        const float rk = 1.0f / sqrtf(wave_sum(k0 * k0 + k1 * k1) * (1.0f / KVR) + EPS);
        const f32x4 g4 = *(const GAS f32x4*)(gq + 4 * lane); const f32x2 g2 = *(const GAS f32x2*)(gkv + 2 * lane);
        v2u oq; oq.x = pk2(q0 * rq * g4.x, q1 * rq * g4.y); oq.y = pk2(q2 * rq * g4.z, q3 * rq * g4.w);
        *(GAS v2u*)(CQN + (size_t)m * QR + 4 * lane) = oq;
        *(GAS unsigned*)(CKVN + (size_t)m * KVR + 2 * lane) = pk2(k0 * rk * g2.x, k1 * rk * g2.y);
        if (lane < 16) { const int j = lane, tpos = m & (L - 1); const float x1 = bf2f(row[384 + j]), x2 = bf2f(row[384 + 16 + j]); const float cs = ct[tpos * 16 + j], sn = st[tpos * 16 + j];
            const int p1 = 8 * (j >> 2) + (j & 3); KPE[(size_t)m * ROPE + p1] = f2bf(x1 * cs - x2 * sn); KPE[(size_t)m * ROPE + p1 + 4] = f2bf(x2 * cs + x1 * sn); }
    }
}

__device__ __forceinline__ void phase_hy_out(Frame& F, int l) {
    const GAS bf16* YT = (const GAS bf16*)(wsq(F) + WS_YT); GAS bf16* MIX = (GAS bf16*)(wsq(F) + WS_MIX); const GAS float* gn = inp(F, I_GNHY) + l * HYW;
    LAS bf16* tl = (LAS bf16*)(F.lds + RING_OFF + F.wave * 16384);
    const int gw = F.vcu * NWAVES + F.wave, NGW = F.G * NWAVES, lane = F.lane;
    for (int task = gw; task < 8 * (M / 64); task += NGW) {
        const int g = task & 7, tb = task >> 3, tok0 = tb * 64; const int cl = lane >> 3, t8 = (lane & 7) * 8;
        float v[8][8]; float ss[8];
#pragma unroll
        for (int j = 0; j < 8; ++j) ss[j] = 0.f;
#pragma unroll
        for (int i = 0; i < 8; ++i) { const int ch = g * 64 + 8 * i + cl; const v4u w = *(const GAS v4u*)(YT + (size_t)ch * M + tok0 + t8);
            v[i][0] = bf2f(w.x & 0xffffu); v[i][1] = bf2f(w.x >> 16); v[i][2] = bf2f(w.y & 0xffffu); v[i][3] = bf2f(w.y >> 16);
            v[i][4] = bf2f(w.z & 0xffffu); v[i][5] = bf2f(w.z >> 16); v[i][6] = bf2f(w.w & 0xffffu); v[i][7] = bf2f(w.w >> 16);
#pragma unroll
            for (int j = 0; j < 8; ++j) ss[j] += v[i][j] * v[i][j]; }
#pragma unroll
        for (int j = 0; j < 8; ++j) { float s = ss[j]; s += __shfl_xor(s, 8); s += __shfl_xor(s, 16); s += __shfl_xor(s, 32); ss[j] = 1.0f / sqrtf(s * (1.0f / 64.0f) + EPS); }
#pragma unroll
        for (int i = 0; i < 8; ++i) { const int cc = 8 * i + cl; const float gg = gn[g * 64 + cc];
#pragma unroll
            for (int j = 0; j < 8; ++j) tl[(t8 + j) * 72 + cc] = f2bf(v[i][j] * ss[j] * gg); }
        LDS_WAIT(); asm volatile("" ::: "memory");
#pragma unroll
        for (int i = 0; i < 8; ++i) { const int tok = 8 * i + (lane >> 3), c8 = (lane & 7) * 8; const v4u w = *(const LAS v4u*)(tl + tok * 72 + c8);
            *(GAS v4u*)(MIX + (size_t)(tok0 + tok) * D + g * 64 + c8) = w; }
        LDS_WAIT(); asm volatile("" ::: "memory");
    }
}

namespace att {
using s16x4 = __attribute__((ext_vector_type(4))) short;
using f32x16 = __attribute__((ext_vector_type(16))) float;
using u32x4 = __attribute__((ext_vector_type(4))) unsigned;
constexpr int QBLK = 32, KVBLK = 64, NW = 8;
constexpr float SCALE = 0.10206207261596575f;
constexpr float THR = 8.f;
constexpr int SHM_K = KVBLK * 256, SHM_V = KVBLK * DV * 2;
constexpr int NSLOT = 3;
constexpr int OFF_V = 0, OFF_K = NSLOT * SHM_V, OFF_WS = OFF_K + NSLOT * SHM_K, SHM_ATTN = OFF_WS + NW * 64 * 4;
#define KSWZ(row, colB) ((row) * 256 + ((colB) ^ (((row) & 15) << 4)))
#define SBAR() __builtin_amdgcn_sched_barrier(0)
__device__ __forceinline__ int crow(int r, int hi) { return (r & 3) + 8 * (r >> 2) + 4 * hi; }
__device__ __forceinline__ unsigned cvtpk(float lo, float hi) { unsigned r; asm volatile("v_cvt_pk_bf16_f32 %0, %1, %2" : "=v"(r) : "v"(lo), "v"(hi)); return r; }
constexpr float THRL = THR * 1.4426950408889634f;
#define EX2(v) __builtin_amdgcn_exp2f(v)
#define MX3(a, b, c) __builtin_fmaxf(__builtin_fmaxf((a), (b)), (c))
__device__ __forceinline__ int v_st(int k, int c) { const int kk = (k & ~0xC) | ((k & 4) << 1) | ((k & 8) >> 1); return ((kk >> 3) * 2 + (c >> 5)) * 512 + ((kk & 7) * 32 + (c & 31)) * 2; }
__device__ __forceinline__ int v_rd_base(int lane) { return ((lane & 3) << 3) | (((lane >> 2) & 3) << 6) | (((lane >> 4) & 1) << 5) | (((lane >> 5) & 1) << 8); }
constexpr int v_rd_off(int d0, int ks, int half) { return d0 * 512 + ks * 2048 + half * 1024; }
template <int OFF> __device__ __forceinline__ s16x4 tr_read(int vb) { s16x4 r; asm volatile("ds_read_b64_tr_b16 %0, %1 offset:%2" : "=&v"(r) : "v"(vb), "i"(OFF) : "memory"); return r; }
__device__ __forceinline__ void attn_unit(const bf16* Qb_, const bf16* KNh_, const bf16* KPEb_, const bf16* Vh_, bf16* Mo_,
                                          const float* gain_, const float* ct_, const float* st_, int tpos0, LAS char* lds, const int wave0) {
  const GAS bf16* Qb = (const GAS bf16*)Qb_; const GAS bf16* KNh = (const GAS bf16*)KNh_; const GAS bf16* KPEb = (const GAS bf16*)KPEb_; const GAS bf16* Vh = (const GAS bf16*)Vh_; GAS bf16* Mo = (GAS bf16*)Mo_;
  const GAS float* gain = (const GAS float*)gain_; const GAS float* ct = (const GAS float*)ct_; const GAS float* st = (const GAS float*)st_;

  int tid_ = tid_from_wave(wave0);
  const int tid = tid_, wid = tid >> 6, lane = tid & 63, r32 = lane & 31, hi = lane >> 5;
  LAS char* V_lds = lds + OFF_V; LAS char* K_lds = lds + OFF_K;
  LAS float* ws = (LAS float*)(lds + OFF_WS) + wid * 64; LAS float* li_l = ws; LAS float* al_l = ws + 32;
  float m_reg = 0.f, l_reg = 0.f; f32x16 o[2] = {}; f32x16 negm = {}; bf16x8 qr[6];
  const GAS bf16* Qw = Qb + (long)(wid * QBLK + r32) * NQ + hi * 8;
#pragma unroll
  for (int d0 = 0; d0 < 6; ++d0) qr[d0] = *reinterpret_cast<const GAS bf16x8*>(Qw + d0 * 16);
  { const int tq = tpos0 + wid * QBLK + r32;
#pragma unroll
    for (int d0 = 4; d0 < 6; ++d0) { const int fq = 2 * (d0 - 4) + hi; const f32x4 cs = *reinterpret_cast<const GAS f32x4*>(ct + tq * 16 + 4 * fq), sn = *reinterpret_cast<const GAS f32x4*>(st + tq * 16 + 4 * fq);
      const u32x4 w = __builtin_bit_cast(u32x4, qr[d0]);
      const f32x4 x1 = {bf2f(w[0] & 0xffffu), bf2f(w[0] >> 16), bf2f(w[1] & 0xffffu), bf2f(w[1] >> 16)}, x2 = {bf2f(w[2] & 0xffffu), bf2f(w[2] >> 16), bf2f(w[3] & 0xffffu), bf2f(w[3] >> 16)};
      const f32x4 a = x1 * cs - x2 * sn, b = x2 * cs + x1 * sn;
      const u32x4 o4 = {cvtpk(a[0], a[1]), cvtpk(a[2], a[3]), cvtpk(b[0], b[1]), cvtpk(b[2], b[3])}; qr[d0] = __builtin_bit_cast(bf16x8, o4); } }
  { constexpr float C = SCALE * 1.4426950408889634f;
#pragma unroll
    for (int d0 = 0; d0 < 6; ++d0) { const u32x4 w = __builtin_bit_cast(u32x4, qr[d0]); u32x4 o4;
#pragma unroll
      for (int e = 0; e < 4; ++e) o4[e] = cvtpk(bf2f(w[e] & 0xffffu) * C, bf2f(w[e] >> 16) * C);
      qr[d0] = __builtin_bit_cast(bf16x8, o4); } }
  const int sr = tid >> 3, sc = (tid & 7) * 8;
  const int rr_ = (tid & 255) >> 2, rc = (tid & 3) * 8;
  const int vst0 = v_st(sr, sc), kst0 = KSWZ(sr, sc * 2), kst1 = KSWZ(rr_, 128 + rc * 2);
  const int vb0 = (int)(unsigned)(uintptr_t)V_lds + v_rd_base(lane);
  struct { bf16x8 vs, kn, kr; } sr_[2];
#define SLOAD(i, k0) do { sr_[i].vs = *reinterpret_cast<const GAS bf16x8*>(&Vh[(long)((k0) + sr) * NKV + sc]); sr_[i].kn = *reinterpret_cast<const GAS bf16x8*>(&KNh[(long)((k0) + sr) * NKV + sc]); \
    sr_[i].kr = *reinterpret_cast<const GAS bf16x8*>(&KPEb[(long)((k0) + rr_) * ROPE + rc]); } while (0)
#define SWRITE(b, i) do { *(LAS bf16x8*)(V_lds + (b) * SHM_V + vst0) = sr_[i].vs; *(LAS bf16x8*)(K_lds + (b) * SHM_K + kst0) = sr_[i].kn; *(LAS bf16x8*)(K_lds + (b) * SHM_K + kst1) = sr_[i].kr; } while (0)
#define SWAIT() asm volatile("s_waitcnt vmcnt(3)" ::: "memory")
#define RESC(a) do { if (__any((a) < 1.f)) { if (hi == 0) al_l[r32] = (a); asm volatile("s_waitcnt lgkmcnt(0)" ::: "memory"); \
    _Pragma("unroll") for (int d = 0; d < 2; ++d) _Pragma("unroll") for (int r = 0; r < 16; ++r) o[d][r] *= al_l[crow(r, hi)]; } } while (0)
  f32x16 pA0, pA1, pB0, pB1; bf16x8 pa0, pa1, pa2, pa3; constexpr int NTL = L / KVBLK; constexpr int SE = 0, SO = 1;
  int koff[6];
#pragma unroll
  for (int d0 = 0; d0 < 6; ++d0) koff[d0] = KSWZ(r32, (d0 * 16 + hi * 8) * 2);
  s16x4 vl[4], vh[4]; float pmax = 0.f, alpha = 1.f;
#define KFR(i) (*(const LAS bf16x8*)(kbase + koff[(i) >> 1] + ((i) & 1) * 8192))
#define VRD8(D0) do { vl[0] = tr_read<v_rd_off(D0, 0, 0)>(vbq); vh[0] = tr_read<v_rd_off(D0, 0, 1)>(vbq); vl[1] = tr_read<v_rd_off(D0, 1, 0)>(vbq); vh[1] = tr_read<v_rd_off(D0, 1, 1)>(vbq); \
    vl[2] = tr_read<v_rd_off(D0, 2, 0)>(vbq); vh[2] = tr_read<v_rd_off(D0, 2, 1)>(vbq); vl[3] = tr_read<v_rd_off(D0, 3, 0)>(vbq); vh[3] = tr_read<v_rd_off(D0, 3, 1)>(vbq); } while (0)
#define VWAIT() asm volatile("s_waitcnt lgkmcnt(0)" : "+v"(vl[0]), "+v"(vh[0]), "+v"(vl[1]), "+v"(vh[1]), "+v"(vl[2]), "+v"(vh[2]), "+v"(vl[3]), "+v"(vh[3]) :: "memory")
#define VFR(k) (bf16x8){vl[k][0], vl[k][1], vl[k][2], vl[k][3], vh[k][0], vh[k][1], vh[k][2], vh[k][3]}
#define PKA(P, B) do { ca_ = cvtpk(P[B + 0], P[B + 1]); cb_ = cvtpk(P[B + 4], P[B + 5]); auto r_ = __builtin_amdgcn_permlane32_swap(ca_, cb_, false, false); w0_ = r_[0]; w2_ = r_[1]; } while (0)
#define PKB(P, B, OUT) do { ca_ = cvtpk(P[B + 2], P[B + 3]); cb_ = cvtpk(P[B + 6], P[B + 7]); auto r_ = __builtin_amdgcn_permlane32_swap(ca_, cb_, false, false); \
    const u32x4 w_ = {w0_, r_[0], w2_, r_[1]}; OUT = __builtin_bit_cast(bf16x8, w_); } while (0)
#define R1(DO_QK, DO_FIN, X0, X1, Y0, Y1, KSLOT) do { const LAS char* kbase = K_lds + (KSLOT) * SHM_K; bf16x8 kf0, kf1, kf2, kf3; unsigned ca_, cb_, w0_ = 0, w2_ = 0; \
    if (DO_QK) { kf0 = KFR(0); kf1 = KFR(1); kf2 = KFR(2); } SBAR(); \
      if (DO_QK) { kf3 = KFR(3); X0 = __builtin_amdgcn_mfma_f32_32x32x16_bf16(kf0, qr[0], negm, 0, 0, 0); } if (DO_FIN) { Y0[0] = EX2(Y0[0]); Y0[1] = EX2(Y0[1]); Y0[2] = EX2(Y0[2]); Y0[3] = EX2(Y0[3]); } SBAR(); \
      if (DO_QK) { kf0 = KFR(4); X1 = __builtin_amdgcn_mfma_f32_32x32x16_bf16(kf1, qr[0], negm, 0, 0, 0); } if (DO_FIN) { Y0[4] = EX2(Y0[4]); Y0[5] = EX2(Y0[5]); Y0[6] = EX2(Y0[6]); Y0[7] = EX2(Y0[7]); } SBAR(); \
      if (DO_QK) { kf1 = KFR(5); X0 = __builtin_amdgcn_mfma_f32_32x32x16_bf16(kf2, qr[1], X0, 0, 0, 0); } if (DO_FIN) { Y0[8] = EX2(Y0[8]); Y0[9] = EX2(Y0[9]); Y0[10] = EX2(Y0[10]); Y0[11] = EX2(Y0[11]); } SBAR(); \
      if (DO_QK) { kf2 = KFR(6); X1 = __builtin_amdgcn_mfma_f32_32x32x16_bf16(kf3, qr[1], X1, 0, 0, 0); } if (DO_FIN) { Y0[12] = EX2(Y0[12]); Y0[13] = EX2(Y0[13]); Y0[14] = EX2(Y0[14]); Y0[15] = EX2(Y0[15]); } SBAR(); \
      if (DO_QK) { kf3 = KFR(7); X0 = __builtin_amdgcn_mfma_f32_32x32x16_bf16(kf0, qr[2], X0, 0, 0, 0); } if (DO_FIN) { Y1[0] = EX2(Y1[0]); Y1[1] = EX2(Y1[1]); Y1[2] = EX2(Y1[2]); Y1[3] = EX2(Y1[3]); PKA(Y0, 0); } SBAR(); \
      if (DO_QK) { kf0 = KFR(8); X1 = __builtin_amdgcn_mfma_f32_32x32x16_bf16(kf1, qr[2], X1, 0, 0, 0); } if (DO_FIN) { Y1[4] = EX2(Y1[4]); Y1[5] = EX2(Y1[5]); Y1[6] = EX2(Y1[6]); Y1[7] = EX2(Y1[7]); PKB(Y0, 0, pa0); } SBAR(); \
      if (DO_QK) { kf1 = KFR(9); X0 = __builtin_amdgcn_mfma_f32_32x32x16_bf16(kf2, qr[3], X0, 0, 0, 0); } if (DO_FIN) { Y1[8] = EX2(Y1[8]); Y1[9] = EX2(Y1[9]); Y1[10] = EX2(Y1[10]); Y1[11] = EX2(Y1[11]); PKA(Y0, 8); } SBAR(); \
      if (DO_QK) { kf2 = KFR(10); X1 = __builtin_amdgcn_mfma_f32_32x32x16_bf16(kf3, qr[3], X1, 0, 0, 0); } if (DO_FIN) { Y1[12] = EX2(Y1[12]); Y1[13] = EX2(Y1[13]); Y1[14] = EX2(Y1[14]); Y1[15] = EX2(Y1[15]); PKB(Y0, 8, pa1); } SBAR(); \
      if (DO_QK) { kf3 = KFR(11); X0 = __builtin_amdgcn_mfma_f32_32x32x16_bf16(kf0, qr[4], X0, 0, 0, 0); } if (DO_FIN) { PKA(Y1, 0); } SBAR(); \
      if (DO_QK) { X1 = __builtin_amdgcn_mfma_f32_32x32x16_bf16(kf1, qr[4], X1, 0, 0, 0); } if (DO_FIN) { PKB(Y1, 0, pa2); } SBAR(); \
      if (DO_QK) { X0 = __builtin_amdgcn_mfma_f32_32x32x16_bf16(kf2, qr[5], X0, 0, 0, 0); } if (DO_FIN) { PKA(Y1, 8); } SBAR(); \
      if (DO_QK) { X1 = __builtin_amdgcn_mfma_f32_32x32x16_bf16(kf3, qr[5], X1, 0, 0, 0); } if (DO_FIN) { PKB(Y1, 8, pa3); } SBAR(); \
  } while (0)
#define R2(DO_PV, DO_MAX, X0, X1, Y0, Y1, VSLOT, LOADS) do { const int vbq = vb0 + (VSLOT) * SHM_V; float ma_ = 0.f, mb_ = 0.f, sa_ = 0.f; \
    if (DO_PV) { VRD8(0); } SBAR(); \
    if (DO_PV) { VWAIT(); o[0] = __builtin_amdgcn_mfma_f32_32x32x16_bf16(pa0, VFR(0), o[0], 0, 0, 0); sa_ = (Y0[0] + Y0[1]) + (Y0[2] + Y0[3]); } SBAR(); \
    if (DO_PV) { o[0] = __builtin_amdgcn_mfma_f32_32x32x16_bf16(pa1, VFR(1), o[0], 0, 0, 0); sa_ += Y0[4]; sa_ += Y0[5]; sa_ += Y0[6]; sa_ += Y0[7]; } LOADS; SBAR(); \
    if (DO_PV) { o[0] = __builtin_amdgcn_mfma_f32_32x32x16_bf16(pa2, VFR(2), o[0], 0, 0, 0); sa_ += Y0[8]; sa_ += Y0[9]; sa_ += Y0[10]; sa_ += Y0[11]; } SBAR(); \
    if (DO_PV) { o[0] = __builtin_amdgcn_mfma_f32_32x32x16_bf16(pa3, VFR(3), o[0], 0, 0, 0); sa_ += Y0[12]; sa_ += Y0[13]; sa_ += Y0[14]; sa_ += Y0[15]; } SBAR(); \
    if (DO_PV) { VRD8(1); sa_ += Y1[0]; sa_ += Y1[1]; sa_ += Y1[2]; sa_ += Y1[3]; sa_ += Y1[4]; sa_ += Y1[5]; sa_ += Y1[6]; sa_ += Y1[7]; } \
    if (DO_MAX) { ma_ = MX3(X0[0], X0[1], X1[0]); mb_ = MX3(X0[2], X0[3], X1[1]); ma_ = MX3(ma_, X1[2], X1[3]); ma_ = MX3(ma_, X0[4], X0[5]); mb_ = MX3(mb_, X0[6], X0[7]); ma_ = MX3(ma_, X1[4], X1[5]); mb_ = MX3(mb_, X1[6], X1[7]); } SBAR(); \
    if (DO_PV) { VWAIT(); o[1] = __builtin_amdgcn_mfma_f32_32x32x16_bf16(pa0, VFR(0), o[1], 0, 0, 0); sa_ += Y1[8]; sa_ += Y1[9]; sa_ += Y1[10]; sa_ += Y1[11]; } if (DO_MAX) { ma_ = MX3(ma_, X0[8], X0[9]); mb_ = MX3(mb_, X0[10], X0[11]); } SBAR(); \
    if (DO_PV) { o[1] = __builtin_amdgcn_mfma_f32_32x32x16_bf16(pa1, VFR(1), o[1], 0, 0, 0); sa_ += Y1[12]; sa_ += Y1[13]; sa_ += Y1[14]; sa_ += Y1[15]; } if (DO_MAX) { ma_ = MX3(ma_, X1[8], X1[9]); mb_ = MX3(mb_, X1[10], X1[11]); } SBAR(); \
    if (DO_PV) { o[1] = __builtin_amdgcn_mfma_f32_32x32x16_bf16(pa2, VFR(2), o[1], 0, 0, 0); l_reg += sa_; } if (DO_MAX) { ma_ = MX3(ma_, X0[12], X0[13]); mb_ = MX3(mb_, X0[14], X0[15]); ma_ = MX3(ma_, X1[12], X1[13]); mb_ = MX3(mb_, X1[14], X1[15]); } SBAR(); \
    if (DO_PV) { o[1] = __builtin_amdgcn_mfma_f32_32x32x16_bf16(pa3, VFR(3), o[1], 0, 0, 0); } if (DO_MAX) { float m_ = __builtin_fmaxf(ma_, mb_); auto rr_ = __builtin_amdgcn_permlane32_swap(__float_as_uint(m_), __float_as_uint(m_), false, false); pmax = __builtin_fmaxf(__uint_as_float(rr_[0]), __uint_as_float(rr_[1])); } SBAR(); \
  } while (0)
#define DECIDE(FIRST, X0, X1) do { alpha = 1.f; \
    if ((FIRST) || !__builtin_expect(__all(pmax <= THRL), 1)) { const float d_ = (FIRST) ? pmax : __builtin_fmaxf(pmax, 0.f); m_reg += d_; if (!(FIRST)) alpha = EX2(-d_); \
      _Pragma("unroll") for (int r = 0; r < 16; ++r) { X0[r] -= d_; X1[r] -= d_; } \
      _Pragma("unroll") for (int r = 0; r < 16; ++r) negm[r] = -m_reg; l_reg *= alpha; } \
    RESC(alpha); } while (0)
  int sp_ = 0, sc_ = 0, sn_ = 1;
#define ROT() do { sp_ = sc_; sc_ = sn_; sn_ = (sn_ == NSLOT - 1) ? 0 : sn_ + 1; } while (0)
  SLOAD(SE, 0); asm volatile("s_waitcnt vmcnt(0)" ::: "memory"); SWRITE(0, SE); __syncthreads();
  R1(true, false, pA0, pA1, pB0, pB1, 0);
  R2(false, true, pA0, pA1, pB0, pB1, 0, (void)0);
  DECIDE(true, pA0, pA1);
  SLOAD(SO, KVBLK); SLOAD(SE, 2 * KVBLK);
  SWAIT(); SWRITE(1, SO); __syncthreads();
  ROT();
  for (int j = 1; j + 1 < NTL; j += 2) {
    R1(true, true, pB0, pB1, pA0, pA1, sc_);
    R2(true, true, pB0, pB1, pA0, pA1, sp_, SLOAD(SO, (j + 2) * KVBLK));
    DECIDE(false, pB0, pB1);
    SWAIT(); SWRITE(sn_, SE);
    __syncthreads(); ROT();
    R1(true, true, pA0, pA1, pB0, pB1, sc_);
    R2(true, true, pA0, pA1, pB0, pB1, sp_, if (j + 3 < NTL) SLOAD(SE, (j + 3) * KVBLK));
    DECIDE(false, pA0, pA1);
    SWAIT(); SWRITE(sn_, SO);
    __syncthreads(); ROT();
  }
  R1(true, true, pB0, pB1, pA0, pA1, sc_);
  R2(true, true, pB0, pB1, pA0, pA1, sp_, (void)0);
  DECIDE(false, pB0, pB1);
  R1(false, true, pA0, pA1, pB0, pB1, sc_);
  R2(true, false, pA0, pA1, pB0, pB1, sc_, (void)0);
#undef ROT
#undef DECIDE
#undef R2
#undef R1
#undef PKA
#undef PKB
#undef VFR
#undef VWAIT
#undef VRD8
#undef KFR
  { auto rr = __builtin_amdgcn_permlane32_swap(__float_as_uint(l_reg), __float_as_uint(l_reg), false, false); l_reg = __uint_as_float(rr[0]) + __uint_as_float(rr[1]); }
  if (hi == 0) li_l[r32] = l_reg; asm volatile("s_waitcnt lgkmcnt(0)" ::: "memory");
  const float g0 = gain[r32], g1 = gain[32 + r32];
  GAS bf16* Ow = Mo + (long)(wid * QBLK) * D;
#pragma unroll
  for (int r = 0; r < 16; ++r) { const int orow = crow(r, hi); const float rl = __builtin_amdgcn_rcpf(li_l[orow]);
    const float y0 = o[0][r] * rl, y1 = o[1][r] * rl; float s = y0 * y0 + y1 * y1;
    s += __shfl_xor(s, 1); s += __shfl_xor(s, 2); s += __shfl_xor(s, 4); s += __shfl_xor(s, 8); s += __shfl_xor(s, 16);
    const float rs = 1.0f / sqrtf(s * (1.0f / 64.0f) + EPS);
    Ow[(long)orow * D + r32] = f2bf(y0 * rs * g0); Ow[(long)orow * D + 32 + r32] = f2bf(y1 * rs * g1); }
  __syncthreads();
#undef SLOAD
#undef SWRITE
#undef SWAIT
#undef RESC
}
#undef EX2
#undef MX3
#undef KSWZ
#undef SBAR
}
#define XB_TMO      128
#define XB_XCNT(j)  (256  + 64 * (j))
#define XB_XSUB(j)  (1280 + 64 * (j))
#define XB_XGEN(j)  (2304 + 64 * (j))
#define XB_TOP      3328
#define XB_TOPGEN   3392
#define XCD_BAR_WORDS 3456
#define XB_SPIN_CAP (1u << 18)

__device__ __forceinline__ unsigned xb_ld(unsigned* p)              { return __hip_atomic_load(p, __ATOMIC_RELAXED, __HIP_MEMORY_SCOPE_AGENT); }
__device__ __forceinline__ unsigned xb_add(unsigned* p, unsigned v) { return __hip_atomic_fetch_add(p, v, __ATOMIC_RELAXED, __HIP_MEMORY_SCOPE_AGENT); }
__device__ __forceinline__ unsigned xb_xcc_id() { return (unsigned)__builtin_amdgcn_s_getreg((3 << 11) | 20) & 0xFu; }
#define XB_SPIN(cond, bar) do { unsigned _sp = 0; while (cond) { __builtin_amdgcn_s_sleep(1); \
    if ((++_sp & 255u) == 0u) { if (xb_ld(&(bar)[XB_TMO])) break; if (_sp > XB_SPIN_CAP) { atomicAdd(&(bar)[XB_TMO], 1u); break; } } } } while (0)

struct XcdBarrier {
    unsigned* bar; unsigned x;
    volatile LAS unsigned* st;
};

__device__ __forceinline__ XcdBarrier xcd_barrier_post(unsigned* bar, volatile LAS unsigned* st, const bool t0) {
    XcdBarrier b; b.bar = bar; b.x = xb_xcc_id(); b.st = st;
    if (t0) (void)xb_add(&bar[XB_XCNT(b.x)], 1u);
    return b;
}
__device__ __forceinline__ void xcd_barrier_complete(unsigned* bar, unsigned x, unsigned& nloc, unsigned& nx) {
    const unsigned G = gridDim.x * gridDim.y * gridDim.z;
    unsigned sum, cnt, mine, sp = 0u;
    for (;;) {
        sum = 0u; cnt = 0u; mine = 0u;
#pragma unroll
        for (unsigned j = 0; j < 16; ++j) { const unsigned c = xb_ld(&bar[XB_XCNT(j)]); sum += c; cnt += (c > 0u) ? 1u : 0u; mine = (j == x) ? c : mine; }
        if (sum == G) break;
        __builtin_amdgcn_s_sleep(1);
        if ((++sp & 255u) == 0u) { if (xb_ld(&bar[XB_TMO])) break; if (sp > XB_SPIN_CAP) { atomicAdd(&bar[XB_TMO], 1u); break; } }
    }
    nloc = mine > 0u ? mine : 1u; nx = cnt > 0u ? cnt : 1u;
}

__device__ __forceinline__ void xcd_barrier(const XcdBarrier& b, const bool t0) {
    asm volatile("s_waitcnt vmcnt(0)" ::: "memory");
    __syncthreads();
    if (t0) {
        unsigned* bar = b.bar;
        __builtin_amdgcn_s_waitcnt(0);
        unsigned nloc = b.st[0], nx = b.st[1];
        if (nloc == 0u) { xcd_barrier_complete(bar, b.x, nloc, nx); b.st[0] = nloc; b.st[1] = nx; }
        const unsigned old = xb_add(&bar[XB_XSUB(b.x)], 1u);
        const unsigned gen = old / nloc;
        if (old + 1u == (gen + 1u) * nloc) {
            __builtin_amdgcn_fence(__ATOMIC_RELEASE, "agent");
            asm volatile("s_waitcnt vmcnt(0)" ::: "memory");
            const unsigned og = xb_add(&bar[XB_TOP], 1u);
            const unsigned tg = og / nx;
            if (og + 1u == (tg + 1u) * nx) xb_add(&bar[XB_TOPGEN], 1u);
            else XB_SPIN(xb_ld(&bar[XB_TOPGEN]) == tg, bar);
            __builtin_amdgcn_fence(__ATOMIC_ACQUIRE, "agent");
            xb_add(&bar[XB_XGEN(b.x)], 1u);
            asm volatile("s_waitcnt vmcnt(0)" ::: "memory");
        } else {
            XB_SPIN(xb_ld(&bar[XB_XGEN(b.x)]) == gen, bar);
            __builtin_amdgcn_fence(__ATOMIC_ACQUIRE, "agent");
            asm volatile("s_waitcnt vmcnt(0)" ::: "memory");
        }
    }
    __syncthreads();
}

__device__ __forceinline__ void xcd_barrier_fast(const XcdBarrier& b, const bool t0) {
    asm volatile("s_waitcnt vmcnt(0)" ::: "memory");
    __syncthreads();
    if (t0) {
        unsigned* bar = b.bar; asm volatile("" : "+s"(bar));
        __builtin_amdgcn_s_waitcnt(0);
        unsigned nloc = b.st[0], nx = b.st[1];
        unsigned bx_ = b.x; asm volatile("" : "+s"(bx_));
        const unsigned old = xb_add(&bar[XB_XSUB(bx_)], 1u);
        const unsigned gen = old / nloc;
        if (old + 1u == (gen + 1u) * nloc) {
            __builtin_amdgcn_fence(__ATOMIC_RELEASE, "agent");
            asm volatile("s_waitcnt vmcnt(0)" ::: "memory");
            const unsigned og = xb_add(&bar[XB_TOP], 1u);
            const unsigned tg = og / nx;
            if (og + 1u == (tg + 1u) * nx) xb_add(&bar[XB_TOPGEN], 1u);
            else XB_SPIN(xb_ld(&bar[XB_TOPGEN]) == tg, bar);
            __builtin_amdgcn_fence(__ATOMIC_ACQUIRE, "agent");
            xb_add(&bar[XB_XGEN(bx_)], 1u);
            asm volatile("s_waitcnt vmcnt(0)" ::: "memory");
        } else {
            XB_SPIN(xb_ld(&bar[XB_XGEN(bx_)]) == gen, bar);
            __builtin_amdgcn_fence(__ATOMIC_ACQUIRE, "agent");
            asm volatile("s_waitcnt vmcnt(0)" ::: "memory");
        }
    }
    __syncthreads();
}

constexpr int CW_BAR = 4096;
struct Args { const float* in[26]; float* out; unsigned char* ws; };
#ifndef REP_ATT
#define REP_ATT 1
#endif
#ifndef REP_GEMM
#define REP_GEMM 1
#endif
#ifndef REP_HY
#define REP_HY 1
#endif
#ifndef REP_FILT
#define REP_FILT 1
#endif
#ifndef REP_MISC
#define REP_MISC 1
#endif
#ifndef PROBE_MASK
#define PROBE_MASK 0
#endif
#define TIC() do { if (PROBE_MASK) pr_t0 = __builtin_amdgcn_s_memrealtime(); } while (0)
#define TOC(ph) do { if (PROBE_MASK & (1u << (ph))) pr_acc += __builtin_amdgcn_s_memrealtime() - pr_t0; } while (0)
#define REPEAT(n) _Pragma("unroll 1") for (int rep_ = 0; rep_ < (n); ++rep_)
#define REFRESH() do { const int t_ = tid_from_wave(F.wave0); F.tid = t_; F.lane = t_ & 63; F.wave = __builtin_amdgcn_readfirstlane(t_ >> 6); int v_ = F.vcu; asm volatile("" : "+s"(v_)); F.vcu = v_; } while (0)
#define BXQ() ({ int b_ = (int)blockIdx.x; asm volatile("" : "+s"(b_)); b_; })
#define GEMM_PHASE(EPI, g, S, E) REPEAT(REP_GEMM) pg8::gemm_phase<EPI, pg8::StaticOrder, true, true>(F.lds + RING_OFF, g, S, E, F.wave0)

__global__ void __launch_bounds__(NTHR, 2) hyena_mla_fwd(Args args) {
    extern __shared__ __attribute__((aligned(16))) unsigned char lds[];
    Frame F;
    F.lds = (LAS unsigned char*)lds;
    F.MISC = (volatile LAS unsigned*)(F.lds + MISC_OFF);
    F.tid = threadIdx.x; F.lane = F.tid & 63; F.wave = __builtin_amdgcn_readfirstlane(F.tid >> 6); F.wave0 = F.wave;
    F.G = gridDim.x; { const int bx = blockIdx.x; F.vcu = (F.G % 8 == 0) ? (bx % 8) * (F.G / 8) + bx / 8 : bx; }
    F.ws = args.ws; F.out = args.out; F.ctl = (gu32*)(args.ws + WS_CTL);
    if (F.tid == 0) {
#pragma unroll
        for (int i = 0; i < 26; ++i) *(LAS unsigned long long*)(F.lds + PTRTAB_OFF + 8 * i) = (unsigned long long)args.in[i];
    }
    for (int u = F.tid; u < 512 / 4; u += NTHR) ((LAS unsigned*)(F.lds + LDSCTL_OFF))[u] = 0u;
    __syncthreads();
    XcdBarrier bar = xcd_barrier_post((unsigned*)(F.ctl + CW_BAR), F.MISC + 8, F.tid == 0);
    xcd_barrier(bar, F.tid == 0);
    unsigned long long pr_t0 = 0, pr_acc = 0; (void)pr_t0;
#pragma unroll 1
    for (int l = 0; l < DEPTH; ++l) {
        TIC();
        REPEAT(REP_MISC) { REFRESH(); phase_weights(F, l); }
        __syncthreads();
        REFRESH(); phase_filter_mlp(F, l);
        if (l == 0) { REFRESH(); phase_rope_tab(F); REFRESH(); phase_norm_first(F, 0, inp(F, I_NMIXPRE)); }
        { REFRESH(); xcd_barrier_fast(bar, F.tid == 0); } TOC(0); TIC();
        { unsigned char* w = (unsigned char*)wsq(F); pg8::Gemm g{(bf16*)(w + WS_W3T), (bf16*)(w + WS_H2), 2048, L, 128}; pg8::StaticOrder S; S.init(2048, L, F.G, BXQ());
          pg8::EpiTaps E{(float*)(w + WS_KT), (const float*)inp(F, I_DECAY) + (size_t)l * 2048}; GEMM_PHASE(pg8::EpiTaps, g, S, E); }
        { REFRESH(); xcd_barrier_fast(bar, F.tid == 0); } TOC(1); TIC();
        REPEAT(REP_FILT) { REFRESH(); phase_filter_fft(F, l); }
        { REFRESH(); xcd_barrier_fast(bar, F.tid == 0); } TOC(2); TIC();
        { unsigned char* w = (unsigned char*)wsq(F); bf16* WinT = (bf16*)(w + WS_WIN); bf16* XN = (bf16*)(w + WS_XN); bf16* UT = (bf16*)(w + WS_UT); bf16* CQKV = (bf16*)(w + WS_CQKV);
          { pg8::Gemm g{WinT, XN, HYP, M, D}; pg8::StaticOrder S; S.init(HYP, M, F.G, BXQ());
          pg8::EpiBf16<0> E{UT, M, nullptr, 0, 0, 1.f}; GEMM_PHASE(pg8::EpiBf16<0>, g, S, E); }
        { pg8::Gemm g{XN, WinT + (size_t)HYP * D, M, 512, D}; pg8::StaticOrder S; S.init(M, 512, F.G, (BXQ() + 128) % F.G);
          pg8::EpiBf16<0> E{CQKV, 512, nullptr, 0, 0, 1.f}; GEMM_PHASE(pg8::EpiBf16<0>, g, S, E); } }
        { REFRESH(); xcd_barrier_fast(bar, F.tid == 0); } TOC(3); TIC();
        REPEAT(REP_MISC) { REFRESH(); phase_mla_prep(F, l); }
        REPEAT(REP_HY) { REFRESH(); phase_hyena(F, l); }
        { REFRESH(); xcd_barrier_fast(bar, F.tid == 0); } TOC(4); TIC();
        { unsigned char* w = (unsigned char*)wsq(F); bf16* CQN = (bf16*)(w + WS_CQN); bf16* CKVN = (bf16*)(w + WS_CKVN); bf16* WuqT = (bf16*)(w + WS_WUQ); bf16* WukvT = (bf16*)(w + WS_WUKV);
          bf16* Qb = (bf16*)(w + WS_Q); bf16* KV = (bf16*)(w + WS_KN);
          { pg8::Gemm g{CQN, WuqT, M, NQ, QR}; pg8::StaticOrder S; S.init(M, NQ, F.G, BXQ());
          pg8::EpiBf16<0> E{Qb, NQ, nullptr, 0, 0, 1.f}; GEMM_PHASE(pg8::EpiBf16<0>, g, S, E); }
        { pg8::Gemm g{CKVN, WukvT, M, NKV, KVR}; pg8::StaticOrder S; S.init(M, NKV, F.G, BXQ());
          pg8::EpiBf16<0> E{KV, NKV, nullptr, 0, 0, 1.f}; GEMM_PHASE(pg8::EpiBf16<0>, g, S, E); } }
        { REFRESH(); xcd_barrier_fast(bar, F.tid == 0); } TOC(5); TIC();
        REFRESH();
        { unsigned char* w = (unsigned char*)wsq(F); bf16* Qb = (bf16*)(w + WS_Q); bf16* KV = (bf16*)(w + WS_KN); bf16* KPE = (bf16*)(w + WS_KPE); bf16* MIX = (bf16*)(w + WS_MIX);
          const float* ct = (const float*)(w + WS_COS); const float* st = (const float*)(w + WS_SIN); const float* gat = (const float*)inp(F, I_GNAT) + l * 512;
        REPEAT(REP_ATT) for (int i = 0; i < 6; ++i) {
            const int bh = 3 * (F.vcu >> 5) + (i >> 1), qb = (i & 1) * 32 + (F.vcu & 31); const int b = bh >> 3, h = bh & 7;
            const size_t row0 = (size_t)b * L + (size_t)qb * 256;
            att::attn_unit(Qb + row0 * NQ + h * DQ, KV + (size_t)b * L * NKV + h * 128, KPE + (size_t)b * L * ROPE, KV + (size_t)b * L * NKV + h * 128 + 64,
                           MIX + row0 * D + 512 + h * 64, gat + h * 64, ct, st, qb * 256, (LAS char*)(F.lds + RING_OFF), F.wave0);
        } }
        REPEAT(REP_MISC) { REFRESH(); phase_hy_out(F, l); }
        { REFRESH(); xcd_barrier_fast(bar, F.tid == 0); } TOC(6); TIC();
        { unsigned char* w = (unsigned char*)wsq(F); bf16* MIX = (bf16*)(w + WS_MIX); bf16* WoutT = (bf16*)(w + WS_WOUT); bf16* T = (bf16*)(w + WS_T);
          pg8::Gemm g{MIX, WoutT, M, D, D}; pg8::StaticOrder S; S.init(M, D, F.G, BXQ());
          pg8::EpiBf16<0> E{T, D, nullptr, 0, 0, 1.f}; GEMM_PHASE(pg8::EpiBf16<0>, g, S, E); }
        { REFRESH(); xcd_barrier_fast(bar, F.tid == 0); } TOC(7); TIC();
        REFRESH(); phase_norm_res(F, l, (const GAS bf16*)(wsq(F) + WS_T), inp(F, I_NMIXPOST) + l * D, inp(F, I_NMLPPRE) + l * D);
        { REFRESH(); xcd_barrier_fast(bar, F.tid == 0); } TOC(8); TIC();
#pragma unroll 1
        for (int ch = 0; ch < N_MLP_CHUNKS; ++ch) {
            { unsigned char* w = (unsigned char*)wsq(F); bf16* XN = (bf16*)(w + WS_XN); bf16* WupT = (bf16*)(w + WS_WUP); bf16* Hb = (bf16*)(w + WS_H);
              pg8::Gemm g{XN + (size_t)ch * MLP_CHUNK * D, WupT, MLP_CHUNK, FF, D}; pg8::StaticOrder S; S.init(MLP_CHUNK, FF, F.G, BXQ());
              pg8::EpiRelu2 E{Hb, FF}; GEMM_PHASE(pg8::EpiRelu2, g, S, E); }
            { REFRESH(); xcd_barrier_fast(bar, F.tid == 0); } TOC(9); TIC();
            { unsigned char* w = (unsigned char*)wsq(F); bf16* Hb = (bf16*)(w + WS_H); bf16* WdownT = (bf16*)(w + WS_WDOWN); bf16* T = (bf16*)(w + WS_T);
              pg8::Gemm g{Hb, WdownT, MLP_CHUNK, D, FF}; pg8::StaticOrder S; S.init(MLP_CHUNK, D, F.G, BXQ());
              pg8::EpiBf16<0> E{T + (size_t)ch * MLP_CHUNK * D, D, nullptr, 0, 0, 1.f}; GEMM_PHASE(pg8::EpiBf16<0>, g, S, E); }
            { REFRESH(); xcd_barrier_fast(bar, F.tid == 0); } TOC(10); TIC();
        }
        REFRESH(); phase_norm_res(F, 1, (const GAS bf16*)(wsq(F) + WS_T), inp(F, I_NMLPPOST) + l * D, (l + 1 < DEPTH) ? inp(F, I_NMIXPRE) + (l + 1) * D : (const GAS float*)nullptr);
        { REFRESH(); xcd_barrier_fast(bar, F.tid == 0); } TOC(11); TIC();
    }
    if (PROBE_MASK) { const unsigned long long ts = __builtin_amdgcn_s_memrealtime(); while (__builtin_amdgcn_s_memrealtime() - ts < pr_acc) __builtin_amdgcn_s_sleep(8); }
}

extern "C" void kernel_launch(void* const* d_in, const int* in_sizes, int n_in, void* d_out, int out_size, void* d_ws, size_t ws_size, hipStream_t stream) {
    static int grid = 0;
    if (grid == 0) {
        if (n_in != 26 || out_size != M * D || ws_size < WS_END) { fprintf(stderr, "kernel_launch: shape mismatch n_in %d out %d ws %zu (need %zu)\n", n_in, out_size, ws_size, (size_t)WS_END); grid = -1; return; }
        int dev = 0, cus = 0, per_cu = 0;
        if (hipGetDevice(&dev) != hipSuccess || hipDeviceGetAttribute(&cus, hipDeviceAttributeMultiprocessorCount, dev) != hipSuccess) { grid = -1; return; }
        if (hipFuncSetAttribute((const void*)hyena_mla_fwd, hipFuncAttributeMaxDynamicSharedMemorySize, LDS_BYTES) != hipSuccess) { fprintf(stderr, "kernel_launch: hipFuncSetAttribute failed\n"); grid = -1; return; }
        if (hipOccupancyMaxActiveBlocksPerMultiprocessor(&per_cu, (const void*)hyena_mla_fwd, NTHR, LDS_BYTES) != hipSuccess || per_cu < 1) fprintf(stderr, "kernel_launch: occupancy query says %d\n", per_cu);
        (void)hipGetLastError();
        grid = cus;
    }
    if (grid < 0) return;
    if (hipMemsetAsync((char*)d_ws + WS_CTL, 0, CTL_ZERO_BYTES, stream) != hipSuccess) { fprintf(stderr, "kernel_launch: memset failed\n"); return; }
    Args a{};
    for (int i = 0; i < 26; ++i) a.in[i] = (const float*)d_in[i];
    a.out = (float*)d_out; a.ws = (unsigned char*)d_ws;
    hipLaunchKernelGGL(hyena_mla_fwd, dim3(grid), dim3(NTHR), LDS_BYTES, stream, a);
    const hipError_t le = hipPeekAtLastError();
    if (le != hipSuccess) fprintf(stderr, "kernel_launch: launch failed: %s\n", hipGetErrorName(le));
}
```

```cpp
#include <hip/hip_runtime.h>
#include <cstdio>
#include <cstdint>
__device__ __forceinline__ int hw_lane() { int l; asm volatile("v_mbcnt_lo_u32_b32 %0, -1, 0\n\tv_mbcnt_hi_u32_b32 %0, -1, %0" : "=v"(l)); return l; }
__device__ __forceinline__ int tid_from_wave(int wave0) { int w = wave0; asm volatile("" : "+s"(w)); int t = w * 64 + hw_lane(); asm volatile("" : "+v"(t)); return t; }
namespace pg8 {
#define PG8_LAS __attribute__((address_space(3)))
#define PG8_GAS __attribute__((address_space(1)))
typedef unsigned short bf16_t;
typedef short bf16x8 __attribute__((ext_vector_type(8)));
typedef float f32x4 __attribute__((ext_vector_type(4)));
typedef unsigned u32x4 __attribute__((ext_vector_type(4)));
constexpr int BM = 256, BK = 64, HALF = 128, HTB = HALF * BK * 2  , STAGE_BYTES = 8 * HTB, NXCD = 8, WGM = 8;

__host__ __device__ __forceinline__ int lds_byte(int r, int c) { const int st = (r >> 4) * 2 + (c >> 5), rr = r & 15, cc = c & 31, ob = rr * 64 + cc * 2; return st * 1024 + (ob ^ (((ob >> 9) & 1) << 5)); }
__host__ __device__ __forceinline__ void stage_rc(int b, int& R, int& C) { const int st = b / 1024, sb = b % 1024, swz = sb ^ (((sb >> 9) & 1) << 5); R = (st >> 1) * 16 + swz / 64; C = (st & 1) * 32 + (swz % 64) / 2; }
__host__ __device__ __forceinline__ int perm32(int rho) { const int n = rho >> 4, i = rho & 15; return 8 * (i >> 2) + 4 * n + (i & 3); }

struct Unit { int pm, pn; };
struct Gemm { const bf16_t* A; const bf16_t* Bt; int M, N, K; };

struct StaticOrder {
    int nM, nN, nwg, G, c;
    __host__ __device__ void init(int M, int N, int G_, int c_) { nM = M / BM; nN = N / BM; nwg = nM * nN; G = G_; c = c_; }
    __host__ __device__ bool next(int i, Unit& u) const {
        const long L = (long)i * G + c; if (L >= nwg) return false;
        int wgid = (int)L; { const int q = nwg / NXCD, r = nwg % NXCD, xcd = wgid % NXCD, off = wgid / NXCD; wgid = (xcd < r ? xcd * (q + 1) : r * (q + 1) + (xcd - r) * q) + off; }
        const int nig = WGM * nN, gid = wgid / nig, fm = gid * WGM, gsz = (nM - fm) < WGM ? (nM - fm) : WGM;
        u.pm = fm + ((wgid % nig) % gsz); u.pn = (wgid % nig) / gsz; return true;
    }
    __device__ __forceinline__ void a_ready(const Unit&) const {}
    __device__ __forceinline__ void done(const Unit&) const {}
};

__device__ __forceinline__ unsigned cvt_pk_bf16(float lo, float hi) { unsigned r; asm volatile("v_cvt_pk_bf16_f32 %0, %1, %2" : "=v"(r) : "v"(lo), "v"(hi)); return r; }
typedef float f32x2 __attribute__((ext_vector_type(2)));
__device__ __forceinline__ void relane(int& wr, int& wc, int& fr, int& fq) { int l = hw_lane(); asm volatile("" : "+v"(l)); fr = l & 15; fq = l >> 4; (void)wr; (void)wc; }
__device__ __forceinline__ f32x2 gelu_pk(f32x2 v) {
    const f32x2 av = __builtin_elementwise_abs(v), d = av * 0.2316418882f + 1.0f;
    f32x2 t; t.x = __builtin_amdgcn_rcpf(d.x); t.y = __builtin_amdgcn_rcpf(d.y);
    f32x2 q = t * 0.5307027145f + (-0.7265760135f); q = q * t + 0.7107068705f; q = q * t + (-0.142248368f); q = q * t + 0.127414796f; q = q * t;
    const f32x2 s = (v * v) * (-0.72134752044f);
    f32x2 e; e.x = __builtin_amdgcn_exp2f(s.x); e.y = __builtin_amdgcn_exp2f(s.y);
    const f32x2 m = v * (q * e), r = v - m;
    f32x2 o; o.x = v.x < 0.f ? m.x : r.x; o.y = v.y < 0.f ? m.y : r.y; return o;
}

template <int ACT  > struct EpiBf16 {
    static constexpr bool PERM = true, AFTER_DRAIN = false; static_assert(ACT == 0 || ACT == 1, "EpiBf16: ACT is 0 (none) or 1 (gelu_pk)");
    bf16_t* O; int ldc; const float* bias; int split_cols; size_t split_stride; float scale0;
    __device__ __forceinline__ void operator()(const f32x4 (&acc)[2][2][4][2], const Unit& u, int wr, int wc, int fr, int fq) const {
        relane(wr, wc, fr, fq);
        const int row0 = u.pm * BM + wr * 64 + fr; int colt = u.pn * BM; bf16_t* base = O;
        float sc = 1.f; if (split_cols) { const int t = colt / split_cols; base += (size_t)t * split_stride; colt -= t * split_cols; if (t == 0) sc = scale0; }
        const int col0 = colt + wc * 32 + 8 * fq, bcol0 = u.pn * BM + wc * 32 + 8 * fq;
        f32x4 bv[2][2];
#pragma unroll
        for (int bj = 0; bj < 2; ++bj)
#pragma unroll
            for (int n = 0; n < 2; ++n) bv[bj][n] = bias ? *(const PG8_GAS f32x4*)(bias + bcol0 + bj * HALF + 4 * n) : (f32x4){0.f, 0.f, 0.f, 0.f};
#pragma unroll
        for (int ai = 0; ai < 2; ++ai)
#pragma unroll
            for (int m = 0; m < 4; ++m) { bf16_t* rowp = base + (size_t)(row0 + ai * HALF + m * 16) * ldc + col0;
#pragma unroll
                for (int bj = 0; bj < 2; ++bj) { f32x4 v0 = acc[ai][bj][m][0] + bv[bj][0], v1 = acc[ai][bj][m][1] + bv[bj][1];
                    if (ACT == 1) { f32x2 a = gelu_pk((f32x2){v0[0], v0[1]}), b = gelu_pk((f32x2){v0[2], v0[3]}), c = gelu_pk((f32x2){v1[0], v1[1]}), d = gelu_pk((f32x2){v1[2], v1[3]});
                        v0 = (f32x4){a.x, a.y, b.x, b.y}; v1 = (f32x4){c.x, c.y, d.x, d.y}; }
                    v0 = v0 * sc; v1 = v1 * sc; u32x4 w; w.x = cvt_pk_bf16(v0[0], v0[1]); w.y = cvt_pk_bf16(v0[2], v0[3]); w.z = cvt_pk_bf16(v1[0], v1[1]); w.w = cvt_pk_bf16(v1[2], v1[3]);
                    *(PG8_GAS u32x4*)(rowp + bj * HALF) = w; } }
    }
};

struct PanelStats {
    unsigned* xbuf;
    unsigned* cnt;
    unsigned* tmo;
    int ntn; float eps;
    unsigned code;
    __device__ __forceinline__ bool run(const f32x4 (&v)[2][2][4][2], const Unit& u, int wr, int wc, int fr, int fq, PG8_LAS unsigned char* lds, int wid, int lane) const {
        typedef float f32x2v __attribute__((ext_vector_type(2)));
        PG8_LAS f32x2v* P = (PG8_LAS f32x2v*)lds;
        PG8_LAS f32x2v* S = (PG8_LAS f32x2v*)(lds + 8192);
        PG8_LAS unsigned* flag = (PG8_LAS unsigned*)(lds + 8192 + 2048);
#pragma unroll
        for (int ai = 0; ai < 2; ++ai)
#pragma unroll
            for (int m = 0; m < 4; ++m) {
                float s = 0.f;
#pragma unroll
                for (int bj = 0; bj < 2; ++bj)
#pragma unroll
                    for (int n = 0; n < 2; ++n) { const f32x4 x = v[ai][bj][m][n]; s += (x[0] + x[1]) + (x[2] + x[3]); }
                s += __shfl_xor(s, 16); s += __shfl_xor(s, 32);
                const float mw = s * (1.0f / 64.0f); float q = 0.f;
#pragma unroll
                for (int bj = 0; bj < 2; ++bj)
#pragma unroll
                    for (int n = 0; n < 2; ++n) { const f32x4 d = v[ai][bj][m][n] - mw; q += (d[0] * d[0] + d[1] * d[1]) + (d[2] * d[2] + d[3] * d[3]); }
                q += __shfl_xor(q, 16); q += __shfl_xor(q, 32);
                if (fq == 0) P[(ai * HALF + wr * 64 + m * 16 + fr) * 4 + wc] = (f32x2v){mw, q};
            }
        asm volatile("s_waitcnt lgkmcnt(0)" ::: "memory"); __builtin_amdgcn_s_barrier(); asm volatile("" ::: "memory");
#if defined(BROKEN_EXCHANGE_NO_WAIT)
#warning BROKEN CONTROL BUILD: the row-statistics exchange does not wait; results are wrong by design
        if (blockIdx.x >= 64) { const long long t0_ = clock64(); while (clock64() - t0_ < 60000) __builtin_amdgcn_s_sleep(8); }
#endif
        const int row = wid * 32 + (lane & 31);
        if (lane < 32) {
            const f32x2v a = P[row * 4 + 0], b = P[row * 4 + 1], c = P[row * 4 + 2], d = P[row * 4 + 3];
            const float mt = (a.x + b.x + c.x + d.x) * 0.25f;
            const float da = a.x - mt, db = b.x - mt, dc = c.x - mt, dd = d.x - mt;
            const float m2 = (a.y + b.y) + (c.y + d.y) + 64.0f * ((da * da + db * db) + (dc * dc + dd * dd));
            unsigned long long* slot = (unsigned long long*)xbuf + ((size_t)(u.pm * BM + row) * 4 + u.pn);
            __hip_atomic_store(slot, ((unsigned long long)__float_as_uint(m2) << 32) | __float_as_uint(mt), __ATOMIC_RELAXED, __HIP_MEMORY_SCOPE_AGENT);
        }
        asm volatile("s_waitcnt vmcnt(0)" ::: "memory");
        if (lane == 0) __hip_atomic_fetch_add(cnt + 64 * u.pm, 1u, __ATOMIC_RELAXED, __HIP_MEMORY_SCOPE_AGENT);
        if (wid == 0) {
            bool dead = false; const unsigned long long t0 = __builtin_amdgcn_s_memrealtime(); const unsigned want = 8u * (unsigned)ntn;
            for (;;) {
#if defined(BROKEN_EXCHANGE_NO_WAIT)
                break;
#endif
                if ((unsigned)__builtin_amdgcn_readfirstlane(__hip_atomic_load(cnt + 64 * u.pm, __ATOMIC_RELAXED, __HIP_MEMORY_SCOPE_AGENT)) >= want) break;
                if (__builtin_amdgcn_s_memrealtime() - t0 > 2000000ull) {
                    if (lane == 0) { unsigned expect = 0u; __hip_atomic_compare_exchange_strong(tmo + 1, &expect, code | (unsigned)(u.pm & 0xff), __ATOMIC_RELAXED, __ATOMIC_RELAXED, __HIP_MEMORY_SCOPE_AGENT);
                                     __hip_atomic_store(tmo, 1u, __ATOMIC_RELAXED, __HIP_MEMORY_SCOPE_AGENT); }
                    dead = true; break; }
                __builtin_amdgcn_s_sleep(2);
            }
            __builtin_amdgcn_fence(__ATOMIC_ACQUIRE, "agent");
            if (lane == 0) flag[0] = dead ? 1u : 0u;
        }
        asm volatile("s_waitcnt vmcnt(0) lgkmcnt(0)" ::: "memory"); __builtin_amdgcn_s_barrier(); asm volatile("" ::: "memory");
        const bool bad = flag[0] != 0u;
        if (lane < 32) {
            const unsigned long long* slot = (const unsigned long long*)xbuf + (size_t)(u.pm * BM + row) * 4; float mt[4], m2[4]; float ms = 0.f;
#pragma unroll
            for (int t = 0; t < 4; ++t) { if (t < ntn) { const unsigned long long w = __hip_atomic_load(slot + t, __ATOMIC_RELAXED, __HIP_MEMORY_SCOPE_AGENT); mt[t] = __uint_as_float((unsigned)w); m2[t] = __uint_as_float((unsigned)(w >> 32)); } else { mt[t] = 0.f; m2[t] = 0.f; } ms += mt[t]; }
            const float mean = ms / (float)ntn; float q = 0.f;
#pragma unroll
            for (int t = 0; t < 4; ++t) if (t < ntn) { const float dm = mt[t] - mean; q += m2[t] + 256.0f * dm * dm; }
            S[row] = (f32x2v){mean, 1.0f / sqrtf(q / (256.0f * (float)ntn) + eps)};
        }
        asm volatile("s_waitcnt lgkmcnt(0)" ::: "memory"); __builtin_amdgcn_s_barrier(); asm volatile("" ::: "memory");
        return bad;
    }
};
struct EpiLnRes {
    static constexpr bool PERM = false, AFTER_DRAIN = true;
    const float* base; float* out; int ldc; const float* bias; PanelStats st; unsigned poison;
    __device__ __forceinline__ void fused(f32x4 (&acc)[2][2][4][2], const Unit& u, int wr, int wc, int fr, int fq, PG8_LAS unsigned char* lds, int wid, int lane) const {
        typedef float f32x2v __attribute__((ext_vector_type(2)));
        const PG8_LAS f32x2v* S = (const PG8_LAS f32x2v*)(lds + 8192);
        const int col0 = u.pn * BM + wc * 32 + 4 * fq;
#pragma unroll
        for (int bj = 0; bj < 2; ++bj)
#pragma unroll
            for (int n = 0; n < 2; ++n) { const f32x4 bv = bias ? *(const f32x4*)(bias + col0 + bj * HALF + n * 16) : (f32x4){0.f, 0.f, 0.f, 0.f};
#pragma unroll
                for (int ai = 0; ai < 2; ++ai)
#pragma unroll
                    for (int m = 0; m < 4; ++m) acc[ai][bj][m][n] += bv; }
        f32x4 pre[4][2][2];
#pragma unroll
        for (int m = 0; m < 4; ++m) { const size_t off = (size_t)(u.pm * BM + wr * 64 + m * 16 + fr) * ldc + col0;
#pragma unroll
            for (int bj = 0; bj < 2; ++bj)
#pragma unroll
                for (int n = 0; n < 2; ++n) pre[m][bj][n] = *(const f32x4*)(base + off + bj * HALF + n * 16); }
        const bool bad = st.run(acc, u, wr, wc, fr, fq, lds, wid, lane) || poison != 0u;
        const float qnan = __builtin_nanf("");
#pragma unroll
        for (int ai = 0; ai < 2; ++ai)
#pragma unroll
            for (int m = 0; m < 4; ++m) { const int r = ai * HALF + wr * 64 + m * 16 + fr; const f32x2v sr = S[r]; const size_t off = (size_t)(u.pm * BM + r) * ldc + col0;
#pragma unroll
                for (int bj = 0; bj < 2; ++bj)
#pragma unroll
                    for (int n = 0; n < 2; ++n) { const f32x4 bs = ai == 0 ? pre[m][bj][n] : *(const f32x4*)(base + off + bj * HALF + n * 16); f32x4 o = bs + (acc[ai][bj][m][n] - sr.x) * sr.y;
                        if (bad) o = (f32x4){qnan, qnan, qnan, qnan}; *(f32x4*)(out + off + bj * HALF + n * 16) = o; }
                if (m & 1) asm volatile("" ::: "memory"); }
    }
};
struct EpiLnResLn {
    static constexpr bool PERM = false, AFTER_DRAIN = true;
    const float* base; float* out; bf16_t* xn; int ldc; const float* bias; PanelStats st1, st2; unsigned poison;
    __device__ __forceinline__ void fused(f32x4 (&acc)[2][2][4][2], const Unit& u, int wr, int wc, int fr, int fq, PG8_LAS unsigned char* lds, int wid, int lane) const {
        typedef float f32x2v __attribute__((ext_vector_type(2))); typedef unsigned u32x2v __attribute__((ext_vector_type(2)));
        const PG8_LAS f32x2v* S = (const PG8_LAS f32x2v*)(lds + 8192);
        const int col0 = u.pn * BM + wc * 32 + 4 * fq;
#pragma unroll
        for (int bj = 0; bj < 2; ++bj)
#pragma unroll
            for (int n = 0; n < 2; ++n) { const f32x4 bv = bias ? *(const f32x4*)(bias + col0 + bj * HALF + n * 16) : (f32x4){0.f, 0.f, 0.f, 0.f};
#pragma unroll
                for (int ai = 0; ai < 2; ++ai)
#pragma unroll
                    for (int m = 0; m < 4; ++m) acc[ai][bj][m][n] += bv; }
        bool bad = st1.run(acc, u, wr, wc, fr, fq, lds, wid, lane) || poison != 0u;
        const float qnan = __builtin_nanf("");
#pragma unroll
        for (int ai = 0; ai < 2; ++ai)
#pragma unroll
            for (int m = 0; m < 4; ++m) { const int r = ai * HALF + wr * 64 + m * 16 + fr; const f32x2v sr = S[r]; const size_t off = (size_t)(u.pm * BM + r) * ldc + col0;
#pragma unroll
                for (int bj = 0; bj < 2; ++bj)
#pragma unroll
                    for (int n = 0; n < 2; ++n) { const f32x4 bs = *(const f32x4*)(base + off + bj * HALF + n * 16); acc[ai][bj][m][n] = bs + (acc[ai][bj][m][n] - sr.x) * sr.y; }
                asm volatile("" : "+v"(acc[ai][0][m][0]), "+v"(acc[ai][0][m][1]), "+v"(acc[ai][1][m][0]), "+v"(acc[ai][1][m][1]));
                if (m & 1) asm volatile("" ::: "memory"); }
        const bool bad1 = bad;
        bad = st2.run(acc, u, wr, wc, fr, fq, lds, wid, lane) || bad;
#pragma unroll
        for (int ai = 0; ai < 2; ++ai)
#pragma unroll
            for (int m = 0; m < 4; ++m) { const int r = ai * HALF + wr * 64 + m * 16 + fr; const f32x2v sr = S[r]; const size_t off = (size_t)(u.pm * BM + r) * ldc + col0;
#pragma unroll
                for (int bj = 0; bj < 2; ++bj)
#pragma unroll
                    for (int n = 0; n < 2; ++n) { const f32x4 x1 = acc[ai][bj][m][n]; *(f32x4*)(out + off + bj * HALF + n * 16) = bad1 ? (f32x4){qnan, qnan, qnan, qnan} : x1;
                        const f32x4 o = (x1 - sr.x) * sr.y; u32x2v w; w.x = cvt_pk_bf16(o[0], o[1]); w.y = cvt_pk_bf16(o[2], o[3]);
                        if (bad) { w.x = 0x7fc07fc0u; w.y = 0x7fc07fc0u; } *(u32x2v*)(xn + off + bj * HALF + n * 16) = w; }
                asm volatile("" ::: "memory"); }
    }
};

template <class Epi, class Sched, bool ALIGN_EPI = false, bool SP2 = false>
__device__ __forceinline__ void gemm_phase(PG8_LAS unsigned char* lds, const Gemm g, const Sched& S, const Epi& E, const int wave0) {
    int tid_ = tid_from_wave(wave0);
    const int tid = tid_, wid = __builtin_amdgcn_readfirstlane(tid >> 6), lane = tid & 63, wr = wid >> 2, wc = wid & 3, fr = lane & 15, fq = lane >> 4;
    const int K = g.K, nt = K / BK;
    unsigned voffA[2], voffB[2];
#pragma unroll
    for (int i = 0; i < 2; ++i) { int R, C; stage_rc(tid * 16 + i * 8192, R, C); const int Rb = Epi::PERM ? ((R & ~31) + perm32(R & 31)) : R;
        voffA[i] = (unsigned)(R * K + C) * 2u; voffB[i] = (unsigned)(Rb * K + C) * 2u; }
    const size_t kstep = (size_t)(BK * 2);
    const size_t hstep = (size_t)HALF * K * 2;
    const size_t tstep = 2 * hstep;
    const unsigned ldsw = (unsigned)wid * 1024u;
    const int aoff = lds_byte(wr * 64 + fr, fq * 8), boff = lds_byte(wc * 32 + fr, fq * 8);
#define PG8_SA(b, h) (((b) * 2 + (h)) * HTB)
#define PG8_SB(b, h) ((4 + (b) * 2 + (h)) * HTB)
#define PG8_STAGE(bufoff, gbase, voff) do { _Pragma("unroll") for (int _i = 0; _i < 2; ++_i) \
        __builtin_amdgcn_global_load_lds((const unsigned*)((const char*)(gbase) + (voff)[_i]), (PG8_LAS unsigned*)(lds + (bufoff) + ldsw + _i * 8192), 16, 0, 0); } while (0)
#define PG8_LDA(dst, b, h) do { _Pragma("unroll") for (int m = 0; m < 4; ++m) _Pragma("unroll") for (int k = 0; k < 2; ++k) dst[m][k] = *(const PG8_LAS bf16x8*)(lds + PG8_SA(b, h) + aoff + m * 2048 + k * 1024); } while (0)
#define PG8_LDB(dst, b, h) do { _Pragma("unroll") for (int n = 0; n < 2; ++n) _Pragma("unroll") for (int k = 0; k < 2; ++k) dst[n][k] = *(const PG8_LAS bf16x8*)(lds + PG8_SB(b, h) + boff + n * 2048 + k * 1024); } while (0)
#define PG8_MMA(ai, bj, At, Bt) do { __builtin_amdgcn_s_setprio(1); _Pragma("unroll") for (int m = 0; m < 4; ++m) _Pragma("unroll") for (int n = 0; n < 2; ++n) _Pragma("unroll") for (int k = 0; k < 2; ++k) \
        acc[ai][bj][m][n] = __builtin_amdgcn_mfma_f32_16x16x32_bf16(Bt[n][k], At[m][k], acc[ai][bj][m][n], 0, 0, 0); __builtin_amdgcn_s_setprio(0); } while (0)
#define PG8_WAIT_V(n) asm volatile("s_waitcnt vmcnt(" #n ")" ::: "memory")
#define PG8_WAIT_L(n) asm volatile("s_waitcnt lgkmcnt(" #n ")" ::: "memory")
#define PG8_BAR __builtin_amdgcn_s_barrier()
#define PG8_SCHED __builtin_amdgcn_sched_barrier(0)
    Unit cur, nxt; int ui = 0;
    if (!S.next(0, cur)) return;
    f32x4 acc[2][2][4][2];
#pragma unroll
    for (int a = 0; a < 2; ++a)
#pragma unroll
        for (int b = 0; b < 2; ++b)
#pragma unroll
            for (int m = 0; m < 4; ++m)
#pragma unroll
                for (int n = 0; n < 2; ++n) acc[a][b][m][n] = (f32x4){0.f, 0.f, 0.f, 0.f};
    bf16x8 At[4][2], B0[2][2], B1[2][2];
    const char* cA = (const char*)g.A + (size_t)cur.pm * tstep; const char* cB = (const char*)g.Bt + (size_t)cur.pn * tstep;
    S.a_ready(cur);
    if constexpr (SP2) {
        PG8_STAGE(PG8_SB(0, 0), cB, voffB); PG8_STAGE(PG8_SB(0, 1), cB + hstep, voffB); PG8_STAGE(PG8_SA(0, 0), cA, voffA); PG8_STAGE(PG8_SA(0, 1), cA + hstep, voffA);
        if (wr == 1) PG8_BAR;
        PG8_WAIT_V(2); PG8_BAR;
        PG8_STAGE(PG8_SB(1, 0), cB + kstep, voffB); PG8_STAGE(PG8_SA(1, 0), cA + kstep, voffA); PG8_STAGE(PG8_SB(1, 1), cB + hstep + kstep, voffB);
        PG8_WAIT_V(6); PG8_BAR;
    } else {
        PG8_STAGE(PG8_SB(0, 0), cB, voffB); PG8_STAGE(PG8_SA(0, 0), cA, voffA); PG8_STAGE(PG8_SB(0, 1), cB + hstep, voffB); PG8_STAGE(PG8_SA(0, 1), cA + hstep, voffA);
        if (wr == 1) PG8_BAR;
        PG8_WAIT_V(4); PG8_BAR;
        PG8_STAGE(PG8_SB(1, 0), cB + kstep, voffB); PG8_STAGE(PG8_SA(1, 0), cA + kstep, voffA); PG8_STAGE(PG8_SB(1, 1), cB + hstep + kstep, voffB);
        PG8_WAIT_V(6); PG8_BAR;
    }
    for (;;) {
        const bool has_next = S.next(ui + 1, nxt);
        const char* nA = has_next ? (const char*)g.A + (size_t)nxt.pm * tstep : cA; const char* nB = has_next ? (const char*)g.Bt + (size_t)nxt.pn * tstep : cB;
        for (int t = 0; t < nt; t += 2) {
            const bool last = (t == nt - 2);
            const char* a1 = cA + (size_t)(t + 1) * kstep;
            const char* a2 = last ? nA : cA + (size_t)(t + 2) * kstep; const char* b2 = last ? nB : cB + (size_t)(t + 2) * kstep;
            const char* a3 = a2 + kstep; const char* b3 = b2 + kstep;
            if (last && has_next) S.a_ready(nxt);
            if constexpr (SP2) {
            PG8_LDB(B0, 0, 0); PG8_LDB(B1, 0, 1); PG8_SCHED; PG8_LDA(At, 0, 0); PG8_STAGE(PG8_SA(1, 1), a1 + hstep, voffA);
            PG8_WAIT_V(8); PG8_WAIT_L(0); PG8_BAR; PG8_MMA(0, 0, At, B0); PG8_MMA(0, 1, At, B1); PG8_BAR; PG8_SCHED;
            PG8_LDA(At, 0, 1); PG8_STAGE(PG8_SB(0, 0), b2, voffB); PG8_STAGE(PG8_SB(0, 1), b2 + hstep, voffB); PG8_STAGE(PG8_SA(0, 0), a2, voffA);
            PG8_WAIT_V(8); PG8_WAIT_L(0); PG8_BAR; PG8_MMA(1, 0, At, B0); PG8_MMA(1, 1, At, B1); PG8_BAR; PG8_SCHED;
            PG8_LDB(B0, 1, 0); PG8_LDB(B1, 1, 1); PG8_SCHED; PG8_LDA(At, 1, 0); PG8_STAGE(PG8_SA(0, 1), a2 + hstep, voffA);
            PG8_WAIT_V(8); PG8_WAIT_L(0); PG8_BAR; PG8_MMA(0, 0, At, B0); PG8_MMA(0, 1, At, B1); PG8_BAR; PG8_SCHED;
            PG8_LDA(At, 1, 1); PG8_STAGE(PG8_SB(1, 0), b3, voffB); PG8_STAGE(PG8_SB(1, 1), b3 + hstep, voffB); PG8_STAGE(PG8_SA(1, 0), a3, voffA);
            PG8_WAIT_V(8); PG8_WAIT_L(0); PG8_BAR; PG8_MMA(1, 0, At, B0); PG8_MMA(1, 1, At, B1); PG8_BAR; PG8_SCHED;
            } else {
            PG8_LDB(B0, 0, 0); PG8_SCHED; PG8_LDA(At, 0, 0); PG8_STAGE(PG8_SA(1, 1), a1 + hstep, voffA);
            PG8_WAIT_L(8); PG8_BAR; PG8_WAIT_L(0); PG8_MMA(0, 0, At, B0); PG8_BAR; PG8_SCHED;
            PG8_LDB(B1, 0, 1); PG8_STAGE(PG8_SB(0, 0), b2, voffB);
            PG8_BAR; PG8_WAIT_L(0); PG8_MMA(0, 1, At, B1); PG8_BAR;
            PG8_LDA(At, 0, 1); PG8_STAGE(PG8_SA(0, 0), a2, voffA);
            PG8_BAR; PG8_WAIT_L(0); PG8_MMA(1, 0, At, B0); PG8_BAR; PG8_SCHED;
            PG8_STAGE(PG8_SB(0, 1), b2 + hstep, voffB);
            PG8_WAIT_V(6); PG8_BAR; PG8_MMA(1, 1, At, B1); PG8_BAR;
            PG8_LDB(B0, 1, 0); PG8_SCHED; PG8_LDA(At, 1, 0); PG8_STAGE(PG8_SA(0, 1), a2 + hstep, voffA);
            PG8_WAIT_L(8); PG8_BAR; PG8_WAIT_L(0); PG8_MMA(0, 0, At, B0); PG8_BAR; PG8_SCHED;
            PG8_LDB(B1, 1, 1); PG8_STAGE(PG8_SB(1, 0), b3, voffB);
            PG8_BAR; PG8_WAIT_L(0); PG8_MMA(0, 1, At, B1); PG8_BAR;
            PG8_LDA(At, 1, 1); PG8_STAGE(PG8_SA(1, 0), a3, voffA);
            PG8_BAR; PG8_WAIT_L(0); PG8_MMA(1, 0, At, B0); PG8_BAR; PG8_SCHED;
            PG8_STAGE(PG8_SB(1, 1), b3 + hstep, voffB);
            PG8_WAIT_V(6); PG8_BAR; PG8_MMA(1, 1, At, B1); PG8_BAR;
            }
        }
        if constexpr (ALIGN_EPI) { if (wr == 0) PG8_BAR; }
        if constexpr (!Epi::AFTER_DRAIN) { E(acc, cur, wr, wc, fr, fq); S.done(cur); }
        if (!has_next) break;
#pragma unroll
        for (int a = 0; a < 2; ++a)
#pragma unroll
            for (int b = 0; b < 2; ++b)
#pragma unroll
                for (int m = 0; m < 4; ++m)
#pragma unroll
                    for (int n = 0; n < 2; ++n) acc[a][b][m][n] = (f32x4){0.f, 0.f, 0.f, 0.f};
        cur = nxt; cA = nA; cB = nB; ++ui;
        if constexpr (ALIGN_EPI) { if (wr == 1) PG8_BAR; }
    }
    PG8_WAIT_V(0);
    if constexpr (!ALIGN_EPI) { if (wr == 0) PG8_BAR; }
    PG8_BAR;
    if constexpr (Epi::AFTER_DRAIN) { E.fused(acc, cur, wr, wc, fr, fq, lds, wid, lane); S.done(cur); }
#undef PG8_SA
#undef PG8_SB
#undef PG8_STAGE
#undef PG8_LDA
#undef PG8_LDB
#undef PG8_MMA
#undef PG8_WAIT_V
#undef PG8_WAIT_L
#undef PG8_BAR
#undef PG8_SCHED
}
}

namespace pg8 {
struct EpiRelu2 {
    static constexpr bool PERM = true, AFTER_DRAIN = false;
    bf16_t* O; int ldc;
    __device__ __forceinline__ void operator()(const f32x4 (&acc)[2][2][4][2], const Unit& u, int wr, int wc, int fr, int fq) const {
        relane(wr, wc, fr, fq);
        const int row0 = u.pm * BM + wr * 64 + fr, col0 = u.pn * BM + wc * 32 + 8 * fq;
#pragma unroll
        for (int ai = 0; ai < 2; ++ai)
#pragma unroll
            for (int m = 0; m < 4; ++m) { bf16_t* rowp = O + (size_t)(row0 + ai * HALF + m * 16) * ldc + col0;
#pragma unroll
                for (int bj = 0; bj < 2; ++bj) { f32x4 v0 = acc[ai][bj][m][0], v1 = acc[ai][bj][m][1];
                    v0 = __builtin_elementwise_max(v0, (f32x4){0.f, 0.f, 0.f, 0.f}); v1 = __builtin_elementwise_max(v1, (f32x4){0.f, 0.f, 0.f, 0.f}); v0 = v0 * v0; v1 = v1 * v1;
                    u32x4 w; w.x = cvt_pk_bf16(v0[0], v0[1]); w.y = cvt_pk_bf16(v0[2], v0[3]); w.z = cvt_pk_bf16(v1[0], v1[1]); w.w = cvt_pk_bf16(v1[2], v1[3]);
                    *(PG8_GAS u32x4*)(rowp + bj * HALF) = w; } }
    }
};
struct EpiF32 {
    static constexpr bool PERM = false, AFTER_DRAIN = false;
    float* O; int ldc;
    __device__ __forceinline__ void operator()(const f32x4 (&acc)[2][2][4][2], const Unit& u, int wr, int wc, int fr, int fq) const {
        relane(wr, wc, fr, fq);
        const int row0 = u.pm * BM + wr * 64 + fr, col0 = u.pn * BM + wc * 32 + 4 * fq;
#pragma unroll
        for (int ai = 0; ai < 2; ++ai)
#pragma unroll
            for (int m = 0; m < 4; ++m) { float* rowp = O + (size_t)(row0 + ai * HALF + m * 16) * ldc + col0;
#pragma unroll
                for (int bj = 0; bj < 2; ++bj)
#pragma unroll
                    for (int n = 0; n < 2; ++n) *(PG8_GAS f32x4*)(rowp + bj * HALF + n * 16) = acc[ai][bj][m][n]; }
    }
};
struct EpiTaps {
    static constexpr bool PERM = false, AFTER_DRAIN = false;
    float* O; const float* decay;
    __device__ __forceinline__ void operator()(const f32x4 (&acc)[2][2][4][2], const Unit& u, int wr, int wc, int fr, int fq) const {
        relane(wr, wc, fr, fq);
        const int row0 = u.pm * BM + wr * 64 + fr, col0 = u.pn * BM + wc * 32 + 4 * fq;
#pragma unroll
        for (int ai = 0; ai < 2; ++ai)
#pragma unroll
            for (int m = 0; m < 4; ++m) { const int row = row0 + ai * HALF + m * 16; float* rowp = O + (size_t)row * 16384 + col0; const float nd = -fabsf(((const PG8_GAS float*)decay)[row]) * (1.0f / 16383.0f) * 1.4426950408889634f;
#pragma unroll
                for (int bj = 0; bj < 2; ++bj)
#pragma unroll
                    for (int n = 0; n < 2; ++n) { const int c = col0 + bj * HALF + n * 16; const f32x4 a = acc[ai][bj][m][n]; f32x4 o;
                        o[0] = a[0] * __builtin_amdgcn_exp2f(nd * (float)(c + 0)); o[1] = a[1] * __builtin_amdgcn_exp2f(nd * (float)(c + 1));
                        o[2] = a[2] * __builtin_amdgcn_exp2f(nd * (float)(c + 2)); o[3] = a[3] * __builtin_amdgcn_exp2f(nd * (float)(c + 3));
                        *(PG8_GAS f32x4*)(rowp + bj * HALF + n * 16) = o; } }
    }
};
}

constexpr int L = 16384, NSEQ = 3, M = NSEQ * L, D = 1024, DEPTH = 4;
constexpr int HYW = 512, HYP = 1536, QR = 256, KVR = 128, ROPE = 32, INW = 1952;
constexpr int NH = 8, DQ = 96, DV = 64, NQ = NH * DQ, NKV = NH * 128;
constexpr int FF = 4096;
constexpr float EPS = 1e-6f;
constexpr int NWAVES = 8, NTHR = 512;
constexpr int MLP_CHUNK = 16384, N_MLP_CHUNKS = M / MLP_CHUNK;

constexpr size_t MiB = 1u << 20;
constexpr size_t WS_CTL = 0, CTL_ZERO_BYTES = 65536;
constexpr size_t WS_COS = 1 * MiB, WS_SIN = 2 * MiB;
constexpr size_t WS_H2 = 4 * MiB;
constexpr size_t WS_W3T = 8 * MiB;
constexpr size_t WS_WIN = 12 * MiB, WS_WOUT = 16 * MiB, WS_WUP = 18 * MiB, WS_WDOWN = 26 * MiB, WS_WUQ = 34 * MiB, WS_WUKV = 34 * MiB + 512 * 1024;
constexpr size_t WS_XN = 36 * MiB;
constexpr size_t WS_CQN = 36 * MiB, WS_CKVN = 60 * MiB, WS_KPE = 72 * MiB;
constexpr size_t WS_KEO = 132 * MiB;
constexpr size_t WS_KT = 261 * MiB;
constexpr size_t WS_UT = 261 * MiB;
constexpr size_t WS_CQKV = 405 * MiB;
constexpr size_t WS_YT = 453 * MiB;
constexpr size_t WS_Q = 132 * MiB, WS_KN = 204 * MiB;
constexpr size_t WS_MIX = 324 * MiB;
constexpr size_t WS_T = 132 * MiB;
constexpr size_t WS_H = 324 * MiB;
constexpr size_t WS_G0 = 75 * MiB, WS_G1A = 107 * MiB, WS_G1B = 501 * MiB;
constexpr size_t WS_END = 508 * MiB;
constexpr int KEO_BLK = 16512, KEO_KO = 8256;
static_assert(WS_KEO + (size_t)1024 * KEO_BLK * 8 <= WS_KT, "KEO fits");
static_assert(WS_UT + (size_t)HYP * M * 2 <= WS_CQKV && WS_CQKV + (size_t)M * 512 * 2 <= WS_YT && WS_YT + (size_t)HYW * M * 2 <= WS_END, "map");
static_assert(WS_KN + (size_t)M * NKV * 2 <= WS_MIX && WS_T + (size_t)M * D * 4 <= WS_MIX && WS_H + (size_t)MLP_CHUNK * FF * 2 <= WS_END, "map2");

constexpr int RING_OFF = 0, RING_BYTES = 139264;
constexpr int LDSCTL_OFF = RING_BYTES, MISC_OFF = LDSCTL_OFF + 320;
constexpr int LDS_BYTES = 147456;
static_assert(MISC_OFF + 128 <= LDS_BYTES, "LDS map");

#define GAS __attribute__((address_space(1)))
#define LAS __attribute__((address_space(3)))
typedef unsigned short bf16;
typedef unsigned v4u __attribute__((ext_vector_type(4)));
typedef unsigned v2u __attribute__((ext_vector_type(2)));
typedef float f32x4 __attribute__((ext_vector_type(4)));
typedef float f32x2 __attribute__((ext_vector_type(2)));
typedef short bf16x8 __attribute__((ext_vector_type(8)));
typedef GAS unsigned gu32;
#define RLX_AGENT __ATOMIC_RELAXED, __HIP_MEMORY_SCOPE_AGENT
#define LDS_WAIT() asm volatile("s_waitcnt lgkmcnt(0)" ::: "memory")
#define VM_WAIT() asm volatile("s_waitcnt vmcnt(0)" ::: "memory")
typedef __bf16 bf16x2_t __attribute__((ext_vector_type(2)));
__device__ __forceinline__ unsigned pk2(float lo, float hi) { f32x2 v = {lo, hi}; bf16x2_t b = __builtin_convertvector(v, bf16x2_t); return __builtin_bit_cast(unsigned, b); }
__device__ __forceinline__ bf16 f2bf(float f) { return (bf16)(pk2(f, 0.f) & 0xffffu); }
__device__ __forceinline__ float bf2f(unsigned h) { return __uint_as_float(h << 16); }
__device__ __forceinline__ float shx(float v, int lane, int o) { return __uint_as_float((unsigned)__builtin_amdgcn_ds_bpermute((lane ^ o) << 2, (int)__float_as_uint(v))); }
__device__ __forceinline__ float wave_sum(float v) {
    const int ln_ = hw_lane();
#pragma unroll
    for (int o = 1; o < 64; o <<= 1) v += shx(v, ln_, o);
    return v;
}

namespace hfft {
constexpr float w32c(int i) { constexpr float t[16] = {1.000000000e+00f, 9.807852507e-01f, 9.238795042e-01f, 8.314695954e-01f, 7.071067691e-01f, 5.555702448e-01f, 3.826834261e-01f, 1.950903237e-01f, 0.f, -1.950903237e-01f, -3.826834261e-01f, -5.555702448e-01f, -7.071067691e-01f, -8.314695954e-01f, -9.238795042e-01f, -9.807852507e-01f}; return t[i]; }
constexpr float w32s(int i) { constexpr float t[16] = {0.000000000e+00f, 1.950903237e-01f, 3.826834261e-01f, 5.555702448e-01f, 7.071067691e-01f, 8.314695954e-01f, 9.238795042e-01f, 9.807852507e-01f, 1.000000000e+00f, 9.807852507e-01f, 9.238795042e-01f, 8.314695954e-01f, 7.071067691e-01f, 5.555702448e-01f, 3.826834261e-01f, 1.950903237e-01f}; return t[i]; }
constexpr int brev(int x, int bits) { int r = 0; for (int i = 0; i < bits; ++i) r |= ((x >> i) & 1) << (bits - 1 - i); return r; }
constexpr int ilog2(int x) { int r = 0; while ((1 << r) < x) ++r; return r; }
__device__ __forceinline__ int pad(int i) { return i + (i >> 5); }

__device__ __forceinline__ void bfly(float ar, float ai, float br, float bi, float& ur, float& ui, float& dr, float& di) {
    asm("v_add_f32_e32 %0, %4, %6\n\tv_add_f32_e32 %1, %5, %7\n\tv_sub_f32_e32 %2, %4, %6\n\tv_sub_f32_e32 %3, %5, %7"
        : "=&v"(ur), "=&v"(ui), "=&v"(dr), "=&v"(di) : "v"(ar), "v"(ai), "v"(br), "v"(bi));
}
template <bool INV> __device__ __forceinline__ void bfly_rot(float ar, float ai, float br, float bi, float& ur, float& ui, float& dr, float& di) {
    if (!INV) asm("v_add_f32_e32 %0, %4, %6\n\tv_add_f32_e32 %1, %5, %7\n\tv_sub_f32_e32 %2, %5, %7\n\tv_sub_f32_e32 %3, %6, %4" : "=&v"(ur), "=&v"(ui), "=&v"(dr), "=&v"(di) : "v"(ar), "v"(ai), "v"(br), "v"(bi));
    else      asm("v_add_f32_e32 %0, %4, %6\n\tv_add_f32_e32 %1, %5, %7\n\tv_sub_f32_e32 %2, %7, %5\n\tv_sub_f32_e32 %3, %4, %6" : "=&v"(ur), "=&v"(ui), "=&v"(dr), "=&v"(di) : "v"(ar), "v"(ai), "v"(br), "v"(bi));
}
__device__ __forceinline__ void bfly_tw(float ar, float ai, float br, float bi, float c, float s, float& ur, float& ui, float& dr, float& di) {
    float tr, ti;
    asm("v_sub_f32_e32 %4, %6, %8\n\tv_sub_f32_e32 %5, %7, %9\n\tv_add_f32_e32 %0, %6, %8\n\tv_add_f32_e32 %1, %7, %9\n\t"
        "v_mul_f32_e32 %2, %10, %4\n\tv_mul_f32_e32 %3, %11, %4\n\tv_fma_f32 %2, -%11, %5, %2\n\tv_fma_f32 %3, %10, %5, %3"
        : "=&v"(ur), "=&v"(ui), "=&v"(dr), "=&v"(di), "=&v"(tr), "=&v"(ti) : "v"(ar), "v"(ai), "v"(br), "v"(bi), "s"(c), "s"(s));
}
__device__ __forceinline__ void cmul_chain(float& xr, float& xi, float& wc, float& ws, float c1, float s1) {
    float a, b, nc, ns;
    asm("v_mul_f32_e32 %0, %4, %6\n\tv_mul_f32_e32 %1, %4, %7\n\tv_fma_f32 %0, -%5, %7, %0\n\tv_fma_f32 %1, %5, %6, %1\n\t"
        "v_mul_f32_e32 %2, %6, %8\n\tv_mul_f32_e32 %3, %6, %9\n\tv_fma_f32 %2, -%7, %9, %2\n\tv_fma_f32 %3, %7, %8, %3"
        : "=&v"(a), "=&v"(b), "=&v"(nc), "=&v"(ns) : "v"(xr), "v"(xi), "v"(wc), "v"(ws), "v"(c1), "v"(s1));
    xr = a; xi = b; wc = nc; ws = ns;
}
template <int R, bool INV> __device__ __forceinline__ void fft_r2(float (&re)[R], float (&im)[R], const unsigned z0) {
    constexpr int LG = ilog2(R);
#pragma unroll
    for (int st = 0; st < LG; ++st) {
        const int s = (R / 2) >> st;
#pragma unroll
        for (int blk = 0; blk < R; blk += 2 * s) {
#pragma unroll
            for (int a = 0; a < s; ++a) {
                const int i0 = blk + a, i1 = i0 + s;
                const int w = a * (16 / s);
                float ur, ui, dr, di;
                if (w == 0) { bfly(re[i0], im[i0], re[i1], im[i1], ur, ui, dr, di); re[i1] = dr; im[i1] = di; }
                else if (w == 8) { bfly_rot<INV>(re[i0], im[i0], re[i1], im[i1], ur, ui, dr, di); re[i1] = dr; im[i1] = di; }
                else { const float c = __uint_as_float(__float_as_uint(w32c(w)) | z0), sn = __uint_as_float(__float_as_uint(INV ? w32s(w) : -w32s(w)) | z0);
                    bfly_tw(re[i0], im[i0], re[i1], im[i1], c, sn, ur, ui, dr, di); re[i1] = dr; im[i1] = di; }
                re[i0] = ur; im[i0] = ui;
            }
        }
    }
}

__device__ __forceinline__ int opaque(int x) { asm volatile("" : "+v"(x)); return x; }
template <bool INV> __device__ __forceinline__ void fft16k(float (&re)[32], float (&im)[32], LAS f32x2* buf, const int t_in) {
    asm volatile("" ::: "memory"); __builtin_amdgcn_sched_barrier(0);
    int t = opaque(t_in);
    unsigned z0 = 0u; asm volatile("" : "+s"(z0));
    fft_r2<32, INV>(re, im, z0);
    __syncthreads();
#pragma unroll
    for (int r = 0; r < 32; ++r) buf[33 * t + r] = (f32x2){re[brev(r, 5)], im[brev(r, 5)]};
    __syncthreads();
    t = opaque(t);
    { const int b2 = t + (t >> 5);
#pragma unroll
    for (int r = 0; r < 32; ++r) { const f32x2 v = buf[b2 + 528 * r]; re[r] = v.x; im[r] = v.y; } }
    {
        const float f1 = (float)(t & 31) * (1.0f / 1024.0f);
        const float c1 = __builtin_amdgcn_cosf(f1), s1 = INV ? __builtin_amdgcn_sinf(f1) : -__builtin_amdgcn_sinf(f1);
        float wc = c1, ws = s1;
#pragma unroll
        for (int r = 1; r < 32; ++r) {
            cmul_chain(re[r], im[r], wc, ws, c1, s1);
        }
    }
    fft_r2<32, INV>(re, im, z0);
    __syncthreads();
    {
        t = opaque(t);
        const int ob = (t >> 5) * 1056 + (t & 31);
#pragma unroll
        for (int r = 0; r < 32; ++r) buf[ob + 33 * r] = (f32x2){re[brev(r, 5)], im[brev(r, 5)]};
    }
    __syncthreads();
#pragma unroll
    for (int h = 0; h < 2; ++h) {
        t = opaque(t);
        float ar[16], ai[16]; const int j = t + 512 * h; const int b3 = t + (t >> 5) + 528 * h;
#pragma unroll
        for (int r = 0; r < 16; ++r) { const f32x2 v = buf[b3 + 1056 * r]; ar[r] = v.x; ai[r] = v.y; }
        {
            const float f1 = (float)j * (1.0f / 16384.0f);
            const float c1 = __builtin_amdgcn_cosf(f1), s1 = INV ? __builtin_amdgcn_sinf(f1) : -__builtin_amdgcn_sinf(f1);
            float wc = c1, ws = s1;
#pragma unroll
            for (int r = 1; r < 16; ++r) {
                cmul_chain(ar[r], ai[r], wc, ws, c1, s1);
            }
        }
        fft_r2<16, INV>(ar, ai, z0);
#pragma unroll
        for (int r = 0; r < 16; ++r) { re[h + 2 * r] = ar[brev(r, 4)]; im[h + 2 * r] = ai[brev(r, 4)]; }
    }
    asm volatile("" ::: "memory"); __builtin_amdgcn_sched_barrier(0);
}
}

struct Frame {
    LAS unsigned char* lds;
    volatile LAS unsigned* MISC;
    gu32* ctl;
    int tid, lane, wave;
    int wave0;
    int vcu, G;
    float* out;
    unsigned char* ws;
};
constexpr int PTRTAB_OFF = LDSCTL_OFF + 512;
__device__ __forceinline__ const GAS float* inp(const Frame& F, int i) {
    const v2u w = *(const LAS v2u*)(F.lds + PTRTAB_OFF + 8 * i);
    const unsigned lo = __builtin_amdgcn_readfirstlane(w.x), hi = __builtin_amdgcn_readfirstlane(w.y);
    return (const GAS float*)(((unsigned long long)hi << 32) | lo);
}
__device__ __forceinline__ GAS unsigned char* wsq(const Frame& F) { unsigned char* p = F.ws; asm volatile("" : "+s"(p)); return (GAS unsigned char*)p; }
enum { I_XP = 0, I_XS, I_WIN, I_CONVW, I_CONVB, I_FW1, I_FB1, I_FW2, I_FB2, I_FW3, I_SINF, I_DECAY, I_HBIAS, I_QNORM, I_WUQ, I_KVNORM, I_WUKV, I_GNHY, I_GNAT, I_WOUT,
       I_NMIXPRE, I_NMIXPOST, I_NMLPPRE, I_NMLPPOST, I_WUP, I_WDOWN };

__device__ __forceinline__ int rope_src(int p) { return 4 * (p >> 3) + (p & 3) + 16 * ((p >> 2) & 1); }
template <bool ROPEPERM>
__device__ __forceinline__ void transpose_item(const GAS float* W, int K, int N, GAS bf16* WT, LAS float* scr, int item, int lane, int ldk = 0, int koff = 0) {
    if (ldk == 0) ldk = K;
    const int nblk = N / 32, kb = item / nblk, nb = item % nblk, k0 = 64 * kb, n0 = 32 * nb;
    int sc = lane & 31; if (ROPEPERM && (nb % 3) == 2) sc = rope_src(sc);
#pragma unroll 8
    for (int i = 0; i < 32; ++i) { const int kk = 2 * i + (lane >> 5); scr[kk * 33 + (lane & 31)] = W[(size_t)(k0 + kk) * N + n0 + sc]; }
    LDS_WAIT(); asm volatile("" ::: "memory");
    const int c = lane & 7;
#pragma unroll
    for (int j = 0; j < 4; ++j) { const int n = (lane >> 3) + 8 * j; const LAS float* s = scr + (8 * c) * 33 + n;
        v4u o; o.x = pk2(s[0 * 33], s[1 * 33]); o.y = pk2(s[2 * 33], s[3 * 33]); o.z = pk2(s[4 * 33], s[5 * 33]); o.w = pk2(s[6 * 33], s[7 * 33]);
        *(GAS v4u*)(WT + (size_t)(n0 + n) * ldk + koff + k0 + 8 * c) = o; }
    LDS_WAIT(); asm volatile("" ::: "memory");
}
__device__ __forceinline__ void phase_weights(Frame& F, int l) {
    LAS float* scr = (LAS float*)(F.lds + RING_OFF + F.wave * 16384);
    const int gw = F.vcu * NWAVES + F.wave, NGW = F.G * NWAVES;
    GAS bf16* WinT = (GAS bf16*)(wsq(F) + WS_WIN); GAS bf16* WoutT = (GAS bf16*)(wsq(F) + WS_WOUT); GAS bf16* WupT = (GAS bf16*)(wsq(F) + WS_WUP); GAS bf16* WdownT = (GAS bf16*)(wsq(F) + WS_WDOWN);
    GAS bf16* WuqT = (GAS bf16*)(wsq(F) + WS_WUQ); GAS bf16* WukvT = (GAS bf16*)(wsq(F) + WS_WUKV);
    constexpr int I_IN = (D / 64) * (INW / 32), I_OUT = (D / 64) * (D / 32), I_UP = (D / 64) * (FF / 32), I_DN = (FF / 64) * (D / 32), I_UQ = (QR / 64) * (NQ / 32), I_UKV = (KVR / 64) * (NKV / 32);
    constexpr int I_W3 = 2048 / 32;
    constexpr int NITEMS = I_IN + I_OUT + I_UP + I_DN + I_UQ + I_UKV + 2 * I_W3;
    for (int it = gw; it < NITEMS; it += NGW) {
        int r = it;
        if (r < I_IN) { transpose_item<false>(inp(F, I_WIN) + (size_t)l * D * INW, D, INW, WinT, scr, r, F.lane); continue; } r -= I_IN;
        if (r < I_OUT) { transpose_item<false>(inp(F, I_WOUT) + (size_t)l * D * D, D, D, WoutT, scr, r, F.lane); continue; } r -= I_OUT;
        if (r < I_UP) { transpose_item<false>(inp(F, I_WUP) + (size_t)l * D * FF, D, FF, WupT, scr, r, F.lane); continue; } r -= I_UP;
        if (r < I_DN) { transpose_item<false>(inp(F, I_WDOWN) + (size_t)l * FF * D, FF, D, WdownT, scr, r, F.lane); continue; } r -= I_DN;
        if (r < I_UQ) { transpose_item<true>(inp(F, I_WUQ) + (size_t)l * QR * NQ, QR, NQ, WuqT, scr, r, F.lane); continue; } r -= I_UQ;
        if (r < I_UKV) { transpose_item<false>(inp(F, I_WUKV) + (size_t)l * KVR * NKV, KVR, NKV, WukvT, scr, r, F.lane); continue; } r -= I_UKV;
        transpose_item<false>(inp(F, I_FW3) + (size_t)l * 64 * 2048, 64, 2048, (GAS bf16*)(wsq(F) + WS_W3T), scr, r % I_W3, F.lane, 128, (r / I_W3) * 64);
    }
    { unsigned z = 0u; asm volatile("" : "+v"(z)); const v4u zz = {z, z, z, z};
      for (int i = gw * 64 + F.lane; i < 12288; i += NGW * 64) ((GAS v4u*)(WinT + (size_t)INW * D))[i] = zz; }
}
__device__ __forceinline__ void phase_rope_tab(Frame& F) {
    const float inv[16] = {1.000000000e+00f, 5.623413324e-01f, 3.162277639e-01f, 1.778279394e-01f, 1.000000015e-01f, 5.623412877e-02f, 3.162277862e-02f, 1.778279431e-02f,
                           9.999999776e-03f, 5.623413250e-03f, 3.162277862e-03f, 1.778279431e-03f, 1.000000047e-03f, 5.623413017e-04f, 3.162277862e-04f, 1.778279402e-04f};
    GAS float* ct = (GAS float*)(wsq(F) + WS_COS); GAS float* st = (GAS float*)(wsq(F) + WS_SIN);
    for (int i = F.vcu * NTHR + F.tid; i < L * 16; i += F.G * NTHR) {
        const int t = i >> 4, j = i & 15; float iv = inv[0];
#pragma unroll
        for (int q = 1; q < 16; ++q) iv = (j == q) ? inv[q] : iv;
        const float ang = (float)t * iv; ct[i] = cosf(ang); st[i] = sinf(ang);
    }
}
__device__ __forceinline__ const GAS float* x_src_row(Frame& F, int l, int m) {
    if (l == 0) return (m < 2 * L) ? inp(F, I_XP) + (size_t)m * D : inp(F, I_XS) + (size_t)(m - 2 * L) * D;
    return (const GAS float*)F.out + (size_t)m * D;
}
__device__ __forceinline__ void store_xn_row(f32x4 (&v)[4], float rstd, const GAS float* g, GAS bf16* orow, int lane) {
    GAS v2u* o8 = (GAS v2u*)orow + lane;
#pragma unroll
    for (int j = 0; j < 4; ++j) { const f32x4 gg = ((const GAS f32x4*)g)[lane + 64 * j]; v2u w; w.x = pk2(v[j].x * rstd * gg.x, v[j].y * rstd * gg.y); w.y = pk2(v[j].z * rstd * gg.z, v[j].w * rstd * gg.w); o8[64 * j] = w; }
}
__device__ __forceinline__ float row_ss(const f32x4 (&v)[4]) { float s = 0.f;
#pragma unroll
    for (int j = 0; j < 4; ++j) s += (v[j].x * v[j].x + v[j].y * v[j].y) + (v[j].z * v[j].z + v[j].w * v[j].w);
    return wave_sum(s); }
__device__ __forceinline__ void phase_norm_first(Frame& F, int l, const GAS float* g) {
    const int gw = F.vcu * NWAVES + F.wave, NGW = F.G * NWAVES; GAS bf16* XN = (GAS bf16*)(wsq(F) + WS_XN);
    for (int m = gw; m < M; m += NGW) {
        const GAS f32x4* xr = (const GAS f32x4*)x_src_row(F, l, m) + F.lane; f32x4 v[4];
#pragma unroll
        for (int j = 0; j < 4; ++j) v[j] = xr[64 * j];
        const float rstd = 1.0f / sqrtf(row_ss(v) * (1.0f / D) + EPS);
        store_xn_row(v, rstd, g, XN + (size_t)m * D, F.lane);
    }
}
__device__ __forceinline__ void phase_norm_res(Frame& F, int lsrc, const GAS bf16* T, const GAS float* gpost, const GAS float* gnext) {
    const int gw = F.vcu * NWAVES + F.wave, NGW = F.G * NWAVES; GAS bf16* XN = (GAS bf16*)(wsq(F) + WS_XN);
    for (int m0 = gw; m0 < M; m0 += 2 * NGW) {
        f32x4 v[2][4], tv[2][4];
#pragma unroll
        for (int q = 0; q < 2; ++q) { const int m = m0 + q * NGW; const GAS f32x4* xr = (const GAS f32x4*)x_src_row(F, lsrc, m) + F.lane; const GAS v2u* tr = (const GAS v2u*)(T + (size_t)m * D) + F.lane;
#pragma unroll
            for (int j = 0; j < 4; ++j) { v[q][j] = xr[64 * j]; const v2u w = tr[64 * j]; tv[q][j] = (f32x4){bf2f(w.x & 0xffffu), bf2f(w.x >> 16), bf2f(w.y & 0xffffu), bf2f(w.y >> 16)}; } }
#pragma unroll
        for (int q = 0; q < 2; ++q) { const int m = m0 + q * NGW;
            const float rt = 1.0f / sqrtf(row_ss(tv[q]) * (1.0f / D) + EPS);
            GAS f32x4* orow = (GAS f32x4*)(F.out + (size_t)m * D) + F.lane;
#pragma unroll
            for (int j = 0; j < 4; ++j) { const f32x4 gg = ((const GAS f32x4*)gpost)[F.lane + 64 * j]; v[q][j] = v[q][j] + tv[q][j] * rt * gg; orow[64 * j] = v[q][j]; }
            if (gnext) { const float rstd = 1.0f / sqrtf(row_ss(v[q]) * (1.0f / D) + EPS); store_xn_row(v[q], rstd, gnext, XN + (size_t)m * D, F.lane); } }
    }
}

__device__ __forceinline__ void phase_filter_mlp(Frame& F, int l) {
    const GAS float* w1 = inp(F, I_FW1) + (size_t)l * 33 * 64; const GAS float* b1 = inp(F, I_FB1) + l * 64; const GAS float* w2 = inp(F, I_FW2) + (size_t)l * 64 * 64; const GAS float* b2 = inp(F, I_FB2) + l * 64;
    const GAS float* sf = inp(F, I_SINF) + l * 128; GAS bf16* H2 = (GAS bf16*)(wsq(F) + WS_H2);
    const int lane = F.lane, gw = F.vcu * NWAVES + F.wave, NGW = F.G * NWAVES;
    float w1c[33], w2c[64];
#pragma unroll
    for (int f = 0; f < 33; ++f) w1c[f] = w1[f * 64 + lane];
#pragma unroll
    for (int i = 0; i < 64; ++i) w2c[i] = w2[i * 64 + lane];
    const float b1l = b1[lane], b2l = b2[lane], sf0 = sf[lane], sf1 = sf[64 + lane];
    for (int n = gw; n < L; n += NGW) {
        const float tn = (float)n * (1.0f / (float)(L - 1)); const float omega = (float)(2.0 * 3.14159265358979323846 / L) * (float)n;
        const int bidx = (lane >= 17) ? lane - 17 : lane - 1; const float band = 1e-4f + (float)bidx * ((15.0f - 1e-4f) / 15.0f); const float ph = omega * band;
        const float zf = (lane == 0) ? tn : ((lane <= 16) ? cosf(ph) : -sinf(ph));
        float acc = b1l;
#pragma unroll
        for (int f = 0; f < 33; ++f) acc += __uint_as_float(__builtin_amdgcn_readlane(__float_as_uint(zf), f)) * w1c[f];
        const float h1 = sinf(sf0 * acc);
        float acc2 = b2l;
#pragma unroll
        for (int i = 0; i < 64; ++i) acc2 += __uint_as_float(__builtin_amdgcn_readlane(__float_as_uint(h1), i)) * w2c[i];
        const float hv = sinf(sf1 * acc2); const bf16 hi = f2bf(hv);
        H2[(size_t)n * 128 + lane] = hi; H2[(size_t)n * 128 + 64 + lane] = f2bf(hv - bf2f(hi));
    }
}

__device__ __forceinline__ void phase_filter_fft(Frame& F, int l) {
    const GAS float* KT = (const GAS float*)(wsq(F) + WS_KT); GAS f32x2* KEO = (GAS f32x2*)(wsq(F) + WS_KEO); const GAS float* hb = inp(F, I_HBIAS) + (size_t)l * 2 * HYW;
    LAS f32x2* buf = (LAS f32x2*)(F.lds + RING_OFF); const int t = F.tid;
    for (int item = F.vcu; item < 2 * HYW; item += F.G) {
        const int o = item >> 9, c = item & 511;
        const GAS float* fw = KT + (size_t)((o * 2 + 0) * HYW + c) * L; const GAS float* bw = KT + (size_t)((o * 2 + 1) * HYW + c) * L;
        const float bias = hb[o * HYW + c]; const float sc = 1.0f / (2.0f * L);
        GAS f32x2* ke = KEO + (size_t)item * KEO_BLK; GAS f32x2* ko = ke + KEO_KO;
        float ar[32], ai[32];
        { const int tq = hfft::opaque(t); (void)tq;
#pragma unroll
        for (int m = 0; m < 32; ++m) { const int n = tq + 512 * m; const float f = fw[n]; float b = bw[n >= 1 ? L - n : 0]; b = n >= 1 ? b : 0.f; ar[m] = f + b; ai[m] = 0.f; if ((m & 15) == 15) { asm volatile("" ::: "memory"); __builtin_amdgcn_sched_barrier(0); } }
        }
        hfft::fft16k<false>(ar, ai, buf, t);
        { const int tq = hfft::opaque(t); (void)tq;
#pragma unroll
        for (int m = 0; m <= 16; ++m) { const int k = tq + 512 * m; if (k <= 8192) ke[k] = (f32x2){(ar[m] + bias) * sc, ai[m] * sc}; }
        }
        { const int tq = hfft::opaque(t); (void)tq;
#pragma unroll
        for (int m = 0; m < 32; ++m) { const int n = tq + 512 * m; const float f = fw[n]; float b = bw[n >= 1 ? L - n : 0]; b = n >= 1 ? b : 0.f; const float d = f - b; const float fr = (float)n * (1.0f / 32768.0f);
            ar[m] = d * __builtin_amdgcn_cosf(fr); ai[m] = -d * __builtin_amdgcn_sinf(fr); if ((m & 15) == 15) { asm volatile("" ::: "memory"); __builtin_amdgcn_sched_barrier(0); } }
        }
        hfft::fft16k<false>(ar, ai, buf, t);
        { const int tq = hfft::opaque(t); (void)tq;
#pragma unroll
        for (int m = 0; m < 16; ++m) { const int k = tq + 512 * m; ko[k] = (f32x2){(ar[m] + bias) * sc, ai[m] * sc}; }
        }
    }
    __syncthreads();
}

__device__ __forceinline__ float u_conv3(const GAS bf16* row, int n, float w0, float w1, float w2, float cb) {
    const int nm = n >= 1 ? n - 1 : 0, np = n + 1 < L ? n + 1 : L - 1;
    float um = bf2f(row[nm]), up = bf2f(row[np]); const float u0 = bf2f(row[n]);
    um = n >= 1 ? um : 0.f; up = n + 1 < L ? up : 0.f;
    return um * w0 + u0 * w1 + up * w2 + cb;
}
__device__ __forceinline__ void cmul_spec(float (&xr)[32], float (&xi)[32], const GAS f32x2* ke, int t, bool odd) {
    { const int tq = hfft::opaque(t); (void)tq;
#pragma unroll
    for (int m = 0; m < 32; ++m) { const int k = tq + 512 * m; int idx; bool cj;
        if (!odd) { cj = k > 8192; idx = cj ? 16384 - k : k; } else { cj = k >= 8192; idx = cj ? 16383 - k : k; }
        const f32x2 kv = ke[idx]; const float kr = kv.x, ki = cj ? -kv.y : kv.y;
        const float a = xr[m], b = xi[m]; xr[m] = a * kr - b * ki; xi[m] = a * ki + b * kr; if ((m & 15) == 15) { asm volatile("" ::: "memory"); __builtin_amdgcn_sched_barrier(0); } }
    }
}
__device__ __forceinline__ f32x2 ld_spec(const GAS f32x2* ke, int k, bool odd) {
    int idx; bool cj;
    if (!odd) { cj = k > 8192; idx = cj ? 16384 - k : k; } else { cj = k >= 8192; idx = cj ? 16383 - k : k; }
    f32x2 kv = ke[idx]; kv.y = cj ? -kv.y : kv.y; return kv;
}
__device__ __forceinline__ void cmul_spec2(float (&xr)[32], float (&xi)[32], const GAS f32x2* ka, const GAS f32x2* kb, LAS f32x2* buf, int t, bool odd) {
    __syncthreads();
    { const int tq = hfft::opaque(t);
#pragma unroll
      for (int m = 0; m < 32; ++m) buf[hfft::pad(tq + 512 * m)] = (f32x2){xr[m], xi[m]}; }
    __syncthreads();
    { const int tq = hfft::opaque(t);
#pragma unroll
      for (int m = 0; m < 32; ++m) { const int k = tq + 512 * m; const int rk = odd ? 16383 - k : ((16384 - k) & 16383);
          const f32x2 xc = buf[hfft::pad(rk)];
          const f32x2 a = ld_spec(ka, k, odd), b = ld_spec(kb, k, odd);
          const float sr = 0.5f * (a.x + b.x), si = 0.5f * (a.y + b.y), dr = 0.5f * (a.x - b.x), di = 0.5f * (a.y - b.y);
          const float x0 = xr[m], x1 = xi[m], c0 = xc.x, c1 = -xc.y;
          xr[m] = (x0 * sr - x1 * si) + (c0 * dr - c1 * di); xi[m] = (x0 * si + x1 * sr) + (c0 * di + c1 * dr);
          if ((m & 7) == 7) { asm volatile("" ::: "memory"); __builtin_amdgcn_sched_barrier(0); } } }
}
__device__ __forceinline__ void phase_hyena(Frame& F, int l) {
    const GAS bf16* UT = (const GAS bf16*)(wsq(F) + WS_UT); GAS bf16* YT = (GAS bf16*)(wsq(F) + WS_YT); const GAS f32x2* KEO = (const GAS f32x2*)(wsq(F) + WS_KEO);
    const GAS float* cw = inp(F, I_CONVW) + (size_t)l * 3 * HYP; const GAS float* cbv = inp(F, I_CONVB) + (size_t)l * HYP;
    LAS f32x2* buf = (LAS f32x2*)(F.lds + RING_OFF); const int t = F.tid;
    GAS f32x2* G0 = (GAS f32x2*)(wsq(F) + WS_G0) + (size_t)F.vcu * 16384 + t;
    GAS f32x2* G1 = (GAS f32x2*)(wsq(F) + (F.vcu < 200 ? WS_G1A + (size_t)F.vcu * 131072 : WS_G1B + (size_t)(F.vcu - 200) * 131072)) + t;
    for (int item = F.vcu; item < HYW + HYW / 2; item += F.G) {
        const bool mode1 = item >= HYW;
        const int c0 = mode1 ? 2 * (item - HYW) : item, c1 = mode1 ? c0 + 1 : c0;
        const size_t s0 = mode1 ? (size_t)2 * L : 0, s1 = mode1 ? (size_t)2 * L : (size_t)L;
        float ar[32], ai[32];
#pragma unroll 1
        for (int o = 0; o < 2; ++o) {
            const GAS f32x2* ke0 = KEO + (size_t)(o * HYW + c0) * KEO_BLK; const GAS f32x2* ke1 = KEO + (size_t)(o * HYW + c1) * KEO_BLK;
#pragma unroll 1
            for (int half = 0; half < 2; ++half) {
                if (o == 0) { const float w0 = cw[c0], w1 = cw[HYP + c0], w2 = cw[2 * HYP + c0], cb = cbv[c0], v0 = cw[c1], v1 = cw[HYP + c1], v2 = cw[2 * HYP + c1], vb = cbv[c1];
                    const GAS bf16* r0 = UT + (size_t)c0 * M + s0; const GAS bf16* r1 = UT + (size_t)c1 * M + s1;
                    { const int tq = hfft::opaque(t); (void)tq;
#pragma unroll
                    for (int m = 0; m < 32; ++m) { const int n = tq + 512 * m; ar[m] = u_conv3(r0, n, w0, w1, w2, cb); ai[m] = u_conv3(r1, n, v0, v1, v2, vb); if ((m & 15) == 15) { asm volatile("" ::: "memory"); __builtin_amdgcn_sched_barrier(0); } } }
                    }
                else {
                    { const int tq = hfft::opaque(t); (void)tq; GAS f32x2* G0q = G0 + (tq - t);
#pragma unroll
                    for (int m = 0; m < 32; ++m) { const f32x2 v = G0q[m * 512]; ar[m] = v.x; ai[m] = v.y; if ((m & 15) == 15) { asm volatile("" ::: "memory"); __builtin_amdgcn_sched_barrier(0); } } }
                    }
                if (half == 0) {
                    hfft::fft16k<false>(ar, ai, buf, t);
                    if (mode1) cmul_spec2(ar, ai, ke0, ke1, buf, t, false); else cmul_spec(ar, ai, ke0, t, false);
                    hfft::fft16k<true>(ar, ai, buf, t);
                    { const int tq = hfft::opaque(t); (void)tq; GAS f32x2* G1q = G1 + (tq - t);
#pragma unroll
                    for (int m = 0; m < 32; ++m) G1q[m * 512] = (f32x2){ar[m], ai[m]};
                    }
                } else {
                    { const int tq = hfft::opaque(t); (void)tq;
#pragma unroll
                    for (int m = 0; m < 32; ++m) { const float fr = (float)(tq + 512 * m) * (1.0f / 32768.0f); const float cs = __builtin_amdgcn_cosf(fr), sn = -__builtin_amdgcn_sinf(fr);
                        const float a = ar[m], b = ai[m]; ar[m] = a * cs - b * sn; ai[m] = a * sn + b * cs; }
                    }
                    hfft::fft16k<false>(ar, ai, buf, t);
                    if (mode1) cmul_spec2(ar, ai, ke0 + KEO_KO, ke1 + KEO_KO, buf, t, true); else cmul_spec(ar, ai, ke0 + KEO_KO, t, true);
                    hfft::fft16k<true>(ar, ai, buf, t);
                    const int g0 = (o + 1) * HYW + c0, g1 = (o + 1) * HYW + c1;
                    const float w0 = cw[g0], w1 = cw[HYP + g0], w2 = cw[2 * HYP + g0], cb = cbv[g0], v0 = cw[g1], v1 = cw[HYP + g1], v2 = cw[2 * HYP + g1], vb = cbv[g1];
                    const GAS bf16* r0 = UT + (size_t)g0 * M + s0; const GAS bf16* r1 = UT + (size_t)g1 * M + s1;
                    { const int tq = hfft::opaque(t); (void)tq; GAS f32x2* G1q = G1 + (tq - t);
#pragma unroll
                    for (int m = 0; m < 32; ++m) { const int n = tq + 512 * m; const float fr = (float)n * (1.0f / 32768.0f); const float cs = __builtin_amdgcn_cosf(fr), sn = __builtin_amdgcn_sinf(fr);
                        const float a = ar[m], b = ai[m]; const f32x2 e = G1q[m * 512]; const float yr = e.x + (a * cs - b * sn), yi = e.y + (a * sn + b * cs);
                        ar[m] = yr * u_conv3(r0, n, w0, w1, w2, cb); ai[m] = yi * u_conv3(r1, n, v0, v1, v2, vb); if ((m & 15) == 15) { asm volatile("" ::: "memory"); __builtin_amdgcn_sched_barrier(0); } }
                    }
                    if (o == 0) {
                        { const int tq = hfft::opaque(t); (void)tq; GAS f32x2* G0q = G0 + (tq - t);
#pragma unroll
                        for (int m = 0; m < 32; ++m) G0q[m * 512] = (f32x2){ar[m], ai[m]};
                        }
                    } else { GAS bf16* y0 = YT + (size_t)c0 * M + s0; GAS bf16* y1 = YT + (size_t)c1 * M + s1;
                        { const int tq = hfft::opaque(t); (void)tq;
#pragma unroll
                        for (int m = 0; m < 32; ++m) { const int n = tq + 512 * m; y0[n] = f2bf(ar[m]); y1[n] = f2bf(ai[m]); } }
                        }
                }
            }
        }
    }
    __syncthreads();
}

__device__ __forceinline__ void phase_mla_prep(Frame& F, int l) {
    const GAS bf16* CQKV = (const GAS bf16*)(wsq(F) + WS_CQKV); GAS bf16* CQN = (GAS bf16*)(wsq(F) + WS_CQN); GAS bf16* CKVN = (GAS bf16*)(wsq(F) + WS_CKVN); GAS bf16* KPE = (GAS bf16*)(wsq(F) + WS_KPE);
    const GAS float* gq = inp(F, I_QNORM) + l * QR; const GAS float* gkv = inp(F, I_KVNORM) + l * KVR; const GAS float* ct = (const GAS float*)(wsq(F) + WS_COS); const GAS float* st = (const GAS float*)(wsq(F) + WS_SIN);
    const int gw = F.vcu * NWAVES + F.wave, NGW = F.G * NWAVES, lane = F.lane;
    for (int m = gw; m < M; m += NGW) {
        const GAS bf16* row = CQKV + (size_t)m * 512;
        const v2u q = *(const GAS v2u*)(row + 4 * lane); const unsigned kv = *(const GAS unsigned*)(row + 256 + 2 * lane);
        const float q0 = bf2f(q.x & 0xffffu), q1 = bf2f(q.x >> 16), q2 = bf2f(q.y & 0xffffu), q3 = bf2f(q.y >> 16), k0 = bf2f(kv & 0xffffu), k1 = bf2f(kv >> 16);
        const float rq = 1.0f / sqrtf(wave_sum((q0 * q0 + q1 * q1) + (q2 * q2 + q3 * q3)) * (1.0f / QR) + EPS);
        const float rk = 1.0f / sqrtf(wave_sum(k0 * k0 + k1 * k1) * (1.0f / KVR) + EPS);
        const f32x4 g4 = *(const GAS f32x4*)(gq + 4 * lane); const f32x2 g2 = *(const GAS f32x2*)(gkv + 2 * lane);
        v2u oq; oq.x = pk2(q0 * rq * g4.x, q1 * rq * g4.y); oq.y = pk2(q2 * rq * g4.z, q3 * rq * g4.w);
        *(GAS v2u*)(CQN + (size_t)m * QR + 4 * lane) = oq;
        *(GAS unsigned*)(CKVN + (size_t)m * KVR + 2 * lane) = pk2(k0 * rk * g2.x, k1 * rk * g2.y);
        if (lane < 16) { const int j = lane, tpos = m & (L - 1); const float x1 = bf2f(row[384 + j]), x2 = bf2f(row[384 + 16 + j]); const float cs = ct[tpos * 16 + j], sn = st[tpos * 16 + j];
            const int p1 = 8 * (j >> 2) + (j & 3); KPE[(size_t)m * ROPE + p1] = f2bf(x1 * cs - x2 * sn); KPE[(size_t)m * ROPE + p1 + 4] = f2bf(x2 * cs + x1 * sn); }
    }
}

__device__ __forceinline__ void phase_hy_out(Frame& F, int l) {
    const GAS bf16* YT = (const GAS bf16*)(wsq(F) + WS_YT); GAS bf16* MIX = (GAS bf16*)(wsq(F) + WS_MIX); const GAS float* gn = inp(F, I_GNHY) + l * HYW;
    LAS bf16* tl = (LAS bf16*)(F.lds + RING_OFF + F.wave * 16384);
    const int gw = F.vcu * NWAVES + F.wave, NGW = F.G * NWAVES, lane = F.lane;
    for (int task = gw; task < 8 * (M / 64); task += NGW) {
        const int g = task & 7, tb = task >> 3, tok0 = tb * 64; const int cl = lane >> 3, t8 = (lane & 7) * 8;
        float v[8][8]; float ss[8]; const int ln_ = hw_lane();
#pragma unroll
        for (int j = 0; j < 8; ++j) ss[j] = 0.f;
#pragma unroll
        for (int i = 0; i < 8; ++i) { const int ch = g * 64 + 8 * i + cl; const v4u w = *(const GAS v4u*)(YT + (size_t)ch * M + tok0 + t8);
            v[i][0] = bf2f(w.x & 0xffffu); v[i][1] = bf2f(w.x >> 16); v[i][2] = bf2f(w.y & 0xffffu); v[i][3] = bf2f(w.y >> 16);
            v[i][4] = bf2f(w.z & 0xffffu); v[i][5] = bf2f(w.z >> 16); v[i][6] = bf2f(w.w & 0xffffu); v[i][7] = bf2f(w.w >> 16);
#pragma unroll
            for (int j = 0; j < 8; ++j) ss[j] += v[i][j] * v[i][j]; }
#pragma unroll
        for (int j = 0; j < 8; ++j) { float s = ss[j]; s += shx(s, ln_, 8); s += shx(s, ln_, 16); s += shx(s, ln_, 32); ss[j] = 1.0f / sqrtf(s * (1.0f / 64.0f) + EPS); }
#pragma unroll
        for (int i = 0; i < 8; ++i) { const int cc = 8 * i + cl; const float gg = gn[g * 64 + cc];
#pragma unroll
            for (int j = 0; j < 8; ++j) tl[(t8 + j) * 72 + cc] = f2bf(v[i][j] * ss[j] * gg); }
        LDS_WAIT(); asm volatile("" ::: "memory");
#pragma unroll
        for (int i = 0; i < 8; ++i) { const int tok = 8 * i + (lane >> 3), c8 = (lane & 7) * 8; const v4u w = *(const LAS v4u*)(tl + tok * 72 + c8);
            *(GAS v4u*)(MIX + (size_t)(tok0 + tok) * D + g * 64 + c8) = w; }
        LDS_WAIT(); asm volatile("" ::: "memory");
    }
}

namespace att {
using s16x4 = __attribute__((ext_vector_type(4))) short;
using f32x16 = __attribute__((ext_vector_type(16))) float;
using u32x4 = __attribute__((ext_vector_type(4))) unsigned;
constexpr int QBLK = 32, KVBLK = 64, NW = 8;
constexpr float SCALE = 0.10206207261596575f;
constexpr float THR = 8.f;
constexpr int SHM_K = KVBLK * 256, SHM_V = KVBLK * DV * 2;
constexpr int NSLOT = 3;
constexpr int OFF_V = 0, OFF_K = NSLOT * SHM_V, OFF_WS = OFF_K + NSLOT * SHM_K, SHM_ATTN = OFF_WS + NW * 64 * 4;
#define KSWZ(row, colB) ((row) * 256 + ((colB) ^ (((row) & 15) << 4)))
#define SBAR() __builtin_amdgcn_sched_barrier(0)
__device__ __forceinline__ int crow(int r, int hi) { return (r & 3) + 8 * (r >> 2) + 4 * hi; }
__device__ __forceinline__ unsigned cvtpk(float lo, float hi) { unsigned r; asm volatile("v_cvt_pk_bf16_f32 %0, %1, %2" : "=v"(r) : "v"(lo), "v"(hi)); return r; }
constexpr float THRL = THR * 1.4426950408889634f;
#define EX2(v) __builtin_amdgcn_exp2f(v)
#define MX3(a, b, c) __builtin_fmaxf(__builtin_fmaxf((a), (b)), (c))
__device__ __forceinline__ int v_st(int k, int c) { const int kk = (k & ~0xC) | ((k & 4) << 1) | ((k & 8) >> 1); return ((kk >> 3) * 2 + (c >> 5)) * 512 + ((kk & 7) * 32 + (c & 31)) * 2; }
__device__ __forceinline__ int v_rd_base(int lane) { return ((lane & 3) << 3) | (((lane >> 2) & 3) << 6) | (((lane >> 4) & 1) << 5) | (((lane >> 5) & 1) << 8); }
constexpr int v_rd_off(int d0, int ks, int half) { return d0 * 512 + ks * 2048 + half * 1024; }
template <int OFF> __device__ __forceinline__ s16x4 tr_read(int vb) { s16x4 r; asm volatile("ds_read_b64_tr_b16 %0, %1 offset:%2" : "=&v"(r) : "v"(vb), "i"(OFF) : "memory"); return r; }
__device__ __forceinline__ void attn_unit(const bf16* Qb_, const bf16* KNh_, const bf16* KPEb_, const bf16* Vh_, bf16* Mo_,
                                          const float* gain_, const float* ct_, const float* st_, int tpos0, LAS char* lds, const int wave0) {
  const GAS bf16* Qb = (const GAS bf16*)Qb_; const GAS bf16* KNh = (const GAS bf16*)KNh_; const GAS bf16* KPEb = (const GAS bf16*)KPEb_; const GAS bf16* Vh = (const GAS bf16*)Vh_; GAS bf16* Mo = (GAS bf16*)Mo_;
  const GAS float* gain = (const GAS float*)gain_; const GAS float* ct = (const GAS float*)ct_; const GAS float* st = (const GAS float*)st_;

  int tid_ = tid_from_wave(wave0);
  const int tid = tid_, wid = tid >> 6, lane = tid & 63, r32 = lane & 31, hi = lane >> 5;
  LAS char* V_lds = lds + OFF_V; LAS char* K_lds = lds + OFF_K;
  LAS float* ws = (LAS float*)(lds + OFF_WS) + wid * 64; LAS float* li_l = ws; LAS float* al_l = ws + 32;
  float m_reg = 0.f, l_reg = 0.f; f32x16 o[2] = {}; f32x16 negm = {}; bf16x8 qr[6];
  const GAS bf16* Qw = Qb + (long)(wid * QBLK + r32) * NQ + hi * 8;
#pragma unroll
  for (int d0 = 0; d0 < 6; ++d0) qr[d0] = *reinterpret_cast<const GAS bf16x8*>(Qw + d0 * 16);
  { const int tq = tpos0 + wid * QBLK + r32;
#pragma unroll
    for (int d0 = 4; d0 < 6; ++d0) { const int fq = 2 * (d0 - 4) + hi; const f32x4 cs = *reinterpret_cast<const GAS f32x4*>(ct + tq * 16 + 4 * fq), sn = *reinterpret_cast<const GAS f32x4*>(st + tq * 16 + 4 * fq);
      const u32x4 w = __builtin_bit_cast(u32x4, qr[d0]);
      const f32x4 x1 = {bf2f(w[0] & 0xffffu), bf2f(w[0] >> 16), bf2f(w[1] & 0xffffu), bf2f(w[1] >> 16)}, x2 = {bf2f(w[2] & 0xffffu), bf2f(w[2] >> 16), bf2f(w[3] & 0xffffu), bf2f(w[3] >> 16)};
      const f32x4 a = x1 * cs - x2 * sn, b = x2 * cs + x1 * sn;
      const u32x4 o4 = {cvtpk(a[0], a[1]), cvtpk(a[2], a[3]), cvtpk(b[0], b[1]), cvtpk(b[2], b[3])}; qr[d0] = __builtin_bit_cast(bf16x8, o4); } }
  { constexpr float C = SCALE * 1.4426950408889634f;
#pragma unroll
    for (int d0 = 0; d0 < 6; ++d0) { const u32x4 w = __builtin_bit_cast(u32x4, qr[d0]); u32x4 o4;
#pragma unroll
      for (int e = 0; e < 4; ++e) o4[e] = cvtpk(bf2f(w[e] & 0xffffu) * C, bf2f(w[e] >> 16) * C);
      qr[d0] = __builtin_bit_cast(bf16x8, o4); } }
  const int sr = tid >> 3, sc = (tid & 7) * 8;
  const int rr_ = (tid & 255) >> 2, rc = (tid & 3) * 8;
  const int vst0 = v_st(sr, sc), kst0 = KSWZ(sr, sc * 2), kst1 = KSWZ(rr_, 128 + rc * 2);
  const int vb0 = (int)(unsigned)(uintptr_t)V_lds + v_rd_base(lane);
  struct { bf16x8 vs, kn, kr; } sr_[2];
#define SLOAD(i, k0) do { sr_[i].vs = *reinterpret_cast<const GAS bf16x8*>(&Vh[(long)((k0) + sr) * NKV + sc]); sr_[i].kn = *reinterpret_cast<const GAS bf16x8*>(&KNh[(long)((k0) + sr) * NKV + sc]); \
    sr_[i].kr = *reinterpret_cast<const GAS bf16x8*>(&KPEb[(long)((k0) + rr_) * ROPE + rc]); } while (0)
#define SWRITE(b, i) do { *(LAS bf16x8*)(V_lds + (b) * SHM_V + vst0) = sr_[i].vs; *(LAS bf16x8*)(K_lds + (b) * SHM_K + kst0) = sr_[i].kn; *(LAS bf16x8*)(K_lds + (b) * SHM_K + kst1) = sr_[i].kr; } while (0)
#define SWAIT() asm volatile("s_waitcnt vmcnt(3)" ::: "memory")
#define RESC(a) do { if (__any((a) < 1.f)) { if (hi == 0) al_l[r32] = (a); asm volatile("s_waitcnt lgkmcnt(0)" ::: "memory"); \
    _Pragma("unroll") for (int d = 0; d < 2; ++d) _Pragma("unroll") for (int r = 0; r < 16; ++r) o[d][r] *= al_l[crow(r, hi)]; } } while (0)
  f32x16 pA0, pA1, pB0, pB1; bf16x8 pa0, pa1, pa2, pa3; constexpr int NTL = L / KVBLK; constexpr int SE = 0, SO = 1;
  int koff[6];
#pragma unroll
  for (int d0 = 0; d0 < 6; ++d0) koff[d0] = KSWZ(r32, (d0 * 16 + hi * 8) * 2);
  s16x4 vl[4], vh[4]; float pmax = 0.f, alpha = 1.f;
#define KFR(i) (*(const LAS bf16x8*)(kbase + koff[(i) >> 1] + ((i) & 1) * 8192))
#define VRD8(D0) do { vl[0] = tr_read<v_rd_off(D0, 0, 0)>(vbq); vh[0] = tr_read<v_rd_off(D0, 0, 1)>(vbq); vl[1] = tr_read<v_rd_off(D0, 1, 0)>(vbq); vh[1] = tr_read<v_rd_off(D0, 1, 1)>(vbq); \
    vl[2] = tr_read<v_rd_off(D0, 2, 0)>(vbq); vh[2] = tr_read<v_rd_off(D0, 2, 1)>(vbq); vl[3] = tr_read<v_rd_off(D0, 3, 0)>(vbq); vh[3] = tr_read<v_rd_off(D0, 3, 1)>(vbq); } while (0)
#define VWAIT() asm volatile("s_waitcnt lgkmcnt(0)" : "+v"(vl[0]), "+v"(vh[0]), "+v"(vl[1]), "+v"(vh[1]), "+v"(vl[2]), "+v"(vh[2]), "+v"(vl[3]), "+v"(vh[3]) :: "memory")
#define VFR(k) (bf16x8){vl[k][0], vl[k][1], vl[k][2], vl[k][3], vh[k][0], vh[k][1], vh[k][2], vh[k][3]}
#define PKA(P, B) do { ca_ = cvtpk(P[B + 0], P[B + 1]); cb_ = cvtpk(P[B + 4], P[B + 5]); auto r_ = __builtin_amdgcn_permlane32_swap(ca_, cb_, false, false); w0_ = r_[0]; w2_ = r_[1]; } while (0)
#define PKB(P, B, OUT) do { ca_ = cvtpk(P[B + 2], P[B + 3]); cb_ = cvtpk(P[B + 6], P[B + 7]); auto r_ = __builtin_amdgcn_permlane32_swap(ca_, cb_, false, false); \
    const u32x4 w_ = {w0_, r_[0], w2_, r_[1]}; OUT = __builtin_bit_cast(bf16x8, w_); } while (0)
#define R1(DO_QK, DO_FIN, X0, X1, Y0, Y1, KSLOT) do { const LAS char* kbase = K_lds + (KSLOT) * SHM_K; bf16x8 kf0, kf1, kf2, kf3; unsigned ca_, cb_, w0_ = 0, w2_ = 0; \
    if (DO_QK) { kf0 = KFR(0); kf1 = KFR(1); kf2 = KFR(2); } SBAR(); \
      if (DO_QK) { kf3 = KFR(3); X0 = __builtin_amdgcn_mfma_f32_32x32x16_bf16(kf0, qr[0], negm, 0, 0, 0); } if (DO_FIN) { Y0[0] = EX2(Y0[0]); Y0[1] = EX2(Y0[1]); Y0[2] = EX2(Y0[2]); Y0[3] = EX2(Y0[3]); } SBAR(); \
      if (DO_QK) { kf0 = KFR(4); X1 = __builtin_amdgcn_mfma_f32_32x32x16_bf16(kf1, qr[0], negm, 0, 0, 0); } if (DO_FIN) { Y0[4] = EX2(Y0[4]); Y0[5] = EX2(Y0[5]); Y0[6] = EX2(Y0[6]); Y0[7] = EX2(Y0[7]); } SBAR(); \
      if (DO_QK) { kf1 = KFR(5); X0 = __builtin_amdgcn_mfma_f32_32x32x16_bf16(kf2, qr[1], X0, 0, 0, 0); } if (DO_FIN) { Y0[8] = EX2(Y0[8]); Y0[9] = EX2(Y0[9]); Y0[10] = EX2(Y0[10]); Y0[11] = EX2(Y0[11]); } SBAR(); \
      if (DO_QK) { kf2 = KFR(6); X1 = __builtin_amdgcn_mfma_f32_32x32x16_bf16(kf3, qr[1], X1, 0, 0, 0); } if (DO_FIN) { Y0[12] = EX2(Y0[12]); Y0[13] = EX2(Y0[13]); Y0[14] = EX2(Y0[14]); Y0[15] = EX2(Y0[15]); } SBAR(); \
      if (DO_QK) { kf3 = KFR(7); X0 = __builtin_amdgcn_mfma_f32_32x32x16_bf16(kf0, qr[2], X0, 0, 0, 0); } if (DO_FIN) { Y1[0] = EX2(Y1[0]); Y1[1] = EX2(Y1[1]); Y1[2] = EX2(Y1[2]); Y1[3] = EX2(Y1[3]); PKA(Y0, 0); } SBAR(); \
      if (DO_QK) { kf0 = KFR(8); X1 = __builtin_amdgcn_mfma_f32_32x32x16_bf16(kf1, qr[2], X1, 0, 0, 0); } if (DO_FIN) { Y1[4] = EX2(Y1[4]); Y1[5] = EX2(Y1[5]); Y1[6] = EX2(Y1[6]); Y1[7] = EX2(Y1[7]); PKB(Y0, 0, pa0); } SBAR(); \
      if (DO_QK) { kf1 = KFR(9); X0 = __builtin_amdgcn_mfma_f32_32x32x16_bf16(kf2, qr[3], X0, 0, 0, 0); } if (DO_FIN) { Y1[8] = EX2(Y1[8]); Y1[9] = EX2(Y1[9]); Y1[10] = EX2(Y1[10]); Y1[11] = EX2(Y1[11]); PKA(Y0, 8); } SBAR(); \
      if (DO_QK) { kf2 = KFR(10); X1 = __builtin_amdgcn_mfma_f32_32x32x16_bf16(kf3, qr[3], X1, 0, 0, 0); } if (DO_FIN) { Y1[12] = EX2(Y1[12]); Y1[13] = EX2(Y1[13]); Y1[14] = EX2(Y1[14]); Y1[15] = EX2(Y1[15]); PKB(Y0, 8, pa1); } SBAR(); \
      if (DO_QK) { kf3 = KFR(11); X0 = __builtin_amdgcn_mfma_f32_32x32x16_bf16(kf0, qr[4], X0, 0, 0, 0); } if (DO_FIN) { PKA(Y1, 0); } SBAR(); \
      if (DO_QK) { X1 = __builtin_amdgcn_mfma_f32_32x32x16_bf16(kf1, qr[4], X1, 0, 0, 0); } if (DO_FIN) { PKB(Y1, 0, pa2); } SBAR(); \
      if (DO_QK) { X0 = __builtin_amdgcn_mfma_f32_32x32x16_bf16(kf2, qr[5], X0, 0, 0, 0); } if (DO_FIN) { PKA(Y1, 8); } SBAR(); \
      if (DO_QK) { X1 = __builtin_amdgcn_mfma_f32_32x32x16_bf16(kf3, qr[5], X1, 0, 0, 0); } if (DO_FIN) { PKB(Y1, 8, pa3); } SBAR(); \
  } while (0)
#define R2(DO_PV, DO_MAX, X0, X1, Y0, Y1, VSLOT, LOADS) do { const int vbq = vb0 + (VSLOT) * SHM_V; float ma_ = 0.f, mb_ = 0.f, sa_ = 0.f; \
    if (DO_PV) { VRD8(0); } SBAR(); \
    if (DO_PV) { VWAIT(); o[0] = __builtin_amdgcn_mfma_f32_32x32x16_bf16(pa0, VFR(0), o[0], 0, 0, 0); sa_ = (Y0[0] + Y0[1]) + (Y0[2] + Y0[3]); } SBAR(); \
    if (DO_PV) { o[0] = __builtin_amdgcn_mfma_f32_32x32x16_bf16(pa1, VFR(1), o[0], 0, 0, 0); sa_ += Y0[4]; sa_ += Y0[5]; sa_ += Y0[6]; sa_ += Y0[7]; } LOADS; SBAR(); \
    if (DO_PV) { o[0] = __builtin_amdgcn_mfma_f32_32x32x16_bf16(pa2, VFR(2), o[0], 0, 0, 0); sa_ += Y0[8]; sa_ += Y0[9]; sa_ += Y0[10]; sa_ += Y0[11]; } SBAR(); \
    if (DO_PV) { o[0] = __builtin_amdgcn_mfma_f32_32x32x16_bf16(pa3, VFR(3), o[0], 0, 0, 0); sa_ += Y0[12]; sa_ += Y0[13]; sa_ += Y0[14]; sa_ += Y0[15]; } SBAR(); \
    if (DO_PV) { VRD8(1); sa_ += Y1[0]; sa_ += Y1[1]; sa_ += Y1[2]; sa_ += Y1[3]; sa_ += Y1[4]; sa_ += Y1[5]; sa_ += Y1[6]; sa_ += Y1[7]; } \
    if (DO_MAX) { ma_ = MX3(X0[0], X0[1], X1[0]); mb_ = MX3(X0[2], X0[3], X1[1]); ma_ = MX3(ma_, X1[2], X1[3]); ma_ = MX3(ma_, X0[4], X0[5]); mb_ = MX3(mb_, X0[6], X0[7]); ma_ = MX3(ma_, X1[4], X1[5]); mb_ = MX3(mb_, X1[6], X1[7]); } SBAR(); \
    if (DO_PV) { VWAIT(); o[1] = __builtin_amdgcn_mfma_f32_32x32x16_bf16(pa0, VFR(0), o[1], 0, 0, 0); sa_ += Y1[8]; sa_ += Y1[9]; sa_ += Y1[10]; sa_ += Y1[11]; } if (DO_MAX) { ma_ = MX3(ma_, X0[8], X0[9]); mb_ = MX3(mb_, X0[10], X0[11]); } SBAR(); \
    if (DO_PV) { o[1] = __builtin_amdgcn_mfma_f32_32x32x16_bf16(pa1, VFR(1), o[1], 0, 0, 0); sa_ += Y1[12]; sa_ += Y1[13]; sa_ += Y1[14]; sa_ += Y1[15]; } if (DO_MAX) { ma_ = MX3(ma_, X1[8], X1[9]); mb_ = MX3(mb_, X1[10], X1[11]); } SBAR(); \
    if (DO_PV) { o[1] = __builtin_amdgcn_mfma_f32_32x32x16_bf16(pa2, VFR(2), o[1], 0, 0, 0); l_reg += sa_; } if (DO_MAX) { ma_ = MX3(ma_, X0[12], X0[13]); mb_ = MX3(mb_, X0[14], X0[15]); ma_ = MX3(ma_, X1[12], X1[13]); mb_ = MX3(mb_, X1[14], X1[15]); } SBAR(); \
    if (DO_PV) { o[1] = __builtin_amdgcn_mfma_f32_32x32x16_bf16(pa3, VFR(3), o[1], 0, 0, 0); } if (DO_MAX) { float m_ = __builtin_fmaxf(ma_, mb_); auto rr_ = __builtin_amdgcn_permlane32_swap(__float_as_uint(m_), __float_as_uint(m_), false, false); pmax = __builtin_fmaxf(__uint_as_float(rr_[0]), __uint_as_float(rr_[1])); } SBAR(); \
  } while (0)
#define DECIDE(FIRST, X0, X1) do { alpha = 1.f; \
    if ((FIRST) || !__builtin_expect(__all(pmax <= THRL), 1)) { const float d_ = (FIRST) ? pmax : __builtin_fmaxf(pmax, 0.f); m_reg += d_; if (!(FIRST)) alpha = EX2(-d_); \
      _Pragma("unroll") for (int r = 0; r < 16; ++r) { X0[r] -= d_; X1[r] -= d_; } \
      _Pragma("unroll") for (int r = 0; r < 16; ++r) negm[r] = -m_reg; l_reg *= alpha; } \
    RESC(alpha); } while (0)
  int sp_ = 0, sc_ = 0, sn_ = 1;
#define ROT() do { sp_ = sc_; sc_ = sn_; sn_ = (sn_ == NSLOT - 1) ? 0 : sn_ + 1; } while (0)
  SLOAD(SE, 0); asm volatile("s_waitcnt vmcnt(0)" ::: "memory"); SWRITE(0, SE); __syncthreads();
  R1(true, false, pA0, pA1, pB0, pB1, 0);
  R2(false, true, pA0, pA1, pB0, pB1, 0, (void)0);
  DECIDE(true, pA0, pA1);
  SLOAD(SO, KVBLK); SLOAD(SE, 2 * KVBLK);
  SWAIT(); SWRITE(1, SO); __syncthreads();
  ROT();
  for (int j = 1; j + 1 < NTL; j += 2) {
    R1(true, true, pB0, pB1, pA0, pA1, sc_);
    R2(true, true, pB0, pB1, pA0, pA1, sp_, SLOAD(SO, (j + 2) * KVBLK));
    DECIDE(false, pB0, pB1);
    SWAIT(); SWRITE(sn_, SE);
    __syncthreads(); ROT();
    R1(true, true, pA0, pA1, pB0, pB1, sc_);
    R2(true, true, pA0, pA1, pB0, pB1, sp_, if (j + 3 < NTL) SLOAD(SE, (j + 3) * KVBLK));
    DECIDE(false, pA0, pA1);
    SWAIT(); SWRITE(sn_, SO);
    __syncthreads(); ROT();
  }
  R1(true, true, pB0, pB1, pA0, pA1, sc_);
  R2(true, true, pB0, pB1, pA0, pA1, sp_, (void)0);
  DECIDE(false, pB0, pB1);
  R1(false, true, pA0, pA1, pB0, pB1, sc_);
  R2(true, false, pA0, pA1, pB0, pB1, sc_, (void)0);
#undef ROT
#undef DECIDE
#undef R2
#undef R1
#undef PKA
#undef PKB
#undef VFR
#undef VWAIT
#undef VRD8
#undef KFR
  { auto rr = __builtin_amdgcn_permlane32_swap(__float_as_uint(l_reg), __float_as_uint(l_reg), false, false); l_reg = __uint_as_float(rr[0]) + __uint_as_float(rr[1]); }
  if (hi == 0) li_l[r32] = l_reg; asm volatile("s_waitcnt lgkmcnt(0)" ::: "memory");
  const float g0 = gain[r32], g1 = gain[32 + r32]; const int ln_ = hw_lane();
  GAS bf16* Ow = Mo + (long)(wid * QBLK) * D;
#pragma unroll
  for (int r = 0; r < 16; ++r) { const int orow = crow(r, hi); const float rl = __builtin_amdgcn_rcpf(li_l[orow]);
    const float y0 = o[0][r] * rl, y1 = o[1][r] * rl; float s = y0 * y0 + y1 * y1;
    s += shx(s, ln_, 1); s += shx(s, ln_, 2); s += shx(s, ln_, 4); s += shx(s, ln_, 8); s += shx(s, ln_, 16);
    const float rs = 1.0f / sqrtf(s * (1.0f / 64.0f) + EPS);
    Ow[(long)orow * D + r32] = f2bf(y0 * rs * g0); Ow[(long)orow * D + 32 + r32] = f2bf(y1 * rs * g1); }
  __syncthreads();
#undef SLOAD
#undef SWRITE
#undef SWAIT
#undef RESC
}
#undef EX2
#undef MX3
#undef KSWZ
#undef SBAR
}
#define XB_TMO      128
#define XB_XCNT(j)  (256  + 64 * (j))
#define XB_XSUB(j)  (1280 + 64 * (j))
#define XB_XGEN(j)  (2304 + 64 * (j))
#define XB_TOP      3328
#define XB_TOPGEN   3392
#define XCD_BAR_WORDS 3456
#define XB_SPIN_CAP (1u << 18)

__device__ __forceinline__ unsigned xb_ld(unsigned* p)              { return __hip_atomic_load(p, __ATOMIC_RELAXED, __HIP_MEMORY_SCOPE_AGENT); }
__device__ __forceinline__ unsigned xb_add(unsigned* p, unsigned v) { return __hip_atomic_fetch_add(p, v, __ATOMIC_RELAXED, __HIP_MEMORY_SCOPE_AGENT); }
__device__ __forceinline__ unsigned xb_xcc_id() { return (unsigned)__builtin_amdgcn_s_getreg((3 << 11) | 20) & 0xFu; }
#define XB_SPIN(cond, bar) do { unsigned _sp = 0; while (cond) { __builtin_amdgcn_s_sleep(1); \
    if ((++_sp & 255u) == 0u) { if (xb_ld(&(bar)[XB_TMO])) break; if (_sp > XB_SPIN_CAP) { atomicAdd(&(bar)[XB_TMO], 1u); break; } } } } while (0)

struct XcdBarrier {
    unsigned* bar; unsigned x;
    volatile LAS unsigned* st;
};

__device__ __forceinline__ XcdBarrier xcd_barrier_post(unsigned* bar, volatile LAS unsigned* st, const bool t0) {
    XcdBarrier b; b.bar = bar; b.x = xb_xcc_id(); b.st = st;
    if (t0) (void)xb_add(&bar[XB_XCNT(b.x)], 1u);
    return b;
}
__device__ __forceinline__ void xcd_barrier_complete(unsigned* bar, unsigned x, unsigned& nloc, unsigned& nx) {
    const unsigned G = gridDim.x * gridDim.y * gridDim.z;
    unsigned sum, cnt, mine, sp = 0u;
    for (;;) {
        sum = 0u; cnt = 0u; mine = 0u;
#pragma unroll
        for (unsigned j = 0; j < 16; ++j) { const unsigned c = xb_ld(&bar[XB_XCNT(j)]); sum += c; cnt += (c > 0u) ? 1u : 0u; mine = (j == x) ? c : mine; }
        if (sum == G) break;
        __builtin_amdgcn_s_sleep(1);
        if ((++sp & 255u) == 0u) { if (xb_ld(&bar[XB_TMO])) break; if (sp > XB_SPIN_CAP) { atomicAdd(&bar[XB_TMO], 1u); break; } }
    }
    nloc = mine > 0u ? mine : 1u; nx = cnt > 0u ? cnt : 1u;
}

__device__ __forceinline__ void xcd_barrier(const XcdBarrier& b, const bool t0) {
    asm volatile("s_waitcnt vmcnt(0)" ::: "memory");
    __syncthreads();
    if (t0) {
        unsigned* bar = b.bar;
        __builtin_amdgcn_s_waitcnt(0);
        unsigned nloc = b.st[0], nx = b.st[1];
        if (nloc == 0u) { xcd_barrier_complete(bar, b.x, nloc, nx); b.st[0] = nloc; b.st[1] = nx; }
        const unsigned old = xb_add(&bar[XB_XSUB(b.x)], 1u);
        const unsigned gen = old / nloc;
        if (old + 1u == (gen + 1u) * nloc) {
            __builtin_amdgcn_fence(__ATOMIC_RELEASE, "agent");
            asm volatile("s_waitcnt vmcnt(0)" ::: "memory");
            const unsigned og = xb_add(&bar[XB_TOP], 1u);
            const unsigned tg = og / nx;
            if (og + 1u == (tg + 1u) * nx) xb_add(&bar[XB_TOPGEN], 1u);
            else XB_SPIN(xb_ld(&bar[XB_TOPGEN]) == tg, bar);
            __builtin_amdgcn_fence(__ATOMIC_ACQUIRE, "agent");
            xb_add(&bar[XB_XGEN(b.x)], 1u);
            asm volatile("s_waitcnt vmcnt(0)" ::: "memory");
        } else {
            XB_SPIN(xb_ld(&bar[XB_XGEN(b.x)]) == gen, bar);
            __builtin_amdgcn_fence(__ATOMIC_ACQUIRE, "agent");
            asm volatile("s_waitcnt vmcnt(0)" ::: "memory");
        }
    }
    __syncthreads();
}

__device__ __forceinline__ void xcd_barrier_fast(const XcdBarrier& b, const bool t0) {
    asm volatile("s_waitcnt vmcnt(0)" ::: "memory");
    __syncthreads();
    if (t0) {
        unsigned* bar = b.bar; asm volatile("" : "+s"(bar));
        __builtin_amdgcn_s_waitcnt(0);
        unsigned nloc = b.st[0], nx = b.st[1];
        unsigned bx_ = b.x; asm volatile("" : "+s"(bx_));
        const unsigned old = xb_add(&bar[XB_XSUB(bx_)], 1u);
        const unsigned gen = old / nloc;
        if (old + 1u == (gen + 1u) * nloc) {
            __builtin_amdgcn_fence(__ATOMIC_RELEASE, "agent");
            asm volatile("s_waitcnt vmcnt(0)" ::: "memory");
            const unsigned og = xb_add(&bar[XB_TOP], 1u);
            const unsigned tg = og / nx;
            if (og + 1u == (tg + 1u) * nx) xb_add(&bar[XB_TOPGEN], 1u);
            else XB_SPIN(xb_ld(&bar[XB_TOPGEN]) == tg, bar);
            __builtin_amdgcn_fence(__ATOMIC_ACQUIRE, "agent");
            xb_add(&bar[XB_XGEN(bx_)], 1u);
            asm volatile("s_waitcnt vmcnt(0)" ::: "memory");
        } else {
            XB_SPIN(xb_ld(&bar[XB_XGEN(bx_)]) == gen, bar);
            __builtin_amdgcn_fence(__ATOMIC_ACQUIRE, "agent");
            asm volatile("s_waitcnt vmcnt(0)" ::: "memory");
        }
    }
    __syncthreads();
}

constexpr int CW_BAR = 4096;
struct Args { const float* in[26]; float* out; unsigned char* ws; };
#ifndef REP_ATT
#define REP_ATT 1
#endif
#ifndef REP_GEMM
#define REP_GEMM 1
#endif
#ifndef REP_HY
#define REP_HY 1
#endif
#ifndef REP_FILT
#define REP_FILT 1
#endif
#ifndef REP_MISC
#define REP_MISC 1
#endif
#ifndef PROBE_MASK
#define PROBE_MASK 0
#endif
#define TIC() do { if (PROBE_MASK) pr_t0 = __builtin_amdgcn_s_memrealtime(); } while (0)
#define TOC(ph) do { if (PROBE_MASK & (1u << (ph))) pr_acc += __builtin_amdgcn_s_memrealtime() - pr_t0; } while (0)
#define REPEAT(n) _Pragma("unroll 1") for (int rep_ = 0; rep_ < (n); ++rep_)
#define REFRESH() do { const int t_ = tid_from_wave(F.wave0); F.tid = t_; F.lane = t_ & 63; F.wave = __builtin_amdgcn_readfirstlane(t_ >> 6); int v_ = F.vcu; asm volatile("" : "+s"(v_)); F.vcu = v_; } while (0)
#define BXQ() ({ int b_ = (int)blockIdx.x; asm volatile("" : "+s"(b_)); b_; })
#define GEMM_PHASE(EPI, g, S, E) REPEAT(REP_GEMM) pg8::gemm_phase<EPI, pg8::StaticOrder, true, true>(F.lds + RING_OFF, g, S, E, F.wave0)

__global__ void __launch_bounds__(NTHR, 2) hyena_mla_fwd(Args args) {
    extern __shared__ __attribute__((aligned(16))) unsigned char lds[];
    Frame F;
    F.lds = (LAS unsigned char*)lds;
    F.MISC = (volatile LAS unsigned*)(F.lds + MISC_OFF);
    F.tid = threadIdx.x; F.lane = F.tid & 63; F.wave = __builtin_amdgcn_readfirstlane(F.tid >> 6); F.wave0 = F.wave;
    F.G = gridDim.x; { const int bx = blockIdx.x; F.vcu = (F.G % 8 == 0) ? (bx % 8) * (F.G / 8) + bx / 8 : bx; }
    F.ws = args.ws; F.out = args.out; F.ctl = (gu32*)(args.ws + WS_CTL);
    if (F.tid == 0) {
#pragma unroll
        for (int i = 0; i < 26; ++i) *(LAS unsigned long long*)(F.lds + PTRTAB_OFF + 8 * i) = (unsigned long long)args.in[i];
    }
    for (int u = F.tid; u < 512 / 4; u += NTHR) ((LAS unsigned*)(F.lds + LDSCTL_OFF))[u] = 0u;
    __syncthreads();
    XcdBarrier bar = xcd_barrier_post((unsigned*)(F.ctl + CW_BAR), F.MISC + 8, F.tid == 0);
    xcd_barrier(bar, F.tid == 0);
    unsigned long long pr_t0 = 0, pr_acc = 0; (void)pr_t0;
#pragma unroll 1
    for (int l = 0; l < DEPTH; ++l) {
        TIC();
        REPEAT(REP_MISC) { REFRESH(); phase_weights(F, l); }
        __syncthreads();
        REFRESH(); phase_filter_mlp(F, l);
        if (l == 0) { REFRESH(); phase_rope_tab(F); REFRESH(); phase_norm_first(F, 0, inp(F, I_NMIXPRE)); }
        { REFRESH(); xcd_barrier_fast(bar, F.tid == 0); } TOC(0); TIC();
        { unsigned char* w = (unsigned char*)wsq(F); pg8::Gemm g{(bf16*)(w + WS_W3T), (bf16*)(w + WS_H2), 2048, L, 128}; pg8::StaticOrder S; S.init(2048, L, F.G, BXQ());
          pg8::EpiTaps E{(float*)(w + WS_KT), (const float*)inp(F, I_DECAY) + (size_t)l * 2048}; GEMM_PHASE(pg8::EpiTaps, g, S, E); }
        { REFRESH(); xcd_barrier_fast(bar, F.tid == 0); } TOC(1); TIC();
        REPEAT(REP_FILT) { REFRESH(); phase_filter_fft(F, l); }
        { REFRESH(); xcd_barrier_fast(bar, F.tid == 0); } TOC(2); TIC();
        { unsigned char* w = (unsigned char*)wsq(F); bf16* WinT = (bf16*)(w + WS_WIN); bf16* XN = (bf16*)(w + WS_XN); bf16* UT = (bf16*)(w + WS_UT); bf16* CQKV = (bf16*)(w + WS_CQKV);
          { pg8::Gemm g{WinT, XN, HYP, M, D}; pg8::StaticOrder S; S.init(HYP, M, F.G, BXQ());
          pg8::EpiBf16<0> E{UT, M, nullptr, 0, 0, 1.f}; GEMM_PHASE(pg8::EpiBf16<0>, g, S, E); }
        { pg8::Gemm g{XN, WinT + (size_t)HYP * D, M, 512, D}; pg8::StaticOrder S; S.init(M, 512, F.G, (BXQ() + 128) % F.G);
          pg8::EpiBf16<0> E{CQKV, 512, nullptr, 0, 0, 1.f}; GEMM_PHASE(pg8::EpiBf16<0>, g, S, E); } }
        { REFRESH(); xcd_barrier_fast(bar, F.tid == 0); } TOC(3); TIC();
        REPEAT(REP_MISC) { REFRESH(); phase_mla_prep(F, l); }
        REPEAT(REP_HY) { REFRESH(); phase_hyena(F, l); }
        { REFRESH(); xcd_barrier_fast(bar, F.tid == 0); } TOC(4); TIC();
        { unsigned char* w = (unsigned char*)wsq(F); bf16* CQN = (bf16*)(w + WS_CQN); bf16* CKVN = (bf16*)(w + WS_CKVN); bf16* WuqT = (bf16*)(w + WS_WUQ); bf16* WukvT = (bf16*)(w + WS_WUKV);
          bf16* Qb = (bf16*)(w + WS_Q); bf16* KV = (bf16*)(w + WS_KN);
          { pg8::Gemm g{CQN, WuqT, M, NQ, QR}; pg8::StaticOrder S; S.init(M, NQ, F.G, BXQ());
          pg8::EpiBf16<0> E{Qb, NQ, nullptr, 0, 0, 1.f}; GEMM_PHASE(pg8::EpiBf16<0>, g, S, E); }
        { pg8::Gemm g{CKVN, WukvT, M, NKV, KVR}; pg8::StaticOrder S; S.init(M, NKV, F.G, BXQ());
          pg8::EpiBf16<0> E{KV, NKV, nullptr, 0, 0, 1.f}; GEMM_PHASE(pg8::EpiBf16<0>, g, S, E); } }
        { REFRESH(); xcd_barrier_fast(bar, F.tid == 0); } TOC(5); TIC();
        REFRESH();
        { unsigned char* w = (unsigned char*)wsq(F); bf16* Qb = (bf16*)(w + WS_Q); bf16* KV = (bf16*)(w + WS_KN); bf16* KPE = (bf16*)(w + WS_KPE); bf16* MIX = (bf16*)(w + WS_MIX);
          const float* ct = (const float*)(w + WS_COS); const float* st = (const float*)(w + WS_SIN); const float* gat = (const float*)inp(F, I_GNAT) + l * 512;
        REPEAT(REP_ATT) for (int i = 0; i < 6; ++i) {
            const int bh = 3 * (F.vcu >> 5) + (i >> 1), qb = (i & 1) * 32 + (F.vcu & 31); const int b = bh >> 3, h = bh & 7;
            const size_t row0 = (size_t)b * L + (size_t)qb * 256;
            att::attn_unit(Qb + row0 * NQ + h * DQ, KV + (size_t)b * L * NKV + h * 128, KPE + (size_t)b * L * ROPE, KV + (size_t)b * L * NKV + h * 128 + 64,
                           MIX + row0 * D + 512 + h * 64, gat + h * 64, ct, st, qb * 256, (LAS char*)(F.lds + RING_OFF), F.wave0);
        } }
        REPEAT(REP_MISC) { REFRESH(); phase_hy_out(F, l); }
        { REFRESH(); xcd_barrier_fast(bar, F.tid == 0); } TOC(6); TIC();
        { unsigned char* w = (unsigned char*)wsq(F); bf16* MIX = (bf16*)(w + WS_MIX); bf16* WoutT = (bf16*)(w + WS_WOUT); bf16* T = (bf16*)(w + WS_T);
          pg8::Gemm g{MIX, WoutT, M, D, D}; pg8::StaticOrder S; S.init(M, D, F.G, BXQ());
          pg8::EpiBf16<0> E{T, D, nullptr, 0, 0, 1.f}; GEMM_PHASE(pg8::EpiBf16<0>, g, S, E); }
        { REFRESH(); xcd_barrier_fast(bar, F.tid == 0); } TOC(7); TIC();
        REFRESH(); phase_norm_res(F, l, (const GAS bf16*)(wsq(F) + WS_T), inp(F, I_NMIXPOST) + l * D, inp(F, I_NMLPPRE) + l * D);
        { REFRESH(); xcd_barrier_fast(bar, F.tid == 0); } TOC(8); TIC();
#pragma unroll 1
        for (int ch = 0; ch < N_MLP_CHUNKS; ++ch) {
            { unsigned char* w = (unsigned char*)wsq(F); bf16* XN = (bf16*)(w + WS_XN); bf16* WupT = (bf16*)(w + WS_WUP); bf16* Hb = (bf16*)(w + WS_H);
              pg8::Gemm g{XN + (size_t)ch * MLP_CHUNK * D, WupT, MLP_CHUNK, FF, D}; pg8::StaticOrder S; S.init(MLP_CHUNK, FF, F.G, BXQ());
              pg8::EpiRelu2 E{Hb, FF}; GEMM_PHASE(pg8::EpiRelu2, g, S, E); }
            { REFRESH(); xcd_barrier_fast(bar, F.tid == 0); } TOC(9); TIC();
            { unsigned char* w = (unsigned char*)wsq(F); bf16* Hb = (bf16*)(w + WS_H); bf16* WdownT = (bf16*)(w + WS_WDOWN); bf16* T = (bf16*)(w + WS_T);
              pg8::Gemm g{Hb, WdownT, MLP_CHUNK, D, FF}; pg8::StaticOrder S; S.init(MLP_CHUNK, D, F.G, BXQ());
              pg8::EpiBf16<0> E{T + (size_t)ch * MLP_CHUNK * D, D, nullptr, 0, 0, 1.f}; GEMM_PHASE(pg8::EpiBf16<0>, g, S, E); }
            { REFRESH(); xcd_barrier_fast(bar, F.tid == 0); } TOC(10); TIC();
        }
        REFRESH(); phase_norm_res(F, 1, (const GAS bf16*)(wsq(F) + WS_T), inp(F, I_NMLPPOST) + l * D, (l + 1 < DEPTH) ? inp(F, I_NMIXPRE) + (l + 1) * D : (const GAS float*)nullptr);
        { REFRESH(); xcd_barrier_fast(bar, F.tid == 0); } TOC(11); TIC();
    }
    if (PROBE_MASK) { const unsigned long long ts = __builtin_amdgcn_s_memrealtime(); while (__builtin_amdgcn_s_memrealtime() - ts < pr_acc) __builtin_amdgcn_s_sleep(8); }
}

extern "C" void kernel_launch(void* const* d_in, const int* in_sizes, int n_in, void* d_out, int out_size, void* d_ws, size_t ws_size, hipStream_t stream) {
    static int grid = 0;
    if (grid == 0) {
        if (n_in != 26 || out_size != M * D || ws_size < WS_END) { fprintf(stderr, "kernel_launch: shape mismatch n_in %d out %d ws %zu (need %zu)\n", n_in, out_size, ws_size, (size_t)WS_END); grid = -1; return; }
        int dev = 0, cus = 0, per_cu = 0;
        if (hipGetDevice(&dev) != hipSuccess || hipDeviceGetAttribute(&cus, hipDeviceAttributeMultiprocessorCount, dev) != hipSuccess) { grid = -1; return; }
        if (hipFuncSetAttribute((const void*)hyena_mla_fwd, hipFuncAttributeMaxDynamicSharedMemorySize, LDS_BYTES) != hipSuccess) { fprintf(stderr, "kernel_launch: hipFuncSetAttribute failed\n"); grid = -1; return; }
        if (hipOccupancyMaxActiveBlocksPerMultiprocessor(&per_cu, (const void*)hyena_mla_fwd, NTHR, LDS_BYTES) != hipSuccess || per_cu < 1) fprintf(stderr, "kernel_launch: occupancy query says %d\n", per_cu);
        (void)hipGetLastError();
        grid = cus;
    }
    if (grid < 0) return;
    if (hipMemsetAsync((char*)d_ws + WS_CTL, 0, CTL_ZERO_BYTES, stream) != hipSuccess) { fprintf(stderr, "kernel_launch: memset failed\n"); return; }
    Args a{};
    for (int i = 0; i < 26; ++i) a.in[i] = (const float*)d_in[i];
    a.out = (float*)d_out; a.ws = (unsigned char*)d_ws;
    hipLaunchKernelGGL(hyena_mla_fwd, dim3(grid), dim3(NTHR), LDS_BYTES, stream, a);
    const hipError_t le = hipPeekAtLastError();
    if (le != hipSuccess) fprintf(stderr, "kernel_launch: launch failed: %s\n", hipGetErrorName(le));
}
```

```cpp
#include <hip/hip_runtime.h>
#include <cstdio>
#include <cstdint>
__device__ __forceinline__ int hw_lane() { int l; asm volatile("v_mbcnt_lo_u32_b32 %0, -1, 0\n\tv_mbcnt_hi_u32_b32 %0, -1, %0" : "=v"(l)); return l; }
__device__ __forceinline__ int tid_from_wave(int wave0) { int w = wave0; asm volatile("" : "+s"(w)); int t = w * 64 + hw_lane(); asm volatile("" : "+v"(t)); return t; }
namespace pg8 {
#define PG8_LAS __attribute__((address_space(3)))
#define PG8_GAS __attribute__((address_space(1)))
typedef unsigned short bf16_t;
typedef short bf16x8 __attribute__((ext_vector_type(8)));
typedef float f32x4 __attribute__((ext_vector_type(4)));
typedef unsigned u32x4 __attribute__((ext_vector_type(4)));
constexpr int BM = 256, BK = 64, HALF = 128, HTB = HALF * BK * 2  , STAGE_BYTES = 8 * HTB, NXCD = 8, WGM = 8;

__host__ __device__ __forceinline__ int lds_byte(int r, int c) { const int st = (r >> 4) * 2 + (c >> 5), rr = r & 15, cc = c & 31, ob = rr * 64 + cc * 2; return st * 1024 + (ob ^ (((ob >> 9) & 1) << 5)); }
__host__ __device__ __forceinline__ void stage_rc(int b, int& R, int& C) { const int st = b / 1024, sb = b % 1024, swz = sb ^ (((sb >> 9) & 1) << 5); R = (st >> 1) * 16 + swz / 64; C = (st & 1) * 32 + (swz % 64) / 2; }
__host__ __device__ __forceinline__ int perm32(int rho) { const int n = rho >> 4, i = rho & 15; return 8 * (i >> 2) + 4 * n + (i & 3); }

struct Unit { int pm, pn; };
struct Gemm { const bf16_t* A; const bf16_t* Bt; int M, N, K; };

struct StaticOrder {
    int nM, nN, nwg, G, c;
    __host__ __device__ void init(int M, int N, int G_, int c_) { nM = M / BM; nN = N / BM; nwg = nM * nN; G = G_; c = c_; }
    __host__ __device__ bool next(int i, Unit& u) const {
        const long L = (long)i * G + c; if (L >= nwg) return false;
        int wgid = (int)L; { const int q = nwg / NXCD, r = nwg % NXCD, xcd = wgid % NXCD, off = wgid / NXCD; wgid = (xcd < r ? xcd * (q + 1) : r * (q + 1) + (xcd - r) * q) + off; }
        const int nig = WGM * nN, gid = wgid / nig, fm = gid * WGM, gsz = (nM - fm) < WGM ? (nM - fm) : WGM;
        u.pm = fm + ((wgid % nig) % gsz); u.pn = (wgid % nig) / gsz; return true;
    }
    __device__ __forceinline__ void a_ready(const Unit&) const {}
    __device__ __forceinline__ void done(const Unit&) const {}
};

__device__ __forceinline__ unsigned cvt_pk_bf16(float lo, float hi) { unsigned r; asm volatile("v_cvt_pk_bf16_f32 %0, %1, %2" : "=v"(r) : "v"(lo), "v"(hi)); return r; }
typedef float f32x2 __attribute__((ext_vector_type(2)));
__device__ __forceinline__ void relane(int& wr, int& wc, int& fr, int& fq) { int l = hw_lane(); asm volatile("" : "+v"(l)); fr = l & 15; fq = l >> 4; (void)wr; (void)wc; }
__device__ __forceinline__ f32x2 gelu_pk(f32x2 v) {
    const f32x2 av = __builtin_elementwise_abs(v), d = av * 0.2316418882f + 1.0f;
    f32x2 t; t.x = __builtin_amdgcn_rcpf(d.x); t.y = __builtin_amdgcn_rcpf(d.y);
    f32x2 q = t * 0.5307027145f + (-0.7265760135f); q = q * t + 0.7107068705f; q = q * t + (-0.142248368f); q = q * t + 0.127414796f; q = q * t;
    const f32x2 s = (v * v) * (-0.72134752044f);
    f32x2 e; e.x = __builtin_amdgcn_exp2f(s.x); e.y = __builtin_amdgcn_exp2f(s.y);
    const f32x2 m = v * (q * e), r = v - m;
    f32x2 o; o.x = v.x < 0.f ? m.x : r.x; o.y = v.y < 0.f ? m.y : r.y; return o;
}

template <int ACT  > struct EpiBf16 {
    static constexpr bool PERM = true, AFTER_DRAIN = false; static_assert(ACT == 0 || ACT == 1, "EpiBf16: ACT is 0 (none) or 1 (gelu_pk)");
    bf16_t* O; int ldc; const float* bias; int split_cols; size_t split_stride; float scale0;
    __device__ __forceinline__ void operator()(const f32x4 (&acc)[2][2][4][2], const Unit& u, int wr, int wc, int fr, int fq) const {
        relane(wr, wc, fr, fq);
        const int row0 = u.pm * BM + wr * 64 + fr; int colt = u.pn * BM; bf16_t* base = O;
        float sc = 1.f; if (split_cols) { const int t = colt / split_cols; base += (size_t)t * split_stride; colt -= t * split_cols; if (t == 0) sc = scale0; }
        const int col0 = colt + wc * 32 + 8 * fq, bcol0 = u.pn * BM + wc * 32 + 8 * fq;
        f32x4 bv[2][2];
#pragma unroll
        for (int bj = 0; bj < 2; ++bj)
#pragma unroll
            for (int n = 0; n < 2; ++n) bv[bj][n] = bias ? *(const PG8_GAS f32x4*)(bias + bcol0 + bj * HALF + 4 * n) : (f32x4){0.f, 0.f, 0.f, 0.f};
#pragma unroll
        for (int ai = 0; ai < 2; ++ai)
#pragma unroll
            for (int m = 0; m < 4; ++m) { bf16_t* rowp = base + (size_t)(row0 + ai * HALF + m * 16) * ldc + col0;
#pragma unroll
                for (int bj = 0; bj < 2; ++bj) { f32x4 v0 = acc[ai][bj][m][0] + bv[bj][0], v1 = acc[ai][bj][m][1] + bv[bj][1];
                    if (ACT == 1) { f32x2 a = gelu_pk((f32x2){v0[0], v0[1]}), b = gelu_pk((f32x2){v0[2], v0[3]}), c = gelu_pk((f32x2){v1[0], v1[1]}), d = gelu_pk((f32x2){v1[2], v1[3]});
                        v0 = (f32x4){a.x, a.y, b.x, b.y}; v1 = (f32x4){c.x, c.y, d.x, d.y}; }
                    v0 = v0 * sc; v1 = v1 * sc; u32x4 w; w.x = cvt_pk_bf16(v0[0], v0[1]); w.y = cvt_pk_bf16(v0[2], v0[3]); w.z = cvt_pk_bf16(v1[0], v1[1]); w.w = cvt_pk_bf16(v1[2], v1[3]);
                    *(PG8_GAS u32x4*)(rowp + bj * HALF) = w; } }
    }
};

struct PanelStats {
    unsigned* xbuf;
    unsigned* cnt;
    unsigned* tmo;
    int ntn; float eps;
    unsigned code;
    __device__ __forceinline__ bool run(const f32x4 (&v)[2][2][4][2], const Unit& u, int wr, int wc, int fr, int fq, PG8_LAS unsigned char* lds, int wid, int lane) const {
        typedef float f32x2v __attribute__((ext_vector_type(2)));
        PG8_LAS f32x2v* P = (PG8_LAS f32x2v*)lds;
        PG8_LAS f32x2v* S = (PG8_LAS f32x2v*)(lds + 8192);
        PG8_LAS unsigned* flag = (PG8_LAS unsigned*)(lds + 8192 + 2048);
#pragma unroll
        for (int ai = 0; ai < 2; ++ai)
#pragma unroll
            for (int m = 0; m < 4; ++m) {
                float s = 0.f;
#pragma unroll
                for (int bj = 0; bj < 2; ++bj)
#pragma unroll
                    for (int n = 0; n < 2; ++n) { const f32x4 x = v[ai][bj][m][n]; s += (x[0] + x[1]) + (x[2] + x[3]); }
                s += __shfl_xor(s, 16); s += __shfl_xor(s, 32);
                const float mw = s * (1.0f / 64.0f); float q = 0.f;
#pragma unroll
                for (int bj = 0; bj < 2; ++bj)
#pragma unroll
                    for (int n = 0; n < 2; ++n) { const f32x4 d = v[ai][bj][m][n] - mw; q += (d[0] * d[0] + d[1] * d[1]) + (d[2] * d[2] + d[3] * d[3]); }
                q += __shfl_xor(q, 16); q += __shfl_xor(q, 32);
                if (fq == 0) P[(ai * HALF + wr * 64 + m * 16 + fr) * 4 + wc] = (f32x2v){mw, q};
            }
        asm volatile("s_waitcnt lgkmcnt(0)" ::: "memory"); __builtin_amdgcn_s_barrier(); asm volatile("" ::: "memory");
#if defined(BROKEN_EXCHANGE_NO_WAIT)
#warning BROKEN CONTROL BUILD: the row-statistics exchange does not wait; results are wrong by design
        if (blockIdx.x >= 64) { const long long t0_ = clock64(); while (clock64() - t0_ < 60000) __builtin_amdgcn_s_sleep(8); }
#endif
        const int row = wid * 32 + (lane & 31);
        if (lane < 32) {
            const f32x2v a = P[row * 4 + 0], b = P[row * 4 + 1], c = P[row * 4 + 2], d = P[row * 4 + 3];
            const float mt = (a.x + b.x + c.x + d.x) * 0.25f;
            const float da = a.x - mt, db = b.x - mt, dc = c.x - mt, dd = d.x - mt;
            const float m2 = (a.y + b.y) + (c.y + d.y) + 64.0f * ((da * da + db * db) + (dc * dc + dd * dd));
            unsigned long long* slot = (unsigned long long*)xbuf + ((size_t)(u.pm * BM + row) * 4 + u.pn);
            __hip_atomic_store(slot, ((unsigned long long)__float_as_uint(m2) << 32) | __float_as_uint(mt), __ATOMIC_RELAXED, __HIP_MEMORY_SCOPE_AGENT);
        }
        asm volatile("s_waitcnt vmcnt(0)" ::: "memory");
        if (lane == 0) __hip_atomic_fetch_add(cnt + 64 * u.pm, 1u, __ATOMIC_RELAXED, __HIP_MEMORY_SCOPE_AGENT);
        if (wid == 0) {
            bool dead = false; const unsigned long long t0 = __builtin_amdgcn_s_memrealtime(); const unsigned want = 8u * (unsigned)ntn;
            for (;;) {
#if defined(BROKEN_EXCHANGE_NO_WAIT)
                break;
#endif
                if ((unsigned)__builtin_amdgcn_readfirstlane(__hip_atomic_load(cnt + 64 * u.pm, __ATOMIC_RELAXED, __HIP_MEMORY_SCOPE_AGENT)) >= want) break;
                if (__builtin_amdgcn_s_memrealtime() - t0 > 2000000ull) {
                    if (lane == 0) { unsigned expect = 0u; __hip_atomic_compare_exchange_strong(tmo + 1, &expect, code | (unsigned)(u.pm & 0xff), __ATOMIC_RELAXED, __ATOMIC_RELAXED, __HIP_MEMORY_SCOPE_AGENT);
                                     __hip_atomic_store(tmo, 1u, __ATOMIC_RELAXED, __HIP_MEMORY_SCOPE_AGENT); }
                    dead = true; break; }
                __builtin_amdgcn_s_sleep(2);
            }
            __builtin_amdgcn_fence(__ATOMIC_ACQUIRE, "agent");
            if (lane == 0) flag[0] = dead ? 1u : 0u;
        }
        asm volatile("s_waitcnt vmcnt(0) lgkmcnt(0)" ::: "memory"); __builtin_amdgcn_s_barrier(); asm volatile("" ::: "memory");
        const bool bad = flag[0] != 0u;
        if (lane < 32) {
            const unsigned long long* slot = (const unsigned long long*)xbuf + (size_t)(u.pm * BM + row) * 4; float mt[4], m2[4]; float ms = 0.f;
#pragma unroll
            for (int t = 0; t < 4; ++t) { if (t < ntn) { const unsigned long long w = __hip_atomic_load(slot + t, __ATOMIC_RELAXED, __HIP_MEMORY_SCOPE_AGENT); mt[t] = __uint_as_float((unsigned)w); m2[t] = __uint_as_float((unsigned)(w >> 32)); } else { mt[t] = 0.f; m2[t] = 0.f; } ms += mt[t]; }
            const float mean = ms / (float)ntn; float q = 0.f;
#pragma unroll
            for (int t = 0; t < 4; ++t) if (t < ntn) { const float dm = mt[t] - mean; q += m2[t] + 256.0f * dm * dm; }
            S[row] = (f32x2v){mean, 1.0f / sqrtf(q / (256.0f * (float)ntn) + eps)};
        }
        asm volatile("s_waitcnt lgkmcnt(0)" ::: "memory"); __builtin_amdgcn_s_barrier(); asm volatile("" ::: "memory");
        return bad;
    }
};
struct EpiLnRes {
    static constexpr bool PERM = false, AFTER_DRAIN = true;
    const float* base; float* out; int ldc; const float* bias; PanelStats st; unsigned poison;
    __device__ __forceinline__ void fused(f32x4 (&acc)[2][2][4][2], const Unit& u, int wr, int wc, int fr, int fq, PG8_LAS unsigned char* lds, int wid, int lane) const {
        typedef float f32x2v __attribute__((ext_vector_type(2)));
        const PG8_LAS f32x2v* S = (const PG8_LAS f32x2v*)(lds + 8192);
        const int col0 = u.pn * BM + wc * 32 + 4 * fq;
#pragma unroll
        for (int bj = 0; bj < 2; ++bj)
#pragma unroll
            for (int n = 0; n < 2; ++n) { const f32x4 bv = bias ? *(const f32x4*)(bias + col0 + bj * HALF + n * 16) : (f32x4){0.f, 0.f, 0.f, 0.f};
#pragma unroll
                for (int ai = 0; ai < 2; ++ai)
#pragma unroll
                    for (int m = 0; m < 4; ++m) acc[ai][bj][m][n] += bv; }
        f32x4 pre[4][2][2];
#pragma unroll
        for (int m = 0; m < 4; ++m) { const size_t off = (size_t)(u.pm * BM + wr * 64 + m * 16 + fr) * ldc + col0;
#pragma unroll
            for (int bj = 0; bj < 2; ++bj)
#pragma unroll
                for (int n = 0; n < 2; ++n) pre[m][bj][n] = *(const f32x4*)(base + off + bj * HALF + n * 16); }
        const bool bad = st.run(acc, u, wr, wc, fr, fq, lds, wid, lane) || poison != 0u;
        const float qnan = __builtin_nanf("");
#pragma unroll
        for (int ai = 0; ai < 2; ++ai)
#pragma unroll
            for (int m = 0; m < 4; ++m) { const int r = ai * HALF + wr * 64 + m * 16 + fr; const f32x2v sr = S[r]; const size_t off = (size_t)(u.pm * BM + r) * ldc + col0;
#pragma unroll
                for (int bj = 0; bj < 2; ++bj)
#pragma unroll
                    for (int n = 0; n < 2; ++n) { const f32x4 bs = ai == 0 ? pre[m][bj][n] : *(const f32x4*)(base + off + bj * HALF + n * 16); f32x4 o = bs + (acc[ai][bj][m][n] - sr.x) * sr.y;
                        if (bad) o = (f32x4){qnan, qnan, qnan, qnan}; *(f32x4*)(out + off + bj * HALF + n * 16) = o; }
                if (m & 1) asm volatile("" ::: "memory"); }
    }
};
struct EpiLnResLn {
    static constexpr bool PERM = false, AFTER_DRAIN = true;
    const float* base; float* out; bf16_t* xn; int ldc; const float* bias; PanelStats st1, st2; unsigned poison;
    __device__ __forceinline__ void fused(f32x4 (&acc)[2][2][4][2], const Unit& u, int wr, int wc, int fr, int fq, PG8_LAS unsigned char* lds, int wid, int lane) const {
        typedef float f32x2v __attribute__((ext_vector_type(2))); typedef unsigned u32x2v __attribute__((ext_vector_type(2)));
        const PG8_LAS f32x2v* S = (const PG8_LAS f32x2v*)(lds + 8192);
        const int col0 = u.pn * BM + wc * 32 + 4 * fq;
#pragma unroll
        for (int bj = 0; bj < 2; ++bj)
#pragma unroll
            for (int n = 0; n < 2; ++n) { const f32x4 bv = bias ? *(const f32x4*)(bias + col0 + bj * HALF + n * 16) : (f32x4){0.f, 0.f, 0.f, 0.f};
#pragma unroll
                for (int ai = 0; ai < 2; ++ai)
#pragma unroll
                    for (int m = 0; m < 4; ++m) acc[ai][bj][m][n] += bv; }
        bool bad = st1.run(acc, u, wr, wc, fr, fq, lds, wid, lane) || poison != 0u;
        const float qnan = __builtin_nanf("");
#pragma unroll
        for (int ai = 0; ai < 2; ++ai)
#pragma unroll
            for (int m = 0; m < 4; ++m) { const int r = ai * HALF + wr * 64 + m * 16 + fr; const f32x2v sr = S[r]; const size_t off = (size_t)(u.pm * BM + r) * ldc + col0;
#pragma unroll
                for (int bj = 0; bj < 2; ++bj)
#pragma unroll
                    for (int n = 0; n < 2; ++n) { const f32x4 bs = *(const f32x4*)(base + off + bj * HALF + n * 16); acc[ai][bj][m][n] = bs + (acc[ai][bj][m][n] - sr.x) * sr.y; }
                asm volatile("" : "+v"(acc[ai][0][m][0]), "+v"(acc[ai][0][m][1]), "+v"(acc[ai][1][m][0]), "+v"(acc[ai][1][m][1]));
                if (m & 1) asm volatile("" ::: "memory"); }
        const bool bad1 = bad;
        bad = st2.run(acc, u, wr, wc, fr, fq, lds, wid, lane) || bad;
#pragma unroll
        for (int ai = 0; ai < 2; ++ai)
#pragma unroll
            for (int m = 0; m < 4; ++m) { const int r = ai * HALF + wr * 64 + m * 16 + fr; const f32x2v sr = S[r]; const size_t off = (size_t)(u.pm * BM + r) * ldc + col0;
#pragma unroll
                for (int bj = 0; bj < 2; ++bj)
#pragma unroll
                    for (int n = 0; n < 2; ++n) { const f32x4 x1 = acc[ai][bj][m][n]; *(f32x4*)(out + off + bj * HALF + n * 16) = bad1 ? (f32x4){qnan, qnan, qnan, qnan} : x1;
                        const f32x4 o = (x1 - sr.x) * sr.y; u32x2v w; w.x = cvt_pk_bf16(o[0], o[1]); w.y = cvt_pk_bf16(o[2], o[3]);
                        if (bad) { w.x = 0x7fc07fc0u; w.y = 0x7fc07fc0u; } *(u32x2v*)(xn + off + bj * HALF + n * 16) = w; }
                asm volatile("" ::: "memory"); }
    }
};

template <class Epi, class Sched, bool ALIGN_EPI = false, bool SP2 = false>
__device__ __forceinline__ void gemm_phase(PG8_LAS unsigned char* lds, const Gemm g, const Sched& S, const Epi& E, const int wave0) {
    int tid_ = tid_from_wave(wave0);
    const int tid = tid_, wid = __builtin_amdgcn_readfirstlane(tid >> 6), lane = tid & 63, wr = wid >> 2, wc = wid & 3, fr = lane & 15, fq = lane >> 4;
    const int K = g.K, nt = K / BK;
    unsigned voffA[2], voffB[2];
#pragma unroll
    for (int i = 0; i < 2; ++i) { int R, C; stage_rc(tid * 16 + i * 8192, R, C); const int Rb = Epi::PERM ? ((R & ~31) + perm32(R & 31)) : R;
        voffA[i] = (unsigned)(R * K + C) * 2u; voffB[i] = (unsigned)(Rb * K + C) * 2u; }
    const size_t kstep = (size_t)(BK * 2);
    const size_t hstep = (size_t)HALF * K * 2;
    const size_t tstep = 2 * hstep;
    const unsigned ldsw = (unsigned)wid * 1024u;
    const int aoff = lds_byte(wr * 64 + fr, fq * 8), boff = lds_byte(wc * 32 + fr, fq * 8);
#define PG8_SA(b, h) (((b) * 2 + (h)) * HTB)
#define PG8_SB(b, h) ((4 + (b) * 2 + (h)) * HTB)
#define PG8_STAGE(bufoff, gbase, voff) do { _Pragma("unroll") for (int _i = 0; _i < 2; ++_i) \
        __builtin_amdgcn_global_load_lds((const unsigned*)((const char*)(gbase) + (voff)[_i]), (PG8_LAS unsigned*)(lds + (bufoff) + ldsw + _i * 8192), 16, 0, 0); } while (0)
#define PG8_LDA(dst, b, h) do { _Pragma("unroll") for (int m = 0; m < 4; ++m) _Pragma("unroll") for (int k = 0; k < 2; ++k) dst[m][k] = *(const PG8_LAS bf16x8*)(lds + PG8_SA(b, h) + aoff + m * 2048 + k * 1024); } while (0)
#define PG8_LDB(dst, b, h) do { _Pragma("unroll") for (int n = 0; n < 2; ++n) _Pragma("unroll") for (int k = 0; k < 2; ++k) dst[n][k] = *(const PG8_LAS bf16x8*)(lds + PG8_SB(b, h) + boff + n * 2048 + k * 1024); } while (0)
#define PG8_MMA(ai, bj, At, Bt) do { __builtin_amdgcn_s_setprio(1); _Pragma("unroll") for (int m = 0; m < 4; ++m) _Pragma("unroll") for (int n = 0; n < 2; ++n) _Pragma("unroll") for (int k = 0; k < 2; ++k) \
        acc[ai][bj][m][n] = __builtin_amdgcn_mfma_f32_16x16x32_bf16(Bt[n][k], At[m][k], acc[ai][bj][m][n], 0, 0, 0); __builtin_amdgcn_s_setprio(0); } while (0)
#define PG8_WAIT_V(n) asm volatile("s_waitcnt vmcnt(" #n ")" ::: "memory")
#define PG8_WAIT_L(n) asm volatile("s_waitcnt lgkmcnt(" #n ")" ::: "memory")
#define PG8_BAR __builtin_amdgcn_s_barrier()
#define PG8_SCHED __builtin_amdgcn_sched_barrier(0)
    Unit cur, nxt; int ui = 0;
    if (!S.next(0, cur)) return;
    f32x4 acc[2][2][4][2];
#pragma unroll
    for (int a = 0; a < 2; ++a)
#pragma unroll
        for (int b = 0; b < 2; ++b)
#pragma unroll
            for (int m = 0; m < 4; ++m)
#pragma unroll
                for (int n = 0; n < 2; ++n) acc[a][b][m][n] = (f32x4){0.f, 0.f, 0.f, 0.f};
    bf16x8 At[4][2], B0[2][2], B1[2][2];
    const char* cA = (const char*)g.A + (size_t)cur.pm * tstep; const char* cB = (const char*)g.Bt + (size_t)cur.pn * tstep;
    S.a_ready(cur);
    if constexpr (SP2) {
        PG8_STAGE(PG8_SB(0, 0), cB, voffB); PG8_STAGE(PG8_SB(0, 1), cB + hstep, voffB); PG8_STAGE(PG8_SA(0, 0), cA, voffA); PG8_STAGE(PG8_SA(0, 1), cA + hstep, voffA);
        if (wr == 1) PG8_BAR;
        PG8_WAIT_V(2); PG8_BAR;
        PG8_STAGE(PG8_SB(1, 0), cB + kstep, voffB); PG8_STAGE(PG8_SA(1, 0), cA + kstep, voffA); PG8_STAGE(PG8_SB(1, 1), cB + hstep + kstep, voffB);
        PG8_WAIT_V(6); PG8_BAR;
    } else {
        PG8_STAGE(PG8_SB(0, 0), cB, voffB); PG8_STAGE(PG8_SA(0, 0), cA, voffA); PG8_STAGE(PG8_SB(0, 1), cB + hstep, voffB); PG8_STAGE(PG8_SA(0, 1), cA + hstep, voffA);
        if (wr == 1) PG8_BAR;
        PG8_WAIT_V(4); PG8_BAR;
        PG8_STAGE(PG8_SB(1, 0), cB + kstep, voffB); PG8_STAGE(PG8_SA(1, 0), cA + kstep, voffA); PG8_STAGE(PG8_SB(1, 1), cB + hstep + kstep, voffB);
        PG8_WAIT_V(6); PG8_BAR;
    }
    for (;;) {
        const bool has_next = S.next(ui + 1, nxt);
        const char* nA = has_next ? (const char*)g.A + (size_t)nxt.pm * tstep : cA; const char* nB = has_next ? (const char*)g.Bt + (size_t)nxt.pn * tstep : cB;
        for (int t = 0; t < nt; t += 2) {
            const bool last = (t == nt - 2);
            const char* a1 = cA + (size_t)(t + 1) * kstep;
            const char* a2 = last ? nA : cA + (size_t)(t + 2) * kstep; const char* b2 = last ? nB : cB + (size_t)(t + 2) * kstep;
            const char* a3 = a2 + kstep; const char* b3 = b2 + kstep;
            if (last && has_next) S.a_ready(nxt);
            if constexpr (SP2) {
            PG8_LDB(B0, 0, 0); PG8_LDB(B1, 0, 1); PG8_SCHED; PG8_LDA(At, 0, 0); PG8_STAGE(PG8_SA(1, 1), a1 + hstep, voffA);
            PG8_WAIT_V(8); PG8_WAIT_L(0); PG8_BAR; PG8_MMA(0, 0, At, B0); PG8_MMA(0, 1, At, B1); PG8_BAR; PG8_SCHED;
            PG8_LDA(At, 0, 1); PG8_STAGE(PG8_SB(0, 0), b2, voffB); PG8_STAGE(PG8_SB(0, 1), b2 + hstep, voffB); PG8_STAGE(PG8_SA(0, 0), a2, voffA);
            PG8_WAIT_V(8); PG8_WAIT_L(0); PG8_BAR; PG8_MMA(1, 0, At, B0); PG8_MMA(1, 1, At, B1); PG8_BAR; PG8_SCHED;
            PG8_LDB(B0, 1, 0); PG8_LDB(B1, 1, 1); PG8_SCHED; PG8_LDA(At, 1, 0); PG8_STAGE(PG8_SA(0, 1), a2 + hstep, voffA);
            PG8_WAIT_V(8); PG8_WAIT_L(0); PG8_BAR; PG8_MMA(0, 0, At, B0); PG8_MMA(0, 1, At, B1); PG8_BAR; PG8_SCHED;
            PG8_LDA(At, 1, 1); PG8_STAGE(PG8_SB(1, 0), b3, voffB); PG8_STAGE(PG8_SB(1, 1), b3 + hstep, voffB); PG8_STAGE(PG8_SA(1, 0), a3, voffA);
            PG8_WAIT_V(8); PG8_WAIT_L(0); PG8_BAR; PG8_MMA(1, 0, At, B0); PG8_MMA(1, 1, At, B1); PG8_BAR; PG8_SCHED;
            } else {
            PG8_LDB(B0, 0, 0); PG8_SCHED; PG8_LDA(At, 0, 0); PG8_STAGE(PG8_SA(1, 1), a1 + hstep, voffA);
            PG8_WAIT_L(8); PG8_BAR; PG8_WAIT_L(0); PG8_MMA(0, 0, At, B0); PG8_BAR; PG8_SCHED;
            PG8_LDB(B1, 0, 1); PG8_STAGE(PG8_SB(0, 0), b2, voffB);
            PG8_BAR; PG8_WAIT_L(0); PG8_MMA(0, 1, At, B1); PG8_BAR;
            PG8_LDA(At, 0, 1); PG8_STAGE(PG8_SA(0, 0), a2, voffA);
            PG8_BAR; PG8_WAIT_L(0); PG8_MMA(1, 0, At, B0); PG8_BAR; PG8_SCHED;
            PG8_STAGE(PG8_SB(0, 1), b2 + hstep, voffB);
            PG8_WAIT_V(6); PG8_BAR; PG8_MMA(1, 1, At, B1); PG8_BAR;
            PG8_LDB(B0, 1, 0); PG8_SCHED; PG8_LDA(At, 1, 0); PG8_STAGE(PG8_SA(0, 1), a2 + hstep, voffA);
            PG8_WAIT_L(8); PG8_BAR; PG8_WAIT_L(0); PG8_MMA(0, 0, At, B0); PG8_BAR; PG8_SCHED;
            PG8_LDB(B1, 1, 1); PG8_STAGE(PG8_SB(1, 0), b3, voffB);
            PG8_BAR; PG8_WAIT_L(0); PG8_MMA(0, 1, At, B1); PG8_BAR;
            PG8_LDA(At, 1, 1); PG8_STAGE(PG8_SA(1, 0), a3, voffA);
            PG8_BAR; PG8_WAIT_L(0); PG8_MMA(1, 0, At, B0); PG8_BAR; PG8_SCHED;
            PG8_STAGE(PG8_SB(1, 1), b3 + hstep, voffB);
            PG8_WAIT_V(6); PG8_BAR; PG8_MMA(1, 1, At, B1); PG8_BAR;
            }
        }
        if constexpr (ALIGN_EPI) { if (wr == 0) PG8_BAR; }
        if constexpr (!Epi::AFTER_DRAIN) { E(acc, cur, wr, wc, fr, fq); S.done(cur); }
        if (!has_next) break;
#pragma unroll
        for (int a = 0; a < 2; ++a)
#pragma unroll
            for (int b = 0; b < 2; ++b)
#pragma unroll
                for (int m = 0; m < 4; ++m)
#pragma unroll
                    for (int n = 0; n < 2; ++n) acc[a][b][m][n] = (f32x4){0.f, 0.f, 0.f, 0.f};
        cur = nxt; cA = nA; cB = nB; ++ui;
        if constexpr (ALIGN_EPI) { if (wr == 1) PG8_BAR; }
    }
    PG8_WAIT_V(0);
    if constexpr (!ALIGN_EPI) { if (wr == 0) PG8_BAR; }
    PG8_BAR;
    if constexpr (Epi::AFTER_DRAIN) { E.fused(acc, cur, wr, wc, fr, fq, lds, wid, lane); S.done(cur); }
#undef PG8_SA
#undef PG8_SB
#undef PG8_STAGE
#undef PG8_LDA
#undef PG8_LDB
#undef PG8_MMA
#undef PG8_WAIT_V
#undef PG8_WAIT_L
#undef PG8_BAR
#undef PG8_SCHED
}
}

namespace pg8 {
struct EpiRelu2 {
    static constexpr bool PERM = true, AFTER_DRAIN = false;
    bf16_t* O; int ldc;
    __device__ __forceinline__ void operator()(const f32x4 (&acc)[2][2][4][2], const Unit& u, int wr, int wc, int fr, int fq) const {
        relane(wr, wc, fr, fq);
        const int row0 = u.pm * BM + wr * 64 + fr, col0 = u.pn * BM + wc * 32 + 8 * fq;
#pragma unroll
        for (int ai = 0; ai < 2; ++ai)
#pragma unroll
            for (int m = 0; m < 4; ++m) { bf16_t* rowp = O + (size_t)(row0 + ai * HALF + m * 16) * ldc + col0;
#pragma unroll
                for (int bj = 0; bj < 2; ++bj) { f32x4 v0 = acc[ai][bj][m][0], v1 = acc[ai][bj][m][1];
                    v0 = __builtin_elementwise_max(v0, (f32x4){0.f, 0.f, 0.f, 0.f}); v1 = __builtin_elementwise_max(v1, (f32x4){0.f, 0.f, 0.f, 0.f}); v0 = v0 * v0; v1 = v1 * v1;
                    u32x4 w; w.x = cvt_pk_bf16(v0[0], v0[1]); w.y = cvt_pk_bf16(v0[2], v0[3]); w.z = cvt_pk_bf16(v1[0], v1[1]); w.w = cvt_pk_bf16(v1[2], v1[3]);
                    *(PG8_GAS u32x4*)(rowp + bj * HALF) = w; } }
    }
};
struct EpiF32 {
    static constexpr bool PERM = false, AFTER_DRAIN = false;
    float* O; int ldc;
    __device__ __forceinline__ void operator()(const f32x4 (&acc)[2][2][4][2], const Unit& u, int wr, int wc, int fr, int fq) const {
        relane(wr, wc, fr, fq);
        const int row0 = u.pm * BM + wr * 64 + fr, col0 = u.pn * BM + wc * 32 + 4 * fq;
#pragma unroll
        for (int ai = 0; ai < 2; ++ai)
#pragma unroll
            for (int m = 0; m < 4; ++m) { float* rowp = O + (size_t)(row0 + ai * HALF + m * 16) * ldc + col0;
#pragma unroll
                for (int bj = 0; bj < 2; ++bj)
#pragma unroll
                    for (int n = 0; n < 2; ++n) *(PG8_GAS f32x4*)(rowp + bj * HALF + n * 16) = acc[ai][bj][m][n]; }
    }
};
struct EpiTaps {
    static constexpr bool PERM = false, AFTER_DRAIN = false;
    float* O; const float* decay;
    __device__ __forceinline__ void operator()(const f32x4 (&acc)[2][2][4][2], const Unit& u, int wr, int wc, int fr, int fq) const {
        relane(wr, wc, fr, fq);
        const int row0 = u.pm * BM + wr * 64 + fr, col0 = u.pn * BM + wc * 32 + 4 * fq;
#pragma unroll
        for (int ai = 0; ai < 2; ++ai)
#pragma unroll
            for (int m = 0; m < 4; ++m) { const int row = row0 + ai * HALF + m * 16; float* rowp = O + (size_t)row * 16384 + col0; const float nd = -fabsf(((const PG8_GAS float*)decay)[row]) * (1.0f / 16383.0f) * 1.4426950408889634f;
#pragma unroll
                for (int bj = 0; bj < 2; ++bj)
#pragma unroll
                    for (int n = 0; n < 2; ++n) { const int c = col0 + bj * HALF + n * 16; const f32x4 a = acc[ai][bj][m][n]; f32x4 o;
                        o[0] = a[0] * __builtin_amdgcn_exp2f(nd * (float)(c + 0)); o[1] = a[1] * __builtin_amdgcn_exp2f(nd * (float)(c + 1));
                        o[2] = a[2] * __builtin_amdgcn_exp2f(nd * (float)(c + 2)); o[3] = a[3] * __builtin_amdgcn_exp2f(nd * (float)(c + 3));
                        *(PG8_GAS f32x4*)(rowp + bj * HALF + n * 16) = o; } }
    }
};
}

constexpr int L = 16384, NSEQ = 3, M = NSEQ * L, D = 1024, DEPTH = 4;
constexpr int HYW = 512, HYP = 1536, QR = 256, KVR = 128, ROPE = 32, INW = 1952;
constexpr int NH = 8, DQ = 96, DV = 64, NQ = NH * DQ, NKV = NH * 128;
constexpr int FF = 4096;
constexpr float EPS = 1e-6f;
constexpr int NWAVES = 8, NTHR = 512;
constexpr int MLP_CHUNK = 16384, N_MLP_CHUNKS = M / MLP_CHUNK;

constexpr size_t MiB = 1u << 20;
constexpr size_t WS_CTL = 0, CTL_ZERO_BYTES = 65536;
constexpr size_t WS_COS = 1 * MiB, WS_SIN = 2 * MiB;
constexpr size_t WS_H2 = 4 * MiB;
constexpr size_t WS_W3T = 8 * MiB;
constexpr size_t WS_WIN = 12 * MiB, WS_WOUT = 16 * MiB, WS_WUP = 18 * MiB, WS_WDOWN = 26 * MiB, WS_WUQ = 34 * MiB, WS_WUKV = 34 * MiB + 512 * 1024;
constexpr size_t WS_XN = 36 * MiB;
constexpr size_t WS_CQN = 36 * MiB, WS_CKVN = 60 * MiB, WS_KPE = 72 * MiB;
constexpr size_t WS_KEO = 132 * MiB;
constexpr size_t WS_KT = 261 * MiB;
constexpr size_t WS_UT = 261 * MiB;
constexpr size_t WS_CQKV = 405 * MiB;
constexpr size_t WS_YT = 453 * MiB;
constexpr size_t WS_Q = 132 * MiB, WS_KN = 204 * MiB;
constexpr size_t WS_MIX = 324 * MiB;
constexpr size_t WS_T = 132 * MiB;
constexpr size_t WS_H = 324 * MiB;
constexpr size_t WS_G0 = 75 * MiB, WS_G1A = 107 * MiB, WS_G1B = 501 * MiB;
constexpr size_t WS_END = 508 * MiB;
constexpr int KEO_BLK = 16512, KEO_KO = 8256;
static_assert(WS_KEO + (size_t)1024 * KEO_BLK * 8 <= WS_KT, "KEO fits");
static_assert(WS_UT + (size_t)HYP * M * 2 <= WS_CQKV && WS_CQKV + (size_t)M * 512 * 2 <= WS_YT && WS_YT + (size_t)HYW * M * 2 <= WS_END, "map");
static_assert(WS_KN + (size_t)M * NKV * 2 <= WS_MIX && WS_T + (size_t)M * D * 4 <= WS_MIX && WS_H + (size_t)MLP_CHUNK * FF * 2 <= WS_END, "map2");

constexpr int RING_OFF = 0, RING_BYTES = 139264;
constexpr int LDSCTL_OFF = RING_BYTES, MISC_OFF = LDSCTL_OFF + 320;
constexpr int LDS_BYTES = 147456;
static_assert(MISC_OFF + 128 <= LDS_BYTES, "LDS map");

#define GAS __attribute__((address_space(1)))
#define LAS __attribute__((address_space(3)))
typedef unsigned short bf16;
typedef unsigned v4u __attribute__((ext_vector_type(4)));
typedef unsigned v2u __attribute__((ext_vector_type(2)));
typedef float f32x4 __attribute__((ext_vector_type(4)));
typedef float f32x2 __attribute__((ext_vector_type(2)));
typedef short bf16x8 __attribute__((ext_vector_type(8)));
typedef GAS unsigned gu32;
#define RLX_AGENT __ATOMIC_RELAXED, __HIP_MEMORY_SCOPE_AGENT
#define LDS_WAIT() asm volatile("s_waitcnt lgkmcnt(0)" ::: "memory")
#define VM_WAIT() asm volatile("s_waitcnt vmcnt(0)" ::: "memory")
typedef __bf16 bf16x2_t __attribute__((ext_vector_type(2)));
__device__ __forceinline__ unsigned pk2(float lo, float hi) { f32x2 v = {lo, hi}; bf16x2_t b = __builtin_convertvector(v, bf16x2_t); return __builtin_bit_cast(unsigned, b); }
__device__ __forceinline__ bf16 f2bf(float f) { return (bf16)(pk2(f, 0.f) & 0xffffu); }
__device__ __forceinline__ float bf2f(unsigned h) { return __uint_as_float(h << 16); }
__device__ __forceinline__ float shx(float v, int lane, int o) { return __uint_as_float((unsigned)__builtin_amdgcn_ds_bpermute((lane ^ o) << 2, (int)__float_as_uint(v))); }
__device__ __forceinline__ float wave_sum(float v) {
    const int ln_ = hw_lane();
#pragma unroll
    for (int o = 1; o < 64; o <<= 1) v += shx(v, ln_, o);
    return v;
}

namespace hfft {
constexpr float w32c(int i) { constexpr float t[16] = {1.000000000e+00f, 9.807852507e-01f, 9.238795042e-01f, 8.314695954e-01f, 7.071067691e-01f, 5.555702448e-01f, 3.826834261e-01f, 1.950903237e-01f, 0.f, -1.950903237e-01f, -3.826834261e-01f, -5.555702448e-01f, -7.071067691e-01f, -8.314695954e-01f, -9.238795042e-01f, -9.807852507e-01f}; return t[i]; }
constexpr float w32s(int i) { constexpr float t[16] = {0.000000000e+00f, 1.950903237e-01f, 3.826834261e-01f, 5.555702448e-01f, 7.071067691e-01f, 8.314695954e-01f, 9.238795042e-01f, 9.807852507e-01f, 1.000000000e+00f, 9.807852507e-01f, 9.238795042e-01f, 8.314695954e-01f, 7.071067691e-01f, 5.555702448e-01f, 3.826834261e-01f, 1.950903237e-01f}; return t[i]; }
constexpr int brev(int x, int bits) { int r = 0; for (int i = 0; i < bits; ++i) r |= ((x >> i) & 1) << (bits - 1 - i); return r; }
constexpr int ilog2(int x) { int r = 0; while ((1 << r) < x) ++r; return r; }
__device__ __forceinline__ int pad(int i) { return i + (i >> 5); }

__device__ __forceinline__ void bfly(float ar, float ai, float br, float bi, float& ur, float& ui, float& dr, float& di) {
    asm("v_add_f32_e32 %0, %4, %6\n\tv_add_f32_e32 %1, %5, %7\n\tv_sub_f32_e32 %2, %4, %6\n\tv_sub_f32_e32 %3, %5, %7"
        : "=&v"(ur), "=&v"(ui), "=&v"(dr), "=&v"(di) : "v"(ar), "v"(ai), "v"(br), "v"(bi));
}
template <bool INV> __device__ __forceinline__ void bfly_rot(float ar, float ai, float br, float bi, float& ur, float& ui, float& dr, float& di) {
    if (!INV) asm("v_add_f32_e32 %0, %4, %6\n\tv_add_f32_e32 %1, %5, %7\n\tv_sub_f32_e32 %2, %5, %7\n\tv_sub_f32_e32 %3, %6, %4" : "=&v"(ur), "=&v"(ui), "=&v"(dr), "=&v"(di) : "v"(ar), "v"(ai), "v"(br), "v"(bi));
    else      asm("v_add_f32_e32 %0, %4, %6\n\tv_add_f32_e32 %1, %5, %7\n\tv_sub_f32_e32 %2, %7, %5\n\tv_sub_f32_e32 %3, %4, %6" : "=&v"(ur), "=&v"(ui), "=&v"(dr), "=&v"(di) : "v"(ar), "v"(ai), "v"(br), "v"(bi));
}
__device__ __forceinline__ void bfly_tw(float ar, float ai, float br, float bi, float c, float s, float& ur, float& ui, float& dr, float& di) {
    float tr, ti;
    asm("v_sub_f32_e32 %4, %6, %8\n\tv_sub_f32_e32 %5, %7, %9\n\tv_add_f32_e32 %0, %6, %8\n\tv_add_f32_e32 %1, %7, %9\n\t"
        "v_mul_f32_e32 %2, %10, %4\n\tv_mul_f32_e32 %3, %11, %4\n\tv_fma_f32 %2, -%11, %5, %2\n\tv_fma_f32 %3, %10, %5, %3"
        : "=&v"(ur), "=&v"(ui), "=&v"(dr), "=&v"(di), "=&v"(tr), "=&v"(ti) : "v"(ar), "v"(ai), "v"(br), "v"(bi), "s"(c), "s"(s));
}
__device__ __forceinline__ void cmul_chain(float& xr, float& xi, float& wc, float& ws, float c1, float s1) {
    float a, b, nc, ns;
    asm("v_mul_f32_e32 %0, %4, %6\n\tv_mul_f32_e32 %1, %4, %7\n\tv_fma_f32 %0, -%5, %7, %0\n\tv_fma_f32 %1, %5, %6, %1\n\t"
        "v_mul_f32_e32 %2, %6, %8\n\tv_mul_f32_e32 %3, %6, %9\n\tv_fma_f32 %2, -%7, %9, %2\n\tv_fma_f32 %3, %7, %8, %3"
        : "=&v"(a), "=&v"(b), "=&v"(nc), "=&v"(ns) : "v"(xr), "v"(xi), "v"(wc), "v"(ws), "v"(c1), "v"(s1));
    xr = a; xi = b; wc = nc; ws = ns;
}
template <int R, bool INV> __device__ __forceinline__ void fft_r2(float (&re)[R], float (&im)[R], const unsigned z0) {
    constexpr int LG = ilog2(R);
#pragma unroll
    for (int st = 0; st < LG; ++st) {
        const int s = (R / 2) >> st;
#pragma unroll
        for (int blk = 0; blk < R; blk += 2 * s) {
#pragma unroll
            for (int a = 0; a < s; ++a) {
                const int i0 = blk + a, i1 = i0 + s;
                const int w = a * (16 / s);
                float ur, ui, dr, di;
                if (w == 0) { bfly(re[i0], im[i0], re[i1], im[i1], ur, ui, dr, di); re[i1] = dr; im[i1] = di; }
                else if (w == 8) { bfly_rot<INV>(re[i0], im[i0], re[i1], im[i1], ur, ui, dr, di); re[i1] = dr; im[i1] = di; }
                else { const float c = __uint_as_float(__float_as_uint(w32c(w)) | z0), sn = __uint_as_float(__float_as_uint(INV ? w32s(w) : -w32s(w)) | z0);
                    bfly_tw(re[i0], im[i0], re[i1], im[i1], c, sn, ur, ui, dr, di); re[i1] = dr; im[i1] = di; }
                re[i0] = ur; im[i0] = ui;
            }
        }
    }
}

__device__ __forceinline__ int opaque(int x) { asm volatile("" : "+v"(x)); return x; }
template <bool INV> __device__ __forceinline__ void fft16k(float (&re)[32], float (&im)[32], LAS f32x2* buf, const int t_in) {
    asm volatile("" ::: "memory"); __builtin_amdgcn_sched_barrier(0);
    int t = opaque(t_in);
    unsigned z0 = 0u; asm volatile("" : "+s"(z0));
    fft_r2<32, INV>(re, im, z0);
    __syncthreads();
#pragma unroll
    for (int r = 0; r < 32; ++r) buf[33 * t + r] = (f32x2){re[brev(r, 5)], im[brev(r, 5)]};
    __syncthreads();
    t = opaque(t);
    { const int b2 = t + (t >> 5);
#pragma unroll
    for (int r = 0; r < 32; ++r) { const f32x2 v = buf[b2 + 528 * r]; re[r] = v.x; im[r] = v.y; } }
    {
        const float f1 = (float)(t & 31) * (1.0f / 1024.0f);
        const float c1 = __builtin_amdgcn_cosf(f1), s1 = INV ? __builtin_amdgcn_sinf(f1) : -__builtin_amdgcn_sinf(f1);
        float wc = c1, ws = s1;
#pragma unroll
        for (int r = 1; r < 32; ++r) {
            cmul_chain(re[r], im[r], wc, ws, c1, s1);
        }
    }
    fft_r2<32, INV>(re, im, z0);
    __syncthreads();
    {
        t = opaque(t);
        const int ob = (t >> 5) * 1056 + (t & 31);
#pragma unroll
        for (int r = 0; r < 32; ++r) buf[ob + 33 * r] = (f32x2){re[brev(r, 5)], im[brev(r, 5)]};
    }
    __syncthreads();
#pragma unroll
    for (int h = 0; h < 2; ++h) {
        t = opaque(t);
        float ar[16], ai[16]; const int j = t + 512 * h; const int b3 = t + (t >> 5) + 528 * h;
#pragma unroll
        for (int r = 0; r < 16; ++r) { const f32x2 v = buf[b3 + 1056 * r]; ar[r] = v.x; ai[r] = v.y; }
        {
            const float f1 = (float)j * (1.0f / 16384.0f);
            const float c1 = __builtin_amdgcn_cosf(f1), s1 = INV ? __builtin_amdgcn_sinf(f1) : -__builtin_amdgcn_sinf(f1);
            float wc = c1, ws = s1;
#pragma unroll
            for (int r = 1; r < 16; ++r) {
                cmul_chain(ar[r], ai[r], wc, ws, c1, s1);
            }
        }
        fft_r2<16, INV>(ar, ai, z0);
#pragma unroll
        for (int r = 0; r < 16; ++r) { re[h + 2 * r] = ar[brev(r, 4)]; im[h + 2 * r] = ai[brev(r, 4)]; }
    }
    asm volatile("" ::: "memory"); __builtin_amdgcn_sched_barrier(0);
}
}

struct Frame {
    LAS unsigned char* lds;
    volatile LAS unsigned* MISC;
    gu32* ctl;
    int tid, lane, wave;
    int wave0;
    int vcu, G;
    float* out;
    unsigned char* ws;
};
constexpr int PTRTAB_OFF = LDSCTL_OFF + 512;
__device__ __forceinline__ const GAS float* inp(const Frame& F, int i) {
    const v2u w = *(const LAS v2u*)(F.lds + PTRTAB_OFF + 8 * i);
    const unsigned lo = __builtin_amdgcn_readfirstlane(w.x), hi = __builtin_amdgcn_readfirstlane(w.y);
    return (const GAS float*)(((unsigned long long)hi << 32) | lo);
}
__device__ __forceinline__ GAS unsigned char* wsq(const Frame& F) { unsigned char* p = F.ws; asm volatile("" : "+s"(p)); return (GAS unsigned char*)p; }
enum { I_XP = 0, I_XS, I_WIN, I_CONVW, I_CONVB, I_FW1, I_FB1, I_FW2, I_FB2, I_FW3, I_SINF, I_DECAY, I_HBIAS, I_QNORM, I_WUQ, I_KVNORM, I_WUKV, I_GNHY, I_GNAT, I_WOUT,
       I_NMIXPRE, I_NMIXPOST, I_NMLPPRE, I_NMLPPOST, I_WUP, I_WDOWN };

__device__ __forceinline__ int rope_src(int p) { return 4 * (p >> 3) + (p & 3) + 16 * ((p >> 2) & 1); }
template <bool ROPEPERM>
__device__ __forceinline__ void transpose_item(const GAS float* W, int K, int N, GAS bf16* WT, LAS float* scr, int item, int lane, int ldk = 0, int koff = 0) {
    if (ldk == 0) ldk = K;
    const int nblk = N / 32, kb = item / nblk, nb = item % nblk, k0 = 64 * kb, n0 = 32 * nb;
    int sc = lane & 31; if (ROPEPERM && (nb % 3) == 2) sc = rope_src(sc);
#pragma unroll 8
    for (int i = 0; i < 32; ++i) { const int kk = 2 * i + (lane >> 5); scr[kk * 33 + (lane & 31)] = W[(size_t)(k0 + kk) * N + n0 + sc]; }
    LDS_WAIT(); asm volatile("" ::: "memory");
    const int c = lane & 7;
#pragma unroll
    for (int j = 0; j < 4; ++j) { const int n = (lane >> 3) + 8 * j; const LAS float* s = scr + (8 * c) * 33 + n;
        v4u o; o.x = pk2(s[0 * 33], s[1 * 33]); o.y = pk2(s[2 * 33], s[3 * 33]); o.z = pk2(s[4 * 33], s[5 * 33]); o.w = pk2(s[6 * 33], s[7 * 33]);
        *(GAS v4u*)(WT + (size_t)(n0 + n) * ldk + koff + k0 + 8 * c) = o; }
    LDS_WAIT(); asm volatile("" ::: "memory");
}
__device__ __forceinline__ void phase_weights(Frame& F, int l) {
    LAS float* scr = (LAS float*)(F.lds + RING_OFF + F.wave * 16384);
    const int gw = F.vcu * NWAVES + F.wave, NGW = F.G * NWAVES;
    GAS bf16* WinT = (GAS bf16*)(wsq(F) + WS_WIN); GAS bf16* WoutT = (GAS bf16*)(wsq(F) + WS_WOUT); GAS bf16* WupT = (GAS bf16*)(wsq(F) + WS_WUP); GAS bf16* WdownT = (GAS bf16*)(wsq(F) + WS_WDOWN);
    GAS bf16* WuqT = (GAS bf16*)(wsq(F) + WS_WUQ); GAS bf16* WukvT = (GAS bf16*)(wsq(F) + WS_WUKV);
    constexpr int I_IN = (D / 64) * (INW / 32), I_OUT = (D / 64) * (D / 32), I_UP = (D / 64) * (FF / 32), I_DN = (FF / 64) * (D / 32), I_UQ = (QR / 64) * (NQ / 32), I_UKV = (KVR / 64) * (NKV / 32);
    constexpr int I_W3 = 2048 / 32;
    constexpr int NITEMS = I_IN + I_OUT + I_UP + I_DN + I_UQ + I_UKV + 2 * I_W3;
    for (int it = gw; it < NITEMS; it += NGW) {
        int r = it;
        if (r < I_IN) { transpose_item<false>(inp(F, I_WIN) + (size_t)l * D * INW, D, INW, WinT, scr, r, F.lane); continue; } r -= I_IN;
        if (r < I_OUT) { transpose_item<false>(inp(F, I_WOUT) + (size_t)l * D * D, D, D, WoutT, scr, r, F.lane); continue; } r -= I_OUT;
        if (r < I_UP) { transpose_item<false>(inp(F, I_WUP) + (size_t)l * D * FF, D, FF, WupT, scr, r, F.lane); continue; } r -= I_UP;
        if (r < I_DN) { transpose_item<false>(inp(F, I_WDOWN) + (size_t)l * FF * D, FF, D, WdownT, scr, r, F.lane); continue; } r -= I_DN;
        if (r < I_UQ) { transpose_item<true>(inp(F, I_WUQ) + (size_t)l * QR * NQ, QR, NQ, WuqT, scr, r, F.lane); continue; } r -= I_UQ;
        if (r < I_UKV) { transpose_item<false>(inp(F, I_WUKV) + (size_t)l * KVR * NKV, KVR, NKV, WukvT, scr, r, F.lane); continue; } r -= I_UKV;
        transpose_item<false>(inp(F, I_FW3) + (size_t)l * 64 * 2048, 64, 2048, (GAS bf16*)(wsq(F) + WS_W3T), scr, r % I_W3, F.lane, 128, (r / I_W3) * 64);
    }
    { unsigned z = 0u; asm volatile("" : "+v"(z)); const v4u zz = {z, z, z, z};
      for (int i = gw * 64 + F.lane; i < 12288; i += NGW * 64) ((GAS v4u*)(WinT + (size_t)INW * D))[i] = zz; }
}
__device__ __forceinline__ void phase_rope_tab(Frame& F) {
    const float inv[16] = {1.000000000e+00f, 5.623413324e-01f, 3.162277639e-01f, 1.778279394e-01f, 1.000000015e-01f, 5.623412877e-02f, 3.162277862e-02f, 1.778279431e-02f,
                           9.999999776e-03f, 5.623413250e-03f, 3.162277862e-03f, 1.778279431e-03f, 1.000000047e-03f, 5.623413017e-04f, 3.162277862e-04f, 1.778279402e-04f};
    GAS float* ct = (GAS float*)(wsq(F) + WS_COS); GAS float* st = (GAS float*)(wsq(F) + WS_SIN);
    for (int i = F.vcu * NTHR + F.tid; i < L * 16; i += F.G * NTHR) {
        const int t = i >> 4, j = i & 15; float iv = inv[0];
#pragma unroll
        for (int q = 1; q < 16; ++q) iv = (j == q) ? inv[q] : iv;
        const float ang = (float)t * iv; ct[i] = cosf(ang); st[i] = sinf(ang);
    }
}
__device__ __forceinline__ const GAS float* x_src_row(Frame& F, int l, int m) {
    if (l == 0) return (m < 2 * L) ? inp(F, I_XP) + (size_t)m * D : inp(F, I_XS) + (size_t)(m - 2 * L) * D;
    return (const GAS float*)F.out + (size_t)m * D;
}
__device__ __forceinline__ void store_xn_row(f32x4 (&v)[4], float rstd, const GAS float* g, GAS bf16* orow, int lane) {
    GAS v2u* o8 = (GAS v2u*)orow + lane;
#pragma unroll
    for (int j = 0; j < 4; ++j) { const f32x4 gg = ((const GAS f32x4*)g)[lane + 64 * j]; v2u w; w.x = pk2(v[j].x * rstd * gg.x, v[j].y * rstd * gg.y); w.y = pk2(v[j].z * rstd * gg.z, v[j].w * rstd * gg.w); o8[64 * j] = w; }
}
__device__ __forceinline__ float row_ss(const f32x4 (&v)[4]) { float s = 0.f;
#pragma unroll
    for (int j = 0; j < 4; ++j) s += (v[j].x * v[j].x + v[j].y * v[j].y) + (v[j].z * v[j].z + v[j].w * v[j].w);
    return wave_sum(s); }
__device__ __forceinline__ void phase_norm_first(Frame& F, int l, const GAS float* g) {
    const int gw = F.vcu * NWAVES + F.wave, NGW = F.G * NWAVES; GAS bf16* XN = (GAS bf16*)(wsq(F) + WS_XN);
    for (int m = gw; m < M; m += NGW) {
        const GAS f32x4* xr = (const GAS f32x4*)x_src_row(F, l, m) + F.lane; f32x4 v[4];
#pragma unroll
        for (int j = 0; j < 4; ++j) v[j] = xr[64 * j];
        const float rstd = 1.0f / sqrtf(row_ss(v) * (1.0f / D) + EPS);
        store_xn_row(v, rstd, g, XN + (size_t)m * D, F.lane);
    }
}
__device__ __forceinline__ void phase_norm_res(Frame& F, int lsrc, const GAS bf16* T, const GAS float* gpost, const GAS float* gnext) {
    const int gw = F.vcu * NWAVES + F.wave, NGW = F.G * NWAVES; GAS bf16* XN = (GAS bf16*)(wsq(F) + WS_XN);
    for (int m0 = gw; m0 < M; m0 += 2 * NGW) {
        f32x4 v[2][4], tv[2][4];
#pragma unroll
        for (int q = 0; q < 2; ++q) { const int m = m0 + q * NGW; const GAS f32x4* xr = (const GAS f32x4*)x_src_row(F, lsrc, m) + F.lane; const GAS v2u* tr = (const GAS v2u*)(T + (size_t)m * D) + F.lane;
#pragma unroll
            for (int j = 0; j < 4; ++j) { v[q][j] = xr[64 * j]; const v2u w = tr[64 * j]; tv[q][j] = (f32x4){bf2f(w.x & 0xffffu), bf2f(w.x >> 16), bf2f(w.y & 0xffffu), bf2f(w.y >> 16)}; } }
#pragma unroll
        for (int q = 0; q < 2; ++q) { const int m = m0 + q * NGW;
            const float rt = 1.0f / sqrtf(row_ss(tv[q]) * (1.0f / D) + EPS);
            GAS f32x4* orow = (GAS f32x4*)(F.out + (size_t)m * D) + F.lane;
#pragma unroll
            for (int j = 0; j < 4; ++j) { const f32x4 gg = ((const GAS f32x4*)gpost)[F.lane + 64 * j]; v[q][j] = v[q][j] + tv[q][j] * rt * gg; orow[64 * j] = v[q][j]; }
            if (gnext) { const float rstd = 1.0f / sqrtf(row_ss(v[q]) * (1.0f / D) + EPS); store_xn_row(v[q], rstd, gnext, XN + (size_t)m * D, F.lane); } }
    }
}

__device__ __forceinline__ void phase_filter_mlp(Frame& F, int l) {
    const GAS float* w1 = inp(F, I_FW1) + (size_t)l * 33 * 64; const GAS float* b1 = inp(F, I_FB1) + l * 64; const GAS float* w2 = inp(F, I_FW2) + (size_t)l * 64 * 64; const GAS float* b2 = inp(F, I_FB2) + l * 64;
    const GAS float* sf = inp(F, I_SINF) + l * 128; GAS bf16* H2 = (GAS bf16*)(wsq(F) + WS_H2);
    const int lane = F.lane, gw = F.vcu * NWAVES + F.wave, NGW = F.G * NWAVES;
    float w1c[33], w2c[64];
#pragma unroll
    for (int f = 0; f < 33; ++f) w1c[f] = w1[f * 64 + lane];
#pragma unroll
    for (int i = 0; i < 64; ++i) w2c[i] = w2[i * 64 + lane];
    const float b1l = b1[lane], b2l = b2[lane], sf0 = sf[lane], sf1 = sf[64 + lane];
    for (int n = gw; n < L; n += NGW) {
        const float tn = (float)n * (1.0f / (float)(L - 1)); const float omega = (float)(2.0 * 3.14159265358979323846 / L) * (float)n;
        const int bidx = (lane >= 17) ? lane - 17 : lane - 1; const float band = 1e-4f + (float)bidx * ((15.0f - 1e-4f) / 15.0f); const float ph = omega * band;
        const float zf = (lane == 0) ? tn : ((lane <= 16) ? cosf(ph) : -sinf(ph));
        float acc = b1l;
#pragma unroll
        for (int f = 0; f < 33; ++f) acc += __uint_as_float(__builtin_amdgcn_readlane(__float_as_uint(zf), f)) * w1c[f];
        const float h1 = sinf(sf0 * acc);
        float acc2 = b2l;
#pragma unroll
        for (int i = 0; i < 64; ++i) acc2 += __uint_as_float(__builtin_amdgcn_readlane(__float_as_uint(h1), i)) * w2c[i];
        const float hv = sinf(sf1 * acc2); const bf16 hi = f2bf(hv);
        H2[(size_t)n * 128 + lane] = hi; H2[(size_t)n * 128 + 64 + lane] = f2bf(hv - bf2f(hi));
    }
}

__device__ __forceinline__ void phase_filter_fft(Frame& F, int l) {
    const GAS float* KT = (const GAS float*)(wsq(F) + WS_KT); GAS f32x2* KEO = (GAS f32x2*)(wsq(F) + WS_KEO); const GAS float* hb = inp(F, I_HBIAS) + (size_t)l * 2 * HYW;
    LAS f32x2* buf = (LAS f32x2*)(F.lds + RING_OFF); const int t = F.tid;
    for (int c = F.vcu; c < HYW; c += F.G) {
        const GAS float* fw0 = KT + (size_t)(0 * HYW + c) * L; const GAS float* bw0 = KT + (size_t)(1 * HYW + c) * L;
        const GAS float* fw1 = KT + (size_t)(2 * HYW + c) * L; const GAS float* bw1 = KT + (size_t)(3 * HYW + c) * L;
        const float bias0 = hb[c], bias1 = hb[HYW + c]; const float sc = 1.0f / (2.0f * L);
        GAS f32x2* k0 = KEO + (size_t)c * KEO_BLK; GAS f32x2* k1 = KEO + (size_t)(HYW + c) * KEO_BLK;
        float ar[32], ai[32];
#pragma unroll 1
        for (int odd = 0; odd < 2; ++odd) {
            { const int tq = hfft::opaque(t);
#pragma unroll
              for (int m = 0; m < 32; ++m) { const int n = tq + 512 * m; const int nb = n >= 1 ? L - n : 0;
                  const float f0 = fw0[n], f1 = fw1[n]; float b0 = bw0[nb], b1 = bw1[nb]; b0 = n >= 1 ? b0 : 0.f; b1 = n >= 1 ? b1 : 0.f;
                  if (!odd) { ar[m] = f0 + b0; ai[m] = f1 + b1; }
                  else { const float d0 = f0 - b0, d1 = f1 - b1; const float fr = (float)n * (1.0f / 32768.0f); const float cs = __builtin_amdgcn_cosf(fr), sn = -__builtin_amdgcn_sinf(fr);
                         ar[m] = d0 * cs - d1 * sn; ai[m] = d0 * sn + d1 * cs; }
                  if ((m & 7) == 7) { asm volatile("" ::: "memory"); __builtin_amdgcn_sched_barrier(0); } } }
            hfft::fft16k<false>(ar, ai, buf, t);
            __syncthreads();
            { const int tq = hfft::opaque(t);
#pragma unroll
              for (int m = 0; m < 32; ++m) buf[hfft::pad(tq + 512 * m)] = (f32x2){ar[m], ai[m]}; }
            __syncthreads();
            { const int tq = hfft::opaque(t); GAS f32x2* d0 = k0 + (odd ? KEO_KO : 0); GAS f32x2* d1 = k1 + (odd ? KEO_KO : 0);
#pragma unroll
              for (int m = 0; m <= 16; ++m) { const int k = tq + 512 * m; const bool keep = odd ? (k < 8192) : (k <= 8192);
                  const int rk = odd ? 16383 - k : ((16384 - k) & 16383); const f32x2 xq = buf[hfft::pad(rk)]; const float cr = xq.x, ci = -xq.y;
                  const float a0 = 0.5f * (ar[m] + cr), a1 = 0.5f * (ai[m] + ci), b0 = 0.5f * (ai[m] - ci), b1 = -0.5f * (ar[m] - cr);
                  if (keep) { d0[k] = (f32x2){(a0 + bias0) * sc, a1 * sc}; d1[k] = (f32x2){(b0 + bias1) * sc, b1 * sc}; } } }
        }
    }
    __syncthreads();
}

__device__ __forceinline__ float u_conv3(const GAS bf16* row, int n, float w0, float w1, float w2, float cb) {
    const int nm = n >= 1 ? n - 1 : 0, np = n + 1 < L ? n + 1 : L - 1;
    float um = bf2f(row[nm]), up = bf2f(row[np]); const float u0 = bf2f(row[n]);
    um = n >= 1 ? um : 0.f; up = n + 1 < L ? up : 0.f;
    return um * w0 + u0 * w1 + up * w2 + cb;
}
__device__ __forceinline__ void cmul_spec(float (&xr)[32], float (&xi)[32], const GAS f32x2* ke, int t, bool odd) {
    { const int tq = hfft::opaque(t); (void)tq;
#pragma unroll
    for (int m = 0; m < 32; ++m) { const int k = tq + 512 * m; int idx; bool cj;
        if (!odd) { cj = k > 8192; idx = cj ? 16384 - k : k; } else { cj = k >= 8192; idx = cj ? 16383 - k : k; }
        const f32x2 kv = ke[idx]; const float kr = kv.x, ki = cj ? -kv.y : kv.y;
        const float a = xr[m], b = xi[m]; xr[m] = a * kr - b * ki; xi[m] = a * ki + b * kr; if ((m & 15) == 15) { asm volatile("" ::: "memory"); __builtin_amdgcn_sched_barrier(0); } }
    }
}
__device__ __forceinline__ f32x2 ld_spec(const GAS f32x2* ke, int k, bool odd) {
    int idx; bool cj;
    if (!odd) { cj = k > 8192; idx = cj ? 16384 - k : k; } else { cj = k >= 8192; idx = cj ? 16383 - k : k; }
    f32x2 kv = ke[idx]; kv.y = cj ? -kv.y : kv.y; return kv;
}
__device__ __forceinline__ void cmul_spec2(float (&xr)[32], float (&xi)[32], const GAS f32x2* ka, const GAS f32x2* kb, LAS f32x2* buf, int t, bool odd) {
    __syncthreads();
    { const int tq = hfft::opaque(t);
#pragma unroll
      for (int m = 0; m < 32; ++m) buf[hfft::pad(tq + 512 * m)] = (f32x2){xr[m], xi[m]}; }
    __syncthreads();
    { const int tq = hfft::opaque(t);
#pragma unroll
      for (int m = 0; m < 32; ++m) { const int k = tq + 512 * m; const int rk = odd ? 16383 - k : ((16384 - k) & 16383);
          const f32x2 xc = buf[hfft::pad(rk)];
          const f32x2 a = ld_spec(ka, k, odd), b = ld_spec(kb, k, odd);
          const float sr = 0.5f * (a.x + b.x), si = 0.5f * (a.y + b.y), dr = 0.5f * (a.x - b.x), di = 0.5f * (a.y - b.y);
          const float x0 = xr[m], x1 = xi[m], c0 = xc.x, c1 = -xc.y;
          xr[m] = (x0 * sr - x1 * si) + (c0 * dr - c1 * di); xi[m] = (x0 * si + x1 * sr) + (c0 * di + c1 * dr);
          if ((m & 7) == 7) { asm volatile("" ::: "memory"); __builtin_amdgcn_sched_barrier(0); } } }
}
__device__ __forceinline__ void phase_hyena(Frame& F, int l) {
    const GAS bf16* UT = (const GAS bf16*)(wsq(F) + WS_UT); GAS bf16* YT = (GAS bf16*)(wsq(F) + WS_YT); const GAS f32x2* KEO = (const GAS f32x2*)(wsq(F) + WS_KEO);
    const GAS float* cw = inp(F, I_CONVW) + (size_t)l * 3 * HYP; const GAS float* cbv = inp(F, I_CONVB) + (size_t)l * HYP;
    LAS f32x2* buf = (LAS f32x2*)(F.lds + RING_OFF); const int t = F.tid;
    GAS f32x2* G0 = (GAS f32x2*)(wsq(F) + WS_G0) + (size_t)F.vcu * 16384 + t;
    GAS f32x2* G1 = (GAS f32x2*)(wsq(F) + (F.vcu < 200 ? WS_G1A + (size_t)F.vcu * 131072 : WS_G1B + (size_t)(F.vcu - 200) * 131072)) + t;
    for (int item = F.vcu; item < HYW + HYW / 2; item += F.G) {
        const bool mode1 = item >= HYW;
        const int c0 = mode1 ? 2 * (item - HYW) : item, c1 = mode1 ? c0 + 1 : c0;
        const size_t s0 = mode1 ? (size_t)2 * L : 0, s1 = mode1 ? (size_t)2 * L : (size_t)L;
        float ar[32], ai[32];
#pragma unroll 1
        for (int o = 0; o < 2; ++o) {
            const GAS f32x2* ke0 = KEO + (size_t)(o * HYW + c0) * KEO_BLK; const GAS f32x2* ke1 = KEO + (size_t)(o * HYW + c1) * KEO_BLK;
#pragma unroll 1
            for (int half = 0; half < 2; ++half) {
                if (o == 0) { const float w0 = cw[c0], w1 = cw[HYP + c0], w2 = cw[2 * HYP + c0], cb = cbv[c0], v0 = cw[c1], v1 = cw[HYP + c1], v2 = cw[2 * HYP + c1], vb = cbv[c1];
                    const GAS bf16* r0 = UT + (size_t)c0 * M + s0; const GAS bf16* r1 = UT + (size_t)c1 * M + s1;
                    { const int tq = hfft::opaque(t); (void)tq;
#pragma unroll
                    for (int m = 0; m < 32; ++m) { const int n = tq + 512 * m; ar[m] = u_conv3(r0, n, w0, w1, w2, cb); ai[m] = u_conv3(r1, n, v0, v1, v2, vb); if ((m & 15) == 15) { asm volatile("" ::: "memory"); __builtin_amdgcn_sched_barrier(0); } } }
                    }
                else {
                    { const int tq = hfft::opaque(t); (void)tq; GAS f32x2* G0q = G0 + (tq - t);
#pragma unroll
                    for (int m = 0; m < 32; ++m) { const f32x2 v = G0q[m * 512]; ar[m] = v.x; ai[m] = v.y; if ((m & 15) == 15) { asm volatile("" ::: "memory"); __builtin_amdgcn_sched_barrier(0); } } }
                    }
                if (half == 0) {
                    hfft::fft16k<false>(ar, ai, buf, t);
                    if (mode1) cmul_spec2(ar, ai, ke0, ke1, buf, t, false); else cmul_spec(ar, ai, ke0, t, false);
                    hfft::fft16k<true>(ar, ai, buf, t);
                    { const int tq = hfft::opaque(t); (void)tq; GAS f32x2* G1q = G1 + (tq - t);
#pragma unroll
                    for (int m = 0; m < 32; ++m) G1q[m * 512] = (f32x2){ar[m], ai[m]};
                    }
                } else {
                    { const int tq = hfft::opaque(t); (void)tq;
#pragma unroll
                    for (int m = 0; m < 32; ++m) { const float fr = (float)(tq + 512 * m) * (1.0f / 32768.0f); const float cs = __builtin_amdgcn_cosf(fr), sn = -__builtin_amdgcn_sinf(fr);
                        const float a = ar[m], b = ai[m]; ar[m] = a * cs - b * sn; ai[m] = a * sn + b * cs; }
                    }
                    hfft::fft16k<false>(ar, ai, buf, t);
                    if (mode1) cmul_spec2(ar, ai, ke0 + KEO_KO, ke1 + KEO_KO, buf, t, true); else cmul_spec(ar, ai, ke0 + KEO_KO, t, true);
                    hfft::fft16k<true>(ar, ai, buf, t);
                    const int g0 = (o + 1) * HYW + c0, g1 = (o + 1) * HYW + c1;
                    const float w0 = cw[g0], w1 = cw[HYP + g0], w2 = cw[2 * HYP + g0], cb = cbv[g0], v0 = cw[g1], v1 = cw[HYP + g1], v2 = cw[2 * HYP + g1], vb = cbv[g1];
                    const GAS bf16* r0 = UT + (size_t)g0 * M + s0; const GAS bf16* r1 = UT + (size_t)g1 * M + s1;
                    { const int tq = hfft::opaque(t); (void)tq; GAS f32x2* G1q = G1 + (tq - t);
#pragma unroll
                    for (int m = 0; m < 32; ++m) { const int n = tq + 512 * m; const float fr = (float)n * (1.0f / 32768.0f); const float cs = __builtin_amdgcn_cosf(fr), sn = __builtin_amdgcn_sinf(fr);
                        const float a = ar[m], b = ai[m]; const f32x2 e = G1q[m * 512]; const float yr = e.x + (a * cs - b * sn), yi = e.y + (a * sn + b * cs);
                        ar[m] = yr * u_conv3(r0, n, w0, w1, w2, cb); ai[m] = yi * u_conv3(r1, n, v0, v1, v2, vb); if ((m & 15) == 15) { asm volatile("" ::: "memory"); __builtin_amdgcn_sched_barrier(0); } }
                    }
                    if (o == 0) {
                        { const int tq = hfft::opaque(t); (void)tq; GAS f32x2* G0q = G0 + (tq - t);
#pragma unroll
                        for (int m = 0; m < 32; ++m) G0q[m * 512] = (f32x2){ar[m], ai[m]};
                        }
                    } else { GAS bf16* y0 = YT + (size_t)c0 * M + s0; GAS bf16* y1 = YT + (size_t)c1 * M + s1;
                        { const int tq = hfft::opaque(t); (void)tq;
#pragma unroll
                        for (int m = 0; m < 32; ++m) { const int n = tq + 512 * m; y0[n] = f2bf(ar[m]); y1[n] = f2bf(ai[m]); } }
                        }
                }
            }
        }
    }
    __syncthreads();
}

__device__ __forceinline__ void phase_mla_prep(Frame& F, int l) {
    const GAS bf16* CQKV = (const GAS bf16*)(wsq(F) + WS_CQKV); GAS bf16* CQN = (GAS bf16*)(wsq(F) + WS_CQN); GAS bf16* CKVN = (GAS bf16*)(wsq(F) + WS_CKVN); GAS bf16* KPE = (GAS bf16*)(wsq(F) + WS_KPE);
    const GAS float* gq = inp(F, I_QNORM) + l * QR; const GAS float* gkv = inp(F, I_KVNORM) + l * KVR; const GAS float* ct = (const GAS float*)(wsq(F) + WS_COS); const GAS float* st = (const GAS float*)(wsq(F) + WS_SIN);
    const int gw = F.vcu * NWAVES + F.wave, NGW = F.G * NWAVES, lane = F.lane;
    for (int m = gw; m < M; m += NGW) {
        const GAS bf16* row = CQKV + (size_t)m * 512;
        const v2u q = *(const GAS v2u*)(row + 4 * lane); const unsigned kv = *(const GAS unsigned*)(row + 256 + 2 * lane);
        const float q0 = bf2f(q.x & 0xffffu), q1 = bf2f(q.x >> 16), q2 = bf2f(q.y & 0xffffu), q3 = bf2f(q.y >> 16), k0 = bf2f(kv & 0xffffu), k1 = bf2f(kv >> 16);
        const float rq = 1.0f / sqrtf(wave_sum((q0 * q0 + q1 * q1) + (q2 * q2 + q3 * q3)) * (1.0f / QR) + EPS);
        const float rk = 1.0f / sqrtf(wave_sum(k0 * k0 + k1 * k1) * (1.0f / KVR) + EPS);
        const f32x4 g4 = *(const GAS f32x4*)(gq + 4 * lane); const f32x2 g2 = *(const GAS f32x2*)(gkv + 2 * lane);
        v2u oq; oq.x = pk2(q0 * rq * g4.x, q1 * rq * g4.y); oq.y = pk2(q2 * rq * g4.z, q3 * rq * g4.w);
        *(GAS v2u*)(CQN + (size_t)m * QR + 4 * lane) = oq;
        *(GAS unsigned*)(CKVN + (size_t)m * KVR + 2 * lane) = pk2(k0 * rk * g2.x, k1 * rk * g2.y);
        if (lane < 16) { const int j = lane, tpos = m & (L - 1); const float x1 = bf2f(row[384 + j]), x2 = bf2f(row[384 + 16 + j]); const float cs = ct[tpos * 16 + j], sn = st[tpos * 16 + j];
            const int p1 = 8 * (j >> 2) + (j & 3); KPE[(size_t)m * ROPE + p1] = f2bf(x1 * cs - x2 * sn); KPE[(size_t)m * ROPE + p1 + 4] = f2bf(x2 * cs + x1 * sn); }
    }
}

__device__ __forceinline__ void phase_hy_out(Frame& F, int l) {
    const GAS bf16* YT = (const GAS bf16*)(wsq(F) + WS_YT); GAS bf16* MIX = (GAS bf16*)(wsq(F) + WS_MIX); const GAS float* gn = inp(F, I_GNHY) + l * HYW;
    LAS bf16* tl = (LAS bf16*)(F.lds + RING_OFF + F.wave * 16384);
    const int gw = F.vcu * NWAVES + F.wave, NGW = F.G * NWAVES, lane = F.lane;
    for (int task = gw; task < 8 * (M / 64); task += NGW) {
        const int g = task & 7, tb = task >> 3, tok0 = tb * 64; const int cl = lane >> 3, t8 = (lane & 7) * 8;
        float v[8][8]; float ss[8]; const int ln_ = hw_lane();
#pragma unroll
        for (int j = 0; j < 8; ++j) ss[j] = 0.f;
#pragma unroll
        for (int i = 0; i < 8; ++i) { const int ch = g * 64 + 8 * i + cl; const v4u w = *(const GAS v4u*)(YT + (size_t)ch * M + tok0 + t8);
            v[i][0] = bf2f(w.x & 0xffffu); v[i][1] = bf2f(w.x >> 16); v[i][2] = bf2f(w.y & 0xffffu); v[i][3] = bf2f(w.y >> 16);
            v[i][4] = bf2f(w.z & 0xffffu); v[i][5] = bf2f(w.z >> 16); v[i][6] = bf2f(w.w & 0xffffu); v[i][7] = bf2f(w.w >> 16);
#pragma unroll
            for (int j = 0; j < 8; ++j) ss[j] += v[i][j] * v[i][j]; }
#pragma unroll
        for (int j = 0; j < 8; ++j) { float s = ss[j]; s += shx(s, ln_, 8); s += shx(s, ln_, 16); s += shx(s, ln_, 32); ss[j] = 1.0f / sqrtf(s * (1.0f / 64.0f) + EPS); }
#pragma unroll
        for (int i = 0; i < 8; ++i) { const int cc = 8 * i + cl; const float gg = gn[g * 64 + cc];
#pragma unroll
            for (int j = 0; j < 8; ++j) tl[(t8 + j) * 72 + cc] = f2bf(v[i][j] * ss[j] * gg); }
        LDS_WAIT(); asm volatile("" ::: "memory");
#pragma unroll
        for (int i = 0; i < 8; ++i) { const int tok = 8 * i + (lane >> 3), c8 = (lane & 7) * 8; const v4u w = *(const LAS v4u*)(tl + tok * 72 + c8);
            *(GAS v4u*)(MIX + (size_t)(tok0 + tok) * D + g * 64 + c8) = w; }
        LDS_WAIT(); asm volatile("" ::: "memory");
    }
}

namespace att {
using s16x4 = __attribute__((ext_vector_type(4))) short;
using f32x16 = __attribute__((ext_vector_type(16))) float;
using u32x4 = __attribute__((ext_vector_type(4))) unsigned;
constexpr int QBLK = 32, KVBLK = 64, NW = 8;
constexpr float SCALE = 0.10206207261596575f;
constexpr float THR = 8.f;
constexpr int SHM_K = KVBLK * 256, SHM_V = KVBLK * DV * 2;
constexpr int NSLOT = 3;
constexpr int OFF_V = 0, OFF_K = NSLOT * SHM_V, OFF_WS = OFF_K + NSLOT * SHM_K, SHM_ATTN = OFF_WS + NW * 64 * 4;
#define KSWZ(row, colB) ((row) * 256 + ((colB) ^ (((row) & 15) << 4)))
#define SBAR() __builtin_amdgcn_sched_barrier(0)
__device__ __forceinline__ int crow(int r, int hi) { return (r & 3) + 8 * (r >> 2) + 4 * hi; }
__device__ __forceinline__ unsigned cvtpk(float lo, float hi) { unsigned r; asm volatile("v_cvt_pk_bf16_f32 %0, %1, %2" : "=v"(r) : "v"(lo), "v"(hi)); return r; }
constexpr float THRL = THR * 1.4426950408889634f;
#define EX2(v) __builtin_amdgcn_exp2f(v)
#define MX3(a, b, c) __builtin_fmaxf(__builtin_fmaxf((a), (b)), (c))
__device__ __forceinline__ int v_st(int k, int c) { const int kk = k; return ((kk >> 3) * 2 + (c >> 5)) * 512 + ((kk & 7) * 32 + (c & 31)) * 2; }
__device__ __forceinline__ int v_rd_base(int lane) { return ((lane & 3) << 3) | (((lane >> 2) & 3) << 6) | (((lane >> 4) & 1) << 5) | (((lane >> 5) & 1) << 8); }
constexpr int v_rd_off(int d0, int ks, int half) { return d0 * 512 + ks * 2048 + half * 1024; }
template <int OFF> __device__ __forceinline__ s16x4 tr_read(int vb) { s16x4 r; asm volatile("ds_read_b64_tr_b16 %0, %1 offset:%2" : "=&v"(r) : "v"(vb), "i"(OFF) : "memory"); return r; }
__device__ __forceinline__ void attn_unit(const bf16* Qb_, const bf16* KNh_, const bf16* KPEb_, const bf16* Vh_, bf16* Mo_,
                                          const float* gain_, const float* ct_, const float* st_, int tpos0, LAS char* lds, const int wave0) {
  const GAS bf16* Qb = (const GAS bf16*)Qb_; const GAS bf16* KNh = (const GAS bf16*)KNh_; const GAS bf16* KPEb = (const GAS bf16*)KPEb_; const GAS bf16* Vh = (const GAS bf16*)Vh_; GAS bf16* Mo = (GAS bf16*)Mo_;
  const GAS float* gain = (const GAS float*)gain_; const GAS float* ct = (const GAS float*)ct_; const GAS float* st = (const GAS float*)st_;

  int tid_ = tid_from_wave(wave0);
  const int tid = tid_, wid = tid >> 6, lane = tid & 63, r32 = lane & 31, hi = lane >> 5;
  LAS char* V_lds = lds + OFF_V; LAS char* K_lds = lds + OFF_K;
  LAS float* ws = (LAS float*)(lds + OFF_WS) + wid * 64; LAS float* li_l = ws; LAS float* al_l = ws + 32;
  float m_reg = 0.f, l_reg = 0.f; f32x16 o[2] = {}; f32x16 negm = {}; bf16x8 qr[6];
  const GAS bf16* Qw = Qb + (long)(wid * QBLK + r32) * NQ + hi * 8;
#pragma unroll
  for (int d0 = 0; d0 < 6; ++d0) qr[d0] = *reinterpret_cast<const GAS bf16x8*>(Qw + d0 * 16);
  { const int tq = tpos0 + wid * QBLK + r32;
#pragma unroll
    for (int d0 = 4; d0 < 6; ++d0) { const int fq = 2 * (d0 - 4) + hi; const f32x4 cs = *reinterpret_cast<const GAS f32x4*>(ct + tq * 16 + 4 * fq), sn = *reinterpret_cast<const GAS f32x4*>(st + tq * 16 + 4 * fq);
      const u32x4 w = __builtin_bit_cast(u32x4, qr[d0]);
      const f32x4 x1 = {bf2f(w[0] & 0xffffu), bf2f(w[0] >> 16), bf2f(w[1] & 0xffffu), bf2f(w[1] >> 16)}, x2 = {bf2f(w[2] & 0xffffu), bf2f(w[2] >> 16), bf2f(w[3] & 0xffffu), bf2f(w[3] >> 16)};
      const f32x4 a = x1 * cs - x2 * sn, b = x2 * cs + x1 * sn;
      const u32x4 o4 = {cvtpk(a[0], a[1]), cvtpk(a[2], a[3]), cvtpk(b[0], b[1]), cvtpk(b[2], b[3])}; qr[d0] = __builtin_bit_cast(bf16x8, o4); } }
  { constexpr float C = SCALE * 1.4426950408889634f;
#pragma unroll
    for (int d0 = 0; d0 < 6; ++d0) { const u32x4 w = __builtin_bit_cast(u32x4, qr[d0]); u32x4 o4;
#pragma unroll
      for (int e = 0; e < 4; ++e) o4[e] = cvtpk(bf2f(w[e] & 0xffffu) * C, bf2f(w[e] >> 16) * C);
      qr[d0] = __builtin_bit_cast(bf16x8, o4); } }
  const int sr = tid >> 3, sc = (tid & 7) * 8;
  const int rr_ = (tid & 255) >> 2, rc = (tid & 3) * 8;
  const int vst0 = v_st(sr, sc), kst0 = KSWZ(sr, sc * 2), kst1 = KSWZ(rr_, 128 + rc * 2);
  const int vb0 = (int)(unsigned)(uintptr_t)V_lds + v_rd_base(lane);
  struct { bf16x8 vs, kn, kr; } sr_[2];
#define SLOAD(i, k0) do { sr_[i].vs = *reinterpret_cast<const GAS bf16x8*>(&Vh[(long)((k0) + sr) * NKV + sc]); sr_[i].kn = *reinterpret_cast<const GAS bf16x8*>(&KNh[(long)((k0) + sr) * NKV + sc]); \
    sr_[i].kr = *reinterpret_cast<const GAS bf16x8*>(&KPEb[(long)((k0) + rr_) * ROPE + rc]); } while (0)
#define SWRITE(b, i) do { *(LAS bf16x8*)(V_lds + (b) * SHM_V + vst0) = sr_[i].vs; *(LAS bf16x8*)(K_lds + (b) * SHM_K + kst0) = sr_[i].kn; *(LAS bf16x8*)(K_lds + (b) * SHM_K + kst1) = sr_[i].kr; } while (0)
#define SWAIT() asm volatile("s_waitcnt vmcnt(3)" ::: "memory")
#define RESC(a) do { if (__any((a) < 1.f)) { if (hi == 0) al_l[r32] = (a); asm volatile("s_waitcnt lgkmcnt(0)" ::: "memory"); \
    _Pragma("unroll") for (int d = 0; d < 2; ++d) _Pragma("unroll") for (int r = 0; r < 16; ++r) o[d][r] *= al_l[crow(r, hi)]; } } while (0)
  f32x16 pA0, pA1, pB0, pB1; bf16x8 pa0, pa1, pa2, pa3; constexpr int NTL = L / KVBLK; constexpr int SE = 0, SO = 1;
  int koff[6];
#pragma unroll
  for (int d0 = 0; d0 < 6; ++d0) koff[d0] = KSWZ(r32, (d0 * 16 + hi * 8) * 2);
  s16x4 vl[4], vh[4]; float pmax = 0.f, alpha = 1.f;
#define KFR(i) (*(const LAS bf16x8*)(kbase + koff[(i) >> 1] + ((i) & 1) * 8192))
#define VRD8(D0) do { vl[0] = tr_read<v_rd_off(D0, 0, 0)>(vbq); vh[0] = tr_read<v_rd_off(D0, 0, 1)>(vbq); vl[1] = tr_read<v_rd_off(D0, 1, 0)>(vbq); vh[1] = tr_read<v_rd_off(D0, 1, 1)>(vbq); \
    vl[2] = tr_read<v_rd_off(D0, 2, 0)>(vbq); vh[2] = tr_read<v_rd_off(D0, 2, 1)>(vbq); vl[3] = tr_read<v_rd_off(D0, 3, 0)>(vbq); vh[3] = tr_read<v_rd_off(D0, 3, 1)>(vbq); } while (0)
#define VWAIT() asm volatile("s_waitcnt lgkmcnt(0)" : "+v"(vl[0]), "+v"(vh[0]), "+v"(vl[1]), "+v"(vh[1]), "+v"(vl[2]), "+v"(vh[2]), "+v"(vl[3]), "+v"(vh[3]) :: "memory")
#define VFR(k) (bf16x8){vl[k][0], vl[k][1], vl[k][2], vl[k][3], vh[k][0], vh[k][1], vh[k][2], vh[k][3]}
#define PKA(P, B) do { w0_ = cvtpk(P[B + 0], P[B + 1]); w1_ = cvtpk(P[B + 2], P[B + 3]); } while (0)
#define PKB(P, B, OUT) do { const u32x4 w_ = {w0_, w1_, cvtpk(P[B + 4], P[B + 5]), cvtpk(P[B + 6], P[B + 7])}; OUT = __builtin_bit_cast(bf16x8, w_); } while (0)
#define R1(DO_QK, DO_FIN, X0, X1, Y0, Y1, KSLOT) do { const LAS char* kbase = K_lds + (KSLOT) * SHM_K; bf16x8 kf0, kf1, kf2, kf3; unsigned w0_ = 0, w1_ = 0; \
    if (DO_QK) { kf0 = KFR(0); kf1 = KFR(1); kf2 = KFR(2); } SBAR(); \
      if (DO_QK) { kf3 = KFR(3); X0 = __builtin_amdgcn_mfma_f32_32x32x16_bf16(kf0, qr[0], negm, 0, 0, 0); } if (DO_FIN) { Y0[0] = EX2(Y0[0]); Y0[1] = EX2(Y0[1]); Y0[2] = EX2(Y0[2]); Y0[3] = EX2(Y0[3]); } SBAR(); \
      if (DO_QK) { kf0 = KFR(4); X1 = __builtin_amdgcn_mfma_f32_32x32x16_bf16(kf1, qr[0], negm, 0, 0, 0); } if (DO_FIN) { Y0[4] = EX2(Y0[4]); Y0[5] = EX2(Y0[5]); Y0[6] = EX2(Y0[6]); Y0[7] = EX2(Y0[7]); } SBAR(); \
      if (DO_QK) { kf1 = KFR(5); X0 = __builtin_amdgcn_mfma_f32_32x32x16_bf16(kf2, qr[1], X0, 0, 0, 0); } if (DO_FIN) { Y0[8] = EX2(Y0[8]); Y0[9] = EX2(Y0[9]); Y0[10] = EX2(Y0[10]); Y0[11] = EX2(Y0[11]); } SBAR(); \
      if (DO_QK) { kf2 = KFR(6); X1 = __builtin_amdgcn_mfma_f32_32x32x16_bf16(kf3, qr[1], X1, 0, 0, 0); } if (DO_FIN) { Y0[12] = EX2(Y0[12]); Y0[13] = EX2(Y0[13]); Y0[14] = EX2(Y0[14]); Y0[15] = EX2(Y0[15]); } SBAR(); \
      if (DO_QK) { kf3 = KFR(7); X0 = __builtin_amdgcn_mfma_f32_32x32x16_bf16(kf0, qr[2], X0, 0, 0, 0); } if (DO_FIN) { Y1[0] = EX2(Y1[0]); Y1[1] = EX2(Y1[1]); Y1[2] = EX2(Y1[2]); Y1[3] = EX2(Y1[3]); PKA(Y0, 0); } SBAR(); \
      if (DO_QK) { kf0 = KFR(8); X1 = __builtin_amdgcn_mfma_f32_32x32x16_bf16(kf1, qr[2], X1, 0, 0, 0); } if (DO_FIN) { Y1[4] = EX2(Y1[4]); Y1[5] = EX2(Y1[5]); Y1[6] = EX2(Y1[6]); Y1[7] = EX2(Y1[7]); PKB(Y0, 0, pa0); } SBAR(); \
      if (DO_QK) { kf1 = KFR(9); X0 = __builtin_amdgcn_mfma_f32_32x32x16_bf16(kf2, qr[3], X0, 0, 0, 0); } if (DO_FIN) { Y1[8] = EX2(Y1[8]); Y1[9] = EX2(Y1[9]); Y1[10] = EX2(Y1[10]); Y1[11] = EX2(Y1[11]); PKA(Y0, 8); } SBAR(); \
      if (DO_QK) { kf2 = KFR(10); X1 = __builtin_amdgcn_mfma_f32_32x32x16_bf16(kf3, qr[3], X1, 0, 0, 0); } if (DO_FIN) { Y1[12] = EX2(Y1[12]); Y1[13] = EX2(Y1[13]); Y1[14] = EX2(Y1[14]); Y1[15] = EX2(Y1[15]); PKB(Y0, 8, pa1); } SBAR(); \
      if (DO_QK) { kf3 = KFR(11); X0 = __builtin_amdgcn_mfma_f32_32x32x16_bf16(kf0, qr[4], X0, 0, 0, 0); } if (DO_FIN) { PKA(Y1, 0); } SBAR(); \
      if (DO_QK) { X1 = __builtin_amdgcn_mfma_f32_32x32x16_bf16(kf1, qr[4], X1, 0, 0, 0); } if (DO_FIN) { PKB(Y1, 0, pa2); } SBAR(); \
      if (DO_QK) { X0 = __builtin_amdgcn_mfma_f32_32x32x16_bf16(kf2, qr[5], X0, 0, 0, 0); } if (DO_FIN) { PKA(Y1, 8); } SBAR(); \
      if (DO_QK) { X1 = __builtin_amdgcn_mfma_f32_32x32x16_bf16(kf3, qr[5], X1, 0, 0, 0); } if (DO_FIN) { PKB(Y1, 8, pa3); } SBAR(); \
  } while (0)
#define R2(DO_PV, DO_MAX, X0, X1, Y0, Y1, VSLOT, LOADS) do { const int vbq = vb0 + (VSLOT) * SHM_V; float ma_ = 0.f, mb_ = 0.f, sa_ = 0.f; \
    if (DO_PV) { VRD8(0); } SBAR(); \
    if (DO_PV) { VWAIT(); o[0] = __builtin_amdgcn_mfma_f32_32x32x16_bf16(pa0, VFR(0), o[0], 0, 0, 0); sa_ = (Y0[0] + Y0[1]) + (Y0[2] + Y0[3]); } SBAR(); \
    if (DO_PV) { o[0] = __builtin_amdgcn_mfma_f32_32x32x16_bf16(pa1, VFR(1), o[0], 0, 0, 0); sa_ += Y0[4]; sa_ += Y0[5]; sa_ += Y0[6]; sa_ += Y0[7]; } LOADS; SBAR(); \
    if (DO_PV) { o[0] = __builtin_amdgcn_mfma_f32_32x32x16_bf16(pa2, VFR(2), o[0], 0, 0, 0); sa_ += Y0[8]; sa_ += Y0[9]; sa_ += Y0[10]; sa_ += Y0[11]; } SBAR(); \
    if (DO_PV) { o[0] = __builtin_amdgcn_mfma_f32_32x32x16_bf16(pa3, VFR(3), o[0], 0, 0, 0); sa_ += Y0[12]; sa_ += Y0[13]; sa_ += Y0[14]; sa_ += Y0[15]; } SBAR(); \
    if (DO_PV) { VRD8(1); sa_ += Y1[0]; sa_ += Y1[1]; sa_ += Y1[2]; sa_ += Y1[3]; sa_ += Y1[4]; sa_ += Y1[5]; sa_ += Y1[6]; sa_ += Y1[7]; } \
    if (DO_MAX) { ma_ = MX3(X0[0], X0[1], X1[0]); mb_ = MX3(X0[2], X0[3], X1[1]); ma_ = MX3(ma_, X1[2], X1[3]); ma_ = MX3(ma_, X0[4], X0[5]); mb_ = MX3(mb_, X0[6], X0[7]); ma_ = MX3(ma_, X1[4], X1[5]); mb_ = MX3(mb_, X1[6], X1[7]); } SBAR(); \
    if (DO_PV) { VWAIT(); o[1] = __builtin_amdgcn_mfma_f32_32x32x16_bf16(pa0, VFR(0), o[1], 0, 0, 0); sa_ += Y1[8]; sa_ += Y1[9]; sa_ += Y1[10]; sa_ += Y1[11]; } if (DO_MAX) { ma_ = MX3(ma_, X0[8], X0[9]); mb_ = MX3(mb_, X0[10], X0[11]); } SBAR(); \
    if (DO_PV) { o[1] = __builtin_amdgcn_mfma_f32_32x32x16_bf16(pa1, VFR(1), o[1], 0, 0, 0); sa_ += Y1[12]; sa_ += Y1[13]; sa_ += Y1[14]; sa_ += Y1[15]; } if (DO_MAX) { ma_ = MX3(ma_, X1[8], X1[9]); mb_ = MX3(mb_, X1[10], X1[11]); } SBAR(); \
    if (DO_PV) { o[1] = __builtin_amdgcn_mfma_f32_32x32x16_bf16(pa2, VFR(2), o[1], 0, 0, 0); l_reg += sa_; } if (DO_MAX) { ma_ = MX3(ma_, X0[12], X0[13]); mb_ = MX3(mb_, X0[14], X0[15]); ma_ = MX3(ma_, X1[12], X1[13]); mb_ = MX3(mb_, X1[14], X1[15]); } SBAR(); \
    if (DO_PV) { o[1] = __builtin_amdgcn_mfma_f32_32x32x16_bf16(pa3, VFR(3), o[1], 0, 0, 0); } if (DO_MAX) { float m_ = __builtin_fmaxf(ma_, mb_); auto rr_ = __builtin_amdgcn_permlane32_swap(__float_as_uint(m_), __float_as_uint(m_), false, false); pmax = __builtin_fmaxf(__uint_as_float(rr_[0]), __uint_as_float(rr_[1])); } SBAR(); \
  } while (0)
#define DECIDE(FIRST, X0, X1) do { alpha = 1.f; \
    if ((FIRST) || !__builtin_expect(__all(pmax <= THRL), 1)) { const float d_ = (FIRST) ? pmax : __builtin_fmaxf(pmax, 0.f); m_reg += d_; if (!(FIRST)) alpha = EX2(-d_); \
      _Pragma("unroll") for (int r = 0; r < 16; ++r) { X0[r] -= d_; X1[r] -= d_; } \
      _Pragma("unroll") for (int r = 0; r < 16; ++r) negm[r] = -m_reg; l_reg *= alpha; } \
    RESC(alpha); } while (0)
  int sp_ = 0, sc_ = 0, sn_ = 1;
#define ROT() do { sp_ = sc_; sc_ = sn_; sn_ = (sn_ == NSLOT - 1) ? 0 : sn_ + 1; } while (0)
  SLOAD(SE, 0); asm volatile("s_waitcnt vmcnt(0)" ::: "memory"); SWRITE(0, SE); __syncthreads();
  R1(true, false, pA0, pA1, pB0, pB1, 0);
  R2(false, true, pA0, pA1, pB0, pB1, 0, (void)0);
  DECIDE(true, pA0, pA1);
  SLOAD(SO, KVBLK); SLOAD(SE, 2 * KVBLK);
  SWAIT(); SWRITE(1, SO); __syncthreads();
  ROT();
  for (int j = 1; j + 1 < NTL; j += 2) {
    R1(true, true, pB0, pB1, pA0, pA1, sc_);
    R2(true, true, pB0, pB1, pA0, pA1, sp_, SLOAD(SO, (j + 2) * KVBLK));
    DECIDE(false, pB0, pB1);
    SWAIT(); SWRITE(sn_, SE);
    __syncthreads(); ROT();
    R1(true, true, pA0, pA1, pB0, pB1, sc_);
    R2(true, true, pA0, pA1, pB0, pB1, sp_, if (j + 3 < NTL) SLOAD(SE, (j + 3) * KVBLK));
    DECIDE(false, pA0, pA1);
    SWAIT(); SWRITE(sn_, SO);
    __syncthreads(); ROT();
  }
  R1(true, true, pB0, pB1, pA0, pA1, sc_);
  R2(true, true, pB0, pB1, pA0, pA1, sp_, (void)0);
  DECIDE(false, pB0, pB1);
  R1(false, true, pA0, pA1, pB0, pB1, sc_);
  R2(true, false, pA0, pA1, pB0, pB1, sc_, (void)0);
#undef ROT
#undef DECIDE
#undef R2
#undef R1
#undef PKA
#undef PKB
#undef VFR
#undef VWAIT
#undef VRD8
#undef KFR
  { auto rr = __builtin_amdgcn_permlane32_swap(__float_as_uint(l_reg), __float_as_uint(l_reg), false, false); l_reg = __uint_as_float(rr[0]) + __uint_as_float(rr[1]); }
  if (hi == 0) li_l[r32] = l_reg; asm volatile("s_waitcnt lgkmcnt(0)" ::: "memory");
  const float g0 = gain[r32], g1 = gain[32 + r32]; const int ln_ = hw_lane();
  GAS bf16* Ow = Mo + (long)(wid * QBLK) * D;
#pragma unroll
  for (int r = 0; r < 16; ++r) { const int orow = crow(r, hi); const float rl = __builtin_amdgcn_rcpf(li_l[orow]);
    const float y0 = o[0][r] * rl, y1 = o[1][r] * rl; float s = y0 * y0 + y1 * y1;
    s += shx(s, ln_, 1); s += shx(s, ln_, 2); s += shx(s, ln_, 4); s += shx(s, ln_, 8); s += shx(s, ln_, 16);
    const float rs = 1.0f / sqrtf(s * (1.0f / 64.0f) + EPS);
    Ow[(long)orow * D + r32] = f2bf(y0 * rs * g0); Ow[(long)orow * D + 32 + r32] = f2bf(y1 * rs * g1); }
  __syncthreads();
#undef SLOAD
#undef SWRITE
#undef SWAIT
#undef RESC
}
#undef EX2
#undef MX3
#undef KSWZ
#undef SBAR
}
#define XB_TMO      128
#define XB_XCNT(j)  (256  + 64 * (j))
#define XB_XSUB(j)  (1280 + 64 * (j))
#define XB_XGEN(j)  (2304 + 64 * (j))
#define XB_TOP      3328
#define XB_TOPGEN   3392
#define XCD_BAR_WORDS 3456
#define XB_SPIN_CAP (1u << 18)

__device__ __forceinline__ unsigned xb_ld(unsigned* p)              { return __hip_atomic_load(p, __ATOMIC_RELAXED, __HIP_MEMORY_SCOPE_AGENT); }
__device__ __forceinline__ unsigned xb_add(unsigned* p, unsigned v) { return __hip_atomic_fetch_add(p, v, __ATOMIC_RELAXED, __HIP_MEMORY_SCOPE_AGENT); }
__device__ __forceinline__ unsigned xb_xcc_id() { return (unsigned)__builtin_amdgcn_s_getreg((3 << 11) | 20) & 0xFu; }
#define XB_SPIN(cond, bar) do { unsigned _sp = 0; while (cond) { __builtin_amdgcn_s_sleep(1); \
    if ((++_sp & 255u) == 0u) { if (xb_ld(&(bar)[XB_TMO])) break; if (_sp > XB_SPIN_CAP) { atomicAdd(&(bar)[XB_TMO], 1u); break; } } } } while (0)

struct XcdBarrier {
    unsigned* bar; unsigned x;
    volatile LAS unsigned* st;
};

__device__ __forceinline__ XcdBarrier xcd_barrier_post(unsigned* bar, volatile LAS unsigned* st, const bool t0) {
    XcdBarrier b; b.bar = bar; b.x = xb_xcc_id(); b.st = st;
    if (t0) (void)xb_add(&bar[XB_XCNT(b.x)], 1u);
    return b;
}
__device__ __forceinline__ void xcd_barrier_complete(unsigned* bar, unsigned x, unsigned& nloc, unsigned& nx) {
    const unsigned G = gridDim.x * gridDim.y * gridDim.z;
    unsigned sum, cnt, mine, sp = 0u;
    for (;;) {
        sum = 0u; cnt = 0u; mine = 0u;
#pragma unroll
        for (unsigned j = 0; j < 16; ++j) { const unsigned c = xb_ld(&bar[XB_XCNT(j)]); sum += c; cnt += (c > 0u) ? 1u : 0u; mine = (j == x) ? c : mine; }
        if (sum == G) break;
        __builtin_amdgcn_s_sleep(1);
        if ((++sp & 255u) == 0u) { if (xb_ld(&bar[XB_TMO])) break; if (sp > XB_SPIN_CAP) { atomicAdd(&bar[XB_TMO], 1u); break; } }
    }
    nloc = mine > 0u ? mine : 1u; nx = cnt > 0u ? cnt : 1u;
}

__device__ __forceinline__ void xcd_barrier(const XcdBarrier& b, const bool t0) {
    asm volatile("s_waitcnt vmcnt(0)" ::: "memory");
    __syncthreads();
    if (t0) {
        unsigned* bar = b.bar;
        __builtin_amdgcn_s_waitcnt(0);
        unsigned nloc = b.st[0], nx = b.st[1];
        if (nloc == 0u) { xcd_barrier_complete(bar, b.x, nloc, nx); b.st[0] = nloc; b.st[1] = nx; }
        const unsigned old = xb_add(&bar[XB_XSUB(b.x)], 1u);
        const unsigned gen = old / nloc;
        if (old + 1u == (gen + 1u) * nloc) {
            __builtin_amdgcn_fence(__ATOMIC_RELEASE, "agent");
            asm volatile("s_waitcnt vmcnt(0)" ::: "memory");
            const unsigned og = xb_add(&bar[XB_TOP], 1u);
            const unsigned tg = og / nx;
            if (og + 1u == (tg + 1u) * nx) xb_add(&bar[XB_TOPGEN], 1u);
            else XB_SPIN(xb_ld(&bar[XB_TOPGEN]) == tg, bar);
            __builtin_amdgcn_fence(__ATOMIC_ACQUIRE, "agent");
            xb_add(&bar[XB_XGEN(b.x)], 1u);
            asm volatile("s_waitcnt vmcnt(0)" ::: "memory");
        } else {
            XB_SPIN(xb_ld(&bar[XB_XGEN(b.x)]) == gen, bar);
            __builtin_amdgcn_fence(__ATOMIC_ACQUIRE, "agent");
            asm volatile("s_waitcnt vmcnt(0)" ::: "memory");
        }
    }
    __syncthreads();
}

__device__ __forceinline__ void xcd_barrier_fast(const XcdBarrier& b, const bool t0) {
    asm volatile("s_waitcnt vmcnt(0)" ::: "memory");
    __syncthreads();
    if (t0) {
        unsigned* bar = b.bar; asm volatile("" : "+s"(bar));
        __builtin_amdgcn_s_waitcnt(0);
        unsigned nloc = b.st[0], nx = b.st[1];
        unsigned bx_ = b.x; asm volatile("" : "+s"(bx_));
        const unsigned old = xb_add(&bar[XB_XSUB(bx_)], 1u);
        const unsigned gen = old / nloc;
        if (old + 1u == (gen + 1u) * nloc) {
            __builtin_amdgcn_fence(__ATOMIC_RELEASE, "agent");
            asm volatile("s_waitcnt vmcnt(0)" ::: "memory");
            const unsigned og = xb_add(&bar[XB_TOP], 1u);
            const unsigned tg = og / nx;
            if (og + 1u == (tg + 1u) * nx) xb_add(&bar[XB_TOPGEN], 1u);
            else XB_SPIN(xb_ld(&bar[XB_TOPGEN]) == tg, bar);
            __builtin_amdgcn_fence(__ATOMIC_ACQUIRE, "agent");
            xb_add(&bar[XB_XGEN(bx_)], 1u);
            asm volatile("s_waitcnt vmcnt(0)" ::: "memory");
        } else {
            XB_SPIN(xb_ld(&bar[XB_XGEN(bx_)]) == gen, bar);
            __builtin_amdgcn_fence(__ATOMIC_ACQUIRE, "agent");
            asm volatile("s_waitcnt vmcnt(0)" ::: "memory");
        }
    }
    __syncthreads();
}

constexpr int CW_BAR = 4096;
struct Args { const float* in[26]; float* out; unsigned char* ws; };
#ifndef REP_ATT
#define REP_ATT 1
#endif
#ifndef REP_GEMM
#define REP_GEMM 1
#endif
#ifndef REP_HY
#define REP_HY 1
#endif
#ifndef REP_FILT
#define REP_FILT 1
#endif
#ifndef REP_MISC
#define REP_MISC 1
#endif
#ifndef PROBE_MASK
#define PROBE_MASK 0
#endif
#define TIC() do { if (PROBE_MASK) pr_t0 = __builtin_amdgcn_s_memrealtime(); } while (0)
#define TOC(ph) do { if (PROBE_MASK & (1u << (ph))) pr_acc += __builtin_amdgcn_s_memrealtime() - pr_t0; } while (0)
#define REPEAT(n) _Pragma("unroll 1") for (int rep_ = 0; rep_ < (n); ++rep_)
#define REFRESH() do { const int t_ = tid_from_wave(F.wave0); F.tid = t_; F.lane = t_ & 63; F.wave = __builtin_amdgcn_readfirstlane(t_ >> 6); int v_ = F.vcu; asm volatile("" : "+s"(v_)); F.vcu = v_; } while (0)
#define BXQ() ({ int b_ = (int)blockIdx.x; asm volatile("" : "+s"(b_)); b_; })
#define GEMM_PHASE(EPI, g, S, E) REPEAT(REP_GEMM) pg8::gemm_phase<EPI, pg8::StaticOrder, true, true>(F.lds + RING_OFF, g, S, E, F.wave0)

__global__ void __launch_bounds__(NTHR, 2) hyena_mla_fwd(Args args) {
    extern __shared__ __attribute__((aligned(16))) unsigned char lds[];
    Frame F;
    F.lds = (LAS unsigned char*)lds;
    F.MISC = (volatile LAS unsigned*)(F.lds + MISC_OFF);
    F.tid = threadIdx.x; F.lane = F.tid & 63; F.wave = __builtin_amdgcn_readfirstlane(F.tid >> 6); F.wave0 = F.wave;
    F.G = gridDim.x; { const int bx = blockIdx.x; F.vcu = (F.G % 8 == 0) ? (bx % 8) * (F.G / 8) + bx / 8 : bx; }
    F.ws = args.ws; F.out = args.out; F.ctl = (gu32*)(args.ws + WS_CTL);
    if (F.tid == 0) {
#pragma unroll
        for (int i = 0; i < 26; ++i) *(LAS unsigned long long*)(F.lds + PTRTAB_OFF + 8 * i) = (unsigned long long)args.in[i];
    }
    for (int u = F.tid; u < 512 / 4; u += NTHR) ((LAS unsigned*)(F.lds + LDSCTL_OFF))[u] = 0u;
    __syncthreads();
    XcdBarrier bar = xcd_barrier_post((unsigned*)(F.ctl + CW_BAR), F.MISC + 8, F.tid == 0);
    xcd_barrier(bar, F.tid == 0);
    unsigned long long pr_t0 = 0, pr_acc = 0; (void)pr_t0;
#pragma unroll 1
    for (int l = 0; l < DEPTH; ++l) {
        TIC();
        REPEAT(REP_MISC) { REFRESH(); phase_weights(F, l); }
        __syncthreads();
        REFRESH(); phase_filter_mlp(F, l);
        if (l == 0) { REFRESH(); phase_rope_tab(F); REFRESH(); phase_norm_first(F, 0, inp(F, I_NMIXPRE)); }
        { REFRESH(); xcd_barrier_fast(bar, F.tid == 0); } TOC(0); TIC();
        { unsigned char* w = (unsigned char*)wsq(F); pg8::Gemm g{(bf16*)(w + WS_W3T), (bf16*)(w + WS_H2), 2048, L, 128}; pg8::StaticOrder S; S.init(2048, L, F.G, BXQ());
          pg8::EpiTaps E{(float*)(w + WS_KT), (const float*)inp(F, I_DECAY) + (size_t)l * 2048}; GEMM_PHASE(pg8::EpiTaps, g, S, E); }
        { REFRESH(); xcd_barrier_fast(bar, F.tid == 0); } TOC(1); TIC();
        REPEAT(REP_FILT) { REFRESH(); phase_filter_fft(F, l); }
        { REFRESH(); xcd_barrier_fast(bar, F.tid == 0); } TOC(2); TIC();
        { unsigned char* w = (unsigned char*)wsq(F); bf16* WinT = (bf16*)(w + WS_WIN); bf16* XN = (bf16*)(w + WS_XN); bf16* UT = (bf16*)(w + WS_UT); bf16* CQKV = (bf16*)(w + WS_CQKV);
          { pg8::Gemm g{WinT, XN, HYP, M, D}; pg8::StaticOrder S; S.init(HYP, M, F.G, BXQ());
          pg8::EpiBf16<0> E{UT, M, nullptr, 0, 0, 1.f}; GEMM_PHASE(pg8::EpiBf16<0>, g, S, E); }
        { pg8::Gemm g{XN, WinT + (size_t)HYP * D, M, 512, D}; pg8::StaticOrder S; S.init(M, 512, F.G, (BXQ() + 128) % F.G);
          pg8::EpiBf16<0> E{CQKV, 512, nullptr, 0, 0, 1.f}; GEMM_PHASE(pg8::EpiBf16<0>, g, S, E); } }
        { REFRESH(); xcd_barrier_fast(bar, F.tid == 0); } TOC(3); TIC();
        REPEAT(REP_MISC) { REFRESH(); phase_mla_prep(F, l); }
        REPEAT(REP_HY) { REFRESH(); phase_hyena(F, l); }
        { REFRESH(); xcd_barrier_fast(bar, F.tid == 0); } TOC(4); TIC();
        { unsigned char* w = (unsigned char*)wsq(F); bf16* CQN = (bf16*)(w + WS_CQN); bf16* CKVN = (bf16*)(w + WS_CKVN); bf16* WuqT = (bf16*)(w + WS_WUQ); bf16* WukvT = (bf16*)(w + WS_WUKV);
          bf16* Qb = (bf16*)(w + WS_Q); bf16* KV = (bf16*)(w + WS_KN);
          { pg8::Gemm g{CQN, WuqT, M, NQ, QR}; pg8::StaticOrder S; S.init(M, NQ, F.G, BXQ());
          pg8::EpiBf16<0> E{Qb, NQ, nullptr, 0, 0, 1.f}; GEMM_PHASE(pg8::EpiBf16<0>, g, S, E); }
        { pg8::Gemm g{CKVN, WukvT, M, NKV, KVR}; pg8::StaticOrder S; S.init(M, NKV, F.G, BXQ());
          pg8::EpiBf16<0> E{KV, NKV, nullptr, 0, 0, 1.f}; GEMM_PHASE(pg8::EpiBf16<0>, g, S, E); } }
        { REFRESH(); xcd_barrier_fast(bar, F.tid == 0); } TOC(5); TIC();
        REFRESH();
        { unsigned char* w = (unsigned char*)wsq(F); bf16* Qb = (bf16*)(w + WS_Q); bf16* KV = (bf16*)(w + WS_KN); bf16* KPE = (bf16*)(w + WS_KPE); bf16* MIX = (bf16*)(w + WS_MIX);
          const float* ct = (const float*)(w + WS_COS); const float* st = (const float*)(w + WS_SIN); const float* gat = (const float*)inp(F, I_GNAT) + l * 512;
        REPEAT(REP_ATT) for (int i = 0; i < (F.G == 256 ? 6 : (1536 - F.vcu + F.G - 1) / F.G); ++i) {
            const int u_ = F.vcu + i * F.G; const int bh = F.G == 256 ? 3 * (F.vcu >> 5) + (i >> 1) : u_ >> 6, qb = F.G == 256 ? (i & 1) * 32 + (F.vcu & 31) : u_ & 63; const int b = bh >> 3, h = bh & 7;
            const size_t row0 = (size_t)b * L + (size_t)qb * 256;
            att::attn_unit(Qb + row0 * NQ + h * DQ, KV + (size_t)b * L * NKV + h * 128, KPE + (size_t)b * L * ROPE, KV + (size_t)b * L * NKV + h * 128 + 64,
                           MIX + row0 * D + 512 + h * 64, gat + h * 64, ct, st, qb * 256, (LAS char*)(F.lds + RING_OFF), F.wave0);
        } }
        REPEAT(REP_MISC) { REFRESH(); phase_hy_out(F, l); }
        { REFRESH(); xcd_barrier_fast(bar, F.tid == 0); } TOC(6); TIC();
        { unsigned char* w = (unsigned char*)wsq(F); bf16* MIX = (bf16*)(w + WS_MIX); bf16* WoutT = (bf16*)(w + WS_WOUT); bf16* T = (bf16*)(w + WS_T);
          pg8::Gemm g{MIX, WoutT, M, D, D}; pg8::StaticOrder S; S.init(M, D, F.G, BXQ());
          pg8::EpiBf16<0> E{T, D, nullptr, 0, 0, 1.f}; GEMM_PHASE(pg8::EpiBf16<0>, g, S, E); }
        { REFRESH(); xcd_barrier_fast(bar, F.tid == 0); } TOC(7); TIC();
        REFRESH(); phase_norm_res(F, l, (const GAS bf16*)(wsq(F) + WS_T), inp(F, I_NMIXPOST) + l * D, inp(F, I_NMLPPRE) + l * D);
        { REFRESH(); xcd_barrier_fast(bar, F.tid == 0); } TOC(8); TIC();
#pragma unroll 1
        for (int ch = 0; ch < N_MLP_CHUNKS; ++ch) {
            { unsigned char* w = (unsigned char*)wsq(F); bf16* XN = (bf16*)(w + WS_XN); bf16* WupT = (bf16*)(w + WS_WUP); bf16* Hb = (bf16*)(w + WS_H);
              pg8::Gemm g{XN + (size_t)ch * MLP_CHUNK * D, WupT, MLP_CHUNK, FF, D}; pg8::StaticOrder S; S.init(MLP_CHUNK, FF, F.G, BXQ());
              pg8::EpiRelu2 E{Hb, FF}; GEMM_PHASE(pg8::EpiRelu2, g, S, E); }
            { REFRESH(); xcd_barrier_fast(bar, F.tid == 0); } TOC(9); TIC();
            { unsigned char* w = (unsigned char*)wsq(F); bf16* Hb = (bf16*)(w + WS_H); bf16* WdownT = (bf16*)(w + WS_WDOWN); bf16* T = (bf16*)(w + WS_T);
              pg8::Gemm g{Hb, WdownT, MLP_CHUNK, D, FF}; pg8::StaticOrder S; S.init(MLP_CHUNK, D, F.G, BXQ());
              pg8::EpiBf16<0> E{T + (size_t)ch * MLP_CHUNK * D, D, nullptr, 0, 0, 1.f}; GEMM_PHASE(pg8::EpiBf16<0>, g, S, E); }
            { REFRESH(); xcd_barrier_fast(bar, F.tid == 0); } TOC(10); TIC();
        }
        REFRESH(); phase_norm_res(F, 1, (const GAS bf16*)(wsq(F) + WS_T), inp(F, I_NMLPPOST) + l * D, (l + 1 < DEPTH) ? inp(F, I_NMIXPRE) + (l + 1) * D : (const GAS float*)nullptr);
        { REFRESH(); xcd_barrier_fast(bar, F.tid == 0); } TOC(11); TIC();
    }
    if (PROBE_MASK) { const unsigned long long ts = __builtin_amdgcn_s_memrealtime(); while (__builtin_amdgcn_s_memrealtime() - ts < pr_acc) __builtin_amdgcn_s_sleep(8); }
}

extern "C" void kernel_launch(void* const* d_in, const int* in_sizes, int n_in, void* d_out, int out_size, void* d_ws, size_t ws_size, hipStream_t stream) {
    static int grid = 0;
    if (grid == 0) {
        if (n_in != 26 || out_size != M * D || ws_size < WS_END) { fprintf(stderr, "kernel_launch: shape mismatch n_in %d out %d ws %zu (need %zu)\n", n_in, out_size, ws_size, (size_t)WS_END); grid = -1; return; }
        int dev = 0, cus = 0, per_cu = 0;
        if (hipGetDevice(&dev) != hipSuccess || hipDeviceGetAttribute(&cus, hipDeviceAttributeMultiprocessorCount, dev) != hipSuccess) { grid = -1; return; }
        if (hipFuncSetAttribute((const void*)hyena_mla_fwd, hipFuncAttributeMaxDynamicSharedMemorySize, LDS_BYTES) != hipSuccess) { fprintf(stderr, "kernel_launch: hipFuncSetAttribute failed\n"); grid = -1; return; }
        if (hipOccupancyMaxActiveBlocksPerMultiprocessor(&per_cu, (const void*)hyena_mla_fwd, NTHR, LDS_BYTES) != hipSuccess || per_cu < 1) fprintf(stderr, "kernel_launch: occupancy query says %d\n", per_cu);
        (void)hipGetLastError();
        grid = cus;
    }
    if (grid < 0) return;
    if (hipMemsetAsync((char*)d_ws + WS_CTL, 0, CTL_ZERO_BYTES, stream) != hipSuccess) { fprintf(stderr, "kernel_launch: memset failed\n"); return; }
    Args a{};
    for (int i = 0; i < 26; ++i) a.in[i] = (const float*)d_in[i];
    a.out = (float*)d_out; a.ws = (unsigned char*)d_ws;
    hipLaunchKernelGGL(hyena_mla_fwd, dim3(grid), dim3(NTHR), LDS_BYTES, stream, a);
    const hipError_t le = hipPeekAtLastError();
    if (le != hipSuccess) fprintf(stderr, "kernel_launch: launch failed: %s\n", hipGetErrorName(le));
}
```

```cpp
#include <hip/hip_runtime.h>
#include <cstdio>
#include <cstdint>
__device__ __forceinline__ int hw_lane() { int l; asm volatile("v_mbcnt_lo_u32_b32 %0, -1, 0\n\tv_mbcnt_hi_u32_b32 %0, -1, %0" : "=v"(l)); return l; }
__device__ __forceinline__ int tid_from_wave(int wave0) { int w = wave0; asm volatile("" : "+s"(w)); int t = w * 64 + hw_lane(); asm volatile("" : "+v"(t)); return t; }
namespace pg8 {
#define PG8_LAS __attribute__((address_space(3)))
#define PG8_GAS __attribute__((address_space(1)))
typedef unsigned short bf16_t;
typedef short bf16x8 __attribute__((ext_vector_type(8)));
typedef float f32x4 __attribute__((ext_vector_type(4)));
typedef unsigned u32x4 __attribute__((ext_vector_type(4)));
constexpr int BM = 256, BK = 64, HALF = 128, HTB = HALF * BK * 2  , STAGE_BYTES = 8 * HTB, NXCD = 8, WGM = 8;

__host__ __device__ __forceinline__ int lds_byte(int r, int c) { const int st = (r >> 4) * 2 + (c >> 5), rr = r & 15, cc = c & 31, ob = rr * 64 + cc * 2; return st * 1024 + (ob ^ (((ob >> 9) & 1) << 5)); }
__host__ __device__ __forceinline__ void stage_rc(int b, int& R, int& C) { const int st = b / 1024, sb = b % 1024, swz = sb ^ (((sb >> 9) & 1) << 5); R = (st >> 1) * 16 + swz / 64; C = (st & 1) * 32 + (swz % 64) / 2; }
__host__ __device__ __forceinline__ int perm32(int rho) { const int n = rho >> 4, i = rho & 15; return 8 * (i >> 2) + 4 * n + (i & 3); }

struct Unit { int pm, pn; };
struct Gemm { const bf16_t* A; const bf16_t* Bt; int M, N, K; };

struct StaticOrder {
    int nM, nN, nwg, G, c;
    __host__ __device__ void init(int M, int N, int G_, int c_) { nM = M / BM; nN = N / BM; nwg = nM * nN; G = G_; c = c_; }
    __host__ __device__ bool next(int i, Unit& u) const {
        const long L = (long)i * G + c; if (L >= nwg) return false;
        int wgid = (int)L; { const int q = nwg / NXCD, r = nwg % NXCD, xcd = wgid % NXCD, off = wgid / NXCD; wgid = (xcd < r ? xcd * (q + 1) : r * (q + 1) + (xcd - r) * q) + off; }
        const int nig = WGM * nN, gid = wgid / nig, fm = gid * WGM, gsz = (nM - fm) < WGM ? (nM - fm) : WGM;
        u.pm = fm + ((wgid % nig) % gsz); u.pn = (wgid % nig) / gsz; return true;
    }
    __device__ __forceinline__ void a_ready(const Unit&) const {}
    __device__ __forceinline__ void done(const Unit&) const {}
};

__device__ __forceinline__ unsigned cvt_pk_bf16(float lo, float hi) { unsigned r; asm volatile("v_cvt_pk_bf16_f32 %0, %1, %2" : "=v"(r) : "v"(lo), "v"(hi)); return r; }
typedef float f32x2 __attribute__((ext_vector_type(2)));
__device__ __forceinline__ void relane(int& wr, int& wc, int& fr, int& fq) { int l = hw_lane(); asm volatile("" : "+v"(l)); fr = l & 15; fq = l >> 4; (void)wr; (void)wc; }
__device__ __forceinline__ f32x2 gelu_pk(f32x2 v) {
    const f32x2 av = __builtin_elementwise_abs(v), d = av * 0.2316418882f + 1.0f;
    f32x2 t; t.x = __builtin_amdgcn_rcpf(d.x); t.y = __builtin_amdgcn_rcpf(d.y);
    f32x2 q = t * 0.5307027145f + (-0.7265760135f); q = q * t + 0.7107068705f; q = q * t + (-0.142248368f); q = q * t + 0.127414796f; q = q * t;
    const f32x2 s = (v * v) * (-0.72134752044f);
    f32x2 e; e.x = __builtin_amdgcn_exp2f(s.x); e.y = __builtin_amdgcn_exp2f(s.y);
    const f32x2 m = v * (q * e), r = v - m;
    f32x2 o; o.x = v.x < 0.f ? m.x : r.x; o.y = v.y < 0.f ? m.y : r.y; return o;
}

template <int ACT  > struct EpiBf16 {
    static constexpr bool PERM = true, AFTER_DRAIN = false; static_assert(ACT == 0 || ACT == 1, "EpiBf16: ACT is 0 (none) or 1 (gelu_pk)");
    bf16_t* O; int ldc; const float* bias; int split_cols; size_t split_stride; float scale0;
    __device__ __forceinline__ void operator()(const f32x4 (&acc)[2][2][4][2], const Unit& u, int wr, int wc, int fr, int fq) const {
        relane(wr, wc, fr, fq);
        const int row0 = u.pm * BM + wr * 64 + fr; int colt = u.pn * BM; bf16_t* base = O;
        float sc = 1.f; if (split_cols) { const int t = colt / split_cols; base += (size_t)t * split_stride; colt -= t * split_cols; if (t == 0) sc = scale0; }
        const int col0 = colt + wc * 32 + 8 * fq, bcol0 = u.pn * BM + wc * 32 + 8 * fq;
        f32x4 bv[2][2];
#pragma unroll
        for (int bj = 0; bj < 2; ++bj)
#pragma unroll
            for (int n = 0; n < 2; ++n) bv[bj][n] = bias ? *(const PG8_GAS f32x4*)(bias + bcol0 + bj * HALF + 4 * n) : (f32x4){0.f, 0.f, 0.f, 0.f};
#pragma unroll
        for (int ai = 0; ai < 2; ++ai)
#pragma unroll
            for (int m = 0; m < 4; ++m) { bf16_t* rowp = base + (size_t)(row0 + ai * HALF + m * 16) * ldc + col0;
#pragma unroll
                for (int bj = 0; bj < 2; ++bj) { f32x4 v0 = acc[ai][bj][m][0] + bv[bj][0], v1 = acc[ai][bj][m][1] + bv[bj][1];
                    if (ACT == 1) { f32x2 a = gelu_pk((f32x2){v0[0], v0[1]}), b = gelu_pk((f32x2){v0[2], v0[3]}), c = gelu_pk((f32x2){v1[0], v1[1]}), d = gelu_pk((f32x2){v1[2], v1[3]});
                        v0 = (f32x4){a.x, a.y, b.x, b.y}; v1 = (f32x4){c.x, c.y, d.x, d.y}; }
                    v0 = v0 * sc; v1 = v1 * sc; u32x4 w; w.x = cvt_pk_bf16(v0[0], v0[1]); w.y = cvt_pk_bf16(v0[2], v0[3]); w.z = cvt_pk_bf16(v1[0], v1[1]); w.w = cvt_pk_bf16(v1[2], v1[3]);
                    *(PG8_GAS u32x4*)(rowp + bj * HALF) = w; } }
    }
};

struct PanelStats {
    unsigned* xbuf;
    unsigned* cnt;
    unsigned* tmo;
    int ntn; float eps;
    unsigned code;
    __device__ __forceinline__ bool run(const f32x4 (&v)[2][2][4][2], const Unit& u, int wr, int wc, int fr, int fq, PG8_LAS unsigned char* lds, int wid, int lane) const {
        typedef float f32x2v __attribute__((ext_vector_type(2)));
        PG8_LAS f32x2v* P = (PG8_LAS f32x2v*)lds;
        PG8_LAS f32x2v* S = (PG8_LAS f32x2v*)(lds + 8192);
        PG8_LAS unsigned* flag = (PG8_LAS unsigned*)(lds + 8192 + 2048);
#pragma unroll
        for (int ai = 0; ai < 2; ++ai)
#pragma unroll
            for (int m = 0; m < 4; ++m) {
                float s = 0.f;
#pragma unroll
                for (int bj = 0; bj < 2; ++bj)
#pragma unroll
                    for (int n = 0; n < 2; ++n) { const f32x4 x = v[ai][bj][m][n]; s += (x[0] + x[1]) + (x[2] + x[3]); }
                s += __shfl_xor(s, 16); s += __shfl_xor(s, 32);
                const float mw = s * (1.0f / 64.0f); float q = 0.f;
#pragma unroll
                for (int bj = 0; bj < 2; ++bj)
#pragma unroll
                    for (int n = 0; n < 2; ++n) { const f32x4 d = v[ai][bj][m][n] - mw; q += (d[0] * d[0] + d[1] * d[1]) + (d[2] * d[2] + d[3] * d[3]); }
                q += __shfl_xor(q, 16); q += __shfl_xor(q, 32);
                if (fq == 0) P[(ai * HALF + wr * 64 + m * 16 + fr) * 4 + wc] = (f32x2v){mw, q};
            }
        asm volatile("s_waitcnt lgkmcnt(0)" ::: "memory"); __builtin_amdgcn_s_barrier(); asm volatile("" ::: "memory");
#if defined(BROKEN_EXCHANGE_NO_WAIT)
#warning BROKEN CONTROL BUILD: the row-statistics exchange does not wait; results are wrong by design
        if (blockIdx.x >= 64) { const long long t0_ = clock64(); while (clock64() - t0_ < 60000) __builtin_amdgcn_s_sleep(8); }
#endif
        const int row = wid * 32 + (lane & 31);
        if (lane < 32) {
            const f32x2v a = P[row * 4 + 0], b = P[row * 4 + 1], c = P[row * 4 + 2], d = P[row * 4 + 3];
            const float mt = (a.x + b.x + c.x + d.x) * 0.25f;
            const float da = a.x - mt, db = b.x - mt, dc = c.x - mt, dd = d.x - mt;
            const float m2 = (a.y + b.y) + (c.y + d.y) + 64.0f * ((da * da + db * db) + (dc * dc + dd * dd));
            unsigned long long* slot = (unsigned long long*)xbuf + ((size_t)(u.pm * BM + row) * 4 + u.pn);
            __hip_atomic_store(slot, ((unsigned long long)__float_as_uint(m2) << 32) | __float_as_uint(mt), __ATOMIC_RELAXED, __HIP_MEMORY_SCOPE_AGENT);
        }
        asm volatile("s_waitcnt vmcnt(0)" ::: "memory");
        if (lane == 0) __hip_atomic_fetch_add(cnt + 64 * u.pm, 1u, __ATOMIC_RELAXED, __HIP_MEMORY_SCOPE_AGENT);
        if (wid == 0) {
            bool dead = false; const unsigned long long t0 = __builtin_amdgcn_s_memrealtime(); const unsigned want = 8u * (unsigned)ntn;
            for (;;) {
#if defined(BROKEN_EXCHANGE_NO_WAIT)
                break;
#endif
                if ((unsigned)__builtin_amdgcn_readfirstlane(__hip_atomic_load(cnt + 64 * u.pm, __ATOMIC_RELAXED, __HIP_MEMORY_SCOPE_AGENT)) >= want) break;
                if (__builtin_amdgcn_s_memrealtime() - t0 > 2000000ull) {
                    if (lane == 0) { unsigned expect = 0u; __hip_atomic_compare_exchange_strong(tmo + 1, &expect, code | (unsigned)(u.pm & 0xff), __ATOMIC_RELAXED, __ATOMIC_RELAXED, __HIP_MEMORY_SCOPE_AGENT);
                                     __hip_atomic_store(tmo, 1u, __ATOMIC_RELAXED, __HIP_MEMORY_SCOPE_AGENT); }
                    dead = true; break; }
                __builtin_amdgcn_s_sleep(2);
            }
            __builtin_amdgcn_fence(__ATOMIC_ACQUIRE, "agent");
            if (lane == 0) flag[0] = dead ? 1u : 0u;
        }
        asm volatile("s_waitcnt vmcnt(0) lgkmcnt(0)" ::: "memory"); __builtin_amdgcn_s_barrier(); asm volatile("" ::: "memory");
        const bool bad = flag[0] != 0u;
        if (lane < 32) {
            const unsigned long long* slot = (const unsigned long long*)xbuf + (size_t)(u.pm * BM + row) * 4; float mt[4], m2[4]; float ms = 0.f;
#pragma unroll
            for (int t = 0; t < 4; ++t) { if (t < ntn) { const unsigned long long w = __hip_atomic_load(slot + t, __ATOMIC_RELAXED, __HIP_MEMORY_SCOPE_AGENT); mt[t] = __uint_as_float((unsigned)w); m2[t] = __uint_as_float((unsigned)(w >> 32)); } else { mt[t] = 0.f; m2[t] = 0.f; } ms += mt[t]; }
            const float mean = ms / (float)ntn; float q = 0.f;
#pragma unroll
            for (int t = 0; t < 4; ++t) if (t < ntn) { const float dm = mt[t] - mean; q += m2[t] + 256.0f * dm * dm; }
            S[row] = (f32x2v){mean, 1.0f / sqrtf(q / (256.0f * (float)ntn) + eps)};
        }
        asm volatile("s_waitcnt lgkmcnt(0)" ::: "memory"); __builtin_amdgcn_s_barrier(); asm volatile("" ::: "memory");
        return bad;
    }
};
struct EpiLnRes {
    static constexpr bool PERM = false, AFTER_DRAIN = true;
    const float* base; float* out; int ldc; const float* bias; PanelStats st; unsigned poison;
    __device__ __forceinline__ void fused(f32x4 (&acc)[2][2][4][2], const Unit& u, int wr, int wc, int fr, int fq, PG8_LAS unsigned char* lds, int wid, int lane) const {
        typedef float f32x2v __attribute__((ext_vector_type(2)));
        const PG8_LAS f32x2v* S = (const PG8_LAS f32x2v*)(lds + 8192);
        const int col0 = u.pn * BM + wc * 32 + 4 * fq;
#pragma unroll
        for (int bj = 0; bj < 2; ++bj)
#pragma unroll
            for (int n = 0; n < 2; ++n) { const f32x4 bv = bias ? *(const f32x4*)(bias + col0 + bj * HALF + n * 16) : (f32x4){0.f, 0.f, 0.f, 0.f};
#pragma unroll
                for (int ai = 0; ai < 2; ++ai)
#pragma unroll
                    for (int m = 0; m < 4; ++m) acc[ai][bj][m][n] += bv; }
        f32x4 pre[4][2][2];
#pragma unroll
        for (int m = 0; m < 4; ++m) { const size_t off = (size_t)(u.pm * BM + wr * 64 + m * 16 + fr) * ldc + col0;
#pragma unroll
            for (int bj = 0; bj < 2; ++bj)
#pragma unroll
                for (int n = 0; n < 2; ++n) pre[m][bj][n] = *(const f32x4*)(base + off + bj * HALF + n * 16); }
        const bool bad = st.run(acc, u, wr, wc, fr, fq, lds, wid, lane) || poison != 0u;
        const float qnan = __builtin_nanf("");
#pragma unroll
        for (int ai = 0; ai < 2; ++ai)
#pragma unroll
            for (int m = 0; m < 4; ++m) { const int r = ai * HALF + wr * 64 + m * 16 + fr; const f32x2v sr = S[r]; const size_t off = (size_t)(u.pm * BM + r) * ldc + col0;
#pragma unroll
                for (int bj = 0; bj < 2; ++bj)
#pragma unroll
                    for (int n = 0; n < 2; ++n) { const f32x4 bs = ai == 0 ? pre[m][bj][n] : *(const f32x4*)(base + off + bj * HALF + n * 16); f32x4 o = bs + (acc[ai][bj][m][n] - sr.x) * sr.y;
                        if (bad) o = (f32x4){qnan, qnan, qnan, qnan}; *(f32x4*)(out + off + bj * HALF + n * 16) = o; }
                if (m & 1) asm volatile("" ::: "memory"); }
    }
};
struct EpiLnResLn {
    static constexpr bool PERM = false, AFTER_DRAIN = true;
    const float* base; float* out; bf16_t* xn; int ldc; const float* bias; PanelStats st1, st2; unsigned poison;
    __device__ __forceinline__ void fused(f32x4 (&acc)[2][2][4][2], const Unit& u, int wr, int wc, int fr, int fq, PG8_LAS unsigned char* lds, int wid, int lane) const {
        typedef float f32x2v __attribute__((ext_vector_type(2))); typedef unsigned u32x2v __attribute__((ext_vector_type(2)));
        const PG8_LAS f32x2v* S = (const PG8_LAS f32x2v*)(lds + 8192);
        const int col0 = u.pn * BM + wc * 32 + 4 * fq;
#pragma unroll
        for (int bj = 0; bj < 2; ++bj)
#pragma unroll
            for (int n = 0; n < 2; ++n) { const f32x4 bv = bias ? *(const f32x4*)(bias + col0 + bj * HALF + n * 16) : (f32x4){0.f, 0.f, 0.f, 0.f};
#pragma unroll
                for (int ai = 0; ai < 2; ++ai)
#pragma unroll
                    for (int m = 0; m < 4; ++m) acc[ai][bj][m][n] += bv; }
        bool bad = st1.run(acc, u, wr, wc, fr, fq, lds, wid, lane) || poison != 0u;
        const float qnan = __builtin_nanf("");
#pragma unroll
        for (int ai = 0; ai < 2; ++ai)
#pragma unroll
            for (int m = 0; m < 4; ++m) { const int r = ai * HALF + wr * 64 + m * 16 + fr; const f32x2v sr = S[r]; const size_t off = (size_t)(u.pm * BM + r) * ldc + col0;
#pragma unroll
                for (int bj = 0; bj < 2; ++bj)
#pragma unroll
                    for (int n = 0; n < 2; ++n) { const f32x4 bs = *(const f32x4*)(base + off + bj * HALF + n * 16); acc[ai][bj][m][n] = bs + (acc[ai][bj][m][n] - sr.x) * sr.y; }
                asm volatile("" : "+v"(acc[ai][0][m][0]), "+v"(acc[ai][0][m][1]), "+v"(acc[ai][1][m][0]), "+v"(acc[ai][1][m][1]));
                if (m & 1) asm volatile("" ::: "memory"); }
        const bool bad1 = bad;
        bad = st2.run(acc, u, wr, wc, fr, fq, lds, wid, lane) || bad;
#pragma unroll
        for (int ai = 0; ai < 2; ++ai)
#pragma unroll
            for (int m = 0; m < 4; ++m) { const int r = ai * HALF + wr * 64 + m * 16 + fr; const f32x2v sr = S[r]; const size_t off = (size_t)(u.pm * BM + r) * ldc + col0;
#pragma unroll
                for (int bj = 0; bj < 2; ++bj)
#pragma unroll
                    for (int n = 0; n < 2; ++n) { const f32x4 x1 = acc[ai][bj][m][n]; *(f32x4*)(out + off + bj * HALF + n * 16) = bad1 ? (f32x4){qnan, qnan, qnan, qnan} : x1;
                        const f32x4 o = (x1 - sr.x) * sr.y; u32x2v w; w.x = cvt_pk_bf16(o[0], o[1]); w.y = cvt_pk_bf16(o[2], o[3]);
                        if (bad) { w.x = 0x7fc07fc0u; w.y = 0x7fc07fc0u; } *(u32x2v*)(xn + off + bj * HALF + n * 16) = w; }
                asm volatile("" ::: "memory"); }
    }
};

template <class Epi, class Sched, bool ALIGN_EPI = false, bool SP2 = false>
__device__ __forceinline__ void gemm_phase(PG8_LAS unsigned char* lds, const Gemm g, const Sched& S, const Epi& E, const int wave0) {
    int tid_ = tid_from_wave(wave0);
    const int tid = tid_, wid = __builtin_amdgcn_readfirstlane(tid >> 6), lane = tid & 63, wr = wid >> 2, wc = wid & 3, fr = lane & 15, fq = lane >> 4;
    const int K = g.K, nt = K / BK;
    unsigned voffA[2], voffB[2];
#pragma unroll
    for (int i = 0; i < 2; ++i) { int R, C; stage_rc(tid * 16 + i * 8192, R, C); const int Rb = Epi::PERM ? ((R & ~31) + perm32(R & 31)) : R;
        voffA[i] = (unsigned)(R * K + C) * 2u; voffB[i] = (unsigned)(Rb * K + C) * 2u; }
    const size_t kstep = (size_t)(BK * 2);
    const size_t hstep = (size_t)HALF * K * 2;
    const size_t tstep = 2 * hstep;
    const unsigned ldsw = (unsigned)wid * 1024u;
    const int aoff = lds_byte(wr * 64 + fr, fq * 8), boff = lds_byte(wc * 32 + fr, fq * 8);
#define PG8_SA(b, h) (((b) * 2 + (h)) * HTB)
#define PG8_SB(b, h) ((4 + (b) * 2 + (h)) * HTB)
#define PG8_STAGE(bufoff, gbase, voff) do { _Pragma("unroll") for (int _i = 0; _i < 2; ++_i) \
        __builtin_amdgcn_global_load_lds((const unsigned*)((const char*)(gbase) + (voff)[_i]), (PG8_LAS unsigned*)(lds + (bufoff) + ldsw + _i * 8192), 16, 0, 0); } while (0)
#define PG8_LDA(dst, b, h) do { _Pragma("unroll") for (int m = 0; m < 4; ++m) _Pragma("unroll") for (int k = 0; k < 2; ++k) dst[m][k] = *(const PG8_LAS bf16x8*)(lds + PG8_SA(b, h) + aoff + m * 2048 + k * 1024); } while (0)
#define PG8_LDB(dst, b, h) do { _Pragma("unroll") for (int n = 0; n < 2; ++n) _Pragma("unroll") for (int k = 0; k < 2; ++k) dst[n][k] = *(const PG8_LAS bf16x8*)(lds + PG8_SB(b, h) + boff + n * 2048 + k * 1024); } while (0)
#define PG8_MMA(ai, bj, At, Bt) do { __builtin_amdgcn_s_setprio(1); _Pragma("unroll") for (int m = 0; m < 4; ++m) _Pragma("unroll") for (int n = 0; n < 2; ++n) _Pragma("unroll") for (int k = 0; k < 2; ++k) \
        acc[ai][bj][m][n] = __builtin_amdgcn_mfma_f32_16x16x32_bf16(Bt[n][k], At[m][k], acc[ai][bj][m][n], 0, 0, 0); __builtin_amdgcn_s_setprio(0); } while (0)
#define PG8_WAIT_V(n) asm volatile("s_waitcnt vmcnt(" #n ")" ::: "memory")
#define PG8_WAIT_L(n) asm volatile("s_waitcnt lgkmcnt(" #n ")" ::: "memory")
#define PG8_BAR __builtin_amdgcn_s_barrier()
#define PG8_SCHED __builtin_amdgcn_sched_barrier(0)
    Unit cur, nxt; int ui = 0;
    if (!S.next(0, cur)) return;
    f32x4 acc[2][2][4][2];
#pragma unroll
    for (int a = 0; a < 2; ++a)
#pragma unroll
        for (int b = 0; b < 2; ++b)
#pragma unroll
            for (int m = 0; m < 4; ++m)
#pragma unroll
                for (int n = 0; n < 2; ++n) acc[a][b][m][n] = (f32x4){0.f, 0.f, 0.f, 0.f};
    bf16x8 At[4][2], B0[2][2], B1[2][2];
    const char* cA = (const char*)g.A + (size_t)cur.pm * tstep; const char* cB = (const char*)g.Bt + (size_t)cur.pn * tstep;
    S.a_ready(cur);
    if constexpr (SP2) {
        PG8_STAGE(PG8_SB(0, 0), cB, voffB); PG8_STAGE(PG8_SB(0, 1), cB + hstep, voffB); PG8_STAGE(PG8_SA(0, 0), cA, voffA); PG8_STAGE(PG8_SA(0, 1), cA + hstep, voffA);
        if (wr == 1) PG8_BAR;
        PG8_WAIT_V(2); PG8_BAR;
        PG8_STAGE(PG8_SB(1, 0), cB + kstep, voffB); PG8_STAGE(PG8_SA(1, 0), cA + kstep, voffA); PG8_STAGE(PG8_SB(1, 1), cB + hstep + kstep, voffB);
        PG8_WAIT_V(6); PG8_BAR;
    } else {
        PG8_STAGE(PG8_SB(0, 0), cB, voffB); PG8_STAGE(PG8_SA(0, 0), cA, voffA); PG8_STAGE(PG8_SB(0, 1), cB + hstep, voffB); PG8_STAGE(PG8_SA(0, 1), cA + hstep, voffA);
        if (wr == 1) PG8_BAR;
        PG8_WAIT_V(4); PG8_BAR;
        PG8_STAGE(PG8_SB(1, 0), cB + kstep, voffB); PG8_STAGE(PG8_SA(1, 0), cA + kstep, voffA); PG8_STAGE(PG8_SB(1, 1), cB + hstep + kstep, voffB);
        PG8_WAIT_V(6); PG8_BAR;
    }
    for (;;) {
        const bool has_next = S.next(ui + 1, nxt);
        const char* nA = has_next ? (const char*)g.A + (size_t)nxt.pm * tstep : cA; const char* nB = has_next ? (const char*)g.Bt + (size_t)nxt.pn * tstep : cB;
        for (int t = 0; t < nt; t += 2) {
            const bool last = (t == nt - 2);
            const char* a1 = cA + (size_t)(t + 1) * kstep;
            const char* a2 = last ? nA : cA + (size_t)(t + 2) * kstep; const char* b2 = last ? nB : cB + (size_t)(t + 2) * kstep;
            const char* a3 = a2 + kstep; const char* b3 = b2 + kstep;
            if (last && has_next) S.a_ready(nxt);
            if constexpr (SP2) {
            PG8_LDB(B0, 0, 0); PG8_LDB(B1, 0, 1); PG8_SCHED; PG8_LDA(At, 0, 0); PG8_STAGE(PG8_SA(1, 1), a1 + hstep, voffA);
            PG8_WAIT_V(8); PG8_WAIT_L(0); PG8_BAR; PG8_MMA(0, 0, At, B0); PG8_MMA(0, 1, At, B1); PG8_BAR; PG8_SCHED;
            PG8_LDA(At, 0, 1); PG8_STAGE(PG8_SB(0, 0), b2, voffB); PG8_STAGE(PG8_SB(0, 1), b2 + hstep, voffB); PG8_STAGE(PG8_SA(0, 0), a2, voffA);
            PG8_WAIT_V(8); PG8_WAIT_L(0); PG8_BAR; PG8_MMA(1, 0, At, B0); PG8_MMA(1, 1, At, B1); PG8_BAR; PG8_SCHED;
            PG8_LDB(B0, 1, 0); PG8_LDB(B1, 1, 1); PG8_SCHED; PG8_LDA(At, 1, 0); PG8_STAGE(PG8_SA(0, 1), a2 + hstep, voffA);
            PG8_WAIT_V(8); PG8_WAIT_L(0); PG8_BAR; PG8_MMA(0, 0, At, B0); PG8_MMA(0, 1, At, B1); PG8_BAR; PG8_SCHED;
            PG8_LDA(At, 1, 1); PG8_STAGE(PG8_SB(1, 0), b3, voffB); PG8_STAGE(PG8_SB(1, 1), b3 + hstep, voffB); PG8_STAGE(PG8_SA(1, 0), a3, voffA);
            PG8_WAIT_V(8); PG8_WAIT_L(0); PG8_BAR; PG8_MMA(1, 0, At, B0); PG8_MMA(1, 1, At, B1); PG8_BAR; PG8_SCHED;
            } else {
            PG8_LDB(B0, 0, 0); PG8_SCHED; PG8_LDA(At, 0, 0); PG8_STAGE(PG8_SA(1, 1), a1 + hstep, voffA);
            PG8_WAIT_L(8); PG8_BAR; PG8_WAIT_L(0); PG8_MMA(0, 0, At, B0); PG8_BAR; PG8_SCHED;
            PG8_LDB(B1, 0, 1); PG8_STAGE(PG8_SB(0, 0), b2, voffB);
            PG8_BAR; PG8_WAIT_L(0); PG8_MMA(0, 1, At, B1); PG8_BAR;
            PG8_LDA(At, 0, 1); PG8_STAGE(PG8_SA(0, 0), a2, voffA);
            PG8_BAR; PG8_WAIT_L(0); PG8_MMA(1, 0, At, B0); PG8_BAR; PG8_SCHED;
            PG8_STAGE(PG8_SB(0, 1), b2 + hstep, voffB);
            PG8_WAIT_V(6); PG8_BAR; PG8_MMA(1, 1, At, B1); PG8_BAR;
            PG8_LDB(B0, 1, 0); PG8_SCHED; PG8_LDA(At, 1, 0); PG8_STAGE(PG8_SA(0, 1), a2 + hstep, voffA);
            PG8_WAIT_L(8); PG8_BAR; PG8_WAIT_L(0); PG8_MMA(0, 0, At, B0); PG8_BAR; PG8_SCHED;
            PG8_LDB(B1, 1, 1); PG8_STAGE(PG8_SB(1, 0), b3, voffB);
            PG8_BAR; PG8_WAIT_L(0); PG8_MMA(0, 1, At, B1); PG8_BAR;
            PG8_LDA(At, 1, 1); PG8_STAGE(PG8_SA(1, 0), a3, voffA);
            PG8_BAR; PG8_WAIT_L(0); PG8_MMA(1, 0, At, B0); PG8_BAR; PG8_SCHED;
            PG8_STAGE(PG8_SB(1, 1), b3 + hstep, voffB);
            PG8_WAIT_V(6); PG8_BAR; PG8_MMA(1, 1, At, B1); PG8_BAR;
            }
        }
        if constexpr (ALIGN_EPI) { if (wr == 0) PG8_BAR; }
        if constexpr (!Epi::AFTER_DRAIN) { E(acc, cur, wr, wc, fr, fq); S.done(cur); }
        if (!has_next) break;
#pragma unroll
        for (int a = 0; a < 2; ++a)
#pragma unroll
            for (int b = 0; b < 2; ++b)
#pragma unroll
                for (int m = 0; m < 4; ++m)
#pragma unroll
                    for (int n = 0; n < 2; ++n) acc[a][b][m][n] = (f32x4){0.f, 0.f, 0.f, 0.f};
        cur = nxt; cA = nA; cB = nB; ++ui;
        if constexpr (ALIGN_EPI) { if (wr == 1) PG8_BAR; }
    }
    PG8_WAIT_V(0);
    if constexpr (!ALIGN_EPI) { if (wr == 0) PG8_BAR; }
    PG8_BAR;
    if constexpr (Epi::AFTER_DRAIN) { E.fused(acc, cur, wr, wc, fr, fq, lds, wid, lane); S.done(cur); }
#undef PG8_SA
#undef PG8_SB
#undef PG8_STAGE
#undef PG8_LDA
#undef PG8_LDB
#undef PG8_MMA
#undef PG8_WAIT_V
#undef PG8_WAIT_L
#undef PG8_BAR
#undef PG8_SCHED
}
}

namespace pg8 {
struct EpiRelu2 {
    static constexpr bool PERM = true, AFTER_DRAIN = false;
    bf16_t* O; int ldc;
    __device__ __forceinline__ void operator()(const f32x4 (&acc)[2][2][4][2], const Unit& u, int wr, int wc, int fr, int fq) const {
        relane(wr, wc, fr, fq);
        const int row0 = u.pm * BM + wr * 64 + fr, col0 = u.pn * BM + wc * 32 + 8 * fq;
#pragma unroll
        for (int ai = 0; ai < 2; ++ai)
#pragma unroll
            for (int m = 0; m < 4; ++m) { bf16_t* rowp = O + (size_t)(row0 + ai * HALF + m * 16) * ldc + col0;
#pragma unroll
                for (int bj = 0; bj < 2; ++bj) { f32x4 v0 = acc[ai][bj][m][0], v1 = acc[ai][bj][m][1];
                    v0 = __builtin_elementwise_max(v0, (f32x4){0.f, 0.f, 0.f, 0.f}); v1 = __builtin_elementwise_max(v1, (f32x4){0.f, 0.f, 0.f, 0.f}); v0 = v0 * v0; v1 = v1 * v1;
                    u32x4 w; w.x = cvt_pk_bf16(v0[0], v0[1]); w.y = cvt_pk_bf16(v0[2], v0[3]); w.z = cvt_pk_bf16(v1[0], v1[1]); w.w = cvt_pk_bf16(v1[2], v1[3]);
                    *(PG8_GAS u32x4*)(rowp + bj * HALF) = w; } }
    }
};
struct EpiF32 {
    static constexpr bool PERM = false, AFTER_DRAIN = false;
    float* O; int ldc;
    __device__ __forceinline__ void operator()(const f32x4 (&acc)[2][2][4][2], const Unit& u, int wr, int wc, int fr, int fq) const {
        relane(wr, wc, fr, fq);
        const int row0 = u.pm * BM + wr * 64 + fr, col0 = u.pn * BM + wc * 32 + 4 * fq;
#pragma unroll
        for (int ai = 0; ai < 2; ++ai)
#pragma unroll
            for (int m = 0; m < 4; ++m) { float* rowp = O + (size_t)(row0 + ai * HALF + m * 16) * ldc + col0;
#pragma unroll
                for (int bj = 0; bj < 2; ++bj)
#pragma unroll
                    for (int n = 0; n < 2; ++n) *(PG8_GAS f32x4*)(rowp + bj * HALF + n * 16) = acc[ai][bj][m][n]; }
    }
};
struct EpiTaps {
    static constexpr bool PERM = false, AFTER_DRAIN = false;
    float* O; const float* decay;
    __device__ __forceinline__ void operator()(const f32x4 (&acc)[2][2][4][2], const Unit& u, int wr, int wc, int fr, int fq) const {
        relane(wr, wc, fr, fq);
        const int row0 = u.pm * BM + wr * 64 + fr, col0 = u.pn * BM + wc * 32 + 4 * fq;
#pragma unroll
        for (int ai = 0; ai < 2; ++ai)
#pragma unroll
            for (int m = 0; m < 4; ++m) { const int row = row0 + ai * HALF + m * 16; float* rowp = O + (size_t)row * 16384 + col0; const float nd = -fabsf(((const PG8_GAS float*)decay)[row]) * (1.0f / 16383.0f) * 1.4426950408889634f;
#pragma unroll
                for (int bj = 0; bj < 2; ++bj)
#pragma unroll
                    for (int n = 0; n < 2; ++n) { const int c = col0 + bj * HALF + n * 16; const f32x4 a = acc[ai][bj][m][n]; f32x4 o;
                        o[0] = a[0] * __builtin_amdgcn_exp2f(nd * (float)(c + 0)); o[1] = a[1] * __builtin_amdgcn_exp2f(nd * (float)(c + 1));
                        o[2] = a[2] * __builtin_amdgcn_exp2f(nd * (float)(c + 2)); o[3] = a[3] * __builtin_amdgcn_exp2f(nd * (float)(c + 3));
                        *(PG8_GAS f32x4*)(rowp + bj * HALF + n * 16) = o; } }
    }
};
}

constexpr int L = 16384, NSEQ = 3, M = NSEQ * L, D = 1024, DEPTH = 4;
constexpr int HYW = 512, HYP = 1536, QR = 256, KVR = 128, ROPE = 32, INW = 1952;
constexpr int NH = 8, DQ = 96, DV = 64, NQ = NH * DQ, NKV = NH * 128;
constexpr int FF = 4096;
constexpr float EPS = 1e-6f;
constexpr int NWAVES = 8, NTHR = 512;
constexpr int MLP_CHUNK = 16384, N_MLP_CHUNKS = M / MLP_CHUNK;

constexpr size_t MiB = 1u << 20;
constexpr size_t WS_CTL = 0, CTL_ZERO_BYTES = 65536;
constexpr size_t WS_COS = 1 * MiB, WS_SIN = 2 * MiB;
constexpr size_t WS_H2 = 4 * MiB;
constexpr size_t WS_W3T = 8 * MiB;
constexpr size_t WS_WIN = 12 * MiB, WS_WOUT = 16 * MiB, WS_WUP = 18 * MiB, WS_WDOWN = 26 * MiB, WS_WUQ = 34 * MiB, WS_WUKV = 34 * MiB + 512 * 1024;
constexpr size_t WS_XN = 36 * MiB;
constexpr size_t WS_CQN = 36 * MiB, WS_CKVN = 60 * MiB, WS_KPE = 72 * MiB;
constexpr size_t WS_KEO = 132 * MiB;
constexpr size_t WS_KT = 261 * MiB;
constexpr size_t WS_UT = 261 * MiB;
constexpr size_t WS_CQKV = 405 * MiB;
constexpr size_t WS_YT = 453 * MiB;
constexpr size_t WS_Q = 132 * MiB, WS_KN = 204 * MiB;
constexpr size_t WS_MIX = 324 * MiB;
constexpr size_t WS_T = 132 * MiB;
constexpr size_t WS_H = 324 * MiB;
constexpr size_t WS_G0 = 75 * MiB, WS_G1A = 107 * MiB, WS_G1B = 501 * MiB;
constexpr size_t WS_END = 508 * MiB;
constexpr int KEO_BLK = 16512, KEO_KO = 8256;
static_assert(WS_KEO + (size_t)1024 * KEO_BLK * 8 <= WS_KT, "KEO fits");
static_assert(WS_UT + (size_t)HYP * M * 2 <= WS_CQKV && WS_CQKV + (size_t)M * 512 * 2 <= WS_YT && WS_YT + (size_t)HYW * M * 2 <= WS_END, "map");
static_assert(WS_KN + (size_t)M * NKV * 2 <= WS_MIX && WS_T + (size_t)M * D * 4 <= WS_MIX && WS_H + (size_t)MLP_CHUNK * FF * 2 <= WS_END, "map2");

constexpr int RING_OFF = 0, RING_BYTES = 139264;
constexpr int LDSCTL_OFF = RING_BYTES, MISC_OFF = LDSCTL_OFF + 320;
constexpr int LDS_BYTES = 147456;
static_assert(MISC_OFF + 128 <= LDS_BYTES, "LDS map");

#define GAS __attribute__((address_space(1)))
#define LAS __attribute__((address_space(3)))
typedef unsigned short bf16;
typedef unsigned v4u __attribute__((ext_vector_type(4)));
typedef unsigned v2u __attribute__((ext_vector_type(2)));
typedef float f32x4 __attribute__((ext_vector_type(4)));
typedef float f32x2 __attribute__((ext_vector_type(2)));
typedef short bf16x8 __attribute__((ext_vector_type(8)));
typedef GAS unsigned gu32;
#define RLX_AGENT __ATOMIC_RELAXED, __HIP_MEMORY_SCOPE_AGENT
#define LDS_WAIT() asm volatile("s_waitcnt lgkmcnt(0)" ::: "memory")
#define VM_WAIT() asm volatile("s_waitcnt vmcnt(0)" ::: "memory")
typedef __bf16 bf16x2_t __attribute__((ext_vector_type(2)));
__device__ __forceinline__ unsigned pk2(float lo, float hi) { f32x2 v = {lo, hi}; bf16x2_t b = __builtin_convertvector(v, bf16x2_t); return __builtin_bit_cast(unsigned, b); }
__device__ __forceinline__ bf16 f2bf(float f) { return (bf16)(pk2(f, 0.f) & 0xffffu); }
__device__ __forceinline__ float bf2f(unsigned h) { return __uint_as_float(h << 16); }
__device__ __forceinline__ float shx(float v, int lane, int o) { return __uint_as_float((unsigned)__builtin_amdgcn_ds_bpermute((lane ^ o) << 2, (int)__float_as_uint(v))); }
__device__ __forceinline__ float wave_sum(float v) {
    const int ln_ = hw_lane();
#pragma unroll
    for (int o = 1; o < 64; o <<= 1) v += shx(v, ln_, o);
    return v;
}

namespace hfft {
constexpr float w32c(int i) { constexpr float t[16] = {1.000000000e+00f, 9.807852507e-01f, 9.238795042e-01f, 8.314695954e-01f, 7.071067691e-01f, 5.555702448e-01f, 3.826834261e-01f, 1.950903237e-01f, 0.f, -1.950903237e-01f, -3.826834261e-01f, -5.555702448e-01f, -7.071067691e-01f, -8.314695954e-01f, -9.238795042e-01f, -9.807852507e-01f}; return t[i]; }
constexpr float w32s(int i) { constexpr float t[16] = {0.000000000e+00f, 1.950903237e-01f, 3.826834261e-01f, 5.555702448e-01f, 7.071067691e-01f, 8.314695954e-01f, 9.238795042e-01f, 9.807852507e-01f, 1.000000000e+00f, 9.807852507e-01f, 9.238795042e-01f, 8.314695954e-01f, 7.071067691e-01f, 5.555702448e-01f, 3.826834261e-01f, 1.950903237e-01f}; return t[i]; }
constexpr int brev(int x, int bits) { int r = 0; for (int i = 0; i < bits; ++i) r |= ((x >> i) & 1) << (bits - 1 - i); return r; }
constexpr int ilog2(int x) { int r = 0; while ((1 << r) < x) ++r; return r; }
__device__ __forceinline__ int pad(int i) { return i + (i >> 5); }

__device__ __forceinline__ void bfly(float ar, float ai, float br, float bi, float& ur, float& ui, float& dr, float& di) {
    asm("v_add_f32_e32 %0, %4, %6\n\tv_add_f32_e32 %1, %5, %7\n\tv_sub_f32_e32 %2, %4, %6\n\tv_sub_f32_e32 %3, %5, %7"
        : "=&v"(ur), "=&v"(ui), "=&v"(dr), "=&v"(di) : "v"(ar), "v"(ai), "v"(br), "v"(bi));
}
template <bool INV> __device__ __forceinline__ void bfly_rot(float ar, float ai, float br, float bi, float& ur, float& ui, float& dr, float& di) {
    if (!INV) asm("v_add_f32_e32 %0, %4, %6\n\tv_add_f32_e32 %1, %5, %7\n\tv_sub_f32_e32 %2, %5, %7\n\tv_sub_f32_e32 %3, %6, %4" : "=&v"(ur), "=&v"(ui), "=&v"(dr), "=&v"(di) : "v"(ar), "v"(ai), "v"(br), "v"(bi));
    else      asm("v_add_f32_e32 %0, %4, %6\n\tv_add_f32_e32 %1, %5, %7\n\tv_sub_f32_e32 %2, %7, %5\n\tv_sub_f32_e32 %3, %4, %6" : "=&v"(ur), "=&v"(ui), "=&v"(dr), "=&v"(di) : "v"(ar), "v"(ai), "v"(br), "v"(bi));
}
__device__ __forceinline__ void bfly_tw(float ar, float ai, float br, float bi, float c, float s, float& ur, float& ui, float& dr, float& di) {
    float tr, ti;
    asm("v_sub_f32_e32 %4, %6, %8\n\tv_sub_f32_e32 %5, %7, %9\n\tv_add_f32_e32 %0, %6, %8\n\tv_add_f32_e32 %1, %7, %9\n\t"
        "v_mul_f32_e32 %2, %10, %4\n\tv_mul_f32_e32 %3, %11, %4\n\tv_fma_f32 %2, -%11, %5, %2\n\tv_fma_f32 %3, %10, %5, %3"
        : "=&v"(ur), "=&v"(ui), "=&v"(dr), "=&v"(di), "=&v"(tr), "=&v"(ti) : "v"(ar), "v"(ai), "v"(br), "v"(bi), "s"(c), "s"(s));
}
__device__ __forceinline__ void cmul_chain(float& xr, float& xi, float& wc, float& ws, float c1, float s1) {
    float a, b, nc, ns;
    asm("v_mul_f32_e32 %0, %4, %6\n\tv_mul_f32_e32 %1, %4, %7\n\tv_fma_f32 %0, -%5, %7, %0\n\tv_fma_f32 %1, %5, %6, %1\n\t"
        "v_mul_f32_e32 %2, %6, %8\n\tv_mul_f32_e32 %3, %6, %9\n\tv_fma_f32 %2, -%7, %9, %2\n\tv_fma_f32 %3, %7, %8, %3"
        : "=&v"(a), "=&v"(b), "=&v"(nc), "=&v"(ns) : "v"(xr), "v"(xi), "v"(wc), "v"(ws), "v"(c1), "v"(s1));
    xr = a; xi = b; wc = nc; ws = ns;
}
template <int R, bool INV> __device__ __forceinline__ void fft_r2(float (&re)[R], float (&im)[R], const unsigned z0) {
    constexpr int LG = ilog2(R);
#pragma unroll
    for (int st = 0; st < LG; ++st) {
        const int s = (R / 2) >> st;
#pragma unroll
        for (int blk = 0; blk < R; blk += 2 * s) {
#pragma unroll
            for (int a = 0; a < s; ++a) {
                const int i0 = blk + a, i1 = i0 + s;
                const int w = a * (16 / s);
                float ur, ui, dr, di;
                if (w == 0) { bfly(re[i0], im[i0], re[i1], im[i1], ur, ui, dr, di); re[i1] = dr; im[i1] = di; }
                else if (w == 8) { bfly_rot<INV>(re[i0], im[i0], re[i1], im[i1], ur, ui, dr, di); re[i1] = dr; im[i1] = di; }
                else { const float c = __uint_as_float(__float_as_uint(w32c(w)) | z0), sn = __uint_as_float(__float_as_uint(INV ? w32s(w) : -w32s(w)) | z0);
                    bfly_tw(re[i0], im[i0], re[i1], im[i1], c, sn, ur, ui, dr, di); re[i1] = dr; im[i1] = di; }
                re[i0] = ur; im[i0] = ui;
            }
        }
    }
}

__device__ __forceinline__ int opaque(int x) { asm volatile("" : "+v"(x)); return x; }
template <bool INV> __device__ __forceinline__ void fft16k(float (&re)[32], float (&im)[32], LAS f32x2* buf, const int t_in) {
    asm volatile("" ::: "memory"); __builtin_amdgcn_sched_barrier(0);
    int t = opaque(t_in);
    unsigned z0 = 0u; asm volatile("" : "+s"(z0));
    fft_r2<32, INV>(re, im, z0);
    __syncthreads();
#pragma unroll
    for (int r = 0; r < 32; ++r) buf[33 * t + r] = (f32x2){re[brev(r, 5)], im[brev(r, 5)]};
    __syncthreads();
    t = opaque(t);
    { const int b2 = t + (t >> 5);
#pragma unroll
    for (int r = 0; r < 32; ++r) { const f32x2 v = buf[b2 + 528 * r]; re[r] = v.x; im[r] = v.y; } }
    {
        const float f1 = (float)(t & 31) * (1.0f / 1024.0f);
        const float c1 = __builtin_amdgcn_cosf(f1), s1 = INV ? __builtin_amdgcn_sinf(f1) : -__builtin_amdgcn_sinf(f1);
        float wc = c1, ws = s1;
#pragma unroll
        for (int r = 1; r < 32; ++r) {
            cmul_chain(re[r], im[r], wc, ws, c1, s1);
        }
    }
    fft_r2<32, INV>(re, im, z0);
    __syncthreads();
    {
        t = opaque(t);
        const int ob = (t >> 5) * 1056 + (t & 31);
#pragma unroll
        for (int r = 0; r < 32; ++r) buf[ob + 33 * r] = (f32x2){re[brev(r, 5)], im[brev(r, 5)]};
    }
    __syncthreads();
#pragma unroll
    for (int h = 0; h < 2; ++h) {
        t = opaque(t);
        float ar[16], ai[16]; const int j = t + 512 * h; const int b3 = t + (t >> 5) + 528 * h;
#pragma unroll
        for (int r = 0; r < 16; ++r) { const f32x2 v = buf[b3 + 1056 * r]; ar[r] = v.x; ai[r] = v.y; }
        {
            const float f1 = (float)j * (1.0f / 16384.0f);
            const float c1 = __builtin_amdgcn_cosf(f1), s1 = INV ? __builtin_amdgcn_sinf(f1) : -__builtin_amdgcn_sinf(f1);
            float wc = c1, ws = s1;
#pragma unroll
            for (int r = 1; r < 16; ++r) {
                cmul_chain(ar[r], ai[r], wc, ws, c1, s1);
            }
        }
        fft_r2<16, INV>(ar, ai, z0);
#pragma unroll
        for (int r = 0; r < 16; ++r) { re[h + 2 * r] = ar[brev(r, 4)]; im[h + 2 * r] = ai[brev(r, 4)]; }
    }
    asm volatile("" ::: "memory"); __builtin_amdgcn_sched_barrier(0);
}
}

struct Frame {
    LAS unsigned char* lds;
    volatile LAS unsigned* MISC;
    gu32* ctl;
    int tid, lane, wave;
    int wave0;
    int vcu, G;
    float* out;
    unsigned char* ws;
};
constexpr int PTRTAB_OFF = LDSCTL_OFF + 512;
__device__ __forceinline__ const GAS float* inp(const Frame& F, int i) {
    const v2u w = *(const LAS v2u*)(F.lds + PTRTAB_OFF + 8 * i);
    const unsigned lo = __builtin_amdgcn_readfirstlane(w.x), hi = __builtin_amdgcn_readfirstlane(w.y);
    return (const GAS float*)(((unsigned long long)hi << 32) | lo);
}
__device__ __forceinline__ GAS unsigned char* wsq(const Frame& F) { unsigned char* p = F.ws; asm volatile("" : "+s"(p)); return (GAS unsigned char*)p; }
enum { I_XP = 0, I_XS, I_WIN, I_CONVW, I_CONVB, I_FW1, I_FB1, I_FW2, I_FB2, I_FW3, I_SINF, I_DECAY, I_HBIAS, I_QNORM, I_WUQ, I_KVNORM, I_WUKV, I_GNHY, I_GNAT, I_WOUT,
       I_NMIXPRE, I_NMIXPOST, I_NMLPPRE, I_NMLPPOST, I_WUP, I_WDOWN };

__device__ __forceinline__ int rope_src(int p) { return 4 * (p >> 3) + (p & 3) + 16 * ((p >> 2) & 1); }
template <bool ROPEPERM>
__device__ __forceinline__ void transpose_item(const GAS float* W, int K, int N, GAS bf16* WT, LAS float* scr, int item, int lane, int ldk = 0, int koff = 0) {
    if (ldk == 0) ldk = K;
    const int nblk = N / 32, kb = item / nblk, nb = item % nblk, k0 = 64 * kb, n0 = 32 * nb;
    int sc = lane & 31; if (ROPEPERM && (nb % 3) == 2) sc = rope_src(sc);
#pragma unroll 8
    for (int i = 0; i < 32; ++i) { const int kk = 2 * i + (lane >> 5); scr[kk * 33 + (lane & 31)] = W[(size_t)(k0 + kk) * N + n0 + sc]; }
    LDS_WAIT(); asm volatile("" ::: "memory");
    const int c = lane & 7;
#pragma unroll
    for (int j = 0; j < 4; ++j) { const int n = (lane >> 3) + 8 * j; const LAS float* s = scr + (8 * c) * 33 + n;
        v4u o; o.x = pk2(s[0 * 33], s[1 * 33]); o.y = pk2(s[2 * 33], s[3 * 33]); o.z = pk2(s[4 * 33], s[5 * 33]); o.w = pk2(s[6 * 33], s[7 * 33]);
        *(GAS v4u*)(WT + (size_t)(n0 + n) * ldk + koff + k0 + 8 * c) = o; }
    LDS_WAIT(); asm volatile("" ::: "memory");
}
__device__ __forceinline__ void phase_weights(Frame& F, int l) {
    LAS float* scr = (LAS float*)(F.lds + RING_OFF + F.wave * 16384);
    const int gw = F.vcu * NWAVES + F.wave, NGW = F.G * NWAVES;
    GAS bf16* WinT = (GAS bf16*)(wsq(F) + WS_WIN); GAS bf16* WoutT = (GAS bf16*)(wsq(F) + WS_WOUT); GAS bf16* WupT = (GAS bf16*)(wsq(F) + WS_WUP); GAS bf16* WdownT = (GAS bf16*)(wsq(F) + WS_WDOWN);
    GAS bf16* WuqT = (GAS bf16*)(wsq(F) + WS_WUQ); GAS bf16* WukvT = (GAS bf16*)(wsq(F) + WS_WUKV);
    constexpr int I_IN = (D / 64) * (INW / 32), I_OUT = (D / 64) * (D / 32), I_UP = (D / 64) * (FF / 32), I_DN = (FF / 64) * (D / 32), I_UQ = (QR / 64) * (NQ / 32), I_UKV = (KVR / 64) * (NKV / 32);
    constexpr int I_W3 = 2048 / 32;
    constexpr int NITEMS = I_IN + I_OUT + I_UP + I_DN + I_UQ + I_UKV + 2 * I_W3;
    for (int it = gw; it < NITEMS; it += NGW) {
        int r = it;
        if (r < I_IN) { transpose_item<false>(inp(F, I_WIN) + (size_t)l * D * INW, D, INW, WinT, scr, r, F.lane); continue; } r -= I_IN;
        if (r < I_OUT) { transpose_item<false>(inp(F, I_WOUT) + (size_t)l * D * D, D, D, WoutT, scr, r, F.lane); continue; } r -= I_OUT;
        if (r < I_UP) { transpose_item<false>(inp(F, I_WUP) + (size_t)l * D * FF, D, FF, WupT, scr, r, F.lane); continue; } r -= I_UP;
        if (r < I_DN) { transpose_item<false>(inp(F, I_WDOWN) + (size_t)l * FF * D, FF, D, WdownT, scr, r, F.lane); continue; } r -= I_DN;
        if (r < I_UQ) { transpose_item<true>(inp(F, I_WUQ) + (size_t)l * QR * NQ, QR, NQ, WuqT, scr, r, F.lane); continue; } r -= I_UQ;
        if (r < I_UKV) { transpose_item<false>(inp(F, I_WUKV) + (size_t)l * KVR * NKV, KVR, NKV, WukvT, scr, r, F.lane); continue; } r -= I_UKV;
        transpose_item<false>(inp(F, I_FW3) + (size_t)l * 64 * 2048, 64, 2048, (GAS bf16*)(wsq(F) + WS_W3T), scr, r % I_W3, F.lane, 128, (r / I_W3) * 64);
    }
    { unsigned z = 0u; asm volatile("" : "+v"(z)); const v4u zz = {z, z, z, z};
      for (int i = gw * 64 + F.lane; i < 12288; i += NGW * 64) ((GAS v4u*)(WinT + (size_t)INW * D))[i] = zz; }
}
__device__ __forceinline__ void phase_rope_tab(Frame& F) {
    const float inv[16] = {1.000000000e+00f, 5.623413324e-01f, 3.162277639e-01f, 1.778279394e-01f, 1.000000015e-01f, 5.623412877e-02f, 3.162277862e-02f, 1.778279431e-02f,
                           9.999999776e-03f, 5.623413250e-03f, 3.162277862e-03f, 1.778279431e-03f, 1.000000047e-03f, 5.623413017e-04f, 3.162277862e-04f, 1.778279402e-04f};
    GAS float* ct = (GAS float*)(wsq(F) + WS_COS); GAS float* st = (GAS float*)(wsq(F) + WS_SIN);
    for (int i = F.vcu * NTHR + F.tid; i < L * 16; i += F.G * NTHR) {
        const int t = i >> 4, j = i & 15; float iv = inv[0];
#pragma unroll
        for (int q = 1; q < 16; ++q) iv = (j == q) ? inv[q] : iv;
        const float ang = (float)t * iv; ct[i] = cosf(ang); st[i] = sinf(ang);
    }
}
__device__ __forceinline__ const GAS float* x_src_row(Frame& F, int l, int m) {
    if (l == 0) return (m < 2 * L) ? inp(F, I_XP) + (size_t)m * D : inp(F, I_XS) + (size_t)(m - 2 * L) * D;
    return (const GAS float*)F.out + (size_t)m * D;
}
__device__ __forceinline__ void store_xn_row(f32x4 (&v)[4], float rstd, const GAS float* g, GAS bf16* orow, int lane) {
    GAS v2u* o8 = (GAS v2u*)orow + lane;
#pragma unroll
    for (int j = 0; j < 4; ++j) { const f32x4 gg = ((const GAS f32x4*)g)[lane + 64 * j]; v2u w; w.x = pk2(v[j].x * rstd * gg.x, v[j].y * rstd * gg.y); w.y = pk2(v[j].z * rstd * gg.z, v[j].w * rstd * gg.w); o8[64 * j] = w; }
}
__device__ __forceinline__ float row_ss(const f32x4 (&v)[4]) { float s = 0.f;
#pragma unroll
    for (int j = 0; j < 4; ++j) s += (v[j].x * v[j].x + v[j].y * v[j].y) + (v[j].z * v[j].z + v[j].w * v[j].w);
    return wave_sum(s); }
__device__ __forceinline__ void phase_norm_first(Frame& F, int l, const GAS float* g) {
    const int gw = F.vcu * NWAVES + F.wave, NGW = F.G * NWAVES; GAS bf16* XN = (GAS bf16*)(wsq(F) + WS_XN);
    for (int m = gw; m < M; m += NGW) {
        const GAS f32x4* xr = (const GAS f32x4*)x_src_row(F, l, m) + F.lane; f32x4 v[4];
#pragma unroll
        for (int j = 0; j < 4; ++j) v[j] = xr[64 * j];
        const float rstd = 1.0f / sqrtf(row_ss(v) * (1.0f / D) + EPS);
        store_xn_row(v, rstd, g, XN + (size_t)m * D, F.lane);
    }
}
__device__ __forceinline__ void phase_norm_res(Frame& F, int lsrc, const GAS bf16* T, const GAS float* gpost, const GAS float* gnext) {
    const int gw = F.vcu * NWAVES + F.wave, NGW = F.G * NWAVES; GAS bf16* XN = (GAS bf16*)(wsq(F) + WS_XN);
    for (int m0 = gw; m0 < M; m0 += 2 * NGW) {
        f32x4 v[2][4], tv[2][4];
#pragma unroll
        for (int q = 0; q < 2; ++q) { const int m = m0 + q * NGW; const GAS f32x4* xr = (const GAS f32x4*)x_src_row(F, lsrc, m) + F.lane; const GAS v2u* tr = (const GAS v2u*)(T + (size_t)m * D) + F.lane;
#pragma unroll
            for (int j = 0; j < 4; ++j) { v[q][j] = xr[64 * j]; const v2u w = tr[64 * j]; tv[q][j] = (f32x4){bf2f(w.x & 0xffffu), bf2f(w.x >> 16), bf2f(w.y & 0xffffu), bf2f(w.y >> 16)}; } }
#pragma unroll
        for (int q = 0; q < 2; ++q) { const int m = m0 + q * NGW;
            const float rt = 1.0f / sqrtf(row_ss(tv[q]) * (1.0f / D) + EPS);
            GAS f32x4* orow = (GAS f32x4*)(F.out + (size_t)m * D) + F.lane;
#pragma unroll
            for (int j = 0; j < 4; ++j) { const f32x4 gg = ((const GAS f32x4*)gpost)[F.lane + 64 * j]; v[q][j] = v[q][j] + tv[q][j] * rt * gg; orow[64 * j] = v[q][j]; }
            if (gnext) { const float rstd = 1.0f / sqrtf(row_ss(v[q]) * (1.0f / D) + EPS); store_xn_row(v[q], rstd, gnext, XN + (size_t)m * D, F.lane); } }
    }
}

__device__ __forceinline__ void phase_filter_mlp(Frame& F, int l) {
    const GAS float* w1 = inp(F, I_FW1) + (size_t)l * 33 * 64; const GAS float* b1 = inp(F, I_FB1) + l * 64; const GAS float* w2 = inp(F, I_FW2) + (size_t)l * 64 * 64; const GAS float* b2 = inp(F, I_FB2) + l * 64;
    const GAS float* sf = inp(F, I_SINF) + l * 128; GAS bf16* H2 = (GAS bf16*)(wsq(F) + WS_H2);
    const int lane = F.lane, gw = F.vcu * NWAVES + F.wave, NGW = F.G * NWAVES;
    float w1c[33], w2c[64];
#pragma unroll
    for (int f = 0; f < 33; ++f) w1c[f] = w1[f * 64 + lane];
#pragma unroll
    for (int i = 0; i < 64; ++i) w2c[i] = w2[i * 64 + lane];
    const float b1l = b1[lane], b2l = b2[lane], sf0 = sf[lane], sf1 = sf[64 + lane];
    for (int n = gw; n < L; n += NGW) {
        const float tn = (float)n * (1.0f / (float)(L - 1)); const float omega = (float)(2.0 * 3.14159265358979323846 / L) * (float)n;
        const int bidx = (lane >= 17) ? lane - 17 : lane - 1; const float band = 1e-4f + (float)bidx * ((15.0f - 1e-4f) / 15.0f); const float ph = omega * band;
        const float zf = (lane == 0) ? tn : ((lane <= 16) ? cosf(ph) : -sinf(ph));
        float acc = b1l;
#pragma unroll
        for (int f = 0; f < 33; ++f) acc += __uint_as_float(__builtin_amdgcn_readlane(__float_as_uint(zf), f)) * w1c[f];
        const float h1 = sinf(sf0 * acc);
        float acc2 = b2l;
#pragma unroll
        for (int i = 0; i < 64; ++i) acc2 += __uint_as_float(__builtin_amdgcn_readlane(__float_as_uint(h1), i)) * w2c[i];
        const float hv = sinf(sf1 * acc2); const bf16 hi = f2bf(hv);
        H2[(size_t)n * 128 + lane] = hi; H2[(size_t)n * 128 + 64 + lane] = f2bf(hv - bf2f(hi));
    }
}

__device__ __forceinline__ void phase_filter_fft(Frame& F, int l) {
    const GAS float* KT = (const GAS float*)(wsq(F) + WS_KT); GAS f32x2* KEO = (GAS f32x2*)(wsq(F) + WS_KEO); const GAS float* hb = inp(F, I_HBIAS) + (size_t)l * 2 * HYW;
    LAS f32x2* buf = (LAS f32x2*)(F.lds + RING_OFF); const int t = F.tid;
    for (int c = F.vcu; c < HYW; c += F.G) {
        const GAS float* fw0 = KT + (size_t)(0 * HYW + c) * L; const GAS float* bw0 = KT + (size_t)(1 * HYW + c) * L;
        const GAS float* fw1 = KT + (size_t)(2 * HYW + c) * L; const GAS float* bw1 = KT + (size_t)(3 * HYW + c) * L;
        const float bias0 = hb[c], bias1 = hb[HYW + c]; const float sc = 1.0f / (2.0f * L);
        GAS f32x2* k0 = KEO + (size_t)c * KEO_BLK; GAS f32x2* k1 = KEO + (size_t)(HYW + c) * KEO_BLK;
        float ar[32], ai[32];
#pragma unroll 1
        for (int odd = 0; odd < 2; ++odd) {
            { const int tq = hfft::opaque(t);
#pragma unroll
              for (int m = 0; m < 32; ++m) { const int n = tq + 512 * m; const int nb = n >= 1 ? L - n : 0;
                  const float f0 = fw0[n], f1 = fw1[n]; float b0 = bw0[nb], b1 = bw1[nb]; b0 = n >= 1 ? b0 : 0.f; b1 = n >= 1 ? b1 : 0.f;
                  if (!odd) { ar[m] = f0 + b0; ai[m] = f1 + b1; }
                  else { const float d0 = f0 - b0, d1 = f1 - b1; const float fr = (float)n * (1.0f / 32768.0f); const float cs = __builtin_amdgcn_cosf(fr), sn = -__builtin_amdgcn_sinf(fr);
                         ar[m] = d0 * cs - d1 * sn; ai[m] = d0 * sn + d1 * cs; }
                  if ((m & 7) == 7) { asm volatile("" ::: "memory"); __builtin_amdgcn_sched_barrier(0); } } }
            hfft::fft16k<false>(ar, ai, buf, t);
            __syncthreads();
            { const int tq = hfft::opaque(t);
#pragma unroll
              for (int m = 0; m < 32; ++m) buf[hfft::pad(tq + 512 * m)] = (f32x2){ar[m], ai[m]}; }
            __syncthreads();
            { const int tq = hfft::opaque(t); GAS f32x2* d0 = k0 + (odd ? KEO_KO : 0); GAS f32x2* d1 = k1 + (odd ? KEO_KO : 0);
#pragma unroll
              for (int m = 0; m <= 16; ++m) { const int k = tq + 512 * m; const bool keep = odd ? (k < 8192) : (k <= 8192);
                  const int rk = odd ? 16383 - k : ((16384 - k) & 16383); const f32x2 xq = buf[hfft::pad(rk)]; const float cr = xq.x, ci = -xq.y;
                  const float a0 = 0.5f * (ar[m] + cr), a1 = 0.5f * (ai[m] + ci), b0 = 0.5f * (ai[m] - ci), b1 = -0.5f * (ar[m] - cr);
                  if (keep) { d0[k] = (f32x2){(a0 + bias0) * sc, a1 * sc}; d1[k] = (f32x2){(b0 + bias1) * sc, b1 * sc}; } } }
        }
    }
    __syncthreads();
}

__device__ __forceinline__ float u_conv3(const GAS bf16* row, int n, float w0, float w1, float w2, float cb) {
    const int nm = n >= 1 ? n - 1 : 0, np = n + 1 < L ? n + 1 : L - 1;
    float um = bf2f(row[nm]), up = bf2f(row[np]); const float u0 = bf2f(row[n]);
    um = n >= 1 ? um : 0.f; up = n + 1 < L ? up : 0.f;
    return um * w0 + u0 * w1 + up * w2 + cb;
}
__device__ __forceinline__ void cmul_spec(float (&xr)[32], float (&xi)[32], const GAS f32x2* ke, int t, bool odd) {
    { const int tq = hfft::opaque(t); (void)tq;
#pragma unroll
    for (int m = 0; m < 32; ++m) { const int k = tq + 512 * m; int idx; bool cj;
        if (!odd) { cj = k > 8192; idx = cj ? 16384 - k : k; } else { cj = k >= 8192; idx = cj ? 16383 - k : k; }
        const f32x2 kv = ke[idx]; const float kr = kv.x, ki = cj ? -kv.y : kv.y;
        const float a = xr[m], b = xi[m]; xr[m] = a * kr - b * ki; xi[m] = a * ki + b * kr; if ((m & 15) == 15) { asm volatile("" ::: "memory"); __builtin_amdgcn_sched_barrier(0); } }
    }
}
__device__ __forceinline__ f32x2 ld_spec(const GAS f32x2* ke, int k, bool odd) {
    int idx; bool cj;
    if (!odd) { cj = k > 8192; idx = cj ? 16384 - k : k; } else { cj = k >= 8192; idx = cj ? 16383 - k : k; }
    f32x2 kv = ke[idx]; kv.y = cj ? -kv.y : kv.y; return kv;
}
__device__ __forceinline__ void cmul_spec2(float (&xr)[32], float (&xi)[32], const GAS f32x2* ka, const GAS f32x2* kb, LAS f32x2* buf, int t, bool odd) {
    __syncthreads();
    { const int tq = hfft::opaque(t);
#pragma unroll
      for (int m = 0; m < 32; ++m) buf[hfft::pad(tq + 512 * m)] = (f32x2){xr[m], xi[m]}; }
    __syncthreads();
    { const int tq = hfft::opaque(t);
#pragma unroll
      for (int m = 0; m < 32; ++m) { const int k = tq + 512 * m; const int rk = odd ? 16383 - k : ((16384 - k) & 16383);
          const f32x2 xc = buf[hfft::pad(rk)];
          const f32x2 a = ld_spec(ka, k, odd), b = ld_spec(kb, k, odd);
          const float sr = 0.5f * (a.x + b.x), si = 0.5f * (a.y + b.y), dr = 0.5f * (a.x - b.x), di = 0.5f * (a.y - b.y);
          const float x0 = xr[m], x1 = xi[m], c0 = xc.x, c1 = -xc.y;
          xr[m] = (x0 * sr - x1 * si) + (c0 * dr - c1 * di); xi[m] = (x0 * si + x1 * sr) + (c0 * di + c1 * dr);
          if ((m & 7) == 7) { asm volatile("" ::: "memory"); __builtin_amdgcn_sched_barrier(0); } } }
}
__device__ __forceinline__ void phase_hyena(Frame& F, int l) {
    const GAS bf16* UT = (const GAS bf16*)(wsq(F) + WS_UT); GAS bf16* YT = (GAS bf16*)(wsq(F) + WS_YT); const GAS f32x2* KEO = (const GAS f32x2*)(wsq(F) + WS_KEO);
    const GAS float* cw = inp(F, I_CONVW) + (size_t)l * 3 * HYP; const GAS float* cbv = inp(F, I_CONVB) + (size_t)l * HYP;
    LAS f32x2* buf = (LAS f32x2*)(F.lds + RING_OFF); const int t = F.tid;
    GAS f32x2* G0 = (GAS f32x2*)(wsq(F) + WS_G0) + (size_t)F.vcu * 16384 + t;
    GAS f32x2* G1 = (GAS f32x2*)(wsq(F) + (F.vcu < 200 ? WS_G1A + (size_t)F.vcu * 131072 : WS_G1B + (size_t)(F.vcu - 200) * 131072)) + t;
    for (int item = F.vcu; item < HYW + HYW / 2; item += F.G) {
        const bool mode1 = item >= HYW;
        const int c0 = mode1 ? 2 * (item - HYW) : item, c1 = mode1 ? c0 + 1 : c0;
        const size_t s0 = mode1 ? (size_t)2 * L : 0, s1 = mode1 ? (size_t)2 * L : (size_t)L;
        float ar[32], ai[32];
#pragma unroll 1
        for (int o = 0; o < 2; ++o) {
            const GAS f32x2* ke0 = KEO + (size_t)(o * HYW + c0) * KEO_BLK; const GAS f32x2* ke1 = KEO + (size_t)(o * HYW + c1) * KEO_BLK;
#pragma unroll 1
            for (int half = 0; half < 2; ++half) {
                if (o == 0) { const float w0 = cw[c0], w1 = cw[HYP + c0], w2 = cw[2 * HYP + c0], cb = cbv[c0], v0 = cw[c1], v1 = cw[HYP + c1], v2 = cw[2 * HYP + c1], vb = cbv[c1];
                    const GAS bf16* r0 = UT + (size_t)c0 * M + s0; const GAS bf16* r1 = UT + (size_t)c1 * M + s1;
                    { const int tq = hfft::opaque(t); (void)tq;
#pragma unroll
                    for (int m = 0; m < 32; ++m) { const int n = tq + 512 * m; ar[m] = u_conv3(r0, n, w0, w1, w2, cb); ai[m] = u_conv3(r1, n, v0, v1, v2, vb); if ((m & 15) == 15) { asm volatile("" ::: "memory"); __builtin_amdgcn_sched_barrier(0); } } }
                    }
                else {
                    { const int tq = hfft::opaque(t); (void)tq; GAS f32x2* G0q = G0 + (tq - t);
#pragma unroll
                    for (int m = 0; m < 32; ++m) { const f32x2 v = G0q[m * 512]; ar[m] = v.x; ai[m] = v.y; if ((m & 15) == 15) { asm volatile("" ::: "memory"); __builtin_amdgcn_sched_barrier(0); } } }
                    }
                if (half == 0) {
                    hfft::fft16k<false>(ar, ai, buf, t);
                    if (mode1) cmul_spec2(ar, ai, ke0, ke1, buf, t, false); else cmul_spec(ar, ai, ke0, t, false);
                    hfft::fft16k<true>(ar, ai, buf, t);
                    { const int tq = hfft::opaque(t); (void)tq; GAS f32x2* G1q = G1 + (tq - t);
#pragma unroll
                    for (int m = 0; m < 32; ++m) G1q[m * 512] = (f32x2){ar[m], ai[m]};
                    }
                } else {
                    { const int tq = hfft::opaque(t); (void)tq;
#pragma unroll
                    for (int m = 0; m < 32; ++m) { const float fr = (float)(tq + 512 * m) * (1.0f / 32768.0f); const float cs = __builtin_amdgcn_cosf(fr), sn = -__builtin_amdgcn_sinf(fr);
                        const float a = ar[m], b = ai[m]; ar[m] = a * cs - b * sn; ai[m] = a * sn + b * cs; }
                    }
                    hfft::fft16k<false>(ar, ai, buf, t);
                    if (mode1) cmul_spec2(ar, ai, ke0 + KEO_KO, ke1 + KEO_KO, buf, t, true); else cmul_spec(ar, ai, ke0 + KEO_KO, t, true);
                    hfft::fft16k<true>(ar, ai, buf, t);
                    const int g0 = (o + 1) * HYW + c0, g1 = (o + 1) * HYW + c1;
                    const float w0 = cw[g0], w1 = cw[HYP + g0], w2 = cw[2 * HYP + g0], cb = cbv[g0], v0 = cw[g1], v1 = cw[HYP + g1], v2 = cw[2 * HYP + g1], vb = cbv[g1];
                    const GAS bf16* r0 = UT + (size_t)g0 * M + s0; const GAS bf16* r1 = UT + (size_t)g1 * M + s1;
                    { const int tq = hfft::opaque(t); (void)tq; GAS f32x2* G1q = G1 + (tq - t);
#pragma unroll
                    for (int m = 0; m < 32; ++m) { const int n = tq + 512 * m; const float fr = (float)n * (1.0f / 32768.0f); const float cs = __builtin_amdgcn_cosf(fr), sn = __builtin_amdgcn_sinf(fr);
                        const float a = ar[m], b = ai[m]; const f32x2 e = G1q[m * 512]; const float yr = e.x + (a * cs - b * sn), yi = e.y + (a * sn + b * cs);
                        ar[m] = yr * u_conv3(r0, n, w0, w1, w2, cb); ai[m] = yi * u_conv3(r1, n, v0, v1, v2, vb); if ((m & 15) == 15) { asm volatile("" ::: "memory"); __builtin_amdgcn_sched_barrier(0); } }
                    }
                    if (o == 0) {
                        { const int tq = hfft::opaque(t); (void)tq; GAS f32x2* G0q = G0 + (tq - t);
#pragma unroll
                        for (int m = 0; m < 32; ++m) G0q[m * 512] = (f32x2){ar[m], ai[m]};
                        }
                    } else { GAS bf16* y0 = YT + (size_t)c0 * M + s0; GAS bf16* y1 = YT + (size_t)c1 * M + s1;
                        { const int tq = hfft::opaque(t); (void)tq;
#pragma unroll
                        for (int m = 0; m < 32; ++m) { const int n = tq + 512 * m; y0[n] = f2bf(ar[m]); y1[n] = f2bf(ai[m]); } }
                        }
                }
            }
        }
    }
    __syncthreads();
}

__device__ __forceinline__ void phase_mla_prep(Frame& F, int l) {
    const GAS bf16* CQKV = (const GAS bf16*)(wsq(F) + WS_CQKV); GAS bf16* CQN = (GAS bf16*)(wsq(F) + WS_CQN); GAS bf16* CKVN = (GAS bf16*)(wsq(F) + WS_CKVN); GAS bf16* KPE = (GAS bf16*)(wsq(F) + WS_KPE);
    const GAS float* gq = inp(F, I_QNORM) + l * QR; const GAS float* gkv = inp(F, I_KVNORM) + l * KVR; const GAS float* ct = (const GAS float*)(wsq(F) + WS_COS); const GAS float* st = (const GAS float*)(wsq(F) + WS_SIN);
    const int gw = F.vcu * NWAVES + F.wave, NGW = F.G * NWAVES, lane = F.lane;
    for (int m = gw; m < M; m += NGW) {
        const GAS bf16* row = CQKV + (size_t)m * 512;
        const v2u q = *(const GAS v2u*)(row + 4 * lane); const unsigned kv = *(const GAS unsigned*)(row + 256 + 2 * lane);
        const float q0 = bf2f(q.x & 0xffffu), q1 = bf2f(q.x >> 16), q2 = bf2f(q.y & 0xffffu), q3 = bf2f(q.y >> 16), k0 = bf2f(kv & 0xffffu), k1 = bf2f(kv >> 16);
        const float rq = 1.0f / sqrtf(wave_sum((q0 * q0 + q1 * q1) + (q2 * q2 + q3 * q3)) * (1.0f / QR) + EPS);
        const float rk = 1.0f / sqrtf(wave_sum(k0 * k0 + k1 * k1) * (1.0f / KVR) + EPS);
        const f32x4 g4 = *(const GAS f32x4*)(gq + 4 * lane); const f32x2 g2 = *(const GAS f32x2*)(gkv + 2 * lane);
        v2u oq; oq.x = pk2(q0 * rq * g4.x, q1 * rq * g4.y); oq.y = pk2(q2 * rq * g4.z, q3 * rq * g4.w);
        *(GAS v2u*)(CQN + (size_t)m * QR + 4 * lane) = oq;
        *(GAS unsigned*)(CKVN + (size_t)m * KVR + 2 * lane) = pk2(k0 * rk * g2.x, k1 * rk * g2.y);
        if (lane < 16) { const int j = lane, tpos = m & (L - 1); const float x1 = bf2f(row[384 + j]), x2 = bf2f(row[384 + 16 + j]); const float cs = ct[tpos * 16 + j], sn = st[tpos * 16 + j];
            const int p1 = 8 * (j >> 2) + (j & 3); KPE[(size_t)m * ROPE + p1] = f2bf(x1 * cs - x2 * sn); KPE[(size_t)m * ROPE + p1 + 4] = f2bf(x2 * cs + x1 * sn); }
    }
}

__device__ __forceinline__ void phase_hy_out(Frame& F, int l) {
    const GAS bf16* YT = (const GAS bf16*)(wsq(F) + WS_YT); GAS bf16* MIX = (GAS bf16*)(wsq(F) + WS_MIX); const GAS float* gn = inp(F, I_GNHY) + l * HYW;
    LAS bf16* tl = (LAS bf16*)(F.lds + RING_OFF + F.wave * 16384);
    const int gw = F.vcu * NWAVES + F.wave, NGW = F.G * NWAVES, lane = F.lane;
    for (int task = gw; task < 8 * (M / 64); task += NGW) {
        const int g = task & 7, tb = task >> 3, tok0 = tb * 64; const int cl = lane >> 3, t8 = (lane & 7) * 8;
        float v[8][8]; float ss[8]; const int ln_ = hw_lane();
#pragma unroll
        for (int j = 0; j < 8; ++j) ss[j] = 0.f;
#pragma unroll
        for (int i = 0; i < 8; ++i) { const int ch = g * 64 + 8 * i + cl; const v4u w = *(const GAS v4u*)(YT + (size_t)ch * M + tok0 + t8);
            v[i][0] = bf2f(w.x & 0xffffu); v[i][1] = bf2f(w.x >> 16); v[i][2] = bf2f(w.y & 0xffffu); v[i][3] = bf2f(w.y >> 16);
            v[i][4] = bf2f(w.z & 0xffffu); v[i][5] = bf2f(w.z >> 16); v[i][6] = bf2f(w.w & 0xffffu); v[i][7] = bf2f(w.w >> 16);
#pragma unroll
            for (int j = 0; j < 8; ++j) ss[j] += v[i][j] * v[i][j]; }
#pragma unroll
        for (int j = 0; j < 8; ++j) { float s = ss[j]; s += shx(s, ln_, 8); s += shx(s, ln_, 16); s += shx(s, ln_, 32); ss[j] = 1.0f / sqrtf(s * (1.0f / 64.0f) + EPS); }
#pragma unroll
        for (int i = 0; i < 8; ++i) { const int cc = 8 * i + cl; const float gg = gn[g * 64 + cc];
#pragma unroll
            for (int j = 0; j < 8; ++j) tl[(t8 + j) * 72 + cc] = f2bf(v[i][j] * ss[j] * gg); }
        LDS_WAIT(); asm volatile("" ::: "memory");
#pragma unroll
        for (int i = 0; i < 8; ++i) { const int tok = 8 * i + (lane >> 3), c8 = (lane & 7) * 8; const v4u w = *(const LAS v4u*)(tl + tok * 72 + c8);
            *(GAS v4u*)(MIX + (size_t)(tok0 + tok) * D + g * 64 + c8) = w; }
        LDS_WAIT(); asm volatile("" ::: "memory");
    }
}

namespace att {
using s16x4 = __attribute__((ext_vector_type(4))) short;
using f32x16 = __attribute__((ext_vector_type(16))) float;
using u32x4 = __attribute__((ext_vector_type(4))) unsigned;
constexpr int QBLK = 32, KVBLK = 64, NW = 8;
constexpr float SCALE = 0.10206207261596575f;
constexpr float THR = 8.f;
constexpr int SHM_K = KVBLK * 256, SHM_V = KVBLK * DV * 2;
constexpr int NSLOT = 4;
constexpr int OFF_V = 0, OFF_K = NSLOT * SHM_V, OFF_WS = OFF_K + NSLOT * SHM_K, SHM_ATTN = OFF_WS + NW * 64 * 4;
#define KSWZ(row, colB) ((row) * 256 + ((colB) ^ (((row) & 15) << 4)))
#define SBAR() __builtin_amdgcn_sched_barrier(0)
__device__ __forceinline__ int crow(int r, int hi) { return (r & 3) + 8 * (r >> 2) + 4 * hi; }
__device__ __forceinline__ unsigned cvtpk(float lo, float hi) { unsigned r; asm volatile("v_cvt_pk_bf16_f32 %0, %1, %2" : "=v"(r) : "v"(lo), "v"(hi)); return r; }
constexpr float THRL = THR * 1.4426950408889634f;
#define EX2(v) ((ABL & 1) ? (v) : __builtin_amdgcn_exp2f(v))
#define MX3(a, b, c) ((ABL & 128) ? (a) : __builtin_fmaxf(__builtin_fmaxf((a), (b)), (c)))
__device__ __forceinline__ int v_st(int k, int c) { const int kk = k; return ((kk >> 3) * 2 + (c >> 5)) * 512 + ((kk & 7) * 32 + (c & 31)) * 2; }
__device__ __forceinline__ int v_rd_base(int lane) { return ((lane & 3) << 3) | (((lane >> 2) & 3) << 6) | (((lane >> 4) & 1) << 5) | (((lane >> 5) & 1) << 8); }
constexpr int v_rd_off(int d0, int ks, int half) { return d0 * 512 + ks * 2048 + half * 1024; }
template <int OFF> __device__ __forceinline__ s16x4 tr_read(int vb) { s16x4 r; asm volatile("ds_read_b64_tr_b16 %0, %1 offset:%2" : "=&v"(r) : "v"(vb), "i"(OFF) : "memory"); return r; }
template <int ABL> __device__ __forceinline__ void attn_unit(const bf16* Qb_, const bf16* KNh_, const bf16* KPEb_, const bf16* Vh_, bf16* Mo_,
                                          const float* gain_, const float* ct_, const float* st_, int tpos0, LAS char* lds, const int wave0) {
  const GAS bf16* Qb = (const GAS bf16*)Qb_; const GAS bf16* KNh = (const GAS bf16*)KNh_; const GAS bf16* KPEb = (const GAS bf16*)KPEb_; const GAS bf16* Vh = (const GAS bf16*)Vh_; GAS bf16* Mo = (GAS bf16*)Mo_;
  const GAS float* gain = (const GAS float*)gain_; const GAS float* ct = (const GAS float*)ct_; const GAS float* st = (const GAS float*)st_;

  int tid_ = tid_from_wave(wave0);
  const int tid = tid_, wid = tid >> 6, lane = tid & 63, r32 = lane & 31, hi = lane >> 5;
  LAS char* V_lds = lds + OFF_V; LAS char* K_lds = lds + OFF_K;
  LAS float* ws = (LAS float*)(lds + OFF_WS) + wid * 64; LAS float* li_l = ws; LAS float* al_l = ws + 32;
  float m_reg = 0.f, l_reg = 0.f; f32x16 o[2] = {}; f32x16 negm = {}; bf16x8 qr[6];
  const GAS bf16* Qw = Qb + (long)(wid * QBLK + r32) * NQ + hi * 8;
#pragma unroll
  for (int d0 = 0; d0 < 6; ++d0) qr[d0] = *reinterpret_cast<const GAS bf16x8*>(Qw + d0 * 16);
  { const int tq = tpos0 + wid * QBLK + r32;
#pragma unroll
    for (int d0 = 4; d0 < 6; ++d0) { const int fq = 2 * (d0 - 4) + hi; const f32x4 cs = *reinterpret_cast<const GAS f32x4*>(ct + tq * 16 + 4 * fq), sn = *reinterpret_cast<const GAS f32x4*>(st + tq * 16 + 4 * fq);
      const u32x4 w = __builtin_bit_cast(u32x4, qr[d0]);
      const f32x4 x1 = {bf2f(w[0] & 0xffffu), bf2f(w[0] >> 16), bf2f(w[1] & 0xffffu), bf2f(w[1] >> 16)}, x2 = {bf2f(w[2] & 0xffffu), bf2f(w[2] >> 16), bf2f(w[3] & 0xffffu), bf2f(w[3] >> 16)};
      const f32x4 a = x1 * cs - x2 * sn, b = x2 * cs + x1 * sn;
      const u32x4 o4 = {cvtpk(a[0], a[1]), cvtpk(a[2], a[3]), cvtpk(b[0], b[1]), cvtpk(b[2], b[3])}; qr[d0] = __builtin_bit_cast(bf16x8, o4); } }
  { constexpr float C = SCALE * 1.4426950408889634f;
#pragma unroll
    for (int d0 = 0; d0 < 6; ++d0) { const u32x4 w = __builtin_bit_cast(u32x4, qr[d0]); u32x4 o4;
#pragma unroll
      for (int e = 0; e < 4; ++e) o4[e] = cvtpk(bf2f(w[e] & 0xffffu) * C, bf2f(w[e] >> 16) * C);
      qr[d0] = __builtin_bit_cast(bf16x8, o4); } }
  const int vb0 = (int)(unsigned)(uintptr_t)V_lds + v_rd_base(lane);
  const int wid_s = __builtin_amdgcn_readfirstlane(wid);
  const GAS bf16* ksrc[2]; long kstep[2];
#pragma unroll
  for (int q = 0; q < 2; ++q) { const int r = 4 * (2 * wid + q) + (lane >> 4), c = (lane & 15) ^ (r & 15); const bool rope = (c >= 8) && (c < 12);
    ksrc[q] = rope ? KPEb + (long)r * ROPE + (c - 8) * 8 : KNh + (long)r * NKV + (c & 7) * 8; kstep[q] = rope ? (long)KVBLK * ROPE : (long)KVBLK * NKV; }
  const GAS bf16* vsrc; { const int p = 64 * wid + lane, sub = p >> 5, kk = (sub >> 1) * 8 + ((p >> 2) & 7), col = (sub & 1) * 32 + (p & 3) * 8; vsrc = Vh + (long)kk * NKV + col; }
#define DMA(t, slot) do { if (ABL & 32) break; \
    __builtin_amdgcn_global_load_lds((const GAS unsigned*)(ksrc[0] + (long)(t) * kstep[0]), (LAS unsigned*)(K_lds + (slot) * SHM_K + (2 * wid_s) * 1024), 16, 0, 0); \
    __builtin_amdgcn_global_load_lds((const GAS unsigned*)(ksrc[1] + (long)(t) * kstep[1]), (LAS unsigned*)(K_lds + (slot) * SHM_K + (2 * wid_s + 1) * 1024), 16, 0, 0); \
    __builtin_amdgcn_global_load_lds((const GAS unsigned*)(vsrc + (long)(t) * ((long)KVBLK * NKV)), (LAS unsigned*)(V_lds + (slot) * SHM_V + wid_s * 1024), 16, 0, 0); } while (0)
#define TBAR(N) do { asm volatile("s_waitcnt vmcnt(" #N ") lgkmcnt(0)" ::: "memory"); if (!(ABL & 64)) __builtin_amdgcn_s_barrier(); asm volatile("" ::: "memory"); } while (0)
#define RESC(a) do { if (__any((a) < 1.f)) { if (hi == 0) al_l[r32] = (a); asm volatile("s_waitcnt lgkmcnt(0)" ::: "memory"); \
    _Pragma("unroll") for (int d = 0; d < 2; ++d) _Pragma("unroll") for (int r = 0; r < 16; ++r) o[d][r] *= al_l[crow(r, hi)]; } } while (0)
  f32x16 pA0, pA1, pB0, pB1; bf16x8 pa0, pa1, pa2, pa3; constexpr int NTL = L / KVBLK; constexpr int SE = 0, SO = 1;
  int koff[6];
#pragma unroll
  for (int d0 = 0; d0 < 6; ++d0) koff[d0] = KSWZ(r32, (d0 * 16 + hi * 8) * 2);
  s16x4 vl[4], vh[4]; float pmax = 0.f, alpha = 1.f;
#define KFR(i) ((ABL & 8) ? qr[(i) >> 1] : *(const LAS bf16x8*)(kbase + koff[(i) >> 1] + ((i) & 1) * 8192))
#define MQK(a_, b_, c_) ((ABL & 2) ? (c_) : __builtin_amdgcn_mfma_f32_32x32x16_bf16(a_, b_, c_, 0, 0, 0))
#define MPV(a_, b_, c_) ((ABL & 4) ? (c_) : __builtin_amdgcn_mfma_f32_32x32x16_bf16(a_, b_, c_, 0, 0, 0))
#define VRD8(D0) do { if (ABL & 16) break; vl[0] = tr_read<v_rd_off(D0, 0, 0)>(vbq); vh[0] = tr_read<v_rd_off(D0, 0, 1)>(vbq); vl[1] = tr_read<v_rd_off(D0, 1, 0)>(vbq); vh[1] = tr_read<v_rd_off(D0, 1, 1)>(vbq); \
    vl[2] = tr_read<v_rd_off(D0, 2, 0)>(vbq); vh[2] = tr_read<v_rd_off(D0, 2, 1)>(vbq); vl[3] = tr_read<v_rd_off(D0, 3, 0)>(vbq); vh[3] = tr_read<v_rd_off(D0, 3, 1)>(vbq); } while (0)
#define VWAIT() if (!(ABL & 16)) asm volatile("s_waitcnt lgkmcnt(0)" : "+v"(vl[0]), "+v"(vh[0]), "+v"(vl[1]), "+v"(vh[1]), "+v"(vl[2]), "+v"(vh[2]), "+v"(vl[3]), "+v"(vh[3]) :: "memory")
#define VFR(k) (bf16x8){vl[k][0], vl[k][1], vl[k][2], vl[k][3], vh[k][0], vh[k][1], vh[k][2], vh[k][3]}
#define PKA(P, B) do { if (ABL & 256) break; w0_ = cvtpk(P[B + 0], P[B + 1]); w1_ = cvtpk(P[B + 2], P[B + 3]); } while (0)
#define PKB(P, B, OUT) do { if (ABL & 256) { OUT = qr[0]; break; } const u32x4 w_ = {w0_, w1_, cvtpk(P[B + 4], P[B + 5]), cvtpk(P[B + 6], P[B + 7])}; OUT = __builtin_bit_cast(bf16x8, w_); } while (0)
#define R1(DO_QK, DO_FIN, X0, X1, Y0, Y1, KSLOT) do { const LAS char* kbase = K_lds + (KSLOT) * SHM_K; bf16x8 kf0, kf1, kf2, kf3; unsigned w0_ = 0, w1_ = 0; \
    if (DO_QK) { kf0 = KFR(0); kf1 = KFR(1); kf2 = KFR(2); } SBAR(); \
      if (DO_QK) { kf3 = KFR(3); X0 = MQK(kf0, qr[0], negm); } if (DO_FIN) { Y0[0] = EX2(Y0[0]); Y0[1] = EX2(Y0[1]); Y0[2] = EX2(Y0[2]); Y0[3] = EX2(Y0[3]); } SBAR(); \
      if (DO_QK) { kf0 = KFR(4); X1 = MQK(kf1, qr[0], negm); } if (DO_FIN) { Y0[4] = EX2(Y0[4]); Y0[5] = EX2(Y0[5]); Y0[6] = EX2(Y0[6]); Y0[7] = EX2(Y0[7]); } SBAR(); \
      if (DO_QK) { kf1 = KFR(5); X0 = MQK(kf2, qr[1], X0); } if (DO_FIN) { Y0[8] = EX2(Y0[8]); Y0[9] = EX2(Y0[9]); Y0[10] = EX2(Y0[10]); Y0[11] = EX2(Y0[11]); } SBAR(); \
      if (DO_QK) { kf2 = KFR(6); X1 = MQK(kf3, qr[1], X1); } if (DO_FIN) { Y0[12] = EX2(Y0[12]); Y0[13] = EX2(Y0[13]); Y0[14] = EX2(Y0[14]); Y0[15] = EX2(Y0[15]); } SBAR(); \
      if (DO_QK) { kf3 = KFR(7); X0 = MQK(kf0, qr[2], X0); } if (DO_FIN) { Y1[0] = EX2(Y1[0]); Y1[1] = EX2(Y1[1]); Y1[2] = EX2(Y1[2]); Y1[3] = EX2(Y1[3]); PKA(Y0, 0); } SBAR(); \
      if (DO_QK) { kf0 = KFR(8); X1 = MQK(kf1, qr[2], X1); } if (DO_FIN) { Y1[4] = EX2(Y1[4]); Y1[5] = EX2(Y1[5]); Y1[6] = EX2(Y1[6]); Y1[7] = EX2(Y1[7]); PKB(Y0, 0, pa0); } SBAR(); \
      if (DO_QK) { kf1 = KFR(9); X0 = MQK(kf2, qr[3], X0); } if (DO_FIN) { Y1[8] = EX2(Y1[8]); Y1[9] = EX2(Y1[9]); Y1[10] = EX2(Y1[10]); Y1[11] = EX2(Y1[11]); PKA(Y0, 8); } SBAR(); \
      if (DO_QK) { kf2 = KFR(10); X1 = MQK(kf3, qr[3], X1); } if (DO_FIN) { Y1[12] = EX2(Y1[12]); Y1[13] = EX2(Y1[13]); Y1[14] = EX2(Y1[14]); Y1[15] = EX2(Y1[15]); PKB(Y0, 8, pa1); } SBAR(); \
      if (DO_QK) { kf3 = KFR(11); X0 = MQK(kf0, qr[4], X0); } if (DO_FIN) { PKA(Y1, 0); } SBAR(); \
      if (DO_QK) { X1 = MQK(kf1, qr[4], X1); } if (DO_FIN) { PKB(Y1, 0, pa2); } SBAR(); \
      if (DO_QK) { X0 = MQK(kf2, qr[5], X0); } if (DO_FIN) { PKA(Y1, 8); } SBAR(); \
      if (DO_QK) { X1 = MQK(kf3, qr[5], X1); } if (DO_FIN) { PKB(Y1, 8, pa3); } SBAR(); \
  } while (0)
#define R2(DO_PV, DO_MAX, X0, X1, Y0, Y1, VSLOT, LOADS) do { const int vbq = vb0 + (VSLOT) * SHM_V; float ma_ = 0.f, mb_ = 0.f, sa_ = 0.f; \
    if (DO_PV) { VRD8(0); } SBAR(); \
    if (DO_PV) { VWAIT(); o[0] = MPV(pa0, VFR(0), o[0]); if (!(ABL & 640)) sa_ = (Y0[0] + Y0[1]) + (Y0[2] + Y0[3]); } SBAR(); \
    if (DO_PV) { o[0] = MPV(pa1, VFR(1), o[0]); if (!(ABL & 640)) sa_ += Y0[4]; if (!(ABL & 640)) sa_ += Y0[5]; if (!(ABL & 640)) sa_ += Y0[6]; if (!(ABL & 640)) sa_ += Y0[7]; } LOADS; SBAR(); \
    if (DO_PV) { o[0] = MPV(pa2, VFR(2), o[0]); if (!(ABL & 640)) sa_ += Y0[8]; if (!(ABL & 640)) sa_ += Y0[9]; if (!(ABL & 640)) sa_ += Y0[10]; if (!(ABL & 640)) sa_ += Y0[11]; } SBAR(); \
    if (DO_PV) { o[0] = MPV(pa3, VFR(3), o[0]); if (!(ABL & 640)) sa_ += Y0[12]; if (!(ABL & 640)) sa_ += Y0[13]; if (!(ABL & 640)) sa_ += Y0[14]; if (!(ABL & 640)) sa_ += Y0[15]; } SBAR(); \
    if (DO_PV) { VRD8(1); if (!(ABL & 640)) sa_ += Y1[0]; if (!(ABL & 640)) sa_ += Y1[1]; if (!(ABL & 640)) sa_ += Y1[2]; if (!(ABL & 640)) sa_ += Y1[3]; if (!(ABL & 640)) sa_ += Y1[4]; if (!(ABL & 640)) sa_ += Y1[5]; if (!(ABL & 640)) sa_ += Y1[6]; if (!(ABL & 640)) sa_ += Y1[7]; } \
    if (DO_MAX) { ma_ = MX3(X0[0], X0[1], X1[0]); mb_ = MX3(X0[2], X0[3], X1[1]); ma_ = MX3(ma_, X1[2], X1[3]); ma_ = MX3(ma_, X0[4], X0[5]); mb_ = MX3(mb_, X0[6], X0[7]); ma_ = MX3(ma_, X1[4], X1[5]); mb_ = MX3(mb_, X1[6], X1[7]); } SBAR(); \
    if (DO_PV) { VWAIT(); o[1] = MPV(pa0, VFR(0), o[1]); if (!(ABL & 640)) sa_ += Y1[8]; if (!(ABL & 640)) sa_ += Y1[9]; if (!(ABL & 640)) sa_ += Y1[10]; if (!(ABL & 640)) sa_ += Y1[11]; } if (DO_MAX) { ma_ = MX3(ma_, X0[8], X0[9]); mb_ = MX3(mb_, X0[10], X0[11]); } SBAR(); \
    if (DO_PV) { o[1] = MPV(pa1, VFR(1), o[1]); if (!(ABL & 640)) sa_ += Y1[12]; if (!(ABL & 640)) sa_ += Y1[13]; if (!(ABL & 640)) sa_ += Y1[14]; if (!(ABL & 640)) sa_ += Y1[15]; } if (DO_MAX) { ma_ = MX3(ma_, X1[8], X1[9]); mb_ = MX3(mb_, X1[10], X1[11]); } SBAR(); \
    if (DO_PV) { o[1] = MPV(pa2, VFR(2), o[1]); l_reg += sa_; if (ABL & 512) { o[0] = MPV(pa0, qr[0], o[0]); o[0] = MPV(pa1, qr[0], o[0]); } } if (DO_MAX) { ma_ = MX3(ma_, X0[12], X0[13]); mb_ = MX3(mb_, X0[14], X0[15]); ma_ = MX3(ma_, X1[12], X1[13]); mb_ = MX3(mb_, X1[14], X1[15]); } SBAR(); \
    if (DO_PV) { o[1] = MPV(pa3, VFR(3), o[1]); if (ABL & 512) { o[0] = MPV(pa2, qr[0], o[0]); o[0] = MPV(pa3, qr[0], o[0]); } } if (DO_MAX) { float m_ = __builtin_fmaxf(ma_, mb_); auto rr_ = __builtin_amdgcn_permlane32_swap(__float_as_uint(m_), __float_as_uint(m_), false, false); pmax = __builtin_fmaxf(__uint_as_float(rr_[0]), __uint_as_float(rr_[1])); } SBAR(); \
  } while (0)
#define DECIDE(FIRST, X0, X1) do { alpha = 1.f; \
    if ((FIRST) || !__builtin_expect(__all(pmax <= THRL), 1)) { const float d_ = (FIRST) ? pmax : __builtin_fmaxf(pmax, 0.f); m_reg += d_; if (!(FIRST)) alpha = EX2(-d_); \
      _Pragma("unroll") for (int r = 0; r < 16; ++r) { X0[r] -= d_; X1[r] -= d_; } \
      _Pragma("unroll") for (int r = 0; r < 16; ++r) negm[r] = -m_reg; l_reg *= alpha; } \
    RESC(alpha); } while (0)
  DMA(0, 0); DMA(1, 1);
  TBAR(3);
  R1(true, false, pA0, pA1, pB0, pB1, 0);
  R2(false, true, pA0, pA1, pB0, pB1, 0, DMA(2, 2));
  DECIDE(true, pA0, pA1);
  TBAR(3);
  for (int j = 1; j + 1 < NTL; j += 2) {
    R1(true, true, pB0, pB1, pA0, pA1, j & 3);
    R2(true, true, pB0, pB1, pA0, pA1, (j - 1) & 3, DMA(j + 2, (j + 2) & 3));
    DECIDE(false, pB0, pB1);
    TBAR(3);
    R1(true, true, pA0, pA1, pB0, pB1, (j + 1) & 3);
    R2(true, true, pA0, pA1, pB0, pB1, j & 3, if (j + 3 < NTL) DMA(j + 3, (j + 3) & 3));
    DECIDE(false, pA0, pA1);
    if (j + 3 < NTL) TBAR(3); else TBAR(0);
  }
  R1(true, true, pB0, pB1, pA0, pA1, (NTL - 1) & 3);
  R2(true, true, pB0, pB1, pA0, pA1, (NTL - 2) & 3, (void)0);
  DECIDE(false, pB0, pB1);
  R1(false, true, pA0, pA1, pB0, pB1, 0);
  R2(true, false, pA0, pA1, pB0, pB1, (NTL - 1) & 3, (void)0);
#undef DECIDE
#undef R2
#undef R1
#undef PKA
#undef PKB
#undef VFR
#undef VWAIT
#undef VRD8
#undef KFR
  { auto rr = __builtin_amdgcn_permlane32_swap(__float_as_uint(l_reg), __float_as_uint(l_reg), false, false); l_reg = __uint_as_float(rr[0]) + __uint_as_float(rr[1]); }
  if (hi == 0) li_l[r32] = l_reg; asm volatile("s_waitcnt lgkmcnt(0)" ::: "memory");
  const float g0 = gain[r32], g1 = gain[32 + r32]; const int ln_ = hw_lane();
  GAS bf16* Ow = Mo + (long)(wid * QBLK) * D;
#pragma unroll
  for (int r = 0; r < 16; ++r) { const int orow = crow(r, hi); const float rl = __builtin_amdgcn_rcpf(li_l[orow]);
    const float y0 = o[0][r] * rl, y1 = o[1][r] * rl; float s = y0 * y0 + y1 * y1;
    s += shx(s, ln_, 1); s += shx(s, ln_, 2); s += shx(s, ln_, 4); s += shx(s, ln_, 8); s += shx(s, ln_, 16);
    const float rs = 1.0f / sqrtf(s * (1.0f / 64.0f) + EPS);
    Ow[(long)orow * D + r32] = f2bf(y0 * rs * g0); Ow[(long)orow * D + 32 + r32] = f2bf(y1 * rs * g1); }
  __syncthreads();
#undef DMA
#undef TBAR
#undef RESC
}
#undef EX2
#undef MX3
#undef KSWZ
#undef SBAR
}
#define XB_TMO      128
#define XB_XCNT(j)  (256  + 64 * (j))
#define XB_XSUB(j)  (1280 + 64 * (j))
#define XB_XGEN(j)  (2304 + 64 * (j))
#define XB_TOP      3328
#define XB_TOPGEN   3392
#define XCD_BAR_WORDS 3456
#define XB_SPIN_CAP (1u << 18)

__device__ __forceinline__ unsigned xb_ld(unsigned* p)              { return __hip_atomic_load(p, __ATOMIC_RELAXED, __HIP_MEMORY_SCOPE_AGENT); }
__device__ __forceinline__ unsigned xb_add(unsigned* p, unsigned v) { return __hip_atomic_fetch_add(p, v, __ATOMIC_RELAXED, __HIP_MEMORY_SCOPE_AGENT); }
__device__ __forceinline__ unsigned xb_xcc_id() { return (unsigned)__builtin_amdgcn_s_getreg((3 << 11) | 20) & 0xFu; }
#define XB_SPIN(cond, bar) do { unsigned _sp = 0; while (cond) { __builtin_amdgcn_s_sleep(1); \
    if ((++_sp & 255u) == 0u) { if (xb_ld(&(bar)[XB_TMO])) break; if (_sp > XB_SPIN_CAP) { atomicAdd(&(bar)[XB_TMO], 1u); break; } } } } while (0)

struct XcdBarrier {
    unsigned* bar; unsigned x;
    volatile LAS unsigned* st;
};

__device__ __forceinline__ XcdBarrier xcd_barrier_post(unsigned* bar, volatile LAS unsigned* st, const bool t0) {
    XcdBarrier b; b.bar = bar; b.x = xb_xcc_id(); b.st = st;
    if (t0) (void)xb_add(&bar[XB_XCNT(b.x)], 1u);
    return b;
}
__device__ __forceinline__ void xcd_barrier_complete(unsigned* bar, unsigned x, unsigned& nloc, unsigned& nx) {
    const unsigned G = gridDim.x * gridDim.y * gridDim.z;
    unsigned sum, cnt, mine, sp = 0u;
    for (;;) {
        sum = 0u; cnt = 0u; mine = 0u;
#pragma unroll
        for (unsigned j = 0; j < 16; ++j) { const unsigned c = xb_ld(&bar[XB_XCNT(j)]); sum += c; cnt += (c > 0u) ? 1u : 0u; mine = (j == x) ? c : mine; }
        if (sum == G) break;
        __builtin_amdgcn_s_sleep(1);
        if ((++sp & 255u) == 0u) { if (xb_ld(&bar[XB_TMO])) break; if (sp > XB_SPIN_CAP) { atomicAdd(&bar[XB_TMO], 1u); break; } }
    }
    nloc = mine > 0u ? mine : 1u; nx = cnt > 0u ? cnt : 1u;
}

__device__ __forceinline__ void xcd_barrier(const XcdBarrier& b, const bool t0) {
    asm volatile("s_waitcnt vmcnt(0)" ::: "memory");
    __syncthreads();
    if (t0) {
        unsigned* bar = b.bar;
        __builtin_amdgcn_s_waitcnt(0);
        unsigned nloc = b.st[0], nx = b.st[1];
        if (nloc == 0u) { xcd_barrier_complete(bar, b.x, nloc, nx); b.st[0] = nloc; b.st[1] = nx; }
        const unsigned old = xb_add(&bar[XB_XSUB(b.x)], 1u);
        const unsigned gen = old / nloc;
        if (old + 1u == (gen + 1u) * nloc) {
            __builtin_amdgcn_fence(__ATOMIC_RELEASE, "agent");
            asm volatile("s_waitcnt vmcnt(0)" ::: "memory");
            const unsigned og = xb_add(&bar[XB_TOP], 1u);
            const unsigned tg = og / nx;
            if (og + 1u == (tg + 1u) * nx) xb_add(&bar[XB_TOPGEN], 1u);
            else XB_SPIN(xb_ld(&bar[XB_TOPGEN]) == tg, bar);
            __builtin_amdgcn_fence(__ATOMIC_ACQUIRE, "agent");
            xb_add(&bar[XB_XGEN(b.x)], 1u);
            asm volatile("s_waitcnt vmcnt(0)" ::: "memory");
        } else {
            XB_SPIN(xb_ld(&bar[XB_XGEN(b.x)]) == gen, bar);
            __builtin_amdgcn_fence(__ATOMIC_ACQUIRE, "agent");
            asm volatile("s_waitcnt vmcnt(0)" ::: "memory");
        }
    }
    __syncthreads();
}

__device__ __forceinline__ void xcd_barrier_fast(const XcdBarrier& b, const bool t0) {
    asm volatile("s_waitcnt vmcnt(0)" ::: "memory");
    __syncthreads();
    if (t0) {
        unsigned* bar = b.bar; asm volatile("" : "+s"(bar));
        __builtin_amdgcn_s_waitcnt(0);
        unsigned nloc = b.st[0], nx = b.st[1];
        unsigned bx_ = b.x; asm volatile("" : "+s"(bx_));
        const unsigned old = xb_add(&bar[XB_XSUB(bx_)], 1u);
        const unsigned gen = old / nloc;
        if (old + 1u == (gen + 1u) * nloc) {
            __builtin_amdgcn_fence(__ATOMIC_RELEASE, "agent");
            asm volatile("s_waitcnt vmcnt(0)" ::: "memory");
            const unsigned og = xb_add(&bar[XB_TOP], 1u);
            const unsigned tg = og / nx;
            if (og + 1u == (tg + 1u) * nx) xb_add(&bar[XB_TOPGEN], 1u);
            else XB_SPIN(xb_ld(&bar[XB_TOPGEN]) == tg, bar);
            __builtin_amdgcn_fence(__ATOMIC_ACQUIRE, "agent");
            xb_add(&bar[XB_XGEN(bx_)], 1u);
            asm volatile("s_waitcnt vmcnt(0)" ::: "memory");
        } else {
            XB_SPIN(xb_ld(&bar[XB_XGEN(bx_)]) == gen, bar);
            __builtin_amdgcn_fence(__ATOMIC_ACQUIRE, "agent");
            asm volatile("s_waitcnt vmcnt(0)" ::: "memory");
        }
    }
    __syncthreads();
}

constexpr int CW_BAR = 4096;
struct Args { const float* in[26]; float* out; unsigned char* ws; };
#ifndef REP_ATT
#define REP_ATT 1
#endif
#ifndef REP_GEMM
#define REP_GEMM 1
#endif
#ifndef REP_HY
#define REP_HY 1
#endif
#ifndef REP_FILT
#define REP_FILT 1
#endif
#ifndef REP_MISC
#define REP_MISC 1
#endif
#ifndef PROBE_MASK
#define PROBE_MASK 0
#endif
#define TIC() do { if (PROBE_MASK) pr_t0 = __builtin_amdgcn_s_memrealtime(); } while (0)
#define TOC(ph) do { if (PROBE_MASK & (1u << (ph))) pr_acc += __builtin_amdgcn_s_memrealtime() - pr_t0; } while (0)
#define REPEAT(n) _Pragma("unroll 1") for (int rep_ = 0; rep_ < (n); ++rep_)
#define REFRESH() do { const int t_ = tid_from_wave(F.wave0); F.tid = t_; F.lane = t_ & 63; F.wave = __builtin_amdgcn_readfirstlane(t_ >> 6); int v_ = F.vcu; asm volatile("" : "+s"(v_)); F.vcu = v_; } while (0)
#define BXQ() ({ int b_ = (int)blockIdx.x; asm volatile("" : "+s"(b_)); b_; })
#define GEMM_PHASE(EPI, g, S, E) REPEAT(REP_GEMM) pg8::gemm_phase<EPI, pg8::StaticOrder, true, true>(F.lds + RING_OFF, g, S, E, F.wave0)

__global__ void __launch_bounds__(NTHR, 2) hyena_mla_fwd(Args args) {
    extern __shared__ __attribute__((aligned(16))) unsigned char lds[];
    Frame F;
    F.lds = (LAS unsigned char*)lds;
    F.MISC = (volatile LAS unsigned*)(F.lds + MISC_OFF);
    F.tid = threadIdx.x; F.lane = F.tid & 63; F.wave = __builtin_amdgcn_readfirstlane(F.tid >> 6); F.wave0 = F.wave;
    F.G = gridDim.x; { const int bx = blockIdx.x; F.vcu = (F.G % 8 == 0) ? (bx % 8) * (F.G / 8) + bx / 8 : bx; }
    F.ws = args.ws; F.out = args.out; F.ctl = (gu32*)(args.ws + WS_CTL);
    if (F.tid == 0) {
#pragma unroll
        for (int i = 0; i < 26; ++i) *(LAS unsigned long long*)(F.lds + PTRTAB_OFF + 8 * i) = (unsigned long long)args.in[i];
    }
    for (int u = F.tid; u < 512 / 4; u += NTHR) ((LAS unsigned*)(F.lds + LDSCTL_OFF))[u] = 0u;
    __syncthreads();
    XcdBarrier bar = xcd_barrier_post((unsigned*)(F.ctl + CW_BAR), F.MISC + 8, F.tid == 0);
    xcd_barrier(bar, F.tid == 0);
    unsigned long long pr_t0 = 0, pr_acc = 0; (void)pr_t0;
#pragma unroll 1
    for (int l = 0; l < DEPTH; ++l) {
        TIC();
        REPEAT(REP_MISC) { REFRESH(); phase_weights(F, l); }
        __syncthreads();
        REFRESH(); phase_filter_mlp(F, l);
        if (l == 0) { REFRESH(); phase_rope_tab(F); REFRESH(); phase_norm_first(F, 0, inp(F, I_NMIXPRE)); }
        { REFRESH(); xcd_barrier_fast(bar, F.tid == 0); } TOC(0); TIC();
        { unsigned char* w = (unsigned char*)wsq(F); pg8::Gemm g{(bf16*)(w + WS_W3T), (bf16*)(w + WS_H2), 2048, L, 128}; pg8::StaticOrder S; S.init(2048, L, F.G, BXQ());
          pg8::EpiTaps E{(float*)(w + WS_KT), (const float*)inp(F, I_DECAY) + (size_t)l * 2048}; GEMM_PHASE(pg8::EpiTaps, g, S, E); }
        { REFRESH(); xcd_barrier_fast(bar, F.tid == 0); } TOC(1); TIC();
        REPEAT(REP_FILT) { REFRESH(); phase_filter_fft(F, l); }
        { REFRESH(); xcd_barrier_fast(bar, F.tid == 0); } TOC(2); TIC();
        { unsigned char* w = (unsigned char*)wsq(F); bf16* WinT = (bf16*)(w + WS_WIN); bf16* XN = (bf16*)(w + WS_XN); bf16* UT = (bf16*)(w + WS_UT); bf16* CQKV = (bf16*)(w + WS_CQKV);
          { pg8::Gemm g{WinT, XN, HYP, M, D}; pg8::StaticOrder S; S.init(HYP, M, F.G, BXQ());
          pg8::EpiBf16<0> E{UT, M, nullptr, 0, 0, 1.f}; GEMM_PHASE(pg8::EpiBf16<0>, g, S, E); }
        { pg8::Gemm g{XN, WinT + (size_t)HYP * D, M, 512, D}; pg8::StaticOrder S; S.init(M, 512, F.G, (BXQ() + 128) % F.G);
          pg8::EpiBf16<0> E{CQKV, 512, nullptr, 0, 0, 1.f}; GEMM_PHASE(pg8::EpiBf16<0>, g, S, E); } }
        { REFRESH(); xcd_barrier_fast(bar, F.tid == 0); } TOC(3); TIC();
        REPEAT(REP_MISC) { REFRESH(); phase_mla_prep(F, l); }
        REPEAT(REP_HY) { REFRESH(); phase_hyena(F, l); }
        { REFRESH(); xcd_barrier_fast(bar, F.tid == 0); } TOC(4); TIC();
        { unsigned char* w = (unsigned char*)wsq(F); bf16* CQN = (bf16*)(w + WS_CQN); bf16* CKVN = (bf16*)(w + WS_CKVN); bf16* WuqT = (bf16*)(w + WS_WUQ); bf16* WukvT = (bf16*)(w + WS_WUKV);
          bf16* Qb = (bf16*)(w + WS_Q); bf16* KV = (bf16*)(w + WS_KN);
          { pg8::Gemm g{CQN, WuqT, M, NQ, QR}; pg8::StaticOrder S; S.init(M, NQ, F.G, BXQ());
          pg8::EpiBf16<0> E{Qb, NQ, nullptr, 0, 0, 1.f}; GEMM_PHASE(pg8::EpiBf16<0>, g, S, E); }
        { pg8::Gemm g{CKVN, WukvT, M, NKV, KVR}; pg8::StaticOrder S; S.init(M, NKV, F.G, BXQ());
          pg8::EpiBf16<0> E{KV, NKV, nullptr, 0, 0, 1.f}; GEMM_PHASE(pg8::EpiBf16<0>, g, S, E); } }
        { REFRESH(); xcd_barrier_fast(bar, F.tid == 0); } TOC(5); TIC();
        REFRESH();
        { unsigned char* w = (unsigned char*)wsq(F); bf16* Qb = (bf16*)(w + WS_Q); bf16* KV = (bf16*)(w + WS_KN); bf16* KPE = (bf16*)(w + WS_KPE); bf16* MIX = (bf16*)(w + WS_MIX);
          const float* ct = (const float*)(w + WS_COS); const float* st = (const float*)(w + WS_SIN); const float* gat = (const float*)inp(F, I_GNAT) + l * 512;
        REPEAT(REP_ATT) for (int i = 0; i < (F.G == 256 ? 6 : (1536 - F.vcu + F.G - 1) / F.G); ++i) {
            const int u_ = F.vcu + i * F.G; const int bh = F.G == 256 ? 3 * (F.vcu >> 5) + (i >> 1) : u_ >> 6, qb = F.G == 256 ? (i & 1) * 32 + (F.vcu & 31) : u_ & 63; const int b = bh >> 3, h = bh & 7;
            const size_t row0 = (size_t)b * L + (size_t)qb * 256;
            att::attn_unit<0>(Qb + row0 * NQ + h * DQ, KV + (size_t)b * L * NKV + h * 128, KPE + (size_t)b * L * ROPE, KV + (size_t)b * L * NKV + h * 128 + 64,
                           MIX + row0 * D + 512 + h * 64, gat + h * 64, ct, st, qb * 256, (LAS char*)(F.lds + RING_OFF), F.wave0);
        } }
        REPEAT(REP_MISC) { REFRESH(); phase_hy_out(F, l); }
        { REFRESH(); xcd_barrier_fast(bar, F.tid == 0); } TOC(6); TIC();
        { unsigned char* w = (unsigned char*)wsq(F); bf16* MIX = (bf16*)(w + WS_MIX); bf16* WoutT = (bf16*)(w + WS_WOUT); bf16* T = (bf16*)(w + WS_T);
          pg8::Gemm g{MIX, WoutT, M, D, D}; pg8::StaticOrder S; S.init(M, D, F.G, BXQ());
          pg8::EpiBf16<0> E{T, D, nullptr, 0, 0, 1.f}; GEMM_PHASE(pg8::EpiBf16<0>, g, S, E); }
        { REFRESH(); xcd_barrier_fast(bar, F.tid == 0); } TOC(7); TIC();
        REFRESH(); phase_norm_res(F, l, (const GAS bf16*)(wsq(F) + WS_T), inp(F, I_NMIXPOST) + l * D, inp(F, I_NMLPPRE) + l * D);
        { REFRESH(); xcd_barrier_fast(bar, F.tid == 0); } TOC(8); TIC();
#pragma unroll 1
        for (int ch = 0; ch < N_MLP_CHUNKS; ++ch) {
            { unsigned char* w = (unsigned char*)wsq(F); bf16* XN = (bf16*)(w + WS_XN); bf16* WupT = (bf16*)(w + WS_WUP); bf16* Hb = (bf16*)(w + WS_H);
              pg8::Gemm g{XN + (size_t)ch * MLP_CHUNK * D, WupT, MLP_CHUNK, FF, D}; pg8::StaticOrder S; S.init(MLP_CHUNK, FF, F.G, BXQ());
              pg8::EpiRelu2 E{Hb, FF}; GEMM_PHASE(pg8::EpiRelu2, g, S, E); }
            { REFRESH(); xcd_barrier_fast(bar, F.tid == 0); } TOC(9); TIC();
            { unsigned char* w = (unsigned char*)wsq(F); bf16* Hb = (bf16*)(w + WS_H); bf16* WdownT = (bf16*)(w + WS_WDOWN); bf16* T = (bf16*)(w + WS_T);
              pg8::Gemm g{Hb, WdownT, MLP_CHUNK, D, FF}; pg8::StaticOrder S; S.init(MLP_CHUNK, D, F.G, BXQ());
              pg8::EpiBf16<0> E{T + (size_t)ch * MLP_CHUNK * D, D, nullptr, 0, 0, 1.f}; GEMM_PHASE(pg8::EpiBf16<0>, g, S, E); }
            { REFRESH(); xcd_barrier_fast(bar, F.tid == 0); } TOC(10); TIC();
        }
        REFRESH(); phase_norm_res(F, 1, (const GAS bf16*)(wsq(F) + WS_T), inp(F, I_NMLPPOST) + l * D, (l + 1 < DEPTH) ? inp(F, I_NMIXPRE) + (l + 1) * D : (const GAS float*)nullptr);
        { REFRESH(); xcd_barrier_fast(bar, F.tid == 0); } TOC(11); TIC();
    }
    if (PROBE_MASK) { const unsigned long long ts = __builtin_amdgcn_s_memrealtime(); while (__builtin_amdgcn_s_memrealtime() - ts < pr_acc) __builtin_amdgcn_s_sleep(8); }
}


#ifdef ATT_BENCH
__global__ void __launch_bounds__(NTHR, 2) attn_bench(Args args) {
    extern __shared__ __attribute__((aligned(16))) unsigned char lds[];
    unsigned char* w = args.ws; const int wave0 = __builtin_amdgcn_readfirstlane(threadIdx.x >> 6);
    const int G = gridDim.x, bxv = (int)blockIdx.x, vcu = (bxv % 8) * (G / 8) + bxv / 8;
    bf16* Qb = (bf16*)(w + WS_Q); bf16* KV = (bf16*)(w + WS_KN); bf16* KPE = (bf16*)(w + WS_KPE); bf16* OUT = (bf16*)(w + WS_H);
    const float* ct = (const float*)(w + WS_COS); const float* st = (const float*)(w + WS_SIN);
    for (int rep = 0; rep < ATT_BENCH_REPS; ++rep)
    for (int i = 0; i < 6; ++i) {
        const int bh = 3 * (vcu >> 5) + (i >> 1), qb = (i & 1) * 32 + (vcu & 31); const int b = bh >> 3, h = bh & 7;
        const size_t row0 = (size_t)b * L + (size_t)qb * 256;
        att::attn_unit<ATT_BENCH>(Qb + row0 * NQ + h * DQ, KV + (size_t)b * L * NKV + h * 128, KPE + (size_t)b * L * ROPE, KV + (size_t)b * L * NKV + h * 128 + 64,
                       OUT + row0 * D + 512 + h * 64, args.in[I_GNAT] + h * 64, ct, st, qb * 256, (LAS char*)lds, wave0);
    }
}
#endif
extern "C" void kernel_launch(void* const* d_in, const int* in_sizes, int n_in, void* d_out, int out_size, void* d_ws, size_t ws_size, hipStream_t stream) {
    static int grid = 0;
    if (grid == 0) {
        if (n_in != 26 || out_size != M * D || ws_size < WS_END) { fprintf(stderr, "kernel_launch: shape mismatch n_in %d out %d ws %zu (need %zu)\n", n_in, out_size, ws_size, (size_t)WS_END); grid = -1; return; }
        int dev = 0, cus = 0, per_cu = 0;
        if (hipGetDevice(&dev) != hipSuccess || hipDeviceGetAttribute(&cus, hipDeviceAttributeMultiprocessorCount, dev) != hipSuccess) { grid = -1; return; }
        if (hipFuncSetAttribute((const void*)hyena_mla_fwd, hipFuncAttributeMaxDynamicSharedMemorySize, LDS_BYTES) != hipSuccess) { fprintf(stderr, "kernel_launch: hipFuncSetAttribute failed\n"); grid = -1; return; }
        if (hipOccupancyMaxActiveBlocksPerMultiprocessor(&per_cu, (const void*)hyena_mla_fwd, NTHR, LDS_BYTES) != hipSuccess || per_cu < 1) fprintf(stderr, "kernel_launch: occupancy query says %d\n", per_cu);
        (void)hipGetLastError();
        grid = cus;
    }
    if (grid < 0) return;
    if (hipMemsetAsync((char*)d_ws + WS_CTL, 0, CTL_ZERO_BYTES, stream) != hipSuccess) { fprintf(stderr, "kernel_launch: memset failed\n"); return; }
    Args a{};
    for (int i = 0; i < 26; ++i) a.in[i] = (const float*)d_in[i];
    a.out = (float*)d_out; a.ws = (unsigned char*)d_ws;
    hipLaunchKernelGGL(hyena_mla_fwd, dim3(grid), dim3(NTHR), LDS_BYTES, stream, a);
#ifdef ATT_BENCH
    { static int once = 0; if (!once) { (void)hipFuncSetAttribute((const void*)attn_bench, hipFuncAttributeMaxDynamicSharedMemorySize, LDS_BYTES); once = 1; }
      hipLaunchKernelGGL(attn_bench, dim3(grid), dim3(NTHR), LDS_BYTES, stream, a); }
#endif
    const hipError_t le = hipPeekAtLastError();
    if (le != hipSuccess) fprintf(stderr, "kernel_launch: launch failed: %s\n", hipGetErrorName(le));
}
```

```cpp
#include <hip/hip_runtime.h>
#include <cstdio>
#include <cstdint>
__device__ __forceinline__ int hw_lane() { int l; asm volatile("v_mbcnt_lo_u32_b32 %0, -1, 0\n\tv_mbcnt_hi_u32_b32 %0, -1, %0" : "=v"(l)); return l; }
__device__ __forceinline__ int tid_from_wave(int wave0) { int w = wave0; asm volatile("" : "+s"(w)); int t = w * 64 + hw_lane(); asm volatile("" : "+v"(t)); return t; }
namespace pg8 {
#define PG8_LAS __attribute__((address_space(3)))
#define PG8_GAS __attribute__((address_space(1)))
typedef unsigned short bf16_t;
typedef short bf16x8 __attribute__((ext_vector_type(8)));
typedef float f32x4 __attribute__((ext_vector_type(4)));
typedef unsigned u32x4 __attribute__((ext_vector_type(4)));
constexpr int BM = 256, BK = 64, HALF = 128, HTB = HALF * BK * 2  , STAGE_BYTES = 8 * HTB, NXCD = 8, WGM = 8;

__host__ __device__ __forceinline__ int lds_byte(int r, int c) { const int st = (r >> 4) * 2 + (c >> 5), rr = r & 15, cc = c & 31, ob = rr * 64 + cc * 2; return st * 1024 + (ob ^ (((ob >> 9) & 1) << 5)); }
__host__ __device__ __forceinline__ void stage_rc(int b, int& R, int& C) { const int st = b / 1024, sb = b % 1024, swz = sb ^ (((sb >> 9) & 1) << 5); R = (st >> 1) * 16 + swz / 64; C = (st & 1) * 32 + (swz % 64) / 2; }
__host__ __device__ __forceinline__ int perm32(int rho) { const int n = rho >> 4, i = rho & 15; return 8 * (i >> 2) + 4 * n + (i & 3); }

struct Unit { int pm, pn; };
struct Gemm { const bf16_t* A; const bf16_t* Bt; int M, N, K; };

struct StaticOrder {
    int nM, nN, nwg, G, c;
    __host__ __device__ void init(int M, int N, int G_, int c_) { nM = M / BM; nN = N / BM; nwg = nM * nN; G = G_; c = c_; }
    __host__ __device__ bool next(int i, Unit& u) const {
        const long L = (long)i * G + c; if (L >= nwg) return false;
        int wgid = (int)L; { const int q = nwg / NXCD, r = nwg % NXCD, xcd = wgid % NXCD, off = wgid / NXCD; wgid = (xcd < r ? xcd * (q + 1) : r * (q + 1) + (xcd - r) * q) + off; }
        const int nig = WGM * nN, gid = wgid / nig, fm = gid * WGM, gsz = (nM - fm) < WGM ? (nM - fm) : WGM;
        u.pm = fm + ((wgid % nig) % gsz); u.pn = (wgid % nig) / gsz; return true;
    }
    __device__ __forceinline__ void a_ready(const Unit&) const {}
    __device__ __forceinline__ void done(const Unit&) const {}
};

__device__ __forceinline__ unsigned cvt_pk_bf16(float lo, float hi) { unsigned r; asm volatile("v_cvt_pk_bf16_f32 %0, %1, %2" : "=v"(r) : "v"(lo), "v"(hi)); return r; }
typedef float f32x2 __attribute__((ext_vector_type(2)));
__device__ __forceinline__ void relane(int& wr, int& wc, int& fr, int& fq) { int l = hw_lane(); asm volatile("" : "+v"(l)); fr = l & 15; fq = l >> 4; (void)wr; (void)wc; }
__device__ __forceinline__ f32x2 gelu_pk(f32x2 v) {
    const f32x2 av = __builtin_elementwise_abs(v), d = av * 0.2316418882f + 1.0f;
    f32x2 t; t.x = __builtin_amdgcn_rcpf(d.x); t.y = __builtin_amdgcn_rcpf(d.y);
    f32x2 q = t * 0.5307027145f + (-0.7265760135f); q = q * t + 0.7107068705f; q = q * t + (-0.142248368f); q = q * t + 0.127414796f; q = q * t;
    const f32x2 s = (v * v) * (-0.72134752044f);
    f32x2 e; e.x = __builtin_amdgcn_exp2f(s.x); e.y = __builtin_amdgcn_exp2f(s.y);
    const f32x2 m = v * (q * e), r = v - m;
    f32x2 o; o.x = v.x < 0.f ? m.x : r.x; o.y = v.y < 0.f ? m.y : r.y; return o;
}

template <int ACT  > struct EpiBf16 {
    static constexpr bool PERM = true, AFTER_DRAIN = false; static_assert(ACT == 0 || ACT == 1, "EpiBf16: ACT is 0 (none) or 1 (gelu_pk)");
    bf16_t* O; int ldc; const float* bias; int split_cols; size_t split_stride; float scale0;
    __device__ __forceinline__ void operator()(const f32x4 (&acc)[2][2][4][2], const Unit& u, int wr, int wc, int fr, int fq) const {
        relane(wr, wc, fr, fq);
        const int row0 = u.pm * BM + wr * 64 + fr; int colt = u.pn * BM; bf16_t* base = O;
        float sc = 1.f; if (split_cols) { const int t = colt / split_cols; base += (size_t)t * split_stride; colt -= t * split_cols; if (t == 0) sc = scale0; }
        const int col0 = colt + wc * 32 + 8 * fq, bcol0 = u.pn * BM + wc * 32 + 8 * fq;
        f32x4 bv[2][2];
#pragma unroll
        for (int bj = 0; bj < 2; ++bj)
#pragma unroll
            for (int n = 0; n < 2; ++n) bv[bj][n] = bias ? *(const PG8_GAS f32x4*)(bias + bcol0 + bj * HALF + 4 * n) : (f32x4){0.f, 0.f, 0.f, 0.f};
#pragma unroll
        for (int ai = 0; ai < 2; ++ai)
#pragma unroll
            for (int m = 0; m < 4; ++m) { bf16_t* rowp = base + (size_t)(row0 + ai * HALF + m * 16) * ldc + col0;
#pragma unroll
                for (int bj = 0; bj < 2; ++bj) { f32x4 v0 = acc[ai][bj][m][0] + bv[bj][0], v1 = acc[ai][bj][m][1] + bv[bj][1];
                    if (ACT == 1) { f32x2 a = gelu_pk((f32x2){v0[0], v0[1]}), b = gelu_pk((f32x2){v0[2], v0[3]}), c = gelu_pk((f32x2){v1[0], v1[1]}), d = gelu_pk((f32x2){v1[2], v1[3]});
                        v0 = (f32x4){a.x, a.y, b.x, b.y}; v1 = (f32x4){c.x, c.y, d.x, d.y}; }
                    v0 = v0 * sc; v1 = v1 * sc; u32x4 w; w.x = cvt_pk_bf16(v0[0], v0[1]); w.y = cvt_pk_bf16(v0[2], v0[3]); w.z = cvt_pk_bf16(v1[0], v1[1]); w.w = cvt_pk_bf16(v1[2], v1[3]);
                    *(PG8_GAS u32x4*)(rowp + bj * HALF) = w; } }
    }
};

struct PanelStats {
    unsigned* xbuf;
    unsigned* cnt;
    unsigned* tmo;
    int ntn; float eps;
    unsigned code;
    __device__ __forceinline__ bool run(const f32x4 (&v)[2][2][4][2], const Unit& u, int wr, int wc, int fr, int fq, PG8_LAS unsigned char* lds, int wid, int lane) const {
        typedef float f32x2v __attribute__((ext_vector_type(2)));
        PG8_LAS f32x2v* P = (PG8_LAS f32x2v*)lds;
        PG8_LAS f32x2v* S = (PG8_LAS f32x2v*)(lds + 8192);
        PG8_LAS unsigned* flag = (PG8_LAS unsigned*)(lds + 8192 + 2048);
#pragma unroll
        for (int ai = 0; ai < 2; ++ai)
#pragma unroll
            for (int m = 0; m < 4; ++m) {
                float s = 0.f;
#pragma unroll
                for (int bj = 0; bj < 2; ++bj)
#pragma unroll
                    for (int n = 0; n < 2; ++n) { const f32x4 x = v[ai][bj][m][n]; s += (x[0] + x[1]) + (x[2] + x[3]); }
                s += __shfl_xor(s, 16); s += __shfl_xor(s, 32);
                const float mw = s * (1.0f / 64.0f); float q = 0.f;
#pragma unroll
                for (int bj = 0; bj < 2; ++bj)
#pragma unroll
                    for (int n = 0; n < 2; ++n) { const f32x4 d = v[ai][bj][m][n] - mw; q += (d[0] * d[0] + d[1] * d[1]) + (d[2] * d[2] + d[3] * d[3]); }
                q += __shfl_xor(q, 16); q += __shfl_xor(q, 32);
                if (fq == 0) P[(ai * HALF + wr * 64 + m * 16 + fr) * 4 + wc] = (f32x2v){mw, q};
            }
        asm volatile("s_waitcnt lgkmcnt(0)" ::: "memory"); __builtin_amdgcn_s_barrier(); asm volatile("" ::: "memory");
#if defined(BROKEN_EXCHANGE_NO_WAIT)
#warning BROKEN CONTROL BUILD: the row-statistics exchange does not wait; results are wrong by design
        if (blockIdx.x >= 64) { const long long t0_ = clock64(); while (clock64() - t0_ < 60000) __builtin_amdgcn_s_sleep(8); }
#endif
        const int row = wid * 32 + (lane & 31);
        if (lane < 32) {
            const f32x2v a = P[row * 4 + 0], b = P[row * 4 + 1], c = P[row * 4 + 2], d = P[row * 4 + 3];
            const float mt = (a.x + b.x + c.x + d.x) * 0.25f;
            const float da = a.x - mt, db = b.x - mt, dc = c.x - mt, dd = d.x - mt;
            const float m2 = (a.y + b.y) + (c.y + d.y) + 64.0f * ((da * da + db * db) + (dc * dc + dd * dd));
            unsigned long long* slot = (unsigned long long*)xbuf + ((size_t)(u.pm * BM + row) * 4 + u.pn);
            __hip_atomic_store(slot, ((unsigned long long)__float_as_uint(m2) << 32) | __float_as_uint(mt), __ATOMIC_RELAXED, __HIP_MEMORY_SCOPE_AGENT);
        }
        asm volatile("s_waitcnt vmcnt(0)" ::: "memory");
        if (lane == 0) __hip_atomic_fetch_add(cnt + 64 * u.pm, 1u, __ATOMIC_RELAXED, __HIP_MEMORY_SCOPE_AGENT);
        if (wid == 0) {
            bool dead = false; const unsigned long long t0 = __builtin_amdgcn_s_memrealtime(); const unsigned want = 8u * (unsigned)ntn;
            for (;;) {
#if defined(BROKEN_EXCHANGE_NO_WAIT)
                break;
#endif
                if ((unsigned)__builtin_amdgcn_readfirstlane(__hip_atomic_load(cnt + 64 * u.pm, __ATOMIC_RELAXED, __HIP_MEMORY_SCOPE_AGENT)) >= want) break;
                if (__builtin_amdgcn_s_memrealtime() - t0 > 2000000ull) {
                    if (lane == 0) { unsigned expect = 0u; __hip_atomic_compare_exchange_strong(tmo + 1, &expect, code | (unsigned)(u.pm & 0xff), __ATOMIC_RELAXED, __ATOMIC_RELAXED, __HIP_MEMORY_SCOPE_AGENT);
                                     __hip_atomic_store(tmo, 1u, __ATOMIC_RELAXED, __HIP_MEMORY_SCOPE_AGENT); }
                    dead = true; break; }
                __builtin_amdgcn_s_sleep(2);
            }
            __builtin_amdgcn_fence(__ATOMIC_ACQUIRE, "agent");
            if (lane == 0) flag[0] = dead ? 1u : 0u;
        }
        asm volatile("s_waitcnt vmcnt(0) lgkmcnt(0)" ::: "memory"); __builtin_amdgcn_s_barrier(); asm volatile("" ::: "memory");
        const bool bad = flag[0] != 0u;
        if (lane < 32) {
            const unsigned long long* slot = (const unsigned long long*)xbuf + (size_t)(u.pm * BM + row) * 4; float mt[4], m2[4]; float ms = 0.f;
#pragma unroll
            for (int t = 0; t < 4; ++t) { if (t < ntn) { const unsigned long long w = __hip_atomic_load(slot + t, __ATOMIC_RELAXED, __HIP_MEMORY_SCOPE_AGENT); mt[t] = __uint_as_float((unsigned)w); m2[t] = __uint_as_float((unsigned)(w >> 32)); } else { mt[t] = 0.f; m2[t] = 0.f; } ms += mt[t]; }
            const float mean = ms / (float)ntn; float q = 0.f;
#pragma unroll
            for (int t = 0; t < 4; ++t) if (t < ntn) { const float dm = mt[t] - mean; q += m2[t] + 256.0f * dm * dm; }
            S[row] = (f32x2v){mean, 1.0f / sqrtf(q / (256.0f * (float)ntn) + eps)};
        }
        asm volatile("s_waitcnt lgkmcnt(0)" ::: "memory"); __builtin_amdgcn_s_barrier(); asm volatile("" ::: "memory");
        return bad;
    }
};
struct EpiLnRes {
    static constexpr bool PERM = false, AFTER_DRAIN = true;
    const float* base; float* out; int ldc; const float* bias; PanelStats st; unsigned poison;
    __device__ __forceinline__ void fused(f32x4 (&acc)[2][2][4][2], const Unit& u, int wr, int wc, int fr, int fq, PG8_LAS unsigned char* lds, int wid, int lane) const {
        typedef float f32x2v __attribute__((ext_vector_type(2)));
        const PG8_LAS f32x2v* S = (const PG8_LAS f32x2v*)(lds + 8192);
        const int col0 = u.pn * BM + wc * 32 + 4 * fq;
#pragma unroll
        for (int bj = 0; bj < 2; ++bj)
#pragma unroll
            for (int n = 0; n < 2; ++n) { const f32x4 bv = bias ? *(const f32x4*)(bias + col0 + bj * HALF + n * 16) : (f32x4){0.f, 0.f, 0.f, 0.f};
#pragma unroll
                for (int ai = 0; ai < 2; ++ai)
#pragma unroll
                    for (int m = 0; m < 4; ++m) acc[ai][bj][m][n] += bv; }
        f32x4 pre[4][2][2];
#pragma unroll
        for (int m = 0; m < 4; ++m) { const size_t off = (size_t)(u.pm * BM + wr * 64 + m * 16 + fr) * ldc + col0;
#pragma unroll
            for (int bj = 0; bj < 2; ++bj)
#pragma unroll
                for (int n = 0; n < 2; ++n) pre[m][bj][n] = *(const f32x4*)(base + off + bj * HALF + n * 16); }
        const bool bad = st.run(acc, u, wr, wc, fr, fq, lds, wid, lane) || poison != 0u;
        const float qnan = __builtin_nanf("");
#pragma unroll
        for (int ai = 0; ai < 2; ++ai)
#pragma unroll
            for (int m = 0; m < 4; ++m) { const int r = ai * HALF + wr * 64 + m * 16 + fr; const f32x2v sr = S[r]; const size_t off = (size_t)(u.pm * BM + r) * ldc + col0;
#pragma unroll
                for (int bj = 0; bj < 2; ++bj)
#pragma unroll
                    for (int n = 0; n < 2; ++n) { const f32x4 bs = ai == 0 ? pre[m][bj][n] : *(const f32x4*)(base + off + bj * HALF + n * 16); f32x4 o = bs + (acc[ai][bj][m][n] - sr.x) * sr.y;
                        if (bad) o = (f32x4){qnan, qnan, qnan, qnan}; *(f32x4*)(out + off + bj * HALF + n * 16) = o; }
                if (m & 1) asm volatile("" ::: "memory"); }
    }
};
struct EpiLnResLn {
    static constexpr bool PERM = false, AFTER_DRAIN = true;
    const float* base; float* out; bf16_t* xn; int ldc; const float* bias; PanelStats st1, st2; unsigned poison;
    __device__ __forceinline__ void fused(f32x4 (&acc)[2][2][4][2], const Unit& u, int wr, int wc, int fr, int fq, PG8_LAS unsigned char* lds, int wid, int lane) const {
        typedef float f32x2v __attribute__((ext_vector_type(2))); typedef unsigned u32x2v __attribute__((ext_vector_type(2)));
        const PG8_LAS f32x2v* S = (const PG8_LAS f32x2v*)(lds + 8192);
        const int col0 = u.pn * BM + wc * 32 + 4 * fq;
#pragma unroll
        for (int bj = 0; bj < 2; ++bj)
#pragma unroll
            for (int n = 0; n < 2; ++n) { const f32x4 bv = bias ? *(const f32x4*)(bias + col0 + bj * HALF + n * 16) : (f32x4){0.f, 0.f, 0.f, 0.f};
#pragma unroll
                for (int ai = 0; ai < 2; ++ai)
#pragma unroll
                    for (int m = 0; m < 4; ++m) acc[ai][bj][m][n] += bv; }
        bool bad = st1.run(acc, u, wr, wc, fr, fq, lds, wid, lane) || poison != 0u;
        const float qnan = __builtin_nanf("");
#pragma unroll
        for (int ai = 0; ai < 2; ++ai)
#pragma unroll
            for (int m = 0; m < 4; ++m) { const int r = ai * HALF + wr * 64 + m * 16 + fr; const f32x2v sr = S[r]; const size_t off = (size_t)(u.pm * BM + r) * ldc + col0;
#pragma unroll
                for (int bj = 0; bj < 2; ++bj)
#pragma unroll
                    for (int n = 0; n < 2; ++n) { const f32x4 bs = *(const f32x4*)(base + off + bj * HALF + n * 16); acc[ai][bj][m][n] = bs + (acc[ai][bj][m][n] - sr.x) * sr.y; }
                asm volatile("" : "+v"(acc[ai][0][m][0]), "+v"(acc[ai][0][m][1]), "+v"(acc[ai][1][m][0]), "+v"(acc[ai][1][m][1]));
                if (m & 1) asm volatile("" ::: "memory"); }
        const bool bad1 = bad;
        bad = st2.run(acc, u, wr, wc, fr, fq, lds, wid, lane) || bad;
#pragma unroll
        for (int ai = 0; ai < 2; ++ai)
#pragma unroll
            for (int m = 0; m < 4; ++m) { const int r = ai * HALF + wr * 64 + m * 16 + fr; const f32x2v sr = S[r]; const size_t off = (size_t)(u.pm * BM + r) * ldc + col0;
#pragma unroll
                for (int bj = 0; bj < 2; ++bj)
#pragma unroll
                    for (int n = 0; n < 2; ++n) { const f32x4 x1 = acc[ai][bj][m][n]; *(f32x4*)(out + off + bj * HALF + n * 16) = bad1 ? (f32x4){qnan, qnan, qnan, qnan} : x1;
                        const f32x4 o = (x1 - sr.x) * sr.y; u32x2v w; w.x = cvt_pk_bf16(o[0], o[1]); w.y = cvt_pk_bf16(o[2], o[3]);
                        if (bad) { w.x = 0x7fc07fc0u; w.y = 0x7fc07fc0u; } *(u32x2v*)(xn + off + bj * HALF + n * 16) = w; }
                asm volatile("" ::: "memory"); }
    }
};

template <class Epi, class Sched, bool ALIGN_EPI = false, bool SP2 = false>
__device__ __forceinline__ void gemm_phase(PG8_LAS unsigned char* lds, const Gemm g, const Sched& S, const Epi& E, const int wave0) {
    int tid_ = tid_from_wave(wave0);
    const int tid = tid_, wid = __builtin_amdgcn_readfirstlane(tid >> 6), lane = tid & 63, wr = wid >> 2, wc = wid & 3, fr = lane & 15, fq = lane >> 4;
    const int K = g.K, nt = K / BK;
    unsigned voffA[2], voffB[2];
#pragma unroll
    for (int i = 0; i < 2; ++i) { int R, C; stage_rc(tid * 16 + i * 8192, R, C); const int Rb = Epi::PERM ? ((R & ~31) + perm32(R & 31)) : R;
        voffA[i] = (unsigned)(R * K + C) * 2u; voffB[i] = (unsigned)(Rb * K + C) * 2u; }
    const size_t kstep = (size_t)(BK * 2);
    const size_t hstep = (size_t)HALF * K * 2;
    const size_t tstep = 2 * hstep;
    const unsigned ldsw = (unsigned)wid * 1024u;
    const int aoff = lds_byte(wr * 64 + fr, fq * 8), boff = lds_byte(wc * 32 + fr, fq * 8);
#define PG8_SA(b, h) (((b) * 2 + (h)) * HTB)
#define PG8_SB(b, h) ((4 + (b) * 2 + (h)) * HTB)
#define PG8_STAGE(bufoff, gbase, voff) do { _Pragma("unroll") for (int _i = 0; _i < 2; ++_i) \
        __builtin_amdgcn_global_load_lds((const unsigned*)((const char*)(gbase) + (voff)[_i]), (PG8_LAS unsigned*)(lds + (bufoff) + ldsw + _i * 8192), 16, 0, 0); } while (0)
#define PG8_LDA(dst, b, h) do { _Pragma("unroll") for (int m = 0; m < 4; ++m) _Pragma("unroll") for (int k = 0; k < 2; ++k) dst[m][k] = *(const PG8_LAS bf16x8*)(lds + PG8_SA(b, h) + aoff + m * 2048 + k * 1024); } while (0)
#define PG8_LDB(dst, b, h) do { _Pragma("unroll") for (int n = 0; n < 2; ++n) _Pragma("unroll") for (int k = 0; k < 2; ++k) dst[n][k] = *(const PG8_LAS bf16x8*)(lds + PG8_SB(b, h) + boff + n * 2048 + k * 1024); } while (0)
#define PG8_MMA(ai, bj, At, Bt) do { __builtin_amdgcn_s_setprio(1); _Pragma("unroll") for (int m = 0; m < 4; ++m) _Pragma("unroll") for (int n = 0; n < 2; ++n) _Pragma("unroll") for (int k = 0; k < 2; ++k) \
        acc[ai][bj][m][n] = __builtin_amdgcn_mfma_f32_16x16x32_bf16(Bt[n][k], At[m][k], acc[ai][bj][m][n], 0, 0, 0); __builtin_amdgcn_s_setprio(0); } while (0)
#define PG8_WAIT_V(n) asm volatile("s_waitcnt vmcnt(" #n ")" ::: "memory")
#define PG8_WAIT_L(n) asm volatile("s_waitcnt lgkmcnt(" #n ")" ::: "memory")
#define PG8_BAR __builtin_amdgcn_s_barrier()
#define PG8_SCHED __builtin_amdgcn_sched_barrier(0)
    Unit cur, nxt; int ui = 0;
    if (!S.next(0, cur)) return;
    f32x4 acc[2][2][4][2];
#pragma unroll
    for (int a = 0; a < 2; ++a)
#pragma unroll
        for (int b = 0; b < 2; ++b)
#pragma unroll
            for (int m = 0; m < 4; ++m)
#pragma unroll
                for (int n = 0; n < 2; ++n) acc[a][b][m][n] = (f32x4){0.f, 0.f, 0.f, 0.f};
    bf16x8 At[4][2], B0[2][2], B1[2][2];
    const char* cA = (const char*)g.A + (size_t)cur.pm * tstep; const char* cB = (const char*)g.Bt + (size_t)cur.pn * tstep;
    S.a_ready(cur);
    if constexpr (SP2) {
        PG8_STAGE(PG8_SB(0, 0), cB, voffB); PG8_STAGE(PG8_SB(0, 1), cB + hstep, voffB); PG8_STAGE(PG8_SA(0, 0), cA, voffA); PG8_STAGE(PG8_SA(0, 1), cA + hstep, voffA);
        if (wr == 1) PG8_BAR;
        PG8_WAIT_V(2); PG8_BAR;
        PG8_STAGE(PG8_SB(1, 0), cB + kstep, voffB); PG8_STAGE(PG8_SA(1, 0), cA + kstep, voffA); PG8_STAGE(PG8_SB(1, 1), cB + hstep + kstep, voffB);
        PG8_WAIT_V(6); PG8_BAR;
    } else {
        PG8_STAGE(PG8_SB(0, 0), cB, voffB); PG8_STAGE(PG8_SA(0, 0), cA, voffA); PG8_STAGE(PG8_SB(0, 1), cB + hstep, voffB); PG8_STAGE(PG8_SA(0, 1), cA + hstep, voffA);
        if (wr == 1) PG8_BAR;
        PG8_WAIT_V(4); PG8_BAR;
        PG8_STAGE(PG8_SB(1, 0), cB + kstep, voffB); PG8_STAGE(PG8_SA(1, 0), cA + kstep, voffA); PG8_STAGE(PG8_SB(1, 1), cB + hstep + kstep, voffB);
        PG8_WAIT_V(6); PG8_BAR;
    }
    for (;;) {
        const bool has_next = S.next(ui + 1, nxt);
        const char* nA = has_next ? (const char*)g.A + (size_t)nxt.pm * tstep : cA; const char* nB = has_next ? (const char*)g.Bt + (size_t)nxt.pn * tstep : cB;
        for (int t = 0; t < nt; t += 2) {
            const bool last = (t == nt - 2);
            const char* a1 = cA + (size_t)(t + 1) * kstep;
            const char* a2 = last ? nA : cA + (size_t)(t + 2) * kstep; const char* b2 = last ? nB : cB + (size_t)(t + 2) * kstep;
            const char* a3 = a2 + kstep; const char* b3 = b2 + kstep;
            if (last && has_next) S.a_ready(nxt);
            if constexpr (SP2) {
            PG8_LDB(B0, 0, 0); PG8_LDB(B1, 0, 1); PG8_SCHED; PG8_LDA(At, 0, 0); PG8_STAGE(PG8_SA(1, 1), a1 + hstep, voffA);
            PG8_WAIT_V(8); PG8_WAIT_L(0); PG8_BAR; PG8_MMA(0, 0, At, B0); PG8_MMA(0, 1, At, B1); PG8_BAR; PG8_SCHED;
            PG8_LDA(At, 0, 1); PG8_STAGE(PG8_SB(0, 0), b2, voffB); PG8_STAGE(PG8_SB(0, 1), b2 + hstep, voffB); PG8_STAGE(PG8_SA(0, 0), a2, voffA);
            PG8_WAIT_V(8); PG8_WAIT_L(0); PG8_BAR; PG8_MMA(1, 0, At, B0); PG8_MMA(1, 1, At, B1); PG8_BAR; PG8_SCHED;
            PG8_LDB(B0, 1, 0); PG8_LDB(B1, 1, 1); PG8_SCHED; PG8_LDA(At, 1, 0); PG8_STAGE(PG8_SA(0, 1), a2 + hstep, voffA);
            PG8_WAIT_V(8); PG8_WAIT_L(0); PG8_BAR; PG8_MMA(0, 0, At, B0); PG8_MMA(0, 1, At, B1); PG8_BAR; PG8_SCHED;
            PG8_LDA(At, 1, 1); PG8_STAGE(PG8_SB(1, 0), b3, voffB); PG8_STAGE(PG8_SB(1, 1), b3 + hstep, voffB); PG8_STAGE(PG8_SA(1, 0), a3, voffA);
            PG8_WAIT_V(8); PG8_WAIT_L(0); PG8_BAR; PG8_MMA(1, 0, At, B0); PG8_MMA(1, 1, At, B1); PG8_BAR; PG8_SCHED;
            } else {
            PG8_LDB(B0, 0, 0); PG8_SCHED; PG8_LDA(At, 0, 0); PG8_STAGE(PG8_SA(1, 1), a1 + hstep, voffA);
            PG8_WAIT_L(8); PG8_BAR; PG8_WAIT_L(0); PG8_MMA(0, 0, At, B0); PG8_BAR; PG8_SCHED;
            PG8_LDB(B1, 0, 1); PG8_STAGE(PG8_SB(0, 0), b2, voffB);
            PG8_BAR; PG8_WAIT_L(0); PG8_MMA(0, 1, At, B1); PG8_BAR;
            PG8_LDA(At, 0, 1); PG8_STAGE(PG8_SA(0, 0), a2, voffA);
            PG8_BAR; PG8_WAIT_L(0); PG8_MMA(1, 0, At, B0); PG8_BAR; PG8_SCHED;
            PG8_STAGE(PG8_SB(0, 1), b2 + hstep, voffB);
            PG8_WAIT_V(6); PG8_BAR; PG8_MMA(1, 1, At, B1); PG8_BAR;
            PG8_LDB(B0, 1, 0); PG8_SCHED; PG8_LDA(At, 1, 0); PG8_STAGE(PG8_SA(0, 1), a2 + hstep, voffA);
            PG8_WAIT_L(8); PG8_BAR; PG8_WAIT_L(0); PG8_MMA(0, 0, At, B0); PG8_BAR; PG8_SCHED;
            PG8_LDB(B1, 1, 1); PG8_STAGE(PG8_SB(1, 0), b3, voffB);
            PG8_BAR; PG8_WAIT_L(0); PG8_MMA(0, 1, At, B1); PG8_BAR;
            PG8_LDA(At, 1, 1); PG8_STAGE(PG8_SA(1, 0), a3, voffA);
            PG8_BAR; PG8_WAIT_L(0); PG8_MMA(1, 0, At, B0); PG8_BAR; PG8_SCHED;
            PG8_STAGE(PG8_SB(1, 1), b3 + hstep, voffB);
            PG8_WAIT_V(6); PG8_BAR; PG8_MMA(1, 1, At, B1); PG8_BAR;
            }
        }
        if constexpr (ALIGN_EPI) { if (wr == 0) PG8_BAR; }
        if constexpr (!Epi::AFTER_DRAIN) { E(acc, cur, wr, wc, fr, fq); S.done(cur); }
        if (!has_next) break;
#pragma unroll
        for (int a = 0; a < 2; ++a)
#pragma unroll
            for (int b = 0; b < 2; ++b)
#pragma unroll
                for (int m = 0; m < 4; ++m)
#pragma unroll
                    for (int n = 0; n < 2; ++n) acc[a][b][m][n] = (f32x4){0.f, 0.f, 0.f, 0.f};
        cur = nxt; cA = nA; cB = nB; ++ui;
        if constexpr (ALIGN_EPI) { if (wr == 1) PG8_BAR; }
    }
    PG8_WAIT_V(0);
    if constexpr (!ALIGN_EPI) { if (wr == 0) PG8_BAR; }
    PG8_BAR;
    if constexpr (Epi::AFTER_DRAIN) { E.fused(acc, cur, wr, wc, fr, fq, lds, wid, lane); S.done(cur); }
#undef PG8_SA
#undef PG8_SB
#undef PG8_STAGE
#undef PG8_LDA
#undef PG8_LDB
#undef PG8_MMA
#undef PG8_WAIT_V
#undef PG8_WAIT_L
#undef PG8_BAR
#undef PG8_SCHED
}
}

namespace pg8 {
struct EpiRelu2 {
    static constexpr bool PERM = true, AFTER_DRAIN = false;
    bf16_t* O; int ldc;
    __device__ __forceinline__ void operator()(const f32x4 (&acc)[2][2][4][2], const Unit& u, int wr, int wc, int fr, int fq) const {
        relane(wr, wc, fr, fq);
        const int row0 = u.pm * BM + wr * 64 + fr, col0 = u.pn * BM + wc * 32 + 8 * fq;
#pragma unroll
        for (int ai = 0; ai < 2; ++ai)
#pragma unroll
            for (int m = 0; m < 4; ++m) { bf16_t* rowp = O + (size_t)(row0 + ai * HALF + m * 16) * ldc + col0;
#pragma unroll
                for (int bj = 0; bj < 2; ++bj) { f32x4 v0 = acc[ai][bj][m][0], v1 = acc[ai][bj][m][1];
                    v0 = __builtin_elementwise_max(v0, (f32x4){0.f, 0.f, 0.f, 0.f}); v1 = __builtin_elementwise_max(v1, (f32x4){0.f, 0.f, 0.f, 0.f}); v0 = v0 * v0; v1 = v1 * v1;
                    u32x4 w; w.x = cvt_pk_bf16(v0[0], v0[1]); w.y = cvt_pk_bf16(v0[2], v0[3]); w.z = cvt_pk_bf16(v1[0], v1[1]); w.w = cvt_pk_bf16(v1[2], v1[3]);
                    *(PG8_GAS u32x4*)(rowp + bj * HALF) = w; } }
    }
};
struct EpiF32 {
    static constexpr bool PERM = false, AFTER_DRAIN = false;
    float* O; int ldc;
    __device__ __forceinline__ void operator()(const f32x4 (&acc)[2][2][4][2], const Unit& u, int wr, int wc, int fr, int fq) const {
        relane(wr, wc, fr, fq);
        const int row0 = u.pm * BM + wr * 64 + fr, col0 = u.pn * BM + wc * 32 + 4 * fq;
#pragma unroll
        for (int ai = 0; ai < 2; ++ai)
#pragma unroll
            for (int m = 0; m < 4; ++m) { float* rowp = O + (size_t)(row0 + ai * HALF + m * 16) * ldc + col0;
#pragma unroll
                for (int bj = 0; bj < 2; ++bj)
#pragma unroll
                    for (int n = 0; n < 2; ++n) *(PG8_GAS f32x4*)(rowp + bj * HALF + n * 16) = acc[ai][bj][m][n]; }
    }
};
struct EpiTaps {
    static constexpr bool PERM = false, AFTER_DRAIN = false;
    float* O; const float* decay;
    __device__ __forceinline__ void operator()(const f32x4 (&acc)[2][2][4][2], const Unit& u, int wr, int wc, int fr, int fq) const {
        relane(wr, wc, fr, fq);
        const int row0 = u.pm * BM + wr * 64 + fr, col0 = u.pn * BM + wc * 32 + 4 * fq;
#pragma unroll
        for (int ai = 0; ai < 2; ++ai)
#pragma unroll
            for (int m = 0; m < 4; ++m) { const int row = row0 + ai * HALF + m * 16; float* rowp = O + (size_t)row * 16384 + col0; const float nd = -fabsf(((const PG8_GAS float*)decay)[row]) * (1.0f / 16383.0f) * 1.4426950408889634f;
#pragma unroll
                for (int bj = 0; bj < 2; ++bj)
#pragma unroll
                    for (int n = 0; n < 2; ++n) { const int c = col0 + bj * HALF + n * 16; const f32x4 a = acc[ai][bj][m][n]; f32x4 o;
                        o[0] = a[0] * __builtin_amdgcn_exp2f(nd * (float)(c + 0)); o[1] = a[1] * __builtin_amdgcn_exp2f(nd * (float)(c + 1));
                        o[2] = a[2] * __builtin_amdgcn_exp2f(nd * (float)(c + 2)); o[3] = a[3] * __builtin_amdgcn_exp2f(nd * (float)(c + 3));
                        *(PG8_GAS f32x4*)(rowp + bj * HALF + n * 16) = o; } }
    }
};
}

constexpr int L = 16384, NSEQ = 3, M = NSEQ * L, D = 1024, DEPTH = 4;
constexpr int HYW = 512, HYP = 1536, QR = 256, KVR = 128, ROPE = 32, INW = 1952;
constexpr int NH = 8, DQ = 96, DV = 64, NQ = NH * DQ, NKV = NH * 128;
constexpr int FF = 4096;
constexpr float EPS = 1e-6f;
constexpr int NWAVES = 8, NTHR = 512;
constexpr int MLP_CHUNK = 16384, N_MLP_CHUNKS = M / MLP_CHUNK;

constexpr size_t MiB = 1u << 20;
constexpr size_t WS_CTL = 0, CTL_ZERO_BYTES = 65536;
constexpr size_t WS_COS = 1 * MiB, WS_SIN = 2 * MiB;
constexpr size_t WS_H2 = 4 * MiB;
constexpr size_t WS_W3T = 8 * MiB;
constexpr size_t WS_WIN = 12 * MiB, WS_WOUT = 16 * MiB, WS_WUP = 18 * MiB, WS_WDOWN = 26 * MiB, WS_WUQ = 34 * MiB, WS_WUKV = 34 * MiB + 512 * 1024;
constexpr size_t WS_XN = 36 * MiB;
constexpr size_t WS_CQN = 36 * MiB, WS_CKVN = 60 * MiB, WS_KPE = 72 * MiB;
constexpr size_t WS_KEO = 132 * MiB;
constexpr size_t WS_KT = 261 * MiB;
constexpr size_t WS_UT = 261 * MiB;
constexpr size_t WS_CQKV = 405 * MiB;
constexpr size_t WS_YT = 453 * MiB;
constexpr size_t WS_Q = 132 * MiB, WS_KN = 204 * MiB;
constexpr size_t WS_MIX = 324 * MiB;
constexpr size_t WS_T = 132 * MiB;
constexpr size_t WS_H = 324 * MiB;
constexpr size_t WS_G0 = 75 * MiB, WS_G1A = 107 * MiB, WS_G1B = 501 * MiB;
constexpr size_t WS_END = 508 * MiB;
constexpr int KEO_BLK = 16512, KEO_KO = 8256;
static_assert(WS_KEO + (size_t)1024 * KEO_BLK * 8 <= WS_KT, "KEO fits");
static_assert(WS_UT + (size_t)HYP * M * 2 <= WS_CQKV && WS_CQKV + (size_t)M * 512 * 2 <= WS_YT && WS_YT + (size_t)HYW * M * 2 <= WS_END, "map");
static_assert(WS_KN + (size_t)M * NKV * 2 <= WS_MIX && WS_T + (size_t)M * D * 4 <= WS_MIX && WS_H + (size_t)MLP_CHUNK * FF * 2 <= WS_END, "map2");

constexpr int RING_OFF = 0, RING_BYTES = 139264;
constexpr int LDSCTL_OFF = RING_BYTES, MISC_OFF = LDSCTL_OFF + 320;
constexpr int LDS_BYTES = 147456;
static_assert(MISC_OFF + 128 <= LDS_BYTES, "LDS map");

#define GAS __attribute__((address_space(1)))
#define LAS __attribute__((address_space(3)))
typedef unsigned short bf16;
typedef unsigned v4u __attribute__((ext_vector_type(4)));
typedef unsigned v2u __attribute__((ext_vector_type(2)));
typedef float f32x4 __attribute__((ext_vector_type(4)));
typedef float f32x2 __attribute__((ext_vector_type(2)));
typedef short bf16x8 __attribute__((ext_vector_type(8)));
typedef GAS unsigned gu32;
#define RLX_AGENT __ATOMIC_RELAXED, __HIP_MEMORY_SCOPE_AGENT
#define LDS_WAIT() asm volatile("s_waitcnt lgkmcnt(0)" ::: "memory")
#define VM_WAIT() asm volatile("s_waitcnt vmcnt(0)" ::: "memory")
typedef __bf16 bf16x2_t __attribute__((ext_vector_type(2)));
__device__ __forceinline__ unsigned pk2(float lo, float hi) { f32x2 v = {lo, hi}; bf16x2_t b = __builtin_convertvector(v, bf16x2_t); return __builtin_bit_cast(unsigned, b); }
__device__ __forceinline__ bf16 f2bf(float f) { return (bf16)(pk2(f, 0.f) & 0xffffu); }
__device__ __forceinline__ float bf2f(unsigned h) { return __uint_as_float(h << 16); }
__device__ __forceinline__ float shx(float v, int lane, int o) { return __uint_as_float((unsigned)__builtin_amdgcn_ds_bpermute((lane ^ o) << 2, (int)__float_as_uint(v))); }
__device__ __forceinline__ float wave_sum(float v) {
    const int ln_ = hw_lane();
#pragma unroll
    for (int o = 1; o < 64; o <<= 1) v += shx(v, ln_, o);
    return v;
}

namespace hfft {
constexpr float w32c(int i) { constexpr float t[16] = {1.000000000e+00f, 9.807852507e-01f, 9.238795042e-01f, 8.314695954e-01f, 7.071067691e-01f, 5.555702448e-01f, 3.826834261e-01f, 1.950903237e-01f, 0.f, -1.950903237e-01f, -3.826834261e-01f, -5.555702448e-01f, -7.071067691e-01f, -8.314695954e-01f, -9.238795042e-01f, -9.807852507e-01f}; return t[i]; }
constexpr float w32s(int i) { constexpr float t[16] = {0.000000000e+00f, 1.950903237e-01f, 3.826834261e-01f, 5.555702448e-01f, 7.071067691e-01f, 8.314695954e-01f, 9.238795042e-01f, 9.807852507e-01f, 1.000000000e+00f, 9.807852507e-01f, 9.238795042e-01f, 8.314695954e-01f, 7.071067691e-01f, 5.555702448e-01f, 3.826834261e-01f, 1.950903237e-01f}; return t[i]; }
constexpr int brev(int x, int bits) { int r = 0; for (int i = 0; i < bits; ++i) r |= ((x >> i) & 1) << (bits - 1 - i); return r; }
constexpr int ilog2(int x) { int r = 0; while ((1 << r) < x) ++r; return r; }
__device__ __forceinline__ int pad(int i) { return i + (i >> 5); }

__device__ __forceinline__ void bfly(float ar, float ai, float br, float bi, float& ur, float& ui, float& dr, float& di) {
    asm("v_add_f32_e32 %0, %4, %6\n\tv_add_f32_e32 %1, %5, %7\n\tv_sub_f32_e32 %2, %4, %6\n\tv_sub_f32_e32 %3, %5, %7"
        : "=&v"(ur), "=&v"(ui), "=&v"(dr), "=&v"(di) : "v"(ar), "v"(ai), "v"(br), "v"(bi));
}
template <bool INV> __device__ __forceinline__ void bfly_rot(float ar, float ai, float br, float bi, float& ur, float& ui, float& dr, float& di) {
    if (!INV) asm("v_add_f32_e32 %0, %4, %6\n\tv_add_f32_e32 %1, %5, %7\n\tv_sub_f32_e32 %2, %5, %7\n\tv_sub_f32_e32 %3, %6, %4" : "=&v"(ur), "=&v"(ui), "=&v"(dr), "=&v"(di) : "v"(ar), "v"(ai), "v"(br), "v"(bi));
    else      asm("v_add_f32_e32 %0, %4, %6\n\tv_add_f32_e32 %1, %5, %7\n\tv_sub_f32_e32 %2, %7, %5\n\tv_sub_f32_e32 %3, %4, %6" : "=&v"(ur), "=&v"(ui), "=&v"(dr), "=&v"(di) : "v"(ar), "v"(ai), "v"(br), "v"(bi));
}
__device__ __forceinline__ void bfly_tw(float ar, float ai, float br, float bi, float c, float s, float& ur, float& ui, float& dr, float& di) {
    float tr, ti;
    asm("v_sub_f32_e32 %4, %6, %8\n\tv_sub_f32_e32 %5, %7, %9\n\tv_add_f32_e32 %0, %6, %8\n\tv_add_f32_e32 %1, %7, %9\n\t"
        "v_mul_f32_e32 %2, %10, %4\n\tv_mul_f32_e32 %3, %11, %4\n\tv_fma_f32 %2, -%11, %5, %2\n\tv_fma_f32 %3, %10, %5, %3"
        : "=&v"(ur), "=&v"(ui), "=&v"(dr), "=&v"(di), "=&v"(tr), "=&v"(ti) : "v"(ar), "v"(ai), "v"(br), "v"(bi), "s"(c), "s"(s));
}
__device__ __forceinline__ void cmul_chain(float& xr, float& xi, float& wc, float& ws, float c1, float s1) {
    float a, b, nc, ns;
    asm("v_mul_f32_e32 %0, %4, %6\n\tv_mul_f32_e32 %1, %4, %7\n\tv_fma_f32 %0, -%5, %7, %0\n\tv_fma_f32 %1, %5, %6, %1\n\t"
        "v_mul_f32_e32 %2, %6, %8\n\tv_mul_f32_e32 %3, %6, %9\n\tv_fma_f32 %2, -%7, %9, %2\n\tv_fma_f32 %3, %7, %8, %3"
        : "=&v"(a), "=&v"(b), "=&v"(nc), "=&v"(ns) : "v"(xr), "v"(xi), "v"(wc), "v"(ws), "v"(c1), "v"(s1));
    xr = a; xi = b; wc = nc; ws = ns;
}
template <int R, bool INV> __device__ __forceinline__ void fft_r2(float (&re)[R], float (&im)[R], const unsigned z0) {
    constexpr int LG = ilog2(R);
#pragma unroll
    for (int st = 0; st < LG; ++st) {
        const int s = (R / 2) >> st;
#pragma unroll
        for (int blk = 0; blk < R; blk += 2 * s) {
#pragma unroll
            for (int a = 0; a < s; ++a) {
                const int i0 = blk + a, i1 = i0 + s;
                const int w = a * (16 / s);
                float ur, ui, dr, di;
                if (w == 0) { bfly(re[i0], im[i0], re[i1], im[i1], ur, ui, dr, di); re[i1] = dr; im[i1] = di; }
                else if (w == 8) { bfly_rot<INV>(re[i0], im[i0], re[i1], im[i1], ur, ui, dr, di); re[i1] = dr; im[i1] = di; }
                else { const float c = __uint_as_float(__float_as_uint(w32c(w)) | z0), sn = __uint_as_float(__float_as_uint(INV ? w32s(w) : -w32s(w)) | z0);
                    bfly_tw(re[i0], im[i0], re[i1], im[i1], c, sn, ur, ui, dr, di); re[i1] = dr; im[i1] = di; }
                re[i0] = ur; im[i0] = ui;
            }
        }
    }
}

__device__ __forceinline__ int opaque(int x) { asm volatile("" : "+v"(x)); return x; }
template <bool INV> __device__ __forceinline__ void fft16k(float (&re)[32], float (&im)[32], LAS f32x2* buf, const int t_in) {
    asm volatile("" ::: "memory"); __builtin_amdgcn_sched_barrier(0);
    int t = opaque(t_in);
    unsigned z0 = 0u; asm volatile("" : "+s"(z0));
    fft_r2<32, INV>(re, im, z0);
    __syncthreads();
#pragma unroll
    for (int r = 0; r < 32; ++r) buf[33 * t + r] = (f32x2){re[brev(r, 5)], im[brev(r, 5)]};
    __syncthreads();
    t = opaque(t);
    { const int b2 = t + (t >> 5);
#pragma unroll
    for (int r = 0; r < 32; ++r) { const f32x2 v = buf[b2 + 528 * r]; re[r] = v.x; im[r] = v.y; } }
    {
        const float f1 = (float)(t & 31) * (1.0f / 1024.0f);
        const float c1 = __builtin_amdgcn_cosf(f1), s1 = INV ? __builtin_amdgcn_sinf(f1) : -__builtin_amdgcn_sinf(f1);
        float wc = c1, ws = s1;
#pragma unroll
        for (int r = 1; r < 32; ++r) {
            cmul_chain(re[r], im[r], wc, ws, c1, s1);
        }
    }
    fft_r2<32, INV>(re, im, z0);
    __syncthreads();
    {
        t = opaque(t);
        const int ob = (t >> 5) * 1056 + (t & 31);
#pragma unroll
        for (int r = 0; r < 32; ++r) buf[ob + 33 * r] = (f32x2){re[brev(r, 5)], im[brev(r, 5)]};
    }
    __syncthreads();
#pragma unroll
    for (int h = 0; h < 2; ++h) {
        t = opaque(t);
        float ar[16], ai[16]; const int j = t + 512 * h; const int b3 = t + (t >> 5) + 528 * h;
#pragma unroll
        for (int r = 0; r < 16; ++r) { const f32x2 v = buf[b3 + 1056 * r]; ar[r] = v.x; ai[r] = v.y; }
        {
            const float f1 = (float)j * (1.0f / 16384.0f);
            const float c1 = __builtin_amdgcn_cosf(f1), s1 = INV ? __builtin_amdgcn_sinf(f1) : -__builtin_amdgcn_sinf(f1);
            float wc = c1, ws = s1;
#pragma unroll
            for (int r = 1; r < 16; ++r) {
                cmul_chain(ar[r], ai[r], wc, ws, c1, s1);
            }
        }
        fft_r2<16, INV>(ar, ai, z0);
#pragma unroll
        for (int r = 0; r < 16; ++r) { re[h + 2 * r] = ar[brev(r, 4)]; im[h + 2 * r] = ai[brev(r, 4)]; }
    }
    asm volatile("" ::: "memory"); __builtin_amdgcn_sched_barrier(0);
}
}

struct Frame {
    LAS unsigned char* lds;
    volatile LAS unsigned* MISC;
    gu32* ctl;
    int tid, lane, wave;
    int wave0;
    int vcu, G;
    float* out;
    unsigned char* ws;
};
constexpr int PTRTAB_OFF = LDSCTL_OFF + 512;
__device__ __forceinline__ const GAS float* inp(const Frame& F, int i) {
    const v2u w = *(const LAS v2u*)(F.lds + PTRTAB_OFF + 8 * i);
    const unsigned lo = __builtin_amdgcn_readfirstlane(w.x), hi = __builtin_amdgcn_readfirstlane(w.y);
    return (const GAS float*)(((unsigned long long)hi << 32) | lo);
}
__device__ __forceinline__ GAS unsigned char* wsq(const Frame& F) { unsigned char* p = F.ws; asm volatile("" : "+s"(p)); return (GAS unsigned char*)p; }
enum { I_XP = 0, I_XS, I_WIN, I_CONVW, I_CONVB, I_FW1, I_FB1, I_FW2, I_FB2, I_FW3, I_SINF, I_DECAY, I_HBIAS, I_QNORM, I_WUQ, I_KVNORM, I_WUKV, I_GNHY, I_GNAT, I_WOUT,
       I_NMIXPRE, I_NMIXPOST, I_NMLPPRE, I_NMLPPOST, I_WUP, I_WDOWN };

__device__ __forceinline__ int rope_src(int p) { return 4 * (p >> 3) + (p & 3) + 16 * ((p >> 2) & 1); }
template <bool ROPEPERM>
__device__ __forceinline__ void transpose_item(const GAS float* W, int K, int N, GAS bf16* WT, LAS float* scr, int item, int lane, int ldk = 0, int koff = 0) {
    if (ldk == 0) ldk = K;
    const int nblk = N / 32, kb = item / nblk, nb = item % nblk, k0 = 64 * kb, n0 = 32 * nb;
    int sc = lane & 31; if (ROPEPERM && (nb % 3) == 2) sc = rope_src(sc);
#pragma unroll 8
    for (int i = 0; i < 32; ++i) { const int kk = 2 * i + (lane >> 5); scr[kk * 33 + (lane & 31)] = W[(size_t)(k0 + kk) * N + n0 + sc]; }
    LDS_WAIT(); asm volatile("" ::: "memory");
    const int c = lane & 7;
#pragma unroll
    for (int j = 0; j < 4; ++j) { const int n = (lane >> 3) + 8 * j; const LAS float* s = scr + (8 * c) * 33 + n;
        v4u o; o.x = pk2(s[0 * 33], s[1 * 33]); o.y = pk2(s[2 * 33], s[3 * 33]); o.z = pk2(s[4 * 33], s[5 * 33]); o.w = pk2(s[6 * 33], s[7 * 33]);
        *(GAS v4u*)(WT + (size_t)(n0 + n) * ldk + koff + k0 + 8 * c) = o; }
    LDS_WAIT(); asm volatile("" ::: "memory");
}
__device__ __forceinline__ void phase_weights(Frame& F, int l) {
    LAS float* scr = (LAS float*)(F.lds + RING_OFF + F.wave * 16384);
    const int gw = F.vcu * NWAVES + F.wave, NGW = F.G * NWAVES;
    GAS bf16* WinT = (GAS bf16*)(wsq(F) + WS_WIN); GAS bf16* WoutT = (GAS bf16*)(wsq(F) + WS_WOUT); GAS bf16* WupT = (GAS bf16*)(wsq(F) + WS_WUP); GAS bf16* WdownT = (GAS bf16*)(wsq(F) + WS_WDOWN);
    GAS bf16* WuqT = (GAS bf16*)(wsq(F) + WS_WUQ); GAS bf16* WukvT = (GAS bf16*)(wsq(F) + WS_WUKV);
    constexpr int I_IN = (D / 64) * (INW / 32), I_OUT = (D / 64) * (D / 32), I_UP = (D / 64) * (FF / 32), I_DN = (FF / 64) * (D / 32), I_UQ = (QR / 64) * (NQ / 32), I_UKV = (KVR / 64) * (NKV / 32);
    constexpr int I_W3 = 2048 / 32;
    constexpr int NITEMS = I_IN + I_OUT + I_UP + I_DN + I_UQ + I_UKV + 2 * I_W3;
    for (int it = gw; it < NITEMS; it += NGW) {
        int r = it;
        if (r < I_IN) { transpose_item<false>(inp(F, I_WIN) + (size_t)l * D * INW, D, INW, WinT, scr, r, F.lane); continue; } r -= I_IN;
        if (r < I_OUT) { transpose_item<false>(inp(F, I_WOUT) + (size_t)l * D * D, D, D, WoutT, scr, r, F.lane); continue; } r -= I_OUT;
        if (r < I_UP) { transpose_item<false>(inp(F, I_WUP) + (size_t)l * D * FF, D, FF, WupT, scr, r, F.lane); continue; } r -= I_UP;
        if (r < I_DN) { transpose_item<false>(inp(F, I_WDOWN) + (size_t)l * FF * D, FF, D, WdownT, scr, r, F.lane); continue; } r -= I_DN;
        if (r < I_UQ) { transpose_item<true>(inp(F, I_WUQ) + (size_t)l * QR * NQ, QR, NQ, WuqT, scr, r, F.lane); continue; } r -= I_UQ;
        if (r < I_UKV) { transpose_item<false>(inp(F, I_WUKV) + (size_t)l * KVR * NKV, KVR, NKV, WukvT, scr, r, F.lane); continue; } r -= I_UKV;
        transpose_item<false>(inp(F, I_FW3) + (size_t)l * 64 * 2048, 64, 2048, (GAS bf16*)(wsq(F) + WS_W3T), scr, r % I_W3, F.lane, 128, (r / I_W3) * 64);
    }
    { unsigned z = 0u; asm volatile("" : "+v"(z)); const v4u zz = {z, z, z, z};
      for (int i = gw * 64 + F.lane; i < 12288; i += NGW * 64) ((GAS v4u*)(WinT + (size_t)INW * D))[i] = zz; }
}
__device__ __forceinline__ void phase_rope_tab(Frame& F) {
    const float inv[16] = {1.000000000e+00f, 5.623413324e-01f, 3.162277639e-01f, 1.778279394e-01f, 1.000000015e-01f, 5.623412877e-02f, 3.162277862e-02f, 1.778279431e-02f,
                           9.999999776e-03f, 5.623413250e-03f, 3.162277862e-03f, 1.778279431e-03f, 1.000000047e-03f, 5.623413017e-04f, 3.162277862e-04f, 1.778279402e-04f};
    GAS float* ct = (GAS float*)(wsq(F) + WS_COS); GAS float* st = (GAS float*)(wsq(F) + WS_SIN);
    for (int i = F.vcu * NTHR + F.tid; i < L * 16; i += F.G * NTHR) {
        const int t = i >> 4, j = i & 15; float iv = inv[0];
#pragma unroll
        for (int q = 1; q < 16; ++q) iv = (j == q) ? inv[q] : iv;
        const float ang = (float)t * iv; ct[i] = cosf(ang); st[i] = sinf(ang);
    }
}
__device__ __forceinline__ const GAS float* x_src_row(Frame& F, int l, int m) {
    if (l == 0) return (m < 2 * L) ? inp(F, I_XP) + (size_t)m * D : inp(F, I_XS) + (size_t)(m - 2 * L) * D;
    return (const GAS float*)F.out + (size_t)m * D;
}
__device__ __forceinline__ void store_xn_row(f32x4 (&v)[4], float rstd, const GAS float* g, GAS bf16* orow, int lane) {
    GAS v2u* o8 = (GAS v2u*)orow + lane;
#pragma unroll
    for (int j = 0; j < 4; ++j) { const f32x4 gg = ((const GAS f32x4*)g)[lane + 64 * j]; v2u w; w.x = pk2(v[j].x * rstd * gg.x, v[j].y * rstd * gg.y); w.y = pk2(v[j].z * rstd * gg.z, v[j].w * rstd * gg.w); o8[64 * j] = w; }
}
__device__ __forceinline__ float row_ss(const f32x4 (&v)[4]) { float s = 0.f;
#pragma unroll
    for (int j = 0; j < 4; ++j) s += (v[j].x * v[j].x + v[j].y * v[j].y) + (v[j].z * v[j].z + v[j].w * v[j].w);
    return wave_sum(s); }
__device__ __forceinline__ void phase_norm_first(Frame& F, int l, const GAS float* g) {
    const int gw = F.vcu * NWAVES + F.wave, NGW = F.G * NWAVES; GAS bf16* XN = (GAS bf16*)(wsq(F) + WS_XN);
    for (int m = gw; m < M; m += NGW) {
        const GAS f32x4* xr = (const GAS f32x4*)x_src_row(F, l, m) + F.lane; f32x4 v[4];
#pragma unroll
        for (int j = 0; j < 4; ++j) v[j] = xr[64 * j];
        const float rstd = 1.0f / sqrtf(row_ss(v) * (1.0f / D) + EPS);
        store_xn_row(v, rstd, g, XN + (size_t)m * D, F.lane);
    }
}
__device__ __forceinline__ void phase_norm_res(Frame& F, int lsrc, const GAS bf16* T, const GAS float* gpost, const GAS float* gnext) {
    const int gw = F.vcu * NWAVES + F.wave, NGW = F.G * NWAVES; GAS bf16* XN = (GAS bf16*)(wsq(F) + WS_XN);
    for (int m0 = gw; m0 < M; m0 += 2 * NGW) {
        f32x4 v[2][4], tv[2][4];
#pragma unroll
        for (int q = 0; q < 2; ++q) { const int m = m0 + q * NGW; const GAS f32x4* xr = (const GAS f32x4*)x_src_row(F, lsrc, m) + F.lane; const GAS v2u* tr = (const GAS v2u*)(T + (size_t)m * D) + F.lane;
#pragma unroll
            for (int j = 0; j < 4; ++j) { v[q][j] = xr[64 * j]; const v2u w = tr[64 * j]; tv[q][j] = (f32x4){bf2f(w.x & 0xffffu), bf2f(w.x >> 16), bf2f(w.y & 0xffffu), bf2f(w.y >> 16)}; } }
#pragma unroll
        for (int q = 0; q < 2; ++q) { const int m = m0 + q * NGW;
            const float rt = 1.0f / sqrtf(row_ss(tv[q]) * (1.0f / D) + EPS);
            GAS f32x4* orow = (GAS f32x4*)(F.out + (size_t)m * D) + F.lane;
#pragma unroll
            for (int j = 0; j < 4; ++j) { const f32x4 gg = ((const GAS f32x4*)gpost)[F.lane + 64 * j]; v[q][j] = v[q][j] + tv[q][j] * rt * gg; orow[64 * j] = v[q][j]; }
            if (gnext) { const float rstd = 1.0f / sqrtf(row_ss(v[q]) * (1.0f / D) + EPS); store_xn_row(v[q], rstd, gnext, XN + (size_t)m * D, F.lane); } }
    }
}

__device__ __forceinline__ void phase_filter_mlp(Frame& F, int l) {
    const GAS float* w1 = inp(F, I_FW1) + (size_t)l * 33 * 64; const GAS float* b1 = inp(F, I_FB1) + l * 64; const GAS float* w2 = inp(F, I_FW2) + (size_t)l * 64 * 64; const GAS float* b2 = inp(F, I_FB2) + l * 64;
    const GAS float* sf = inp(F, I_SINF) + l * 128; GAS bf16* H2 = (GAS bf16*)(wsq(F) + WS_H2);
    const int lane = F.lane, gw = F.vcu * NWAVES + F.wave, NGW = F.G * NWAVES;
    float w1c[33], w2c[64];
#pragma unroll
    for (int f = 0; f < 33; ++f) w1c[f] = w1[f * 64 + lane];
#pragma unroll
    for (int i = 0; i < 64; ++i) w2c[i] = w2[i * 64 + lane];
    const float b1l = b1[lane], b2l = b2[lane], sf0 = sf[lane], sf1 = sf[64 + lane];
    for (int n = gw; n < L; n += NGW) {
        const float tn = (float)n * (1.0f / (float)(L - 1)); const float omega = (float)(2.0 * 3.14159265358979323846 / L) * (float)n;
        const int bidx = (lane >= 17) ? lane - 17 : lane - 1; const float band = 1e-4f + (float)bidx * ((15.0f - 1e-4f) / 15.0f); const float ph = omega * band;
        const float zf = (lane == 0) ? tn : ((lane <= 16) ? cosf(ph) : -sinf(ph));
        float acc = b1l;
#pragma unroll
        for (int f = 0; f < 33; ++f) acc += __uint_as_float(__builtin_amdgcn_readlane(__float_as_uint(zf), f)) * w1c[f];
        const float h1 = sinf(sf0 * acc);
        float acc2 = b2l;
#pragma unroll
        for (int i = 0; i < 64; ++i) acc2 += __uint_as_float(__builtin_amdgcn_readlane(__float_as_uint(h1), i)) * w2c[i];
        const float hv = sinf(sf1 * acc2); const bf16 hi = f2bf(hv);
        H2[(size_t)n * 128 + lane] = hi; H2[(size_t)n * 128 + 64 + lane] = f2bf(hv - bf2f(hi));
    }
}

__device__ __forceinline__ void phase_filter_fft(Frame& F, int l) {
    const GAS float* KT = (const GAS float*)(wsq(F) + WS_KT); GAS f32x2* KEO = (GAS f32x2*)(wsq(F) + WS_KEO); const GAS float* hb = inp(F, I_HBIAS) + (size_t)l * 2 * HYW;
    LAS f32x2* buf = (LAS f32x2*)(F.lds + RING_OFF); const int t = F.tid;
    for (int c = F.vcu; c < HYW; c += F.G) {
        const GAS float* fw0 = KT + (size_t)(0 * HYW + c) * L; const GAS float* bw0 = KT + (size_t)(1 * HYW + c) * L;
        const GAS float* fw1 = KT + (size_t)(2 * HYW + c) * L; const GAS float* bw1 = KT + (size_t)(3 * HYW + c) * L;
        const float bias0 = hb[c], bias1 = hb[HYW + c]; const float sc = 1.0f / (2.0f * L);
        GAS f32x2* k0 = KEO + (size_t)c * KEO_BLK; GAS f32x2* k1 = KEO + (size_t)(HYW + c) * KEO_BLK;
        float ar[32], ai[32];
#pragma unroll 1
        for (int odd = 0; odd < 2; ++odd) {
            { const int tq = hfft::opaque(t);
#pragma unroll
              for (int m = 0; m < 32; ++m) { const int n = tq + 512 * m; const int nb = n >= 1 ? L - n : 0;
                  const float f0 = fw0[n], f1 = fw1[n]; float b0 = bw0[nb], b1 = bw1[nb]; b0 = n >= 1 ? b0 : 0.f; b1 = n >= 1 ? b1 : 0.f;
                  if (!odd) { ar[m] = f0 + b0; ai[m] = f1 + b1; }
                  else { const float d0 = f0 - b0, d1 = f1 - b1; const float fr = (float)n * (1.0f / 32768.0f); const float cs = __builtin_amdgcn_cosf(fr), sn = -__builtin_amdgcn_sinf(fr);
                         ar[m] = d0 * cs - d1 * sn; ai[m] = d0 * sn + d1 * cs; }
                  if ((m & 7) == 7) { asm volatile("" ::: "memory"); __builtin_amdgcn_sched_barrier(0); } } }
            hfft::fft16k<false>(ar, ai, buf, t);
            __syncthreads();
            { const int tq = hfft::opaque(t);
#pragma unroll
              for (int m = 0; m < 32; ++m) buf[hfft::pad(tq + 512 * m)] = (f32x2){ar[m], ai[m]}; }
            __syncthreads();
            { const int tq = hfft::opaque(t); GAS f32x2* d0 = k0 + (odd ? KEO_KO : 0); GAS f32x2* d1 = k1 + (odd ? KEO_KO : 0);
#pragma unroll
              for (int m = 0; m <= 16; ++m) { const int k = tq + 512 * m; const bool keep = odd ? (k < 8192) : (k <= 8192);
                  const int rk = odd ? 16383 - k : ((16384 - k) & 16383); const f32x2 xq = buf[hfft::pad(rk)]; const float cr = xq.x, ci = -xq.y;
                  const float a0 = 0.5f * (ar[m] + cr), a1 = 0.5f * (ai[m] + ci), b0 = 0.5f * (ai[m] - ci), b1 = -0.5f * (ar[m] - cr);
                  if (keep) { d0[k] = (f32x2){(a0 + bias0) * sc, a1 * sc}; d1[k] = (f32x2){(b0 + bias1) * sc, b1 * sc}; } } }
        }
    }
    __syncthreads();
}

__device__ __forceinline__ float u_conv3(const GAS bf16* row, int n, float w0, float w1, float w2, float cb) {
    const int nm = n >= 1 ? n - 1 : 0, np = n + 1 < L ? n + 1 : L - 1;
    float um = bf2f(row[nm]), up = bf2f(row[np]); const float u0 = bf2f(row[n]);
    um = n >= 1 ? um : 0.f; up = n + 1 < L ? up : 0.f;
    return um * w0 + u0 * w1 + up * w2 + cb;
}
__device__ __forceinline__ void cmul_spec(float (&xr)[32], float (&xi)[32], const GAS f32x2* ke, int t, bool odd) {
    { const int tq = hfft::opaque(t); (void)tq;
#pragma unroll
    for (int m = 0; m < 32; ++m) { const int k = tq + 512 * m; int idx; bool cj;
        if (!odd) { cj = k > 8192; idx = cj ? 16384 - k : k; } else { cj = k >= 8192; idx = cj ? 16383 - k : k; }
        const f32x2 kv = ke[idx]; const float kr = kv.x, ki = cj ? -kv.y : kv.y;
        const float a = xr[m], b = xi[m]; xr[m] = a * kr - b * ki; xi[m] = a * ki + b * kr; if ((m & 15) == 15) { asm volatile("" ::: "memory"); __builtin_amdgcn_sched_barrier(0); } }
    }
}
__device__ __forceinline__ f32x2 ld_spec(const GAS f32x2* ke, int k, bool odd) {
    int idx; bool cj;
    if (!odd) { cj = k > 8192; idx = cj ? 16384 - k : k; } else { cj = k >= 8192; idx = cj ? 16383 - k : k; }
    f32x2 kv = ke[idx]; kv.y = cj ? -kv.y : kv.y; return kv;
}
__device__ __forceinline__ void cmul_spec2(float (&xr)[32], float (&xi)[32], const GAS f32x2* ka, const GAS f32x2* kb, LAS f32x2* buf, int t, bool odd) {
    __syncthreads();
    { const int tq = hfft::opaque(t);
#pragma unroll
      for (int m = 0; m < 32; ++m) buf[hfft::pad(tq + 512 * m)] = (f32x2){xr[m], xi[m]}; }
    __syncthreads();
    { const int tq = hfft::opaque(t);
#pragma unroll
      for (int m = 0; m < 32; ++m) { const int k = tq + 512 * m; const int rk = odd ? 16383 - k : ((16384 - k) & 16383);
          const f32x2 xc = buf[hfft::pad(rk)];
          const f32x2 a = ld_spec(ka, k, odd), b = ld_spec(kb, k, odd);
          const float sr = 0.5f * (a.x + b.x), si = 0.5f * (a.y + b.y), dr = 0.5f * (a.x - b.x), di = 0.5f * (a.y - b.y);
          const float x0 = xr[m], x1 = xi[m], c0 = xc.x, c1 = -xc.y;
          xr[m] = (x0 * sr - x1 * si) + (c0 * dr - c1 * di); xi[m] = (x0 * si + x1 * sr) + (c0 * di + c1 * dr);
          if ((m & 7) == 7) { asm volatile("" ::: "memory"); __builtin_amdgcn_sched_barrier(0); } } }
}
__device__ __forceinline__ void phase_hyena(Frame& F, int l) {
    const GAS bf16* UT = (const GAS bf16*)(wsq(F) + WS_UT); GAS bf16* YT = (GAS bf16*)(wsq(F) + WS_YT); const GAS f32x2* KEO = (const GAS f32x2*)(wsq(F) + WS_KEO);
    const GAS float* cw = inp(F, I_CONVW) + (size_t)l * 3 * HYP; const GAS float* cbv = inp(F, I_CONVB) + (size_t)l * HYP;
    LAS f32x2* buf = (LAS f32x2*)(F.lds + RING_OFF); const int t = F.tid;
    GAS f32x2* G0 = (GAS f32x2*)(wsq(F) + WS_G0) + (size_t)F.vcu * 16384 + t;
    for (int item = F.vcu; item < HYW + HYW / 2; item += F.G) {
        const bool mode1 = item >= HYW;
        const int c0 = mode1 ? 2 * (item - HYW) : item, c1 = mode1 ? c0 + 1 : c0;
        const size_t s0 = mode1 ? (size_t)2 * L : 0, s1 = mode1 ? (size_t)2 * L : (size_t)L;
        float ar[32], ai[32]; unsigned ep[32];
#pragma unroll 1
        for (int o = 0; o < 2; ++o) {
            const GAS f32x2* ke0 = KEO + (size_t)(o * HYW + c0) * KEO_BLK; const GAS f32x2* ke1 = KEO + (size_t)(o * HYW + c1) * KEO_BLK;
#pragma unroll 1
            for (int half = 0; half < 2; ++half) {
                if (o == 0) { const float w0 = cw[c0], w1 = cw[HYP + c0], w2 = cw[2 * HYP + c0], cb = cbv[c0], v0 = cw[c1], v1 = cw[HYP + c1], v2 = cw[2 * HYP + c1], vb = cbv[c1];
                    const GAS bf16* r0 = UT + (size_t)c0 * M + s0; const GAS bf16* r1 = UT + (size_t)c1 * M + s1;
                    { const int tq = hfft::opaque(t); (void)tq;
#pragma unroll
                    for (int m = 0; m < 32; ++m) { const int n = tq + 512 * m; ar[m] = u_conv3(r0, n, w0, w1, w2, cb); ai[m] = u_conv3(r1, n, v0, v1, v2, vb); if ((m & 15) == 15) { asm volatile("" ::: "memory"); __builtin_amdgcn_sched_barrier(0); } } }
                    }
                else {
                    { const int tq = hfft::opaque(t); (void)tq; GAS f32x2* G0q = G0 + (tq - t);
#pragma unroll
                    for (int m = 0; m < 32; ++m) { const f32x2 v = G0q[m * 512]; ar[m] = v.x; ai[m] = v.y; if ((m & 15) == 15) { asm volatile("" ::: "memory"); __builtin_amdgcn_sched_barrier(0); } } }
                    }
                if (half == 0) {
                    hfft::fft16k<false>(ar, ai, buf, t);
                    if (mode1) cmul_spec2(ar, ai, ke0, ke1, buf, t, false); else cmul_spec(ar, ai, ke0, t, false);
                    hfft::fft16k<true>(ar, ai, buf, t);
                    {
#pragma unroll
                    for (int m = 0; m < 32; ++m) ep[m] = pk2(ar[m], ai[m]);
                    }
                } else {
                    { const int tq = hfft::opaque(t); (void)tq;
#pragma unroll
                    for (int m = 0; m < 32; ++m) { const float fr = (float)(tq + 512 * m) * (1.0f / 32768.0f); const float cs = __builtin_amdgcn_cosf(fr), sn = -__builtin_amdgcn_sinf(fr);
                        const float a = ar[m], b = ai[m]; ar[m] = a * cs - b * sn; ai[m] = a * sn + b * cs; }
                    }
                    hfft::fft16k<false>(ar, ai, buf, t);
                    if (mode1) cmul_spec2(ar, ai, ke0 + KEO_KO, ke1 + KEO_KO, buf, t, true); else cmul_spec(ar, ai, ke0 + KEO_KO, t, true);
                    hfft::fft16k<true>(ar, ai, buf, t);
                    const int g0 = (o + 1) * HYW + c0, g1 = (o + 1) * HYW + c1;
                    const float w0 = cw[g0], w1 = cw[HYP + g0], w2 = cw[2 * HYP + g0], cb = cbv[g0], v0 = cw[g1], v1 = cw[HYP + g1], v2 = cw[2 * HYP + g1], vb = cbv[g1];
                    const GAS bf16* r0 = UT + (size_t)g0 * M + s0; const GAS bf16* r1 = UT + (size_t)g1 * M + s1;
                    { const int tq = hfft::opaque(t); (void)tq;
#pragma unroll
                    for (int m = 0; m < 32; ++m) { const int n = tq + 512 * m; const float fr = (float)n * (1.0f / 32768.0f); const float cs = __builtin_amdgcn_cosf(fr), sn = __builtin_amdgcn_sinf(fr);
                        const float a = ar[m], b = ai[m]; const f32x2 e = {__uint_as_float(ep[m] << 16), __uint_as_float(ep[m] & 0xffff0000u)}; const float yr = e.x + (a * cs - b * sn), yi = e.y + (a * sn + b * cs);
                        ar[m] = yr * u_conv3(r0, n, w0, w1, w2, cb); ai[m] = yi * u_conv3(r1, n, v0, v1, v2, vb); if ((m & 15) == 15) { asm volatile("" ::: "memory"); __builtin_amdgcn_sched_barrier(0); } }
                    }
                    if (o == 0) {
                        { const int tq = hfft::opaque(t); (void)tq; GAS f32x2* G0q = G0 + (tq - t);
#pragma unroll
                        for (int m = 0; m < 32; ++m) G0q[m * 512] = (f32x2){ar[m], ai[m]};
                        }
                    } else { GAS bf16* y0 = YT + (size_t)c0 * M + s0; GAS bf16* y1 = YT + (size_t)c1 * M + s1;
                        { const int tq = hfft::opaque(t); (void)tq;
#pragma unroll
                        for (int m = 0; m < 32; ++m) { const int n = tq + 512 * m; y0[n] = f2bf(ar[m]); y1[n] = f2bf(ai[m]); } }
                        }
                }
            }
        }
    }
    __syncthreads();
}

__device__ __forceinline__ void phase_mla_prep(Frame& F, int l) {
    const GAS bf16* CQKV = (const GAS bf16*)(wsq(F) + WS_CQKV); GAS bf16* CQN = (GAS bf16*)(wsq(F) + WS_CQN); GAS bf16* CKVN = (GAS bf16*)(wsq(F) + WS_CKVN); GAS bf16* KPE = (GAS bf16*)(wsq(F) + WS_KPE);
    const GAS float* gq = inp(F, I_QNORM) + l * QR; const GAS float* gkv = inp(F, I_KVNORM) + l * KVR; const GAS float* ct = (const GAS float*)(wsq(F) + WS_COS); const GAS float* st = (const GAS float*)(wsq(F) + WS_SIN);
    const int gw = F.vcu * NWAVES + F.wave, NGW = F.G * NWAVES, lane = F.lane;
    for (int m = gw; m < M; m += NGW) {
        const GAS bf16* row = CQKV + (size_t)m * 512;
        const v2u q = *(const GAS v2u*)(row + 4 * lane); const unsigned kv = *(const GAS unsigned*)(row + 256 + 2 * lane);
        const float q0 = bf2f(q.x & 0xffffu), q1 = bf2f(q.x >> 16), q2 = bf2f(q.y & 0xffffu), q3 = bf2f(q.y >> 16), k0 = bf2f(kv & 0xffffu), k1 = bf2f(kv >> 16);
        const float rq = 1.0f / sqrtf(wave_sum((q0 * q0 + q1 * q1) + (q2 * q2 + q3 * q3)) * (1.0f / QR) + EPS);
        const float rk = 1.0f / sqrtf(wave_sum(k0 * k0 + k1 * k1) * (1.0f / KVR) + EPS);
        const f32x4 g4 = *(const GAS f32x4*)(gq + 4 * lane); const f32x2 g2 = *(const GAS f32x2*)(gkv + 2 * lane);
        v2u oq; oq.x = pk2(q0 * rq * g4.x, q1 * rq * g4.y); oq.y = pk2(q2 * rq * g4.z, q3 * rq * g4.w);
        *(GAS v2u*)(CQN + (size_t)m * QR + 4 * lane) = oq;
        *(GAS unsigned*)(CKVN + (size_t)m * KVR + 2 * lane) = pk2(k0 * rk * g2.x, k1 * rk * g2.y);
        if (lane < 16) { const int j = lane, tpos = m & (L - 1); const float x1 = bf2f(row[384 + j]), x2 = bf2f(row[384 + 16 + j]); const float cs = ct[tpos * 16 + j], sn = st[tpos * 16 + j];
            const int p1 = 8 * (j >> 2) + (j & 3); KPE[(size_t)m * ROPE + p1] = f2bf(x1 * cs - x2 * sn); KPE[(size_t)m * ROPE + p1 + 4] = f2bf(x2 * cs + x1 * sn); }
    }
}

__device__ __forceinline__ void phase_hy_out(Frame& F, int l) {
    const GAS bf16* YT = (const GAS bf16*)(wsq(F) + WS_YT); GAS bf16* MIX = (GAS bf16*)(wsq(F) + WS_MIX); const GAS float* gn = inp(F, I_GNHY) + l * HYW;
    LAS bf16* tl = (LAS bf16*)(F.lds + RING_OFF + F.wave * 16384);
    const int gw = F.vcu * NWAVES + F.wave, NGW = F.G * NWAVES, lane = F.lane;
    for (int task = gw; task < 8 * (M / 64); task += NGW) {
        const int g = task & 7, tb = task >> 3, tok0 = tb * 64; const int cl = lane >> 3, t8 = (lane & 7) * 8;
        float v[8][8]; float ss[8]; const int ln_ = hw_lane();
#pragma unroll
        for (int j = 0; j < 8; ++j) ss[j] = 0.f;
#pragma unroll
        for (int i = 0; i < 8; ++i) { const int ch = g * 64 + 8 * i + cl; const v4u w = *(const GAS v4u*)(YT + (size_t)ch * M + tok0 + t8);
            v[i][0] = bf2f(w.x & 0xffffu); v[i][1] = bf2f(w.x >> 16); v[i][2] = bf2f(w.y & 0xffffu); v[i][3] = bf2f(w.y >> 16);
            v[i][4] = bf2f(w.z & 0xffffu); v[i][5] = bf2f(w.z >> 16); v[i][6] = bf2f(w.w & 0xffffu); v[i][7] = bf2f(w.w >> 16);
#pragma unroll
            for (int j = 0; j < 8; ++j) ss[j] += v[i][j] * v[i][j]; }
#pragma unroll
        for (int j = 0; j < 8; ++j) { float s = ss[j]; s += shx(s, ln_, 8); s += shx(s, ln_, 16); s += shx(s, ln_, 32); ss[j] = 1.0f / sqrtf(s * (1.0f / 64.0f) + EPS); }
#pragma unroll
        for (int i = 0; i < 8; ++i) { const int cc = 8 * i + cl; const float gg = gn[g * 64 + cc];
#pragma unroll
            for (int j = 0; j < 8; ++j) tl[(t8 + j) * 72 + cc] = f2bf(v[i][j] * ss[j] * gg); }
        LDS_WAIT(); asm volatile("" ::: "memory");
#pragma unroll
        for (int i = 0; i < 8; ++i) { const int tok = 8 * i + (lane >> 3), c8 = (lane & 7) * 8; const v4u w = *(const LAS v4u*)(tl + tok * 72 + c8);
            *(GAS v4u*)(MIX + (size_t)(tok0 + tok) * D + g * 64 + c8) = w; }
        LDS_WAIT(); asm volatile("" ::: "memory");
    }
}

namespace att {
using s16x4 = __attribute__((ext_vector_type(4))) short;
using f32x16 = __attribute__((ext_vector_type(16))) float;
using u32x4 = __attribute__((ext_vector_type(4))) unsigned;
constexpr int QBLK = 32, KVBLK = 64, NW = 8;
constexpr float SCALE = 0.10206207261596575f;
constexpr float THR = 8.f;
constexpr int SHM_K = KVBLK * 256, SHM_V = KVBLK * DV * 2;
constexpr int NSLOT = 4;
constexpr int OFF_V = 0, OFF_K = NSLOT * SHM_V, OFF_WS = OFF_K + NSLOT * SHM_K, SHM_ATTN = OFF_WS + NW * 64 * 4;
#define KSWZ(row, colB) ((row) * 256 + ((colB) ^ (((row) & 15) << 4)))
#define SBAR() __builtin_amdgcn_sched_barrier(0)
__device__ __forceinline__ int crow(int r, int hi) { return (r & 3) + 8 * (r >> 2) + 4 * hi; }
__device__ __forceinline__ unsigned cvtpk(float lo, float hi) { unsigned r; asm volatile("v_cvt_pk_bf16_f32 %0, %1, %2" : "=v"(r) : "v"(lo), "v"(hi)); return r; }
constexpr float THRL = THR * 1.4426950408889634f;
#define EX2(v) ((ABL & 1) ? (v) : __builtin_amdgcn_exp2f(v))
#define MX3(a, b, c) ((ABL & 128) ? (a) : __builtin_fmaxf(__builtin_fmaxf((a), (b)), (c)))
__device__ __forceinline__ int v_st(int k, int c) { const int kk = k; return ((kk >> 3) * 2 + (c >> 5)) * 512 + ((kk & 7) * 32 + (c & 31)) * 2; }
__device__ __forceinline__ int v_rd_base(int lane) { return ((lane & 3) << 3) | (((lane >> 2) & 3) << 6) | (((lane >> 4) & 1) << 5) | (((lane >> 5) & 1) << 8); }
constexpr int v_rd_off(int d0, int ks, int half) { return d0 * 512 + ks * 2048 + half * 1024; }
template <int OFF> __device__ __forceinline__ s16x4 tr_read(int vb) { s16x4 r; asm volatile("ds_read_b64_tr_b16 %0, %1 offset:%2" : "=&v"(r) : "v"(vb), "i"(OFF) : "memory"); return r; }
template <int ABL> __device__ __forceinline__ void attn_unit(const bf16* Qb_, const bf16* KNh_, const bf16* KPEb_, const bf16* Vh_, bf16* Mo_,
                                          const float* gain_, const float* ct_, const float* st_, int tpos0, LAS char* lds, const int wave0) {
  const GAS bf16* Qb = (const GAS bf16*)Qb_; const GAS bf16* KNh = (const GAS bf16*)KNh_; const GAS bf16* KPEb = (const GAS bf16*)KPEb_; const GAS bf16* Vh = (const GAS bf16*)Vh_; GAS bf16* Mo = (GAS bf16*)Mo_;
  const GAS float* gain = (const GAS float*)gain_; const GAS float* ct = (const GAS float*)ct_; const GAS float* st = (const GAS float*)st_;

  int tid_ = tid_from_wave(wave0);
  const int tid = tid_, wid = tid >> 6, lane = tid & 63, r32 = lane & 31, hi = lane >> 5;
  LAS char* V_lds = lds + OFF_V; LAS char* K_lds = lds + OFF_K;
  LAS float* ws = (LAS float*)(lds + OFF_WS) + wid * 64; LAS float* li_l = ws; LAS float* al_l = ws + 32;
  float m_reg = 0.f, l_reg = 0.f; f32x16 o[2] = {}; f32x16 negm = {}; bf16x8 qr[6];
  const GAS bf16* Qw = Qb + (long)(wid * QBLK + r32) * NQ + hi * 8;
#pragma unroll
  for (int d0 = 0; d0 < 6; ++d0) qr[d0] = *reinterpret_cast<const GAS bf16x8*>(Qw + d0 * 16);
  { const int tq = tpos0 + wid * QBLK + r32;
#pragma unroll
    for (int d0 = 4; d0 < 6; ++d0) { const int fq = 2 * (d0 - 4) + hi; const f32x4 cs = *reinterpret_cast<const GAS f32x4*>(ct + tq * 16 + 4 * fq), sn = *reinterpret_cast<const GAS f32x4*>(st + tq * 16 + 4 * fq);
      const u32x4 w = __builtin_bit_cast(u32x4, qr[d0]);
      const f32x4 x1 = {bf2f(w[0] & 0xffffu), bf2f(w[0] >> 16), bf2f(w[1] & 0xffffu), bf2f(w[1] >> 16)}, x2 = {bf2f(w[2] & 0xffffu), bf2f(w[2] >> 16), bf2f(w[3] & 0xffffu), bf2f(w[3] >> 16)};
      const f32x4 a = x1 * cs - x2 * sn, b = x2 * cs + x1 * sn;
      const u32x4 o4 = {cvtpk(a[0], a[1]), cvtpk(a[2], a[3]), cvtpk(b[0], b[1]), cvtpk(b[2], b[3])}; qr[d0] = __builtin_bit_cast(bf16x8, o4); } }
  { constexpr float C = SCALE * 1.4426950408889634f;
#pragma unroll
    for (int d0 = 0; d0 < 6; ++d0) { const u32x4 w = __builtin_bit_cast(u32x4, qr[d0]); u32x4 o4;
#pragma unroll
      for (int e = 0; e < 4; ++e) o4[e] = cvtpk(bf2f(w[e] & 0xffffu) * C, bf2f(w[e] >> 16) * C);
      qr[d0] = __builtin_bit_cast(bf16x8, o4); } }
  const int vb0 = (int)(unsigned)(uintptr_t)V_lds + v_rd_base(lane);
  const int wid_s = __builtin_amdgcn_readfirstlane(wid);
  const GAS bf16* ksrc[2]; long kstep[2];
#pragma unroll
  for (int q = 0; q < 2; ++q) { const int r = 4 * (2 * wid + q) + (lane >> 4), c = (lane & 15) ^ (r & 15); const bool rope = (c >= 8) && (c < 12);
    ksrc[q] = rope ? KPEb + (long)r * ROPE + (c - 8) * 8 : KNh + (long)r * NKV + (c & 7) * 8; kstep[q] = rope ? (long)KVBLK * ROPE : (long)KVBLK * NKV; }
  const GAS bf16* vsrc; { const int p = 64 * wid + lane, sub = p >> 5, kk = (sub >> 1) * 8 + ((p >> 2) & 7), col = (sub & 1) * 32 + (p & 3) * 8; vsrc = Vh + (long)kk * NKV + col; }
#define DMA(t, slot) do { if (ABL & 32) break; \
    __builtin_amdgcn_global_load_lds((const GAS unsigned*)(ksrc[0] + (long)(t) * kstep[0]), (LAS unsigned*)(K_lds + (slot) * SHM_K + (2 * wid_s) * 1024), 16, 0, 0); \
    __builtin_amdgcn_global_load_lds((const GAS unsigned*)(ksrc[1] + (long)(t) * kstep[1]), (LAS unsigned*)(K_lds + (slot) * SHM_K + (2 * wid_s + 1) * 1024), 16, 0, 0); \
    __builtin_amdgcn_global_load_lds((const GAS unsigned*)(vsrc + (long)(t) * ((long)KVBLK * NKV)), (LAS unsigned*)(V_lds + (slot) * SHM_V + wid_s * 1024), 16, 0, 0); } while (0)
#define TBAR(N) do { asm volatile("s_waitcnt vmcnt(" #N ") lgkmcnt(0)" ::: "memory"); if (!(ABL & 64)) __builtin_amdgcn_s_barrier(); asm volatile("" ::: "memory"); } while (0)
#define RESC(a) do { if (__any((a) < 1.f)) { if (hi == 0) al_l[r32] = (a); asm volatile("s_waitcnt lgkmcnt(0)" ::: "memory"); \
    _Pragma("unroll") for (int d = 0; d < 2; ++d) _Pragma("unroll") for (int r = 0; r < 16; ++r) o[d][r] *= al_l[crow(r, hi)]; } } while (0)
  f32x16 pA0, pA1, pB0, pB1; bf16x8 pa0, pa1, pa2, pa3; constexpr int NTL = L / KVBLK; constexpr int SE = 0, SO = 1;
  int koff[6];
#pragma unroll
  for (int d0 = 0; d0 < 6; ++d0) koff[d0] = KSWZ(r32, (d0 * 16 + hi * 8) * 2);
  s16x4 vl[4], vh[4]; float pmax = 0.f, alpha = 1.f;
#define KFR(i) ((ABL & 8) ? qr[(i) >> 1] : *(const LAS bf16x8*)(kbase + koff[(i) >> 1] + ((i) & 1) * 8192))
#define MQK(a_, b_, c_) ((ABL & 2) ? (c_) : __builtin_amdgcn_mfma_f32_32x32x16_bf16(a_, b_, c_, 0, 0, 0))
#define MPV(a_, b_, c_) ((ABL & 4) ? (c_) : __builtin_amdgcn_mfma_f32_32x32x16_bf16(a_, b_, c_, 0, 0, 0))
#define VRD8(D0) do { if (ABL & 16) break; vl[0] = tr_read<v_rd_off(D0, 0, 0)>(vbq); vh[0] = tr_read<v_rd_off(D0, 0, 1)>(vbq); vl[1] = tr_read<v_rd_off(D0, 1, 0)>(vbq); vh[1] = tr_read<v_rd_off(D0, 1, 1)>(vbq); \
    vl[2] = tr_read<v_rd_off(D0, 2, 0)>(vbq); vh[2] = tr_read<v_rd_off(D0, 2, 1)>(vbq); vl[3] = tr_read<v_rd_off(D0, 3, 0)>(vbq); vh[3] = tr_read<v_rd_off(D0, 3, 1)>(vbq); } while (0)
#define VWAIT() if (!(ABL & 16)) asm volatile("s_waitcnt lgkmcnt(0)" : "+v"(vl[0]), "+v"(vh[0]), "+v"(vl[1]), "+v"(vh[1]), "+v"(vl[2]), "+v"(vh[2]), "+v"(vl[3]), "+v"(vh[3]) :: "memory")
#define VFR(k) (bf16x8){vl[k][0], vl[k][1], vl[k][2], vl[k][3], vh[k][0], vh[k][1], vh[k][2], vh[k][3]}
#define PKA(P, B) do { if (ABL & 256) break; w0_ = cvtpk(P[B + 0], P[B + 1]); w1_ = cvtpk(P[B + 2], P[B + 3]); } while (0)
#define PKB(P, B, OUT) do { if (ABL & 256) { OUT = qr[0]; break; } const u32x4 w_ = {w0_, w1_, cvtpk(P[B + 4], P[B + 5]), cvtpk(P[B + 6], P[B + 7])}; OUT = __builtin_bit_cast(bf16x8, w_); } while (0)
#define R1(DO_QK, DO_FIN, X0, X1, Y0, Y1, KSLOT) do { const LAS char* kbase = K_lds + (KSLOT) * SHM_K; bf16x8 kf0, kf1, kf2, kf3; unsigned w0_ = 0, w1_ = 0; \
    if (DO_QK) { kf0 = KFR(0); kf1 = KFR(1); kf2 = KFR(2); } SBAR(); \
      if (DO_QK) { kf3 = KFR(3); X0 = MQK(kf0, qr[0], negm); } if (DO_FIN) { Y0[0] = EX2(Y0[0]); Y0[1] = EX2(Y0[1]); Y0[2] = EX2(Y0[2]); Y0[3] = EX2(Y0[3]); } SBAR(); \
      if (DO_QK) { kf0 = KFR(4); X1 = MQK(kf1, qr[0], negm); } if (DO_FIN) { Y0[4] = EX2(Y0[4]); Y0[5] = EX2(Y0[5]); Y0[6] = EX2(Y0[6]); Y0[7] = EX2(Y0[7]); } SBAR(); \
      if (DO_QK) { kf1 = KFR(5); X0 = MQK(kf2, qr[1], X0); } if (DO_FIN) { Y0[8] = EX2(Y0[8]); Y0[9] = EX2(Y0[9]); Y0[10] = EX2(Y0[10]); Y0[11] = EX2(Y0[11]); } SBAR(); \
      if (DO_QK) { kf2 = KFR(6); X1 = MQK(kf3, qr[1], X1); } if (DO_FIN) { Y0[12] = EX2(Y0[12]); Y0[13] = EX2(Y0[13]); Y0[14] = EX2(Y0[14]); Y0[15] = EX2(Y0[15]); } SBAR(); \
      if (DO_QK) { kf3 = KFR(7); X0 = MQK(kf0, qr[2], X0); } if (DO_FIN) { Y1[0] = EX2(Y1[0]); Y1[1] = EX2(Y1[1]); Y1[2] = EX2(Y1[2]); Y1[3] = EX2(Y1[3]); PKA(Y0, 0); } SBAR(); \
      if (DO_QK) { kf0 = KFR(8); X1 = MQK(kf1, qr[2], X1); } if (DO_FIN) { Y1[4] = EX2(Y1[4]); Y1[5] = EX2(Y1[5]); Y1[6] = EX2(Y1[6]); Y1[7] = EX2(Y1[7]); PKB(Y0, 0, pa0); } SBAR(); \
      if (DO_QK) { kf1 = KFR(9); X0 = MQK(kf2, qr[3], X0); } if (DO_FIN) { Y1[8] = EX2(Y1[8]); Y1[9] = EX2(Y1[9]); Y1[10] = EX2(Y1[10]); Y1[11] = EX2(Y1[11]); PKA(Y0, 8); } SBAR(); \
      if (DO_QK) { kf2 = KFR(10); X1 = MQK(kf3, qr[3], X1); } if (DO_FIN) { Y1[12] = EX2(Y1[12]); Y1[13] = EX2(Y1[13]); Y1[14] = EX2(Y1[14]); Y1[15] = EX2(Y1[15]); PKB(Y0, 8, pa1); } SBAR(); \
      if (DO_QK) { kf3 = KFR(11); X0 = MQK(kf0, qr[4], X0); } if (DO_FIN) { PKA(Y1, 0); } SBAR(); \
      if (DO_QK) { X1 = MQK(kf1, qr[4], X1); } if (DO_FIN) { PKB(Y1, 0, pa2); } SBAR(); \
      if (DO_QK) { X0 = MQK(kf2, qr[5], X0); } if (DO_FIN) { PKA(Y1, 8); } SBAR(); \
      if (DO_QK) { X1 = MQK(kf3, qr[5], X1); } if (DO_FIN) { PKB(Y1, 8, pa3); } SBAR(); \
  } while (0)
#define R2(DO_PV, DO_MAX, X0, X1, Y0, Y1, VSLOT, LOADS) do { const int vbq = vb0 + (VSLOT) * SHM_V; float ma_ = 0.f, mb_ = 0.f, sa_ = 0.f; \
    if (DO_PV) { VRD8(0); } SBAR(); \
    if (DO_PV) { VWAIT(); o[0] = MPV(pa0, VFR(0), o[0]); if (!(ABL & 640)) sa_ = (Y0[0] + Y0[1]) + (Y0[2] + Y0[3]); } SBAR(); \
    if (DO_PV) { o[0] = MPV(pa1, VFR(1), o[0]); if (!(ABL & 640)) sa_ += Y0[4]; if (!(ABL & 640)) sa_ += Y0[5]; if (!(ABL & 640)) sa_ += Y0[6]; if (!(ABL & 640)) sa_ += Y0[7]; } LOADS; SBAR(); \
    if (DO_PV) { o[0] = MPV(pa2, VFR(2), o[0]); if (!(ABL & 640)) sa_ += Y0[8]; if (!(ABL & 640)) sa_ += Y0[9]; if (!(ABL & 640)) sa_ += Y0[10]; if (!(ABL & 640)) sa_ += Y0[11]; } SBAR(); \
    if (DO_PV) { o[0] = MPV(pa3, VFR(3), o[0]); if (!(ABL & 640)) sa_ += Y0[12]; if (!(ABL & 640)) sa_ += Y0[13]; if (!(ABL & 640)) sa_ += Y0[14]; if (!(ABL & 640)) sa_ += Y0[15]; } SBAR(); \
    if (DO_PV) { VRD8(1); if (!(ABL & 640)) sa_ += Y1[0]; if (!(ABL & 640)) sa_ += Y1[1]; if (!(ABL & 640)) sa_ += Y1[2]; if (!(ABL & 640)) sa_ += Y1[3]; if (!(ABL & 640)) sa_ += Y1[4]; if (!(ABL & 640)) sa_ += Y1[5]; if (!(ABL & 640)) sa_ += Y1[6]; if (!(ABL & 640)) sa_ += Y1[7]; } \
    if (DO_MAX) { ma_ = MX3(X0[0], X0[1], X1[0]); mb_ = MX3(X0[2], X0[3], X1[1]); ma_ = MX3(ma_, X1[2], X1[3]); ma_ = MX3(ma_, X0[4], X0[5]); mb_ = MX3(mb_, X0[6], X0[7]); ma_ = MX3(ma_, X1[4], X1[5]); mb_ = MX3(mb_, X1[6], X1[7]); } SBAR(); \
    if (DO_PV) { VWAIT(); o[1] = MPV(pa0, VFR(0), o[1]); if (!(ABL & 640)) sa_ += Y1[8]; if (!(ABL & 640)) sa_ += Y1[9]; if (!(ABL & 640)) sa_ += Y1[10]; if (!(ABL & 640)) sa_ += Y1[11]; } if (DO_MAX) { ma_ = MX3(ma_, X0[8], X0[9]); mb_ = MX3(mb_, X0[10], X0[11]); } SBAR(); \
    if (DO_PV) { o[1] = MPV(pa1, VFR(1), o[1]); if (!(ABL & 640)) sa_ += Y1[12]; if (!(ABL & 640)) sa_ += Y1[13]; if (!(ABL & 640)) sa_ += Y1[14]; if (!(ABL & 640)) sa_ += Y1[15]; } if (DO_MAX) { ma_ = MX3(ma_, X1[8], X1[9]); mb_ = MX3(mb_, X1[10], X1[11]); } SBAR(); \
    if (DO_PV) { o[1] = MPV(pa2, VFR(2), o[1]); l_reg += sa_; if (ABL & 512) { o[0] = MPV(pa0, qr[0], o[0]); o[0] = MPV(pa1, qr[0], o[0]); } } if (DO_MAX) { ma_ = MX3(ma_, X0[12], X0[13]); mb_ = MX3(mb_, X0[14], X0[15]); ma_ = MX3(ma_, X1[12], X1[13]); mb_ = MX3(mb_, X1[14], X1[15]); } SBAR(); \
    if (DO_PV) { o[1] = MPV(pa3, VFR(3), o[1]); if (ABL & 512) { o[0] = MPV(pa2, qr[0], o[0]); o[0] = MPV(pa3, qr[0], o[0]); } } if (DO_MAX) { float m_ = __builtin_fmaxf(ma_, mb_); auto rr_ = __builtin_amdgcn_permlane32_swap(__float_as_uint(m_), __float_as_uint(m_), false, false); pmax = __builtin_fmaxf(__uint_as_float(rr_[0]), __uint_as_float(rr_[1])); } SBAR(); \
  } while (0)
#define DECIDE(FIRST, X0, X1) do { alpha = 1.f; \
    if ((FIRST) || !__builtin_expect(__all(pmax <= THRL), 1)) { const float d_ = (FIRST) ? pmax : __builtin_fmaxf(pmax, 0.f); m_reg += d_; if (!(FIRST)) alpha = EX2(-d_); \
      _Pragma("unroll") for (int r = 0; r < 16; ++r) { X0[r] -= d_; X1[r] -= d_; } \
      _Pragma("unroll") for (int r = 0; r < 16; ++r) negm[r] = -m_reg; l_reg *= alpha; } \
    RESC(alpha); } while (0)
  DMA(0, 0); DMA(1, 1);
  TBAR(3);
  R1(true, false, pA0, pA1, pB0, pB1, 0);
  R2(false, true, pA0, pA1, pB0, pB1, 0, DMA(2, 2));
  DECIDE(true, pA0, pA1);
  TBAR(3);
  for (int j = 1; j + 1 < NTL; j += 2) {
    R1(true, true, pB0, pB1, pA0, pA1, j & 3);
    R2(true, true, pB0, pB1, pA0, pA1, (j - 1) & 3, DMA(j + 2, (j + 2) & 3));
    DECIDE(false, pB0, pB1);
    TBAR(3);
    R1(true, true, pA0, pA1, pB0, pB1, (j + 1) & 3);
    R2(true, true, pA0, pA1, pB0, pB1, j & 3, if (j + 3 < NTL) DMA(j + 3, (j + 3) & 3));
    DECIDE(false, pA0, pA1);
    if (j + 3 < NTL) TBAR(3); else TBAR(0);
  }
  R1(true, true, pB0, pB1, pA0, pA1, (NTL - 1) & 3);
  R2(true, true, pB0, pB1, pA0, pA1, (NTL - 2) & 3, (void)0);
  DECIDE(false, pB0, pB1);
  R1(false, true, pA0, pA1, pB0, pB1, 0);
  R2(true, false, pA0, pA1, pB0, pB1, (NTL - 1) & 3, (void)0);
#undef DECIDE
#undef R2
#undef R1
#undef PKA
#undef PKB
#undef VFR
#undef VWAIT
#undef VRD8
#undef KFR
  { auto rr = __builtin_amdgcn_permlane32_swap(__float_as_uint(l_reg), __float_as_uint(l_reg), false, false); l_reg = __uint_as_float(rr[0]) + __uint_as_float(rr[1]); }
  if (hi == 0) li_l[r32] = l_reg; asm volatile("s_waitcnt lgkmcnt(0)" ::: "memory");
  const float g0 = gain[r32], g1 = gain[32 + r32]; const int ln_ = hw_lane();
  GAS bf16* Ow = Mo + (long)(wid * QBLK) * D;
#pragma unroll
  for (int r = 0; r < 16; ++r) { const int orow = crow(r, hi); const float rl = __builtin_amdgcn_rcpf(li_l[orow]);
    const float y0 = o[0][r] * rl, y1 = o[1][r] * rl; float s = y0 * y0 + y1 * y1;
    s += shx(s, ln_, 1); s += shx(s, ln_, 2); s += shx(s, ln_, 4); s += shx(s, ln_, 8); s += shx(s, ln_, 16);
    const float rs = 1.0f / sqrtf(s * (1.0f / 64.0f) + EPS);
    Ow[(long)orow * D + r32] = f2bf(y0 * rs * g0); Ow[(long)orow * D + 32 + r32] = f2bf(y1 * rs * g1); }
  __syncthreads();
#undef DMA
#undef TBAR
#undef RESC
}
#undef EX2
#undef MX3
#undef KSWZ
#undef SBAR
}
#define XB_TMO      128
#define XB_XCNT(j)  (256  + 64 * (j))
#define XB_XSUB(j)  (1280 + 64 * (j))
#define XB_XGEN(j)  (2304 + 64 * (j))
#define XB_TOP      3328
#define XB_TOPGEN   3392
#define XCD_BAR_WORDS 3456
#define XB_SPIN_CAP (1u << 18)

__device__ __forceinline__ unsigned xb_ld(unsigned* p)              { return __hip_atomic_load(p, __ATOMIC_RELAXED, __HIP_MEMORY_SCOPE_AGENT); }
__device__ __forceinline__ unsigned xb_add(unsigned* p, unsigned v) { return __hip_atomic_fetch_add(p, v, __ATOMIC_RELAXED, __HIP_MEMORY_SCOPE_AGENT); }
__device__ __forceinline__ unsigned xb_xcc_id() { return (unsigned)__builtin_amdgcn_s_getreg((3 << 11) | 20) & 0xFu; }
#define XB_SPIN(cond, bar) do { unsigned _sp = 0; while (cond) { __builtin_amdgcn_s_sleep(1); \
    if ((++_sp & 255u) == 0u) { if (xb_ld(&(bar)[XB_TMO])) break; if (_sp > XB_SPIN_CAP) { atomicAdd(&(bar)[XB_TMO], 1u); break; } } } } while (0)

struct XcdBarrier {
    unsigned* bar; unsigned x;
    volatile LAS unsigned* st;
};

__device__ __forceinline__ XcdBarrier xcd_barrier_post(unsigned* bar, volatile LAS unsigned* st, const bool t0) {
    XcdBarrier b; b.bar = bar; b.x = xb_xcc_id(); b.st = st;
    if (t0) (void)xb_add(&bar[XB_XCNT(b.x)], 1u);
    return b;
}
__device__ __forceinline__ void xcd_barrier_complete(unsigned* bar, unsigned x, unsigned& nloc, unsigned& nx) {
    const unsigned G = gridDim.x * gridDim.y * gridDim.z;
    unsigned sum, cnt, mine, sp = 0u;
    for (;;) {
        sum = 0u; cnt = 0u; mine = 0u;
#pragma unroll
        for (unsigned j = 0; j < 16; ++j) { const unsigned c = xb_ld(&bar[XB_XCNT(j)]); sum += c; cnt += (c > 0u) ? 1u : 0u; mine = (j == x) ? c : mine; }
        if (sum == G) break;
        __builtin_amdgcn_s_sleep(1);
        if ((++sp & 255u) == 0u) { if (xb_ld(&bar[XB_TMO])) break; if (sp > XB_SPIN_CAP) { atomicAdd(&bar[XB_TMO], 1u); break; } }
    }
    nloc = mine > 0u ? mine : 1u; nx = cnt > 0u ? cnt : 1u;
}

__device__ __forceinline__ void xcd_barrier(const XcdBarrier& b, const bool t0) {
    asm volatile("s_waitcnt vmcnt(0)" ::: "memory");
    __syncthreads();
    if (t0) {
        unsigned* bar = b.bar;
        __builtin_amdgcn_s_waitcnt(0);
        unsigned nloc = b.st[0], nx = b.st[1];
        if (nloc == 0u) { xcd_barrier_complete(bar, b.x, nloc, nx); b.st[0] = nloc; b.st[1] = nx; }
        const unsigned old = xb_add(&bar[XB_XSUB(b.x)], 1u);
        const unsigned gen = old / nloc;
        if (old + 1u == (gen + 1u) * nloc) {
            __builtin_amdgcn_fence(__ATOMIC_RELEASE, "agent");
            asm volatile("s_waitcnt vmcnt(0)" ::: "memory");
            const unsigned og = xb_add(&bar[XB_TOP], 1u);
            const unsigned tg = og / nx;
            if (og + 1u == (tg + 1u) * nx) xb_add(&bar[XB_TOPGEN], 1u);
            else XB_SPIN(xb_ld(&bar[XB_TOPGEN]) == tg, bar);
            __builtin_amdgcn_fence(__ATOMIC_ACQUIRE, "agent");
            xb_add(&bar[XB_XGEN(b.x)], 1u);
            asm volatile("s_waitcnt vmcnt(0)" ::: "memory");
        } else {
            XB_SPIN(xb_ld(&bar[XB_XGEN(b.x)]) == gen, bar);
            __builtin_amdgcn_fence(__ATOMIC_ACQUIRE, "agent");
            asm volatile("s_waitcnt vmcnt(0)" ::: "memory");
        }
    }
    __syncthreads();
}

__device__ __forceinline__ void xcd_barrier_fast(const XcdBarrier& b, const bool t0) {
    asm volatile("s_waitcnt vmcnt(0)" ::: "memory");
    __syncthreads();
    if (t0) {
        unsigned* bar = b.bar; asm volatile("" : "+s"(bar));
        __builtin_amdgcn_s_waitcnt(0);
        unsigned nloc = b.st[0], nx = b.st[1];
        unsigned bx_ = b.x; asm volatile("" : "+s"(bx_));
        const unsigned old = xb_add(&bar[XB_XSUB(bx_)], 1u);
        const unsigned gen = old / nloc;
        if (old + 1u == (gen + 1u) * nloc) {
            __builtin_amdgcn_fence(__ATOMIC_RELEASE, "agent");
            asm volatile("s_waitcnt vmcnt(0)" ::: "memory");
            const unsigned og = xb_add(&bar[XB_TOP], 1u);
            const unsigned tg = og / nx;
            if (og + 1u == (tg + 1u) * nx) xb_add(&bar[XB_TOPGEN], 1u);
            else XB_SPIN(xb_ld(&bar[XB_TOPGEN]) == tg, bar);
            __builtin_amdgcn_fence(__ATOMIC_ACQUIRE, "agent");
            xb_add(&bar[XB_XGEN(bx_)], 1u);
            asm volatile("s_waitcnt vmcnt(0)" ::: "memory");
        } else {
            XB_SPIN(xb_ld(&bar[XB_XGEN(bx_)]) == gen, bar);
            __builtin_amdgcn_fence(__ATOMIC_ACQUIRE, "agent");
            asm volatile("s_waitcnt vmcnt(0)" ::: "memory");
        }
    }
    __syncthreads();
}

constexpr int CW_BAR = 4096;
struct Args { const float* in[26]; float* out; unsigned char* ws; };
#ifndef REP_ATT
#define REP_ATT 1
#endif
#ifndef REP_GEMM
#define REP_GEMM 1
#endif
#ifndef REP_HY
#define REP_HY 1
#endif
#ifndef REP_FILT
#define REP_FILT 1
#endif
#ifndef REP_MISC
#define REP_MISC 1
#endif
#ifndef PROBE_MASK
#define PROBE_MASK 0
#endif
#define TIC() do { if (PROBE_MASK) pr_t0 = __builtin_amdgcn_s_memrealtime(); } while (0)
#define TOC(ph) do { if (PROBE_MASK & (1u << (ph))) pr_acc += __builtin_amdgcn_s_memrealtime() - pr_t0; } while (0)
#define REPEAT(n) _Pragma("unroll 1") for (int rep_ = 0; rep_ < (n); ++rep_)
#define REFRESH() do { const int t_ = tid_from_wave(F.wave0); F.tid = t_; F.lane = t_ & 63; F.wave = __builtin_amdgcn_readfirstlane(t_ >> 6); int v_ = F.vcu; asm volatile("" : "+s"(v_)); F.vcu = v_; } while (0)
#define BXQ() ({ int b_ = (int)blockIdx.x; asm volatile("" : "+s"(b_)); b_; })
#define GEMM_PHASE(EPI, g, S, E) REPEAT(REP_GEMM) pg8::gemm_phase<EPI, pg8::StaticOrder, true, true>(F.lds + RING_OFF, g, S, E, F.wave0)

__global__ void __launch_bounds__(NTHR, 2) hyena_mla_fwd(Args args) {
    extern __shared__ __attribute__((aligned(16))) unsigned char lds[];
    Frame F;
    F.lds = (LAS unsigned char*)lds;
    F.MISC = (volatile LAS unsigned*)(F.lds + MISC_OFF);
    F.tid = threadIdx.x; F.lane = F.tid & 63; F.wave = __builtin_amdgcn_readfirstlane(F.tid >> 6); F.wave0 = F.wave;
    F.G = gridDim.x; { const int bx = blockIdx.x; F.vcu = (F.G % 8 == 0) ? (bx % 8) * (F.G / 8) + bx / 8 : bx; }
    F.ws = args.ws; F.out = args.out; F.ctl = (gu32*)(args.ws + WS_CTL);
    if (F.tid == 0) {
#pragma unroll
        for (int i = 0; i < 26; ++i) *(LAS unsigned long long*)(F.lds + PTRTAB_OFF + 8 * i) = (unsigned long long)args.in[i];
    }
    for (int u = F.tid; u < 512 / 4; u += NTHR) ((LAS unsigned*)(F.lds + LDSCTL_OFF))[u] = 0u;
    __syncthreads();
    XcdBarrier bar = xcd_barrier_post((unsigned*)(F.ctl + CW_BAR), F.MISC + 8, F.tid == 0);
    xcd_barrier(bar, F.tid == 0);
    unsigned long long pr_t0 = 0, pr_acc = 0; (void)pr_t0;
#pragma unroll 1
    for (int l = 0; l < DEPTH; ++l) {
        TIC();
        REPEAT(REP_MISC) { REFRESH(); phase_weights(F, l); }
        __syncthreads();
        REFRESH(); phase_filter_mlp(F, l);
        if (l == 0) { REFRESH(); phase_rope_tab(F); REFRESH(); phase_norm_first(F, 0, inp(F, I_NMIXPRE)); }
        { REFRESH(); xcd_barrier_fast(bar, F.tid == 0); } TOC(0); TIC();
        { unsigned char* w = (unsigned char*)wsq(F); pg8::Gemm g{(bf16*)(w + WS_W3T), (bf16*)(w + WS_H2), 2048, L, 128}; pg8::StaticOrder S; S.init(2048, L, F.G, BXQ());
          pg8::EpiTaps E{(float*)(w + WS_KT), (const float*)inp(F, I_DECAY) + (size_t)l * 2048}; GEMM_PHASE(pg8::EpiTaps, g, S, E); }
        { REFRESH(); xcd_barrier_fast(bar, F.tid == 0); } TOC(1); TIC();
        REPEAT(REP_FILT) { REFRESH(); phase_filter_fft(F, l); }
        { REFRESH(); xcd_barrier_fast(bar, F.tid == 0); } TOC(2); TIC();
        { unsigned char* w = (unsigned char*)wsq(F); bf16* WinT = (bf16*)(w + WS_WIN); bf16* XN = (bf16*)(w + WS_XN); bf16* UT = (bf16*)(w + WS_UT); bf16* CQKV = (bf16*)(w + WS_CQKV);
          { pg8::Gemm g{WinT, XN, HYP, M, D}; pg8::StaticOrder S; S.init(HYP, M, F.G, BXQ());
          pg8::EpiBf16<0> E{UT, M, nullptr, 0, 0, 1.f}; GEMM_PHASE(pg8::EpiBf16<0>, g, S, E); }
        { pg8::Gemm g{XN, WinT + (size_t)HYP * D, M, 512, D}; pg8::StaticOrder S; S.init(M, 512, F.G, (BXQ() + 128) % F.G);
          pg8::EpiBf16<0> E{CQKV, 512, nullptr, 0, 0, 1.f}; GEMM_PHASE(pg8::EpiBf16<0>, g, S, E); } }
        { REFRESH(); xcd_barrier_fast(bar, F.tid == 0); } TOC(3); TIC();
        REPEAT(REP_MISC) { REFRESH(); phase_mla_prep(F, l); }
        REPEAT(REP_HY) { REFRESH(); phase_hyena(F, l); }
        { REFRESH(); xcd_barrier_fast(bar, F.tid == 0); } TOC(4); TIC();
        { unsigned char* w = (unsigned char*)wsq(F); bf16* CQN = (bf16*)(w + WS_CQN); bf16* CKVN = (bf16*)(w + WS_CKVN); bf16* WuqT = (bf16*)(w + WS_WUQ); bf16* WukvT = (bf16*)(w + WS_WUKV);
          bf16* Qb = (bf16*)(w + WS_Q); bf16* KV = (bf16*)(w + WS_KN);
          { pg8::Gemm g{CQN, WuqT, M, NQ, QR}; pg8::StaticOrder S; S.init(M, NQ, F.G, BXQ());
          pg8::EpiBf16<0> E{Qb, NQ, nullptr, 0, 0, 1.f}; GEMM_PHASE(pg8::EpiBf16<0>, g, S, E); }
        { pg8::Gemm g{CKVN, WukvT, M, NKV, KVR}; pg8::StaticOrder S; S.init(M, NKV, F.G, BXQ());
          pg8::EpiBf16<0> E{KV, NKV, nullptr, 0, 0, 1.f}; GEMM_PHASE(pg8::EpiBf16<0>, g, S, E); } }
        { REFRESH(); xcd_barrier_fast(bar, F.tid == 0); } TOC(5); TIC();
        REFRESH();
        { unsigned char* w = (unsigned char*)wsq(F); bf16* Qb = (bf16*)(w + WS_Q); bf16* KV = (bf16*)(w + WS_KN); bf16* KPE = (bf16*)(w + WS_KPE); bf16* MIX = (bf16*)(w + WS_MIX);
          const float* ct = (const float*)(w + WS_COS); const float* st = (const float*)(w + WS_SIN); const float* gat = (const float*)inp(F, I_GNAT) + l * 512;
        REPEAT(REP_ATT) for (int i = 0; i < (F.G == 256 ? 6 : (1536 - F.vcu + F.G - 1) / F.G); ++i) {
            const int u_ = F.vcu + i * F.G; const int bh = F.G == 256 ? 3 * (F.vcu >> 5) + (i >> 1) : u_ >> 6, qb = F.G == 256 ? (i & 1) * 32 + (F.vcu & 31) : u_ & 63; const int b = bh >> 3, h = bh & 7;
            const size_t row0 = (size_t)b * L + (size_t)qb * 256;
            att::attn_unit<0>(Qb + row0 * NQ + h * DQ, KV + (size_t)b * L * NKV + h * 128, KPE + (size_t)b * L * ROPE, KV + (size_t)b * L * NKV + h * 128 + 64,
                           MIX + row0 * D + 512 + h * 64, gat + h * 64, ct, st, qb * 256, (LAS char*)(F.lds + RING_OFF), F.wave0);
        } }
        REPEAT(REP_MISC) { REFRESH(); phase_hy_out(F, l); }
        { REFRESH(); xcd_barrier_fast(bar, F.tid == 0); } TOC(6); TIC();
        { unsigned char* w = (unsigned char*)wsq(F); bf16* MIX = (bf16*)(w + WS_MIX); bf16* WoutT = (bf16*)(w + WS_WOUT); bf16* T = (bf16*)(w + WS_T);
          pg8::Gemm g{MIX, WoutT, M, D, D}; pg8::StaticOrder S; S.init(M, D, F.G, BXQ());
          pg8::EpiBf16<0> E{T, D, nullptr, 0, 0, 1.f}; GEMM_PHASE(pg8::EpiBf16<0>, g, S, E); }
        { REFRESH(); xcd_barrier_fast(bar, F.tid == 0); } TOC(7); TIC();
        REFRESH(); phase_norm_res(F, l, (const GAS bf16*)(wsq(F) + WS_T), inp(F, I_NMIXPOST) + l * D, inp(F, I_NMLPPRE) + l * D);
        { REFRESH(); xcd_barrier_fast(bar, F.tid == 0); } TOC(8); TIC();
#pragma unroll 1
        for (int ch = 0; ch < N_MLP_CHUNKS; ++ch) {
            { unsigned char* w = (unsigned char*)wsq(F); bf16* XN = (bf16*)(w + WS_XN); bf16* WupT = (bf16*)(w + WS_WUP); bf16* Hb = (bf16*)(w + WS_H);
              pg8::Gemm g{XN + (size_t)ch * MLP_CHUNK * D, WupT, MLP_CHUNK, FF, D}; pg8::StaticOrder S; S.init(MLP_CHUNK, FF, F.G, BXQ());
              pg8::EpiRelu2 E{Hb, FF}; GEMM_PHASE(pg8::EpiRelu2, g, S, E); }
            { REFRESH(); xcd_barrier_fast(bar, F.tid == 0); } TOC(9); TIC();
            { unsigned char* w = (unsigned char*)wsq(F); bf16* Hb = (bf16*)(w + WS_H); bf16* WdownT = (bf16*)(w + WS_WDOWN); bf16* T = (bf16*)(w + WS_T);
              pg8::Gemm g{Hb, WdownT, MLP_CHUNK, D, FF}; pg8::StaticOrder S; S.init(MLP_CHUNK, D, F.G, BXQ());
              pg8::EpiBf16<0> E{T + (size_t)ch * MLP_CHUNK * D, D, nullptr, 0, 0, 1.f}; GEMM_PHASE(pg8::EpiBf16<0>, g, S, E); }
            { REFRESH(); xcd_barrier_fast(bar, F.tid == 0); } TOC(10); TIC();
        }
        REFRESH(); phase_norm_res(F, 1, (const GAS bf16*)(wsq(F) + WS_T), inp(F, I_NMLPPOST) + l * D, (l + 1 < DEPTH) ? inp(F, I_NMIXPRE) + (l + 1) * D : (const GAS float*)nullptr);
        { REFRESH(); xcd_barrier_fast(bar, F.tid == 0); } TOC(11); TIC();
    }
    if (PROBE_MASK) { const unsigned long long ts = __builtin_amdgcn_s_memrealtime(); while (__builtin_amdgcn_s_memrealtime() - ts < pr_acc) __builtin_amdgcn_s_sleep(8); }
}


#ifdef ATT_BENCH
__global__ void __launch_bounds__(NTHR, 2) attn_bench(Args args) {
    extern __shared__ __attribute__((aligned(16))) unsigned char lds[];
    unsigned char* w = args.ws; const int wave0 = __builtin_amdgcn_readfirstlane(threadIdx.x >> 6);
    const int G = gridDim.x, bxv = (int)blockIdx.x, vcu = (bxv % 8) * (G / 8) + bxv / 8;
    bf16* Qb = (bf16*)(w + WS_Q); bf16* KV = (bf16*)(w + WS_KN); bf16* KPE = (bf16*)(w + WS_KPE); bf16* OUT = (bf16*)(w + WS_H);
    const float* ct = (const float*)(w + WS_COS); const float* st = (const float*)(w + WS_SIN);
    for (int rep = 0; rep < ATT_BENCH_REPS; ++rep)
    for (int i = 0; i < 6; ++i) {
        const int bh = 3 * (vcu >> 5) + (i >> 1), qb = (i & 1) * 32 + (vcu & 31); const int b = bh >> 3, h = bh & 7;
        const size_t row0 = (size_t)b * L + (size_t)qb * 256;
        att::attn_unit<ATT_BENCH>(Qb + row0 * NQ + h * DQ, KV + (size_t)b * L * NKV + h * 128, KPE + (size_t)b * L * ROPE, KV + (size_t)b * L * NKV + h * 128 + 64,
                       OUT + row0 * D + 512 + h * 64, args.in[I_GNAT] + h * 64, ct, st, qb * 256, (LAS char*)lds, wave0);
    }
}
#endif
extern "C" void kernel_launch(void* const* d_in, const int* in_sizes, int n_in, void* d_out, int out_size, void* d_ws, size_t ws_size, hipStream_t stream) {
    static int grid = 0;
    if (grid == 0) {
        if (n_in != 26 || out_size != M * D || ws_size < WS_END) { fprintf(stderr, "kernel_launch: shape mismatch n_in %d out %d ws %zu (need %zu)\n", n_in, out_size, ws_size, (size_t)WS_END); grid = -1; return; }
        int dev = 0, cus = 0, per_cu = 0;
        if (hipGetDevice(&dev) != hipSuccess || hipDeviceGetAttribute(&cus, hipDeviceAttributeMultiprocessorCount, dev) != hipSuccess) { grid = -1; return; }
        if (hipFuncSetAttribute((const void*)hyena_mla_fwd, hipFuncAttributeMaxDynamicSharedMemorySize, LDS_BYTES) != hipSuccess) { fprintf(stderr, "kernel_launch: hipFuncSetAttribute failed\n"); grid = -1; return; }
        if (hipOccupancyMaxActiveBlocksPerMultiprocessor(&per_cu, (const void*)hyena_mla_fwd, NTHR, LDS_BYTES) != hipSuccess || per_cu < 1) fprintf(stderr, "kernel_launch: occupancy query says %d\n", per_cu);
        (void)hipGetLastError();
        grid = cus;
    }
    if (grid < 0) return;
    if (hipMemsetAsync((char*)d_ws + WS_CTL, 0, CTL_ZERO_BYTES, stream) != hipSuccess) { fprintf(stderr, "kernel_launch: memset failed\n"); return; }
    Args a{};
    for (int i = 0; i < 26; ++i) a.in[i] = (const float*)d_in[i];
    a.out = (float*)d_out; a.ws = (unsigned char*)d_ws;
    hipLaunchKernelGGL(hyena_mla_fwd, dim3(grid), dim3(NTHR), LDS_BYTES, stream, a);
#ifdef ATT_BENCH
    { static int once = 0; if (!once) { (void)hipFuncSetAttribute((const void*)attn_bench, hipFuncAttributeMaxDynamicSharedMemorySize, LDS_BYTES); once = 1; }
      hipLaunchKernelGGL(attn_bench, dim3(grid), dim3(NTHR), LDS_BYTES, stream, a); }
#endif
    const hipError_t le = hipPeekAtLastError();
    if (le != hipSuccess) fprintf(stderr, "kernel_launch: launch failed: %s\n", hipGetErrorName(le));
}
```

```cpp
#include <hip/hip_runtime.h>
#include <cstdio>
#include <cstdint>
__device__ __forceinline__ int hw_lane() { int l; asm volatile("v_mbcnt_lo_u32_b32 %0, -1, 0\n\tv_mbcnt_hi_u32_b32 %0, -1, %0" : "=v"(l)); return l; }
__device__ __forceinline__ int tid_from_wave(int wave0) { int w = wave0; asm volatile("" : "+s"(w)); int t = w * 64 + hw_lane(); asm volatile("" : "+v"(t)); return t; }
namespace pg8 {
#define PG8_LAS __attribute__((address_space(3)))
#define PG8_GAS __attribute__((address_space(1)))
typedef unsigned short bf16_t;
typedef short bf16x8 __attribute__((ext_vector_type(8)));
typedef float f32x4 __attribute__((ext_vector_type(4)));
typedef unsigned u32x4 __attribute__((ext_vector_type(4)));
constexpr int BM = 256, BK = 64, HALF = 128, HTB = HALF * BK * 2  , STAGE_BYTES = 8 * HTB, NXCD = 8, WGM = 8;

__host__ __device__ __forceinline__ int lds_byte(int r, int c) { const int st = (r >> 4) * 2 + (c >> 5), rr = r & 15, cc = c & 31, ob = rr * 64 + cc * 2; return st * 1024 + (ob ^ (((ob >> 9) & 1) << 5)); }
__host__ __device__ __forceinline__ void stage_rc(int b, int& R, int& C) { const int st = b / 1024, sb = b % 1024, swz = sb ^ (((sb >> 9) & 1) << 5); R = (st >> 1) * 16 + swz / 64; C = (st & 1) * 32 + (swz % 64) / 2; }
__host__ __device__ __forceinline__ int perm32(int rho) { const int n = rho >> 4, i = rho & 15; return 8 * (i >> 2) + 4 * n + (i & 3); }

struct Unit { int pm, pn; };
struct Gemm { const bf16_t* A; const bf16_t* Bt; int M, N, K; };

struct StaticOrder {
    int nM, nN, nwg, G, c;
    __host__ __device__ void init(int M, int N, int G_, int c_) { nM = M / BM; nN = N / BM; nwg = nM * nN; G = G_; c = c_; }
    __host__ __device__ bool next(int i, Unit& u) const {
        const long L = (long)i * G + c; if (L >= nwg) return false;
        int wgid = (int)L; { const int q = nwg / NXCD, r = nwg % NXCD, xcd = wgid % NXCD, off = wgid / NXCD; wgid = (xcd < r ? xcd * (q + 1) : r * (q + 1) + (xcd - r) * q) + off; }
        const int nig = WGM * nN, gid = wgid / nig, fm = gid * WGM, gsz = (nM - fm) < WGM ? (nM - fm) : WGM;
        u.pm = fm + ((wgid % nig) % gsz); u.pn = (wgid % nig) / gsz; return true;
    }
    __device__ __forceinline__ void a_ready(const Unit&) const {}
    __device__ __forceinline__ void done(const Unit&) const {}
};

__device__ __forceinline__ unsigned cvt_pk_bf16(float lo, float hi) { unsigned r; asm volatile("v_cvt_pk_bf16_f32 %0, %1, %2" : "=v"(r) : "v"(lo), "v"(hi)); return r; }
typedef float f32x2 __attribute__((ext_vector_type(2)));
__device__ __forceinline__ void relane(int& wr, int& wc, int& fr, int& fq) { int l = hw_lane(); asm volatile("" : "+v"(l)); fr = l & 15; fq = l >> 4; (void)wr; (void)wc; }
__device__ __forceinline__ f32x2 gelu_pk(f32x2 v) {
    const f32x2 av = __builtin_elementwise_abs(v), d = av * 0.2316418882f + 1.0f;
    f32x2 t; t.x = __builtin_amdgcn_rcpf(d.x); t.y = __builtin_amdgcn_rcpf(d.y);
    f32x2 q = t * 0.5307027145f + (-0.7265760135f); q = q * t + 0.7107068705f; q = q * t + (-0.142248368f); q = q * t + 0.127414796f; q = q * t;
    const f32x2 s = (v * v) * (-0.72134752044f);
    f32x2 e; e.x = __builtin_amdgcn_exp2f(s.x); e.y = __builtin_amdgcn_exp2f(s.y);
    const f32x2 m = v * (q * e), r = v - m;
    f32x2 o; o.x = v.x < 0.f ? m.x : r.x; o.y = v.y < 0.f ? m.y : r.y; return o;
}

template <int ACT  > struct EpiBf16 {
    static constexpr bool PERM = true, AFTER_DRAIN = false; static_assert(ACT == 0 || ACT == 1, "EpiBf16: ACT is 0 (none) or 1 (gelu_pk)");
    bf16_t* O; int ldc; const float* bias; int split_cols; size_t split_stride; float scale0;
    __device__ __forceinline__ void operator()(const f32x4 (&acc)[2][2][4][2], const Unit& u, int wr, int wc, int fr, int fq) const {
        relane(wr, wc, fr, fq);
        const int row0 = u.pm * BM + wr * 64 + fr; int colt = u.pn * BM; bf16_t* base = O;
        float sc = 1.f; if (split_cols) { const int t = colt / split_cols; base += (size_t)t * split_stride; colt -= t * split_cols; if (t == 0) sc = scale0; }
        const int col0 = colt + wc * 32 + 8 * fq, bcol0 = u.pn * BM + wc * 32 + 8 * fq;
        f32x4 bv[2][2];
#pragma unroll
        for (int bj = 0; bj < 2; ++bj)
#pragma unroll
            for (int n = 0; n < 2; ++n) bv[bj][n] = bias ? *(const PG8_GAS f32x4*)(bias + bcol0 + bj * HALF + 4 * n) : (f32x4){0.f, 0.f, 0.f, 0.f};
#pragma unroll
        for (int ai = 0; ai < 2; ++ai)
#pragma unroll
            for (int m = 0; m < 4; ++m) { bf16_t* rowp = base + (size_t)(row0 + ai * HALF + m * 16) * ldc + col0;
#pragma unroll
                for (int bj = 0; bj < 2; ++bj) { f32x4 v0 = acc[ai][bj][m][0] + bv[bj][0], v1 = acc[ai][bj][m][1] + bv[bj][1];
                    if (ACT == 1) { f32x2 a = gelu_pk((f32x2){v0[0], v0[1]}), b = gelu_pk((f32x2){v0[2], v0[3]}), c = gelu_pk((f32x2){v1[0], v1[1]}), d = gelu_pk((f32x2){v1[2], v1[3]});
                        v0 = (f32x4){a.x, a.y, b.x, b.y}; v1 = (f32x4){c.x, c.y, d.x, d.y}; }
                    v0 = v0 * sc; v1 = v1 * sc; u32x4 w; w.x = cvt_pk_bf16(v0[0], v0[1]); w.y = cvt_pk_bf16(v0[2], v0[3]); w.z = cvt_pk_bf16(v1[0], v1[1]); w.w = cvt_pk_bf16(v1[2], v1[3]);
                    *(PG8_GAS u32x4*)(rowp + bj * HALF) = w; } }
    }
};

struct PanelStats {
    unsigned* xbuf;
    unsigned* cnt;
    unsigned* tmo;
    int ntn; float eps;
    unsigned code;
    __device__ __forceinline__ bool run(const f32x4 (&v)[2][2][4][2], const Unit& u, int wr, int wc, int fr, int fq, PG8_LAS unsigned char* lds, int wid, int lane) const {
        typedef float f32x2v __attribute__((ext_vector_type(2)));
        PG8_LAS f32x2v* P = (PG8_LAS f32x2v*)lds;
        PG8_LAS f32x2v* S = (PG8_LAS f32x2v*)(lds + 8192);
        PG8_LAS unsigned* flag = (PG8_LAS unsigned*)(lds + 8192 + 2048);
#pragma unroll
        for (int ai = 0; ai < 2; ++ai)
#pragma unroll
            for (int m = 0; m < 4; ++m) {
                float s = 0.f;
#pragma unroll
                for (int bj = 0; bj < 2; ++bj)
#pragma unroll
                    for (int n = 0; n < 2; ++n) { const f32x4 x = v[ai][bj][m][n]; s += (x[0] + x[1]) + (x[2] + x[3]); }
                s += __shfl_xor(s, 16); s += __shfl_xor(s, 32);
                const float mw = s * (1.0f / 64.0f); float q = 0.f;
#pragma unroll
                for (int bj = 0; bj < 2; ++bj)
#pragma unroll
                    for (int n = 0; n < 2; ++n) { const f32x4 d = v[ai][bj][m][n] - mw; q += (d[0] * d[0] + d[1] * d[1]) + (d[2] * d[2] + d[3] * d[3]); }
                q += __shfl_xor(q, 16); q += __shfl_xor(q, 32);
                if (fq == 0) P[(ai * HALF + wr * 64 + m * 16 + fr) * 4 + wc] = (f32x2v){mw, q};
            }
        asm volatile("s_waitcnt lgkmcnt(0)" ::: "memory"); __builtin_amdgcn_s_barrier(); asm volatile("" ::: "memory");
#if defined(BROKEN_EXCHANGE_NO_WAIT)
#warning BROKEN CONTROL BUILD: the row-statistics exchange does not wait; results are wrong by design
        if (blockIdx.x >= 64) { const long long t0_ = clock64(); while (clock64() - t0_ < 60000) __builtin_amdgcn_s_sleep(8); }
#endif
        const int row = wid * 32 + (lane & 31);
        if (lane < 32) {
            const f32x2v a = P[row * 4 + 0], b = P[row * 4 + 1], c = P[row * 4 + 2], d = P[row * 4 + 3];
            const float mt = (a.x + b.x + c.x + d.x) * 0.25f;
            const float da = a.x - mt, db = b.x - mt, dc = c.x - mt, dd = d.x - mt;
            const float m2 = (a.y + b.y) + (c.y + d.y) + 64.0f * ((da * da + db * db) + (dc * dc + dd * dd));
            unsigned long long* slot = (unsigned long long*)xbuf + ((size_t)(u.pm * BM + row) * 4 + u.pn);
            __hip_atomic_store(slot, ((unsigned long long)__float_as_uint(m2) << 32) | __float_as_uint(mt), __ATOMIC_RELAXED, __HIP_MEMORY_SCOPE_AGENT);
        }
        asm volatile("s_waitcnt vmcnt(0)" ::: "memory");
        if (lane == 0) __hip_atomic_fetch_add(cnt + 64 * u.pm, 1u, __ATOMIC_RELAXED, __HIP_MEMORY_SCOPE_AGENT);
        if (wid == 0) {
            bool dead = false; const unsigned long long t0 = __builtin_amdgcn_s_memrealtime(); const unsigned want = 8u * (unsigned)ntn;
            for (;;) {
#if defined(BROKEN_EXCHANGE_NO_WAIT)
                break;
#endif
                if ((unsigned)__builtin_amdgcn_readfirstlane(__hip_atomic_load(cnt + 64 * u.pm, __ATOMIC_RELAXED, __HIP_MEMORY_SCOPE_AGENT)) >= want) break;
                if (__builtin_amdgcn_s_memrealtime() - t0 > 2000000ull) {
                    if (lane == 0) { unsigned expect = 0u; __hip_atomic_compare_exchange_strong(tmo + 1, &expect, code | (unsigned)(u.pm & 0xff), __ATOMIC_RELAXED, __ATOMIC_RELAXED, __HIP_MEMORY_SCOPE_AGENT);
                                     __hip_atomic_store(tmo, 1u, __ATOMIC_RELAXED, __HIP_MEMORY_SCOPE_AGENT); }
                    dead = true; break; }
                __builtin_amdgcn_s_sleep(2);
            }
            __builtin_amdgcn_fence(__ATOMIC_ACQUIRE, "agent");
            if (lane == 0) flag[0] = dead ? 1u : 0u;
        }
        asm volatile("s_waitcnt vmcnt(0) lgkmcnt(0)" ::: "memory"); __builtin_amdgcn_s_barrier(); asm volatile("" ::: "memory");
        const bool bad = flag[0] != 0u;
        if (lane < 32) {
            const unsigned long long* slot = (const unsigned long long*)xbuf + (size_t)(u.pm * BM + row) * 4; float mt[4], m2[4]; float ms = 0.f;
#pragma unroll
            for (int t = 0; t < 4; ++t) { if (t < ntn) { const unsigned long long w = __hip_atomic_load(slot + t, __ATOMIC_RELAXED, __HIP_MEMORY_SCOPE_AGENT); mt[t] = __uint_as_float((unsigned)w); m2[t] = __uint_as_float((unsigned)(w >> 32)); } else { mt[t] = 0.f; m2[t] = 0.f; } ms += mt[t]; }
            const float mean = ms / (float)ntn; float q = 0.f;
#pragma unroll
            for (int t = 0; t < 4; ++t) if (t < ntn) { const float dm = mt[t] - mean; q += m2[t] + 256.0f * dm * dm; }
            S[row] = (f32x2v){mean, 1.0f / sqrtf(q / (256.0f * (float)ntn) + eps)};
        }
        asm volatile("s_waitcnt lgkmcnt(0)" ::: "memory"); __builtin_amdgcn_s_barrier(); asm volatile("" ::: "memory");
        return bad;
    }
};
struct EpiLnRes {
    static constexpr bool PERM = false, AFTER_DRAIN = true;
    const float* base; float* out; int ldc; const float* bias; PanelStats st; unsigned poison;
    __device__ __forceinline__ void fused(f32x4 (&acc)[2][2][4][2], const Unit& u, int wr, int wc, int fr, int fq, PG8_LAS unsigned char* lds, int wid, int lane) const {
        typedef float f32x2v __attribute__((ext_vector_type(2)));
        const PG8_LAS f32x2v* S = (const PG8_LAS f32x2v*)(lds + 8192);
        const int col0 = u.pn * BM + wc * 32 + 4 * fq;
#pragma unroll
        for (int bj = 0; bj < 2; ++bj)
#pragma unroll
            for (int n = 0; n < 2; ++n) { const f32x4 bv = bias ? *(const f32x4*)(bias + col0 + bj * HALF + n * 16) : (f32x4){0.f, 0.f, 0.f, 0.f};
#pragma unroll
                for (int ai = 0; ai < 2; ++ai)
#pragma unroll
                    for (int m = 0; m < 4; ++m) acc[ai][bj][m][n] += bv; }
        f32x4 pre[4][2][2];
#pragma unroll
        for (int m = 0; m < 4; ++m) { const size_t off = (size_t)(u.pm * BM + wr * 64 + m * 16 + fr) * ldc + col0;
#pragma unroll
            for (int bj = 0; bj < 2; ++bj)
#pragma unroll
                for (int n = 0; n < 2; ++n) pre[m][bj][n] = *(const f32x4*)(base + off + bj * HALF + n * 16); }
        const bool bad = st.run(acc, u, wr, wc, fr, fq, lds, wid, lane) || poison != 0u;
        const float qnan = __builtin_nanf("");
#pragma unroll
        for (int ai = 0; ai < 2; ++ai)
#pragma unroll
            for (int m = 0; m < 4; ++m) { const int r = ai * HALF + wr * 64 + m * 16 + fr; const f32x2v sr = S[r]; const size_t off = (size_t)(u.pm * BM + r) * ldc + col0;
#pragma unroll
                for (int bj = 0; bj < 2; ++bj)
#pragma unroll
                    for (int n = 0; n < 2; ++n) { const f32x4 bs = ai == 0 ? pre[m][bj][n] : *(const f32x4*)(base + off + bj * HALF + n * 16); f32x4 o = bs + (acc[ai][bj][m][n] - sr.x) * sr.y;
                        if (bad) o = (f32x4){qnan, qnan, qnan, qnan}; *(f32x4*)(out + off + bj * HALF + n * 16) = o; }
                if (m & 1) asm volatile("" ::: "memory"); }
    }
};
struct EpiLnResLn {
    static constexpr bool PERM = false, AFTER_DRAIN = true;
    const float* base; float* out; bf16_t* xn; int ldc; const float* bias; PanelStats st1, st2; unsigned poison;
    __device__ __forceinline__ void fused(f32x4 (&acc)[2][2][4][2], const Unit& u, int wr, int wc, int fr, int fq, PG8_LAS unsigned char* lds, int wid, int lane) const {
        typedef float f32x2v __attribute__((ext_vector_type(2))); typedef unsigned u32x2v __attribute__((ext_vector_type(2)));
        const PG8_LAS f32x2v* S = (const PG8_LAS f32x2v*)(lds + 8192);
        const int col0 = u.pn * BM + wc * 32 + 4 * fq;
#pragma unroll
        for (int bj = 0; bj < 2; ++bj)
#pragma unroll
            for (int n = 0; n < 2; ++n) { const f32x4 bv = bias ? *(const f32x4*)(bias + col0 + bj * HALF + n * 16) : (f32x4){0.f, 0.f, 0.f, 0.f};
#pragma unroll
                for (int ai = 0; ai < 2; ++ai)
#pragma unroll
                    for (int m = 0; m < 4; ++m) acc[ai][bj][m][n] += bv; }
        bool bad = st1.run(acc, u, wr, wc, fr, fq, lds, wid, lane) || poison != 0u;
        const float qnan = __builtin_nanf("");
#pragma unroll
        for (int ai = 0; ai < 2; ++ai)
#pragma unroll
            for (int m = 0; m < 4; ++m) { const int r = ai * HALF + wr * 64 + m * 16 + fr; const f32x2v sr = S[r]; const size_t off = (size_t)(u.pm * BM + r) * ldc + col0;
#pragma unroll
                for (int bj = 0; bj < 2; ++bj)
#pragma unroll
                    for (int n = 0; n < 2; ++n) { const f32x4 bs = *(const f32x4*)(base + off + bj * HALF + n * 16); acc[ai][bj][m][n] = bs + (acc[ai][bj][m][n] - sr.x) * sr.y; }
                asm volatile("" : "+v"(acc[ai][0][m][0]), "+v"(acc[ai][0][m][1]), "+v"(acc[ai][1][m][0]), "+v"(acc[ai][1][m][1]));
                if (m & 1) asm volatile("" ::: "memory"); }
        const bool bad1 = bad;
        bad = st2.run(acc, u, wr, wc, fr, fq, lds, wid, lane) || bad;
#pragma unroll
        for (int ai = 0; ai < 2; ++ai)
#pragma unroll
            for (int m = 0; m < 4; ++m) { const int r = ai * HALF + wr * 64 + m * 16 + fr; const f32x2v sr = S[r]; const size_t off = (size_t)(u.pm * BM + r) * ldc + col0;
#pragma unroll
                for (int bj = 0; bj < 2; ++bj)
#pragma unroll
                    for (int n = 0; n < 2; ++n) { const f32x4 x1 = acc[ai][bj][m][n]; *(f32x4*)(out + off + bj * HALF + n * 16) = bad1 ? (f32x4){qnan, qnan, qnan, qnan} : x1;
                        const f32x4 o = (x1 - sr.x) * sr.y; u32x2v w; w.x = cvt_pk_bf16(o[0], o[1]); w.y = cvt_pk_bf16(o[2], o[3]);
                        if (bad) { w.x = 0x7fc07fc0u; w.y = 0x7fc07fc0u; } *(u32x2v*)(xn + off + bj * HALF + n * 16) = w; }
                asm volatile("" ::: "memory"); }
    }
};

template <class Epi, class Sched, bool ALIGN_EPI = false, bool SP2 = false>
__device__ __forceinline__ void gemm_phase(PG8_LAS unsigned char* lds, const Gemm g, const Sched& S, const Epi& E, const int wave0) {
    int tid_ = tid_from_wave(wave0);
    const int tid = tid_, wid = __builtin_amdgcn_readfirstlane(tid >> 6), lane = tid & 63, wr = wid >> 2, wc = wid & 3, fr = lane & 15, fq = lane >> 4;
    const int K = g.K, nt = K / BK;
    unsigned voffA[2], voffB[2];
#pragma unroll
    for (int i = 0; i < 2; ++i) { int R, C; stage_rc(tid * 16 + i * 8192, R, C); const int Rb = Epi::PERM ? ((R & ~31) + perm32(R & 31)) : R;
        voffA[i] = (unsigned)(R * K + C) * 2u; voffB[i] = (unsigned)(Rb * K + C) * 2u; }
    const size_t kstep = (size_t)(BK * 2);
    const size_t hstep = (size_t)HALF * K * 2;
    const size_t tstep = 2 * hstep;
    const unsigned ldsw = (unsigned)wid * 1024u;
    const int aoff = lds_byte(wr * 64 + fr, fq * 8), boff = lds_byte(wc * 32 + fr, fq * 8);
#define PG8_SA(b, h) (((b) * 2 + (h)) * HTB)
#define PG8_SB(b, h) ((4 + (b) * 2 + (h)) * HTB)
#define PG8_STAGE(bufoff, gbase, voff) do { _Pragma("unroll") for (int _i = 0; _i < 2; ++_i) \
        __builtin_amdgcn_global_load_lds((const unsigned*)((const char*)(gbase) + (voff)[_i]), (PG8_LAS unsigned*)(lds + (bufoff) + ldsw + _i * 8192), 16, 0, 0); } while (0)
#define PG8_LDA(dst, b, h) do { _Pragma("unroll") for (int m = 0; m < 4; ++m) _Pragma("unroll") for (int k = 0; k < 2; ++k) dst[m][k] = *(const PG8_LAS bf16x8*)(lds + PG8_SA(b, h) + aoff + m * 2048 + k * 1024); } while (0)
#define PG8_LDB(dst, b, h) do { _Pragma("unroll") for (int n = 0; n < 2; ++n) _Pragma("unroll") for (int k = 0; k < 2; ++k) dst[n][k] = *(const PG8_LAS bf16x8*)(lds + PG8_SB(b, h) + boff + n * 2048 + k * 1024); } while (0)
#define PG8_MMA(ai, bj, At, Bt) do { __builtin_amdgcn_s_setprio(1); _Pragma("unroll") for (int m = 0; m < 4; ++m) _Pragma("unroll") for (int n = 0; n < 2; ++n) _Pragma("unroll") for (int k = 0; k < 2; ++k) \
        acc[ai][bj][m][n] = __builtin_amdgcn_mfma_f32_16x16x32_bf16(Bt[n][k], At[m][k], acc[ai][bj][m][n], 0, 0, 0); __builtin_amdgcn_s_setprio(0); } while (0)
#define PG8_WAIT_V(n) asm volatile("s_waitcnt vmcnt(" #n ")" ::: "memory")
#define PG8_WAIT_L(n) asm volatile("s_waitcnt lgkmcnt(" #n ")" ::: "memory")
#define PG8_BAR __builtin_amdgcn_s_barrier()
#define PG8_SCHED __builtin_amdgcn_sched_barrier(0)
    Unit cur, nxt; int ui = 0;
    if (!S.next(0, cur)) return;
    f32x4 acc[2][2][4][2];
#pragma unroll
    for (int a = 0; a < 2; ++a)
#pragma unroll
        for (int b = 0; b < 2; ++b)
#pragma unroll
            for (int m = 0; m < 4; ++m)
#pragma unroll
                for (int n = 0; n < 2; ++n) acc[a][b][m][n] = (f32x4){0.f, 0.f, 0.f, 0.f};
    bf16x8 At[4][2], B0[2][2], B1[2][2];
    const char* cA = (const char*)g.A + (size_t)cur.pm * tstep; const char* cB = (const char*)g.Bt + (size_t)cur.pn * tstep;
    S.a_ready(cur);
    if constexpr (SP2) {
        PG8_STAGE(PG8_SB(0, 0), cB, voffB); PG8_STAGE(PG8_SB(0, 1), cB + hstep, voffB); PG8_STAGE(PG8_SA(0, 0), cA, voffA); PG8_STAGE(PG8_SA(0, 1), cA + hstep, voffA);
        if (wr == 1) PG8_BAR;
        PG8_WAIT_V(2); PG8_BAR;
        PG8_STAGE(PG8_SB(1, 0), cB + kstep, voffB); PG8_STAGE(PG8_SA(1, 0), cA + kstep, voffA); PG8_STAGE(PG8_SB(1, 1), cB + hstep + kstep, voffB);
        PG8_WAIT_V(6); PG8_BAR;
    } else {
        PG8_STAGE(PG8_SB(0, 0), cB, voffB); PG8_STAGE(PG8_SA(0, 0), cA, voffA); PG8_STAGE(PG8_SB(0, 1), cB + hstep, voffB); PG8_STAGE(PG8_SA(0, 1), cA + hstep, voffA);
        if (wr == 1) PG8_BAR;
        PG8_WAIT_V(4); PG8_BAR;
        PG8_STAGE(PG8_SB(1, 0), cB + kstep, voffB); PG8_STAGE(PG8_SA(1, 0), cA + kstep, voffA); PG8_STAGE(PG8_SB(1, 1), cB + hstep + kstep, voffB);
        PG8_WAIT_V(6); PG8_BAR;
    }
    for (;;) {
        const bool has_next = S.next(ui + 1, nxt);
        const char* nA = has_next ? (const char*)g.A + (size_t)nxt.pm * tstep : cA; const char* nB = has_next ? (const char*)g.Bt + (size_t)nxt.pn * tstep : cB;
        for (int t = 0; t < nt; t += 2) {
            const bool last = (t == nt - 2);
            const char* a1 = cA + (size_t)(t + 1) * kstep;
            const char* a2 = last ? nA : cA + (size_t)(t + 2) * kstep; const char* b2 = last ? nB : cB + (size_t)(t + 2) * kstep;
            const char* a3 = a2 + kstep; const char* b3 = b2 + kstep;
            if (last && has_next) S.a_ready(nxt);
            if constexpr (SP2) {
            PG8_LDB(B0, 0, 0); PG8_LDB(B1, 0, 1); PG8_SCHED; PG8_LDA(At, 0, 0); PG8_STAGE(PG8_SA(1, 1), a1 + hstep, voffA);
            PG8_WAIT_V(8); PG8_WAIT_L(0); PG8_BAR; PG8_MMA(0, 0, At, B0); PG8_MMA(0, 1, At, B1); PG8_BAR; PG8_SCHED;
            PG8_LDA(At, 0, 1); PG8_STAGE(PG8_SB(0, 0), b2, voffB); PG8_STAGE(PG8_SB(0, 1), b2 + hstep, voffB); PG8_STAGE(PG8_SA(0, 0), a2, voffA);
            PG8_WAIT_V(8); PG8_WAIT_L(0); PG8_BAR; PG8_MMA(1, 0, At, B0); PG8_MMA(1, 1, At, B1); PG8_BAR; PG8_SCHED;
            PG8_LDB(B0, 1, 0); PG8_LDB(B1, 1, 1); PG8_SCHED; PG8_LDA(At, 1, 0); PG8_STAGE(PG8_SA(0, 1), a2 + hstep, voffA);
            PG8_WAIT_V(8); PG8_WAIT_L(0); PG8_BAR; PG8_MMA(0, 0, At, B0); PG8_MMA(0, 1, At, B1); PG8_BAR; PG8_SCHED;
            PG8_LDA(At, 1, 1); PG8_STAGE(PG8_SB(1, 0), b3, voffB); PG8_STAGE(PG8_SB(1, 1), b3 + hstep, voffB); PG8_STAGE(PG8_SA(1, 0), a3, voffA);
            PG8_WAIT_V(8); PG8_WAIT_L(0); PG8_BAR; PG8_MMA(1, 0, At, B0); PG8_MMA(1, 1, At, B1); PG8_BAR; PG8_SCHED;
            } else {
            PG8_LDB(B0, 0, 0); PG8_SCHED; PG8_LDA(At, 0, 0); PG8_STAGE(PG8_SA(1, 1), a1 + hstep, voffA);
            PG8_WAIT_L(8); PG8_BAR; PG8_WAIT_L(0); PG8_MMA(0, 0, At, B0); PG8_BAR; PG8_SCHED;
            PG8_LDB(B1, 0, 1); PG8_STAGE(PG8_SB(0, 0), b2, voffB);
            PG8_BAR; PG8_WAIT_L(0); PG8_MMA(0, 1, At, B1); PG8_BAR;
            PG8_LDA(At, 0, 1); PG8_STAGE(PG8_SA(0, 0), a2, voffA);
            PG8_BAR; PG8_WAIT_L(0); PG8_MMA(1, 0, At, B0); PG8_BAR; PG8_SCHED;
            PG8_STAGE(PG8_SB(0, 1), b2 + hstep, voffB);
            PG8_WAIT_V(6); PG8_BAR; PG8_MMA(1, 1, At, B1); PG8_BAR;
            PG8_LDB(B0, 1, 0); PG8_SCHED; PG8_LDA(At, 1, 0); PG8_STAGE(PG8_SA(0, 1), a2 + hstep, voffA);
            PG8_WAIT_L(8); PG8_BAR; PG8_WAIT_L(0); PG8_MMA(0, 0, At, B0); PG8_BAR; PG8_SCHED;
            PG8_LDB(B1, 1, 1); PG8_STAGE(PG8_SB(1, 0), b3, voffB);
            PG8_BAR; PG8_WAIT_L(0); PG8_MMA(0, 1, At, B1); PG8_BAR;
            PG8_LDA(At, 1, 1); PG8_STAGE(PG8_SA(1, 0), a3, voffA);
            PG8_BAR; PG8_WAIT_L(0); PG8_MMA(1, 0, At, B0); PG8_BAR; PG8_SCHED;
            PG8_STAGE(PG8_SB(1, 1), b3 + hstep, voffB);
            PG8_WAIT_V(6); PG8_BAR; PG8_MMA(1, 1, At, B1); PG8_BAR;
            }
        }
        if constexpr (ALIGN_EPI) { if (wr == 0) PG8_BAR; }
        if constexpr (!Epi::AFTER_DRAIN) { E(acc, cur, wr, wc, fr, fq); S.done(cur); }
        if (!has_next) break;
#pragma unroll
        for (int a = 0; a < 2; ++a)
#pragma unroll
            for (int b = 0; b < 2; ++b)
#pragma unroll
                for (int m = 0; m < 4; ++m)
#pragma unroll
                    for (int n = 0; n < 2; ++n) acc[a][b][m][n] = (f32x4){0.f, 0.f, 0.f, 0.f};
        cur = nxt; cA = nA; cB = nB; ++ui;
        if constexpr (ALIGN_EPI) { if (wr == 1) PG8_BAR; }
    }
    PG8_WAIT_V(0);
    if constexpr (!ALIGN_EPI) { if (wr == 0) PG8_BAR; }
    PG8_BAR;
    if constexpr (Epi::AFTER_DRAIN) { E.fused(acc, cur, wr, wc, fr, fq, lds, wid, lane); S.done(cur); }
#undef PG8_SA
#undef PG8_SB
#undef PG8_STAGE
#undef PG8_LDA
#undef PG8_LDB
#undef PG8_MMA
#undef PG8_WAIT_V
#undef PG8_WAIT_L
#undef PG8_BAR
#undef PG8_SCHED
}
}

namespace pg8 {
struct EpiRelu2 {
    static constexpr bool PERM = true, AFTER_DRAIN = false;
    bf16_t* O; int ldc;
    __device__ __forceinline__ void operator()(const f32x4 (&acc)[2][2][4][2], const Unit& u, int wr, int wc, int fr, int fq) const {
        relane(wr, wc, fr, fq);
        const int row0 = u.pm * BM + wr * 64 + fr, col0 = u.pn * BM + wc * 32 + 8 * fq;
#pragma unroll
        for (int ai = 0; ai < 2; ++ai)
#pragma unroll
            for (int m = 0; m < 4; ++m) { bf16_t* rowp = O + (size_t)(row0 + ai * HALF + m * 16) * ldc + col0;
#pragma unroll
                for (int bj = 0; bj < 2; ++bj) { f32x4 v0 = acc[ai][bj][m][0], v1 = acc[ai][bj][m][1];
                    v0 = __builtin_elementwise_max(v0, (f32x4){0.f, 0.f, 0.f, 0.f}); v1 = __builtin_elementwise_max(v1, (f32x4){0.f, 0.f, 0.f, 0.f}); v0 = v0 * v0; v1 = v1 * v1;
                    u32x4 w; w.x = cvt_pk_bf16(v0[0], v0[1]); w.y = cvt_pk_bf16(v0[2], v0[3]); w.z = cvt_pk_bf16(v1[0], v1[1]); w.w = cvt_pk_bf16(v1[2], v1[3]);
                    *(PG8_GAS u32x4*)(rowp + bj * HALF) = w; } }
    }
};
struct EpiF32 {
    static constexpr bool PERM = false, AFTER_DRAIN = false;
    float* O; int ldc;
    __device__ __forceinline__ void operator()(const f32x4 (&acc)[2][2][4][2], const Unit& u, int wr, int wc, int fr, int fq) const {
        relane(wr, wc, fr, fq);
        const int row0 = u.pm * BM + wr * 64 + fr, col0 = u.pn * BM + wc * 32 + 4 * fq;
#pragma unroll
        for (int ai = 0; ai < 2; ++ai)
#pragma unroll
            for (int m = 0; m < 4; ++m) { float* rowp = O + (size_t)(row0 + ai * HALF + m * 16) * ldc + col0;
#pragma unroll
                for (int bj = 0; bj < 2; ++bj)
#pragma unroll
                    for (int n = 0; n < 2; ++n) *(PG8_GAS f32x4*)(rowp + bj * HALF + n * 16) = acc[ai][bj][m][n]; }
    }
};
struct EpiTaps {
    static constexpr bool PERM = false, AFTER_DRAIN = false;
    float* O; const float* decay;
    __device__ __forceinline__ void operator()(const f32x4 (&acc)[2][2][4][2], const Unit& u, int wr, int wc, int fr, int fq) const {
        relane(wr, wc, fr, fq);
        const int row0 = u.pm * BM + wr * 64 + fr, col0 = u.pn * BM + wc * 32 + 4 * fq;
#pragma unroll
        for (int ai = 0; ai < 2; ++ai)
#pragma unroll
            for (int m = 0; m < 4; ++m) { const int row = row0 + ai * HALF + m * 16; float* rowp = O + (size_t)row * 16384 + col0; const float nd = -fabsf(((const PG8_GAS float*)decay)[row]) * (1.0f / 16383.0f) * 1.4426950408889634f;
#pragma unroll
                for (int bj = 0; bj < 2; ++bj)
#pragma unroll
                    for (int n = 0; n < 2; ++n) { const int c = col0 + bj * HALF + n * 16; const f32x4 a = acc[ai][bj][m][n]; f32x4 o;
                        o[0] = a[0] * __builtin_amdgcn_exp2f(nd * (float)(c + 0)); o[1] = a[1] * __builtin_amdgcn_exp2f(nd * (float)(c + 1));
                        o[2] = a[2] * __builtin_amdgcn_exp2f(nd * (float)(c + 2)); o[3] = a[3] * __builtin_amdgcn_exp2f(nd * (float)(c + 3));
                        *(PG8_GAS f32x4*)(rowp + bj * HALF + n * 16) = o; } }
    }
};
}

constexpr int L = 16384, NSEQ = 3, M = NSEQ * L, D = 1024, DEPTH = 4;
constexpr int HYW = 512, HYP = 1536, QR = 256, KVR = 128, ROPE = 32, INW = 1952;
constexpr int NH = 8, DQ = 96, DV = 64, NQ = NH * DQ, NKV = NH * 128;
constexpr int FF = 4096;
constexpr float EPS = 1e-6f;
constexpr int NWAVES = 8, NTHR = 512;
constexpr int MLP_CHUNK = 16384, N_MLP_CHUNKS = M / MLP_CHUNK;

constexpr size_t MiB = 1u << 20;
constexpr size_t WS_CTL = 0, CTL_ZERO_BYTES = 65536;
constexpr size_t WS_COS = 1 * MiB, WS_SIN = 2 * MiB;
constexpr size_t WS_H2 = 4 * MiB;
constexpr size_t WS_W3T = 8 * MiB;
constexpr size_t WS_WIN = 12 * MiB, WS_WOUT = 16 * MiB, WS_WUP = 18 * MiB, WS_WDOWN = 26 * MiB, WS_WUQ = 34 * MiB, WS_WUKV = 34 * MiB + 512 * 1024;
constexpr size_t WS_XN = 36 * MiB;
constexpr size_t WS_CQN = 36 * MiB, WS_CKVN = 60 * MiB, WS_KPE = 72 * MiB;
constexpr size_t WS_KEO = 132 * MiB;
constexpr size_t WS_KT = 261 * MiB;
constexpr size_t WS_UT = 261 * MiB;
constexpr size_t WS_CQKV = 405 * MiB;
constexpr size_t WS_YT = 453 * MiB;
constexpr size_t WS_Q = 132 * MiB, WS_KN = 204 * MiB;
constexpr size_t WS_MIX = 324 * MiB;
constexpr size_t WS_T = 132 * MiB;
constexpr size_t WS_H = 324 * MiB;
constexpr size_t WS_G0 = 75 * MiB, WS_G1A = 107 * MiB, WS_G1B = 501 * MiB;
constexpr size_t WS_END = 508 * MiB;
constexpr int KEO_BLK = 16512, KEO_KO = 8256;
static_assert(WS_KEO + (size_t)1024 * KEO_BLK * 8 <= WS_KT, "KEO fits");
static_assert(WS_UT + (size_t)HYP * M * 2 <= WS_CQKV && WS_CQKV + (size_t)M * 512 * 2 <= WS_YT && WS_YT + (size_t)HYW * M * 2 <= WS_END, "map");
static_assert(WS_KN + (size_t)M * NKV * 2 <= WS_MIX && WS_T + (size_t)M * D * 4 <= WS_MIX && WS_H + (size_t)MLP_CHUNK * FF * 2 <= WS_END, "map2");

constexpr int RING_OFF = 0, RING_BYTES = 139264;
constexpr int LDSCTL_OFF = RING_BYTES, MISC_OFF = LDSCTL_OFF + 320;
constexpr int LDS_BYTES = 147456;
static_assert(MISC_OFF + 128 <= LDS_BYTES, "LDS map");

#define GAS __attribute__((address_space(1)))
#define LAS __attribute__((address_space(3)))
typedef unsigned short bf16;
typedef unsigned v4u __attribute__((ext_vector_type(4)));
typedef unsigned v2u __attribute__((ext_vector_type(2)));
typedef float f32x4 __attribute__((ext_vector_type(4)));
typedef float f32x2 __attribute__((ext_vector_type(2)));
typedef short bf16x8 __attribute__((ext_vector_type(8)));
typedef GAS unsigned gu32;
#define RLX_AGENT __ATOMIC_RELAXED, __HIP_MEMORY_SCOPE_AGENT
#define LDS_WAIT() asm volatile("s_waitcnt lgkmcnt(0)" ::: "memory")
#define VM_WAIT() asm volatile("s_waitcnt vmcnt(0)" ::: "memory")
typedef __bf16 bf16x2_t __attribute__((ext_vector_type(2)));
__device__ __forceinline__ unsigned pk2(float lo, float hi) { f32x2 v = {lo, hi}; bf16x2_t b = __builtin_convertvector(v, bf16x2_t); return __builtin_bit_cast(unsigned, b); }
__device__ __forceinline__ bf16 f2bf(float f) { return (bf16)(pk2(f, 0.f) & 0xffffu); }
__device__ __forceinline__ float bf2f(unsigned h) { return __uint_as_float(h << 16); }
__device__ __forceinline__ float shx(float v, int lane, int o) { return __uint_as_float((unsigned)__builtin_amdgcn_ds_bpermute((lane ^ o) << 2, (int)__float_as_uint(v))); }
__device__ __forceinline__ float wave_sum(float v) {
    const int ln_ = hw_lane();
#pragma unroll
    for (int o = 1; o < 64; o <<= 1) v += shx(v, ln_, o);
    return v;
}

namespace hfft {
constexpr float w32c(int i) { constexpr float t[16] = {1.000000000e+00f, 9.807852507e-01f, 9.238795042e-01f, 8.314695954e-01f, 7.071067691e-01f, 5.555702448e-01f, 3.826834261e-01f, 1.950903237e-01f, 0.f, -1.950903237e-01f, -3.826834261e-01f, -5.555702448e-01f, -7.071067691e-01f, -8.314695954e-01f, -9.238795042e-01f, -9.807852507e-01f}; return t[i]; }
constexpr float w32s(int i) { constexpr float t[16] = {0.000000000e+00f, 1.950903237e-01f, 3.826834261e-01f, 5.555702448e-01f, 7.071067691e-01f, 8.314695954e-01f, 9.238795042e-01f, 9.807852507e-01f, 1.000000000e+00f, 9.807852507e-01f, 9.238795042e-01f, 8.314695954e-01f, 7.071067691e-01f, 5.555702448e-01f, 3.826834261e-01f, 1.950903237e-01f}; return t[i]; }
constexpr int brev(int x, int bits) { int r = 0; for (int i = 0; i < bits; ++i) r |= ((x >> i) & 1) << (bits - 1 - i); return r; }
constexpr int ilog2(int x) { int r = 0; while ((1 << r) < x) ++r; return r; }
__device__ __forceinline__ int pad(int i) { return i + (i >> 5); }

__device__ __forceinline__ void bfly(float ar, float ai, float br, float bi, float& ur, float& ui, float& dr, float& di) {
    asm("v_add_f32_e32 %0, %4, %6\n\tv_add_f32_e32 %1, %5, %7\n\tv_sub_f32_e32 %2, %4, %6\n\tv_sub_f32_e32 %3, %5, %7"
        : "=&v"(ur), "=&v"(ui), "=&v"(dr), "=&v"(di) : "v"(ar), "v"(ai), "v"(br), "v"(bi));
}
template <bool INV> __device__ __forceinline__ void bfly_rot(float ar, float ai, float br, float bi, float& ur, float& ui, float& dr, float& di) {
    if (!INV) asm("v_add_f32_e32 %0, %4, %6\n\tv_add_f32_e32 %1, %5, %7\n\tv_sub_f32_e32 %2, %5, %7\n\tv_sub_f32_e32 %3, %6, %4" : "=&v"(ur), "=&v"(ui), "=&v"(dr), "=&v"(di) : "v"(ar), "v"(ai), "v"(br), "v"(bi));
    else      asm("v_add_f32_e32 %0, %4, %6\n\tv_add_f32_e32 %1, %5, %7\n\tv_sub_f32_e32 %2, %7, %5\n\tv_sub_f32_e32 %3, %4, %6" : "=&v"(ur), "=&v"(ui), "=&v"(dr), "=&v"(di) : "v"(ar), "v"(ai), "v"(br), "v"(bi));
}
__device__ __forceinline__ void bfly_tw(float ar, float ai, float br, float bi, float c, float s, float& ur, float& ui, float& dr, float& di) {
    float tr, ti;
    asm("v_sub_f32_e32 %4, %6, %8\n\tv_sub_f32_e32 %5, %7, %9\n\tv_add_f32_e32 %0, %6, %8\n\tv_add_f32_e32 %1, %7, %9\n\t"
        "v_mul_f32_e32 %2, %10, %4\n\tv_mul_f32_e32 %3, %11, %4\n\tv_fma_f32 %2, -%11, %5, %2\n\tv_fma_f32 %3, %10, %5, %3"
        : "=&v"(ur), "=&v"(ui), "=&v"(dr), "=&v"(di), "=&v"(tr), "=&v"(ti) : "v"(ar), "v"(ai), "v"(br), "v"(bi), "s"(c), "s"(s));
}
__device__ __forceinline__ void cmul_chain(float& xr, float& xi, float& wc, float& ws, float c1, float s1) {
    float a, b, nc, ns;
    asm("v_mul_f32_e32 %0, %4, %6\n\tv_mul_f32_e32 %1, %4, %7\n\tv_fma_f32 %0, -%5, %7, %0\n\tv_fma_f32 %1, %5, %6, %1\n\t"
        "v_mul_f32_e32 %2, %6, %8\n\tv_mul_f32_e32 %3, %6, %9\n\tv_fma_f32 %2, -%7, %9, %2\n\tv_fma_f32 %3, %7, %8, %3"
        : "=&v"(a), "=&v"(b), "=&v"(nc), "=&v"(ns) : "v"(xr), "v"(xi), "v"(wc), "v"(ws), "v"(c1), "v"(s1));
    xr = a; xi = b; wc = nc; ws = ns;
}
template <int R, bool INV> __device__ __forceinline__ void fft_r2(float (&re)[R], float (&im)[R], const unsigned z0) {
    constexpr int LG = ilog2(R);
#pragma unroll
    for (int st = 0; st < LG; ++st) {
        const int s = (R / 2) >> st;
#pragma unroll
        for (int blk = 0; blk < R; blk += 2 * s) {
#pragma unroll
            for (int a = 0; a < s; ++a) {
                const int i0 = blk + a, i1 = i0 + s;
                const int w = a * (16 / s);
                float ur, ui, dr, di;
                if (w == 0) { bfly(re[i0], im[i0], re[i1], im[i1], ur, ui, dr, di); re[i1] = dr; im[i1] = di; }
                else if (w == 8) { bfly_rot<INV>(re[i0], im[i0], re[i1], im[i1], ur, ui, dr, di); re[i1] = dr; im[i1] = di; }
                else { const float c = __uint_as_float(__float_as_uint(w32c(w)) | z0), sn = __uint_as_float(__float_as_uint(INV ? w32s(w) : -w32s(w)) | z0);
                    bfly_tw(re[i0], im[i0], re[i1], im[i1], c, sn, ur, ui, dr, di); re[i1] = dr; im[i1] = di; }
                re[i0] = ur; im[i0] = ui;
            }
        }
    }
}

__device__ __forceinline__ int opaque(int x) { asm volatile("" : "+v"(x)); return x; }
template <bool INV> __device__ __forceinline__ void fft16k(float (&re)[32], float (&im)[32], LAS f32x2* buf, const int t_in) {
    asm volatile("" ::: "memory"); __builtin_amdgcn_sched_barrier(0);
    int t = opaque(t_in);
    unsigned z0 = 0u; asm volatile("" : "+s"(z0));
    fft_r2<32, INV>(re, im, z0);
    __syncthreads();
#pragma unroll
    for (int r = 0; r < 32; ++r) buf[33 * t + r] = (f32x2){re[brev(r, 5)], im[brev(r, 5)]};
    __syncthreads();
    t = opaque(t);
    { const int b2 = t + (t >> 5);
#pragma unroll
    for (int r = 0; r < 32; ++r) { const f32x2 v = buf[b2 + 528 * r]; re[r] = v.x; im[r] = v.y; } }
    {
        const float f1 = (float)(t & 31) * (1.0f / 1024.0f);
        const float c1 = __builtin_amdgcn_cosf(f1), s1 = INV ? __builtin_amdgcn_sinf(f1) : -__builtin_amdgcn_sinf(f1);
        float wc = c1, ws = s1;
#pragma unroll
        for (int r = 1; r < 32; ++r) {
            cmul_chain(re[r], im[r], wc, ws, c1, s1);
        }
    }
    fft_r2<32, INV>(re, im, z0);
    __syncthreads();
    {
        t = opaque(t);
        const int ob = (t >> 5) * 1056 + (t & 31);
#pragma unroll
        for (int r = 0; r < 32; ++r) buf[ob + 33 * r] = (f32x2){re[brev(r, 5)], im[brev(r, 5)]};
    }
    __syncthreads();
#pragma unroll
    for (int h = 0; h < 2; ++h) {
        t = opaque(t);
        float ar[16], ai[16]; const int j = t + 512 * h; const int b3 = t + (t >> 5) + 528 * h;
#pragma unroll
        for (int r = 0; r < 16; ++r) { const f32x2 v = buf[b3 + 1056 * r]; ar[r] = v.x; ai[r] = v.y; }
        {
            const float f1 = (float)j * (1.0f / 16384.0f);
            const float c1 = __builtin_amdgcn_cosf(f1), s1 = INV ? __builtin_amdgcn_sinf(f1) : -__builtin_amdgcn_sinf(f1);
            float wc = c1, ws = s1;
#pragma unroll
            for (int r = 1; r < 16; ++r) {
                cmul_chain(ar[r], ai[r], wc, ws, c1, s1);
            }
        }
        fft_r2<16, INV>(ar, ai, z0);
#pragma unroll
        for (int r = 0; r < 16; ++r) { re[h + 2 * r] = ar[brev(r, 4)]; im[h + 2 * r] = ai[brev(r, 4)]; }
    }
    asm volatile("" ::: "memory"); __builtin_amdgcn_sched_barrier(0);
}
}

struct Frame {
    LAS unsigned char* lds;
    volatile LAS unsigned* MISC;
    gu32* ctl;
    int tid, lane, wave;
    int wave0;
    int vcu, G;
    float* out;
    unsigned char* ws;
};
constexpr int PTRTAB_OFF = LDSCTL_OFF + 512;
__device__ __forceinline__ const GAS float* inp(const Frame& F, int i) {
    const v2u w = *(const LAS v2u*)(F.lds + PTRTAB_OFF + 8 * i);
    const unsigned lo = __builtin_amdgcn_readfirstlane(w.x), hi = __builtin_amdgcn_readfirstlane(w.y);
    return (const GAS float*)(((unsigned long long)hi << 32) | lo);
}
__device__ __forceinline__ GAS unsigned char* wsq(const Frame& F) { unsigned char* p = F.ws; asm volatile("" : "+s"(p)); return (GAS unsigned char*)p; }
enum { I_XP = 0, I_XS, I_WIN, I_CONVW, I_CONVB, I_FW1, I_FB1, I_FW2, I_FB2, I_FW3, I_SINF, I_DECAY, I_HBIAS, I_QNORM, I_WUQ, I_KVNORM, I_WUKV, I_GNHY, I_GNAT, I_WOUT,
       I_NMIXPRE, I_NMIXPOST, I_NMLPPRE, I_NMLPPOST, I_WUP, I_WDOWN };

__device__ __forceinline__ int rope_src(int p) { return 4 * (p >> 3) + (p & 3) + 16 * ((p >> 2) & 1); }
template <bool ROPEPERM>
__device__ __forceinline__ void transpose_item(const GAS float* W, int K, int N, GAS bf16* WT, LAS float* scr, int item, int lane, int ldk = 0, int koff = 0) {
    if (ldk == 0) ldk = K;
    const int nblk = N / 32, kb = item / nblk, nb = item % nblk, k0 = 64 * kb, n0 = 32 * nb;
    int sc = lane & 31; if (ROPEPERM && (nb % 3) == 2) sc = rope_src(sc);
#pragma unroll 8
    for (int i = 0; i < 32; ++i) { const int kk = 2 * i + (lane >> 5); scr[kk * 33 + (lane & 31)] = W[(size_t)(k0 + kk) * N + n0 + sc]; }
    LDS_WAIT(); asm volatile("" ::: "memory");
    const int c = lane & 7;
#pragma unroll
    for (int j = 0; j < 4; ++j) { const int n = (lane >> 3) + 8 * j; const LAS float* s = scr + (8 * c) * 33 + n;
        v4u o; o.x = pk2(s[0 * 33], s[1 * 33]); o.y = pk2(s[2 * 33], s[3 * 33]); o.z = pk2(s[4 * 33], s[5 * 33]); o.w = pk2(s[6 * 33], s[7 * 33]);
        *(GAS v4u*)(WT + (size_t)(n0 + n) * ldk + koff + k0 + 8 * c) = o; }
    LDS_WAIT(); asm volatile("" ::: "memory");
}
__device__ __forceinline__ void phase_weights(Frame& F, int l) {
    LAS float* scr = (LAS float*)(F.lds + RING_OFF + F.wave * 16384);
    const int gw = F.vcu * NWAVES + F.wave, NGW = F.G * NWAVES;
    GAS bf16* WinT = (GAS bf16*)(wsq(F) + WS_WIN); GAS bf16* WoutT = (GAS bf16*)(wsq(F) + WS_WOUT); GAS bf16* WupT = (GAS bf16*)(wsq(F) + WS_WUP); GAS bf16* WdownT = (GAS bf16*)(wsq(F) + WS_WDOWN);
    GAS bf16* WuqT = (GAS bf16*)(wsq(F) + WS_WUQ); GAS bf16* WukvT = (GAS bf16*)(wsq(F) + WS_WUKV);
    constexpr int I_IN = (D / 64) * (INW / 32), I_OUT = (D / 64) * (D / 32), I_UP = (D / 64) * (FF / 32), I_DN = (FF / 64) * (D / 32), I_UQ = (QR / 64) * (NQ / 32), I_UKV = (KVR / 64) * (NKV / 32);
    constexpr int I_W3 = 2048 / 32;
    constexpr int NITEMS = I_IN + I_OUT + I_UP + I_DN + I_UQ + I_UKV + 2 * I_W3;
    for (int it = gw; it < NITEMS; it += NGW) {
        int r = it;
        if (r < I_IN) { transpose_item<false>(inp(F, I_WIN) + (size_t)l * D * INW, D, INW, WinT, scr, r, F.lane); continue; } r -= I_IN;
        if (r < I_OUT) { transpose_item<false>(inp(F, I_WOUT) + (size_t)l * D * D, D, D, WoutT, scr, r, F.lane); continue; } r -= I_OUT;
        if (r < I_UP) { transpose_item<false>(inp(F, I_WUP) + (size_t)l * D * FF, D, FF, WupT, scr, r, F.lane); continue; } r -= I_UP;
        if (r < I_DN) { transpose_item<false>(inp(F, I_WDOWN) + (size_t)l * FF * D, FF, D, WdownT, scr, r, F.lane); continue; } r -= I_DN;
        if (r < I_UQ) { transpose_item<true>(inp(F, I_WUQ) + (size_t)l * QR * NQ, QR, NQ, WuqT, scr, r, F.lane); continue; } r -= I_UQ;
        if (r < I_UKV) { transpose_item<false>(inp(F, I_WUKV) + (size_t)l * KVR * NKV, KVR, NKV, WukvT, scr, r, F.lane); continue; } r -= I_UKV;
        transpose_item<false>(inp(F, I_FW3) + (size_t)l * 64 * 2048, 64, 2048, (GAS bf16*)(wsq(F) + WS_W3T), scr, r % I_W3, F.lane, 128, (r / I_W3) * 64);
    }
    { unsigned z = 0u; asm volatile("" : "+v"(z)); const v4u zz = {z, z, z, z};
      for (int i = gw * 64 + F.lane; i < 12288; i += NGW * 64) ((GAS v4u*)(WinT + (size_t)INW * D))[i] = zz; }
}
__device__ __forceinline__ void phase_rope_tab(Frame& F) {
    const float inv[16] = {1.000000000e+00f, 5.623413324e-01f, 3.162277639e-01f, 1.778279394e-01f, 1.000000015e-01f, 5.623412877e-02f, 3.162277862e-02f, 1.778279431e-02f,
                           9.999999776e-03f, 5.623413250e-03f, 3.162277862e-03f, 1.778279431e-03f, 1.000000047e-03f, 5.623413017e-04f, 3.162277862e-04f, 1.778279402e-04f};
    GAS float* ct = (GAS float*)(wsq(F) + WS_COS); GAS float* st = (GAS float*)(wsq(F) + WS_SIN);
    for (int i = F.vcu * NTHR + F.tid; i < L * 16; i += F.G * NTHR) {
        const int t = i >> 4, j = i & 15; float iv = inv[0];
#pragma unroll
        for (int q = 1; q < 16; ++q) iv = (j == q) ? inv[q] : iv;
        const float ang = (float)t * iv; ct[i] = cosf(ang); st[i] = sinf(ang);
    }
}
__device__ __forceinline__ const GAS float* x_src_row(Frame& F, int l, int m) {
    if (l == 0) return (m < 2 * L) ? inp(F, I_XP) + (size_t)m * D : inp(F, I_XS) + (size_t)(m - 2 * L) * D;
    return (const GAS float*)F.out + (size_t)m * D;
}
__device__ __forceinline__ void store_xn_row(f32x4 (&v)[4], float rstd, const GAS float* g, GAS bf16* orow, int lane) {
    GAS v2u* o8 = (GAS v2u*)orow + lane;
#pragma unroll
    for (int j = 0; j < 4; ++j) { const f32x4 gg = ((const GAS f32x4*)g)[lane + 64 * j]; v2u w; w.x = pk2(v[j].x * rstd * gg.x, v[j].y * rstd * gg.y); w.y = pk2(v[j].z * rstd * gg.z, v[j].w * rstd * gg.w); o8[64 * j] = w; }
}
__device__ __forceinline__ float row_ss(const f32x4 (&v)[4]) { float s = 0.f;
#pragma unroll
    for (int j = 0; j < 4; ++j) s += (v[j].x * v[j].x + v[j].y * v[j].y) + (v[j].z * v[j].z + v[j].w * v[j].w);
    return wave_sum(s); }
__device__ __forceinline__ void phase_norm_first(Frame& F, int l, const GAS float* g) {
    const int gw = F.vcu * NWAVES + F.wave, NGW = F.G * NWAVES; GAS bf16* XN = (GAS bf16*)(wsq(F) + WS_XN);
    for (int m = gw; m < M; m += NGW) {
        const GAS f32x4* xr = (const GAS f32x4*)x_src_row(F, l, m) + F.lane; f32x4 v[4];
#pragma unroll
        for (int j = 0; j < 4; ++j) v[j] = xr[64 * j];
        const float rstd = 1.0f / sqrtf(row_ss(v) * (1.0f / D) + EPS);
        store_xn_row(v, rstd, g, XN + (size_t)m * D, F.lane);
    }
}
__device__ __forceinline__ void phase_norm_res(Frame& F, int lsrc, const GAS bf16* T, const GAS float* gpost, const GAS float* gnext) {
    const int gw = F.vcu * NWAVES + F.wave, NGW = F.G * NWAVES; GAS bf16* XN = (GAS bf16*)(wsq(F) + WS_XN);
    for (int m0 = gw; m0 < M; m0 += 2 * NGW) {
        f32x4 v[2][4], tv[2][4];
#pragma unroll
        for (int q = 0; q < 2; ++q) { const int m = m0 + q * NGW; const GAS f32x4* xr = (const GAS f32x4*)x_src_row(F, lsrc, m) + F.lane; const GAS v2u* tr = (const GAS v2u*)(T + (size_t)m * D) + F.lane;
#pragma unroll
            for (int j = 0; j < 4; ++j) { v[q][j] = xr[64 * j]; const v2u w = tr[64 * j]; tv[q][j] = (f32x4){bf2f(w.x & 0xffffu), bf2f(w.x >> 16), bf2f(w.y & 0xffffu), bf2f(w.y >> 16)}; } }
#pragma unroll
        for (int q = 0; q < 2; ++q) { const int m = m0 + q * NGW;
            const float rt = 1.0f / sqrtf(row_ss(tv[q]) * (1.0f / D) + EPS);
            GAS f32x4* orow = (GAS f32x4*)(F.out + (size_t)m * D) + F.lane;
#pragma unroll
            for (int j = 0; j < 4; ++j) { const f32x4 gg = ((const GAS f32x4*)gpost)[F.lane + 64 * j]; v[q][j] = v[q][j] + tv[q][j] * rt * gg; orow[64 * j] = v[q][j]; }
            if (gnext) { const float rstd = 1.0f / sqrtf(row_ss(v[q]) * (1.0f / D) + EPS); store_xn_row(v[q], rstd, gnext, XN + (size_t)m * D, F.lane); } }
    }
}

__device__ __forceinline__ void phase_filter_mlp(Frame& F, int l) {
    const GAS float* w1 = inp(F, I_FW1) + (size_t)l * 33 * 64; const GAS float* b1 = inp(F, I_FB1) + l * 64; const GAS float* w2 = inp(F, I_FW2) + (size_t)l * 64 * 64; const GAS float* b2 = inp(F, I_FB2) + l * 64;
    const GAS float* sf = inp(F, I_SINF) + l * 128; GAS bf16* H2 = (GAS bf16*)(wsq(F) + WS_H2);
    const int lane = F.lane, gw = F.vcu * NWAVES + F.wave, NGW = F.G * NWAVES;
    float w1c[33], w2c[64];
#pragma unroll
    for (int f = 0; f < 33; ++f) w1c[f] = w1[f * 64 + lane];
#pragma unroll
    for (int i = 0; i < 64; ++i) w2c[i] = w2[i * 64 + lane];
    const float b1l = b1[lane], b2l = b2[lane], sf0 = sf[lane], sf1 = sf[64 + lane];
    for (int n = gw; n < L; n += NGW) {
        const float tn = (float)n * (1.0f / (float)(L - 1)); const float omega = (float)(2.0 * 3.14159265358979323846 / L) * (float)n;
        const int bidx = (lane >= 17) ? lane - 17 : lane - 1; const float band = 1e-4f + (float)bidx * ((15.0f - 1e-4f) / 15.0f); const float ph = omega * band;
        const float zf = (lane == 0) ? tn : ((lane <= 16) ? cosf(ph) : -sinf(ph));
        float acc = b1l;
#pragma unroll
        for (int f = 0; f < 33; ++f) acc += __uint_as_float(__builtin_amdgcn_readlane(__float_as_uint(zf), f)) * w1c[f];
        const float h1 = sinf(sf0 * acc);
        float acc2 = b2l;
#pragma unroll
        for (int i = 0; i < 64; ++i) acc2 += __uint_as_float(__builtin_amdgcn_readlane(__float_as_uint(h1), i)) * w2c[i];
        const float hv = sinf(sf1 * acc2); const bf16 hi = f2bf(hv);
        H2[(size_t)n * 128 + lane] = hi; H2[(size_t)n * 128 + 64 + lane] = f2bf(hv - bf2f(hi));
    }
}

__device__ __forceinline__ void phase_filter_fft(Frame& F, int l) {
    const GAS float* KT = (const GAS float*)(wsq(F) + WS_KT); GAS f32x2* KEO = (GAS f32x2*)(wsq(F) + WS_KEO); const GAS float* hb = inp(F, I_HBIAS) + (size_t)l * 2 * HYW;
    LAS f32x2* buf = (LAS f32x2*)(F.lds + RING_OFF); const int t = F.tid;
    for (int c = F.vcu; c < HYW; c += F.G) {
        const GAS float* fw0 = KT + (size_t)(0 * HYW + c) * L; const GAS float* bw0 = KT + (size_t)(1 * HYW + c) * L;
        const GAS float* fw1 = KT + (size_t)(2 * HYW + c) * L; const GAS float* bw1 = KT + (size_t)(3 * HYW + c) * L;
        const float bias0 = hb[c], bias1 = hb[HYW + c]; const float sc = 1.0f / (2.0f * L);
        GAS f32x2* k0 = KEO + (size_t)c * KEO_BLK; GAS f32x2* k1 = KEO + (size_t)(HYW + c) * KEO_BLK;
        float ar[32], ai[32];
#pragma unroll 1
        for (int odd = 0; odd < 2; ++odd) {
            { const int tq = hfft::opaque(t);
#pragma unroll
              for (int m = 0; m < 32; ++m) { const int n = tq + 512 * m; const int nb = n >= 1 ? L - n : 0;
                  const float f0 = fw0[n], f1 = fw1[n]; float b0 = bw0[nb], b1 = bw1[nb]; b0 = n >= 1 ? b0 : 0.f; b1 = n >= 1 ? b1 : 0.f;
                  if (!odd) { ar[m] = f0 + b0; ai[m] = f1 + b1; }
                  else { const float d0 = f0 - b0, d1 = f1 - b1; const float fr = (float)n * (1.0f / 32768.0f); const float cs = __builtin_amdgcn_cosf(fr), sn = -__builtin_amdgcn_sinf(fr);
                         ar[m] = d0 * cs - d1 * sn; ai[m] = d0 * sn + d1 * cs; }
                  if ((m & 7) == 7) { asm volatile("" ::: "memory"); __builtin_amdgcn_sched_barrier(0); } } }
            hfft::fft16k<false>(ar, ai, buf, t);
            __syncthreads();
            { const int tq = hfft::opaque(t);
#pragma unroll
              for (int m = 0; m < 32; ++m) buf[hfft::pad(tq + 512 * m)] = (f32x2){ar[m], ai[m]}; }
            __syncthreads();
            { const int tq = hfft::opaque(t); GAS f32x2* d0 = k0 + (odd ? KEO_KO : 0); GAS f32x2* d1 = k1 + (odd ? KEO_KO : 0);
#pragma unroll
              for (int m = 0; m <= 16; ++m) { const int k = tq + 512 * m; const bool keep = odd ? (k < 8192) : (k <= 8192);
                  const int rk = odd ? 16383 - k : ((16384 - k) & 16383); const f32x2 xq = buf[hfft::pad(rk)]; const float cr = xq.x, ci = -xq.y;
                  const float a0 = 0.5f * (ar[m] + cr), a1 = 0.5f * (ai[m] + ci), b0 = 0.5f * (ai[m] - ci), b1 = -0.5f * (ar[m] - cr);
                  if (keep) { d0[k] = (f32x2){(a0 + bias0) * sc, a1 * sc}; d1[k] = (f32x2){(b0 + bias1) * sc, b1 * sc}; } } }
        }
    }
    __syncthreads();
}

__device__ __forceinline__ float u_conv3(const GAS bf16* row, int n, float w0, float w1, float w2, float cb) {
    const int nm = n >= 1 ? n - 1 : 0, np = n + 1 < L ? n + 1 : L - 1;
    float um = bf2f(row[nm]), up = bf2f(row[np]); const float u0 = bf2f(row[n]);
    um = n >= 1 ? um : 0.f; up = n + 1 < L ? up : 0.f;
    return um * w0 + u0 * w1 + up * w2 + cb;
}
__device__ __forceinline__ void conv3_stage(const GAS bf16* r0, const GAS bf16* r1, float w0, float w1, float w2, float cb, float v0, float v1, float v2, float vb, LAS f32x2* buf, int t) {
    const int tq = hfft::opaque(t);
#pragma unroll
    for (int q = 0; q < 4; ++q) { const int j = tq + 512 * q; const bool hl = j > 0, hr = j < L / 8 - 1; const int nl = hl ? 8 * j - 1 : 0, nr = hr ? 8 * j + 8 : L - 1;
        const v4u a = *(const GAS v4u*)(r0 + 8 * j), b = *(const GAS v4u*)(r1 + 8 * j);
        float al = bf2f(r0[nl]), ar = bf2f(r0[nr]), bl = bf2f(r1[nl]), br = bf2f(r1[nr]);
        al = hl ? al : 0.f; bl = hl ? bl : 0.f; ar = hr ? ar : 0.f; br = hr ? br : 0.f;
        const float ua[10] = {al, __uint_as_float(a.x << 16), __uint_as_float(a.x & 0xffff0000u), __uint_as_float(a.y << 16), __uint_as_float(a.y & 0xffff0000u),
                              __uint_as_float(a.z << 16), __uint_as_float(a.z & 0xffff0000u), __uint_as_float(a.w << 16), __uint_as_float(a.w & 0xffff0000u), ar};
        const float ub[10] = {bl, __uint_as_float(b.x << 16), __uint_as_float(b.x & 0xffff0000u), __uint_as_float(b.y << 16), __uint_as_float(b.y & 0xffff0000u),
                              __uint_as_float(b.z << 16), __uint_as_float(b.z & 0xffff0000u), __uint_as_float(b.w << 16), __uint_as_float(b.w & 0xffff0000u), br};
        LAS f32x4* dst = (LAS f32x4*)(buf + 8 * j);
#pragma unroll
        for (int e = 0; e < 8; e += 2) { f32x4 o;
            o[0] = ua[e] * w0 + ua[e + 1] * w1 + ua[e + 2] * w2 + cb; o[1] = ub[e] * v0 + ub[e + 1] * v1 + ub[e + 2] * v2 + vb;
            o[2] = ua[e + 1] * w0 + ua[e + 2] * w1 + ua[e + 3] * w2 + cb; o[3] = ub[e + 1] * v0 + ub[e + 2] * v1 + ub[e + 3] * v2 + vb; dst[e >> 1] = o; } }
}
__device__ __forceinline__ void cmul_spec(float (&xr)[32], float (&xi)[32], const GAS f32x2* ke, int t, bool odd) {
    { const int tq = hfft::opaque(t); (void)tq;
#pragma unroll
    for (int m = 0; m < 32; ++m) { const int k = tq + 512 * m; int idx; bool cj;
        if (!odd) { cj = k > 8192; idx = cj ? 16384 - k : k; } else { cj = k >= 8192; idx = cj ? 16383 - k : k; }
        const f32x2 kv = ke[idx]; const float kr = kv.x, ki = cj ? -kv.y : kv.y;
        const float a = xr[m], b = xi[m]; xr[m] = a * kr - b * ki; xi[m] = a * ki + b * kr; if ((m & 15) == 15) { asm volatile("" ::: "memory"); __builtin_amdgcn_sched_barrier(0); } }
    }
}
__device__ __forceinline__ f32x2 ld_spec(const GAS f32x2* ke, int k, bool odd) {
    int idx; bool cj;
    if (!odd) { cj = k > 8192; idx = cj ? 16384 - k : k; } else { cj = k >= 8192; idx = cj ? 16383 - k : k; }
    f32x2 kv = ke[idx]; kv.y = cj ? -kv.y : kv.y; return kv;
}
__device__ __forceinline__ void cmul_spec2(float (&xr)[32], float (&xi)[32], const GAS f32x2* ka, const GAS f32x2* kb, LAS f32x2* buf, int t, bool odd) {
    __syncthreads();
    { const int tq = hfft::opaque(t);
#pragma unroll
      for (int m = 0; m < 32; ++m) buf[hfft::pad(tq + 512 * m)] = (f32x2){xr[m], xi[m]}; }
    __syncthreads();
    { const int tq = hfft::opaque(t);
#pragma unroll
      for (int m = 0; m < 32; ++m) { const int k = tq + 512 * m; const int rk = odd ? 16383 - k : ((16384 - k) & 16383);
          const f32x2 xc = buf[hfft::pad(rk)];
          const f32x2 a = ld_spec(ka, k, odd), b = ld_spec(kb, k, odd);
          const float sr = 0.5f * (a.x + b.x), si = 0.5f * (a.y + b.y), dr = 0.5f * (a.x - b.x), di = 0.5f * (a.y - b.y);
          const float x0 = xr[m], x1 = xi[m], c0 = xc.x, c1 = -xc.y;
          xr[m] = (x0 * sr - x1 * si) + (c0 * dr - c1 * di); xi[m] = (x0 * si + x1 * sr) + (c0 * di + c1 * dr);
          if ((m & 7) == 7) { asm volatile("" ::: "memory"); __builtin_amdgcn_sched_barrier(0); } } }
}
__device__ __forceinline__ void spec_prefetch(const GAS f32x2* ke, LAS unsigned char* lds, int t) {
    const int tq = hfft::opaque(t); const GAS unsigned char* src = (const GAS unsigned char*)ke + (tq >> 6) * 1024 + (tq & 63) * 16;
#pragma unroll
    for (int p = 0; p < 9; ++p) { int off = p * 8192; if (p == 8) off = (tq >> 6) == 0 ? off : 0;
        __builtin_amdgcn_global_load_lds((const GAS unsigned*)(src + off), (LAS unsigned*)(lds + RING_OFF + 135168), 16, 0, 0); }
}
#ifndef HYSUB
#define HYSUB 0
#endif
#define HT0() do { if (HYSUB) { __syncthreads(); if (F.tid == 0) F.MISC[20] = (unsigned)__builtin_amdgcn_s_memrealtime(); } } while (0)
#define HT1(s) do { if (HYSUB == (s)) { __syncthreads(); if (F.tid == 0) F.MISC[21] += (unsigned)__builtin_amdgcn_s_memrealtime() - F.MISC[20]; } } while (0)
__device__ __forceinline__ void phase_hyena(Frame& F, int l) {
    const GAS bf16* UT = (const GAS bf16*)(wsq(F) + WS_UT); GAS bf16* YT = (GAS bf16*)(wsq(F) + WS_YT); const GAS f32x2* KEO = (const GAS f32x2*)(wsq(F) + WS_KEO);
    const GAS float* cw = inp(F, I_CONVW) + (size_t)l * 3 * HYP; const GAS float* cbv = inp(F, I_CONVB) + (size_t)l * HYP;
    LAS f32x2* buf = (LAS f32x2*)(F.lds + RING_OFF); const int t = F.tid;
    GAS f32x2* G0 = (GAS f32x2*)(wsq(F) + WS_G0) + (size_t)F.vcu * 16384 + t;
    for (int item = F.vcu; item < HYW + HYW / 2; item += F.G) {
        const bool mode1 = item >= HYW;
        const int c0 = mode1 ? 2 * (item - HYW) : item, c1 = mode1 ? c0 + 1 : c0;
        const size_t s0 = mode1 ? (size_t)2 * L : 0, s1 = mode1 ? (size_t)2 * L : (size_t)L;
        float ar[32], ai[32]; unsigned ep[32];
#pragma unroll 1
        for (int o = 0; o < 2; ++o) {
            const GAS f32x2* ke0 = KEO + (size_t)(o * HYW + c0) * KEO_BLK; const GAS f32x2* ke1 = KEO + (size_t)(o * HYW + c1) * KEO_BLK;
#pragma unroll 1
            for (int half = 0; half < 2; ++half) {
                HT0();
                if (o == 0) { const float w0 = cw[c0], w1 = cw[HYP + c0], w2 = cw[2 * HYP + c0], cb = cbv[c0], v0 = cw[c1], v1 = cw[HYP + c1], v2 = cw[2 * HYP + c1], vb = cbv[c1];
                    const GAS bf16* r0 = UT + (size_t)c0 * M + s0; const GAS bf16* r1 = UT + (size_t)c1 * M + s1;
                    __syncthreads(); conv3_stage(r0, r1, w0, w1, w2, cb, v0, v1, v2, vb, buf, t); __syncthreads();
                    { const int tq = hfft::opaque(t);
#pragma unroll
                    for (int m = 0; m < 32; ++m) { const f32x2 v = buf[tq + 512 * m]; ar[m] = v.x; ai[m] = v.y; } }
                    }
                else {
                    { const int tq = hfft::opaque(t); (void)tq; GAS f32x2* G0q = G0 + (tq - t);
#pragma unroll
                    for (int m = 0; m < 32; ++m) { const f32x2 v = G0q[m * 512]; ar[m] = v.x; ai[m] = v.y; if ((m & 15) == 15) { asm volatile("" ::: "memory"); __builtin_amdgcn_sched_barrier(0); } } }
                    }
                HT1(1);
                if (half == 0) {
                    spec_prefetch(ke0, F.lds, t); if (mode1) spec_prefetch(ke1, F.lds, t);
                    HT0(); hfft::fft16k<false>(ar, ai, buf, t); HT1(2); HT0();
                    if (mode1) cmul_spec2(ar, ai, ke0, ke1, buf, t, false); else cmul_spec(ar, ai, ke0, t, false);
                    HT1(3); HT0(); hfft::fft16k<true>(ar, ai, buf, t); HT1(2); HT0();
                    {
#pragma unroll
                    for (int m = 0; m < 32; ++m) ep[m] = pk2(ar[m], ai[m]);
                    }
                    HT1(4);
                } else {
                    HT0();
                    { const int tq = hfft::opaque(t); (void)tq;
#pragma unroll
                    for (int m = 0; m < 32; ++m) { const float fr = (float)(tq + 512 * m) * (1.0f / 32768.0f); const float cs = __builtin_amdgcn_cosf(fr), sn = -__builtin_amdgcn_sinf(fr);
                        const float a = ar[m], b = ai[m]; ar[m] = a * cs - b * sn; ai[m] = a * sn + b * cs; }
                    }
                    spec_prefetch(ke0 + KEO_KO, F.lds, t); if (mode1) spec_prefetch(ke1 + KEO_KO, F.lds, t);
                    HT1(5); HT0(); hfft::fft16k<false>(ar, ai, buf, t); HT1(2); HT0();
                    if (mode1) cmul_spec2(ar, ai, ke0 + KEO_KO, ke1 + KEO_KO, buf, t, true); else cmul_spec(ar, ai, ke0 + KEO_KO, t, true);
                    HT1(3); HT0(); hfft::fft16k<true>(ar, ai, buf, t); HT1(2); HT0();
                    const int g0 = (o + 1) * HYW + c0, g1 = (o + 1) * HYW + c1;
                    const float w0 = cw[g0], w1 = cw[HYP + g0], w2 = cw[2 * HYP + g0], cb = cbv[g0], v0 = cw[g1], v1 = cw[HYP + g1], v2 = cw[2 * HYP + g1], vb = cbv[g1];
                    const GAS bf16* r0 = UT + (size_t)g0 * M + s0; const GAS bf16* r1 = UT + (size_t)g1 * M + s1;
                    __syncthreads(); conv3_stage(r0, r1, w0, w1, w2, cb, v0, v1, v2, vb, buf, t); __syncthreads();
                    { const int tq = hfft::opaque(t); (void)tq;
#pragma unroll
                    for (int m = 0; m < 32; ++m) { const int n = tq + 512 * m; const float fr = (float)n * (1.0f / 32768.0f); const float cs = __builtin_amdgcn_cosf(fr), sn = __builtin_amdgcn_sinf(fr); const f32x2 g = buf[n];
                        const float a = ar[m], b = ai[m]; const f32x2 e = {__uint_as_float(ep[m] << 16), __uint_as_float(ep[m] & 0xffff0000u)}; const float yr = e.x + (a * cs - b * sn), yi = e.y + (a * sn + b * cs);
                        ar[m] = yr * g.x; ai[m] = yi * g.y; }
                    }
                    if (o == 0) {
                        { const int tq = hfft::opaque(t); (void)tq; GAS f32x2* G0q = G0 + (tq - t);
#pragma unroll
                        for (int m = 0; m < 32; ++m) G0q[m * 512] = (f32x2){ar[m], ai[m]};
                        }
                    } else { GAS bf16* y0 = YT + (size_t)c0 * M + s0; GAS bf16* y1 = YT + (size_t)c1 * M + s1;
                        { const int tq = hfft::opaque(t); (void)tq;
#pragma unroll
                        for (int m = 0; m < 32; ++m) { const int n = tq + 512 * m; y0[n] = f2bf(ar[m]); y1[n] = f2bf(ai[m]); } }
                        }
                    HT1(6);
                }
            }
        }
    }
    __syncthreads();
}

__device__ __forceinline__ void phase_mla_prep(Frame& F, int l) {
    const GAS bf16* CQKV = (const GAS bf16*)(wsq(F) + WS_CQKV); GAS bf16* CQN = (GAS bf16*)(wsq(F) + WS_CQN); GAS bf16* CKVN = (GAS bf16*)(wsq(F) + WS_CKVN); GAS bf16* KPE = (GAS bf16*)(wsq(F) + WS_KPE);
    const GAS float* gq = inp(F, I_QNORM) + l * QR; const GAS float* gkv = inp(F, I_KVNORM) + l * KVR; const GAS float* ct = (const GAS float*)(wsq(F) + WS_COS); const GAS float* st = (const GAS float*)(wsq(F) + WS_SIN);
    const int gw = F.vcu * NWAVES + F.wave, NGW = F.G * NWAVES, lane = F.lane;
    for (int m = gw; m < M; m += NGW) {
        const GAS bf16* row = CQKV + (size_t)m * 512;
        const v2u q = *(const GAS v2u*)(row + 4 * lane); const unsigned kv = *(const GAS unsigned*)(row + 256 + 2 * lane);
        const float q0 = bf2f(q.x & 0xffffu), q1 = bf2f(q.x >> 16), q2 = bf2f(q.y & 0xffffu), q3 = bf2f(q.y >> 16), k0 = bf2f(kv & 0xffffu), k1 = bf2f(kv >> 16);
        const float rq = 1.0f / sqrtf(wave_sum((q0 * q0 + q1 * q1) + (q2 * q2 + q3 * q3)) * (1.0f / QR) + EPS);
        const float rk = 1.0f / sqrtf(wave_sum(k0 * k0 + k1 * k1) * (1.0f / KVR) + EPS);
        const f32x4 g4 = *(const GAS f32x4*)(gq + 4 * lane); const f32x2 g2 = *(const GAS f32x2*)(gkv + 2 * lane);
        v2u oq; oq.x = pk2(q0 * rq * g4.x, q1 * rq * g4.y); oq.y = pk2(q2 * rq * g4.z, q3 * rq * g4.w);
        *(GAS v2u*)(CQN + (size_t)m * QR + 4 * lane) = oq;
        *(GAS unsigned*)(CKVN + (size_t)m * KVR + 2 * lane) = pk2(k0 * rk * g2.x, k1 * rk * g2.y);
        if (lane < 16) { const int j = lane, tpos = m & (L - 1); const float x1 = bf2f(row[384 + j]), x2 = bf2f(row[384 + 16 + j]); const float cs = ct[tpos * 16 + j], sn = st[tpos * 16 + j];
            const int p1 = 8 * (j >> 2) + (j & 3); KPE[(size_t)m * ROPE + p1] = f2bf(x1 * cs - x2 * sn); KPE[(size_t)m * ROPE + p1 + 4] = f2bf(x2 * cs + x1 * sn); }
    }
}

__device__ __forceinline__ void phase_hy_out(Frame& F, int l) {
    const GAS bf16* YT = (const GAS bf16*)(wsq(F) + WS_YT); GAS bf16* MIX = (GAS bf16*)(wsq(F) + WS_MIX); const GAS float* gn = inp(F, I_GNHY) + l * HYW;
    LAS bf16* tl = (LAS bf16*)(F.lds + RING_OFF + F.wave * 16384);
    const int gw = F.vcu * NWAVES + F.wave, NGW = F.G * NWAVES, lane = F.lane;
    for (int task = gw; task < 8 * (M / 64); task += NGW) {
        const int g = task & 7, tb = task >> 3, tok0 = tb * 64; const int cl = lane >> 3, t8 = (lane & 7) * 8;
        float v[8][8]; float ss[8]; const int ln_ = hw_lane();
#pragma unroll
        for (int j = 0; j < 8; ++j) ss[j] = 0.f;
#pragma unroll
        for (int i = 0; i < 8; ++i) { const int ch = g * 64 + 8 * i + cl; const v4u w = *(const GAS v4u*)(YT + (size_t)ch * M + tok0 + t8);
            v[i][0] = bf2f(w.x & 0xffffu); v[i][1] = bf2f(w.x >> 16); v[i][2] = bf2f(w.y & 0xffffu); v[i][3] = bf2f(w.y >> 16);
            v[i][4] = bf2f(w.z & 0xffffu); v[i][5] = bf2f(w.z >> 16); v[i][6] = bf2f(w.w & 0xffffu); v[i][7] = bf2f(w.w >> 16);
#pragma unroll
            for (int j = 0; j < 8; ++j) ss[j] += v[i][j] * v[i][j]; }
#pragma unroll
        for (int j = 0; j < 8; ++j) { float s = ss[j]; s += shx(s, ln_, 8); s += shx(s, ln_, 16); s += shx(s, ln_, 32); ss[j] = 1.0f / sqrtf(s * (1.0f / 64.0f) + EPS); }
#pragma unroll
        for (int i = 0; i < 8; ++i) { const int cc = 8 * i + cl; const float gg = gn[g * 64 + cc];
#pragma unroll
            for (int j = 0; j < 8; ++j) tl[(t8 + j) * 72 + cc] = f2bf(v[i][j] * ss[j] * gg); }
        LDS_WAIT(); asm volatile("" ::: "memory");
#pragma unroll
        for (int i = 0; i < 8; ++i) { const int tok = 8 * i + (lane >> 3), c8 = (lane & 7) * 8; const v4u w = *(const LAS v4u*)(tl + tok * 72 + c8);
            *(GAS v4u*)(MIX + (size_t)(tok0 + tok) * D + g * 64 + c8) = w; }
        LDS_WAIT(); asm volatile("" ::: "memory");
    }
}

namespace att {
using s16x4 = __attribute__((ext_vector_type(4))) short;
using f32x16 = __attribute__((ext_vector_type(16))) float;
using u32x4 = __attribute__((ext_vector_type(4))) unsigned;
constexpr int QBLK = 32, KVBLK = 64, NW = 8;
constexpr float SCALE = 0.10206207261596575f;
constexpr float THR = 8.f;
constexpr int SHM_K = KVBLK * 256, SHM_V = KVBLK * DV * 2;
constexpr int NSLOT = 4;
constexpr int OFF_V = 0, OFF_K = NSLOT * SHM_V, OFF_WS = OFF_K + NSLOT * SHM_K, SHM_ATTN = OFF_WS + NW * 64 * 4;
#define KSWZ(row, colB) ((row) * 256 + ((colB) ^ (((row) & 15) << 4)))
#define SBAR() __builtin_amdgcn_sched_barrier(0)
__device__ __forceinline__ int crow(int r, int hi) { return (r & 3) + 8 * (r >> 2) + 4 * hi; }
__device__ __forceinline__ unsigned cvtpk(float lo, float hi) { unsigned r; asm volatile("v_cvt_pk_bf16_f32 %0, %1, %2" : "=v"(r) : "v"(lo), "v"(hi)); return r; }
constexpr float THRL = THR * 1.4426950408889634f;
#define EX2(v) ((ABL & 1) ? (v) : __builtin_amdgcn_exp2f(v))
#define MX3(a, b, c) ((ABL & 128) ? (a) : __builtin_fmaxf(__builtin_fmaxf((a), (b)), (c)))
__device__ __forceinline__ int v_st(int k, int c) { const int kk = k; return ((kk >> 3) * 2 + (c >> 5)) * 512 + ((kk & 7) * 32 + (c & 31)) * 2; }
__device__ __forceinline__ int v_rd_base(int lane) { return ((lane & 3) << 3) | (((lane >> 2) & 3) << 6) | (((lane >> 4) & 1) << 5) | (((lane >> 5) & 1) << 8); }
constexpr int v_rd_off(int d0, int ks, int half) { return d0 * 512 + ks * 2048 + half * 1024; }
template <int OFF> __device__ __forceinline__ s16x4 tr_read(int vb) { s16x4 r; asm volatile("ds_read_b64_tr_b16 %0, %1 offset:%2" : "=&v"(r) : "v"(vb), "i"(OFF) : "memory"); return r; }
template <int ABL> __device__ __forceinline__ void attn_unit(const bf16* Qb_, const bf16* KNh_, const bf16* KPEb_, const bf16* Vh_, bf16* Mo_,
                                          const float* gain_, const float* ct_, const float* st_, int tpos0, LAS char* lds, const int wave0) {
  const GAS bf16* Qb = (const GAS bf16*)Qb_; const GAS bf16* KNh = (const GAS bf16*)KNh_; const GAS bf16* KPEb = (const GAS bf16*)KPEb_; const GAS bf16* Vh = (const GAS bf16*)Vh_; GAS bf16* Mo = (GAS bf16*)Mo_;
  const GAS float* gain = (const GAS float*)gain_; const GAS float* ct = (const GAS float*)ct_; const GAS float* st = (const GAS float*)st_;

  int tid_ = tid_from_wave(wave0);
  const int tid = tid_, wid = tid >> 6, lane = tid & 63, r32 = lane & 31, hi = lane >> 5;
  LAS char* V_lds = lds + OFF_V; LAS char* K_lds = lds + OFF_K;
  LAS float* ws = (LAS float*)(lds + OFF_WS) + wid * 64; LAS float* li_l = ws; LAS float* al_l = ws + 32;
  float m_reg = 0.f, l_reg = 0.f; f32x16 o[2] = {}; f32x16 negm = {}; bf16x8 qr[6];
  const GAS bf16* Qw = Qb + (long)(wid * QBLK + r32) * NQ + hi * 8;
#pragma unroll
  for (int d0 = 0; d0 < 6; ++d0) qr[d0] = *reinterpret_cast<const GAS bf16x8*>(Qw + d0 * 16);
  { const int tq = tpos0 + wid * QBLK + r32;
#pragma unroll
    for (int d0 = 4; d0 < 6; ++d0) { const int fq = 2 * (d0 - 4) + hi; const f32x4 cs = *reinterpret_cast<const GAS f32x4*>(ct + tq * 16 + 4 * fq), sn = *reinterpret_cast<const GAS f32x4*>(st + tq * 16 + 4 * fq);
      const u32x4 w = __builtin_bit_cast(u32x4, qr[d0]);
      const f32x4 x1 = {bf2f(w[0] & 0xffffu), bf2f(w[0] >> 16), bf2f(w[1] & 0xffffu), bf2f(w[1] >> 16)}, x2 = {bf2f(w[2] & 0xffffu), bf2f(w[2] >> 16), bf2f(w[3] & 0xffffu), bf2f(w[3] >> 16)};
      const f32x4 a = x1 * cs - x2 * sn, b = x2 * cs + x1 * sn;
      const u32x4 o4 = {cvtpk(a[0], a[1]), cvtpk(a[2], a[3]), cvtpk(b[0], b[1]), cvtpk(b[2], b[3])}; qr[d0] = __builtin_bit_cast(bf16x8, o4); } }
  { constexpr float C = SCALE * 1.4426950408889634f;
#pragma unroll
    for (int d0 = 0; d0 < 6; ++d0) { const u32x4 w = __builtin_bit_cast(u32x4, qr[d0]); u32x4 o4;
#pragma unroll
      for (int e = 0; e < 4; ++e) o4[e] = cvtpk(bf2f(w[e] & 0xffffu) * C, bf2f(w[e] >> 16) * C);
      qr[d0] = __builtin_bit_cast(bf16x8, o4); } }
  const int vb0 = (int)(unsigned)(uintptr_t)V_lds + v_rd_base(lane);
  const int wid_s = __builtin_amdgcn_readfirstlane(wid);
  const GAS bf16* ksrc[2]; long kstep[2];
#pragma unroll
  for (int q = 0; q < 2; ++q) { const int r = 4 * (2 * wid + q) + (lane >> 4), c = (lane & 15) ^ (r & 15); const bool rope = (c >= 8) && (c < 12);
    ksrc[q] = rope ? KPEb + (long)r * ROPE + (c - 8) * 8 : KNh + (long)r * NKV + (c & 7) * 8; kstep[q] = rope ? (long)KVBLK * ROPE : (long)KVBLK * NKV; }
  const GAS bf16* vsrc; { const int p = 64 * wid + lane, sub = p >> 5, kk = (sub >> 1) * 8 + ((p >> 2) & 7), col = (sub & 1) * 32 + (p & 3) * 8; vsrc = Vh + (long)kk * NKV + col; }
#define DMA(t, slot) do { if (ABL & 32) break; \
    __builtin_amdgcn_global_load_lds((const GAS unsigned*)(ksrc[0] + (long)(t) * kstep[0]), (LAS unsigned*)(K_lds + (slot) * SHM_K + (2 * wid_s) * 1024), 16, 0, 0); \
    __builtin_amdgcn_global_load_lds((const GAS unsigned*)(ksrc[1] + (long)(t) * kstep[1]), (LAS unsigned*)(K_lds + (slot) * SHM_K + (2 * wid_s + 1) * 1024), 16, 0, 0); \
    __builtin_amdgcn_global_load_lds((const GAS unsigned*)(vsrc + (long)(t) * ((long)KVBLK * NKV)), (LAS unsigned*)(V_lds + (slot) * SHM_V + wid_s * 1024), 16, 0, 0); } while (0)
#define TBAR(N) do { asm volatile("s_waitcnt vmcnt(" #N ") lgkmcnt(0)" ::: "memory"); if (!(ABL & 64)) __builtin_amdgcn_s_barrier(); asm volatile("" ::: "memory"); } while (0)
#define RESC(a) do { if (__any((a) < 1.f)) { if (hi == 0) al_l[r32] = (a); asm volatile("s_waitcnt lgkmcnt(0)" ::: "memory"); \
    _Pragma("unroll") for (int d = 0; d < 2; ++d) _Pragma("unroll") for (int r = 0; r < 16; ++r) o[d][r] *= al_l[crow(r, hi)]; } } while (0)
  f32x16 pA0, pA1, pB0, pB1; bf16x8 pa0, pa1, pa2, pa3; constexpr int NTL = L / KVBLK; constexpr int SE = 0, SO = 1;
  int koff[6];
#pragma unroll
  for (int d0 = 0; d0 < 6; ++d0) koff[d0] = KSWZ(r32, (d0 * 16 + hi * 8) * 2);
  s16x4 vl[4], vh[4]; float pmax = 0.f, alpha = 1.f;
#define KFR(i) ((ABL & 8) ? qr[(i) >> 1] : *(const LAS bf16x8*)(kbase + koff[(i) >> 1] + ((i) & 1) * 8192))
#define MQK(a_, b_, c_) ((ABL & 2) ? (c_) : __builtin_amdgcn_mfma_f32_32x32x16_bf16(a_, b_, c_, 0, 0, 0))
#define MPV(a_, b_, c_) ((ABL & 4) ? (c_) : __builtin_amdgcn_mfma_f32_32x32x16_bf16(a_, b_, c_, 0, 0, 0))
#define VRD8(D0) do { if (ABL & 16) break; vl[0] = tr_read<v_rd_off(D0, 0, 0)>(vbq); vh[0] = tr_read<v_rd_off(D0, 0, 1)>(vbq); vl[1] = tr_read<v_rd_off(D0, 1, 0)>(vbq); vh[1] = tr_read<v_rd_off(D0, 1, 1)>(vbq); \
    vl[2] = tr_read<v_rd_off(D0, 2, 0)>(vbq); vh[2] = tr_read<v_rd_off(D0, 2, 1)>(vbq); vl[3] = tr_read<v_rd_off(D0, 3, 0)>(vbq); vh[3] = tr_read<v_rd_off(D0, 3, 1)>(vbq); } while (0)
#define VWAIT() if (!(ABL & 16)) asm volatile("s_waitcnt lgkmcnt(0)" : "+v"(vl[0]), "+v"(vh[0]), "+v"(vl[1]), "+v"(vh[1]), "+v"(vl[2]), "+v"(vh[2]), "+v"(vl[3]), "+v"(vh[3]) :: "memory")
#define VFR(k) (bf16x8){vl[k][0], vl[k][1], vl[k][2], vl[k][3], vh[k][0], vh[k][1], vh[k][2], vh[k][3]}
#define PKA(P, B) do { if (ABL & 256) break; w0_ = cvtpk(P[B + 0], P[B + 1]); w1_ = cvtpk(P[B + 2], P[B + 3]); } while (0)
#define PKB(P, B, OUT) do { if (ABL & 256) { OUT = qr[0]; break; } const u32x4 w_ = {w0_, w1_, cvtpk(P[B + 4], P[B + 5]), cvtpk(P[B + 6], P[B + 7])}; OUT = __builtin_bit_cast(bf16x8, w_); } while (0)
#define R1(DO_QK, DO_FIN, X0, X1, Y0, Y1, KSLOT) do { const LAS char* kbase = K_lds + (KSLOT) * SHM_K; bf16x8 kf0, kf1, kf2, kf3; unsigned w0_ = 0, w1_ = 0; \
    if (DO_QK) { kf0 = KFR(0); kf1 = KFR(1); kf2 = KFR(2); } SBAR(); \
      if (DO_QK) { kf3 = KFR(3); X0 = MQK(kf0, qr[0], negm); } if (DO_FIN) { Y0[0] = EX2(Y0[0]); Y0[1] = EX2(Y0[1]); Y0[2] = EX2(Y0[2]); Y0[3] = EX2(Y0[3]); } SBAR(); \
      if (DO_QK) { kf0 = KFR(4); X1 = MQK(kf1, qr[0], negm); } if (DO_FIN) { Y0[4] = EX2(Y0[4]); Y0[5] = EX2(Y0[5]); Y0[6] = EX2(Y0[6]); Y0[7] = EX2(Y0[7]); } SBAR(); \
      if (DO_QK) { kf1 = KFR(5); X0 = MQK(kf2, qr[1], X0); } if (DO_FIN) { Y0[8] = EX2(Y0[8]); Y0[9] = EX2(Y0[9]); Y0[10] = EX2(Y0[10]); Y0[11] = EX2(Y0[11]); } SBAR(); \
      if (DO_QK) { kf2 = KFR(6); X1 = MQK(kf3, qr[1], X1); } if (DO_FIN) { Y0[12] = EX2(Y0[12]); Y0[13] = EX2(Y0[13]); Y0[14] = EX2(Y0[14]); Y0[15] = EX2(Y0[15]); } SBAR(); \
      if (DO_QK) { kf3 = KFR(7); X0 = MQK(kf0, qr[2], X0); } if (DO_FIN) { Y1[0] = EX2(Y1[0]); Y1[1] = EX2(Y1[1]); Y1[2] = EX2(Y1[2]); Y1[3] = EX2(Y1[3]); PKA(Y0, 0); } SBAR(); \
      if (DO_QK) { kf0 = KFR(8); X1 = MQK(kf1, qr[2], X1); } if (DO_FIN) { Y1[4] = EX2(Y1[4]); Y1[5] = EX2(Y1[5]); Y1[6] = EX2(Y1[6]); Y1[7] = EX2(Y1[7]); PKB(Y0, 0, pa0); } SBAR(); \
      if (DO_QK) { kf1 = KFR(9); X0 = MQK(kf2, qr[3], X0); } if (DO_FIN) { Y1[8] = EX2(Y1[8]); Y1[9] = EX2(Y1[9]); Y1[10] = EX2(Y1[10]); Y1[11] = EX2(Y1[11]); PKA(Y0, 8); } SBAR(); \
      if (DO_QK) { kf2 = KFR(10); X1 = MQK(kf3, qr[3], X1); } if (DO_FIN) { Y1[12] = EX2(Y1[12]); Y1[13] = EX2(Y1[13]); Y1[14] = EX2(Y1[14]); Y1[15] = EX2(Y1[15]); PKB(Y0, 8, pa1); } SBAR(); \
      if (DO_QK) { kf3 = KFR(11); X0 = MQK(kf0, qr[4], X0); } if (DO_FIN) { PKA(Y1, 0); } SBAR(); \
      if (DO_QK) { X1 = MQK(kf1, qr[4], X1); } if (DO_FIN) { PKB(Y1, 0, pa2); } SBAR(); \
      if (DO_QK) { X0 = MQK(kf2, qr[5], X0); } if (DO_FIN) { PKA(Y1, 8); } SBAR(); \
      if (DO_QK) { X1 = MQK(kf3, qr[5], X1); } if (DO_FIN) { PKB(Y1, 8, pa3); } SBAR(); \
  } while (0)
#define R2(DO_PV, DO_MAX, X0, X1, Y0, Y1, VSLOT, LOADS) do { const int vbq = vb0 + (VSLOT) * SHM_V; float ma_ = 0.f, mb_ = 0.f, sa_ = 0.f; \
    if (DO_PV) { VRD8(0); } SBAR(); \
    if (DO_PV) { VWAIT(); o[0] = MPV(pa0, VFR(0), o[0]); if (!(ABL & 640)) sa_ = (Y0[0] + Y0[1]) + (Y0[2] + Y0[3]); } SBAR(); \
    if (DO_PV) { o[0] = MPV(pa1, VFR(1), o[0]); if (!(ABL & 640)) sa_ += Y0[4]; if (!(ABL & 640)) sa_ += Y0[5]; if (!(ABL & 640)) sa_ += Y0[6]; if (!(ABL & 640)) sa_ += Y0[7]; } LOADS; SBAR(); \
    if (DO_PV) { o[0] = MPV(pa2, VFR(2), o[0]); if (!(ABL & 640)) sa_ += Y0[8]; if (!(ABL & 640)) sa_ += Y0[9]; if (!(ABL & 640)) sa_ += Y0[10]; if (!(ABL & 640)) sa_ += Y0[11]; } SBAR(); \
    if (DO_PV) { o[0] = MPV(pa3, VFR(3), o[0]); if (!(ABL & 640)) sa_ += Y0[12]; if (!(ABL & 640)) sa_ += Y0[13]; if (!(ABL & 640)) sa_ += Y0[14]; if (!(ABL & 640)) sa_ += Y0[15]; } SBAR(); \
    if (DO_PV) { VRD8(1); if (!(ABL & 640)) sa_ += Y1[0]; if (!(ABL & 640)) sa_ += Y1[1]; if (!(ABL & 640)) sa_ += Y1[2]; if (!(ABL & 640)) sa_ += Y1[3]; if (!(ABL & 640)) sa_ += Y1[4]; if (!(ABL & 640)) sa_ += Y1[5]; if (!(ABL & 640)) sa_ += Y1[6]; if (!(ABL & 640)) sa_ += Y1[7]; } \
    if (DO_MAX) { ma_ = MX3(X0[0], X0[1], X1[0]); mb_ = MX3(X0[2], X0[3], X1[1]); ma_ = MX3(ma_, X1[2], X1[3]); ma_ = MX3(ma_, X0[4], X0[5]); mb_ = MX3(mb_, X0[6], X0[7]); ma_ = MX3(ma_, X1[4], X1[5]); mb_ = MX3(mb_, X1[6], X1[7]); } SBAR(); \
    if (DO_PV) { VWAIT(); o[1] = MPV(pa0, VFR(0), o[1]); if (!(ABL & 640)) sa_ += Y1[8]; if (!(ABL & 640)) sa_ += Y1[9]; if (!(ABL & 640)) sa_ += Y1[10]; if (!(ABL & 640)) sa_ += Y1[11]; } if (DO_MAX) { ma_ = MX3(ma_, X0[8], X0[9]); mb_ = MX3(mb_, X0[10], X0[11]); } SBAR(); \
    if (DO_PV) { o[1] = MPV(pa1, VFR(1), o[1]); if (!(ABL & 640)) sa_ += Y1[12]; if (!(ABL & 640)) sa_ += Y1[13]; if (!(ABL & 640)) sa_ += Y1[14]; if (!(ABL & 640)) sa_ += Y1[15]; } if (DO_MAX) { ma_ = MX3(ma_, X1[8], X1[9]); mb_ = MX3(mb_, X1[10], X1[11]); } SBAR(); \
    if (DO_PV) { o[1] = MPV(pa2, VFR(2), o[1]); l_reg += sa_; if (ABL & 512) { o[0] = MPV(pa0, qr[0], o[0]); o[0] = MPV(pa1, qr[0], o[0]); } } if (DO_MAX) { ma_ = MX3(ma_, X0[12], X0[13]); mb_ = MX3(mb_, X0[14], X0[15]); ma_ = MX3(ma_, X1[12], X1[13]); mb_ = MX3(mb_, X1[14], X1[15]); } SBAR(); \
    if (DO_PV) { o[1] = MPV(pa3, VFR(3), o[1]); if (ABL & 512) { o[0] = MPV(pa2, qr[0], o[0]); o[0] = MPV(pa3, qr[0], o[0]); } } if (DO_MAX) { float m_ = __builtin_fmaxf(ma_, mb_); auto rr_ = __builtin_amdgcn_permlane32_swap(__float_as_uint(m_), __float_as_uint(m_), false, false); pmax = __builtin_fmaxf(__uint_as_float(rr_[0]), __uint_as_float(rr_[1])); } SBAR(); \
  } while (0)
#define DECIDE(FIRST, X0, X1) do { alpha = 1.f; \
    if ((FIRST) || !__builtin_expect(__all(pmax <= THRL), 1)) { const float d_ = (FIRST) ? pmax : __builtin_fmaxf(pmax, 0.f); m_reg += d_; if (!(FIRST)) alpha = EX2(-d_); \
      _Pragma("unroll") for (int r = 0; r < 16; ++r) { X0[r] -= d_; X1[r] -= d_; } \
      _Pragma("unroll") for (int r = 0; r < 16; ++r) negm[r] = -m_reg; l_reg *= alpha; } \
    RESC(alpha); } while (0)
  DMA(0, 0); DMA(1, 1);
  TBAR(3);
  R1(true, false, pA0, pA1, pB0, pB1, 0);
  R2(false, true, pA0, pA1, pB0, pB1, 0, DMA(2, 2));
  DECIDE(true, pA0, pA1);
  TBAR(3);
  for (int j = 1; j + 1 < NTL; j += 2) {
    R1(true, true, pB0, pB1, pA0, pA1, j & 3);
    R2(true, true, pB0, pB1, pA0, pA1, (j - 1) & 3, DMA(j + 2, (j + 2) & 3));
    DECIDE(false, pB0, pB1);
    TBAR(3);
    R1(true, true, pA0, pA1, pB0, pB1, (j + 1) & 3);
    R2(true, true, pA0, pA1, pB0, pB1, j & 3, if (j + 3 < NTL) DMA(j + 3, (j + 3) & 3));
    DECIDE(false, pA0, pA1);
    if (j + 3 < NTL) TBAR(3); else TBAR(0);
  }
  R1(true, true, pB0, pB1, pA0, pA1, (NTL - 1) & 3);
  R2(true, true, pB0, pB1, pA0, pA1, (NTL - 2) & 3, (void)0);
  DECIDE(false, pB0, pB1);
  R1(false, true, pA0, pA1, pB0, pB1, 0);
  R2(true, false, pA0, pA1, pB0, pB1, (NTL - 1) & 3, (void)0);
#undef DECIDE
#undef R2
#undef R1
#undef PKA
#undef PKB
#undef VFR
#undef VWAIT
#undef VRD8
#undef KFR
  { auto rr = __builtin_amdgcn_permlane32_swap(__float_as_uint(l_reg), __float_as_uint(l_reg), false, false); l_reg = __uint_as_float(rr[0]) + __uint_as_float(rr[1]); }
  if (hi == 0) li_l[r32] = l_reg; asm volatile("s_waitcnt lgkmcnt(0)" ::: "memory");
  const float g0 = gain[r32], g1 = gain[32 + r32]; const int ln_ = hw_lane();
  GAS bf16* Ow = Mo + (long)(wid * QBLK) * D;
#pragma unroll
  for (int r = 0; r < 16; ++r) { const int orow = crow(r, hi); const float rl = __builtin_amdgcn_rcpf(li_l[orow]);
    const float y0 = o[0][r] * rl, y1 = o[1][r] * rl; float s = y0 * y0 + y1 * y1;
    s += shx(s, ln_, 1); s += shx(s, ln_, 2); s += shx(s, ln_, 4); s += shx(s, ln_, 8); s += shx(s, ln_, 16);
    const float rs = 1.0f / sqrtf(s * (1.0f / 64.0f) + EPS);
    Ow[(long)orow * D + r32] = f2bf(y0 * rs * g0); Ow[(long)orow * D + 32 + r32] = f2bf(y1 * rs * g1); }
  __syncthreads();
#undef DMA
#undef TBAR
#undef RESC
}
#undef EX2
#undef MX3
#undef KSWZ
#undef SBAR
}
#define XB_TMO      128
#define XB_XCNT(j)  (256  + 64 * (j))
#define XB_XSUB(j)  (1280 + 64 * (j))
#define XB_XGEN(j)  (2304 + 64 * (j))
#define XB_TOP      3328
#define XB_TOPGEN   3392
#define XCD_BAR_WORDS 3456
#define XB_SPIN_CAP (1u << 18)

__device__ __forceinline__ unsigned xb_ld(unsigned* p)              { return __hip_atomic_load(p, __ATOMIC_RELAXED, __HIP_MEMORY_SCOPE_AGENT); }
__device__ __forceinline__ unsigned xb_add(unsigned* p, unsigned v) { return __hip_atomic_fetch_add(p, v, __ATOMIC_RELAXED, __HIP_MEMORY_SCOPE_AGENT); }
__device__ __forceinline__ unsigned xb_xcc_id() { return (unsigned)__builtin_amdgcn_s_getreg((3 << 11) | 20) & 0xFu; }
#define XB_SPIN(cond, bar) do { unsigned _sp = 0; while (cond) { __builtin_amdgcn_s_sleep(1); \
    if ((++_sp & 255u) == 0u) { if (xb_ld(&(bar)[XB_TMO])) break; if (_sp > XB_SPIN_CAP) { atomicAdd(&(bar)[XB_TMO], 1u); break; } } } } while (0)

struct XcdBarrier {
    unsigned* bar; unsigned x;
    volatile LAS unsigned* st;
};

__device__ __forceinline__ XcdBarrier xcd_barrier_post(unsigned* bar, volatile LAS unsigned* st, const bool t0) {
    XcdBarrier b; b.bar = bar; b.x = xb_xcc_id(); b.st = st;
    if (t0) (void)xb_add(&bar[XB_XCNT(b.x)], 1u);
    return b;
}
__device__ __forceinline__ void xcd_barrier_complete(unsigned* bar, unsigned x, unsigned& nloc, unsigned& nx) {
    const unsigned G = gridDim.x * gridDim.y * gridDim.z;
    unsigned sum, cnt, mine, sp = 0u;
    for (;;) {
        sum = 0u; cnt = 0u; mine = 0u;
#pragma unroll
        for (unsigned j = 0; j < 16; ++j) { const unsigned c = xb_ld(&bar[XB_XCNT(j)]); sum += c; cnt += (c > 0u) ? 1u : 0u; mine = (j == x) ? c : mine; }
        if (sum == G) break;
        __builtin_amdgcn_s_sleep(1);
        if ((++sp & 255u) == 0u) { if (xb_ld(&bar[XB_TMO])) break; if (sp > XB_SPIN_CAP) { atomicAdd(&bar[XB_TMO], 1u); break; } }
    }
    nloc = mine > 0u ? mine : 1u; nx = cnt > 0u ? cnt : 1u;
}

__device__ __forceinline__ void xcd_barrier(const XcdBarrier& b, const bool t0) {
    asm volatile("s_waitcnt vmcnt(0)" ::: "memory");
    __syncthreads();
    if (t0) {
        unsigned* bar = b.bar;
        __builtin_amdgcn_s_waitcnt(0);
        unsigned nloc = b.st[0], nx = b.st[1];
        if (nloc == 0u) { xcd_barrier_complete(bar, b.x, nloc, nx); b.st[0] = nloc; b.st[1] = nx; }
        const unsigned old = xb_add(&bar[XB_XSUB(b.x)], 1u);
        const unsigned gen = old / nloc;
        if (old + 1u == (gen + 1u) * nloc) {
            __builtin_amdgcn_fence(__ATOMIC_RELEASE, "agent");
            asm volatile("s_waitcnt vmcnt(0)" ::: "memory");
            const unsigned og = xb_add(&bar[XB_TOP], 1u);
            const unsigned tg = og / nx;
            if (og + 1u == (tg + 1u) * nx) xb_add(&bar[XB_TOPGEN], 1u);
            else XB_SPIN(xb_ld(&bar[XB_TOPGEN]) == tg, bar);
            __builtin_amdgcn_fence(__ATOMIC_ACQUIRE, "agent");
            xb_add(&bar[XB_XGEN(b.x)], 1u);
            asm volatile("s_waitcnt vmcnt(0)" ::: "memory");
        } else {
            XB_SPIN(xb_ld(&bar[XB_XGEN(b.x)]) == gen, bar);
            __builtin_amdgcn_fence(__ATOMIC_ACQUIRE, "agent");
            asm volatile("s_waitcnt vmcnt(0)" ::: "memory");
        }
    }
    __syncthreads();
}

__device__ __forceinline__ void xcd_barrier_fast(const XcdBarrier& b, const bool t0) {
    asm volatile("s_waitcnt vmcnt(0)" ::: "memory");
    __syncthreads();
    if (t0) {
        unsigned* bar = b.bar; asm volatile("" : "+s"(bar));
        __builtin_amdgcn_s_waitcnt(0);
        unsigned nloc = b.st[0], nx = b.st[1];
        unsigned bx_ = b.x; asm volatile("" : "+s"(bx_));
        const unsigned old = xb_add(&bar[XB_XSUB(bx_)], 1u);
        const unsigned gen = old / nloc;
        if (old + 1u == (gen + 1u) * nloc) {
            __builtin_amdgcn_fence(__ATOMIC_RELEASE, "agent");
            asm volatile("s_waitcnt vmcnt(0)" ::: "memory");
            const unsigned og = xb_add(&bar[XB_TOP], 1u);
            const unsigned tg = og / nx;
            if (og + 1u == (tg + 1u) * nx) xb_add(&bar[XB_TOPGEN], 1u);
            else XB_SPIN(xb_ld(&bar[XB_TOPGEN]) == tg, bar);
            __builtin_amdgcn_fence(__ATOMIC_ACQUIRE, "agent");
            xb_add(&bar[XB_XGEN(bx_)], 1u);
            asm volatile("s_waitcnt vmcnt(0)" ::: "memory");
        } else {
            XB_SPIN(xb_ld(&bar[XB_XGEN(bx_)]) == gen, bar);
            __builtin_amdgcn_fence(__ATOMIC_ACQUIRE, "agent");
            asm volatile("s_waitcnt vmcnt(0)" ::: "memory");
        }
    }
    __syncthreads();
}

constexpr int CW_BAR = 4096;
struct Args { const float* in[26]; float* out; unsigned char* ws; };
#ifndef REP_ATT
#define REP_ATT 1
#endif
#ifndef REP_GEMM
#define REP_GEMM 1
#endif
#ifndef REP_HY
#define REP_HY 1
#endif
#ifndef REP_FILT
#define REP_FILT 1
#endif
#ifndef REP_MISC
#define REP_MISC 1
#endif
#ifndef PROBE_MASK
#define PROBE_MASK 0
#endif
#define TIC() do { if (PROBE_MASK) pr_t0 = __builtin_amdgcn_s_memrealtime(); } while (0)
#define TOC(ph) do { if (PROBE_MASK & (1u << (ph))) pr_acc += __builtin_amdgcn_s_memrealtime() - pr_t0; } while (0)
#define REPEAT(n) _Pragma("unroll 1") for (int rep_ = 0; rep_ < (n); ++rep_)
#define REFRESH() do { const int t_ = tid_from_wave(F.wave0); F.tid = t_; F.lane = t_ & 63; F.wave = __builtin_amdgcn_readfirstlane(t_ >> 6); int v_ = F.vcu; asm volatile("" : "+s"(v_)); F.vcu = v_; } while (0)
#define BXQ() ({ int b_ = (int)blockIdx.x; asm volatile("" : "+s"(b_)); b_; })
#define GEMM_PHASE(EPI, g, S, E) REPEAT(REP_GEMM) pg8::gemm_phase<EPI, pg8::StaticOrder, true, true>(F.lds + RING_OFF, g, S, E, F.wave0)

__global__ void __launch_bounds__(NTHR, 2) hyena_mla_fwd(Args args) {
    extern __shared__ __attribute__((aligned(16))) unsigned char lds[];
    Frame F;
    F.lds = (LAS unsigned char*)lds;
    F.MISC = (volatile LAS unsigned*)(F.lds + MISC_OFF);
    F.tid = threadIdx.x; F.lane = F.tid & 63; F.wave = __builtin_amdgcn_readfirstlane(F.tid >> 6); F.wave0 = F.wave;
    F.G = gridDim.x; { const int bx = blockIdx.x; F.vcu = (F.G % 8 == 0) ? (bx % 8) * (F.G / 8) + bx / 8 : bx; }
    F.ws = args.ws; F.out = args.out; F.ctl = (gu32*)(args.ws + WS_CTL);
    if (F.tid == 0) {
#pragma unroll
        for (int i = 0; i < 26; ++i) *(LAS unsigned long long*)(F.lds + PTRTAB_OFF + 8 * i) = (unsigned long long)args.in[i];
    }
    for (int u = F.tid; u < 512 / 4; u += NTHR) ((LAS unsigned*)(F.lds + LDSCTL_OFF))[u] = 0u;
    __syncthreads();
    XcdBarrier bar = xcd_barrier_post((unsigned*)(F.ctl + CW_BAR), F.MISC + 8, F.tid == 0);
    xcd_barrier(bar, F.tid == 0);
    unsigned long long pr_t0 = 0, pr_acc = 0; (void)pr_t0;
#pragma unroll 1
    for (int l = 0; l < DEPTH; ++l) {
        TIC();
        REPEAT(REP_MISC) { REFRESH(); phase_weights(F, l); }
        __syncthreads();
        REFRESH(); phase_filter_mlp(F, l);
        if (l == 0) { REFRESH(); phase_rope_tab(F); REFRESH(); phase_norm_first(F, 0, inp(F, I_NMIXPRE)); }
        { REFRESH(); xcd_barrier_fast(bar, F.tid == 0); } TOC(0); TIC();
        { unsigned char* w = (unsigned char*)wsq(F); pg8::Gemm g{(bf16*)(w + WS_W3T), (bf16*)(w + WS_H2), 2048, L, 128}; pg8::StaticOrder S; S.init(2048, L, F.G, BXQ());
          pg8::EpiTaps E{(float*)(w + WS_KT), (const float*)inp(F, I_DECAY) + (size_t)l * 2048}; GEMM_PHASE(pg8::EpiTaps, g, S, E); }
        { REFRESH(); xcd_barrier_fast(bar, F.tid == 0); } TOC(1); TIC();
        REPEAT(REP_FILT) { REFRESH(); phase_filter_fft(F, l); }
        { REFRESH(); xcd_barrier_fast(bar, F.tid == 0); } TOC(2); TIC();
        { unsigned char* w = (unsigned char*)wsq(F); bf16* WinT = (bf16*)(w + WS_WIN); bf16* XN = (bf16*)(w + WS_XN); bf16* UT = (bf16*)(w + WS_UT); bf16* CQKV = (bf16*)(w + WS_CQKV);
          { pg8::Gemm g{WinT, XN, HYP, M, D}; pg8::StaticOrder S; S.init(HYP, M, F.G, BXQ());
          pg8::EpiBf16<0> E{UT, M, nullptr, 0, 0, 1.f}; GEMM_PHASE(pg8::EpiBf16<0>, g, S, E); }
        { pg8::Gemm g{XN, WinT + (size_t)HYP * D, M, 512, D}; pg8::StaticOrder S; S.init(M, 512, F.G, (BXQ() + 128) % F.G);
          pg8::EpiBf16<0> E{CQKV, 512, nullptr, 0, 0, 1.f}; GEMM_PHASE(pg8::EpiBf16<0>, g, S, E); } }
        { REFRESH(); xcd_barrier_fast(bar, F.tid == 0); } TOC(3); TIC();
        REPEAT(REP_MISC) { REFRESH(); phase_mla_prep(F, l); }
        REPEAT(REP_HY) { REFRESH(); phase_hyena(F, l); }
        { REFRESH(); xcd_barrier_fast(bar, F.tid == 0); } TOC(4); TIC();
        { unsigned char* w = (unsigned char*)wsq(F); bf16* CQN = (bf16*)(w + WS_CQN); bf16* CKVN = (bf16*)(w + WS_CKVN); bf16* WuqT = (bf16*)(w + WS_WUQ); bf16* WukvT = (bf16*)(w + WS_WUKV);
          bf16* Qb = (bf16*)(w + WS_Q); bf16* KV = (bf16*)(w + WS_KN);
          { pg8::Gemm g{CQN, WuqT, M, NQ, QR}; pg8::StaticOrder S; S.init(M, NQ, F.G, BXQ());
          pg8::EpiBf16<0> E{Qb, NQ, nullptr, 0, 0, 1.f}; GEMM_PHASE(pg8::EpiBf16<0>, g, S, E); }
        { pg8::Gemm g{CKVN, WukvT, M, NKV, KVR}; pg8::StaticOrder S; S.init(M, NKV, F.G, BXQ());
          pg8::EpiBf16<0> E{KV, NKV, nullptr, 0, 0, 1.f}; GEMM_PHASE(pg8::EpiBf16<0>, g, S, E); } }
        { REFRESH(); xcd_barrier_fast(bar, F.tid == 0); } TOC(5); TIC();
        REFRESH();
        { unsigned char* w = (unsigned char*)wsq(F); bf16* Qb = (bf16*)(w + WS_Q); bf16* KV = (bf16*)(w + WS_KN); bf16* KPE = (bf16*)(w + WS_KPE); bf16* MIX = (bf16*)(w + WS_MIX);
          const float* ct = (const float*)(w + WS_COS); const float* st = (const float*)(w + WS_SIN); const float* gat = (const float*)inp(F, I_GNAT) + l * 512;
        REPEAT(REP_ATT) for (int i = 0; i < (F.G == 256 ? 6 : (1536 - F.vcu + F.G - 1) / F.G); ++i) {
            const int u_ = F.vcu + i * F.G; const int bh = F.G == 256 ? 3 * (F.vcu >> 5) + (i >> 1) : u_ >> 6, qb = F.G == 256 ? (i & 1) * 32 + (F.vcu & 31) : u_ & 63; const int b = bh >> 3, h = bh & 7;
            const size_t row0 = (size_t)b * L + (size_t)qb * 256;
            att::attn_unit<0>(Qb + row0 * NQ + h * DQ, KV + (size_t)b * L * NKV + h * 128, KPE + (size_t)b * L * ROPE, KV + (size_t)b * L * NKV + h * 128 + 64,
                           MIX + row0 * D + 512 + h * 64, gat + h * 64, ct, st, qb * 256, (LAS char*)(F.lds + RING_OFF), F.wave0);
        } }
        REPEAT(REP_MISC) { REFRESH(); phase_hy_out(F, l); }
        { REFRESH(); xcd_barrier_fast(bar, F.tid == 0); } TOC(6); TIC();
        { unsigned char* w = (unsigned char*)wsq(F); bf16* MIX = (bf16*)(w + WS_MIX); bf16* WoutT = (bf16*)(w + WS_WOUT); bf16* T = (bf16*)(w + WS_T);
          pg8::Gemm g{MIX, WoutT, M, D, D}; pg8::StaticOrder S; S.init(M, D, F.G, BXQ());
          pg8::EpiBf16<0> E{T, D, nullptr, 0, 0, 1.f}; GEMM_PHASE(pg8::EpiBf16<0>, g, S, E); }
        { REFRESH(); xcd_barrier_fast(bar, F.tid == 0); } TOC(7); TIC();
        REFRESH(); phase_norm_res(F, l, (const GAS bf16*)(wsq(F) + WS_T), inp(F, I_NMIXPOST) + l * D, inp(F, I_NMLPPRE) + l * D);
        { REFRESH(); xcd_barrier_fast(bar, F.tid == 0); } TOC(8); TIC();
#pragma unroll 1
        for (int ch = 0; ch < N_MLP_CHUNKS; ++ch) {
            { unsigned char* w = (unsigned char*)wsq(F); bf16* XN = (bf16*)(w + WS_XN); bf16* WupT = (bf16*)(w + WS_WUP); bf16* Hb = (bf16*)(w + WS_H);
              pg8::Gemm g{XN + (size_t)ch * MLP_CHUNK * D, WupT, MLP_CHUNK, FF, D}; pg8::StaticOrder S; S.init(MLP_CHUNK, FF, F.G, BXQ());
              pg8::EpiRelu2 E{Hb, FF}; GEMM_PHASE(pg8::EpiRelu2, g, S, E); }
            { REFRESH(); xcd_barrier_fast(bar, F.tid == 0); } TOC(9); TIC();
            { unsigned char* w = (unsigned char*)wsq(F); bf16* Hb = (bf16*)(w + WS_H); bf16* WdownT = (bf16*)(w + WS_WDOWN); bf16* T = (bf16*)(w + WS_T);
              pg8::Gemm g{Hb, WdownT, MLP_CHUNK, D, FF}; pg8::StaticOrder S; S.init(MLP_CHUNK, D, F.G, BXQ());
              pg8::EpiBf16<0> E{T + (size_t)ch * MLP_CHUNK * D, D, nullptr, 0, 0, 1.f}; GEMM_PHASE(pg8::EpiBf16<0>, g, S, E); }
            { REFRESH(); xcd_barrier_fast(bar, F.tid == 0); } TOC(10); TIC();
        }
        REFRESH(); phase_norm_res(F, 1, (const GAS bf16*)(wsq(F) + WS_T), inp(F, I_NMLPPOST) + l * D, (l + 1 < DEPTH) ? inp(F, I_NMIXPRE) + (l + 1) * D : (const GAS float*)nullptr);
        { REFRESH(); xcd_barrier_fast(bar, F.tid == 0); } TOC(11); TIC();
    }
    if (HYSUB) { __syncthreads(); pr_acc += (unsigned long long)__builtin_amdgcn_readfirstlane((int)F.MISC[21]); }
    if (PROBE_MASK || HYSUB) { const unsigned long long ts = __builtin_amdgcn_s_memrealtime(); while (__builtin_amdgcn_s_memrealtime() - ts < pr_acc) __builtin_amdgcn_s_sleep(8); }
}


#ifdef ATT_BENCH
__global__ void __launch_bounds__(NTHR, 2) attn_bench(Args args) {
    extern __shared__ __attribute__((aligned(16))) unsigned char lds[];
    unsigned char* w = args.ws; const int wave0 = __builtin_amdgcn_readfirstlane(threadIdx.x >> 6);
    const int G = gridDim.x, bxv = (int)blockIdx.x, vcu = (bxv % 8) * (G / 8) + bxv / 8;
    bf16* Qb = (bf16*)(w + WS_Q); bf16* KV = (bf16*)(w + WS_KN); bf16* KPE = (bf16*)(w + WS_KPE); bf16* OUT = (bf16*)(w + WS_H);
    const float* ct = (const float*)(w + WS_COS); const float* st = (const float*)(w + WS_SIN);
    for (int rep = 0; rep < ATT_BENCH_REPS; ++rep)
    for (int i = 0; i < 6; ++i) {
        const int bh = 3 * (vcu >> 5) + (i >> 1), qb = (i & 1) * 32 + (vcu & 31); const int b = bh >> 3, h = bh & 7;
        const size_t row0 = (size_t)b * L + (size_t)qb * 256;
        att::attn_unit<ATT_BENCH>(Qb + row0 * NQ + h * DQ, KV + (size_t)b * L * NKV + h * 128, KPE + (size_t)b * L * ROPE, KV + (size_t)b * L * NKV + h * 128 + 64,
                       OUT + row0 * D + 512 + h * 64, args.in[I_GNAT] + h * 64, ct, st, qb * 256, (LAS char*)lds, wave0);
    }
}
#endif
extern "C" void kernel_launch(void* const* d_in, const int* in_sizes, int n_in, void* d_out, int out_size, void* d_ws, size_t ws_size, hipStream_t stream) {
    static int grid = 0;
    if (grid == 0) {
        if (n_in != 26 || out_size != M * D || ws_size < WS_END) { fprintf(stderr, "kernel_launch: shape mismatch n_in %d out %d ws %zu (need %zu)\n", n_in, out_size, ws_size, (size_t)WS_END); grid = -1; return; }
        int dev = 0, cus = 0, per_cu = 0;
        if (hipGetDevice(&dev) != hipSuccess || hipDeviceGetAttribute(&cus, hipDeviceAttributeMultiprocessorCount, dev) != hipSuccess) { grid = -1; return; }
        if (hipFuncSetAttribute((const void*)hyena_mla_fwd, hipFuncAttributeMaxDynamicSharedMemorySize, LDS_BYTES) != hipSuccess) { fprintf(stderr, "kernel_launch: hipFuncSetAttribute failed\n"); grid = -1; return; }
        if (hipOccupancyMaxActiveBlocksPerMultiprocessor(&per_cu, (const void*)hyena_mla_fwd, NTHR, LDS_BYTES) != hipSuccess || per_cu < 1) fprintf(stderr, "kernel_launch: occupancy query says %d\n", per_cu);
        (void)hipGetLastError();
        grid = cus;
    }
    if (grid < 0) return;
    if (hipMemsetAsync((char*)d_ws + WS_CTL, 0, CTL_ZERO_BYTES, stream) != hipSuccess) { fprintf(stderr, "kernel_launch: memset failed\n"); return; }
    Args a{};
    for (int i = 0; i < 26; ++i) a.in[i] = (const float*)d_in[i];
    a.out = (float*)d_out; a.ws = (unsigned char*)d_ws;
    hipLaunchKernelGGL(hyena_mla_fwd, dim3(grid), dim3(NTHR), LDS_BYTES, stream, a);
#ifdef ATT_BENCH
    { static int once = 0; if (!once) { (void)hipFuncSetAttribute((const void*)attn_bench, hipFuncAttributeMaxDynamicSharedMemorySize, LDS_BYTES); once = 1; }
      hipLaunchKernelGGL(attn_bench, dim3(grid), dim3(NTHR), LDS_BYTES, stream, a); }
#endif
    const hipError_t le = hipPeekAtLastError();
    if (le != hipSuccess) fprintf(stderr, "kernel_launch: launch failed: %s\n", hipGetErrorName(le));
}
```

```cpp
#include <hip/hip_runtime.h>
#include <cstdio>
#include <cstdint>
__device__ __forceinline__ int hw_lane() { int l; asm volatile("v_mbcnt_lo_u32_b32 %0, -1, 0\n\tv_mbcnt_hi_u32_b32 %0, -1, %0" : "=v"(l)); return l; }
__device__ __forceinline__ int tid_from_wave(int wave0) { int w = wave0; asm volatile("" : "+s"(w)); int t = w * 64 + hw_lane(); asm volatile("" : "+v"(t)); return t; }
namespace pg8 {
#define PG8_LAS __attribute__((address_space(3)))
#define PG8_GAS __attribute__((address_space(1)))
typedef unsigned short bf16_t;
typedef short bf16x8 __attribute__((ext_vector_type(8)));
typedef float f32x4 __attribute__((ext_vector_type(4)));
typedef unsigned u32x4 __attribute__((ext_vector_type(4)));
constexpr int BM = 256, BK = 64, HALF = 128, HTB = HALF * BK * 2  , STAGE_BYTES = 8 * HTB, NXCD = 8, WGM = 8;

__host__ __device__ __forceinline__ int lds_byte(int r, int c) { const int st = (r >> 4) * 2 + (c >> 5), rr = r & 15, cc = c & 31, ob = rr * 64 + cc * 2; return st * 1024 + (ob ^ (((ob >> 9) & 1) << 5)); }
__host__ __device__ __forceinline__ void stage_rc(int b, int& R, int& C) { const int st = b / 1024, sb = b % 1024, swz = sb ^ (((sb >> 9) & 1) << 5); R = (st >> 1) * 16 + swz / 64; C = (st & 1) * 32 + (swz % 64) / 2; }
__host__ __device__ __forceinline__ int perm32(int rho) { const int n = rho >> 4, i = rho & 15; return 8 * (i >> 2) + 4 * n + (i & 3); }

struct Unit { int pm, pn; };
struct Gemm { const bf16_t* A; const bf16_t* Bt; int M, N, K; };

struct StaticOrder {
    int nM, nN, nwg, G, c;
    __host__ __device__ void init(int M, int N, int G_, int c_) { nM = M / BM; nN = N / BM; nwg = nM * nN; G = G_; c = c_; }
    __host__ __device__ bool next(int i, Unit& u) const {
        const long L = (long)i * G + c; if (L >= nwg) return false;
        int wgid = (int)L; { const int q = nwg / NXCD, r = nwg % NXCD, xcd = wgid % NXCD, off = wgid / NXCD; wgid = (xcd < r ? xcd * (q + 1) : r * (q + 1) + (xcd - r) * q) + off; }
        const int nig = WGM * nN, gid = wgid / nig, fm = gid * WGM, gsz = (nM - fm) < WGM ? (nM - fm) : WGM;
        u.pm = fm + ((wgid % nig) % gsz); u.pn = (wgid % nig) / gsz; return true;
    }
    __device__ __forceinline__ void a_ready(const Unit&) const {}
    __device__ __forceinline__ void done(const Unit&) const {}
};

__device__ __forceinline__ unsigned cvt_pk_bf16(float lo, float hi) { unsigned r; asm volatile("v_cvt_pk_bf16_f32 %0, %1, %2" : "=v"(r) : "v"(lo), "v"(hi)); return r; }
typedef float f32x2 __attribute__((ext_vector_type(2)));
__device__ __forceinline__ void relane(int& wr, int& wc, int& fr, int& fq) { int l = hw_lane(); asm volatile("" : "+v"(l)); fr = l & 15; fq = l >> 4; (void)wr; (void)wc; }
__device__ __forceinline__ f32x2 gelu_pk(f32x2 v) {
    const f32x2 av = __builtin_elementwise_abs(v), d = av * 0.2316418882f + 1.0f;
    f32x2 t; t.x = __builtin_amdgcn_rcpf(d.x); t.y = __builtin_amdgcn_rcpf(d.y);
    f32x2 q = t * 0.5307027145f + (-0.7265760135f); q = q * t + 0.7107068705f; q = q * t + (-0.142248368f); q = q * t + 0.127414796f; q = q * t;
    const f32x2 s = (v * v) * (-0.72134752044f);
    f32x2 e; e.x = __builtin_amdgcn_exp2f(s.x); e.y = __builtin_amdgcn_exp2f(s.y);
    const f32x2 m = v * (q * e), r = v - m;
    f32x2 o; o.x = v.x < 0.f ? m.x : r.x; o.y = v.y < 0.f ? m.y : r.y; return o;
}

template <int ACT  > struct EpiBf16 {
    static constexpr bool PERM = true, AFTER_DRAIN = false; static_assert(ACT == 0 || ACT == 1, "EpiBf16: ACT is 0 (none) or 1 (gelu_pk)");
    bf16_t* O; int ldc; const float* bias; int split_cols; size_t split_stride; float scale0;
    __device__ __forceinline__ void operator()(const f32x4 (&acc)[2][2][4][2], const Unit& u, int wr, int wc, int fr, int fq) const {
        relane(wr, wc, fr, fq);
        const int row0 = u.pm * BM + wr * 64 + fr; int colt = u.pn * BM; bf16_t* base = O;
        float sc = 1.f; if (split_cols) { const int t = colt / split_cols; base += (size_t)t * split_stride; colt -= t * split_cols; if (t == 0) sc = scale0; }
        const int col0 = colt + wc * 32 + 8 * fq, bcol0 = u.pn * BM + wc * 32 + 8 * fq;
        f32x4 bv[2][2];
#pragma unroll
        for (int bj = 0; bj < 2; ++bj)
#pragma unroll
            for (int n = 0; n < 2; ++n) bv[bj][n] = bias ? *(const PG8_GAS f32x4*)(bias + bcol0 + bj * HALF + 4 * n) : (f32x4){0.f, 0.f, 0.f, 0.f};
#pragma unroll
        for (int ai = 0; ai < 2; ++ai)
#pragma unroll
            for (int m = 0; m < 4; ++m) { bf16_t* rowp = base + (size_t)(row0 + ai * HALF + m * 16) * ldc + col0;
#pragma unroll
                for (int bj = 0; bj < 2; ++bj) { f32x4 v0 = acc[ai][bj][m][0] + bv[bj][0], v1 = acc[ai][bj][m][1] + bv[bj][1];
                    if (ACT == 1) { f32x2 a = gelu_pk((f32x2){v0[0], v0[1]}), b = gelu_pk((f32x2){v0[2], v0[3]}), c = gelu_pk((f32x2){v1[0], v1[1]}), d = gelu_pk((f32x2){v1[2], v1[3]});
                        v0 = (f32x4){a.x, a.y, b.x, b.y}; v1 = (f32x4){c.x, c.y, d.x, d.y}; }
                    v0 = v0 * sc; v1 = v1 * sc; u32x4 w; w.x = cvt_pk_bf16(v0[0], v0[1]); w.y = cvt_pk_bf16(v0[2], v0[3]); w.z = cvt_pk_bf16(v1[0], v1[1]); w.w = cvt_pk_bf16(v1[2], v1[3]);
                    *(PG8_GAS u32x4*)(rowp + bj * HALF) = w; } }
    }
};

struct PanelStats {
    unsigned* xbuf;
    unsigned* cnt;
    unsigned* tmo;
    int ntn; float eps;
    unsigned code;
    __device__ __forceinline__ bool run(const f32x4 (&v)[2][2][4][2], const Unit& u, int wr, int wc, int fr, int fq, PG8_LAS unsigned char* lds, int wid, int lane) const {
        typedef float f32x2v __attribute__((ext_vector_type(2)));
        PG8_LAS f32x2v* P = (PG8_LAS f32x2v*)lds;
        PG8_LAS f32x2v* S = (PG8_LAS f32x2v*)(lds + 8192);
        PG8_LAS unsigned* flag = (PG8_LAS unsigned*)(lds + 8192 + 2048);
#pragma unroll
        for (int ai = 0; ai < 2; ++ai)
#pragma unroll
            for (int m = 0; m < 4; ++m) {
                float s = 0.f;
#pragma unroll
                for (int bj = 0; bj < 2; ++bj)
#pragma unroll
                    for (int n = 0; n < 2; ++n) { const f32x4 x = v[ai][bj][m][n]; s += (x[0] + x[1]) + (x[2] + x[3]); }
                s += __shfl_xor(s, 16); s += __shfl_xor(s, 32);
                const float mw = s * (1.0f / 64.0f); float q = 0.f;
#pragma unroll
                for (int bj = 0; bj < 2; ++bj)
#pragma unroll
                    for (int n = 0; n < 2; ++n) { const f32x4 d = v[ai][bj][m][n] - mw; q += (d[0] * d[0] + d[1] * d[1]) + (d[2] * d[2] + d[3] * d[3]); }
                q += __shfl_xor(q, 16); q += __shfl_xor(q, 32);
                if (fq == 0) P[(ai * HALF + wr * 64 + m * 16 + fr) * 4 + wc] = (f32x2v){mw, q};
            }
        asm volatile("s_waitcnt lgkmcnt(0)" ::: "memory"); __builtin_amdgcn_s_barrier(); asm volatile("" ::: "memory");
#if defined(BROKEN_EXCHANGE_NO_WAIT)
#warning BROKEN CONTROL BUILD: the row-statistics exchange does not wait; results are wrong by design
        if (blockIdx.x >= 64) { const long long t0_ = clock64(); while (clock64() - t0_ < 60000) __builtin_amdgcn_s_sleep(8); }
#endif
        const int row = wid * 32 + (lane & 31);
        if (lane < 32) {
            const f32x2v a = P[row * 4 + 0], b = P[row * 4 + 1], c = P[row * 4 + 2], d = P[row * 4 + 3];
            const float mt = (a.x + b.x + c.x + d.x) * 0.25f;
            const float da = a.x - mt, db = b.x - mt, dc = c.x - mt, dd = d.x - mt;
            const float m2 = (a.y + b.y) + (c.y + d.y) + 64.0f * ((da * da + db * db) + (dc * dc + dd * dd));
            unsigned long long* slot = (unsigned long long*)xbuf + ((size_t)(u.pm * BM + row) * 4 + u.pn);
            __hip_atomic_store(slot, ((unsigned long long)__float_as_uint(m2) << 32) | __float_as_uint(mt), __ATOMIC_RELAXED, __HIP_MEMORY_SCOPE_AGENT);
        }
        asm volatile("s_waitcnt vmcnt(0)" ::: "memory");
        if (lane == 0) __hip_atomic_fetch_add(cnt + 64 * u.pm, 1u, __ATOMIC_RELAXED, __HIP_MEMORY_SCOPE_AGENT);
        if (wid == 0) {
            bool dead = false; const unsigned long long t0 = __builtin_amdgcn_s_memrealtime(); const unsigned want = 8u * (unsigned)ntn;
            for (;;) {
#if defined(BROKEN_EXCHANGE_NO_WAIT)
                break;
#endif
                if ((unsigned)__builtin_amdgcn_readfirstlane(__hip_atomic_load(cnt + 64 * u.pm, __ATOMIC_RELAXED, __HIP_MEMORY_SCOPE_AGENT)) >= want) break;
                if (__builtin_amdgcn_s_memrealtime() - t0 > 2000000ull) {
                    if (lane == 0) { unsigned expect = 0u; __hip_atomic_compare_exchange_strong(tmo + 1, &expect, code | (unsigned)(u.pm & 0xff), __ATOMIC_RELAXED, __ATOMIC_RELAXED, __HIP_MEMORY_SCOPE_AGENT);
                                     __hip_atomic_store(tmo, 1u, __ATOMIC_RELAXED, __HIP_MEMORY_SCOPE_AGENT); }
                    dead = true; break; }
                __builtin_amdgcn_s_sleep(2);
            }
            __builtin_amdgcn_fence(__ATOMIC_ACQUIRE, "agent");
            if (lane == 0) flag[0] = dead ? 1u : 0u;
        }
        asm volatile("s_waitcnt vmcnt(0) lgkmcnt(0)" ::: "memory"); __builtin_amdgcn_s_barrier(); asm volatile("" ::: "memory");
        const bool bad = flag[0] != 0u;
        if (lane < 32) {
            const unsigned long long* slot = (const unsigned long long*)xbuf + (size_t)(u.pm * BM + row) * 4; float mt[4], m2[4]; float ms = 0.f;
#pragma unroll
            for (int t = 0; t < 4; ++t) { if (t < ntn) { const unsigned long long w = __hip_atomic_load(slot + t, __ATOMIC_RELAXED, __HIP_MEMORY_SCOPE_AGENT); mt[t] = __uint_as_float((unsigned)w); m2[t] = __uint_as_float((unsigned)(w >> 32)); } else { mt[t] = 0.f; m2[t] = 0.f; } ms += mt[t]; }
            const float mean = ms / (float)ntn; float q = 0.f;
#pragma unroll
            for (int t = 0; t < 4; ++t) if (t < ntn) { const float dm = mt[t] - mean; q += m2[t] + 256.0f * dm * dm; }
            S[row] = (f32x2v){mean, 1.0f / sqrtf(q / (256.0f * (float)ntn) + eps)};
        }
        asm volatile("s_waitcnt lgkmcnt(0)" ::: "memory"); __builtin_amdgcn_s_barrier(); asm volatile("" ::: "memory");
        return bad;
    }
};
struct EpiLnRes {
    static constexpr bool PERM = false, AFTER_DRAIN = true;
    const float* base; float* out; int ldc; const float* bias; PanelStats st; unsigned poison;
    __device__ __forceinline__ void fused(f32x4 (&acc)[2][2][4][2], const Unit& u, int wr, int wc, int fr, int fq, PG8_LAS unsigned char* lds, int wid, int lane) const {
        typedef float f32x2v __attribute__((ext_vector_type(2)));
        const PG8_LAS f32x2v* S = (const PG8_LAS f32x2v*)(lds + 8192);
        const int col0 = u.pn * BM + wc * 32 + 4 * fq;
#pragma unroll
        for (int bj = 0; bj < 2; ++bj)
#pragma unroll
            for (int n = 0; n < 2; ++n) { const f32x4 bv = bias ? *(const f32x4*)(bias + col0 + bj * HALF + n * 16) : (f32x4){0.f, 0.f, 0.f, 0.f};
#pragma unroll
                for (int ai = 0; ai < 2; ++ai)
#pragma unroll
                    for (int m = 0; m < 4; ++m) acc[ai][bj][m][n] += bv; }
        f32x4 pre[4][2][2];
#pragma unroll
        for (int m = 0; m < 4; ++m) { const size_t off = (size_t)(u.pm * BM + wr * 64 + m * 16 + fr) * ldc + col0;
#pragma unroll
            for (int bj = 0; bj < 2; ++bj)
#pragma unroll
                for (int n = 0; n < 2; ++n) pre[m][bj][n] = *(const f32x4*)(base + off + bj * HALF + n * 16); }
        const bool bad = st.run(acc, u, wr, wc, fr, fq, lds, wid, lane) || poison != 0u;
        const float qnan = __builtin_nanf("");
#pragma unroll
        for (int ai = 0; ai < 2; ++ai)
#pragma unroll
            for (int m = 0; m < 4; ++m) { const int r = ai * HALF + wr * 64 + m * 16 + fr; const f32x2v sr = S[r]; const size_t off = (size_t)(u.pm * BM + r) * ldc + col0;
#pragma unroll
                for (int bj = 0; bj < 2; ++bj)
#pragma unroll
                    for (int n = 0; n < 2; ++n) { const f32x4 bs = ai == 0 ? pre[m][bj][n] : *(const f32x4*)(base + off + bj * HALF + n * 16); f32x4 o = bs + (acc[ai][bj][m][n] - sr.x) * sr.y;
                        if (bad) o = (f32x4){qnan, qnan, qnan, qnan}; *(f32x4*)(out + off + bj * HALF + n * 16) = o; }
                if (m & 1) asm volatile("" ::: "memory"); }
    }
};
struct EpiLnResLn {
    static constexpr bool PERM = false, AFTER_DRAIN = true;
    const float* base; float* out; bf16_t* xn; int ldc; const float* bias; PanelStats st1, st2; unsigned poison;
    __device__ __forceinline__ void fused(f32x4 (&acc)[2][2][4][2], const Unit& u, int wr, int wc, int fr, int fq, PG8_LAS unsigned char* lds, int wid, int lane) const {
        typedef float f32x2v __attribute__((ext_vector_type(2))); typedef unsigned u32x2v __attribute__((ext_vector_type(2)));
        const PG8_LAS f32x2v* S = (const PG8_LAS f32x2v*)(lds + 8192);
        const int col0 = u.pn * BM + wc * 32 + 4 * fq;
#pragma unroll
        for (int bj = 0; bj < 2; ++bj)
#pragma unroll
            for (int n = 0; n < 2; ++n) { const f32x4 bv = bias ? *(const f32x4*)(bias + col0 + bj * HALF + n * 16) : (f32x4){0.f, 0.f, 0.f, 0.f};
#pragma unroll
                for (int ai = 0; ai < 2; ++ai)
#pragma unroll
                    for (int m = 0; m < 4; ++m) acc[ai][bj][m][n] += bv; }
        bool bad = st1.run(acc, u, wr, wc, fr, fq, lds, wid, lane) || poison != 0u;
        const float qnan = __builtin_nanf("");
#pragma unroll
        for (int ai = 0; ai < 2; ++ai)
#pragma unroll
            for (int m = 0; m < 4; ++m) { const int r = ai * HALF + wr * 64 + m * 16 + fr; const f32x2v sr = S[r]; const size_t off = (size_t)(u.pm * BM + r) * ldc + col0;
#pragma unroll
                for (int bj = 0; bj < 2; ++bj)
#pragma unroll
                    for (int n = 0; n < 2; ++n) { const f32x4 bs = *(const f32x4*)(base + off + bj * HALF + n * 16); acc[ai][bj][m][n] = bs + (acc[ai][bj][m][n] - sr.x) * sr.y; }
                asm volatile("" : "+v"(acc[ai][0][m][0]), "+v"(acc[ai][0][m][1]), "+v"(acc[ai][1][m][0]), "+v"(acc[ai][1][m][1]));
                if (m & 1) asm volatile("" ::: "memory"); }
        const bool bad1 = bad;
        bad = st2.run(acc, u, wr, wc, fr, fq, lds, wid, lane) || bad;
#pragma unroll
        for (int ai = 0; ai < 2; ++ai)
#pragma unroll
            for (int m = 0; m < 4; ++m) { const int r = ai * HALF + wr * 64 + m * 16 + fr; const f32x2v sr = S[r]; const size_t off = (size_t)(u.pm * BM + r) * ldc + col0;
#pragma unroll
                for (int bj = 0; bj < 2; ++bj)
#pragma unroll
                    for (int n = 0; n < 2; ++n) { const f32x4 x1 = acc[ai][bj][m][n]; *(f32x4*)(out + off + bj * HALF + n * 16) = bad1 ? (f32x4){qnan, qnan, qnan, qnan} : x1;
                        const f32x4 o = (x1 - sr.x) * sr.y; u32x2v w; w.x = cvt_pk_bf16(o[0], o[1]); w.y = cvt_pk_bf16(o[2], o[3]);
                        if (bad) { w.x = 0x7fc07fc0u; w.y = 0x7fc07fc0u; } *(u32x2v*)(xn + off + bj * HALF + n * 16) = w; }
                asm volatile("" ::: "memory"); }
    }
};

template <class Epi, class Sched, bool ALIGN_EPI = false, bool SP2 = false>
__device__ __forceinline__ void gemm_phase(PG8_LAS unsigned char* lds, const Gemm g, const Sched& S, const Epi& E, const int wave0) {
    int tid_ = tid_from_wave(wave0);
    const int tid = tid_, wid = __builtin_amdgcn_readfirstlane(tid >> 6), lane = tid & 63, wr = wid >> 2, wc = wid & 3, fr = lane & 15, fq = lane >> 4;
    const int K = g.K, nt = K / BK;
    unsigned voffA[2], voffB[2];
#pragma unroll
    for (int i = 0; i < 2; ++i) { int R, C; stage_rc(tid * 16 + i * 8192, R, C); const int Rb = Epi::PERM ? ((R & ~31) + perm32(R & 31)) : R;
        voffA[i] = (unsigned)(R * K + C) * 2u; voffB[i] = (unsigned)(Rb * K + C) * 2u; }
    const size_t kstep = (size_t)(BK * 2);
    const size_t hstep = (size_t)HALF * K * 2;
    const size_t tstep = 2 * hstep;
    const unsigned ldsw = (unsigned)wid * 1024u;
    const int aoff = lds_byte(wr * 64 + fr, fq * 8), boff = lds_byte(wc * 32 + fr, fq * 8);
#define PG8_SA(b, h) (((b) * 2 + (h)) * HTB)
#define PG8_SB(b, h) ((4 + (b) * 2 + (h)) * HTB)
#define PG8_STAGE(bufoff, gbase, voff) do { _Pragma("unroll") for (int _i = 0; _i < 2; ++_i) \
        __builtin_amdgcn_global_load_lds((const unsigned*)((const char*)(gbase) + (voff)[_i]), (PG8_LAS unsigned*)(lds + (bufoff) + ldsw + _i * 8192), 16, 0, 0); } while (0)
#define PG8_LDA(dst, b, h) do { _Pragma("unroll") for (int m = 0; m < 4; ++m) _Pragma("unroll") for (int k = 0; k < 2; ++k) dst[m][k] = *(const PG8_LAS bf16x8*)(lds + PG8_SA(b, h) + aoff + m * 2048 + k * 1024); } while (0)
#define PG8_LDB(dst, b, h) do { _Pragma("unroll") for (int n = 0; n < 2; ++n) _Pragma("unroll") for (int k = 0; k < 2; ++k) dst[n][k] = *(const PG8_LAS bf16x8*)(lds + PG8_SB(b, h) + boff + n * 2048 + k * 1024); } while (0)
#define PG8_MMA(ai, bj, At, Bt) do { __builtin_amdgcn_s_setprio(1); _Pragma("unroll") for (int m = 0; m < 4; ++m) _Pragma("unroll") for (int n = 0; n < 2; ++n) _Pragma("unroll") for (int k = 0; k < 2; ++k) \
        acc[ai][bj][m][n] = __builtin_amdgcn_mfma_f32_16x16x32_bf16(Bt[n][k], At[m][k], acc[ai][bj][m][n], 0, 0, 0); __builtin_amdgcn_s_setprio(0); } while (0)
#define PG8_WAIT_V(n) asm volatile("s_waitcnt vmcnt(" #n ")" ::: "memory")
#define PG8_WAIT_L(n) asm volatile("s_waitcnt lgkmcnt(" #n ")" ::: "memory")
#define PG8_BAR __builtin_amdgcn_s_barrier()
#define PG8_SCHED __builtin_amdgcn_sched_barrier(0)
    Unit cur, nxt; int ui = 0;
    if (!S.next(0, cur)) return;
    f32x4 acc[2][2][4][2];
#pragma unroll
    for (int a = 0; a < 2; ++a)
#pragma unroll
        for (int b = 0; b < 2; ++b)
#pragma unroll
            for (int m = 0; m < 4; ++m)
#pragma unroll
                for (int n = 0; n < 2; ++n) acc[a][b][m][n] = (f32x4){0.f, 0.f, 0.f, 0.f};
    bf16x8 At[4][2], B0[2][2], B1[2][2];
    const char* cA = (const char*)g.A + (size_t)cur.pm * tstep; const char* cB = (const char*)g.Bt + (size_t)cur.pn * tstep;
    S.a_ready(cur);
    if constexpr (SP2) {
        PG8_STAGE(PG8_SB(0, 0), cB, voffB); PG8_STAGE(PG8_SB(0, 1), cB + hstep, voffB); PG8_STAGE(PG8_SA(0, 0), cA, voffA); PG8_STAGE(PG8_SA(0, 1), cA + hstep, voffA);
        if (wr == 1) PG8_BAR;
        PG8_WAIT_V(2); PG8_BAR;
        PG8_STAGE(PG8_SB(1, 0), cB + kstep, voffB); PG8_STAGE(PG8_SA(1, 0), cA + kstep, voffA); PG8_STAGE(PG8_SB(1, 1), cB + hstep + kstep, voffB);
        PG8_WAIT_V(6); PG8_BAR;
    } else {
        PG8_STAGE(PG8_SB(0, 0), cB, voffB); PG8_STAGE(PG8_SA(0, 0), cA, voffA); PG8_STAGE(PG8_SB(0, 1), cB + hstep, voffB); PG8_STAGE(PG8_SA(0, 1), cA + hstep, voffA);
        if (wr == 1) PG8_BAR;
        PG8_WAIT_V(4); PG8_BAR;
        PG8_STAGE(PG8_SB(1, 0), cB + kstep, voffB); PG8_STAGE(PG8_SA(1, 0), cA + kstep, voffA); PG8_STAGE(PG8_SB(1, 1), cB + hstep + kstep, voffB);
        PG8_WAIT_V(6); PG8_BAR;
    }
    for (;;) {
        const bool has_next = S.next(ui + 1, nxt);
        const char* nA = has_next ? (const char*)g.A + (size_t)nxt.pm * tstep : cA; const char* nB = has_next ? (const char*)g.Bt + (size_t)nxt.pn * tstep : cB;
        for (int t = 0; t < nt; t += 2) {
            const bool last = (t == nt - 2);
            const char* a1 = cA + (size_t)(t + 1) * kstep;
            const char* a2 = last ? nA : cA + (size_t)(t + 2) * kstep; const char* b2 = last ? nB : cB + (size_t)(t + 2) * kstep;
            const char* a3 = a2 + kstep; const char* b3 = b2 + kstep;
            if (last && has_next) S.a_ready(nxt);
            if constexpr (SP2) {
            PG8_LDB(B0, 0, 0); PG8_LDB(B1, 0, 1); PG8_SCHED; PG8_LDA(At, 0, 0); PG8_STAGE(PG8_SA(1, 1), a1 + hstep, voffA);
            PG8_WAIT_V(8); PG8_WAIT_L(0); PG8_BAR; PG8_MMA(0, 0, At, B0); PG8_MMA(0, 1, At, B1); PG8_BAR; PG8_SCHED;
            PG8_LDA(At, 0, 1); PG8_STAGE(PG8_SB(0, 0), b2, voffB); PG8_STAGE(PG8_SB(0, 1), b2 + hstep, voffB); PG8_STAGE(PG8_SA(0, 0), a2, voffA);
            PG8_WAIT_V(8); PG8_WAIT_L(0); PG8_BAR; PG8_MMA(1, 0, At, B0); PG8_MMA(1, 1, At, B1); PG8_BAR; PG8_SCHED;
            PG8_LDB(B0, 1, 0); PG8_LDB(B1, 1, 1); PG8_SCHED; PG8_LDA(At, 1, 0); PG8_STAGE(PG8_SA(0, 1), a2 + hstep, voffA);
            PG8_WAIT_V(8); PG8_WAIT_L(0); PG8_BAR; PG8_MMA(0, 0, At, B0); PG8_MMA(0, 1, At, B1); PG8_BAR; PG8_SCHED;
            PG8_LDA(At, 1, 1); PG8_STAGE(PG8_SB(1, 0), b3, voffB); PG8_STAGE(PG8_SB(1, 1), b3 + hstep, voffB); PG8_STAGE(PG8_SA(1, 0), a3, voffA);
            PG8_WAIT_V(8); PG8_WAIT_L(0); PG8_BAR; PG8_MMA(1, 0, At, B0); PG8_MMA(1, 1, At, B1); PG8_BAR; PG8_SCHED;
            } else {
            PG8_LDB(B0, 0, 0); PG8_SCHED; PG8_LDA(At, 0, 0); PG8_STAGE(PG8_SA(1, 1), a1 + hstep, voffA);
            PG8_WAIT_L(8); PG8_BAR; PG8_WAIT_L(0); PG8_MMA(0, 0, At, B0); PG8_BAR; PG8_SCHED;
            PG8_LDB(B1, 0, 1); PG8_STAGE(PG8_SB(0, 0), b2, voffB);
            PG8_BAR; PG8_WAIT_L(0); PG8_MMA(0, 1, At, B1); PG8_BAR;
            PG8_LDA(At, 0, 1); PG8_STAGE(PG8_SA(0, 0), a2, voffA);
            PG8_BAR; PG8_WAIT_L(0); PG8_MMA(1, 0, At, B0); PG8_BAR; PG8_SCHED;
            PG8_STAGE(PG8_SB(0, 1), b2 + hstep, voffB);
            PG8_WAIT_V(6); PG8_BAR; PG8_MMA(1, 1, At, B1); PG8_BAR;
            PG8_LDB(B0, 1, 0); PG8_SCHED; PG8_LDA(At, 1, 0); PG8_STAGE(PG8_SA(0, 1), a2 + hstep, voffA);
            PG8_WAIT_L(8); PG8_BAR; PG8_WAIT_L(0); PG8_MMA(0, 0, At, B0); PG8_BAR; PG8_SCHED;
            PG8_LDB(B1, 1, 1); PG8_STAGE(PG8_SB(1, 0), b3, voffB);
            PG8_BAR; PG8_WAIT_L(0); PG8_MMA(0, 1, At, B1); PG8_BAR;
            PG8_LDA(At, 1, 1); PG8_STAGE(PG8_SA(1, 0), a3, voffA);
            PG8_BAR; PG8_WAIT_L(0); PG8_MMA(1, 0, At, B0); PG8_BAR; PG8_SCHED;
            PG8_STAGE(PG8_SB(1, 1), b3 + hstep, voffB);
            PG8_WAIT_V(6); PG8_BAR; PG8_MMA(1, 1, At, B1); PG8_BAR;
            }
        }
        if constexpr (ALIGN_EPI) { if (wr == 0) PG8_BAR; }
        if constexpr (!Epi::AFTER_DRAIN) { E(acc, cur, wr, wc, fr, fq); S.done(cur); }
        if (!has_next) break;
#pragma unroll
        for (int a = 0; a < 2; ++a)
#pragma unroll
            for (int b = 0; b < 2; ++b)
#pragma unroll
                for (int m = 0; m < 4; ++m)
#pragma unroll
                    for (int n = 0; n < 2; ++n) acc[a][b][m][n] = (f32x4){0.f, 0.f, 0.f, 0.f};
        cur = nxt; cA = nA; cB = nB; ++ui;
        if constexpr (ALIGN_EPI) { if (wr == 1) PG8_BAR; }
    }
    PG8_WAIT_V(0);
    if constexpr (!ALIGN_EPI) { if (wr == 0) PG8_BAR; }
    PG8_BAR;
    if constexpr (Epi::AFTER_DRAIN) { E.fused(acc, cur, wr, wc, fr, fq, lds, wid, lane); S.done(cur); }
#undef PG8_SA
#undef PG8_SB
#undef PG8_STAGE
#undef PG8_LDA
#undef PG8_LDB
#undef PG8_MMA
#undef PG8_WAIT_V
#undef PG8_WAIT_L
#undef PG8_BAR
#undef PG8_SCHED
}
}

namespace pg8 {
struct EpiRelu2 {
    static constexpr bool PERM = true, AFTER_DRAIN = false;
    bf16_t* O; int ldc;
    __device__ __forceinline__ void operator()(const f32x4 (&acc)[2][2][4][2], const Unit& u, int wr, int wc, int fr, int fq) const {
        relane(wr, wc, fr, fq);
        const int row0 = u.pm * BM + wr * 64 + fr, col0 = u.pn * BM + wc * 32 + 8 * fq;
#pragma unroll
        for (int ai = 0; ai < 2; ++ai)
#pragma unroll
            for (int m = 0; m < 4; ++m) { bf16_t* rowp = O + (size_t)(row0 + ai * HALF + m * 16) * ldc + col0;
#pragma unroll
                for (int bj = 0; bj < 2; ++bj) { f32x4 v0 = acc[ai][bj][m][0], v1 = acc[ai][bj][m][1];
                    v0 = __builtin_elementwise_max(v0, (f32x4){0.f, 0.f, 0.f, 0.f}); v1 = __builtin_elementwise_max(v1, (f32x4){0.f, 0.f, 0.f, 0.f}); v0 = v0 * v0; v1 = v1 * v1;
                    u32x4 w; w.x = cvt_pk_bf16(v0[0], v0[1]); w.y = cvt_pk_bf16(v0[2], v0[3]); w.z = cvt_pk_bf16(v1[0], v1[1]); w.w = cvt_pk_bf16(v1[2], v1[3]);
                    *(PG8_GAS u32x4*)(rowp + bj * HALF) = w; } }
    }
};
struct EpiF32 {
    static constexpr bool PERM = false, AFTER_DRAIN = false;
    float* O; int ldc;
    __device__ __forceinline__ void operator()(const f32x4 (&acc)[2][2][4][2], const Unit& u, int wr, int wc, int fr, int fq) const {
        relane(wr, wc, fr, fq);
        const int row0 = u.pm * BM + wr * 64 + fr, col0 = u.pn * BM + wc * 32 + 4 * fq;
#pragma unroll
        for (int ai = 0; ai < 2; ++ai)
#pragma unroll
            for (int m = 0; m < 4; ++m) { float* rowp = O + (size_t)(row0 + ai * HALF + m * 16) * ldc + col0;
#pragma unroll
                for (int bj = 0; bj < 2; ++bj)
#pragma unroll
                    for (int n = 0; n < 2; ++n) *(PG8_GAS f32x4*)(rowp + bj * HALF + n * 16) = acc[ai][bj][m][n]; }
    }
};
struct EpiTaps {
    static constexpr bool PERM = false, AFTER_DRAIN = false;
    float* O; const float* decay;
    __device__ __forceinline__ void operator()(const f32x4 (&acc)[2][2][4][2], const Unit& u, int wr, int wc, int fr, int fq) const {
        relane(wr, wc, fr, fq);
        const int row0 = u.pm * BM + wr * 64 + fr, col0 = u.pn * BM + wc * 32 + 4 * fq;
#pragma unroll
        for (int ai = 0; ai < 2; ++ai)
#pragma unroll
            for (int m = 0; m < 4; ++m) { const int row = row0 + ai * HALF + m * 16; float* rowp = O + (size_t)row * 16384 + col0; const float nd = -fabsf(((const PG8_GAS float*)decay)[row]) * (1.0f / 16383.0f) * 1.4426950408889634f;
#pragma unroll
                for (int bj = 0; bj < 2; ++bj)
#pragma unroll
                    for (int n = 0; n < 2; ++n) { const int c = col0 + bj * HALF + n * 16; const f32x4 a = acc[ai][bj][m][n]; f32x4 o;
                        o[0] = a[0] * __builtin_amdgcn_exp2f(nd * (float)(c + 0)); o[1] = a[1] * __builtin_amdgcn_exp2f(nd * (float)(c + 1));
                        o[2] = a[2] * __builtin_amdgcn_exp2f(nd * (float)(c + 2)); o[3] = a[3] * __builtin_amdgcn_exp2f(nd * (float)(c + 3));
                        *(PG8_GAS f32x4*)(rowp + bj * HALF + n * 16) = o; } }
    }
};
}

constexpr int L = 16384, NSEQ = 3, M = NSEQ * L, D = 1024, DEPTH = 4;
constexpr int HYW = 512, HYP = 1536, QR = 256, KVR = 128, ROPE = 32, INW = 1952;
constexpr int NH = 8, DQ = 96, DV = 64, NQ = NH * DQ, NKV = NH * 128;
constexpr int FF = 4096;
constexpr float EPS = 1e-6f;
constexpr int NWAVES = 8, NTHR = 512;
constexpr int MLP_CHUNK = 16384, N_MLP_CHUNKS = M / MLP_CHUNK;

constexpr size_t MiB = 1u << 20;
constexpr size_t WS_CTL = 0, CTL_ZERO_BYTES = 65536;
constexpr size_t WS_COS = 1 * MiB, WS_SIN = 2 * MiB;
constexpr size_t WS_H2 = 4 * MiB;
constexpr size_t WS_W3T = 8 * MiB;
constexpr size_t WS_WIN = 12 * MiB, WS_WOUT = 16 * MiB, WS_WUP = 18 * MiB, WS_WDOWN = 26 * MiB, WS_WUQ = 34 * MiB, WS_WUKV = 34 * MiB + 512 * 1024;
constexpr size_t WS_XN = 36 * MiB;
constexpr size_t WS_CQN = 36 * MiB, WS_CKVN = 60 * MiB, WS_KPE = 72 * MiB;
constexpr size_t WS_KEO = 132 * MiB;
constexpr size_t WS_KT = 261 * MiB;
constexpr size_t WS_UT = 261 * MiB;
constexpr size_t WS_CQKV = 405 * MiB;
constexpr size_t WS_YT = 453 * MiB;
constexpr size_t WS_Q = 132 * MiB, WS_KN = 204 * MiB;
constexpr size_t WS_MIX = 324 * MiB;
constexpr size_t WS_T = 132 * MiB;
constexpr size_t WS_H = 324 * MiB;
constexpr size_t WS_G0 = 75 * MiB, WS_G1A = 107 * MiB, WS_G1B = 501 * MiB;
constexpr size_t WS_END = 508 * MiB;
constexpr int KEO_BLK = 16512, KEO_KO = 8256;
static_assert(WS_KEO + (size_t)1024 * KEO_BLK * 8 <= WS_KT, "KEO fits");
static_assert(WS_UT + (size_t)HYP * M * 2 <= WS_CQKV && WS_CQKV + (size_t)M * 512 * 2 <= WS_YT && WS_YT + (size_t)HYW * M * 2 <= WS_END, "map");
static_assert(WS_KN + (size_t)M * NKV * 2 <= WS_MIX && WS_T + (size_t)M * D * 4 <= WS_MIX && WS_H + (size_t)MLP_CHUNK * FF * 2 <= WS_END, "map2");

constexpr int RING_OFF = 0, RING_BYTES = 139264;
constexpr int LDSCTL_OFF = RING_BYTES, MISC_OFF = LDSCTL_OFF + 320;
constexpr int LDS_BYTES = 147456;
static_assert(MISC_OFF + 128 <= LDS_BYTES, "LDS map");

#define GAS __attribute__((address_space(1)))
#define LAS __attribute__((address_space(3)))
typedef unsigned short bf16;
typedef unsigned v4u __attribute__((ext_vector_type(4)));
typedef unsigned v2u __attribute__((ext_vector_type(2)));
typedef float f32x4 __attribute__((ext_vector_type(4)));
typedef float f32x2 __attribute__((ext_vector_type(2)));
typedef short bf16x8 __attribute__((ext_vector_type(8)));
typedef GAS unsigned gu32;
#define RLX_AGENT __ATOMIC_RELAXED, __HIP_MEMORY_SCOPE_AGENT
#define LDS_WAIT() asm volatile("s_waitcnt lgkmcnt(0)" ::: "memory")
#define VM_WAIT() asm volatile("s_waitcnt vmcnt(0)" ::: "memory")
typedef __bf16 bf16x2_t __attribute__((ext_vector_type(2)));
__device__ __forceinline__ unsigned pk2(float lo, float hi) { f32x2 v = {lo, hi}; bf16x2_t b = __builtin_convertvector(v, bf16x2_t); return __builtin_bit_cast(unsigned, b); }
__device__ __forceinline__ bf16 f2bf(float f) { return (bf16)(pk2(f, 0.f) & 0xffffu); }
__device__ __forceinline__ float bf2f(unsigned h) { return __uint_as_float(h << 16); }
__device__ __forceinline__ float shx(float v, int lane, int o) { return __uint_as_float((unsigned)__builtin_amdgcn_ds_bpermute((lane ^ o) << 2, (int)__float_as_uint(v))); }
__device__ __forceinline__ float wave_sum(float v) {
    const int ln_ = hw_lane();
#pragma unroll
    for (int o = 1; o < 64; o <<= 1) v += shx(v, ln_, o);
    return v;
}

namespace hfft {
constexpr float w32c(int i) { constexpr float t[16] = {1.000000000e+00f, 9.807852507e-01f, 9.238795042e-01f, 8.314695954e-01f, 7.071067691e-01f, 5.555702448e-01f, 3.826834261e-01f, 1.950903237e-01f, 0.f, -1.950903237e-01f, -3.826834261e-01f, -5.555702448e-01f, -7.071067691e-01f, -8.314695954e-01f, -9.238795042e-01f, -9.807852507e-01f}; return t[i]; }
constexpr float w32s(int i) { constexpr float t[16] = {0.000000000e+00f, 1.950903237e-01f, 3.826834261e-01f, 5.555702448e-01f, 7.071067691e-01f, 8.314695954e-01f, 9.238795042e-01f, 9.807852507e-01f, 1.000000000e+00f, 9.807852507e-01f, 9.238795042e-01f, 8.314695954e-01f, 7.071067691e-01f, 5.555702448e-01f, 3.826834261e-01f, 1.950903237e-01f}; return t[i]; }
constexpr int brev(int x, int bits) { int r = 0; for (int i = 0; i < bits; ++i) r |= ((x >> i) & 1) << (bits - 1 - i); return r; }
constexpr int ilog2(int x) { int r = 0; while ((1 << r) < x) ++r; return r; }
__device__ __forceinline__ int pad(int i) { return i + (i >> 5); }

__device__ __forceinline__ void bfly(float ar, float ai, float br, float bi, float& ur, float& ui, float& dr, float& di) {
    asm("v_add_f32_e32 %0, %4, %6\n\tv_add_f32_e32 %1, %5, %7\n\tv_sub_f32_e32 %2, %4, %6\n\tv_sub_f32_e32 %3, %5, %7"
        : "=&v"(ur), "=&v"(ui), "=&v"(dr), "=&v"(di) : "v"(ar), "v"(ai), "v"(br), "v"(bi));
}
template <bool INV> __device__ __forceinline__ void bfly_rot(float ar, float ai, float br, float bi, float& ur, float& ui, float& dr, float& di) {
    if (!INV) asm("v_add_f32_e32 %0, %4, %6\n\tv_add_f32_e32 %1, %5, %7\n\tv_sub_f32_e32 %2, %5, %7\n\tv_sub_f32_e32 %3, %6, %4" : "=&v"(ur), "=&v"(ui), "=&v"(dr), "=&v"(di) : "v"(ar), "v"(ai), "v"(br), "v"(bi));
    else      asm("v_add_f32_e32 %0, %4, %6\n\tv_add_f32_e32 %1, %5, %7\n\tv_sub_f32_e32 %2, %7, %5\n\tv_sub_f32_e32 %3, %4, %6" : "=&v"(ur), "=&v"(ui), "=&v"(dr), "=&v"(di) : "v"(ar), "v"(ai), "v"(br), "v"(bi));
}
__device__ __forceinline__ void bfly_tw(float ar, float ai, float br, float bi, float c, float s, float& ur, float& ui, float& dr, float& di) {
    float tr, ti;
    asm("v_sub_f32_e32 %4, %6, %8\n\tv_sub_f32_e32 %5, %7, %9\n\tv_add_f32_e32 %0, %6, %8\n\tv_add_f32_e32 %1, %7, %9\n\t"
        "v_mul_f32_e32 %2, %10, %4\n\tv_mul_f32_e32 %3, %11, %4\n\tv_fma_f32 %2, -%11, %5, %2\n\tv_fma_f32 %3, %10, %5, %3"
        : "=&v"(ur), "=&v"(ui), "=&v"(dr), "=&v"(di), "=&v"(tr), "=&v"(ti) : "v"(ar), "v"(ai), "v"(br), "v"(bi), "s"(c), "s"(s));
}
__device__ __forceinline__ void cmul_chain(float& xr, float& xi, float& wc, float& ws, float c1, float s1) {
    float a, b, nc, ns;
    asm("v_mul_f32_e32 %0, %4, %6\n\tv_mul_f32_e32 %1, %4, %7\n\tv_fma_f32 %0, -%5, %7, %0\n\tv_fma_f32 %1, %5, %6, %1\n\t"
        "v_mul_f32_e32 %2, %6, %8\n\tv_mul_f32_e32 %3, %6, %9\n\tv_fma_f32 %2, -%7, %9, %2\n\tv_fma_f32 %3, %7, %8, %3"
        : "=&v"(a), "=&v"(b), "=&v"(nc), "=&v"(ns) : "v"(xr), "v"(xi), "v"(wc), "v"(ws), "v"(c1), "v"(s1));
    xr = a; xi = b; wc = nc; ws = ns;
}
template <int R, bool INV> __device__ __forceinline__ void fft_r2(float (&re)[R], float (&im)[R], const unsigned z0) {
    constexpr int LG = ilog2(R);
#pragma unroll
    for (int st = 0; st < LG; ++st) {
        const int s = (R / 2) >> st;
#pragma unroll
        for (int blk = 0; blk < R; blk += 2 * s) {
#pragma unroll
            for (int a = 0; a < s; ++a) {
                const int i0 = blk + a, i1 = i0 + s;
                const int w = a * (16 / s);
                float ur, ui, dr, di;
                if (w == 0) { bfly(re[i0], im[i0], re[i1], im[i1], ur, ui, dr, di); re[i1] = dr; im[i1] = di; }
                else if (w == 8) { bfly_rot<INV>(re[i0], im[i0], re[i1], im[i1], ur, ui, dr, di); re[i1] = dr; im[i1] = di; }
                else { const float c = __uint_as_float(__float_as_uint(w32c(w)) | z0), sn = __uint_as_float(__float_as_uint(INV ? w32s(w) : -w32s(w)) | z0);
                    bfly_tw(re[i0], im[i0], re[i1], im[i1], c, sn, ur, ui, dr, di); re[i1] = dr; im[i1] = di; }
                re[i0] = ur; im[i0] = ui;
            }
        }
    }
}

__device__ __forceinline__ int opaque(int x) { asm volatile("" : "+v"(x)); return x; }
template <bool INV> __device__ __forceinline__ void fft16k(float (&re)[32], float (&im)[32], LAS f32x2* buf, const int t_in) {
    asm volatile("" ::: "memory"); __builtin_amdgcn_sched_barrier(0);
    int t = opaque(t_in);
    unsigned z0 = 0u; asm volatile("" : "+s"(z0));
    fft_r2<32, INV>(re, im, z0);
    __syncthreads();
#pragma unroll
    for (int r = 0; r < 32; ++r) buf[33 * t + r] = (f32x2){re[brev(r, 5)], im[brev(r, 5)]};
    __syncthreads();
    t = opaque(t);
    { const int b2 = t + (t >> 5);
#pragma unroll
    for (int r = 0; r < 32; ++r) { const f32x2 v = buf[b2 + 528 * r]; re[r] = v.x; im[r] = v.y; } }
    {
        const float f1 = (float)(t & 31) * (1.0f / 1024.0f);
        const float c1 = __builtin_amdgcn_cosf(f1), s1 = INV ? __builtin_amdgcn_sinf(f1) : -__builtin_amdgcn_sinf(f1);
        float wc = c1, ws = s1;
#pragma unroll
        for (int r = 1; r < 32; ++r) {
            cmul_chain(re[r], im[r], wc, ws, c1, s1);
        }
    }
    fft_r2<32, INV>(re, im, z0);
    __syncthreads();
    {
        t = opaque(t);
        const int ob = (t >> 5) * 1056 + (t & 31);
#pragma unroll
        for (int r = 0; r < 32; ++r) buf[ob + 33 * r] = (f32x2){re[brev(r, 5)], im[brev(r, 5)]};
    }
    __syncthreads();
#pragma unroll
    for (int h = 0; h < 2; ++h) {
        t = opaque(t);
        float ar[16], ai[16]; const int j = t + 512 * h; const int b3 = t + (t >> 5) + 528 * h;
#pragma unroll
        for (int r = 0; r < 16; ++r) { const f32x2 v = buf[b3 + 1056 * r]; ar[r] = v.x; ai[r] = v.y; }
        {
            const float f1 = (float)j * (1.0f / 16384.0f);
            const float c1 = __builtin_amdgcn_cosf(f1), s1 = INV ? __builtin_amdgcn_sinf(f1) : -__builtin_amdgcn_sinf(f1);
            float wc = c1, ws = s1;
#pragma unroll
            for (int r = 1; r < 16; ++r) {
                cmul_chain(ar[r], ai[r], wc, ws, c1, s1);
            }
        }
        fft_r2<16, INV>(ar, ai, z0);
#pragma unroll
        for (int r = 0; r < 16; ++r) { re[h + 2 * r] = ar[brev(r, 4)]; im[h + 2 * r] = ai[brev(r, 4)]; }
    }
    asm volatile("" ::: "memory"); __builtin_amdgcn_sched_barrier(0);
}
}

struct Frame {
    LAS unsigned char* lds;
    volatile LAS unsigned* MISC;
    gu32* ctl;
    int tid, lane, wave;
    int wave0;
    int vcu, G;
    float* out;
    unsigned char* ws;
};
constexpr int PTRTAB_OFF = LDSCTL_OFF + 512;
__device__ __forceinline__ const GAS float* inp(const Frame& F, int i) {
    const v2u w = *(const LAS v2u*)(F.lds + PTRTAB_OFF + 8 * i);
    const unsigned lo = __builtin_amdgcn_readfirstlane(w.x), hi = __builtin_amdgcn_readfirstlane(w.y);
    return (const GAS float*)(((unsigned long long)hi << 32) | lo);
}
__device__ __forceinline__ GAS unsigned char* wsq(const Frame& F) { unsigned char* p = F.ws; asm volatile("" : "+s"(p)); return (GAS unsigned char*)p; }
enum { I_XP = 0, I_XS, I_WIN, I_CONVW, I_CONVB, I_FW1, I_FB1, I_FW2, I_FB2, I_FW3, I_SINF, I_DECAY, I_HBIAS, I_QNORM, I_WUQ, I_KVNORM, I_WUKV, I_GNHY, I_GNAT, I_WOUT,
       I_NMIXPRE, I_NMIXPOST, I_NMLPPRE, I_NMLPPOST, I_WUP, I_WDOWN };

__device__ __forceinline__ int rope_src(int p) { return 4 * (p >> 3) + (p & 3) + 16 * ((p >> 2) & 1); }
template <bool ROPEPERM>
__device__ __forceinline__ void transpose_item(const GAS float* W, int K, int N, GAS bf16* WT, LAS float* scr, int item, int lane, int ldk = 0, int koff = 0) {
    if (ldk == 0) ldk = K;
    const int nblk = N / 32, kb = item / nblk, nb = item % nblk, k0 = 64 * kb, n0 = 32 * nb;
    int sc = lane & 31; if (ROPEPERM && (nb % 3) == 2) sc = rope_src(sc);
#pragma unroll 8
    for (int i = 0; i < 32; ++i) { const int kk = 2 * i + (lane >> 5); scr[kk * 33 + (lane & 31)] = W[(size_t)(k0 + kk) * N + n0 + sc]; }
    LDS_WAIT(); asm volatile("" ::: "memory");
    const int c = lane & 7;
#pragma unroll
    for (int j = 0; j < 4; ++j) { const int n = (lane >> 3) + 8 * j; const LAS float* s = scr + (8 * c) * 33 + n;
        v4u o; o.x = pk2(s[0 * 33], s[1 * 33]); o.y = pk2(s[2 * 33], s[3 * 33]); o.z = pk2(s[4 * 33], s[5 * 33]); o.w = pk2(s[6 * 33], s[7 * 33]);
        *(GAS v4u*)(WT + (size_t)(n0 + n) * ldk + koff + k0 + 8 * c) = o; }
    LDS_WAIT(); asm volatile("" ::: "memory");
}
__device__ __forceinline__ void phase_weights(Frame& F, int l) {
    LAS float* scr = (LAS float*)(F.lds + RING_OFF + F.wave * 16384);
    const int gw = F.vcu * NWAVES + F.wave, NGW = F.G * NWAVES;
    GAS bf16* WinT = (GAS bf16*)(wsq(F) + WS_WIN); GAS bf16* WoutT = (GAS bf16*)(wsq(F) + WS_WOUT); GAS bf16* WupT = (GAS bf16*)(wsq(F) + WS_WUP); GAS bf16* WdownT = (GAS bf16*)(wsq(F) + WS_WDOWN);
    GAS bf16* WuqT = (GAS bf16*)(wsq(F) + WS_WUQ); GAS bf16* WukvT = (GAS bf16*)(wsq(F) + WS_WUKV);
    constexpr int I_IN = (D / 64) * (INW / 32), I_OUT = (D / 64) * (D / 32), I_UP = (D / 64) * (FF / 32), I_DN = (FF / 64) * (D / 32), I_UQ = (QR / 64) * (NQ / 32), I_UKV = (KVR / 64) * (NKV / 32);
    constexpr int I_W3 = 2048 / 32;
    constexpr int NITEMS = I_IN + I_OUT + I_UP + I_DN + I_UQ + I_UKV + 2 * I_W3;
    for (int it = gw; it < NITEMS; it += NGW) {
        int r = it;
        if (r < I_IN) { transpose_item<false>(inp(F, I_WIN) + (size_t)l * D * INW, D, INW, WinT, scr, r, F.lane); continue; } r -= I_IN;
        if (r < I_OUT) { transpose_item<false>(inp(F, I_WOUT) + (size_t)l * D * D, D, D, WoutT, scr, r, F.lane); continue; } r -= I_OUT;
        if (r < I_UP) { transpose_item<false>(inp(F, I_WUP) + (size_t)l * D * FF, D, FF, WupT, scr, r, F.lane); continue; } r -= I_UP;
        if (r < I_DN) { transpose_item<false>(inp(F, I_WDOWN) + (size_t)l * FF * D, FF, D, WdownT, scr, r, F.lane); continue; } r -= I_DN;
        if (r < I_UQ) { transpose_item<true>(inp(F, I_WUQ) + (size_t)l * QR * NQ, QR, NQ, WuqT, scr, r, F.lane); continue; } r -= I_UQ;
        if (r < I_UKV) { transpose_item<false>(inp(F, I_WUKV) + (size_t)l * KVR * NKV, KVR, NKV, WukvT, scr, r, F.lane); continue; } r -= I_UKV;
        transpose_item<false>(inp(F, I_FW3) + (size_t)l * 64 * 2048, 64, 2048, (GAS bf16*)(wsq(F) + WS_W3T), scr, r % I_W3, F.lane, 128, (r / I_W3) * 64);
    }
    { unsigned z = 0u; asm volatile("" : "+v"(z)); const v4u zz = {z, z, z, z};
      for (int i = gw * 64 + F.lane; i < 12288; i += NGW * 64) ((GAS v4u*)(WinT + (size_t)INW * D))[i] = zz; }
}
__device__ __forceinline__ void phase_rope_tab(Frame& F) {
    const float inv[16] = {1.000000000e+00f, 5.623413324e-01f, 3.162277639e-01f, 1.778279394e-01f, 1.000000015e-01f, 5.623412877e-02f, 3.162277862e-02f, 1.778279431e-02f,
                           9.999999776e-03f, 5.623413250e-03f, 3.162277862e-03f, 1.778279431e-03f, 1.000000047e-03f, 5.623413017e-04f, 3.162277862e-04f, 1.778279402e-04f};
    GAS float* ct = (GAS float*)(wsq(F) + WS_COS); GAS float* st = (GAS float*)(wsq(F) + WS_SIN);
    for (int i = F.vcu * NTHR + F.tid; i < L * 16; i += F.G * NTHR) {
        const int t = i >> 4, j = i & 15; float iv = inv[0];
#pragma unroll
        for (int q = 1; q < 16; ++q) iv = (j == q) ? inv[q] : iv;
        const float ang = (float)t * iv; ct[i] = cosf(ang); st[i] = sinf(ang);
    }
}
__device__ __forceinline__ const GAS float* x_src_row(Frame& F, int l, int m) {
    if (l == 0) return (m < 2 * L) ? inp(F, I_XP) + (size_t)m * D : inp(F, I_XS) + (size_t)(m - 2 * L) * D;
    return (const GAS float*)F.out + (size_t)m * D;
}
__device__ __forceinline__ void store_xn_row(f32x4 (&v)[4], float rstd, const GAS float* g, GAS bf16* orow, int lane) {
    GAS v2u* o8 = (GAS v2u*)orow + lane;
#pragma unroll
    for (int j = 0; j < 4; ++j) { const f32x4 gg = ((const GAS f32x4*)g)[lane + 64 * j]; v2u w; w.x = pk2(v[j].x * rstd * gg.x, v[j].y * rstd * gg.y); w.y = pk2(v[j].z * rstd * gg.z, v[j].w * rstd * gg.w); o8[64 * j] = w; }
}
__device__ __forceinline__ float row_ss(const f32x4 (&v)[4]) { float s = 0.f;
#pragma unroll
    for (int j = 0; j < 4; ++j) s += (v[j].x * v[j].x + v[j].y * v[j].y) + (v[j].z * v[j].z + v[j].w * v[j].w);
    return wave_sum(s); }
__device__ __forceinline__ void phase_norm_first(Frame& F, int l, const GAS float* g) {
    const int gw = F.vcu * NWAVES + F.wave, NGW = F.G * NWAVES; GAS bf16* XN = (GAS bf16*)(wsq(F) + WS_XN);
    for (int m = gw; m < M; m += NGW) {
        const GAS f32x4* xr = (const GAS f32x4*)x_src_row(F, l, m) + F.lane; f32x4 v[4];
#pragma unroll
        for (int j = 0; j < 4; ++j) v[j] = xr[64 * j];
        const float rstd = 1.0f / sqrtf(row_ss(v) * (1.0f / D) + EPS);
        store_xn_row(v, rstd, g, XN + (size_t)m * D, F.lane);
    }
}
__device__ __forceinline__ void phase_norm_res(Frame& F, int lsrc, const GAS bf16* T, const GAS float* gpost, const GAS float* gnext) {
    const int gw = F.vcu * NWAVES + F.wave, NGW = F.G * NWAVES; GAS bf16* XN = (GAS bf16*)(wsq(F) + WS_XN);
    for (int m0 = gw; m0 < M; m0 += 2 * NGW) {
        f32x4 v[2][4], tv[2][4];
#pragma unroll
        for (int q = 0; q < 2; ++q) { const int m = m0 + q * NGW; const GAS f32x4* xr = (const GAS f32x4*)x_src_row(F, lsrc, m) + F.lane; const GAS v2u* tr = (const GAS v2u*)(T + (size_t)m * D) + F.lane;
#pragma unroll
            for (int j = 0; j < 4; ++j) { v[q][j] = xr[64 * j]; const v2u w = tr[64 * j]; tv[q][j] = (f32x4){bf2f(w.x & 0xffffu), bf2f(w.x >> 16), bf2f(w.y & 0xffffu), bf2f(w.y >> 16)}; } }
#pragma unroll
        for (int q = 0; q < 2; ++q) { const int m = m0 + q * NGW;
            const float rt = 1.0f / sqrtf(row_ss(tv[q]) * (1.0f / D) + EPS);
            GAS f32x4* orow = (GAS f32x4*)(F.out + (size_t)m * D) + F.lane;
#pragma unroll
            for (int j = 0; j < 4; ++j) { const f32x4 gg = ((const GAS f32x4*)gpost)[F.lane + 64 * j]; v[q][j] = v[q][j] + tv[q][j] * rt * gg; orow[64 * j] = v[q][j]; }
            if (gnext) { const float rstd = 1.0f / sqrtf(row_ss(v[q]) * (1.0f / D) + EPS); store_xn_row(v[q], rstd, gnext, XN + (size_t)m * D, F.lane); } }
    }
}

__device__ __forceinline__ void phase_filter_mlp(Frame& F, int l) {
    const GAS float* w1 = inp(F, I_FW1) + (size_t)l * 33 * 64; const GAS float* b1 = inp(F, I_FB1) + l * 64; const GAS float* w2 = inp(F, I_FW2) + (size_t)l * 64 * 64; const GAS float* b2 = inp(F, I_FB2) + l * 64;
    const GAS float* sf = inp(F, I_SINF) + l * 128; GAS bf16* H2 = (GAS bf16*)(wsq(F) + WS_H2);
    const int lane = F.lane, gw = F.vcu * NWAVES + F.wave, NGW = F.G * NWAVES;
    float w1c[33], w2c[64];
#pragma unroll
    for (int f = 0; f < 33; ++f) w1c[f] = w1[f * 64 + lane];
#pragma unroll
    for (int i = 0; i < 64; ++i) w2c[i] = w2[i * 64 + lane];
    const float b1l = b1[lane], b2l = b2[lane], sf0 = sf[lane], sf1 = sf[64 + lane];
    for (int n = gw; n < L; n += NGW) {
        const float tn = (float)n * (1.0f / (float)(L - 1)); const float omega = (float)(2.0 * 3.14159265358979323846 / L) * (float)n;
        const int bidx = (lane >= 17) ? lane - 17 : lane - 1; const float band = 1e-4f + (float)bidx * ((15.0f - 1e-4f) / 15.0f); const float ph = omega * band;
        const float zf = (lane == 0) ? tn : ((lane <= 16) ? cosf(ph) : -sinf(ph));
        float acc = b1l;
#pragma unroll
        for (int f = 0; f < 33; ++f) acc += __uint_as_float(__builtin_amdgcn_readlane(__float_as_uint(zf), f)) * w1c[f];
        const float h1 = sinf(sf0 * acc);
        float acc2 = b2l;
#pragma unroll
        for (int i = 0; i < 64; ++i) acc2 += __uint_as_float(__builtin_amdgcn_readlane(__float_as_uint(h1), i)) * w2c[i];
        const float hv = sinf(sf1 * acc2); const bf16 hi = f2bf(hv);
        H2[(size_t)n * 128 + lane] = hi; H2[(size_t)n * 128 + 64 + lane] = f2bf(hv - bf2f(hi));
    }
}

__device__ __forceinline__ void phase_filter_fft(Frame& F, int l) {
    const GAS float* KT = (const GAS float*)(wsq(F) + WS_KT); GAS f32x2* KEO = (GAS f32x2*)(wsq(F) + WS_KEO); const GAS float* hb = inp(F, I_HBIAS) + (size_t)l * 2 * HYW;
    LAS f32x2* buf = (LAS f32x2*)(F.lds + RING_OFF); const int t = F.tid;
    for (int c = F.vcu; c < HYW; c += F.G) {
        const GAS float* fw0 = KT + (size_t)(0 * HYW + c) * L; const GAS float* bw0 = KT + (size_t)(1 * HYW + c) * L;
        const GAS float* fw1 = KT + (size_t)(2 * HYW + c) * L; const GAS float* bw1 = KT + (size_t)(3 * HYW + c) * L;
        const float bias0 = hb[c], bias1 = hb[HYW + c]; const float sc = 1.0f / (2.0f * L);
        GAS f32x2* k0 = KEO + (size_t)c * KEO_BLK; GAS f32x2* k1 = KEO + (size_t)(HYW + c) * KEO_BLK;
        float ar[32], ai[32];
#pragma unroll 1
        for (int odd = 0; odd < 2; ++odd) {
            { const int tq = hfft::opaque(t);
#pragma unroll
              for (int m = 0; m < 32; ++m) { const int n = tq + 512 * m; const int nb = n >= 1 ? L - n : 0;
                  const float f0 = fw0[n], f1 = fw1[n]; float b0 = bw0[nb], b1 = bw1[nb]; b0 = n >= 1 ? b0 : 0.f; b1 = n >= 1 ? b1 : 0.f;
                  if (!odd) { ar[m] = f0 + b0; ai[m] = f1 + b1; }
                  else { const float d0 = f0 - b0, d1 = f1 - b1; const float fr = (float)n * (1.0f / 32768.0f); const float cs = __builtin_amdgcn_cosf(fr), sn = -__builtin_amdgcn_sinf(fr);
                         ar[m] = d0 * cs - d1 * sn; ai[m] = d0 * sn + d1 * cs; }
                  if ((m & 7) == 7) { asm volatile("" ::: "memory"); __builtin_amdgcn_sched_barrier(0); } } }
            hfft::fft16k<false>(ar, ai, buf, t);
            __syncthreads();
            { const int tq = hfft::opaque(t);
#pragma unroll
              for (int m = 0; m < 32; ++m) buf[hfft::pad(tq + 512 * m)] = (f32x2){ar[m], ai[m]}; }
            __syncthreads();
            { const int tq = hfft::opaque(t); GAS f32x2* d0 = k0 + (odd ? KEO_KO : 0); GAS f32x2* d1 = k1 + (odd ? KEO_KO : 0);
#pragma unroll
              for (int m = 0; m <= 16; ++m) { const int k = tq + 512 * m; const bool keep = odd ? (k < 8192) : (k <= 8192);
                  const int rk = odd ? 16383 - k : ((16384 - k) & 16383); const f32x2 xq = buf[hfft::pad(rk)]; const float cr = xq.x, ci = -xq.y;
                  const float a0 = 0.5f * (ar[m] + cr), a1 = 0.5f * (ai[m] + ci), b0 = 0.5f * (ai[m] - ci), b1 = -0.5f * (ar[m] - cr);
                  if (keep) { d0[k] = (f32x2){(a0 + bias0) * sc, a1 * sc}; d1[k] = (f32x2){(b0 + bias1) * sc, b1 * sc}; } } }
        }
    }
    __syncthreads();
}

__device__ __forceinline__ float u_conv3(const GAS bf16* row, int n, float w0, float w1, float w2, float cb) {
    const int nm = n >= 1 ? n - 1 : 0, np = n + 1 < L ? n + 1 : L - 1;
    float um = bf2f(row[nm]), up = bf2f(row[np]); const float u0 = bf2f(row[n]);
    um = n >= 1 ? um : 0.f; up = n + 1 < L ? up : 0.f;
    return um * w0 + u0 * w1 + up * w2 + cb;
}
__device__ __forceinline__ void conv3_stage(const GAS bf16* r0, const GAS bf16* r1, float w0, float w1, float w2, float cb, float v0, float v1, float v2, float vb, LAS f32x2* buf, int t) {
    const int tq = hfft::opaque(t);
#pragma unroll
    for (int q = 0; q < 4; ++q) { const int j = tq + 512 * q; const bool hl = j > 0, hr = j < L / 8 - 1; const int nl = hl ? 8 * j - 1 : 0, nr = hr ? 8 * j + 8 : L - 1;
        const v4u a = *(const GAS v4u*)(r0 + 8 * j), b = *(const GAS v4u*)(r1 + 8 * j);
        float al = bf2f(r0[nl]), ar = bf2f(r0[nr]), bl = bf2f(r1[nl]), br = bf2f(r1[nr]);
        al = hl ? al : 0.f; bl = hl ? bl : 0.f; ar = hr ? ar : 0.f; br = hr ? br : 0.f;
        const float ua[10] = {al, __uint_as_float(a.x << 16), __uint_as_float(a.x & 0xffff0000u), __uint_as_float(a.y << 16), __uint_as_float(a.y & 0xffff0000u),
                              __uint_as_float(a.z << 16), __uint_as_float(a.z & 0xffff0000u), __uint_as_float(a.w << 16), __uint_as_float(a.w & 0xffff0000u), ar};
        const float ub[10] = {bl, __uint_as_float(b.x << 16), __uint_as_float(b.x & 0xffff0000u), __uint_as_float(b.y << 16), __uint_as_float(b.y & 0xffff0000u),
                              __uint_as_float(b.z << 16), __uint_as_float(b.z & 0xffff0000u), __uint_as_float(b.w << 16), __uint_as_float(b.w & 0xffff0000u), br};
        LAS f32x4* dst = (LAS f32x4*)(buf + 8 * j);
#pragma unroll
        for (int e = 0; e < 8; e += 2) { f32x4 o;
            o[0] = ua[e] * w0 + ua[e + 1] * w1 + ua[e + 2] * w2 + cb; o[1] = ub[e] * v0 + ub[e + 1] * v1 + ub[e + 2] * v2 + vb;
            o[2] = ua[e + 1] * w0 + ua[e + 2] * w1 + ua[e + 3] * w2 + cb; o[3] = ub[e + 1] * v0 + ub[e + 2] * v1 + ub[e + 3] * v2 + vb; dst[e >> 1] = o; } }
}
__device__ __forceinline__ void cmul_spec(float (&xr)[32], float (&xi)[32], const GAS f32x2* ke, int t, bool odd) {
    { const int tq = hfft::opaque(t); (void)tq;
#pragma unroll
    for (int m = 0; m < 32; ++m) { const int k = tq + 512 * m; int idx; bool cj;
        if (!odd) { cj = k > 8192; idx = cj ? 16384 - k : k; } else { cj = k >= 8192; idx = cj ? 16383 - k : k; }
        const f32x2 kv = ke[idx]; const float kr = kv.x, ki = cj ? -kv.y : kv.y;
        const float a = xr[m], b = xi[m]; xr[m] = a * kr - b * ki; xi[m] = a * ki + b * kr; if ((m & 15) == 15) { asm volatile("" ::: "memory"); __builtin_amdgcn_sched_barrier(0); } }
    }
}
__device__ __forceinline__ f32x2 ld_spec(const GAS f32x2* ke, int k, bool odd) {
    int idx; bool cj;
    if (!odd) { cj = k > 8192; idx = cj ? 16384 - k : k; } else { cj = k >= 8192; idx = cj ? 16383 - k : k; }
    f32x2 kv = ke[idx]; kv.y = cj ? -kv.y : kv.y; return kv;
}
__device__ __forceinline__ void cmul_spec2(float (&xr)[32], float (&xi)[32], const GAS f32x2* ka, const GAS f32x2* kb, LAS f32x2* buf, int t, bool odd) {
    __syncthreads();
    { const int tq = hfft::opaque(t);
#pragma unroll
      for (int m = 0; m < 32; ++m) buf[hfft::pad(tq + 512 * m)] = (f32x2){xr[m], xi[m]}; }
    __syncthreads();
    { const int tq = hfft::opaque(t);
#pragma unroll
      for (int m = 0; m < 32; ++m) { const int k = tq + 512 * m; const int rk = odd ? 16383 - k : ((16384 - k) & 16383);
          const f32x2 xc = buf[hfft::pad(rk)];
          const f32x2 a = ld_spec(ka, k, odd), b = ld_spec(kb, k, odd);
          const float sr = 0.5f * (a.x + b.x), si = 0.5f * (a.y + b.y), dr = 0.5f * (a.x - b.x), di = 0.5f * (a.y - b.y);
          const float x0 = xr[m], x1 = xi[m], c0 = xc.x, c1 = -xc.y;
          xr[m] = (x0 * sr - x1 * si) + (c0 * dr - c1 * di); xi[m] = (x0 * si + x1 * sr) + (c0 * di + c1 * dr);
          if ((m & 7) == 7) { asm volatile("" ::: "memory"); __builtin_amdgcn_sched_barrier(0); } } }
}
__device__ __forceinline__ void spec_prefetch(const GAS f32x2* ke, LAS unsigned char* lds, int t) {
    const int tq = hfft::opaque(t); const GAS unsigned char* src = (const GAS unsigned char*)ke + (tq >> 6) * 1024 + (tq & 63) * 16;
#pragma unroll
    for (int p = 0; p < 9; ++p) { int off = p * 8192; if (p == 8) off = (tq >> 6) == 0 ? off : 0;
        __builtin_amdgcn_global_load_lds((const GAS unsigned*)(src + off), (LAS unsigned*)(lds + RING_OFF + 135168), 16, 0, 0); }
}
#ifndef HYSUB
#define HYSUB 0
#endif
#define HT0() do { if (HYSUB) { __syncthreads(); if (F.tid == 0) F.MISC[20] = (unsigned)__builtin_amdgcn_s_memrealtime(); } } while (0)
#define HT1(s) do { if (HYSUB == (s)) { __syncthreads(); if (F.tid == 0) F.MISC[21] += (unsigned)__builtin_amdgcn_s_memrealtime() - F.MISC[20]; } } while (0)
__device__ __forceinline__ void phase_hyena(Frame& F, int l) {
    const GAS bf16* UT = (const GAS bf16*)(wsq(F) + WS_UT); GAS bf16* YT = (GAS bf16*)(wsq(F) + WS_YT); const GAS f32x2* KEO = (const GAS f32x2*)(wsq(F) + WS_KEO);
    const GAS float* cw = inp(F, I_CONVW) + (size_t)l * 3 * HYP; const GAS float* cbv = inp(F, I_CONVB) + (size_t)l * HYP;
    LAS f32x2* buf = (LAS f32x2*)(F.lds + RING_OFF); const int t = F.tid;
    GAS f32x2* G0 = (GAS f32x2*)(wsq(F) + WS_G0) + (size_t)F.vcu * 16384 + t;
    for (int item = F.vcu; item < HYW + HYW / 2; item += F.G) {
        const bool mode1 = item >= HYW;
        const int c0 = mode1 ? 2 * (item - HYW) : item, c1 = mode1 ? c0 + 1 : c0;
        const size_t s0 = mode1 ? (size_t)2 * L : 0, s1 = mode1 ? (size_t)2 * L : (size_t)L;
        float ar[32], ai[32]; unsigned ep[32];
#pragma unroll 1
        for (int o = 0; o < 2; ++o) {
            const GAS f32x2* ke0 = KEO + (size_t)(o * HYW + c0) * KEO_BLK; const GAS f32x2* ke1 = KEO + (size_t)(o * HYW + c1) * KEO_BLK;
#pragma unroll 1
            for (int half = 0; half < 2; ++half) {
                HT0();
                if (o == 0) { const float w0 = cw[c0], w1 = cw[HYP + c0], w2 = cw[2 * HYP + c0], cb = cbv[c0], v0 = cw[c1], v1 = cw[HYP + c1], v2 = cw[2 * HYP + c1], vb = cbv[c1];
                    const GAS bf16* r0 = UT + (size_t)c0 * M + s0; const GAS bf16* r1 = UT + (size_t)c1 * M + s1;
                    __syncthreads(); conv3_stage(r0, r1, w0, w1, w2, cb, v0, v1, v2, vb, buf, t); __syncthreads();
                    { const int tq = hfft::opaque(t);
#pragma unroll
                    for (int m = 0; m < 32; ++m) { const f32x2 v = buf[tq + 512 * m]; ar[m] = v.x; ai[m] = v.y; } }
                    }
                else {
                    { const int tq = hfft::opaque(t); (void)tq; GAS f32x2* G0q = G0 + (tq - t);
#pragma unroll
                    for (int m = 0; m < 32; ++m) { const f32x2 v = G0q[m * 512]; ar[m] = v.x; ai[m] = v.y; if ((m & 15) == 15) { asm volatile("" ::: "memory"); __builtin_amdgcn_sched_barrier(0); } } }
                    }
                HT1(1);
                if (half == 0) {
                    spec_prefetch(ke0, F.lds, t); if (mode1) spec_prefetch(ke1, F.lds, t);
                    HT0(); hfft::fft16k<false>(ar, ai, buf, t); HT1(2); HT0();
                    if (mode1) cmul_spec2(ar, ai, ke0, ke1, buf, t, false); else cmul_spec(ar, ai, ke0, t, false);
                    HT1(3); HT0(); hfft::fft16k<true>(ar, ai, buf, t); HT1(2); HT0();
                    {
#pragma unroll
                    for (int m = 0; m < 32; ++m) ep[m] = pk2(ar[m], ai[m]);
                    }
                    HT1(4);
                } else {
                    HT0();
                    { const int tq = hfft::opaque(t); (void)tq;
#pragma unroll
                    for (int m = 0; m < 32; ++m) { const float fr = (float)(tq + 512 * m) * (1.0f / 32768.0f); const float cs = __builtin_amdgcn_cosf(fr), sn = -__builtin_amdgcn_sinf(fr);
                        const float a = ar[m], b = ai[m]; ar[m] = a * cs - b * sn; ai[m] = a * sn + b * cs; }
                    }
                    spec_prefetch(ke0 + KEO_KO, F.lds, t); if (mode1) spec_prefetch(ke1 + KEO_KO, F.lds, t);
                    HT1(5); HT0(); hfft::fft16k<false>(ar, ai, buf, t); HT1(2); HT0();
                    if (mode1) cmul_spec2(ar, ai, ke0 + KEO_KO, ke1 + KEO_KO, buf, t, true); else cmul_spec(ar, ai, ke0 + KEO_KO, t, true);
                    HT1(3); HT0(); hfft::fft16k<true>(ar, ai, buf, t); HT1(2); HT0();
                    const int g0 = (o + 1) * HYW + c0, g1 = (o + 1) * HYW + c1;
                    const float w0 = cw[g0], w1 = cw[HYP + g0], w2 = cw[2 * HYP + g0], cb = cbv[g0], v0 = cw[g1], v1 = cw[HYP + g1], v2 = cw[2 * HYP + g1], vb = cbv[g1];
                    const GAS bf16* r0 = UT + (size_t)g0 * M + s0; const GAS bf16* r1 = UT + (size_t)g1 * M + s1;
                    __syncthreads(); conv3_stage(r0, r1, w0, w1, w2, cb, v0, v1, v2, vb, buf, t); __syncthreads();
                    { const int tq = hfft::opaque(t); (void)tq;
#pragma unroll
                    for (int m = 0; m < 32; ++m) { const int n = tq + 512 * m; const float fr = (float)n * (1.0f / 32768.0f); const float cs = __builtin_amdgcn_cosf(fr), sn = __builtin_amdgcn_sinf(fr); const f32x2 g = buf[n];
                        const float a = ar[m], b = ai[m]; const f32x2 e = {__uint_as_float(ep[m] << 16), __uint_as_float(ep[m] & 0xffff0000u)}; const float yr = e.x + (a * cs - b * sn), yi = e.y + (a * sn + b * cs);
                        ar[m] = yr * g.x; ai[m] = yi * g.y; }
                    }
                    if (o == 0) {
                        { const int tq = hfft::opaque(t); (void)tq; GAS f32x2* G0q = G0 + (tq - t);
#pragma unroll
                        for (int m = 0; m < 32; ++m) G0q[m * 512] = (f32x2){ar[m], ai[m]};
                        }
                    } else { GAS bf16* y0 = YT + (size_t)c0 * M + s0; GAS bf16* y1 = YT + (size_t)c1 * M + s1;
                        { const int tq = hfft::opaque(t); (void)tq;
#pragma unroll
                        for (int m = 0; m < 32; ++m) { const int n = tq + 512 * m; y0[n] = f2bf(ar[m]); y1[n] = f2bf(ai[m]); } }
                        }
                    HT1(6);
                }
            }
        }
    }
    __syncthreads();
}

__device__ __forceinline__ void phase_mla_prep(Frame& F, int l) {
    const GAS bf16* CQKV = (const GAS bf16*)(wsq(F) + WS_CQKV); GAS bf16* CQN = (GAS bf16*)(wsq(F) + WS_CQN); GAS bf16* CKVN = (GAS bf16*)(wsq(F) + WS_CKVN); GAS bf16* KPE = (GAS bf16*)(wsq(F) + WS_KPE);
    const GAS float* gq = inp(F, I_QNORM) + l * QR; const GAS float* gkv = inp(F, I_KVNORM) + l * KVR; const GAS float* ct = (const GAS float*)(wsq(F) + WS_COS); const GAS float* st = (const GAS float*)(wsq(F) + WS_SIN);
    const int gw = F.vcu * NWAVES + F.wave, NGW = F.G * NWAVES, lane = F.lane;
    for (int m0 = gw; m0 < M; m0 += 4 * NGW) {
        v2u q[4]; unsigned kv[4]; float x1[4], x2[4], cs[4], sn[4]; const int j = lane & 15;
#pragma unroll
        for (int u = 0; u < 4; ++u) { const int mm = m0 + u * NGW, m = mm < M ? mm : M - 1; const GAS bf16* row = CQKV + (size_t)m * 512; const int tpos = m & (L - 1);
            q[u] = *(const GAS v2u*)(row + 4 * lane); kv[u] = *(const GAS unsigned*)(row + 256 + 2 * lane);
            x1[u] = bf2f(row[384 + j]); x2[u] = bf2f(row[384 + 16 + j]); cs[u] = ct[tpos * 16 + j]; sn[u] = st[tpos * 16 + j]; }
        const f32x4 g4 = *(const GAS f32x4*)(gq + 4 * lane); const f32x2 g2 = *(const GAS f32x2*)(gkv + 2 * lane);
#pragma unroll
        for (int u = 0; u < 4; ++u) { const int m = m0 + u * NGW; if (m >= M) break;
            const float q0 = bf2f(q[u].x & 0xffffu), q1 = bf2f(q[u].x >> 16), q2 = bf2f(q[u].y & 0xffffu), q3 = bf2f(q[u].y >> 16), k0 = bf2f(kv[u] & 0xffffu), k1 = bf2f(kv[u] >> 16);
            const float rq = 1.0f / sqrtf(wave_sum((q0 * q0 + q1 * q1) + (q2 * q2 + q3 * q3)) * (1.0f / QR) + EPS);
            const float rk = 1.0f / sqrtf(wave_sum(k0 * k0 + k1 * k1) * (1.0f / KVR) + EPS);
            v2u oq; oq.x = pk2(q0 * rq * g4.x, q1 * rq * g4.y); oq.y = pk2(q2 * rq * g4.z, q3 * rq * g4.w);
            *(GAS v2u*)(CQN + (size_t)m * QR + 4 * lane) = oq;
            *(GAS unsigned*)(CKVN + (size_t)m * KVR + 2 * lane) = pk2(k0 * rk * g2.x, k1 * rk * g2.y);
            if (lane < 16) { const int p1 = 8 * (j >> 2) + (j & 3); KPE[(size_t)m * ROPE + p1] = f2bf(x1[u] * cs[u] - x2[u] * sn[u]); KPE[(size_t)m * ROPE + p1 + 4] = f2bf(x2[u] * cs[u] + x1[u] * sn[u]); } }
    }
}

__device__ __forceinline__ void phase_hy_out(Frame& F, int l) {
    const GAS bf16* YT = (const GAS bf16*)(wsq(F) + WS_YT); GAS bf16* MIX = (GAS bf16*)(wsq(F) + WS_MIX); const GAS float* gn = inp(F, I_GNHY) + l * HYW;
    LAS bf16* tl = (LAS bf16*)(F.lds + RING_OFF + F.wave * 16384);
    const int gw = F.vcu * NWAVES + F.wave, NGW = F.G * NWAVES, lane = F.lane;
    for (int task = gw; task < 8 * (M / 64); task += NGW) {
        const int g = task & 7, tb = task >> 3, tok0 = tb * 64; const int cl = lane >> 3, t8 = (lane & 7) * 8;
        float v[8][8]; float ss[8]; const int ln_ = hw_lane();
#pragma unroll
        for (int j = 0; j < 8; ++j) ss[j] = 0.f;
#pragma unroll
        for (int i = 0; i < 8; ++i) { const int ch = g * 64 + 8 * i + cl; const v4u w = *(const GAS v4u*)(YT + (size_t)ch * M + tok0 + t8);
            v[i][0] = bf2f(w.x & 0xffffu); v[i][1] = bf2f(w.x >> 16); v[i][2] = bf2f(w.y & 0xffffu); v[i][3] = bf2f(w.y >> 16);
            v[i][4] = bf2f(w.z & 0xffffu); v[i][5] = bf2f(w.z >> 16); v[i][6] = bf2f(w.w & 0xffffu); v[i][7] = bf2f(w.w >> 16);
#pragma unroll
            for (int j = 0; j < 8; ++j) ss[j] += v[i][j] * v[i][j]; }
#pragma unroll
        for (int j = 0; j < 8; ++j) { float s = ss[j]; s += shx(s, ln_, 8); s += shx(s, ln_, 16); s += shx(s, ln_, 32); ss[j] = 1.0f / sqrtf(s * (1.0f / 64.0f) + EPS); }
#pragma unroll
        for (int i = 0; i < 8; ++i) { const int cc = 8 * i + cl; const float gg = gn[g * 64 + cc];
#pragma unroll
            for (int j = 0; j < 8; ++j) tl[(t8 + j) * 72 + cc] = f2bf(v[i][j] * ss[j] * gg); }
        LDS_WAIT(); asm volatile("" ::: "memory");
#pragma unroll
        for (int i = 0; i < 8; ++i) { const int tok = 8 * i + (lane >> 3), c8 = (lane & 7) * 8; const v4u w = *(const LAS v4u*)(tl + tok * 72 + c8);
            *(GAS v4u*)(MIX + (size_t)(tok0 + tok) * D + g * 64 + c8) = w; }
        LDS_WAIT(); asm volatile("" ::: "memory");
    }
}

namespace att {
using s16x4 = __attribute__((ext_vector_type(4))) short;
using f32x16 = __attribute__((ext_vector_type(16))) float;
using u32x4 = __attribute__((ext_vector_type(4))) unsigned;
constexpr int QBLK = 32, KVBLK = 64, NW = 8;
constexpr float SCALE = 0.10206207261596575f;
constexpr float THR = 8.f;
constexpr int SHM_K = KVBLK * 256, SHM_V = KVBLK * DV * 2;
constexpr int NSLOT = 4;
constexpr int OFF_V = 0, OFF_K = NSLOT * SHM_V, OFF_WS = OFF_K + NSLOT * SHM_K, SHM_ATTN = OFF_WS + NW * 64 * 4;
#define KSWZ(row, colB) ((row) * 256 + ((colB) ^ (((row) & 15) << 4)))
#define SBAR() __builtin_amdgcn_sched_barrier(0)
__device__ __forceinline__ int crow(int r, int hi) { return (r & 3) + 8 * (r >> 2) + 4 * hi; }
__device__ __forceinline__ unsigned cvtpk(float lo, float hi) { unsigned r; asm volatile("v_cvt_pk_bf16_f32 %0, %1, %2" : "=v"(r) : "v"(lo), "v"(hi)); return r; }
constexpr float THRL = THR * 1.4426950408889634f;
#define EX2(v) ((ABL & 1) ? (v) : __builtin_amdgcn_exp2f(v))
#define MX3(a, b, c) ((ABL & 128) ? (a) : __builtin_fmaxf(__builtin_fmaxf((a), (b)), (c)))
__device__ __forceinline__ int v_st(int k, int c) { const int kk = k; return ((kk >> 3) * 2 + (c >> 5)) * 512 + ((kk & 7) * 32 + (c & 31)) * 2; }
__device__ __forceinline__ int v_rd_base(int lane) { return ((lane & 3) << 3) | (((lane >> 2) & 3) << 6) | (((lane >> 4) & 1) << 5) | (((lane >> 5) & 1) << 8); }
constexpr int v_rd_off(int d0, int ks, int half) { return d0 * 512 + ks * 2048 + half * 1024; }
template <int OFF> __device__ __forceinline__ s16x4 tr_read(int vb) { s16x4 r; asm volatile("ds_read_b64_tr_b16 %0, %1 offset:%2" : "=&v"(r) : "v"(vb), "i"(OFF) : "memory"); return r; }
template <int ABL> __device__ __forceinline__ void attn_unit(const bf16* Qb_, const bf16* KNh_, const bf16* KPEb_, const bf16* Vh_, bf16* Mo_,
                                          const float* gain_, const float* ct_, const float* st_, int tpos0, LAS char* lds, const int wave0) {
  const GAS bf16* Qb = (const GAS bf16*)Qb_; const GAS bf16* KNh = (const GAS bf16*)KNh_; const GAS bf16* KPEb = (const GAS bf16*)KPEb_; const GAS bf16* Vh = (const GAS bf16*)Vh_; GAS bf16* Mo = (GAS bf16*)Mo_;
  const GAS float* gain = (const GAS float*)gain_; const GAS float* ct = (const GAS float*)ct_; const GAS float* st = (const GAS float*)st_;

  int tid_ = tid_from_wave(wave0);
  const int tid = tid_, wid = tid >> 6, lane = tid & 63, r32 = lane & 31, hi = lane >> 5;
  LAS char* V_lds = lds + OFF_V; LAS char* K_lds = lds + OFF_K;
  LAS float* ws = (LAS float*)(lds + OFF_WS) + wid * 64; LAS float* li_l = ws; LAS float* al_l = ws + 32;
  float m_reg = 0.f, l_reg = 0.f; f32x16 o[2] = {}; f32x16 negm = {}; bf16x8 qr[6];
  const GAS bf16* Qw = Qb + (long)(wid * QBLK + r32) * NQ + hi * 8;
#pragma unroll
  for (int d0 = 0; d0 < 6; ++d0) qr[d0] = *reinterpret_cast<const GAS bf16x8*>(Qw + d0 * 16);
  { const int tq = tpos0 + wid * QBLK + r32;
#pragma unroll
    for (int d0 = 4; d0 < 6; ++d0) { const int fq = 2 * (d0 - 4) + hi; const f32x4 cs = *reinterpret_cast<const GAS f32x4*>(ct + tq * 16 + 4 * fq), sn = *reinterpret_cast<const GAS f32x4*>(st + tq * 16 + 4 * fq);
      const u32x4 w = __builtin_bit_cast(u32x4, qr[d0]);
      const f32x4 x1 = {bf2f(w[0] & 0xffffu), bf2f(w[0] >> 16), bf2f(w[1] & 0xffffu), bf2f(w[1] >> 16)}, x2 = {bf2f(w[2] & 0xffffu), bf2f(w[2] >> 16), bf2f(w[3] & 0xffffu), bf2f(w[3] >> 16)};
      const f32x4 a = x1 * cs - x2 * sn, b = x2 * cs + x1 * sn;
      const u32x4 o4 = {cvtpk(a[0], a[1]), cvtpk(a[2], a[3]), cvtpk(b[0], b[1]), cvtpk(b[2], b[3])}; qr[d0] = __builtin_bit_cast(bf16x8, o4); } }
  { constexpr float C = SCALE * 1.4426950408889634f;
#pragma unroll
    for (int d0 = 0; d0 < 6; ++d0) { const u32x4 w = __builtin_bit_cast(u32x4, qr[d0]); u32x4 o4;
#pragma unroll
      for (int e = 0; e < 4; ++e) o4[e] = cvtpk(bf2f(w[e] & 0xffffu) * C, bf2f(w[e] >> 16) * C);
      qr[d0] = __builtin_bit_cast(bf16x8, o4); } }
  const int vb0 = (int)(unsigned)(uintptr_t)V_lds + v_rd_base(lane);
  const int wid_s = __builtin_amdgcn_readfirstlane(wid);
  const GAS bf16* ksrc[2]; long kstep[2];
#pragma unroll
  for (int q = 0; q < 2; ++q) { const int r = 4 * (2 * wid + q) + (lane >> 4), c = (lane & 15) ^ (r & 15); const bool rope = (c >= 8) && (c < 12);
    ksrc[q] = rope ? KPEb + (long)r * ROPE + (c - 8) * 8 : KNh + (long)r * NKV + (c & 7) * 8; kstep[q] = rope ? (long)KVBLK * ROPE : (long)KVBLK * NKV; }
  const GAS bf16* vsrc; { const int p = 64 * wid + lane, sub = p >> 5, kk = (sub >> 1) * 8 + ((p >> 2) & 7), col = (sub & 1) * 32 + (p & 3) * 8; vsrc = Vh + (long)kk * NKV + col; }
#define DMA(t, slot) do { if (ABL & 32) break; \
    __builtin_amdgcn_global_load_lds((const GAS unsigned*)(ksrc[0] + (long)(t) * kstep[0]), (LAS unsigned*)(K_lds + (slot) * SHM_K + (2 * wid_s) * 1024), 16, 0, 0); \
    __builtin_amdgcn_global_load_lds((const GAS unsigned*)(ksrc[1] + (long)(t) * kstep[1]), (LAS unsigned*)(K_lds + (slot) * SHM_K + (2 * wid_s + 1) * 1024), 16, 0, 0); \
    __builtin_amdgcn_global_load_lds((const GAS unsigned*)(vsrc + (long)(t) * ((long)KVBLK * NKV)), (LAS unsigned*)(V_lds + (slot) * SHM_V + wid_s * 1024), 16, 0, 0); } while (0)
#define TBAR(N) do { asm volatile("s_waitcnt vmcnt(" #N ") lgkmcnt(0)" ::: "memory"); if (!(ABL & 64)) __builtin_amdgcn_s_barrier(); asm volatile("" ::: "memory"); } while (0)
#define RESC(a) do { if (__any((a) < 1.f)) { if (hi == 0) al_l[r32] = (a); asm volatile("s_waitcnt lgkmcnt(0)" ::: "memory"); \
    _Pragma("unroll") for (int d = 0; d < 2; ++d) _Pragma("unroll") for (int r = 0; r < 16; ++r) o[d][r] *= al_l[crow(r, hi)]; } } while (0)
  f32x16 pA0, pA1, pB0, pB1; bf16x8 pa0, pa1, pa2, pa3; constexpr int NTL = L / KVBLK; constexpr int SE = 0, SO = 1;
  int koff[6];
#pragma unroll
  for (int d0 = 0; d0 < 6; ++d0) koff[d0] = KSWZ(r32, (d0 * 16 + hi * 8) * 2);
  s16x4 vl[4], vh[4]; float pmax = 0.f, alpha = 1.f;
#define KFR(i) ((ABL & 8) ? qr[(i) >> 1] : *(const LAS bf16x8*)(kbase + koff[(i) >> 1] + ((i) & 1) * 8192))
#define MQK(a_, b_, c_) ((ABL & 2) ? (c_) : __builtin_amdgcn_mfma_f32_32x32x16_bf16(a_, b_, c_, 0, 0, 0))
#define MPV(a_, b_, c_) ((ABL & 4) ? (c_) : __builtin_amdgcn_mfma_f32_32x32x16_bf16(a_, b_, c_, 0, 0, 0))
#define VRD8(D0) do { if (ABL & 16) break; vl[0] = tr_read<v_rd_off(D0, 0, 0)>(vbq); vh[0] = tr_read<v_rd_off(D0, 0, 1)>(vbq); vl[1] = tr_read<v_rd_off(D0, 1, 0)>(vbq); vh[1] = tr_read<v_rd_off(D0, 1, 1)>(vbq); \
    vl[2] = tr_read<v_rd_off(D0, 2, 0)>(vbq); vh[2] = tr_read<v_rd_off(D0, 2, 1)>(vbq); vl[3] = tr_read<v_rd_off(D0, 3, 0)>(vbq); vh[3] = tr_read<v_rd_off(D0, 3, 1)>(vbq); } while (0)
#define VWAIT() if (!(ABL & 16)) asm volatile("s_waitcnt lgkmcnt(0)" : "+v"(vl[0]), "+v"(vh[0]), "+v"(vl[1]), "+v"(vh[1]), "+v"(vl[2]), "+v"(vh[2]), "+v"(vl[3]), "+v"(vh[3]) :: "memory")
#define VFR(k) (bf16x8){vl[k][0], vl[k][1], vl[k][2], vl[k][3], vh[k][0], vh[k][1], vh[k][2], vh[k][3]}
#define PKA(P, B) do { if (ABL & 256) break; w0_ = cvtpk(P[B + 0], P[B + 1]); w1_ = cvtpk(P[B + 2], P[B + 3]); } while (0)
#define PKB(P, B, OUT) do { if (ABL & 256) { OUT = qr[0]; break; } const u32x4 w_ = {w0_, w1_, cvtpk(P[B + 4], P[B + 5]), cvtpk(P[B + 6], P[B + 7])}; OUT = __builtin_bit_cast(bf16x8, w_); } while (0)
#define R1(DO_QK, DO_FIN, X0, X1, Y0, Y1, KSLOT) do { const LAS char* kbase = K_lds + (KSLOT) * SHM_K; bf16x8 kf0, kf1, kf2, kf3; unsigned w0_ = 0, w1_ = 0; \
    if (DO_QK) { kf0 = KFR(0); kf1 = KFR(1); kf2 = KFR(2); } SBAR(); \
      if (DO_QK) { kf3 = KFR(3); X0 = MQK(kf0, qr[0], negm); } if (DO_FIN) { Y0[0] = EX2(Y0[0]); Y0[1] = EX2(Y0[1]); Y0[2] = EX2(Y0[2]); Y0[3] = EX2(Y0[3]); } SBAR(); \
      if (DO_QK) { kf0 = KFR(4); X1 = MQK(kf1, qr[0], negm); } if (DO_FIN) { Y0[4] = EX2(Y0[4]); Y0[5] = EX2(Y0[5]); Y0[6] = EX2(Y0[6]); Y0[7] = EX2(Y0[7]); } SBAR(); \
      if (DO_QK) { kf1 = KFR(5); X0 = MQK(kf2, qr[1], X0); } if (DO_FIN) { Y0[8] = EX2(Y0[8]); Y0[9] = EX2(Y0[9]); Y0[10] = EX2(Y0[10]); Y0[11] = EX2(Y0[11]); } SBAR(); \
      if (DO_QK) { kf2 = KFR(6); X1 = MQK(kf3, qr[1], X1); } if (DO_FIN) { Y0[12] = EX2(Y0[12]); Y0[13] = EX2(Y0[13]); Y0[14] = EX2(Y0[14]); Y0[15] = EX2(Y0[15]); } SBAR(); \
      if (DO_QK) { kf3 = KFR(7); X0 = MQK(kf0, qr[2], X0); } if (DO_FIN) { Y1[0] = EX2(Y1[0]); Y1[1] = EX2(Y1[1]); Y1[2] = EX2(Y1[2]); Y1[3] = EX2(Y1[3]); PKA(Y0, 0); } SBAR(); \
      if (DO_QK) { kf0 = KFR(8); X1 = MQK(kf1, qr[2], X1); } if (DO_FIN) { Y1[4] = EX2(Y1[4]); Y1[5] = EX2(Y1[5]); Y1[6] = EX2(Y1[6]); Y1[7] = EX2(Y1[7]); PKB(Y0, 0, pa0); } SBAR(); \
      if (DO_QK) { kf1 = KFR(9); X0 = MQK(kf2, qr[3], X0); } if (DO_FIN) { Y1[8] = EX2(Y1[8]); Y1[9] = EX2(Y1[9]); Y1[10] = EX2(Y1[10]); Y1[11] = EX2(Y1[11]); PKA(Y0, 8); } SBAR(); \
      if (DO_QK) { kf2 = KFR(10); X1 = MQK(kf3, qr[3], X1); } if (DO_FIN) { Y1[12] = EX2(Y1[12]); Y1[13] = EX2(Y1[13]); Y1[14] = EX2(Y1[14]); Y1[15] = EX2(Y1[15]); PKB(Y0, 8, pa1); } SBAR(); \
      if (DO_QK) { kf3 = KFR(11); X0 = MQK(kf0, qr[4], X0); } if (DO_FIN) { PKA(Y1, 0); } SBAR(); \
      if (DO_QK) { X1 = MQK(kf1, qr[4], X1); } if (DO_FIN) { PKB(Y1, 0, pa2); } SBAR(); \
      if (DO_QK) { X0 = MQK(kf2, qr[5], X0); } if (DO_FIN) { PKA(Y1, 8); } SBAR(); \
      if (DO_QK) { X1 = MQK(kf3, qr[5], X1); } if (DO_FIN) { PKB(Y1, 8, pa3); } SBAR(); \
  } while (0)
#define R2(DO_PV, DO_MAX, X0, X1, Y0, Y1, VSLOT, LOADS) do { const int vbq = vb0 + (VSLOT) * SHM_V; float ma_ = 0.f, mb_ = 0.f, sa_ = 0.f; \
    if (DO_PV) { VRD8(0); } SBAR(); \
    if (DO_PV) { VWAIT(); o[0] = MPV(pa0, VFR(0), o[0]); if (!(ABL & 640)) sa_ = (Y0[0] + Y0[1]) + (Y0[2] + Y0[3]); } SBAR(); \
    if (DO_PV) { o[0] = MPV(pa1, VFR(1), o[0]); if (!(ABL & 640)) sa_ += Y0[4]; if (!(ABL & 640)) sa_ += Y0[5]; if (!(ABL & 640)) sa_ += Y0[6]; if (!(ABL & 640)) sa_ += Y0[7]; } LOADS; SBAR(); \
    if (DO_PV) { o[0] = MPV(pa2, VFR(2), o[0]); if (!(ABL & 640)) sa_ += Y0[8]; if (!(ABL & 640)) sa_ += Y0[9]; if (!(ABL & 640)) sa_ += Y0[10]; if (!(ABL & 640)) sa_ += Y0[11]; } SBAR(); \
    if (DO_PV) { o[0] = MPV(pa3, VFR(3), o[0]); if (!(ABL & 640)) sa_ += Y0[12]; if (!(ABL & 640)) sa_ += Y0[13]; if (!(ABL & 640)) sa_ += Y0[14]; if (!(ABL & 640)) sa_ += Y0[15]; } SBAR(); \
    if (DO_PV) { VRD8(1); if (!(ABL & 640)) sa_ += Y1[0]; if (!(ABL & 640)) sa_ += Y1[1]; if (!(ABL & 640)) sa_ += Y1[2]; if (!(ABL & 640)) sa_ += Y1[3]; if (!(ABL & 640)) sa_ += Y1[4]; if (!(ABL & 640)) sa_ += Y1[5]; if (!(ABL & 640)) sa_ += Y1[6]; if (!(ABL & 640)) sa_ += Y1[7]; } \
    if (DO_MAX) { ma_ = MX3(X0[0], X0[1], X1[0]); mb_ = MX3(X0[2], X0[3], X1[1]); ma_ = MX3(ma_, X1[2], X1[3]); ma_ = MX3(ma_, X0[4], X0[5]); mb_ = MX3(mb_, X0[6], X0[7]); ma_ = MX3(ma_, X1[4], X1[5]); mb_ = MX3(mb_, X1[6], X1[7]); } SBAR(); \
    if (DO_PV) { VWAIT(); o[1] = MPV(pa0, VFR(0), o[1]); if (!(ABL & 640)) sa_ += Y1[8]; if (!(ABL & 640)) sa_ += Y1[9]; if (!(ABL & 640)) sa_ += Y1[10]; if (!(ABL & 640)) sa_ += Y1[11]; } if (DO_MAX) { ma_ = MX3(ma_, X0[8], X0[9]); mb_ = MX3(mb_, X0[10], X0[11]); } SBAR(); \
    if (DO_PV) { o[1] = MPV(pa1, VFR(1), o[1]); if (!(ABL & 640)) sa_ += Y1[12]; if (!(ABL & 640)) sa_ += Y1[13]; if (!(ABL & 640)) sa_ += Y1[14]; if (!(ABL & 640)) sa_ += Y1[15]; } if (DO_MAX) { ma_ = MX3(ma_, X1[8], X1[9]); mb_ = MX3(mb_, X1[10], X1[11]); } SBAR(); \
    if (DO_PV) { o[1] = MPV(pa2, VFR(2), o[1]); l_reg += sa_; if (ABL & 512) { o[0] = MPV(pa0, qr[0], o[0]); o[0] = MPV(pa1, qr[0], o[0]); } } if (DO_MAX) { ma_ = MX3(ma_, X0[12], X0[13]); mb_ = MX3(mb_, X0[14], X0[15]); ma_ = MX3(ma_, X1[12], X1[13]); mb_ = MX3(mb_, X1[14], X1[15]); } SBAR(); \
    if (DO_PV) { o[1] = MPV(pa3, VFR(3), o[1]); if (ABL & 512) { o[0] = MPV(pa2, qr[0], o[0]); o[0] = MPV(pa3, qr[0], o[0]); } } if (DO_MAX) { float m_ = __builtin_fmaxf(ma_, mb_); auto rr_ = __builtin_amdgcn_permlane32_swap(__float_as_uint(m_), __float_as_uint(m_), false, false); pmax = __builtin_fmaxf(__uint_as_float(rr_[0]), __uint_as_float(rr_[1])); } SBAR(); \
  } while (0)
#define DECIDE(FIRST, X0, X1) do { alpha = 1.f; \
    if ((FIRST) || !__builtin_expect(__all(pmax <= THRL), 1)) { const float d_ = (FIRST) ? pmax : __builtin_fmaxf(pmax, 0.f); m_reg += d_; if (!(FIRST)) alpha = EX2(-d_); \
      _Pragma("unroll") for (int r = 0; r < 16; ++r) { X0[r] -= d_; X1[r] -= d_; } \
      _Pragma("unroll") for (int r = 0; r < 16; ++r) negm[r] = -m_reg; l_reg *= alpha; } \
    RESC(alpha); } while (0)
  DMA(0, 0); DMA(1, 1);
  TBAR(3);
  R1(true, false, pA0, pA1, pB0, pB1, 0);
  R2(false, true, pA0, pA1, pB0, pB1, 0, DMA(2, 2));
  DECIDE(true, pA0, pA1);
  TBAR(3);
  for (int j = 1; j + 1 < NTL; j += 2) {
    R1(true, true, pB0, pB1, pA0, pA1, j & 3);
    R2(true, true, pB0, pB1, pA0, pA1, (j - 1) & 3, DMA(j + 2, (j + 2) & 3));
    DECIDE(false, pB0, pB1);
    TBAR(3);
    R1(true, true, pA0, pA1, pB0, pB1, (j + 1) & 3);
    R2(true, true, pA0, pA1, pB0, pB1, j & 3, if (j + 3 < NTL) DMA(j + 3, (j + 3) & 3));
    DECIDE(false, pA0, pA1);
    if (j + 3 < NTL) TBAR(3); else TBAR(0);
  }
  R1(true, true, pB0, pB1, pA0, pA1, (NTL - 1) & 3);
  R2(true, true, pB0, pB1, pA0, pA1, (NTL - 2) & 3, (void)0);
  DECIDE(false, pB0, pB1);
  R1(false, true, pA0, pA1, pB0, pB1, 0);
  R2(true, false, pA0, pA1, pB0, pB1, (NTL - 1) & 3, (void)0);
#undef DECIDE
#undef R2
#undef R1
#undef PKA
#undef PKB
#undef VFR
#undef VWAIT
#undef VRD8
#undef KFR
  { auto rr = __builtin_amdgcn_permlane32_swap(__float_as_uint(l_reg), __float_as_uint(l_reg), false, false); l_reg = __uint_as_float(rr[0]) + __uint_as_float(rr[1]); }
  if (hi == 0) li_l[r32] = l_reg; asm volatile("s_waitcnt lgkmcnt(0)" ::: "memory");
  const float g0 = gain[r32], g1 = gain[32 + r32]; const int ln_ = hw_lane();
  GAS bf16* Ow = Mo + (long)(wid * QBLK) * D;
#pragma unroll
  for (int r = 0; r < 16; ++r) { const int orow = crow(r, hi); const float rl = __builtin_amdgcn_rcpf(li_l[orow]);
    const float y0 = o[0][r] * rl, y1 = o[1][r] * rl; float s = y0 * y0 + y1 * y1;
    s += shx(s, ln_, 1); s += shx(s, ln_, 2); s += shx(s, ln_, 4); s += shx(s, ln_, 8); s += shx(s, ln_, 16);
    const float rs = 1.0f / sqrtf(s * (1.0f / 64.0f) + EPS);
    Ow[(long)orow * D + r32] = f2bf(y0 * rs * g0); Ow[(long)orow * D + 32 + r32] = f2bf(y1 * rs * g1); }
  __syncthreads();
#undef DMA
#undef TBAR
#undef RESC
}
#undef EX2
#undef MX3
#undef KSWZ
#undef SBAR
}
#define XB_TMO      128
#define XB_XCNT(j)  (256  + 64 * (j))
#define XB_XSUB(j)  (1280 + 64 * (j))
#define XB_XGEN(j)  (2304 + 64 * (j))
#define XB_TOP      3328
#define XB_TOPGEN   3392
#define XCD_BAR_WORDS 3456
#define XB_SPIN_CAP (1u << 18)

__device__ __forceinline__ unsigned xb_ld(unsigned* p)              { return __hip_atomic_load(p, __ATOMIC_RELAXED, __HIP_MEMORY_SCOPE_AGENT); }
__device__ __forceinline__ unsigned xb_add(unsigned* p, unsigned v) { return __hip_atomic_fetch_add(p, v, __ATOMIC_RELAXED, __HIP_MEMORY_SCOPE_AGENT); }
__device__ __forceinline__ unsigned xb_xcc_id() { return (unsigned)__builtin_amdgcn_s_getreg((3 << 11) | 20) & 0xFu; }
#define XB_SPIN(cond, bar) do { unsigned _sp = 0; while (cond) { __builtin_amdgcn_s_sleep(1); \
    if ((++_sp & 255u) == 0u) { if (xb_ld(&(bar)[XB_TMO])) break; if (_sp > XB_SPIN_CAP) { atomicAdd(&(bar)[XB_TMO], 1u); break; } } } } while (0)

struct XcdBarrier {
    unsigned* bar; unsigned x;
    volatile LAS unsigned* st;
};

__device__ __forceinline__ XcdBarrier xcd_barrier_post(unsigned* bar, volatile LAS unsigned* st, const bool t0) {
    XcdBarrier b; b.bar = bar; b.x = xb_xcc_id(); b.st = st;
    if (t0) (void)xb_add(&bar[XB_XCNT(b.x)], 1u);
    return b;
}
__device__ __forceinline__ void xcd_barrier_complete(unsigned* bar, unsigned x, unsigned& nloc, unsigned& nx) {
    const unsigned G = gridDim.x * gridDim.y * gridDim.z;
    unsigned sum, cnt, mine, sp = 0u;
    for (;;) {
        sum = 0u; cnt = 0u; mine = 0u;
#pragma unroll
        for (unsigned j = 0; j < 16; ++j) { const unsigned c = xb_ld(&bar[XB_XCNT(j)]); sum += c; cnt += (c > 0u) ? 1u : 0u; mine = (j == x) ? c : mine; }
        if (sum == G) break;
        __builtin_amdgcn_s_sleep(1);
        if ((++sp & 255u) == 0u) { if (xb_ld(&bar[XB_TMO])) break; if (sp > XB_SPIN_CAP) { atomicAdd(&bar[XB_TMO], 1u); break; } }
    }
    nloc = mine > 0u ? mine : 1u; nx = cnt > 0u ? cnt : 1u;
}

__device__ __forceinline__ void xcd_barrier(const XcdBarrier& b, const bool t0) {
    asm volatile("s_waitcnt vmcnt(0)" ::: "memory");
    __syncthreads();
    if (t0) {
        unsigned* bar = b.bar;
        __builtin_amdgcn_s_waitcnt(0);
        unsigned nloc = b.st[0], nx = b.st[1];
        if (nloc == 0u) { xcd_barrier_complete(bar, b.x, nloc, nx); b.st[0] = nloc; b.st[1] = nx; }
        const unsigned old = xb_add(&bar[XB_XSUB(b.x)], 1u);
        const unsigned gen = old / nloc;
        if (old + 1u == (gen + 1u) * nloc) {
            __builtin_amdgcn_fence(__ATOMIC_RELEASE, "agent");
            asm volatile("s_waitcnt vmcnt(0)" ::: "memory");
            const unsigned og = xb_add(&bar[XB_TOP], 1u);
            const unsigned tg = og / nx;
            if (og + 1u == (tg + 1u) * nx) xb_add(&bar[XB_TOPGEN], 1u);
            else XB_SPIN(xb_ld(&bar[XB_TOPGEN]) == tg, bar);
            __builtin_amdgcn_fence(__ATOMIC_ACQUIRE, "agent");
            xb_add(&bar[XB_XGEN(b.x)], 1u);
            asm volatile("s_waitcnt vmcnt(0)" ::: "memory");
        } else {
            XB_SPIN(xb_ld(&bar[XB_XGEN(b.x)]) == gen, bar);
            __builtin_amdgcn_fence(__ATOMIC_ACQUIRE, "agent");
            asm volatile("s_waitcnt vmcnt(0)" ::: "memory");
        }
    }
    __syncthreads();
}

__device__ __forceinline__ void xcd_barrier_fast(const XcdBarrier& b, const bool t0) {
    asm volatile("s_waitcnt vmcnt(0)" ::: "memory");
    __syncthreads();
    if (t0) {
        unsigned* bar = b.bar; asm volatile("" : "+s"(bar));
        __builtin_amdgcn_s_waitcnt(0);
        unsigned nloc = b.st[0], nx = b.st[1];
        unsigned bx_ = b.x; asm volatile("" : "+s"(bx_));
        const unsigned old = xb_add(&bar[XB_XSUB(bx_)], 1u);
        const unsigned gen = old / nloc;
        if (old + 1u == (gen + 1u) * nloc) {
            __builtin_amdgcn_fence(__ATOMIC_RELEASE, "agent");
            asm volatile("s_waitcnt vmcnt(0)" ::: "memory");
            const unsigned og = xb_add(&bar[XB_TOP], 1u);
            const unsigned tg = og / nx;
            if (og + 1u == (tg + 1u) * nx) xb_add(&bar[XB_TOPGEN], 1u);
            else XB_SPIN(xb_ld(&bar[XB_TOPGEN]) == tg, bar);
            __builtin_amdgcn_fence(__ATOMIC_ACQUIRE, "agent");
            xb_add(&bar[XB_XGEN(bx_)], 1u);
            asm volatile("s_waitcnt vmcnt(0)" ::: "memory");
        } else {
            XB_SPIN(xb_ld(&bar[XB_XGEN(bx_)]) == gen, bar);
            __builtin_amdgcn_fence(__ATOMIC_ACQUIRE, "agent");
            asm volatile("s_waitcnt vmcnt(0)" ::: "memory");
        }
    }
    __syncthreads();
}

constexpr int CW_BAR = 4096;
struct Args { const float* in[26]; float* out; unsigned char* ws; };
#ifndef REP_ATT
#define REP_ATT 1
#endif
#ifndef REP_GEMM
#define REP_GEMM 1
#endif
#ifndef REP_HY
#define REP_HY 1
#endif
#ifndef REP_FILT
#define REP_FILT 1
#endif
#ifndef REP_PREP
#define REP_PREP 1
#endif
#ifndef REP_HYOUT
#define REP_HYOUT 1
#endif
#ifndef REP_MISC
#define REP_MISC 1
#endif
#ifndef PROBE_MASK
#define PROBE_MASK 0
#endif
#define TIC() do { if (PROBE_MASK) pr_t0 = __builtin_amdgcn_s_memrealtime(); } while (0)
#define TOC(ph) do { if (PROBE_MASK & (1u << (ph))) pr_acc += __builtin_amdgcn_s_memrealtime() - pr_t0; } while (0)
#define REPEAT(n) _Pragma("unroll 1") for (int rep_ = 0; rep_ < (n); ++rep_)
#define REFRESH() do { const int t_ = tid_from_wave(F.wave0); F.tid = t_; F.lane = t_ & 63; F.wave = __builtin_amdgcn_readfirstlane(t_ >> 6); int v_ = F.vcu; asm volatile("" : "+s"(v_)); F.vcu = v_; } while (0)
#define BXQ() ({ int b_ = (int)blockIdx.x; asm volatile("" : "+s"(b_)); b_; })
#define GEMM_PHASE(EPI, g, S, E) REPEAT(REP_GEMM) pg8::gemm_phase<EPI, pg8::StaticOrder, true, true>(F.lds + RING_OFF, g, S, E, F.wave0)

__global__ void __launch_bounds__(NTHR, 2) hyena_mla_fwd(Args args) {
    extern __shared__ __attribute__((aligned(16))) unsigned char lds[];
    Frame F;
    F.lds = (LAS unsigned char*)lds;
    F.MISC = (volatile LAS unsigned*)(F.lds + MISC_OFF);
    F.tid = threadIdx.x; F.lane = F.tid & 63; F.wave = __builtin_amdgcn_readfirstlane(F.tid >> 6); F.wave0 = F.wave;
    F.G = gridDim.x; { const int bx = blockIdx.x; F.vcu = (F.G % 8 == 0) ? (bx % 8) * (F.G / 8) + bx / 8 : bx; }
    F.ws = args.ws; F.out = args.out; F.ctl = (gu32*)(args.ws + WS_CTL);
    if (F.tid == 0) {
#pragma unroll
        for (int i = 0; i < 26; ++i) *(LAS unsigned long long*)(F.lds + PTRTAB_OFF + 8 * i) = (unsigned long long)args.in[i];
    }
    for (int u = F.tid; u < 512 / 4; u += NTHR) ((LAS unsigned*)(F.lds + LDSCTL_OFF))[u] = 0u;
    __syncthreads();
    XcdBarrier bar = xcd_barrier_post((unsigned*)(F.ctl + CW_BAR), F.MISC + 8, F.tid == 0);
    xcd_barrier(bar, F.tid == 0);
    unsigned long long pr_t0 = 0, pr_acc = 0; (void)pr_t0;
#pragma unroll 1
    for (int l = 0; l < DEPTH; ++l) {
        TIC();
        REPEAT(REP_MISC) { REFRESH(); phase_weights(F, l); }
        __syncthreads();
        REFRESH(); phase_filter_mlp(F, l);
        if (l == 0) { REFRESH(); phase_rope_tab(F); REFRESH(); phase_norm_first(F, 0, inp(F, I_NMIXPRE)); }
        { REFRESH(); xcd_barrier_fast(bar, F.tid == 0); } TOC(0); TIC();
        { unsigned char* w = (unsigned char*)wsq(F); pg8::Gemm g{(bf16*)(w + WS_W3T), (bf16*)(w + WS_H2), 2048, L, 128}; pg8::StaticOrder S; S.init(2048, L, F.G, BXQ());
          pg8::EpiTaps E{(float*)(w + WS_KT), (const float*)inp(F, I_DECAY) + (size_t)l * 2048}; GEMM_PHASE(pg8::EpiTaps, g, S, E); }
        { REFRESH(); xcd_barrier_fast(bar, F.tid == 0); } TOC(1); TIC();
        REPEAT(REP_FILT) { REFRESH(); phase_filter_fft(F, l); }
        { REFRESH(); xcd_barrier_fast(bar, F.tid == 0); } TOC(2); TIC();
        { unsigned char* w = (unsigned char*)wsq(F); bf16* WinT = (bf16*)(w + WS_WIN); bf16* XN = (bf16*)(w + WS_XN); bf16* UT = (bf16*)(w + WS_UT); bf16* CQKV = (bf16*)(w + WS_CQKV);
          { pg8::Gemm g{WinT, XN, HYP, M, D}; pg8::StaticOrder S; S.init(HYP, M, F.G, BXQ());
          pg8::EpiBf16<0> E{UT, M, nullptr, 0, 0, 1.f}; GEMM_PHASE(pg8::EpiBf16<0>, g, S, E); }
        { pg8::Gemm g{XN, WinT + (size_t)HYP * D, M, 512, D}; pg8::StaticOrder S; S.init(M, 512, F.G, (BXQ() + 128) % F.G);
          pg8::EpiBf16<0> E{CQKV, 512, nullptr, 0, 0, 1.f}; GEMM_PHASE(pg8::EpiBf16<0>, g, S, E); } }
        { REFRESH(); xcd_barrier_fast(bar, F.tid == 0); } TOC(3); TIC();
        REPEAT(REP_PREP) { REFRESH(); phase_mla_prep(F, l); }
        REPEAT(REP_HY) { REFRESH(); phase_hyena(F, l); }
        { REFRESH(); xcd_barrier_fast(bar, F.tid == 0); } TOC(4); TIC();
        { unsigned char* w = (unsigned char*)wsq(F); bf16* CQN = (bf16*)(w + WS_CQN); bf16* CKVN = (bf16*)(w + WS_CKVN); bf16* WuqT = (bf16*)(w + WS_WUQ); bf16* WukvT = (bf16*)(w + WS_WUKV);
          bf16* Qb = (bf16*)(w + WS_Q); bf16* KV = (bf16*)(w + WS_KN);
          { pg8::Gemm g{CQN, WuqT, M, NQ, QR}; pg8::StaticOrder S; S.init(M, NQ, F.G, BXQ());
          pg8::EpiBf16<0> E{Qb, NQ, nullptr, 0, 0, 1.f}; GEMM_PHASE(pg8::EpiBf16<0>, g, S, E); }
        { pg8::Gemm g{CKVN, WukvT, M, NKV, KVR}; pg8::StaticOrder S; S.init(M, NKV, F.G, BXQ());
          pg8::EpiBf16<0> E{KV, NKV, nullptr, 0, 0, 1.f}; GEMM_PHASE(pg8::EpiBf16<0>, g, S, E); } }
        { REFRESH(); xcd_barrier_fast(bar, F.tid == 0); } TOC(5); TIC();
        REFRESH();
        { unsigned char* w = (unsigned char*)wsq(F); bf16* Qb = (bf16*)(w + WS_Q); bf16* KV = (bf16*)(w + WS_KN); bf16* KPE = (bf16*)(w + WS_KPE); bf16* MIX = (bf16*)(w + WS_MIX);
          const float* ct = (const float*)(w + WS_COS); const float* st = (const float*)(w + WS_SIN); const float* gat = (const float*)inp(F, I_GNAT) + l * 512;
        REPEAT(REP_ATT) for (int i = 0; i < (F.G == 256 ? 6 : (1536 - F.vcu + F.G - 1) / F.G); ++i) {
            const int u_ = F.vcu + i * F.G; const int bh = F.G == 256 ? 3 * (F.vcu >> 5) + (i >> 1) : u_ >> 6, qb = F.G == 256 ? (i & 1) * 32 + (F.vcu & 31) : u_ & 63; const int b = bh >> 3, h = bh & 7;
            const size_t row0 = (size_t)b * L + (size_t)qb * 256;
            att::attn_unit<0>(Qb + row0 * NQ + h * DQ, KV + (size_t)b * L * NKV + h * 128, KPE + (size_t)b * L * ROPE, KV + (size_t)b * L * NKV + h * 128 + 64,
                           MIX + row0 * D + 512 + h * 64, gat + h * 64, ct, st, qb * 256, (LAS char*)(F.lds + RING_OFF), F.wave0);
        } }
        REPEAT(REP_HYOUT) { REFRESH(); phase_hy_out(F, l); }
        { REFRESH(); xcd_barrier_fast(bar, F.tid == 0); } TOC(6); TIC();
        { unsigned char* w = (unsigned char*)wsq(F); bf16* MIX = (bf16*)(w + WS_MIX); bf16* WoutT = (bf16*)(w + WS_WOUT); bf16* T = (bf16*)(w + WS_T);
          pg8::Gemm g{MIX, WoutT, M, D, D}; pg8::StaticOrder S; S.init(M, D, F.G, BXQ());
          pg8::EpiBf16<0> E{T, D, nullptr, 0, 0, 1.f}; GEMM_PHASE(pg8::EpiBf16<0>, g, S, E); }
        { REFRESH(); xcd_barrier_fast(bar, F.tid == 0); } TOC(7); TIC();
        REFRESH(); phase_norm_res(F, l, (const GAS bf16*)(wsq(F) + WS_T), inp(F, I_NMIXPOST) + l * D, inp(F, I_NMLPPRE) + l * D);
        { REFRESH(); xcd_barrier_fast(bar, F.tid == 0); } TOC(8); TIC();
#pragma unroll 1
        for (int ch = 0; ch < N_MLP_CHUNKS; ++ch) {
            { unsigned char* w = (unsigned char*)wsq(F); bf16* XN = (bf16*)(w + WS_XN); bf16* WupT = (bf16*)(w + WS_WUP); bf16* Hb = (bf16*)(w + WS_H);
              pg8::Gemm g{XN + (size_t)ch * MLP_CHUNK * D, WupT, MLP_CHUNK, FF, D}; pg8::StaticOrder S; S.init(MLP_CHUNK, FF, F.G, BXQ());
              pg8::EpiRelu2 E{Hb, FF}; GEMM_PHASE(pg8::EpiRelu2, g, S, E); }
            { REFRESH(); xcd_barrier_fast(bar, F.tid == 0); } TOC(9); TIC();
            { unsigned char* w = (unsigned char*)wsq(F); bf16* Hb = (bf16*)(w + WS_H); bf16* WdownT = (bf16*)(w + WS_WDOWN); bf16* T = (bf16*)(w + WS_T);
              pg8::Gemm g{Hb, WdownT, MLP_CHUNK, D, FF}; pg8::StaticOrder S; S.init(MLP_CHUNK, D, F.G, BXQ());
              pg8::EpiBf16<0> E{T + (size_t)ch * MLP_CHUNK * D, D, nullptr, 0, 0, 1.f}; GEMM_PHASE(pg8::EpiBf16<0>, g, S, E); }
            { REFRESH(); xcd_barrier_fast(bar, F.tid == 0); } TOC(10); TIC();
        }
        REFRESH(); phase_norm_res(F, 1, (const GAS bf16*)(wsq(F) + WS_T), inp(F, I_NMLPPOST) + l * D, (l + 1 < DEPTH) ? inp(F, I_NMIXPRE) + (l + 1) * D : (const GAS float*)nullptr);
        { REFRESH(); xcd_barrier_fast(bar, F.tid == 0); } TOC(11); TIC();
    }
    if (HYSUB) { __syncthreads(); pr_acc += (unsigned long long)__builtin_amdgcn_readfirstlane((int)F.MISC[21]); }
    if (PROBE_MASK || HYSUB) { const unsigned long long ts = __builtin_amdgcn_s_memrealtime(); while (__builtin_amdgcn_s_memrealtime() - ts < pr_acc) __builtin_amdgcn_s_sleep(8); }
}


#ifdef ATT_BENCH
__global__ void __launch_bounds__(NTHR, 2) attn_bench(Args args) {
    extern __shared__ __attribute__((aligned(16))) unsigned char lds[];
    unsigned char* w = args.ws; const int wave0 = __builtin_amdgcn_readfirstlane(threadIdx.x >> 6);
    const int G = gridDim.x, bxv = (int)blockIdx.x, vcu = (bxv % 8) * (G / 8) + bxv / 8;
    bf16* Qb = (bf16*)(w + WS_Q); bf16* KV = (bf16*)(w + WS_KN); bf16* KPE = (bf16*)(w + WS_KPE); bf16* OUT = (bf16*)(w + WS_H);
    const float* ct = (const float*)(w + WS_COS); const float* st = (const float*)(w + WS_SIN);
    for (int rep = 0; rep < ATT_BENCH_REPS; ++rep)
    for (int i = 0; i < 6; ++i) {
        const int bh = 3 * (vcu >> 5) + (i >> 1), qb = (i & 1) * 32 + (vcu & 31); const int b = bh >> 3, h = bh & 7;
        const size_t row0 = (size_t)b * L + (size_t)qb * 256;
        att::attn_unit<ATT_BENCH>(Qb + row0 * NQ + h * DQ, KV + (size_t)b * L * NKV + h * 128, KPE + (size_t)b * L * ROPE, KV + (size_t)b * L * NKV + h * 128 + 64,
                       OUT + row0 * D + 512 + h * 64, args.in[I_GNAT] + h * 64, ct, st, qb * 256, (LAS char*)lds, wave0);
    }
}
#endif
extern "C" void kernel_launch(void* const* d_in, const int* in_sizes, int n_in, void* d_out, int out_size, void* d_ws, size_t ws_size, hipStream_t stream) {
    static int grid = 0;
    if (grid == 0) {
        if (n_in != 26 || out_size != M * D || ws_size < WS_END) { fprintf(stderr, "kernel_launch: shape mismatch n_in %d out %d ws %zu (need %zu)\n", n_in, out_size, ws_size, (size_t)WS_END); grid = -1; return; }
        int dev = 0, cus = 0, per_cu = 0;
        if (hipGetDevice(&dev) != hipSuccess || hipDeviceGetAttribute(&cus, hipDeviceAttributeMultiprocessorCount, dev) != hipSuccess) { grid = -1; return; }
        if (hipFuncSetAttribute((const void*)hyena_mla_fwd, hipFuncAttributeMaxDynamicSharedMemorySize, LDS_BYTES) != hipSuccess) { fprintf(stderr, "kernel_launch: hipFuncSetAttribute failed\n"); grid = -1; return; }
        if (hipOccupancyMaxActiveBlocksPerMultiprocessor(&per_cu, (const void*)hyena_mla_fwd, NTHR, LDS_BYTES) != hipSuccess || per_cu < 1) fprintf(stderr, "kernel_launch: occupancy query says %d\n", per_cu);
        (void)hipGetLastError();
        grid = cus;
    }
    if (grid < 0) return;
    if (hipMemsetAsync((char*)d_ws + WS_CTL, 0, CTL_ZERO_BYTES, stream) != hipSuccess) { fprintf(stderr, "kernel_launch: memset failed\n"); return; }
    Args a{};
    for (int i = 0; i < 26; ++i) a.in[i] = (const float*)d_in[i];
    a.out = (float*)d_out; a.ws = (unsigned char*)d_ws;
    hipLaunchKernelGGL(hyena_mla_fwd, dim3(grid), dim3(NTHR), LDS_BYTES, stream, a);
#ifdef ATT_BENCH
    { static int once = 0; if (!once) { (void)hipFuncSetAttribute((const void*)attn_bench, hipFuncAttributeMaxDynamicSharedMemorySize, LDS_BYTES); once = 1; }
      hipLaunchKernelGGL(attn_bench, dim3(grid), dim3(NTHR), LDS_BYTES, stream, a); }
#endif
    const hipError_t le = hipPeekAtLastError();
    if (le != hipSuccess) fprintf(stderr, "kernel_launch: launch failed: %s\n", hipGetErrorName(le));
}
```

```cpp
#include <hip/hip_runtime.h>
#include <cstdio>
#include <cstdint>
__device__ __forceinline__ int hw_lane() { int l; asm volatile("v_mbcnt_lo_u32_b32 %0, -1, 0\n\tv_mbcnt_hi_u32_b32 %0, -1, %0" : "=v"(l)); return l; }
__device__ __forceinline__ int tid_from_wave(int wave0) { int w = wave0; asm volatile("" : "+s"(w)); int t = w * 64 + hw_lane(); asm volatile("" : "+v"(t)); return t; }
namespace pg8 {
#define PG8_LAS __attribute__((address_space(3)))
#define PG8_GAS __attribute__((address_space(1)))
typedef unsigned short bf16_t;
typedef short bf16x8 __attribute__((ext_vector_type(8)));
typedef float f32x4 __attribute__((ext_vector_type(4)));
typedef unsigned u32x4 __attribute__((ext_vector_type(4)));
constexpr int BM = 256, BK = 64, HALF = 128, HTB = HALF * BK * 2  , STAGE_BYTES = 8 * HTB, NXCD = 8, WGM = 8;

__host__ __device__ __forceinline__ int lds_byte(int r, int c) { const int st = (r >> 4) * 2 + (c >> 5), rr = r & 15, cc = c & 31, ob = rr * 64 + cc * 2; return st * 1024 + (ob ^ (((ob >> 9) & 1) << 5)); }
__host__ __device__ __forceinline__ void stage_rc(int b, int& R, int& C) { const int st = b / 1024, sb = b % 1024, swz = sb ^ (((sb >> 9) & 1) << 5); R = (st >> 1) * 16 + swz / 64; C = (st & 1) * 32 + (swz % 64) / 2; }
__host__ __device__ __forceinline__ int perm32(int rho) { const int n = rho >> 4, i = rho & 15; return 8 * (i >> 2) + 4 * n + (i & 3); }

struct Unit { int pm, pn; };
struct Gemm { const bf16_t* A; const bf16_t* Bt; int M, N, K; };

struct StaticOrder {
    int nM, nN, nwg, G, c;
    __host__ __device__ void init(int M, int N, int G_, int c_) { nM = M / BM; nN = N / BM; nwg = nM * nN; G = G_; c = c_; }
    __host__ __device__ bool next(int i, Unit& u) const {
        const long L = (long)i * G + c; if (L >= nwg) return false;
        int wgid = (int)L; { const int q = nwg / NXCD, r = nwg % NXCD, xcd = wgid % NXCD, off = wgid / NXCD; wgid = (xcd < r ? xcd * (q + 1) : r * (q + 1) + (xcd - r) * q) + off; }
        const int nig = WGM * nN, gid = wgid / nig, fm = gid * WGM, gsz = (nM - fm) < WGM ? (nM - fm) : WGM;
        u.pm = fm + ((wgid % nig) % gsz); u.pn = (wgid % nig) / gsz; return true;
    }
    __device__ __forceinline__ void a_ready(const Unit&) const {}
    __device__ __forceinline__ void done(const Unit&) const {}
};

__device__ __forceinline__ unsigned cvt_pk_bf16(float lo, float hi) { unsigned r; asm volatile("v_cvt_pk_bf16_f32 %0, %1, %2" : "=v"(r) : "v"(lo), "v"(hi)); return r; }
typedef float f32x2 __attribute__((ext_vector_type(2)));
__device__ __forceinline__ void relane(int& wr, int& wc, int& fr, int& fq) { int l = hw_lane(); asm volatile("" : "+v"(l)); fr = l & 15; fq = l >> 4; (void)wr; (void)wc; }
__device__ __forceinline__ f32x2 gelu_pk(f32x2 v) {
    const f32x2 av = __builtin_elementwise_abs(v), d = av * 0.2316418882f + 1.0f;
    f32x2 t; t.x = __builtin_amdgcn_rcpf(d.x); t.y = __builtin_amdgcn_rcpf(d.y);
    f32x2 q = t * 0.5307027145f + (-0.7265760135f); q = q * t + 0.7107068705f; q = q * t + (-0.142248368f); q = q * t + 0.127414796f; q = q * t;
    const f32x2 s = (v * v) * (-0.72134752044f);
    f32x2 e; e.x = __builtin_amdgcn_exp2f(s.x); e.y = __builtin_amdgcn_exp2f(s.y);
    const f32x2 m = v * (q * e), r = v - m;
    f32x2 o; o.x = v.x < 0.f ? m.x : r.x; o.y = v.y < 0.f ? m.y : r.y; return o;
}

template <int ACT  > struct EpiBf16 {
    static constexpr bool PERM = true, AFTER_DRAIN = false; static_assert(ACT == 0 || ACT == 1, "EpiBf16: ACT is 0 (none) or 1 (gelu_pk)");
    bf16_t* O; int ldc; const float* bias; int split_cols; size_t split_stride; float scale0;
    __device__ __forceinline__ void operator()(const f32x4 (&acc)[2][2][4][2], const Unit& u, int wr, int wc, int fr, int fq) const {
        relane(wr, wc, fr, fq);
        const int row0 = u.pm * BM + wr * 64 + fr; int colt = u.pn * BM; bf16_t* base = O;
        float sc = 1.f; if (split_cols) { const int t = colt / split_cols; base += (size_t)t * split_stride; colt -= t * split_cols; if (t == 0) sc = scale0; }
        const int col0 = colt + wc * 32 + 8 * fq, bcol0 = u.pn * BM + wc * 32 + 8 * fq;
        f32x4 bv[2][2];
#pragma unroll
        for (int bj = 0; bj < 2; ++bj)
#pragma unroll
            for (int n = 0; n < 2; ++n) bv[bj][n] = bias ? *(const PG8_GAS f32x4*)(bias + bcol0 + bj * HALF + 4 * n) : (f32x4){0.f, 0.f, 0.f, 0.f};
#pragma unroll
        for (int ai = 0; ai < 2; ++ai)
#pragma unroll
            for (int m = 0; m < 4; ++m) { bf16_t* rowp = base + (size_t)(row0 + ai * HALF + m * 16) * ldc + col0;
#pragma unroll
                for (int bj = 0; bj < 2; ++bj) { f32x4 v0 = acc[ai][bj][m][0] + bv[bj][0], v1 = acc[ai][bj][m][1] + bv[bj][1];
                    if (ACT == 1) { f32x2 a = gelu_pk((f32x2){v0[0], v0[1]}), b = gelu_pk((f32x2){v0[2], v0[3]}), c = gelu_pk((f32x2){v1[0], v1[1]}), d = gelu_pk((f32x2){v1[2], v1[3]});
                        v0 = (f32x4){a.x, a.y, b.x, b.y}; v1 = (f32x4){c.x, c.y, d.x, d.y}; }
                    v0 = v0 * sc; v1 = v1 * sc; u32x4 w; w.x = cvt_pk_bf16(v0[0], v0[1]); w.y = cvt_pk_bf16(v0[2], v0[3]); w.z = cvt_pk_bf16(v1[0], v1[1]); w.w = cvt_pk_bf16(v1[2], v1[3]);
                    *(PG8_GAS u32x4*)(rowp + bj * HALF) = w; } }
    }
};

struct PanelStats {
    unsigned* xbuf;
    unsigned* cnt;
    unsigned* tmo;
    int ntn; float eps;
    unsigned code;
    __device__ __forceinline__ bool run(const f32x4 (&v)[2][2][4][2], const Unit& u, int wr, int wc, int fr, int fq, PG8_LAS unsigned char* lds, int wid, int lane) const {
        typedef float f32x2v __attribute__((ext_vector_type(2)));
        PG8_LAS f32x2v* P = (PG8_LAS f32x2v*)lds;
        PG8_LAS f32x2v* S = (PG8_LAS f32x2v*)(lds + 8192);
        PG8_LAS unsigned* flag = (PG8_LAS unsigned*)(lds + 8192 + 2048);
#pragma unroll
        for (int ai = 0; ai < 2; ++ai)
#pragma unroll
            for (int m = 0; m < 4; ++m) {
                float s = 0.f;
#pragma unroll
                for (int bj = 0; bj < 2; ++bj)
#pragma unroll
                    for (int n = 0; n < 2; ++n) { const f32x4 x = v[ai][bj][m][n]; s += (x[0] + x[1]) + (x[2] + x[3]); }
                s += __shfl_xor(s, 16); s += __shfl_xor(s, 32);
                const float mw = s * (1.0f / 64.0f); float q = 0.f;
#pragma unroll
                for (int bj = 0; bj < 2; ++bj)
#pragma unroll
                    for (int n = 0; n < 2; ++n) { const f32x4 d = v[ai][bj][m][n] - mw; q += (d[0] * d[0] + d[1] * d[1]) + (d[2] * d[2] + d[3] * d[3]); }
                q += __shfl_xor(q, 16); q += __shfl_xor(q, 32);
                if (fq == 0) P[(ai * HALF + wr * 64 + m * 16 + fr) * 4 + wc] = (f32x2v){mw, q};
            }
        asm volatile("s_waitcnt lgkmcnt(0)" ::: "memory"); __builtin_amdgcn_s_barrier(); asm volatile("" ::: "memory");
#if defined(BROKEN_EXCHANGE_NO_WAIT)
#warning BROKEN CONTROL BUILD: the row-statistics exchange does not wait; results are wrong by design
        if (blockIdx.x >= 64) { const long long t0_ = clock64(); while (clock64() - t0_ < 60000) __builtin_amdgcn_s_sleep(8); }
#endif
        const int row = wid * 32 + (lane & 31);
        if (lane < 32) {
            const f32x2v a = P[row * 4 + 0], b = P[row * 4 + 1], c = P[row * 4 + 2], d = P[row * 4 + 3];
            const float mt = (a.x + b.x + c.x + d.x) * 0.25f;
            const float da = a.x - mt, db = b.x - mt, dc = c.x - mt, dd = d.x - mt;
            const float m2 = (a.y + b.y) + (c.y + d.y) + 64.0f * ((da * da + db * db) + (dc * dc + dd * dd));
            unsigned long long* slot = (unsigned long long*)xbuf + ((size_t)(u.pm * BM + row) * 4 + u.pn);
            __hip_atomic_store(slot, ((unsigned long long)__float_as_uint(m2) << 32) | __float_as_uint(mt), __ATOMIC_RELAXED, __HIP_MEMORY_SCOPE_AGENT);
        }
        asm volatile("s_waitcnt vmcnt(0)" ::: "memory");
        if (lane == 0) __hip_atomic_fetch_add(cnt + 64 * u.pm, 1u, __ATOMIC_RELAXED, __HIP_MEMORY_SCOPE_AGENT);
        if (wid == 0) {
            bool dead = false; const unsigned long long t0 = __builtin_amdgcn_s_memrealtime(); const unsigned want = 8u * (unsigned)ntn;
            for (;;) {
#if defined(BROKEN_EXCHANGE_NO_WAIT)
                break;
#endif
                if ((unsigned)__builtin_amdgcn_readfirstlane(__hip_atomic_load(cnt + 64 * u.pm, __ATOMIC_RELAXED, __HIP_MEMORY_SCOPE_AGENT)) >= want) break;
                if (__builtin_amdgcn_s_memrealtime() - t0 > 2000000ull) {
                    if (lane == 0) { unsigned expect = 0u; __hip_atomic_compare_exchange_strong(tmo + 1, &expect, code | (unsigned)(u.pm & 0xff), __ATOMIC_RELAXED, __ATOMIC_RELAXED, __HIP_MEMORY_SCOPE_AGENT);
                                     __hip_atomic_store(tmo, 1u, __ATOMIC_RELAXED, __HIP_MEMORY_SCOPE_AGENT); }
                    dead = true; break; }
                __builtin_amdgcn_s_sleep(2);
            }
            __builtin_amdgcn_fence(__ATOMIC_ACQUIRE, "agent");
            if (lane == 0) flag[0] = dead ? 1u : 0u;
        }
        asm volatile("s_waitcnt vmcnt(0) lgkmcnt(0)" ::: "memory"); __builtin_amdgcn_s_barrier(); asm volatile("" ::: "memory");
        const bool bad = flag[0] != 0u;
        if (lane < 32) {
            const unsigned long long* slot = (const unsigned long long*)xbuf + (size_t)(u.pm * BM + row) * 4; float mt[4], m2[4]; float ms = 0.f;
#pragma unroll
            for (int t = 0; t < 4; ++t) { if (t < ntn) { const unsigned long long w = __hip_atomic_load(slot + t, __ATOMIC_RELAXED, __HIP_MEMORY_SCOPE_AGENT); mt[t] = __uint_as_float((unsigned)w); m2[t] = __uint_as_float((unsigned)(w >> 32)); } else { mt[t] = 0.f; m2[t] = 0.f; } ms += mt[t]; }
            const float mean = ms / (float)ntn; float q = 0.f;
#pragma unroll
            for (int t = 0; t < 4; ++t) if (t < ntn) { const float dm = mt[t] - mean; q += m2[t] + 256.0f * dm * dm; }
            S[row] = (f32x2v){mean, 1.0f / sqrtf(q / (256.0f * (float)ntn) + eps)};
        }
        asm volatile("s_waitcnt lgkmcnt(0)" ::: "memory"); __builtin_amdgcn_s_barrier(); asm volatile("" ::: "memory");
        return bad;
    }
};
struct EpiLnRes {
    static constexpr bool PERM = false, AFTER_DRAIN = true;
    const float* base; float* out; int ldc; const float* bias; PanelStats st; unsigned poison;
    __device__ __forceinline__ void fused(f32x4 (&acc)[2][2][4][2], const Unit& u, int wr, int wc, int fr, int fq, PG8_LAS unsigned char* lds, int wid, int lane) const {
        typedef float f32x2v __attribute__((ext_vector_type(2)));
        const PG8_LAS f32x2v* S = (const PG8_LAS f32x2v*)(lds + 8192);
        const int col0 = u.pn * BM + wc * 32 + 4 * fq;
#pragma unroll
        for (int bj = 0; bj < 2; ++bj)
#pragma unroll
            for (int n = 0; n < 2; ++n) { const f32x4 bv = bias ? *(const f32x4*)(bias + col0 + bj * HALF + n * 16) : (f32x4){0.f, 0.f, 0.f, 0.f};
#pragma unroll
                for (int ai = 0; ai < 2; ++ai)
#pragma unroll
                    for (int m = 0; m < 4; ++m) acc[ai][bj][m][n] += bv; }
        f32x4 pre[4][2][2];
#pragma unroll
        for (int m = 0; m < 4; ++m) { const size_t off = (size_t)(u.pm * BM + wr * 64 + m * 16 + fr) * ldc + col0;
#pragma unroll
            for (int bj = 0; bj < 2; ++bj)
#pragma unroll
                for (int n = 0; n < 2; ++n) pre[m][bj][n] = *(const f32x4*)(base + off + bj * HALF + n * 16); }
        const bool bad = st.run(acc, u, wr, wc, fr, fq, lds, wid, lane) || poison != 0u;
        const float qnan = __builtin_nanf("");
#pragma unroll
        for (int ai = 0; ai < 2; ++ai)
#pragma unroll
            for (int m = 0; m < 4; ++m) { const int r = ai * HALF + wr * 64 + m * 16 + fr; const f32x2v sr = S[r]; const size_t off = (size_t)(u.pm * BM + r) * ldc + col0;
#pragma unroll
                for (int bj = 0; bj < 2; ++bj)
#pragma unroll
                    for (int n = 0; n < 2; ++n) { const f32x4 bs = ai == 0 ? pre[m][bj][n] : *(const f32x4*)(base + off + bj * HALF + n * 16); f32x4 o = bs + (acc[ai][bj][m][n] - sr.x) * sr.y;
                        if (bad) o = (f32x4){qnan, qnan, qnan, qnan}; *(f32x4*)(out + off + bj * HALF + n * 16) = o; }
                if (m & 1) asm volatile("" ::: "memory"); }
    }
};
struct EpiLnResLn {
    static constexpr bool PERM = false, AFTER_DRAIN = true;
    const float* base; float* out; bf16_t* xn; int ldc; const float* bias; PanelStats st1, st2; unsigned poison;
    __device__ __forceinline__ void fused(f32x4 (&acc)[2][2][4][2], const Unit& u, int wr, int wc, int fr, int fq, PG8_LAS unsigned char* lds, int wid, int lane) const {
        typedef float f32x2v __attribute__((ext_vector_type(2))); typedef unsigned u32x2v __attribute__((ext_vector_type(2)));
        const PG8_LAS f32x2v* S = (const PG8_LAS f32x2v*)(lds + 8192);
        const int col0 = u.pn * BM + wc * 32 + 4 * fq;
#pragma unroll
        for (int bj = 0; bj < 2; ++bj)
#pragma unroll
            for (int n = 0; n < 2; ++n) { const f32x4 bv = bias ? *(const f32x4*)(bias + col0 + bj * HALF + n * 16) : (f32x4){0.f, 0.f, 0.f, 0.f};
#pragma unroll
                for (int ai = 0; ai < 2; ++ai)
#pragma unroll
                    for (int m = 0; m < 4; ++m) acc[ai][bj][m][n] += bv; }
        bool bad = st1.run(acc, u, wr, wc, fr, fq, lds, wid, lane) || poison != 0u;
        const float qnan = __builtin_nanf("");
#pragma unroll
        for (int ai = 0; ai < 2; ++ai)
#pragma unroll
            for (int m = 0; m < 4; ++m) { const int r = ai * HALF + wr * 64 + m * 16 + fr; const f32x2v sr = S[r]; const size_t off = (size_t)(u.pm * BM + r) * ldc + col0;
#pragma unroll
                for (int bj = 0; bj < 2; ++bj)
#pragma unroll
                    for (int n = 0; n < 2; ++n) { const f32x4 bs = *(const f32x4*)(base + off + bj * HALF + n * 16); acc[ai][bj][m][n] = bs + (acc[ai][bj][m][n] - sr.x) * sr.y; }
                asm volatile("" : "+v"(acc[ai][0][m][0]), "+v"(acc[ai][0][m][1]), "+v"(acc[ai][1][m][0]), "+v"(acc[ai][1][m][1]));
                if (m & 1) asm volatile("" ::: "memory"); }
        const bool bad1 = bad;
        bad = st2.run(acc, u, wr, wc, fr, fq, lds, wid, lane) || bad;
#pragma unroll
        for (int ai = 0; ai < 2; ++ai)
#pragma unroll
            for (int m = 0; m < 4; ++m) { const int r = ai * HALF + wr * 64 + m * 16 + fr; const f32x2v sr = S[r]; const size_t off = (size_t)(u.pm * BM + r) * ldc + col0;
#pragma unroll
                for (int bj = 0; bj < 2; ++bj)
#pragma unroll
                    for (int n = 0; n < 2; ++n) { const f32x4 x1 = acc[ai][bj][m][n]; *(f32x4*)(out + off + bj * HALF + n * 16) = bad1 ? (f32x4){qnan, qnan, qnan, qnan} : x1;
                        const f32x4 o = (x1 - sr.x) * sr.y; u32x2v w; w.x = cvt_pk_bf16(o[0], o[1]); w.y = cvt_pk_bf16(o[2], o[3]);
                        if (bad) { w.x = 0x7fc07fc0u; w.y = 0x7fc07fc0u; } *(u32x2v*)(xn + off + bj * HALF + n * 16) = w; }
                asm volatile("" ::: "memory"); }
    }
};

template <class Epi, class Sched, bool ALIGN_EPI = false, bool SP2 = false>
__device__ __forceinline__ void gemm_phase(PG8_LAS unsigned char* lds, const Gemm g, const Sched& S, const Epi& E, const int wave0) {
    int tid_ = tid_from_wave(wave0);
    const int tid = tid_, wid = __builtin_amdgcn_readfirstlane(tid >> 6), lane = tid & 63, wr = wid >> 2, wc = wid & 3, fr = lane & 15, fq = lane >> 4;
    const int K = g.K, nt = K / BK;
    unsigned voffA[2], voffB[2];
#pragma unroll
    for (int i = 0; i < 2; ++i) { int R, C; stage_rc(tid * 16 + i * 8192, R, C); const int Rb = Epi::PERM ? ((R & ~31) + perm32(R & 31)) : R;
        voffA[i] = (unsigned)(R * K + C) * 2u; voffB[i] = (unsigned)(Rb * K + C) * 2u; }
    const size_t kstep = (size_t)(BK * 2);
    const size_t hstep = (size_t)HALF * K * 2;
    const size_t tstep = 2 * hstep;
    const unsigned ldsw = (unsigned)wid * 1024u;
    const int aoff = lds_byte(wr * 64 + fr, fq * 8), boff = lds_byte(wc * 32 + fr, fq * 8);
#define PG8_SA(b, h) (((b) * 2 + (h)) * HTB)
#define PG8_SB(b, h) ((4 + (b) * 2 + (h)) * HTB)
#define PG8_STAGE(bufoff, gbase, voff) do { _Pragma("unroll") for (int _i = 0; _i < 2; ++_i) \
        __builtin_amdgcn_global_load_lds((const unsigned*)((const char*)(gbase) + (voff)[_i]), (PG8_LAS unsigned*)(lds + (bufoff) + ldsw + _i * 8192), 16, 0, 0); } while (0)
#define PG8_LDA(dst, b, h) do { _Pragma("unroll") for (int m = 0; m < 4; ++m) _Pragma("unroll") for (int k = 0; k < 2; ++k) dst[m][k] = *(const PG8_LAS bf16x8*)(lds + PG8_SA(b, h) + aoff + m * 2048 + k * 1024); } while (0)
#define PG8_LDB(dst, b, h) do { _Pragma("unroll") for (int n = 0; n < 2; ++n) _Pragma("unroll") for (int k = 0; k < 2; ++k) dst[n][k] = *(const PG8_LAS bf16x8*)(lds + PG8_SB(b, h) + boff + n * 2048 + k * 1024); } while (0)
#define PG8_MMA(ai, bj, At, Bt) do { __builtin_amdgcn_s_setprio(1); _Pragma("unroll") for (int m = 0; m < 4; ++m) _Pragma("unroll") for (int n = 0; n < 2; ++n) _Pragma("unroll") for (int k = 0; k < 2; ++k) \
        acc[ai][bj][m][n] = __builtin_amdgcn_mfma_f32_16x16x32_bf16(Bt[n][k], At[m][k], acc[ai][bj][m][n], 0, 0, 0); __builtin_amdgcn_s_setprio(0); } while (0)
#define PG8_WAIT_V(n) asm volatile("s_waitcnt vmcnt(" #n ")" ::: "memory")
#define PG8_WAIT_L(n) asm volatile("s_waitcnt lgkmcnt(" #n ")" ::: "memory")
#define PG8_BAR __builtin_amdgcn_s_barrier()
#define PG8_SCHED __builtin_amdgcn_sched_barrier(0)
    Unit cur, nxt; int ui = 0;
    if (!S.next(0, cur)) return;
    f32x4 acc[2][2][4][2];
#pragma unroll
    for (int a = 0; a < 2; ++a)
#pragma unroll
        for (int b = 0; b < 2; ++b)
#pragma unroll
            for (int m = 0; m < 4; ++m)
#pragma unroll
                for (int n = 0; n < 2; ++n) acc[a][b][m][n] = (f32x4){0.f, 0.f, 0.f, 0.f};
    bf16x8 At[4][2], B0[2][2], B1[2][2];
    const char* cA = (const char*)g.A + (size_t)cur.pm * tstep; const char* cB = (const char*)g.Bt + (size_t)cur.pn * tstep;
    S.a_ready(cur);
    if constexpr (SP2) {
        PG8_STAGE(PG8_SB(0, 0), cB, voffB); PG8_STAGE(PG8_SB(0, 1), cB + hstep, voffB); PG8_STAGE(PG8_SA(0, 0), cA, voffA); PG8_STAGE(PG8_SA(0, 1), cA + hstep, voffA);
        if (wr == 1) PG8_BAR;
        PG8_WAIT_V(2); PG8_BAR;
        PG8_STAGE(PG8_SB(1, 0), cB + kstep, voffB); PG8_STAGE(PG8_SA(1, 0), cA + kstep, voffA); PG8_STAGE(PG8_SB(1, 1), cB + hstep + kstep, voffB);
        PG8_WAIT_V(6); PG8_BAR;
    } else {
        PG8_STAGE(PG8_SB(0, 0), cB, voffB); PG8_STAGE(PG8_SA(0, 0), cA, voffA); PG8_STAGE(PG8_SB(0, 1), cB + hstep, voffB); PG8_STAGE(PG8_SA(0, 1), cA + hstep, voffA);
        if (wr == 1) PG8_BAR;
        PG8_WAIT_V(4); PG8_BAR;
        PG8_STAGE(PG8_SB(1, 0), cB + kstep, voffB); PG8_STAGE(PG8_SA(1, 0), cA + kstep, voffA); PG8_STAGE(PG8_SB(1, 1), cB + hstep + kstep, voffB);
        PG8_WAIT_V(6); PG8_BAR;
    }
    for (;;) {
        const bool has_next = S.next(ui + 1, nxt);
        const char* nA = has_next ? (const char*)g.A + (size_t)nxt.pm * tstep : cA; const char* nB = has_next ? (const char*)g.Bt + (size_t)nxt.pn * tstep : cB;
        for (int t = 0; t < nt; t += 2) {
            const bool last = (t == nt - 2);
            const char* a1 = cA + (size_t)(t + 1) * kstep;
            const char* a2 = last ? nA : cA + (size_t)(t + 2) * kstep; const char* b2 = last ? nB : cB + (size_t)(t + 2) * kstep;
            const char* a3 = a2 + kstep; const char* b3 = b2 + kstep;
            if (last && has_next) S.a_ready(nxt);
            if constexpr (SP2) {
            PG8_LDB(B0, 0, 0); PG8_LDB(B1, 0, 1); PG8_SCHED; PG8_LDA(At, 0, 0); PG8_STAGE(PG8_SA(1, 1), a1 + hstep, voffA);
            PG8_WAIT_V(8); PG8_WAIT_L(0); PG8_BAR; PG8_MMA(0, 0, At, B0); PG8_MMA(0, 1, At, B1); PG8_BAR; PG8_SCHED;
            PG8_LDA(At, 0, 1); PG8_STAGE(PG8_SB(0, 0), b2, voffB); PG8_STAGE(PG8_SB(0, 1), b2 + hstep, voffB); PG8_STAGE(PG8_SA(0, 0), a2, voffA);
            PG8_WAIT_V(8); PG8_WAIT_L(0); PG8_BAR; PG8_MMA(1, 0, At, B0); PG8_MMA(1, 1, At, B1); PG8_BAR; PG8_SCHED;
            PG8_LDB(B0, 1, 0); PG8_LDB(B1, 1, 1); PG8_SCHED; PG8_LDA(At, 1, 0); PG8_STAGE(PG8_SA(0, 1), a2 + hstep, voffA);
            PG8_WAIT_V(8); PG8_WAIT_L(0); PG8_BAR; PG8_MMA(0, 0, At, B0); PG8_MMA(0, 1, At, B1); PG8_BAR; PG8_SCHED;
            PG8_LDA(At, 1, 1); PG8_STAGE(PG8_SB(1, 0), b3, voffB); PG8_STAGE(PG8_SB(1, 1), b3 + hstep, voffB); PG8_STAGE(PG8_SA(1, 0), a3, voffA);
            PG8_WAIT_V(8); PG8_WAIT_L(0); PG8_BAR; PG8_MMA(1, 0, At, B0); PG8_MMA(1, 1, At, B1); PG8_BAR; PG8_SCHED;
            } else {
            PG8_LDB(B0, 0, 0); PG8_SCHED; PG8_LDA(At, 0, 0); PG8_STAGE(PG8_SA(1, 1), a1 + hstep, voffA);
            PG8_WAIT_L(8); PG8_BAR; PG8_WAIT_L(0); PG8_MMA(0, 0, At, B0); PG8_BAR; PG8_SCHED;
            PG8_LDB(B1, 0, 1); PG8_STAGE(PG8_SB(0, 0), b2, voffB);
            PG8_BAR; PG8_WAIT_L(0); PG8_MMA(0, 1, At, B1); PG8_BAR;
            PG8_LDA(At, 0, 1); PG8_STAGE(PG8_SA(0, 0), a2, voffA);
            PG8_BAR; PG8_WAIT_L(0); PG8_MMA(1, 0, At, B0); PG8_BAR; PG8_SCHED;
            PG8_STAGE(PG8_SB(0, 1), b2 + hstep, voffB);
            PG8_WAIT_V(6); PG8_BAR; PG8_MMA(1, 1, At, B1); PG8_BAR;
            PG8_LDB(B0, 1, 0); PG8_SCHED; PG8_LDA(At, 1, 0); PG8_STAGE(PG8_SA(0, 1), a2 + hstep, voffA);
            PG8_WAIT_L(8); PG8_BAR; PG8_WAIT_L(0); PG8_MMA(0, 0, At, B0); PG8_BAR; PG8_SCHED;
            PG8_LDB(B1, 1, 1); PG8_STAGE(PG8_SB(1, 0), b3, voffB);
            PG8_BAR; PG8_WAIT_L(0); PG8_MMA(0, 1, At, B1); PG8_BAR;
            PG8_LDA(At, 1, 1); PG8_STAGE(PG8_SA(1, 0), a3, voffA);
            PG8_BAR; PG8_WAIT_L(0); PG8_MMA(1, 0, At, B0); PG8_BAR; PG8_SCHED;
            PG8_STAGE(PG8_SB(1, 1), b3 + hstep, voffB);
            PG8_WAIT_V(6); PG8_BAR; PG8_MMA(1, 1, At, B1); PG8_BAR;
            }
        }
        if constexpr (ALIGN_EPI) { if (wr == 0) PG8_BAR; }
        if constexpr (!Epi::AFTER_DRAIN) { E(acc, cur, wr, wc, fr, fq); S.done(cur); }
        if (!has_next) break;
#pragma unroll
        for (int a = 0; a < 2; ++a)
#pragma unroll
            for (int b = 0; b < 2; ++b)
#pragma unroll
                for (int m = 0; m < 4; ++m)
#pragma unroll
                    for (int n = 0; n < 2; ++n) acc[a][b][m][n] = (f32x4){0.f, 0.f, 0.f, 0.f};
        cur = nxt; cA = nA; cB = nB; ++ui;
        if constexpr (ALIGN_EPI) { if (wr == 1) PG8_BAR; }
    }
    PG8_WAIT_V(0);
    if constexpr (!ALIGN_EPI) { if (wr == 0) PG8_BAR; }
    PG8_BAR;
    if constexpr (Epi::AFTER_DRAIN) { E.fused(acc, cur, wr, wc, fr, fq, lds, wid, lane); S.done(cur); }
#undef PG8_SA
#undef PG8_SB
#undef PG8_STAGE
#undef PG8_LDA
#undef PG8_LDB
#undef PG8_MMA
#undef PG8_WAIT_V
#undef PG8_WAIT_L
#undef PG8_BAR
#undef PG8_SCHED
}
}

namespace pg8 {
struct EpiRelu2 {
    static constexpr bool PERM = true, AFTER_DRAIN = false;
    bf16_t* O; int ldc;
    __device__ __forceinline__ void operator()(const f32x4 (&acc)[2][2][4][2], const Unit& u, int wr, int wc, int fr, int fq) const {
        relane(wr, wc, fr, fq);
        const int row0 = u.pm * BM + wr * 64 + fr, col0 = u.pn * BM + wc * 32 + 8 * fq;
#pragma unroll
        for (int ai = 0; ai < 2; ++ai)
#pragma unroll
            for (int m = 0; m < 4; ++m) { bf16_t* rowp = O + (size_t)(row0 + ai * HALF + m * 16) * ldc + col0;
#pragma unroll
                for (int bj = 0; bj < 2; ++bj) { f32x4 v0 = acc[ai][bj][m][0], v1 = acc[ai][bj][m][1];
                    v0 = __builtin_elementwise_max(v0, (f32x4){0.f, 0.f, 0.f, 0.f}); v1 = __builtin_elementwise_max(v1, (f32x4){0.f, 0.f, 0.f, 0.f}); v0 = v0 * v0; v1 = v1 * v1;
                    u32x4 w; w.x = cvt_pk_bf16(v0[0], v0[1]); w.y = cvt_pk_bf16(v0[2], v0[3]); w.z = cvt_pk_bf16(v1[0], v1[1]); w.w = cvt_pk_bf16(v1[2], v1[3]);
                    *(PG8_GAS u32x4*)(rowp + bj * HALF) = w; } }
    }
};
struct EpiF32 {
    static constexpr bool PERM = false, AFTER_DRAIN = false;
    float* O; int ldc;
    __device__ __forceinline__ void operator()(const f32x4 (&acc)[2][2][4][2], const Unit& u, int wr, int wc, int fr, int fq) const {
        relane(wr, wc, fr, fq);
        const int row0 = u.pm * BM + wr * 64 + fr, col0 = u.pn * BM + wc * 32 + 4 * fq;
#pragma unroll
        for (int ai = 0; ai < 2; ++ai)
#pragma unroll
            for (int m = 0; m < 4; ++m) { float* rowp = O + (size_t)(row0 + ai * HALF + m * 16) * ldc + col0;
#pragma unroll
                for (int bj = 0; bj < 2; ++bj)
#pragma unroll
                    for (int n = 0; n < 2; ++n) *(PG8_GAS f32x4*)(rowp + bj * HALF + n * 16) = acc[ai][bj][m][n]; }
    }
};
struct EpiTaps {
    static constexpr bool PERM = false, AFTER_DRAIN = false;
    float* O; const float* decay;
    __device__ __forceinline__ void operator()(const f32x4 (&acc)[2][2][4][2], const Unit& u, int wr, int wc, int fr, int fq) const {
        relane(wr, wc, fr, fq);
        const int row0 = u.pm * BM + wr * 64 + fr, col0 = u.pn * BM + wc * 32 + 4 * fq;
#pragma unroll
        for (int ai = 0; ai < 2; ++ai)
#pragma unroll
            for (int m = 0; m < 4; ++m) { const int row = row0 + ai * HALF + m * 16; float* rowp = O + (size_t)row * 16384 + col0; const float nd = -fabsf(((const PG8_GAS float*)decay)[row]) * (1.0f / 16383.0f) * 1.4426950408889634f;
#pragma unroll
                for (int bj = 0; bj < 2; ++bj)
#pragma unroll
                    for (int n = 0; n < 2; ++n) { const int c = col0 + bj * HALF + n * 16; const f32x4 a = acc[ai][bj][m][n]; f32x4 o;
                        o[0] = a[0] * __builtin_amdgcn_exp2f(nd * (float)(c + 0)); o[1] = a[1] * __builtin_amdgcn_exp2f(nd * (float)(c + 1));
                        o[2] = a[2] * __builtin_amdgcn_exp2f(nd * (float)(c + 2)); o[3] = a[3] * __builtin_amdgcn_exp2f(nd * (float)(c + 3));
                        *(PG8_GAS f32x4*)(rowp + bj * HALF + n * 16) = o; } }
    }
};
}

constexpr int L = 16384, NSEQ = 3, M = NSEQ * L, D = 1024, DEPTH = 4;
constexpr int HYW = 512, HYP = 1536, QR = 256, KVR = 128, ROPE = 32, INW = 1952;
constexpr int NH = 8, DQ = 96, DV = 64, NQ = NH * DQ, NKV = NH * 128;
constexpr int FF = 4096;
constexpr float EPS = 1e-6f;
constexpr int NWAVES = 8, NTHR = 512;
constexpr int MLP_CHUNK = 16384, N_MLP_CHUNKS = M / MLP_CHUNK;

constexpr size_t MiB = 1u << 20;
constexpr size_t WS_CTL = 0, CTL_ZERO_BYTES = 65536;
constexpr size_t WS_COS = 1 * MiB, WS_SIN = 2 * MiB;
constexpr size_t WS_H2 = 4 * MiB;
constexpr size_t WS_W3T = 8 * MiB;
constexpr size_t WS_WIN = 12 * MiB, WS_WOUT = 16 * MiB, WS_WUP = 18 * MiB, WS_WDOWN = 26 * MiB, WS_WUQ = 34 * MiB, WS_WUKV = 34 * MiB + 512 * 1024;
constexpr size_t WS_XN = 36 * MiB;
constexpr size_t WS_CQN = 36 * MiB, WS_CKVN = 60 * MiB, WS_KPE = 72 * MiB;
constexpr size_t WS_KEO = 132 * MiB;
constexpr size_t WS_KT = 261 * MiB;
constexpr size_t WS_UT = 261 * MiB;
constexpr size_t WS_CQKV = 405 * MiB;
constexpr size_t WS_YT = 453 * MiB;
constexpr size_t WS_Q = 132 * MiB, WS_KN = 204 * MiB;
constexpr size_t WS_MIX = 324 * MiB;
constexpr size_t WS_T = 132 * MiB;
constexpr size_t WS_H = 324 * MiB;
constexpr size_t WS_G0 = 75 * MiB, WS_G1A = 107 * MiB, WS_G1B = 501 * MiB;
constexpr size_t WS_XR = 508 * MiB;
constexpr size_t WS_END = 604 * MiB;
constexpr int KEO_BLK = 16512, KEO_KO = 8256;
static_assert(WS_KEO + (size_t)1024 * KEO_BLK * 8 <= WS_KT, "KEO fits");
static_assert(WS_UT + (size_t)HYP * M * 2 <= WS_CQKV && WS_CQKV + (size_t)M * 512 * 2 <= WS_YT && WS_YT + (size_t)HYW * M * 2 <= WS_XR, "map");
static_assert(WS_KN + (size_t)M * NKV * 2 <= WS_MIX && WS_T + (size_t)M * D * 4 <= WS_MIX && WS_H + (size_t)MLP_CHUNK * FF * 2 <= WS_XR && WS_XR + (size_t)M * D * 2 <= WS_END, "map2");

constexpr int RING_OFF = 0, RING_BYTES = 139264;
constexpr int LDSCTL_OFF = RING_BYTES, MISC_OFF = LDSCTL_OFF + 320;
constexpr int LDS_BYTES = 147456;
static_assert(MISC_OFF + 128 <= LDS_BYTES, "LDS map");

#define GAS __attribute__((address_space(1)))
#define LAS __attribute__((address_space(3)))
typedef unsigned short bf16;
typedef unsigned v4u __attribute__((ext_vector_type(4)));
typedef unsigned v2u __attribute__((ext_vector_type(2)));
typedef float f32x4 __attribute__((ext_vector_type(4)));
typedef float f32x2 __attribute__((ext_vector_type(2)));
typedef short bf16x8 __attribute__((ext_vector_type(8)));
typedef GAS unsigned gu32;
#define RLX_AGENT __ATOMIC_RELAXED, __HIP_MEMORY_SCOPE_AGENT
#define LDS_WAIT() asm volatile("s_waitcnt lgkmcnt(0)" ::: "memory")
#define VM_WAIT() asm volatile("s_waitcnt vmcnt(0)" ::: "memory")
typedef __bf16 bf16x2_t __attribute__((ext_vector_type(2)));
__device__ __forceinline__ unsigned pk2(float lo, float hi) { f32x2 v = {lo, hi}; bf16x2_t b = __builtin_convertvector(v, bf16x2_t); return __builtin_bit_cast(unsigned, b); }
__device__ __forceinline__ bf16 f2bf(float f) { return (bf16)(pk2(f, 0.f) & 0xffffu); }
__device__ __forceinline__ float bf2f(unsigned h) { return __uint_as_float(h << 16); }
__device__ __forceinline__ float shx(float v, int lane, int o) { return __uint_as_float((unsigned)__builtin_amdgcn_ds_bpermute((lane ^ o) << 2, (int)__float_as_uint(v))); }
__device__ __forceinline__ float wave_sum(float v) {
    const int ln_ = hw_lane();
#pragma unroll
    for (int o = 1; o < 64; o <<= 1) v += shx(v, ln_, o);
    return v;
}

namespace hfft {
constexpr float w32c(int i) { constexpr float t[16] = {1.000000000e+00f, 9.807852507e-01f, 9.238795042e-01f, 8.314695954e-01f, 7.071067691e-01f, 5.555702448e-01f, 3.826834261e-01f, 1.950903237e-01f, 0.f, -1.950903237e-01f, -3.826834261e-01f, -5.555702448e-01f, -7.071067691e-01f, -8.314695954e-01f, -9.238795042e-01f, -9.807852507e-01f}; return t[i]; }
constexpr float w32s(int i) { constexpr float t[16] = {0.000000000e+00f, 1.950903237e-01f, 3.826834261e-01f, 5.555702448e-01f, 7.071067691e-01f, 8.314695954e-01f, 9.238795042e-01f, 9.807852507e-01f, 1.000000000e+00f, 9.807852507e-01f, 9.238795042e-01f, 8.314695954e-01f, 7.071067691e-01f, 5.555702448e-01f, 3.826834261e-01f, 1.950903237e-01f}; return t[i]; }
constexpr int brev(int x, int bits) { int r = 0; for (int i = 0; i < bits; ++i) r |= ((x >> i) & 1) << (bits - 1 - i); return r; }
constexpr int ilog2(int x) { int r = 0; while ((1 << r) < x) ++r; return r; }
__device__ __forceinline__ int pad(int i) { return i + (i >> 5); }

__device__ __forceinline__ void bfly(float ar, float ai, float br, float bi, float& ur, float& ui, float& dr, float& di) {
    asm("v_add_f32_e32 %0, %4, %6\n\tv_add_f32_e32 %1, %5, %7\n\tv_sub_f32_e32 %2, %4, %6\n\tv_sub_f32_e32 %3, %5, %7"
        : "=&v"(ur), "=&v"(ui), "=&v"(dr), "=&v"(di) : "v"(ar), "v"(ai), "v"(br), "v"(bi));
}
template <bool INV> __device__ __forceinline__ void bfly_rot(float ar, float ai, float br, float bi, float& ur, float& ui, float& dr, float& di) {
    if (!INV) asm("v_add_f32_e32 %0, %4, %6\n\tv_add_f32_e32 %1, %5, %7\n\tv_sub_f32_e32 %2, %5, %7\n\tv_sub_f32_e32 %3, %6, %4" : "=&v"(ur), "=&v"(ui), "=&v"(dr), "=&v"(di) : "v"(ar), "v"(ai), "v"(br), "v"(bi));
    else      asm("v_add_f32_e32 %0, %4, %6\n\tv_add_f32_e32 %1, %5, %7\n\tv_sub_f32_e32 %2, %7, %5\n\tv_sub_f32_e32 %3, %4, %6" : "=&v"(ur), "=&v"(ui), "=&v"(dr), "=&v"(di) : "v"(ar), "v"(ai), "v"(br), "v"(bi));
}
__device__ __forceinline__ void bfly_tw(float ar, float ai, float br, float bi, float c, float s, float& ur, float& ui, float& dr, float& di) {
    float tr, ti;
    asm("v_sub_f32_e32 %4, %6, %8\n\tv_sub_f32_e32 %5, %7, %9\n\tv_add_f32_e32 %0, %6, %8\n\tv_add_f32_e32 %1, %7, %9\n\t"
        "v_mul_f32_e32 %2, %10, %4\n\tv_mul_f32_e32 %3, %11, %4\n\tv_fma_f32 %2, -%11, %5, %2\n\tv_fma_f32 %3, %10, %5, %3"
        : "=&v"(ur), "=&v"(ui), "=&v"(dr), "=&v"(di), "=&v"(tr), "=&v"(ti) : "v"(ar), "v"(ai), "v"(br), "v"(bi), "s"(c), "s"(s));
}
__device__ __forceinline__ void cmul_chain(float& xr, float& xi, float& wc, float& ws, float c1, float s1) {
    float a, b, nc, ns;
    asm("v_mul_f32_e32 %0, %4, %6\n\tv_mul_f32_e32 %1, %4, %7\n\tv_fma_f32 %0, -%5, %7, %0\n\tv_fma_f32 %1, %5, %6, %1\n\t"
        "v_mul_f32_e32 %2, %6, %8\n\tv_mul_f32_e32 %3, %6, %9\n\tv_fma_f32 %2, -%7, %9, %2\n\tv_fma_f32 %3, %7, %8, %3"
        : "=&v"(a), "=&v"(b), "=&v"(nc), "=&v"(ns) : "v"(xr), "v"(xi), "v"(wc), "v"(ws), "v"(c1), "v"(s1));
    xr = a; xi = b; wc = nc; ws = ns;
}
template <int R, bool INV> __device__ __forceinline__ void fft_r2(float (&re)[R], float (&im)[R], const unsigned z0) {
    constexpr int LG = ilog2(R);
#pragma unroll
    for (int st = 0; st < LG; ++st) {
        const int s = (R / 2) >> st;
#pragma unroll
        for (int blk = 0; blk < R; blk += 2 * s) {
#pragma unroll
            for (int a = 0; a < s; ++a) {
                const int i0 = blk + a, i1 = i0 + s;
                const int w = a * (16 / s);
                float ur, ui, dr, di;
                if (w == 0) { bfly(re[i0], im[i0], re[i1], im[i1], ur, ui, dr, di); re[i1] = dr; im[i1] = di; }
                else if (w == 8) { bfly_rot<INV>(re[i0], im[i0], re[i1], im[i1], ur, ui, dr, di); re[i1] = dr; im[i1] = di; }
                else { const float c = __uint_as_float(__float_as_uint(w32c(w)) | z0), sn = __uint_as_float(__float_as_uint(INV ? w32s(w) : -w32s(w)) | z0);
                    bfly_tw(re[i0], im[i0], re[i1], im[i1], c, sn, ur, ui, dr, di); re[i1] = dr; im[i1] = di; }
                re[i0] = ur; im[i0] = ui;
            }
        }
    }
}

__device__ __forceinline__ int opaque(int x) { asm volatile("" : "+v"(x)); return x; }
template <bool INV> __device__ __forceinline__ void fft16k(float (&re)[32], float (&im)[32], LAS f32x2* buf, const int t_in) {
    asm volatile("" ::: "memory"); __builtin_amdgcn_sched_barrier(0);
    int t = opaque(t_in);
    unsigned z0 = 0u; asm volatile("" : "+s"(z0));
    fft_r2<32, INV>(re, im, z0);
    __syncthreads();
#pragma unroll
    for (int r = 0; r < 32; ++r) buf[33 * t + r] = (f32x2){re[brev(r, 5)], im[brev(r, 5)]};
    __syncthreads();
    t = opaque(t);
    { const int b2 = t + (t >> 5);
#pragma unroll
    for (int r = 0; r < 32; ++r) { const f32x2 v = buf[b2 + 528 * r]; re[r] = v.x; im[r] = v.y; } }
    {
        const float f1 = (float)(t & 31) * (1.0f / 1024.0f);
        const float c1 = __builtin_amdgcn_cosf(f1), s1 = INV ? __builtin_amdgcn_sinf(f1) : -__builtin_amdgcn_sinf(f1);
        float wc = c1, ws = s1;
#pragma unroll
        for (int r = 1; r < 32; ++r) {
            cmul_chain(re[r], im[r], wc, ws, c1, s1);
        }
    }
    fft_r2<32, INV>(re, im, z0);
    __syncthreads();
    {
        t = opaque(t);
        const int ob = (t >> 5) * 1056 + (t & 31);
#pragma unroll
        for (int r = 0; r < 32; ++r) buf[ob + 33 * r] = (f32x2){re[brev(r, 5)], im[brev(r, 5)]};
    }
    __syncthreads();
#pragma unroll
    for (int h = 0; h < 2; ++h) {
        t = opaque(t);
        float ar[16], ai[16]; const int j = t + 512 * h; const int b3 = t + (t >> 5) + 528 * h;
#pragma unroll
        for (int r = 0; r < 16; ++r) { const f32x2 v = buf[b3 + 1056 * r]; ar[r] = v.x; ai[r] = v.y; }
        {
            const float f1 = (float)j * (1.0f / 16384.0f);
            const float c1 = __builtin_amdgcn_cosf(f1), s1 = INV ? __builtin_amdgcn_sinf(f1) : -__builtin_amdgcn_sinf(f1);
            float wc = c1, ws = s1;
#pragma unroll
            for (int r = 1; r < 16; ++r) {
                cmul_chain(ar[r], ai[r], wc, ws, c1, s1);
            }
        }
        fft_r2<16, INV>(ar, ai, z0);
#pragma unroll
        for (int r = 0; r < 16; ++r) { re[h + 2 * r] = ar[brev(r, 4)]; im[h + 2 * r] = ai[brev(r, 4)]; }
    }
    asm volatile("" ::: "memory"); __builtin_amdgcn_sched_barrier(0);
}
}

struct Frame {
    LAS unsigned char* lds;
    volatile LAS unsigned* MISC;
    gu32* ctl;
    int tid, lane, wave;
    int wave0;
    int vcu, G;
    float* out;
    unsigned char* ws;
};
constexpr int PTRTAB_OFF = LDSCTL_OFF + 512;
__device__ __forceinline__ const GAS float* inp(const Frame& F, int i) {
    const v2u w = *(const LAS v2u*)(F.lds + PTRTAB_OFF + 8 * i);
    const unsigned lo = __builtin_amdgcn_readfirstlane(w.x), hi = __builtin_amdgcn_readfirstlane(w.y);
    return (const GAS float*)(((unsigned long long)hi << 32) | lo);
}
__device__ __forceinline__ GAS unsigned char* wsq(const Frame& F) { unsigned char* p = F.ws; asm volatile("" : "+s"(p)); return (GAS unsigned char*)p; }
enum { I_XP = 0, I_XS, I_WIN, I_CONVW, I_CONVB, I_FW1, I_FB1, I_FW2, I_FB2, I_FW3, I_SINF, I_DECAY, I_HBIAS, I_QNORM, I_WUQ, I_KVNORM, I_WUKV, I_GNHY, I_GNAT, I_WOUT,
       I_NMIXPRE, I_NMIXPOST, I_NMLPPRE, I_NMLPPOST, I_WUP, I_WDOWN };

__device__ __forceinline__ int rope_src(int p) { return 4 * (p >> 3) + (p & 3) + 16 * ((p >> 2) & 1); }
template <bool ROPEPERM>
__device__ __forceinline__ void transpose_item(const GAS float* W, int K, int N, GAS bf16* WT, LAS float* scr, int item, int lane, int ldk = 0, int koff = 0) {
    if (ldk == 0) ldk = K;
    const int nblk = N / 32, kb = item / nblk, nb = item % nblk, k0 = 64 * kb, n0 = 32 * nb;
    int sc = lane & 31; if (ROPEPERM && (nb % 3) == 2) sc = rope_src(sc);
#pragma unroll 8
    for (int i = 0; i < 32; ++i) { const int kk = 2 * i + (lane >> 5); scr[kk * 33 + (lane & 31)] = W[(size_t)(k0 + kk) * N + n0 + sc]; }
    LDS_WAIT(); asm volatile("" ::: "memory");
    const int c = lane & 7;
#pragma unroll
    for (int j = 0; j < 4; ++j) { const int n = (lane >> 3) + 8 * j; const LAS float* s = scr + (8 * c) * 33 + n;
        v4u o; o.x = pk2(s[0 * 33], s[1 * 33]); o.y = pk2(s[2 * 33], s[3 * 33]); o.z = pk2(s[4 * 33], s[5 * 33]); o.w = pk2(s[6 * 33], s[7 * 33]);
        *(GAS v4u*)(WT + (size_t)(n0 + n) * ldk + koff + k0 + 8 * c) = o; }
    LDS_WAIT(); asm volatile("" ::: "memory");
}
__device__ __forceinline__ void phase_weights(Frame& F, int l) {
    LAS float* scr = (LAS float*)(F.lds + RING_OFF + F.wave * 16384);
    const int gw = F.vcu * NWAVES + F.wave, NGW = F.G * NWAVES;
    GAS bf16* WinT = (GAS bf16*)(wsq(F) + WS_WIN); GAS bf16* WoutT = (GAS bf16*)(wsq(F) + WS_WOUT); GAS bf16* WupT = (GAS bf16*)(wsq(F) + WS_WUP); GAS bf16* WdownT = (GAS bf16*)(wsq(F) + WS_WDOWN);
    GAS bf16* WuqT = (GAS bf16*)(wsq(F) + WS_WUQ); GAS bf16* WukvT = (GAS bf16*)(wsq(F) + WS_WUKV);
    constexpr int I_IN = (D / 64) * (INW / 32), I_OUT = (D / 64) * (D / 32), I_UP = (D / 64) * (FF / 32), I_DN = (FF / 64) * (D / 32), I_UQ = (QR / 64) * (NQ / 32), I_UKV = (KVR / 64) * (NKV / 32);
    constexpr int I_W3 = 2048 / 32;
    constexpr int NITEMS = I_IN + I_OUT + I_UP + I_DN + I_UQ + I_UKV + 2 * I_W3;
    for (int it = gw; it < NITEMS; it += NGW) {
        int r = it;
        if (r < I_IN) { transpose_item<false>(inp(F, I_WIN) + (size_t)l * D * INW, D, INW, WinT, scr, r, F.lane); continue; } r -= I_IN;
        if (r < I_OUT) { transpose_item<false>(inp(F, I_WOUT) + (size_t)l * D * D, D, D, WoutT, scr, r, F.lane); continue; } r -= I_OUT;
        if (r < I_UP) { transpose_item<false>(inp(F, I_WUP) + (size_t)l * D * FF, D, FF, WupT, scr, r, F.lane); continue; } r -= I_UP;
        if (r < I_DN) { transpose_item<false>(inp(F, I_WDOWN) + (size_t)l * FF * D, FF, D, WdownT, scr, r, F.lane); continue; } r -= I_DN;
        if (r < I_UQ) { transpose_item<true>(inp(F, I_WUQ) + (size_t)l * QR * NQ, QR, NQ, WuqT, scr, r, F.lane); continue; } r -= I_UQ;
        if (r < I_UKV) { transpose_item<false>(inp(F, I_WUKV) + (size_t)l * KVR * NKV, KVR, NKV, WukvT, scr, r, F.lane); continue; } r -= I_UKV;
        transpose_item<false>(inp(F, I_FW3) + (size_t)l * 64 * 2048, 64, 2048, (GAS bf16*)(wsq(F) + WS_W3T), scr, r % I_W3, F.lane, 128, (r / I_W3) * 64);
    }
    { unsigned z = 0u; asm volatile("" : "+v"(z)); const v4u zz = {z, z, z, z};
      for (int i = gw * 64 + F.lane; i < 12288; i += NGW * 64) ((GAS v4u*)(WinT + (size_t)INW * D))[i] = zz; }
}
__device__ __forceinline__ void phase_rope_tab(Frame& F) {
    const float inv[16] = {1.000000000e+00f, 5.623413324e-01f, 3.162277639e-01f, 1.778279394e-01f, 1.000000015e-01f, 5.623412877e-02f, 3.162277862e-02f, 1.778279431e-02f,
                           9.999999776e-03f, 5.623413250e-03f, 3.162277862e-03f, 1.778279431e-03f, 1.000000047e-03f, 5.623413017e-04f, 3.162277862e-04f, 1.778279402e-04f};
    GAS float* ct = (GAS float*)(wsq(F) + WS_COS); GAS float* st = (GAS float*)(wsq(F) + WS_SIN);
    for (int i = F.vcu * NTHR + F.tid; i < L * 16; i += F.G * NTHR) {
        const int t = i >> 4, j = i & 15; float iv = inv[0];
#pragma unroll
        for (int q = 1; q < 16; ++q) iv = (j == q) ? inv[q] : iv;
        const float ang = (float)t * iv; ct[i] = cosf(ang); st[i] = sinf(ang);
    }
}
__device__ __forceinline__ const GAS float* x_src_row(Frame& F, int l, int m) {
    if (l == 0) return (m < 2 * L) ? inp(F, I_XP) + (size_t)m * D : inp(F, I_XS) + (size_t)(m - 2 * L) * D;
    return (const GAS float*)F.out + (size_t)m * D;
}
__device__ __forceinline__ void store_xn_row(f32x4 (&v)[4], float rstd, const GAS float* g, GAS bf16* orow, int lane) {
    GAS v2u* o8 = (GAS v2u*)orow + lane;
#pragma unroll
    for (int j = 0; j < 4; ++j) { const f32x4 gg = ((const GAS f32x4*)g)[lane + 64 * j]; v2u w; w.x = pk2(v[j].x * rstd * gg.x, v[j].y * rstd * gg.y); w.y = pk2(v[j].z * rstd * gg.z, v[j].w * rstd * gg.w); o8[64 * j] = w; }
}
__device__ __forceinline__ float row_ss(const f32x4 (&v)[4]) { float s = 0.f;
#pragma unroll
    for (int j = 0; j < 4; ++j) s += (v[j].x * v[j].x + v[j].y * v[j].y) + (v[j].z * v[j].z + v[j].w * v[j].w);
    return wave_sum(s); }
__device__ __forceinline__ void phase_norm_first(Frame& F, int l, const GAS float* g) {
    const int gw = F.vcu * NWAVES + F.wave, NGW = F.G * NWAVES; GAS bf16* XN = (GAS bf16*)(wsq(F) + WS_XN);
    for (int m0 = gw; m0 < M; m0 += 4 * NGW) {
        f32x4 v[4][4];
#pragma unroll
        for (int q = 0; q < 4; ++q) { const int mm = m0 + q * NGW, m = mm < M ? mm : M - 1; const GAS f32x4* xr = (const GAS f32x4*)x_src_row(F, l, m) + F.lane;
#pragma unroll
            for (int j = 0; j < 4; ++j) v[q][j] = xr[64 * j]; }
#pragma unroll
        for (int q = 0; q < 4; ++q) { const int m = m0 + q * NGW; if (m >= M) break;
            const float rstd = 1.0f / sqrtf(row_ss(v[q]) * (1.0f / D) + EPS);
            store_xn_row(v[q], rstd, g, XN + (size_t)m * D, F.lane); }
    }
}
template <bool SRC_IN, bool DST_OUT>
__device__ __forceinline__ void phase_norm_res(Frame& F, const GAS bf16* T, const GAS float* gpost, const GAS float* gnext) {
    const int gw = F.vcu * NWAVES + F.wave, NGW = F.G * NWAVES; GAS bf16* XN = (GAS bf16*)(wsq(F) + WS_XN); GAS bf16* XR = (GAS bf16*)(wsq(F) + WS_XR);
    constexpr int R = SRC_IN ? 2 : 4;
    for (int m0 = gw; m0 < M; m0 += R * NGW) {
        f32x4 vf[SRC_IN ? R : 1][4]; v2u xw[SRC_IN ? 1 : R][4], tw[R][4];
#pragma unroll
        for (int q = 0; q < R; ++q) { const int mm = m0 + q * NGW, m = mm < M ? mm : M - 1; const GAS v2u* tr = (const GAS v2u*)(T + (size_t)m * D) + F.lane;
            if (SRC_IN) { const GAS f32x4* xr = (const GAS f32x4*)x_src_row(F, 0, m) + F.lane;
#pragma unroll
                for (int j = 0; j < 4; ++j) vf[SRC_IN ? q : 0][j] = xr[64 * j]; }
            else { const GAS v2u* xr = (const GAS v2u*)(XR + (size_t)m * D) + F.lane;
#pragma unroll
                for (int j = 0; j < 4; ++j) xw[SRC_IN ? 0 : q][j] = xr[64 * j]; }
#pragma unroll
            for (int j = 0; j < 4; ++j) tw[q][j] = tr[64 * j]; }
#pragma unroll
        for (int q = 0; q < R; ++q) { const int m = m0 + q * NGW; if (m >= M) break;
            f32x4 v[4], tv[4];
#pragma unroll
            for (int j = 0; j < 4; ++j) { const v2u w = tw[q][j]; tv[j] = (f32x4){bf2f(w.x & 0xffffu), bf2f(w.x >> 16), bf2f(w.y & 0xffffu), bf2f(w.y >> 16)};
                if (SRC_IN) v[j] = vf[SRC_IN ? q : 0][j]; else { const v2u x = xw[SRC_IN ? 0 : q][j]; v[j] = (f32x4){bf2f(x.x & 0xffffu), bf2f(x.x >> 16), bf2f(x.y & 0xffffu), bf2f(x.y >> 16)}; } }
            const float rt = 1.0f / sqrtf(row_ss(tv) * (1.0f / D) + EPS);
#pragma unroll
            for (int j = 0; j < 4; ++j) { const f32x4 gg = ((const GAS f32x4*)gpost)[F.lane + 64 * j]; v[j] = v[j] + tv[j] * rt * gg; }
            if (DST_OUT) { GAS f32x4* orow = (GAS f32x4*)(F.out + (size_t)m * D) + F.lane;
#pragma unroll
                for (int j = 0; j < 4; ++j) orow[64 * j] = v[j]; }
            else { GAS v2u* orow = (GAS v2u*)(XR + (size_t)m * D) + F.lane;
#pragma unroll
                for (int j = 0; j < 4; ++j) { v2u w; w.x = pk2(v[j].x, v[j].y); w.y = pk2(v[j].z, v[j].w); orow[64 * j] = w; } }
            if (gnext) { const float rstd = 1.0f / sqrtf(row_ss(v) * (1.0f / D) + EPS); store_xn_row(v, rstd, gnext, XN + (size_t)m * D, F.lane); } }
    }
}

__device__ __forceinline__ void phase_filter_mlp(Frame& F, int l) {
    const GAS float* w1 = inp(F, I_FW1) + (size_t)l * 33 * 64; const GAS float* b1 = inp(F, I_FB1) + l * 64; const GAS float* w2 = inp(F, I_FW2) + (size_t)l * 64 * 64; const GAS float* b2 = inp(F, I_FB2) + l * 64;
    const GAS float* sf = inp(F, I_SINF) + l * 128; GAS bf16* H2 = (GAS bf16*)(wsq(F) + WS_H2);
    const int lane = F.lane, gw = F.vcu * NWAVES + F.wave, NGW = F.G * NWAVES;
    float w1c[33], w2c[64];
#pragma unroll
    for (int f = 0; f < 33; ++f) w1c[f] = w1[f * 64 + lane];
#pragma unroll
    for (int i = 0; i < 64; ++i) w2c[i] = w2[i * 64 + lane];
    const float b1l = b1[lane], b2l = b2[lane], sf0 = sf[lane], sf1 = sf[64 + lane];
    for (int n = gw; n < L; n += NGW) {
        const float tn = (float)n * (1.0f / (float)(L - 1)); const float omega = (float)(2.0 * 3.14159265358979323846 / L) * (float)n;
        const int bidx = (lane >= 17) ? lane - 17 : lane - 1; const float band = 1e-4f + (float)bidx * ((15.0f - 1e-4f) / 15.0f); const float ph = omega * band;
        const float zf = (lane == 0) ? tn : ((lane <= 16) ? cosf(ph) : -sinf(ph));
        float acc = b1l;
#pragma unroll
        for (int f = 0; f < 33; ++f) acc += __uint_as_float(__builtin_amdgcn_readlane(__float_as_uint(zf), f)) * w1c[f];
        const float h1 = sinf(sf0 * acc);
        float acc2 = b2l;
#pragma unroll
        for (int i = 0; i < 64; ++i) acc2 += __uint_as_float(__builtin_amdgcn_readlane(__float_as_uint(h1), i)) * w2c[i];
        const float hv = sinf(sf1 * acc2); const bf16 hi = f2bf(hv);
        H2[(size_t)n * 128 + lane] = hi; H2[(size_t)n * 128 + 64 + lane] = f2bf(hv - bf2f(hi));
    }
}
#ifndef HYSUB
#define HYSUB 0
#endif
#define HT0() do { if (HYSUB) { __syncthreads(); if (F.tid == 0) F.MISC[20] = (unsigned)__builtin_amdgcn_s_memrealtime(); } } while (0)
#define HT1(s) do { if (HYSUB == (s)) { __syncthreads(); if (F.tid == 0) F.MISC[21] += (unsigned)__builtin_amdgcn_s_memrealtime() - F.MISC[20]; } } while (0)
typedef float f32x4u __attribute__((ext_vector_type(4), aligned(4)));
__device__ __forceinline__ void taps_stage(const GAS float* fw0, const GAS float* bw0, const GAS float* fw1, const GAS float* bw1, bool odd, LAS f32x2* buf, int t) {
    const float sg = odd ? -1.f : 1.f;
#pragma unroll 1
    for (int h = 0; h < 2; ++h) { const int tq = hfft::opaque(t) + 2048 * h; f32x4 a0[4], a1[4], r0[4], r1[4];
#pragma unroll
        for (int q = 0; q < 4; ++q) { const int c = tq + 512 * q; a0[q] = *(const GAS f32x4*)(fw0 + 4 * c); a1[q] = *(const GAS f32x4*)(fw1 + 4 * c);
            r0[q] = *(const GAS f32x4u*)(bw0 + (L - 3 - 4 * c)); r1[q] = *(const GAS f32x4u*)(bw1 + (L - 3 - 4 * c)); }
#pragma unroll
        for (int q = 0; q < 4; ++q) { const int c = tq + 512 * q; const float e0 = c > 0 ? r0[q][3] : 0.f, e1 = c > 0 ? r1[q][3] : 0.f;
            LAS f32x4* dst = (LAS f32x4*)(buf + 4 * c);
            dst[0] = (f32x4){a0[q][0] + sg * e0, a1[q][0] + sg * e1, a0[q][1] + sg * r0[q][2], a1[q][1] + sg * r1[q][2]};
            dst[1] = (f32x4){a0[q][2] + sg * r0[q][1], a1[q][2] + sg * r1[q][1], a0[q][3] + sg * r0[q][0], a1[q][3] + sg * r1[q][0]}; } }
}
__device__ __forceinline__ void phase_filter_fft(Frame& F, int l) {
    const GAS float* KT = (const GAS float*)(wsq(F) + WS_KT); GAS f32x2* KEO = (GAS f32x2*)(wsq(F) + WS_KEO); const GAS float* hb = inp(F, I_HBIAS) + (size_t)l * 2 * HYW;
    LAS f32x2* buf = (LAS f32x2*)(F.lds + RING_OFF); const int t = F.tid;
    for (int c = F.vcu; c < HYW; c += F.G) {
        const GAS float* fw0 = KT + (size_t)(0 * HYW + c) * L; const GAS float* bw0 = KT + (size_t)(1 * HYW + c) * L;
        const GAS float* fw1 = KT + (size_t)(2 * HYW + c) * L; const GAS float* bw1 = KT + (size_t)(3 * HYW + c) * L;
        const float bias0 = hb[c], bias1 = hb[HYW + c]; const float sc = 1.0f / (2.0f * L);
        GAS f32x2* k0 = KEO + (size_t)c * KEO_BLK; GAS f32x2* k1 = KEO + (size_t)(HYW + c) * KEO_BLK;
        float ar[32], ai[32];
#pragma unroll 1
        for (int odd = 0; odd < 2; ++odd) {
            HT0();
            __syncthreads(); taps_stage(fw0, bw0, fw1, bw1, odd != 0, buf, t); __syncthreads();
            { const int tq = hfft::opaque(t);
#pragma unroll
              for (int m = 0; m < 32; ++m) { const int n = tq + 512 * m; const f32x2 v = buf[n];
                  if (!odd) { ar[m] = v.x; ai[m] = v.y; }
                  else { const float d0 = v.x, d1 = v.y; const float fr = (float)n * (1.0f / 32768.0f); const float cs = __builtin_amdgcn_cosf(fr), sn = -__builtin_amdgcn_sinf(fr);
                         ar[m] = d0 * cs - d1 * sn; ai[m] = d0 * sn + d1 * cs; } } }
            HT1(11); HT0(); hfft::fft16k<false>(ar, ai, buf, t); HT1(12); HT0();
            __syncthreads();
            { const int tq = hfft::opaque(t);
#pragma unroll
              for (int m = 0; m < 32; ++m) buf[hfft::pad(tq + 512 * m)] = (f32x2){ar[m], ai[m]}; }
            __syncthreads();
            { const int tq = hfft::opaque(t); GAS f32x2* d0 = k0 + (odd ? KEO_KO : 0); GAS f32x2* d1 = k1 + (odd ? KEO_KO : 0);
#pragma unroll
              for (int m = 0; m <= 16; ++m) { const int k = tq + 512 * m; const bool keep = odd ? (k < 8192) : (k <= 8192);
                  const int rk = odd ? 16383 - k : ((16384 - k) & 16383); const f32x2 xq = buf[hfft::pad(rk)]; const float cr = xq.x, ci = -xq.y;
                  const float a0 = 0.5f * (ar[m] + cr), a1 = 0.5f * (ai[m] + ci), b0 = 0.5f * (ai[m] - ci), b1 = -0.5f * (ar[m] - cr);
                  if (keep) { d0[k] = (f32x2){(a0 + bias0) * sc, a1 * sc}; d1[k] = (f32x2){(b0 + bias1) * sc, b1 * sc}; } } }
            HT1(13);
        }
    }
    __syncthreads();
}

__device__ __forceinline__ float u_conv3(const GAS bf16* row, int n, float w0, float w1, float w2, float cb) {
    const int nm = n >= 1 ? n - 1 : 0, np = n + 1 < L ? n + 1 : L - 1;
    float um = bf2f(row[nm]), up = bf2f(row[np]); const float u0 = bf2f(row[n]);
    um = n >= 1 ? um : 0.f; up = n + 1 < L ? up : 0.f;
    return um * w0 + u0 * w1 + up * w2 + cb;
}
__device__ __forceinline__ void conv3_stage(const GAS bf16* r0, const GAS bf16* r1, float w0, float w1, float w2, float cb, float v0, float v1, float v2, float vb, LAS f32x2* buf, int t) {
    const int tq = hfft::opaque(t);
#pragma unroll
    for (int q = 0; q < 4; ++q) { const int j = tq + 512 * q; const bool hl = j > 0, hr = j < L / 8 - 1; const int nl = hl ? 8 * j - 1 : 0, nr = hr ? 8 * j + 8 : L - 1;
        const v4u a = *(const GAS v4u*)(r0 + 8 * j), b = *(const GAS v4u*)(r1 + 8 * j);
        float al = bf2f(r0[nl]), ar = bf2f(r0[nr]), bl = bf2f(r1[nl]), br = bf2f(r1[nr]);
        al = hl ? al : 0.f; bl = hl ? bl : 0.f; ar = hr ? ar : 0.f; br = hr ? br : 0.f;
        const float ua[10] = {al, __uint_as_float(a.x << 16), __uint_as_float(a.x & 0xffff0000u), __uint_as_float(a.y << 16), __uint_as_float(a.y & 0xffff0000u),
                              __uint_as_float(a.z << 16), __uint_as_float(a.z & 0xffff0000u), __uint_as_float(a.w << 16), __uint_as_float(a.w & 0xffff0000u), ar};
        const float ub[10] = {bl, __uint_as_float(b.x << 16), __uint_as_float(b.x & 0xffff0000u), __uint_as_float(b.y << 16), __uint_as_float(b.y & 0xffff0000u),
                              __uint_as_float(b.z << 16), __uint_as_float(b.z & 0xffff0000u), __uint_as_float(b.w << 16), __uint_as_float(b.w & 0xffff0000u), br};
        LAS f32x4* dst = (LAS f32x4*)(buf + 8 * j);
#pragma unroll
        for (int e = 0; e < 8; e += 2) { f32x4 o;
            o[0] = ua[e] * w0 + ua[e + 1] * w1 + ua[e + 2] * w2 + cb; o[1] = ub[e] * v0 + ub[e + 1] * v1 + ub[e + 2] * v2 + vb;
            o[2] = ua[e + 1] * w0 + ua[e + 2] * w1 + ua[e + 3] * w2 + cb; o[3] = ub[e + 1] * v0 + ub[e + 2] * v1 + ub[e + 3] * v2 + vb; dst[e >> 1] = o; } }
}
__device__ __forceinline__ void cmul_spec(float (&xr)[32], float (&xi)[32], const GAS f32x2* ke, int t, bool odd) {
    { const int tq = hfft::opaque(t); (void)tq;
#pragma unroll
    for (int m = 0; m < 32; ++m) { const int k = tq + 512 * m; int idx; bool cj;
        if (!odd) { cj = k > 8192; idx = cj ? 16384 - k : k; } else { cj = k >= 8192; idx = cj ? 16383 - k : k; }
        const f32x2 kv = ke[idx]; const float kr = kv.x, ki = cj ? -kv.y : kv.y;
        const float a = xr[m], b = xi[m]; xr[m] = a * kr - b * ki; xi[m] = a * ki + b * kr; if ((m & 15) == 15) { asm volatile("" ::: "memory"); __builtin_amdgcn_sched_barrier(0); } }
    }
}
__device__ __forceinline__ f32x2 ld_spec(const GAS f32x2* ke, int k, bool odd) {
    int idx; bool cj;
    if (!odd) { cj = k > 8192; idx = cj ? 16384 - k : k; } else { cj = k >= 8192; idx = cj ? 16383 - k : k; }
    f32x2 kv = ke[idx]; kv.y = cj ? -kv.y : kv.y; return kv;
}
__device__ __forceinline__ void cmul_spec2(float (&xr)[32], float (&xi)[32], const GAS f32x2* ka, const GAS f32x2* kb, LAS f32x2* buf, int t, bool odd) {
    __syncthreads();
    { const int tq = hfft::opaque(t);
#pragma unroll
      for (int m = 0; m < 32; ++m) buf[hfft::pad(tq + 512 * m)] = (f32x2){xr[m], xi[m]}; }
    __syncthreads();
    { const int tq = hfft::opaque(t);
#pragma unroll
      for (int m = 0; m < 32; ++m) { const int k = tq + 512 * m; const int rk = odd ? 16383 - k : ((16384 - k) & 16383);
          const f32x2 xc = buf[hfft::pad(rk)];
          const f32x2 a = ld_spec(ka, k, odd), b = ld_spec(kb, k, odd);
          const float sr = 0.5f * (a.x + b.x), si = 0.5f * (a.y + b.y), dr = 0.5f * (a.x - b.x), di = 0.5f * (a.y - b.y);
          const float x0 = xr[m], x1 = xi[m], c0 = xc.x, c1 = -xc.y;
          xr[m] = (x0 * sr - x1 * si) + (c0 * dr - c1 * di); xi[m] = (x0 * si + x1 * sr) + (c0 * di + c1 * dr);
          if ((m & 7) == 7) { asm volatile("" ::: "memory"); __builtin_amdgcn_sched_barrier(0); } } }
}
__device__ __forceinline__ void spec_prefetch(const GAS f32x2* ke, LAS unsigned char* lds, int t) {
    const int tq = hfft::opaque(t); const GAS unsigned char* src = (const GAS unsigned char*)ke + (tq >> 6) * 1024 + (tq & 63) * 16;
#pragma unroll
    for (int p = 0; p < 9; ++p) { int off = p * 8192; if (p == 8) off = (tq >> 6) == 0 ? off : 0;
        __builtin_amdgcn_global_load_lds((const GAS unsigned*)(src + off), (LAS unsigned*)(lds + RING_OFF + 135168), 16, 0, 0); }
}
__device__ __forceinline__ void phase_hyena(Frame& F, int l) {
    const GAS bf16* UT = (const GAS bf16*)(wsq(F) + WS_UT); GAS bf16* YT = (GAS bf16*)(wsq(F) + WS_YT); const GAS f32x2* KEO = (const GAS f32x2*)(wsq(F) + WS_KEO);
    const GAS float* cw = inp(F, I_CONVW) + (size_t)l * 3 * HYP; const GAS float* cbv = inp(F, I_CONVB) + (size_t)l * HYP;
    LAS f32x2* buf = (LAS f32x2*)(F.lds + RING_OFF); const int t = F.tid;
    GAS f32x2* G0 = (GAS f32x2*)(wsq(F) + WS_G0) + (size_t)F.vcu * 16384 + t;
    for (int item = F.vcu; item < HYW + HYW / 2; item += F.G) {
        const bool mode1 = item >= HYW;
        const int c0 = mode1 ? 2 * (item - HYW) : item, c1 = mode1 ? c0 + 1 : c0;
        const size_t s0 = mode1 ? (size_t)2 * L : 0, s1 = mode1 ? (size_t)2 * L : (size_t)L;
        float ar[32], ai[32]; unsigned ep[32];
#pragma unroll 1
        for (int o = 0; o < 2; ++o) {
            const GAS f32x2* ke0 = KEO + (size_t)(o * HYW + c0) * KEO_BLK; const GAS f32x2* ke1 = KEO + (size_t)(o * HYW + c1) * KEO_BLK;
#pragma unroll 1
            for (int half = 0; half < 2; ++half) {
                HT0();
                if (o == 0) { const float w0 = cw[c0], w1 = cw[HYP + c0], w2 = cw[2 * HYP + c0], cb = cbv[c0], v0 = cw[c1], v1 = cw[HYP + c1], v2 = cw[2 * HYP + c1], vb = cbv[c1];
                    const GAS bf16* r0 = UT + (size_t)c0 * M + s0; const GAS bf16* r1 = UT + (size_t)c1 * M + s1;
                    __syncthreads(); conv3_stage(r0, r1, w0, w1, w2, cb, v0, v1, v2, vb, buf, t); __syncthreads();
                    { const int tq = hfft::opaque(t);
#pragma unroll
                    for (int m = 0; m < 32; ++m) { const f32x2 v = buf[tq + 512 * m]; ar[m] = v.x; ai[m] = v.y; } }
                    }
                else {
                    { const int tq = hfft::opaque(t); (void)tq; GAS f32x2* G0q = G0 + (tq - t);
#pragma unroll
                    for (int m = 0; m < 32; ++m) { const f32x2 v = G0q[m * 512]; ar[m] = v.x; ai[m] = v.y; if ((m & 15) == 15) { asm volatile("" ::: "memory"); __builtin_amdgcn_sched_barrier(0); } } }
                    }
                HT1(1);
                if (half == 0) {
                    spec_prefetch(ke0, F.lds, t); if (mode1) spec_prefetch(ke1, F.lds, t);
                    HT0(); hfft::fft16k<false>(ar, ai, buf, t); HT1(2); HT0();
                    if (mode1) cmul_spec2(ar, ai, ke0, ke1, buf, t, false); else cmul_spec(ar, ai, ke0, t, false);
                    HT1(3); HT0(); hfft::fft16k<true>(ar, ai, buf, t); HT1(2); HT0();
                    {
#pragma unroll
                    for (int m = 0; m < 32; ++m) ep[m] = pk2(ar[m], ai[m]);
                    }
                    HT1(4);
                } else {
                    HT0();
                    { const int tq = hfft::opaque(t); (void)tq;
#pragma unroll
                    for (int m = 0; m < 32; ++m) { const float fr = (float)(tq + 512 * m) * (1.0f / 32768.0f); const float cs = __builtin_amdgcn_cosf(fr), sn = -__builtin_amdgcn_sinf(fr);
                        const float a = ar[m], b = ai[m]; ar[m] = a * cs - b * sn; ai[m] = a * sn + b * cs; }
                    }
                    spec_prefetch(ke0 + KEO_KO, F.lds, t); if (mode1) spec_prefetch(ke1 + KEO_KO, F.lds, t);
                    HT1(5); HT0(); hfft::fft16k<false>(ar, ai, buf, t); HT1(2); HT0();
                    if (mode1) cmul_spec2(ar, ai, ke0 + KEO_KO, ke1 + KEO_KO, buf, t, true); else cmul_spec(ar, ai, ke0 + KEO_KO, t, true);
                    HT1(3); HT0(); hfft::fft16k<true>(ar, ai, buf, t); HT1(2); HT0();
                    const int g0 = (o + 1) * HYW + c0, g1 = (o + 1) * HYW + c1;
                    const float w0 = cw[g0], w1 = cw[HYP + g0], w2 = cw[2 * HYP + g0], cb = cbv[g0], v0 = cw[g1], v1 = cw[HYP + g1], v2 = cw[2 * HYP + g1], vb = cbv[g1];
                    const GAS bf16* r0 = UT + (size_t)g0 * M + s0; const GAS bf16* r1 = UT + (size_t)g1 * M + s1;
                    __syncthreads(); conv3_stage(r0, r1, w0, w1, w2, cb, v0, v1, v2, vb, buf, t); __syncthreads();
                    { const int tq = hfft::opaque(t); (void)tq;
#pragma unroll
                    for (int m = 0; m < 32; ++m) { const int n = tq + 512 * m; const float fr = (float)n * (1.0f / 32768.0f); const float cs = __builtin_amdgcn_cosf(fr), sn = __builtin_amdgcn_sinf(fr); const f32x2 g = buf[n];
                        const float a = ar[m], b = ai[m]; const f32x2 e = {__uint_as_float(ep[m] << 16), __uint_as_float(ep[m] & 0xffff0000u)}; const float yr = e.x + (a * cs - b * sn), yi = e.y + (a * sn + b * cs);
                        ar[m] = yr * g.x; ai[m] = yi * g.y; }
                    }
                    if (o == 0) {
                        { const int tq = hfft::opaque(t); (void)tq; GAS f32x2* G0q = G0 + (tq - t);
#pragma unroll
                        for (int m = 0; m < 32; ++m) G0q[m * 512] = (f32x2){ar[m], ai[m]};
                        }
                    } else { GAS bf16* y0 = YT + (size_t)c0 * M + s0; GAS bf16* y1 = YT + (size_t)c1 * M + s1;
                        { const int tq = hfft::opaque(t); (void)tq;
#pragma unroll
                        for (int m = 0; m < 32; ++m) { const int n = tq + 512 * m; y0[n] = f2bf(ar[m]); y1[n] = f2bf(ai[m]); } }
                        }
                    HT1(6);
                }
            }
        }
    }
    __syncthreads();
}

__device__ __forceinline__ void phase_mla_prep(Frame& F, int l) {
    const GAS bf16* CQKV = (const GAS bf16*)(wsq(F) + WS_CQKV); GAS bf16* CQN = (GAS bf16*)(wsq(F) + WS_CQN); GAS bf16* CKVN = (GAS bf16*)(wsq(F) + WS_CKVN); GAS bf16* KPE = (GAS bf16*)(wsq(F) + WS_KPE);
    const GAS float* gq = inp(F, I_QNORM) + l * QR; const GAS float* gkv = inp(F, I_KVNORM) + l * KVR; const GAS float* ct = (const GAS float*)(wsq(F) + WS_COS); const GAS float* st = (const GAS float*)(wsq(F) + WS_SIN);
    const int gw = F.vcu * NWAVES + F.wave, NGW = F.G * NWAVES, lane = F.lane;
    for (int m0 = gw; m0 < M; m0 += 4 * NGW) {
        v2u q[4]; unsigned kv[4]; float x1[4], x2[4], cs[4], sn[4]; const int j = lane & 15;
#pragma unroll
        for (int u = 0; u < 4; ++u) { const int mm = m0 + u * NGW, m = mm < M ? mm : M - 1; const GAS bf16* row = CQKV + (size_t)m * 512; const int tpos = m & (L - 1);
            q[u] = *(const GAS v2u*)(row + 4 * lane); kv[u] = *(const GAS unsigned*)(row + 256 + 2 * lane);
            x1[u] = bf2f(row[384 + j]); x2[u] = bf2f(row[384 + 16 + j]); cs[u] = ct[tpos * 16 + j]; sn[u] = st[tpos * 16 + j]; }
        const f32x4 g4 = *(const GAS f32x4*)(gq + 4 * lane); const f32x2 g2 = *(const GAS f32x2*)(gkv + 2 * lane);
#pragma unroll
        for (int u = 0; u < 4; ++u) { const int m = m0 + u * NGW; if (m >= M) break;
            const float q0 = bf2f(q[u].x & 0xffffu), q1 = bf2f(q[u].x >> 16), q2 = bf2f(q[u].y & 0xffffu), q3 = bf2f(q[u].y >> 16), k0 = bf2f(kv[u] & 0xffffu), k1 = bf2f(kv[u] >> 16);
            const float rq = 1.0f / sqrtf(wave_sum((q0 * q0 + q1 * q1) + (q2 * q2 + q3 * q3)) * (1.0f / QR) + EPS);
            const float rk = 1.0f / sqrtf(wave_sum(k0 * k0 + k1 * k1) * (1.0f / KVR) + EPS);
            v2u oq; oq.x = pk2(q0 * rq * g4.x, q1 * rq * g4.y); oq.y = pk2(q2 * rq * g4.z, q3 * rq * g4.w);
            *(GAS v2u*)(CQN + (size_t)m * QR + 4 * lane) = oq;
            *(GAS unsigned*)(CKVN + (size_t)m * KVR + 2 * lane) = pk2(k0 * rk * g2.x, k1 * rk * g2.y);
            if (lane < 16) { const int p1 = 8 * (j >> 2) + (j & 3); KPE[(size_t)m * ROPE + p1] = f2bf(x1[u] * cs[u] - x2[u] * sn[u]); KPE[(size_t)m * ROPE + p1 + 4] = f2bf(x2[u] * cs[u] + x1[u] * sn[u]); } }
    }
}

__device__ __forceinline__ void phase_hy_out(Frame& F, int l) {
    const GAS bf16* YT = (const GAS bf16*)(wsq(F) + WS_YT); GAS bf16* MIX = (GAS bf16*)(wsq(F) + WS_MIX); const GAS float* gn = inp(F, I_GNHY) + l * HYW;
    LAS bf16* tl = (LAS bf16*)(F.lds + RING_OFF + F.wave * 16384);
    const int gw = F.vcu * NWAVES + F.wave, NGW = F.G * NWAVES, lane = F.lane;
    for (int task = gw; task < 8 * (M / 64); task += NGW) {
        const int g = task & 7, tb = task >> 3, tok0 = tb * 64; const int cl = lane >> 3, t8 = (lane & 7) * 8;
        float v[8][8]; float ss[8]; const int ln_ = hw_lane();
#pragma unroll
        for (int j = 0; j < 8; ++j) ss[j] = 0.f;
#pragma unroll
        for (int i = 0; i < 8; ++i) { const int ch = g * 64 + 8 * i + cl; const v4u w = *(const GAS v4u*)(YT + (size_t)ch * M + tok0 + t8);
            v[i][0] = bf2f(w.x & 0xffffu); v[i][1] = bf2f(w.x >> 16); v[i][2] = bf2f(w.y & 0xffffu); v[i][3] = bf2f(w.y >> 16);
            v[i][4] = bf2f(w.z & 0xffffu); v[i][5] = bf2f(w.z >> 16); v[i][6] = bf2f(w.w & 0xffffu); v[i][7] = bf2f(w.w >> 16);
#pragma unroll
            for (int j = 0; j < 8; ++j) ss[j] += v[i][j] * v[i][j]; }
#pragma unroll
        for (int j = 0; j < 8; ++j) { float s = ss[j]; s += shx(s, ln_, 8); s += shx(s, ln_, 16); s += shx(s, ln_, 32); ss[j] = 1.0f / sqrtf(s * (1.0f / 64.0f) + EPS); }
#pragma unroll
        for (int i = 0; i < 8; ++i) { const int cc = 8 * i + cl; const float gg = gn[g * 64 + cc];
#pragma unroll
            for (int j = 0; j < 8; ++j) tl[(t8 + j) * 72 + cc] = f2bf(v[i][j] * ss[j] * gg); }
        LDS_WAIT(); asm volatile("" ::: "memory");
#pragma unroll
        for (int i = 0; i < 8; ++i) { const int tok = 8 * i + (lane >> 3), c8 = (lane & 7) * 8; const v4u w = *(const LAS v4u*)(tl + tok * 72 + c8);
            *(GAS v4u*)(MIX + (size_t)(tok0 + tok) * D + g * 64 + c8) = w; }
        LDS_WAIT(); asm volatile("" ::: "memory");
    }
}

namespace att {
using s16x4 = __attribute__((ext_vector_type(4))) short;
using f32x16 = __attribute__((ext_vector_type(16))) float;
using u32x4 = __attribute__((ext_vector_type(4))) unsigned;
constexpr int QBLK = 32, KVBLK = 64, NW = 8;
constexpr float SCALE = 0.10206207261596575f;
constexpr float THR = 8.f;
constexpr int SHM_K = KVBLK * 256, SHM_V = KVBLK * DV * 2;
constexpr int NSLOT = 4;
constexpr int OFF_V = 0, OFF_K = NSLOT * SHM_V, OFF_WS = OFF_K + NSLOT * SHM_K, SHM_ATTN = OFF_WS + NW * 64 * 4;
#define KSWZ(row, colB) ((row) * 256 + ((colB) ^ (((row) & 15) << 4)))
#define SBAR() __builtin_amdgcn_sched_barrier(0)
__device__ __forceinline__ int crow(int r, int hi) { return (r & 3) + 8 * (r >> 2) + 4 * hi; }
__device__ __forceinline__ unsigned cvtpk(float lo, float hi) { unsigned r; asm volatile("v_cvt_pk_bf16_f32 %0, %1, %2" : "=v"(r) : "v"(lo), "v"(hi)); return r; }
constexpr float THRL = THR * 1.4426950408889634f;
#define EX2(v) ((ABL & 1) ? (v) : __builtin_amdgcn_exp2f(v))
#define MX3(a, b, c) ((ABL & 128) ? (a) : __builtin_fmaxf(__builtin_fmaxf((a), (b)), (c)))
__device__ __forceinline__ int v_st(int k, int c) { const int kk = k; return ((kk >> 3) * 2 + (c >> 5)) * 512 + ((kk & 7) * 32 + (c & 31)) * 2; }
__device__ __forceinline__ int v_rd_base(int lane) { return ((lane & 3) << 3) | (((lane >> 2) & 3) << 6) | (((lane >> 4) & 1) << 5) | (((lane >> 5) & 1) << 8); }
constexpr int v_rd_off(int d0, int ks, int half) { return d0 * 512 + ks * 2048 + half * 1024; }
template <int OFF> __device__ __forceinline__ s16x4 tr_read(int vb) { s16x4 r; asm volatile("ds_read_b64_tr_b16 %0, %1 offset:%2" : "=&v"(r) : "v"(vb), "i"(OFF) : "memory"); return r; }
template <int ABL> __device__ __forceinline__ void attn_unit(const bf16* Qb_, const bf16* KNh_, const bf16* KPEb_, const bf16* Vh_, bf16* Mo_,
                                          const float* gain_, const float* ct_, const float* st_, int tpos0, LAS char* lds, const int wave0) {
  const GAS bf16* Qb = (const GAS bf16*)Qb_; const GAS bf16* KNh = (const GAS bf16*)KNh_; const GAS bf16* KPEb = (const GAS bf16*)KPEb_; const GAS bf16* Vh = (const GAS bf16*)Vh_; GAS bf16* Mo = (GAS bf16*)Mo_;
  const GAS float* gain = (const GAS float*)gain_; const GAS float* ct = (const GAS float*)ct_; const GAS float* st = (const GAS float*)st_;

  int tid_ = tid_from_wave(wave0);
  const int tid = tid_, wid = tid >> 6, lane = tid & 63, r32 = lane & 31, hi = lane >> 5;
  LAS char* V_lds = lds + OFF_V; LAS char* K_lds = lds + OFF_K;
  LAS float* ws = (LAS float*)(lds + OFF_WS) + wid * 64; LAS float* li_l = ws; LAS float* al_l = ws + 32;
  float m_reg = 0.f, l_reg = 0.f; f32x16 o[2] = {}; f32x16 negm = {}; bf16x8 qr[6];
  const GAS bf16* Qw = Qb + (long)(wid * QBLK + r32) * NQ + hi * 8;
#pragma unroll
  for (int d0 = 0; d0 < 6; ++d0) qr[d0] = *reinterpret_cast<const GAS bf16x8*>(Qw + d0 * 16);
  { const int tq = tpos0 + wid * QBLK + r32;
#pragma unroll
    for (int d0 = 4; d0 < 6; ++d0) { const int fq = 2 * (d0 - 4) + hi; const f32x4 cs = *reinterpret_cast<const GAS f32x4*>(ct + tq * 16 + 4 * fq), sn = *reinterpret_cast<const GAS f32x4*>(st + tq * 16 + 4 * fq);
      const u32x4 w = __builtin_bit_cast(u32x4, qr[d0]);
      const f32x4 x1 = {bf2f(w[0] & 0xffffu), bf2f(w[0] >> 16), bf2f(w[1] & 0xffffu), bf2f(w[1] >> 16)}, x2 = {bf2f(w[2] & 0xffffu), bf2f(w[2] >> 16), bf2f(w[3] & 0xffffu), bf2f(w[3] >> 16)};
      const f32x4 a = x1 * cs - x2 * sn, b = x2 * cs + x1 * sn;
      const u32x4 o4 = {cvtpk(a[0], a[1]), cvtpk(a[2], a[3]), cvtpk(b[0], b[1]), cvtpk(b[2], b[3])}; qr[d0] = __builtin_bit_cast(bf16x8, o4); } }
  { constexpr float C = SCALE * 1.4426950408889634f;
#pragma unroll
    for (int d0 = 0; d0 < 6; ++d0) { const u32x4 w = __builtin_bit_cast(u32x4, qr[d0]); u32x4 o4;
#pragma unroll
      for (int e = 0; e < 4; ++e) o4[e] = cvtpk(bf2f(w[e] & 0xffffu) * C, bf2f(w[e] >> 16) * C);
      qr[d0] = __builtin_bit_cast(bf16x8, o4); } }
  const int vb0 = (int)(unsigned)(uintptr_t)V_lds + v_rd_base(lane);
  const int wid_s = __builtin_amdgcn_readfirstlane(wid);
  const GAS bf16* ksrc[2]; long kstep[2];
#pragma unroll
  for (int q = 0; q < 2; ++q) { const int r = 4 * (2 * wid + q) + (lane >> 4), c = (lane & 15) ^ (r & 15); const bool rope = (c >= 8) && (c < 12);
    ksrc[q] = rope ? KPEb + (long)r * ROPE + (c - 8) * 8 : KNh + (long)r * NKV + (c & 7) * 8; kstep[q] = rope ? (long)KVBLK * ROPE : (long)KVBLK * NKV; }
  const GAS bf16* vsrc; { const int p = 64 * wid + lane, sub = p >> 5, kk = (sub >> 1) * 8 + ((p >> 2) & 7), col = (sub & 1) * 32 + (p & 3) * 8; vsrc = Vh + (long)kk * NKV + col; }
#define DMA(t, slot) do { if (ABL & 32) break; \
    __builtin_amdgcn_global_load_lds((const GAS unsigned*)(ksrc[0] + (long)(t) * kstep[0]), (LAS unsigned*)(K_lds + (slot) * SHM_K + (2 * wid_s) * 1024), 16, 0, 0); \
    __builtin_amdgcn_global_load_lds((const GAS unsigned*)(ksrc[1] + (long)(t) * kstep[1]), (LAS unsigned*)(K_lds + (slot) * SHM_K + (2 * wid_s + 1) * 1024), 16, 0, 0); \
    __builtin_amdgcn_global_load_lds((const GAS unsigned*)(vsrc + (long)(t) * ((long)KVBLK * NKV)), (LAS unsigned*)(V_lds + (slot) * SHM_V + wid_s * 1024), 16, 0, 0); } while (0)
#define TBAR(N) do { asm volatile("s_waitcnt vmcnt(" #N ") lgkmcnt(0)" ::: "memory"); if (!(ABL & 64)) __builtin_amdgcn_s_barrier(); asm volatile("" ::: "memory"); } while (0)
#define RESC(a) do { if (__any((a) < 1.f)) { if (hi == 0) al_l[r32] = (a); asm volatile("s_waitcnt lgkmcnt(0)" ::: "memory"); \
    _Pragma("unroll") for (int d = 0; d < 2; ++d) _Pragma("unroll") for (int r = 0; r < 16; ++r) o[d][r] *= al_l[crow(r, hi)]; } } while (0)
  f32x16 pA0, pA1, pB0, pB1; bf16x8 pa0, pa1, pa2, pa3; constexpr int NTL = L / KVBLK; constexpr int SE = 0, SO = 1;
  int koff[6];
#pragma unroll
  for (int d0 = 0; d0 < 6; ++d0) koff[d0] = KSWZ(r32, (d0 * 16 + hi * 8) * 2);
  s16x4 vl[4], vh[4]; float pmax = 0.f, alpha = 1.f;
#define KFR(i) ((ABL & 8) ? qr[(i) >> 1] : *(const LAS bf16x8*)(kbase + koff[(i) >> 1] + ((i) & 1) * 8192))
#define MQK(a_, b_, c_) ((ABL & 2) ? (c_) : __builtin_amdgcn_mfma_f32_32x32x16_bf16(a_, b_, c_, 0, 0, 0))
#define MPV(a_, b_, c_) ((ABL & 4) ? (c_) : __builtin_amdgcn_mfma_f32_32x32x16_bf16(a_, b_, c_, 0, 0, 0))
#define VRD8(D0) do { if (ABL & 16) break; vl[0] = tr_read<v_rd_off(D0, 0, 0)>(vbq); vh[0] = tr_read<v_rd_off(D0, 0, 1)>(vbq); vl[1] = tr_read<v_rd_off(D0, 1, 0)>(vbq); vh[1] = tr_read<v_rd_off(D0, 1, 1)>(vbq); \
    vl[2] = tr_read<v_rd_off(D0, 2, 0)>(vbq); vh[2] = tr_read<v_rd_off(D0, 2, 1)>(vbq); vl[3] = tr_read<v_rd_off(D0, 3, 0)>(vbq); vh[3] = tr_read<v_rd_off(D0, 3, 1)>(vbq); } while (0)
#define VWAIT() if (!(ABL & 16)) asm volatile("s_waitcnt lgkmcnt(0)" : "+v"(vl[0]), "+v"(vh[0]), "+v"(vl[1]), "+v"(vh[1]), "+v"(vl[2]), "+v"(vh[2]), "+v"(vl[3]), "+v"(vh[3]) :: "memory")
#define VFR(k) (bf16x8){vl[k][0], vl[k][1], vl[k][2], vl[k][3], vh[k][0], vh[k][1], vh[k][2], vh[k][3]}
#define PKA(P, B) do { if (ABL & 256) break; w0_ = cvtpk(P[B + 0], P[B + 1]); w1_ = cvtpk(P[B + 2], P[B + 3]); } while (0)
#define PKB(P, B, OUT) do { if (ABL & 256) { OUT = qr[0]; break; } const u32x4 w_ = {w0_, w1_, cvtpk(P[B + 4], P[B + 5]), cvtpk(P[B + 6], P[B + 7])}; OUT = __builtin_bit_cast(bf16x8, w_); } while (0)
#define R1(DO_QK, DO_FIN, X0, X1, Y0, Y1, KSLOT) do { const LAS char* kbase = K_lds + (KSLOT) * SHM_K; bf16x8 kf0, kf1, kf2, kf3; unsigned w0_ = 0, w1_ = 0; \
    if (DO_QK) { kf0 = KFR(0); kf1 = KFR(1); kf2 = KFR(2); } SBAR(); \
      if (DO_QK) { kf3 = KFR(3); X0 = MQK(kf0, qr[0], negm); } if (DO_FIN) { Y0[0] = EX2(Y0[0]); Y0[1] = EX2(Y0[1]); Y0[2] = EX2(Y0[2]); Y0[3] = EX2(Y0[3]); } SBAR(); \
      if (DO_QK) { kf0 = KFR(4); X1 = MQK(kf1, qr[0], negm); } if (DO_FIN) { Y0[4] = EX2(Y0[4]); Y0[5] = EX2(Y0[5]); Y0[6] = EX2(Y0[6]); Y0[7] = EX2(Y0[7]); } SBAR(); \
      if (DO_QK) { kf1 = KFR(5); X0 = MQK(kf2, qr[1], X0); } if (DO_FIN) { Y0[8] = EX2(Y0[8]); Y0[9] = EX2(Y0[9]); Y0[10] = EX2(Y0[10]); Y0[11] = EX2(Y0[11]); } SBAR(); \
      if (DO_QK) { kf2 = KFR(6); X1 = MQK(kf3, qr[1], X1); } if (DO_FIN) { Y0[12] = EX2(Y0[12]); Y0[13] = EX2(Y0[13]); Y0[14] = EX2(Y0[14]); Y0[15] = EX2(Y0[15]); } SBAR(); \
      if (DO_QK) { kf3 = KFR(7); X0 = MQK(kf0, qr[2], X0); } if (DO_FIN) { Y1[0] = EX2(Y1[0]); Y1[1] = EX2(Y1[1]); Y1[2] = EX2(Y1[2]); Y1[3] = EX2(Y1[3]); PKA(Y0, 0); } SBAR(); \
      if (DO_QK) { kf0 = KFR(8); X1 = MQK(kf1, qr[2], X1); } if (DO_FIN) { Y1[4] = EX2(Y1[4]); Y1[5] = EX2(Y1[5]); Y1[6] = EX2(Y1[6]); Y1[7] = EX2(Y1[7]); PKB(Y0, 0, pa0); } SBAR(); \
      if (DO_QK) { kf1 = KFR(9); X0 = MQK(kf2, qr[3], X0); } if (DO_FIN) { Y1[8] = EX2(Y1[8]); Y1[9] = EX2(Y1[9]); Y1[10] = EX2(Y1[10]); Y1[11] = EX2(Y1[11]); PKA(Y0, 8); } SBAR(); \
      if (DO_QK) { kf2 = KFR(10); X1 = MQK(kf3, qr[3], X1); } if (DO_FIN) { Y1[12] = EX2(Y1[12]); Y1[13] = EX2(Y1[13]); Y1[14] = EX2(Y1[14]); Y1[15] = EX2(Y1[15]); PKB(Y0, 8, pa1); } SBAR(); \
      if (DO_QK) { kf3 = KFR(11); X0 = MQK(kf0, qr[4], X0); } if (DO_FIN) { PKA(Y1, 0); } SBAR(); \
      if (DO_QK) { X1 = MQK(kf1, qr[4], X1); } if (DO_FIN) { PKB(Y1, 0, pa2); } SBAR(); \
      if (DO_QK) { X0 = MQK(kf2, qr[5], X0); } if (DO_FIN) { PKA(Y1, 8); } SBAR(); \
      if (DO_QK) { X1 = MQK(kf3, qr[5], X1); } if (DO_FIN) { PKB(Y1, 8, pa3); } SBAR(); \
  } while (0)
#define R2(DO_PV, DO_MAX, X0, X1, Y0, Y1, VSLOT, LOADS) do { const int vbq = vb0 + (VSLOT) * SHM_V; float ma_ = 0.f, mb_ = 0.f, sa_ = 0.f; \
    if (DO_PV) { VRD8(0); } SBAR(); \
    if (DO_PV) { VWAIT(); o[0] = MPV(pa0, VFR(0), o[0]); if (!(ABL & 640)) sa_ = (Y0[0] + Y0[1]) + (Y0[2] + Y0[3]); } SBAR(); \
    if (DO_PV) { o[0] = MPV(pa1, VFR(1), o[0]); if (!(ABL & 640)) sa_ += Y0[4]; if (!(ABL & 640)) sa_ += Y0[5]; if (!(ABL & 640)) sa_ += Y0[6]; if (!(ABL & 640)) sa_ += Y0[7]; } LOADS; SBAR(); \
    if (DO_PV) { o[0] = MPV(pa2, VFR(2), o[0]); if (!(ABL & 640)) sa_ += Y0[8]; if (!(ABL & 640)) sa_ += Y0[9]; if (!(ABL & 640)) sa_ += Y0[10]; if (!(ABL & 640)) sa_ += Y0[11]; } SBAR(); \
    if (DO_PV) { o[0] = MPV(pa3, VFR(3), o[0]); if (!(ABL & 640)) sa_ += Y0[12]; if (!(ABL & 640)) sa_ += Y0[13]; if (!(ABL & 640)) sa_ += Y0[14]; if (!(ABL & 640)) sa_ += Y0[15]; } SBAR(); \
    if (DO_PV) { VRD8(1); if (!(ABL & 640)) sa_ += Y1[0]; if (!(ABL & 640)) sa_ += Y1[1]; if (!(ABL & 640)) sa_ += Y1[2]; if (!(ABL & 640)) sa_ += Y1[3]; if (!(ABL & 640)) sa_ += Y1[4]; if (!(ABL & 640)) sa_ += Y1[5]; if (!(ABL & 640)) sa_ += Y1[6]; if (!(ABL & 640)) sa_ += Y1[7]; } \
    if (DO_MAX) { ma_ = MX3(X0[0], X0[1], X1[0]); mb_ = MX3(X0[2], X0[3], X1[1]); ma_ = MX3(ma_, X1[2], X1[3]); ma_ = MX3(ma_, X0[4], X0[5]); mb_ = MX3(mb_, X0[6], X0[7]); ma_ = MX3(ma_, X1[4], X1[5]); mb_ = MX3(mb_, X1[6], X1[7]); } SBAR(); \
    if (DO_PV) { VWAIT(); o[1] = MPV(pa0, VFR(0), o[1]); if (!(ABL & 640)) sa_ += Y1[8]; if (!(ABL & 640)) sa_ += Y1[9]; if (!(ABL & 640)) sa_ += Y1[10]; if (!(ABL & 640)) sa_ += Y1[11]; } if (DO_MAX) { ma_ = MX3(ma_, X0[8], X0[9]); mb_ = MX3(mb_, X0[10], X0[11]); } SBAR(); \
    if (DO_PV) { o[1] = MPV(pa1, VFR(1), o[1]); if (!(ABL & 640)) sa_ += Y1[12]; if (!(ABL & 640)) sa_ += Y1[13]; if (!(ABL & 640)) sa_ += Y1[14]; if (!(ABL & 640)) sa_ += Y1[15]; } if (DO_MAX) { ma_ = MX3(ma_, X1[8], X1[9]); mb_ = MX3(mb_, X1[10], X1[11]); } SBAR(); \
    if (DO_PV) { o[1] = MPV(pa2, VFR(2), o[1]); l_reg += sa_; if (ABL & 512) { o[0] = MPV(pa0, qr[0], o[0]); o[0] = MPV(pa1, qr[0], o[0]); } } if (DO_MAX) { ma_ = MX3(ma_, X0[12], X0[13]); mb_ = MX3(mb_, X0[14], X0[15]); ma_ = MX3(ma_, X1[12], X1[13]); mb_ = MX3(mb_, X1[14], X1[15]); } SBAR(); \
    if (DO_PV) { o[1] = MPV(pa3, VFR(3), o[1]); if (ABL & 512) { o[0] = MPV(pa2, qr[0], o[0]); o[0] = MPV(pa3, qr[0], o[0]); } } if (DO_MAX) { float m_ = __builtin_fmaxf(ma_, mb_); auto rr_ = __builtin_amdgcn_permlane32_swap(__float_as_uint(m_), __float_as_uint(m_), false, false); pmax = __builtin_fmaxf(__uint_as_float(rr_[0]), __uint_as_float(rr_[1])); } SBAR(); \
  } while (0)
#define DECIDE(FIRST, X0, X1) do { alpha = 1.f; \
    if ((FIRST) || !__builtin_expect(__all(pmax <= THRL), 1)) { const float d_ = (FIRST) ? pmax : __builtin_fmaxf(pmax, 0.f); m_reg += d_; if (!(FIRST)) alpha = EX2(-d_); \
      _Pragma("unroll") for (int r = 0; r < 16; ++r) { X0[r] -= d_; X1[r] -= d_; } \
      _Pragma("unroll") for (int r = 0; r < 16; ++r) negm[r] = -m_reg; l_reg *= alpha; } \
    RESC(alpha); } while (0)
  DMA(0, 0); DMA(1, 1);
  TBAR(3);
  R1(true, false, pA0, pA1, pB0, pB1, 0);
  R2(false, true, pA0, pA1, pB0, pB1, 0, DMA(2, 2));
  DECIDE(true, pA0, pA1);
  TBAR(3);
  for (int j = 1; j + 1 < NTL; j += 2) {
    R1(true, true, pB0, pB1, pA0, pA1, j & 3);
    R2(true, true, pB0, pB1, pA0, pA1, (j - 1) & 3, DMA(j + 2, (j + 2) & 3));
    DECIDE(false, pB0, pB1);
    TBAR(3);
    R1(true, true, pA0, pA1, pB0, pB1, (j + 1) & 3);
    R2(true, true, pA0, pA1, pB0, pB1, j & 3, if (j + 3 < NTL) DMA(j + 3, (j + 3) & 3));
    DECIDE(false, pA0, pA1);
    if (j + 3 < NTL) TBAR(3); else TBAR(0);
  }
  R1(true, true, pB0, pB1, pA0, pA1, (NTL - 1) & 3);
  R2(true, true, pB0, pB1, pA0, pA1, (NTL - 2) & 3, (void)0);
  DECIDE(false, pB0, pB1);
  R1(false, true, pA0, pA1, pB0, pB1, 0);
  R2(true, false, pA0, pA1, pB0, pB1, (NTL - 1) & 3, (void)0);
#undef DECIDE
#undef R2
#undef R1
#undef PKA
#undef PKB
#undef VFR
#undef VWAIT
#undef VRD8
#undef KFR
  { auto rr = __builtin_amdgcn_permlane32_swap(__float_as_uint(l_reg), __float_as_uint(l_reg), false, false); l_reg = __uint_as_float(rr[0]) + __uint_as_float(rr[1]); }
  if (hi == 0) li_l[r32] = l_reg; asm volatile("s_waitcnt lgkmcnt(0)" ::: "memory");
  const float g0 = gain[r32], g1 = gain[32 + r32]; const int ln_ = hw_lane();
  GAS bf16* Ow = Mo + (long)(wid * QBLK) * D;
#pragma unroll
  for (int r = 0; r < 16; ++r) { const int orow = crow(r, hi); const float rl = __builtin_amdgcn_rcpf(li_l[orow]);
    const float y0 = o[0][r] * rl, y1 = o[1][r] * rl; float s = y0 * y0 + y1 * y1;
    s += shx(s, ln_, 1); s += shx(s, ln_, 2); s += shx(s, ln_, 4); s += shx(s, ln_, 8); s += shx(s, ln_, 16);
    const float rs = 1.0f / sqrtf(s * (1.0f / 64.0f) + EPS);
    Ow[(long)orow * D + r32] = f2bf(y0 * rs * g0); Ow[(long)orow * D + 32 + r32] = f2bf(y1 * rs * g1); }
  __syncthreads();
#undef DMA
#undef TBAR
#undef RESC
}
#undef EX2
#undef MX3
#undef KSWZ
#undef SBAR
}
#define XB_TMO      128
#define XB_XCNT(j)  (256  + 64 * (j))
#define XB_XSUB(j)  (1280 + 64 * (j))
#define XB_XGEN(j)  (2304 + 64 * (j))
#define XB_TOP      3328
#define XB_TOPGEN   3392
#define XCD_BAR_WORDS 3456
#define XB_SPIN_CAP (1u << 18)

__device__ __forceinline__ unsigned xb_ld(unsigned* p)              { return __hip_atomic_load(p, __ATOMIC_RELAXED, __HIP_MEMORY_SCOPE_AGENT); }
__device__ __forceinline__ unsigned xb_add(unsigned* p, unsigned v) { return __hip_atomic_fetch_add(p, v, __ATOMIC_RELAXED, __HIP_MEMORY_SCOPE_AGENT); }
__device__ __forceinline__ unsigned xb_xcc_id() { return (unsigned)__builtin_amdgcn_s_getreg((3 << 11) | 20) & 0xFu; }
#define XB_SPIN(cond, bar) do { unsigned _sp = 0; while (cond) { __builtin_amdgcn_s_sleep(1); \
    if ((++_sp & 255u) == 0u) { if (xb_ld(&(bar)[XB_TMO])) break; if (_sp > XB_SPIN_CAP) { atomicAdd(&(bar)[XB_TMO], 1u); break; } } } } while (0)

struct XcdBarrier {
    unsigned* bar; unsigned x;
    volatile LAS unsigned* st;
};

__device__ __forceinline__ XcdBarrier xcd_barrier_post(unsigned* bar, volatile LAS unsigned* st, const bool t0) {
    XcdBarrier b; b.bar = bar; b.x = xb_xcc_id(); b.st = st;
    if (t0) (void)xb_add(&bar[XB_XCNT(b.x)], 1u);
    return b;
}
__device__ __forceinline__ void xcd_barrier_complete(unsigned* bar, unsigned x, unsigned& nloc, unsigned& nx) {
    const unsigned G = gridDim.x * gridDim.y * gridDim.z;
    unsigned sum, cnt, mine, sp = 0u;
    for (;;) {
        sum = 0u; cnt = 0u; mine = 0u;
#pragma unroll
        for (unsigned j = 0; j < 16; ++j) { const unsigned c = xb_ld(&bar[XB_XCNT(j)]); sum += c; cnt += (c > 0u) ? 1u : 0u; mine = (j == x) ? c : mine; }
        if (sum == G) break;
        __builtin_amdgcn_s_sleep(1);
        if ((++sp & 255u) == 0u) { if (xb_ld(&bar[XB_TMO])) break; if (sp > XB_SPIN_CAP) { atomicAdd(&bar[XB_TMO], 1u); break; } }
    }
    nloc = mine > 0u ? mine : 1u; nx = cnt > 0u ? cnt : 1u;
}

__device__ __forceinline__ void xcd_barrier(const XcdBarrier& b, const bool t0) {
    asm volatile("s_waitcnt vmcnt(0)" ::: "memory");
    __syncthreads();
    if (t0) {
        unsigned* bar = b.bar;
        __builtin_amdgcn_s_waitcnt(0);
        unsigned nloc = b.st[0], nx = b.st[1];
        if (nloc == 0u) { xcd_barrier_complete(bar, b.x, nloc, nx); b.st[0] = nloc; b.st[1] = nx; }
        const unsigned old = xb_add(&bar[XB_XSUB(b.x)], 1u);
        const unsigned gen = old / nloc;
        if (old + 1u == (gen + 1u) * nloc) {
            __builtin_amdgcn_fence(__ATOMIC_RELEASE, "agent");
            asm volatile("s_waitcnt vmcnt(0)" ::: "memory");
            const unsigned og = xb_add(&bar[XB_TOP], 1u);
            const unsigned tg = og / nx;
            if (og + 1u == (tg + 1u) * nx) xb_add(&bar[XB_TOPGEN], 1u);
            else XB_SPIN(xb_ld(&bar[XB_TOPGEN]) == tg, bar);
            __builtin_amdgcn_fence(__ATOMIC_ACQUIRE, "agent");
            xb_add(&bar[XB_XGEN(b.x)], 1u);
            asm volatile("s_waitcnt vmcnt(0)" ::: "memory");
        } else {
            XB_SPIN(xb_ld(&bar[XB_XGEN(b.x)]) == gen, bar);
            __builtin_amdgcn_fence(__ATOMIC_ACQUIRE, "agent");
            asm volatile("s_waitcnt vmcnt(0)" ::: "memory");
        }
    }
    __syncthreads();
}

__device__ __forceinline__ void xcd_barrier_fast(const XcdBarrier& b, const bool t0) {
    asm volatile("s_waitcnt vmcnt(0)" ::: "memory");
    __syncthreads();
    if (t0) {
        unsigned* bar = b.bar; asm volatile("" : "+s"(bar));
        __builtin_amdgcn_s_waitcnt(0);
        unsigned nloc = b.st[0], nx = b.st[1];
        unsigned bx_ = b.x; asm volatile("" : "+s"(bx_));
        const unsigned old = xb_add(&bar[XB_XSUB(bx_)], 1u);
        const unsigned gen = old / nloc;
        if (old + 1u == (gen + 1u) * nloc) {
            __builtin_amdgcn_fence(__ATOMIC_RELEASE, "agent");
            asm volatile("s_waitcnt vmcnt(0)" ::: "memory");
            const unsigned og = xb_add(&bar[XB_TOP], 1u);
            const unsigned tg = og / nx;
            if (og + 1u == (tg + 1u) * nx) xb_add(&bar[XB_TOPGEN], 1u);
            else XB_SPIN(xb_ld(&bar[XB_TOPGEN]) == tg, bar);
            __builtin_amdgcn_fence(__ATOMIC_ACQUIRE, "agent");
            xb_add(&bar[XB_XGEN(bx_)], 1u);
            asm volatile("s_waitcnt vmcnt(0)" ::: "memory");
        } else {
            XB_SPIN(xb_ld(&bar[XB_XGEN(bx_)]) == gen, bar);
            __builtin_amdgcn_fence(__ATOMIC_ACQUIRE, "agent");
            asm volatile("s_waitcnt vmcnt(0)" ::: "memory");
        }
    }
    __syncthreads();
}

constexpr int CW_BAR = 4096;
struct Args { const float* in[26]; float* out; unsigned char* ws; };
#ifndef REP_ATT
#define REP_ATT 1
#endif
#ifndef REP_GEMM
#define REP_GEMM 1
#endif
#ifndef REP_HY
#define REP_HY 1
#endif
#ifndef REP_FILT
#define REP_FILT 1
#endif
#ifndef REP_PREP
#define REP_PREP 1
#endif
#ifndef REP_HYOUT
#define REP_HYOUT 1
#endif
#ifndef REP_MISC
#define REP_MISC 1
#endif
#ifndef PROBE_MASK
#define PROBE_MASK 0
#endif
#define TIC() do { if (PROBE_MASK) pr_t0 = __builtin_amdgcn_s_memrealtime(); } while (0)
#define TOC(ph) do { if (PROBE_MASK & (1u << (ph))) pr_acc += __builtin_amdgcn_s_memrealtime() - pr_t0; } while (0)
#define REPEAT(n) _Pragma("unroll 1") for (int rep_ = 0; rep_ < (n); ++rep_)
#define REFRESH() do { const int t_ = tid_from_wave(F.wave0); F.tid = t_; F.lane = t_ & 63; F.wave = __builtin_amdgcn_readfirstlane(t_ >> 6); int v_ = F.vcu; asm volatile("" : "+s"(v_)); F.vcu = v_; } while (0)
#define BXQ() ({ int b_ = (int)blockIdx.x; asm volatile("" : "+s"(b_)); b_; })
#define GEMM_PHASE(EPI, g, S, E) REPEAT(REP_GEMM) pg8::gemm_phase<EPI, pg8::StaticOrder, true, true>(F.lds + RING_OFF, g, S, E, F.wave0)

__global__ void __launch_bounds__(NTHR, 2) hyena_mla_fwd(Args args) {
    extern __shared__ __attribute__((aligned(16))) unsigned char lds[];
    Frame F;
    F.lds = (LAS unsigned char*)lds;
    F.MISC = (volatile LAS unsigned*)(F.lds + MISC_OFF);
    F.tid = threadIdx.x; F.lane = F.tid & 63; F.wave = __builtin_amdgcn_readfirstlane(F.tid >> 6); F.wave0 = F.wave;
    F.G = gridDim.x; { const int bx = blockIdx.x; F.vcu = (F.G % 8 == 0) ? (bx % 8) * (F.G / 8) + bx / 8 : bx; }
    F.ws = args.ws; F.out = args.out; F.ctl = (gu32*)(args.ws + WS_CTL);
    if (F.tid == 0) {
#pragma unroll
        for (int i = 0; i < 26; ++i) *(LAS unsigned long long*)(F.lds + PTRTAB_OFF + 8 * i) = (unsigned long long)args.in[i];
    }
    for (int u = F.tid; u < 512 / 4; u += NTHR) ((LAS unsigned*)(F.lds + LDSCTL_OFF))[u] = 0u;
    __syncthreads();
    XcdBarrier bar = xcd_barrier_post((unsigned*)(F.ctl + CW_BAR), F.MISC + 8, F.tid == 0);
    xcd_barrier(bar, F.tid == 0);
    unsigned long long pr_t0 = 0, pr_acc = 0; (void)pr_t0;
#pragma unroll 1
    for (int l = 0; l < DEPTH; ++l) {
        TIC();
        REPEAT(REP_MISC) { REFRESH(); phase_weights(F, l); }
        __syncthreads();
        REFRESH(); phase_filter_mlp(F, l);
        if (l == 0) { REFRESH(); phase_rope_tab(F); REFRESH(); phase_norm_first(F, 0, inp(F, I_NMIXPRE)); }
        { REFRESH(); xcd_barrier_fast(bar, F.tid == 0); } TOC(0); TIC();
        { unsigned char* w = (unsigned char*)wsq(F); pg8::Gemm g{(bf16*)(w + WS_W3T), (bf16*)(w + WS_H2), 2048, L, 128}; pg8::StaticOrder S; S.init(2048, L, F.G, BXQ());
          pg8::EpiTaps E{(float*)(w + WS_KT), (const float*)inp(F, I_DECAY) + (size_t)l * 2048}; GEMM_PHASE(pg8::EpiTaps, g, S, E); }
        { REFRESH(); xcd_barrier_fast(bar, F.tid == 0); } TOC(1); TIC();
        REPEAT(REP_FILT) { REFRESH(); phase_filter_fft(F, l); }
        { REFRESH(); xcd_barrier_fast(bar, F.tid == 0); } TOC(2); TIC();
        { unsigned char* w = (unsigned char*)wsq(F); bf16* WinT = (bf16*)(w + WS_WIN); bf16* XN = (bf16*)(w + WS_XN); bf16* UT = (bf16*)(w + WS_UT); bf16* CQKV = (bf16*)(w + WS_CQKV);
          { pg8::Gemm g{WinT, XN, HYP, M, D}; pg8::StaticOrder S; S.init(HYP, M, F.G, BXQ());
          pg8::EpiBf16<0> E{UT, M, nullptr, 0, 0, 1.f}; GEMM_PHASE(pg8::EpiBf16<0>, g, S, E); }
        { pg8::Gemm g{XN, WinT + (size_t)HYP * D, M, 512, D}; pg8::StaticOrder S; S.init(M, 512, F.G, (BXQ() + 128) % F.G);
          pg8::EpiBf16<0> E{CQKV, 512, nullptr, 0, 0, 1.f}; GEMM_PHASE(pg8::EpiBf16<0>, g, S, E); } }
        { REFRESH(); xcd_barrier_fast(bar, F.tid == 0); } TOC(3); TIC();
        REPEAT(REP_PREP) { REFRESH(); phase_mla_prep(F, l); }
        REPEAT(REP_HY) { REFRESH(); phase_hyena(F, l); }
        { REFRESH(); xcd_barrier_fast(bar, F.tid == 0); } TOC(4); TIC();
        { unsigned char* w = (unsigned char*)wsq(F); bf16* CQN = (bf16*)(w + WS_CQN); bf16* CKVN = (bf16*)(w + WS_CKVN); bf16* WuqT = (bf16*)(w + WS_WUQ); bf16* WukvT = (bf16*)(w + WS_WUKV);
          bf16* Qb = (bf16*)(w + WS_Q); bf16* KV = (bf16*)(w + WS_KN);
          { pg8::Gemm g{CQN, WuqT, M, NQ, QR}; pg8::StaticOrder S; S.init(M, NQ, F.G, BXQ());
          pg8::EpiBf16<0> E{Qb, NQ, nullptr, 0, 0, 1.f}; GEMM_PHASE(pg8::EpiBf16<0>, g, S, E); }
        { pg8::Gemm g{CKVN, WukvT, M, NKV, KVR}; pg8::StaticOrder S; S.init(M, NKV, F.G, BXQ());
          pg8::EpiBf16<0> E{KV, NKV, nullptr, 0, 0, 1.f}; GEMM_PHASE(pg8::EpiBf16<0>, g, S, E); } }
        { REFRESH(); xcd_barrier_fast(bar, F.tid == 0); } TOC(5); TIC();
        REFRESH();
        { unsigned char* w = (unsigned char*)wsq(F); bf16* Qb = (bf16*)(w + WS_Q); bf16* KV = (bf16*)(w + WS_KN); bf16* KPE = (bf16*)(w + WS_KPE); bf16* MIX = (bf16*)(w + WS_MIX);
          const float* ct = (const float*)(w + WS_COS); const float* st = (const float*)(w + WS_SIN); const float* gat = (const float*)inp(F, I_GNAT) + l * 512;
        REPEAT(REP_ATT) for (int i = 0; i < (F.G == 256 ? 6 : (1536 - F.vcu + F.G - 1) / F.G); ++i) {
            const int u_ = F.vcu + i * F.G; const int bh = F.G == 256 ? 3 * (F.vcu >> 5) + (i >> 1) : u_ >> 6, qb = F.G == 256 ? (i & 1) * 32 + (F.vcu & 31) : u_ & 63; const int b = bh >> 3, h = bh & 7;
            const size_t row0 = (size_t)b * L + (size_t)qb * 256;
            att::attn_unit<0>(Qb + row0 * NQ + h * DQ, KV + (size_t)b * L * NKV + h * 128, KPE + (size_t)b * L * ROPE, KV + (size_t)b * L * NKV + h * 128 + 64,
                           MIX + row0 * D + 512 + h * 64, gat + h * 64, ct, st, qb * 256, (LAS char*)(F.lds + RING_OFF), F.wave0);
        } }
        REPEAT(REP_HYOUT) { REFRESH(); phase_hy_out(F, l); }
        { REFRESH(); xcd_barrier_fast(bar, F.tid == 0); } TOC(6); TIC();
        { unsigned char* w = (unsigned char*)wsq(F); bf16* MIX = (bf16*)(w + WS_MIX); bf16* WoutT = (bf16*)(w + WS_WOUT); bf16* T = (bf16*)(w + WS_T);
          pg8::Gemm g{MIX, WoutT, M, D, D}; pg8::StaticOrder S; S.init(M, D, F.G, BXQ());
          pg8::EpiBf16<0> E{T, D, nullptr, 0, 0, 1.f}; GEMM_PHASE(pg8::EpiBf16<0>, g, S, E); }
        { REFRESH(); xcd_barrier_fast(bar, F.tid == 0); } TOC(7); TIC();
        REFRESH(); if (l == 0) phase_norm_res<true, false>(F, (const GAS bf16*)(wsq(F) + WS_T), inp(F, I_NMIXPOST) + l * D, inp(F, I_NMLPPRE) + l * D);
        else phase_norm_res<false, false>(F, (const GAS bf16*)(wsq(F) + WS_T), inp(F, I_NMIXPOST) + l * D, inp(F, I_NMLPPRE) + l * D);
        { REFRESH(); xcd_barrier_fast(bar, F.tid == 0); } TOC(8); TIC();
#pragma unroll 1
        for (int ch = 0; ch < N_MLP_CHUNKS; ++ch) {
            { unsigned char* w = (unsigned char*)wsq(F); bf16* XN = (bf16*)(w + WS_XN); bf16* WupT = (bf16*)(w + WS_WUP); bf16* Hb = (bf16*)(w + WS_H);
              pg8::Gemm g{XN + (size_t)ch * MLP_CHUNK * D, WupT, MLP_CHUNK, FF, D}; pg8::StaticOrder S; S.init(MLP_CHUNK, FF, F.G, BXQ());
              pg8::EpiRelu2 E{Hb, FF}; GEMM_PHASE(pg8::EpiRelu2, g, S, E); }
            { REFRESH(); xcd_barrier_fast(bar, F.tid == 0); } TOC(9); TIC();
            { unsigned char* w = (unsigned char*)wsq(F); bf16* Hb = (bf16*)(w + WS_H); bf16* WdownT = (bf16*)(w + WS_WDOWN); bf16* T = (bf16*)(w + WS_T);
              pg8::Gemm g{Hb, WdownT, MLP_CHUNK, D, FF}; pg8::StaticOrder S; S.init(MLP_CHUNK, D, F.G, BXQ());
              pg8::EpiBf16<0> E{T + (size_t)ch * MLP_CHUNK * D, D, nullptr, 0, 0, 1.f}; GEMM_PHASE(pg8::EpiBf16<0>, g, S, E); }
            { REFRESH(); xcd_barrier_fast(bar, F.tid == 0); } TOC(10); TIC();
        }
        REFRESH(); if (l + 1 < DEPTH) phase_norm_res<false, false>(F, (const GAS bf16*)(wsq(F) + WS_T), inp(F, I_NMLPPOST) + l * D, inp(F, I_NMIXPRE) + (l + 1) * D);
        else phase_norm_res<false, true>(F, (const GAS bf16*)(wsq(F) + WS_T), inp(F, I_NMLPPOST) + l * D, (const GAS float*)nullptr);
        { REFRESH(); xcd_barrier_fast(bar, F.tid == 0); } TOC(11); TIC();
    }
    if (HYSUB) { __syncthreads(); pr_acc += (unsigned long long)__builtin_amdgcn_readfirstlane((int)F.MISC[21]); }
    if (PROBE_MASK || HYSUB) { const unsigned long long ts = __builtin_amdgcn_s_memrealtime(); while (__builtin_amdgcn_s_memrealtime() - ts < pr_acc) __builtin_amdgcn_s_sleep(8); }
}


#ifdef ATT_BENCH
__global__ void __launch_bounds__(NTHR, 2) attn_bench(Args args) {
    extern __shared__ __attribute__((aligned(16))) unsigned char lds[];
    unsigned char* w = args.ws; const int wave0 = __builtin_amdgcn_readfirstlane(threadIdx.x >> 6);
    const int G = gridDim.x, bxv = (int)blockIdx.x, vcu = (bxv % 8) * (G / 8) + bxv / 8;
    bf16* Qb = (bf16*)(w + WS_Q); bf16* KV = (bf16*)(w + WS_KN); bf16* KPE = (bf16*)(w + WS_KPE); bf16* OUT = (bf16*)(w + WS_H);
    const float* ct = (const float*)(w + WS_COS); const float* st = (const float*)(w + WS_SIN);
    for (int rep = 0; rep < ATT_BENCH_REPS; ++rep)
    for (int i = 0; i < 6; ++i) {
        const int bh = 3 * (vcu >> 5) + (i >> 1), qb = (i & 1) * 32 + (vcu & 31); const int b = bh >> 3, h = bh & 7;
        const size_t row0 = (size_t)b * L + (size_t)qb * 256;
        att::attn_unit<ATT_BENCH>(Qb + row0 * NQ + h * DQ, KV + (size_t)b * L * NKV + h * 128, KPE + (size_t)b * L * ROPE, KV + (size_t)b * L * NKV + h * 128 + 64,
                       OUT + row0 * D + 512 + h * 64, args.in[I_GNAT] + h * 64, ct, st, qb * 256, (LAS char*)lds, wave0);
    }
}
#endif
extern "C" void kernel_launch(void* const* d_in, const int* in_sizes, int n_in, void* d_out, int out_size, void* d_ws, size_t ws_size, hipStream_t stream) {
    static int grid = 0;
    if (grid == 0) {
        if (n_in != 26 || out_size != M * D || ws_size < WS_END) { fprintf(stderr, "kernel_launch: shape mismatch n_in %d out %d ws %zu (need %zu)\n", n_in, out_size, ws_size, (size_t)WS_END); grid = -1; return; }
        int dev = 0, cus = 0, per_cu = 0;
        if (hipGetDevice(&dev) != hipSuccess || hipDeviceGetAttribute(&cus, hipDeviceAttributeMultiprocessorCount, dev) != hipSuccess) { grid = -1; return; }
        if (hipFuncSetAttribute((const void*)hyena_mla_fwd, hipFuncAttributeMaxDynamicSharedMemorySize, LDS_BYTES) != hipSuccess) { fprintf(stderr, "kernel_launch: hipFuncSetAttribute failed\n"); grid = -1; return; }
        if (hipOccupancyMaxActiveBlocksPerMultiprocessor(&per_cu, (const void*)hyena_mla_fwd, NTHR, LDS_BYTES) != hipSuccess || per_cu < 1) fprintf(stderr, "kernel_launch: occupancy query says %d\n", per_cu);
        (void)hipGetLastError();
        grid = cus;
    }
    if (grid < 0) return;
    if (hipMemsetAsync((char*)d_ws + WS_CTL, 0, CTL_ZERO_BYTES, stream) != hipSuccess) { fprintf(stderr, "kernel_launch: memset failed\n"); return; }
    Args a{};
    for (int i = 0; i < 26; ++i) a.in[i] = (const float*)d_in[i];
    a.out = (float*)d_out; a.ws = (unsigned char*)d_ws;
    hipLaunchKernelGGL(hyena_mla_fwd, dim3(grid), dim3(NTHR), LDS_BYTES, stream, a);
#ifdef ATT_BENCH
    { static int once = 0; if (!once) { (void)hipFuncSetAttribute((const void*)attn_bench, hipFuncAttributeMaxDynamicSharedMemorySize, LDS_BYTES); once = 1; }
      hipLaunchKernelGGL(attn_bench, dim3(grid), dim3(NTHR), LDS_BYTES, stream, a); }
#endif
    const hipError_t le = hipPeekAtLastError();
    if (le != hipSuccess) fprintf(stderr, "kernel_launch: launch failed: %s\n", hipGetErrorName(le));
}
```

```cpp
#include <hip/hip_runtime.h>
#include <cstdio>
#include <cstdint>
__device__ __forceinline__ int hw_lane() { int l; asm volatile("v_mbcnt_lo_u32_b32 %0, -1, 0\n\tv_mbcnt_hi_u32_b32 %0, -1, %0" : "=v"(l)); return l; }
__device__ __forceinline__ int tid_from_wave(int wave0) { int w = wave0; asm volatile("" : "+s"(w)); int t = w * 64 + hw_lane(); asm volatile("" : "+v"(t)); return t; }
namespace pg8 {
#define PG8_LAS __attribute__((address_space(3)))
#define PG8_GAS __attribute__((address_space(1)))
typedef unsigned short bf16_t;
typedef short bf16x8 __attribute__((ext_vector_type(8)));
typedef float f32x4 __attribute__((ext_vector_type(4)));
typedef unsigned u32x4 __attribute__((ext_vector_type(4)));
constexpr int BM = 256, BK = 64, HALF = 128, HTB = HALF * BK * 2  , STAGE_BYTES = 8 * HTB, NXCD = 8, WGM = 8;

__host__ __device__ __forceinline__ int lds_byte(int r, int c) { const int st = (r >> 4) * 2 + (c >> 5), rr = r & 15, cc = c & 31, ob = rr * 64 + cc * 2; return st * 1024 + (ob ^ (((ob >> 9) & 1) << 5)); }
__host__ __device__ __forceinline__ void stage_rc(int b, int& R, int& C) { const int st = b / 1024, sb = b % 1024, swz = sb ^ (((sb >> 9) & 1) << 5); R = (st >> 1) * 16 + swz / 64; C = (st & 1) * 32 + (swz % 64) / 2; }
__host__ __device__ __forceinline__ int perm32(int rho) { const int n = rho >> 4, i = rho & 15; return 8 * (i >> 2) + 4 * n + (i & 3); }

struct Unit { int pm, pn; };
struct Gemm { const bf16_t* A; const bf16_t* Bt; int M, N, K; };

struct StaticOrder {
    int nM, nN, nwg, G, c;
    __host__ __device__ void init(int M, int N, int G_, int c_) { nM = M / BM; nN = N / BM; nwg = nM * nN; G = G_; c = c_; }
    __host__ __device__ bool next(int i, Unit& u) const {
        const long L = (long)i * G + c; if (L >= nwg) return false;
        int wgid = (int)L; { const int q = nwg / NXCD, r = nwg % NXCD, xcd = wgid % NXCD, off = wgid / NXCD; wgid = (xcd < r ? xcd * (q + 1) : r * (q + 1) + (xcd - r) * q) + off; }
        const int nig = WGM * nN, gid = wgid / nig, fm = gid * WGM, gsz = (nM - fm) < WGM ? (nM - fm) : WGM;
        u.pm = fm + ((wgid % nig) % gsz); u.pn = (wgid % nig) / gsz; return true;
    }
    __device__ __forceinline__ void a_ready(const Unit&) const {}
    __device__ __forceinline__ void done(const Unit&) const {}
};

__device__ __forceinline__ unsigned cvt_pk_bf16(float lo, float hi) { unsigned r; asm volatile("v_cvt_pk_bf16_f32 %0, %1, %2" : "=v"(r) : "v"(lo), "v"(hi)); return r; }
typedef float f32x2 __attribute__((ext_vector_type(2)));
__device__ __forceinline__ void relane(int& wr, int& wc, int& fr, int& fq) { int l = hw_lane(); asm volatile("" : "+v"(l)); fr = l & 15; fq = l >> 4; (void)wr; (void)wc; }
__device__ __forceinline__ f32x2 gelu_pk(f32x2 v) {
    const f32x2 av = __builtin_elementwise_abs(v), d = av * 0.2316418882f + 1.0f;
    f32x2 t; t.x = __builtin_amdgcn_rcpf(d.x); t.y = __builtin_amdgcn_rcpf(d.y);
    f32x2 q = t * 0.5307027145f + (-0.7265760135f); q = q * t + 0.7107068705f; q = q * t + (-0.142248368f); q = q * t + 0.127414796f; q = q * t;
    const f32x2 s = (v * v) * (-0.72134752044f);
    f32x2 e; e.x = __builtin_amdgcn_exp2f(s.x); e.y = __builtin_amdgcn_exp2f(s.y);
    const f32x2 m = v * (q * e), r = v - m;
    f32x2 o; o.x = v.x < 0.f ? m.x : r.x; o.y = v.y < 0.f ? m.y : r.y; return o;
}

template <int ACT  > struct EpiBf16 {
    static constexpr bool PERM = true, AFTER_DRAIN = false; static_assert(ACT == 0 || ACT == 1, "EpiBf16: ACT is 0 (none) or 1 (gelu_pk)");
    bf16_t* O; int ldc; const float* bias; int split_cols; size_t split_stride; float scale0;
    __device__ __forceinline__ void operator()(const f32x4 (&acc)[2][2][4][2], const Unit& u, int wr, int wc, int fr, int fq) const {
        relane(wr, wc, fr, fq);
        const int row0 = u.pm * BM + wr * 64 + fr; int colt = u.pn * BM; bf16_t* base = O;
        float sc = 1.f; if (split_cols) { const int t = colt / split_cols; base += (size_t)t * split_stride; colt -= t * split_cols; if (t == 0) sc = scale0; }
        const int col0 = colt + wc * 32 + 8 * fq, bcol0 = u.pn * BM + wc * 32 + 8 * fq;
        f32x4 bv[2][2];
#pragma unroll
        for (int bj = 0; bj < 2; ++bj)
#pragma unroll
            for (int n = 0; n < 2; ++n) bv[bj][n] = bias ? *(const PG8_GAS f32x4*)(bias + bcol0 + bj * HALF + 4 * n) : (f32x4){0.f, 0.f, 0.f, 0.f};
#pragma unroll
        for (int ai = 0; ai < 2; ++ai)
#pragma unroll
            for (int m = 0; m < 4; ++m) { bf16_t* rowp = base + (size_t)(row0 + ai * HALF + m * 16) * ldc + col0;
#pragma unroll
                for (int bj = 0; bj < 2; ++bj) { f32x4 v0 = acc[ai][bj][m][0] + bv[bj][0], v1 = acc[ai][bj][m][1] + bv[bj][1];
                    if (ACT == 1) { f32x2 a = gelu_pk((f32x2){v0[0], v0[1]}), b = gelu_pk((f32x2){v0[2], v0[3]}), c = gelu_pk((f32x2){v1[0], v1[1]}), d = gelu_pk((f32x2){v1[2], v1[3]});
                        v0 = (f32x4){a.x, a.y, b.x, b.y}; v1 = (f32x4){c.x, c.y, d.x, d.y}; }
                    v0 = v0 * sc; v1 = v1 * sc; u32x4 w; w.x = cvt_pk_bf16(v0[0], v0[1]); w.y = cvt_pk_bf16(v0[2], v0[3]); w.z = cvt_pk_bf16(v1[0], v1[1]); w.w = cvt_pk_bf16(v1[2], v1[3]);
                    *(PG8_GAS u32x4*)(rowp + bj * HALF) = w; } }
    }
};

struct PanelStats {
    unsigned* xbuf;
    unsigned* cnt;
    unsigned* tmo;
    int ntn; float eps;
    unsigned code;
    __device__ __forceinline__ bool run(const f32x4 (&v)[2][2][4][2], const Unit& u, int wr, int wc, int fr, int fq, PG8_LAS unsigned char* lds, int wid, int lane) const {
        typedef float f32x2v __attribute__((ext_vector_type(2)));
        PG8_LAS f32x2v* P = (PG8_LAS f32x2v*)lds;
        PG8_LAS f32x2v* S = (PG8_LAS f32x2v*)(lds + 8192);
        PG8_LAS unsigned* flag = (PG8_LAS unsigned*)(lds + 8192 + 2048);
#pragma unroll
        for (int ai = 0; ai < 2; ++ai)
#pragma unroll
            for (int m = 0; m < 4; ++m) {
                float s = 0.f;
#pragma unroll
                for (int bj = 0; bj < 2; ++bj)
#pragma unroll
                    for (int n = 0; n < 2; ++n) { const f32x4 x = v[ai][bj][m][n]; s += (x[0] + x[1]) + (x[2] + x[3]); }
                s += __shfl_xor(s, 16); s += __shfl_xor(s, 32);
                const float mw = s * (1.0f / 64.0f); float q = 0.f;
#pragma unroll
                for (int bj = 0; bj < 2; ++bj)
#pragma unroll
                    for (int n = 0; n < 2; ++n) { const f32x4 d = v[ai][bj][m][n] - mw; q += (d[0] * d[0] + d[1] * d[1]) + (d[2] * d[2] + d[3] * d[3]); }
                q += __shfl_xor(q, 16); q += __shfl_xor(q, 32);
                if (fq == 0) P[(ai * HALF + wr * 64 + m * 16 + fr) * 4 + wc] = (f32x2v){mw, q};
            }
        asm volatile("s_waitcnt lgkmcnt(0)" ::: "memory"); __builtin_amdgcn_s_barrier(); asm volatile("" ::: "memory");
#if defined(BROKEN_EXCHANGE_NO_WAIT)
#warning BROKEN CONTROL BUILD: the row-statistics exchange does not wait; results are wrong by design
        if (blockIdx.x >= 64) { const long long t0_ = clock64(); while (clock64() - t0_ < 60000) __builtin_amdgcn_s_sleep(8); }
#endif
        const int row = wid * 32 + (lane & 31);
        if (lane < 32) {
            const f32x2v a = P[row * 4 + 0], b = P[row * 4 + 1], c = P[row * 4 + 2], d = P[row * 4 + 3];
            const float mt = (a.x + b.x + c.x + d.x) * 0.25f;
            const float da = a.x - mt, db = b.x - mt, dc = c.x - mt, dd = d.x - mt;
            const float m2 = (a.y + b.y) + (c.y + d.y) + 64.0f * ((da * da + db * db) + (dc * dc + dd * dd));
            unsigned long long* slot = (unsigned long long*)xbuf + ((size_t)(u.pm * BM + row) * 4 + u.pn);
            __hip_atomic_store(slot, ((unsigned long long)__float_as_uint(m2) << 32) | __float_as_uint(mt), __ATOMIC_RELAXED, __HIP_MEMORY_SCOPE_AGENT);
        }
        asm volatile("s_waitcnt vmcnt(0)" ::: "memory");
        if (lane == 0) __hip_atomic_fetch_add(cnt + 64 * u.pm, 1u, __ATOMIC_RELAXED, __HIP_MEMORY_SCOPE_AGENT);
        if (wid == 0) {
            bool dead = false; const unsigned long long t0 = __builtin_amdgcn_s_memrealtime(); const unsigned want = 8u * (unsigned)ntn;
            for (;;) {
#if defined(BROKEN_EXCHANGE_NO_WAIT)
                break;
#endif
                if ((unsigned)__builtin_amdgcn_readfirstlane(__hip_atomic_load(cnt + 64 * u.pm, __ATOMIC_RELAXED, __HIP_MEMORY_SCOPE_AGENT)) >= want) break;
                if (__builtin_amdgcn_s_memrealtime() - t0 > 2000000ull) {
                    if (lane == 0) { unsigned expect = 0u; __hip_atomic_compare_exchange_strong(tmo + 1, &expect, code | (unsigned)(u.pm & 0xff), __ATOMIC_RELAXED, __ATOMIC_RELAXED, __HIP_MEMORY_SCOPE_AGENT);
                                     __hip_atomic_store(tmo, 1u, __ATOMIC_RELAXED, __HIP_MEMORY_SCOPE_AGENT); }
                    dead = true; break; }
                __builtin_amdgcn_s_sleep(2);
            }
            __builtin_amdgcn_fence(__ATOMIC_ACQUIRE, "agent");
            if (lane == 0) flag[0] = dead ? 1u : 0u;
        }
        asm volatile("s_waitcnt vmcnt(0) lgkmcnt(0)" ::: "memory"); __builtin_amdgcn_s_barrier(); asm volatile("" ::: "memory");
        const bool bad = flag[0] != 0u;
        if (lane < 32) {
            const unsigned long long* slot = (const unsigned long long*)xbuf + (size_t)(u.pm * BM + row) * 4; float mt[4], m2[4]; float ms = 0.f;
#pragma unroll
            for (int t = 0; t < 4; ++t) { if (t < ntn) { const unsigned long long w = __hip_atomic_load(slot + t, __ATOMIC_RELAXED, __HIP_MEMORY_SCOPE_AGENT); mt[t] = __uint_as_float((unsigned)w); m2[t] = __uint_as_float((unsigned)(w >> 32)); } else { mt[t] = 0.f; m2[t] = 0.f; } ms += mt[t]; }
            const float mean = ms / (float)ntn; float q = 0.f;
#pragma unroll
            for (int t = 0; t < 4; ++t) if (t < ntn) { const float dm = mt[t] - mean; q += m2[t] + 256.0f * dm * dm; }
            S[row] = (f32x2v){mean, 1.0f / sqrtf(q / (256.0f * (float)ntn) + eps)};
        }
        asm volatile("s_waitcnt lgkmcnt(0)" ::: "memory"); __builtin_amdgcn_s_barrier(); asm volatile("" ::: "memory");
        return bad;
    }
};
struct EpiLnRes {
    static constexpr bool PERM = false, AFTER_DRAIN = true;
    const float* base; float* out; int ldc; const float* bias; PanelStats st; unsigned poison;
    __device__ __forceinline__ void fused(f32x4 (&acc)[2][2][4][2], const Unit& u, int wr, int wc, int fr, int fq, PG8_LAS unsigned char* lds, int wid, int lane) const {
        typedef float f32x2v __attribute__((ext_vector_type(2)));
        const PG8_LAS f32x2v* S = (const PG8_LAS f32x2v*)(lds + 8192);
        const int col0 = u.pn * BM + wc * 32 + 4 * fq;
#pragma unroll
        for (int bj = 0; bj < 2; ++bj)
#pragma unroll
            for (int n = 0; n < 2; ++n) { const f32x4 bv = bias ? *(const f32x4*)(bias + col0 + bj * HALF + n * 16) : (f32x4){0.f, 0.f, 0.f, 0.f};
#pragma unroll
                for (int ai = 0; ai < 2; ++ai)
#pragma unroll
                    for (int m = 0; m < 4; ++m) acc[ai][bj][m][n] += bv; }
        f32x4 pre[4][2][2];
#pragma unroll
        for (int m = 0; m < 4; ++m) { const size_t off = (size_t)(u.pm * BM + wr * 64 + m * 16 + fr) * ldc + col0;
#pragma unroll
            for (int bj = 0; bj < 2; ++bj)
#pragma unroll
                for (int n = 0; n < 2; ++n) pre[m][bj][n] = *(const f32x4*)(base + off + bj * HALF + n * 16); }
        const bool bad = st.run(acc, u, wr, wc, fr, fq, lds, wid, lane) || poison != 0u;
        const float qnan = __builtin_nanf("");
#pragma unroll
        for (int ai = 0; ai < 2; ++ai)
#pragma unroll
            for (int m = 0; m < 4; ++m) { const int r = ai * HALF + wr * 64 + m * 16 + fr; const f32x2v sr = S[r]; const size_t off = (size_t)(u.pm * BM + r) * ldc + col0;
#pragma unroll
                for (int bj = 0; bj < 2; ++bj)
#pragma unroll
                    for (int n = 0; n < 2; ++n) { const f32x4 bs = ai == 0 ? pre[m][bj][n] : *(const f32x4*)(base + off + bj * HALF + n * 16); f32x4 o = bs + (acc[ai][bj][m][n] - sr.x) * sr.y;
                        if (bad) o = (f32x4){qnan, qnan, qnan, qnan}; *(f32x4*)(out + off + bj * HALF + n * 16) = o; }
                if (m & 1) asm volatile("" ::: "memory"); }
    }
};
struct EpiLnResLn {
    static constexpr bool PERM = false, AFTER_DRAIN = true;
    const float* base; float* out; bf16_t* xn; int ldc; const float* bias; PanelStats st1, st2; unsigned poison;
    __device__ __forceinline__ void fused(f32x4 (&acc)[2][2][4][2], const Unit& u, int wr, int wc, int fr, int fq, PG8_LAS unsigned char* lds, int wid, int lane) const {
        typedef float f32x2v __attribute__((ext_vector_type(2))); typedef unsigned u32x2v __attribute__((ext_vector_type(2)));
        const PG8_LAS f32x2v* S = (const PG8_LAS f32x2v*)(lds + 8192);
        const int col0 = u.pn * BM + wc * 32 + 4 * fq;
#pragma unroll
        for (int bj = 0; bj < 2; ++bj)
#pragma unroll
            for (int n = 0; n < 2; ++n) { const f32x4 bv = bias ? *(const f32x4*)(bias + col0 + bj * HALF + n * 16) : (f32x4){0.f, 0.f, 0.f, 0.f};
#pragma unroll
                for (int ai = 0; ai < 2; ++ai)
#pragma unroll
                    for (int m = 0; m < 4; ++m) acc[ai][bj][m][n] += bv; }
        bool bad = st1.run(acc, u, wr, wc, fr, fq, lds, wid, lane) || poison != 0u;
        const float qnan = __builtin_nanf("");
#pragma unroll
        for (int ai = 0; ai < 2; ++ai)
#pragma unroll
            for (int m = 0; m < 4; ++m) { const int r = ai * HALF + wr * 64 + m * 16 + fr; const f32x2v sr = S[r]; const size_t off = (size_t)(u.pm * BM + r) * ldc + col0;
#pragma unroll
                for (int bj = 0; bj < 2; ++bj)
#pragma unroll
                    for (int n = 0; n < 2; ++n) { const f32x4 bs = *(const f32x4*)(base + off + bj * HALF + n * 16); acc[ai][bj][m][n] = bs + (acc[ai][bj][m][n] - sr.x) * sr.y; }
                asm volatile("" : "+v"(acc[ai][0][m][0]), "+v"(acc[ai][0][m][1]), "+v"(acc[ai][1][m][0]), "+v"(acc[ai][1][m][1]));
                if (m & 1) asm volatile("" ::: "memory"); }
        const bool bad1 = bad;
        bad = st2.run(acc, u, wr, wc, fr, fq, lds, wid, lane) || bad;
#pragma unroll
        for (int ai = 0; ai < 2; ++ai)
#pragma unroll
            for (int m = 0; m < 4; ++m) { const int r = ai * HALF + wr * 64 + m * 16 + fr; const f32x2v sr = S[r]; const size_t off = (size_t)(u.pm * BM + r) * ldc + col0;
#pragma unroll
                for (int bj = 0; bj < 2; ++bj)
#pragma unroll
                    for (int n = 0; n < 2; ++n) { const f32x4 x1 = acc[ai][bj][m][n]; *(f32x4*)(out + off + bj * HALF + n * 16) = bad1 ? (f32x4){qnan, qnan, qnan, qnan} : x1;
                        const f32x4 o = (x1 - sr.x) * sr.y; u32x2v w; w.x = cvt_pk_bf16(o[0], o[1]); w.y = cvt_pk_bf16(o[2], o[3]);
                        if (bad) { w.x = 0x7fc07fc0u; w.y = 0x7fc07fc0u; } *(u32x2v*)(xn + off + bj * HALF + n * 16) = w; }
                asm volatile("" ::: "memory"); }
    }
};

template <class Epi, class Sched, bool ALIGN_EPI = false, bool SP2 = false>
__device__ __forceinline__ void gemm_phase(PG8_LAS unsigned char* lds, const Gemm g, const Sched& S, const Epi& E, const int wave0) {
    int tid_ = tid_from_wave(wave0);
    const int tid = tid_, wid = __builtin_amdgcn_readfirstlane(tid >> 6), lane = tid & 63, wr = wid >> 2, wc = wid & 3, fr = lane & 15, fq = lane >> 4;
    const int K = g.K, nt = K / BK;
    unsigned voffA[2], voffB[2];
#pragma unroll
    for (int i = 0; i < 2; ++i) { int R, C; stage_rc(tid * 16 + i * 8192, R, C); const int Rb = Epi::PERM ? ((R & ~31) + perm32(R & 31)) : R;
        voffA[i] = (unsigned)(R * K + C) * 2u; voffB[i] = (unsigned)(Rb * K + C) * 2u; }
    const size_t kstep = (size_t)(BK * 2);
    const size_t hstep = (size_t)HALF * K * 2;
    const size_t tstep = 2 * hstep;
    const unsigned ldsw = (unsigned)wid * 1024u;
    const int aoff = lds_byte(wr * 64 + fr, fq * 8), boff = lds_byte(wc * 32 + fr, fq * 8);
#define PG8_SA(b, h) (((b) * 2 + (h)) * HTB)
#define PG8_SB(b, h) ((4 + (b) * 2 + (h)) * HTB)
#define PG8_STAGE(bufoff, gbase, voff) do { _Pragma("unroll") for (int _i = 0; _i < 2; ++_i) \
        __builtin_amdgcn_global_load_lds((const unsigned*)((const char*)(gbase) + (voff)[_i]), (PG8_LAS unsigned*)(lds + (bufoff) + ldsw + _i * 8192), 16, 0, 0); } while (0)
#define PG8_LDA(dst, b, h) do { _Pragma("unroll") for (int m = 0; m < 4; ++m) _Pragma("unroll") for (int k = 0; k < 2; ++k) dst[m][k] = *(const PG8_LAS bf16x8*)(lds + PG8_SA(b, h) + aoff + m * 2048 + k * 1024); } while (0)
#define PG8_LDB(dst, b, h) do { _Pragma("unroll") for (int n = 0; n < 2; ++n) _Pragma("unroll") for (int k = 0; k < 2; ++k) dst[n][k] = *(const PG8_LAS bf16x8*)(lds + PG8_SB(b, h) + boff + n * 2048 + k * 1024); } while (0)
#define PG8_MMA(ai, bj, At, Bt) do { __builtin_amdgcn_s_setprio(1); _Pragma("unroll") for (int m = 0; m < 4; ++m) _Pragma("unroll") for (int n = 0; n < 2; ++n) _Pragma("unroll") for (int k = 0; k < 2; ++k) \
        acc[ai][bj][m][n] = __builtin_amdgcn_mfma_f32_16x16x32_bf16(Bt[n][k], At[m][k], acc[ai][bj][m][n], 0, 0, 0); __builtin_amdgcn_s_setprio(0); } while (0)
#define PG8_WAIT_V(n) asm volatile("s_waitcnt vmcnt(" #n ")" ::: "memory")
#define PG8_WAIT_L(n) asm volatile("s_waitcnt lgkmcnt(" #n ")" ::: "memory")
#define PG8_BAR __builtin_amdgcn_s_barrier()
#define PG8_SCHED __builtin_amdgcn_sched_barrier(0)
    Unit cur, nxt; int ui = 0;
    if (!S.next(0, cur)) return;
    f32x4 acc[2][2][4][2];
#pragma unroll
    for (int a = 0; a < 2; ++a)
#pragma unroll
        for (int b = 0; b < 2; ++b)
#pragma unroll
            for (int m = 0; m < 4; ++m)
#pragma unroll
                for (int n = 0; n < 2; ++n) acc[a][b][m][n] = (f32x4){0.f, 0.f, 0.f, 0.f};
    bf16x8 At[4][2], B0[2][2], B1[2][2];
    const char* cA = (const char*)g.A + (size_t)cur.pm * tstep; const char* cB = (const char*)g.Bt + (size_t)cur.pn * tstep;
    S.a_ready(cur);
    if constexpr (SP2) {
        PG8_STAGE(PG8_SB(0, 0), cB, voffB); PG8_STAGE(PG8_SB(0, 1), cB + hstep, voffB); PG8_STAGE(PG8_SA(0, 0), cA, voffA); PG8_STAGE(PG8_SA(0, 1), cA + hstep, voffA);
        if (wr == 1) PG8_BAR;
        PG8_WAIT_V(2); PG8_BAR;
        PG8_STAGE(PG8_SB(1, 0), cB + kstep, voffB); PG8_STAGE(PG8_SA(1, 0), cA + kstep, voffA); PG8_STAGE(PG8_SB(1, 1), cB + hstep + kstep, voffB);
        PG8_WAIT_V(6); PG8_BAR;
    } else {
        PG8_STAGE(PG8_SB(0, 0), cB, voffB); PG8_STAGE(PG8_SA(0, 0), cA, voffA); PG8_STAGE(PG8_SB(0, 1), cB + hstep, voffB); PG8_STAGE(PG8_SA(0, 1), cA + hstep, voffA);
        if (wr == 1) PG8_BAR;
        PG8_WAIT_V(4); PG8_BAR;
        PG8_STAGE(PG8_SB(1, 0), cB + kstep, voffB); PG8_STAGE(PG8_SA(1, 0), cA + kstep, voffA); PG8_STAGE(PG8_SB(1, 1), cB + hstep + kstep, voffB);
        PG8_WAIT_V(6); PG8_BAR;
    }
    for (;;) {
        const bool has_next = S.next(ui + 1, nxt);
        const char* nA = has_next ? (const char*)g.A + (size_t)nxt.pm * tstep : cA; const char* nB = has_next ? (const char*)g.Bt + (size_t)nxt.pn * tstep : cB;
        for (int t = 0; t < nt; t += 2) {
            const bool last = (t == nt - 2);
            const char* a1 = cA + (size_t)(t + 1) * kstep;
            const char* a2 = last ? nA : cA + (size_t)(t + 2) * kstep; const char* b2 = last ? nB : cB + (size_t)(t + 2) * kstep;
            const char* a3 = a2 + kstep; const char* b3 = b2 + kstep;
            if (last && has_next) S.a_ready(nxt);
            if constexpr (SP2) {
            PG8_LDB(B0, 0, 0); PG8_LDB(B1, 0, 1); PG8_SCHED; PG8_LDA(At, 0, 0); PG8_STAGE(PG8_SA(1, 1), a1 + hstep, voffA);
            PG8_WAIT_V(8); PG8_WAIT_L(0); PG8_BAR; PG8_MMA(0, 0, At, B0); PG8_MMA(0, 1, At, B1); PG8_BAR; PG8_SCHED;
            PG8_LDA(At, 0, 1); PG8_STAGE(PG8_SB(0, 0), b2, voffB); PG8_STAGE(PG8_SB(0, 1), b2 + hstep, voffB); PG8_STAGE(PG8_SA(0, 0), a2, voffA);
            PG8_WAIT_V(8); PG8_WAIT_L(0); PG8_BAR; PG8_MMA(1, 0, At, B0); PG8_MMA(1, 1, At, B1); PG8_BAR; PG8_SCHED;
            PG8_LDB(B0, 1, 0); PG8_LDB(B1, 1, 1); PG8_SCHED; PG8_LDA(At, 1, 0); PG8_STAGE(PG8_SA(0, 1), a2 + hstep, voffA);
            PG8_WAIT_V(8); PG8_WAIT_L(0); PG8_BAR; PG8_MMA(0, 0, At, B0); PG8_MMA(0, 1, At, B1); PG8_BAR; PG8_SCHED;
            PG8_LDA(At, 1, 1); PG8_STAGE(PG8_SB(1, 0), b3, voffB); PG8_STAGE(PG8_SB(1, 1), b3 + hstep, voffB); PG8_STAGE(PG8_SA(1, 0), a3, voffA);
            PG8_WAIT_V(8); PG8_WAIT_L(0); PG8_BAR; PG8_MMA(1, 0, At, B0); PG8_MMA(1, 1, At, B1); PG8_BAR; PG8_SCHED;
            } else {
            PG8_LDB(B0, 0, 0); PG8_SCHED; PG8_LDA(At, 0, 0); PG8_STAGE(PG8_SA(1, 1), a1 + hstep, voffA);
            PG8_WAIT_L(8); PG8_BAR; PG8_WAIT_L(0); PG8_MMA(0, 0, At, B0); PG8_BAR; PG8_SCHED;
            PG8_LDB(B1, 0, 1); PG8_STAGE(PG8_SB(0, 0), b2, voffB);
            PG8_BAR; PG8_WAIT_L(0); PG8_MMA(0, 1, At, B1); PG8_BAR;
            PG8_LDA(At, 0, 1); PG8_STAGE(PG8_SA(0, 0), a2, voffA);
            PG8_BAR; PG8_WAIT_L(0); PG8_MMA(1, 0, At, B0); PG8_BAR; PG8_SCHED;
            PG8_STAGE(PG8_SB(0, 1), b2 + hstep, voffB);
            PG8_WAIT_V(6); PG8_BAR; PG8_MMA(1, 1, At, B1); PG8_BAR;
            PG8_LDB(B0, 1, 0); PG8_SCHED; PG8_LDA(At, 1, 0); PG8_STAGE(PG8_SA(0, 1), a2 + hstep, voffA);
            PG8_WAIT_L(8); PG8_BAR; PG8_WAIT_L(0); PG8_MMA(0, 0, At, B0); PG8_BAR; PG8_SCHED;
            PG8_LDB(B1, 1, 1); PG8_STAGE(PG8_SB(1, 0), b3, voffB);
            PG8_BAR; PG8_WAIT_L(0); PG8_MMA(0, 1, At, B1); PG8_BAR;
            PG8_LDA(At, 1, 1); PG8_STAGE(PG8_SA(1, 0), a3, voffA);
            PG8_BAR; PG8_WAIT_L(0); PG8_MMA(1, 0, At, B0); PG8_BAR; PG8_SCHED;
            PG8_STAGE(PG8_SB(1, 1), b3 + hstep, voffB);
            PG8_WAIT_V(6); PG8_BAR; PG8_MMA(1, 1, At, B1); PG8_BAR;
            }
        }
        if constexpr (ALIGN_EPI) { if (wr == 0) PG8_BAR; }
        if constexpr (!Epi::AFTER_DRAIN) { E(acc, cur, wr, wc, fr, fq); S.done(cur); }
        if (!has_next) break;
#pragma unroll
        for (int a = 0; a < 2; ++a)
#pragma unroll
            for (int b = 0; b < 2; ++b)
#pragma unroll
                for (int m = 0; m < 4; ++m)
#pragma unroll
                    for (int n = 0; n < 2; ++n) acc[a][b][m][n] = (f32x4){0.f, 0.f, 0.f, 0.f};
        cur = nxt; cA = nA; cB = nB; ++ui;
        if constexpr (ALIGN_EPI) { if (wr == 1) PG8_BAR; }
    }
    PG8_WAIT_V(0);
    if constexpr (!ALIGN_EPI) { if (wr == 0) PG8_BAR; }
    PG8_BAR;
    if constexpr (Epi::AFTER_DRAIN) { E.fused(acc, cur, wr, wc, fr, fq, lds, wid, lane); S.done(cur); }
#undef PG8_SA
#undef PG8_SB
#undef PG8_STAGE
#undef PG8_LDA
#undef PG8_LDB
#undef PG8_MMA
#undef PG8_WAIT_V
#undef PG8_WAIT_L
#undef PG8_BAR
#undef PG8_SCHED
}
}

namespace pg8 {
struct EpiRelu2 {
    static constexpr bool PERM = true, AFTER_DRAIN = false;
    bf16_t* O; int ldc;
    __device__ __forceinline__ void operator()(const f32x4 (&acc)[2][2][4][2], const Unit& u, int wr, int wc, int fr, int fq) const {
        relane(wr, wc, fr, fq);
        const int row0 = u.pm * BM + wr * 64 + fr, col0 = u.pn * BM + wc * 32 + 8 * fq;
#pragma unroll
        for (int ai = 0; ai < 2; ++ai)
#pragma unroll
            for (int m = 0; m < 4; ++m) { bf16_t* rowp = O + (size_t)(row0 + ai * HALF + m * 16) * ldc + col0;
#pragma unroll
                for (int bj = 0; bj < 2; ++bj) { f32x4 v0 = acc[ai][bj][m][0], v1 = acc[ai][bj][m][1];
                    v0 = __builtin_elementwise_max(v0, (f32x4){0.f, 0.f, 0.f, 0.f}); v1 = __builtin_elementwise_max(v1, (f32x4){0.f, 0.f, 0.f, 0.f}); v0 = v0 * v0; v1 = v1 * v1;
                    u32x4 w; w.x = cvt_pk_bf16(v0[0], v0[1]); w.y = cvt_pk_bf16(v0[2], v0[3]); w.z = cvt_pk_bf16(v1[0], v1[1]); w.w = cvt_pk_bf16(v1[2], v1[3]);
                    *(PG8_GAS u32x4*)(rowp + bj * HALF) = w; } }
    }
};
struct EpiF32 {
    static constexpr bool PERM = false, AFTER_DRAIN = false;
    float* O; int ldc;
    __device__ __forceinline__ void operator()(const f32x4 (&acc)[2][2][4][2], const Unit& u, int wr, int wc, int fr, int fq) const {
        relane(wr, wc, fr, fq);
        const int row0 = u.pm * BM + wr * 64 + fr, col0 = u.pn * BM + wc * 32 + 4 * fq;
#pragma unroll
        for (int ai = 0; ai < 2; ++ai)
#pragma unroll
            for (int m = 0; m < 4; ++m) { float* rowp = O + (size_t)(row0 + ai * HALF + m * 16) * ldc + col0;
#pragma unroll
                for (int bj = 0; bj < 2; ++bj)
#pragma unroll
                    for (int n = 0; n < 2; ++n) *(PG8_GAS f32x4*)(rowp + bj * HALF + n * 16) = acc[ai][bj][m][n]; }
    }
};
struct EpiTaps {
    static constexpr bool PERM = false, AFTER_DRAIN = false;
    float* O; const float* decay;
    __device__ __forceinline__ void operator()(const f32x4 (&acc)[2][2][4][2], const Unit& u, int wr, int wc, int fr, int fq) const {
        relane(wr, wc, fr, fq);
        const int row0 = u.pm * BM + wr * 64 + fr, col0 = u.pn * BM + wc * 32 + 4 * fq;
#pragma unroll
        for (int ai = 0; ai < 2; ++ai)
#pragma unroll
            for (int m = 0; m < 4; ++m) { const int row = row0 + ai * HALF + m * 16; float* rowp = O + (size_t)row * 16384 + col0; const float nd = -fabsf(((const PG8_GAS float*)decay)[row]) * (1.0f / 16383.0f) * 1.4426950408889634f;
#pragma unroll
                for (int bj = 0; bj < 2; ++bj)
#pragma unroll
                    for (int n = 0; n < 2; ++n) { const int c = col0 + bj * HALF + n * 16; const f32x4 a = acc[ai][bj][m][n]; f32x4 o;
                        o[0] = a[0] * __builtin_amdgcn_exp2f(nd * (float)(c + 0)); o[1] = a[1] * __builtin_amdgcn_exp2f(nd * (float)(c + 1));
                        o[2] = a[2] * __builtin_amdgcn_exp2f(nd * (float)(c + 2)); o[3] = a[3] * __builtin_amdgcn_exp2f(nd * (float)(c + 3));
                        *(PG8_GAS f32x4*)(rowp + bj * HALF + n * 16) = o; } }
    }
};
}

constexpr int L = 16384, NSEQ = 3, M = NSEQ * L, D = 1024, DEPTH = 4;
constexpr int HYW = 512, HYP = 1536, QR = 256, KVR = 128, ROPE = 32, INW = 1952;
constexpr int NH = 8, DQ = 96, DV = 64, NQ = NH * DQ, NKV = NH * 128;
constexpr int FF = 4096;
constexpr float EPS = 1e-6f;
constexpr int NWAVES = 8, NTHR = 512;
constexpr int MLP_CHUNK = 16384, N_MLP_CHUNKS = M / MLP_CHUNK;

constexpr size_t MiB = 1u << 20;
constexpr size_t WS_CTL = 0, CTL_ZERO_BYTES = 65536;
constexpr size_t WS_COS = 1 * MiB, WS_SIN = 2 * MiB;
constexpr size_t WS_H2 = 4 * MiB;
constexpr size_t WS_W3T = 8 * MiB;
constexpr size_t WS_WIN = 12 * MiB, WS_WOUT = 16 * MiB, WS_WUP = 18 * MiB, WS_WDOWN = 26 * MiB, WS_WUQ = 34 * MiB, WS_WUKV = 34 * MiB + 512 * 1024;
constexpr size_t WS_XN = 36 * MiB;
constexpr size_t WS_CQN = 36 * MiB, WS_CKVN = 60 * MiB, WS_KPE = 72 * MiB;
constexpr size_t WS_KEO = 132 * MiB;
constexpr size_t WS_KT = 261 * MiB;
constexpr size_t WS_UT = 261 * MiB;
constexpr size_t WS_CQKV = 405 * MiB;
constexpr size_t WS_YT = 453 * MiB;
constexpr size_t WS_Q = 132 * MiB, WS_KN = 204 * MiB;
constexpr size_t WS_MIX = 324 * MiB;
constexpr size_t WS_T = 132 * MiB;
constexpr size_t WS_H = 324 * MiB;
constexpr size_t WS_G0 = 75 * MiB, WS_G1A = 107 * MiB, WS_G1B = 501 * MiB;
constexpr size_t WS_XR = 508 * MiB;
constexpr size_t WS_END = 604 * MiB;
constexpr int KEO_BLK = 16512, KEO_KO = 8256;
static_assert(WS_KEO + (size_t)1024 * KEO_BLK * 8 <= WS_KT, "KEO fits");
static_assert(WS_UT + (size_t)HYP * M * 2 <= WS_CQKV && WS_CQKV + (size_t)M * 512 * 2 <= WS_YT && WS_YT + (size_t)HYW * M * 2 <= WS_XR, "map");
static_assert(WS_KN + (size_t)M * NKV * 2 <= WS_MIX && WS_T + (size_t)M * D * 4 <= WS_MIX && WS_H + (size_t)MLP_CHUNK * FF * 2 <= WS_XR && WS_XR + (size_t)M * D * 2 <= WS_END, "map2");

constexpr int RING_OFF = 0, RING_BYTES = 139264;
constexpr int LDSCTL_OFF = RING_BYTES, MISC_OFF = LDSCTL_OFF + 320;
constexpr int LDS_BYTES = 147456;
static_assert(MISC_OFF + 128 <= LDS_BYTES, "LDS map");

#define GAS __attribute__((address_space(1)))
#define LAS __attribute__((address_space(3)))
typedef unsigned short bf16;
typedef unsigned v4u __attribute__((ext_vector_type(4)));
typedef unsigned v2u __attribute__((ext_vector_type(2)));
typedef float f32x4 __attribute__((ext_vector_type(4)));
typedef float f32x2 __attribute__((ext_vector_type(2)));
typedef short bf16x8 __attribute__((ext_vector_type(8)));
typedef GAS unsigned gu32;
#define RLX_AGENT __ATOMIC_RELAXED, __HIP_MEMORY_SCOPE_AGENT
#define LDS_WAIT() asm volatile("s_waitcnt lgkmcnt(0)" ::: "memory")
#define VM_WAIT() asm volatile("s_waitcnt vmcnt(0)" ::: "memory")
typedef __bf16 bf16x2_t __attribute__((ext_vector_type(2)));
__device__ __forceinline__ unsigned pk2(float lo, float hi) { f32x2 v = {lo, hi}; bf16x2_t b = __builtin_convertvector(v, bf16x2_t); return __builtin_bit_cast(unsigned, b); }
__device__ __forceinline__ bf16 f2bf(float f) { return (bf16)(pk2(f, 0.f) & 0xffffu); }
__device__ __forceinline__ float bf2f(unsigned h) { return __uint_as_float(h << 16); }
__device__ __forceinline__ float shx(float v, int lane, int o) { return __uint_as_float((unsigned)__builtin_amdgcn_ds_bpermute((lane ^ o) << 2, (int)__float_as_uint(v))); }
__device__ __forceinline__ float wave_sum(float v) {
    const int ln_ = hw_lane();
#pragma unroll
    for (int o = 1; o < 64; o <<= 1) v += shx(v, ln_, o);
    return v;
}

#ifndef HYSUB
#define HYSUB 0
#endif
#define HT0_(F_) do { if (HYSUB) { __syncthreads(); if (F_.tid == 0) F_.MISC[20] = (unsigned)__builtin_amdgcn_s_memrealtime(); } } while (0)
#define HT1_(F_, s) do { if (HYSUB == (s)) { __syncthreads(); if (F_.tid == 0) F_.MISC[21] += (unsigned)__builtin_amdgcn_s_memrealtime() - F_.MISC[20]; } } while (0)
#define HT0() HT0_(F)
#define HT1(s) HT1_(F, s)

namespace hfft {
constexpr float w32c(int i) { constexpr float t[16] = {1.000000000e+00f, 9.807852507e-01f, 9.238795042e-01f, 8.314695954e-01f, 7.071067691e-01f, 5.555702448e-01f, 3.826834261e-01f, 1.950903237e-01f, 0.f, -1.950903237e-01f, -3.826834261e-01f, -5.555702448e-01f, -7.071067691e-01f, -8.314695954e-01f, -9.238795042e-01f, -9.807852507e-01f}; return t[i]; }
constexpr float w32s(int i) { constexpr float t[16] = {0.000000000e+00f, 1.950903237e-01f, 3.826834261e-01f, 5.555702448e-01f, 7.071067691e-01f, 8.314695954e-01f, 9.238795042e-01f, 9.807852507e-01f, 1.000000000e+00f, 9.807852507e-01f, 9.238795042e-01f, 8.314695954e-01f, 7.071067691e-01f, 5.555702448e-01f, 3.826834261e-01f, 1.950903237e-01f}; return t[i]; }
constexpr int brev(int x, int bits) { int r = 0; for (int i = 0; i < bits; ++i) r |= ((x >> i) & 1) << (bits - 1 - i); return r; }
constexpr int ilog2(int x) { int r = 0; while ((1 << r) < x) ++r; return r; }
__device__ __forceinline__ int pad(int i) { return i + (i >> 5); }

__device__ __forceinline__ void bfly(float ar, float ai, float br, float bi, float& ur, float& ui, float& dr, float& di) {
    asm("v_add_f32_e32 %0, %4, %6\n\tv_add_f32_e32 %1, %5, %7\n\tv_sub_f32_e32 %2, %4, %6\n\tv_sub_f32_e32 %3, %5, %7"
        : "=&v"(ur), "=&v"(ui), "=&v"(dr), "=&v"(di) : "v"(ar), "v"(ai), "v"(br), "v"(bi));
}
template <bool INV> __device__ __forceinline__ void bfly_rot(float ar, float ai, float br, float bi, float& ur, float& ui, float& dr, float& di) {
    if (!INV) asm("v_add_f32_e32 %0, %4, %6\n\tv_add_f32_e32 %1, %5, %7\n\tv_sub_f32_e32 %2, %5, %7\n\tv_sub_f32_e32 %3, %6, %4" : "=&v"(ur), "=&v"(ui), "=&v"(dr), "=&v"(di) : "v"(ar), "v"(ai), "v"(br), "v"(bi));
    else      asm("v_add_f32_e32 %0, %4, %6\n\tv_add_f32_e32 %1, %5, %7\n\tv_sub_f32_e32 %2, %7, %5\n\tv_sub_f32_e32 %3, %4, %6" : "=&v"(ur), "=&v"(ui), "=&v"(dr), "=&v"(di) : "v"(ar), "v"(ai), "v"(br), "v"(bi));
}
__device__ __forceinline__ void bfly_tw(float ar, float ai, float br, float bi, float c, float s, float& ur, float& ui, float& dr, float& di) {
    float tr, ti;
    asm("v_sub_f32_e32 %4, %6, %8\n\tv_sub_f32_e32 %5, %7, %9\n\tv_add_f32_e32 %0, %6, %8\n\tv_add_f32_e32 %1, %7, %9\n\t"
        "v_mul_f32_e32 %2, %10, %4\n\tv_mul_f32_e32 %3, %11, %4\n\tv_fma_f32 %2, -%11, %5, %2\n\tv_fma_f32 %3, %10, %5, %3"
        : "=&v"(ur), "=&v"(ui), "=&v"(dr), "=&v"(di), "=&v"(tr), "=&v"(ti) : "v"(ar), "v"(ai), "v"(br), "v"(bi), "s"(c), "s"(s));
}
__device__ __forceinline__ void cmul_chain(float& xr, float& xi, float& wc, float& ws, float c1, float s1) {
    float a, b, nc, ns;
    asm("v_mul_f32_e32 %0, %4, %6\n\tv_mul_f32_e32 %1, %4, %7\n\tv_fma_f32 %0, -%5, %7, %0\n\tv_fma_f32 %1, %5, %6, %1\n\t"
        "v_mul_f32_e32 %2, %6, %8\n\tv_mul_f32_e32 %3, %6, %9\n\tv_fma_f32 %2, -%7, %9, %2\n\tv_fma_f32 %3, %7, %8, %3"
        : "=&v"(a), "=&v"(b), "=&v"(nc), "=&v"(ns) : "v"(xr), "v"(xi), "v"(wc), "v"(ws), "v"(c1), "v"(s1));
    xr = a; xi = b; wc = nc; ws = ns;
}
template <int R, bool INV> __device__ __forceinline__ void fft_r2(float (&re)[R], float (&im)[R], const unsigned z0) {
    constexpr int LG = ilog2(R);
#pragma unroll
    for (int st = 0; st < LG; ++st) {
        const int s = (R / 2) >> st;
#pragma unroll
        for (int blk = 0; blk < R; blk += 2 * s) {
#pragma unroll
            for (int a = 0; a < s; ++a) {
                const int i0 = blk + a, i1 = i0 + s;
                const int w = a * (16 / s);
                float ur, ui, dr, di;
                if (w == 0) { bfly(re[i0], im[i0], re[i1], im[i1], ur, ui, dr, di); re[i1] = dr; im[i1] = di; }
                else if (w == 8) { bfly_rot<INV>(re[i0], im[i0], re[i1], im[i1], ur, ui, dr, di); re[i1] = dr; im[i1] = di; }
                else { const float c = __uint_as_float(__float_as_uint(w32c(w)) | z0), sn = __uint_as_float(__float_as_uint(INV ? w32s(w) : -w32s(w)) | z0);
                    bfly_tw(re[i0], im[i0], re[i1], im[i1], c, sn, ur, ui, dr, di); re[i1] = dr; im[i1] = di; }
                re[i0] = ur; im[i0] = ui;
            }
        }
    }
}

__device__ __forceinline__ int opaque(int x) { asm volatile("" : "+v"(x)); return x; }
template <bool INV> __device__ __forceinline__ void fft16k(float (&re)[32], float (&im)[32], LAS f32x2* buf, const int t_in) {
    asm volatile("" ::: "memory"); __builtin_amdgcn_sched_barrier(0);
    int t = opaque(t_in);
    unsigned z0 = 0u; asm volatile("" : "+s"(z0));
    fft_r2<32, INV>(re, im, z0);
    __syncthreads();
#pragma unroll
    for (int r = 0; r < 32; ++r) buf[33 * t + r] = (f32x2){re[brev(r, 5)], im[brev(r, 5)]};
    __syncthreads();
    t = opaque(t);
    { const int b2 = t + (t >> 5);
#pragma unroll
    for (int r = 0; r < 32; ++r) { const f32x2 v = buf[b2 + 528 * r]; re[r] = v.x; im[r] = v.y; } }
    {
        const float f1 = (float)(t & 31) * (1.0f / 1024.0f);
        const float c1 = __builtin_amdgcn_cosf(f1), s1 = INV ? __builtin_amdgcn_sinf(f1) : -__builtin_amdgcn_sinf(f1);
        float wc = c1, ws = s1;
#pragma unroll
        for (int r = 1; r < 32; ++r) {
            cmul_chain(re[r], im[r], wc, ws, c1, s1);
        }
    }
    fft_r2<32, INV>(re, im, z0);
    __syncthreads();
    {
        t = opaque(t);
        const int ob = (t >> 5) * 1056 + (t & 31);
#pragma unroll
        for (int r = 0; r < 32; ++r) buf[ob + 33 * r] = (f32x2){re[brev(r, 5)], im[brev(r, 5)]};
    }
    __syncthreads();
#pragma unroll
    for (int h = 0; h < 2; ++h) {
        t = opaque(t);
        float ar[16], ai[16]; const int j = t + 512 * h; const int b3 = t + (t >> 5) + 528 * h;
#pragma unroll
        for (int r = 0; r < 16; ++r) { const f32x2 v = buf[b3 + 1056 * r]; ar[r] = v.x; ai[r] = v.y; }
        {
            const float f1 = (float)j * (1.0f / 16384.0f);
            const float c1 = __builtin_amdgcn_cosf(f1), s1 = INV ? __builtin_amdgcn_sinf(f1) : -__builtin_amdgcn_sinf(f1);
            float wc = c1, ws = s1;
#pragma unroll
            for (int r = 1; r < 16; ++r) {
                cmul_chain(ar[r], ai[r], wc, ws, c1, s1);
            }
        }
        fft_r2<16, INV>(ar, ai, z0);
#pragma unroll
        for (int r = 0; r < 16; ++r) { re[h + 2 * r] = ar[brev(r, 4)]; im[h + 2 * r] = ai[brev(r, 4)]; }
    }
    asm volatile("" ::: "memory"); __builtin_amdgcn_sched_barrier(0);
}
}

struct Frame {
    LAS unsigned char* lds;
    volatile LAS unsigned* MISC;
    gu32* ctl;
    int tid, lane, wave;
    int wave0;
    int vcu, G;
    float* out;
    unsigned char* ws;
};
constexpr int PTRTAB_OFF = LDSCTL_OFF + 512;
__device__ __forceinline__ const GAS float* inp(const Frame& F, int i) {
    const v2u w = *(const LAS v2u*)(F.lds + PTRTAB_OFF + 8 * i);
    const unsigned lo = __builtin_amdgcn_readfirstlane(w.x), hi = __builtin_amdgcn_readfirstlane(w.y);
    return (const GAS float*)(((unsigned long long)hi << 32) | lo);
}
__device__ __forceinline__ GAS unsigned char* wsq(const Frame& F) { unsigned char* p = F.ws; asm volatile("" : "+s"(p)); return (GAS unsigned char*)p; }
enum { I_XP = 0, I_XS, I_WIN, I_CONVW, I_CONVB, I_FW1, I_FB1, I_FW2, I_FB2, I_FW3, I_SINF, I_DECAY, I_HBIAS, I_QNORM, I_WUQ, I_KVNORM, I_WUKV, I_GNHY, I_GNAT, I_WOUT,
       I_NMIXPRE, I_NMIXPOST, I_NMLPPRE, I_NMLPPOST, I_WUP, I_WDOWN };

__device__ __forceinline__ int rope_src(int p) { return 4 * (p >> 3) + (p & 3) + 16 * ((p >> 2) & 1); }
template <bool ROPEPERM>
__device__ __forceinline__ void transpose_item(const GAS float* W, int K, int N, GAS bf16* WT, LAS float* scr, int item, int lane, int ldk = 0, int koff = 0) {
    if (ldk == 0) ldk = K;
    const int nblk = N / 32, kb = item / nblk, nb = item % nblk, k0 = 64 * kb, n0 = 32 * nb;
    int sc = lane & 31; if (ROPEPERM && (nb % 3) == 2) sc = rope_src(sc);
#pragma unroll 8
    for (int i = 0; i < 32; ++i) { const int kk = 2 * i + (lane >> 5); scr[kk * 33 + (lane & 31)] = W[(size_t)(k0 + kk) * N + n0 + sc]; }
    LDS_WAIT(); asm volatile("" ::: "memory");
    const int c = lane & 7;
#pragma unroll
    for (int j = 0; j < 4; ++j) { const int n = (lane >> 3) + 8 * j; const LAS float* s = scr + (8 * c) * 33 + n;
        v4u o; o.x = pk2(s[0 * 33], s[1 * 33]); o.y = pk2(s[2 * 33], s[3 * 33]); o.z = pk2(s[4 * 33], s[5 * 33]); o.w = pk2(s[6 * 33], s[7 * 33]);
        *(GAS v4u*)(WT + (size_t)(n0 + n) * ldk + koff + k0 + 8 * c) = o; }
    LDS_WAIT(); asm volatile("" ::: "memory");
}
__device__ __forceinline__ void phase_weights(Frame& F, int l) {
    LAS float* scr = (LAS float*)(F.lds + RING_OFF + F.wave * 16384);
    const int gw = F.vcu * NWAVES + F.wave, NGW = F.G * NWAVES;
    GAS bf16* WinT = (GAS bf16*)(wsq(F) + WS_WIN); GAS bf16* WoutT = (GAS bf16*)(wsq(F) + WS_WOUT); GAS bf16* WupT = (GAS bf16*)(wsq(F) + WS_WUP); GAS bf16* WdownT = (GAS bf16*)(wsq(F) + WS_WDOWN);
    GAS bf16* WuqT = (GAS bf16*)(wsq(F) + WS_WUQ); GAS bf16* WukvT = (GAS bf16*)(wsq(F) + WS_WUKV);
    constexpr int I_IN = (D / 64) * (INW / 32), I_OUT = (D / 64) * (D / 32), I_UP = (D / 64) * (FF / 32), I_DN = (FF / 64) * (D / 32), I_UQ = (QR / 64) * (NQ / 32), I_UKV = (KVR / 64) * (NKV / 32);
    constexpr int I_W3 = 2048 / 32;
    constexpr int NITEMS = I_IN + I_OUT + I_UP + I_DN + I_UQ + I_UKV + 2 * I_W3;
    for (int it = gw; it < NITEMS; it += NGW) {
        int r = it;
        if (r < I_IN) { transpose_item<false>(inp(F, I_WIN) + (size_t)l * D * INW, D, INW, WinT, scr, r, F.lane); continue; } r -= I_IN;
        if (r < I_OUT) { transpose_item<false>(inp(F, I_WOUT) + (size_t)l * D * D, D, D, WoutT, scr, r, F.lane); continue; } r -= I_OUT;
        if (r < I_UP) { transpose_item<false>(inp(F, I_WUP) + (size_t)l * D * FF, D, FF, WupT, scr, r, F.lane); continue; } r -= I_UP;
        if (r < I_DN) { transpose_item<false>(inp(F, I_WDOWN) + (size_t)l * FF * D, FF, D, WdownT, scr, r, F.lane); continue; } r -= I_DN;
        if (r < I_UQ) { transpose_item<true>(inp(F, I_WUQ) + (size_t)l * QR * NQ, QR, NQ, WuqT, scr, r, F.lane); continue; } r -= I_UQ;
        if (r < I_UKV) { transpose_item<false>(inp(F, I_WUKV) + (size_t)l * KVR * NKV, KVR, NKV, WukvT, scr, r, F.lane); continue; } r -= I_UKV;
        transpose_item<false>(inp(F, I_FW3) + (size_t)l * 64 * 2048, 64, 2048, (GAS bf16*)(wsq(F) + WS_W3T), scr, r % I_W3, F.lane, 128, (r / I_W3) * 64);
    }
    { unsigned z = 0u; asm volatile("" : "+v"(z)); const v4u zz = {z, z, z, z};
      for (int i = gw * 64 + F.lane; i < 12288; i += NGW * 64) ((GAS v4u*)(WinT + (size_t)INW * D))[i] = zz; }
}
__device__ __forceinline__ void phase_rope_tab(Frame& F) {
    const float inv[16] = {1.000000000e+00f, 5.623413324e-01f, 3.162277639e-01f, 1.778279394e-01f, 1.000000015e-01f, 5.623412877e-02f, 3.162277862e-02f, 1.778279431e-02f,
                           9.999999776e-03f, 5.623413250e-03f, 3.162277862e-03f, 1.778279431e-03f, 1.000000047e-03f, 5.623413017e-04f, 3.162277862e-04f, 1.778279402e-04f};
    GAS float* ct = (GAS float*)(wsq(F) + WS_COS); GAS float* st = (GAS float*)(wsq(F) + WS_SIN);
    for (int i = F.vcu * NTHR + F.tid; i < L * 16; i += F.G * NTHR) {
        const int t = i >> 4, j = i & 15; float iv = inv[0];
#pragma unroll
        for (int q = 1; q < 16; ++q) iv = (j == q) ? inv[q] : iv;
        const float ang = (float)t * iv; ct[i] = cosf(ang); st[i] = sinf(ang);
    }
}
__device__ __forceinline__ const GAS float* x_src_row(Frame& F, int l, int m) {
    if (l == 0) return (m < 2 * L) ? inp(F, I_XP) + (size_t)m * D : inp(F, I_XS) + (size_t)(m - 2 * L) * D;
    return (const GAS float*)F.out + (size_t)m * D;
}
__device__ __forceinline__ void store_xn_row(f32x4 (&v)[4], float rstd, const GAS float* g, GAS bf16* orow, int lane) {
    GAS v2u* o8 = (GAS v2u*)orow + lane;
#pragma unroll
    for (int j = 0; j < 4; ++j) { const f32x4 gg = ((const GAS f32x4*)g)[lane + 64 * j]; v2u w; w.x = pk2(v[j].x * rstd * gg.x, v[j].y * rstd * gg.y); w.y = pk2(v[j].z * rstd * gg.z, v[j].w * rstd * gg.w); o8[64 * j] = w; }
}
__device__ __forceinline__ float row_ss(const f32x4 (&v)[4]) { float s = 0.f;
#pragma unroll
    for (int j = 0; j < 4; ++j) s += (v[j].x * v[j].x + v[j].y * v[j].y) + (v[j].z * v[j].z + v[j].w * v[j].w);
    return wave_sum(s); }
__device__ __forceinline__ void phase_norm_first(Frame& F, int l, const GAS float* g) {
    const int gw = F.vcu * NWAVES + F.wave, NGW = F.G * NWAVES; GAS bf16* XN = (GAS bf16*)(wsq(F) + WS_XN);
    for (int m0 = gw; m0 < M; m0 += 4 * NGW) {
        f32x4 v[4][4];
#pragma unroll
        for (int q = 0; q < 4; ++q) { const int mm = m0 + q * NGW, m = mm < M ? mm : M - 1; const GAS f32x4* xr = (const GAS f32x4*)x_src_row(F, l, m) + F.lane;
#pragma unroll
            for (int j = 0; j < 4; ++j) v[q][j] = xr[64 * j]; }
#pragma unroll
        for (int q = 0; q < 4; ++q) { const int m = m0 + q * NGW; if (m >= M) break;
            const float rstd = 1.0f / sqrtf(row_ss(v[q]) * (1.0f / D) + EPS);
            store_xn_row(v[q], rstd, g, XN + (size_t)m * D, F.lane); }
    }
}
template <bool SRC_IN, bool DST_OUT>
__device__ __forceinline__ void phase_norm_res(Frame& F, const GAS bf16* T, const GAS float* gpost, const GAS float* gnext) {
    const int gw = F.vcu * NWAVES + F.wave, NGW = F.G * NWAVES; GAS bf16* XN = (GAS bf16*)(wsq(F) + WS_XN); GAS bf16* XR = (GAS bf16*)(wsq(F) + WS_XR);
    constexpr int R = SRC_IN ? 2 : 4;
    for (int m0 = gw; m0 < M; m0 += R * NGW) {
        f32x4 vf[SRC_IN ? R : 1][4]; v2u xw[SRC_IN ? 1 : R][4], tw[R][4];
#pragma unroll
        for (int q = 0; q < R; ++q) { const int mm = m0 + q * NGW, m = mm < M ? mm : M - 1; const GAS v2u* tr = (const GAS v2u*)(T + (size_t)m * D) + F.lane;
            if (SRC_IN) { const GAS f32x4* xr = (const GAS f32x4*)x_src_row(F, 0, m) + F.lane;
#pragma unroll
                for (int j = 0; j < 4; ++j) vf[SRC_IN ? q : 0][j] = xr[64 * j]; }
            else { const GAS v2u* xr = (const GAS v2u*)(XR + (size_t)m * D) + F.lane;
#pragma unroll
                for (int j = 0; j < 4; ++j) xw[SRC_IN ? 0 : q][j] = xr[64 * j]; }
#pragma unroll
            for (int j = 0; j < 4; ++j) tw[q][j] = tr[64 * j]; }
#pragma unroll
        for (int q = 0; q < R; ++q) { const int m = m0 + q * NGW; if (m >= M) break;
            f32x4 v[4], tv[4];
#pragma unroll
            for (int j = 0; j < 4; ++j) { const v2u w = tw[q][j]; tv[j] = (f32x4){bf2f(w.x & 0xffffu), bf2f(w.x >> 16), bf2f(w.y & 0xffffu), bf2f(w.y >> 16)};
                if (SRC_IN) v[j] = vf[SRC_IN ? q : 0][j]; else { const v2u x = xw[SRC_IN ? 0 : q][j]; v[j] = (f32x4){bf2f(x.x & 0xffffu), bf2f(x.x >> 16), bf2f(x.y & 0xffffu), bf2f(x.y >> 16)}; } }
            const float rt = 1.0f / sqrtf(row_ss(tv) * (1.0f / D) + EPS);
#pragma unroll
            for (int j = 0; j < 4; ++j) { const f32x4 gg = ((const GAS f32x4*)gpost)[F.lane + 64 * j]; v[j] = v[j] + tv[j] * rt * gg; }
            if (DST_OUT) { GAS f32x4* orow = (GAS f32x4*)(F.out + (size_t)m * D) + F.lane;
#pragma unroll
                for (int j = 0; j < 4; ++j) orow[64 * j] = v[j]; }
            else { GAS v2u* orow = (GAS v2u*)(XR + (size_t)m * D) + F.lane;
#pragma unroll
                for (int j = 0; j < 4; ++j) { v2u w; w.x = pk2(v[j].x, v[j].y); w.y = pk2(v[j].z, v[j].w); orow[64 * j] = w; } }
            if (gnext) { const float rstd = 1.0f / sqrtf(row_ss(v) * (1.0f / D) + EPS); store_xn_row(v, rstd, gnext, XN + (size_t)m * D, F.lane); } }
    }
}

__device__ __forceinline__ void phase_filter_mlp(Frame& F, int l) {
    const GAS float* w1 = inp(F, I_FW1) + (size_t)l * 33 * 64; const GAS float* b1 = inp(F, I_FB1) + l * 64; const GAS float* w2 = inp(F, I_FW2) + (size_t)l * 64 * 64; const GAS float* b2 = inp(F, I_FB2) + l * 64;
    const GAS float* sf = inp(F, I_SINF) + l * 128; GAS bf16* H2 = (GAS bf16*)(wsq(F) + WS_H2);
    const int lane = F.lane, gw = F.vcu * NWAVES + F.wave, NGW = F.G * NWAVES;
    float w1c[33], w2c[64];
#pragma unroll
    for (int f = 0; f < 33; ++f) w1c[f] = w1[f * 64 + lane];
#pragma unroll
    for (int i = 0; i < 64; ++i) w2c[i] = w2[i * 64 + lane];
    const float b1l = b1[lane], b2l = b2[lane], sf0 = sf[lane], sf1 = sf[64 + lane];
    for (int n = gw; n < L; n += NGW) {
        const float tn = (float)n * (1.0f / (float)(L - 1)); const float omega = (float)(2.0 * 3.14159265358979323846 / L) * (float)n;
        const int bidx = (lane >= 17) ? lane - 17 : lane - 1; const float band = 1e-4f + (float)bidx * ((15.0f - 1e-4f) / 15.0f); const float ph = omega * band;
        const float zf = (lane == 0) ? tn : ((lane <= 16) ? cosf(ph) : -sinf(ph));
        float acc = b1l;
#pragma unroll
        for (int f = 0; f < 33; ++f) acc += __uint_as_float(__builtin_amdgcn_readlane(__float_as_uint(zf), f)) * w1c[f];
        const float h1 = sinf(sf0 * acc);
        float acc2 = b2l;
#pragma unroll
        for (int i = 0; i < 64; ++i) acc2 += __uint_as_float(__builtin_amdgcn_readlane(__float_as_uint(h1), i)) * w2c[i];
        const float hv = sinf(sf1 * acc2); const bf16 hi = f2bf(hv);
        H2[(size_t)n * 128 + lane] = hi; H2[(size_t)n * 128 + 64 + lane] = f2bf(hv - bf2f(hi));
    }
}
typedef float f32x4u __attribute__((ext_vector_type(4), aligned(4)));
__device__ __forceinline__ void taps_stage(const GAS float* fw0, const GAS float* bw0, const GAS float* fw1, const GAS float* bw1, bool odd, LAS f32x2* buf, int t) {
    const float sg = odd ? -1.f : 1.f;
#pragma unroll 1
    for (int h = 0; h < 2; ++h) { const int tq = hfft::opaque(t) + 2048 * h; f32x4 a0[4], a1[4], r0[4], r1[4];
#pragma unroll
        for (int q = 0; q < 4; ++q) { const int c = tq + 512 * q; a0[q] = *(const GAS f32x4*)(fw0 + 4 * c); a1[q] = *(const GAS f32x4*)(fw1 + 4 * c);
            r0[q] = *(const GAS f32x4u*)(bw0 + (L - 3 - 4 * c)); r1[q] = *(const GAS f32x4u*)(bw1 + (L - 3 - 4 * c)); }
#pragma unroll
        for (int q = 0; q < 4; ++q) { const int c = tq + 512 * q; const float e0 = c > 0 ? r0[q][3] : 0.f, e1 = c > 0 ? r1[q][3] : 0.f;
            LAS f32x4* dst = (LAS f32x4*)(buf + 4 * c);
            dst[0] = (f32x4){a0[q][0] + sg * e0, a1[q][0] + sg * e1, a0[q][1] + sg * r0[q][2], a1[q][1] + sg * r1[q][2]};
            dst[1] = (f32x4){a0[q][2] + sg * r0[q][1], a1[q][2] + sg * r1[q][1], a0[q][3] + sg * r0[q][0], a1[q][3] + sg * r1[q][0]}; } }
}
__device__ __forceinline__ void phase_filter_fft(Frame& F, int l) {
    const GAS float* KT = (const GAS float*)(wsq(F) + WS_KT); GAS f32x2* KEO = (GAS f32x2*)(wsq(F) + WS_KEO); const GAS float* hb = inp(F, I_HBIAS) + (size_t)l * 2 * HYW;
    LAS f32x2* buf = (LAS f32x2*)(F.lds + RING_OFF); const int t = F.tid;
    for (int c = F.vcu; c < HYW; c += F.G) {
        const GAS float* fw0 = KT + (size_t)(0 * HYW + c) * L; const GAS float* bw0 = KT + (size_t)(1 * HYW + c) * L;
        const GAS float* fw1 = KT + (size_t)(2 * HYW + c) * L; const GAS float* bw1 = KT + (size_t)(3 * HYW + c) * L;
        const float bias0 = hb[c], bias1 = hb[HYW + c]; const float sc = 1.0f / (2.0f * L);
        GAS f32x2* k0 = KEO + (size_t)c * KEO_BLK; GAS f32x2* k1 = KEO + (size_t)(HYW + c) * KEO_BLK;
        float ar[32], ai[32];
#pragma unroll 1
        for (int odd = 0; odd < 2; ++odd) {
            HT0();
            __syncthreads(); taps_stage(fw0, bw0, fw1, bw1, odd != 0, buf, t); __syncthreads();
            { const int tq = hfft::opaque(t);
#pragma unroll
              for (int m = 0; m < 32; ++m) { const int n = tq + 512 * m; const f32x2 v = buf[n];
                  if (!odd) { ar[m] = v.x; ai[m] = v.y; }
                  else { const float d0 = v.x, d1 = v.y; const float fr = (float)n * (1.0f / 32768.0f); const float cs = __builtin_amdgcn_cosf(fr), sn = -__builtin_amdgcn_sinf(fr);
                         ar[m] = d0 * cs - d1 * sn; ai[m] = d0 * sn + d1 * cs; } } }
            HT1(11); if (HYSUB != 40) HT0(); hfft::fft16k<false>(ar, ai, buf, t); HT1(12); HT0();
            __syncthreads();
            { const int tq = hfft::opaque(t);
#pragma unroll
              for (int m = 0; m < 32; ++m) buf[hfft::pad(tq + 512 * m)] = (f32x2){ar[m], ai[m]}; }
            __syncthreads();
            { const int tq = hfft::opaque(t); GAS f32x2* d0 = k0 + (odd ? KEO_KO : 0); GAS f32x2* d1 = k1 + (odd ? KEO_KO : 0);
#pragma unroll
              for (int m = 0; m <= 16; ++m) { const int k = tq + 512 * m; const bool keep = odd ? (k < 8192) : (k <= 8192);
                  const int rk = odd ? 16383 - k : ((16384 - k) & 16383); const f32x2 xq = buf[hfft::pad(rk)]; const float cr = xq.x, ci = -xq.y;
                  const float a0 = 0.5f * (ar[m] + cr), a1 = 0.5f * (ai[m] + ci), b0 = 0.5f * (ai[m] - ci), b1 = -0.5f * (ar[m] - cr);
                  if (keep) { d0[k] = (f32x2){(a0 + bias0) * sc, a1 * sc}; d1[k] = (f32x2){(b0 + bias1) * sc, b1 * sc}; } } }
            HT1(13);
        }
    }
    __syncthreads();
}

__device__ __forceinline__ float u_conv3(const GAS bf16* row, int n, float w0, float w1, float w2, float cb) {
    const int nm = n >= 1 ? n - 1 : 0, np = n + 1 < L ? n + 1 : L - 1;
    float um = bf2f(row[nm]), up = bf2f(row[np]); const float u0 = bf2f(row[n]);
    um = n >= 1 ? um : 0.f; up = n + 1 < L ? up : 0.f;
    return um * w0 + u0 * w1 + up * w2 + cb;
}
__device__ __forceinline__ void conv3_stage(const GAS bf16* r0, const GAS bf16* r1, float w0, float w1, float w2, float cb, float v0, float v1, float v2, float vb, LAS f32x2* buf, int t) {
    const int tq = hfft::opaque(t);
#pragma unroll
    for (int q = 0; q < 4; ++q) { const int j = tq + 512 * q; const bool hl = j > 0, hr = j < L / 8 - 1; const int nl = hl ? 8 * j - 1 : 0, nr = hr ? 8 * j + 8 : L - 1;
        const v4u a = *(const GAS v4u*)(r0 + 8 * j), b = *(const GAS v4u*)(r1 + 8 * j);
        float al = bf2f(r0[nl]), ar = bf2f(r0[nr]), bl = bf2f(r1[nl]), br = bf2f(r1[nr]);
        al = hl ? al : 0.f; bl = hl ? bl : 0.f; ar = hr ? ar : 0.f; br = hr ? br : 0.f;
        const float ua[10] = {al, __uint_as_float(a.x << 16), __uint_as_float(a.x & 0xffff0000u), __uint_as_float(a.y << 16), __uint_as_float(a.y & 0xffff0000u),
                              __uint_as_float(a.z << 16), __uint_as_float(a.z & 0xffff0000u), __uint_as_float(a.w << 16), __uint_as_float(a.w & 0xffff0000u), ar};
        const float ub[10] = {bl, __uint_as_float(b.x << 16), __uint_as_float(b.x & 0xffff0000u), __uint_as_float(b.y << 16), __uint_as_float(b.y & 0xffff0000u),
                              __uint_as_float(b.z << 16), __uint_as_float(b.z & 0xffff0000u), __uint_as_float(b.w << 16), __uint_as_float(b.w & 0xffff0000u), br};
        LAS f32x4* dst = (LAS f32x4*)(buf + 8 * j);
#pragma unroll
        for (int e = 0; e < 8; e += 2) { f32x4 o;
            o[0] = ua[e] * w0 + ua[e + 1] * w1 + ua[e + 2] * w2 + cb; o[1] = ub[e] * v0 + ub[e + 1] * v1 + ub[e + 2] * v2 + vb;
            o[2] = ua[e + 1] * w0 + ua[e + 2] * w1 + ua[e + 3] * w2 + cb; o[3] = ub[e + 1] * v0 + ub[e + 2] * v1 + ub[e + 3] * v2 + vb; dst[e >> 1] = o; } }
}
__device__ __forceinline__ void cmul_spec(float (&xr)[32], float (&xi)[32], const GAS f32x2* ke, int t, bool odd) {
    { const int tq = hfft::opaque(t); (void)tq;
#pragma unroll
    for (int m = 0; m < 32; ++m) { const int k = tq + 512 * m; int idx; bool cj;
        if (!odd) { cj = k > 8192; idx = cj ? 16384 - k : k; } else { cj = k >= 8192; idx = cj ? 16383 - k : k; }
        const f32x2 kv = ke[idx]; const float kr = kv.x, ki = cj ? -kv.y : kv.y;
        const float a = xr[m], b = xi[m]; xr[m] = a * kr - b * ki; xi[m] = a * ki + b * kr; if ((m & 15) == 15) { asm volatile("" ::: "memory"); __builtin_amdgcn_sched_barrier(0); } }
    }
}
__device__ __forceinline__ f32x2 ld_spec(const GAS f32x2* ke, int k, bool odd) {
    int idx; bool cj;
    if (!odd) { cj = k > 8192; idx = cj ? 16384 - k : k; } else { cj = k >= 8192; idx = cj ? 16383 - k : k; }
    f32x2 kv = ke[idx]; kv.y = cj ? -kv.y : kv.y; return kv;
}
__device__ __forceinline__ void cmul_spec2(float (&xr)[32], float (&xi)[32], const GAS f32x2* ka, const GAS f32x2* kb, LAS f32x2* buf, int t, bool odd) {
    __syncthreads();
    { const int tq = hfft::opaque(t);
#pragma unroll
      for (int m = 0; m < 32; ++m) buf[hfft::pad(tq + 512 * m)] = (f32x2){xr[m], xi[m]}; }
    __syncthreads();
    { const int tq = hfft::opaque(t);
#pragma unroll
      for (int m = 0; m < 32; ++m) { const int k = tq + 512 * m; const int rk = odd ? 16383 - k : ((16384 - k) & 16383);
          const f32x2 xc = buf[hfft::pad(rk)];
          const f32x2 a = ld_spec(ka, k, odd), b = ld_spec(kb, k, odd);
          const float sr = 0.5f * (a.x + b.x), si = 0.5f * (a.y + b.y), dr = 0.5f * (a.x - b.x), di = 0.5f * (a.y - b.y);
          const float x0 = xr[m], x1 = xi[m], c0 = xc.x, c1 = -xc.y;
          xr[m] = (x0 * sr - x1 * si) + (c0 * dr - c1 * di); xi[m] = (x0 * si + x1 * sr) + (c0 * di + c1 * dr);
          if ((m & 7) == 7) { asm volatile("" ::: "memory"); __builtin_amdgcn_sched_barrier(0); } } }
}
__device__ __forceinline__ void spec_prefetch(const GAS f32x2* ke, LAS unsigned char* lds, int t) {
    const int tq = hfft::opaque(t); const GAS unsigned char* src = (const GAS unsigned char*)ke + (tq >> 6) * 1024 + (tq & 63) * 16;
#pragma unroll
    for (int p = 0; p < 9; ++p) { int off = p * 8192; if (p == 8) off = (tq >> 6) == 0 ? off : 0;
        __builtin_amdgcn_global_load_lds((const GAS unsigned*)(src + off), (LAS unsigned*)(lds + RING_OFF + 135168), 16, 0, 0); }
}
__device__ __forceinline__ void phase_hyena(Frame& F, int l) {
    const GAS bf16* UT = (const GAS bf16*)(wsq(F) + WS_UT); GAS bf16* YT = (GAS bf16*)(wsq(F) + WS_YT); const GAS f32x2* KEO = (const GAS f32x2*)(wsq(F) + WS_KEO);
    const GAS float* cw = inp(F, I_CONVW) + (size_t)l * 3 * HYP; const GAS float* cbv = inp(F, I_CONVB) + (size_t)l * HYP;
    LAS f32x2* buf = (LAS f32x2*)(F.lds + RING_OFF); const int t = F.tid;
    GAS f32x2* G0 = (GAS f32x2*)(wsq(F) + WS_G0) + (size_t)F.vcu * 16384 + t;
    for (int item = F.vcu; item < HYW + HYW / 2; item += F.G) {
        const bool mode1 = item >= HYW;
        const int c0 = mode1 ? 2 * (item - HYW) : item, c1 = mode1 ? c0 + 1 : c0;
        const size_t s0 = mode1 ? (size_t)2 * L : 0, s1 = mode1 ? (size_t)2 * L : (size_t)L;
        float ar[32], ai[32]; unsigned ep[32];
#pragma unroll 1
        for (int o = 0; o < 2; ++o) {
            const GAS f32x2* ke0 = KEO + (size_t)(o * HYW + c0) * KEO_BLK; const GAS f32x2* ke1 = KEO + (size_t)(o * HYW + c1) * KEO_BLK;
#pragma unroll 1
            for (int half = 0; half < 2; ++half) {
                if (HYSUB != 40) HT0();
                if (o == 0) { const float w0 = cw[c0], w1 = cw[HYP + c0], w2 = cw[2 * HYP + c0], cb = cbv[c0], v0 = cw[c1], v1 = cw[HYP + c1], v2 = cw[2 * HYP + c1], vb = cbv[c1];
                    const GAS bf16* r0 = UT + (size_t)c0 * M + s0; const GAS bf16* r1 = UT + (size_t)c1 * M + s1;
                    __syncthreads(); conv3_stage(r0, r1, w0, w1, w2, cb, v0, v1, v2, vb, buf, t); __syncthreads();
                    { const int tq = hfft::opaque(t);
#pragma unroll
                    for (int m = 0; m < 32; ++m) { const f32x2 v = buf[tq + 512 * m]; ar[m] = v.x; ai[m] = v.y; } }
                    }
                else {
                    { const int tq = hfft::opaque(t); (void)tq; GAS f32x2* G0q = G0 + (tq - t);
#pragma unroll
                    for (int m = 0; m < 32; ++m) { const f32x2 v = G0q[m * 512]; ar[m] = v.x; ai[m] = v.y; if ((m & 15) == 15) { asm volatile("" ::: "memory"); __builtin_amdgcn_sched_barrier(0); } } }
                    }
                HT1(1);
                if (half == 0) {
                    spec_prefetch(ke0, F.lds, t); if (mode1) spec_prefetch(ke1, F.lds, t);
                    if (HYSUB != 40) HT0(); hfft::fft16k<false>(ar, ai, buf, t); HT1(2); if (HYSUB != 40) HT0();
                    if (mode1) cmul_spec2(ar, ai, ke0, ke1, buf, t, false); else cmul_spec(ar, ai, ke0, t, false);
                    HT1(3); if (HYSUB != 40) HT0(); hfft::fft16k<true>(ar, ai, buf, t); HT1(2); if (HYSUB != 40) HT0();
                    {
#pragma unroll
                    for (int m = 0; m < 32; ++m) ep[m] = pk2(ar[m], ai[m]);
                    }
                    HT1(4);
                } else {
                    if (HYSUB != 40) HT0();
                    { const int tq = hfft::opaque(t); (void)tq;
#pragma unroll
                    for (int m = 0; m < 32; ++m) { const float fr = (float)(tq + 512 * m) * (1.0f / 32768.0f); const float cs = __builtin_amdgcn_cosf(fr), sn = -__builtin_amdgcn_sinf(fr);
                        const float a = ar[m], b = ai[m]; ar[m] = a * cs - b * sn; ai[m] = a * sn + b * cs; }
                    }
                    spec_prefetch(ke0 + KEO_KO, F.lds, t); if (mode1) spec_prefetch(ke1 + KEO_KO, F.lds, t);
                    HT1(5); if (HYSUB != 40) HT0(); hfft::fft16k<false>(ar, ai, buf, t); HT1(2); if (HYSUB != 40) HT0();
                    if (mode1) cmul_spec2(ar, ai, ke0 + KEO_KO, ke1 + KEO_KO, buf, t, true); else cmul_spec(ar, ai, ke0 + KEO_KO, t, true);
                    HT1(3); if (HYSUB != 40) HT0(); hfft::fft16k<true>(ar, ai, buf, t); HT1(2); if (HYSUB != 40) HT0();
                    const int g0 = (o + 1) * HYW + c0, g1 = (o + 1) * HYW + c1;
                    const float w0 = cw[g0], w1 = cw[HYP + g0], w2 = cw[2 * HYP + g0], cb = cbv[g0], v0 = cw[g1], v1 = cw[HYP + g1], v2 = cw[2 * HYP + g1], vb = cbv[g1];
                    const GAS bf16* r0 = UT + (size_t)g0 * M + s0; const GAS bf16* r1 = UT + (size_t)g1 * M + s1;
                    __syncthreads(); conv3_stage(r0, r1, w0, w1, w2, cb, v0, v1, v2, vb, buf, t); __syncthreads();
                    { const int tq = hfft::opaque(t); (void)tq;
#pragma unroll
                    for (int m = 0; m < 32; ++m) { const int n = tq + 512 * m; const float fr = (float)n * (1.0f / 32768.0f); const float cs = __builtin_amdgcn_cosf(fr), sn = __builtin_amdgcn_sinf(fr); const f32x2 g = buf[n];
                        const float a = ar[m], b = ai[m]; const f32x2 e = {__uint_as_float(ep[m] << 16), __uint_as_float(ep[m] & 0xffff0000u)}; const float yr = e.x + (a * cs - b * sn), yi = e.y + (a * sn + b * cs);
                        ar[m] = yr * g.x; ai[m] = yi * g.y; }
                    }
                    if (o == 0) {
                        { const int tq = hfft::opaque(t); (void)tq; GAS f32x2* G0q = G0 + (tq - t);
#pragma unroll
                        for (int m = 0; m < 32; ++m) G0q[m * 512] = (f32x2){ar[m], ai[m]};
                        }
                    } else { GAS bf16* y0 = YT + (size_t)c0 * M + s0; GAS bf16* y1 = YT + (size_t)c1 * M + s1;
                        { const int tq = hfft::opaque(t); (void)tq;
#pragma unroll
                        for (int m = 0; m < 32; ++m) { const int n = tq + 512 * m; y0[n] = f2bf(ar[m]); y1[n] = f2bf(ai[m]); } }
                        }
                    HT1(6);
                }
            }
        }
    }
    __syncthreads();
}

__device__ __forceinline__ void phase_mla_prep(Frame& F, int l) {
    const GAS bf16* CQKV = (const GAS bf16*)(wsq(F) + WS_CQKV); GAS bf16* CQN = (GAS bf16*)(wsq(F) + WS_CQN); GAS bf16* CKVN = (GAS bf16*)(wsq(F) + WS_CKVN); GAS bf16* KPE = (GAS bf16*)(wsq(F) + WS_KPE);
    const GAS float* gq = inp(F, I_QNORM) + l * QR; const GAS float* gkv = inp(F, I_KVNORM) + l * KVR; const GAS float* ct = (const GAS float*)(wsq(F) + WS_COS); const GAS float* st = (const GAS float*)(wsq(F) + WS_SIN);
    const int gw = F.vcu * NWAVES + F.wave, NGW = F.G * NWAVES, lane = F.lane;
    for (int m0 = gw; m0 < M; m0 += 4 * NGW) {
        v2u q[4]; unsigned kv[4]; float x1[4], x2[4], cs[4], sn[4]; const int j = lane & 15;
#pragma unroll
        for (int u = 0; u < 4; ++u) { const int mm = m0 + u * NGW, m = mm < M ? mm : M - 1; const GAS bf16* row = CQKV + (size_t)m * 512; const int tpos = m & (L - 1);
            q[u] = *(const GAS v2u*)(row + 4 * lane); kv[u] = *(const GAS unsigned*)(row + 256 + 2 * lane);
            x1[u] = bf2f(row[384 + j]); x2[u] = bf2f(row[384 + 16 + j]); cs[u] = ct[tpos * 16 + j]; sn[u] = st[tpos * 16 + j]; }
        const f32x4 g4 = *(const GAS f32x4*)(gq + 4 * lane); const f32x2 g2 = *(const GAS f32x2*)(gkv + 2 * lane);
#pragma unroll
        for (int u = 0; u < 4; ++u) { const int m = m0 + u * NGW; if (m >= M) break;
            const float q0 = bf2f(q[u].x & 0xffffu), q1 = bf2f(q[u].x >> 16), q2 = bf2f(q[u].y & 0xffffu), q3 = bf2f(q[u].y >> 16), k0 = bf2f(kv[u] & 0xffffu), k1 = bf2f(kv[u] >> 16);
            const float rq = 1.0f / sqrtf(wave_sum((q0 * q0 + q1 * q1) + (q2 * q2 + q3 * q3)) * (1.0f / QR) + EPS);
            const float rk = 1.0f / sqrtf(wave_sum(k0 * k0 + k1 * k1) * (1.0f / KVR) + EPS);
            v2u oq; oq.x = pk2(q0 * rq * g4.x, q1 * rq * g4.y); oq.y = pk2(q2 * rq * g4.z, q3 * rq * g4.w);
            *(GAS v2u*)(CQN + (size_t)m * QR + 4 * lane) = oq;
            *(GAS unsigned*)(CKVN + (size_t)m * KVR + 2 * lane) = pk2(k0 * rk * g2.x, k1 * rk * g2.y);
            if (lane < 16) { const int p1 = 8 * (j >> 2) + (j & 3); KPE[(size_t)m * ROPE + p1] = f2bf(x1[u] * cs[u] - x2[u] * sn[u]); KPE[(size_t)m * ROPE + p1 + 4] = f2bf(x2[u] * cs[u] + x1[u] * sn[u]); } }
    }
}

__device__ __forceinline__ void phase_hy_out(Frame& F, int l) {
    const GAS bf16* YT = (const GAS bf16*)(wsq(F) + WS_YT); GAS bf16* MIX = (GAS bf16*)(wsq(F) + WS_MIX); const GAS float* gn = inp(F, I_GNHY) + l * HYW;
    LAS bf16* tl = (LAS bf16*)(F.lds + RING_OFF + F.wave * 16384);
    const int gw = F.vcu * NWAVES + F.wave, NGW = F.G * NWAVES, lane = F.lane;
    for (int task = gw; task < 8 * (M / 64); task += NGW) {
        const int g = task & 7, tb = task >> 3, tok0 = tb * 64; const int cl = lane >> 3, t8 = (lane & 7) * 8;
        float v[8][8]; float ss[8]; const int ln_ = hw_lane();
#pragma unroll
        for (int j = 0; j < 8; ++j) ss[j] = 0.f;
#pragma unroll
        for (int i = 0; i < 8; ++i) { const int ch = g * 64 + 8 * i + cl; const v4u w = *(const GAS v4u*)(YT + (size_t)ch * M + tok0 + t8);
            v[i][0] = bf2f(w.x & 0xffffu); v[i][1] = bf2f(w.x >> 16); v[i][2] = bf2f(w.y & 0xffffu); v[i][3] = bf2f(w.y >> 16);
            v[i][4] = bf2f(w.z & 0xffffu); v[i][5] = bf2f(w.z >> 16); v[i][6] = bf2f(w.w & 0xffffu); v[i][7] = bf2f(w.w >> 16);
#pragma unroll
            for (int j = 0; j < 8; ++j) ss[j] += v[i][j] * v[i][j]; }
#pragma unroll
        for (int j = 0; j < 8; ++j) { float s = ss[j]; s += shx(s, ln_, 8); s += shx(s, ln_, 16); s += shx(s, ln_, 32); ss[j] = 1.0f / sqrtf(s * (1.0f / 64.0f) + EPS); }
#pragma unroll
        for (int i = 0; i < 8; ++i) { const int cc = 8 * i + cl; const float gg = gn[g * 64 + cc];
#pragma unroll
            for (int j = 0; j < 8; ++j) tl[(t8 + j) * 72 + cc] = f2bf(v[i][j] * ss[j] * gg); }
        LDS_WAIT(); asm volatile("" ::: "memory");
#pragma unroll
        for (int i = 0; i < 8; ++i) { const int tok = 8 * i + (lane >> 3), c8 = (lane & 7) * 8; const v4u w = *(const LAS v4u*)(tl + tok * 72 + c8);
            *(GAS v4u*)(MIX + (size_t)(tok0 + tok) * D + g * 64 + c8) = w; }
        LDS_WAIT(); asm volatile("" ::: "memory");
    }
}

namespace att {
using s16x4 = __attribute__((ext_vector_type(4))) short;
using f32x16 = __attribute__((ext_vector_type(16))) float;
using u32x4 = __attribute__((ext_vector_type(4))) unsigned;
constexpr int QBLK = 32, KVBLK = 64, NW = 8;
constexpr float SCALE = 0.10206207261596575f;
constexpr float THR = 8.f;
constexpr int SHM_K = KVBLK * 256, SHM_V = KVBLK * DV * 2;
constexpr int NSLOT = 4;
constexpr int OFF_V = 0, OFF_K = NSLOT * SHM_V, OFF_WS = OFF_K + NSLOT * SHM_K, SHM_ATTN = OFF_WS + NW * 64 * 4;
#define KSWZ(row, colB) ((row) * 256 + ((colB) ^ (((row) & 15) << 4)))
#define SBAR() __builtin_amdgcn_sched_barrier(0)
__device__ __forceinline__ int crow(int r, int hi) { return (r & 3) + 8 * (r >> 2) + 4 * hi; }
__device__ __forceinline__ unsigned cvtpk(float lo, float hi) { unsigned r; asm volatile("v_cvt_pk_bf16_f32 %0, %1, %2" : "=v"(r) : "v"(lo), "v"(hi)); return r; }
constexpr float THRL = THR * 1.4426950408889634f;
#define EX2(v) ((ABL & 1) ? (v) : __builtin_amdgcn_exp2f(v))
#define MX3(a, b, c) ((ABL & 128) ? (a) : __builtin_fmaxf(__builtin_fmaxf((a), (b)), (c)))
__device__ __forceinline__ int v_st(int k, int c) { const int kk = k; return ((kk >> 3) * 2 + (c >> 5)) * 512 + ((kk & 7) * 32 + (c & 31)) * 2; }
__device__ __forceinline__ int v_rd_base(int lane) { return ((lane & 3) << 3) | (((lane >> 2) & 3) << 6) | (((lane >> 4) & 1) << 5) | (((lane >> 5) & 1) << 8); }
constexpr int v_rd_off(int d0, int ks, int half) { return d0 * 512 + ks * 2048 + half * 1024; }
template <int OFF> __device__ __forceinline__ s16x4 tr_read(int vb) { s16x4 r; asm volatile("ds_read_b64_tr_b16 %0, %1 offset:%2" : "=&v"(r) : "v"(vb), "i"(OFF) : "memory"); return r; }
template <int ABL, bool FAST> __device__ __forceinline__ bool attn_unit(const bf16* Qb_, const bf16* KNh_, const bf16* KPEb_, const bf16* Vh_, bf16* Mo_,
                                          const float* gain_, const float* ct_, const float* st_, int tpos0, LAS char* lds, const int wave0) {
  const GAS bf16* Qb = (const GAS bf16*)Qb_; const GAS bf16* KNh = (const GAS bf16*)KNh_; const GAS bf16* KPEb = (const GAS bf16*)KPEb_; const GAS bf16* Vh = (const GAS bf16*)Vh_; GAS bf16* Mo = (GAS bf16*)Mo_;
  const GAS float* gain = (const GAS float*)gain_; const GAS float* ct = (const GAS float*)ct_; const GAS float* st = (const GAS float*)st_;

  int tid_ = tid_from_wave(wave0);
  const int tid = tid_, wid = tid >> 6, lane = tid & 63, r32 = lane & 31, hi = lane >> 5;
  LAS char* V_lds = lds + OFF_V; LAS char* K_lds = lds + OFF_K;
  LAS float* ws = (LAS float*)(lds + OFF_WS) + wid * 64; LAS float* li_l = ws; LAS float* al_l = ws + 32;
  volatile LAS unsigned* bad_l = (volatile LAS unsigned*)(lds + SHM_ATTN);
  if (FAST && tid == 0) *bad_l = 0u;
  float m_reg = 0.f, l_reg = 0.f; f32x16 o[2] = {}; f32x16 negm = {}; bf16x8 qr[6];
  const GAS bf16* Qw = Qb + (long)(wid * QBLK + r32) * NQ + hi * 8;
#pragma unroll
  for (int d0 = 0; d0 < 6; ++d0) qr[d0] = *reinterpret_cast<const GAS bf16x8*>(Qw + d0 * 16);
  { const int tq = tpos0 + wid * QBLK + r32;
#pragma unroll
    for (int d0 = 4; d0 < 6; ++d0) { const int fq = 2 * (d0 - 4) + hi; const f32x4 cs = *reinterpret_cast<const GAS f32x4*>(ct + tq * 16 + 4 * fq), sn = *reinterpret_cast<const GAS f32x4*>(st + tq * 16 + 4 * fq);
      const u32x4 w = __builtin_bit_cast(u32x4, qr[d0]);
      const f32x4 x1 = {bf2f(w[0] & 0xffffu), bf2f(w[0] >> 16), bf2f(w[1] & 0xffffu), bf2f(w[1] >> 16)}, x2 = {bf2f(w[2] & 0xffffu), bf2f(w[2] >> 16), bf2f(w[3] & 0xffffu), bf2f(w[3] >> 16)};
      const f32x4 a = x1 * cs - x2 * sn, b = x2 * cs + x1 * sn;
      const u32x4 o4 = {cvtpk(a[0], a[1]), cvtpk(a[2], a[3]), cvtpk(b[0], b[1]), cvtpk(b[2], b[3])}; qr[d0] = __builtin_bit_cast(bf16x8, o4); } }
  { constexpr float C = SCALE * 1.4426950408889634f;
#pragma unroll
    for (int d0 = 0; d0 < 6; ++d0) { const u32x4 w = __builtin_bit_cast(u32x4, qr[d0]); u32x4 o4;
#pragma unroll
      for (int e = 0; e < 4; ++e) o4[e] = cvtpk(bf2f(w[e] & 0xffffu) * C, bf2f(w[e] >> 16) * C);
      qr[d0] = __builtin_bit_cast(bf16x8, o4); } }
  const int vb0 = (int)(unsigned)(uintptr_t)V_lds + v_rd_base(lane);
  const int wid_s = __builtin_amdgcn_readfirstlane(wid);
  const GAS bf16* ksrc[2]; long kstep[2];
#pragma unroll
  for (int q = 0; q < 2; ++q) { const int r = 4 * (2 * wid + q) + (lane >> 4), c = (lane & 15) ^ (r & 15); const bool rope = (c >= 8) && (c < 12);
    ksrc[q] = rope ? KPEb + (long)r * ROPE + (c - 8) * 8 : KNh + (long)r * NKV + (c & 7) * 8; kstep[q] = rope ? (long)KVBLK * ROPE : (long)KVBLK * NKV; }
  const GAS bf16* vsrc; { const int p = 64 * wid + lane, sub = p >> 5, kk = (sub >> 1) * 8 + ((p >> 2) & 7), col = (sub & 1) * 32 + (p & 3) * 8; vsrc = Vh + (long)kk * NKV + col; }
#define DMA(t, slot) do { if (ABL & 32) break; \
    __builtin_amdgcn_global_load_lds((const GAS unsigned*)(ksrc[0] + (long)(t) * kstep[0]), (LAS unsigned*)(K_lds + (slot) * SHM_K + (2 * wid_s) * 1024), 16, 0, 0); \
    __builtin_amdgcn_global_load_lds((const GAS unsigned*)(ksrc[1] + (long)(t) * kstep[1]), (LAS unsigned*)(K_lds + (slot) * SHM_K + (2 * wid_s + 1) * 1024), 16, 0, 0); \
    __builtin_amdgcn_global_load_lds((const GAS unsigned*)(vsrc + (long)(t) * ((long)KVBLK * NKV)), (LAS unsigned*)(V_lds + (slot) * SHM_V + wid_s * 1024), 16, 0, 0); } while (0)
#define TBAR(N) do { asm volatile("s_waitcnt vmcnt(" #N ") lgkmcnt(0)" ::: "memory"); if (!(ABL & 64)) __builtin_amdgcn_s_barrier(); asm volatile("" ::: "memory"); } while (0)
#define RESC(a) do { if (__any((a) < 1.f)) { if (hi == 0) al_l[r32] = (a); asm volatile("s_waitcnt lgkmcnt(0)" ::: "memory"); \
    _Pragma("unroll") for (int d = 0; d < 2; ++d) _Pragma("unroll") for (int r = 0; r < 16; ++r) o[d][r] *= al_l[crow(r, hi)]; } } while (0)
  f32x16 pA0, pA1, pB0, pB1; bf16x8 pa0, pa1, pa2, pa3; constexpr int NTL = L / KVBLK; constexpr int SE = 0, SO = 1;
  int koff[6];
#pragma unroll
  for (int d0 = 0; d0 < 6; ++d0) koff[d0] = KSWZ(r32, (d0 * 16 + hi * 8) * 2);
  s16x4 vl[4], vh[4]; float pmax = 0.f, alpha = 1.f;
#define KFR(i) ((ABL & 8) ? qr[(i) >> 1] : *(const LAS bf16x8*)(kbase + koff[(i) >> 1] + ((i) & 1) * 8192))
#define MQK(a_, b_, c_) ((ABL & 2) ? (c_) : __builtin_amdgcn_mfma_f32_32x32x16_bf16(a_, b_, c_, 0, 0, 0))
#define MPV(a_, b_, c_) ((ABL & 4) ? (c_) : __builtin_amdgcn_mfma_f32_32x32x16_bf16(a_, b_, c_, 0, 0, 0))
#define VRD8(D0) do { if (ABL & 16) break; vl[0] = tr_read<v_rd_off(D0, 0, 0)>(vbq); vh[0] = tr_read<v_rd_off(D0, 0, 1)>(vbq); vl[1] = tr_read<v_rd_off(D0, 1, 0)>(vbq); vh[1] = tr_read<v_rd_off(D0, 1, 1)>(vbq); \
    vl[2] = tr_read<v_rd_off(D0, 2, 0)>(vbq); vh[2] = tr_read<v_rd_off(D0, 2, 1)>(vbq); vl[3] = tr_read<v_rd_off(D0, 3, 0)>(vbq); vh[3] = tr_read<v_rd_off(D0, 3, 1)>(vbq); } while (0)
#define VWAIT() if (!(ABL & 16)) asm volatile("s_waitcnt lgkmcnt(0)" : "+v"(vl[0]), "+v"(vh[0]), "+v"(vl[1]), "+v"(vh[1]), "+v"(vl[2]), "+v"(vh[2]), "+v"(vl[3]), "+v"(vh[3]) :: "memory")
#define VFR(k) (bf16x8){vl[k][0], vl[k][1], vl[k][2], vl[k][3], vh[k][0], vh[k][1], vh[k][2], vh[k][3]}
#define PKA(P, B) do { if (ABL & 256) break; w0_ = cvtpk(P[B + 0], P[B + 1]); w1_ = cvtpk(P[B + 2], P[B + 3]); } while (0)
#define PKB(P, B, OUT) do { if (ABL & 256) { OUT = qr[0]; break; } const u32x4 w_ = {w0_, w1_, cvtpk(P[B + 4], P[B + 5]), cvtpk(P[B + 6], P[B + 7])}; OUT = __builtin_bit_cast(bf16x8, w_); } while (0)
#define R1(DO_QK, DO_FIN, X0, X1, Y0, Y1, KSLOT) do { const LAS char* kbase = K_lds + (KSLOT) * SHM_K; bf16x8 kf0, kf1, kf2, kf3; unsigned w0_ = 0, w1_ = 0; \
    if (DO_QK) { kf0 = KFR(0); kf1 = KFR(1); kf2 = KFR(2); } SBAR(); \
      if (DO_QK) { kf3 = KFR(3); X0 = MQK(kf0, qr[0], negm); } if (DO_FIN) { Y0[0] = EX2(Y0[0]); Y0[1] = EX2(Y0[1]); Y0[2] = EX2(Y0[2]); Y0[3] = EX2(Y0[3]); } SBAR(); \
      if (DO_QK) { kf0 = KFR(4); X1 = MQK(kf1, qr[0], negm); } if (DO_FIN) { Y0[4] = EX2(Y0[4]); Y0[5] = EX2(Y0[5]); Y0[6] = EX2(Y0[6]); Y0[7] = EX2(Y0[7]); } SBAR(); \
      if (DO_QK) { kf1 = KFR(5); X0 = MQK(kf2, qr[1], X0); } if (DO_FIN) { Y0[8] = EX2(Y0[8]); Y0[9] = EX2(Y0[9]); Y0[10] = EX2(Y0[10]); Y0[11] = EX2(Y0[11]); } SBAR(); \
      if (DO_QK) { kf2 = KFR(6); X1 = MQK(kf3, qr[1], X1); } if (DO_FIN) { Y0[12] = EX2(Y0[12]); Y0[13] = EX2(Y0[13]); Y0[14] = EX2(Y0[14]); Y0[15] = EX2(Y0[15]); } SBAR(); \
      if (DO_QK) { kf3 = KFR(7); X0 = MQK(kf0, qr[2], X0); } if (DO_FIN) { Y1[0] = EX2(Y1[0]); Y1[1] = EX2(Y1[1]); Y1[2] = EX2(Y1[2]); Y1[3] = EX2(Y1[3]); PKA(Y0, 0); } SBAR(); \
      if (DO_QK) { kf0 = KFR(8); X1 = MQK(kf1, qr[2], X1); } if (DO_FIN) { Y1[4] = EX2(Y1[4]); Y1[5] = EX2(Y1[5]); Y1[6] = EX2(Y1[6]); Y1[7] = EX2(Y1[7]); PKB(Y0, 0, pa0); } SBAR(); \
      if (DO_QK) { kf1 = KFR(9); X0 = MQK(kf2, qr[3], X0); } if (DO_FIN) { Y1[8] = EX2(Y1[8]); Y1[9] = EX2(Y1[9]); Y1[10] = EX2(Y1[10]); Y1[11] = EX2(Y1[11]); PKA(Y0, 8); } SBAR(); \
      if (DO_QK) { kf2 = KFR(10); X1 = MQK(kf3, qr[3], X1); } if (DO_FIN) { Y1[12] = EX2(Y1[12]); Y1[13] = EX2(Y1[13]); Y1[14] = EX2(Y1[14]); Y1[15] = EX2(Y1[15]); PKB(Y0, 8, pa1); } SBAR(); \
      if (DO_QK) { kf3 = KFR(11); X0 = MQK(kf0, qr[4], X0); } if (DO_FIN) { PKA(Y1, 0); } SBAR(); \
      if (DO_QK) { X1 = MQK(kf1, qr[4], X1); } if (DO_FIN) { PKB(Y1, 0, pa2); } SBAR(); \
      if (DO_QK) { X0 = MQK(kf2, qr[5], X0); } if (DO_FIN) { PKA(Y1, 8); } SBAR(); \
      if (DO_QK) { X1 = MQK(kf3, qr[5], X1); } if (DO_FIN) { PKB(Y1, 8, pa3); } SBAR(); \
  } while (0)
#define R2(DO_PV, DO_MAX, X0, X1, Y0, Y1, VSLOT, LOADS) do { const int vbq = vb0 + (VSLOT) * SHM_V; float ma_ = 0.f, mb_ = 0.f, sa_ = 0.f; \
    if (DO_PV) { VRD8(0); } SBAR(); \
    if (DO_PV) { VWAIT(); o[0] = MPV(pa0, VFR(0), o[0]); if (!(ABL & 640)) sa_ = (Y0[0] + Y0[1]) + (Y0[2] + Y0[3]); } SBAR(); \
    if (DO_PV) { o[0] = MPV(pa1, VFR(1), o[0]); if (!(ABL & 640)) sa_ += Y0[4]; if (!(ABL & 640)) sa_ += Y0[5]; if (!(ABL & 640)) sa_ += Y0[6]; if (!(ABL & 640)) sa_ += Y0[7]; } LOADS; SBAR(); \
    if (DO_PV) { o[0] = MPV(pa2, VFR(2), o[0]); if (!(ABL & 640)) sa_ += Y0[8]; if (!(ABL & 640)) sa_ += Y0[9]; if (!(ABL & 640)) sa_ += Y0[10]; if (!(ABL & 640)) sa_ += Y0[11]; } SBAR(); \
    if (DO_PV) { o[0] = MPV(pa3, VFR(3), o[0]); if (!(ABL & 640)) sa_ += Y0[12]; if (!(ABL & 640)) sa_ += Y0[13]; if (!(ABL & 640)) sa_ += Y0[14]; if (!(ABL & 640)) sa_ += Y0[15]; } SBAR(); \
    if (DO_PV) { VRD8(1); if (!(ABL & 640)) sa_ += Y1[0]; if (!(ABL & 640)) sa_ += Y1[1]; if (!(ABL & 640)) sa_ += Y1[2]; if (!(ABL & 640)) sa_ += Y1[3]; if (!(ABL & 640)) sa_ += Y1[4]; if (!(ABL & 640)) sa_ += Y1[5]; if (!(ABL & 640)) sa_ += Y1[6]; if (!(ABL & 640)) sa_ += Y1[7]; } \
    if (DO_MAX) { ma_ = MX3(X0[0], X0[1], X1[0]); mb_ = MX3(X0[2], X0[3], X1[1]); ma_ = MX3(ma_, X1[2], X1[3]); ma_ = MX3(ma_, X0[4], X0[5]); mb_ = MX3(mb_, X0[6], X0[7]); ma_ = MX3(ma_, X1[4], X1[5]); mb_ = MX3(mb_, X1[6], X1[7]); } SBAR(); \
    if (DO_PV) { VWAIT(); o[1] = MPV(pa0, VFR(0), o[1]); if (!(ABL & 640)) sa_ += Y1[8]; if (!(ABL & 640)) sa_ += Y1[9]; if (!(ABL & 640)) sa_ += Y1[10]; if (!(ABL & 640)) sa_ += Y1[11]; } if (DO_MAX) { ma_ = MX3(ma_, X0[8], X0[9]); mb_ = MX3(mb_, X0[10], X0[11]); } SBAR(); \
    if (DO_PV) { o[1] = MPV(pa1, VFR(1), o[1]); if (!(ABL & 640)) sa_ += Y1[12]; if (!(ABL & 640)) sa_ += Y1[13]; if (!(ABL & 640)) sa_ += Y1[14]; if (!(ABL & 640)) sa_ += Y1[15]; } if (DO_MAX) { ma_ = MX3(ma_, X1[8], X1[9]); mb_ = MX3(mb_, X1[10], X1[11]); } SBAR(); \
    if (DO_PV) { o[1] = MPV(pa2, VFR(2), o[1]); l_reg += sa_; if (ABL & 512) { o[0] = MPV(pa0, qr[0], o[0]); o[0] = MPV(pa1, qr[0], o[0]); } } if (DO_MAX) { ma_ = MX3(ma_, X0[12], X0[13]); mb_ = MX3(mb_, X0[14], X0[15]); ma_ = MX3(ma_, X1[12], X1[13]); mb_ = MX3(mb_, X1[14], X1[15]); } SBAR(); \
    if (DO_PV) { o[1] = MPV(pa3, VFR(3), o[1]); if (ABL & 512) { o[0] = MPV(pa2, qr[0], o[0]); o[0] = MPV(pa3, qr[0], o[0]); } } if (DO_MAX) { float m_ = __builtin_fmaxf(ma_, mb_); auto rr_ = __builtin_amdgcn_permlane32_swap(__float_as_uint(m_), __float_as_uint(m_), false, false); pmax = __builtin_fmaxf(__uint_as_float(rr_[0]), __uint_as_float(rr_[1])); } SBAR(); \
  } while (0)
#define DECIDE(FIRST, X0, X1) do { alpha = 1.f; \
    if ((FIRST) || !__builtin_expect(__all(pmax <= THRL), 1)) { const float d_ = (FIRST) ? pmax : __builtin_fmaxf(pmax, 0.f); m_reg += d_; if (!(FIRST)) alpha = EX2(-d_); \
      _Pragma("unroll") for (int r = 0; r < 16; ++r) { X0[r] -= d_; X1[r] -= d_; } \
      _Pragma("unroll") for (int r = 0; r < 16; ++r) negm[r] = -m_reg; l_reg *= alpha; } \
    RESC(alpha); } while (0)
  DMA(0, 0); DMA(1, 1);
  TBAR(3);
  R1(true, false, pA0, pA1, pB0, pB1, 0);
  R2(false, true, pA0, pA1, pB0, pB1, 0, DMA(2, 2));
  DECIDE(true, pA0, pA1);
  TBAR(3);
  for (int j = 1; j + 1 < NTL; j += 2) {
    R1(true, true, pB0, pB1, pA0, pA1, j & 3);
    R2(true, !FAST, pB0, pB1, pA0, pA1, (j - 1) & 3, DMA(j + 2, (j + 2) & 3));
    if (!FAST) DECIDE(false, pB0, pB1);
    TBAR(3);
    R1(true, true, pA0, pA1, pB0, pB1, (j + 1) & 3);
    R2(true, !FAST, pA0, pA1, pB0, pB1, j & 3, if (j + 3 < NTL) DMA(j + 3, (j + 3) & 3));
    if (!FAST) DECIDE(false, pA0, pA1);
    if (j + 3 < NTL) TBAR(3); else TBAR(0);
  }
  R1(true, true, pB0, pB1, pA0, pA1, (NTL - 1) & 3);
  R2(true, !FAST, pB0, pB1, pA0, pA1, (NTL - 2) & 3, (void)0);
  if (!FAST) DECIDE(false, pB0, pB1);
  R1(false, true, pA0, pA1, pB0, pB1, 0);
  R2(true, false, pA0, pA1, pB0, pB1, (NTL - 1) & 3, (void)0);
#undef DECIDE
#undef R2
#undef R1
#undef PKA
#undef PKB
#undef VFR
#undef VWAIT
#undef VRD8
#undef KFR
  if (FAST) {
    if (__any(!(l_reg < 1.0e30f)) && lane == 0) *bad_l = 1u;
    __syncthreads();
    const unsigned bad = *bad_l;
    if (__builtin_amdgcn_readfirstlane((int)bad) != 0) { __syncthreads(); return false; }
  }
  { auto rr = __builtin_amdgcn_permlane32_swap(__float_as_uint(l_reg), __float_as_uint(l_reg), false, false); l_reg = __uint_as_float(rr[0]) + __uint_as_float(rr[1]); }
  if (hi == 0) li_l[r32] = l_reg; asm volatile("s_waitcnt lgkmcnt(0)" ::: "memory");
  const float g0 = gain[r32], g1 = gain[32 + r32]; const int ln_ = hw_lane();
  GAS bf16* Ow = Mo + (long)(wid * QBLK) * D;
#pragma unroll
  for (int r = 0; r < 16; ++r) { const int orow = crow(r, hi); const float rl = __builtin_amdgcn_rcpf(li_l[orow]);
    const float y0 = o[0][r] * rl, y1 = o[1][r] * rl; float s = y0 * y0 + y1 * y1;
    s += shx(s, ln_, 1); s += shx(s, ln_, 2); s += shx(s, ln_, 4); s += shx(s, ln_, 8); s += shx(s, ln_, 16);
    const float rs = 1.0f / sqrtf(s * (1.0f / 64.0f) + EPS);
    Ow[(long)orow * D + r32] = f2bf(y0 * rs * g0); Ow[(long)orow * D + 32 + r32] = f2bf(y1 * rs * g1); }
  __syncthreads();
  return true;
#undef DMA
#undef TBAR
#undef RESC
}
#undef EX2
#undef MX3
#undef KSWZ
#undef SBAR
}
#define XB_TMO      128
#define XB_XCNT(j)  (256  + 64 * (j))
#define XB_XSUB(j)  (1280 + 64 * (j))
#define XB_XGEN(j)  (2304 + 64 * (j))
#define XB_TOP      3328
#define XB_TOPGEN   3392
#define XCD_BAR_WORDS 3456
#define XB_SPIN_CAP (1u << 18)

__device__ __forceinline__ unsigned xb_ld(unsigned* p)              { return __hip_atomic_load(p, __ATOMIC_RELAXED, __HIP_MEMORY_SCOPE_AGENT); }
__device__ __forceinline__ unsigned xb_add(unsigned* p, unsigned v) { return __hip_atomic_fetch_add(p, v, __ATOMIC_RELAXED, __HIP_MEMORY_SCOPE_AGENT); }
__device__ __forceinline__ unsigned xb_xcc_id() { return (unsigned)__builtin_amdgcn_s_getreg((3 << 11) | 20) & 0xFu; }
#define XB_SPIN(cond, bar) do { unsigned _sp = 0; while (cond) { __builtin_amdgcn_s_sleep(1); \
    if ((++_sp & 255u) == 0u) { if (xb_ld(&(bar)[XB_TMO])) break; if (_sp > XB_SPIN_CAP) { atomicAdd(&(bar)[XB_TMO], 1u); break; } } } } while (0)

struct XcdBarrier {
    unsigned* bar; unsigned x;
    volatile LAS unsigned* st;
};

__device__ __forceinline__ XcdBarrier xcd_barrier_post(unsigned* bar, volatile LAS unsigned* st, const bool t0) {
    XcdBarrier b; b.bar = bar; b.x = xb_xcc_id(); b.st = st;
    if (t0) (void)xb_add(&bar[XB_XCNT(b.x)], 1u);
    return b;
}
__device__ __forceinline__ void xcd_barrier_complete(unsigned* bar, unsigned x, unsigned& nloc, unsigned& nx) {
    const unsigned G = gridDim.x * gridDim.y * gridDim.z;
    unsigned sum, cnt, mine, sp = 0u;
    for (;;) {
        sum = 0u; cnt = 0u; mine = 0u;
#pragma unroll
        for (unsigned j = 0; j < 16; ++j) { const unsigned c = xb_ld(&bar[XB_XCNT(j)]); sum += c; cnt += (c > 0u) ? 1u : 0u; mine = (j == x) ? c : mine; }
        if (sum == G) break;
        __builtin_amdgcn_s_sleep(1);
        if ((++sp & 255u) == 0u) { if (xb_ld(&bar[XB_TMO])) break; if (sp > XB_SPIN_CAP) { atomicAdd(&bar[XB_TMO], 1u); break; } }
    }
    nloc = mine > 0u ? mine : 1u; nx = cnt > 0u ? cnt : 1u;
}

__device__ __forceinline__ void xcd_barrier(const XcdBarrier& b, const bool t0) {
    asm volatile("s_waitcnt vmcnt(0)" ::: "memory");
    __syncthreads();
    if (t0) {
        unsigned* bar = b.bar;
        __builtin_amdgcn_s_waitcnt(0);
        unsigned nloc = b.st[0], nx = b.st[1];
        if (nloc == 0u) { xcd_barrier_complete(bar, b.x, nloc, nx); b.st[0] = nloc; b.st[1] = nx; }
        const unsigned old = xb_add(&bar[XB_XSUB(b.x)], 1u);
        const unsigned gen = old / nloc;
        if (old + 1u == (gen + 1u) * nloc) {
            __builtin_amdgcn_fence(__ATOMIC_RELEASE, "agent");
            asm volatile("s_waitcnt vmcnt(0)" ::: "memory");
            const unsigned og = xb_add(&bar[XB_TOP], 1u);
            const unsigned tg = og / nx;
            if (og + 1u == (tg + 1u) * nx) xb_add(&bar[XB_TOPGEN], 1u);
            else XB_SPIN(xb_ld(&bar[XB_TOPGEN]) == tg, bar);
            __builtin_amdgcn_fence(__ATOMIC_ACQUIRE, "agent");
            xb_add(&bar[XB_XGEN(b.x)], 1u);
            asm volatile("s_waitcnt vmcnt(0)" ::: "memory");
        } else {
            XB_SPIN(xb_ld(&bar[XB_XGEN(b.x)]) == gen, bar);
            __builtin_amdgcn_fence(__ATOMIC_ACQUIRE, "agent");
            asm volatile("s_waitcnt vmcnt(0)" ::: "memory");
        }
    }
    __syncthreads();
}

__device__ __forceinline__ void xcd_barrier_fast(const XcdBarrier& b, const bool t0) {
    asm volatile("s_waitcnt vmcnt(0)" ::: "memory");
    __syncthreads();
    if (t0) {
        unsigned* bar = b.bar; asm volatile("" : "+s"(bar));
        __builtin_amdgcn_s_waitcnt(0);
        unsigned nloc = b.st[0], nx = b.st[1];
        unsigned bx_ = b.x; asm volatile("" : "+s"(bx_));
        const unsigned old = xb_add(&bar[XB_XSUB(bx_)], 1u);
        const unsigned gen = old / nloc;
        if (old + 1u == (gen + 1u) * nloc) {
            __builtin_amdgcn_fence(__ATOMIC_RELEASE, "agent");
            asm volatile("s_waitcnt vmcnt(0)" ::: "memory");
            const unsigned og = xb_add(&bar[XB_TOP], 1u);
            const unsigned tg = og / nx;
            if (og + 1u == (tg + 1u) * nx) xb_add(&bar[XB_TOPGEN], 1u);
            else XB_SPIN(xb_ld(&bar[XB_TOPGEN]) == tg, bar);
            __builtin_amdgcn_fence(__ATOMIC_ACQUIRE, "agent");
            xb_add(&bar[XB_XGEN(bx_)], 1u);
            asm volatile("s_waitcnt vmcnt(0)" ::: "memory");
        } else {
            XB_SPIN(xb_ld(&bar[XB_XGEN(bx_)]) == gen, bar);
            __builtin_amdgcn_fence(__ATOMIC_ACQUIRE, "agent");
            asm volatile("s_waitcnt vmcnt(0)" ::: "memory");
        }
    }
    __syncthreads();
}

constexpr int CW_BAR = 4096;
struct Args { const float* in[26]; float* out; unsigned char* ws; };
#ifndef REP_ATT
#define REP_ATT 1
#endif
#ifndef REP_GEMM
#define REP_GEMM 1
#endif
#ifndef REP_HY
#define REP_HY 1
#endif
#ifndef REP_FILT
#define REP_FILT 1
#endif
#ifndef REP_PREP
#define REP_PREP 1
#endif
#ifndef REP_HYOUT
#define REP_HYOUT 1
#endif
#ifndef REP_MISC
#define REP_MISC 1
#endif
#ifndef PROBE_MASK
#define PROBE_MASK 0
#endif
#define TIC() do { if (PROBE_MASK) pr_t0 = __builtin_amdgcn_s_memrealtime(); } while (0)
#define TOC(ph) do { if (PROBE_MASK & (1u << (ph))) pr_acc += __builtin_amdgcn_s_memrealtime() - pr_t0; } while (0)
#define REPEAT(n) _Pragma("unroll 1") for (int rep_ = 0; rep_ < (n); ++rep_)
#define REFRESH() do { const int t_ = tid_from_wave(F.wave0); F.tid = t_; F.lane = t_ & 63; F.wave = __builtin_amdgcn_readfirstlane(t_ >> 6); int v_ = F.vcu; asm volatile("" : "+s"(v_)); F.vcu = v_; } while (0)
#define BXQ() ({ int b_ = (int)blockIdx.x; asm volatile("" : "+s"(b_)); b_; })
#define GEMM_PHASE(EPI, g, S, E) REPEAT(REP_GEMM) pg8::gemm_phase<EPI, pg8::StaticOrder, true, true>(F.lds + RING_OFF, g, S, E, F.wave0)

__global__ void __launch_bounds__(NTHR, 2) hyena_mla_fwd(Args args) {
    extern __shared__ __attribute__((aligned(16))) unsigned char lds[];
    Frame F;
    F.lds = (LAS unsigned char*)lds;
    F.MISC = (volatile LAS unsigned*)(F.lds + MISC_OFF);
    F.tid = threadIdx.x; F.lane = F.tid & 63; F.wave = __builtin_amdgcn_readfirstlane(F.tid >> 6); F.wave0 = F.wave;
    F.G = gridDim.x; { const int bx = blockIdx.x; F.vcu = (F.G % 8 == 0) ? (bx % 8) * (F.G / 8) + bx / 8 : bx; }
    F.ws = args.ws; F.out = args.out; F.ctl = (gu32*)(args.ws + WS_CTL);
    if (F.tid == 0) {
#pragma unroll
        for (int i = 0; i < 26; ++i) *(LAS unsigned long long*)(F.lds + PTRTAB_OFF + 8 * i) = (unsigned long long)args.in[i];
    }
    for (int u = F.tid; u < 512 / 4; u += NTHR) ((LAS unsigned*)(F.lds + LDSCTL_OFF))[u] = 0u;
    __syncthreads();
    XcdBarrier bar = xcd_barrier_post((unsigned*)(F.ctl + CW_BAR), F.MISC + 8, F.tid == 0);
    xcd_barrier(bar, F.tid == 0);
    unsigned long long pr_t0 = 0, pr_acc = 0; (void)pr_t0;
#pragma unroll 1
    for (int l = 0; l < DEPTH; ++l) {
        TIC();
        HT0(); REPEAT(REP_MISC) { REFRESH(); phase_weights(F, l); }
        __syncthreads(); HT1(21); HT0();
        REFRESH(); phase_filter_mlp(F, l); HT1(22); HT0();
        if (l == 0) { REFRESH(); phase_rope_tab(F); REFRESH(); phase_norm_first(F, 0, inp(F, I_NMIXPRE)); } HT1(23);
        { REFRESH(); xcd_barrier_fast(bar, F.tid == 0); } TOC(0); TIC();
        { unsigned char* w = (unsigned char*)wsq(F); pg8::Gemm g{(bf16*)(w + WS_W3T), (bf16*)(w + WS_H2), 2048, L, 128}; pg8::StaticOrder S; S.init(2048, L, F.G, BXQ());
          pg8::EpiTaps E{(float*)(w + WS_KT), (const float*)inp(F, I_DECAY) + (size_t)l * 2048}; GEMM_PHASE(pg8::EpiTaps, g, S, E); }
        { REFRESH(); xcd_barrier_fast(bar, F.tid == 0); } TOC(1); TIC();
        REPEAT(REP_FILT) { REFRESH(); phase_filter_fft(F, l); }
        { REFRESH(); xcd_barrier_fast(bar, F.tid == 0); } TOC(2); TIC();
        { unsigned char* w = (unsigned char*)wsq(F); bf16* WinT = (bf16*)(w + WS_WIN); bf16* XN = (bf16*)(w + WS_XN); bf16* UT = (bf16*)(w + WS_UT); bf16* CQKV = (bf16*)(w + WS_CQKV);
          { pg8::Gemm g{WinT, XN, HYP, M, D}; pg8::StaticOrder S; S.init(HYP, M, F.G, BXQ());
          pg8::EpiBf16<0> E{UT, M, nullptr, 0, 0, 1.f}; GEMM_PHASE(pg8::EpiBf16<0>, g, S, E); }
        { pg8::Gemm g{XN, WinT + (size_t)HYP * D, M, 512, D}; pg8::StaticOrder S; S.init(M, 512, F.G, (BXQ() + 128) % F.G);
          pg8::EpiBf16<0> E{CQKV, 512, nullptr, 0, 0, 1.f}; GEMM_PHASE(pg8::EpiBf16<0>, g, S, E); } }
        { REFRESH(); xcd_barrier_fast(bar, F.tid == 0); } TOC(3); TIC();
        REPEAT(REP_PREP) { REFRESH(); phase_mla_prep(F, l); }
        HT0(); REPEAT(REP_HY) { REFRESH(); phase_hyena(F, l); } HT1(40);
        { REFRESH(); xcd_barrier_fast(bar, F.tid == 0); } TOC(4); TIC();
        { unsigned char* w = (unsigned char*)wsq(F); bf16* CQN = (bf16*)(w + WS_CQN); bf16* CKVN = (bf16*)(w + WS_CKVN); bf16* WuqT = (bf16*)(w + WS_WUQ); bf16* WukvT = (bf16*)(w + WS_WUKV);
          bf16* Qb = (bf16*)(w + WS_Q); bf16* KV = (bf16*)(w + WS_KN);
          { pg8::Gemm g{CQN, WuqT, M, NQ, QR}; pg8::StaticOrder S; S.init(M, NQ, F.G, BXQ());
          pg8::EpiBf16<0> E{Qb, NQ, nullptr, 0, 0, 1.f}; GEMM_PHASE(pg8::EpiBf16<0>, g, S, E); }
        { pg8::Gemm g{CKVN, WukvT, M, NKV, KVR}; pg8::StaticOrder S; S.init(M, NKV, F.G, BXQ());
          pg8::EpiBf16<0> E{KV, NKV, nullptr, 0, 0, 1.f}; GEMM_PHASE(pg8::EpiBf16<0>, g, S, E); } }
        { REFRESH(); xcd_barrier_fast(bar, F.tid == 0); } TOC(5); TIC();
        REFRESH();
        HT0();
        { unsigned char* w = (unsigned char*)wsq(F); bf16* Qb = (bf16*)(w + WS_Q); bf16* KV = (bf16*)(w + WS_KN); bf16* KPE = (bf16*)(w + WS_KPE); bf16* MIX = (bf16*)(w + WS_MIX);
          const float* ct = (const float*)(w + WS_COS); const float* st = (const float*)(w + WS_SIN); const float* gat = (const float*)inp(F, I_GNAT) + l * 512;
        REPEAT(REP_ATT) for (int i = 0; i < (F.G == 256 ? 6 : (1536 - F.vcu + F.G - 1) / F.G); ++i) {
            const int u_ = F.vcu + i * F.G; const int bh = F.G == 256 ? 3 * (F.vcu >> 5) + (i >> 1) : u_ >> 6, qb = F.G == 256 ? (i & 1) * 32 + (F.vcu & 31) : u_ & 63; const int b = bh >> 3, h = bh & 7;
            const size_t row0 = (size_t)b * L + (size_t)qb * 256;
            if (!att::attn_unit<0, true>(Qb + row0 * NQ + h * DQ, KV + (size_t)b * L * NKV + h * 128, KPE + (size_t)b * L * ROPE, KV + (size_t)b * L * NKV + h * 128 + 64,
                           MIX + row0 * D + 512 + h * 64, gat + h * 64, ct, st, qb * 256, (LAS char*)(F.lds + RING_OFF), F.wave0))
                (void)att::attn_unit<0, false>(Qb + row0 * NQ + h * DQ, KV + (size_t)b * L * NKV + h * 128, KPE + (size_t)b * L * ROPE, KV + (size_t)b * L * NKV + h * 128 + 64,
                           MIX + row0 * D + 512 + h * 64, gat + h * 64, ct, st, qb * 256, (LAS char*)(F.lds + RING_OFF), F.wave0);
        } }
        HT1(32); HT0(); REPEAT(REP_HYOUT) { REFRESH(); phase_hy_out(F, l); } HT1(31);
        { REFRESH(); xcd_barrier_fast(bar, F.tid == 0); } TOC(6); TIC();
        { unsigned char* w = (unsigned char*)wsq(F); bf16* MIX = (bf16*)(w + WS_MIX); bf16* WoutT = (bf16*)(w + WS_WOUT); bf16* T = (bf16*)(w + WS_T);
          pg8::Gemm g{MIX, WoutT, M, D, D}; pg8::StaticOrder S; S.init(M, D, F.G, BXQ());
          pg8::EpiBf16<0> E{T, D, nullptr, 0, 0, 1.f}; GEMM_PHASE(pg8::EpiBf16<0>, g, S, E); }
        { REFRESH(); xcd_barrier_fast(bar, F.tid == 0); } TOC(7); TIC();
        REFRESH(); if (l == 0) phase_norm_res<true, false>(F, (const GAS bf16*)(wsq(F) + WS_T), inp(F, I_NMIXPOST) + l * D, inp(F, I_NMLPPRE) + l * D);
        else phase_norm_res<false, false>(F, (const GAS bf16*)(wsq(F) + WS_T), inp(F, I_NMIXPOST) + l * D, inp(F, I_NMLPPRE) + l * D);
        { REFRESH(); xcd_barrier_fast(bar, F.tid == 0); } TOC(8); TIC();
#pragma unroll 1
        for (int ch = 0; ch < N_MLP_CHUNKS; ++ch) {
            { unsigned char* w = (unsigned char*)wsq(F); bf16* XN = (bf16*)(w + WS_XN); bf16* WupT = (bf16*)(w + WS_WUP); bf16* Hb = (bf16*)(w + WS_H);
              pg8::Gemm g{XN + (size_t)ch * MLP_CHUNK * D, WupT, MLP_CHUNK, FF, D}; pg8::StaticOrder S; S.init(MLP_CHUNK, FF, F.G, BXQ());
              pg8::EpiRelu2 E{Hb, FF}; GEMM_PHASE(pg8::EpiRelu2, g, S, E); }
            { REFRESH(); xcd_barrier_fast(bar, F.tid == 0); } TOC(9); TIC();
            { unsigned char* w = (unsigned char*)wsq(F); bf16* Hb = (bf16*)(w + WS_H); bf16* WdownT = (bf16*)(w + WS_WDOWN); bf16* T = (bf16*)(w + WS_T);
              pg8::Gemm g{Hb, WdownT, MLP_CHUNK, D, FF}; pg8::StaticOrder S; S.init(MLP_CHUNK, D, F.G, BXQ());
              pg8::EpiBf16<0> E{T + (size_t)ch * MLP_CHUNK * D, D, nullptr, 0, 0, 1.f}; GEMM_PHASE(pg8::EpiBf16<0>, g, S, E); }
            { REFRESH(); xcd_barrier_fast(bar, F.tid == 0); } TOC(10); TIC();
        }
        REFRESH(); if (l + 1 < DEPTH) phase_norm_res<false, false>(F, (const GAS bf16*)(wsq(F) + WS_T), inp(F, I_NMLPPOST) + l * D, inp(F, I_NMIXPRE) + (l + 1) * D);
        else phase_norm_res<false, true>(F, (const GAS bf16*)(wsq(F) + WS_T), inp(F, I_NMLPPOST) + l * D, (const GAS float*)nullptr);
        { REFRESH(); xcd_barrier_fast(bar, F.tid == 0); } TOC(11); TIC();
    }
    if (HYSUB) { __syncthreads(); pr_acc += (unsigned long long)__builtin_amdgcn_readfirstlane((int)F.MISC[21]); }
    if (PROBE_MASK || HYSUB) { const unsigned long long ts = __builtin_amdgcn_s_memrealtime(); while (__builtin_amdgcn_s_memrealtime() - ts < pr_acc) __builtin_amdgcn_s_sleep(8); }
}


#ifdef ATT_BENCH
#ifndef ATT_BENCH_FAST
#define ATT_BENCH_FAST 0
#endif
__global__ void __launch_bounds__(NTHR, 2) attn_bench(Args args) {
    extern __shared__ __attribute__((aligned(16))) unsigned char lds[];
    unsigned char* w = args.ws; const int wave0 = __builtin_amdgcn_readfirstlane(threadIdx.x >> 6);
    const int G = gridDim.x, bxv = (int)blockIdx.x, vcu = (bxv % 8) * (G / 8) + bxv / 8;
    bf16* Qb = (bf16*)(w + WS_Q); bf16* KV = (bf16*)(w + WS_KN); bf16* KPE = (bf16*)(w + WS_KPE); bf16* OUT = (bf16*)(w + WS_H);
    const float* ct = (const float*)(w + WS_COS); const float* st = (const float*)(w + WS_SIN);
    for (int rep = 0; rep < ATT_BENCH_REPS; ++rep)
    for (int i = 0; i < 6; ++i) {
        const int bh = 3 * (vcu >> 5) + (i >> 1), qb = (i & 1) * 32 + (vcu & 31); const int b = bh >> 3, h = bh & 7;
        const size_t row0 = (size_t)b * L + (size_t)qb * 256;
        (void)att::attn_unit<ATT_BENCH, (ATT_BENCH_FAST != 0)>(Qb + row0 * NQ + h * DQ, KV + (size_t)b * L * NKV + h * 128, KPE + (size_t)b * L * ROPE, KV + (size_t)b * L * NKV + h * 128 + 64,
                       OUT + row0 * D + 512 + h * 64, args.in[I_GNAT] + h * 64, ct, st, qb * 256, (LAS char*)lds, wave0);
    }
}
#endif
extern "C" void kernel_launch(void* const* d_in, const int* in_sizes, int n_in, void* d_out, int out_size, void* d_ws, size_t ws_size, hipStream_t stream) {
    static int grid = 0;
    if (grid == 0) {
        if (n_in != 26 || out_size != M * D || ws_size < WS_END) { fprintf(stderr, "kernel_launch: shape mismatch n_in %d out %d ws %zu (need %zu)\n", n_in, out_size, ws_size, (size_t)WS_END); grid = -1; return; }
        int dev = 0, cus = 0, per_cu = 0;
        if (hipGetDevice(&dev) != hipSuccess || hipDeviceGetAttribute(&cus, hipDeviceAttributeMultiprocessorCount, dev) != hipSuccess) { grid = -1; return; }
        if (hipFuncSetAttribute((const void*)hyena_mla_fwd, hipFuncAttributeMaxDynamicSharedMemorySize, LDS_BYTES) != hipSuccess) { fprintf(stderr, "kernel_launch: hipFuncSetAttribute failed\n"); grid = -1; return; }
        if (hipOccupancyMaxActiveBlocksPerMultiprocessor(&per_cu, (const void*)hyena_mla_fwd, NTHR, LDS_BYTES) != hipSuccess || per_cu < 1) fprintf(stderr, "kernel_launch: occupancy query says %d\n", per_cu);
        (void)hipGetLastError();
        grid = cus;
    }
    if (grid < 0) return;
    if (hipMemsetAsync((char*)d_ws + WS_CTL, 0, CTL_ZERO_BYTES, stream) != hipSuccess) { fprintf(stderr, "kernel_launch: memset failed\n"); return; }
    Args a{};
    for (int i = 0; i < 26; ++i) a.in[i] = (const float*)d_in[i];
    a.out = (float*)d_out; a.ws = (unsigned char*)d_ws;
    hipLaunchKernelGGL(hyena_mla_fwd, dim3(grid), dim3(NTHR), LDS_BYTES, stream, a);
#ifdef ATT_BENCH
    { static int once = 0; if (!once) { (void)hipFuncSetAttribute((const void*)attn_bench, hipFuncAttributeMaxDynamicSharedMemorySize, LDS_BYTES); once = 1; }
      hipLaunchKernelGGL(attn_bench, dim3(grid), dim3(NTHR), LDS_BYTES, stream, a); }
#endif
    const hipError_t le = hipPeekAtLastError();
    if (le != hipSuccess) fprintf(stderr, "kernel_launch: launch failed: %s\n", hipGetErrorName(le));
}
```

```cpp
#include <hip/hip_runtime.h>
#include <cstdio>
#include <cstdint>
__device__ __forceinline__ int hw_lane() { int l; asm volatile("v_mbcnt_lo_u32_b32 %0, -1, 0\n\tv_mbcnt_hi_u32_b32 %0, -1, %0" : "=v"(l)); return l; }
__device__ __forceinline__ int tid_from_wave(int wave0) { int w = wave0; asm volatile("" : "+s"(w)); int t = w * 64 + hw_lane(); asm volatile("" : "+v"(t)); return t; }
namespace pg8 {
#define PG8_LAS __attribute__((address_space(3)))
#define PG8_GAS __attribute__((address_space(1)))
typedef unsigned short bf16_t;
typedef short bf16x8 __attribute__((ext_vector_type(8)));
typedef float f32x4 __attribute__((ext_vector_type(4)));
typedef unsigned u32x4 __attribute__((ext_vector_type(4)));
constexpr int BM = 256, BK = 64, HALF = 128, HTB = HALF * BK * 2  , STAGE_BYTES = 8 * HTB, NXCD = 8, WGM = 8;

__host__ __device__ __forceinline__ int lds_byte(int r, int c) { const int st = (r >> 4) * 2 + (c >> 5), rr = r & 15, cc = c & 31, ob = rr * 64 + cc * 2; return st * 1024 + (ob ^ (((ob >> 9) & 1) << 5)); }
__host__ __device__ __forceinline__ void stage_rc(int b, int& R, int& C) { const int st = b / 1024, sb = b % 1024, swz = sb ^ (((sb >> 9) & 1) << 5); R = (st >> 1) * 16 + swz / 64; C = (st & 1) * 32 + (swz % 64) / 2; }
__host__ __device__ __forceinline__ int perm32(int rho) { const int n = rho >> 4, i = rho & 15; return 8 * (i >> 2) + 4 * n + (i & 3); }

struct Unit { int pm, pn; };
struct Gemm { const bf16_t* A; const bf16_t* Bt; int M, N, K; };

struct StaticOrder {
    int nM, nN, nwg, G, c;
    __host__ __device__ void init(int M, int N, int G_, int c_) { nM = M / BM; nN = N / BM; nwg = nM * nN; G = G_; c = c_; }
    __host__ __device__ bool next(int i, Unit& u) const {
        const long L = (long)i * G + c; if (L >= nwg) return false;
        int wgid = (int)L; { const int q = nwg / NXCD, r = nwg % NXCD, xcd = wgid % NXCD, off = wgid / NXCD; wgid = (xcd < r ? xcd * (q + 1) : r * (q + 1) + (xcd - r) * q) + off; }
        const int nig = WGM * nN, gid = wgid / nig, fm = gid * WGM, gsz = (nM - fm) < WGM ? (nM - fm) : WGM;
        u.pm = fm + ((wgid % nig) % gsz); u.pn = (wgid % nig) / gsz; return true;
    }
    __device__ __forceinline__ void a_ready(const Unit&) const {}
    __device__ __forceinline__ void done(const Unit&) const {}
};

__device__ __forceinline__ unsigned cvt_pk_bf16(float lo, float hi) { unsigned r; asm volatile("v_cvt_pk_bf16_f32 %0, %1, %2" : "=v"(r) : "v"(lo), "v"(hi)); return r; }
typedef float f32x2 __attribute__((ext_vector_type(2)));
__device__ __forceinline__ void relane(int& wr, int& wc, int& fr, int& fq) { int l = hw_lane(); asm volatile("" : "+v"(l)); fr = l & 15; fq = l >> 4; (void)wr; (void)wc; }
__device__ __forceinline__ f32x2 gelu_pk(f32x2 v) {
    const f32x2 av = __builtin_elementwise_abs(v), d = av * 0.2316418882f + 1.0f;
    f32x2 t; t.x = __builtin_amdgcn_rcpf(d.x); t.y = __builtin_amdgcn_rcpf(d.y);
    f32x2 q = t * 0.5307027145f + (-0.7265760135f); q = q * t + 0.7107068705f; q = q * t + (-0.142248368f); q = q * t + 0.127414796f; q = q * t;
    const f32x2 s = (v * v) * (-0.72134752044f);
    f32x2 e; e.x = __builtin_amdgcn_exp2f(s.x); e.y = __builtin_amdgcn_exp2f(s.y);
    const f32x2 m = v * (q * e), r = v - m;
    f32x2 o; o.x = v.x < 0.f ? m.x : r.x; o.y = v.y < 0.f ? m.y : r.y; return o;
}

template <int ACT  > struct EpiBf16 {
    static constexpr bool PERM = true, AFTER_DRAIN = false; static_assert(ACT == 0 || ACT == 1, "EpiBf16: ACT is 0 (none) or 1 (gelu_pk)");
    bf16_t* O; int ldc; const float* bias; int split_cols; size_t split_stride; float scale0;
    __device__ __forceinline__ void operator()(const f32x4 (&acc)[2][2][4][2], const Unit& u, int wr, int wc, int fr, int fq) const {
        relane(wr, wc, fr, fq);
        const int row0 = u.pm * BM + wr * 64 + fr; int colt = u.pn * BM; bf16_t* base = O;
        float sc = 1.f; if (split_cols) { const int t = colt / split_cols; base += (size_t)t * split_stride; colt -= t * split_cols; if (t == 0) sc = scale0; }
        const int col0 = colt + wc * 32 + 8 * fq, bcol0 = u.pn * BM + wc * 32 + 8 * fq;
        f32x4 bv[2][2];
#pragma unroll
        for (int bj = 0; bj < 2; ++bj)
#pragma unroll
            for (int n = 0; n < 2; ++n) bv[bj][n] = bias ? *(const PG8_GAS f32x4*)(bias + bcol0 + bj * HALF + 4 * n) : (f32x4){0.f, 0.f, 0.f, 0.f};
#pragma unroll
        for (int ai = 0; ai < 2; ++ai)
#pragma unroll
            for (int m = 0; m < 4; ++m) { bf16_t* rowp = base + (size_t)(row0 + ai * HALF + m * 16) * ldc + col0;
#pragma unroll
                for (int bj = 0; bj < 2; ++bj) { f32x4 v0 = acc[ai][bj][m][0] + bv[bj][0], v1 = acc[ai][bj][m][1] + bv[bj][1];
                    if (ACT == 1) { f32x2 a = gelu_pk((f32x2){v0[0], v0[1]}), b = gelu_pk((f32x2){v0[2], v0[3]}), c = gelu_pk((f32x2){v1[0], v1[1]}), d = gelu_pk((f32x2){v1[2], v1[3]});
                        v0 = (f32x4){a.x, a.y, b.x, b.y}; v1 = (f32x4){c.x, c.y, d.x, d.y}; }
                    v0 = v0 * sc; v1 = v1 * sc; u32x4 w; w.x = cvt_pk_bf16(v0[0], v0[1]); w.y = cvt_pk_bf16(v0[2], v0[3]); w.z = cvt_pk_bf16(v1[0], v1[1]); w.w = cvt_pk_bf16(v1[2], v1[3]);
                    *(PG8_GAS u32x4*)(rowp + bj * HALF) = w; } }
    }
};

struct PanelStats {
    unsigned* xbuf;
    unsigned* cnt;
    unsigned* tmo;
    int ntn; float eps;
    unsigned code;
    __device__ __forceinline__ bool run(const f32x4 (&v)[2][2][4][2], const Unit& u, int wr, int wc, int fr, int fq, PG8_LAS unsigned char* lds, int wid, int lane) const {
        typedef float f32x2v __attribute__((ext_vector_type(2)));
        PG8_LAS f32x2v* P = (PG8_LAS f32x2v*)lds;
        PG8_LAS f32x2v* S = (PG8_LAS f32x2v*)(lds + 8192);
        PG8_LAS unsigned* flag = (PG8_LAS unsigned*)(lds + 8192 + 2048);
#pragma unroll
        for (int ai = 0; ai < 2; ++ai)
#pragma unroll
            for (int m = 0; m < 4; ++m) {
                float s = 0.f;
#pragma unroll
                for (int bj = 0; bj < 2; ++bj)
#pragma unroll
                    for (int n = 0; n < 2; ++n) { const f32x4 x = v[ai][bj][m][n]; s += (x[0] + x[1]) + (x[2] + x[3]); }
                s += __shfl_xor(s, 16); s += __shfl_xor(s, 32);
                const float mw = s * (1.0f / 64.0f); float q = 0.f;
#pragma unroll
                for (int bj = 0; bj < 2; ++bj)
#pragma unroll
                    for (int n = 0; n < 2; ++n) { const f32x4 d = v[ai][bj][m][n] - mw; q += (d[0] * d[0] + d[1] * d[1]) + (d[2] * d[2] + d[3] * d[3]); }
                q += __shfl_xor(q, 16); q += __shfl_xor(q, 32);
                if (fq == 0) P[(ai * HALF + wr * 64 + m * 16 + fr) * 4 + wc] = (f32x2v){mw, q};
            }
        asm volatile("s_waitcnt lgkmcnt(0)" ::: "memory"); __builtin_amdgcn_s_barrier(); asm volatile("" ::: "memory");
#if defined(BROKEN_EXCHANGE_NO_WAIT)
#warning BROKEN CONTROL BUILD: the row-statistics exchange does not wait; results are wrong by design
        if (blockIdx.x >= 64) { const long long t0_ = clock64(); while (clock64() - t0_ < 60000) __builtin_amdgcn_s_sleep(8); }
#endif
        const int row = wid * 32 + (lane & 31);
        if (lane < 32) {
            const f32x2v a = P[row * 4 + 0], b = P[row * 4 + 1], c = P[row * 4 + 2], d = P[row * 4 + 3];
            const float mt = (a.x + b.x + c.x + d.x) * 0.25f;
            const float da = a.x - mt, db = b.x - mt, dc = c.x - mt, dd = d.x - mt;
            const float m2 = (a.y + b.y) + (c.y + d.y) + 64.0f * ((da * da + db * db) + (dc * dc + dd * dd));
            unsigned long long* slot = (unsigned long long*)xbuf + ((size_t)(u.pm * BM + row) * 4 + u.pn);
            __hip_atomic_store(slot, ((unsigned long long)__float_as_uint(m2) << 32) | __float_as_uint(mt), __ATOMIC_RELAXED, __HIP_MEMORY_SCOPE_AGENT);
        }
        asm volatile("s_waitcnt vmcnt(0)" ::: "memory");
        if (lane == 0) __hip_atomic_fetch_add(cnt + 64 * u.pm, 1u, __ATOMIC_RELAXED, __HIP_MEMORY_SCOPE_AGENT);
        if (wid == 0) {
            bool dead = false; const unsigned long long t0 = __builtin_amdgcn_s_memrealtime(); const unsigned want = 8u * (unsigned)ntn;
            for (;;) {
#if defined(BROKEN_EXCHANGE_NO_WAIT)
                break;
#endif
                if ((unsigned)__builtin_amdgcn_readfirstlane(__hip_atomic_load(cnt + 64 * u.pm, __ATOMIC_RELAXED, __HIP_MEMORY_SCOPE_AGENT)) >= want) break;
                if (__builtin_amdgcn_s_memrealtime() - t0 > 2000000ull) {
                    if (lane == 0) { unsigned expect = 0u; __hip_atomic_compare_exchange_strong(tmo + 1, &expect, code | (unsigned)(u.pm & 0xff), __ATOMIC_RELAXED, __ATOMIC_RELAXED, __HIP_MEMORY_SCOPE_AGENT);
                                     __hip_atomic_store(tmo, 1u, __ATOMIC_RELAXED, __HIP_MEMORY_SCOPE_AGENT); }
                    dead = true; break; }
                __builtin_amdgcn_s_sleep(2);
            }
            __builtin_amdgcn_fence(__ATOMIC_ACQUIRE, "agent");
            if (lane == 0) flag[0] = dead ? 1u : 0u;
        }
        asm volatile("s_waitcnt vmcnt(0) lgkmcnt(0)" ::: "memory"); __builtin_amdgcn_s_barrier(); asm volatile("" ::: "memory");
        const bool bad = flag[0] != 0u;
        if (lane < 32) {
            const unsigned long long* slot = (const unsigned long long*)xbuf + (size_t)(u.pm * BM + row) * 4; float mt[4], m2[4]; float ms = 0.f;
#pragma unroll
            for (int t = 0; t < 4; ++t) { if (t < ntn) { const unsigned long long w = __hip_atomic_load(slot + t, __ATOMIC_RELAXED, __HIP_MEMORY_SCOPE_AGENT); mt[t] = __uint_as_float((unsigned)w); m2[t] = __uint_as_float((unsigned)(w >> 32)); } else { mt[t] = 0.f; m2[t] = 0.f; } ms += mt[t]; }
            const float mean = ms / (float)ntn; float q = 0.f;
#pragma unroll
            for (int t = 0; t < 4; ++t) if (t < ntn) { const float dm = mt[t] - mean; q += m2[t] + 256.0f * dm * dm; }
            S[row] = (f32x2v){mean, 1.0f / sqrtf(q / (256.0f * (float)ntn) + eps)};
        }
        asm volatile("s_waitcnt lgkmcnt(0)" ::: "memory"); __builtin_amdgcn_s_barrier(); asm volatile("" ::: "memory");
        return bad;
    }
};
struct EpiLnRes {
    static constexpr bool PERM = false, AFTER_DRAIN = true;
    const float* base; float* out; int ldc; const float* bias; PanelStats st; unsigned poison;
    __device__ __forceinline__ void fused(f32x4 (&acc)[2][2][4][2], const Unit& u, int wr, int wc, int fr, int fq, PG8_LAS unsigned char* lds, int wid, int lane) const {
        typedef float f32x2v __attribute__((ext_vector_type(2)));
        const PG8_LAS f32x2v* S = (const PG8_LAS f32x2v*)(lds + 8192);
        const int col0 = u.pn * BM + wc * 32 + 4 * fq;
#pragma unroll
        for (int bj = 0; bj < 2; ++bj)
#pragma unroll
            for (int n = 0; n < 2; ++n) { const f32x4 bv = bias ? *(const f32x4*)(bias + col0 + bj * HALF + n * 16) : (f32x4){0.f, 0.f, 0.f, 0.f};
#pragma unroll
                for (int ai = 0; ai < 2; ++ai)
#pragma unroll
                    for (int m = 0; m < 4; ++m) acc[ai][bj][m][n] += bv; }
        f32x4 pre[4][2][2];
#pragma unroll
        for (int m = 0; m < 4; ++m) { const size_t off = (size_t)(u.pm * BM + wr * 64 + m * 16 + fr) * ldc + col0;
#pragma unroll
            for (int bj = 0; bj < 2; ++bj)
#pragma unroll
                for (int n = 0; n < 2; ++n) pre[m][bj][n] = *(const f32x4*)(base + off + bj * HALF + n * 16); }
        const bool bad = st.run(acc, u, wr, wc, fr, fq, lds, wid, lane) || poison != 0u;
        const float qnan = __builtin_nanf("");
#pragma unroll
        for (int ai = 0; ai < 2; ++ai)
#pragma unroll
            for (int m = 0; m < 4; ++m) { const int r = ai * HALF + wr * 64 + m * 16 + fr; const f32x2v sr = S[r]; const size_t off = (size_t)(u.pm * BM + r) * ldc + col0;
#pragma unroll
                for (int bj = 0; bj < 2; ++bj)
#pragma unroll
                    for (int n = 0; n < 2; ++n) { const f32x4 bs = ai == 0 ? pre[m][bj][n] : *(const f32x4*)(base + off + bj * HALF + n * 16); f32x4 o = bs + (acc[ai][bj][m][n] - sr.x) * sr.y;
                        if (bad) o = (f32x4){qnan, qnan, qnan, qnan}; *(f32x4*)(out + off + bj * HALF + n * 16) = o; }
                if (m & 1) asm volatile("" ::: "memory"); }
    }
};
struct EpiLnResLn {
    static constexpr bool PERM = false, AFTER_DRAIN = true;
    const float* base; float* out; bf16_t* xn; int ldc; const float* bias; PanelStats st1, st2; unsigned poison;
    __device__ __forceinline__ void fused(f32x4 (&acc)[2][2][4][2], const Unit& u, int wr, int wc, int fr, int fq, PG8_LAS unsigned char* lds, int wid, int lane) const {
        typedef float f32x2v __attribute__((ext_vector_type(2))); typedef unsigned u32x2v __attribute__((ext_vector_type(2)));
        const PG8_LAS f32x2v* S = (const PG8_LAS f32x2v*)(lds + 8192);
        const int col0 = u.pn * BM + wc * 32 + 4 * fq;
#pragma unroll
        for (int bj = 0; bj < 2; ++bj)
#pragma unroll
            for (int n = 0; n < 2; ++n) { const f32x4 bv = bias ? *(const f32x4*)(bias + col0 + bj * HALF + n * 16) : (f32x4){0.f, 0.f, 0.f, 0.f};
#pragma unroll
                for (int ai = 0; ai < 2; ++ai)
#pragma unroll
                    for (int m = 0; m < 4; ++m) acc[ai][bj][m][n] += bv; }
        bool bad = st1.run(acc, u, wr, wc, fr, fq, lds, wid, lane) || poison != 0u;
        const float qnan = __builtin_nanf("");
#pragma unroll
        for (int ai = 0; ai < 2; ++ai)
#pragma unroll
            for (int m = 0; m < 4; ++m) { const int r = ai * HALF + wr * 64 + m * 16 + fr; const f32x2v sr = S[r]; const size_t off = (size_t)(u.pm * BM + r) * ldc + col0;
#pragma unroll
                for (int bj = 0; bj < 2; ++bj)
#pragma unroll
                    for (int n = 0; n < 2; ++n) { const f32x4 bs = *(const f32x4*)(base + off + bj * HALF + n * 16); acc[ai][bj][m][n] = bs + (acc[ai][bj][m][n] - sr.x) * sr.y; }
                asm volatile("" : "+v"(acc[ai][0][m][0]), "+v"(acc[ai][0][m][1]), "+v"(acc[ai][1][m][0]), "+v"(acc[ai][1][m][1]));
                if (m & 1) asm volatile("" ::: "memory"); }
        const bool bad1 = bad;
        bad = st2.run(acc, u, wr, wc, fr, fq, lds, wid, lane) || bad;
#pragma unroll
        for (int ai = 0; ai < 2; ++ai)
#pragma unroll
            for (int m = 0; m < 4; ++m) { const int r = ai * HALF + wr * 64 + m * 16 + fr; const f32x2v sr = S[r]; const size_t off = (size_t)(u.pm * BM + r) * ldc + col0;
#pragma unroll
                for (int bj = 0; bj < 2; ++bj)
#pragma unroll
                    for (int n = 0; n < 2; ++n) { const f32x4 x1 = acc[ai][bj][m][n]; *(f32x4*)(out + off + bj * HALF + n * 16) = bad1 ? (f32x4){qnan, qnan, qnan, qnan} : x1;
                        const f32x4 o = (x1 - sr.x) * sr.y; u32x2v w; w.x = cvt_pk_bf16(o[0], o[1]); w.y = cvt_pk_bf16(o[2], o[3]);
                        if (bad) { w.x = 0x7fc07fc0u; w.y = 0x7fc07fc0u; } *(u32x2v*)(xn + off + bj * HALF + n * 16) = w; }
                asm volatile("" ::: "memory"); }
    }
};

template <class Epi, class Sched, bool ALIGN_EPI = false, bool SP2 = false>
__device__ __forceinline__ void gemm_phase(PG8_LAS unsigned char* lds, const Gemm g, const Sched& S, const Epi& E, const int wave0) {
    int tid_ = tid_from_wave(wave0);
    const int tid = tid_, wid = __builtin_amdgcn_readfirstlane(tid >> 6), lane = tid & 63, wr = wid >> 2, wc = wid & 3, fr = lane & 15, fq = lane >> 4;
    const int K = g.K, nt = K / BK;
    unsigned voffA[2], voffB[2];
#pragma unroll
    for (int i = 0; i < 2; ++i) { int R, C; stage_rc(tid * 16 + i * 8192, R, C); const int Rb = Epi::PERM ? ((R & ~31) + perm32(R & 31)) : R;
        voffA[i] = (unsigned)(R * K + C) * 2u; voffB[i] = (unsigned)(Rb * K + C) * 2u; }
    const size_t kstep = (size_t)(BK * 2);
    const size_t hstep = (size_t)HALF * K * 2;
    const size_t tstep = 2 * hstep;
    const unsigned ldsw = (unsigned)wid * 1024u;
    const int aoff = lds_byte(wr * 64 + fr, fq * 8), boff = lds_byte(wc * 32 + fr, fq * 8);
#define PG8_SA(b, h) (((b) * 2 + (h)) * HTB)
#define PG8_SB(b, h) ((4 + (b) * 2 + (h)) * HTB)
#define PG8_STAGE(bufoff, gbase, voff) do { _Pragma("unroll") for (int _i = 0; _i < 2; ++_i) \
        __builtin_amdgcn_global_load_lds((const unsigned*)((const char*)(gbase) + (voff)[_i]), (PG8_LAS unsigned*)(lds + (bufoff) + ldsw + _i * 8192), 16, 0, 0); } while (0)
#define PG8_LDA(dst, b, h) do { _Pragma("unroll") for (int m = 0; m < 4; ++m) _Pragma("unroll") for (int k = 0; k < 2; ++k) dst[m][k] = *(const PG8_LAS bf16x8*)(lds + PG8_SA(b, h) + aoff + m * 2048 + k * 1024); } while (0)
#define PG8_LDB(dst, b, h) do { _Pragma("unroll") for (int n = 0; n < 2; ++n) _Pragma("unroll") for (int k = 0; k < 2; ++k) dst[n][k] = *(const PG8_LAS bf16x8*)(lds + PG8_SB(b, h) + boff + n * 2048 + k * 1024); } while (0)
#define PG8_MMA(ai, bj, At, Bt) do { __builtin_amdgcn_s_setprio(1); _Pragma("unroll") for (int m = 0; m < 4; ++m) _Pragma("unroll") for (int n = 0; n < 2; ++n) _Pragma("unroll") for (int k = 0; k < 2; ++k) \
        acc[ai][bj][m][n] = __builtin_amdgcn_mfma_f32_16x16x32_bf16(Bt[n][k], At[m][k], acc[ai][bj][m][n], 0, 0, 0); __builtin_amdgcn_s_setprio(0); } while (0)
#define PG8_WAIT_V(n) asm volatile("s_waitcnt vmcnt(" #n ")" ::: "memory")
#define PG8_WAIT_L(n) asm volatile("s_waitcnt lgkmcnt(" #n ")" ::: "memory")
#define PG8_BAR __builtin_amdgcn_s_barrier()
#define PG8_SCHED __builtin_amdgcn_sched_barrier(0)
    Unit cur, nxt; int ui = 0;
    if (!S.next(0, cur)) return;
    f32x4 acc[2][2][4][2];
#pragma unroll
    for (int a = 0; a < 2; ++a)
#pragma unroll
        for (int b = 0; b < 2; ++b)
#pragma unroll
            for (int m = 0; m < 4; ++m)
#pragma unroll
                for (int n = 0; n < 2; ++n) acc[a][b][m][n] = (f32x4){0.f, 0.f, 0.f, 0.f};
    bf16x8 At[4][2], B0[2][2], B1[2][2];
    const char* cA = (const char*)g.A + (size_t)cur.pm * tstep; const char* cB = (const char*)g.Bt + (size_t)cur.pn * tstep;
    S.a_ready(cur);
    if constexpr (SP2) {
        PG8_STAGE(PG8_SB(0, 0), cB, voffB); PG8_STAGE(PG8_SB(0, 1), cB + hstep, voffB); PG8_STAGE(PG8_SA(0, 0), cA, voffA); PG8_STAGE(PG8_SA(0, 1), cA + hstep, voffA);
        if (wr == 1) PG8_BAR;
        PG8_WAIT_V(2); PG8_BAR;
        PG8_STAGE(PG8_SB(1, 0), cB + kstep, voffB); PG8_STAGE(PG8_SA(1, 0), cA + kstep, voffA); PG8_STAGE(PG8_SB(1, 1), cB + hstep + kstep, voffB);
        PG8_WAIT_V(6); PG8_BAR;
    } else {
        PG8_STAGE(PG8_SB(0, 0), cB, voffB); PG8_STAGE(PG8_SA(0, 0), cA, voffA); PG8_STAGE(PG8_SB(0, 1), cB + hstep, voffB); PG8_STAGE(PG8_SA(0, 1), cA + hstep, voffA);
        if (wr == 1) PG8_BAR;
        PG8_WAIT_V(4); PG8_BAR;
        PG8_STAGE(PG8_SB(1, 0), cB + kstep, voffB); PG8_STAGE(PG8_SA(1, 0), cA + kstep, voffA); PG8_STAGE(PG8_SB(1, 1), cB + hstep + kstep, voffB);
        PG8_WAIT_V(6); PG8_BAR;
    }
    for (;;) {
        const bool has_next = S.next(ui + 1, nxt);
        const char* nA = has_next ? (const char*)g.A + (size_t)nxt.pm * tstep : cA; const char* nB = has_next ? (const char*)g.Bt + (size_t)nxt.pn * tstep : cB;
        for (int t = 0; t < nt; t += 2) {
            const bool last = (t == nt - 2);
            const char* a1 = cA + (size_t)(t + 1) * kstep;
            const char* a2 = last ? nA : cA + (size_t)(t + 2) * kstep; const char* b2 = last ? nB : cB + (size_t)(t + 2) * kstep;
            const char* a3 = a2 + kstep; const char* b3 = b2 + kstep;
            if (last && has_next) S.a_ready(nxt);
            if constexpr (SP2) {
            PG8_LDB(B0, 0, 0); PG8_LDB(B1, 0, 1); PG8_SCHED; PG8_LDA(At, 0, 0); PG8_STAGE(PG8_SA(1, 1), a1 + hstep, voffA);
            PG8_WAIT_V(8); PG8_WAIT_L(0); PG8_BAR; PG8_MMA(0, 0, At, B0); PG8_MMA(0, 1, At, B1); PG8_BAR; PG8_SCHED;
            PG8_LDA(At, 0, 1); PG8_STAGE(PG8_SB(0, 0), b2, voffB); PG8_STAGE(PG8_SB(0, 1), b2 + hstep, voffB); PG8_STAGE(PG8_SA(0, 0), a2, voffA);
            PG8_WAIT_V(8); PG8_WAIT_L(0); PG8_BAR; PG8_MMA(1, 0, At, B0); PG8_MMA(1, 1, At, B1); PG8_BAR; PG8_SCHED;
            PG8_LDB(B0, 1, 0); PG8_LDB(B1, 1, 1); PG8_SCHED; PG8_LDA(At, 1, 0); PG8_STAGE(PG8_SA(0, 1), a2 + hstep, voffA);
            PG8_WAIT_V(8); PG8_WAIT_L(0); PG8_BAR; PG8_MMA(0, 0, At, B0); PG8_MMA(0, 1, At, B1); PG8_BAR; PG8_SCHED;
            PG8_LDA(At, 1, 1); PG8_STAGE(PG8_SB(1, 0), b3, voffB); PG8_STAGE(PG8_SB(1, 1), b3 + hstep, voffB); PG8_STAGE(PG8_SA(1, 0), a3, voffA);
            PG8_WAIT_V(8); PG8_WAIT_L(0); PG8_BAR; PG8_MMA(1, 0, At, B0); PG8_MMA(1, 1, At, B1); PG8_BAR; PG8_SCHED;
            } else {
            PG8_LDB(B0, 0, 0); PG8_SCHED; PG8_LDA(At, 0, 0); PG8_STAGE(PG8_SA(1, 1), a1 + hstep, voffA);
            PG8_WAIT_L(8); PG8_BAR; PG8_WAIT_L(0); PG8_MMA(0, 0, At, B0); PG8_BAR; PG8_SCHED;
            PG8_LDB(B1, 0, 1); PG8_STAGE(PG8_SB(0, 0), b2, voffB);
            PG8_BAR; PG8_WAIT_L(0); PG8_MMA(0, 1, At, B1); PG8_BAR;
            PG8_LDA(At, 0, 1); PG8_STAGE(PG8_SA(0, 0), a2, voffA);
            PG8_BAR; PG8_WAIT_L(0); PG8_MMA(1, 0, At, B0); PG8_BAR; PG8_SCHED;
            PG8_STAGE(PG8_SB(0, 1), b2 + hstep, voffB);
            PG8_WAIT_V(6); PG8_BAR; PG8_MMA(1, 1, At, B1); PG8_BAR;
            PG8_LDB(B0, 1, 0); PG8_SCHED; PG8_LDA(At, 1, 0); PG8_STAGE(PG8_SA(0, 1), a2 + hstep, voffA);
            PG8_WAIT_L(8); PG8_BAR; PG8_WAIT_L(0); PG8_MMA(0, 0, At, B0); PG8_BAR; PG8_SCHED;
            PG8_LDB(B1, 1, 1); PG8_STAGE(PG8_SB(1, 0), b3, voffB);
            PG8_BAR; PG8_WAIT_L(0); PG8_MMA(0, 1, At, B1); PG8_BAR;
            PG8_LDA(At, 1, 1); PG8_STAGE(PG8_SA(1, 0), a3, voffA);
            PG8_BAR; PG8_WAIT_L(0); PG8_MMA(1, 0, At, B0); PG8_BAR; PG8_SCHED;
            PG8_STAGE(PG8_SB(1, 1), b3 + hstep, voffB);
            PG8_WAIT_V(6); PG8_BAR; PG8_MMA(1, 1, At, B1); PG8_BAR;
            }
        }
        if constexpr (ALIGN_EPI) { if (wr == 0) PG8_BAR; }
        if constexpr (!Epi::AFTER_DRAIN) { E(acc, cur, wr, wc, fr, fq); S.done(cur); }
        if (!has_next) break;
#pragma unroll
        for (int a = 0; a < 2; ++a)
#pragma unroll
            for (int b = 0; b < 2; ++b)
#pragma unroll
                for (int m = 0; m < 4; ++m)
#pragma unroll
                    for (int n = 0; n < 2; ++n) acc[a][b][m][n] = (f32x4){0.f, 0.f, 0.f, 0.f};
        cur = nxt; cA = nA; cB = nB; ++ui;
        if constexpr (ALIGN_EPI) { if (wr == 1) PG8_BAR; }
    }
    PG8_WAIT_V(0);
    if constexpr (!ALIGN_EPI) { if (wr == 0) PG8_BAR; }
    PG8_BAR;
    if constexpr (Epi::AFTER_DRAIN) { E.fused(acc, cur, wr, wc, fr, fq, lds, wid, lane); S.done(cur); }
#undef PG8_SA
#undef PG8_SB
#undef PG8_STAGE
#undef PG8_LDA
#undef PG8_LDB
#undef PG8_MMA
#undef PG8_WAIT_V
#undef PG8_WAIT_L
#undef PG8_BAR
#undef PG8_SCHED
}
}

namespace pg8 {
struct EpiRelu2 {
    static constexpr bool PERM = true, AFTER_DRAIN = false;
    bf16_t* O; int ldc;
    __device__ __forceinline__ void operator()(const f32x4 (&acc)[2][2][4][2], const Unit& u, int wr, int wc, int fr, int fq) const {
        relane(wr, wc, fr, fq);
        const int row0 = u.pm * BM + wr * 64 + fr, col0 = u.pn * BM + wc * 32 + 8 * fq;
#pragma unroll
        for (int ai = 0; ai < 2; ++ai)
#pragma unroll
            for (int m = 0; m < 4; ++m) { bf16_t* rowp = O + (size_t)(row0 + ai * HALF + m * 16) * ldc + col0;
#pragma unroll
                for (int bj = 0; bj < 2; ++bj) { f32x4 v0 = acc[ai][bj][m][0], v1 = acc[ai][bj][m][1];
                    v0 = __builtin_elementwise_max(v0, (f32x4){0.f, 0.f, 0.f, 0.f}); v1 = __builtin_elementwise_max(v1, (f32x4){0.f, 0.f, 0.f, 0.f}); v0 = v0 * v0; v1 = v1 * v1;
                    u32x4 w; w.x = cvt_pk_bf16(v0[0], v0[1]); w.y = cvt_pk_bf16(v0[2], v0[3]); w.z = cvt_pk_bf16(v1[0], v1[1]); w.w = cvt_pk_bf16(v1[2], v1[3]);
                    *(PG8_GAS u32x4*)(rowp + bj * HALF) = w; } }
    }
};
struct EpiF32 {
    static constexpr bool PERM = false, AFTER_DRAIN = false;
    float* O; int ldc;
    __device__ __forceinline__ void operator()(const f32x4 (&acc)[2][2][4][2], const Unit& u, int wr, int wc, int fr, int fq) const {
        relane(wr, wc, fr, fq);
        const int row0 = u.pm * BM + wr * 64 + fr, col0 = u.pn * BM + wc * 32 + 4 * fq;
#pragma unroll
        for (int ai = 0; ai < 2; ++ai)
#pragma unroll
            for (int m = 0; m < 4; ++m) { float* rowp = O + (size_t)(row0 + ai * HALF + m * 16) * ldc + col0;
#pragma unroll
                for (int bj = 0; bj < 2; ++bj)
#pragma unroll
                    for (int n = 0; n < 2; ++n) *(PG8_GAS f32x4*)(rowp + bj * HALF + n * 16) = acc[ai][bj][m][n]; }
    }
};
struct EpiTaps {
    static constexpr bool PERM = false, AFTER_DRAIN = false;
    float* O; const float* decay;
    __device__ __forceinline__ void operator()(const f32x4 (&acc)[2][2][4][2], const Unit& u, int wr, int wc, int fr, int fq) const {
        relane(wr, wc, fr, fq);
        const int row0 = u.pm * BM + wr * 64 + fr, col0 = u.pn * BM + wc * 32 + 4 * fq;
#pragma unroll
        for (int ai = 0; ai < 2; ++ai)
#pragma unroll
            for (int m = 0; m < 4; ++m) { const int row = row0 + ai * HALF + m * 16; float* rowp = O + (size_t)row * 16384 + col0; const float nd = -fabsf(((const PG8_GAS float*)decay)[row]) * (1.0f / 16383.0f) * 1.4426950408889634f;
#pragma unroll
                for (int bj = 0; bj < 2; ++bj)
#pragma unroll
                    for (int n = 0; n < 2; ++n) { const int c = col0 + bj * HALF + n * 16; const f32x4 a = acc[ai][bj][m][n]; f32x4 o;
                        o[0] = a[0] * __builtin_amdgcn_exp2f(nd * (float)(c + 0)); o[1] = a[1] * __builtin_amdgcn_exp2f(nd * (float)(c + 1));
                        o[2] = a[2] * __builtin_amdgcn_exp2f(nd * (float)(c + 2)); o[3] = a[3] * __builtin_amdgcn_exp2f(nd * (float)(c + 3));
                        *(PG8_GAS f32x4*)(rowp + bj * HALF + n * 16) = o; } }
    }
};
}

constexpr int L = 16384, NSEQ = 3, M = NSEQ * L, D = 1024, DEPTH = 4;
constexpr int HYW = 512, HYP = 1536, QR = 256, KVR = 128, ROPE = 32, INW = 1952;
constexpr int NH = 8, DQ = 96, DV = 64, NQ = NH * DQ, NKV = NH * 128;
constexpr int FF = 4096;
constexpr float EPS = 1e-6f;
constexpr int NWAVES = 8, NTHR = 512;
constexpr int MLP_CHUNK = 16384, N_MLP_CHUNKS = M / MLP_CHUNK;

constexpr size_t MiB = 1u << 20;
constexpr size_t WS_CTL = 0, CTL_ZERO_BYTES = 65536;
constexpr size_t WS_COS = 1 * MiB, WS_SIN = 2 * MiB;
constexpr size_t WS_H2 = 4 * MiB;
constexpr size_t WS_W3T = 8 * MiB;
constexpr size_t WS_WIN = 12 * MiB, WS_WOUT = 16 * MiB, WS_WUP = 18 * MiB, WS_WDOWN = 26 * MiB, WS_WUQ = 34 * MiB, WS_WUKV = 34 * MiB + 512 * 1024;
constexpr size_t WS_XN = 36 * MiB;
constexpr size_t WS_CQN = 36 * MiB, WS_CKVN = 60 * MiB, WS_KPE = 72 * MiB;
constexpr size_t WS_KEO = 132 * MiB;
constexpr size_t WS_KT = 261 * MiB;
constexpr size_t WS_UT = 261 * MiB;
constexpr size_t WS_CQKV = 405 * MiB;
constexpr size_t WS_YT = 453 * MiB;
constexpr size_t WS_Q = 132 * MiB, WS_KN = 204 * MiB;
constexpr size_t WS_MIX = 324 * MiB;
constexpr size_t WS_T = 132 * MiB;
constexpr size_t WS_H = 324 * MiB;
constexpr size_t WS_G0 = 75 * MiB, WS_G1A = 107 * MiB, WS_G1B = 501 * MiB;
constexpr size_t WS_XR = 508 * MiB;
constexpr size_t WS_END = 604 * MiB;
constexpr int KEO_BLK = 16512, KEO_KO = 8256;
static_assert(WS_KEO + (size_t)1024 * KEO_BLK * 8 <= WS_KT, "KEO fits");
static_assert(WS_UT + (size_t)HYP * M * 2 <= WS_CQKV && WS_CQKV + (size_t)M * 512 * 2 <= WS_YT && WS_YT + (size_t)HYW * M * 2 <= WS_XR, "map");
static_assert(WS_KN + (size_t)M * NKV * 2 <= WS_MIX && WS_T + (size_t)M * D * 4 <= WS_MIX && WS_H + (size_t)MLP_CHUNK * FF * 2 <= WS_XR && WS_XR + (size_t)M * D * 2 <= WS_END, "map2");

constexpr int RING_OFF = 0, RING_BYTES = 139264;
constexpr int LDSCTL_OFF = RING_BYTES, MISC_OFF = LDSCTL_OFF + 320;
constexpr int LDS_BYTES = 147456;
static_assert(MISC_OFF + 128 <= LDS_BYTES, "LDS map");

#define GAS __attribute__((address_space(1)))
#define LAS __attribute__((address_space(3)))
typedef unsigned short bf16;
typedef unsigned v4u __attribute__((ext_vector_type(4)));
typedef unsigned v2u __attribute__((ext_vector_type(2)));
typedef float f32x4 __attribute__((ext_vector_type(4)));
typedef float f32x2 __attribute__((ext_vector_type(2)));
typedef short bf16x8 __attribute__((ext_vector_type(8)));
typedef GAS unsigned gu32;
#define RLX_AGENT __ATOMIC_RELAXED, __HIP_MEMORY_SCOPE_AGENT
#define LDS_WAIT() asm volatile("s_waitcnt lgkmcnt(0)" ::: "memory")
#define VM_WAIT() asm volatile("s_waitcnt vmcnt(0)" ::: "memory")
typedef __bf16 bf16x2_t __attribute__((ext_vector_type(2)));
__device__ __forceinline__ unsigned pk2(float lo, float hi) { f32x2 v = {lo, hi}; bf16x2_t b = __builtin_convertvector(v, bf16x2_t); return __builtin_bit_cast(unsigned, b); }
__device__ __forceinline__ bf16 f2bf(float f) { return (bf16)(pk2(f, 0.f) & 0xffffu); }
__device__ __forceinline__ float bf2f(unsigned h) { return __uint_as_float(h << 16); }
__device__ __forceinline__ float shx(float v, int lane, int o) { return __uint_as_float((unsigned)__builtin_amdgcn_ds_bpermute((lane ^ o) << 2, (int)__float_as_uint(v))); }
__device__ __forceinline__ float wave_sum(float v) {
    const int ln_ = hw_lane();
#pragma unroll
    for (int o = 1; o < 64; o <<= 1) v += shx(v, ln_, o);
    return v;
}

#ifndef HYSUB
#define HYSUB 0
#endif
#define HT0_(F_) do { if (HYSUB) { __syncthreads(); if (F_.tid == 0) F_.MISC[20] = (unsigned)__builtin_amdgcn_s_memrealtime(); } } while (0)
#define HT1_(F_, s) do { if (HYSUB == (s)) { __syncthreads(); if (F_.tid == 0) F_.MISC[21] += (unsigned)__builtin_amdgcn_s_memrealtime() - F_.MISC[20]; } } while (0)
#define HT0() HT0_(F)
#define HT1(s) HT1_(F, s)

namespace hfft {
constexpr float w32c(int i) { constexpr float t[16] = {1.000000000e+00f, 9.807852507e-01f, 9.238795042e-01f, 8.314695954e-01f, 7.071067691e-01f, 5.555702448e-01f, 3.826834261e-01f, 1.950903237e-01f, 0.f, -1.950903237e-01f, -3.826834261e-01f, -5.555702448e-01f, -7.071067691e-01f, -8.314695954e-01f, -9.238795042e-01f, -9.807852507e-01f}; return t[i]; }
constexpr float w32s(int i) { constexpr float t[16] = {0.000000000e+00f, 1.950903237e-01f, 3.826834261e-01f, 5.555702448e-01f, 7.071067691e-01f, 8.314695954e-01f, 9.238795042e-01f, 9.807852507e-01f, 1.000000000e+00f, 9.807852507e-01f, 9.238795042e-01f, 8.314695954e-01f, 7.071067691e-01f, 5.555702448e-01f, 3.826834261e-01f, 1.950903237e-01f}; return t[i]; }
constexpr int brev(int x, int bits) { int r = 0; for (int i = 0; i < bits; ++i) r |= ((x >> i) & 1) << (bits - 1 - i); return r; }
constexpr int ilog2(int x) { int r = 0; while ((1 << r) < x) ++r; return r; }
__device__ __forceinline__ int pad(int i) { return i + (i >> 5); }

__device__ __forceinline__ void bfly(float ar, float ai, float br, float bi, float& ur, float& ui, float& dr, float& di) {
    asm("v_add_f32_e32 %0, %4, %6\n\tv_add_f32_e32 %1, %5, %7\n\tv_sub_f32_e32 %2, %4, %6\n\tv_sub_f32_e32 %3, %5, %7"
        : "=&v"(ur), "=&v"(ui), "=&v"(dr), "=&v"(di) : "v"(ar), "v"(ai), "v"(br), "v"(bi));
}
template <bool INV> __device__ __forceinline__ void bfly_rot(float ar, float ai, float br, float bi, float& ur, float& ui, float& dr, float& di) {
    if (!INV) asm("v_add_f32_e32 %0, %4, %6\n\tv_add_f32_e32 %1, %5, %7\n\tv_sub_f32_e32 %2, %5, %7\n\tv_sub_f32_e32 %3, %6, %4" : "=&v"(ur), "=&v"(ui), "=&v"(dr), "=&v"(di) : "v"(ar), "v"(ai), "v"(br), "v"(bi));
    else      asm("v_add_f32_e32 %0, %4, %6\n\tv_add_f32_e32 %1, %5, %7\n\tv_sub_f32_e32 %2, %7, %5\n\tv_sub_f32_e32 %3, %4, %6" : "=&v"(ur), "=&v"(ui), "=&v"(dr), "=&v"(di) : "v"(ar), "v"(ai), "v"(br), "v"(bi));
}
__device__ __forceinline__ void bfly_tw(float ar, float ai, float br, float bi, float c, float s, float& ur, float& ui, float& dr, float& di) {
    float tr, ti;
    asm("v_sub_f32_e32 %4, %6, %8\n\tv_sub_f32_e32 %5, %7, %9\n\tv_add_f32_e32 %0, %6, %8\n\tv_add_f32_e32 %1, %7, %9\n\t"
        "v_mul_f32_e32 %2, %10, %4\n\tv_mul_f32_e32 %3, %11, %4\n\tv_fma_f32 %2, -%11, %5, %2\n\tv_fma_f32 %3, %10, %5, %3"
        : "=&v"(ur), "=&v"(ui), "=&v"(dr), "=&v"(di), "=&v"(tr), "=&v"(ti) : "v"(ar), "v"(ai), "v"(br), "v"(bi), "s"(c), "s"(s));
}
__device__ __forceinline__ void cmul_chain(float& xr, float& xi, float& wc, float& ws, float c1, float s1) {
    float a, b, nc, ns;
    asm("v_mul_f32_e32 %0, %4, %6\n\tv_mul_f32_e32 %1, %4, %7\n\tv_fma_f32 %0, -%5, %7, %0\n\tv_fma_f32 %1, %5, %6, %1\n\t"
        "v_mul_f32_e32 %2, %6, %8\n\tv_mul_f32_e32 %3, %6, %9\n\tv_fma_f32 %2, -%7, %9, %2\n\tv_fma_f32 %3, %7, %8, %3"
        : "=&v"(a), "=&v"(b), "=&v"(nc), "=&v"(ns) : "v"(xr), "v"(xi), "v"(wc), "v"(ws), "v"(c1), "v"(s1));
    xr = a; xi = b; wc = nc; ws = ns;
}
template <int R, bool INV> __device__ __forceinline__ void fft_r2(float (&re)[R], float (&im)[R], const unsigned z0) {
    constexpr int LG = ilog2(R);
#pragma unroll
    for (int st = 0; st < LG; ++st) {
        const int s = (R / 2) >> st;
#pragma unroll
        for (int blk = 0; blk < R; blk += 2 * s) {
#pragma unroll
            for (int a = 0; a < s; ++a) {
                const int i0 = blk + a, i1 = i0 + s;
                const int w = a * (16 / s);
                float ur, ui, dr, di;
                if (w == 0) { bfly(re[i0], im[i0], re[i1], im[i1], ur, ui, dr, di); re[i1] = dr; im[i1] = di; }
                else if (w == 8) { bfly_rot<INV>(re[i0], im[i0], re[i1], im[i1], ur, ui, dr, di); re[i1] = dr; im[i1] = di; }
                else { const float c = __uint_as_float(__float_as_uint(w32c(w)) | z0), sn = __uint_as_float(__float_as_uint(INV ? w32s(w) : -w32s(w)) | z0);
                    bfly_tw(re[i0], im[i0], re[i1], im[i1], c, sn, ur, ui, dr, di); re[i1] = dr; im[i1] = di; }
                re[i0] = ur; im[i0] = ui;
            }
        }
    }
}

__device__ __forceinline__ int opaque(int x) { asm volatile("" : "+v"(x)); return x; }
template <bool INV> __device__ __forceinline__ void fft16k(float (&re)[32], float (&im)[32], LAS f32x2* buf, const int t_in) {
    asm volatile("" ::: "memory"); __builtin_amdgcn_sched_barrier(0);
    int t = opaque(t_in);
    unsigned z0 = 0u; asm volatile("" : "+s"(z0));
    fft_r2<32, INV>(re, im, z0);
    __syncthreads();
#pragma unroll
    for (int r = 0; r < 32; ++r) buf[33 * t + r] = (f32x2){re[brev(r, 5)], im[brev(r, 5)]};
    __syncthreads();
    t = opaque(t);
    { const int b2 = t + (t >> 5);
#pragma unroll
    for (int r = 0; r < 32; ++r) { const f32x2 v = buf[b2 + 528 * r]; re[r] = v.x; im[r] = v.y; } }
    {
        const float f1 = (float)(t & 31) * (1.0f / 1024.0f);
        const float c1 = __builtin_amdgcn_cosf(f1), s1 = INV ? __builtin_amdgcn_sinf(f1) : -__builtin_amdgcn_sinf(f1);
        float wc = c1, ws = s1;
#pragma unroll
        for (int r = 1; r < 32; ++r) {
            cmul_chain(re[r], im[r], wc, ws, c1, s1);
        }
    }
    fft_r2<32, INV>(re, im, z0);
    __syncthreads();
    {
        t = opaque(t);
        const int ob = (t >> 5) * 1056 + (t & 31);
#pragma unroll
        for (int r = 0; r < 32; ++r) buf[ob + 33 * r] = (f32x2){re[brev(r, 5)], im[brev(r, 5)]};
    }
    __syncthreads();
#pragma unroll
    for (int h = 0; h < 2; ++h) {
        t = opaque(t);
        float ar[16], ai[16]; const int j = t + 512 * h; const int b3 = t + (t >> 5) + 528 * h;
#pragma unroll
        for (int r = 0; r < 16; ++r) { const f32x2 v = buf[b3 + 1056 * r]; ar[r] = v.x; ai[r] = v.y; }
        {
            const float f1 = (float)j * (1.0f / 16384.0f);
            const float c1 = __builtin_amdgcn_cosf(f1), s1 = INV ? __builtin_amdgcn_sinf(f1) : -__builtin_amdgcn_sinf(f1);
            float wc = c1, ws = s1;
#pragma unroll
            for (int r = 1; r < 16; ++r) {
                cmul_chain(ar[r], ai[r], wc, ws, c1, s1);
            }
        }
        fft_r2<16, INV>(ar, ai, z0);
#pragma unroll
        for (int r = 0; r < 16; ++r) { re[h + 2 * r] = ar[brev(r, 4)]; im[h + 2 * r] = ai[brev(r, 4)]; }
    }
    asm volatile("" ::: "memory"); __builtin_amdgcn_sched_barrier(0);
}
}

struct Frame {
    LAS unsigned char* lds;
    volatile LAS unsigned* MISC;
    gu32* ctl;
    int tid, lane, wave;
    int wave0;
    int vcu, G;
    float* out;
    unsigned char* ws;
};
constexpr int PTRTAB_OFF = LDSCTL_OFF + 512;
__device__ __forceinline__ const GAS float* inp(const Frame& F, int i) {
    const v2u w = *(const LAS v2u*)(F.lds + PTRTAB_OFF + 8 * i);
    const unsigned lo = __builtin_amdgcn_readfirstlane(w.x), hi = __builtin_amdgcn_readfirstlane(w.y);
    return (const GAS float*)(((unsigned long long)hi << 32) | lo);
}
__device__ __forceinline__ GAS unsigned char* wsq(const Frame& F) { unsigned char* p = F.ws; asm volatile("" : "+s"(p)); return (GAS unsigned char*)p; }
enum { I_XP = 0, I_XS, I_WIN, I_CONVW, I_CONVB, I_FW1, I_FB1, I_FW2, I_FB2, I_FW3, I_SINF, I_DECAY, I_HBIAS, I_QNORM, I_WUQ, I_KVNORM, I_WUKV, I_GNHY, I_GNAT, I_WOUT,
       I_NMIXPRE, I_NMIXPOST, I_NMLPPRE, I_NMLPPOST, I_WUP, I_WDOWN };

__device__ __forceinline__ int rope_src(int p) { return 4 * (p >> 3) + (p & 3) + 16 * ((p >> 2) & 1); }
template <bool ROPEPERM>
__device__ __forceinline__ void transpose_item(const GAS float* W, int K, int N, GAS bf16* WT, LAS float* scr, int item, int lane, int ldk = 0, int koff = 0) {
    if (ldk == 0) ldk = K;
    const int nblk = N / 32, kb = item / nblk, nb = item % nblk, k0 = 64 * kb, n0 = 32 * nb;
    int sc = lane & 31; if (ROPEPERM && (nb % 3) == 2) sc = rope_src(sc);
#pragma unroll 8
    for (int i = 0; i < 32; ++i) { const int kk = 2 * i + (lane >> 5); scr[kk * 33 + (lane & 31)] = W[(size_t)(k0 + kk) * N + n0 + sc]; }
    LDS_WAIT(); asm volatile("" ::: "memory");
    const int c = lane & 7;
#pragma unroll
    for (int j = 0; j < 4; ++j) { const int n = (lane >> 3) + 8 * j; const LAS float* s = scr + (8 * c) * 33 + n;
        v4u o; o.x = pk2(s[0 * 33], s[1 * 33]); o.y = pk2(s[2 * 33], s[3 * 33]); o.z = pk2(s[4 * 33], s[5 * 33]); o.w = pk2(s[6 * 33], s[7 * 33]);
        *(GAS v4u*)(WT + (size_t)(n0 + n) * ldk + koff + k0 + 8 * c) = o; }
    LDS_WAIT(); asm volatile("" ::: "memory");
}
__device__ __forceinline__ void phase_weights(Frame& F, int l) {
    LAS float* scr = (LAS float*)(F.lds + RING_OFF + F.wave * 16384);
    const int gw = F.vcu * NWAVES + F.wave, NGW = F.G * NWAVES;
    GAS bf16* WinT = (GAS bf16*)(wsq(F) + WS_WIN); GAS bf16* WoutT = (GAS bf16*)(wsq(F) + WS_WOUT); GAS bf16* WupT = (GAS bf16*)(wsq(F) + WS_WUP); GAS bf16* WdownT = (GAS bf16*)(wsq(F) + WS_WDOWN);
    GAS bf16* WuqT = (GAS bf16*)(wsq(F) + WS_WUQ); GAS bf16* WukvT = (GAS bf16*)(wsq(F) + WS_WUKV);
    constexpr int I_IN = (D / 64) * (INW / 32), I_OUT = (D / 64) * (D / 32), I_UP = (D / 64) * (FF / 32), I_DN = (FF / 64) * (D / 32), I_UQ = (QR / 64) * (NQ / 32), I_UKV = (KVR / 64) * (NKV / 32);
    constexpr int I_W3 = 2048 / 32;
    constexpr int NITEMS = I_IN + I_OUT + I_UP + I_DN + I_UQ + I_UKV + 2 * I_W3;
    for (int it = gw; it < NITEMS; it += NGW) {
        int r = it;
        if (r < I_IN) { transpose_item<false>(inp(F, I_WIN) + (size_t)l * D * INW, D, INW, WinT, scr, r, F.lane); continue; } r -= I_IN;
        if (r < I_OUT) { transpose_item<false>(inp(F, I_WOUT) + (size_t)l * D * D, D, D, WoutT, scr, r, F.lane); continue; } r -= I_OUT;
        if (r < I_UP) { transpose_item<false>(inp(F, I_WUP) + (size_t)l * D * FF, D, FF, WupT, scr, r, F.lane); continue; } r -= I_UP;
        if (r < I_DN) { transpose_item<false>(inp(F, I_WDOWN) + (size_t)l * FF * D, FF, D, WdownT, scr, r, F.lane); continue; } r -= I_DN;
        if (r < I_UQ) { transpose_item<true>(inp(F, I_WUQ) + (size_t)l * QR * NQ, QR, NQ, WuqT, scr, r, F.lane); continue; } r -= I_UQ;
        if (r < I_UKV) { transpose_item<false>(inp(F, I_WUKV) + (size_t)l * KVR * NKV, KVR, NKV, WukvT, scr, r, F.lane); continue; } r -= I_UKV;
        transpose_item<false>(inp(F, I_FW3) + (size_t)l * 64 * 2048, 64, 2048, (GAS bf16*)(wsq(F) + WS_W3T), scr, r % I_W3, F.lane, 128, (r / I_W3) * 64);
    }
    { unsigned z = 0u; asm volatile("" : "+v"(z)); const v4u zz = {z, z, z, z};
      for (int i = gw * 64 + F.lane; i < 12288; i += NGW * 64) ((GAS v4u*)(WinT + (size_t)INW * D))[i] = zz; }
}
__device__ __forceinline__ void phase_rope_tab(Frame& F) {
    const float inv[16] = {1.000000000e+00f, 5.623413324e-01f, 3.162277639e-01f, 1.778279394e-01f, 1.000000015e-01f, 5.623412877e-02f, 3.162277862e-02f, 1.778279431e-02f,
                           9.999999776e-03f, 5.623413250e-03f, 3.162277862e-03f, 1.778279431e-03f, 1.000000047e-03f, 5.623413017e-04f, 3.162277862e-04f, 1.778279402e-04f};
    GAS float* ct = (GAS float*)(wsq(F) + WS_COS); GAS float* st = (GAS float*)(wsq(F) + WS_SIN);
    for (int i = F.vcu * NTHR + F.tid; i < L * 16; i += F.G * NTHR) {
        const int t = i >> 4, j = i & 15; float iv = inv[0];
#pragma unroll
        for (int q = 1; q < 16; ++q) iv = (j == q) ? inv[q] : iv;
        const float ang = (float)t * iv; ct[i] = cosf(ang); st[i] = sinf(ang);
    }
}
__device__ __forceinline__ const GAS float* x_src_row(Frame& F, int l, int m) {
    if (l == 0) return (m < 2 * L) ? inp(F, I_XP) + (size_t)m * D : inp(F, I_XS) + (size_t)(m - 2 * L) * D;
    return (const GAS float*)F.out + (size_t)m * D;
}
__device__ __forceinline__ void store_xn_row(f32x4 (&v)[4], float rstd, const GAS float* g, GAS bf16* orow, int lane) {
    GAS v2u* o8 = (GAS v2u*)orow + lane;
#pragma unroll
    for (int j = 0; j < 4; ++j) { const f32x4 gg = ((const GAS f32x4*)g)[lane + 64 * j]; v2u w; w.x = pk2(v[j].x * rstd * gg.x, v[j].y * rstd * gg.y); w.y = pk2(v[j].z * rstd * gg.z, v[j].w * rstd * gg.w); o8[64 * j] = w; }
}
__device__ __forceinline__ float row_ss(const f32x4 (&v)[4]) { float s = 0.f;
#pragma unroll
    for (int j = 0; j < 4; ++j) s += (v[j].x * v[j].x + v[j].y * v[j].y) + (v[j].z * v[j].z + v[j].w * v[j].w);
    return wave_sum(s); }
__device__ __forceinline__ void phase_norm_first(Frame& F, int l, const GAS float* g) {
    const int gw = F.vcu * NWAVES + F.wave, NGW = F.G * NWAVES; GAS bf16* XN = (GAS bf16*)(wsq(F) + WS_XN);
    for (int m0 = gw; m0 < M; m0 += 4 * NGW) {
        f32x4 v[4][4];
#pragma unroll
        for (int q = 0; q < 4; ++q) { const int mm = m0 + q * NGW, m = mm < M ? mm : M - 1; const GAS f32x4* xr = (const GAS f32x4*)x_src_row(F, l, m) + F.lane;
#pragma unroll
            for (int j = 0; j < 4; ++j) v[q][j] = xr[64 * j]; }
#pragma unroll
        for (int q = 0; q < 4; ++q) { const int m = m0 + q * NGW; if (m >= M) break;
            const float rstd = 1.0f / sqrtf(row_ss(v[q]) * (1.0f / D) + EPS);
            store_xn_row(v[q], rstd, g, XN + (size_t)m * D, F.lane); }
    }
}
template <bool SRC_IN, bool DST_OUT>
__device__ __forceinline__ void phase_norm_res(Frame& F, const GAS bf16* T, const GAS float* gpost, const GAS float* gnext) {
    const int gw = F.vcu * NWAVES + F.wave, NGW = F.G * NWAVES; GAS bf16* XN = (GAS bf16*)(wsq(F) + WS_XN); GAS bf16* XR = (GAS bf16*)(wsq(F) + WS_XR);
    constexpr int R = SRC_IN ? 2 : 4;
    for (int m0 = gw; m0 < M; m0 += R * NGW) {
        f32x4 vf[SRC_IN ? R : 1][4]; v2u xw[SRC_IN ? 1 : R][4], tw[R][4];
#pragma unroll
        for (int q = 0; q < R; ++q) { const int mm = m0 + q * NGW, m = mm < M ? mm : M - 1; const GAS v2u* tr = (const GAS v2u*)(T + (size_t)m * D) + F.lane;
            if (SRC_IN) { const GAS f32x4* xr = (const GAS f32x4*)x_src_row(F, 0, m) + F.lane;
#pragma unroll
                for (int j = 0; j < 4; ++j) vf[SRC_IN ? q : 0][j] = xr[64 * j]; }
            else { const GAS v2u* xr = (const GAS v2u*)(XR + (size_t)m * D) + F.lane;
#pragma unroll
                for (int j = 0; j < 4; ++j) xw[SRC_IN ? 0 : q][j] = xr[64 * j]; }
#pragma unroll
            for (int j = 0; j < 4; ++j) tw[q][j] = tr[64 * j]; }
#pragma unroll
        for (int q = 0; q < R; ++q) { const int m = m0 + q * NGW; if (m >= M) break;
            f32x4 v[4], tv[4];
#pragma unroll
            for (int j = 0; j < 4; ++j) { const v2u w = tw[q][j]; tv[j] = (f32x4){bf2f(w.x & 0xffffu), bf2f(w.x >> 16), bf2f(w.y & 0xffffu), bf2f(w.y >> 16)};
                if (SRC_IN) v[j] = vf[SRC_IN ? q : 0][j]; else { const v2u x = xw[SRC_IN ? 0 : q][j]; v[j] = (f32x4){bf2f(x.x & 0xffffu), bf2f(x.x >> 16), bf2f(x.y & 0xffffu), bf2f(x.y >> 16)}; } }
            const float rt = 1.0f / sqrtf(row_ss(tv) * (1.0f / D) + EPS);
#pragma unroll
            for (int j = 0; j < 4; ++j) { const f32x4 gg = ((const GAS f32x4*)gpost)[F.lane + 64 * j]; v[j] = v[j] + tv[j] * rt * gg; }
            if (DST_OUT) { GAS f32x4* orow = (GAS f32x4*)(F.out + (size_t)m * D) + F.lane;
#pragma unroll
                for (int j = 0; j < 4; ++j) orow[64 * j] = v[j]; }
            else { GAS v2u* orow = (GAS v2u*)(XR + (size_t)m * D) + F.lane;
#pragma unroll
                for (int j = 0; j < 4; ++j) { v2u w; w.x = pk2(v[j].x, v[j].y); w.y = pk2(v[j].z, v[j].w); orow[64 * j] = w; } }
            if (gnext) { const float rstd = 1.0f / sqrtf(row_ss(v) * (1.0f / D) + EPS); store_xn_row(v, rstd, gnext, XN + (size_t)m * D, F.lane); } }
    }
}

__device__ __forceinline__ void phase_filter_mlp(Frame& F, int l) {
    const GAS float* w1 = inp(F, I_FW1) + (size_t)l * 33 * 64; const GAS float* b1 = inp(F, I_FB1) + l * 64; const GAS float* w2 = inp(F, I_FW2) + (size_t)l * 64 * 64; const GAS float* b2 = inp(F, I_FB2) + l * 64;
    const GAS float* sf = inp(F, I_SINF) + l * 128; GAS bf16* H2 = (GAS bf16*)(wsq(F) + WS_H2);
    const int lane = F.lane, gw = F.vcu * NWAVES + F.wave, NGW = F.G * NWAVES;
    float w1c[33], w2c[64];
#pragma unroll
    for (int f = 0; f < 33; ++f) w1c[f] = w1[f * 64 + lane];
#pragma unroll
    for (int i = 0; i < 64; ++i) w2c[i] = w2[i * 64 + lane];
    const float b1l = b1[lane], b2l = b2[lane], sf0 = sf[lane], sf1 = sf[64 + lane];
    for (int n = gw; n < L; n += NGW) {
        const float tn = (float)n * (1.0f / (float)(L - 1)); const float omega = (float)(2.0 * 3.14159265358979323846 / L) * (float)n;
        const int bidx = (lane >= 17) ? lane - 17 : lane - 1; const float band = 1e-4f + (float)bidx * ((15.0f - 1e-4f) / 15.0f); const float ph = omega * band;
        const float zf = (lane == 0) ? tn : ((lane <= 16) ? cosf(ph) : -sinf(ph));
        float acc = b1l;
#pragma unroll
        for (int f = 0; f < 33; ++f) acc += __uint_as_float(__builtin_amdgcn_readlane(__float_as_uint(zf), f)) * w1c[f];
        const float h1 = sinf(sf0 * acc);
        float acc2 = b2l;
#pragma unroll
        for (int i = 0; i < 64; ++i) acc2 += __uint_as_float(__builtin_amdgcn_readlane(__float_as_uint(h1), i)) * w2c[i];
        const float hv = sinf(sf1 * acc2); const bf16 hi = f2bf(hv);
        H2[(size_t)n * 128 + lane] = hi; H2[(size_t)n * 128 + 64 + lane] = f2bf(hv - bf2f(hi));
    }
}
typedef float f32x4u __attribute__((ext_vector_type(4), aligned(4)));
__device__ __forceinline__ void taps_stage(const GAS float* fw0, const GAS float* bw0, const GAS float* fw1, const GAS float* bw1, bool odd, LAS f32x2* buf, int t) {
    const float sg = odd ? -1.f : 1.f;
#pragma unroll 1
    for (int h = 0; h < 2; ++h) { const int tq = hfft::opaque(t) + 2048 * h; f32x4 a0[4], a1[4], r0[4], r1[4];
#pragma unroll
        for (int q = 0; q < 4; ++q) { const int c = tq + 512 * q; a0[q] = *(const GAS f32x4*)(fw0 + 4 * c); a1[q] = *(const GAS f32x4*)(fw1 + 4 * c);
            r0[q] = *(const GAS f32x4u*)(bw0 + (L - 3 - 4 * c)); r1[q] = *(const GAS f32x4u*)(bw1 + (L - 3 - 4 * c)); }
#pragma unroll
        for (int q = 0; q < 4; ++q) { const int c = tq + 512 * q; const float e0 = c > 0 ? r0[q][3] : 0.f, e1 = c > 0 ? r1[q][3] : 0.f;
            LAS f32x4* dst = (LAS f32x4*)(buf + 4 * c);
            dst[0] = (f32x4){a0[q][0] + sg * e0, a1[q][0] + sg * e1, a0[q][1] + sg * r0[q][2], a1[q][1] + sg * r1[q][2]};
            dst[1] = (f32x4){a0[q][2] + sg * r0[q][1], a1[q][2] + sg * r1[q][1], a0[q][3] + sg * r0[q][0], a1[q][3] + sg * r1[q][0]}; } }
}
__device__ __forceinline__ void phase_filter_fft(Frame& F, int l) {
    const GAS float* KT = (const GAS float*)(wsq(F) + WS_KT); GAS f32x2* KEO = (GAS f32x2*)(wsq(F) + WS_KEO); const GAS float* hb = inp(F, I_HBIAS) + (size_t)l * 2 * HYW;
    LAS f32x2* buf = (LAS f32x2*)(F.lds + RING_OFF); const int t = F.tid;
    for (int c = F.vcu; c < HYW; c += F.G) {
        const GAS float* fw0 = KT + (size_t)(0 * HYW + c) * L; const GAS float* bw0 = KT + (size_t)(1 * HYW + c) * L;
        const GAS float* fw1 = KT + (size_t)(2 * HYW + c) * L; const GAS float* bw1 = KT + (size_t)(3 * HYW + c) * L;
        const float bias0 = hb[c], bias1 = hb[HYW + c]; const float sc = 1.0f / (2.0f * L);
        GAS f32x2* k0 = KEO + (size_t)c * KEO_BLK; GAS f32x2* k1 = KEO + (size_t)(HYW + c) * KEO_BLK;
        float ar[32], ai[32];
#pragma unroll 1
        for (int odd = 0; odd < 2; ++odd) {
            HT0();
            __syncthreads(); taps_stage(fw0, bw0, fw1, bw1, odd != 0, buf, t); __syncthreads();
            { const int tq = hfft::opaque(t);
#pragma unroll
              for (int m = 0; m < 32; ++m) { const int n = tq + 512 * m; const f32x2 v = buf[n];
                  if (!odd) { ar[m] = v.x; ai[m] = v.y; }
                  else { const float d0 = v.x, d1 = v.y; const float fr = (float)n * (1.0f / 32768.0f); const float cs = __builtin_amdgcn_cosf(fr), sn = -__builtin_amdgcn_sinf(fr);
                         ar[m] = d0 * cs - d1 * sn; ai[m] = d0 * sn + d1 * cs; } } }
            HT1(11); if (HYSUB != 40) HT0(); hfft::fft16k<false>(ar, ai, buf, t); HT1(12); HT0();
            __syncthreads();
            { const int tq = hfft::opaque(t);
#pragma unroll
              for (int m = 0; m < 32; ++m) buf[hfft::pad(tq + 512 * m)] = (f32x2){ar[m], ai[m]}; }
            __syncthreads();
            { const int tq = hfft::opaque(t); GAS f32x2* d0 = k0 + (odd ? KEO_KO : 0); GAS f32x2* d1 = k1 + (odd ? KEO_KO : 0);
#pragma unroll
              for (int m = 0; m <= 16; ++m) { const int k = tq + 512 * m; const bool keep = odd ? (k < 8192) : (k <= 8192);
                  const int rk = odd ? 16383 - k : ((16384 - k) & 16383); const f32x2 xq = buf[hfft::pad(rk)]; const float cr = xq.x, ci = -xq.y;
                  const float a0 = 0.5f * (ar[m] + cr), a1 = 0.5f * (ai[m] + ci), b0 = 0.5f * (ai[m] - ci), b1 = -0.5f * (ar[m] - cr);
                  if (keep) { d0[k] = (f32x2){(a0 + bias0) * sc, a1 * sc}; d1[k] = (f32x2){(b0 + bias1) * sc, b1 * sc}; } } }
            HT1(13);
        }
    }
    __syncthreads();
}

__device__ __forceinline__ float u_conv3(const GAS bf16* row, int n, float w0, float w1, float w2, float cb) {
    const int nm = n >= 1 ? n - 1 : 0, np = n + 1 < L ? n + 1 : L - 1;
    float um = bf2f(row[nm]), up = bf2f(row[np]); const float u0 = bf2f(row[n]);
    um = n >= 1 ? um : 0.f; up = n + 1 < L ? up : 0.f;
    return um * w0 + u0 * w1 + up * w2 + cb;
}
__device__ __forceinline__ void conv3_stage(const GAS bf16* r0, const GAS bf16* r1, float w0, float w1, float w2, float cb, float v0, float v1, float v2, float vb, LAS f32x2* buf, int t) {
    const int tq = hfft::opaque(t);
#pragma unroll
    for (int q = 0; q < 4; ++q) { const int j = tq + 512 * q; const bool hl = j > 0, hr = j < L / 8 - 1; const int nl = hl ? 8 * j - 1 : 0, nr = hr ? 8 * j + 8 : L - 1;
        const v4u a = *(const GAS v4u*)(r0 + 8 * j), b = *(const GAS v4u*)(r1 + 8 * j);
        float al = bf2f(r0[nl]), ar = bf2f(r0[nr]), bl = bf2f(r1[nl]), br = bf2f(r1[nr]);
        al = hl ? al : 0.f; bl = hl ? bl : 0.f; ar = hr ? ar : 0.f; br = hr ? br : 0.f;
        const float ua[10] = {al, __uint_as_float(a.x << 16), __uint_as_float(a.x & 0xffff0000u), __uint_as_float(a.y << 16), __uint_as_float(a.y & 0xffff0000u),
                              __uint_as_float(a.z << 16), __uint_as_float(a.z & 0xffff0000u), __uint_as_float(a.w << 16), __uint_as_float(a.w & 0xffff0000u), ar};
        const float ub[10] = {bl, __uint_as_float(b.x << 16), __uint_as_float(b.x & 0xffff0000u), __uint_as_float(b.y << 16), __uint_as_float(b.y & 0xffff0000u),
                              __uint_as_float(b.z << 16), __uint_as_float(b.z & 0xffff0000u), __uint_as_float(b.w << 16), __uint_as_float(b.w & 0xffff0000u), br};
        LAS f32x4* dst = (LAS f32x4*)(buf + 8 * j);
#pragma unroll
        for (int e = 0; e < 8; e += 2) { f32x4 o;
            o[0] = ua[e] * w0 + ua[e + 1] * w1 + ua[e + 2] * w2 + cb; o[1] = ub[e] * v0 + ub[e + 1] * v1 + ub[e + 2] * v2 + vb;
            o[2] = ua[e + 1] * w0 + ua[e + 2] * w1 + ua[e + 3] * w2 + cb; o[3] = ub[e + 1] * v0 + ub[e + 2] * v1 + ub[e + 3] * v2 + vb; dst[e >> 1] = o; } }
}
__device__ __forceinline__ void cmul_spec(float (&xr)[32], float (&xi)[32], const GAS f32x2* ke, int t, bool odd) {
    { const int tq = hfft::opaque(t); (void)tq;
#pragma unroll
    for (int m = 0; m < 32; ++m) { const int k = tq + 512 * m; int idx; bool cj;
        if (!odd) { cj = k > 8192; idx = cj ? 16384 - k : k; } else { cj = k >= 8192; idx = cj ? 16383 - k : k; }
        const f32x2 kv = ke[idx]; const float kr = kv.x, ki = cj ? -kv.y : kv.y;
        const float a = xr[m], b = xi[m]; xr[m] = a * kr - b * ki; xi[m] = a * ki + b * kr; if ((m & 15) == 15) { asm volatile("" ::: "memory"); __builtin_amdgcn_sched_barrier(0); } }
    }
}
__device__ __forceinline__ f32x2 ld_spec(const GAS f32x2* ke, int k, bool odd) {
    int idx; bool cj;
    if (!odd) { cj = k > 8192; idx = cj ? 16384 - k : k; } else { cj = k >= 8192; idx = cj ? 16383 - k : k; }
    f32x2 kv = ke[idx]; kv.y = cj ? -kv.y : kv.y; return kv;
}
__device__ __forceinline__ void cmul_spec2(float (&xr)[32], float (&xi)[32], const GAS f32x2* ka, const GAS f32x2* kb, LAS f32x2* buf, int t, bool odd) {
    __syncthreads();
    { const int tq = hfft::opaque(t);
#pragma unroll
      for (int m = 0; m < 32; ++m) buf[hfft::pad(tq + 512 * m)] = (f32x2){xr[m], xi[m]}; }
    __syncthreads();
    { const int tq = hfft::opaque(t);
#pragma unroll
      for (int m = 0; m < 32; ++m) { const int k = tq + 512 * m; const int rk = odd ? 16383 - k : ((16384 - k) & 16383);
          const f32x2 xc = buf[hfft::pad(rk)];
          const f32x2 a = ld_spec(ka, k, odd), b = ld_spec(kb, k, odd);
          const float sr = 0.5f * (a.x + b.x), si = 0.5f * (a.y + b.y), dr = 0.5f * (a.x - b.x), di = 0.5f * (a.y - b.y);
          const float x0 = xr[m], x1 = xi[m], c0 = xc.x, c1 = -xc.y;
          xr[m] = (x0 * sr - x1 * si) + (c0 * dr - c1 * di); xi[m] = (x0 * si + x1 * sr) + (c0 * di + c1 * dr);
          if ((m & 7) == 7) { asm volatile("" ::: "memory"); __builtin_amdgcn_sched_barrier(0); } } }
}
__device__ __forceinline__ void spec_prefetch(const GAS f32x2* ke, LAS unsigned char* lds, int t) {
    const int tq = hfft::opaque(t); const GAS unsigned char* src = (const GAS unsigned char*)ke + (tq >> 6) * 1024 + (tq & 63) * 16;
#pragma unroll
    for (int p = 0; p < 9; ++p) { int off = p * 8192; if (p == 8) off = (tq >> 6) == 0 ? off : 0;
        __builtin_amdgcn_global_load_lds((const GAS unsigned*)(src + off), (LAS unsigned*)(lds + RING_OFF + 135168), 16, 0, 0); }
}
__device__ __forceinline__ void phase_hyena(Frame& F, int l) {
    const GAS bf16* UT = (const GAS bf16*)(wsq(F) + WS_UT); GAS bf16* YT = (GAS bf16*)(wsq(F) + WS_YT); const GAS f32x2* KEO = (const GAS f32x2*)(wsq(F) + WS_KEO);
    const GAS float* cw = inp(F, I_CONVW) + (size_t)l * 3 * HYP; const GAS float* cbv = inp(F, I_CONVB) + (size_t)l * HYP;
    LAS f32x2* buf = (LAS f32x2*)(F.lds + RING_OFF); const int t = F.tid;
    GAS f32x2* G0 = (GAS f32x2*)(wsq(F) + WS_G0) + (size_t)F.vcu * 16384 + t;
    for (int item = F.vcu; item < HYW + HYW / 2; item += F.G) {
        const bool mode1 = item >= HYW;
        const int c0 = mode1 ? 2 * (item - HYW) : item, c1 = mode1 ? c0 + 1 : c0;
        const size_t s0 = mode1 ? (size_t)2 * L : 0, s1 = mode1 ? (size_t)2 * L : (size_t)L;
        float ar[32], ai[32]; unsigned ep[32];
#pragma unroll 1
        for (int o = 0; o < 2; ++o) {
            const GAS f32x2* ke0 = KEO + (size_t)(o * HYW + c0) * KEO_BLK; const GAS f32x2* ke1 = KEO + (size_t)(o * HYW + c1) * KEO_BLK;
#pragma unroll 1
            for (int half = 0; half < 2; ++half) {
                if (HYSUB != 40) HT0();
                if (o == 0) { const float w0 = cw[c0], w1 = cw[HYP + c0], w2 = cw[2 * HYP + c0], cb = cbv[c0], v0 = cw[c1], v1 = cw[HYP + c1], v2 = cw[2 * HYP + c1], vb = cbv[c1];
                    const GAS bf16* r0 = UT + (size_t)c0 * M + s0; const GAS bf16* r1 = UT + (size_t)c1 * M + s1;
                    __syncthreads(); conv3_stage(r0, r1, w0, w1, w2, cb, v0, v1, v2, vb, buf, t); __syncthreads();
                    { const int tq = hfft::opaque(t);
#pragma unroll
                    for (int m = 0; m < 32; ++m) { const f32x2 v = buf[tq + 512 * m]; ar[m] = v.x; ai[m] = v.y; } }
                    }
                else {
                    { const int tq = hfft::opaque(t); (void)tq; GAS f32x2* G0q = G0 + (tq - t);
#pragma unroll
                    for (int m = 0; m < 32; ++m) { const f32x2 v = G0q[m * 512]; ar[m] = v.x; ai[m] = v.y; if ((m & 15) == 15) { asm volatile("" ::: "memory"); __builtin_amdgcn_sched_barrier(0); } } }
                    }
                HT1(1);
                if (half == 0) {
                    spec_prefetch(ke0, F.lds, t); if (mode1) spec_prefetch(ke1, F.lds, t);
                    if (HYSUB != 40) HT0(); hfft::fft16k<false>(ar, ai, buf, t); HT1(2); if (HYSUB != 40) HT0();
                    if (mode1) cmul_spec2(ar, ai, ke0, ke1, buf, t, false); else cmul_spec(ar, ai, ke0, t, false);
                    HT1(3); if (HYSUB != 40) HT0(); hfft::fft16k<true>(ar, ai, buf, t); HT1(2); if (HYSUB != 40) HT0();
                    {
#pragma unroll
                    for (int m = 0; m < 32; ++m) ep[m] = pk2(ar[m], ai[m]);
                    }
                    HT1(4);
                } else {
                    if (HYSUB != 40) HT0();
                    { const int tq = hfft::opaque(t); (void)tq;
#pragma unroll
                    for (int m = 0; m < 32; ++m) { const float fr = (float)(tq + 512 * m) * (1.0f / 32768.0f); const float cs = __builtin_amdgcn_cosf(fr), sn = -__builtin_amdgcn_sinf(fr);
                        const float a = ar[m], b = ai[m]; ar[m] = a * cs - b * sn; ai[m] = a * sn + b * cs; }
                    }
                    spec_prefetch(ke0 + KEO_KO, F.lds, t); if (mode1) spec_prefetch(ke1 + KEO_KO, F.lds, t);
                    HT1(5); if (HYSUB != 40) HT0(); hfft::fft16k<false>(ar, ai, buf, t); HT1(2); if (HYSUB != 40) HT0();
                    if (mode1) cmul_spec2(ar, ai, ke0 + KEO_KO, ke1 + KEO_KO, buf, t, true); else cmul_spec(ar, ai, ke0 + KEO_KO, t, true);
                    HT1(3); if (HYSUB != 40) HT0(); hfft::fft16k<true>(ar, ai, buf, t); HT1(2); if (HYSUB != 40) HT0();
                    const int g0 = (o + 1) * HYW + c0, g1 = (o + 1) * HYW + c1;
                    const float w0 = cw[g0], w1 = cw[HYP + g0], w2 = cw[2 * HYP + g0], cb = cbv[g0], v0 = cw[g1], v1 = cw[HYP + g1], v2 = cw[2 * HYP + g1], vb = cbv[g1];
                    const GAS bf16* r0 = UT + (size_t)g0 * M + s0; const GAS bf16* r1 = UT + (size_t)g1 * M + s1;
                    __syncthreads(); conv3_stage(r0, r1, w0, w1, w2, cb, v0, v1, v2, vb, buf, t); __syncthreads();
                    { const int tq = hfft::opaque(t); (void)tq;
#pragma unroll
                    for (int m = 0; m < 32; ++m) { const int n = tq + 512 * m; const float fr = (float)n * (1.0f / 32768.0f); const float cs = __builtin_amdgcn_cosf(fr), sn = __builtin_amdgcn_sinf(fr); const f32x2 g = buf[n];
                        const float a = ar[m], b = ai[m]; const f32x2 e = {__uint_as_float(ep[m] << 16), __uint_as_float(ep[m] & 0xffff0000u)}; const float yr = e.x + (a * cs - b * sn), yi = e.y + (a * sn + b * cs);
                        ar[m] = yr * g.x; ai[m] = yi * g.y; }
                    }
                    if (o == 0) {
                        { const int tq = hfft::opaque(t); (void)tq; GAS f32x2* G0q = G0 + (tq - t);
#pragma unroll
                        for (int m = 0; m < 32; ++m) G0q[m * 512] = (f32x2){ar[m], ai[m]};
                        }
                    } else { GAS bf16* y0 = YT + (size_t)c0 * M + s0; GAS bf16* y1 = YT + (size_t)c1 * M + s1;
                        { const int tq = hfft::opaque(t); (void)tq;
#pragma unroll
                        for (int m = 0; m < 32; ++m) { const int n = tq + 512 * m; y0[n] = f2bf(ar[m]); y1[n] = f2bf(ai[m]); } }
                        }
                    HT1(6);
                }
            }
        }
    }
    __syncthreads();
}

__device__ __forceinline__ void phase_mla_prep(Frame& F, int l) {
    const GAS bf16* CQKV = (const GAS bf16*)(wsq(F) + WS_CQKV); GAS bf16* CQN = (GAS bf16*)(wsq(F) + WS_CQN); GAS bf16* CKVN = (GAS bf16*)(wsq(F) + WS_CKVN); GAS bf16* KPE = (GAS bf16*)(wsq(F) + WS_KPE);
    const GAS float* gq = inp(F, I_QNORM) + l * QR; const GAS float* gkv = inp(F, I_KVNORM) + l * KVR; const GAS float* ct = (const GAS float*)(wsq(F) + WS_COS); const GAS float* st = (const GAS float*)(wsq(F) + WS_SIN);
    const int gw = F.vcu * NWAVES + F.wave, NGW = F.G * NWAVES, lane = F.lane;
    for (int m0 = gw; m0 < M; m0 += 4 * NGW) {
        v2u q[4]; unsigned kv[4]; float x1[4], x2[4], cs[4], sn[4]; const int j = lane & 15;
#pragma unroll
        for (int u = 0; u < 4; ++u) { const int mm = m0 + u * NGW, m = mm < M ? mm : M - 1; const GAS bf16* row = CQKV + (size_t)m * 512; const int tpos = m & (L - 1);
            q[u] = *(const GAS v2u*)(row + 4 * lane); kv[u] = *(const GAS unsigned*)(row + 256 + 2 * lane);
            x1[u] = bf2f(row[384 + j]); x2[u] = bf2f(row[384 + 16 + j]); cs[u] = ct[tpos * 16 + j]; sn[u] = st[tpos * 16 + j]; }
        const f32x4 g4 = *(const GAS f32x4*)(gq + 4 * lane); const f32x2 g2 = *(const GAS f32x2*)(gkv + 2 * lane);
#pragma unroll
        for (int u = 0; u < 4; ++u) { const int m = m0 + u * NGW; if (m >= M) break;
            const float q0 = bf2f(q[u].x & 0xffffu), q1 = bf2f(q[u].x >> 16), q2 = bf2f(q[u].y & 0xffffu), q3 = bf2f(q[u].y >> 16), k0 = bf2f(kv[u] & 0xffffu), k1 = bf2f(kv[u] >> 16);
            const float rq = 1.0f / sqrtf(wave_sum((q0 * q0 + q1 * q1) + (q2 * q2 + q3 * q3)) * (1.0f / QR) + EPS);
            const float rk = 1.0f / sqrtf(wave_sum(k0 * k0 + k1 * k1) * (1.0f / KVR) + EPS);
            v2u oq; oq.x = pk2(q0 * rq * g4.x, q1 * rq * g4.y); oq.y = pk2(q2 * rq * g4.z, q3 * rq * g4.w);
            *(GAS v2u*)(CQN + (size_t)m * QR + 4 * lane) = oq;
            *(GAS unsigned*)(CKVN + (size_t)m * KVR + 2 * lane) = pk2(k0 * rk * g2.x, k1 * rk * g2.y);
            if (lane < 16) { const int p1 = 8 * (j >> 2) + (j & 3); KPE[(size_t)m * ROPE + p1] = f2bf(x1[u] * cs[u] - x2[u] * sn[u]); KPE[(size_t)m * ROPE + p1 + 4] = f2bf(x2[u] * cs[u] + x1[u] * sn[u]); } }
    }
}

__device__ __forceinline__ void phase_hy_out(Frame& F, int l) {
    const GAS bf16* YT = (const GAS bf16*)(wsq(F) + WS_YT); GAS bf16* MIX = (GAS bf16*)(wsq(F) + WS_MIX); const GAS float* gn = inp(F, I_GNHY) + l * HYW;
    LAS bf16* tl = (LAS bf16*)(F.lds + RING_OFF + F.wave * 16384);
    const int gw = F.vcu * NWAVES + F.wave, NGW = F.G * NWAVES, lane = F.lane;
    for (int task = gw; task < 8 * (M / 64); task += NGW) {
        const int g = task & 7, tb = task >> 3, tok0 = tb * 64; const int cl = lane >> 3, t8 = (lane & 7) * 8;
        float v[8][8]; float ss[8]; const int ln_ = hw_lane();
#pragma unroll
        for (int j = 0; j < 8; ++j) ss[j] = 0.f;
#pragma unroll
        for (int i = 0; i < 8; ++i) { const int ch = g * 64 + 8 * i + cl; const v4u w = *(const GAS v4u*)(YT + (size_t)ch * M + tok0 + t8);
            v[i][0] = bf2f(w.x & 0xffffu); v[i][1] = bf2f(w.x >> 16); v[i][2] = bf2f(w.y & 0xffffu); v[i][3] = bf2f(w.y >> 16);
            v[i][4] = bf2f(w.z & 0xffffu); v[i][5] = bf2f(w.z >> 16); v[i][6] = bf2f(w.w & 0xffffu); v[i][7] = bf2f(w.w >> 16);
#pragma unroll
            for (int j = 0; j < 8; ++j) ss[j] += v[i][j] * v[i][j]; }
#pragma unroll
        for (int j = 0; j < 8; ++j) { float s = ss[j]; s += shx(s, ln_, 8); s += shx(s, ln_, 16); s += shx(s, ln_, 32); ss[j] = 1.0f / sqrtf(s * (1.0f / 64.0f) + EPS); }
#pragma unroll
        for (int i = 0; i < 8; ++i) { const int cc = 8 * i + cl; const float gg = gn[g * 64 + cc];
#pragma unroll
            for (int j = 0; j < 8; ++j) tl[(t8 + j) * 72 + cc] = f2bf(v[i][j] * ss[j] * gg); }
        LDS_WAIT(); asm volatile("" ::: "memory");
#pragma unroll
        for (int i = 0; i < 8; ++i) { const int tok = 8 * i + (lane >> 3), c8 = (lane & 7) * 8; const v4u w = *(const LAS v4u*)(tl + tok * 72 + c8);
            *(GAS v4u*)(MIX + (size_t)(tok0 + tok) * D + g * 64 + c8) = w; }
        LDS_WAIT(); asm volatile("" ::: "memory");
    }
}

namespace att {
using s16x4 = __attribute__((ext_vector_type(4))) short;
using f32x16 = __attribute__((ext_vector_type(16))) float;
using u32x4 = __attribute__((ext_vector_type(4))) unsigned;
constexpr int QBLK = 32, KVBLK = 64, NW = 8;
constexpr float SCALE = 0.10206207261596575f;
constexpr float THR = 8.f;
constexpr int SHM_K = KVBLK * 256, SHM_V = KVBLK * DV * 2;
constexpr int NSLOT = 4;
constexpr int OFF_V = 0, OFF_K = NSLOT * SHM_V, OFF_WS = OFF_K + NSLOT * SHM_K, SHM_ATTN = OFF_WS + NW * 64 * 4;
#define KSWZ(row, colB) ((row) * 256 + ((colB) ^ (((row) & 15) << 4)))
#define SBAR() __builtin_amdgcn_sched_barrier(0)
__device__ __forceinline__ int crow(int r, int hi) { return (r & 3) + 8 * (r >> 2) + 4 * hi; }
__device__ __forceinline__ unsigned cvtpk(float lo, float hi) { unsigned r; asm volatile("v_cvt_pk_bf16_f32 %0, %1, %2" : "=v"(r) : "v"(lo), "v"(hi)); return r; }
constexpr float THRL = THR * 1.4426950408889634f;
#define EX2(v) ((ABL & 1) ? (v) : __builtin_amdgcn_exp2f(v))
#define MX3(a, b, c) ((ABL & 128) ? (a) : __builtin_fmaxf(__builtin_fmaxf((a), (b)), (c)))
__device__ __forceinline__ int v_st(int k, int c) { const int kk = k; return ((kk >> 3) * 2 + (c >> 5)) * 512 + ((kk & 7) * 32 + (c & 31)) * 2; }
__device__ __forceinline__ int v_rd_base(int lane) { return ((lane & 3) << 3) | (((lane >> 2) & 3) << 6) | (((lane >> 4) & 1) << 5) | (((lane >> 5) & 1) << 8); }
constexpr int v_rd_off(int d0, int ks, int half) { return d0 * 512 + ks * 2048 + half * 1024; }
template <int OFF> __device__ __forceinline__ s16x4 tr_read(int vb) { s16x4 r; asm volatile("ds_read_b64_tr_b16 %0, %1 offset:%2" : "=&v"(r) : "v"(vb), "i"(OFF) : "memory"); return r; }
template <int ABL, bool FAST> __device__ __forceinline__ bool attn_unit(const bf16* Qb_, const bf16* KNh_, const bf16* KPEb_, const bf16* Vh_, bf16* Mo_,
                                          const float* gain_, const float* ct_, const float* st_, int tpos0, LAS char* lds, const int wave0) {
  const GAS bf16* Qb = (const GAS bf16*)Qb_; const GAS bf16* KNh = (const GAS bf16*)KNh_; const GAS bf16* KPEb = (const GAS bf16*)KPEb_; const GAS bf16* Vh = (const GAS bf16*)Vh_; GAS bf16* Mo = (GAS bf16*)Mo_;
  const GAS float* gain = (const GAS float*)gain_; const GAS float* ct = (const GAS float*)ct_; const GAS float* st = (const GAS float*)st_;

  int tid_ = tid_from_wave(wave0);
  const int tid = tid_, wid = tid >> 6, lane = tid & 63, r32 = lane & 31, hi = lane >> 5;
  LAS char* V_lds = lds + OFF_V; LAS char* K_lds = lds + OFF_K;
  LAS float* ws = (LAS float*)(lds + OFF_WS) + wid * 64; LAS float* li_l = ws; LAS float* al_l = ws + 32;
  volatile LAS unsigned* bad_l = (volatile LAS unsigned*)(lds + SHM_ATTN);
  if (FAST && tid == 0) *bad_l = 0u;
  float m_reg = 0.f, l_reg = 0.f; f32x16 o[2] = {}; f32x16 negm = {}; bf16x8 qr[6];
  const GAS bf16* Qw = Qb + (long)(wid * QBLK + r32) * NQ + hi * 8;
#pragma unroll
  for (int d0 = 0; d0 < 6; ++d0) qr[d0] = *reinterpret_cast<const GAS bf16x8*>(Qw + d0 * 16);
  { const int tq = tpos0 + wid * QBLK + r32;
#pragma unroll
    for (int d0 = 4; d0 < 6; ++d0) { const int fq = 2 * (d0 - 4) + hi; const f32x4 cs = *reinterpret_cast<const GAS f32x4*>(ct + tq * 16 + 4 * fq), sn = *reinterpret_cast<const GAS f32x4*>(st + tq * 16 + 4 * fq);
      const u32x4 w = __builtin_bit_cast(u32x4, qr[d0]);
      const f32x4 x1 = {bf2f(w[0] & 0xffffu), bf2f(w[0] >> 16), bf2f(w[1] & 0xffffu), bf2f(w[1] >> 16)}, x2 = {bf2f(w[2] & 0xffffu), bf2f(w[2] >> 16), bf2f(w[3] & 0xffffu), bf2f(w[3] >> 16)};
      const f32x4 a = x1 * cs - x2 * sn, b = x2 * cs + x1 * sn;
      const u32x4 o4 = {cvtpk(a[0], a[1]), cvtpk(a[2], a[3]), cvtpk(b[0], b[1]), cvtpk(b[2], b[3])}; qr[d0] = __builtin_bit_cast(bf16x8, o4); } }
  { constexpr float C = SCALE * 1.4426950408889634f;
#pragma unroll
    for (int d0 = 0; d0 < 6; ++d0) { const u32x4 w = __builtin_bit_cast(u32x4, qr[d0]); u32x4 o4;
#pragma unroll
      for (int e = 0; e < 4; ++e) o4[e] = cvtpk(bf2f(w[e] & 0xffffu) * C, bf2f(w[e] >> 16) * C);
      qr[d0] = __builtin_bit_cast(bf16x8, o4); } }
  const int vb0 = (int)(unsigned)(uintptr_t)V_lds + v_rd_base(lane);
  const int wid_s = __builtin_amdgcn_readfirstlane(wid);
  const GAS bf16* ksrc[2]; long kstep[2];
#pragma unroll
  for (int q = 0; q < 2; ++q) { const int r = 4 * (2 * wid + q) + (lane >> 4), c = (lane & 15) ^ (r & 15); const bool rope = (c >= 8) && (c < 12);
    ksrc[q] = rope ? KPEb + (long)r * ROPE + (c - 8) * 8 : KNh + (long)r * NKV + (c & 7) * 8; kstep[q] = rope ? (long)KVBLK * ROPE : (long)KVBLK * NKV; }
  const GAS bf16* vsrc; { const int p = 64 * wid + lane, sub = p >> 5, kk = (sub >> 1) * 8 + ((p >> 2) & 7), col = (sub & 1) * 32 + (p & 3) * 8; vsrc = Vh + (long)kk * NKV + col; }
#define DMA(t, slot) do { if (ABL & 32) break; \
    __builtin_amdgcn_global_load_lds((const GAS unsigned*)(ksrc[0] + (long)(t) * kstep[0]), (LAS unsigned*)(K_lds + (slot) * SHM_K + (2 * wid_s) * 1024), 16, 0, 0); \
    __builtin_amdgcn_global_load_lds((const GAS unsigned*)(ksrc[1] + (long)(t) * kstep[1]), (LAS unsigned*)(K_lds + (slot) * SHM_K + (2 * wid_s + 1) * 1024), 16, 0, 0); \
    __builtin_amdgcn_global_load_lds((const GAS unsigned*)(vsrc + (long)(t) * ((long)KVBLK * NKV)), (LAS unsigned*)(V_lds + (slot) * SHM_V + wid_s * 1024), 16, 0, 0); } while (0)
#define TBAR(N) do { asm volatile("s_waitcnt vmcnt(" #N ") lgkmcnt(0)" ::: "memory"); if (!(ABL & 64)) __builtin_amdgcn_s_barrier(); asm volatile("" ::: "memory"); } while (0)
#define RESC(a) do { if (__any((a) < 1.f)) { if (hi == 0) al_l[r32] = (a); asm volatile("s_waitcnt lgkmcnt(0)" ::: "memory"); \
    _Pragma("unroll") for (int d = 0; d < 2; ++d) _Pragma("unroll") for (int r = 0; r < 16; ++r) o[d][r] *= al_l[crow(r, hi)]; } } while (0)
  f32x16 pA0, pA1, pB0, pB1; bf16x8 pa0, pa1, pa2, pa3; constexpr int NTL = L / KVBLK; constexpr int SE = 0, SO = 1;
  int koff[6];
#pragma unroll
  for (int d0 = 0; d0 < 6; ++d0) koff[d0] = KSWZ(r32, (d0 * 16 + hi * 8) * 2);
  s16x4 vl[4], vh[4]; float pmax = 0.f, alpha = 1.f; unsigned w0_ = 0, w1_ = 0; float sa_ = 0.f, sb_ = 0.f;
#define KFR(i) ((ABL & 8) ? qr[(i) >> 1] : *(const LAS bf16x8*)(kbase + koff[(i) >> 1] + ((i) & 1) * 8192))
#define MQK(a_, b_, c_) ((ABL & 2) ? (c_) : __builtin_amdgcn_mfma_f32_32x32x16_bf16(a_, b_, c_, 0, 0, 0))
#define MPV(a_, b_, c_) ((ABL & 4) ? (c_) : __builtin_amdgcn_mfma_f32_32x32x16_bf16(a_, b_, c_, 0, 0, 0))
#define VRD8(D0) do { if (ABL & 16) break; vl[0] = tr_read<v_rd_off(D0, 0, 0)>(vbq); vh[0] = tr_read<v_rd_off(D0, 0, 1)>(vbq); vl[1] = tr_read<v_rd_off(D0, 1, 0)>(vbq); vh[1] = tr_read<v_rd_off(D0, 1, 1)>(vbq); \
    vl[2] = tr_read<v_rd_off(D0, 2, 0)>(vbq); vh[2] = tr_read<v_rd_off(D0, 2, 1)>(vbq); vl[3] = tr_read<v_rd_off(D0, 3, 0)>(vbq); vh[3] = tr_read<v_rd_off(D0, 3, 1)>(vbq); } while (0)
#define VWAIT() if (!(ABL & 16)) asm volatile("s_waitcnt lgkmcnt(0)" : "+v"(vl[0]), "+v"(vh[0]), "+v"(vl[1]), "+v"(vh[1]), "+v"(vl[2]), "+v"(vh[2]), "+v"(vl[3]), "+v"(vh[3]) :: "memory")
#define VFR(k) (bf16x8){vl[k][0], vl[k][1], vl[k][2], vl[k][3], vh[k][0], vh[k][1], vh[k][2], vh[k][3]}
#define PKA(P, B) do { if (ABL & 256) break; w0_ = cvtpk(P[B + 0], P[B + 1]); w1_ = cvtpk(P[B + 2], P[B + 3]); } while (0)
#define PKB(P, B, OUT) do { if (ABL & 256) { OUT = qr[0]; break; } const u32x4 w_ = {w0_, w1_, cvtpk(P[B + 4], P[B + 5]), cvtpk(P[B + 6], P[B + 7])}; OUT = __builtin_bit_cast(bf16x8, w_); } while (0)
#define R1(DO_QK, DO_FIN, X0, X1, Y0, Y1, KSLOT) do { const LAS char* kbase = K_lds + (KSLOT) * SHM_K; bf16x8 kf0, kf1, kf2, kf3; unsigned w0_ = 0, w1_ = 0; \
    if (DO_QK) { kf0 = KFR(0); kf1 = KFR(1); kf2 = KFR(2); } SBAR(); \
      if (DO_QK) { kf3 = KFR(3); X0 = MQK(kf0, qr[0], negm); } if (DO_FIN) { Y0[0] = EX2(Y0[0]); Y0[1] = EX2(Y0[1]); Y0[2] = EX2(Y0[2]); Y0[3] = EX2(Y0[3]); } SBAR(); \
      if (DO_QK) { kf0 = KFR(4); X1 = MQK(kf1, qr[0], negm); } if (DO_FIN) { Y0[4] = EX2(Y0[4]); Y0[5] = EX2(Y0[5]); Y0[6] = EX2(Y0[6]); Y0[7] = EX2(Y0[7]); } SBAR(); \
      if (DO_QK) { kf1 = KFR(5); X0 = MQK(kf2, qr[1], X0); } if (DO_FIN) { Y0[8] = EX2(Y0[8]); Y0[9] = EX2(Y0[9]); Y0[10] = EX2(Y0[10]); Y0[11] = EX2(Y0[11]); } SBAR(); \
      if (DO_QK) { kf2 = KFR(6); X1 = MQK(kf3, qr[1], X1); } if (DO_FIN) { Y0[12] = EX2(Y0[12]); Y0[13] = EX2(Y0[13]); Y0[14] = EX2(Y0[14]); Y0[15] = EX2(Y0[15]); } SBAR(); \
      if (DO_QK) { kf3 = KFR(7); X0 = MQK(kf0, qr[2], X0); } if (DO_FIN) { Y1[0] = EX2(Y1[0]); Y1[1] = EX2(Y1[1]); Y1[2] = EX2(Y1[2]); Y1[3] = EX2(Y1[3]); PKA(Y0, 0); } SBAR(); \
      if (DO_QK) { kf0 = KFR(8); X1 = MQK(kf1, qr[2], X1); } if (DO_FIN) { Y1[4] = EX2(Y1[4]); Y1[5] = EX2(Y1[5]); Y1[6] = EX2(Y1[6]); Y1[7] = EX2(Y1[7]); PKB(Y0, 0, pa0); } SBAR(); \
      if (DO_QK) { kf1 = KFR(9); X0 = MQK(kf2, qr[3], X0); } if (DO_FIN) { Y1[8] = EX2(Y1[8]); Y1[9] = EX2(Y1[9]); Y1[10] = EX2(Y1[10]); Y1[11] = EX2(Y1[11]); PKA(Y0, 8); } SBAR(); \
      if (DO_QK) { kf2 = KFR(10); X1 = MQK(kf3, qr[3], X1); } if (DO_FIN) { Y1[12] = EX2(Y1[12]); Y1[13] = EX2(Y1[13]); Y1[14] = EX2(Y1[14]); Y1[15] = EX2(Y1[15]); PKB(Y0, 8, pa1); } SBAR(); \
      if (DO_QK) { kf3 = KFR(11); X0 = MQK(kf0, qr[4], X0); } if (DO_FIN) { PKA(Y1, 0); } SBAR(); \
      if (DO_QK) { X1 = MQK(kf1, qr[4], X1); } if (DO_FIN) { PKB(Y1, 0, pa2); } SBAR(); \
      if (DO_QK) { X0 = MQK(kf2, qr[5], X0); } if (DO_FIN) { PKA(Y1, 8); } SBAR(); \
      if (DO_QK) { X1 = MQK(kf3, qr[5], X1); } if (DO_FIN) { PKB(Y1, 8, pa3); } SBAR(); \
  } while (0)
#define R2(DO_PV, DO_MAX, X0, X1, Y0, Y1, VSLOT, LOADS) do { const int vbq = vb0 + (VSLOT) * SHM_V; float ma_ = 0.f, mb_ = 0.f, sa_ = 0.f; \
    if (DO_PV) { VRD8(0); } SBAR(); \
    if (DO_PV) { VWAIT(); o[0] = MPV(pa0, VFR(0), o[0]); if (!(ABL & 640)) sa_ = (Y0[0] + Y0[1]) + (Y0[2] + Y0[3]); } SBAR(); \
    if (DO_PV) { o[0] = MPV(pa1, VFR(1), o[0]); if (!(ABL & 640)) sa_ += Y0[4]; if (!(ABL & 640)) sa_ += Y0[5]; if (!(ABL & 640)) sa_ += Y0[6]; if (!(ABL & 640)) sa_ += Y0[7]; } LOADS; SBAR(); \
    if (DO_PV) { o[0] = MPV(pa2, VFR(2), o[0]); if (!(ABL & 640)) sa_ += Y0[8]; if (!(ABL & 640)) sa_ += Y0[9]; if (!(ABL & 640)) sa_ += Y0[10]; if (!(ABL & 640)) sa_ += Y0[11]; } SBAR(); \
    if (DO_PV) { o[0] = MPV(pa3, VFR(3), o[0]); if (!(ABL & 640)) sa_ += Y0[12]; if (!(ABL & 640)) sa_ += Y0[13]; if (!(ABL & 640)) sa_ += Y0[14]; if (!(ABL & 640)) sa_ += Y0[15]; } SBAR(); \
    if (DO_PV) { VRD8(1); if (!(ABL & 640)) sa_ += Y1[0]; if (!(ABL & 640)) sa_ += Y1[1]; if (!(ABL & 640)) sa_ += Y1[2]; if (!(ABL & 640)) sa_ += Y1[3]; if (!(ABL & 640)) sa_ += Y1[4]; if (!(ABL & 640)) sa_ += Y1[5]; if (!(ABL & 640)) sa_ += Y1[6]; if (!(ABL & 640)) sa_ += Y1[7]; } \
    if (DO_MAX) { ma_ = MX3(X0[0], X0[1], X1[0]); mb_ = MX3(X0[2], X0[3], X1[1]); ma_ = MX3(ma_, X1[2], X1[3]); ma_ = MX3(ma_, X0[4], X0[5]); mb_ = MX3(mb_, X0[6], X0[7]); ma_ = MX3(ma_, X1[4], X1[5]); mb_ = MX3(mb_, X1[6], X1[7]); } SBAR(); \
    if (DO_PV) { VWAIT(); o[1] = MPV(pa0, VFR(0), o[1]); if (!(ABL & 640)) sa_ += Y1[8]; if (!(ABL & 640)) sa_ += Y1[9]; if (!(ABL & 640)) sa_ += Y1[10]; if (!(ABL & 640)) sa_ += Y1[11]; } if (DO_MAX) { ma_ = MX3(ma_, X0[8], X0[9]); mb_ = MX3(mb_, X0[10], X0[11]); } SBAR(); \
    if (DO_PV) { o[1] = MPV(pa1, VFR(1), o[1]); if (!(ABL & 640)) sa_ += Y1[12]; if (!(ABL & 640)) sa_ += Y1[13]; if (!(ABL & 640)) sa_ += Y1[14]; if (!(ABL & 640)) sa_ += Y1[15]; } if (DO_MAX) { ma_ = MX3(ma_, X1[8], X1[9]); mb_ = MX3(mb_, X1[10], X1[11]); } SBAR(); \
    if (DO_PV) { o[1] = MPV(pa2, VFR(2), o[1]); l_reg += sa_; if (ABL & 512) { o[0] = MPV(pa0, qr[0], o[0]); o[0] = MPV(pa1, qr[0], o[0]); } } if (DO_MAX) { ma_ = MX3(ma_, X0[12], X0[13]); mb_ = MX3(mb_, X0[14], X0[15]); ma_ = MX3(ma_, X1[12], X1[13]); mb_ = MX3(mb_, X1[14], X1[15]); } SBAR(); \
    if (DO_PV) { o[1] = MPV(pa3, VFR(3), o[1]); if (ABL & 512) { o[0] = MPV(pa2, qr[0], o[0]); o[0] = MPV(pa3, qr[0], o[0]); } } if (DO_MAX) { float m_ = __builtin_fmaxf(ma_, mb_); auto rr_ = __builtin_amdgcn_permlane32_swap(__float_as_uint(m_), __float_as_uint(m_), false, false); pmax = __builtin_fmaxf(__uint_as_float(rr_[0]), __uint_as_float(rr_[1])); } SBAR(); \
  } while (0)
#define EXF(Y, i) Y[i] = EX2(Y[i])
#define R1F(X0, X1, Y0, Y1, KSLOT) do { const LAS char* kbase = K_lds + (KSLOT) * SHM_K; bf16x8 kf0, kf1, kf2, kf3; \
    kf0 = KFR(0); kf1 = KFR(1); kf2 = KFR(2); SBAR(); \
      kf3 = KFR(3); X0 = MQK(kf0, qr[0], negm); EXF(Y0, 0); EXF(Y0, 1); EXF(Y0, 2); SBAR(); \
      kf0 = KFR(4); X1 = MQK(kf1, qr[0], negm); EXF(Y0, 3); EXF(Y0, 4); EXF(Y0, 5); SBAR(); \
      kf1 = KFR(5); X0 = MQK(kf2, qr[1], X0); EXF(Y0, 6); EXF(Y0, 7); PKA(Y0, 0); SBAR(); \
      kf2 = KFR(6); X1 = MQK(kf3, qr[1], X1); EXF(Y0, 8); EXF(Y0, 9); PKB(Y0, 0, pa0); SBAR(); \
      kf3 = KFR(7); X0 = MQK(kf0, qr[2], X0); EXF(Y0, 10); EXF(Y0, 11); sa_ = Y0[0] + Y0[1]; sb_ = Y0[2] + Y0[3]; SBAR(); \
      kf0 = KFR(8); X1 = MQK(kf1, qr[2], X1); EXF(Y0, 12); EXF(Y0, 13); sa_ += Y0[4]; sb_ += Y0[5]; SBAR(); \
      kf1 = KFR(9); X0 = MQK(kf2, qr[3], X0); EXF(Y0, 14); EXF(Y0, 15); PKA(Y0, 8); SBAR(); \
      kf2 = KFR(10); X1 = MQK(kf3, qr[3], X1); EXF(Y1, 0); EXF(Y1, 1); PKB(Y0, 8, pa1); SBAR(); \
      kf3 = KFR(11); X0 = MQK(kf0, qr[4], X0); EXF(Y1, 2); EXF(Y1, 3); sa_ += Y0[6]; sb_ += Y0[7]; SBAR(); \
      X1 = MQK(kf1, qr[4], X1); EXF(Y1, 4); EXF(Y1, 5); sa_ += Y0[8]; sb_ += Y0[9]; SBAR(); \
      X0 = MQK(kf2, qr[5], X0); EXF(Y1, 6); EXF(Y1, 7); PKA(Y1, 0); SBAR(); \
      X1 = MQK(kf3, qr[5], X1); EXF(Y1, 8); EXF(Y1, 9); PKB(Y1, 0, pa2); SBAR(); \
  } while (0)
#define R2F(Y0, Y1, VSLOT, LOADS) do { const int vbq = vb0 + (VSLOT) * SHM_V; \
    VRD8(0); SBAR(); \
      VWAIT(); o[0] = MPV(pa0, VFR(0), o[0]); EXF(Y1, 10); EXF(Y1, 11); sa_ += Y0[10]; sb_ += Y0[11]; SBAR(); \
      o[0] = MPV(pa1, VFR(1), o[0]); EXF(Y1, 12); EXF(Y1, 13); sa_ += Y0[12]; sb_ += Y0[13]; LOADS; SBAR(); \
      o[0] = MPV(pa2, VFR(2), o[0]); EXF(Y1, 14); EXF(Y1, 15); PKA(Y1, 8); SBAR(); \
      PKB(Y1, 8, pa3); o[0] = MPV(pa3, VFR(3), o[0]); sa_ += Y0[14]; sb_ += Y0[15]; sa_ += Y1[0]; SBAR(); \
    VRD8(1); sb_ += Y1[1]; sa_ += Y1[2]; sb_ += Y1[3]; SBAR(); \
      VWAIT(); o[1] = MPV(pa0, VFR(0), o[1]); sa_ += Y1[4]; sb_ += Y1[5]; sa_ += Y1[6]; sb_ += Y1[7]; SBAR(); \
      o[1] = MPV(pa1, VFR(1), o[1]); sa_ += Y1[8]; sb_ += Y1[9]; sa_ += Y1[10]; sb_ += Y1[11]; SBAR(); \
      o[1] = MPV(pa2, VFR(2), o[1]); sa_ += Y1[12]; sb_ += Y1[13]; sa_ += Y1[14]; sb_ += Y1[15]; SBAR(); \
      o[1] = MPV(pa3, VFR(3), o[1]); l_reg += sa_ + sb_; SBAR(); \
  } while (0)
#define DECIDE(FIRST, X0, X1) do { alpha = 1.f; \
    if ((FIRST) || !__builtin_expect(__all(pmax <= THRL), 1)) { const float d_ = (FIRST) ? pmax : __builtin_fmaxf(pmax, 0.f); m_reg += d_; if (!(FIRST)) alpha = EX2(-d_); \
      _Pragma("unroll") for (int r = 0; r < 16; ++r) { X0[r] -= d_; X1[r] -= d_; } \
      _Pragma("unroll") for (int r = 0; r < 16; ++r) negm[r] = -m_reg; l_reg *= alpha; } \
    RESC(alpha); } while (0)
  DMA(0, 0); DMA(1, 1);
  TBAR(3);
  R1(true, false, pA0, pA1, pB0, pB1, 0);
  R2(false, true, pA0, pA1, pB0, pB1, 0, DMA(2, 2));
  DECIDE(true, pA0, pA1);
  TBAR(3);
  for (int j = 1; j + 1 < NTL; j += 2) {
    if (FAST) { R1F(pB0, pB1, pA0, pA1, j & 3); R2F(pA0, pA1, (j - 1) & 3, DMA(j + 2, (j + 2) & 3)); }
    else { R1(true, true, pB0, pB1, pA0, pA1, j & 3);
    R2(true, true, pB0, pB1, pA0, pA1, (j - 1) & 3, DMA(j + 2, (j + 2) & 3));
    DECIDE(false, pB0, pB1); }
    TBAR(3);
    if (FAST) { R1F(pA0, pA1, pB0, pB1, (j + 1) & 3); R2F(pB0, pB1, j & 3, if (j + 3 < NTL) DMA(j + 3, (j + 3) & 3)); }
    else { R1(true, true, pA0, pA1, pB0, pB1, (j + 1) & 3);
    R2(true, true, pA0, pA1, pB0, pB1, j & 3, if (j + 3 < NTL) DMA(j + 3, (j + 3) & 3));
    DECIDE(false, pA0, pA1); }
    if (j + 3 < NTL) TBAR(3); else TBAR(0);
  }
  if (FAST) { R1F(pB0, pB1, pA0, pA1, (NTL - 1) & 3); R2F(pA0, pA1, (NTL - 2) & 3, (void)0); }
  else { R1(true, true, pB0, pB1, pA0, pA1, (NTL - 1) & 3);
  R2(true, true, pB0, pB1, pA0, pA1, (NTL - 2) & 3, (void)0);
  DECIDE(false, pB0, pB1); }
  R1(false, true, pA0, pA1, pB0, pB1, 0);
  R2(true, false, pA0, pA1, pB0, pB1, (NTL - 1) & 3, (void)0);
#undef DECIDE
#undef R1F
#undef R2F
#undef EXF
#undef R2
#undef R1
#undef PKA
#undef PKB
#undef VFR
#undef VWAIT
#undef VRD8
#undef KFR
  if (FAST) {
    if (__any(!(l_reg < 1.0e30f)) && lane == 0) *bad_l = 1u;
    __syncthreads();
    const unsigned bad = *bad_l;
    if (__builtin_amdgcn_readfirstlane((int)bad) != 0) { __syncthreads(); return false; }
  }
  { auto rr = __builtin_amdgcn_permlane32_swap(__float_as_uint(l_reg), __float_as_uint(l_reg), false, false); l_reg = __uint_as_float(rr[0]) + __uint_as_float(rr[1]); }
  if (hi == 0) li_l[r32] = l_reg; asm volatile("s_waitcnt lgkmcnt(0)" ::: "memory");
  const float g0 = gain[r32], g1 = gain[32 + r32]; const int ln_ = hw_lane();
  GAS bf16* Ow = Mo + (long)(wid * QBLK) * D;
#pragma unroll
  for (int r = 0; r < 16; ++r) { const int orow = crow(r, hi); const float rl = __builtin_amdgcn_rcpf(li_l[orow]);
    const float y0 = o[0][r] * rl, y1 = o[1][r] * rl; float s = y0 * y0 + y1 * y1;
    s += shx(s, ln_, 1); s += shx(s, ln_, 2); s += shx(s, ln_, 4); s += shx(s, ln_, 8); s += shx(s, ln_, 16);
    const float rs = 1.0f / sqrtf(s * (1.0f / 64.0f) + EPS);
    Ow[(long)orow * D + r32] = f2bf(y0 * rs * g0); Ow[(long)orow * D + 32 + r32] = f2bf(y1 * rs * g1); }
  __syncthreads();
  return true;
#undef DMA
#undef TBAR
#undef RESC
}
#undef EX2
#undef MX3
#undef KSWZ
#undef SBAR
}
#define XB_TMO      128
#define XB_XCNT(j)  (256  + 64 * (j))
#define XB_XSUB(j)  (1280 + 64 * (j))
#define XB_XGEN(j)  (2304 + 64 * (j))
#define XB_TOP      3328
#define XB_TOPGEN   3392
#define XCD_BAR_WORDS 3456
#define XB_SPIN_CAP (1u << 18)

__device__ __forceinline__ unsigned xb_ld(unsigned* p)              { return __hip_atomic_load(p, __ATOMIC_RELAXED, __HIP_MEMORY_SCOPE_AGENT); }
__device__ __forceinline__ unsigned xb_add(unsigned* p, unsigned v) { return __hip_atomic_fetch_add(p, v, __ATOMIC_RELAXED, __HIP_MEMORY_SCOPE_AGENT); }
__device__ __forceinline__ unsigned xb_xcc_id() { return (unsigned)__builtin_amdgcn_s_getreg((3 << 11) | 20) & 0xFu; }
#define XB_SPIN(cond, bar) do { unsigned _sp = 0; while (cond) { __builtin_amdgcn_s_sleep(1); \
    if ((++_sp & 255u) == 0u) { if (xb_ld(&(bar)[XB_TMO])) break; if (_sp > XB_SPIN_CAP) { atomicAdd(&(bar)[XB_TMO], 1u); break; } } } } while (0)

struct XcdBarrier {
    unsigned* bar; unsigned x;
    volatile LAS unsigned* st;
};

__device__ __forceinline__ XcdBarrier xcd_barrier_post(unsigned* bar, volatile LAS unsigned* st, const bool t0) {
    XcdBarrier b; b.bar = bar; b.x = xb_xcc_id(); b.st = st;
    if (t0) (void)xb_add(&bar[XB_XCNT(b.x)], 1u);
    return b;
}
__device__ __forceinline__ void xcd_barrier_complete(unsigned* bar, unsigned x, unsigned& nloc, unsigned& nx) {
    const unsigned G = gridDim.x * gridDim.y * gridDim.z;
    unsigned sum, cnt, mine, sp = 0u;
    for (;;) {
        sum = 0u; cnt = 0u; mine = 0u;
#pragma unroll
        for (unsigned j = 0; j < 16; ++j) { const unsigned c = xb_ld(&bar[XB_XCNT(j)]); sum += c; cnt += (c > 0u) ? 1u : 0u; mine = (j == x) ? c : mine; }
        if (sum == G) break;
        __builtin_amdgcn_s_sleep(1);
        if ((++sp & 255u) == 0u) { if (xb_ld(&bar[XB_TMO])) break; if (sp > XB_SPIN_CAP) { atomicAdd(&bar[XB_TMO], 1u); break; } }
    }
    nloc = mine > 0u ? mine : 1u; nx = cnt > 0u ? cnt : 1u;
}

__device__ __forceinline__ void xcd_barrier(const XcdBarrier& b, const bool t0) {
    asm volatile("s_waitcnt vmcnt(0)" ::: "memory");
    __syncthreads();
    if (t0) {
        unsigned* bar = b.bar;
        __builtin_amdgcn_s_waitcnt(0);
        unsigned nloc = b.st[0], nx = b.st[1];
        if (nloc == 0u) { xcd_barrier_complete(bar, b.x, nloc, nx); b.st[0] = nloc; b.st[1] = nx; }
        const unsigned old = xb_add(&bar[XB_XSUB(b.x)], 1u);
        const unsigned gen = old / nloc;
        if (old + 1u == (gen + 1u) * nloc) {
            __builtin_amdgcn_fence(__ATOMIC_RELEASE, "agent");
            asm volatile("s_waitcnt vmcnt(0)" ::: "memory");
            const unsigned og = xb_add(&bar[XB_TOP], 1u);
            const unsigned tg = og / nx;
            if (og + 1u == (tg + 1u) * nx) xb_add(&bar[XB_TOPGEN], 1u);
            else XB_SPIN(xb_ld(&bar[XB_TOPGEN]) == tg, bar);
            __builtin_amdgcn_fence(__ATOMIC_ACQUIRE, "agent");
            xb_add(&bar[XB_XGEN(b.x)], 1u);
            asm volatile("s_waitcnt vmcnt(0)" ::: "memory");
        } else {
            XB_SPIN(xb_ld(&bar[XB_XGEN(b.x)]) == gen, bar);
            __builtin_amdgcn_fence(__ATOMIC_ACQUIRE, "agent");
            asm volatile("s_waitcnt vmcnt(0)" ::: "memory");
        }
    }
    __syncthreads();
}

__device__ __forceinline__ void xcd_barrier_fast(const XcdBarrier& b, const bool t0) {
    asm volatile("s_waitcnt vmcnt(0)" ::: "memory");
    __syncthreads();
    if (t0) {
        unsigned* bar = b.bar; asm volatile("" : "+s"(bar));
        __builtin_amdgcn_s_waitcnt(0);
        unsigned nloc = b.st[0], nx = b.st[1];
        unsigned bx_ = b.x; asm volatile("" : "+s"(bx_));
        const unsigned old = xb_add(&bar[XB_XSUB(bx_)], 1u);
        const unsigned gen = old / nloc;
        if (old + 1u == (gen + 1u) * nloc) {
            __builtin_amdgcn_fence(__ATOMIC_RELEASE, "agent");
            asm volatile("s_waitcnt vmcnt(0)" ::: "memory");
            const unsigned og = xb_add(&bar[XB_TOP], 1u);
            const unsigned tg = og / nx;
            if (og + 1u == (tg + 1u) * nx) xb_add(&bar[XB_TOPGEN], 1u);
            else XB_SPIN(xb_ld(&bar[XB_TOPGEN]) == tg, bar);
            __builtin_amdgcn_fence(__ATOMIC_ACQUIRE, "agent");
            xb_add(&bar[XB_XGEN(bx_)], 1u);
            asm volatile("s_waitcnt vmcnt(0)" ::: "memory");
        } else {
            XB_SPIN(xb_ld(&bar[XB_XGEN(bx_)]) == gen, bar);
            __builtin_amdgcn_fence(__ATOMIC_ACQUIRE, "agent");
            asm volatile("s_waitcnt vmcnt(0)" ::: "memory");
        }
    }
    __syncthreads();
}

constexpr int CW_BAR = 4096;
struct Args { const float* in[26]; float* out; unsigned char* ws; };
#ifndef REP_ATT
#define REP_ATT 1
#endif
#ifndef REP_GEMM
#define REP_GEMM 1
#endif
#ifndef REP_HY
#define REP_HY 1
#endif
#ifndef REP_FILT
#define REP_FILT 1
#endif
#ifndef REP_PREP
#define REP_PREP 1
#endif
#ifndef REP_HYOUT
#define REP_HYOUT 1
#endif
#ifndef REP_MISC
#define REP_MISC 1
#endif
#ifndef PROBE_MASK
#define PROBE_MASK 0
#endif
#define TIC() do { if (PROBE_MASK) pr_t0 = __builtin_amdgcn_s_memrealtime(); } while (0)
#define TOC(ph) do { if (PROBE_MASK & (1u << (ph))) pr_acc += __builtin_amdgcn_s_memrealtime() - pr_t0; } while (0)
#define REPEAT(n) _Pragma("unroll 1") for (int rep_ = 0; rep_ < (n); ++rep_)
#define REFRESH() do { const int t_ = tid_from_wave(F.wave0); F.tid = t_; F.lane = t_ & 63; F.wave = __builtin_amdgcn_readfirstlane(t_ >> 6); int v_ = F.vcu; asm volatile("" : "+s"(v_)); F.vcu = v_; } while (0)
#define BXQ() ({ int b_ = (int)blockIdx.x; asm volatile("" : "+s"(b_)); b_; })
#define GEMM_PHASE(EPI, g, S, E) REPEAT(REP_GEMM) pg8::gemm_phase<EPI, pg8::StaticOrder, true, true>(F.lds + RING_OFF, g, S, E, F.wave0)

__global__ void __launch_bounds__(NTHR, 2) hyena_mla_fwd(Args args) {
    extern __shared__ __attribute__((aligned(16))) unsigned char lds[];
    Frame F;
    F.lds = (LAS unsigned char*)lds;
    F.MISC = (volatile LAS unsigned*)(F.lds + MISC_OFF);
    F.tid = threadIdx.x; F.lane = F.tid & 63; F.wave = __builtin_amdgcn_readfirstlane(F.tid >> 6); F.wave0 = F.wave;
    F.G = gridDim.x; { const int bx = blockIdx.x; F.vcu = (F.G % 8 == 0) ? (bx % 8) * (F.G / 8) + bx / 8 : bx; }
    F.ws = args.ws; F.out = args.out; F.ctl = (gu32*)(args.ws + WS_CTL);
    if (F.tid == 0) {
#pragma unroll
        for (int i = 0; i < 26; ++i) *(LAS unsigned long long*)(F.lds + PTRTAB_OFF + 8 * i) = (unsigned long long)args.in[i];
    }
    for (int u = F.tid; u < 512 / 4; u += NTHR) ((LAS unsigned*)(F.lds + LDSCTL_OFF))[u] = 0u;
    __syncthreads();
    XcdBarrier bar = xcd_barrier_post((unsigned*)(F.ctl + CW_BAR), F.MISC + 8, F.tid == 0);
    xcd_barrier(bar, F.tid == 0);
    unsigned long long pr_t0 = 0, pr_acc = 0; (void)pr_t0;
#pragma unroll 1
    for (int l = 0; l < DEPTH; ++l) {
        TIC();
        HT0(); REPEAT(REP_MISC) { REFRESH(); phase_weights(F, l); }
        __syncthreads(); HT1(21); HT0();
        REFRESH(); phase_filter_mlp(F, l); HT1(22); HT0();
        if (l == 0) { REFRESH(); phase_rope_tab(F); REFRESH(); phase_norm_first(F, 0, inp(F, I_NMIXPRE)); } HT1(23);
        { REFRESH(); xcd_barrier_fast(bar, F.tid == 0); } TOC(0); TIC();
        { unsigned char* w = (unsigned char*)wsq(F); pg8::Gemm g{(bf16*)(w + WS_W3T), (bf16*)(w + WS_H2), 2048, L, 128}; pg8::StaticOrder S; S.init(2048, L, F.G, BXQ());
          pg8::EpiTaps E{(float*)(w + WS_KT), (const float*)inp(F, I_DECAY) + (size_t)l * 2048}; GEMM_PHASE(pg8::EpiTaps, g, S, E); }
        { REFRESH(); xcd_barrier_fast(bar, F.tid == 0); } TOC(1); TIC();
        REPEAT(REP_FILT) { REFRESH(); phase_filter_fft(F, l); }
        { REFRESH(); xcd_barrier_fast(bar, F.tid == 0); } TOC(2); TIC();
        { unsigned char* w = (unsigned char*)wsq(F); bf16* WinT = (bf16*)(w + WS_WIN); bf16* XN = (bf16*)(w + WS_XN); bf16* UT = (bf16*)(w + WS_UT); bf16* CQKV = (bf16*)(w + WS_CQKV);
          { pg8::Gemm g{WinT, XN, HYP, M, D}; pg8::StaticOrder S; S.init(HYP, M, F.G, BXQ());
          pg8::EpiBf16<0> E{UT, M, nullptr, 0, 0, 1.f}; GEMM_PHASE(pg8::EpiBf16<0>, g, S, E); }
        { pg8::Gemm g{XN, WinT + (size_t)HYP * D, M, 512, D}; pg8::StaticOrder S; S.init(M, 512, F.G, (BXQ() + 128) % F.G);
          pg8::EpiBf16<0> E{CQKV, 512, nullptr, 0, 0, 1.f}; GEMM_PHASE(pg8::EpiBf16<0>, g, S, E); } }
        { REFRESH(); xcd_barrier_fast(bar, F.tid == 0); } TOC(3); TIC();
        REPEAT(REP_PREP) { REFRESH(); phase_mla_prep(F, l); }
        HT0(); REPEAT(REP_HY) { REFRESH(); phase_hyena(F, l); } HT1(40);
        { REFRESH(); xcd_barrier_fast(bar, F.tid == 0); } TOC(4); TIC();
        { unsigned char* w = (unsigned char*)wsq(F); bf16* CQN = (bf16*)(w + WS_CQN); bf16* CKVN = (bf16*)(w + WS_CKVN); bf16* WuqT = (bf16*)(w + WS_WUQ); bf16* WukvT = (bf16*)(w + WS_WUKV);
          bf16* Qb = (bf16*)(w + WS_Q); bf16* KV = (bf16*)(w + WS_KN);
          { pg8::Gemm g{CQN, WuqT, M, NQ, QR}; pg8::StaticOrder S; S.init(M, NQ, F.G, BXQ());
          pg8::EpiBf16<0> E{Qb, NQ, nullptr, 0, 0, 1.f}; GEMM_PHASE(pg8::EpiBf16<0>, g, S, E); }
        { pg8::Gemm g{CKVN, WukvT, M, NKV, KVR}; pg8::StaticOrder S; S.init(M, NKV, F.G, BXQ());
          pg8::EpiBf16<0> E{KV, NKV, nullptr, 0, 0, 1.f}; GEMM_PHASE(pg8::EpiBf16<0>, g, S, E); } }
        { REFRESH(); xcd_barrier_fast(bar, F.tid == 0); } TOC(5); TIC();
        REFRESH();
        HT0();
        { unsigned char* w = (unsigned char*)wsq(F); bf16* Qb = (bf16*)(w + WS_Q); bf16* KV = (bf16*)(w + WS_KN); bf16* KPE = (bf16*)(w + WS_KPE); bf16* MIX = (bf16*)(w + WS_MIX);
          const float* ct = (const float*)(w + WS_COS); const float* st = (const float*)(w + WS_SIN); const float* gat = (const float*)inp(F, I_GNAT) + l * 512;
        REPEAT(REP_ATT) for (int i = 0; i < (F.G == 256 ? 6 : (1536 - F.vcu + F.G - 1) / F.G); ++i) {
            const int u_ = F.vcu + i * F.G; const int bh = F.G == 256 ? 3 * (F.vcu >> 5) + (i >> 1) : u_ >> 6, qb = F.G == 256 ? (i & 1) * 32 + (F.vcu & 31) : u_ & 63; const int b = bh >> 3, h = bh & 7;
            const size_t row0 = (size_t)b * L + (size_t)qb * 256;
            if (!att::attn_unit<0, true>(Qb + row0 * NQ + h * DQ, KV + (size_t)b * L * NKV + h * 128, KPE + (size_t)b * L * ROPE, KV + (size_t)b * L * NKV + h * 128 + 64,
                           MIX + row0 * D + 512 + h * 64, gat + h * 64, ct, st, qb * 256, (LAS char*)(F.lds + RING_OFF), F.wave0))
                (void)att::attn_unit<0, false>(Qb + row0 * NQ + h * DQ, KV + (size_t)b * L * NKV + h * 128, KPE + (size_t)b * L * ROPE, KV + (size_t)b * L * NKV + h * 128 + 64,
                           MIX + row0 * D + 512 + h * 64, gat + h * 64, ct, st, qb * 256, (LAS char*)(F.lds + RING_OFF), F.wave0);
        } }
        HT1(32); HT0(); REPEAT(REP_HYOUT) { REFRESH(); phase_hy_out(F, l); } HT1(31);
        { REFRESH(); xcd_barrier_fast(bar, F.tid == 0); } TOC(6); TIC();
        { unsigned char* w = (unsigned char*)wsq(F); bf16* MIX = (bf16*)(w + WS_MIX); bf16* WoutT = (bf16*)(w + WS_WOUT); bf16* T = (bf16*)(w + WS_T);
          pg8::Gemm g{MIX, WoutT, M, D, D}; pg8::StaticOrder S; S.init(M, D, F.G, BXQ());
          pg8::EpiBf16<0> E{T, D, nullptr, 0, 0, 1.f}; GEMM_PHASE(pg8::EpiBf16<0>, g, S, E); }
        { REFRESH(); xcd_barrier_fast(bar, F.tid == 0); } TOC(7); TIC();
        REFRESH(); if (l == 0) phase_norm_res<true, false>(F, (const GAS bf16*)(wsq(F) + WS_T), inp(F, I_NMIXPOST) + l * D, inp(F, I_NMLPPRE) + l * D);
        else phase_norm_res<false, false>(F, (const GAS bf16*)(wsq(F) + WS_T), inp(F, I_NMIXPOST) + l * D, inp(F, I_NMLPPRE) + l * D);
        { REFRESH(); xcd_barrier_fast(bar, F.tid == 0); } TOC(8); TIC();
#pragma unroll 1
        for (int ch = 0; ch < N_MLP_CHUNKS; ++ch) {
            { unsigned char* w = (unsigned char*)wsq(F); bf16* XN = (bf16*)(w + WS_XN); bf16* WupT = (bf16*)(w + WS_WUP); bf16* Hb = (bf16*)(w + WS_H);
              pg8::Gemm g{XN + (size_t)ch * MLP_CHUNK * D, WupT, MLP_CHUNK, FF, D}; pg8::StaticOrder S; S.init(MLP_CHUNK, FF, F.G, BXQ());
              pg8::EpiRelu2 E{Hb, FF}; GEMM_PHASE(pg8::EpiRelu2, g, S, E); }
            { REFRESH(); xcd_barrier_fast(bar, F.tid == 0); } TOC(9); TIC();
            { unsigned char* w = (unsigned char*)wsq(F); bf16* Hb = (bf16*)(w + WS_H); bf16* WdownT = (bf16*)(w + WS_WDOWN); bf16* T = (bf16*)(w + WS_T);
              pg8::Gemm g{Hb, WdownT, MLP_CHUNK, D, FF}; pg8::StaticOrder S; S.init(MLP_CHUNK, D, F.G, BXQ());
              pg8::EpiBf16<0> E{T + (size_t)ch * MLP_CHUNK * D, D, nullptr, 0, 0, 1.f}; GEMM_PHASE(pg8::EpiBf16<0>, g, S, E); }
            { REFRESH(); xcd_barrier_fast(bar, F.tid == 0); } TOC(10); TIC();
        }
        REFRESH(); if (l + 1 < DEPTH) phase_norm_res<false, false>(F, (const GAS bf16*)(wsq(F) + WS_T), inp(F, I_NMLPPOST) + l * D, inp(F, I_NMIXPRE) + (l + 1) * D);
        else phase_norm_res<false, true>(F, (const GAS bf16*)(wsq(F) + WS_T), inp(F, I_NMLPPOST) + l * D, (const GAS float*)nullptr);
        { REFRESH(); xcd_barrier_fast(bar, F.tid == 0); } TOC(11); TIC();
    }
    if (HYSUB) { __syncthreads(); pr_acc += (unsigned long long)__builtin_amdgcn_readfirstlane((int)F.MISC[21]); }
    if (PROBE_MASK || HYSUB) { const unsigned long long ts = __builtin_amdgcn_s_memrealtime(); while (__builtin_amdgcn_s_memrealtime() - ts < pr_acc) __builtin_amdgcn_s_sleep(8); }
}


#ifdef ATT_BENCH
#ifndef ATT_BENCH_FAST
#define ATT_BENCH_FAST 0
#endif
__global__ void __launch_bounds__(NTHR, 2) attn_bench(Args args) {
    extern __shared__ __attribute__((aligned(16))) unsigned char lds[];
    unsigned char* w = args.ws; const int wave0 = __builtin_amdgcn_readfirstlane(threadIdx.x >> 6);
    const int G = gridDim.x, bxv = (int)blockIdx.x, vcu = (bxv % 8) * (G / 8) + bxv / 8;
    bf16* Qb = (bf16*)(w + WS_Q); bf16* KV = (bf16*)(w + WS_KN); bf16* KPE = (bf16*)(w + WS_KPE); bf16* OUT = (bf16*)(w + WS_H);
    const float* ct = (const float*)(w + WS_COS); const float* st = (const float*)(w + WS_SIN);
    for (int rep = 0; rep < ATT_BENCH_REPS; ++rep)
    for (int i = 0; i < 6; ++i) {
        const int bh = 3 * (vcu >> 5) + (i >> 1), qb = (i & 1) * 32 + (vcu & 31); const int b = bh >> 3, h = bh & 7;
        const size_t row0 = (size_t)b * L + (size_t)qb * 256;
        (void)att::attn_unit<ATT_BENCH, (ATT_BENCH_FAST != 0)>(Qb + row0 * NQ + h * DQ, KV + (size_t)b * L * NKV + h * 128, KPE + (size_t)b * L * ROPE, KV + (size_t)b * L * NKV + h * 128 + 64,
                       OUT + row0 * D + 512 + h * 64, args.in[I_GNAT] + h * 64, ct, st, qb * 256, (LAS char*)lds, wave0);
    }
}
#endif
extern "C" void kernel_launch(void* const* d_in, const int* in_sizes, int n_in, void* d_out, int out_size, void* d_ws, size_t ws_size, hipStream_t stream) {
    static int grid = 0;
    if (grid == 0) {
        if (n_in != 26 || out_size != M * D || ws_size < WS_END) { fprintf(stderr, "kernel_launch: shape mismatch n_in %d out %d ws %zu (need %zu)\n", n_in, out_size, ws_size, (size_t)WS_END); grid = -1; return; }
        int dev = 0, cus = 0, per_cu = 0;
        if (hipGetDevice(&dev) != hipSuccess || hipDeviceGetAttribute(&cus, hipDeviceAttributeMultiprocessorCount, dev) != hipSuccess) { grid = -1; return; }
        if (hipFuncSetAttribute((const void*)hyena_mla_fwd, hipFuncAttributeMaxDynamicSharedMemorySize, LDS_BYTES) != hipSuccess) { fprintf(stderr, "kernel_launch: hipFuncSetAttribute failed\n"); grid = -1; return; }
        if (hipOccupancyMaxActiveBlocksPerMultiprocessor(&per_cu, (const void*)hyena_mla_fwd, NTHR, LDS_BYTES) != hipSuccess || per_cu < 1) fprintf(stderr, "kernel_launch: occupancy query says %d\n", per_cu);
        (void)hipGetLastError();
        grid = cus;
    }
    if (grid < 0) return;
    if (hipMemsetAsync((char*)d_ws + WS_CTL, 0, CTL_ZERO_BYTES, stream) != hipSuccess) { fprintf(stderr, "kernel_launch: memset failed\n"); return; }
    Args a{};
    for (int i = 0; i < 26; ++i) a.in[i] = (const float*)d_in[i];
    a.out = (float*)d_out; a.ws = (unsigned char*)d_ws;
    hipLaunchKernelGGL(hyena_mla_fwd, dim3(grid), dim3(NTHR), LDS_BYTES, stream, a);
#ifdef ATT_BENCH
    { static int once = 0; if (!once) { (void)hipFuncSetAttribute((const void*)attn_bench, hipFuncAttributeMaxDynamicSharedMemorySize, LDS_BYTES); once = 1; }
      hipLaunchKernelGGL(attn_bench, dim3(grid), dim3(NTHR), LDS_BYTES, stream, a); }
#endif
    const hipError_t le = hipPeekAtLastError();
    if (le != hipSuccess) fprintf(stderr, "kernel_launch: launch failed: %s\n", hipGetErrorName(le));
}
```

```cpp
#include <hip/hip_runtime.h>
#include <cstdio>
#include <cstdint>
__device__ __forceinline__ int hw_lane() { int l; asm volatile("v_mbcnt_lo_u32_b32 %0, -1, 0\n\tv_mbcnt_hi_u32_b32 %0, -1, %0" : "=v"(l)); return l; }
__device__ __forceinline__ int tid_from_wave(int wave0) { int w = wave0; asm volatile("" : "+s"(w)); int t = w * 64 + hw_lane(); asm volatile("" : "+v"(t)); return t; }
namespace pg8 {
#define PG8_LAS __attribute__((address_space(3)))
#define PG8_GAS __attribute__((address_space(1)))
typedef unsigned short bf16_t;
typedef short bf16x8 __attribute__((ext_vector_type(8)));
typedef float f32x4 __attribute__((ext_vector_type(4)));
typedef unsigned u32x4 __attribute__((ext_vector_type(4)));
constexpr int BM = 256, BK = 64, HALF = 128, HTB = HALF * BK * 2  , STAGE_BYTES = 8 * HTB, NXCD = 8, WGM = 8;

__host__ __device__ __forceinline__ int lds_byte(int r, int c) { const int st = (r >> 4) * 2 + (c >> 5), rr = r & 15, cc = c & 31, ob = rr * 64 + cc * 2; return st * 1024 + (ob ^ (((ob >> 9) & 1) << 5)); }
__host__ __device__ __forceinline__ void stage_rc(int b, int& R, int& C) { const int st = b / 1024, sb = b % 1024, swz = sb ^ (((sb >> 9) & 1) << 5); R = (st >> 1) * 16 + swz / 64; C = (st & 1) * 32 + (swz % 64) / 2; }
__host__ __device__ __forceinline__ int perm32(int rho) { const int n = rho >> 4, i = rho & 15; return 8 * (i >> 2) + 4 * n + (i & 3); }

struct Unit { int pm, pn; };
struct Gemm { const bf16_t* A; const bf16_t* Bt; int M, N, K; };

struct StaticOrder {
    int nM, nN, nwg, G, c;
    __host__ __device__ void init(int M, int N, int G_, int c_) { nM = M / BM; nN = N / BM; nwg = nM * nN; G = G_; c = c_; }
    __host__ __device__ bool next(int i, Unit& u) const {
        const long L = (long)i * G + c; if (L >= nwg) return false;
        int wgid = (int)L; { const int q = nwg / NXCD, r = nwg % NXCD, xcd = wgid % NXCD, off = wgid / NXCD; wgid = (xcd < r ? xcd * (q + 1) : r * (q + 1) + (xcd - r) * q) + off; }
        const int nig = WGM * nN, gid = wgid / nig, fm = gid * WGM, gsz = (nM - fm) < WGM ? (nM - fm) : WGM;
        u.pm = fm + ((wgid % nig) % gsz); u.pn = (wgid % nig) / gsz; return true;
    }
    __device__ __forceinline__ void a_ready(const Unit&) const {}
    __device__ __forceinline__ void done(const Unit&) const {}
};

__device__ __forceinline__ unsigned cvt_pk_bf16(float lo, float hi) { unsigned r; asm volatile("v_cvt_pk_bf16_f32 %0, %1, %2" : "=v"(r) : "v"(lo), "v"(hi)); return r; }
typedef float f32x2 __attribute__((ext_vector_type(2)));
__device__ __forceinline__ void relane(int& wr, int& wc, int& fr, int& fq) { int l = hw_lane(); asm volatile("" : "+v"(l)); fr = l & 15; fq = l >> 4; (void)wr; (void)wc; }
__device__ __forceinline__ f32x2 gelu_pk(f32x2 v) {
    const f32x2 av = __builtin_elementwise_abs(v), d = av * 0.2316418882f + 1.0f;
    f32x2 t; t.x = __builtin_amdgcn_rcpf(d.x); t.y = __builtin_amdgcn_rcpf(d.y);
    f32x2 q = t * 0.5307027145f + (-0.7265760135f); q = q * t + 0.7107068705f; q = q * t + (-0.142248368f); q = q * t + 0.127414796f; q = q * t;
    const f32x2 s = (v * v) * (-0.72134752044f);
    f32x2 e; e.x = __builtin_amdgcn_exp2f(s.x); e.y = __builtin_amdgcn_exp2f(s.y);
    const f32x2 m = v * (q * e), r = v - m;
    f32x2 o; o.x = v.x < 0.f ? m.x : r.x; o.y = v.y < 0.f ? m.y : r.y; return o;
}

template <int ACT  > struct EpiBf16 {
    static constexpr bool PERM = true, AFTER_DRAIN = false; static_assert(ACT == 0 || ACT == 1, "EpiBf16: ACT is 0 (none) or 1 (gelu_pk)");
    bf16_t* O; int ldc; const float* bias; int split_cols; size_t split_stride; float scale0;
    __device__ __forceinline__ void operator()(const f32x4 (&acc)[2][2][4][2], const Unit& u, int wr, int wc, int fr, int fq) const {
        relane(wr, wc, fr, fq);
        const int row0 = u.pm * BM + wr * 64 + fr; int colt = u.pn * BM; bf16_t* base = O;
        float sc = 1.f; if (split_cols) { const int t = colt / split_cols; base += (size_t)t * split_stride; colt -= t * split_cols; if (t == 0) sc = scale0; }
        const int col0 = colt + wc * 32 + 8 * fq, bcol0 = u.pn * BM + wc * 32 + 8 * fq;
        f32x4 bv[2][2];
#pragma unroll
        for (int bj = 0; bj < 2; ++bj)
#pragma unroll
            for (int n = 0; n < 2; ++n) bv[bj][n] = bias ? *(const PG8_GAS f32x4*)(bias + bcol0 + bj * HALF + 4 * n) : (f32x4){0.f, 0.f, 0.f, 0.f};
#pragma unroll
        for (int ai = 0; ai < 2; ++ai)
#pragma unroll
            for (int m = 0; m < 4; ++m) { bf16_t* rowp = base + (size_t)(row0 + ai * HALF + m * 16) * ldc + col0;
#pragma unroll
                for (int bj = 0; bj < 2; ++bj) { f32x4 v0 = acc[ai][bj][m][0] + bv[bj][0], v1 = acc[ai][bj][m][1] + bv[bj][1];
                    if (ACT == 1) { f32x2 a = gelu_pk((f32x2){v0[0], v0[1]}), b = gelu_pk((f32x2){v0[2], v0[3]}), c = gelu_pk((f32x2){v1[0], v1[1]}), d = gelu_pk((f32x2){v1[2], v1[3]});
                        v0 = (f32x4){a.x, a.y, b.x, b.y}; v1 = (f32x4){c.x, c.y, d.x, d.y}; }
                    v0 = v0 * sc; v1 = v1 * sc; u32x4 w; w.x = cvt_pk_bf16(v0[0], v0[1]); w.y = cvt_pk_bf16(v0[2], v0[3]); w.z = cvt_pk_bf16(v1[0], v1[1]); w.w = cvt_pk_bf16(v1[2], v1[3]);
                    *(PG8_GAS u32x4*)(rowp + bj * HALF) = w; } }
    }
};

struct PanelStats {
    unsigned* xbuf;
    unsigned* cnt;
    unsigned* tmo;
    int ntn; float eps;
    unsigned code;
    __device__ __forceinline__ bool run(const f32x4 (&v)[2][2][4][2], const Unit& u, int wr, int wc, int fr, int fq, PG8_LAS unsigned char* lds, int wid, int lane) const {
        typedef float f32x2v __attribute__((ext_vector_type(2)));
        PG8_LAS f32x2v* P = (PG8_LAS f32x2v*)lds;
        PG8_LAS f32x2v* S = (PG8_LAS f32x2v*)(lds + 8192);
        PG8_LAS unsigned* flag = (PG8_LAS unsigned*)(lds + 8192 + 2048);
#pragma unroll
        for (int ai = 0; ai < 2; ++ai)
#pragma unroll
            for (int m = 0; m < 4; ++m) {
                float s = 0.f;
#pragma unroll
                for (int bj = 0; bj < 2; ++bj)
#pragma unroll
                    for (int n = 0; n < 2; ++n) { const f32x4 x = v[ai][bj][m][n]; s += (x[0] + x[1]) + (x[2] + x[3]); }
                s += __shfl_xor(s, 16); s += __shfl_xor(s, 32);
                const float mw = s * (1.0f / 64.0f); float q = 0.f;
#pragma unroll
                for (int bj = 0; bj < 2; ++bj)
#pragma unroll
                    for (int n = 0; n < 2; ++n) { const f32x4 d = v[ai][bj][m][n] - mw; q += (d[0] * d[0] + d[1] * d[1]) + (d[2] * d[2] + d[3] * d[3]); }
                q += __shfl_xor(q, 16); q += __shfl_xor(q, 32);
                if (fq == 0) P[(ai * HALF + wr * 64 + m * 16 + fr) * 4 + wc] = (f32x2v){mw, q};
            }
        asm volatile("s_waitcnt lgkmcnt(0)" ::: "memory"); __builtin_amdgcn_s_barrier(); asm volatile("" ::: "memory");
#if defined(BROKEN_EXCHANGE_NO_WAIT)
#warning BROKEN CONTROL BUILD: the row-statistics exchange does not wait; results are wrong by design
        if (blockIdx.x >= 64) { const long long t0_ = clock64(); while (clock64() - t0_ < 60000) __builtin_amdgcn_s_sleep(8); }
#endif
        const int row = wid * 32 + (lane & 31);
        if (lane < 32) {
            const f32x2v a = P[row * 4 + 0], b = P[row * 4 + 1], c = P[row * 4 + 2], d = P[row * 4 + 3];
            const float mt = (a.x + b.x + c.x + d.x) * 0.25f;
            const float da = a.x - mt, db = b.x - mt, dc = c.x - mt, dd = d.x - mt;
            const float m2 = (a.y + b.y) + (c.y + d.y) + 64.0f * ((da * da + db * db) + (dc * dc + dd * dd));
            unsigned long long* slot = (unsigned long long*)xbuf + ((size_t)(u.pm * BM + row) * 4 + u.pn);
            __hip_atomic_store(slot, ((unsigned long long)__float_as_uint(m2) << 32) | __float_as_uint(mt), __ATOMIC_RELAXED, __HIP_MEMORY_SCOPE_AGENT);
        }
        asm volatile("s_waitcnt vmcnt(0)" ::: "memory");
        if (lane == 0) __hip_atomic_fetch_add(cnt + 64 * u.pm, 1u, __ATOMIC_RELAXED, __HIP_MEMORY_SCOPE_AGENT);
        if (wid == 0) {
            bool dead = false; const unsigned long long t0 = __builtin_amdgcn_s_memrealtime(); const unsigned want = 8u * (unsigned)ntn;
            for (;;) {
#if defined(BROKEN_EXCHANGE_NO_WAIT)
                break;
#endif
                if ((unsigned)__builtin_amdgcn_readfirstlane(__hip_atomic_load(cnt + 64 * u.pm, __ATOMIC_RELAXED, __HIP_MEMORY_SCOPE_AGENT)) >= want) break;
                if (__builtin_amdgcn_s_memrealtime() - t0 > 2000000ull) {
                    if (lane == 0) { unsigned expect = 0u; __hip_atomic_compare_exchange_strong(tmo + 1, &expect, code | (unsigned)(u.pm & 0xff), __ATOMIC_RELAXED, __ATOMIC_RELAXED, __HIP_MEMORY_SCOPE_AGENT);
                                     __hip_atomic_store(tmo, 1u, __ATOMIC_RELAXED, __HIP_MEMORY_SCOPE_AGENT); }
                    dead = true; break; }
                __builtin_amdgcn_s_sleep(2);
            }
            __builtin_amdgcn_fence(__ATOMIC_ACQUIRE, "agent");
            if (lane == 0) flag[0] = dead ? 1u : 0u;
        }
        asm volatile("s_waitcnt vmcnt(0) lgkmcnt(0)" ::: "memory"); __builtin_amdgcn_s_barrier(); asm volatile("" ::: "memory");
        const bool bad = flag[0] != 0u;
        if (lane < 32) {
            const unsigned long long* slot = (const unsigned long long*)xbuf + (size_t)(u.pm * BM + row) * 4; float mt[4], m2[4]; float ms = 0.f;
#pragma unroll
            for (int t = 0; t < 4; ++t) { if (t < ntn) { const unsigned long long w = __hip_atomic_load(slot + t, __ATOMIC_RELAXED, __HIP_MEMORY_SCOPE_AGENT); mt[t] = __uint_as_float((unsigned)w); m2[t] = __uint_as_float((unsigned)(w >> 32)); } else { mt[t] = 0.f; m2[t] = 0.f; } ms += mt[t]; }
            const float mean = ms / (float)ntn; float q = 0.f;
#pragma unroll
            for (int t = 0; t < 4; ++t) if (t < ntn) { const float dm = mt[t] - mean; q += m2[t] + 256.0f * dm * dm; }
            S[row] = (f32x2v){mean, 1.0f / sqrtf(q / (256.0f * (float)ntn) + eps)};
        }
        asm volatile("s_waitcnt lgkmcnt(0)" ::: "memory"); __builtin_amdgcn_s_barrier(); asm volatile("" ::: "memory");
        return bad;
    }
};
struct EpiLnRes {
    static constexpr bool PERM = false, AFTER_DRAIN = true;
    const float* base; float* out; int ldc; const float* bias; PanelStats st; unsigned poison;
    __device__ __forceinline__ void fused(f32x4 (&acc)[2][2][4][2], const Unit& u, int wr, int wc, int fr, int fq, PG8_LAS unsigned char* lds, int wid, int lane) const {
        typedef float f32x2v __attribute__((ext_vector_type(2)));
        const PG8_LAS f32x2v* S = (const PG8_LAS f32x2v*)(lds + 8192);
        const int col0 = u.pn * BM + wc * 32 + 4 * fq;
#pragma unroll
        for (int bj = 0; bj < 2; ++bj)
#pragma unroll
            for (int n = 0; n < 2; ++n) { const f32x4 bv = bias ? *(const f32x4*)(bias + col0 + bj * HALF + n * 16) : (f32x4){0.f, 0.f, 0.f, 0.f};
#pragma unroll
                for (int ai = 0; ai < 2; ++ai)
#pragma unroll
                    for (int m = 0; m < 4; ++m) acc[ai][bj][m][n] += bv; }
        f32x4 pre[4][2][2];
#pragma unroll
        for (int m = 0; m < 4; ++m) { const size_t off = (size_t)(u.pm * BM + wr * 64 + m * 16 + fr) * ldc + col0;
#pragma unroll
            for (int bj = 0; bj < 2; ++bj)
#pragma unroll
                for (int n = 0; n < 2; ++n) pre[m][bj][n] = *(const f32x4*)(base + off + bj * HALF + n * 16); }
        const bool bad = st.run(acc, u, wr, wc, fr, fq, lds, wid, lane) || poison != 0u;
        const float qnan = __builtin_nanf("");
#pragma unroll
        for (int ai = 0; ai < 2; ++ai)
#pragma unroll
            for (int m = 0; m < 4; ++m) { const int r = ai * HALF + wr * 64 + m * 16 + fr; const f32x2v sr = S[r]; const size_t off = (size_t)(u.pm * BM + r) * ldc + col0;
#pragma unroll
                for (int bj = 0; bj < 2; ++bj)
#pragma unroll
                    for (int n = 0; n < 2; ++n) { const f32x4 bs = ai == 0 ? pre[m][bj][n] : *(const f32x4*)(base + off + bj * HALF + n * 16); f32x4 o = bs + (acc[ai][bj][m][n] - sr.x) * sr.y;
                        if (bad) o = (f32x4){qnan, qnan, qnan, qnan}; *(f32x4*)(out + off + bj * HALF + n * 16) = o; }
                if (m & 1) asm volatile("" ::: "memory"); }
    }
};
struct EpiLnResLn {
    static constexpr bool PERM = false, AFTER_DRAIN = true;
    const float* base; float* out; bf16_t* xn; int ldc; const float* bias; PanelStats st1, st2; unsigned poison;
    __device__ __forceinline__ void fused(f32x4 (&acc)[2][2][4][2], const Unit& u, int wr, int wc, int fr, int fq, PG8_LAS unsigned char* lds, int wid, int lane) const {
        typedef float f32x2v __attribute__((ext_vector_type(2))); typedef unsigned u32x2v __attribute__((ext_vector_type(2)));
        const PG8_LAS f32x2v* S = (const PG8_LAS f32x2v*)(lds + 8192);
        const int col0 = u.pn * BM + wc * 32 + 4 * fq;
#pragma unroll
        for (int bj = 0; bj < 2; ++bj)
#pragma unroll
            for (int n = 0; n < 2; ++n) { const f32x4 bv = bias ? *(const f32x4*)(bias + col0 + bj * HALF + n * 16) : (f32x4){0.f, 0.f, 0.f, 0.f};
#pragma unroll
                for (int ai = 0; ai < 2; ++ai)
#pragma unroll
                    for (int m = 0; m < 4; ++m) acc[ai][bj][m][n] += bv; }
        bool bad = st1.run(acc, u, wr, wc, fr, fq, lds, wid, lane) || poison != 0u;
        const float qnan = __builtin_nanf("");
#pragma unroll
        for (int ai = 0; ai < 2; ++ai)
#pragma unroll
            for (int m = 0; m < 4; ++m) { const int r = ai * HALF + wr * 64 + m * 16 + fr; const f32x2v sr = S[r]; const size_t off = (size_t)(u.pm * BM + r) * ldc + col0;
#pragma unroll
                for (int bj = 0; bj < 2; ++bj)
#pragma unroll
                    for (int n = 0; n < 2; ++n) { const f32x4 bs = *(const f32x4*)(base + off + bj * HALF + n * 16); acc[ai][bj][m][n] = bs + (acc[ai][bj][m][n] - sr.x) * sr.y; }
                asm volatile("" : "+v"(acc[ai][0][m][0]), "+v"(acc[ai][0][m][1]), "+v"(acc[ai][1][m][0]), "+v"(acc[ai][1][m][1]));
                if (m & 1) asm volatile("" ::: "memory"); }
        const bool bad1 = bad;
        bad = st2.run(acc, u, wr, wc, fr, fq, lds, wid, lane) || bad;
#pragma unroll
        for (int ai = 0; ai < 2; ++ai)
#pragma unroll
            for (int m = 0; m < 4; ++m) { const int r = ai * HALF + wr * 64 + m * 16 + fr; const f32x2v sr = S[r]; const size_t off = (size_t)(u.pm * BM + r) * ldc + col0;
#pragma unroll
                for (int bj = 0; bj < 2; ++bj)
#pragma unroll
                    for (int n = 0; n < 2; ++n) { const f32x4 x1 = acc[ai][bj][m][n]; *(f32x4*)(out + off + bj * HALF + n * 16) = bad1 ? (f32x4){qnan, qnan, qnan, qnan} : x1;
                        const f32x4 o = (x1 - sr.x) * sr.y; u32x2v w; w.x = cvt_pk_bf16(o[0], o[1]); w.y = cvt_pk_bf16(o[2], o[3]);
                        if (bad) { w.x = 0x7fc07fc0u; w.y = 0x7fc07fc0u; } *(u32x2v*)(xn + off + bj * HALF + n * 16) = w; }
                asm volatile("" ::: "memory"); }
    }
};

template <class Epi, class Sched, bool ALIGN_EPI = false, bool SP2 = false>
__device__ __forceinline__ void gemm_phase(PG8_LAS unsigned char* lds, const Gemm g, const Sched& S, const Epi& E, const int wave0) {
    int tid_ = tid_from_wave(wave0);
    const int tid = tid_, wid = __builtin_amdgcn_readfirstlane(tid >> 6), lane = tid & 63, wr = wid >> 2, wc = wid & 3, fr = lane & 15, fq = lane >> 4;
    const int K = g.K, nt = K / BK;
    unsigned voffA[2], voffB[2];
#pragma unroll
    for (int i = 0; i < 2; ++i) { int R, C; stage_rc(tid * 16 + i * 8192, R, C); const int Rb = Epi::PERM ? ((R & ~31) + perm32(R & 31)) : R;
        voffA[i] = (unsigned)(R * K + C) * 2u; voffB[i] = (unsigned)(Rb * K + C) * 2u; }
    const size_t kstep = (size_t)(BK * 2);
    const size_t hstep = (size_t)HALF * K * 2;
    const size_t tstep = 2 * hstep;
    const unsigned ldsw = (unsigned)wid * 1024u;
    const int aoff = lds_byte(wr * 64 + fr, fq * 8), boff = lds_byte(wc * 32 + fr, fq * 8);
#define PG8_SA(b, h) (((b) * 2 + (h)) * HTB)
#define PG8_SB(b, h) ((4 + (b) * 2 + (h)) * HTB)
#define PG8_STAGE(bufoff, gbase, voff) do { _Pragma("unroll") for (int _i = 0; _i < 2; ++_i) \
        __builtin_amdgcn_global_load_lds((const unsigned*)((const char*)(gbase) + (voff)[_i]), (PG8_LAS unsigned*)(lds + (bufoff) + ldsw + _i * 8192), 16, 0, 0); } while (0)
#define PG8_LDA(dst, b, h) do { _Pragma("unroll") for (int m = 0; m < 4; ++m) _Pragma("unroll") for (int k = 0; k < 2; ++k) dst[m][k] = *(const PG8_LAS bf16x8*)(lds + PG8_SA(b, h) + aoff + m * 2048 + k * 1024); } while (0)
#define PG8_LDB(dst, b, h) do { _Pragma("unroll") for (int n = 0; n < 2; ++n) _Pragma("unroll") for (int k = 0; k < 2; ++k) dst[n][k] = *(const PG8_LAS bf16x8*)(lds + PG8_SB(b, h) + boff + n * 2048 + k * 1024); } while (0)
#define PG8_MMA(ai, bj, At, Bt) do { __builtin_amdgcn_s_setprio(1); _Pragma("unroll") for (int m = 0; m < 4; ++m) _Pragma("unroll") for (int n = 0; n < 2; ++n) _Pragma("unroll") for (int k = 0; k < 2; ++k) \
        acc[ai][bj][m][n] = __builtin_amdgcn_mfma_f32_16x16x32_bf16(Bt[n][k], At[m][k], acc[ai][bj][m][n], 0, 0, 0); __builtin_amdgcn_s_setprio(0); } while (0)
#define PG8_WAIT_V(n) asm volatile("s_waitcnt vmcnt(" #n ")" ::: "memory")
#define PG8_WAIT_L(n) asm volatile("s_waitcnt lgkmcnt(" #n ")" ::: "memory")
#define PG8_BAR __builtin_amdgcn_s_barrier()
#define PG8_SCHED __builtin_amdgcn_sched_barrier(0)
    Unit cur, nxt; int ui = 0;
    if (!S.next(0, cur)) return;
    f32x4 acc[2][2][4][2];
#pragma unroll
    for (int a = 0; a < 2; ++a)
#pragma unroll
        for (int b = 0; b < 2; ++b)
#pragma unroll
            for (int m = 0; m < 4; ++m)
#pragma unroll
                for (int n = 0; n < 2; ++n) acc[a][b][m][n] = (f32x4){0.f, 0.f, 0.f, 0.f};
    bf16x8 At[4][2], B0[2][2], B1[2][2];
    const char* cA = (const char*)g.A + (size_t)cur.pm * tstep; const char* cB = (const char*)g.Bt + (size_t)cur.pn * tstep;
    S.a_ready(cur);
    if constexpr (SP2) {
        PG8_STAGE(PG8_SB(0, 0), cB, voffB); PG8_STAGE(PG8_SB(0, 1), cB + hstep, voffB); PG8_STAGE(PG8_SA(0, 0), cA, voffA); PG8_STAGE(PG8_SA(0, 1), cA + hstep, voffA);
        if (wr == 1) PG8_BAR;
        PG8_WAIT_V(2); PG8_BAR;
        PG8_STAGE(PG8_SB(1, 0), cB + kstep, voffB); PG8_STAGE(PG8_SA(1, 0), cA + kstep, voffA); PG8_STAGE(PG8_SB(1, 1), cB + hstep + kstep, voffB);
        PG8_WAIT_V(6); PG8_BAR;
    } else {
        PG8_STAGE(PG8_SB(0, 0), cB, voffB); PG8_STAGE(PG8_SA(0, 0), cA, voffA); PG8_STAGE(PG8_SB(0, 1), cB + hstep, voffB); PG8_STAGE(PG8_SA(0, 1), cA + hstep, voffA);
        if (wr == 1) PG8_BAR;
        PG8_WAIT_V(4); PG8_BAR;
        PG8_STAGE(PG8_SB(1, 0), cB + kstep, voffB); PG8_STAGE(PG8_SA(1, 0), cA + kstep, voffA); PG8_STAGE(PG8_SB(1, 1), cB + hstep + kstep, voffB);
        PG8_WAIT_V(6); PG8_BAR;
    }
    for (;;) {
        const bool has_next = S.next(ui + 1, nxt);
        const char* nA = has_next ? (const char*)g.A + (size_t)nxt.pm * tstep : cA; const char* nB = has_next ? (const char*)g.Bt + (size_t)nxt.pn * tstep : cB;
        for (int t = 0; t < nt; t += 2) {
            const bool last = (t == nt - 2);
            const char* a1 = cA + (size_t)(t + 1) * kstep;
            const char* a2 = last ? nA : cA + (size_t)(t + 2) * kstep; const char* b2 = last ? nB : cB + (size_t)(t + 2) * kstep;
            const char* a3 = a2 + kstep; const char* b3 = b2 + kstep;
            if (last && has_next) S.a_ready(nxt);
            if constexpr (SP2) {
            PG8_LDB(B0, 0, 0); PG8_LDB(B1, 0, 1); PG8_SCHED; PG8_LDA(At, 0, 0); PG8_STAGE(PG8_SA(1, 1), a1 + hstep, voffA);
            PG8_WAIT_V(8); PG8_WAIT_L(0); PG8_BAR; PG8_MMA(0, 0, At, B0); PG8_MMA(0, 1, At, B1); PG8_BAR; PG8_SCHED;
            PG8_LDA(At, 0, 1); PG8_STAGE(PG8_SB(0, 0), b2, voffB); PG8_STAGE(PG8_SB(0, 1), b2 + hstep, voffB); PG8_STAGE(PG8_SA(0, 0), a2, voffA);
            PG8_WAIT_V(8); PG8_WAIT_L(0); PG8_BAR; PG8_MMA(1, 0, At, B0); PG8_MMA(1, 1, At, B1); PG8_BAR; PG8_SCHED;
            PG8_LDB(B0, 1, 0); PG8_LDB(B1, 1, 1); PG8_SCHED; PG8_LDA(At, 1, 0); PG8_STAGE(PG8_SA(0, 1), a2 + hstep, voffA);
            PG8_WAIT_V(8); PG8_WAIT_L(0); PG8_BAR; PG8_MMA(0, 0, At, B0); PG8_MMA(0, 1, At, B1); PG8_BAR; PG8_SCHED;
            PG8_LDA(At, 1, 1); PG8_STAGE(PG8_SB(1, 0), b3, voffB); PG8_STAGE(PG8_SB(1, 1), b3 + hstep, voffB); PG8_STAGE(PG8_SA(1, 0), a3, voffA);
            PG8_WAIT_V(8); PG8_WAIT_L(0); PG8_BAR; PG8_MMA(1, 0, At, B0); PG8_MMA(1, 1, At, B1); PG8_BAR; PG8_SCHED;
            } else {
            PG8_LDB(B0, 0, 0); PG8_SCHED; PG8_LDA(At, 0, 0); PG8_STAGE(PG8_SA(1, 1), a1 + hstep, voffA);
            PG8_WAIT_L(8); PG8_BAR; PG8_WAIT_L(0); PG8_MMA(0, 0, At, B0); PG8_BAR; PG8_SCHED;
            PG8_LDB(B1, 0, 1); PG8_STAGE(PG8_SB(0, 0), b2, voffB);
            PG8_BAR; PG8_WAIT_L(0); PG8_MMA(0, 1, At, B1); PG8_BAR;
            PG8_LDA(At, 0, 1); PG8_STAGE(PG8_SA(0, 0), a2, voffA);
            PG8_BAR; PG8_WAIT_L(0); PG8_MMA(1, 0, At, B0); PG8_BAR; PG8_SCHED;
            PG8_STAGE(PG8_SB(0, 1), b2 + hstep, voffB);
            PG8_WAIT_V(6); PG8_BAR; PG8_MMA(1, 1, At, B1); PG8_BAR;
            PG8_LDB(B0, 1, 0); PG8_SCHED; PG8_LDA(At, 1, 0); PG8_STAGE(PG8_SA(0, 1), a2 + hstep, voffA);
            PG8_WAIT_L(8); PG8_BAR; PG8_WAIT_L(0); PG8_MMA(0, 0, At, B0); PG8_BAR; PG8_SCHED;
            PG8_LDB(B1, 1, 1); PG8_STAGE(PG8_SB(1, 0), b3, voffB);
            PG8_BAR; PG8_WAIT_L(0); PG8_MMA(0, 1, At, B1); PG8_BAR;
            PG8_LDA(At, 1, 1); PG8_STAGE(PG8_SA(1, 0), a3, voffA);
            PG8_BAR; PG8_WAIT_L(0); PG8_MMA(1, 0, At, B0); PG8_BAR; PG8_SCHED;
            PG8_STAGE(PG8_SB(1, 1), b3 + hstep, voffB);
            PG8_WAIT_V(6); PG8_BAR; PG8_MMA(1, 1, At, B1); PG8_BAR;
            }
        }
        if constexpr (ALIGN_EPI) { if (wr == 0) PG8_BAR; }
        if constexpr (!Epi::AFTER_DRAIN) { E(acc, cur, wr, wc, fr, fq); S.done(cur); }
        if (!has_next) break;
#pragma unroll
        for (int a = 0; a < 2; ++a)
#pragma unroll
            for (int b = 0; b < 2; ++b)
#pragma unroll
                for (int m = 0; m < 4; ++m)
#pragma unroll
                    for (int n = 0; n < 2; ++n) acc[a][b][m][n] = (f32x4){0.f, 0.f, 0.f, 0.f};
        cur = nxt; cA = nA; cB = nB; ++ui;
        if constexpr (ALIGN_EPI) { if (wr == 1) PG8_BAR; }
    }
    PG8_WAIT_V(0);
    if constexpr (!ALIGN_EPI) { if (wr == 0) PG8_BAR; }
    PG8_BAR;
    if constexpr (Epi::AFTER_DRAIN) { E.fused(acc, cur, wr, wc, fr, fq, lds, wid, lane); S.done(cur); }
#undef PG8_SA
#undef PG8_SB
#undef PG8_STAGE
#undef PG8_LDA
#undef PG8_LDB
#undef PG8_MMA
#undef PG8_WAIT_V
#undef PG8_WAIT_L
#undef PG8_BAR
#undef PG8_SCHED
}
}

namespace pg8 {
struct EpiRelu2 {
    static constexpr bool PERM = true, AFTER_DRAIN = false;
    bf16_t* O; int ldc;
    __device__ __forceinline__ void operator()(const f32x4 (&acc)[2][2][4][2], const Unit& u, int wr, int wc, int fr, int fq) const {
        relane(wr, wc, fr, fq);
        const int row0 = u.pm * BM + wr * 64 + fr, col0 = u.pn * BM + wc * 32 + 8 * fq;
#pragma unroll
        for (int ai = 0; ai < 2; ++ai)
#pragma unroll
            for (int m = 0; m < 4; ++m) { bf16_t* rowp = O + (size_t)(row0 + ai * HALF + m * 16) * ldc + col0;
#pragma unroll
                for (int bj = 0; bj < 2; ++bj) { f32x4 v0 = acc[ai][bj][m][0], v1 = acc[ai][bj][m][1];
                    v0 = __builtin_elementwise_max(v0, (f32x4){0.f, 0.f, 0.f, 0.f}); v1 = __builtin_elementwise_max(v1, (f32x4){0.f, 0.f, 0.f, 0.f}); v0 = v0 * v0; v1 = v1 * v1;
                    u32x4 w; w.x = cvt_pk_bf16(v0[0], v0[1]); w.y = cvt_pk_bf16(v0[2], v0[3]); w.z = cvt_pk_bf16(v1[0], v1[1]); w.w = cvt_pk_bf16(v1[2], v1[3]);
                    *(PG8_GAS u32x4*)(rowp + bj * HALF) = w; } }
    }
};
struct EpiF32 {
    static constexpr bool PERM = false, AFTER_DRAIN = false;
    float* O; int ldc;
    __device__ __forceinline__ void operator()(const f32x4 (&acc)[2][2][4][2], const Unit& u, int wr, int wc, int fr, int fq) const {
        relane(wr, wc, fr, fq);
        const int row0 = u.pm * BM + wr * 64 + fr, col0 = u.pn * BM + wc * 32 + 4 * fq;
#pragma unroll
        for (int ai = 0; ai < 2; ++ai)
#pragma unroll
            for (int m = 0; m < 4; ++m) { float* rowp = O + (size_t)(row0 + ai * HALF + m * 16) * ldc + col0;
#pragma unroll
                for (int bj = 0; bj < 2; ++bj)
#pragma unroll
                    for (int n = 0; n < 2; ++n) *(PG8_GAS f32x4*)(rowp + bj * HALF + n * 16) = acc[ai][bj][m][n]; }
    }
};
struct EpiTaps {
    static constexpr bool PERM = false, AFTER_DRAIN = false;
    float* O; const float* decay;
    __device__ __forceinline__ void operator()(const f32x4 (&acc)[2][2][4][2], const Unit& u, int wr, int wc, int fr, int fq) const {
        relane(wr, wc, fr, fq);
        const int row0 = u.pm * BM + wr * 64 + fr, col0 = u.pn * BM + wc * 32 + 4 * fq;
#pragma unroll
        for (int ai = 0; ai < 2; ++ai)
#pragma unroll
            for (int m = 0; m < 4; ++m) { const int row = row0 + ai * HALF + m * 16; float* rowp = O + (size_t)row * 16384 + col0; const float nd = -fabsf(((const PG8_GAS float*)decay)[row]) * (1.0f / 16383.0f) * 1.4426950408889634f;
#pragma unroll
                for (int bj = 0; bj < 2; ++bj)
#pragma unroll
                    for (int n = 0; n < 2; ++n) { const int c = col0 + bj * HALF + n * 16; const f32x4 a = acc[ai][bj][m][n]; f32x4 o;
                        o[0] = a[0] * __builtin_amdgcn_exp2f(nd * (float)(c + 0)); o[1] = a[1] * __builtin_amdgcn_exp2f(nd * (float)(c + 1));
                        o[2] = a[2] * __builtin_amdgcn_exp2f(nd * (float)(c + 2)); o[3] = a[3] * __builtin_amdgcn_exp2f(nd * (float)(c + 3));
                        *(PG8_GAS f32x4*)(rowp + bj * HALF + n * 16) = o; } }
    }
};
}

constexpr int L = 16384, NSEQ = 3, M = NSEQ * L, D = 1024, DEPTH = 4;
constexpr int HYW = 512, HYP = 1536, QR = 256, KVR = 128, ROPE = 32, INW = 1952;
constexpr int NH = 8, DQ = 96, DV = 64, NQ = NH * DQ, NKV = NH * 128;
constexpr int FF = 4096;
constexpr float EPS = 1e-6f;
constexpr int NWAVES = 8, NTHR = 512;
constexpr int MLP_CHUNK = 16384, N_MLP_CHUNKS = M / MLP_CHUNK;

constexpr size_t MiB = 1u << 20;
constexpr size_t WS_CTL = 0, CTL_ZERO_BYTES = 65536;
constexpr size_t WS_COS = 1 * MiB, WS_SIN = 2 * MiB;
constexpr size_t WS_H2 = 4 * MiB;
constexpr size_t WS_W3T = 8 * MiB;
constexpr size_t WS_WIN = 12 * MiB, WS_WOUT = 16 * MiB, WS_WUP = 18 * MiB, WS_WDOWN = 26 * MiB, WS_WUQ = 34 * MiB, WS_WUKV = 34 * MiB + 512 * 1024;
constexpr size_t WS_XN = 36 * MiB;
constexpr size_t WS_CQN = 36 * MiB, WS_CKVN = 60 * MiB, WS_KPE = 72 * MiB;
constexpr size_t WS_KEO = 132 * MiB;
constexpr size_t WS_KT = 261 * MiB;
constexpr size_t WS_UT = 261 * MiB;
constexpr size_t WS_CQKV = 405 * MiB;
constexpr size_t WS_YT = 453 * MiB;
constexpr size_t WS_Q = 132 * MiB, WS_KN = 204 * MiB;
constexpr size_t WS_MIX = 324 * MiB;
constexpr size_t WS_T = 132 * MiB;
constexpr size_t WS_H = 324 * MiB;
constexpr size_t WS_G0 = 75 * MiB, WS_G1A = 107 * MiB, WS_G1B = 501 * MiB;
constexpr size_t WS_XR = 508 * MiB;
constexpr size_t WS_END = 604 * MiB;
constexpr int KEO_BLK = 16512, KEO_KO = 8256;
static_assert(WS_KEO + (size_t)1024 * KEO_BLK * 8 <= WS_KT, "KEO fits");
static_assert(WS_UT + (size_t)HYP * M * 2 <= WS_CQKV && WS_CQKV + (size_t)M * 512 * 2 <= WS_YT && WS_YT + (size_t)HYW * M * 2 <= WS_XR, "map");
static_assert(WS_KN + (size_t)M * NKV * 2 <= WS_MIX && WS_T + (size_t)M * D * 4 <= WS_MIX && WS_H + (size_t)MLP_CHUNK * FF * 2 <= WS_XR && WS_XR + (size_t)M * D * 2 <= WS_END, "map2");

constexpr int RING_OFF = 0, RING_BYTES = 139264;
constexpr int LDSCTL_OFF = RING_BYTES, MISC_OFF = LDSCTL_OFF + 320;
constexpr int LDS_BYTES = 147456;
static_assert(MISC_OFF + 128 <= LDS_BYTES, "LDS map");

#define GAS __attribute__((address_space(1)))
#define LAS __attribute__((address_space(3)))
typedef unsigned short bf16;
typedef unsigned v4u __attribute__((ext_vector_type(4)));
typedef unsigned v2u __attribute__((ext_vector_type(2)));
typedef float f32x4 __attribute__((ext_vector_type(4)));
typedef float f32x2 __attribute__((ext_vector_type(2)));
typedef short bf16x8 __attribute__((ext_vector_type(8)));
typedef GAS unsigned gu32;
#define RLX_AGENT __ATOMIC_RELAXED, __HIP_MEMORY_SCOPE_AGENT
#define LDS_WAIT() asm volatile("s_waitcnt lgkmcnt(0)" ::: "memory")
#define VM_WAIT() asm volatile("s_waitcnt vmcnt(0)" ::: "memory")
typedef __bf16 bf16x2_t __attribute__((ext_vector_type(2)));
__device__ __forceinline__ unsigned pk2(float lo, float hi) { f32x2 v = {lo, hi}; bf16x2_t b = __builtin_convertvector(v, bf16x2_t); return __builtin_bit_cast(unsigned, b); }
__device__ __forceinline__ bf16 f2bf(float f) { return (bf16)(pk2(f, 0.f) & 0xffffu); }
__device__ __forceinline__ float bf2f(unsigned h) { return __uint_as_float(h << 16); }
__device__ __forceinline__ float shx(float v, int lane, int o) { return __uint_as_float((unsigned)__builtin_amdgcn_ds_bpermute((lane ^ o) << 2, (int)__float_as_uint(v))); }
__device__ __forceinline__ float wave_sum(float v) {
    const int ln_ = hw_lane();
#pragma unroll
    for (int o = 1; o < 64; o <<= 1) v += shx(v, ln_, o);
    return v;
}

#ifndef HYSUB
#define HYSUB 0
#endif
#define HT0_(F_) do { if (HYSUB) { __syncthreads(); if (F_.tid == 0) F_.MISC[20] = (unsigned)__builtin_amdgcn_s_memrealtime(); } } while (0)
#define HT1_(F_, s) do { if (HYSUB == (s)) { __syncthreads(); if (F_.tid == 0) F_.MISC[21] += (unsigned)__builtin_amdgcn_s_memrealtime() - F_.MISC[20]; } } while (0)
#define HT0() HT0_(F)
#define HT1(s) HT1_(F, s)

namespace hfft {
constexpr float w32c(int i) { constexpr float t[16] = {1.000000000e+00f, 9.807852507e-01f, 9.238795042e-01f, 8.314695954e-01f, 7.071067691e-01f, 5.555702448e-01f, 3.826834261e-01f, 1.950903237e-01f, 0.f, -1.950903237e-01f, -3.826834261e-01f, -5.555702448e-01f, -7.071067691e-01f, -8.314695954e-01f, -9.238795042e-01f, -9.807852507e-01f}; return t[i]; }
constexpr float w32s(int i) { constexpr float t[16] = {0.000000000e+00f, 1.950903237e-01f, 3.826834261e-01f, 5.555702448e-01f, 7.071067691e-01f, 8.314695954e-01f, 9.238795042e-01f, 9.807852507e-01f, 1.000000000e+00f, 9.807852507e-01f, 9.238795042e-01f, 8.314695954e-01f, 7.071067691e-01f, 5.555702448e-01f, 3.826834261e-01f, 1.950903237e-01f}; return t[i]; }
constexpr int brev(int x, int bits) { int r = 0; for (int i = 0; i < bits; ++i) r |= ((x >> i) & 1) << (bits - 1 - i); return r; }
constexpr int ilog2(int x) { int r = 0; while ((1 << r) < x) ++r; return r; }
__device__ __forceinline__ int pad(int i) { return i + (i >> 5); }

__device__ __forceinline__ void bfly(float ar, float ai, float br, float bi, float& ur, float& ui, float& dr, float& di) {
    asm("v_add_f32_e32 %0, %4, %6\n\tv_add_f32_e32 %1, %5, %7\n\tv_sub_f32_e32 %2, %4, %6\n\tv_sub_f32_e32 %3, %5, %7"
        : "=&v"(ur), "=&v"(ui), "=&v"(dr), "=&v"(di) : "v"(ar), "v"(ai), "v"(br), "v"(bi));
}
template <bool INV> __device__ __forceinline__ void bfly_rot(float ar, float ai, float br, float bi, float& ur, float& ui, float& dr, float& di) {
    if (!INV) asm("v_add_f32_e32 %0, %4, %6\n\tv_add_f32_e32 %1, %5, %7\n\tv_sub_f32_e32 %2, %5, %7\n\tv_sub_f32_e32 %3, %6, %4" : "=&v"(ur), "=&v"(ui), "=&v"(dr), "=&v"(di) : "v"(ar), "v"(ai), "v"(br), "v"(bi));
    else      asm("v_add_f32_e32 %0, %4, %6\n\tv_add_f32_e32 %1, %5, %7\n\tv_sub_f32_e32 %2, %7, %5\n\tv_sub_f32_e32 %3, %4, %6" : "=&v"(ur), "=&v"(ui), "=&v"(dr), "=&v"(di) : "v"(ar), "v"(ai), "v"(br), "v"(bi));
}
__device__ __forceinline__ void bfly_tw(float ar, float ai, float br, float bi, float c, float s, float& ur, float& ui, float& dr, float& di) {
    float tr, ti;
    asm("v_sub_f32_e32 %4, %6, %8\n\tv_sub_f32_e32 %5, %7, %9\n\tv_add_f32_e32 %0, %6, %8\n\tv_add_f32_e32 %1, %7, %9\n\t"
        "v_mul_f32_e32 %2, %10, %4\n\tv_mul_f32_e32 %3, %11, %4\n\tv_fma_f32 %2, -%11, %5, %2\n\tv_fma_f32 %3, %10, %5, %3"
        : "=&v"(ur), "=&v"(ui), "=&v"(dr), "=&v"(di), "=&v"(tr), "=&v"(ti) : "v"(ar), "v"(ai), "v"(br), "v"(bi), "s"(c), "s"(s));
}
__device__ __forceinline__ void cmul_chain(float& xr, float& xi, float& wc, float& ws, float c1, float s1) {
    float a, b, nc, ns;
    asm("v_mul_f32_e32 %0, %4, %6\n\tv_mul_f32_e32 %1, %4, %7\n\tv_fma_f32 %0, -%5, %7, %0\n\tv_fma_f32 %1, %5, %6, %1\n\t"
        "v_mul_f32_e32 %2, %6, %8\n\tv_mul_f32_e32 %3, %6, %9\n\tv_fma_f32 %2, -%7, %9, %2\n\tv_fma_f32 %3, %7, %8, %3"
        : "=&v"(a), "=&v"(b), "=&v"(nc), "=&v"(ns) : "v"(xr), "v"(xi), "v"(wc), "v"(ws), "v"(c1), "v"(s1));
    xr = a; xi = b; wc = nc; ws = ns;
}
template <int R, bool INV> __device__ __forceinline__ void fft_r2(float (&re)[R], float (&im)[R], const unsigned z0) {
    constexpr int LG = ilog2(R);
#pragma unroll
    for (int st = 0; st < LG; ++st) {
        const int s = (R / 2) >> st;
#pragma unroll
        for (int blk = 0; blk < R; blk += 2 * s) {
#pragma unroll
            for (int a = 0; a < s; ++a) {
                const int i0 = blk + a, i1 = i0 + s;
                const int w = a * (16 / s);
                float ur, ui, dr, di;
                if (w == 0) { bfly(re[i0], im[i0], re[i1], im[i1], ur, ui, dr, di); re[i1] = dr; im[i1] = di; }
                else if (w == 8) { bfly_rot<INV>(re[i0], im[i0], re[i1], im[i1], ur, ui, dr, di); re[i1] = dr; im[i1] = di; }
                else { const float c = __uint_as_float(__float_as_uint(w32c(w)) | z0), sn = __uint_as_float(__float_as_uint(INV ? w32s(w) : -w32s(w)) | z0);
                    bfly_tw(re[i0], im[i0], re[i1], im[i1], c, sn, ur, ui, dr, di); re[i1] = dr; im[i1] = di; }
                re[i0] = ur; im[i0] = ui;
            }
        }
    }
}

__device__ __forceinline__ int opaque(int x) { asm volatile("" : "+v"(x)); return x; }
template <bool INV> __device__ __forceinline__ void fft16k(float (&re)[32], float (&im)[32], LAS f32x2* buf, const int t_in) {
    asm volatile("" ::: "memory"); __builtin_amdgcn_sched_barrier(0);
    int t = opaque(t_in);
    unsigned z0 = 0u; asm volatile("" : "+s"(z0));
    fft_r2<32, INV>(re, im, z0);
    __syncthreads();
#pragma unroll
    for (int r = 0; r < 32; ++r) buf[33 * t + r] = (f32x2){re[brev(r, 5)], im[brev(r, 5)]};
    __syncthreads();
    t = opaque(t);
    { const int b2 = t + (t >> 5);
#pragma unroll
    for (int r = 0; r < 32; ++r) { const f32x2 v = buf[b2 + 528 * r]; re[r] = v.x; im[r] = v.y; } }
    {
        const float f1 = (float)(t & 31) * (1.0f / 1024.0f);
        const float c1 = __builtin_amdgcn_cosf(f1), s1 = INV ? __builtin_amdgcn_sinf(f1) : -__builtin_amdgcn_sinf(f1);
        float wc = c1, ws = s1;
#pragma unroll
        for (int r = 1; r < 32; ++r) {
            cmul_chain(re[r], im[r], wc, ws, c1, s1);
        }
    }
    fft_r2<32, INV>(re, im, z0);
    __syncthreads();
    {
        t = opaque(t);
        const int ob = (t >> 5) * 1056 + (t & 31);
#pragma unroll
        for (int r = 0; r < 32; ++r) buf[ob + 33 * r] = (f32x2){re[brev(r, 5)], im[brev(r, 5)]};
    }
    __syncthreads();
#pragma unroll
    for (int h = 0; h < 2; ++h) {
        t = opaque(t);
        float ar[16], ai[16]; const int j = t + 512 * h; const int b3 = t + (t >> 5) + 528 * h;
#pragma unroll
        for (int r = 0; r < 16; ++r) { const f32x2 v = buf[b3 + 1056 * r]; ar[r] = v.x; ai[r] = v.y; }
        {
            const float f1 = (float)j * (1.0f / 16384.0f);
            const float c1 = __builtin_amdgcn_cosf(f1), s1 = INV ? __builtin_amdgcn_sinf(f1) : -__builtin_amdgcn_sinf(f1);
            float wc = c1, ws = s1;
#pragma unroll
            for (int r = 1; r < 16; ++r) {
                cmul_chain(ar[r], ai[r], wc, ws, c1, s1);
            }
        }
        fft_r2<16, INV>(ar, ai, z0);
#pragma unroll
        for (int r = 0; r < 16; ++r) { re[h + 2 * r] = ar[brev(r, 4)]; im[h + 2 * r] = ai[brev(r, 4)]; }
    }
    asm volatile("" ::: "memory"); __builtin_amdgcn_sched_barrier(0);
}
}

struct Frame {
    LAS unsigned char* lds;
    volatile LAS unsigned* MISC;
    gu32* ctl;
    int tid, lane, wave;
    int wave0;
    int vcu, G;
    float* out;
    unsigned char* ws;
};
constexpr int PTRTAB_OFF = LDSCTL_OFF + 512;
__device__ __forceinline__ const GAS float* inp(const Frame& F, int i) {
    const v2u w = *(const LAS v2u*)(F.lds + PTRTAB_OFF + 8 * i);
    const unsigned lo = __builtin_amdgcn_readfirstlane(w.x), hi = __builtin_amdgcn_readfirstlane(w.y);
    return (const GAS float*)(((unsigned long long)hi << 32) | lo);
}
__device__ __forceinline__ GAS unsigned char* wsq(const Frame& F) { unsigned char* p = F.ws; asm volatile("" : "+s"(p)); return (GAS unsigned char*)p; }
enum { I_XP = 0, I_XS, I_WIN, I_CONVW, I_CONVB, I_FW1, I_FB1, I_FW2, I_FB2, I_FW3, I_SINF, I_DECAY, I_HBIAS, I_QNORM, I_WUQ, I_KVNORM, I_WUKV, I_GNHY, I_GNAT, I_WOUT,
       I_NMIXPRE, I_NMIXPOST, I_NMLPPRE, I_NMLPPOST, I_WUP, I_WDOWN };

__device__ __forceinline__ int rope_src(int p) { return 4 * (p >> 3) + (p & 3) + 16 * ((p >> 2) & 1); }
template <bool ROPEPERM>
__device__ __forceinline__ void transpose_item(const GAS float* W, int K, int N, GAS bf16* WT, LAS float* scr, int item, int lane, int ldk = 0, int koff = 0) {
    if (ldk == 0) ldk = K;
    const int nblk = N / 32, kb = item / nblk, nb = item % nblk, k0 = 64 * kb, n0 = 32 * nb;
    int sc = lane & 31; if (ROPEPERM && (nb % 3) == 2) sc = rope_src(sc);
#pragma unroll 8
    for (int i = 0; i < 32; ++i) { const int kk = 2 * i + (lane >> 5); scr[kk * 33 + (lane & 31)] = W[(size_t)(k0 + kk) * N + n0 + sc]; }
    LDS_WAIT(); asm volatile("" ::: "memory");
    const int c = lane & 7;
#pragma unroll
    for (int j = 0; j < 4; ++j) { const int n = (lane >> 3) + 8 * j; const LAS float* s = scr + (8 * c) * 33 + n;
        v4u o; o.x = pk2(s[0 * 33], s[1 * 33]); o.y = pk2(s[2 * 33], s[3 * 33]); o.z = pk2(s[4 * 33], s[5 * 33]); o.w = pk2(s[6 * 33], s[7 * 33]);
        *(GAS v4u*)(WT + (size_t)(n0 + n) * ldk + koff + k0 + 8 * c) = o; }
    LDS_WAIT(); asm volatile("" ::: "memory");
}
__device__ __forceinline__ void phase_weights(Frame& F, int l) {
    LAS float* scr = (LAS float*)(F.lds + RING_OFF + F.wave * 16384);
    const int gw = F.vcu * NWAVES + F.wave, NGW = F.G * NWAVES;
    GAS bf16* WinT = (GAS bf16*)(wsq(F) + WS_WIN); GAS bf16* WoutT = (GAS bf16*)(wsq(F) + WS_WOUT); GAS bf16* WupT = (GAS bf16*)(wsq(F) + WS_WUP); GAS bf16* WdownT = (GAS bf16*)(wsq(F) + WS_WDOWN);
    GAS bf16* WuqT = (GAS bf16*)(wsq(F) + WS_WUQ); GAS bf16* WukvT = (GAS bf16*)(wsq(F) + WS_WUKV);
    constexpr int I_IN = (D / 64) * (INW / 32), I_OUT = (D / 64) * (D / 32), I_UP = (D / 64) * (FF / 32), I_DN = (FF / 64) * (D / 32), I_UQ = (QR / 64) * (NQ / 32), I_UKV = (KVR / 64) * (NKV / 32);
    constexpr int I_W3 = 2048 / 32;
    constexpr int NITEMS = I_IN + I_OUT + I_UP + I_DN + I_UQ + I_UKV + 2 * I_W3;
    for (int it = gw; it < NITEMS; it += NGW) {
        int r = it;
        if (r < I_IN) { transpose_item<false>(inp(F, I_WIN) + (size_t)l * D * INW, D, INW, WinT, scr, r, F.lane); continue; } r -= I_IN;
        if (r < I_OUT) { transpose_item<false>(inp(F, I_WOUT) + (size_t)l * D * D, D, D, WoutT, scr, r, F.lane); continue; } r -= I_OUT;
        if (r < I_UP) { transpose_item<false>(inp(F, I_WUP) + (size_t)l * D * FF, D, FF, WupT, scr, r, F.lane); continue; } r -= I_UP;
        if (r < I_DN) { transpose_item<false>(inp(F, I_WDOWN) + (size_t)l * FF * D, FF, D, WdownT, scr, r, F.lane); continue; } r -= I_DN;
        if (r < I_UQ) { transpose_item<true>(inp(F, I_WUQ) + (size_t)l * QR * NQ, QR, NQ, WuqT, scr, r, F.lane); continue; } r -= I_UQ;
        if (r < I_UKV) { transpose_item<false>(inp(F, I_WUKV) + (size_t)l * KVR * NKV, KVR, NKV, WukvT, scr, r, F.lane); continue; } r -= I_UKV;
        transpose_item<false>(inp(F, I_FW3) + (size_t)l * 64 * 2048, 64, 2048, (GAS bf16*)(wsq(F) + WS_W3T), scr, r % I_W3, F.lane, 128, (r / I_W3) * 64);
    }
    { unsigned z = 0u; asm volatile("" : "+v"(z)); const v4u zz = {z, z, z, z};
      for (int i = gw * 64 + F.lane; i < 12288; i += NGW * 64) ((GAS v4u*)(WinT + (size_t)INW * D))[i] = zz; }
}
__device__ __forceinline__ void phase_rope_tab(Frame& F) {
    const float inv[16] = {1.000000000e+00f, 5.623413324e-01f, 3.162277639e-01f, 1.778279394e-01f, 1.000000015e-01f, 5.623412877e-02f, 3.162277862e-02f, 1.778279431e-02f,
                           9.999999776e-03f, 5.623413250e-03f, 3.162277862e-03f, 1.778279431e-03f, 1.000000047e-03f, 5.623413017e-04f, 3.162277862e-04f, 1.778279402e-04f};
    GAS float* ct = (GAS float*)(wsq(F) + WS_COS); GAS float* st = (GAS float*)(wsq(F) + WS_SIN);
    for (int i = F.vcu * NTHR + F.tid; i < L * 16; i += F.G * NTHR) {
        const int t = i >> 4, j = i & 15; float iv = inv[0];
#pragma unroll
        for (int q = 1; q < 16; ++q) iv = (j == q) ? inv[q] : iv;
        const float ang = (float)t * iv; ct[i] = cosf(ang); st[i] = sinf(ang);
    }
}
__device__ __forceinline__ const GAS float* x_src_row(Frame& F, int l, int m) {
    if (l == 0) return (m < 2 * L) ? inp(F, I_XP) + (size_t)m * D : inp(F, I_XS) + (size_t)(m - 2 * L) * D;
    return (const GAS float*)F.out + (size_t)m * D;
}
__device__ __forceinline__ void store_xn_row(f32x4 (&v)[4], float rstd, const GAS float* g, GAS bf16* orow, int lane) {
    GAS v2u* o8 = (GAS v2u*)orow + lane;
#pragma unroll
    for (int j = 0; j < 4; ++j) { const f32x4 gg = ((const GAS f32x4*)g)[lane + 64 * j]; v2u w; w.x = pk2(v[j].x * rstd * gg.x, v[j].y * rstd * gg.y); w.y = pk2(v[j].z * rstd * gg.z, v[j].w * rstd * gg.w); o8[64 * j] = w; }
}
__device__ __forceinline__ float row_ss(const f32x4 (&v)[4]) { float s = 0.f;
#pragma unroll
    for (int j = 0; j < 4; ++j) s += (v[j].x * v[j].x + v[j].y * v[j].y) + (v[j].z * v[j].z + v[j].w * v[j].w);
    return wave_sum(s); }
__device__ __forceinline__ void phase_norm_first(Frame& F, int l, const GAS float* g) {
    const int gw = F.vcu * NWAVES + F.wave, NGW = F.G * NWAVES; GAS bf16* XN = (GAS bf16*)(wsq(F) + WS_XN);
    for (int m0 = gw; m0 < M; m0 += 4 * NGW) {
        f32x4 v[4][4];
#pragma unroll
        for (int q = 0; q < 4; ++q) { const int mm = m0 + q * NGW, m = mm < M ? mm : M - 1; const GAS f32x4* xr = (const GAS f32x4*)x_src_row(F, l, m) + F.lane;
#pragma unroll
            for (int j = 0; j < 4; ++j) v[q][j] = xr[64 * j]; }
#pragma unroll
        for (int q = 0; q < 4; ++q) { const int m = m0 + q * NGW; if (m >= M) break;
            const float rstd = 1.0f / sqrtf(row_ss(v[q]) * (1.0f / D) + EPS);
            store_xn_row(v[q], rstd, g, XN + (size_t)m * D, F.lane); }
    }
}
template <bool SRC_IN, bool DST_OUT>
__device__ __forceinline__ void phase_norm_res(Frame& F, const GAS bf16* T, const GAS float* gpost, const GAS float* gnext) {
    const int gw = F.vcu * NWAVES + F.wave, NGW = F.G * NWAVES; GAS bf16* XN = (GAS bf16*)(wsq(F) + WS_XN); GAS bf16* XR = (GAS bf16*)(wsq(F) + WS_XR);
    constexpr int R = SRC_IN ? 2 : 4;
    for (int m0 = gw; m0 < M; m0 += R * NGW) {
        f32x4 vf[SRC_IN ? R : 1][4]; v2u xw[SRC_IN ? 1 : R][4], tw[R][4];
#pragma unroll
        for (int q = 0; q < R; ++q) { const int mm = m0 + q * NGW, m = mm < M ? mm : M - 1; const GAS v2u* tr = (const GAS v2u*)(T + (size_t)m * D) + F.lane;
            if (SRC_IN) { const GAS f32x4* xr = (const GAS f32x4*)x_src_row(F, 0, m) + F.lane;
#pragma unroll
                for (int j = 0; j < 4; ++j) vf[SRC_IN ? q : 0][j] = xr[64 * j]; }
            else { const GAS v2u* xr = (const GAS v2u*)(XR + (size_t)m * D) + F.lane;
#pragma unroll
                for (int j = 0; j < 4; ++j) xw[SRC_IN ? 0 : q][j] = xr[64 * j]; }
#pragma unroll
            for (int j = 0; j < 4; ++j) tw[q][j] = tr[64 * j]; }
#pragma unroll
        for (int q = 0; q < R; ++q) { const int m = m0 + q * NGW; if (m >= M) break;
            f32x4 v[4], tv[4];
#pragma unroll
            for (int j = 0; j < 4; ++j) { const v2u w = tw[q][j]; tv[j] = (f32x4){bf2f(w.x & 0xffffu), bf2f(w.x >> 16), bf2f(w.y & 0xffffu), bf2f(w.y >> 16)};
                if (SRC_IN) v[j] = vf[SRC_IN ? q : 0][j]; else { const v2u x = xw[SRC_IN ? 0 : q][j]; v[j] = (f32x4){bf2f(x.x & 0xffffu), bf2f(x.x >> 16), bf2f(x.y & 0xffffu), bf2f(x.y >> 16)}; } }
            const float rt = 1.0f / sqrtf(row_ss(tv) * (1.0f / D) + EPS);
#pragma unroll
            for (int j = 0; j < 4; ++j) { const f32x4 gg = ((const GAS f32x4*)gpost)[F.lane + 64 * j]; v[j] = v[j] + tv[j] * rt * gg; }
            if (DST_OUT) { GAS f32x4* orow = (GAS f32x4*)(F.out + (size_t)m * D) + F.lane;
#pragma unroll
                for (int j = 0; j < 4; ++j) orow[64 * j] = v[j]; }
            else { GAS v2u* orow = (GAS v2u*)(XR + (size_t)m * D) + F.lane;
#pragma unroll
                for (int j = 0; j < 4; ++j) { v2u w; w.x = pk2(v[j].x, v[j].y); w.y = pk2(v[j].z, v[j].w); orow[64 * j] = w; } }
            if (gnext) { const float rstd = 1.0f / sqrtf(row_ss(v) * (1.0f / D) + EPS); store_xn_row(v, rstd, gnext, XN + (size_t)m * D, F.lane); } }
    }
}

__device__ __forceinline__ void phase_filter_mlp(Frame& F, int l) {
    const GAS float* w1 = inp(F, I_FW1) + (size_t)l * 33 * 64; const GAS float* b1 = inp(F, I_FB1) + l * 64; const GAS float* w2 = inp(F, I_FW2) + (size_t)l * 64 * 64; const GAS float* b2 = inp(F, I_FB2) + l * 64;
    const GAS float* sf = inp(F, I_SINF) + l * 128; GAS bf16* H2 = (GAS bf16*)(wsq(F) + WS_H2);
    const int lane = F.lane, gw = F.vcu * NWAVES + F.wave, NGW = F.G * NWAVES;
    float w1c[33], w2c[64];
#pragma unroll
    for (int f = 0; f < 33; ++f) w1c[f] = w1[f * 64 + lane];
#pragma unroll
    for (int i = 0; i < 64; ++i) w2c[i] = w2[i * 64 + lane];
    const float b1l = b1[lane], b2l = b2[lane], sf0 = sf[lane], sf1 = sf[64 + lane];
    for (int n = gw; n < L; n += NGW) {
        const float tn = (float)n * (1.0f / (float)(L - 1)); const float omega = (float)(2.0 * 3.14159265358979323846 / L) * (float)n;
        const int bidx = (lane >= 17) ? lane - 17 : lane - 1; const float band = 1e-4f + (float)bidx * ((15.0f - 1e-4f) / 15.0f); const float ph = omega * band;
        const float zf = (lane == 0) ? tn : ((lane <= 16) ? cosf(ph) : -sinf(ph));
        float acc = b1l;
#pragma unroll
        for (int f = 0; f < 33; ++f) acc += __uint_as_float(__builtin_amdgcn_readlane(__float_as_uint(zf), f)) * w1c[f];
        const float h1 = sinf(sf0 * acc);
        float acc2 = b2l;
#pragma unroll
        for (int i = 0; i < 64; ++i) acc2 += __uint_as_float(__builtin_amdgcn_readlane(__float_as_uint(h1), i)) * w2c[i];
        const float hv = sinf(sf1 * acc2); const bf16 hi = f2bf(hv);
        H2[(size_t)n * 128 + lane] = hi; H2[(size_t)n * 128 + 64 + lane] = f2bf(hv - bf2f(hi));
    }
}
typedef float f32x4u __attribute__((ext_vector_type(4), aligned(4)));
__device__ __forceinline__ void taps_stage(const GAS float* fw0, const GAS float* bw0, const GAS float* fw1, const GAS float* bw1, bool odd, LAS f32x2* buf, int t) {
    const float sg = odd ? -1.f : 1.f;
#pragma unroll 1
    for (int h = 0; h < 2; ++h) { const int tq = hfft::opaque(t) + 2048 * h; f32x4 a0[4], a1[4], r0[4], r1[4];
#pragma unroll
        for (int q = 0; q < 4; ++q) { const int c = tq + 512 * q; a0[q] = *(const GAS f32x4*)(fw0 + 4 * c); a1[q] = *(const GAS f32x4*)(fw1 + 4 * c);
            r0[q] = *(const GAS f32x4u*)(bw0 + (L - 3 - 4 * c)); r1[q] = *(const GAS f32x4u*)(bw1 + (L - 3 - 4 * c)); }
#pragma unroll
        for (int q = 0; q < 4; ++q) { const int c = tq + 512 * q; const float e0 = c > 0 ? r0[q][3] : 0.f, e1 = c > 0 ? r1[q][3] : 0.f;
            LAS f32x4* dst = (LAS f32x4*)(buf + 4 * c);
            dst[0] = (f32x4){a0[q][0] + sg * e0, a1[q][0] + sg * e1, a0[q][1] + sg * r0[q][2], a1[q][1] + sg * r1[q][2]};
            dst[1] = (f32x4){a0[q][2] + sg * r0[q][1], a1[q][2] + sg * r1[q][1], a0[q][3] + sg * r0[q][0], a1[q][3] + sg * r1[q][0]}; } }
}
__device__ __forceinline__ void phase_filter_fft(Frame& F, int l) {
    const GAS float* KT = (const GAS float*)(wsq(F) + WS_KT); GAS f32x2* KEO = (GAS f32x2*)(wsq(F) + WS_KEO); const GAS float* hb = inp(F, I_HBIAS) + (size_t)l * 2 * HYW;
    LAS f32x2* buf = (LAS f32x2*)(F.lds + RING_OFF); const int t = F.tid;
    for (int c = F.vcu; c < HYW; c += F.G) {
        const GAS float* fw0 = KT + (size_t)(0 * HYW + c) * L; const GAS float* bw0 = KT + (size_t)(1 * HYW + c) * L;
        const GAS float* fw1 = KT + (size_t)(2 * HYW + c) * L; const GAS float* bw1 = KT + (size_t)(3 * HYW + c) * L;
        const float bias0 = hb[c], bias1 = hb[HYW + c]; const float sc = 1.0f / (2.0f * L);
        GAS f32x2* k0 = KEO + (size_t)c * KEO_BLK; GAS f32x2* k1 = KEO + (size_t)(HYW + c) * KEO_BLK;
        float ar[32], ai[32];
#pragma unroll 1
        for (int odd = 0; odd < 2; ++odd) {
            HT0();
            __syncthreads(); taps_stage(fw0, bw0, fw1, bw1, odd != 0, buf, t); __syncthreads();
            { const int tq = hfft::opaque(t);
#pragma unroll
              for (int m = 0; m < 32; ++m) { const int n = tq + 512 * m; const f32x2 v = buf[n];
                  if (!odd) { ar[m] = v.x; ai[m] = v.y; }
                  else { const float d0 = v.x, d1 = v.y; const float fr = (float)n * (1.0f / 32768.0f); const float cs = __builtin_amdgcn_cosf(fr), sn = -__builtin_amdgcn_sinf(fr);
                         ar[m] = d0 * cs - d1 * sn; ai[m] = d0 * sn + d1 * cs; } } }
            HT1(11); if (HYSUB != 40) HT0(); hfft::fft16k<false>(ar, ai, buf, t); HT1(12); HT0();
            __syncthreads();
            { const int tq = hfft::opaque(t);
#pragma unroll
              for (int m = 0; m < 32; ++m) buf[hfft::pad(tq + 512 * m)] = (f32x2){ar[m], ai[m]}; }
            __syncthreads();
            { const int tq = hfft::opaque(t); GAS f32x2* d0 = k0 + (odd ? KEO_KO : 0); GAS f32x2* d1 = k1 + (odd ? KEO_KO : 0);
#pragma unroll
              for (int m = 0; m <= 16; ++m) { const int k = tq + 512 * m; const bool keep = odd ? (k < 8192) : (k <= 8192);
                  const int rk = odd ? 16383 - k : ((16384 - k) & 16383); const f32x2 xq = buf[hfft::pad(rk)]; const float cr = xq.x, ci = -xq.y;
                  const float a0 = 0.5f * (ar[m] + cr), a1 = 0.5f * (ai[m] + ci), b0 = 0.5f * (ai[m] - ci), b1 = -0.5f * (ar[m] - cr);
                  if (keep) { d0[k] = (f32x2){(a0 + bias0) * sc, a1 * sc}; d1[k] = (f32x2){(b0 + bias1) * sc, b1 * sc}; } } }
            HT1(13);
        }
    }
    __syncthreads();
}

__device__ __forceinline__ float u_conv3(const GAS bf16* row, int n, float w0, float w1, float w2, float cb) {
    const int nm = n >= 1 ? n - 1 : 0, np = n + 1 < L ? n + 1 : L - 1;
    float um = bf2f(row[nm]), up = bf2f(row[np]); const float u0 = bf2f(row[n]);
    um = n >= 1 ? um : 0.f; up = n + 1 < L ? up : 0.f;
    return um * w0 + u0 * w1 + up * w2 + cb;
}
__device__ __forceinline__ void conv3_stage(const GAS bf16* r0, const GAS bf16* r1, float w0, float w1, float w2, float cb, float v0, float v1, float v2, float vb, LAS f32x2* buf, int t) {
    const int tq = hfft::opaque(t);
#pragma unroll
    for (int q = 0; q < 4; ++q) { const int j = tq + 512 * q; const bool hl = j > 0, hr = j < L / 8 - 1; const int nl = hl ? 8 * j - 1 : 0, nr = hr ? 8 * j + 8 : L - 1;
        const v4u a = *(const GAS v4u*)(r0 + 8 * j), b = *(const GAS v4u*)(r1 + 8 * j);
        float al = bf2f(r0[nl]), ar = bf2f(r0[nr]), bl = bf2f(r1[nl]), br = bf2f(r1[nr]);
        al = hl ? al : 0.f; bl = hl ? bl : 0.f; ar = hr ? ar : 0.f; br = hr ? br : 0.f;
        const float ua[10] = {al, __uint_as_float(a.x << 16), __uint_as_float(a.x & 0xffff0000u), __uint_as_float(a.y << 16), __uint_as_float(a.y & 0xffff0000u),
                              __uint_as_float(a.z << 16), __uint_as_float(a.z & 0xffff0000u), __uint_as_float(a.w << 16), __uint_as_float(a.w & 0xffff0000u), ar};
        const float ub[10] = {bl, __uint_as_float(b.x << 16), __uint_as_float(b.x & 0xffff0000u), __uint_as_float(b.y << 16), __uint_as_float(b.y & 0xffff0000u),
                              __uint_as_float(b.z << 16), __uint_as_float(b.z & 0xffff0000u), __uint_as_float(b.w << 16), __uint_as_float(b.w & 0xffff0000u), br};
        LAS f32x4* dst = (LAS f32x4*)(buf + 8 * j);
#pragma unroll
        for (int e = 0; e < 8; e += 2) { f32x4 o;
            o[0] = ua[e] * w0 + ua[e + 1] * w1 + ua[e + 2] * w2 + cb; o[1] = ub[e] * v0 + ub[e + 1] * v1 + ub[e + 2] * v2 + vb;
            o[2] = ua[e + 1] * w0 + ua[e + 2] * w1 + ua[e + 3] * w2 + cb; o[3] = ub[e + 1] * v0 + ub[e + 2] * v1 + ub[e + 3] * v2 + vb; dst[e >> 1] = o; } }
}
__device__ __forceinline__ void cmul_spec(float (&xr)[32], float (&xi)[32], const GAS f32x2* ke, int t, bool odd) {
    { const int tq = hfft::opaque(t); (void)tq;
#pragma unroll
    for (int m = 0; m < 32; ++m) { const int k = tq + 512 * m; int idx; bool cj;
        if (!odd) { cj = k > 8192; idx = cj ? 16384 - k : k; } else { cj = k >= 8192; idx = cj ? 16383 - k : k; }
        const f32x2 kv = ke[idx]; const float kr = kv.x, ki = cj ? -kv.y : kv.y;
        const float a = xr[m], b = xi[m]; xr[m] = a * kr - b * ki; xi[m] = a * ki + b * kr; if ((m & 15) == 15) { asm volatile("" ::: "memory"); __builtin_amdgcn_sched_barrier(0); } }
    }
}
__device__ __forceinline__ f32x2 ld_spec(const GAS f32x2* ke, int k, bool odd) {
    int idx; bool cj;
    if (!odd) { cj = k > 8192; idx = cj ? 16384 - k : k; } else { cj = k >= 8192; idx = cj ? 16383 - k : k; }
    f32x2 kv = ke[idx]; kv.y = cj ? -kv.y : kv.y; return kv;
}
__device__ __forceinline__ void cmul_spec2(float (&xr)[32], float (&xi)[32], const GAS f32x2* ka, const GAS f32x2* kb, LAS f32x2* buf, int t, bool odd) {
    __syncthreads();
    { const int tq = hfft::opaque(t);
#pragma unroll
      for (int m = 0; m < 32; ++m) buf[hfft::pad(tq + 512 * m)] = (f32x2){xr[m], xi[m]}; }
    __syncthreads();
    { const int tq = hfft::opaque(t);
#pragma unroll
      for (int m = 0; m < 32; ++m) { const int k = tq + 512 * m; const int rk = odd ? 16383 - k : ((16384 - k) & 16383);
          const f32x2 xc = buf[hfft::pad(rk)];
          const f32x2 a = ld_spec(ka, k, odd), b = ld_spec(kb, k, odd);
          const float sr = 0.5f * (a.x + b.x), si = 0.5f * (a.y + b.y), dr = 0.5f * (a.x - b.x), di = 0.5f * (a.y - b.y);
          const float x0 = xr[m], x1 = xi[m], c0 = xc.x, c1 = -xc.y;
          xr[m] = (x0 * sr - x1 * si) + (c0 * dr - c1 * di); xi[m] = (x0 * si + x1 * sr) + (c0 * di + c1 * dr);
          if ((m & 7) == 7) { asm volatile("" ::: "memory"); __builtin_amdgcn_sched_barrier(0); } } }
}
__device__ __forceinline__ void spec_prefetch(const GAS f32x2* ke, LAS unsigned char* lds, int t) {
    const int tq = hfft::opaque(t); const GAS unsigned char* src = (const GAS unsigned char*)ke + (tq >> 6) * 1024 + (tq & 63) * 16;
#pragma unroll
    for (int p = 0; p < 9; ++p) { int off = p * 8192; if (p == 8) off = (tq >> 6) == 0 ? off : 0;
        __builtin_amdgcn_global_load_lds((const GAS unsigned*)(src + off), (LAS unsigned*)(lds + RING_OFF + 135168), 16, 0, 0); }
}
__device__ __forceinline__ void phase_hyena(Frame& F, int l) {
    const GAS bf16* UT = (const GAS bf16*)(wsq(F) + WS_UT); GAS bf16* YT = (GAS bf16*)(wsq(F) + WS_YT); const GAS f32x2* KEO = (const GAS f32x2*)(wsq(F) + WS_KEO);
    const GAS float* cw = inp(F, I_CONVW) + (size_t)l * 3 * HYP; const GAS float* cbv = inp(F, I_CONVB) + (size_t)l * HYP;
    LAS f32x2* buf = (LAS f32x2*)(F.lds + RING_OFF); const int t = F.tid;
    GAS f32x2* G0 = (GAS f32x2*)(wsq(F) + WS_G0) + (size_t)F.vcu * 16384 + t;
    for (int item = F.vcu; item < HYW + HYW / 2; item += F.G) {
        const bool mode1 = item >= HYW;
        const int c0 = mode1 ? 2 * (item - HYW) : item, c1 = mode1 ? c0 + 1 : c0;
        const size_t s0 = mode1 ? (size_t)2 * L : 0, s1 = mode1 ? (size_t)2 * L : (size_t)L;
        float ar[32], ai[32]; unsigned ep[32];
#pragma unroll 1
        for (int o = 0; o < 2; ++o) {
            const GAS f32x2* ke0 = KEO + (size_t)(o * HYW + c0) * KEO_BLK; const GAS f32x2* ke1 = KEO + (size_t)(o * HYW + c1) * KEO_BLK;
#pragma unroll 1
            for (int half = 0; half < 2; ++half) {
                if (HYSUB != 40) HT0();
                if (o == 0) { const float w0 = cw[c0], w1 = cw[HYP + c0], w2 = cw[2 * HYP + c0], cb = cbv[c0], v0 = cw[c1], v1 = cw[HYP + c1], v2 = cw[2 * HYP + c1], vb = cbv[c1];
                    const GAS bf16* r0 = UT + (size_t)c0 * M + s0; const GAS bf16* r1 = UT + (size_t)c1 * M + s1;
                    __syncthreads(); conv3_stage(r0, r1, w0, w1, w2, cb, v0, v1, v2, vb, buf, t); __syncthreads();
                    { const int tq = hfft::opaque(t);
#pragma unroll
                    for (int m = 0; m < 32; ++m) { const f32x2 v = buf[tq + 512 * m]; ar[m] = v.x; ai[m] = v.y; } }
                    }
                else {
                    { const int tq = hfft::opaque(t); (void)tq; GAS f32x2* G0q = G0 + (tq - t);
#pragma unroll
                    for (int m = 0; m < 32; ++m) { const f32x2 v = G0q[m * 512]; ar[m] = v.x; ai[m] = v.y; if ((m & 15) == 15) { asm volatile("" ::: "memory"); __builtin_amdgcn_sched_barrier(0); } } }
                    }
                HT1(1);
                if (half == 0) {
                    spec_prefetch(ke0, F.lds, t); if (mode1) spec_prefetch(ke1, F.lds, t);
                    if (HYSUB != 40) HT0(); hfft::fft16k<false>(ar, ai, buf, t); HT1(2); if (HYSUB != 40) HT0();
                    if (mode1) cmul_spec2(ar, ai, ke0, ke1, buf, t, false); else cmul_spec(ar, ai, ke0, t, false);
                    HT1(3); if (HYSUB != 40) HT0(); hfft::fft16k<true>(ar, ai, buf, t); HT1(2); if (HYSUB != 40) HT0();
                    {
#pragma unroll
                    for (int m = 0; m < 32; ++m) ep[m] = pk2(ar[m], ai[m]);
                    }
                    HT1(4);
                } else {
                    if (HYSUB != 40) HT0();
                    { const int tq = hfft::opaque(t); (void)tq;
#pragma unroll
                    for (int m = 0; m < 32; ++m) { const float fr = (float)(tq + 512 * m) * (1.0f / 32768.0f); const float cs = __builtin_amdgcn_cosf(fr), sn = -__builtin_amdgcn_sinf(fr);
                        const float a = ar[m], b = ai[m]; ar[m] = a * cs - b * sn; ai[m] = a * sn + b * cs; }
                    }
                    spec_prefetch(ke0 + KEO_KO, F.lds, t); if (mode1) spec_prefetch(ke1 + KEO_KO, F.lds, t);
                    HT1(5); if (HYSUB != 40) HT0(); hfft::fft16k<false>(ar, ai, buf, t); HT1(2); if (HYSUB != 40) HT0();
                    if (mode1) cmul_spec2(ar, ai, ke0 + KEO_KO, ke1 + KEO_KO, buf, t, true); else cmul_spec(ar, ai, ke0 + KEO_KO, t, true);
                    HT1(3); if (HYSUB != 40) HT0(); hfft::fft16k<true>(ar, ai, buf, t); HT1(2); if (HYSUB != 40) HT0();
                    const int g0 = (o + 1) * HYW + c0, g1 = (o + 1) * HYW + c1;
                    const float w0 = cw[g0], w1 = cw[HYP + g0], w2 = cw[2 * HYP + g0], cb = cbv[g0], v0 = cw[g1], v1 = cw[HYP + g1], v2 = cw[2 * HYP + g1], vb = cbv[g1];
                    const GAS bf16* r0 = UT + (size_t)g0 * M + s0; const GAS bf16* r1 = UT + (size_t)g1 * M + s1;
                    __syncthreads(); conv3_stage(r0, r1, w0, w1, w2, cb, v0, v1, v2, vb, buf, t); __syncthreads();
                    { const int tq = hfft::opaque(t); (void)tq;
#pragma unroll
                    for (int m = 0; m < 32; ++m) { const int n = tq + 512 * m; const float fr = (float)n * (1.0f / 32768.0f); const float cs = __builtin_amdgcn_cosf(fr), sn = __builtin_amdgcn_sinf(fr); const f32x2 g = buf[n];
                        const float a = ar[m], b = ai[m]; const f32x2 e = {__uint_as_float(ep[m] << 16), __uint_as_float(ep[m] & 0xffff0000u)}; const float yr = e.x + (a * cs - b * sn), yi = e.y + (a * sn + b * cs);
                        ar[m] = yr * g.x; ai[m] = yi * g.y; }
                    }
                    if (o == 0) {
                        { const int tq = hfft::opaque(t); (void)tq; GAS f32x2* G0q = G0 + (tq - t);
#pragma unroll
                        for (int m = 0; m < 32; ++m) G0q[m * 512] = (f32x2){ar[m], ai[m]};
                        }
                    } else { GAS bf16* y0 = YT + (size_t)c0 * M + s0; GAS bf16* y1 = YT + (size_t)c1 * M + s1;
                        { const int tq = hfft::opaque(t); (void)tq;
#pragma unroll
                        for (int m = 0; m < 32; ++m) { const int n = tq + 512 * m; y0[n] = f2bf(ar[m]); y1[n] = f2bf(ai[m]); } }
                        }
                    HT1(6);
                }
            }
        }
    }
    __syncthreads();
}

__device__ __forceinline__ void phase_mla_prep(Frame& F, int l) {
    const GAS bf16* CQKV = (const GAS bf16*)(wsq(F) + WS_CQKV); GAS bf16* CQN = (GAS bf16*)(wsq(F) + WS_CQN); GAS bf16* CKVN = (GAS bf16*)(wsq(F) + WS_CKVN); GAS bf16* KPE = (GAS bf16*)(wsq(F) + WS_KPE);
    const GAS float* gq = inp(F, I_QNORM) + l * QR; const GAS float* gkv = inp(F, I_KVNORM) + l * KVR; const GAS float* ct = (const GAS float*)(wsq(F) + WS_COS); const GAS float* st = (const GAS float*)(wsq(F) + WS_SIN);
    const int gw = F.vcu * NWAVES + F.wave, NGW = F.G * NWAVES, lane = F.lane;
    for (int m0 = gw; m0 < M; m0 += 4 * NGW) {
        v2u q[4]; unsigned kv[4]; float x1[4], x2[4], cs[4], sn[4]; const int j = lane & 15;
#pragma unroll
        for (int u = 0; u < 4; ++u) { const int mm = m0 + u * NGW, m = mm < M ? mm : M - 1; const GAS bf16* row = CQKV + (size_t)m * 512; const int tpos = m & (L - 1);
            q[u] = *(const GAS v2u*)(row + 4 * lane); kv[u] = *(const GAS unsigned*)(row + 256 + 2 * lane);
            x1[u] = bf2f(row[384 + j]); x2[u] = bf2f(row[384 + 16 + j]); cs[u] = ct[tpos * 16 + j]; sn[u] = st[tpos * 16 + j]; }
        const f32x4 g4 = *(const GAS f32x4*)(gq + 4 * lane); const f32x2 g2 = *(const GAS f32x2*)(gkv + 2 * lane);
#pragma unroll
        for (int u = 0; u < 4; ++u) { const int m = m0 + u * NGW; if (m >= M) break;
            const float q0 = bf2f(q[u].x & 0xffffu), q1 = bf2f(q[u].x >> 16), q2 = bf2f(q[u].y & 0xffffu), q3 = bf2f(q[u].y >> 16), k0 = bf2f(kv[u] & 0xffffu), k1 = bf2f(kv[u] >> 16);
            const float rq = 1.0f / sqrtf(wave_sum((q0 * q0 + q1 * q1) + (q2 * q2 + q3 * q3)) * (1.0f / QR) + EPS);
            const float rk = 1.0f / sqrtf(wave_sum(k0 * k0 + k1 * k1) * (1.0f / KVR) + EPS);
            v2u oq; oq.x = pk2(q0 * rq * g4.x, q1 * rq * g4.y); oq.y = pk2(q2 * rq * g4.z, q3 * rq * g4.w);
            *(GAS v2u*)(CQN + (size_t)m * QR + 4 * lane) = oq;
            *(GAS unsigned*)(CKVN + (size_t)m * KVR + 2 * lane) = pk2(k0 * rk * g2.x, k1 * rk * g2.y);
            if (lane < 16) { const int p1 = 8 * (j >> 2) + (j & 3); KPE[(size_t)m * ROPE + p1] = f2bf(x1[u] * cs[u] - x2[u] * sn[u]); KPE[(size_t)m * ROPE + p1 + 4] = f2bf(x2[u] * cs[u] + x1[u] * sn[u]); } }
    }
}

__device__ __forceinline__ void phase_hy_out(Frame& F, int l) {
    const GAS bf16* YT = (const GAS bf16*)(wsq(F) + WS_YT); GAS bf16* MIX = (GAS bf16*)(wsq(F) + WS_MIX); const GAS float* gn = inp(F, I_GNHY) + l * HYW;
    LAS bf16* tl = (LAS bf16*)(F.lds + RING_OFF + F.wave * 16384);
    const int gw = F.vcu * NWAVES + F.wave, NGW = F.G * NWAVES, lane = F.lane;
    for (int task = gw; task < 8 * (M / 64); task += NGW) {
        const int g = task & 7, tb = task >> 3, tok0 = tb * 64; const int cl = lane >> 3, t8 = (lane & 7) * 8;
        float v[8][8]; float ss[8]; const int ln_ = hw_lane();
#pragma unroll
        for (int j = 0; j < 8; ++j) ss[j] = 0.f;
#pragma unroll
        for (int i = 0; i < 8; ++i) { const int ch = g * 64 + 8 * i + cl; const v4u w = *(const GAS v4u*)(YT + (size_t)ch * M + tok0 + t8);
            v[i][0] = bf2f(w.x & 0xffffu); v[i][1] = bf2f(w.x >> 16); v[i][2] = bf2f(w.y & 0xffffu); v[i][3] = bf2f(w.y >> 16);
            v[i][4] = bf2f(w.z & 0xffffu); v[i][5] = bf2f(w.z >> 16); v[i][6] = bf2f(w.w & 0xffffu); v[i][7] = bf2f(w.w >> 16);
#pragma unroll
            for (int j = 0; j < 8; ++j) ss[j] += v[i][j] * v[i][j]; }
#pragma unroll
        for (int j = 0; j < 8; ++j) { float s = ss[j]; s += shx(s, ln_, 8); s += shx(s, ln_, 16); s += shx(s, ln_, 32); ss[j] = 1.0f / sqrtf(s * (1.0f / 64.0f) + EPS); }
#pragma unroll
        for (int i = 0; i < 8; ++i) { const int cc = 8 * i + cl; const float gg = gn[g * 64 + cc];
#pragma unroll
            for (int j = 0; j < 8; ++j) tl[(t8 + j) * 72 + cc] = f2bf(v[i][j] * ss[j] * gg); }
        LDS_WAIT(); asm volatile("" ::: "memory");
#pragma unroll
        for (int i = 0; i < 8; ++i) { const int tok = 8 * i + (lane >> 3), c8 = (lane & 7) * 8; const v4u w = *(const LAS v4u*)(tl + tok * 72 + c8);
            *(GAS v4u*)(MIX + (size_t)(tok0 + tok) * D + g * 64 + c8) = w; }
        LDS_WAIT(); asm volatile("" ::: "memory");
    }
}

namespace att {
using s16x4 = __attribute__((ext_vector_type(4))) short;
using f32x16 = __attribute__((ext_vector_type(16))) float;
using u32x4 = __attribute__((ext_vector_type(4))) unsigned;
constexpr int QBLK = 32, KVBLK = 64, NW = 8;
constexpr float SCALE = 0.10206207261596575f;
constexpr float THR = 8.f;
constexpr int SHM_K = KVBLK * 256, SHM_V = KVBLK * DV * 2;
constexpr int NSLOT = 4;
constexpr int OFF_V = 0, OFF_K = NSLOT * SHM_V, OFF_WS = OFF_K + NSLOT * SHM_K, SHM_ATTN = OFF_WS + NW * 64 * 4;
#define KSWZ(row, colB) ((row) * 256 + ((colB) ^ (((row) & 15) << 4)))
#define SBAR() __builtin_amdgcn_sched_barrier(0)
__device__ __forceinline__ int crow(int r, int hi) { return (r & 3) + 8 * (r >> 2) + 4 * hi; }
__device__ __forceinline__ unsigned cvtpk(float lo, float hi) { unsigned r; asm volatile("v_cvt_pk_bf16_f32 %0, %1, %2" : "=v"(r) : "v"(lo), "v"(hi)); return r; }
constexpr float THRL = THR * 1.4426950408889634f;
#define EX2(v) ((ABL & 1) ? (v) : __builtin_amdgcn_exp2f(v))
#define MX3(a, b, c) ((ABL & 128) ? (a) : __builtin_fmaxf(__builtin_fmaxf((a), (b)), (c)))
__device__ __forceinline__ int v_st(int k, int c) { const int kk = k; return ((kk >> 3) * 2 + (c >> 5)) * 512 + ((kk & 7) * 32 + (c & 31)) * 2; }
__device__ __forceinline__ int v_rd_base(int lane) { return ((lane & 3) << 3) | (((lane >> 2) & 3) << 6) | (((lane >> 4) & 1) << 5) | (((lane >> 5) & 1) << 8); }
constexpr int v_rd_off(int d0, int ks, int half) { return d0 * 512 + ks * 2048 + half * 1024; }
template <int OFF> __device__ __forceinline__ s16x4 tr_read(int vb) { s16x4 r; asm volatile("ds_read_b64_tr_b16 %0, %1 offset:%2" : "=&v"(r) : "v"(vb), "i"(OFF) : "memory"); return r; }
template <int ABL, bool FAST> __device__ __forceinline__ bool attn_unit(const bf16* Qb_, const bf16* KNh_, const bf16* KPEb_, const bf16* Vh_, bf16* Mo_,
                                          const float* gain_, const float* ct_, const float* st_, int tpos0, LAS char* lds, const int wave0) {
  const GAS bf16* Qb = (const GAS bf16*)Qb_; const GAS bf16* KNh = (const GAS bf16*)KNh_; const GAS bf16* KPEb = (const GAS bf16*)KPEb_; const GAS bf16* Vh = (const GAS bf16*)Vh_; GAS bf16* Mo = (GAS bf16*)Mo_;
  const GAS float* gain = (const GAS float*)gain_; const GAS float* ct = (const GAS float*)ct_; const GAS float* st = (const GAS float*)st_;

  int tid_ = tid_from_wave(wave0);
  const int tid = tid_, wid = tid >> 6, lane = tid & 63, r32 = lane & 31, hi = lane >> 5;
  LAS char* V_lds = lds + OFF_V; LAS char* K_lds = lds + OFF_K;
  LAS float* ws = (LAS float*)(lds + OFF_WS) + wid * 64; LAS float* li_l = ws; LAS float* al_l = ws + 32;
  volatile LAS unsigned* bad_l = (volatile LAS unsigned*)(lds + SHM_ATTN);
  if (FAST && tid == 0) *bad_l = 0u;
  float m_reg = 0.f, l_reg = 0.f; f32x16 o[2] = {}; f32x16 negm = {}; bf16x8 qr[6];
  const GAS bf16* Qw = Qb + (long)(wid * QBLK + r32) * NQ + hi * 8;
#pragma unroll
  for (int d0 = 0; d0 < 6; ++d0) qr[d0] = *reinterpret_cast<const GAS bf16x8*>(Qw + d0 * 16);
  { const int tq = tpos0 + wid * QBLK + r32;
#pragma unroll
    for (int d0 = 4; d0 < 6; ++d0) { const int fq = 2 * (d0 - 4) + hi; const f32x4 cs = *reinterpret_cast<const GAS f32x4*>(ct + tq * 16 + 4 * fq), sn = *reinterpret_cast<const GAS f32x4*>(st + tq * 16 + 4 * fq);
      const u32x4 w = __builtin_bit_cast(u32x4, qr[d0]);
      const f32x4 x1 = {bf2f(w[0] & 0xffffu), bf2f(w[0] >> 16), bf2f(w[1] & 0xffffu), bf2f(w[1] >> 16)}, x2 = {bf2f(w[2] & 0xffffu), bf2f(w[2] >> 16), bf2f(w[3] & 0xffffu), bf2f(w[3] >> 16)};
      const f32x4 a = x1 * cs - x2 * sn, b = x2 * cs + x1 * sn;
      const u32x4 o4 = {cvtpk(a[0], a[1]), cvtpk(a[2], a[3]), cvtpk(b[0], b[1]), cvtpk(b[2], b[3])}; qr[d0] = __builtin_bit_cast(bf16x8, o4); } }
  { constexpr float C = SCALE * 1.4426950408889634f;
#pragma unroll
    for (int d0 = 0; d0 < 6; ++d0) { const u32x4 w = __builtin_bit_cast(u32x4, qr[d0]); u32x4 o4;
#pragma unroll
      for (int e = 0; e < 4; ++e) o4[e] = cvtpk(bf2f(w[e] & 0xffffu) * C, bf2f(w[e] >> 16) * C);
      qr[d0] = __builtin_bit_cast(bf16x8, o4); } }
  const int vb0 = (int)(unsigned)(uintptr_t)V_lds + v_rd_base(lane);
  const int wid_s = __builtin_amdgcn_readfirstlane(wid);
  const GAS bf16* ksrc[2]; long kstep[2];
#pragma unroll
  for (int q = 0; q < 2; ++q) { const int r = 4 * (2 * wid + q) + (lane >> 4), c = (lane & 15) ^ (r & 15); const bool rope = (c >= 8) && (c < 12);
    ksrc[q] = rope ? KPEb + (long)r * ROPE + (c - 8) * 8 : KNh + (long)r * NKV + (c & 7) * 8; kstep[q] = rope ? (long)KVBLK * ROPE : (long)KVBLK * NKV; }
  const GAS bf16* vsrc; { const int p = 64 * wid + lane, sub = p >> 5, kk = (sub >> 1) * 8 + ((p >> 2) & 7), col = (sub & 1) * 32 + (p & 3) * 8; vsrc = Vh + (long)kk * NKV + col; }
#define DMA(t, slot) do { if (ABL & 32) break; \
    __builtin_amdgcn_global_load_lds((const GAS unsigned*)(ksrc[0] + (long)(t) * kstep[0]), (LAS unsigned*)(K_lds + (slot) * SHM_K + (2 * wid_s) * 1024), 16, 0, 0); \
    __builtin_amdgcn_global_load_lds((const GAS unsigned*)(ksrc[1] + (long)(t) * kstep[1]), (LAS unsigned*)(K_lds + (slot) * SHM_K + (2 * wid_s + 1) * 1024), 16, 0, 0); \
    __builtin_amdgcn_global_load_lds((const GAS unsigned*)(vsrc + (long)(t) * ((long)KVBLK * NKV)), (LAS unsigned*)(V_lds + (slot) * SHM_V + wid_s * 1024), 16, 0, 0); } while (0)
#define TBAR(N) do { asm volatile("s_waitcnt vmcnt(" #N ") lgkmcnt(0)" ::: "memory"); if (!(ABL & 64)) __builtin_amdgcn_s_barrier(); asm volatile("" ::: "memory"); } while (0)
#define RESC(a) do { if (__any((a) < 1.f)) { if (hi == 0) al_l[r32] = (a); asm volatile("s_waitcnt lgkmcnt(0)" ::: "memory"); \
    _Pragma("unroll") for (int d = 0; d < 2; ++d) _Pragma("unroll") for (int r = 0; r < 16; ++r) o[d][r] *= al_l[crow(r, hi)]; } } while (0)
  f32x16 pA0, pA1, pB0, pB1; bf16x8 pa0, pa1, pa2, pa3; constexpr int NTL = L / KVBLK; constexpr int SE = 0, SO = 1;
  int koff[6];
#pragma unroll
  for (int d0 = 0; d0 < 6; ++d0) koff[d0] = KSWZ(r32, (d0 * 16 + hi * 8) * 2);
  s16x4 vl[4], vh[4], vl2[4], vh2[4]; float pmax = 0.f, alpha = 1.f; unsigned w0_ = 0, w1_ = 0; float sa_ = 0.f, sb_ = 0.f;
#define KFR(i) ((ABL & 8) ? qr[(i) >> 1] : *(const LAS bf16x8*)(kbase + koff[(i) >> 1] + ((i) & 1) * 8192))
#define MQK(a_, b_, c_) ((ABL & 2) ? (c_) : __builtin_amdgcn_mfma_f32_32x32x16_bf16(a_, b_, c_, 0, 0, 0))
#define MPV(a_, b_, c_) ((ABL & 4) ? (c_) : __builtin_amdgcn_mfma_f32_32x32x16_bf16(a_, b_, c_, 0, 0, 0))
#define VRD8(D0) do { if (ABL & 16) break; vl[0] = tr_read<v_rd_off(D0, 0, 0)>(vbq); vh[0] = tr_read<v_rd_off(D0, 0, 1)>(vbq); vl[1] = tr_read<v_rd_off(D0, 1, 0)>(vbq); vh[1] = tr_read<v_rd_off(D0, 1, 1)>(vbq); \
    vl[2] = tr_read<v_rd_off(D0, 2, 0)>(vbq); vh[2] = tr_read<v_rd_off(D0, 2, 1)>(vbq); vl[3] = tr_read<v_rd_off(D0, 3, 0)>(vbq); vh[3] = tr_read<v_rd_off(D0, 3, 1)>(vbq); } while (0)
#define VWAIT() if (!(ABL & 16)) asm volatile("s_waitcnt lgkmcnt(0)" : "+v"(vl[0]), "+v"(vh[0]), "+v"(vl[1]), "+v"(vh[1]), "+v"(vl[2]), "+v"(vh[2]), "+v"(vl[3]), "+v"(vh[3]) :: "memory")
#define VFR(k) (bf16x8){vl[k][0], vl[k][1], vl[k][2], vl[k][3], vh[k][0], vh[k][1], vh[k][2], vh[k][3]}
#define PKA(P, B) do { if (ABL & 256) break; w0_ = cvtpk(P[B + 0], P[B + 1]); w1_ = cvtpk(P[B + 2], P[B + 3]); } while (0)
#define PKB(P, B, OUT) do { if (ABL & 256) { OUT = qr[0]; break; } const u32x4 w_ = {w0_, w1_, cvtpk(P[B + 4], P[B + 5]), cvtpk(P[B + 6], P[B + 7])}; OUT = __builtin_bit_cast(bf16x8, w_); } while (0)
#define R1(DO_QK, DO_FIN, X0, X1, Y0, Y1, KSLOT) do { const LAS char* kbase = K_lds + (KSLOT) * SHM_K; bf16x8 kf0, kf1, kf2, kf3; unsigned w0_ = 0, w1_ = 0; \
    if (DO_QK) { kf0 = KFR(0); kf1 = KFR(1); kf2 = KFR(2); } SBAR(); \
      if (DO_QK) { kf3 = KFR(3); X0 = MQK(kf0, qr[0], negm); } if (DO_FIN) { Y0[0] = EX2(Y0[0]); Y0[1] = EX2(Y0[1]); Y0[2] = EX2(Y0[2]); Y0[3] = EX2(Y0[3]); } SBAR(); \
      if (DO_QK) { kf0 = KFR(4); X1 = MQK(kf1, qr[0], negm); } if (DO_FIN) { Y0[4] = EX2(Y0[4]); Y0[5] = EX2(Y0[5]); Y0[6] = EX2(Y0[6]); Y0[7] = EX2(Y0[7]); } SBAR(); \
      if (DO_QK) { kf1 = KFR(5); X0 = MQK(kf2, qr[1], X0); } if (DO_FIN) { Y0[8] = EX2(Y0[8]); Y0[9] = EX2(Y0[9]); Y0[10] = EX2(Y0[10]); Y0[11] = EX2(Y0[11]); } SBAR(); \
      if (DO_QK) { kf2 = KFR(6); X1 = MQK(kf3, qr[1], X1); } if (DO_FIN) { Y0[12] = EX2(Y0[12]); Y0[13] = EX2(Y0[13]); Y0[14] = EX2(Y0[14]); Y0[15] = EX2(Y0[15]); } SBAR(); \
      if (DO_QK) { kf3 = KFR(7); X0 = MQK(kf0, qr[2], X0); } if (DO_FIN) { Y1[0] = EX2(Y1[0]); Y1[1] = EX2(Y1[1]); Y1[2] = EX2(Y1[2]); Y1[3] = EX2(Y1[3]); PKA(Y0, 0); } SBAR(); \
      if (DO_QK) { kf0 = KFR(8); X1 = MQK(kf1, qr[2], X1); } if (DO_FIN) { Y1[4] = EX2(Y1[4]); Y1[5] = EX2(Y1[5]); Y1[6] = EX2(Y1[6]); Y1[7] = EX2(Y1[7]); PKB(Y0, 0, pa0); } SBAR(); \
      if (DO_QK) { kf1 = KFR(9); X0 = MQK(kf2, qr[3], X0); } if (DO_FIN) { Y1[8] = EX2(Y1[8]); Y1[9] = EX2(Y1[9]); Y1[10] = EX2(Y1[10]); Y1[11] = EX2(Y1[11]); PKA(Y0, 8); } SBAR(); \
      if (DO_QK) { kf2 = KFR(10); X1 = MQK(kf3, qr[3], X1); } if (DO_FIN) { Y1[12] = EX2(Y1[12]); Y1[13] = EX2(Y1[13]); Y1[14] = EX2(Y1[14]); Y1[15] = EX2(Y1[15]); PKB(Y0, 8, pa1); } SBAR(); \
      if (DO_QK) { kf3 = KFR(11); X0 = MQK(kf0, qr[4], X0); } if (DO_FIN) { PKA(Y1, 0); } SBAR(); \
      if (DO_QK) { X1 = MQK(kf1, qr[4], X1); } if (DO_FIN) { PKB(Y1, 0, pa2); } SBAR(); \
      if (DO_QK) { X0 = MQK(kf2, qr[5], X0); } if (DO_FIN) { PKA(Y1, 8); } SBAR(); \
      if (DO_QK) { X1 = MQK(kf3, qr[5], X1); } if (DO_FIN) { PKB(Y1, 8, pa3); } SBAR(); \
  } while (0)
#define R2(DO_PV, DO_MAX, X0, X1, Y0, Y1, VSLOT, LOADS) do { const int vbq = vb0 + (VSLOT) * SHM_V; float ma_ = 0.f, mb_ = 0.f, sa_ = 0.f; \
    if (DO_PV) { VRD8(0); } SBAR(); \
    if (DO_PV) { VWAIT(); o[0] = MPV(pa0, VFR(0), o[0]); if (!(ABL & 640)) sa_ = (Y0[0] + Y0[1]) + (Y0[2] + Y0[3]); } SBAR(); \
    if (DO_PV) { o[0] = MPV(pa1, VFR(1), o[0]); if (!(ABL & 640)) sa_ += Y0[4]; if (!(ABL & 640)) sa_ += Y0[5]; if (!(ABL & 640)) sa_ += Y0[6]; if (!(ABL & 640)) sa_ += Y0[7]; } LOADS; SBAR(); \
    if (DO_PV) { o[0] = MPV(pa2, VFR(2), o[0]); if (!(ABL & 640)) sa_ += Y0[8]; if (!(ABL & 640)) sa_ += Y0[9]; if (!(ABL & 640)) sa_ += Y0[10]; if (!(ABL & 640)) sa_ += Y0[11]; } SBAR(); \
    if (DO_PV) { o[0] = MPV(pa3, VFR(3), o[0]); if (!(ABL & 640)) sa_ += Y0[12]; if (!(ABL & 640)) sa_ += Y0[13]; if (!(ABL & 640)) sa_ += Y0[14]; if (!(ABL & 640)) sa_ += Y0[15]; } SBAR(); \
    if (DO_PV) { VRD8(1); if (!(ABL & 640)) sa_ += Y1[0]; if (!(ABL & 640)) sa_ += Y1[1]; if (!(ABL & 640)) sa_ += Y1[2]; if (!(ABL & 640)) sa_ += Y1[3]; if (!(ABL & 640)) sa_ += Y1[4]; if (!(ABL & 640)) sa_ += Y1[5]; if (!(ABL & 640)) sa_ += Y1[6]; if (!(ABL & 640)) sa_ += Y1[7]; } \
    if (DO_MAX) { ma_ = MX3(X0[0], X0[1], X1[0]); mb_ = MX3(X0[2], X0[3], X1[1]); ma_ = MX3(ma_, X1[2], X1[3]); ma_ = MX3(ma_, X0[4], X0[5]); mb_ = MX3(mb_, X0[6], X0[7]); ma_ = MX3(ma_, X1[4], X1[5]); mb_ = MX3(mb_, X1[6], X1[7]); } SBAR(); \
    if (DO_PV) { VWAIT(); o[1] = MPV(pa0, VFR(0), o[1]); if (!(ABL & 640)) sa_ += Y1[8]; if (!(ABL & 640)) sa_ += Y1[9]; if (!(ABL & 640)) sa_ += Y1[10]; if (!(ABL & 640)) sa_ += Y1[11]; } if (DO_MAX) { ma_ = MX3(ma_, X0[8], X0[9]); mb_ = MX3(mb_, X0[10], X0[11]); } SBAR(); \
    if (DO_PV) { o[1] = MPV(pa1, VFR(1), o[1]); if (!(ABL & 640)) sa_ += Y1[12]; if (!(ABL & 640)) sa_ += Y1[13]; if (!(ABL & 640)) sa_ += Y1[14]; if (!(ABL & 640)) sa_ += Y1[15]; } if (DO_MAX) { ma_ = MX3(ma_, X1[8], X1[9]); mb_ = MX3(mb_, X1[10], X1[11]); } SBAR(); \
    if (DO_PV) { o[1] = MPV(pa2, VFR(2), o[1]); l_reg += sa_; if (ABL & 512) { o[0] = MPV(pa0, qr[0], o[0]); o[0] = MPV(pa1, qr[0], o[0]); } } if (DO_MAX) { ma_ = MX3(ma_, X0[12], X0[13]); mb_ = MX3(mb_, X0[14], X0[15]); ma_ = MX3(ma_, X1[12], X1[13]); mb_ = MX3(mb_, X1[14], X1[15]); } SBAR(); \
    if (DO_PV) { o[1] = MPV(pa3, VFR(3), o[1]); if (ABL & 512) { o[0] = MPV(pa2, qr[0], o[0]); o[0] = MPV(pa3, qr[0], o[0]); } } if (DO_MAX) { float m_ = __builtin_fmaxf(ma_, mb_); auto rr_ = __builtin_amdgcn_permlane32_swap(__float_as_uint(m_), __float_as_uint(m_), false, false); pmax = __builtin_fmaxf(__uint_as_float(rr_[0]), __uint_as_float(rr_[1])); } SBAR(); \
  } while (0)
#define EXF(Y, i) Y[i] = EX2(Y[i])
#define VRDH(D0, K0, VL, VH) do { VL[K0] = tr_read<v_rd_off(D0, K0, 0)>(vbq); VH[K0] = tr_read<v_rd_off(D0, K0, 1)>(vbq); VL[K0 + 1] = tr_read<v_rd_off(D0, K0 + 1, 0)>(vbq); VH[K0 + 1] = tr_read<v_rd_off(D0, K0 + 1, 1)>(vbq); } while (0)
#define VWAIT2() asm volatile("s_waitcnt lgkmcnt(0)" : "+v"(vl2[0]), "+v"(vh2[0]), "+v"(vl2[1]), "+v"(vh2[1]), "+v"(vl2[2]), "+v"(vh2[2]), "+v"(vl2[3]), "+v"(vh2[3]) :: "memory")
#define VFR2(k) (bf16x8){vl2[k][0], vl2[k][1], vl2[k][2], vl2[k][3], vh2[k][0], vh2[k][1], vh2[k][2], vh2[k][3]}
#define R1F(X0, X1, Y0, Y1, KSLOT, VSLOT) do { const LAS char* kbase = K_lds + (KSLOT) * SHM_K; const int vbq = vb0 + (VSLOT) * SHM_V; bf16x8 kf0, kf1, kf2, kf3; \
    kf0 = KFR(0); kf1 = KFR(1); kf2 = KFR(2); EXF(Y0, 0); EXF(Y0, 1); EXF(Y0, 2); EXF(Y0, 3); SBAR(); \
      kf3 = KFR(3); X0 = MQK(kf0, qr[0], negm); EXF(Y0, 4); EXF(Y0, 5); SBAR(); \
      kf0 = KFR(4); X1 = MQK(kf1, qr[0], negm); EXF(Y0, 6); EXF(Y0, 7); PKA(Y0, 0); SBAR(); \
      kf1 = KFR(5); X0 = MQK(kf2, qr[1], X0); EXF(Y0, 8); EXF(Y0, 9); PKB(Y0, 0, pa0); SBAR(); \
      kf2 = KFR(6); X1 = MQK(kf3, qr[1], X1); EXF(Y0, 10); EXF(Y0, 11); sa_ = Y0[0] + Y0[1]; sb_ = Y0[2] + Y0[3]; SBAR(); \
      kf3 = KFR(7); X0 = MQK(kf0, qr[2], X0); EXF(Y0, 12); EXF(Y0, 13); sa_ += Y0[4]; sb_ += Y0[5]; SBAR(); \
      kf0 = KFR(8); X1 = MQK(kf1, qr[2], X1); EXF(Y0, 14); EXF(Y0, 15); PKA(Y0, 8); SBAR(); \
      kf1 = KFR(9); X0 = MQK(kf2, qr[3], X0); EXF(Y1, 0); EXF(Y1, 1); PKB(Y0, 8, pa1); SBAR(); \
      kf2 = KFR(10); X1 = MQK(kf3, qr[3], X1); EXF(Y1, 2); EXF(Y1, 3); sa_ += Y0[6]; sb_ += Y0[7]; SBAR(); \
      kf3 = KFR(11); X0 = MQK(kf0, qr[4], X0); EXF(Y1, 4); EXF(Y1, 5); sa_ += Y0[8]; sb_ += Y0[9]; SBAR(); \
      X1 = MQK(kf1, qr[4], X1); VRDH(0, 0, vl, vh); EXF(Y1, 6); EXF(Y1, 7); PKA(Y1, 0); SBAR(); \
      X0 = MQK(kf2, qr[5], X0); VRDH(0, 2, vl, vh); EXF(Y1, 8); EXF(Y1, 9); PKB(Y1, 0, pa2); SBAR(); \
      X1 = MQK(kf3, qr[5], X1); EXF(Y1, 10); EXF(Y1, 11); sa_ += Y0[10]; sb_ += Y0[11]; SBAR(); \
  } while (0)
#define R2F(Y0, Y1, VSLOT, LOADS) do { const int vbq = vb0 + (VSLOT) * SHM_V; \
      VWAIT(); o[0] = MPV(pa0, VFR(0), o[0]); EXF(Y1, 12); EXF(Y1, 13); sa_ += Y0[12]; sb_ += Y0[13]; SBAR(); \
      o[0] = MPV(pa1, VFR(1), o[0]); VRDH(1, 0, vl2, vh2); EXF(Y1, 14); EXF(Y1, 15); PKA(Y1, 8); LOADS; SBAR(); \
      o[0] = MPV(pa2, VFR(2), o[0]); VRDH(1, 2, vl2, vh2); PKB(Y1, 8, pa3); sa_ += Y0[14]; sb_ += Y0[15]; sa_ += Y1[0]; SBAR(); \
      o[0] = MPV(pa3, VFR(3), o[0]); sb_ += Y1[1]; sa_ += Y1[2]; sb_ += Y1[3]; sa_ += Y1[4]; SBAR(); \
      VWAIT2(); o[1] = MPV(pa0, VFR2(0), o[1]); sb_ += Y1[5]; sa_ += Y1[6]; sb_ += Y1[7]; sa_ += Y1[8]; SBAR(); \
      o[1] = MPV(pa1, VFR2(1), o[1]); sb_ += Y1[9]; sa_ += Y1[10]; sb_ += Y1[11]; sa_ += Y1[12]; SBAR(); \
      o[1] = MPV(pa2, VFR2(2), o[1]); sb_ += Y1[13]; sa_ += Y1[14]; sb_ += Y1[15]; SBAR(); \
      o[1] = MPV(pa3, VFR2(3), o[1]); l_reg += sa_ + sb_; SBAR(); \
  } while (0)
#define DECIDE(FIRST, X0, X1) do { alpha = 1.f; \
    if ((FIRST) || !__builtin_expect(__all(pmax <= THRL), 1)) { const float d_ = (FIRST) ? pmax : __builtin_fmaxf(pmax, 0.f); m_reg += d_; if (!(FIRST)) alpha = EX2(-d_); \
      _Pragma("unroll") for (int r = 0; r < 16; ++r) { X0[r] -= d_; X1[r] -= d_; } \
      _Pragma("unroll") for (int r = 0; r < 16; ++r) negm[r] = -m_reg; l_reg *= alpha; } \
    RESC(alpha); } while (0)
  DMA(0, 0); DMA(1, 1);
  TBAR(3);
  R1(true, false, pA0, pA1, pB0, pB1, 0);
  R2(false, true, pA0, pA1, pB0, pB1, 0, DMA(2, 2));
  DECIDE(true, pA0, pA1);
  TBAR(3);
  for (int j = 1; j + 1 < NTL; j += 2) {
    if (FAST) { R1F(pB0, pB1, pA0, pA1, j & 3, (j - 1) & 3); R2F(pA0, pA1, (j - 1) & 3, DMA(j + 2, (j + 2) & 3)); }
    else { R1(true, true, pB0, pB1, pA0, pA1, j & 3);
    R2(true, true, pB0, pB1, pA0, pA1, (j - 1) & 3, DMA(j + 2, (j + 2) & 3));
    DECIDE(false, pB0, pB1); }
    TBAR(3);
    if (FAST) { R1F(pA0, pA1, pB0, pB1, (j + 1) & 3, j & 3); R2F(pB0, pB1, j & 3, if (j + 3 < NTL) DMA(j + 3, (j + 3) & 3)); }
    else { R1(true, true, pA0, pA1, pB0, pB1, (j + 1) & 3);
    R2(true, true, pA0, pA1, pB0, pB1, j & 3, if (j + 3 < NTL) DMA(j + 3, (j + 3) & 3));
    DECIDE(false, pA0, pA1); }
    if (j + 3 < NTL) TBAR(3); else TBAR(0);
  }
  if (FAST) { R1F(pB0, pB1, pA0, pA1, (NTL - 1) & 3, (NTL - 2) & 3); R2F(pA0, pA1, (NTL - 2) & 3, (void)0); }
  else { R1(true, true, pB0, pB1, pA0, pA1, (NTL - 1) & 3);
  R2(true, true, pB0, pB1, pA0, pA1, (NTL - 2) & 3, (void)0);
  DECIDE(false, pB0, pB1); }
  R1(false, true, pA0, pA1, pB0, pB1, 0);
  R2(true, false, pA0, pA1, pB0, pB1, (NTL - 1) & 3, (void)0);
#undef DECIDE
#undef R1F
#undef R2F
#undef EXF
#undef VRDH
#undef VWAIT2
#undef VFR2
#undef R2
#undef R1
#undef PKA
#undef PKB
#undef VFR
#undef VWAIT
#undef VRD8
#undef KFR
  if (FAST) {
    if (__any(!(l_reg < 1.0e30f)) && lane == 0) *bad_l = 1u;
    __syncthreads();
    const unsigned bad = *bad_l;
    if (__builtin_amdgcn_readfirstlane((int)bad) != 0) { __syncthreads(); return false; }
  }
  { auto rr = __builtin_amdgcn_permlane32_swap(__float_as_uint(l_reg), __float_as_uint(l_reg), false, false); l_reg = __uint_as_float(rr[0]) + __uint_as_float(rr[1]); }
  if (hi == 0) li_l[r32] = l_reg; asm volatile("s_waitcnt lgkmcnt(0)" ::: "memory");
  const float g0 = gain[r32], g1 = gain[32 + r32]; const int ln_ = hw_lane();
  GAS bf16* Ow = Mo + (long)(wid * QBLK) * D;
#pragma unroll
  for (int r = 0; r < 16; ++r) { const int orow = crow(r, hi); const float rl = __builtin_amdgcn_rcpf(li_l[orow]);
    const float y0 = o[0][r] * rl, y1 = o[1][r] * rl; float s = y0 * y0 + y1 * y1;
    s += shx(s, ln_, 1); s += shx(s, ln_, 2); s += shx(s, ln_, 4); s += shx(s, ln_, 8); s += shx(s, ln_, 16);
    const float rs = 1.0f / sqrtf(s * (1.0f / 64.0f) + EPS);
    Ow[(long)orow * D + r32] = f2bf(y0 * rs * g0); Ow[(long)orow * D + 32 + r32] = f2bf(y1 * rs * g1); }
  __syncthreads();
  return true;
#undef DMA
#undef TBAR
#undef RESC
}
#undef EX2
#undef MX3
#undef KSWZ
#undef SBAR
}
#define XB_TMO      128
#define XB_XCNT(j)  (256  + 64 * (j))
#define XB_XSUB(j)  (1280 + 64 * (j))
#define XB_XGEN(j)  (2304 + 64 * (j))
#define XB_TOP      3328
#define XB_TOPGEN   3392
#define XCD_BAR_WORDS 3456
#define XB_SPIN_CAP (1u << 18)

__device__ __forceinline__ unsigned xb_ld(unsigned* p)              { return __hip_atomic_load(p, __ATOMIC_RELAXED, __HIP_MEMORY_SCOPE_AGENT); }
__device__ __forceinline__ unsigned xb_add(unsigned* p, unsigned v) { return __hip_atomic_fetch_add(p, v, __ATOMIC_RELAXED, __HIP_MEMORY_SCOPE_AGENT); }
__device__ __forceinline__ unsigned xb_xcc_id() { return (unsigned)__builtin_amdgcn_s_getreg((3 << 11) | 20) & 0xFu; }
#define XB_SPIN(cond, bar) do { unsigned _sp = 0; while (cond) { __builtin_amdgcn_s_sleep(1); \
    if ((++_sp & 255u) == 0u) { if (xb_ld(&(bar)[XB_TMO])) break; if (_sp > XB_SPIN_CAP) { atomicAdd(&(bar)[XB_TMO], 1u); break; } } } } while (0)

struct XcdBarrier {
    unsigned* bar; unsigned x;
    volatile LAS unsigned* st;
};

__device__ __forceinline__ XcdBarrier xcd_barrier_post(unsigned* bar, volatile LAS unsigned* st, const bool t0) {
    XcdBarrier b; b.bar = bar; b.x = xb_xcc_id(); b.st = st;
    if (t0) (void)xb_add(&bar[XB_XCNT(b.x)], 1u);
    return b;
}
__device__ __forceinline__ void xcd_barrier_complete(unsigned* bar, unsigned x, unsigned& nloc, unsigned& nx) {
    const unsigned G = gridDim.x * gridDim.y * gridDim.z;
    unsigned sum, cnt, mine, sp = 0u;
    for (;;) {
        sum = 0u; cnt = 0u; mine = 0u;
#pragma unroll
        for (unsigned j = 0; j < 16; ++j) { const unsigned c = xb_ld(&bar[XB_XCNT(j)]); sum += c; cnt += (c > 0u) ? 1u : 0u; mine = (j == x) ? c : mine; }
        if (sum == G) break;
        __builtin_amdgcn_s_sleep(1);
        if ((++sp & 255u) == 0u) { if (xb_ld(&bar[XB_TMO])) break; if (sp > XB_SPIN_CAP) { atomicAdd(&bar[XB_TMO], 1u); break; } }
    }
    nloc = mine > 0u ? mine : 1u; nx = cnt > 0u ? cnt : 1u;
}

__device__ __forceinline__ void xcd_barrier(const XcdBarrier& b, const bool t0) {
    asm volatile("s_waitcnt vmcnt(0)" ::: "memory");
    __syncthreads();
    if (t0) {
        unsigned* bar = b.bar;
        __builtin_amdgcn_s_waitcnt(0);
        unsigned nloc = b.st[0], nx = b.st[1];
        if (nloc == 0u) { xcd_barrier_complete(bar, b.x, nloc, nx); b.st[0] = nloc; b.st[1] = nx; }
        const unsigned old = xb_add(&bar[XB_XSUB(b.x)], 1u);
        const unsigned gen = old / nloc;
        if (old + 1u == (gen + 1u) * nloc) {
            __builtin_amdgcn_fence(__ATOMIC_RELEASE, "agent");
            asm volatile("s_waitcnt vmcnt(0)" ::: "memory");
            const unsigned og = xb_add(&bar[XB_TOP], 1u);
            const unsigned tg = og / nx;
            if (og + 1u == (tg + 1u) * nx) xb_add(&bar[XB_TOPGEN], 1u);
            else XB_SPIN(xb_ld(&bar[XB_TOPGEN]) == tg, bar);
            __builtin_amdgcn_fence(__ATOMIC_ACQUIRE, "agent");
            xb_add(&bar[XB_XGEN(b.x)], 1u);
            asm volatile("s_waitcnt vmcnt(0)" ::: "memory");
        } else {
            XB_SPIN(xb_ld(&bar[XB_XGEN(b.x)]) == gen, bar);
            __builtin_amdgcn_fence(__ATOMIC_ACQUIRE, "agent");
            asm volatile("s_waitcnt vmcnt(0)" ::: "memory");
        }
    }
    __syncthreads();
}

__device__ __forceinline__ void xcd_barrier_fast(const XcdBarrier& b, const bool t0) {
    asm volatile("s_waitcnt vmcnt(0)" ::: "memory");
    __syncthreads();
    if (t0) {
        unsigned* bar = b.bar; asm volatile("" : "+s"(bar));
        __builtin_amdgcn_s_waitcnt(0);
        unsigned nloc = b.st[0], nx = b.st[1];
        unsigned bx_ = b.x; asm volatile("" : "+s"(bx_));
        const unsigned old = xb_add(&bar[XB_XSUB(bx_)], 1u);
        const unsigned gen = old / nloc;
        if (old + 1u == (gen + 1u) * nloc) {
            __builtin_amdgcn_fence(__ATOMIC_RELEASE, "agent");
            asm volatile("s_waitcnt vmcnt(0)" ::: "memory");
            const unsigned og = xb_add(&bar[XB_TOP], 1u);
            const unsigned tg = og / nx;
            if (og + 1u == (tg + 1u) * nx) xb_add(&bar[XB_TOPGEN], 1u);
            else XB_SPIN(xb_ld(&bar[XB_TOPGEN]) == tg, bar);
            __builtin_amdgcn_fence(__ATOMIC_ACQUIRE, "agent");
            xb_add(&bar[XB_XGEN(bx_)], 1u);
            asm volatile("s_waitcnt vmcnt(0)" ::: "memory");
        } else {
            XB_SPIN(xb_ld(&bar[XB_XGEN(bx_)]) == gen, bar);
            __builtin_amdgcn_fence(__ATOMIC_ACQUIRE, "agent");
            asm volatile("s_waitcnt vmcnt(0)" ::: "memory");
        }
    }
    __syncthreads();
}

constexpr int CW_BAR = 4096;
struct Args { const float* in[26]; float* out; unsigned char* ws; };
#ifndef REP_ATT
#define REP_ATT 1
#endif
#ifndef REP_GEMM
#define REP_GEMM 1
#endif
#ifndef REP_HY
#define REP_HY 1
#endif
#ifndef REP_FILT
#define REP_FILT 1
#endif
#ifndef REP_PREP
#define REP_PREP 1
#endif
#ifndef REP_HYOUT
#define REP_HYOUT 1
#endif
#ifndef REP_MISC
#define REP_MISC 1
#endif
#ifndef PROBE_MASK
#define PROBE_MASK 0
#endif
#define TIC() do { if (PROBE_MASK) pr_t0 = __builtin_amdgcn_s_memrealtime(); } while (0)
#define TOC(ph) do { if (PROBE_MASK & (1u << (ph))) pr_acc += __builtin_amdgcn_s_memrealtime() - pr_t0; } while (0)
#define REPEAT(n) _Pragma("unroll 1") for (int rep_ = 0; rep_ < (n); ++rep_)
#define REFRESH() do { const int t_ = tid_from_wave(F.wave0); F.tid = t_; F.lane = t_ & 63; F.wave = __builtin_amdgcn_readfirstlane(t_ >> 6); int v_ = F.vcu; asm volatile("" : "+s"(v_)); F.vcu = v_; } while (0)
#define BXQ() ({ int b_ = (int)blockIdx.x; asm volatile("" : "+s"(b_)); b_; })
#define GEMM_PHASE(EPI, g, S, E) REPEAT(REP_GEMM) pg8::gemm_phase<EPI, pg8::StaticOrder, true, true>(F.lds + RING_OFF, g, S, E, F.wave0)

__global__ void __launch_bounds__(NTHR, 2) hyena_mla_fwd(Args args) {
    extern __shared__ __attribute__((aligned(16))) unsigned char lds[];
    Frame F;
    F.lds = (LAS unsigned char*)lds;
    F.MISC = (volatile LAS unsigned*)(F.lds + MISC_OFF);
    F.tid = threadIdx.x; F.lane = F.tid & 63; F.wave = __builtin_amdgcn_readfirstlane(F.tid >> 6); F.wave0 = F.wave;
    F.G = gridDim.x; { const int bx = blockIdx.x; F.vcu = (F.G % 8 == 0) ? (bx % 8) * (F.G / 8) + bx / 8 : bx; }
    F.ws = args.ws; F.out = args.out; F.ctl = (gu32*)(args.ws + WS_CTL);
    if (F.tid == 0) {
#pragma unroll
        for (int i = 0; i < 26; ++i) *(LAS unsigned long long*)(F.lds + PTRTAB_OFF + 8 * i) = (unsigned long long)args.in[i];
    }
    for (int u = F.tid; u < 512 / 4; u += NTHR) ((LAS unsigned*)(F.lds + LDSCTL_OFF))[u] = 0u;
    __syncthreads();
    XcdBarrier bar = xcd_barrier_post((unsigned*)(F.ctl + CW_BAR), F.MISC + 8, F.tid == 0);
    xcd_barrier(bar, F.tid == 0);
    unsigned long long pr_t0 = 0, pr_acc = 0; (void)pr_t0;
#pragma unroll 1
    for (int l = 0; l < DEPTH; ++l) {
        TIC();
        HT0(); REPEAT(REP_MISC) { REFRESH(); phase_weights(F, l); }
        __syncthreads(); HT1(21); HT0();
        REFRESH(); phase_filter_mlp(F, l); HT1(22); HT0();
        if (l == 0) { REFRESH(); phase_rope_tab(F); REFRESH(); phase_norm_first(F, 0, inp(F, I_NMIXPRE)); } HT1(23);
        { REFRESH(); xcd_barrier_fast(bar, F.tid == 0); } TOC(0); TIC();
        { unsigned char* w = (unsigned char*)wsq(F); pg8::Gemm g{(bf16*)(w + WS_W3T), (bf16*)(w + WS_H2), 2048, L, 128}; pg8::StaticOrder S; S.init(2048, L, F.G, BXQ());
          pg8::EpiTaps E{(float*)(w + WS_KT), (const float*)inp(F, I_DECAY) + (size_t)l * 2048}; GEMM_PHASE(pg8::EpiTaps, g, S, E); }
        { REFRESH(); xcd_barrier_fast(bar, F.tid == 0); } TOC(1); TIC();
        REPEAT(REP_FILT) { REFRESH(); phase_filter_fft(F, l); }
        { REFRESH(); xcd_barrier_fast(bar, F.tid == 0); } TOC(2); TIC();
        { unsigned char* w = (unsigned char*)wsq(F); bf16* WinT = (bf16*)(w + WS_WIN); bf16* XN = (bf16*)(w + WS_XN); bf16* UT = (bf16*)(w + WS_UT); bf16* CQKV = (bf16*)(w + WS_CQKV);
          { pg8::Gemm g{WinT, XN, HYP, M, D}; pg8::StaticOrder S; S.init(HYP, M, F.G, BXQ());
          pg8::EpiBf16<0> E{UT, M, nullptr, 0, 0, 1.f}; GEMM_PHASE(pg8::EpiBf16<0>, g, S, E); }
        { pg8::Gemm g{XN, WinT + (size_t)HYP * D, M, 512, D}; pg8::StaticOrder S; S.init(M, 512, F.G, (BXQ() + 128) % F.G);
          pg8::EpiBf16<0> E{CQKV, 512, nullptr, 0, 0, 1.f}; GEMM_PHASE(pg8::EpiBf16<0>, g, S, E); } }
        { REFRESH(); xcd_barrier_fast(bar, F.tid == 0); } TOC(3); TIC();
        REPEAT(REP_PREP) { REFRESH(); phase_mla_prep(F, l); }
        HT0(); REPEAT(REP_HY) { REFRESH(); phase_hyena(F, l); } HT1(40);
        { REFRESH(); xcd_barrier_fast(bar, F.tid == 0); } TOC(4); TIC();
        { unsigned char* w = (unsigned char*)wsq(F); bf16* CQN = (bf16*)(w + WS_CQN); bf16* CKVN = (bf16*)(w + WS_CKVN); bf16* WuqT = (bf16*)(w + WS_WUQ); bf16* WukvT = (bf16*)(w + WS_WUKV);
          bf16* Qb = (bf16*)(w + WS_Q); bf16* KV = (bf16*)(w + WS_KN);
          { pg8::Gemm g{CQN, WuqT, M, NQ, QR}; pg8::StaticOrder S; S.init(M, NQ, F.G, BXQ());
          pg8::EpiBf16<0> E{Qb, NQ, nullptr, 0, 0, 1.f}; GEMM_PHASE(pg8::EpiBf16<0>, g, S, E); }
        { pg8::Gemm g{CKVN, WukvT, M, NKV, KVR}; pg8::StaticOrder S; S.init(M, NKV, F.G, BXQ());
          pg8::EpiBf16<0> E{KV, NKV, nullptr, 0, 0, 1.f}; GEMM_PHASE(pg8::EpiBf16<0>, g, S, E); } }
        { REFRESH(); xcd_barrier_fast(bar, F.tid == 0); } TOC(5); TIC();
        REFRESH();
        HT0();
        { unsigned char* w = (unsigned char*)wsq(F); bf16* Qb = (bf16*)(w + WS_Q); bf16* KV = (bf16*)(w + WS_KN); bf16* KPE = (bf16*)(w + WS_KPE); bf16* MIX = (bf16*)(w + WS_MIX);
          const float* ct = (const float*)(w + WS_COS); const float* st = (const float*)(w + WS_SIN); const float* gat = (const float*)inp(F, I_GNAT) + l * 512;
        REPEAT(REP_ATT) for (int i = 0; i < (F.G == 256 ? 6 : (1536 - F.vcu + F.G - 1) / F.G); ++i) {
            const int u_ = F.vcu + i * F.G; const int bh = F.G == 256 ? 3 * (F.vcu >> 5) + (i >> 1) : u_ >> 6, qb = F.G == 256 ? (i & 1) * 32 + (F.vcu & 31) : u_ & 63; const int b = bh >> 3, h = bh & 7;
            const size_t row0 = (size_t)b * L + (size_t)qb * 256;
            if (!att::attn_unit<0, true>(Qb + row0 * NQ + h * DQ, KV + (size_t)b * L * NKV + h * 128, KPE + (size_t)b * L * ROPE, KV + (size_t)b * L * NKV + h * 128 + 64,
                           MIX + row0 * D + 512 + h * 64, gat + h * 64, ct, st, qb * 256, (LAS char*)(F.lds + RING_OFF), F.wave0))
                (void)att::attn_unit<0, false>(Qb + row0 * NQ + h * DQ, KV + (size_t)b * L * NKV + h * 128, KPE + (size_t)b * L * ROPE, KV + (size_t)b * L * NKV + h * 128 + 64,
                           MIX + row0 * D + 512 + h * 64, gat + h * 64, ct, st, qb * 256, (LAS char*)(F.lds + RING_OFF), F.wave0);
        } }
        HT1(32); HT0(); REPEAT(REP_HYOUT) { REFRESH(); phase_hy_out(F, l); } HT1(31);
        { REFRESH(); xcd_barrier_fast(bar, F.tid == 0); } TOC(6); TIC();
        { unsigned char* w = (unsigned char*)wsq(F); bf16* MIX = (bf16*)(w + WS_MIX); bf16* WoutT = (bf16*)(w + WS_WOUT); bf16* T = (bf16*)(w + WS_T);
          pg8::Gemm g{MIX, WoutT, M, D, D}; pg8::StaticOrder S; S.init(M, D, F.G, BXQ());
          pg8::EpiBf16<0> E{T, D, nullptr, 0, 0, 1.f}; GEMM_PHASE(pg8::EpiBf16<0>, g, S, E); }
        { REFRESH(); xcd_barrier_fast(bar, F.tid == 0); } TOC(7); TIC();
        REFRESH(); if (l == 0) phase_norm_res<true, false>(F, (const GAS bf16*)(wsq(F) + WS_T), inp(F, I_NMIXPOST) + l * D, inp(F, I_NMLPPRE) + l * D);
        else phase_norm_res<false, false>(F, (const GAS bf16*)(wsq(F) + WS_T), inp(F, I_NMIXPOST) + l * D, inp(F, I_NMLPPRE) + l * D);
        { REFRESH(); xcd_barrier_fast(bar, F.tid == 0); } TOC(8); TIC();
#pragma unroll 1
        for (int ch = 0; ch < N_MLP_CHUNKS; ++ch) {
            { unsigned char* w = (unsigned char*)wsq(F); bf16* XN = (bf16*)(w + WS_XN); bf16* WupT = (bf16*)(w + WS_WUP); bf16* Hb = (bf16*)(w + WS_H);
              pg8::Gemm g{XN + (size_t)ch * MLP_CHUNK * D, WupT, MLP_CHUNK, FF, D}; pg8::StaticOrder S; S.init(MLP_CHUNK, FF, F.G, BXQ());
              pg8::EpiRelu2 E{Hb, FF}; GEMM_PHASE(pg8::EpiRelu2, g, S, E); }
            { REFRESH(); xcd_barrier_fast(bar, F.tid == 0); } TOC(9); TIC();
            { unsigned char* w = (unsigned char*)wsq(F); bf16* Hb = (bf16*)(w + WS_H); bf16* WdownT = (bf16*)(w + WS_WDOWN); bf16* T = (bf16*)(w + WS_T);
              pg8::Gemm g{Hb, WdownT, MLP_CHUNK, D, FF}; pg8::StaticOrder S; S.init(MLP_CHUNK, D, F.G, BXQ());
              pg8::EpiBf16<0> E{T + (size_t)ch * MLP_CHUNK * D, D, nullptr, 0, 0, 1.f}; GEMM_PHASE(pg8::EpiBf16<0>, g, S, E); }
            { REFRESH(); xcd_barrier_fast(bar, F.tid == 0); } TOC(10); TIC();
        }
        REFRESH(); if (l + 1 < DEPTH) phase_norm_res<false, false>(F, (const GAS bf16*)(wsq(F) + WS_T), inp(F, I_NMLPPOST) + l * D, inp(F, I_NMIXPRE) + (l + 1) * D);
        else phase_norm_res<false, true>(F, (const GAS bf16*)(wsq(F) + WS_T), inp(F, I_NMLPPOST) + l * D, (const GAS float*)nullptr);
        { REFRESH(); xcd_barrier_fast(bar, F.tid == 0); } TOC(11); TIC();
    }
    if (HYSUB) { __syncthreads(); pr_acc += (unsigned long long)__builtin_amdgcn_readfirstlane((int)F.MISC[21]); }
    if (PROBE_MASK || HYSUB) { const unsigned long long ts = __builtin_amdgcn_s_memrealtime(); while (__builtin_amdgcn_s_memrealtime() - ts < pr_acc) __builtin_amdgcn_s_sleep(8); }
}


#ifdef ATT_BENCH
#ifndef ATT_BENCH_FAST
#define ATT_BENCH_FAST 0
#endif
__global__ void __launch_bounds__(NTHR, 2) attn_bench(Args args) {
    extern __shared__ __attribute__((aligned(16))) unsigned char lds[];
    unsigned char* w = args.ws; const int wave0 = __builtin_amdgcn_readfirstlane(threadIdx.x >> 6);
    const int G = gridDim.x, bxv = (int)blockIdx.x, vcu = (bxv % 8) * (G / 8) + bxv / 8;
    bf16* Qb = (bf16*)(w + WS_Q); bf16* KV = (bf16*)(w + WS_KN); bf16* KPE = (bf16*)(w + WS_KPE); bf16* OUT = (bf16*)(w + WS_H);
    const float* ct = (const float*)(w + WS_COS); const float* st = (const float*)(w + WS_SIN);
    for (int rep = 0; rep < ATT_BENCH_REPS; ++rep)
    for (int i = 0; i < 6; ++i) {
        const int bh = 3 * (vcu >> 5) + (i >> 1), qb = (i & 1) * 32 + (vcu & 31); const int b = bh >> 3, h = bh & 7;
        const size_t row0 = (size_t)b * L + (size_t)qb * 256;
        (void)att::attn_unit<ATT_BENCH, (ATT_BENCH_FAST != 0)>(Qb + row0 * NQ + h * DQ, KV + (size_t)b * L * NKV + h * 128, KPE + (size_t)b * L * ROPE, KV + (size_t)b * L * NKV + h * 128 + 64,
                       OUT + row0 * D + 512 + h * 64, args.in[I_GNAT] + h * 64, ct, st, qb * 256, (LAS char*)lds, wave0);
    }
}
#endif
extern "C" void kernel_launch(void* const* d_in, const int* in_sizes, int n_in, void* d_out, int out_size, void* d_ws, size_t ws_size, hipStream_t stream) {
    static int grid = 0;
    if (grid == 0) {
        if (n_in != 26 || out_size != M * D || ws_size < WS_END) { fprintf(stderr, "kernel_launch: shape mismatch n_in %d out %d ws %zu (need %zu)\n", n_in, out_size, ws_size, (size_t)WS_END); grid = -1; return; }
        int dev = 0, cus = 0, per_cu = 0;
        if (hipGetDevice(&dev) != hipSuccess || hipDeviceGetAttribute(&cus, hipDeviceAttributeMultiprocessorCount, dev) != hipSuccess) { grid = -1; return; }
        if (hipFuncSetAttribute((const void*)hyena_mla_fwd, hipFuncAttributeMaxDynamicSharedMemorySize, LDS_BYTES) != hipSuccess) { fprintf(stderr, "kernel_launch: hipFuncSetAttribute failed\n"); grid = -1; return; }
        if (hipOccupancyMaxActiveBlocksPerMultiprocessor(&per_cu, (const void*)hyena_mla_fwd, NTHR, LDS_BYTES) != hipSuccess || per_cu < 1) fprintf(stderr, "kernel_launch: occupancy query says %d\n", per_cu);
        (void)hipGetLastError();
        grid = cus;
    }
    if (grid < 0) return;
    if (hipMemsetAsync((char*)d_ws + WS_CTL, 0, CTL_ZERO_BYTES, stream) != hipSuccess) { fprintf(stderr, "kernel_launch: memset failed\n"); return; }
    Args a{};
    for (int i = 0; i < 26; ++i) a.in[i] = (const float*)d_in[i];
    a.out = (float*)d_out; a.ws = (unsigned char*)d_ws;
    hipLaunchKernelGGL(hyena_mla_fwd, dim3(grid), dim3(NTHR), LDS_BYTES, stream, a);
#ifdef ATT_BENCH
    { static int once = 0; if (!once) { (void)hipFuncSetAttribute((const void*)attn_bench, hipFuncAttributeMaxDynamicSharedMemorySize, LDS_BYTES); once = 1; }
      hipLaunchKernelGGL(attn_bench, dim3(grid), dim3(NTHR), LDS_BYTES, stream, a); }
#endif
    const hipError_t le = hipPeekAtLastError();
    if (le != hipSuccess) fprintf(stderr, "kernel_launch: launch failed: %s\n", hipGetErrorName(le));
}
```
